# Optimizing an MI355X kernel written in HIP

```python
import math
import jax
import jax.numpy as jnp
from jax import lax
import numpy as np

D_MODEL = 1024
BATCH = 2
SEQ = 16384
DEPTH = 4

CTX_LEN = 256
GRID_W = 64
N_MIXERS = 3
N_A = (DEPTH + 2) // 3
N_B = (DEPTH + 1) // 3
N_C = DEPTH // 3
EPS = 1e-6
N_MOD = 6

DN_HEADS = 8
DN_DK = D_MODEL // DN_HEADS
DN_DV = D_MODEL // DN_HEADS
DN_CHUNK = 64
DN_IN = 4 * D_MODEL + 4 * DN_HEADS

HY_ORDER = 2
HY_BANDS = 16
HY_EMB = 1 + 2 * HY_BANDS
HY_HIDDEN = 64
HY_TARGET = 1e-2
HY_FAST = 0.3
HY_SLOW = 1.5

N_EXPERTS = 32
N_GROUPS = 8
EXPERTS_PER_GROUP = N_EXPERTS // N_GROUPS
GROUP_SCORE_K = 2
TOP_K = 2
D_EXPERT = 512
MOE_BLOCK = 512

kernel_name = 'hybrid_deltanet_hyena_shortconv_grouped_moe_trunk'


def rmsnorm(x, gain):
    x32 = x.astype(jnp.float32)
    y = x32 * lax.rsqrt(jnp.mean(x32 * x32, axis=-1, keepdims=True) + EPS)
    return (y * gain.astype(jnp.float32)).astype(x.dtype)


def modulate(x, gain, shift, scale):
    return rmsnorm(x, gain) * (1 + scale) + shift


def l2norm(t):
    return t * lax.rsqrt(jnp.sum(t * t, axis=-1, keepdims=True) + EPS)


def short_conv(x, w, on_grid):
    b, l, ch = x.shape
    xs = x.reshape(b, l // GRID_W, GRID_W, ch) if on_grid else x.reshape(b, 1, l, ch)
    n = xs.shape[2]
    xp = jnp.pad(xs, ((0, 0), (0, 0), (1, 1), (0, 0)))
    y = w[0] * xp[:, :, 0:n] + w[1] * xp[:, :, 1:n + 1] + w[2] * xp[:, :, 2:n + 2]
    return y.reshape(b, l, ch)


def gated_delta_chunked(q, k, v, g, beta, s0):
    b, h, l, dk = q.shape
    dv = v.shape[-1]
    c = DN_CHUNK
    n = l // c
    q = q.reshape(b, h, n, c, dk)
    k = k.reshape(b, h, n, c, dk)
    v = v.reshape(b, h, n, c, dv)
    g = jnp.cumsum(g.reshape(b, h, n, c), axis=-1)
    beta = beta.reshape(b, h, n, c, 1)
    pos = jnp.arange(c)
    incl = pos[:, None] >= pos[None, :]
    strict = pos[:, None] > pos[None, :]
    decay = jnp.exp(jnp.where(incl, g[..., :, None] - g[..., None, :], -jnp.inf))
    kb = k * beta
    a_mat = jnp.einsum('bhnid,bhnjd->bhnij', kb, k) * jnp.where(strict, decay, 0.0)
    rhs = jnp.concatenate([v * beta, kb * jnp.exp(g)[..., None]], axis=-1)
    sol = lax.linalg.triangular_solve(a_mat + jnp.eye(c, dtype=a_mat.dtype), rhs,
                                      left_side=True, lower=True, unit_diagonal=True)
    u, w = sol[..., :dv], sol[..., dv:]
    attn = jnp.einsum('bhnid,bhnjd->bhnij', q, k) * decay
    g_last = g[..., -1:]
    q_dec = q * jnp.exp(g)[..., None]
    k_dec = k * jnp.exp(g_last - g)[..., None]

    def step(s, inp):
        qd, kd, uu, ww, at, gl = inp
        v_new = uu - jnp.einsum('bhck,bhkv->bhcv', ww, s)
        o = jnp.einsum('bhck,bhkv->bhcv', qd, s) + jnp.einsum('bhcs,bhsv->bhcv', at, v_new)
        s = s * jnp.exp(gl)[..., None] + jnp.einsum('bhck,bhcv->bhkv', kd, v_new)
        return s, o

    xs = tuple(jnp.moveaxis(t, 2, 0) for t in (q_dec, k_dec, u, w, attn, g_last))
    s_final, o = lax.scan(step, s0, xs)
    o = jnp.moveaxis(o, 0, 2).reshape(b, h, l, dv)
    return o, s_final


def deltanet_mixer(h_ctx, h_lat, w_in, conv_w, a_log, dt_bias, out_norm, w_out, need_ctx_out):
    d = D_MODEL
    nh = DN_HEADS
    f32 = jnp.float32

    def project(h, on_grid):
        b, l, _ = h.shape
        p = h @ w_in
        qkv = jax.nn.silu(short_conv(p[..., :3 * d], conv_w, on_grid))
        z = p[..., 3 * d:4 * d]
        a = p[..., 4 * d:4 * d + 2 * nh].reshape(b, l, 2, nh).astype(f32)
        bb = p[..., 4 * d + 2 * nh:].reshape(b, l, 2, nh).astype(f32)

        def heads(t):
            return jnp.transpose(t.reshape(b, l, nh, -1), (0, 2, 1, 3)).astype(f32)

        q, k, v = (heads(t) for t in jnp.split(qkv, 3, axis=-1))
        q = l2norm(q) * DN_DK ** -0.5
        k = l2norm(k)
        g = -jnp.exp(a_log.astype(f32)) * jax.nn.softplus(a + dt_bias.astype(f32))
        g = jnp.transpose(g, (2, 0, 3, 1))
        beta = jnp.transpose(jax.nn.sigmoid(bb), (2, 0, 3, 1))
        return q, k, v, g, beta, z

    def scan_both(q, k, v, g, beta, s_f, s_b):
        o_f, s_f = gated_delta_chunked(q, k, v, g[0], beta[0], s_f)
        rev = lambda t: jnp.flip(t, axis=2)
        o_b, s_b = gated_delta_chunked(rev(q), rev(k), rev(v), rev(g[1]), rev(beta[1]), s_b)
        return o_f + rev(o_b), s_f, s_b

    def finish(o, z, dtype):
        b, _, l, _ = o.shape
        o = jnp.transpose(o, (0, 2, 1, 3))
        o = o * lax.rsqrt(jnp.mean(o * o, axis=-1, keepdims=True) + EPS) * out_norm.astype(f32)
        o = o * jax.nn.silu(z.reshape(b, l, nh, DN_DV).astype(f32))
        return o.reshape(b, l, d).astype(dtype) @ w_out

    qc, kc, vc, gc, bc, zc = project(h_ctx, False)
    s0 = jnp.zeros((h_ctx.shape[0], nh, DN_DK, DN_DV), f32)
    o_c, s_f, s_b = scan_both(qc, kc, vc, gc, bc, s0, s0)
    ql, kl, vl, gla, bl, zl = project(h_lat, True)
    o_l, _, _ = scan_both(ql, kl, vl, gla, bl, s_f, s_b)
    y_lat = finish(o_l, zl, h_lat.dtype)
    y_ctx = finish(o_c, zc, h_ctx.dtype) if need_ctx_out else None
    return y_ctx, y_lat


def hyena_filters(l, w1, b1, freq, w2, b2, w3):
    f32 = jnp.float32
    pos = jnp.arange(l, dtype=f32)[:, None]
    t = pos / max(l - 1, 1)
    bands = jnp.linspace(1e-4, HY_BANDS - 1, HY_BANDS, dtype=f32)[None, :]
    ang = (2 * math.pi / l) * pos * bands
    feat = jnp.concatenate([t, jnp.cos(ang), -jnp.sin(ang)], axis=-1)
    fr = freq.astype(f32)
    hdn = jnp.sin(fr * (feat @ w1.astype(f32) + b1.astype(f32)))
    hdn = jnp.sin(fr * (hdn @ w2.astype(f32) + b2.astype(f32)))
    filt = (hdn @ w3.astype(f32)).reshape(l, HY_ORDER, 2, D_MODEL)
    deltas = jnp.abs(jnp.linspace(math.log(HY_TARGET) / HY_SLOW, math.log(HY_TARGET) / HY_FAST,
                                  D_MODEL, dtype=f32))
    window = jnp.exp(-t * deltas[None, :])
    return filt * window[:, None, None, :]


def two_sided_fftconv(u, h_fwd, h_bwd):
    l = u.shape[1]
    k = jnp.concatenate([h_fwd, jnp.zeros_like(h_fwd[:1]), jnp.flip(h_bwd[1:], axis=0)], axis=0)
    kf = jnp.fft.rfft(k, axis=0)
    uf = jnp.fft.rfft(u, n=2 * l, axis=1)
    return jnp.fft.irfft(uf * kf[None], n=2 * l, axis=1)[:, :l]


def hyena_stream(h, on_grid, w_in, conv_w, f_w1, f_b1, f_freq, f_w2, f_b2, f_w3, bias, w_out):
    l = h.shape[1]
    p = short_conv(h @ w_in, conv_w, on_grid)
    v, x1, x2 = jnp.split(p, 3, axis=-1)
    filt = hyena_filters(l, f_w1, f_b1, f_freq, f_w2, f_b2, f_w3)
    z = v.astype(jnp.float32)
    for n, gate in enumerate((x1, x2)):
        conv = two_sided_fftconv(z, filt[:, n, 0], filt[:, n, 1])
        z = gate.astype(jnp.float32) * (conv + bias[n].astype(jnp.float32) * z)
    return z.astype(h.dtype) @ w_out


def shortconv_stream(h, on_grid, w_in, conv_w, w_out):
    bg, cg, xin = jnp.split(h @ w_in, 3, axis=-1)
    return (bg * short_conv(cg * xin, conv_w, on_grid)) @ w_out


def route(h, w_router, router_bias):
    t = h.shape[0]
    scores = jax.nn.sigmoid(h.astype(jnp.float32) @ w_router.astype(jnp.float32))
    choice = (scores + router_bias.astype(jnp.float32)).reshape(t, N_GROUPS, EXPERTS_PER_GROUP)
    group_score = lax.top_k(choice, GROUP_SCORE_K)[0].sum(-1)
    group = jnp.argmax(group_score, axis=-1)
    in_group = jnp.take_along_axis(choice, group[:, None, None], axis=1)[:, 0]
    local = lax.top_k(in_group, TOP_K)[1]
    expert = group[:, None] * EXPERTS_PER_GROUP + local
    weight = jnp.take_along_axis(scores, expert, axis=1)
    weight = weight / jnp.sum(weight, axis=-1, keepdims=True)
    return expert.astype(jnp.int32), weight


def moe_ffn(x, w_router, router_bias, w_gate, w_up, w_down):
    t, d = x.shape
    expert, weight = route(x, w_router, router_bias)
    a = t * TOP_K
    e_flat = expert.reshape(-1)
    order = jnp.argsort(e_flat)
    e_sorted = e_flat[order]
    tok_sorted = (order // TOP_K).astype(jnp.int32)
    w_sorted = weight.reshape(-1)[order]
    counts = jnp.zeros((N_EXPERTS,), jnp.int32).at[e_flat].add(1)
    start = jnp.cumsum(counts) - counts
    padded = (counts + MOE_BLOCK - 1) // MOE_BLOCK * MOE_BLOCK
    pend = jnp.cumsum(padded)
    pstart = pend - padded
    dest = pstart[e_sorted] + (jnp.arange(a, dtype=jnp.int32) - start[e_sorted])
    n_blocks = -(-a // MOE_BLOCK) + N_EXPERTS
    n_slots = n_blocks * MOE_BLOCK
    slot_tok = jnp.full((n_slots,), t, jnp.int32).at[dest].set(tok_sorted)
    slot_w = jnp.zeros((n_slots,), jnp.float32).at[dest].set(w_sorted)
    block_start = jnp.arange(n_blocks, dtype=jnp.int32) * MOE_BLOCK
    block_expert = jnp.minimum(jnp.searchsorted(pend, block_start, side='right'), N_EXPERTS - 1)
    x_pad = jnp.concatenate([x, jnp.zeros((1, d), x.dtype)], axis=0)
    xs = x_pad[slot_tok].reshape(n_blocks, MOE_BLOCK, d)

    def expert_block(args):
        e, xb = args
        hid = jax.nn.silu(xb @ w_gate[e]) * (xb @ w_up[e])
        return hid @ w_down[e]

    ys = lax.map(expert_block, (block_expert, xs)).reshape(n_slots, d)
    ys = ys * slot_w[:, None].astype(ys.dtype)
    return jnp.zeros((t + 1, d), ys.dtype).at[slot_tok].add(ys)[:t]


def setup_inputs(seed: int = 0) -> dict:
    key = jax.random.key(seed)
    ks = iter(jax.random.split(key, 48))
    f32 = jnp.float32

    def nrm(shape, s):
        return jax.random.normal(next(ks), shape, f32) * s

    d = D_MODEL
    inv = d ** -0.5
    dt = jnp.exp(jax.random.uniform(next(ks), (N_A, 2, DN_HEADS), f32, math.log(1e-3), math.log(1e-1)))
    dn_dt_bias = dt + jnp.log(-jnp.expm1(-dt))
    dn_a_log = jnp.log(jax.random.uniform(next(ks), (N_A, 2, DN_HEADS), f32, 1.0, 16.0))
    return {
        'x': nrm((BATCH, SEQ, d), 1.0),
        'c': nrm((BATCH, d), 1.0),
        'ctx': nrm((BATCH, CTX_LEN, d), 1.0),
        'c_ctx': nrm((d,), 1.0),
        'ada_w': nrm((DEPTH, d, N_MOD * d), 0.5 * inv),
        'ada_b': nrm((DEPTH, N_MOD * d), 0.02),
        'norm_mix': 1.0 + nrm((DEPTH, d), 0.05),
        'norm_ffn': 1.0 + nrm((DEPTH, d), 0.05),
        'norm_final': 1.0 + nrm((d,), 0.05),
        'dn_w_in': nrm((N_A, d, DN_IN), inv),
        'dn_conv': nrm((N_A, 3, 3 * d), 3 ** -0.5),
        'dn_a_log': dn_a_log,
        'dn_dt_bias': dn_dt_bias,
        'dn_out_norm': 1.0 + nrm((N_A, DN_DV), 0.05),
        'dn_w_out': nrm((N_A, d, d), inv),
        'hy_w_in': nrm((N_B, d, 3 * d), inv),
        'hy_conv': nrm((N_B, 3, 3 * d), 3 ** -0.5),
        'hy_f_w1': nrm((N_B, HY_EMB, HY_HIDDEN), HY_EMB ** -0.5),
        'hy_f_b1': nrm((N_B, HY_HIDDEN), 0.2),
        'hy_f_freq': 1.0 + nrm((N_B, HY_HIDDEN), 0.1),
        'hy_f_w2': nrm((N_B, HY_HIDDEN, HY_HIDDEN), HY_HIDDEN ** -0.5),
        'hy_f_b2': nrm((N_B, HY_HIDDEN), 0.2),
        'hy_f_w3': nrm((N_B, HY_HIDDEN, HY_ORDER * 2 * d), 0.02 * HY_HIDDEN ** -0.5),
        'hy_bias': nrm((N_B, HY_ORDER, d), 0.5),
        'hy_w_out': nrm((N_B, d, d), inv),
        'sc_w_in': nrm((N_C, d, 3 * d), inv),
        'sc_conv': nrm((N_C, 3, d), 3 ** -0.5),
        'sc_w_out': nrm((N_C, d, d), inv),
        'w_router': nrm((d, N_EXPERTS), inv),
        'router_bias': nrm((N_EXPERTS,), 0.01),
        'moe_w_gate': nrm((DEPTH, N_EXPERTS, d, D_EXPERT), inv),
        'moe_w_up': nrm((DEPTH, N_EXPERTS, d, D_EXPERT), inv),
        'moe_w_down': nrm((DEPTH, N_EXPERTS, D_EXPERT, d), D_EXPERT ** -0.5),
    }


def reference(x, c, ctx, c_ctx, ada_w, ada_b, norm_mix, norm_ffn, norm_final,
              dn_w_in, dn_conv, dn_a_log, dn_dt_bias, dn_out_norm, dn_w_out,
              hy_w_in, hy_conv, hy_f_w1, hy_f_b1, hy_f_freq, hy_f_w2, hy_f_b2, hy_f_w3, hy_bias, hy_w_out,
              sc_w_in, sc_conv, sc_w_out,
              w_router, router_bias, moe_w_gate, moe_w_up, moe_w_down):
    d = D_MODEL
    silu_c = jax.nn.silu(c)
    silu_cc = jax.nn.silu(c_ctx)
    for i in range(DEPTH):
        last = i == DEPTH - 1
        kind, j = i % N_MIXERS, i // N_MIXERS
        ml = jnp.split((silu_c @ ada_w[i] + ada_b[i])[:, None, :], N_MOD, axis=-1)
        mc = jnp.split(silu_cc @ ada_w[i] + ada_b[i], N_MOD, axis=-1)
        h_lat = modulate(x, norm_mix[i], ml[0], ml[1])
        h_ctx = modulate(ctx, norm_mix[i], mc[0], mc[1]) if (kind == 0 or not last) else None
        if kind == 0:
            y_ctx, y_lat = deltanet_mixer(h_ctx, h_lat, dn_w_in[j], dn_conv[j], dn_a_log[j], dn_dt_bias[j],
                                          dn_out_norm[j], dn_w_out[j], not last)
        elif kind == 1:
            hy = (hy_w_in[j], hy_conv[j], hy_f_w1[j], hy_f_b1[j], hy_f_freq[j], hy_f_w2[j], hy_f_b2[j],
                  hy_f_w3[j], hy_bias[j], hy_w_out[j])
            y_lat = hyena_stream(h_lat, True, *hy)
            y_ctx = None if last else hyena_stream(h_ctx, False, *hy)
        else:
            scw = (sc_w_in[j], sc_conv[j], sc_w_out[j])
            y_lat = shortconv_stream(h_lat, True, *scw)
            y_ctx = None if last else shortconv_stream(h_ctx, False, *scw)
        x = x + ml[2] * y_lat
        f_lat = modulate(x, norm_ffn[i], ml[3], ml[4])
        if last:
            out = moe_ffn(f_lat.reshape(-1, d), w_router, router_bias, moe_w_gate[i], moe_w_up[i], moe_w_down[i])
            x = x + ml[5] * out.reshape(x.shape)
        else:
            ctx = ctx + mc[2] * y_ctx
            f_ctx = modulate(ctx, norm_ffn[i], mc[3], mc[4])
            n_ctx = ctx.shape[0] * ctx.shape[1]
            tokens = jnp.concatenate([f_ctx.reshape(-1, d), f_lat.reshape(-1, d)], axis=0)
            out = moe_ffn(tokens, w_router, router_bias, moe_w_gate[i], moe_w_up[i], moe_w_down[i])
            ctx = ctx + mc[5] * out[:n_ctx].reshape(ctx.shape)
            x = x + ml[5] * out[n_ctx:].reshape(x.shape)
    return rmsnorm(x, norm_final)
```

```cpp
#include <hip/hip_runtime.h>
#include <stdint.h>
#include <stdio.h>
#include <math.h>

#ifndef MK_MULTI
#define MK_MULTI 0
#endif

#define LAS __attribute__((address_space(3)))
#define HD __host__ __device__ __forceinline__
#define DI __device__ __forceinline__
#ifdef NOINL
#define PF __device__ __noinline__
#else
#define PF __device__ __forceinline__
#endif
typedef unsigned short bf16_t;
typedef short bf16x8 __attribute__((ext_vector_type(8)));
typedef float f32x4 __attribute__((ext_vector_type(4)));
typedef unsigned u32x4 __attribute__((ext_vector_type(4)));
typedef unsigned u32x2 __attribute__((ext_vector_type(2)));

constexpr int D = 1024, NB = 2, SEQ = 16384, CTXL = 256, DEPTH = 4;
constexpr int TC = NB * CTXL, TL = NB * SEQ, T = TC + TL, NA = 2 * T;
constexpr int NTHR = 512;
constexpr int DN_IN = 4128;
constexpr float EPS = 1e-6f;
constexpr int LDS_BYTES = 140 * 1024;

constexpr size_t AL(size_t x) { return (x + 255) & ~(size_t)255; }
constexpr size_t WS_CTL = 0;
constexpr size_t CTL_BYTES = 65536;
constexpr size_t CTL_CNT = 16384;
constexpr size_t WS_MOD = WS_CTL + CTL_BYTES;
constexpr size_t WS_HDNL = AL(WS_MOD + 4 * 3 * 6144 * 4);
constexpr size_t WS_HDNC = AL(WS_HDNL + 16384 * 64 * 4);
constexpr size_t WS_FILTC = AL(WS_HDNC + 256 * 64 * 4);
constexpr size_t WS_DNWIN = AL(WS_FILTC + 256 * 4096 * 4);
constexpr size_t WS_DNWOUT = AL(WS_DNWIN + (size_t)2 * 4096 * 1024 * 2);
constexpr size_t WS_HYWIN = AL(WS_DNWOUT + (size_t)2 * 1024 * 1024 * 2);
constexpr size_t WS_HYWOUT = AL(WS_HYWIN + (size_t)3072 * 1024 * 2);
constexpr size_t WS_SCWIN = AL(WS_HYWOUT + (size_t)1024 * 1024 * 2);
constexpr size_t WS_SCWOUT = AL(WS_SCWIN + (size_t)3072 * 1024 * 2);
constexpr size_t WS_XS = AL(WS_SCWOUT + (size_t)1024 * 1024 * 2);
constexpr size_t WS_TOKE = AL(WS_XS + (size_t)T * 1024 * 4);
constexpr size_t WS_TOKW = AL(WS_TOKE + (size_t)T * 2 * 4);
constexpr size_t WS_TOKP = AL(WS_TOKW + (size_t)T * 2 * 4);
constexpr size_t WS_SLOT = AL(WS_TOKP + (size_t)T * 2 * 4);
constexpr size_t WS_GB = AL(WS_SLOT + (size_t)NA * 4);
constexpr size_t WS_AR = AL(WS_GB + (size_t)T * 32 * 4);
constexpr size_t AR_HBUF = WS_AR;
constexpr size_t AR_UBUF = AR_HBUF + (size_t)T * 1024 * 2;
constexpr size_t AR_PB = AR_UBUF + (size_t)T * 1024 * 2;
constexpr size_t AR_Q = AR_PB + (size_t)T * 4096 * 2;
constexpr size_t AR_QKV = AR_Q;
constexpr size_t AR_O = AR_QKV + (size_t)T * 3072 * 2;
constexpr size_t AR_DN_END = AR_O + (size_t)2 * T * 1024 * 4;
constexpr size_t AR_ZT = AR_Q;
constexpr size_t AR_FFTS = AR_ZT + (size_t)1024 * T * 2;
constexpr size_t AR_HY_END = AR_FFTS + (size_t)256 * 4 * 16384 * 8;
constexpr size_t AR_HID = AR_PB;
constexpr size_t AR_YS = AR_HID + (size_t)NA * 512 * 2;
constexpr size_t AR_WGU = AR_YS + (size_t)NA * 1024 * 2;
constexpr size_t AR_WD = AR_WGU + (size_t)32 * 1024 * 1024 * 2;
constexpr size_t AR_MOE_END = AR_WD + (size_t)32 * 1024 * 512 * 2;
constexpr size_t WS_END = AR_DN_END > AR_HY_END ? (AR_DN_END > AR_MOE_END ? AR_DN_END : AR_MOE_END) : (AR_HY_END > AR_MOE_END ? AR_HY_END : AR_MOE_END);

#define XB_TMO      128
#define XB_XCNT(j)  (256  + 64 * (j))
#define XB_XSUB(j)  (1280 + 64 * (j))
#define XB_XGEN(j)  (2304 + 64 * (j))
#define XB_TOP      3328
#define XB_TOPGEN   3392
#define XCD_BAR_WORDS 3456
#define XB_SPIN_CAP (1u << 25)
DI unsigned xb_ld(unsigned* p)              { return __hip_atomic_load(p, __ATOMIC_RELAXED, __HIP_MEMORY_SCOPE_AGENT); }
DI unsigned xb_add(unsigned* p, unsigned v) { return __hip_atomic_fetch_add(p, v, __ATOMIC_RELAXED, __HIP_MEMORY_SCOPE_AGENT); }
DI unsigned xb_xcc_id() { return (unsigned)__builtin_amdgcn_s_getreg((3 << 11) | 20) & 0xFu; }
#define XB_SPIN(cond, bar) do { unsigned _sp = 0; while (cond) { __builtin_amdgcn_s_sleep(1); \
    if ((++_sp & 255u) == 0u) { if (xb_ld(&(bar)[XB_TMO])) break; if (_sp > XB_SPIN_CAP) { atomicAdd(&(bar)[XB_TMO], 1u); break; } } } } while (0)
struct XcdBarrier { unsigned* bar; unsigned x; volatile LAS unsigned* st; };
DI XcdBarrier xcd_barrier_post(unsigned* bar, volatile LAS unsigned* st) {
    XcdBarrier b; b.bar = bar; b.x = xb_xcc_id(); b.st = st;
    if (threadIdx.x == 0) (void)xb_add(&bar[XB_XCNT(b.x)], 1u);
    return b;
}
DI void xcd_barrier_complete(unsigned* bar, unsigned x, unsigned& nloc, unsigned& nx) {
    const unsigned G = gridDim.x * gridDim.y * gridDim.z;
    unsigned sum, cnt, mine, sp = 0u;
    for (;;) {
        sum = 0u; cnt = 0u; mine = 0u;
#pragma unroll
        for (unsigned j = 0; j < 16; ++j) { const unsigned c = xb_ld(&bar[XB_XCNT(j)]); sum += c; cnt += (c > 0u) ? 1u : 0u; mine = (j == x) ? c : mine; }
        if (sum == G) break;
        __builtin_amdgcn_s_sleep(1);
        if ((++sp & 255u) == 0u) { if (xb_ld(&bar[XB_TMO])) break; if (sp > XB_SPIN_CAP) { atomicAdd(&bar[XB_TMO], 1u); break; } }
    }
    nloc = mine > 0u ? mine : 1u; nx = cnt > 0u ? cnt : 1u;
}
DI void xcd_barrier(const XcdBarrier& b) {
    asm volatile("s_waitcnt vmcnt(0)" ::: "memory");
    __syncthreads();
    if (threadIdx.x == 0) {
        unsigned* bar = b.bar;
        __builtin_amdgcn_s_waitcnt(0);
        unsigned nloc = b.st[0], nx = b.st[1];
        if (nloc == 0u) { xcd_barrier_complete(bar, b.x, nloc, nx); b.st[0] = nloc; b.st[1] = nx; }
        const unsigned old = xb_add(&bar[XB_XSUB(b.x)], 1u);
        const unsigned gen = old / nloc;
        if (old + 1u == (gen + 1u) * nloc) {
            __builtin_amdgcn_fence(__ATOMIC_RELEASE, "agent");
            asm volatile("s_waitcnt vmcnt(0)" ::: "memory");
            const unsigned og = xb_add(&bar[XB_TOP], 1u);
            const unsigned tg = og / nx;
            if (og + 1u == (tg + 1u) * nx) xb_add(&bar[XB_TOPGEN], 1u);
            else XB_SPIN(xb_ld(&bar[XB_TOPGEN]) == tg, bar);
            __builtin_amdgcn_fence(__ATOMIC_ACQUIRE, "agent");
            xb_add(&bar[XB_XGEN(b.x)], 1u);
            asm volatile("s_waitcnt vmcnt(0)" ::: "memory");
        } else {
            XB_SPIN(xb_ld(&bar[XB_XGEN(b.x)]) == gen, bar);
            __builtin_amdgcn_fence(__ATOMIC_ACQUIRE, "agent");
            asm volatile("s_waitcnt vmcnt(0)" ::: "memory");
        }
    }
    __syncthreads();
}

DI bf16_t f2bf(float f) { unsigned u = __float_as_uint(f); u += 0x7fffu + ((u >> 16) & 1u); return (bf16_t)(u >> 16); }
DI float bf2f(bf16_t b) { return __uint_as_float(((unsigned)b) << 16); }
DI unsigned pk2(float lo, float hi) { return (unsigned)f2bf(lo) | ((unsigned)f2bf(hi) << 16); }
DI float siluf(float x) { return x / (1.0f + __expf(-x)); }
DI float sigmf(float x) { return 1.0f / (1.0f + __expf(-x)); }
DI float wsum(float v) {
#pragma unroll
    for (int m = 32; m >= 1; m >>= 1) v += __shfl_xor(v, m);
    return v;
}
DI int TID() { int t = threadIdx.x; asm volatile("" : "+v"(t)); return t; }
DI int modrow(int r) { return r < TC ? 0 : 1 + (r - TC) / SEQ; }

typedef float cf __attribute__((ext_vector_type(2)));
HD cf cmul(cf a, cf b) { cf r; r.x = a.x * b.x - a.y * b.y; r.y = a.x * b.y + a.y * b.x; return r; }
HD cf cadd(cf a, cf b) { cf r; r.x = a.x + b.x; r.y = a.y + b.y; return r; }
HD cf csub(cf a, cf b) { cf r; r.x = a.x - b.x; r.y = a.y - b.y; return r; }
template <int R> HD constexpr int brev(int i) { int r = 0; for (int b = 1, t = R >> 1; b < R; b <<= 1, t >>= 1) if (i & b) r |= t; return r; }
#define FFT_C32 {1.0f, 0.98078528040323044913f, 0.92387953251128675613f, 0.83146961230254523708f, 0.70710678118654752440f, 0.55557023301960222474f, 0.38268343236508977173f, 0.19509032201612826785f, 0.0f, -0.19509032201612826785f, -0.38268343236508977173f, -0.55557023301960222474f, -0.70710678118654752440f, -0.83146961230254523708f, -0.92387953251128675613f, -0.98078528040323044913f}
#define FFT_S32 {0.0f, 0.19509032201612826785f, 0.38268343236508977173f, 0.55557023301960222474f, 0.70710678118654752440f, 0.83146961230254523708f, 0.92387953251128675613f, 0.98078528040323044913f, 1.0f, 0.98078528040323044913f, 0.92387953251128675613f, 0.83146961230254523708f, 0.70710678118654752440f, 0.55557023301960222474f, 0.38268343236508977173f, 0.19509032201612826785f}
template <int R> HD constexpr int ilog2c() { int l = 0; for (int r = R; r > 1; r >>= 1) ++l; return l; }
template <int R> HD void dft_fwd(cf (&v)[R]) {
    constexpr float C[16] = FFT_C32; constexpr float S[16] = FFT_S32;
    constexpr int LG = ilog2c<R>();
#pragma unroll
    for (int st = 0; st < LG; ++st) {
#pragma unroll
        for (int i = 0; i < R / 2; ++i) {
            const int len = R >> st, half = len >> 1, blk = i / half, j = i % half, i0 = blk * len + j, i1 = i0 + half;
            const cf a = v[i0], c = v[i1];
            v[i0] = cadd(a, c);
            const cf d = csub(a, c);
            const int ti = j * (32 / len);
            cf w; w.x = C[ti]; w.y = -S[ti];
            v[i1] = (ti == 0) ? d : cmul(d, w);
        }
    }
}
template <int R> HD void dft_inv(cf (&v)[R]) {
    constexpr float C[16] = FFT_C32; constexpr float S[16] = FFT_S32;
    constexpr int LG = ilog2c<R>();
#pragma unroll
    for (int st = LG - 1; st >= 0; --st) {
#pragma unroll
        for (int i = 0; i < R / 2; ++i) {
            const int len = R >> st, half = len >> 1, blk = i / half, j = i % half, i0 = blk * len + j, i1 = i0 + half;
            const int ti = j * (32 / len);
            cf w; w.x = C[ti]; w.y = S[ti];
            const cf a = v[i0];
            const cf c = (ti == 0) ? v[i1] : cmul(v[i1], w);
            v[i0] = cadd(a, c);
            v[i1] = csub(a, c);
        }
    }
}
template <int R> DI void fft_pass_fwd(LAS cf* X, int n, int g) {
    const int s = n / R, q = g / s, p = g - q * s, base = q * n + p;
    cf v[R];
#pragma unroll
    for (int k = 0; k < R; ++k) v[k] = X[base + k * s];
    dft_fwd<R>(v);
    if (s > 1) {
        int pp = p; asm volatile("" : "+v"(pp));
        float sn, cs; sincospif(-2.0f * (float)pp / (float)n, &sn, &cs);
        cf w1; w1.x = cs; w1.y = sn; cf w = w1;
#pragma unroll
        for (int m = 1; m < R; ++m) { v[brev<R>(m)] = cmul(v[brev<R>(m)], w); w = cmul(w, w1); }
    }
#pragma unroll
    for (int k = 0; k < R; ++k) X[base + k * s] = v[k];
}
template <int R> DI void fft_pass_inv(LAS cf* X, int n, int g) {
    const int s = n / R, q = g / s, p = g - q * s, base = q * n + p;
    cf v[R];
#pragma unroll
    for (int k = 0; k < R; ++k) v[k] = X[base + k * s];
    if (s > 1) {
        int pp = p; asm volatile("" : "+v"(pp));
        float sn, cs; sincospif(2.0f * (float)pp / (float)n, &sn, &cs);
        cf w1; w1.x = cs; w1.y = sn; cf w = w1;
#pragma unroll
        for (int m = 1; m < R; ++m) { v[brev<R>(m)] = cmul(v[brev<R>(m)], w); w = cmul(w, w1); }
    }
    dft_inv<R>(v);
#pragma unroll
    for (int k = 0; k < R; ++k) X[base + k * s] = v[k];
}
DI void fft16k_fwd(LAS cf* X) {
    const int t = TID();
#pragma unroll 1
    for (int g = 0; g < 2; ++g) fft_pass_fwd<16>(X, 16384, t + 512 * g);
    __syncthreads();
#pragma unroll 1
    for (int g = 0; g < 2; ++g) fft_pass_fwd<16>(X, 1024, t + 512 * g);
    __syncthreads();
#pragma unroll 1
    for (int g = 0; g < 2; ++g) fft_pass_fwd<16>(X, 64, t + 512 * g);
    __syncthreads();
#pragma unroll 1
    for (int g = 0; g < 8; ++g) fft_pass_fwd<4>(X, 4, t + 512 * g);
    __syncthreads();
}
DI void fft16k_inv(LAS cf* X) {
    const int t = TID();
#pragma unroll 1
    for (int g = 0; g < 8; ++g) fft_pass_inv<4>(X, 4, t + 512 * g);
    __syncthreads();
#pragma unroll 1
    for (int g = 0; g < 2; ++g) fft_pass_inv<16>(X, 64, t + 512 * g);
    __syncthreads();
#pragma unroll 1
    for (int g = 0; g < 2; ++g) fft_pass_inv<16>(X, 1024, t + 512 * g);
    __syncthreads();
#pragma unroll 1
    for (int g = 0; g < 2; ++g) fft_pass_inv<16>(X, 16384, t + 512 * g);
    __syncthreads();
}

struct Params { const float* in[33]; float* out; unsigned char* ws; int ph_lo, ph_hi; };
struct KC {
    const float *x, *c, *ctx, *c_ctx, *ada_w, *ada_b, *norm_mix, *norm_ffn, *norm_final;
    const float *dn_w_in, *dn_conv, *dn_a_log, *dn_dt_bias, *dn_out_norm, *dn_w_out;
    const float *hy_w_in, *hy_conv, *hy_f_w1, *hy_f_b1, *hy_f_freq, *hy_f_w2, *hy_f_b2, *hy_f_w3, *hy_bias, *hy_w_out;
    const float *sc_w_in, *sc_conv, *sc_w_out, *w_router, *router_bias, *moe_w_gate, *moe_w_up, *moe_w_down;
    float* out; unsigned char* ws;
};

PF void job_mod(const KC& k, LAS float* lds) {
    const int tid = TID(), cj = tid & 63, kq = tid >> 6;
    float* mod = (float*)(k.ws + WS_MOD);
    for (int u = blockIdx.x; u < DEPTH * 96; u += gridDim.x) {
        const int l = u / 96, cc = u % 96, col = cc * 64 + cj;
        const float* W = k.ada_w + (size_t)l * 1024 * 6144;
        float a0 = 0.f, a1 = 0.f, a2 = 0.f;
        for (int kk = kq * 128; kk < kq * 128 + 128; ++kk) {
            const float w = W[(size_t)kk * 6144 + col];
            a0 += siluf(k.c_ctx[kk]) * w; a1 += siluf(k.c[kk]) * w; a2 += siluf(k.c[1024 + kk]) * w;
        }
        lds[(kq * 3 + 0) * 64 + cj] = a0; lds[(kq * 3 + 1) * 64 + cj] = a1; lds[(kq * 3 + 2) * 64 + cj] = a2;
        __syncthreads();
        if (tid < 192) {
            const int r = tid >> 6, j = tid & 63;
            float s = 0.f;
            for (int q = 0; q < 8; ++q) s += lds[(q * 3 + r) * 64 + j];
            mod[(size_t)(l * 3 + r) * 6144 + cc * 64 + j] = s + k.ada_b[l * 6144 + cc * 64 + j];
        }
        __syncthreads();
    }
}
DI void cvt_tile(const float* __restrict__ src, int ld, bf16_t* __restrict__ dst, int ldd, int k0, int n0, int mapmode, LAS float* lds) {
    const int tid = TID();
    { const int r = tid >> 4, c4 = (tid & 15) * 4;
#pragma unroll
      for (int h = 0; h < 2; ++h) {
          const f32x4 v = *(const f32x4*)(src + (size_t)(k0 + r + 32 * h) * ld + n0 + c4);
          LAS float* p = lds + (r + 32 * h) * 65 + c4; p[0] = v[0]; p[1] = v[1]; p[2] = v[2]; p[3] = v[3];
      } }
    __syncthreads();
    { const int nn = tid >> 3, ks = (tid & 7) * 8; const int n = n0 + nn;
      const int row = mapmode == 0 ? n : (32 * (n >> 4) + (n & 15) + (mapmode == 2 ? 16 : 0));
      u32x4 o;
      o[0] = pk2(lds[(ks + 0) * 65 + nn], lds[(ks + 1) * 65 + nn]); o[1] = pk2(lds[(ks + 2) * 65 + nn], lds[(ks + 3) * 65 + nn]);
      o[2] = pk2(lds[(ks + 4) * 65 + nn], lds[(ks + 5) * 65 + nn]); o[3] = pk2(lds[(ks + 6) * 65 + nn], lds[(ks + 7) * 65 + nn]);
      *(u32x4*)(dst + (size_t)row * ldd + k0 + ks) = o; }
    __syncthreads();
}
DI void cvt_matrix(const float* src, int ld, size_t sstride, int K, int N, int nmat, bf16_t* dst, int ldd, size_t dstride, int mapmode, LAS float* lds) {
    const int tk = K / 64, tn = N / 64, per = tk * tn;
    for (int u = blockIdx.x; u < per * nmat; u += gridDim.x) {
        const int m = u / per, t = u % per;
        cvt_tile(src + (size_t)m * sstride, ld, dst + (size_t)m * dstride, ldd, (t / tn) * 64, (t % tn) * 64, mapmode, lds);
    }
}
PF void job_cvt_small(const KC& k, LAS float* lds) {
    cvt_matrix(k.dn_w_in, DN_IN, (size_t)1024 * DN_IN, 1024, 4096, 2, (bf16_t*)(k.ws + WS_DNWIN), 1024, (size_t)4096 * 1024, 0, lds);
    cvt_matrix(k.dn_w_out, 1024, (size_t)1024 * 1024, 1024, 1024, 2, (bf16_t*)(k.ws + WS_DNWOUT), 1024, (size_t)1024 * 1024, 0, lds);
    cvt_matrix(k.hy_w_in, 3072, 0, 1024, 3072, 1, (bf16_t*)(k.ws + WS_HYWIN), 1024, 0, 0, lds);
    cvt_matrix(k.hy_w_out, 1024, 0, 1024, 1024, 1, (bf16_t*)(k.ws + WS_HYWOUT), 1024, 0, 0, lds);
    cvt_matrix(k.sc_w_in, 3072, 0, 1024, 3072, 1, (bf16_t*)(k.ws + WS_SCWIN), 1024, 0, 0, lds);
    cvt_matrix(k.sc_w_out, 1024, 0, 1024, 1024, 1, (bf16_t*)(k.ws + WS_SCWOUT), 1024, 0, 0, lds);
}
PF void job_cvt_moe(const KC& k, int layer, LAS float* lds) {
    const size_t lo = (size_t)layer * 32 * 1024 * 512;
    cvt_matrix(k.moe_w_gate + lo, 512, (size_t)1024 * 512, 1024, 512, 32, (bf16_t*)(k.ws + AR_WGU), 1024, (size_t)1024 * 1024, 1, lds);
    cvt_matrix(k.moe_w_up + lo, 512, (size_t)1024 * 512, 1024, 512, 32, (bf16_t*)(k.ws + AR_WGU), 1024, (size_t)1024 * 1024, 2, lds);
    cvt_matrix(k.moe_w_down + lo, 1024, (size_t)512 * 1024, 512, 1024, 32, (bf16_t*)(k.ws + AR_WD), 512, (size_t)1024 * 512, 0, lds);
}
PF void job_hdn(const KC& k, LAS float* lds) {
    const int tid = TID(), lane = tid & 63, wave = tid >> 6;
    LAS float* feat = lds + wave * 128; LAS float* h1 = feat + 64;
    const float fr = k.hy_f_freq[lane], b1 = k.hy_f_b1[lane], b2 = k.hy_f_b2[lane];
    for (int u0 = blockIdx.x * 8; u0 < 16384 + 256; u0 += gridDim.x * 8) {
        const int u = u0 + wave;
        int l, pos; float* dst;
        if (u < 16384) { l = 16384; pos = u; dst = (float*)(k.ws + WS_HDNL) + (size_t)u * 64; }
        else { l = 256; pos = u - 16384; dst = (float*)(k.ws + WS_HDNC) + (size_t)pos * 64; }
        const float t = (float)pos / (float)(l - 1);
        float f = 0.f;
        if (lane == 0) f = t;
        else if (lane <= 32) {
            const int bi = (lane - 1) & 15;
            const float band = 1e-4f + (float)bi * ((15.0f - 1e-4f) / 15.0f);
            const float ang = (6.283185307179586f / (float)l) * (float)pos * band;
            f = lane <= 16 ? cosf(ang) : -sinf(ang);
        }
        feat[lane] = f;
        __syncthreads();
        float a = b1;
        for (int i = 0; i < 33; ++i) a += feat[i] * k.hy_f_w1[i * 64 + lane];
        h1[lane] = sinf(fr * a);
        __syncthreads();
        float a2 = b2;
        for (int j = 0; j < 64; ++j) a2 += h1[j] * k.hy_f_w2[j * 64 + lane];
        dst[lane] = sinf(fr * a2);
        __syncthreads();
    }
}
DI float hy_delta(int ch) {
    const float lo = -4.605170185988091f / 1.5f, hi = -4.605170185988091f / 0.3f;
    return fabsf(lo + (float)ch * ((hi - lo) / 1023.0f));
}
PF void job_filtc(const KC& k, int j) {
    const float* hdn = (const float*)(k.ws + WS_HDNC);
    const float* w3 = k.hy_f_w3 + (size_t)j * 64 * 4096;
    float* filtc = (float*)(k.ws + WS_FILTC);
    const int tq = TID();
    for (int u = blockIdx.x; u < 256 * 8; u += gridDim.x) {
        const int l = u >> 3, col = (u & 7) * 512 + tq;
        float a = 0.f;
        for (int q = 0; q < 64; ++q) a += hdn[l * 64 + q] * w3[(size_t)q * 4096 + col];
        const float t = (float)l / 255.0f;
        filtc[(size_t)l * 4096 + col] = a * expf(-t * hy_delta(col & 1023));
    }
}

template <int MODE>
PF void norm_phase(const KC& k, int layer, bool first, bool combine, const float* __restrict__ gain, int mb, const float* __restrict__ Wsk, int ldw,
                   const float* __restrict__ aux0, const float* __restrict__ aux1, bool last, LAS float* lds) {
    const int tid = TID(), lane = tid & 63, wave = tid >> 6;
    float* xs = (float*)(k.ws + WS_XS);
    bf16_t* hbuf = (bf16_t*)(k.ws + AR_HBUF);
    const float* mod = (const float*)(k.ws + WS_MOD);
    const bf16_t* ys = (const bf16_t*)(k.ws + AR_YS);
    const int* tokp = (const int*)(k.ws + WS_TOKP);
    const float* tokw = (const float*)(k.ws + WS_TOKW);
    if (MODE == 1 || MODE == 2) {
        for (int idx = tid; idx < 1024 * 32; idx += NTHR) {
            const int kk = idx >> 5, n = idx & 31;
            lds[kk * 32 + (((n >> 2) ^ ((kk >> 1) & 7)) << 2) + (n & 3)] = Wsk[(size_t)kk * ldw + n];
        }
        __syncthreads();
    }
    const int rbeg = (MODE == 3) ? TC : 0;
    for (int r = rbeg + blockIdx.x * 8 + wave; r < T; r += gridDim.x * 8) {
        const int mr = modrow(r);
        const float* src = first ? (r < TC ? k.ctx + (size_t)r * 1024 : k.x + (size_t)(r - TC) * 1024) : xs + (size_t)r * 1024;
        float x[16];
#pragma unroll
        for (int m = 0; m < 16; ++m) x[m] = src[lane + 64 * m];
        if (combine) {
            const int p0 = tokp[2 * r], p1 = tokp[2 * r + 1];
            const float w0 = tokw[2 * r], w1 = tokw[2 * r + 1];
            const float* g5 = mod + ((size_t)((layer - 1) * 3 + mr) * 6 + 5) * 1024;
#pragma unroll
            for (int m = 0; m < 16; ++m) {
                const int col = lane + 64 * m;
                x[m] += g5[col] * (w0 * bf2f(ys[(size_t)p0 * 1024 + col]) + w1 * bf2f(ys[(size_t)p1 * 1024 + col]));
            }
        }
        if (first || combine) {
#pragma unroll
            for (int m = 0; m < 16; ++m) xs[(size_t)r * 1024 + lane + 64 * m] = x[m];
        }
        float ss = 0.f;
#pragma unroll
        for (int m = 0; m < 16; ++m) ss += x[m] * x[m];
        ss = wsum(ss);
        const float rstd = rsqrtf(ss * (1.0f / 1024.0f) + EPS);
        if (MODE == 3) {
#pragma unroll
            for (int m = 0; m < 16; ++m) { const int col = lane + 64 * m; k.out[(size_t)(r - TC) * 1024 + col] = x[m] * rstd * gain[col]; }
            continue;
        }
        const float* shift = mod + ((size_t)(layer * 3 + mr) * 6 + mb) * 1024;
        const float* scale = shift + 1024;
        float y[16];
#pragma unroll
        for (int m = 0; m < 16; ++m) {
            const int col = lane + 64 * m;
            y[m] = x[m] * rstd * gain[col] * (1.0f + scale[col]) + shift[col];
            hbuf[(size_t)r * 1024 + col] = f2bf(y[m]);
        }
        if (MODE == 1 || MODE == 2) {
            float acc[32];
#pragma unroll
            for (int n = 0; n < 32; ++n) acc[n] = 0.f;
#pragma unroll
            for (int m = 0; m < 16; ++m) {
                asm volatile("" ::: "memory");
                const int c = lane + 64 * m;
                const LAS float* wr = lds + c * 32; const int sw = (c >> 1) & 7;
#pragma unroll
                for (int q = 0; q < 8; ++q) {
                    const f32x4 w4 = *(const LAS f32x4*)(wr + ((q ^ sw) << 2));
                    acc[4 * q + 0] += y[m] * w4[0]; acc[4 * q + 1] += y[m] * w4[1]; acc[4 * q + 2] += y[m] * w4[2]; acc[4 * q + 3] += y[m] * w4[3];
                }
            }
            float val;
            {
                float a16[16], a8[8], a4[4], a2[2];
                const bool b5 = (lane & 32) != 0, b4 = (lane & 16) != 0, b3 = (lane & 8) != 0, b2 = (lane & 4) != 0, b1 = (lane & 2) != 0;
#pragma unroll
                for (int i = 0; i < 16; ++i) { const float send = b5 ? acc[i] : acc[i + 16], keep = b5 ? acc[i + 16] : acc[i]; a16[i] = keep + __shfl_xor(send, 32); }
#pragma unroll
                for (int i = 0; i < 8; ++i) { const float send = b4 ? a16[i] : a16[i + 8], keep = b4 ? a16[i + 8] : a16[i]; a8[i] = keep + __shfl_xor(send, 16); }
#pragma unroll
                for (int i = 0; i < 4; ++i) { const float send = b3 ? a8[i] : a8[i + 4], keep = b3 ? a8[i + 4] : a8[i]; a4[i] = keep + __shfl_xor(send, 8); }
#pragma unroll
                for (int i = 0; i < 2; ++i) { const float send = b2 ? a4[i] : a4[i + 2], keep = b2 ? a4[i + 2] : a4[i]; a2[i] = keep + __shfl_xor(send, 4); }
                { const float send = b1 ? a2[0] : a2[1], keep = b1 ? a2[1] : a2[0]; val = keep + __shfl_xor(send, 2); }
                val += __shfl_xor(val, 1);
            }
            const int n = lane >> 1;
            if (MODE == 1) {
                int* toke = (int*)(k.ws + WS_TOKE); float* tokwW = (float*)(k.ws + WS_TOKW);
                int* cnt = (int*)(k.ws + WS_CTL + CTL_CNT) + layer * 32;
                if (last && r < TC) { if (lane == 0) { toke[2 * r] = -1; toke[2 * r + 1] = -1; } continue; }
                const float sc = 1.0f / (1.0f + expf(-val)), ch = sc + aux0[n];
                const int gl = lane & ~7;
                const float ca = __shfl(ch, gl), cb = __shfl(ch, gl + 2), cc = __shfl(ch, gl + 4), cd = __shfl(ch, gl + 6);
                const float hi1 = fmaxf(ca, cb), lo1 = fminf(ca, cb), hi2 = fmaxf(cc, cd), lo2 = fminf(cc, cd);
                float gs = fmaxf(hi1, hi2) + fmaxf(fminf(hi1, hi2), fmaxf(lo1, lo2));
                int gi = lane >> 3;
#pragma unroll
                for (int m = 8; m <= 32; m <<= 1) {
                    const float og = __shfl_xor(gs, m); const int oi = __shfl_xor(gi, m);
                    if (og > gs || (og == gs && oi < gi)) { gs = og; gi = oi; }
                }
                float c4[4], s4[4];
#pragma unroll
                for (int i = 0; i < 4; ++i) { c4[i] = __shfl(ch, gi * 8 + 2 * i); s4[i] = __shfl(sc, gi * 8 + 2 * i); }
                int i1 = 0; float b1v = c4[0];
#pragma unroll
                for (int i = 1; i < 4; ++i) if (c4[i] > b1v) { b1v = c4[i]; i1 = i; }
                int i2 = -1; float b2v = -1e30f;
#pragma unroll
                for (int i = 0; i < 4; ++i) if (i != i1 && c4[i] > b2v) { b2v = c4[i]; i2 = i; }
                float w1v = 0.f, w2v = 0.f;
#pragma unroll
                for (int i = 0; i < 4; ++i) { if (i == i1) w1v = s4[i]; if (i == i2) w2v = s4[i]; }
                const float inv = 1.0f / (w1v + w2v);
                if (lane == 0) {
                    const int e1 = gi * 4 + i1, e2 = gi * 4 + i2;
                    toke[2 * r] = e1; toke[2 * r + 1] = e2; tokwW[2 * r] = w1v * inv; tokwW[2 * r + 1] = w2v * inv;
                    atomicAdd(&cnt[e1], 1); atomicAdd(&cnt[e2], 1);
                }
            } else {
                float* gb = (float*)(k.ws + WS_GB);
                if ((lane & 1) == 0) {
                    if (n < 16) {
                        const float z = val + aux1[n];
                        const float sp = z > 20.f ? z : log1pf(expf(z));
                        gb[(size_t)r * 32 + n] = -expf(aux0[n]) * sp;
                    } else {
                        gb[(size_t)r * 32 + n] = 1.0f / (1.0f + expf(-val));
                    }
                }
            }
        }
    }
}

template <class Epi>
DI void gemm_tile(LAS bf16_t* lds, const bf16_t* __restrict__ A, int lda, const int* __restrict__ rowidx, int m0, int mrows,
                  const bf16_t* __restrict__ Bt, int K, int n0, const Epi& epi) {
    const int tid = TID(), lane = tid & 63, wave = tid >> 6, wr = wave >> 2, wc = wave & 3, fr = lane & 15, fq = lane >> 4;
    LAS bf16_t* As = lds; LAS bf16_t* Bs = lds + 128 * 72;
    const int seg = tid & 7, r0 = tid >> 3;
    const int ra0 = r0 < mrows ? r0 : 0, ra1 = (r0 + 64) < mrows ? (r0 + 64) : 0;
    size_t ar0, ar1;
    if (rowidx) { ar0 = (size_t)rowidx[m0 + ra0]; ar1 = (size_t)rowidx[m0 + ra1]; } else { ar0 = (size_t)(m0 + ra0); ar1 = (size_t)(m0 + ra1); }
    const bf16_t* pa0 = A + ar0 * lda + seg * 8; const bf16_t* pa1 = A + ar1 * lda + seg * 8;
    const bf16_t* pb0 = Bt + (size_t)(n0 + r0) * K + seg * 8; const bf16_t* pb1 = Bt + (size_t)(n0 + r0 + 64) * K + seg * 8;
    u32x4 ga0 = *(const u32x4*)pa0, ga1 = *(const u32x4*)pa1, gb0 = *(const u32x4*)pb0, gb1 = *(const u32x4*)pb1;
    f32x4 acc[4][2];
#pragma unroll
    for (int m = 0; m < 4; ++m)
#pragma unroll
        for (int n = 0; n < 2; ++n) acc[m][n] = (f32x4){0.f, 0.f, 0.f, 0.f};
    const int nk = K >> 6;
    for (int kt = 0; kt < nk; ++kt) {
        __syncthreads();
        *(LAS u32x4*)(As + r0 * 72 + seg * 8) = ga0; *(LAS u32x4*)(As + (r0 + 64) * 72 + seg * 8) = ga1;
        *(LAS u32x4*)(Bs + r0 * 72 + seg * 8) = gb0; *(LAS u32x4*)(Bs + (r0 + 64) * 72 + seg * 8) = gb1;
        __syncthreads();
        if (kt + 1 < nk) {
            const int ko = (kt + 1) * 64;
            ga0 = *(const u32x4*)(pa0 + ko); ga1 = *(const u32x4*)(pa1 + ko); gb0 = *(const u32x4*)(pb0 + ko); gb1 = *(const u32x4*)(pb1 + ko);
        }
#pragma unroll
        for (int kk = 0; kk < 2; ++kk) {
            bf16x8 af[4], bfv[2];
#pragma unroll
            for (int m = 0; m < 4; ++m) af[m] = *(const LAS bf16x8*)(As + (wr * 64 + m * 16 + fr) * 72 + kk * 32 + fq * 8);
#pragma unroll
            for (int n = 0; n < 2; ++n) bfv[n] = *(const LAS bf16x8*)(Bs + (wc * 32 + n * 16 + fr) * 72 + kk * 32 + fq * 8);
#pragma unroll
            for (int m = 0; m < 4; ++m)
#pragma unroll
                for (int n = 0; n < 2; ++n) acc[m][n] = __builtin_amdgcn_mfma_f32_16x16x32_bf16(af[m], bfv[n], acc[m][n], 0, 0, 0);
        }
    }
    epi(acc, m0, mrows, n0, wr, wc, fr, fq);
}
struct EpiBf16 {
    bf16_t* C; int ldc;
    DI void operator()(const f32x4 (&acc)[4][2], int m0, int mrows, int n0, int wr, int wc, int fr, int fq) const {
#pragma unroll
        for (int m = 0; m < 4; ++m)
#pragma unroll
            for (int j = 0; j < 4; ++j) {
                const int rl = wr * 64 + m * 16 + fq * 4 + j;
                if (rl < mrows) {
#pragma unroll
                    for (int n = 0; n < 2; ++n) C[(size_t)(m0 + rl) * ldc + n0 + wc * 32 + n * 16 + fr] = f2bf(acc[m][n][j]);
                }
            }
    }
};
struct EpiBf16T {
    bf16_t* C; int ldc;
    DI void operator()(const f32x4 (&acc)[4][2], int m0, int mrows, int n0, int wr, int wc, int fr, int fq) const {
#pragma unroll
        for (int m = 0; m < 4; ++m)
#pragma unroll
            for (int n = 0; n < 2; ++n) {
                const int row = m0 + wr * 64 + m * 16 + fq * 4, col = n0 + wc * 32 + n * 16 + fr;
                u32x2 o; o[0] = pk2(acc[m][n][0], acc[m][n][1]); o[1] = pk2(acc[m][n][2], acc[m][n][3]);
                *(u32x2*)(C + (size_t)col * ldc + row) = o;
            }
    }
};
struct EpiResid {
    float* xs; const float* mod; int layer; int chunk;
    DI void operator()(const f32x4 (&acc)[4][2], int m0, int mrows, int n0, int wr, int wc, int fr, int fq) const {
        const float* g = mod + ((size_t)(layer * 3 + modrow(m0)) * 6 + chunk) * 1024;
#pragma unroll
        for (int n = 0; n < 2; ++n) {
            const int col = n0 + wc * 32 + n * 16 + fr; const float gv = g[col];
#pragma unroll
            for (int m = 0; m < 4; ++m)
#pragma unroll
                for (int j = 0; j < 4; ++j) { float* p = xs + (size_t)(m0 + wr * 64 + m * 16 + fq * 4 + j) * 1024 + col; *p = *p + gv * acc[m][n][j]; }
        }
    }
};
struct EpiGateUp {
    bf16_t* hid;
    DI void operator()(const f32x4 (&acc)[4][2], int m0, int mrows, int n0, int wr, int wc, int fr, int fq) const {
        const int hc = ((n0 + wc * 32) >> 1) + fr;
#pragma unroll
        for (int m = 0; m < 4; ++m)
#pragma unroll
            for (int j = 0; j < 4; ++j) {
                const int rl = wr * 64 + m * 16 + fq * 4 + j;
                if (rl < mrows) { const float g = acc[m][0][j]; hid[(size_t)(m0 + rl) * 512 + hc] = f2bf(siluf(g) * acc[m][1][j]); }
            }
    }
};
template <class Epi>
PF void gemm_dense(LAS bf16_t* lds, const bf16_t* A, int M, const bf16_t* Bt, int N, int K, const Epi& epi) {
    const int tn = N / 128, tm = M / 128;
    for (int u = blockIdx.x; u < tm * tn; u += gridDim.x) {
        const int mt = u / tn, nt = u % tn;
        gemm_tile(lds, A, K, (const int*)nullptr, mt * 128, 128, Bt, K, nt * 128, epi);
    }
}
DI void moe_table(const KC& k, int layer, LAS int* tb) {
    const int* cnt = (const int*)(k.ws + WS_CTL + CTL_CNT) + layer * 32;
    __syncthreads();
    const int tq = TID();
    if (tq < 32) tb[tq] = __hip_atomic_load(cnt + tq, __ATOMIC_RELAXED, __HIP_MEMORY_SCOPE_AGENT);
    __syncthreads();
    if (tq == 0) {
        int s = 0, tp = 0;
        for (int e = 0; e < 32; ++e) { tb[32 + e] = s; tb[65 + e] = tp; s += tb[e]; tp += (tb[e] + 127) >> 7; }
        tb[64] = s; tb[97] = tp;
    }
    __syncthreads();
}
template <int WHICH>
PF void moe_gemm(const KC& k, int layer, LAS bf16_t* lds, LAS int* tb) {
    moe_table(k, layer, tb);
    const int ntile = tb[97];
    for (int u = blockIdx.x; u < ntile * 8; u += gridDim.x) {
        const int tile = u >> 3, nt = u & 7;
        int e = 0;
        for (int q = 1; q < 32; ++q) if (tb[65 + q] <= tile) e = q;
        const int lt = tile - tb[65 + e], m0 = tb[32 + e] + lt * 128;
        int mrows = tb[e] - lt * 128; mrows = mrows > 128 ? 128 : mrows;
        if (WHICH == 0) {
            EpiGateUp epi{(bf16_t*)(k.ws + AR_HID)};
            gemm_tile(lds, (const bf16_t*)(k.ws + AR_HBUF), 1024, (const int*)(k.ws + WS_SLOT), m0, mrows,
                      (const bf16_t*)(k.ws + AR_WGU) + (size_t)e * 1024 * 1024, 1024, nt * 128, epi);
        } else {
            EpiBf16 epi{(bf16_t*)(k.ws + AR_YS), 1024};
            gemm_tile(lds, (const bf16_t*)(k.ws + AR_HID), 512, (const int*)nullptr, m0, mrows,
                      (const bf16_t*)(k.ws + AR_WD) + (size_t)e * 1024 * 512, 512, nt * 128, epi);
        }
    }
}
PF void moe_scatter(const KC& k, int layer, LAS int* tb) {
    moe_table(k, layer, tb);
    const int* toke = (const int*)(k.ws + WS_TOKE);
    int* tokp = (int*)(k.ws + WS_TOKP); int* slot = (int*)(k.ws + WS_SLOT);
    int* cur = (int*)(k.ws + WS_CTL + CTL_CNT) + 128 + layer * 32;
    const int tq2 = TID();
    for (int r = blockIdx.x * NTHR + tq2; r < T; r += gridDim.x * NTHR) {
#pragma unroll
        for (int q = 0; q < 2; ++q) {
            const int e = toke[2 * r + q];
            if (e >= 0) { const int pos = tb[32 + e] + atomicAdd(&cur[e], 1); slot[pos] = r; tokp[2 * r + q] = pos; }
        }
    }
}

PF void sc_mix(const KC& k, int j) {
    const int tid = TID(), lane = tid & 63, wave = tid >> 6;
    const bf16_t* P = (const bf16_t*)(k.ws + AR_PB);
    bf16_t* U = (bf16_t*)(k.ws + AR_UBUF);
    const float* cw = k.sc_conv + (size_t)j * 3 * 1024;
    for (int r = blockIdx.x * 8 + wave; r < T; r += gridDim.x * 8) {
        bool lok, rok;
        if (r < TC) { const int t = r & 255; lok = t != 0; rok = t != 255; } else { const int t = (r - TC) & 63; lok = t != 0; rok = t != 63; }
        const bf16_t* p = P + (size_t)r * 3072;
#pragma unroll 4
        for (int m = 0; m < 16; ++m) {
            const int col = lane + 64 * m;
            const float bg = bf2f(p[col]);
            const float mc = bf2f(p[1024 + col]) * bf2f(p[2048 + col]);
            const float ml = lok ? bf2f(p[-3072 + 1024 + col]) * bf2f(p[-3072 + 2048 + col]) : 0.f;
            const float mrr = rok ? bf2f(p[3072 + 1024 + col]) * bf2f(p[3072 + 2048 + col]) : 0.f;
            U[(size_t)r * 1024 + col] = f2bf(bg * (cw[col] * ml + cw[1024 + col] * mc + cw[2048 + col] * mrr));
        }
    }
}

PF void dn_prep(const KC& k, int j) {
    const int tid = TID(), lane = tid & 63, wave = tid >> 6;
    const bf16_t* P = (const bf16_t*)(k.ws + AR_PB);
    bf16_t* Q = (bf16_t*)(k.ws + AR_QKV);
    const float* cw = k.dn_conv + (size_t)j * 3 * 3072;
    for (int r = blockIdx.x * 8 + wave; r < T; r += gridDim.x * 8) {
        bool lok, rok;
        if (r < TC) { const int t = r & 255; lok = t != 0; rok = t != 255; } else { const int t = (r - TC) & 63; lok = t != 0; rok = t != 63; }
        const bf16_t* p = P + (size_t)r * 4096;
        for (int g = 0; g < 24; ++g) {
            const int col = g * 128 + lane * 2;
            const unsigned c = *(const unsigned*)(p + col);
            const unsigned l = lok ? *(const unsigned*)(p - 4096 + col) : 0u;
            const unsigned rr = rok ? *(const unsigned*)(p + 4096 + col) : 0u;
            float v0 = cw[col] * bf2f((bf16_t)(l & 0xffff)) + cw[3072 + col] * bf2f((bf16_t)(c & 0xffff)) + cw[6144 + col] * bf2f((bf16_t)(rr & 0xffff));
            float v1 = cw[col + 1] * bf2f((bf16_t)(l >> 16)) + cw[3072 + col + 1] * bf2f((bf16_t)(c >> 16)) + cw[6144 + col + 1] * bf2f((bf16_t)(rr >> 16));
            v0 = siluf(v0); v1 = siluf(v1);
            if (g < 16) {
                const float ss = wsum(v0 * v0 + v1 * v1);
                const float sc = rsqrtf(ss + EPS) * (g < 8 ? 0.08838834764831845f : 1.0f);
                v0 *= sc; v1 *= sc;
            }
            *(unsigned*)(Q + (size_t)r * 3072 + col) = pk2(v0, v1);
        }
    }
}
PF void dn_scan(const KC& k, LAS float* lds) {
    const int tid = TID(), lane = tid & 63, wave = tid >> 6, kk = tid >> 4, vv = tid & 15;
    LAS float* ks = lds; LAS float* qs = lds + 64 * 128; LAS float* vs = qs + 64 * 128; LAS float* ga = vs + 64 * 16; LAS float* be = ga + 64;
    LAS float* red = be + 64; LAS float* red2 = red + 128;
    const bf16_t* Q = (const bf16_t*)(k.ws + AR_QKV);
    const float* gb = (const float*)(k.ws + WS_GB);
    float* O = (float*)(k.ws + AR_O);
    for (int u = blockIdx.x; u < 256; u += gridDim.x) {
        const int sl = u & 7, dir = (u >> 3) & 1, h = (u >> 4) & 7, b = u >> 7;
        float S[4] = {0.f, 0.f, 0.f, 0.f};
        for (int c = 0; c < 260; ++c) {
            int rbase, rstep;
            if (c < 4) { rbase = dir == 0 ? b * 256 + c * 64 : b * 256 + 255 - c * 64; }
            else { const int cc = c - 4; rbase = dir == 0 ? TC + b * SEQ + cc * 64 : TC + b * SEQ + SEQ - 1 - cc * 64; }
            rstep = dir == 0 ? 1 : -1;
            __syncthreads();
#pragma unroll
            for (int e = 0; e < 2; ++e) {
                const int idx = tid + 512 * e, i = idx >> 4, sg = idx & 15;
                const size_t row = (size_t)(rbase + rstep * i);
                const u32x4 kq = *(const u32x4*)(Q + row * 3072 + 1024 + h * 128 + sg * 8);
                const u32x4 qq = *(const u32x4*)(Q + row * 3072 + h * 128 + sg * 8);
#pragma unroll
                for (int w = 0; w < 4; ++w) {
                    ks[i * 128 + sg * 8 + 2 * w] = __uint_as_float(kq[w] << 16); ks[i * 128 + sg * 8 + 2 * w + 1] = __uint_as_float(kq[w] & 0xffff0000u);
                    qs[i * 128 + sg * 8 + 2 * w] = __uint_as_float(qq[w] << 16); qs[i * 128 + sg * 8 + 2 * w + 1] = __uint_as_float(qq[w] & 0xffff0000u);
                }
            }
            for (int idx = tid; idx < 64 * 16; idx += NTHR) {
                const int i = idx >> 4, d = idx & 15; const size_t row = (size_t)(rbase + rstep * i);
                vs[idx] = bf2f(Q[row * 3072 + 2048 + h * 128 + sl * 16 + d]);
            }
            if (tid < 64) { const size_t row = (size_t)(rbase + rstep * tid); ga[tid] = expf(gb[row * 32 + dir * 8 + h]); be[tid] = gb[row * 32 + 16 + dir * 8 + h]; }
            __syncthreads();
            for (int i = 0; i < 64; ++i) {
                float kv[4], qv[4];
#pragma unroll
                for (int e = 0; e < 4; ++e) { kv[e] = ks[i * 128 + kk + 32 * e]; qv[e] = qs[i * 128 + kk + 32 * e]; }
                const float a = ga[i], bt = be[i], vc = vs[i * 16 + vv];
                float part = kv[0] * S[0] + kv[1] * S[1] + kv[2] * S[2] + kv[3] * S[3];
                part += __shfl_xor(part, 16); part += __shfl_xor(part, 32);
                if (lane < 16) red[wave * 16 + lane] = part;
                __syncthreads();
                float kS = 0.f;
#pragma unroll
                for (int w = 0; w < 8; ++w) kS += red[w * 16 + vv];
#pragma unroll
                for (int e = 0; e < 4; ++e) S[e] = a * (S[e] - bt * kv[e] * kS) + bt * kv[e] * vc;
                float p2 = qv[0] * S[0] + qv[1] * S[1] + qv[2] * S[2] + qv[3] * S[3];
                p2 += __shfl_xor(p2, 16); p2 += __shfl_xor(p2, 32);
                if (lane < 16) red2[wave * 16 + lane] = p2;
                __syncthreads();
                if (tid < 16) {
                    float o = 0.f;
#pragma unroll
                    for (int w = 0; w < 8; ++w) o += red2[w * 16 + tid];
                    O[((size_t)dir * T + (size_t)(rbase + rstep * i)) * 1024 + h * 128 + sl * 16 + tid] = o;
                }
            }
        }
    }
}
PF void dn_finish(const KC& k, int j) {
    const int tid = TID(), lane = tid & 63, wave = tid >> 6;
    const float* O = (const float*)(k.ws + AR_O);
    const bf16_t* P = (const bf16_t*)(k.ws + AR_PB);
    bf16_t* U = (bf16_t*)(k.ws + AR_UBUF);
    const float* on = k.dn_out_norm + j * 128;
    for (int r = blockIdx.x * 8 + wave; r < T; r += gridDim.x * 8) {
        float o[16];
#pragma unroll
        for (int m = 0; m < 16; ++m) o[m] = O[(size_t)r * 1024 + lane + 64 * m] + O[((size_t)T + r) * 1024 + lane + 64 * m];
#pragma unroll
        for (int hh = 0; hh < 8; ++hh) {
            const float ss = wsum(o[2 * hh] * o[2 * hh] + o[2 * hh + 1] * o[2 * hh + 1]);
            const float rs = rsqrtf(ss * (1.0f / 128.0f) + EPS);
#pragma unroll
            for (int q = 0; q < 2; ++q) {
                const int m = 2 * hh + q, col = lane + 64 * m;
                const float z = bf2f(P[(size_t)r * 4096 + 3072 + col]);
                U[(size_t)r * 1024 + col] = f2bf(o[m] * rs * on[col & 127] * siluf(z));
            }
        }
    }
}

DI float conv3g(const bf16_t* p, int j, float w0, float w1, float w2) {
    const int gc = j & 63;
    const float l = gc != 0 ? bf2f(p[j - 1]) : 0.f, c = bf2f(p[j]), r = gc != 63 ? bf2f(p[j + 1]) : 0.f;
    return w0 * l + w1 * c + w2 * r;
}
PF void hy_lat(const KC& k, int jl, LAS float* ldsf) {
    const int tid = TID();
    LAS cf* X = (LAS cf*)ldsf;
    LAS float* wf = ldsf + 32768; LAS float* wb = wf + 64;
    const bf16_t* PT = (const bf16_t*)(k.ws + AR_PB);
    bf16_t* ZT = (bf16_t*)(k.ws + AR_ZT);
    cf* scr = (cf*)(k.ws + AR_FFTS) + (size_t)blockIdx.x * 4 * 16384;
    cf* sKe = scr; cf* sKo = scr + 16384; cf* zp = scr + 2 * 16384; cf* ye = scr + 3 * 16384;
    const float* hdn = (const float*)(k.ws + WS_HDNL);
    const float* w3 = k.hy_f_w3 + (size_t)jl * 64 * 4096;
    const float* cw = k.hy_conv + (size_t)jl * 3 * 3072;
    for (int ch = blockIdx.x; ch < 1024; ch += gridDim.x) {
        const float delta = hy_delta(ch);
        {
            const bf16_t* pv = PT + (size_t)ch * T + TC;
            const float w0 = cw[ch], w1 = cw[3072 + ch], w2 = cw[6144 + ch];
            _Pragma("unroll 1") for (int m = 0; m < 32; ++m) { const int j = tid + 512 * m; cf z; z.x = conv3g(pv, j, w0, w1, w2); z.y = conv3g(pv + SEQ, j, w0, w1, w2); zp[j] = z; }
        }
        for (int n = 0; n < 2; ++n) {
            __syncthreads();
            if (tid < 64) wf[tid] = w3[(size_t)tid * 4096 + n * 2048 + ch];
            else if (tid < 128) wb[tid - 64] = w3[(size_t)(tid - 64) * 4096 + n * 2048 + 1024 + ch];
            __syncthreads();
            _Pragma("unroll 1") for (int m = 0; m < 32; ++m) {
                const int j = tid + 512 * m;
                float hf = 0.f, hb = 0.f;
                { const f32x4* hr = (const f32x4*)(hdn + (size_t)j * 64);
#pragma unroll 4
                  for (int q = 0; q < 16; ++q) { const f32x4 h4 = hr[q]; hf += h4[0] * wf[4 * q] + h4[1] * wf[4 * q + 1] + h4[2] * wf[4 * q + 2] + h4[3] * wf[4 * q + 3]; }
                  hf *= expf(-((float)j / 16383.0f) * delta); }
                asm volatile("" ::: "memory");
                if (j > 0) { const int jb = SEQ - j; const f32x4* hr = (const f32x4*)(hdn + (size_t)jb * 64);
#pragma unroll 4
                  for (int q = 0; q < 16; ++q) { const f32x4 h4 = hr[q]; hb += h4[0] * wb[4 * q] + h4[1] * wb[4 * q + 1] + h4[2] * wb[4 * q + 2] + h4[3] * wb[4 * q + 3]; }
                  hb *= expf(-((float)jb / 16383.0f) * delta); }
                float sn, cs; sincospif(-(float)j / 16384.0f, &sn, &cs);
                cf a; a.x = hf + hb; a.y = 0.f; X[j] = a;
                const float kd = hf - hb; cf o; o.x = kd * cs; o.y = kd * sn; sKo[j] = o;
            }
            __syncthreads();
            fft16k_fwd(X);
            _Pragma("unroll 1") for (int m = 0; m < 32; ++m) { const int j = tid + 512 * m; sKe[j] = X[j]; }
            __syncthreads();
            _Pragma("unroll 1") for (int m = 0; m < 32; ++m) { const int j = tid + 512 * m; X[j] = sKo[j]; }
            __syncthreads();
            fft16k_fwd(X);
            _Pragma("unroll 1") for (int m = 0; m < 32; ++m) { const int j = tid + 512 * m; sKo[j] = X[j]; }
            __syncthreads();
            _Pragma("unroll 1") for (int m = 0; m < 32; ++m) { const int j = tid + 512 * m; X[j] = zp[j]; }
            __syncthreads();
            fft16k_fwd(X);
            _Pragma("unroll 1") for (int m = 0; m < 32; ++m) { const int j = tid + 512 * m; X[j] = cmul(X[j], sKe[j]); }
            __syncthreads();
            fft16k_inv(X);
            _Pragma("unroll 1") for (int m = 0; m < 32; ++m) { const int j = tid + 512 * m; ye[j] = X[j]; }
            __syncthreads();
            _Pragma("unroll 1") for (int m = 0; m < 32; ++m) { const int j = tid + 512 * m; float sn, cs; sincospif(-(float)j / 16384.0f, &sn, &cs); cf w; w.x = cs; w.y = sn; X[j] = cmul(zp[j], w); }
            __syncthreads();
            fft16k_fwd(X);
            _Pragma("unroll 1") for (int m = 0; m < 32; ++m) { const int j = tid + 512 * m; X[j] = cmul(X[j], sKo[j]); }
            __syncthreads();
            fft16k_inv(X);
            {
                const bf16_t* pg = PT + (size_t)((n + 1) * 1024 + ch) * T + TC;
                const int gcol = (n + 1) * 1024 + ch;
                const float w0 = cw[gcol], w1 = cw[3072 + gcol], w2 = cw[6144 + gcol];
                const float bias = k.hy_bias[(size_t)jl * 2 * 1024 + n * 1024 + ch];
                _Pragma("unroll 1") for (int m = 0; m < 32; ++m) {
                    const int j = tid + 512 * m;
                    float sn, cs; sincospif((float)j / 16384.0f, &sn, &cs); cf w; w.x = cs; w.y = sn;
                    const cf yo = cmul(X[j], w); const cf e = ye[j]; const cf zprev = zp[j];
                    const float y0 = (0.5f / 16384.0f) * (e.x + yo.x), y1 = (0.5f / 16384.0f) * (e.y + yo.y);
                    cf zn; zn.x = conv3g(pg, j, w0, w1, w2) * (y0 + bias * zprev.x); zn.y = conv3g(pg + SEQ, j, w0, w1, w2) * (y1 + bias * zprev.y);
                    zp[j] = zn;
                }
            }
        }
        _Pragma("unroll 1") for (int m = 0; m < 32; ++m) { const int j = tid + 512 * m; const cf z = zp[j]; ZT[(size_t)ch * T + TC + j] = f2bf(z.x); ZT[(size_t)ch * T + TC + SEQ + j] = f2bf(z.y); }
        __syncthreads();
    }
}
PF void hy_ctx(const KC& k, int jl, LAS float* lds) {
    const int tid = TID(), t = tid & 255, hsel = tid >> 8;
    LAS float* z = lds + hsel * 768; LAS float* hf = z + 256; LAS float* hb = hf + 256;
    const bf16_t* PT = (const bf16_t*)(k.ws + AR_PB);
    bf16_t* U = (bf16_t*)(k.ws + AR_UBUF);
    const float* filtc = (const float*)(k.ws + WS_FILTC);
    const float* cw = k.hy_conv + (size_t)jl * 3 * 3072;
    for (int u = blockIdx.x; u < 1024; u += gridDim.x) {
        const int pr = u * 2 + hsel, b = pr >> 10, ch = pr & 1023;
        float zc;
        {
            const bf16_t* pv = PT + (size_t)ch * T + b * 256;
            const float l = t != 0 ? bf2f(pv[t - 1]) : 0.f, c = bf2f(pv[t]), r = t != 255 ? bf2f(pv[t + 1]) : 0.f;
            zc = cw[ch] * l + cw[3072 + ch] * c + cw[6144 + ch] * r;
        }
        for (int n = 0; n < 2; ++n) {
            __syncthreads();
            z[t] = zc; hf[t] = filtc[(size_t)t * 4096 + n * 2048 + ch]; hb[t] = filtc[(size_t)t * 4096 + n * 2048 + 1024 + ch];
            __syncthreads();
            float y = 0.f;
            for (int s = 0; s <= t; ++s) y += hf[t - s] * z[s];
            for (int s = t + 1; s < 256; ++s) y += hb[s - t] * z[s];
            const int gcol = (n + 1) * 1024 + ch;
            const bf16_t* pg = PT + (size_t)gcol * T + b * 256;
            const float l = t != 0 ? bf2f(pg[t - 1]) : 0.f, c = bf2f(pg[t]), r = t != 255 ? bf2f(pg[t + 1]) : 0.f;
            const float gate = cw[gcol] * l + cw[3072 + gcol] * c + cw[6144 + gcol] * r;
            zc = gate * (y + k.hy_bias[(size_t)jl * 2048 + n * 1024 + ch] * zc);
        }
        U[(size_t)(b * 256 + t) * 1024 + ch] = f2bf(zc);
        __syncthreads();
    }
}
PF void hy_transpose(const KC& k, LAS bf16_t* lds) {
    const int tid = TID();
    const bf16_t* ZT = (const bf16_t*)(k.ws + AR_ZT);
    bf16_t* U = (bf16_t*)(k.ws + AR_UBUF);
    for (int u = blockIdx.x; u < 16 * (TL / 64); u += gridDim.x) {
        const int c0 = (u & 15) * 64, r0 = TC + (u >> 4) * 64;
        { const int c = tid >> 3, sg = (tid & 7) * 8;
          const u32x4 v = *(const u32x4*)(ZT + (size_t)(c0 + c) * T + r0 + sg);
#pragma unroll
          for (int w = 0; w < 4; ++w) { lds[(sg + 2 * w) * 66 + c] = (bf16_t)(v[w] & 0xffff); lds[(sg + 2 * w + 1) * 66 + c] = (bf16_t)(v[w] >> 16); } }
        __syncthreads();
        { const int r = tid >> 3, sg = (tid & 7) * 8; u32x4 o;
#pragma unroll
          for (int w = 0; w < 4; ++w) o[w] = (unsigned)lds[r * 66 + sg + 2 * w] | ((unsigned)lds[r * 66 + sg + 2 * w + 1] << 16);
          *(u32x4*)(U + (size_t)(r0 + r) * 1024 + c0 + sg) = o; }
        __syncthreads();
    }
}

__global__ void __launch_bounds__(NTHR, 2) fwd_kernel(Params prm) {
    extern __shared__ __attribute__((aligned(16))) unsigned char lds_raw[];
    LAS unsigned char* lds = (LAS unsigned char*)lds_raw;
    LAS float* ldsf = (LAS float*)lds;
    LAS bf16_t* ldsh = (LAS bf16_t*)lds;
    LAS int* tb = (LAS int*)(lds + 136 * 1024);
    volatile LAS unsigned* xbw = (volatile LAS unsigned*)(lds + 139 * 1024);
    KC k;
    k.x = prm.in[0]; k.c = prm.in[1]; k.ctx = prm.in[2]; k.c_ctx = prm.in[3]; k.ada_w = prm.in[4]; k.ada_b = prm.in[5];
    k.norm_mix = prm.in[6]; k.norm_ffn = prm.in[7]; k.norm_final = prm.in[8];
    k.dn_w_in = prm.in[9]; k.dn_conv = prm.in[10]; k.dn_a_log = prm.in[11]; k.dn_dt_bias = prm.in[12]; k.dn_out_norm = prm.in[13]; k.dn_w_out = prm.in[14];
    k.hy_w_in = prm.in[15]; k.hy_conv = prm.in[16]; k.hy_f_w1 = prm.in[17]; k.hy_f_b1 = prm.in[18]; k.hy_f_freq = prm.in[19]; k.hy_f_w2 = prm.in[20];
    k.hy_f_b2 = prm.in[21]; k.hy_f_w3 = prm.in[22]; k.hy_bias = prm.in[23]; k.hy_w_out = prm.in[24];
    k.sc_w_in = prm.in[25]; k.sc_conv = prm.in[26]; k.sc_w_out = prm.in[27]; k.w_router = prm.in[28]; k.router_bias = prm.in[29];
    k.moe_w_gate = prm.in[30]; k.moe_w_up = prm.in[31]; k.moe_w_down = prm.in[32];
    k.out = prm.out; k.ws = prm.ws;
    const int lo = prm.ph_lo, hi = prm.ph_hi;
    XcdBarrier bar; bar.bar = (unsigned*)(k.ws + WS_CTL); bar.x = 0; bar.st = xbw;
    if (hi - lo > 1) {
        if (threadIdx.x == 0) { xbw[0] = 0u; xbw[1] = 0u; }
        __syncthreads();
        bar = xcd_barrier_post((unsigned*)(k.ws + WS_CTL), xbw);
    }
    int ph = 0;
#define PH_BEGIN if (ph >= lo && ph < hi) { asm volatile("" : "+s"(k.ws));
#define PH_END   if (ph + 1 < hi) xcd_barrier(bar); } ++ph;

    float* xs = (float*)(k.ws + WS_XS);
    const float* mod = (const float*)(k.ws + WS_MOD);

    PH_BEGIN
        job_mod(k, ldsf);
        job_cvt_small(k, ldsf);
        job_hdn(k, ldsf);
    PH_END

    for (int i = 0; i < DEPTH; ++i) {
        const int kind = i % 3, j = i / 3;
        const bool last = (i == DEPTH - 1);
        PH_BEGIN
            if (kind == 0) norm_phase<2>(k, i, i == 0, i > 0, k.norm_mix + i * 1024, 0, k.dn_w_in + (size_t)j * 1024 * DN_IN + 4096, DN_IN,
                                         k.dn_a_log + j * 16, k.dn_dt_bias + j * 16, last, ldsf);
            else norm_phase<0>(k, i, i == 0, i > 0, k.norm_mix + i * 1024, 0, nullptr, 0, nullptr, nullptr, last, ldsf);
            if (kind == 1) job_filtc(k, j);
        PH_END
        PH_BEGIN
            if (kind == 0) { EpiBf16 e{(bf16_t*)(k.ws + AR_PB), 4096}; gemm_dense(ldsh, (const bf16_t*)(k.ws + AR_HBUF), T, (const bf16_t*)(k.ws + WS_DNWIN) + (size_t)j * 4096 * 1024, 4096, 1024, e); }
            else if (kind == 1) { EpiBf16T e{(bf16_t*)(k.ws + AR_PB), T}; gemm_dense(ldsh, (const bf16_t*)(k.ws + AR_HBUF), T, (const bf16_t*)(k.ws + WS_HYWIN), 3072, 1024, e); }
            else { EpiBf16 e{(bf16_t*)(k.ws + AR_PB), 3072}; gemm_dense(ldsh, (const bf16_t*)(k.ws + AR_HBUF), T, (const bf16_t*)(k.ws + WS_SCWIN), 3072, 1024, e); }
        PH_END
        if (kind == 0) {
            PH_BEGIN dn_prep(k, j); PH_END
            PH_BEGIN dn_scan(k, ldsf); PH_END
            PH_BEGIN dn_finish(k, j); PH_END
        } else if (kind == 1) {
            PH_BEGIN hy_lat(k, j, ldsf); hy_ctx(k, j, ldsf); PH_END
            PH_BEGIN hy_transpose(k, ldsh); PH_END
        } else {
            PH_BEGIN sc_mix(k, j); PH_END
        }
        PH_BEGIN
            const bf16_t* Wt = kind == 0 ? (const bf16_t*)(k.ws + WS_DNWOUT) + (size_t)j * 1024 * 1024 : (kind == 1 ? (const bf16_t*)(k.ws + WS_HYWOUT) : (const bf16_t*)(k.ws + WS_SCWOUT));
            EpiResid e{xs, mod, i, 2};
            gemm_dense(ldsh, (const bf16_t*)(k.ws + AR_UBUF), T, Wt, 1024, 1024, e);
        PH_END
        PH_BEGIN
            norm_phase<1>(k, i, false, false, k.norm_ffn + i * 1024, 3, k.w_router, 32, k.router_bias, nullptr, last, ldsf);
        PH_END
        PH_BEGIN
            moe_scatter(k, i, tb);
            job_cvt_moe(k, i, ldsf);
        PH_END
        PH_BEGIN moe_gemm<0>(k, i, ldsh, tb); PH_END
        PH_BEGIN moe_gemm<1>(k, i, ldsh, tb); PH_END
    }
    PH_BEGIN
        norm_phase<3>(k, DEPTH, false, true, k.norm_final, 0, nullptr, 0, nullptr, nullptr, false, ldsf);
    PH_END
#undef PH_BEGIN
#undef PH_END
}
constexpr int N_PHASES = 1 + (10 + 9 + 8 + 10) + 1;

extern "C" void kernel_launch(void* const* d_in, const int* in_sizes, int n_in, void* d_out, int out_size, void* d_ws, size_t ws_size, hipStream_t stream) {
    static int grid = 0;
    if (grid == 0) {
        if (n_in != 33 || out_size != TL * D || ws_size < WS_END) { fprintf(stderr, "kernel_launch: unexpected shapes: n_in %d out %d ws %zu (need %zu)\n", n_in, out_size, ws_size, (size_t)WS_END); grid = -1; return; }
        int dev = 0, cus = 0, per_cu = 0;
        if (hipGetDevice(&dev) != hipSuccess || hipDeviceGetAttribute(&cus, hipDeviceAttributeMultiprocessorCount, dev) != hipSuccess) { grid = -1; return; }
        if (hipFuncSetAttribute((const void*)fwd_kernel, hipFuncAttributeMaxDynamicSharedMemorySize, LDS_BYTES) != hipSuccess) { fprintf(stderr, "kernel_launch: hipFuncSetAttribute failed\n"); grid = -1; return; }
        if (hipOccupancyMaxActiveBlocksPerMultiprocessor(&per_cu, (const void*)fwd_kernel, NTHR, LDS_BYTES) != hipSuccess || per_cu < 1) fprintf(stderr, "kernel_launch: occupancy query reports %d\n", per_cu);
        (void)hipGetLastError();
        grid = cus;
    }
    if (grid < 0) return;
    (void)hipMemsetAsync((char*)d_ws + WS_CTL, 0, CTL_BYTES, stream);
    Params p{};
    for (int i = 0; i < 33; ++i) p.in[i] = (const float*)d_in[i];
    p.out = (float*)d_out; p.ws = (unsigned char*)d_ws;
#if MK_MULTI
    for (int ph = 0; ph < N_PHASES; ++ph) { p.ph_lo = ph; p.ph_hi = ph + 1; hipLaunchKernelGGL(fwd_kernel, dim3(grid), dim3(NTHR), LDS_BYTES, stream, p); }
#else
    p.ph_lo = 0; p.ph_hi = N_PHASES;
    hipLaunchKernelGGL(fwd_kernel, dim3(grid), dim3(NTHR), LDS_BYTES, stream, p);
#endif
}
```

```cpp
#include <hip/hip_runtime.h>
#include <stdint.h>
#include <stdio.h>
#include <math.h>

#ifndef MK_MULTI
#define MK_MULTI 0
#endif

#ifndef PROBE_REP
#define PROBE_REP (-1)
#endif
#define LAS __attribute__((address_space(3)))
#define HD __host__ __device__ __forceinline__
#define DI __device__ __forceinline__
#ifdef NOINL
#define PF __device__ __noinline__
#else
#define PF __device__ __forceinline__
#endif
typedef unsigned short bf16_t;
typedef short bf16x8 __attribute__((ext_vector_type(8)));
typedef float f32x4 __attribute__((ext_vector_type(4)));
typedef unsigned u32x4 __attribute__((ext_vector_type(4)));
typedef unsigned u32x2 __attribute__((ext_vector_type(2)));

constexpr int D = 1024, NB = 2, SEQ = 16384, CTXL = 256, DEPTH = 4;
constexpr int TC = NB * CTXL, TL = NB * SEQ, T = TC + TL, NA = 2 * T;
constexpr int NTHR = 512;
constexpr int DN_IN = 4128;
constexpr float EPS = 1e-6f;
constexpr int LDS_BYTES = 140 * 1024;

constexpr size_t AL(size_t x) { return (x + 255) & ~(size_t)255; }
constexpr size_t WS_CTL = 0;
constexpr size_t CTL_BYTES = 65536;
constexpr size_t CTL_CNT = 16384;
constexpr size_t WS_MOD = WS_CTL + CTL_BYTES;
constexpr size_t WS_HDNL = AL(WS_MOD + 4 * 3 * 6144 * 4);
constexpr size_t WS_HDNC = AL(WS_HDNL + 16384 * 64 * 4);
constexpr size_t WS_FILTC = AL(WS_HDNC + 256 * 64 * 4);
constexpr size_t WS_DNWIN = AL(WS_FILTC + 256 * 4096 * 4);
constexpr size_t WS_DNWOUT = AL(WS_DNWIN + (size_t)2 * 4096 * 1024 * 2);
constexpr size_t WS_HYWIN = AL(WS_DNWOUT + (size_t)2 * 1024 * 1024 * 2);
constexpr size_t WS_HYWOUT = AL(WS_HYWIN + (size_t)3072 * 1024 * 2);
constexpr size_t WS_SCWIN = AL(WS_HYWOUT + (size_t)1024 * 1024 * 2);
constexpr size_t WS_SCWOUT = AL(WS_SCWIN + (size_t)3072 * 1024 * 2);
constexpr size_t WS_XS = AL(WS_SCWOUT + (size_t)1024 * 1024 * 2);
constexpr size_t WS_TOKE = AL(WS_XS + (size_t)T * 1024 * 4);
constexpr size_t WS_TOKW = AL(WS_TOKE + (size_t)T * 2 * 4);
constexpr size_t WS_TOKP = AL(WS_TOKW + (size_t)T * 2 * 4);
constexpr size_t WS_SLOT = AL(WS_TOKP + (size_t)T * 2 * 4);
constexpr size_t WS_GB = AL(WS_SLOT + (size_t)NA * 4);
constexpr size_t WS_EGL = AL(WS_GB + (size_t)T * 32 * 4);
constexpr size_t WS_AR = AL(WS_EGL + (size_t)32 * 260 * 4);
constexpr size_t AR_HBUF = WS_AR;
constexpr size_t AR_UBUF = AR_HBUF + (size_t)T * 1024 * 2;
constexpr size_t AR_PB = AR_UBUF + (size_t)T * 1024 * 2;
constexpr size_t AR_Q = AR_PB + (size_t)T * 4096 * 2;
constexpr size_t AR_CHUNK = AR_PB + (size_t)T * 3072 * 2;
constexpr size_t AR_DN_END = AR_CHUNK + (size_t)32 * 260 * 65536;
constexpr size_t AR_ZT = AR_Q;
constexpr size_t AR_FFTS = AR_ZT + (size_t)1024 * T * 2;
constexpr size_t AR_HY_END = AR_FFTS + (size_t)256 * 4 * 16384 * 8;
constexpr size_t AR_HID = AR_PB;
constexpr size_t AR_YS = AR_HID + (size_t)NA * 512 * 2;
constexpr size_t AR_WGU = AR_YS + (size_t)NA * 1024 * 2;
constexpr size_t AR_WD = AR_WGU + (size_t)32 * 1024 * 1024 * 2;
constexpr size_t AR_MOE_END = AR_WD + (size_t)32 * 1024 * 512 * 2;
constexpr size_t WS_END = AR_DN_END > AR_HY_END ? (AR_DN_END > AR_MOE_END ? AR_DN_END : AR_MOE_END) : (AR_HY_END > AR_MOE_END ? AR_HY_END : AR_MOE_END);

#define XB_TMO      128
#define XB_XCNT(j)  (256  + 64 * (j))
#define XB_XSUB(j)  (1280 + 64 * (j))
#define XB_XGEN(j)  (2304 + 64 * (j))
#define XB_TOP      3328
#define XB_TOPGEN   3392
#define XCD_BAR_WORDS 3456
#define XB_SPIN_CAP (1u << 25)
DI unsigned xb_ld(unsigned* p)              { return __hip_atomic_load(p, __ATOMIC_RELAXED, __HIP_MEMORY_SCOPE_AGENT); }
DI unsigned xb_add(unsigned* p, unsigned v) { return __hip_atomic_fetch_add(p, v, __ATOMIC_RELAXED, __HIP_MEMORY_SCOPE_AGENT); }
DI unsigned xb_xcc_id() { return (unsigned)__builtin_amdgcn_s_getreg((3 << 11) | 20) & 0xFu; }
#define XB_SPIN(cond, bar) do { unsigned _sp = 0; while (cond) { __builtin_amdgcn_s_sleep(1); \
    if ((++_sp & 255u) == 0u) { if (xb_ld(&(bar)[XB_TMO])) break; if (_sp > XB_SPIN_CAP) { atomicAdd(&(bar)[XB_TMO], 1u); break; } } } } while (0)
struct XcdBarrier { unsigned* bar; unsigned x; volatile LAS unsigned* st; };
DI XcdBarrier xcd_barrier_post(unsigned* bar, volatile LAS unsigned* st) {
    XcdBarrier b; b.bar = bar; b.x = xb_xcc_id(); b.st = st;
    if (threadIdx.x == 0) (void)xb_add(&bar[XB_XCNT(b.x)], 1u);
    return b;
}
DI void xcd_barrier_complete(unsigned* bar, unsigned x, unsigned& nloc, unsigned& nx) {
    const unsigned G = gridDim.x * gridDim.y * gridDim.z;
    unsigned sum, cnt, mine, sp = 0u;
    for (;;) {
        sum = 0u; cnt = 0u; mine = 0u;
#pragma unroll
        for (unsigned j = 0; j < 16; ++j) { const unsigned c = xb_ld(&bar[XB_XCNT(j)]); sum += c; cnt += (c > 0u) ? 1u : 0u; mine = (j == x) ? c : mine; }
        if (sum == G) break;
        __builtin_amdgcn_s_sleep(1);
        if ((++sp & 255u) == 0u) { if (xb_ld(&bar[XB_TMO])) break; if (sp > XB_SPIN_CAP) { atomicAdd(&bar[XB_TMO], 1u); break; } }
    }
    nloc = mine > 0u ? mine : 1u; nx = cnt > 0u ? cnt : 1u;
}
DI void xcd_barrier(const XcdBarrier& b) {
    asm volatile("s_waitcnt vmcnt(0)" ::: "memory");
    __syncthreads();
    if (threadIdx.x == 0) {
        unsigned* bar = b.bar;
        __builtin_amdgcn_s_waitcnt(0);
        unsigned nloc = b.st[0], nx = b.st[1];
        if (nloc == 0u) { xcd_barrier_complete(bar, b.x, nloc, nx); b.st[0] = nloc; b.st[1] = nx; }
        const unsigned old = xb_add(&bar[XB_XSUB(b.x)], 1u);
        const unsigned gen = old / nloc;
        if (old + 1u == (gen + 1u) * nloc) {
            __builtin_amdgcn_fence(__ATOMIC_RELEASE, "agent");
            asm volatile("s_waitcnt vmcnt(0)" ::: "memory");
            const unsigned og = xb_add(&bar[XB_TOP], 1u);
            const unsigned tg = og / nx;
            if (og + 1u == (tg + 1u) * nx) xb_add(&bar[XB_TOPGEN], 1u);
            else XB_SPIN(xb_ld(&bar[XB_TOPGEN]) == tg, bar);
            __builtin_amdgcn_fence(__ATOMIC_ACQUIRE, "agent");
            xb_add(&bar[XB_XGEN(b.x)], 1u);
            asm volatile("s_waitcnt vmcnt(0)" ::: "memory");
        } else {
            XB_SPIN(xb_ld(&bar[XB_XGEN(b.x)]) == gen, bar);
            __builtin_amdgcn_fence(__ATOMIC_ACQUIRE, "agent");
            asm volatile("s_waitcnt vmcnt(0)" ::: "memory");
        }
    }
    __syncthreads();
}

DI bf16_t f2bf(float f) { unsigned u = __float_as_uint(f); u += 0x7fffu + ((u >> 16) & 1u); return (bf16_t)(u >> 16); }
DI float bf2f(bf16_t b) { return __uint_as_float(((unsigned)b) << 16); }
DI unsigned pk2(float lo, float hi) { return (unsigned)f2bf(lo) | ((unsigned)f2bf(hi) << 16); }
DI float siluf(float x) { return x / (1.0f + __expf(-x)); }
DI float sigmf(float x) { return 1.0f / (1.0f + __expf(-x)); }
DI float wsum(float v) {
#pragma unroll
    for (int m = 32; m >= 1; m >>= 1) v += __shfl_xor(v, m);
    return v;
}
DI int TID() { int t = threadIdx.x; asm volatile("" : "+v"(t)); return t; }
DI int modrow(int r) { return r < TC ? 0 : 1 + (r - TC) / SEQ; }

typedef float cf __attribute__((ext_vector_type(2)));
HD cf cmul(cf a, cf b) { cf r; r.x = a.x * b.x - a.y * b.y; r.y = a.x * b.y + a.y * b.x; return r; }
HD cf cadd(cf a, cf b) { cf r; r.x = a.x + b.x; r.y = a.y + b.y; return r; }
HD cf csub(cf a, cf b) { cf r; r.x = a.x - b.x; r.y = a.y - b.y; return r; }
template <int R> HD constexpr int brev(int i) { int r = 0; for (int b = 1, t = R >> 1; b < R; b <<= 1, t >>= 1) if (i & b) r |= t; return r; }
#define FFT_C32 {1.0f, 0.98078528040323044913f, 0.92387953251128675613f, 0.83146961230254523708f, 0.70710678118654752440f, 0.55557023301960222474f, 0.38268343236508977173f, 0.19509032201612826785f, 0.0f, -0.19509032201612826785f, -0.38268343236508977173f, -0.55557023301960222474f, -0.70710678118654752440f, -0.83146961230254523708f, -0.92387953251128675613f, -0.98078528040323044913f}
#define FFT_S32 {0.0f, 0.19509032201612826785f, 0.38268343236508977173f, 0.55557023301960222474f, 0.70710678118654752440f, 0.83146961230254523708f, 0.92387953251128675613f, 0.98078528040323044913f, 1.0f, 0.98078528040323044913f, 0.92387953251128675613f, 0.83146961230254523708f, 0.70710678118654752440f, 0.55557023301960222474f, 0.38268343236508977173f, 0.19509032201612826785f}
template <int R> HD constexpr int ilog2c() { int l = 0; for (int r = R; r > 1; r >>= 1) ++l; return l; }
template <int R> HD void dft_fwd(cf (&v)[R]) {
    constexpr float C[16] = FFT_C32; constexpr float S[16] = FFT_S32;
    constexpr int LG = ilog2c<R>();
#pragma unroll
    for (int st = 0; st < LG; ++st) {
#pragma unroll
        for (int i = 0; i < R / 2; ++i) {
            const int len = R >> st, half = len >> 1, blk = i / half, j = i % half, i0 = blk * len + j, i1 = i0 + half;
            const cf a = v[i0], c = v[i1];
            v[i0] = cadd(a, c);
            const cf d = csub(a, c);
            const int ti = j * (32 / len);
            cf w; w.x = C[ti]; w.y = -S[ti];
            v[i1] = (ti == 0) ? d : cmul(d, w);
        }
    }
}
template <int R> HD void dft_inv(cf (&v)[R]) {
    constexpr float C[16] = FFT_C32; constexpr float S[16] = FFT_S32;
    constexpr int LG = ilog2c<R>();
#pragma unroll
    for (int st = LG - 1; st >= 0; --st) {
#pragma unroll
        for (int i = 0; i < R / 2; ++i) {
            const int len = R >> st, half = len >> 1, blk = i / half, j = i % half, i0 = blk * len + j, i1 = i0 + half;
            const int ti = j * (32 / len);
            cf w; w.x = C[ti]; w.y = S[ti];
            const cf a = v[i0];
            const cf c = (ti == 0) ? v[i1] : cmul(v[i1], w);
            v[i0] = cadd(a, c);
            v[i1] = csub(a, c);
        }
    }
}
template <int R> DI void fft_pass_fwd(LAS cf* X, int n, int g) {
    const int s = n / R, q = g / s, p = g - q * s, base = q * n + p;
    cf v[R];
#pragma unroll
    for (int k = 0; k < R; ++k) v[k] = X[base + k * s];
    dft_fwd<R>(v);
    if (s > 1) {
        int pp = p; asm volatile("" : "+v"(pp));
        float sn, cs; sincospif(-2.0f * (float)pp / (float)n, &sn, &cs);
        cf w1; w1.x = cs; w1.y = sn; cf w = w1;
#pragma unroll
        for (int m = 1; m < R; ++m) { v[brev<R>(m)] = cmul(v[brev<R>(m)], w); w = cmul(w, w1); }
    }
#pragma unroll
    for (int k = 0; k < R; ++k) X[base + k * s] = v[k];
}
template <int R> DI void fft_pass_inv(LAS cf* X, int n, int g) {
    const int s = n / R, q = g / s, p = g - q * s, base = q * n + p;
    cf v[R];
#pragma unroll
    for (int k = 0; k < R; ++k) v[k] = X[base + k * s];
    if (s > 1) {
        int pp = p; asm volatile("" : "+v"(pp));
        float sn, cs; sincospif(2.0f * (float)pp / (float)n, &sn, &cs);
        cf w1; w1.x = cs; w1.y = sn; cf w = w1;
#pragma unroll
        for (int m = 1; m < R; ++m) { v[brev<R>(m)] = cmul(v[brev<R>(m)], w); w = cmul(w, w1); }
    }
    dft_inv<R>(v);
#pragma unroll
    for (int k = 0; k < R; ++k) X[base + k * s] = v[k];
}
DI void fft16k_fwd(LAS cf* X) {
    const int t = TID();
#pragma unroll 1
    for (int g = 0; g < 2; ++g) fft_pass_fwd<16>(X, 16384, t + 512 * g);
    __syncthreads();
#pragma unroll 1
    for (int g = 0; g < 2; ++g) fft_pass_fwd<16>(X, 1024, t + 512 * g);
    __syncthreads();
#pragma unroll 1
    for (int g = 0; g < 2; ++g) fft_pass_fwd<16>(X, 64, t + 512 * g);
    __syncthreads();
#pragma unroll 1
    for (int g = 0; g < 8; ++g) fft_pass_fwd<4>(X, 4, t + 512 * g);
    __syncthreads();
}
DI void fft16k_inv(LAS cf* X) {
    const int t = TID();
#pragma unroll 1
    for (int g = 0; g < 8; ++g) fft_pass_inv<4>(X, 4, t + 512 * g);
    __syncthreads();
#pragma unroll 1
    for (int g = 0; g < 2; ++g) fft_pass_inv<16>(X, 64, t + 512 * g);
    __syncthreads();
#pragma unroll 1
    for (int g = 0; g < 2; ++g) fft_pass_inv<16>(X, 1024, t + 512 * g);
    __syncthreads();
#pragma unroll 1
    for (int g = 0; g < 2; ++g) fft_pass_inv<16>(X, 16384, t + 512 * g);
    __syncthreads();
}

struct Params { const float* in[33]; float* out; unsigned char* ws; int ph_lo, ph_hi; };
struct KC {
    const float *x, *c, *ctx, *c_ctx, *ada_w, *ada_b, *norm_mix, *norm_ffn, *norm_final;
    const float *dn_w_in, *dn_conv, *dn_a_log, *dn_dt_bias, *dn_out_norm, *dn_w_out;
    const float *hy_w_in, *hy_conv, *hy_f_w1, *hy_f_b1, *hy_f_freq, *hy_f_w2, *hy_f_b2, *hy_f_w3, *hy_bias, *hy_w_out;
    const float *sc_w_in, *sc_conv, *sc_w_out, *w_router, *router_bias, *moe_w_gate, *moe_w_up, *moe_w_down;
    float* out; unsigned char* ws;
};

PF void job_mod(const KC& k, LAS float* lds) {
    const int tid = TID(), cj = tid & 63, kq = tid >> 6;
    float* mod = (float*)(k.ws + WS_MOD);
    for (int u = blockIdx.x; u < DEPTH * 96; u += gridDim.x) {
        const int l = u / 96, cc = u % 96, col = cc * 64 + cj;
        const float* W = k.ada_w + (size_t)l * 1024 * 6144;
        float a0 = 0.f, a1 = 0.f, a2 = 0.f;
        for (int kk = kq * 128; kk < kq * 128 + 128; ++kk) {
            const float w = W[(size_t)kk * 6144 + col];
            a0 += siluf(k.c_ctx[kk]) * w; a1 += siluf(k.c[kk]) * w; a2 += siluf(k.c[1024 + kk]) * w;
        }
        lds[(kq * 3 + 0) * 64 + cj] = a0; lds[(kq * 3 + 1) * 64 + cj] = a1; lds[(kq * 3 + 2) * 64 + cj] = a2;
        __syncthreads();
        if (tid < 192) {
            const int r = tid >> 6, j = tid & 63;
            float s = 0.f;
            for (int q = 0; q < 8; ++q) s += lds[(q * 3 + r) * 64 + j];
            mod[(size_t)(l * 3 + r) * 6144 + cc * 64 + j] = s + k.ada_b[l * 6144 + cc * 64 + j];
        }
        __syncthreads();
    }
}
DI void cvt_tile(const float* __restrict__ src, int ld, bf16_t* __restrict__ dst, int ldd, int k0, int n0, int mapmode, LAS float* lds) {
    const int tid = TID();
    { const int r = tid >> 4, c4 = (tid & 15) * 4;
#pragma unroll
      for (int h = 0; h < 2; ++h) {
          const f32x4 v = *(const f32x4*)(src + (size_t)(k0 + r + 32 * h) * ld + n0 + c4);
          LAS float* p = lds + (r + 32 * h) * 65 + c4; p[0] = v[0]; p[1] = v[1]; p[2] = v[2]; p[3] = v[3];
      } }
    __syncthreads();
    { const int nn = tid >> 3, ks = (tid & 7) * 8; const int n = n0 + nn;
      const int row = mapmode == 0 ? n : (32 * (n >> 4) + (n & 15) + (mapmode == 2 ? 16 : 0));
      u32x4 o;
      o[0] = pk2(lds[(ks + 0) * 65 + nn], lds[(ks + 1) * 65 + nn]); o[1] = pk2(lds[(ks + 2) * 65 + nn], lds[(ks + 3) * 65 + nn]);
      o[2] = pk2(lds[(ks + 4) * 65 + nn], lds[(ks + 5) * 65 + nn]); o[3] = pk2(lds[(ks + 6) * 65 + nn], lds[(ks + 7) * 65 + nn]);
      *(u32x4*)(dst + (size_t)row * ldd + k0 + ks) = o; }
    __syncthreads();
}
DI void cvt_matrix(const float* src, int ld, size_t sstride, int K, int N, int nmat, bf16_t* dst, int ldd, size_t dstride, int mapmode, LAS float* lds) {
    const int tk = K / 64, tn = N / 64, per = tk * tn;
    for (int u = blockIdx.x; u < per * nmat; u += gridDim.x) {
        const int m = u / per, t = u % per;
        cvt_tile(src + (size_t)m * sstride, ld, dst + (size_t)m * dstride, ldd, (t / tn) * 64, (t % tn) * 64, mapmode, lds);
    }
}
PF void job_cvt_small(const KC& k, LAS float* lds) {
    cvt_matrix(k.dn_w_in, DN_IN, (size_t)1024 * DN_IN, 1024, 4096, 2, (bf16_t*)(k.ws + WS_DNWIN), 1024, (size_t)4096 * 1024, 0, lds);
    cvt_matrix(k.dn_w_out, 1024, (size_t)1024 * 1024, 1024, 1024, 2, (bf16_t*)(k.ws + WS_DNWOUT), 1024, (size_t)1024 * 1024, 0, lds);
    cvt_matrix(k.hy_w_in, 3072, 0, 1024, 3072, 1, (bf16_t*)(k.ws + WS_HYWIN), 1024, 0, 0, lds);
    cvt_matrix(k.hy_w_out, 1024, 0, 1024, 1024, 1, (bf16_t*)(k.ws + WS_HYWOUT), 1024, 0, 0, lds);
    cvt_matrix(k.sc_w_in, 3072, 0, 1024, 3072, 1, (bf16_t*)(k.ws + WS_SCWIN), 1024, 0, 0, lds);
    cvt_matrix(k.sc_w_out, 1024, 0, 1024, 1024, 1, (bf16_t*)(k.ws + WS_SCWOUT), 1024, 0, 0, lds);
}
PF void job_cvt_moe(const KC& k, int layer, LAS float* lds) {
    const size_t lo = (size_t)layer * 32 * 1024 * 512;
    cvt_matrix(k.moe_w_gate + lo, 512, (size_t)1024 * 512, 1024, 512, 32, (bf16_t*)(k.ws + AR_WGU), 1024, (size_t)1024 * 1024, 1, lds);
    cvt_matrix(k.moe_w_up + lo, 512, (size_t)1024 * 512, 1024, 512, 32, (bf16_t*)(k.ws + AR_WGU), 1024, (size_t)1024 * 1024, 2, lds);
    cvt_matrix(k.moe_w_down + lo, 1024, (size_t)512 * 1024, 512, 1024, 32, (bf16_t*)(k.ws + AR_WD), 512, (size_t)1024 * 512, 0, lds);
}
PF void job_hdn(const KC& k, LAS float* lds) {
    const int tid = TID(), lane = tid & 63, wave = tid >> 6;
    LAS float* feat = lds + wave * 128; LAS float* h1 = feat + 64;
    const float fr = k.hy_f_freq[lane], b1 = k.hy_f_b1[lane], b2 = k.hy_f_b2[lane];
    for (int u0 = blockIdx.x * 8; u0 < 16384 + 256; u0 += gridDim.x * 8) {
        const int u = u0 + wave;
        int l, pos; float* dst;
        if (u < 16384) { l = 16384; pos = u; dst = (float*)(k.ws + WS_HDNL) + (size_t)u * 64; }
        else { l = 256; pos = u - 16384; dst = (float*)(k.ws + WS_HDNC) + (size_t)pos * 64; }
        const float t = (float)pos / (float)(l - 1);
        float f = 0.f;
        if (lane == 0) f = t;
        else if (lane <= 32) {
            const int bi = (lane - 1) & 15;
            const float band = 1e-4f + (float)bi * ((15.0f - 1e-4f) / 15.0f);
            const float ang = (6.283185307179586f / (float)l) * (float)pos * band;
            f = lane <= 16 ? cosf(ang) : -sinf(ang);
        }
        feat[lane] = f;
        __syncthreads();
        float a = b1;
        for (int i = 0; i < 33; ++i) a += feat[i] * k.hy_f_w1[i * 64 + lane];
        h1[lane] = sinf(fr * a);
        __syncthreads();
        float a2 = b2;
        for (int j = 0; j < 64; ++j) a2 += h1[j] * k.hy_f_w2[j * 64 + lane];
        dst[lane] = sinf(fr * a2);
        __syncthreads();
    }
}
DI float hy_delta(int ch) {
    const float lo = -4.605170185988091f / 1.5f, hi = -4.605170185988091f / 0.3f;
    return fabsf(lo + (float)ch * ((hi - lo) / 1023.0f));
}
PF void job_filtc(const KC& k, int j) {
    const float* hdn = (const float*)(k.ws + WS_HDNC);
    const float* w3 = k.hy_f_w3 + (size_t)j * 64 * 4096;
    float* filtc = (float*)(k.ws + WS_FILTC);
    const int tq = TID();
    for (int u = blockIdx.x; u < 256 * 8; u += gridDim.x) {
        const int l = u >> 3, col = (u & 7) * 512 + tq;
        float a = 0.f;
        for (int q = 0; q < 64; ++q) a += hdn[l * 64 + q] * w3[(size_t)q * 4096 + col];
        const float t = (float)l / 255.0f;
        filtc[(size_t)l * 4096 + col] = a * expf(-t * hy_delta(col & 1023));
    }
}

template <int MODE>
PF void norm_phase(const KC& k, int layer, bool first, bool combine, const float* __restrict__ gain, int mb, const float* __restrict__ Wsk, int ldw,
                   const float* __restrict__ aux0, const float* __restrict__ aux1, bool last, LAS float* lds) {
    const int tid = TID(), lane = tid & 63, wave = tid >> 6;
    float* xs = (float*)(k.ws + WS_XS);
    bf16_t* hbuf = (bf16_t*)(k.ws + AR_HBUF);
    const float* mod = (const float*)(k.ws + WS_MOD);
    const bf16_t* ys = (const bf16_t*)(k.ws + AR_YS);
    const int* tokp = (const int*)(k.ws + WS_TOKP);
    const float* tokw = (const float*)(k.ws + WS_TOKW);
    if (MODE == 1 || MODE == 2) {
        for (int idx = tid; idx < 1024 * 32; idx += NTHR) {
            const int kk = idx >> 5, n = idx & 31;
            lds[kk * 32 + (((n >> 2) ^ ((kk >> 1) & 7)) << 2) + (n & 3)] = Wsk[(size_t)kk * ldw + n];
        }
        __syncthreads();
    }
    const int rbeg = (MODE == 3) ? TC : 0;
    for (int r = rbeg + blockIdx.x * 8 + wave; r < T; r += gridDim.x * 8) {
        const int mr = modrow(r);
        const float* src = first ? (r < TC ? k.ctx + (size_t)r * 1024 : k.x + (size_t)(r - TC) * 1024) : xs + (size_t)r * 1024;
        float x[16];
#pragma unroll
        for (int m = 0; m < 16; ++m) x[m] = src[lane + 64 * m];
        if (combine) {
            const int p0 = tokp[2 * r], p1 = tokp[2 * r + 1];
            const float w0 = tokw[2 * r], w1 = tokw[2 * r + 1];
            const float* g5 = mod + ((size_t)((layer - 1) * 3 + mr) * 6 + 5) * 1024;
#pragma unroll
            for (int m = 0; m < 16; ++m) {
                const int col = lane + 64 * m;
                x[m] += g5[col] * (w0 * bf2f(ys[(size_t)p0 * 1024 + col]) + w1 * bf2f(ys[(size_t)p1 * 1024 + col]));
            }
        }
        if (first || combine) {
#pragma unroll
            for (int m = 0; m < 16; ++m) xs[(size_t)r * 1024 + lane + 64 * m] = x[m];
        }
        float ss = 0.f;
#pragma unroll
        for (int m = 0; m < 16; ++m) ss += x[m] * x[m];
        ss = wsum(ss);
        const float rstd = rsqrtf(ss * (1.0f / 1024.0f) + EPS);
        if (MODE == 3) {
#pragma unroll
            for (int m = 0; m < 16; ++m) { const int col = lane + 64 * m; k.out[(size_t)(r - TC) * 1024 + col] = x[m] * rstd * gain[col]; }
            continue;
        }
        const float* shift = mod + ((size_t)(layer * 3 + mr) * 6 + mb) * 1024;
        const float* scale = shift + 1024;
        float y[16];
#pragma unroll
        for (int m = 0; m < 16; ++m) {
            const int col = lane + 64 * m;
            y[m] = x[m] * rstd * gain[col] * (1.0f + scale[col]) + shift[col];
            hbuf[(size_t)r * 1024 + col] = f2bf(y[m]);
        }
        if (MODE == 1 || MODE == 2) {
            float acc[32];
#pragma unroll
            for (int n = 0; n < 32; ++n) acc[n] = 0.f;
#pragma unroll
            for (int m = 0; m < 16; ++m) {
                asm volatile("" ::: "memory");
                const int c = lane + 64 * m;
                const LAS float* wr = lds + c * 32; const int sw = (c >> 1) & 7;
#pragma unroll
                for (int q = 0; q < 8; ++q) {
                    const f32x4 w4 = *(const LAS f32x4*)(wr + ((q ^ sw) << 2));
                    acc[4 * q + 0] += y[m] * w4[0]; acc[4 * q + 1] += y[m] * w4[1]; acc[4 * q + 2] += y[m] * w4[2]; acc[4 * q + 3] += y[m] * w4[3];
                }
            }
            float val;
            {
                float a16[16], a8[8], a4[4], a2[2];
                const bool b5 = (lane & 32) != 0, b4 = (lane & 16) != 0, b3 = (lane & 8) != 0, b2 = (lane & 4) != 0, b1 = (lane & 2) != 0;
#pragma unroll
                for (int i = 0; i < 16; ++i) { const float send = b5 ? acc[i] : acc[i + 16], keep = b5 ? acc[i + 16] : acc[i]; a16[i] = keep + __shfl_xor(send, 32); }
#pragma unroll
                for (int i = 0; i < 8; ++i) { const float send = b4 ? a16[i] : a16[i + 8], keep = b4 ? a16[i + 8] : a16[i]; a8[i] = keep + __shfl_xor(send, 16); }
#pragma unroll
                for (int i = 0; i < 4; ++i) { const float send = b3 ? a8[i] : a8[i + 4], keep = b3 ? a8[i + 4] : a8[i]; a4[i] = keep + __shfl_xor(send, 8); }
#pragma unroll
                for (int i = 0; i < 2; ++i) { const float send = b2 ? a4[i] : a4[i + 2], keep = b2 ? a4[i + 2] : a4[i]; a2[i] = keep + __shfl_xor(send, 4); }
                { const float send = b1 ? a2[0] : a2[1], keep = b1 ? a2[1] : a2[0]; val = keep + __shfl_xor(send, 2); }
                val += __shfl_xor(val, 1);
            }
            const int n = lane >> 1;
            if (MODE == 1) {
                int* toke = (int*)(k.ws + WS_TOKE); float* tokwW = (float*)(k.ws + WS_TOKW);
                int* cnt = (int*)(k.ws + WS_CTL + CTL_CNT) + layer * 32;
                if (last && r < TC) { if (lane == 0) { toke[2 * r] = -1; toke[2 * r + 1] = -1; } continue; }
                const float sc = 1.0f / (1.0f + expf(-val)), ch = sc + aux0[n];
                const int gl = lane & ~7;
                const float ca = __shfl(ch, gl), cb = __shfl(ch, gl + 2), cc = __shfl(ch, gl + 4), cd = __shfl(ch, gl + 6);
                const float hi1 = fmaxf(ca, cb), lo1 = fminf(ca, cb), hi2 = fmaxf(cc, cd), lo2 = fminf(cc, cd);
                float gs = fmaxf(hi1, hi2) + fmaxf(fminf(hi1, hi2), fmaxf(lo1, lo2));
                int gi = lane >> 3;
#pragma unroll
                for (int m = 8; m <= 32; m <<= 1) {
                    const float og = __shfl_xor(gs, m); const int oi = __shfl_xor(gi, m);
                    if (og > gs || (og == gs && oi < gi)) { gs = og; gi = oi; }
                }
                float c4[4], s4[4];
#pragma unroll
                for (int i = 0; i < 4; ++i) { c4[i] = __shfl(ch, gi * 8 + 2 * i); s4[i] = __shfl(sc, gi * 8 + 2 * i); }
                int i1 = 0; float b1v = c4[0];
#pragma unroll
                for (int i = 1; i < 4; ++i) if (c4[i] > b1v) { b1v = c4[i]; i1 = i; }
                int i2 = -1; float b2v = -1e30f;
#pragma unroll
                for (int i = 0; i < 4; ++i) if (i != i1 && c4[i] > b2v) { b2v = c4[i]; i2 = i; }
                float w1v = 0.f, w2v = 0.f;
#pragma unroll
                for (int i = 0; i < 4; ++i) { if (i == i1) w1v = s4[i]; if (i == i2) w2v = s4[i]; }
                const float inv = 1.0f / (w1v + w2v);
                if (lane == 0) {
                    const int e1 = gi * 4 + i1, e2 = gi * 4 + i2;
                    toke[2 * r] = e1; toke[2 * r + 1] = e2; tokwW[2 * r] = w1v * inv; tokwW[2 * r + 1] = w2v * inv;
                    atomicAdd(&cnt[e1], 1); atomicAdd(&cnt[e2], 1);
                }
            } else {
                float* gb = (float*)(k.ws + WS_GB);
                if ((lane & 1) == 0) {
                    if (n < 16) {
                        const float z = val + aux1[n];
                        const float sp = z > 20.f ? z : log1pf(expf(z));
                        gb[(size_t)r * 32 + n] = -expf(aux0[n]) * sp;
                    } else {
                        gb[(size_t)r * 32 + n] = 1.0f / (1.0f + expf(-val));
                    }
                }
            }
        }
    }
}

template <class Epi>
DI void gemm_tile(LAS bf16_t* lds, const bf16_t* __restrict__ A, int lda, const int* __restrict__ rowidx, int m0, int mrows,
                  const bf16_t* __restrict__ Bt, int K, int n0, const Epi& epi) {
    const int tid = TID(), lane = tid & 63, wave = tid >> 6, wr = wave >> 2, wc = wave & 3, fr = lane & 15, fq = lane >> 4;
    LAS bf16_t* As = lds; LAS bf16_t* Bs = lds + 128 * 72;
    const int seg = tid & 7, r0 = tid >> 3;
    const int ra0 = r0 < mrows ? r0 : 0, ra1 = (r0 + 64) < mrows ? (r0 + 64) : 0;
    size_t ar0, ar1;
    if (rowidx) { ar0 = (size_t)rowidx[m0 + ra0]; ar1 = (size_t)rowidx[m0 + ra1]; } else { ar0 = (size_t)(m0 + ra0); ar1 = (size_t)(m0 + ra1); }
    const bf16_t* pa0 = A + ar0 * lda + seg * 8; const bf16_t* pa1 = A + ar1 * lda + seg * 8;
    const bf16_t* pb0 = Bt + (size_t)(n0 + r0) * K + seg * 8; const bf16_t* pb1 = Bt + (size_t)(n0 + r0 + 64) * K + seg * 8;
    u32x4 ga0 = *(const u32x4*)pa0, ga1 = *(const u32x4*)pa1, gb0 = *(const u32x4*)pb0, gb1 = *(const u32x4*)pb1;
    f32x4 acc[4][2];
#pragma unroll
    for (int m = 0; m < 4; ++m)
#pragma unroll
        for (int n = 0; n < 2; ++n) acc[m][n] = (f32x4){0.f, 0.f, 0.f, 0.f};
    const int nk = K >> 6;
    for (int kt = 0; kt < nk; ++kt) {
        __syncthreads();
        *(LAS u32x4*)(As + r0 * 72 + seg * 8) = ga0; *(LAS u32x4*)(As + (r0 + 64) * 72 + seg * 8) = ga1;
        *(LAS u32x4*)(Bs + r0 * 72 + seg * 8) = gb0; *(LAS u32x4*)(Bs + (r0 + 64) * 72 + seg * 8) = gb1;
        __syncthreads();
        if (kt + 1 < nk) {
            const int ko = (kt + 1) * 64;
            ga0 = *(const u32x4*)(pa0 + ko); ga1 = *(const u32x4*)(pa1 + ko); gb0 = *(const u32x4*)(pb0 + ko); gb1 = *(const u32x4*)(pb1 + ko);
        }
#pragma unroll
        for (int kk = 0; kk < 2; ++kk) {
            bf16x8 af[4], bfv[2];
#pragma unroll
            for (int m = 0; m < 4; ++m) af[m] = *(const LAS bf16x8*)(As + (wr * 64 + m * 16 + fr) * 72 + kk * 32 + fq * 8);
#pragma unroll
            for (int n = 0; n < 2; ++n) bfv[n] = *(const LAS bf16x8*)(Bs + (wc * 32 + n * 16 + fr) * 72 + kk * 32 + fq * 8);
#pragma unroll
            for (int m = 0; m < 4; ++m)
#pragma unroll
                for (int n = 0; n < 2; ++n) acc[m][n] = __builtin_amdgcn_mfma_f32_16x16x32_bf16(af[m], bfv[n], acc[m][n], 0, 0, 0);
        }
    }
    epi(acc, m0, mrows, n0, wr, wc, fr, fq);
}
struct EpiBf16 {
    bf16_t* C; int ldc;
    DI void operator()(const f32x4 (&acc)[4][2], int m0, int mrows, int n0, int wr, int wc, int fr, int fq) const {
#pragma unroll
        for (int m = 0; m < 4; ++m)
#pragma unroll
            for (int j = 0; j < 4; ++j) {
                const int rl = wr * 64 + m * 16 + fq * 4 + j;
                if (rl < mrows) {
#pragma unroll
                    for (int n = 0; n < 2; ++n) C[(size_t)(m0 + rl) * ldc + n0 + wc * 32 + n * 16 + fr] = f2bf(acc[m][n][j]);
                }
            }
    }
};
struct EpiDnSplit {
    bf16_t* P; bf16_t* Z;
    DI void operator()(const f32x4 (&acc)[4][2], int m0, int mrows, int n0, int wr, int wc, int fr, int fq) const {
        bf16_t* base; int ldc, cb;
        if (n0 < 3072) { base = P; ldc = 3072; cb = n0; } else { base = Z; ldc = 1024; cb = n0 - 3072; }
#pragma unroll
        for (int m = 0; m < 4; ++m)
#pragma unroll
            for (int j = 0; j < 4; ++j) {
                const int rl = wr * 64 + m * 16 + fq * 4 + j;
#pragma unroll
                for (int n = 0; n < 2; ++n) base[(size_t)(m0 + rl) * ldc + cb + wc * 32 + n * 16 + fr] = f2bf(acc[m][n][j]);
            }
    }
};
struct EpiBf16T {
    bf16_t* C; int ldc;
    DI void operator()(const f32x4 (&acc)[4][2], int m0, int mrows, int n0, int wr, int wc, int fr, int fq) const {
#pragma unroll
        for (int m = 0; m < 4; ++m)
#pragma unroll
            for (int n = 0; n < 2; ++n) {
                const int row = m0 + wr * 64 + m * 16 + fq * 4, col = n0 + wc * 32 + n * 16 + fr;
                u32x2 o; o[0] = pk2(acc[m][n][0], acc[m][n][1]); o[1] = pk2(acc[m][n][2], acc[m][n][3]);
                *(u32x2*)(C + (size_t)col * ldc + row) = o;
            }
    }
};
struct EpiResid {
    float* xs; const float* mod; int layer; int chunk;
    DI void operator()(const f32x4 (&acc)[4][2], int m0, int mrows, int n0, int wr, int wc, int fr, int fq) const {
        const float* g = mod + ((size_t)(layer * 3 + modrow(m0)) * 6 + chunk) * 1024;
#pragma unroll
        for (int n = 0; n < 2; ++n) {
            const int col = n0 + wc * 32 + n * 16 + fr; const float gv = g[col];
#pragma unroll
            for (int m = 0; m < 4; ++m)
#pragma unroll
                for (int j = 0; j < 4; ++j) { float* p = xs + (size_t)(m0 + wr * 64 + m * 16 + fq * 4 + j) * 1024 + col; *p = *p + gv * acc[m][n][j]; }
        }
    }
};
struct EpiGateUp {
    bf16_t* hid;
    DI void operator()(const f32x4 (&acc)[4][2], int m0, int mrows, int n0, int wr, int wc, int fr, int fq) const {
        const int hc = ((n0 + wc * 32) >> 1) + fr;
#pragma unroll
        for (int m = 0; m < 4; ++m)
#pragma unroll
            for (int j = 0; j < 4; ++j) {
                const int rl = wr * 64 + m * 16 + fq * 4 + j;
                if (rl < mrows) { const float g = acc[m][0][j]; hid[(size_t)(m0 + rl) * 512 + hc] = f2bf(siluf(g) * acc[m][1][j]); }
            }
    }
};
template <class Epi>
PF void gemm_dense(LAS bf16_t* lds, const bf16_t* A, int M, const bf16_t* Bt, int N, int K, const Epi& epi) {
    const int tn = N / 128, tm = M / 128;
    for (int u = blockIdx.x; u < tm * tn; u += gridDim.x) {
        const int mt = u / tn, nt = u % tn;
        gemm_tile(lds, A, K, (const int*)nullptr, mt * 128, 128, Bt, K, nt * 128, epi);
    }
}
DI void moe_table(const KC& k, int layer, LAS int* tb) {
    const int* cnt = (const int*)(k.ws + WS_CTL + CTL_CNT) + layer * 32;
    __syncthreads();
    const int tq = TID();
    if (tq < 32) tb[tq] = __hip_atomic_load(cnt + tq, __ATOMIC_RELAXED, __HIP_MEMORY_SCOPE_AGENT);
    __syncthreads();
    if (tq == 0) {
        int s = 0, tp = 0;
        for (int e = 0; e < 32; ++e) { tb[32 + e] = s; tb[65 + e] = tp; s += tb[e]; tp += (tb[e] + 127) >> 7; }
        tb[64] = s; tb[97] = tp;
    }
    __syncthreads();
}
template <int WHICH>
PF void moe_gemm(const KC& k, int layer, LAS bf16_t* lds, LAS int* tb) {
    moe_table(k, layer, tb);
    const int ntile = tb[97];
    for (int u = blockIdx.x; u < ntile * 8; u += gridDim.x) {
        const int tile = u >> 3, nt = u & 7;
        int e = 0;
        for (int q = 1; q < 32; ++q) if (tb[65 + q] <= tile) e = q;
        const int lt = tile - tb[65 + e], m0 = tb[32 + e] + lt * 128;
        int mrows = tb[e] - lt * 128; mrows = mrows > 128 ? 128 : mrows;
        if (WHICH == 0) {
            EpiGateUp epi{(bf16_t*)(k.ws + AR_HID)};
            gemm_tile(lds, (const bf16_t*)(k.ws + AR_HBUF), 1024, (const int*)(k.ws + WS_SLOT), m0, mrows,
                      (const bf16_t*)(k.ws + AR_WGU) + (size_t)e * 1024 * 1024, 1024, nt * 128, epi);
        } else {
            EpiBf16 epi{(bf16_t*)(k.ws + AR_YS), 1024};
            gemm_tile(lds, (const bf16_t*)(k.ws + AR_HID), 512, (const int*)nullptr, m0, mrows,
                      (const bf16_t*)(k.ws + AR_WD) + (size_t)e * 1024 * 512, 512, nt * 128, epi);
        }
    }
}
PF void moe_scatter(const KC& k, int layer, LAS int* tb) {
    moe_table(k, layer, tb);
    const int* toke = (const int*)(k.ws + WS_TOKE);
    int* tokp = (int*)(k.ws + WS_TOKP); int* slot = (int*)(k.ws + WS_SLOT);
    int* cur = (int*)(k.ws + WS_CTL + CTL_CNT) + 128 + layer * 32;
    const int tq2 = TID();
    for (int r = blockIdx.x * NTHR + tq2; r < T; r += gridDim.x * NTHR) {
#pragma unroll
        for (int q = 0; q < 2; ++q) {
            const int e = toke[2 * r + q];
            if (e >= 0) { const int pos = tb[32 + e] + atomicAdd(&cur[e], 1); slot[pos] = r; tokp[2 * r + q] = pos; }
        }
    }
}

PF void sc_mix(const KC& k, int j) {
    const int tid = TID(), lane = tid & 63, wave = tid >> 6;
    const bf16_t* P = (const bf16_t*)(k.ws + AR_PB);
    bf16_t* U = (bf16_t*)(k.ws + AR_UBUF);
    const float* cw = k.sc_conv + (size_t)j * 3 * 1024;
    for (int r = blockIdx.x * 8 + wave; r < T; r += gridDim.x * 8) {
        bool lok, rok;
        if (r < TC) { const int t = r & 255; lok = t != 0; rok = t != 255; } else { const int t = (r - TC) & 63; lok = t != 0; rok = t != 63; }
        const bf16_t* p = P + (size_t)r * 3072;
#pragma unroll 4
        for (int m = 0; m < 16; ++m) {
            const int col = lane + 64 * m;
            const float bg = bf2f(p[col]);
            const float mc = bf2f(p[1024 + col]) * bf2f(p[2048 + col]);
            const float ml = lok ? bf2f(p[-3072 + 1024 + col]) * bf2f(p[-3072 + 2048 + col]) : 0.f;
            const float mrr = rok ? bf2f(p[3072 + 1024 + col]) * bf2f(p[3072 + 2048 + col]) : 0.f;
            U[(size_t)r * 1024 + col] = f2bf(bg * (cw[col] * ml + cw[1024 + col] * mc + cw[2048 + col] * mrr));
        }
    }
}

constexpr int DN_STEPS = 260, DN_UNITS = 32 * DN_STEPS;
DI int dn_rbase(int b, int dir, int s) {
    if (s < 4) return dir == 0 ? b * 256 + s * 64 : b * 256 + 255 - s * 64;
    const int cc = s - 4;
    return dir == 0 ? TC + b * SEQ + cc * 64 : TC + b * SEQ + SEQ - 1 - cc * 64;
}
PF void dn_chunk(const KC& k, int jl, LAS unsigned char* lds) {
    const int tid = TID(), lane = tid & 63, wave = tid >> 6, fr = lane & 15, fq = lane >> 4;
    LAS bf16_t* Kt = (LAS bf16_t*)lds;
    LAS bf16_t* Qt = Kt + 64 * 136;
    LAS bf16_t* Vt = Qt + 64 * 136;
    LAS float* Amat = (LAS float*)(Vt + 64 * 136);
    LAS bf16_t* Tb = (LAS bf16_t*)(Amat + 64 * 64);
    LAS bf16_t* VbT = Tb + 64 * 72;
    LAS bf16_t* KbT = VbT + 128 * 72;
    LAS float* gcs = (LAS float*)(KbT + 128 * 72);
    LAS float* bet = gcs + 64; LAS float* eg = bet + 64; LAS float* egr = eg + 64;
    const bf16_t* P = (const bf16_t*)(k.ws + AR_PB);
    const float* gb = (const float*)(k.ws + WS_GB);
    const float* cw = k.dn_conv + (size_t)jl * 3 * 3072;
    bf16_t* CH = (bf16_t*)(k.ws + AR_CHUNK);
    bf16_t* ATT = (bf16_t*)(k.ws + AR_HBUF);
    float* EGL = (float*)(k.ws + WS_EGL);
    for (int u = blockIdx.x; u < DN_UNITS; u += gridDim.x) {
        const int chain = u / DN_STEPS, s = u - chain * DN_STEPS, dir = chain & 1, h = (chain >> 1) & 7, b = chain >> 4;
        const int rbase = dn_rbase(b, dir, s), rstep = dir == 0 ? 1 : -1;
        bf16_t* cW = CH + (size_t)u * 32768; bf16_t* cQd = cW + 8192; bf16_t* cKd = cQd + 8192; bf16_t* cU = cKd + 8192;
        bf16_t* cAt = ATT + (size_t)u * 4096;
        __syncthreads();
        {
            const int i = tid >> 3, sg = tid & 7, r = rbase + rstep * i;
            bool lok, rok;
            if (r < TC) { const int t = r & 255; lok = t != 0; rok = t != 255; } else { const int t = (r - TC) & 63; lok = t != 0; rok = t != 63; }
#pragma unroll 1
            for (int part = 0; part < 3; ++part) {
                const int col = part * 1024 + h * 128 + sg * 16;
                const bf16_t* pc = P + (size_t)r * 3072 + col;
                float v[16];
#pragma unroll
                for (int hf = 0; hf < 2; ++hf) {
                    const u32x4 c4 = *(const u32x4*)(pc + hf * 8);
                    u32x4 l4 = (u32x4){0u, 0u, 0u, 0u}, r4 = (u32x4){0u, 0u, 0u, 0u};
                    if (lok) l4 = *(const u32x4*)(pc - 3072 + hf * 8);
                    if (rok) r4 = *(const u32x4*)(pc + 3072 + hf * 8);
#pragma unroll
                    for (int w = 0; w < 4; ++w) {
#pragma unroll
                        for (int e = 0; e < 2; ++e) {
                            const int cc = col + hf * 8 + 2 * w + e;
                            const float lv = __uint_as_float(e ? (l4[w] & 0xffff0000u) : (l4[w] << 16));
                            const float cv = __uint_as_float(e ? (c4[w] & 0xffff0000u) : (c4[w] << 16));
                            const float rv = __uint_as_float(e ? (r4[w] & 0xffff0000u) : (r4[w] << 16));
                            v[hf * 8 + 2 * w + e] = siluf(cw[cc] * lv + cw[3072 + cc] * cv + cw[6144 + cc] * rv);
                        }
                    }
                }
                if (part < 2) {
                    float ss = 0.f;
#pragma unroll
                    for (int e = 0; e < 16; ++e) ss += v[e] * v[e];
                    ss += __shfl_xor(ss, 1); ss += __shfl_xor(ss, 2); ss += __shfl_xor(ss, 4);
                    const float sc = rsqrtf(ss + EPS) * (part == 0 ? 0.08838834764831845f : 1.0f);
#pragma unroll
                    for (int e = 0; e < 16; ++e) v[e] *= sc;
                }
                LAS bf16_t* dst = (part == 0 ? Qt : (part == 1 ? Kt : Vt)) + i * 136 + sg * 16;
                u32x4 o0, o1;
#pragma unroll
                for (int w = 0; w < 4; ++w) { o0[w] = pk2(v[2 * w], v[2 * w + 1]); o1[w] = pk2(v[8 + 2 * w], v[8 + 2 * w + 1]); }
                *(LAS u32x4*)dst = o0; *(LAS u32x4*)(dst + 8) = o1;
            }
        }
        if (wave == 0) {
            const size_t row = (size_t)(rbase + rstep * lane);
            float g = gb[row * 32 + dir * 8 + h];
            const float be = gb[row * 32 + 16 + dir * 8 + h];
#pragma unroll
            for (int d = 1; d < 64; d <<= 1) { const float o = __shfl_up(g, d); if (lane >= d) g += o; }
            const float glast = __shfl(g, 63);
            gcs[lane] = g; bet[lane] = be; eg[lane] = expf(g); egr[lane] = expf(glast - g);
            if (lane == 0) EGL[u] = expf(glast);
        }
        __syncthreads();
#pragma unroll 1
        for (int x = 0; x < 4; ++x) {
            const int t = wave + 8 * x, isq = t >> 4, mt = (t >> 2) & 3, nt = t & 3;
            f32x4 acc = (f32x4){0.f, 0.f, 0.f, 0.f};
            if (mt >= nt) {
                const LAS bf16_t* Ar = (isq ? Qt : Kt) + (16 * mt + fr) * 136 + 8 * fq;
                const LAS bf16_t* Br = Kt + (16 * nt + fr) * 136 + 8 * fq;
#pragma unroll
                for (int ks = 0; ks < 4; ++ks) acc = __builtin_amdgcn_mfma_f32_16x16x32_bf16(*(const LAS bf16x8*)(Ar + 32 * ks), *(const LAS bf16x8*)(Br + 32 * ks), acc, 0, 0, 0);
            }
            const int jc = 16 * nt + fr; const float gj = gcs[jc];
#pragma unroll
            for (int jj = 0; jj < 4; ++jj) {
                const int ir = 16 * mt + 4 * fq + jj;
                const float dec = expf(fminf(gcs[ir] - gj, 0.f));
                if (isq) cAt[ir * 64 + jc] = f2bf(ir >= jc ? acc[jj] * dec : 0.f);
                else Amat[ir * 64 + jc] = ir > jc ? bet[ir] * acc[jj] * dec : 0.f;
            }
        }
        __syncthreads();
        if (wave == 0) {
            float tc[64];
#pragma unroll
            for (int i = 0; i < 64; ++i) {
                float a = (i == lane) ? 1.f : 0.f;
#pragma unroll
                for (int j4 = 0; j4 < (i + 3) / 4; ++j4) {
                    const f32x4 av = *(const LAS f32x4*)(Amat + i * 64 + 4 * j4);
#pragma unroll
                    for (int e = 0; e < 4; ++e) if (4 * j4 + e < i) a -= av[e] * tc[4 * j4 + e];
                }
                tc[i] = a;
                Tb[i * 72 + lane] = f2bf(a);
            }
        } else {
            for (int it = tid - 64; it < 1024; it += NTHR - 64) {
                const int c = it & 127, ig = it >> 7;
                float kv[8], vv[8];
#pragma unroll
                for (int e = 0; e < 8; ++e) { kv[e] = bf2f(Kt[(8 * ig + e) * 136 + c]); vv[e] = bf2f(Vt[(8 * ig + e) * 136 + c]); }
                u32x4 ov, ok, od;
#pragma unroll
                for (int w = 0; w < 4; ++w) {
                    const int i0 = 8 * ig + 2 * w, i1 = i0 + 1;
                    ov[w] = pk2(bet[i0] * vv[2 * w], bet[i1] * vv[2 * w + 1]);
                    ok[w] = pk2(bet[i0] * eg[i0] * kv[2 * w], bet[i1] * eg[i1] * kv[2 * w + 1]);
                    od[w] = pk2(egr[i0] * kv[2 * w], egr[i1] * kv[2 * w + 1]);
                }
                *(LAS u32x4*)(VbT + c * 72 + 8 * ig) = ov;
                *(LAS u32x4*)(KbT + c * 72 + 8 * ig) = ok;
                *(u32x4*)(cKd + c * 64 + 8 * ig) = od;
            }
            for (int it = tid - 64; it < 1024; it += NTHR - 64) {
                const int i = it >> 4, c8 = (it & 15) * 8; const float e = eg[i];
                const u32x4 qv = *(const LAS u32x4*)(Qt + i * 136 + c8); u32x4 o;
#pragma unroll
                for (int w = 0; w < 4; ++w) o[w] = pk2(__uint_as_float(qv[w] << 16) * e, __uint_as_float(qv[w] & 0xffff0000u) * e);
                *(u32x4*)(cQd + i * 128 + c8) = o;
            }
        }
        __syncthreads();
        {
            f32x4 au[4], aw[4];
#pragma unroll
            for (int mt = 0; mt < 4; ++mt) { au[mt] = (f32x4){0.f, 0.f, 0.f, 0.f}; aw[mt] = (f32x4){0.f, 0.f, 0.f, 0.f}; }
#pragma unroll
            for (int ks = 0; ks < 2; ++ks) {
                const bf16x8 bv = *(const LAS bf16x8*)(VbT + (16 * wave + fr) * 72 + 32 * ks + 8 * fq);
                const bf16x8 bk = *(const LAS bf16x8*)(KbT + (16 * wave + fr) * 72 + 32 * ks + 8 * fq);
#pragma unroll
                for (int mt = 0; mt < 4; ++mt) {
                    const bf16x8 at = *(const LAS bf16x8*)(Tb + (16 * mt + fr) * 72 + 32 * ks + 8 * fq);
                    au[mt] = __builtin_amdgcn_mfma_f32_16x16x32_bf16(at, bv, au[mt], 0, 0, 0);
                    aw[mt] = __builtin_amdgcn_mfma_f32_16x16x32_bf16(at, bk, aw[mt], 0, 0, 0);
                }
            }
#pragma unroll
            for (int mt = 0; mt < 4; ++mt)
#pragma unroll
                for (int jj = 0; jj < 4; ++jj) {
                    const int ir = 16 * mt + 4 * fq + jj, c = 16 * wave + fr;
                    cU[ir * 128 + c] = f2bf(au[mt][jj]); cW[ir * 128 + c] = f2bf(aw[mt][jj]);
                }
        }
    }
}
constexpr int SC_W = 0, SC_QD = 64 * 136, SC_KD = SC_QD + 64 * 136, SC_AT = SC_KD + 128 * 72, SC_U = SC_AT + 64 * 72, SC_STAGE = SC_U + 16 * 72;
DI void dn_scan_load(const bf16_t* CH, const bf16_t* ATT, int u, int sl, LAS bf16_t* st, int lt) {
    const bf16_t* cW = CH + (size_t)u * 32768; const bf16_t* cAt = ATT + (size_t)u * 4096;
    for (int id = lt; id < 3072; id += 448) {
        const int which = id >> 10, x = id & 1023;
        if (which < 2) { const int row = x >> 4, seg = x & 15; *(LAS u32x4*)(st + (which ? SC_QD : SC_W) + row * 136 + seg * 8) = *(const u32x4*)(cW + which * 8192 + row * 128 + seg * 8); }
        else { const int row = x >> 3, seg = x & 7; *(LAS u32x4*)(st + SC_KD + row * 72 + seg * 8) = *(const u32x4*)(cW + 16384 + row * 64 + seg * 8); }
    }
    for (int id = lt; id < 512; id += 448) { const int row = id >> 3, seg = id & 7; *(LAS u32x4*)(st + SC_AT + row * 72 + seg * 8) = *(const u32x4*)(cAt + row * 64 + seg * 8); }
    if (lt < 128) {
        const int i = lt >> 1, hf = lt & 1;
        const u32x4 v = *(const u32x4*)(cW + 24576 + i * 128 + sl * 16 + hf * 8);
#pragma unroll
        for (int w = 0; w < 4; ++w) { st[SC_U + (hf * 8 + 2 * w) * 72 + i] = (bf16_t)(v[w] & 0xffff); st[SC_U + (hf * 8 + 2 * w + 1) * 72 + i] = (bf16_t)(v[w] >> 16); }
    }
}
DI bf16x8 ld2(const LAS bf16_t* p0, const LAS bf16_t* p1) {
    const u32x2 a = *(const LAS u32x2*)p0, b = *(const LAS u32x2*)p1;
    u32x4 r; r[0] = a[0]; r[1] = a[1]; r[2] = b[0]; r[3] = b[1];
    return __builtin_bit_cast(bf16x8, r);
}
DI bf16x8 pk8(f32x4 a, f32x4 b) { u32x4 r; r[0] = pk2(a[0], a[1]); r[1] = pk2(a[2], a[3]); r[2] = pk2(b[0], b[1]); r[3] = pk2(b[2], b[3]); return __builtin_bit_cast(bf16x8, r); }
PF void dn_scan(const KC& k, LAS unsigned char* lds) {
    const int tid = TID(), lane = tid & 63, wave = tid >> 6, fr = lane & 15, fq = lane >> 4;
    LAS bf16_t* ring = (LAS bf16_t*)lds;
    const bf16_t* CH = (const bf16_t*)(k.ws + AR_CHUNK);
    const bf16_t* ATT = (const bf16_t*)(k.ws + AR_HBUF);
    const float* EGL = (const float*)(k.ws + WS_EGL);
    bf16_t* O = (bf16_t*)(k.ws + AR_PB);
    for (int un = blockIdx.x; un < 256; un += gridDim.x) {
        const int sl = un & 7, chain = un >> 3, dir = chain & 1, h = (chain >> 1) & 7, b = chain >> 4;
        const int rstep = dir == 0 ? 1 : -1;
        f32x4 S[8];
#pragma unroll
        for (int t = 0; t < 8; ++t) S[t] = (f32x4){0.f, 0.f, 0.f, 0.f};
        __syncthreads();
        if (wave > 0) dn_scan_load(CH, ATT, chain * DN_STEPS, sl, ring, tid - 64);
        __syncthreads();
#pragma unroll 1
        for (int s = 0; s < DN_STEPS; ++s) {
            LAS bf16_t* st = ring + (s & 1) * SC_STAGE;
            if (wave > 0) {
                if (s + 1 < DN_STEPS) dn_scan_load(CH, ATT, chain * DN_STEPS + s + 1, sl, ring + ((s + 1) & 1) * SC_STAGE, tid - 64);
            } else {
                const float egl = EGL[chain * DN_STEPS + s];
                bf16x8 sb[4];
#pragma unroll
                for (int ks = 0; ks < 4; ++ks) sb[ks] = pk8(S[2 * ks], S[2 * ks + 1]);
                bf16x8 vb[2]; f32x4 vn[4];
#pragma unroll
                for (int mt = 0; mt < 4; ++mt) {
                    f32x4 p = (f32x4){0.f, 0.f, 0.f, 0.f};
                    const LAS bf16_t* wr = st + SC_W + (16 * mt + fr) * 136 + 4 * fq;
#pragma unroll
                    for (int ks = 0; ks < 4; ++ks) p = __builtin_amdgcn_mfma_f32_16x16x32_bf16(ld2(wr + 32 * ks, wr + 32 * ks + 16), sb[ks], p, 0, 0, 0);
                    const u32x2 uu = *(const LAS u32x2*)(st + SC_U + fr * 72 + 16 * mt + 4 * fq);
                    vn[mt][0] = __uint_as_float(uu[0] << 16) - p[0]; vn[mt][1] = __uint_as_float(uu[0] & 0xffff0000u) - p[1];
                    vn[mt][2] = __uint_as_float(uu[1] << 16) - p[2]; vn[mt][3] = __uint_as_float(uu[1] & 0xffff0000u) - p[3];
                }
                vb[0] = pk8(vn[0], vn[1]); vb[1] = pk8(vn[2], vn[3]);
                const int rbase = dn_rbase(b, dir, s);
#pragma unroll
                for (int mt = 0; mt < 4; ++mt) {
                    f32x4 o = (f32x4){0.f, 0.f, 0.f, 0.f};
                    const LAS bf16_t* qr = st + SC_QD + (16 * mt + fr) * 136 + 4 * fq;
#pragma unroll
                    for (int ks = 0; ks < 4; ++ks) o = __builtin_amdgcn_mfma_f32_16x16x32_bf16(ld2(qr + 32 * ks, qr + 32 * ks + 16), sb[ks], o, 0, 0, 0);
                    const LAS bf16_t* ar = st + SC_AT + (16 * mt + fr) * 72 + 4 * fq;
#pragma unroll
                    for (int kc = 0; kc < 2; ++kc) o = __builtin_amdgcn_mfma_f32_16x16x32_bf16(ld2(ar + 32 * kc, ar + 32 * kc + 16), vb[kc], o, 0, 0, 0);
#pragma unroll
                    for (int jj = 0; jj < 4; ++jj) {
                        const int row = rbase + rstep * (16 * mt + 4 * fq + jj);
                        O[((size_t)dir * T + row) * 1024 + h * 128 + sl * 16 + fr] = f2bf(o[jj]);
                    }
                }
#pragma unroll
                for (int t = 0; t < 8; ++t) {
                    f32x4 a = S[t] * egl;
                    const LAS bf16_t* kr = st + SC_KD + (16 * t + fr) * 72 + 4 * fq;
#pragma unroll
                    for (int kc = 0; kc < 2; ++kc) a = __builtin_amdgcn_mfma_f32_16x16x32_bf16(ld2(kr + 32 * kc, kr + 32 * kc + 16), vb[kc], a, 0, 0, 0);
                    S[t] = a;
                }
            }
            __syncthreads();
        }
    }
}
PF void dn_finish(const KC& k, int j) {
    const int tid = TID(), lane = tid & 63, wave = tid >> 6;
    const bf16_t* O = (const bf16_t*)(k.ws + AR_PB);
    const bf16_t* Z = (const bf16_t*)k.out;
    bf16_t* U = (bf16_t*)(k.ws + AR_UBUF);
    const float* on = k.dn_out_norm + j * 128;
    for (int r = blockIdx.x * 8 + wave; r < T; r += gridDim.x * 8) {
        float o[16];
#pragma unroll
        for (int m = 0; m < 16; ++m) o[m] = bf2f(O[(size_t)r * 1024 + lane + 64 * m]) + bf2f(O[((size_t)T + r) * 1024 + lane + 64 * m]);
#pragma unroll
        for (int hh = 0; hh < 8; ++hh) {
            const float ss = wsum(o[2 * hh] * o[2 * hh] + o[2 * hh + 1] * o[2 * hh + 1]);
            const float rs = rsqrtf(ss * (1.0f / 128.0f) + EPS);
#pragma unroll
            for (int q = 0; q < 2; ++q) {
                const int m = 2 * hh + q, col = lane + 64 * m;
                const float z = bf2f(Z[(size_t)r * 1024 + col]);
                U[(size_t)r * 1024 + col] = f2bf(o[m] * rs * on[col & 127] * siluf(z));
            }
        }
    }
}

DI float conv3g(const bf16_t* p, int j, float w0, float w1, float w2) {
    const int gc = j & 63;
    const float l = gc != 0 ? bf2f(p[j - 1]) : 0.f, c = bf2f(p[j]), r = gc != 63 ? bf2f(p[j + 1]) : 0.f;
    return w0 * l + w1 * c + w2 * r;
}
PF void hy_lat(const KC& k, int jl, LAS float* ldsf) {
    const int tid = TID();
    LAS cf* X = (LAS cf*)ldsf;
    LAS float* wf = ldsf + 32768; LAS float* wb = wf + 64;
    const bf16_t* PT = (const bf16_t*)(k.ws + AR_PB);
    bf16_t* ZT = (bf16_t*)(k.ws + AR_ZT);
    cf* scr = (cf*)(k.ws + AR_FFTS) + (size_t)blockIdx.x * 4 * 16384;
    cf* sKe = scr; cf* sKo = scr + 16384; cf* zp = scr + 2 * 16384; cf* ye = scr + 3 * 16384;
    const float* hdn = (const float*)(k.ws + WS_HDNL);
    const float* w3 = k.hy_f_w3 + (size_t)jl * 64 * 4096;
    const float* cw = k.hy_conv + (size_t)jl * 3 * 3072;
    for (int ch = blockIdx.x; ch < 1024; ch += gridDim.x) {
        const float delta = hy_delta(ch);
        {
            const bf16_t* pv = PT + (size_t)ch * T + TC;
            const float w0 = cw[ch], w1 = cw[3072 + ch], w2 = cw[6144 + ch];
            _Pragma("unroll 1") for (int m = 0; m < 32; ++m) { const int j = tid + 512 * m; cf z; z.x = conv3g(pv, j, w0, w1, w2); z.y = conv3g(pv + SEQ, j, w0, w1, w2); zp[j] = z; }
        }
        for (int n = 0; n < 2; ++n) {
            __syncthreads();
            if (tid < 64) wf[tid] = w3[(size_t)tid * 4096 + n * 2048 + ch];
            else if (tid < 128) wb[tid - 64] = w3[(size_t)(tid - 64) * 4096 + n * 2048 + 1024 + ch];
            __syncthreads();
            _Pragma("unroll 1") for (int m = 0; m < 32; ++m) {
                const int j = tid + 512 * m;
                float hf = 0.f, hb = 0.f;
                { const f32x4* hr = (const f32x4*)(hdn + (size_t)j * 64);
#pragma unroll 4
                  for (int q = 0; q < 16; ++q) { const f32x4 h4 = hr[q]; hf += h4[0] * wf[4 * q] + h4[1] * wf[4 * q + 1] + h4[2] * wf[4 * q + 2] + h4[3] * wf[4 * q + 3]; }
                  hf *= expf(-((float)j / 16383.0f) * delta); }
                asm volatile("" ::: "memory");
                if (j > 0) { const int jb = SEQ - j; const f32x4* hr = (const f32x4*)(hdn + (size_t)jb * 64);
#pragma unroll 4
                  for (int q = 0; q < 16; ++q) { const f32x4 h4 = hr[q]; hb += h4[0] * wb[4 * q] + h4[1] * wb[4 * q + 1] + h4[2] * wb[4 * q + 2] + h4[3] * wb[4 * q + 3]; }
                  hb *= expf(-((float)jb / 16383.0f) * delta); }
                float sn, cs; sincospif(-(float)j / 16384.0f, &sn, &cs);
                cf a; a.x = hf + hb; a.y = 0.f; X[j] = a;
                const float kd = hf - hb; cf o; o.x = kd * cs; o.y = kd * sn; sKo[j] = o;
            }
            __syncthreads();
            fft16k_fwd(X);
            _Pragma("unroll 1") for (int m = 0; m < 32; ++m) { const int j = tid + 512 * m; sKe[j] = X[j]; }
            __syncthreads();
            _Pragma("unroll 1") for (int m = 0; m < 32; ++m) { const int j = tid + 512 * m; X[j] = sKo[j]; }
            __syncthreads();
            fft16k_fwd(X);
            _Pragma("unroll 1") for (int m = 0; m < 32; ++m) { const int j = tid + 512 * m; sKo[j] = X[j]; }
            __syncthreads();
            _Pragma("unroll 1") for (int m = 0; m < 32; ++m) { const int j = tid + 512 * m; X[j] = zp[j]; }
            __syncthreads();
            fft16k_fwd(X);
            _Pragma("unroll 1") for (int m = 0; m < 32; ++m) { const int j = tid + 512 * m; X[j] = cmul(X[j], sKe[j]); }
            __syncthreads();
            fft16k_inv(X);
            _Pragma("unroll 1") for (int m = 0; m < 32; ++m) { const int j = tid + 512 * m; ye[j] = X[j]; }
            __syncthreads();
            _Pragma("unroll 1") for (int m = 0; m < 32; ++m) { const int j = tid + 512 * m; float sn, cs; sincospif(-(float)j / 16384.0f, &sn, &cs); cf w; w.x = cs; w.y = sn; X[j] = cmul(zp[j], w); }
            __syncthreads();
            fft16k_fwd(X);
            _Pragma("unroll 1") for (int m = 0; m < 32; ++m) { const int j = tid + 512 * m; X[j] = cmul(X[j], sKo[j]); }
            __syncthreads();
            fft16k_inv(X);
            {
                const bf16_t* pg = PT + (size_t)((n + 1) * 1024 + ch) * T + TC;
                const int gcol = (n + 1) * 1024 + ch;
                const float w0 = cw[gcol], w1 = cw[3072 + gcol], w2 = cw[6144 + gcol];
                const float bias = k.hy_bias[(size_t)jl * 2 * 1024 + n * 1024 + ch];
                _Pragma("unroll 1") for (int m = 0; m < 32; ++m) {
                    const int j = tid + 512 * m;
                    float sn, cs; sincospif((float)j / 16384.0f, &sn, &cs); cf w; w.x = cs; w.y = sn;
                    const cf yo = cmul(X[j], w); const cf e = ye[j]; const cf zprev = zp[j];
                    const float y0 = (0.5f / 16384.0f) * (e.x + yo.x), y1 = (0.5f / 16384.0f) * (e.y + yo.y);
                    cf zn; zn.x = conv3g(pg, j, w0, w1, w2) * (y0 + bias * zprev.x); zn.y = conv3g(pg + SEQ, j, w0, w1, w2) * (y1 + bias * zprev.y);
                    zp[j] = zn;
                }
            }
        }
        _Pragma("unroll 1") for (int m = 0; m < 32; ++m) { const int j = tid + 512 * m; const cf z = zp[j]; ZT[(size_t)ch * T + TC + j] = f2bf(z.x); ZT[(size_t)ch * T + TC + SEQ + j] = f2bf(z.y); }
        __syncthreads();
    }
}
PF void hy_ctx(const KC& k, int jl, LAS float* lds) {
    const int tid = TID(), t = tid & 255, hsel = tid >> 8;
    LAS float* z = lds + hsel * 768; LAS float* hf = z + 256; LAS float* hb = hf + 256;
    const bf16_t* PT = (const bf16_t*)(k.ws + AR_PB);
    bf16_t* U = (bf16_t*)(k.ws + AR_UBUF);
    const float* filtc = (const float*)(k.ws + WS_FILTC);
    const float* cw = k.hy_conv + (size_t)jl * 3 * 3072;
    for (int u = blockIdx.x; u < 1024; u += gridDim.x) {
        const int pr = u * 2 + hsel, b = pr >> 10, ch = pr & 1023;
        float zc;
        {
            const bf16_t* pv = PT + (size_t)ch * T + b * 256;
            const float l = t != 0 ? bf2f(pv[t - 1]) : 0.f, c = bf2f(pv[t]), r = t != 255 ? bf2f(pv[t + 1]) : 0.f;
            zc = cw[ch] * l + cw[3072 + ch] * c + cw[6144 + ch] * r;
        }
        for (int n = 0; n < 2; ++n) {
            __syncthreads();
            z[t] = zc; hf[t] = filtc[(size_t)t * 4096 + n * 2048 + ch]; hb[t] = filtc[(size_t)t * 4096 + n * 2048 + 1024 + ch];
            __syncthreads();
            float y = 0.f;
            for (int s = 0; s <= t; ++s) y += hf[t - s] * z[s];
            for (int s = t + 1; s < 256; ++s) y += hb[s - t] * z[s];
            const int gcol = (n + 1) * 1024 + ch;
            const bf16_t* pg = PT + (size_t)gcol * T + b * 256;
            const float l = t != 0 ? bf2f(pg[t - 1]) : 0.f, c = bf2f(pg[t]), r = t != 255 ? bf2f(pg[t + 1]) : 0.f;
            const float gate = cw[gcol] * l + cw[3072 + gcol] * c + cw[6144 + gcol] * r;
            zc = gate * (y + k.hy_bias[(size_t)jl * 2048 + n * 1024 + ch] * zc);
        }
        U[(size_t)(b * 256 + t) * 1024 + ch] = f2bf(zc);
        __syncthreads();
    }
}
PF void hy_transpose(const KC& k, LAS bf16_t* lds) {
    const int tid = TID();
    const bf16_t* ZT = (const bf16_t*)(k.ws + AR_ZT);
    bf16_t* U = (bf16_t*)(k.ws + AR_UBUF);
    for (int u = blockIdx.x; u < 16 * (TL / 64); u += gridDim.x) {
        const int c0 = (u & 15) * 64, r0 = TC + (u >> 4) * 64;
        { const int c = tid >> 3, sg = (tid & 7) * 8;
          const u32x4 v = *(const u32x4*)(ZT + (size_t)(c0 + c) * T + r0 + sg);
#pragma unroll
          for (int w = 0; w < 4; ++w) { lds[(sg + 2 * w) * 66 + c] = (bf16_t)(v[w] & 0xffff); lds[(sg + 2 * w + 1) * 66 + c] = (bf16_t)(v[w] >> 16); } }
        __syncthreads();
        { const int r = tid >> 3, sg = (tid & 7) * 8; u32x4 o;
#pragma unroll
          for (int w = 0; w < 4; ++w) o[w] = (unsigned)lds[r * 66 + sg + 2 * w] | ((unsigned)lds[r * 66 + sg + 2 * w + 1] << 16);
          *(u32x4*)(U + (size_t)(r0 + r) * 1024 + c0 + sg) = o; }
        __syncthreads();
    }
}

__global__ void __launch_bounds__(NTHR, 2) fwd_kernel(Params prm) {
    extern __shared__ __attribute__((aligned(16))) unsigned char lds_raw[];
    LAS unsigned char* lds = (LAS unsigned char*)lds_raw;
    LAS float* ldsf = (LAS float*)lds;
    LAS bf16_t* ldsh = (LAS bf16_t*)lds;
    LAS int* tb = (LAS int*)(lds + 136 * 1024);
    volatile LAS unsigned* xbw = (volatile LAS unsigned*)(lds + 139 * 1024);
    KC k;
    k.x = prm.in[0]; k.c = prm.in[1]; k.ctx = prm.in[2]; k.c_ctx = prm.in[3]; k.ada_w = prm.in[4]; k.ada_b = prm.in[5];
    k.norm_mix = prm.in[6]; k.norm_ffn = prm.in[7]; k.norm_final = prm.in[8];
    k.dn_w_in = prm.in[9]; k.dn_conv = prm.in[10]; k.dn_a_log = prm.in[11]; k.dn_dt_bias = prm.in[12]; k.dn_out_norm = prm.in[13]; k.dn_w_out = prm.in[14];
    k.hy_w_in = prm.in[15]; k.hy_conv = prm.in[16]; k.hy_f_w1 = prm.in[17]; k.hy_f_b1 = prm.in[18]; k.hy_f_freq = prm.in[19]; k.hy_f_w2 = prm.in[20];
    k.hy_f_b2 = prm.in[21]; k.hy_f_w3 = prm.in[22]; k.hy_bias = prm.in[23]; k.hy_w_out = prm.in[24];
    k.sc_w_in = prm.in[25]; k.sc_conv = prm.in[26]; k.sc_w_out = prm.in[27]; k.w_router = prm.in[28]; k.router_bias = prm.in[29];
    k.moe_w_gate = prm.in[30]; k.moe_w_up = prm.in[31]; k.moe_w_down = prm.in[32];
    k.out = prm.out; k.ws = prm.ws;
    const int lo = prm.ph_lo, hi = prm.ph_hi;
    XcdBarrier bar; bar.bar = (unsigned*)(k.ws + WS_CTL); bar.x = 0; bar.st = xbw;
    if (hi - lo > 1) {
        if (threadIdx.x == 0) { xbw[0] = 0u; xbw[1] = 0u; }
        __syncthreads();
        bar = xcd_barrier_post((unsigned*)(k.ws + WS_CTL), xbw);
    }
    int ph = 0;
#define PH_BEGIN(id) if (ph >= lo && ph < hi) { for (int rep_ = 0; rep_ < (((id) == PROBE_REP) ? 2 : 1); ++rep_) { asm volatile("" : "+s"(k.ws));
#define PH_END   if (ph + 1 < hi) xcd_barrier(bar); } } ++ph;

    float* xs = (float*)(k.ws + WS_XS);
    const float* mod = (const float*)(k.ws + WS_MOD);

    PH_BEGIN(0)
        job_mod(k, ldsf);
        job_cvt_small(k, ldsf);
        job_hdn(k, ldsf);
    PH_END

    for (int i = 0; i < DEPTH; ++i) {
        const int kind = i % 3, j = i / 3;
        const bool last = (i == DEPTH - 1);
        PH_BEGIN(1)
            if (kind == 0) norm_phase<2>(k, i, i == 0, i > 0, k.norm_mix + i * 1024, 0, k.dn_w_in + (size_t)j * 1024 * DN_IN + 4096, DN_IN,
                                         k.dn_a_log + j * 16, k.dn_dt_bias + j * 16, last, ldsf);
            else norm_phase<0>(k, i, i == 0, i > 0, k.norm_mix + i * 1024, 0, nullptr, 0, nullptr, nullptr, last, ldsf);
            if (kind == 1) job_filtc(k, j);
        PH_END
        PH_BEGIN(2)
            if (kind == 0) { EpiDnSplit e{(bf16_t*)(k.ws + AR_PB), (bf16_t*)k.out}; gemm_dense(ldsh, (const bf16_t*)(k.ws + AR_HBUF), T, (const bf16_t*)(k.ws + WS_DNWIN) + (size_t)j * 4096 * 1024, 4096, 1024, e); }
            else if (kind == 1) { EpiBf16T e{(bf16_t*)(k.ws + AR_PB), T}; gemm_dense(ldsh, (const bf16_t*)(k.ws + AR_HBUF), T, (const bf16_t*)(k.ws + WS_HYWIN), 3072, 1024, e); }
            else { EpiBf16 e{(bf16_t*)(k.ws + AR_PB), 3072}; gemm_dense(ldsh, (const bf16_t*)(k.ws + AR_HBUF), T, (const bf16_t*)(k.ws + WS_SCWIN), 3072, 1024, e); }
        PH_END
        if (kind == 0) {
            PH_BEGIN(3) dn_chunk(k, j, lds); PH_END
            PH_BEGIN(4) dn_scan(k, lds); PH_END
            PH_BEGIN(5) dn_finish(k, j); PH_END
        } else if (kind == 1) {
            PH_BEGIN(6) hy_lat(k, j, ldsf); hy_ctx(k, j, ldsf); PH_END
            PH_BEGIN(7) hy_transpose(k, ldsh); PH_END
        } else {
            PH_BEGIN(8) sc_mix(k, j); PH_END
        }
        PH_BEGIN(9)
            const bf16_t* Wt = kind == 0 ? (const bf16_t*)(k.ws + WS_DNWOUT) + (size_t)j * 1024 * 1024 : (kind == 1 ? (const bf16_t*)(k.ws + WS_HYWOUT) : (const bf16_t*)(k.ws + WS_SCWOUT));
            EpiResid e{xs, mod, i, 2};
            gemm_dense(ldsh, (const bf16_t*)(k.ws + AR_UBUF), T, Wt, 1024, 1024, e);
        PH_END
        PH_BEGIN(10)
            norm_phase<1>(k, i, false, false, k.norm_ffn + i * 1024, 3, k.w_router, 32, k.router_bias, nullptr, last, ldsf);
        PH_END
        PH_BEGIN(11)
            moe_scatter(k, i, tb);
            job_cvt_moe(k, i, ldsf);
        PH_END
        PH_BEGIN(12) moe_gemm<0>(k, i, ldsh, tb); PH_END
        PH_BEGIN(13) moe_gemm<1>(k, i, ldsh, tb); PH_END
    }
    PH_BEGIN(14)
        norm_phase<3>(k, DEPTH, false, true, k.norm_final, 0, nullptr, 0, nullptr, nullptr, false, ldsf);
    PH_END
#undef PH_BEGIN
#undef PH_END
}
constexpr int N_PHASES = 1 + (10 + 9 + 8 + 10) + 1;

extern "C" void kernel_launch(void* const* d_in, const int* in_sizes, int n_in, void* d_out, int out_size, void* d_ws, size_t ws_size, hipStream_t stream) {
    static int grid = 0;
    if (grid == 0) {
        if (n_in != 33 || out_size != TL * D || ws_size < WS_END) { fprintf(stderr, "kernel_launch: unexpected shapes: n_in %d out %d ws %zu (need %zu)\n", n_in, out_size, ws_size, (size_t)WS_END); grid = -1; return; }
        int dev = 0, cus = 0, per_cu = 0;
        if (hipGetDevice(&dev) != hipSuccess || hipDeviceGetAttribute(&cus, hipDeviceAttributeMultiprocessorCount, dev) != hipSuccess) { grid = -1; return; }
        if (hipFuncSetAttribute((const void*)fwd_kernel, hipFuncAttributeMaxDynamicSharedMemorySize, LDS_BYTES) != hipSuccess) { fprintf(stderr, "kernel_launch: hipFuncSetAttribute failed\n"); grid = -1; return; }
        if (hipOccupancyMaxActiveBlocksPerMultiprocessor(&per_cu, (const void*)fwd_kernel, NTHR, LDS_BYTES) != hipSuccess || per_cu < 1) fprintf(stderr, "kernel_launch: occupancy query reports %d\n", per_cu);
        (void)hipGetLastError();
        grid = cus;
    }
    if (grid < 0) return;
    (void)hipMemsetAsync((char*)d_ws + WS_CTL, 0, CTL_BYTES, stream);
    Params p{};
    for (int i = 0; i < 33; ++i) p.in[i] = (const float*)d_in[i];
    p.out = (float*)d_out; p.ws = (unsigned char*)d_ws;
#if MK_MULTI
    for (int ph = 0; ph < N_PHASES; ++ph) { p.ph_lo = ph; p.ph_hi = ph + 1; hipLaunchKernelGGL(fwd_kernel, dim3(grid), dim3(NTHR), LDS_BYTES, stream, p); }
#else
    p.ph_lo = 0; p.ph_hi = N_PHASES;
    hipLaunchKernelGGL(fwd_kernel, dim3(grid), dim3(NTHR), LDS_BYTES, stream, p);
#endif
}
```

```cpp
#include <hip/hip_runtime.h>
#include <stdint.h>
#include <stdio.h>
#include <math.h>

#ifndef MK_MULTI
#define MK_MULTI 0
#endif

#ifndef PROBE_REP
#define PROBE_REP (-1)
#endif
#define LAS __attribute__((address_space(3)))
#define GAS __attribute__((address_space(1)))
#define HD __host__ __device__ __forceinline__
#define DI __device__ __forceinline__
#ifdef NOINL
#define PF __device__ __noinline__
#else
#define PF __device__ __forceinline__
#endif
typedef unsigned short bf16_t;
typedef short bf16x8 __attribute__((ext_vector_type(8)));
typedef float f32x4 __attribute__((ext_vector_type(4)));
typedef unsigned u32x4 __attribute__((ext_vector_type(4)));
typedef unsigned u32x2 __attribute__((ext_vector_type(2)));

constexpr int D = 1024, NB = 2, SEQ = 16384, CTXL = 256, DEPTH = 4;
constexpr int TC = NB * CTXL, TL = NB * SEQ, T = TC + TL, NA = 2 * T;
constexpr int NTHR = 512;
constexpr int DN_IN = 4128;
constexpr float EPS = 1e-6f;
constexpr int LDS_BYTES = 140 * 1024;

constexpr size_t AL(size_t x) { return (x + 255) & ~(size_t)255; }
constexpr size_t WS_CTL = 0;
constexpr size_t CTL_BYTES = 65536;
constexpr size_t CTL_CNT = 16384;
constexpr size_t WS_MOD = WS_CTL + CTL_BYTES;
constexpr size_t WS_HDNL = AL(WS_MOD + 4 * 3 * 6144 * 4);
constexpr size_t WS_HDNC = AL(WS_HDNL + 16384 * 64 * 4);
constexpr size_t WS_FILTC = AL(WS_HDNC + 256 * 64 * 4);
constexpr size_t WS_DNWIN = AL(WS_FILTC + 256 * 4096 * 4);
constexpr size_t WS_DNWOUT = AL(WS_DNWIN + (size_t)2 * 4096 * 1024 * 2);
constexpr size_t WS_HYWIN = AL(WS_DNWOUT + (size_t)2 * 1024 * 1024 * 2);
constexpr size_t WS_HYWOUT = AL(WS_HYWIN + (size_t)3072 * 1024 * 2);
constexpr size_t WS_SCWIN = AL(WS_HYWOUT + (size_t)1024 * 1024 * 2);
constexpr size_t WS_SCWOUT = AL(WS_SCWIN + (size_t)3072 * 1024 * 2);
constexpr size_t WS_XS = AL(WS_SCWOUT + (size_t)1024 * 1024 * 2);
constexpr size_t WS_TOKE = AL(WS_XS + (size_t)T * 1024 * 4);
constexpr size_t WS_TOKW = AL(WS_TOKE + (size_t)T * 2 * 4);
constexpr size_t WS_TOKP = AL(WS_TOKW + (size_t)T * 2 * 4);
constexpr size_t WS_SLOT = AL(WS_TOKP + (size_t)T * 2 * 4);
constexpr size_t WS_GB = AL(WS_SLOT + (size_t)NA * 4);
constexpr size_t WS_EGL = AL(WS_GB + (size_t)T * 32 * 4);
constexpr size_t WS_AR = AL(WS_EGL + (size_t)32 * 260 * 4);
constexpr size_t AR_HBUF = WS_AR;
constexpr size_t AR_UBUF = AR_HBUF + (size_t)T * 1024 * 2;
constexpr size_t AR_PB = AR_UBUF + (size_t)T * 1024 * 2;
constexpr size_t AR_Q = AR_PB + (size_t)T * 4096 * 2;
constexpr size_t AR_CHUNK = AR_PB + (size_t)T * 3072 * 2;
constexpr size_t AR_DN_END = AR_CHUNK + (size_t)32 * 260 * 65536;
constexpr size_t AR_ZT = AR_Q;
constexpr size_t AR_FFTS = AR_ZT + (size_t)1024 * T * 2;
constexpr size_t AR_HY_END = AR_FFTS + (size_t)256 * 4 * 16384 * 8;
constexpr size_t AR_HID = AR_PB;
constexpr size_t AR_YS = AR_HID + (size_t)NA * 512 * 2;
constexpr size_t AR_WGU = AR_YS + (size_t)NA * 1024 * 2;
constexpr size_t AR_WD = AR_WGU + (size_t)32 * 1024 * 1024 * 2;
constexpr size_t AR_MOE_END = AR_WD + (size_t)32 * 1024 * 512 * 2;
constexpr size_t WS_END = AR_DN_END > AR_HY_END ? (AR_DN_END > AR_MOE_END ? AR_DN_END : AR_MOE_END) : (AR_HY_END > AR_MOE_END ? AR_HY_END : AR_MOE_END);

#define XB_TMO      128
#define XB_XCNT(j)  (256  + 64 * (j))
#define XB_XSUB(j)  (1280 + 64 * (j))
#define XB_XGEN(j)  (2304 + 64 * (j))
#define XB_TOP      3328
#define XB_TOPGEN   3392
#define XCD_BAR_WORDS 3456
#define XB_SPIN_CAP (1u << 25)
DI unsigned xb_ld(unsigned* p)              { return __hip_atomic_load(p, __ATOMIC_RELAXED, __HIP_MEMORY_SCOPE_AGENT); }
DI unsigned xb_add(unsigned* p, unsigned v) { return __hip_atomic_fetch_add(p, v, __ATOMIC_RELAXED, __HIP_MEMORY_SCOPE_AGENT); }
DI unsigned xb_xcc_id() { return (unsigned)__builtin_amdgcn_s_getreg((3 << 11) | 20) & 0xFu; }
#define XB_SPIN(cond, bar) do { unsigned _sp = 0; while (cond) { __builtin_amdgcn_s_sleep(1); \
    if ((++_sp & 255u) == 0u) { if (xb_ld(&(bar)[XB_TMO])) break; if (_sp > XB_SPIN_CAP) { atomicAdd(&(bar)[XB_TMO], 1u); break; } } } } while (0)
struct XcdBarrier { unsigned* bar; unsigned x; volatile LAS unsigned* st; };
DI XcdBarrier xcd_barrier_post(unsigned* bar, volatile LAS unsigned* st) {
    XcdBarrier b; b.bar = bar; b.x = xb_xcc_id(); b.st = st;
    if (threadIdx.x == 0) (void)xb_add(&bar[XB_XCNT(b.x)], 1u);
    return b;
}
DI void xcd_barrier_complete(unsigned* bar, unsigned x, unsigned& nloc, unsigned& nx) {
    const unsigned G = gridDim.x * gridDim.y * gridDim.z;
    unsigned sum, cnt, mine, sp = 0u;
    for (;;) {
        sum = 0u; cnt = 0u; mine = 0u;
#pragma unroll
        for (unsigned j = 0; j < 16; ++j) { const unsigned c = xb_ld(&bar[XB_XCNT(j)]); sum += c; cnt += (c > 0u) ? 1u : 0u; mine = (j == x) ? c : mine; }
        if (sum == G) break;
        __builtin_amdgcn_s_sleep(1);
        if ((++sp & 255u) == 0u) { if (xb_ld(&bar[XB_TMO])) break; if (sp > XB_SPIN_CAP) { atomicAdd(&bar[XB_TMO], 1u); break; } }
    }
    nloc = mine > 0u ? mine : 1u; nx = cnt > 0u ? cnt : 1u;
}
DI void xcd_barrier(const XcdBarrier& b) {
    asm volatile("s_waitcnt vmcnt(0)" ::: "memory");
    __syncthreads();
    if (threadIdx.x == 0) {
        unsigned* bar = b.bar;
        __builtin_amdgcn_s_waitcnt(0);
        unsigned nloc = b.st[0], nx = b.st[1];
        if (nloc == 0u) { xcd_barrier_complete(bar, b.x, nloc, nx); b.st[0] = nloc; b.st[1] = nx; }
        const unsigned old = xb_add(&bar[XB_XSUB(b.x)], 1u);
        const unsigned gen = old / nloc;
        if (old + 1u == (gen + 1u) * nloc) {
            __builtin_amdgcn_fence(__ATOMIC_RELEASE, "agent");
            asm volatile("s_waitcnt vmcnt(0)" ::: "memory");
            const unsigned og = xb_add(&bar[XB_TOP], 1u);
            const unsigned tg = og / nx;
            if (og + 1u == (tg + 1u) * nx) xb_add(&bar[XB_TOPGEN], 1u);
            else XB_SPIN(xb_ld(&bar[XB_TOPGEN]) == tg, bar);
            __builtin_amdgcn_fence(__ATOMIC_ACQUIRE, "agent");
            xb_add(&bar[XB_XGEN(b.x)], 1u);
            asm volatile("s_waitcnt vmcnt(0)" ::: "memory");
        } else {
            XB_SPIN(xb_ld(&bar[XB_XGEN(b.x)]) == gen, bar);
            __builtin_amdgcn_fence(__ATOMIC_ACQUIRE, "agent");
            asm volatile("s_waitcnt vmcnt(0)" ::: "memory");
        }
    }
    __syncthreads();
}

DI bf16_t f2bf(float f) { unsigned u = __float_as_uint(f); u += 0x7fffu + ((u >> 16) & 1u); return (bf16_t)(u >> 16); }
DI float bf2f(bf16_t b) { return __uint_as_float(((unsigned)b) << 16); }
DI unsigned pk2(float lo, float hi) { return (unsigned)f2bf(lo) | ((unsigned)f2bf(hi) << 16); }
DI float siluf(float x) { return x / (1.0f + __expf(-x)); }
DI float sigmf(float x) { return 1.0f / (1.0f + __expf(-x)); }
DI float wsum(float v) {
#pragma unroll
    for (int m = 32; m >= 1; m >>= 1) v += __shfl_xor(v, m);
    return v;
}
DI void lds_barrier() { asm volatile("s_waitcnt lgkmcnt(0)\n\ts_barrier" ::: "memory"); }
DI int TID() { int t = threadIdx.x; asm volatile("" : "+v"(t)); return t; }
DI int modrow(int r) { return r < TC ? 0 : 1 + (r - TC) / SEQ; }

typedef float cf __attribute__((ext_vector_type(2)));
HD cf cmul(cf a, cf b) { cf r; r.x = a.x * b.x - a.y * b.y; r.y = a.x * b.y + a.y * b.x; return r; }
HD cf cadd(cf a, cf b) { cf r; r.x = a.x + b.x; r.y = a.y + b.y; return r; }
HD cf csub(cf a, cf b) { cf r; r.x = a.x - b.x; r.y = a.y - b.y; return r; }
template <int R> HD constexpr int brev(int i) { int r = 0; for (int b = 1, t = R >> 1; b < R; b <<= 1, t >>= 1) if (i & b) r |= t; return r; }
#define FFT_C32 {1.0f, 0.98078528040323044913f, 0.92387953251128675613f, 0.83146961230254523708f, 0.70710678118654752440f, 0.55557023301960222474f, 0.38268343236508977173f, 0.19509032201612826785f, 0.0f, -0.19509032201612826785f, -0.38268343236508977173f, -0.55557023301960222474f, -0.70710678118654752440f, -0.83146961230254523708f, -0.92387953251128675613f, -0.98078528040323044913f}
#define FFT_S32 {0.0f, 0.19509032201612826785f, 0.38268343236508977173f, 0.55557023301960222474f, 0.70710678118654752440f, 0.83146961230254523708f, 0.92387953251128675613f, 0.98078528040323044913f, 1.0f, 0.98078528040323044913f, 0.92387953251128675613f, 0.83146961230254523708f, 0.70710678118654752440f, 0.55557023301960222474f, 0.38268343236508977173f, 0.19509032201612826785f}
template <int R> HD constexpr int ilog2c() { int l = 0; for (int r = R; r > 1; r >>= 1) ++l; return l; }
template <int R> HD void dft_fwd(cf (&v)[R]) {
    constexpr float C[16] = FFT_C32; constexpr float S[16] = FFT_S32;
    constexpr int LG = ilog2c<R>();
#pragma unroll
    for (int st = 0; st < LG; ++st) {
#pragma unroll
        for (int i = 0; i < R / 2; ++i) {
            const int len = R >> st, half = len >> 1, blk = i / half, j = i % half, i0 = blk * len + j, i1 = i0 + half;
            const cf a = v[i0], c = v[i1];
            v[i0] = cadd(a, c);
            const cf d = csub(a, c);
            const int ti = j * (32 / len);
            cf w; w.x = C[ti]; w.y = -S[ti];
            v[i1] = (ti == 0) ? d : cmul(d, w);
        }
    }
}
template <int R> HD void dft_inv(cf (&v)[R]) {
    constexpr float C[16] = FFT_C32; constexpr float S[16] = FFT_S32;
    constexpr int LG = ilog2c<R>();
#pragma unroll
    for (int st = LG - 1; st >= 0; --st) {
#pragma unroll
        for (int i = 0; i < R / 2; ++i) {
            const int len = R >> st, half = len >> 1, blk = i / half, j = i % half, i0 = blk * len + j, i1 = i0 + half;
            const int ti = j * (32 / len);
            cf w; w.x = C[ti]; w.y = S[ti];
            const cf a = v[i0];
            const cf c = (ti == 0) ? v[i1] : cmul(v[i1], w);
            v[i0] = cadd(a, c);
            v[i1] = csub(a, c);
        }
    }
}
template <int R> DI void fft_pass_fwd(LAS cf* X, int n, int g) {
    const int s = n / R, q = g / s, p = g - q * s, base = q * n + p;
    cf v[R];
#pragma unroll
    for (int k = 0; k < R; ++k) v[k] = X[base + k * s];
    dft_fwd<R>(v);
    if (s > 1) {
        int pp = p; asm volatile("" : "+v"(pp));
        float sn, cs; sincospif(-2.0f * (float)pp / (float)n, &sn, &cs);
        cf w1; w1.x = cs; w1.y = sn; cf w = w1;
#pragma unroll
        for (int m = 1; m < R; ++m) { v[brev<R>(m)] = cmul(v[brev<R>(m)], w); w = cmul(w, w1); }
    }
#pragma unroll
    for (int k = 0; k < R; ++k) X[base + k * s] = v[k];
}
template <int R> DI void fft_pass_inv(LAS cf* X, int n, int g) {
    const int s = n / R, q = g / s, p = g - q * s, base = q * n + p;
    cf v[R];
#pragma unroll
    for (int k = 0; k < R; ++k) v[k] = X[base + k * s];
    if (s > 1) {
        int pp = p; asm volatile("" : "+v"(pp));
        float sn, cs; sincospif(2.0f * (float)pp / (float)n, &sn, &cs);
        cf w1; w1.x = cs; w1.y = sn; cf w = w1;
#pragma unroll
        for (int m = 1; m < R; ++m) { v[brev<R>(m)] = cmul(v[brev<R>(m)], w); w = cmul(w, w1); }
    }
    dft_inv<R>(v);
#pragma unroll
    for (int k = 0; k < R; ++k) X[base + k * s] = v[k];
}
DI void fft16k_fwd(LAS cf* X) {
    const int t = TID();
#pragma unroll 1
    for (int g = 0; g < 2; ++g) fft_pass_fwd<16>(X, 16384, t + 512 * g);
    __syncthreads();
#pragma unroll 1
    for (int g = 0; g < 2; ++g) fft_pass_fwd<16>(X, 1024, t + 512 * g);
    __syncthreads();
#pragma unroll 1
    for (int g = 0; g < 2; ++g) fft_pass_fwd<16>(X, 64, t + 512 * g);
    __syncthreads();
#pragma unroll 1
    for (int g = 0; g < 8; ++g) fft_pass_fwd<4>(X, 4, t + 512 * g);
    __syncthreads();
}
DI void fft16k_inv(LAS cf* X) {
    const int t = TID();
#pragma unroll 1
    for (int g = 0; g < 8; ++g) fft_pass_inv<4>(X, 4, t + 512 * g);
    __syncthreads();
#pragma unroll 1
    for (int g = 0; g < 2; ++g) fft_pass_inv<16>(X, 64, t + 512 * g);
    __syncthreads();
#pragma unroll 1
    for (int g = 0; g < 2; ++g) fft_pass_inv<16>(X, 1024, t + 512 * g);
    __syncthreads();
#pragma unroll 1
    for (int g = 0; g < 2; ++g) fft_pass_inv<16>(X, 16384, t + 512 * g);
    __syncthreads();
}

struct Params { const float* in[33]; float* out; unsigned char* ws; int ph_lo, ph_hi; };
struct KC {
    const float *x, *c, *ctx, *c_ctx, *ada_w, *ada_b, *norm_mix, *norm_ffn, *norm_final;
    const float *dn_w_in, *dn_conv, *dn_a_log, *dn_dt_bias, *dn_out_norm, *dn_w_out;
    const float *hy_w_in, *hy_conv, *hy_f_w1, *hy_f_b1, *hy_f_freq, *hy_f_w2, *hy_f_b2, *hy_f_w3, *hy_bias, *hy_w_out;
    const float *sc_w_in, *sc_conv, *sc_w_out, *w_router, *router_bias, *moe_w_gate, *moe_w_up, *moe_w_down;
    float* out; unsigned char* ws;
};

PF void job_mod(const KC& k, LAS float* lds) {
    const int tid = TID(), cj = tid & 63, kq = tid >> 6;
    float* mod = (float*)(k.ws + WS_MOD);
    for (int u = blockIdx.x; u < DEPTH * 96; u += gridDim.x) {
        const int l = u / 96, cc = u % 96, col = cc * 64 + cj;
        const float* W = k.ada_w + (size_t)l * 1024 * 6144;
        float a0 = 0.f, a1 = 0.f, a2 = 0.f;
        for (int kk = kq * 128; kk < kq * 128 + 128; ++kk) {
            const float w = W[(size_t)kk * 6144 + col];
            a0 += siluf(k.c_ctx[kk]) * w; a1 += siluf(k.c[kk]) * w; a2 += siluf(k.c[1024 + kk]) * w;
        }
        lds[(kq * 3 + 0) * 64 + cj] = a0; lds[(kq * 3 + 1) * 64 + cj] = a1; lds[(kq * 3 + 2) * 64 + cj] = a2;
        __syncthreads();
        if (tid < 192) {
            const int r = tid >> 6, j = tid & 63;
            float s = 0.f;
            for (int q = 0; q < 8; ++q) s += lds[(q * 3 + r) * 64 + j];
            mod[(size_t)(l * 3 + r) * 6144 + cc * 64 + j] = s + k.ada_b[l * 6144 + cc * 64 + j];
        }
        __syncthreads();
    }
}
DI void cvt_tile(const float* __restrict__ src, int ld, bf16_t* __restrict__ dst, int ldd, int k0, int n0, int mapmode, LAS float* lds) {
    const int tid = TID();
    { const int r = tid >> 4, c4 = (tid & 15) * 4;
#pragma unroll
      for (int h = 0; h < 2; ++h) {
          const f32x4 v = *(const f32x4*)(src + (size_t)(k0 + r + 32 * h) * ld + n0 + c4);
          LAS float* p = lds + (r + 32 * h) * 65 + c4; p[0] = v[0]; p[1] = v[1]; p[2] = v[2]; p[3] = v[3];
      } }
    __syncthreads();
    { const int nn = tid >> 3, ks = (tid & 7) * 8; const int n = n0 + nn;
      const int row = mapmode == 0 ? n : (32 * (n >> 4) + (n & 15) + (mapmode == 2 ? 16 : 0));
      u32x4 o;
      o[0] = pk2(lds[(ks + 0) * 65 + nn], lds[(ks + 1) * 65 + nn]); o[1] = pk2(lds[(ks + 2) * 65 + nn], lds[(ks + 3) * 65 + nn]);
      o[2] = pk2(lds[(ks + 4) * 65 + nn], lds[(ks + 5) * 65 + nn]); o[3] = pk2(lds[(ks + 6) * 65 + nn], lds[(ks + 7) * 65 + nn]);
      *(u32x4*)(dst + (size_t)row * ldd + k0 + ks) = o; }
    __syncthreads();
}
DI void cvt_matrix(const float* src, int ld, size_t sstride, int K, int N, int nmat, bf16_t* dst, int ldd, size_t dstride, int mapmode, LAS float* lds) {
    const int tk = K / 64, tn = N / 64, per = tk * tn;
    for (int u = blockIdx.x; u < per * nmat; u += gridDim.x) {
        const int m = u / per, t = u % per;
        cvt_tile(src + (size_t)m * sstride, ld, dst + (size_t)m * dstride, ldd, (t / tn) * 64, (t % tn) * 64, mapmode, lds);
    }
}
PF void job_cvt_small(const KC& k, LAS float* lds) {
    cvt_matrix(k.dn_w_in, DN_IN, (size_t)1024 * DN_IN, 1024, 4096, 2, (bf16_t*)(k.ws + WS_DNWIN), 1024, (size_t)4096 * 1024, 0, lds);
    cvt_matrix(k.dn_w_out, 1024, (size_t)1024 * 1024, 1024, 1024, 2, (bf16_t*)(k.ws + WS_DNWOUT), 1024, (size_t)1024 * 1024, 0, lds);
    cvt_matrix(k.hy_w_in, 3072, 0, 1024, 3072, 1, (bf16_t*)(k.ws + WS_HYWIN), 1024, 0, 0, lds);
    cvt_matrix(k.hy_w_out, 1024, 0, 1024, 1024, 1, (bf16_t*)(k.ws + WS_HYWOUT), 1024, 0, 0, lds);
    cvt_matrix(k.sc_w_in, 3072, 0, 1024, 3072, 1, (bf16_t*)(k.ws + WS_SCWIN), 1024, 0, 0, lds);
    cvt_matrix(k.sc_w_out, 1024, 0, 1024, 1024, 1, (bf16_t*)(k.ws + WS_SCWOUT), 1024, 0, 0, lds);
}
PF void job_cvt_moe(const KC& k, int layer, LAS float* lds) {
    const size_t lo = (size_t)layer * 32 * 1024 * 512;
    cvt_matrix(k.moe_w_gate + lo, 512, (size_t)1024 * 512, 1024, 512, 32, (bf16_t*)(k.ws + AR_WGU), 1024, (size_t)1024 * 1024, 1, lds);
    cvt_matrix(k.moe_w_up + lo, 512, (size_t)1024 * 512, 1024, 512, 32, (bf16_t*)(k.ws + AR_WGU), 1024, (size_t)1024 * 1024, 2, lds);
    cvt_matrix(k.moe_w_down + lo, 1024, (size_t)512 * 1024, 512, 1024, 32, (bf16_t*)(k.ws + AR_WD), 512, (size_t)1024 * 512, 0, lds);
}
PF void job_hdn(const KC& k, LAS float* lds) {
    const int tid = TID(), lane = tid & 63, wave = tid >> 6;
    LAS float* feat = lds + wave * 128; LAS float* h1 = feat + 64;
    const float fr = k.hy_f_freq[lane], b1 = k.hy_f_b1[lane], b2 = k.hy_f_b2[lane];
    for (int u0 = blockIdx.x * 8; u0 < 16384 + 256; u0 += gridDim.x * 8) {
        const int u = u0 + wave;
        int l, pos; float* dst;
        if (u < 16384) { l = 16384; pos = u; dst = (float*)(k.ws + WS_HDNL) + (size_t)u * 64; }
        else { l = 256; pos = u - 16384; dst = (float*)(k.ws + WS_HDNC) + (size_t)pos * 64; }
        const float t = (float)pos / (float)(l - 1);
        float f = 0.f;
        if (lane == 0) f = t;
        else if (lane <= 32) {
            const int bi = (lane - 1) & 15;
            const float band = 1e-4f + (float)bi * ((15.0f - 1e-4f) / 15.0f);
            const float ang = (6.283185307179586f / (float)l) * (float)pos * band;
            f = lane <= 16 ? cosf(ang) : -sinf(ang);
        }
        feat[lane] = f;
        __syncthreads();
        float a = b1;
        for (int i = 0; i < 33; ++i) a += feat[i] * k.hy_f_w1[i * 64 + lane];
        h1[lane] = sinf(fr * a);
        __syncthreads();
        float a2 = b2;
        for (int j = 0; j < 64; ++j) a2 += h1[j] * k.hy_f_w2[j * 64 + lane];
        dst[lane] = sinf(fr * a2);
        __syncthreads();
    }
}
DI float hy_delta(int ch) {
    const float lo = -4.605170185988091f / 1.5f, hi = -4.605170185988091f / 0.3f;
    return fabsf(lo + (float)ch * ((hi - lo) / 1023.0f));
}
PF void job_filtc(const KC& k, int j) {
    const float* hdn = (const float*)(k.ws + WS_HDNC);
    const float* w3 = k.hy_f_w3 + (size_t)j * 64 * 4096;
    float* filtc = (float*)(k.ws + WS_FILTC);
    const int tq = TID();
    for (int u = blockIdx.x; u < 256 * 8; u += gridDim.x) {
        const int l = u >> 3, col = (u & 7) * 512 + tq;
        float a = 0.f;
        for (int q = 0; q < 64; ++q) a += hdn[l * 64 + q] * w3[(size_t)q * 4096 + col];
        const float t = (float)l / 255.0f;
        filtc[(size_t)l * 4096 + col] = a * expf(-t * hy_delta(col & 1023));
    }
}

template <int MODE>
PF void norm_phase(const KC& k, int layer, bool first, bool combine, const float* __restrict__ gain, int mb, const float* __restrict__ Wsk, int ldw,
                   const float* __restrict__ aux0, const float* __restrict__ aux1, bool last, LAS float* lds) {
    const int tid = TID(), lane = tid & 63, wave = tid >> 6;
    float* xs = (float*)(k.ws + WS_XS);
    bf16_t* hbuf = (bf16_t*)(k.ws + AR_HBUF);
    const float* mod = (const float*)(k.ws + WS_MOD);
    const bf16_t* ys = (const bf16_t*)(k.ws + AR_YS);
    const int* tokp = (const int*)(k.ws + WS_TOKP);
    const float* tokw = (const float*)(k.ws + WS_TOKW);
    if (MODE == 1 || MODE == 2) {
        for (int idx = tid; idx < 1024 * 32; idx += NTHR) {
            const int kk = idx >> 5, n = idx & 31;
            lds[kk * 32 + (((n >> 2) ^ ((kk >> 1) & 7)) << 2) + (n & 3)] = Wsk[(size_t)kk * ldw + n];
        }
        __syncthreads();
    }
    const int rbeg = (MODE == 3) ? TC : 0;
    for (int r = rbeg + blockIdx.x * 8 + wave; r < T; r += gridDim.x * 8) {
        const int mr = modrow(r);
        const float* src = first ? (r < TC ? k.ctx + (size_t)r * 1024 : k.x + (size_t)(r - TC) * 1024) : xs + (size_t)r * 1024;
        float x[16];
#pragma unroll
        for (int m = 0; m < 16; ++m) x[m] = src[lane + 64 * m];
        if (combine) {
            const int p0 = tokp[2 * r], p1 = tokp[2 * r + 1];
            const float w0 = tokw[2 * r], w1 = tokw[2 * r + 1];
            const float* g5 = mod + ((size_t)((layer - 1) * 3 + mr) * 6 + 5) * 1024;
#pragma unroll
            for (int m = 0; m < 16; ++m) {
                const int col = lane + 64 * m;
                x[m] += g5[col] * (w0 * bf2f(ys[(size_t)p0 * 1024 + col]) + w1 * bf2f(ys[(size_t)p1 * 1024 + col]));
            }
        }
        if (first || combine) {
#pragma unroll
            for (int m = 0; m < 16; ++m) xs[(size_t)r * 1024 + lane + 64 * m] = x[m];
        }
        float ss = 0.f;
#pragma unroll
        for (int m = 0; m < 16; ++m) ss += x[m] * x[m];
        ss = wsum(ss);
        const float rstd = rsqrtf(ss * (1.0f / 1024.0f) + EPS);
        if (MODE == 3) {
#pragma unroll
            for (int m = 0; m < 16; ++m) { const int col = lane + 64 * m; k.out[(size_t)(r - TC) * 1024 + col] = x[m] * rstd * gain[col]; }
            continue;
        }
        const float* shift = mod + ((size_t)(layer * 3 + mr) * 6 + mb) * 1024;
        const float* scale = shift + 1024;
        float y[16];
#pragma unroll
        for (int m = 0; m < 16; ++m) {
            const int col = lane + 64 * m;
            y[m] = x[m] * rstd * gain[col] * (1.0f + scale[col]) + shift[col];
            hbuf[(size_t)r * 1024 + col] = f2bf(y[m]);
        }
        if (MODE == 1 || MODE == 2) {
            float acc[32];
#pragma unroll
            for (int n = 0; n < 32; ++n) acc[n] = 0.f;
#pragma unroll
            for (int m = 0; m < 16; ++m) {
                asm volatile("" ::: "memory");
                const int c = lane + 64 * m;
                const LAS float* wr = lds + c * 32; const int sw = (c >> 1) & 7;
#pragma unroll
                for (int q = 0; q < 8; ++q) {
                    const f32x4 w4 = *(const LAS f32x4*)(wr + ((q ^ sw) << 2));
                    acc[4 * q + 0] += y[m] * w4[0]; acc[4 * q + 1] += y[m] * w4[1]; acc[4 * q + 2] += y[m] * w4[2]; acc[4 * q + 3] += y[m] * w4[3];
                }
            }
            float val;
            {
                float a16[16], a8[8], a4[4], a2[2];
                const bool b5 = (lane & 32) != 0, b4 = (lane & 16) != 0, b3 = (lane & 8) != 0, b2 = (lane & 4) != 0, b1 = (lane & 2) != 0;
#pragma unroll
                for (int i = 0; i < 16; ++i) { const float send = b5 ? acc[i] : acc[i + 16], keep = b5 ? acc[i + 16] : acc[i]; a16[i] = keep + __shfl_xor(send, 32); }
#pragma unroll
                for (int i = 0; i < 8; ++i) { const float send = b4 ? a16[i] : a16[i + 8], keep = b4 ? a16[i + 8] : a16[i]; a8[i] = keep + __shfl_xor(send, 16); }
#pragma unroll
                for (int i = 0; i < 4; ++i) { const float send = b3 ? a8[i] : a8[i + 4], keep = b3 ? a8[i + 4] : a8[i]; a4[i] = keep + __shfl_xor(send, 8); }
#pragma unroll
                for (int i = 0; i < 2; ++i) { const float send = b2 ? a4[i] : a4[i + 2], keep = b2 ? a4[i + 2] : a4[i]; a2[i] = keep + __shfl_xor(send, 4); }
                { const float send = b1 ? a2[0] : a2[1], keep = b1 ? a2[1] : a2[0]; val = keep + __shfl_xor(send, 2); }
                val += __shfl_xor(val, 1);
            }
            const int n = lane >> 1;
            if (MODE == 1) {
                int* toke = (int*)(k.ws + WS_TOKE); float* tokwW = (float*)(k.ws + WS_TOKW);
                int* cnt = (int*)(k.ws + WS_CTL + CTL_CNT) + layer * 32;
                if (last && r < TC) { if (lane == 0) { toke[2 * r] = -1; toke[2 * r + 1] = -1; } continue; }
                const float sc = 1.0f / (1.0f + expf(-val)), ch = sc + aux0[n];
                const int gl = lane & ~7;
                const float ca = __shfl(ch, gl), cb = __shfl(ch, gl + 2), cc = __shfl(ch, gl + 4), cd = __shfl(ch, gl + 6);
                const float hi1 = fmaxf(ca, cb), lo1 = fminf(ca, cb), hi2 = fmaxf(cc, cd), lo2 = fminf(cc, cd);
                float gs = fmaxf(hi1, hi2) + fmaxf(fminf(hi1, hi2), fmaxf(lo1, lo2));
                int gi = lane >> 3;
#pragma unroll
                for (int m = 8; m <= 32; m <<= 1) {
                    const float og = __shfl_xor(gs, m); const int oi = __shfl_xor(gi, m);
                    if (og > gs || (og == gs && oi < gi)) { gs = og; gi = oi; }
                }
                float c4[4], s4[4];
#pragma unroll
                for (int i = 0; i < 4; ++i) { c4[i] = __shfl(ch, gi * 8 + 2 * i); s4[i] = __shfl(sc, gi * 8 + 2 * i); }
                int i1 = 0; float b1v = c4[0];
#pragma unroll
                for (int i = 1; i < 4; ++i) if (c4[i] > b1v) { b1v = c4[i]; i1 = i; }
                int i2 = -1; float b2v = -1e30f;
#pragma unroll
                for (int i = 0; i < 4; ++i) if (i != i1 && c4[i] > b2v) { b2v = c4[i]; i2 = i; }
                float w1v = 0.f, w2v = 0.f;
#pragma unroll
                for (int i = 0; i < 4; ++i) { if (i == i1) w1v = s4[i]; if (i == i2) w2v = s4[i]; }
                const float inv = 1.0f / (w1v + w2v);
                if (lane == 0) {
                    const int e1 = gi * 4 + i1, e2 = gi * 4 + i2;
                    toke[2 * r] = e1; toke[2 * r + 1] = e2; tokwW[2 * r] = w1v * inv; tokwW[2 * r + 1] = w2v * inv;
                    atomicAdd(&cnt[e1], 1); atomicAdd(&cnt[e2], 1);
                }
            } else {
                float* gb = (float*)(k.ws + WS_GB);
                if ((lane & 1) == 0) {
                    if (n < 16) {
                        const float z = val + aux1[n];
                        const float sp = z > 20.f ? z : log1pf(expf(z));
                        gb[(size_t)r * 32 + n] = -expf(aux0[n]) * sp;
                    } else {
                        gb[(size_t)r * 32 + n] = 1.0f / (1.0f + expf(-val));
                    }
                }
            }
        }
    }
}

template <class Epi>
DI void gemm_tile(LAS bf16_t* lds, const bf16_t* __restrict__ A, int lda, const int* __restrict__ rowidx, int m0, int mrows,
                  const bf16_t* __restrict__ Bt, int K, int n0, const Epi& epi) {
    const int tid = TID(), lane = tid & 63, wave = tid >> 6, wr = wave >> 2, wc = wave & 3, fr = lane & 15, fq = lane >> 4;
    LAS bf16_t* As = lds; LAS bf16_t* Bs = lds + 128 * 72;
    const int seg = tid & 7, r0 = tid >> 3;
    const int ra0 = r0 < mrows ? r0 : 0, ra1 = (r0 + 64) < mrows ? (r0 + 64) : 0;
    size_t ar0, ar1;
    if (rowidx) { ar0 = (size_t)rowidx[m0 + ra0]; ar1 = (size_t)rowidx[m0 + ra1]; } else { ar0 = (size_t)(m0 + ra0); ar1 = (size_t)(m0 + ra1); }
    const bf16_t* pa0 = A + ar0 * lda + seg * 8; const bf16_t* pa1 = A + ar1 * lda + seg * 8;
    const bf16_t* pb0 = Bt + (size_t)(n0 + r0) * K + seg * 8; const bf16_t* pb1 = Bt + (size_t)(n0 + r0 + 64) * K + seg * 8;
    u32x4 ga0 = *(const u32x4*)pa0, ga1 = *(const u32x4*)pa1, gb0 = *(const u32x4*)pb0, gb1 = *(const u32x4*)pb1;
    f32x4 acc[4][2];
#pragma unroll
    for (int m = 0; m < 4; ++m)
#pragma unroll
        for (int n = 0; n < 2; ++n) acc[m][n] = (f32x4){0.f, 0.f, 0.f, 0.f};
    const int nk = K >> 6;
    for (int kt = 0; kt < nk; ++kt) {
        __syncthreads();
        *(LAS u32x4*)(As + r0 * 72 + seg * 8) = ga0; *(LAS u32x4*)(As + (r0 + 64) * 72 + seg * 8) = ga1;
        *(LAS u32x4*)(Bs + r0 * 72 + seg * 8) = gb0; *(LAS u32x4*)(Bs + (r0 + 64) * 72 + seg * 8) = gb1;
        __syncthreads();
        if (kt + 1 < nk) {
            const int ko = (kt + 1) * 64;
            ga0 = *(const u32x4*)(pa0 + ko); ga1 = *(const u32x4*)(pa1 + ko); gb0 = *(const u32x4*)(pb0 + ko); gb1 = *(const u32x4*)(pb1 + ko);
        }
#pragma unroll
        for (int kk = 0; kk < 2; ++kk) {
            bf16x8 af[4], bfv[2];
#pragma unroll
            for (int m = 0; m < 4; ++m) af[m] = *(const LAS bf16x8*)(As + (wr * 64 + m * 16 + fr) * 72 + kk * 32 + fq * 8);
#pragma unroll
            for (int n = 0; n < 2; ++n) bfv[n] = *(const LAS bf16x8*)(Bs + (wc * 32 + n * 16 + fr) * 72 + kk * 32 + fq * 8);
#pragma unroll
            for (int m = 0; m < 4; ++m)
#pragma unroll
                for (int n = 0; n < 2; ++n) acc[m][n] = __builtin_amdgcn_mfma_f32_16x16x32_bf16(af[m], bfv[n], acc[m][n], 0, 0, 0);
        }
    }
    epi(acc, m0, mrows, n0, wr, wc, fr, fq);
}
struct EpiBf16 {
    bf16_t* C; int ldc;
    DI void operator()(const f32x4 (&acc)[4][2], int m0, int mrows, int n0, int wr, int wc, int fr, int fq) const {
#pragma unroll
        for (int m = 0; m < 4; ++m)
#pragma unroll
            for (int j = 0; j < 4; ++j) {
                const int rl = wr * 64 + m * 16 + fq * 4 + j;
                if (rl < mrows) {
#pragma unroll
                    for (int n = 0; n < 2; ++n) C[(size_t)(m0 + rl) * ldc + n0 + wc * 32 + n * 16 + fr] = f2bf(acc[m][n][j]);
                }
            }
    }
};
struct EpiDnSplit {
    bf16_t* P; bf16_t* Z;
    DI void operator()(const f32x4 (&acc)[4][2], int m0, int mrows, int n0, int wr, int wc, int fr, int fq) const {
        bf16_t* base; int ldc, cb;
        if (n0 < 3072) { base = P; ldc = 3072; cb = n0; } else { base = Z; ldc = 1024; cb = n0 - 3072; }
#pragma unroll
        for (int m = 0; m < 4; ++m)
#pragma unroll
            for (int j = 0; j < 4; ++j) {
                const int rl = wr * 64 + m * 16 + fq * 4 + j;
#pragma unroll
                for (int n = 0; n < 2; ++n) base[(size_t)(m0 + rl) * ldc + cb + wc * 32 + n * 16 + fr] = f2bf(acc[m][n][j]);
            }
    }
};
struct EpiBf16T {
    bf16_t* C; int ldc;
    DI void operator()(const f32x4 (&acc)[4][2], int m0, int mrows, int n0, int wr, int wc, int fr, int fq) const {
#pragma unroll
        for (int m = 0; m < 4; ++m)
#pragma unroll
            for (int n = 0; n < 2; ++n) {
                const int row = m0 + wr * 64 + m * 16 + fq * 4, col = n0 + wc * 32 + n * 16 + fr;
                u32x2 o; o[0] = pk2(acc[m][n][0], acc[m][n][1]); o[1] = pk2(acc[m][n][2], acc[m][n][3]);
                *(u32x2*)(C + (size_t)col * ldc + row) = o;
            }
    }
};
struct EpiResid {
    float* xs; const float* mod; int layer; int chunk;
    DI void operator()(const f32x4 (&acc)[4][2], int m0, int mrows, int n0, int wr, int wc, int fr, int fq) const {
        const float* g = mod + ((size_t)(layer * 3 + modrow(m0)) * 6 + chunk) * 1024;
#pragma unroll
        for (int n = 0; n < 2; ++n) {
            const int col = n0 + wc * 32 + n * 16 + fr; const float gv = g[col];
#pragma unroll
            for (int m = 0; m < 4; ++m)
#pragma unroll
                for (int j = 0; j < 4; ++j) { float* p = xs + (size_t)(m0 + wr * 64 + m * 16 + fq * 4 + j) * 1024 + col; *p = *p + gv * acc[m][n][j]; }
        }
    }
};
struct EpiGateUp {
    bf16_t* hid;
    DI void operator()(const f32x4 (&acc)[4][2], int m0, int mrows, int n0, int wr, int wc, int fr, int fq) const {
        const int hc = ((n0 + wc * 32) >> 1) + fr;
#pragma unroll
        for (int m = 0; m < 4; ++m)
#pragma unroll
            for (int j = 0; j < 4; ++j) {
                const int rl = wr * 64 + m * 16 + fq * 4 + j;
                if (rl < mrows) { const float g = acc[m][0][j]; hid[(size_t)(m0 + rl) * 512 + hc] = f2bf(siluf(g) * acc[m][1][j]); }
            }
    }
};
template <class Epi>
PF void gemm_dense(LAS bf16_t* lds, const bf16_t* A, int M, const bf16_t* Bt, int N, int K, const Epi& epi) {
    const int tn = N / 128, tm = M / 128;
    for (int u = blockIdx.x; u < tm * tn; u += gridDim.x) {
        const int mt = u / tn, nt = u % tn;
        gemm_tile(lds, A, K, (const int*)nullptr, mt * 128, 128, Bt, K, nt * 128, epi);
    }
}
DI void moe_table(const KC& k, int layer, LAS int* tb) {
    const int* cnt = (const int*)(k.ws + WS_CTL + CTL_CNT) + layer * 32;
    __syncthreads();
    const int tq = TID();
    if (tq < 32) tb[tq] = __hip_atomic_load(cnt + tq, __ATOMIC_RELAXED, __HIP_MEMORY_SCOPE_AGENT);
    __syncthreads();
    if (tq == 0) {
        int s = 0, tp = 0;
        for (int e = 0; e < 32; ++e) { tb[32 + e] = s; tb[65 + e] = tp; s += tb[e]; tp += (tb[e] + 127) >> 7; }
        tb[64] = s; tb[97] = tp;
    }
    __syncthreads();
}
template <int WHICH>
PF void moe_gemm(const KC& k, int layer, LAS bf16_t* lds, LAS int* tb) {
    moe_table(k, layer, tb);
    const int ntile = tb[97];
    for (int u = blockIdx.x; u < ntile * 8; u += gridDim.x) {
        const int tile = u >> 3, nt = u & 7;
        int e = 0;
        for (int q = 1; q < 32; ++q) if (tb[65 + q] <= tile) e = q;
        const int lt = tile - tb[65 + e], m0 = tb[32 + e] + lt * 128;
        int mrows = tb[e] - lt * 128; mrows = mrows > 128 ? 128 : mrows;
        if (WHICH == 0) {
            EpiGateUp epi{(bf16_t*)(k.ws + AR_HID)};
            gemm_tile(lds, (const bf16_t*)(k.ws + AR_HBUF), 1024, (const int*)(k.ws + WS_SLOT), m0, mrows,
                      (const bf16_t*)(k.ws + AR_WGU) + (size_t)e * 1024 * 1024, 1024, nt * 128, epi);
        } else {
            EpiBf16 epi{(bf16_t*)(k.ws + AR_YS), 1024};
            gemm_tile(lds, (const bf16_t*)(k.ws + AR_HID), 512, (const int*)nullptr, m0, mrows,
                      (const bf16_t*)(k.ws + AR_WD) + (size_t)e * 1024 * 512, 512, nt * 128, epi);
        }
    }
}
PF void moe_scatter(const KC& k, int layer, LAS int* tb) {
    moe_table(k, layer, tb);
    const int* toke = (const int*)(k.ws + WS_TOKE);
    int* tokp = (int*)(k.ws + WS_TOKP); int* slot = (int*)(k.ws + WS_SLOT);
    int* cur = (int*)(k.ws + WS_CTL + CTL_CNT) + 128 + layer * 32;
    const int tq2 = TID();
    for (int r = blockIdx.x * NTHR + tq2; r < T; r += gridDim.x * NTHR) {
#pragma unroll
        for (int q = 0; q < 2; ++q) {
            const int e = toke[2 * r + q];
            if (e >= 0) { const int pos = tb[32 + e] + atomicAdd(&cur[e], 1); slot[pos] = r; tokp[2 * r + q] = pos; }
        }
    }
}

PF void sc_mix(const KC& k, int j) {
    const int tid = TID(), lane = tid & 63, wave = tid >> 6;
    const bf16_t* P = (const bf16_t*)(k.ws + AR_PB);
    bf16_t* U = (bf16_t*)(k.ws + AR_UBUF);
    const float* cw = k.sc_conv + (size_t)j * 3 * 1024;
    for (int r = blockIdx.x * 8 + wave; r < T; r += gridDim.x * 8) {
        bool lok, rok;
        if (r < TC) { const int t = r & 255; lok = t != 0; rok = t != 255; } else { const int t = (r - TC) & 63; lok = t != 0; rok = t != 63; }
        const bf16_t* p = P + (size_t)r * 3072;
#pragma unroll 4
        for (int m = 0; m < 16; ++m) {
            const int col = lane + 64 * m;
            const float bg = bf2f(p[col]);
            const float mc = bf2f(p[1024 + col]) * bf2f(p[2048 + col]);
            const float ml = lok ? bf2f(p[-3072 + 1024 + col]) * bf2f(p[-3072 + 2048 + col]) : 0.f;
            const float mrr = rok ? bf2f(p[3072 + 1024 + col]) * bf2f(p[3072 + 2048 + col]) : 0.f;
            U[(size_t)r * 1024 + col] = f2bf(bg * (cw[col] * ml + cw[1024 + col] * mc + cw[2048 + col] * mrr));
        }
    }
}

constexpr int DN_STEPS = 260, DN_UNITS = 32 * DN_STEPS;
DI int dn_rbase(int b, int dir, int s) {
    if (s < 4) return dir == 0 ? b * 256 + s * 64 : b * 256 + 255 - s * 64;
    const int cc = s - 4;
    return dir == 0 ? TC + b * SEQ + cc * 64 : TC + b * SEQ + SEQ - 1 - cc * 64;
}
PF void dn_chunk(const KC& k, int jl, LAS unsigned char* lds) {
    const int tid = TID(), lane = tid & 63, wave = tid >> 6, fr = lane & 15, fq = lane >> 4;
    LAS bf16_t* Kt = (LAS bf16_t*)lds;
    LAS bf16_t* Qt = Kt + 64 * 136;
    LAS bf16_t* Vt = Qt + 64 * 136;
    LAS float* Amat = (LAS float*)(Vt + 64 * 136);
    LAS bf16_t* Tb = (LAS bf16_t*)(Amat + 64 * 64);
    LAS bf16_t* VbT = Tb + 64 * 72;
    LAS bf16_t* KbT = VbT + 128 * 72;
    LAS float* gcs = (LAS float*)(KbT + 128 * 72);
    LAS float* bet = gcs + 64; LAS float* eg = bet + 64; LAS float* egr = eg + 64;
    LAS float* Tm = egr + 64;
    const bf16_t* P = (const bf16_t*)(k.ws + AR_PB);
    const float* gb = (const float*)(k.ws + WS_GB);
    const float* cw = k.dn_conv + (size_t)jl * 3 * 3072;
    bf16_t* CH = (bf16_t*)(k.ws + AR_CHUNK);
    bf16_t* ATT = (bf16_t*)(k.ws + AR_HBUF);
    float* EGL = (float*)(k.ws + WS_EGL);
    for (int u = blockIdx.x; u < DN_UNITS; u += gridDim.x) {
        const int chain = u / DN_STEPS, s = u - chain * DN_STEPS, dir = chain & 1, h = (chain >> 1) & 7, b = chain >> 4;
        const int rbase = dn_rbase(b, dir, s), rstep = dir == 0 ? 1 : -1;
        bf16_t* cW = CH + (size_t)u * 32768; bf16_t* cQd = cW + 8192; bf16_t* cKd = cQd + 8192; bf16_t* cU = cKd + 8192;
        bf16_t* cAt = ATT + (size_t)u * 4096;
        lds_barrier();
        {
            const int i = tid >> 3, sg = tid & 7, r = rbase + rstep * i;
            bool lok, rok;
            if (r < TC) { const int t = r & 255; lok = t != 0; rok = t != 255; } else { const int t = (r - TC) & 63; lok = t != 0; rok = t != 63; }
#pragma unroll 1
            for (int part = 0; part < 3; ++part) {
                const int col = part * 1024 + h * 128 + sg * 16;
                const bf16_t* pc = P + (size_t)r * 3072 + col;
                float v[16];
#pragma unroll
                for (int hf = 0; hf < 2; ++hf) {
                    const u32x4 c4 = *(const u32x4*)(pc + hf * 8);
                    u32x4 l4 = (u32x4){0u, 0u, 0u, 0u}, r4 = (u32x4){0u, 0u, 0u, 0u};
                    if (lok) l4 = *(const u32x4*)(pc - 3072 + hf * 8);
                    if (rok) r4 = *(const u32x4*)(pc + 3072 + hf * 8);
#pragma unroll
                    for (int w = 0; w < 4; ++w) {
#pragma unroll
                        for (int e = 0; e < 2; ++e) {
                            const int cc = col + hf * 8 + 2 * w + e;
                            const float lv = __uint_as_float(e ? (l4[w] & 0xffff0000u) : (l4[w] << 16));
                            const float cv = __uint_as_float(e ? (c4[w] & 0xffff0000u) : (c4[w] << 16));
                            const float rv = __uint_as_float(e ? (r4[w] & 0xffff0000u) : (r4[w] << 16));
                            v[hf * 8 + 2 * w + e] = siluf(cw[cc] * lv + cw[3072 + cc] * cv + cw[6144 + cc] * rv);
                        }
                    }
                }
                if (part < 2) {
                    float ss = 0.f;
#pragma unroll
                    for (int e = 0; e < 16; ++e) ss += v[e] * v[e];
                    ss += __shfl_xor(ss, 1); ss += __shfl_xor(ss, 2); ss += __shfl_xor(ss, 4);
                    const float sc = rsqrtf(ss + EPS) * (part == 0 ? 0.08838834764831845f : 1.0f);
#pragma unroll
                    for (int e = 0; e < 16; ++e) v[e] *= sc;
                }
                LAS bf16_t* dst = (part == 0 ? Qt : (part == 1 ? Kt : Vt)) + i * 136 + sg * 16;
                u32x4 o0, o1;
#pragma unroll
                for (int w = 0; w < 4; ++w) { o0[w] = pk2(v[2 * w], v[2 * w + 1]); o1[w] = pk2(v[8 + 2 * w], v[8 + 2 * w + 1]); }
                *(LAS u32x4*)dst = o0; *(LAS u32x4*)(dst + 8) = o1;
            }
        }
        if (wave == 0) {
            const size_t row = (size_t)(rbase + rstep * lane);
            float g = gb[row * 32 + dir * 8 + h];
            const float be = gb[row * 32 + 16 + dir * 8 + h];
#pragma unroll
            for (int d = 1; d < 64; d <<= 1) { const float o = __shfl_up(g, d); if (lane >= d) g += o; }
            const float glast = __shfl(g, 63);
            gcs[lane] = g; bet[lane] = be; eg[lane] = expf(g); egr[lane] = expf(glast - g);
            if (lane == 0) EGL[u] = expf(glast);
        }
        lds_barrier();
#pragma unroll 1
        for (int x = 0; x < 4; ++x) {
            const int t = wave + 8 * x, isq = t >> 4, mt = (t >> 2) & 3, nt = t & 3;
            f32x4 acc = (f32x4){0.f, 0.f, 0.f, 0.f};
            if (mt >= nt) {
                const LAS bf16_t* Ar = (isq ? Qt : Kt) + (16 * mt + fr) * 136 + 8 * fq;
                const LAS bf16_t* Br = Kt + (16 * nt + fr) * 136 + 8 * fq;
#pragma unroll
                for (int ks = 0; ks < 4; ++ks) acc = __builtin_amdgcn_mfma_f32_16x16x32_bf16(*(const LAS bf16x8*)(Ar + 32 * ks), *(const LAS bf16x8*)(Br + 32 * ks), acc, 0, 0, 0);
            }
            const int jc = 16 * nt + fr; const float gj = gcs[jc];
#pragma unroll
            for (int jj = 0; jj < 4; ++jj) {
                const int ir = 16 * mt + 4 * fq + jj;
                const float dec = expf(fminf(gcs[ir] - gj, 0.f));
                if (isq) cAt[ir * 64 + jc] = f2bf(ir >= jc ? acc[jj] * dec : 0.f);
                else Amat[ir * 64 + jc] = ir > jc ? bet[ir] * acc[jj] * dec : 0.f;
            }
        }
        lds_barrier();
        if (wave < 4) {
            if (lane < 16) {
                const int bo = 16 * wave;
                float tc[16];
#pragma unroll
                for (int i = 0; i < 16; ++i) {
                    float a0 = (i == lane) ? 1.f : 0.f, a1 = 0.f;
#pragma unroll
                    for (int j = 0; j < i; ++j) { const float av = Amat[(bo + i) * 64 + bo + j]; if (j & 1) a1 -= av * tc[j]; else a0 -= av * tc[j]; }
                    tc[i] = a0 + a1;
                    Tm[(bo + i) * 64 + bo + lane] = tc[i];
                }
            }
        } else {
            for (int it = tid - 256; it < 1024; it += 256) {
                const int c = it & 127, ig = it >> 7;
                float kv[8], vv[8];
#pragma unroll
                for (int e = 0; e < 8; ++e) { kv[e] = bf2f(Kt[(8 * ig + e) * 136 + c]); vv[e] = bf2f(Vt[(8 * ig + e) * 136 + c]); }
                u32x4 ov, ok, od;
#pragma unroll
                for (int w = 0; w < 4; ++w) {
                    const int i0 = 8 * ig + 2 * w, i1 = i0 + 1;
                    ov[w] = pk2(bet[i0] * vv[2 * w], bet[i1] * vv[2 * w + 1]);
                    ok[w] = pk2(bet[i0] * eg[i0] * kv[2 * w], bet[i1] * eg[i1] * kv[2 * w + 1]);
                    od[w] = pk2(egr[i0] * kv[2 * w], egr[i1] * kv[2 * w + 1]);
                }
                *(LAS u32x4*)(VbT + c * 72 + 8 * ig) = ov;
                *(LAS u32x4*)(KbT + c * 72 + 8 * ig) = ok;
                *(u32x4*)(cKd + c * 64 + 8 * ig) = od;
            }
            for (int it = tid - 256; it < 1024; it += 256) {
                const int i = it >> 4, c8 = (it & 15) * 8; const float e = eg[i];
                const u32x4 qv = *(const LAS u32x4*)(Qt + i * 136 + c8); u32x4 o;
#pragma unroll
                for (int w = 0; w < 4; ++w) o[w] = pk2(__uint_as_float(qv[w] << 16) * e, __uint_as_float(qv[w] & 0xffff0000u) * e);
                *(u32x4*)(cQd + i * 128 + c8) = o;
            }
        }
        lds_barrier();
#pragma unroll 1
        for (int d = 1; d < 4; ++d) {
            if (wave < 4 - d) {
                const int bi = wave + d, bj = wave, r = lane >> 2, c0 = 4 * (lane & 3);
                f32x4 m = (f32x4){0.f, 0.f, 0.f, 0.f};
                for (int kb = bj; kb < bi; ++kb) {
#pragma unroll
                    for (int kk = 0; kk < 16; ++kk) {
                        const float av = Amat[(16 * bi + r) * 64 + 16 * kb + kk];
                        const f32x4 tv = *(const LAS f32x4*)(Tm + (16 * kb + kk) * 64 + 16 * bj + c0);
                        m += tv * av;
                    }
                }
                *(LAS f32x4*)(Tm + (16 * bj + r) * 64 + 16 * bi + c0) = m;
                f32x4 t = (f32x4){0.f, 0.f, 0.f, 0.f};
#pragma unroll
                for (int kk = 0; kk < 16; ++kk) {
                    const float dv = Tm[(16 * bi + r) * 64 + 16 * bi + kk];
                    const f32x4 mv = *(const LAS f32x4*)(Tm + (16 * bj + kk) * 64 + 16 * bi + c0);
                    t -= mv * dv;
                }
                *(LAS f32x4*)(Tm + (16 * bi + r) * 64 + 16 * bj + c0) = t;
            }
            lds_barrier();
        }
        for (int it = tid; it < 64 * 8; it += NTHR) {
            const int i = it >> 3, c8 = (it & 7) * 8; u32x4 o;
#pragma unroll
            for (int w = 0; w < 4; ++w) {
                const int c = c8 + 2 * w;
                o[w] = pk2(c <= i ? Tm[i * 64 + c] : 0.f, c + 1 <= i ? Tm[i * 64 + c + 1] : 0.f);
            }
            *(LAS u32x4*)(Tb + i * 72 + c8) = o;
        }
        lds_barrier();
        {
            f32x4 au[4], aw[4];
#pragma unroll
            for (int mt = 0; mt < 4; ++mt) { au[mt] = (f32x4){0.f, 0.f, 0.f, 0.f}; aw[mt] = (f32x4){0.f, 0.f, 0.f, 0.f}; }
#pragma unroll
            for (int ks = 0; ks < 2; ++ks) {
                const bf16x8 bv = *(const LAS bf16x8*)(VbT + (16 * wave + fr) * 72 + 32 * ks + 8 * fq);
                const bf16x8 bk = *(const LAS bf16x8*)(KbT + (16 * wave + fr) * 72 + 32 * ks + 8 * fq);
#pragma unroll
                for (int mt = 0; mt < 4; ++mt) {
                    const bf16x8 at = *(const LAS bf16x8*)(Tb + (16 * mt + fr) * 72 + 32 * ks + 8 * fq);
                    au[mt] = __builtin_amdgcn_mfma_f32_16x16x32_bf16(at, bv, au[mt], 0, 0, 0);
                    aw[mt] = __builtin_amdgcn_mfma_f32_16x16x32_bf16(at, bk, aw[mt], 0, 0, 0);
                }
            }
#pragma unroll
            for (int mt = 0; mt < 4; ++mt)
#pragma unroll
                for (int jj = 0; jj < 4; ++jj) {
                    const int ir = 16 * mt + 4 * fq + jj, c = 16 * wave + fr;
                    cU[ir * 128 + c] = f2bf(au[mt][jj]); cW[ir * 128 + c] = f2bf(aw[mt][jj]);
                }
        }
    }
}
constexpr int SC_W = 0, SC_QD = 64 * 136, SC_KD = SC_QD + 64 * 136, SC_AT = SC_KD + 128 * 72, SC_U = SC_AT + 64 * 72, SC_STAGE = SC_U + 16 * 72;
struct ScanRegs { u32x4 v[8]; u32x4 u; };
DI void dn_scan_fetch(const bf16_t* CH, const bf16_t* ATT, int u, int sl, int lt, ScanRegs& R) {
    const bf16_t* cW = CH + (size_t)u * 32768; const bf16_t* cAt = ATT + (size_t)u * 4096;
#pragma unroll
    for (int q = 0; q < 8; ++q) {
        const int id = lt + 448 * q;
        const bf16_t* src;
        if (id < 2048) src = cW + id * 8;
        else if (id < 3072) src = cW + 16384 + (id - 2048) * 8;
        else src = cAt + (id - 3072) * 8;
        R.v[q] = *(const u32x4*)src;
    }
    if (lt < 128) R.u = *(const u32x4*)(cW + 24576 + (lt >> 1) * 128 + sl * 16 + (lt & 1) * 8);
}
DI void dn_scan_put(LAS bf16_t* st, int lt, const ScanRegs& R) {
#pragma unroll
    for (int q = 0; q < 8; ++q) {
        const int id = lt + 448 * q;
        int off;
        if (id < 2048) { const int which = id >> 10, x = id & 1023; off = (which ? SC_QD : SC_W) + (x >> 4) * 136 + (x & 15) * 8; }
        else if (id < 3072) { const int x = id - 2048; off = SC_KD + (x >> 3) * 72 + (x & 7) * 8; }
        else { const int x = id - 3072; off = SC_AT + (x >> 3) * 72 + (x & 7) * 8; }
        *(LAS u32x4*)(st + off) = R.v[q];
    }
    if (lt < 128) {
        const int i = lt >> 1, hf = lt & 1;
#pragma unroll
        for (int w = 0; w < 4; ++w) { st[SC_U + (hf * 8 + 2 * w) * 72 + i] = (bf16_t)(R.u[w] & 0xffff); st[SC_U + (hf * 8 + 2 * w + 1) * 72 + i] = (bf16_t)(R.u[w] >> 16); }
    }
}
DI bf16x8 ld2(const LAS bf16_t* p0, const LAS bf16_t* p1) {
    const u32x2 a = *(const LAS u32x2*)p0, b = *(const LAS u32x2*)p1;
    u32x4 r; r[0] = a[0]; r[1] = a[1]; r[2] = b[0]; r[3] = b[1];
    return __builtin_bit_cast(bf16x8, r);
}
DI bf16x8 pk8(f32x4 a, f32x4 b) { u32x4 r; r[0] = pk2(a[0], a[1]); r[1] = pk2(a[2], a[3]); r[2] = pk2(b[0], b[1]); r[3] = pk2(b[2], b[3]); return __builtin_bit_cast(bf16x8, r); }
PF void dn_scan(const KC& k, LAS unsigned char* lds) {
    const int tid = TID(), lane = tid & 63, wave = tid >> 6, fr = lane & 15, fq = lane >> 4;
    LAS bf16_t* ring = (LAS bf16_t*)lds;
    const bf16_t* CH = (const bf16_t*)(k.ws + AR_CHUNK);
    const bf16_t* ATT = (const bf16_t*)(k.ws + AR_HBUF);
    const float* EGL = (const float*)(k.ws + WS_EGL);
    bf16_t* O = (bf16_t*)(k.ws + AR_PB);
    for (int un0 = blockIdx.x; un0 < 256; un0 += gridDim.x) {
        const int un = (gridDim.x == 256) ? ((un0 & 7) * 32 + (un0 >> 3)) : un0;
        const int sl = un & 7, chain = un >> 3, dir = chain & 1, h = (chain >> 1) & 7, b = chain >> 4;
        const int rstep = dir == 0 ? 1 : -1;
        f32x4 S[8];
#pragma unroll
        for (int t = 0; t < 8; ++t) S[t] = (f32x4){0.f, 0.f, 0.f, 0.f};
        ScanRegs R;
        lds_barrier();
        if (wave > 0) { dn_scan_fetch(CH, ATT, chain * DN_STEPS, sl, tid - 64, R); dn_scan_put(ring, tid - 64, R); dn_scan_fetch(CH, ATT, chain * DN_STEPS + 1, sl, tid - 64, R); }
        lds_barrier();
#pragma unroll 1
        for (int s = 0; s < DN_STEPS; ++s) {
            LAS bf16_t* st = ring + (s & 1) * SC_STAGE;
            if (wave > 0) {
                if (s + 1 < DN_STEPS) dn_scan_put(ring + ((s + 1) & 1) * SC_STAGE, tid - 64, R);
                if (s + 2 < DN_STEPS) dn_scan_fetch(CH, ATT, chain * DN_STEPS + s + 2, sl, tid - 64, R);
            } else {
                const float egl = EGL[chain * DN_STEPS + s];
                bf16x8 sb[4];
#pragma unroll
                for (int ks = 0; ks < 4; ++ks) sb[ks] = pk8(S[2 * ks], S[2 * ks + 1]);
                bf16x8 vb[2]; f32x4 vn[4];
#pragma unroll
                for (int mt = 0; mt < 4; ++mt) {
                    f32x4 p = (f32x4){0.f, 0.f, 0.f, 0.f};
                    const LAS bf16_t* wr = st + SC_W + (16 * mt + fr) * 136 + 4 * fq;
#pragma unroll
                    for (int ks = 0; ks < 4; ++ks) p = __builtin_amdgcn_mfma_f32_16x16x32_bf16(ld2(wr + 32 * ks, wr + 32 * ks + 16), sb[ks], p, 0, 0, 0);
                    const u32x2 uu = *(const LAS u32x2*)(st + SC_U + fr * 72 + 16 * mt + 4 * fq);
                    vn[mt][0] = __uint_as_float(uu[0] << 16) - p[0]; vn[mt][1] = __uint_as_float(uu[0] & 0xffff0000u) - p[1];
                    vn[mt][2] = __uint_as_float(uu[1] << 16) - p[2]; vn[mt][3] = __uint_as_float(uu[1] & 0xffff0000u) - p[3];
                }
                vb[0] = pk8(vn[0], vn[1]); vb[1] = pk8(vn[2], vn[3]);
                const int rbase = dn_rbase(b, dir, s);
#pragma unroll
                for (int mt = 0; mt < 4; ++mt) {
                    f32x4 o = (f32x4){0.f, 0.f, 0.f, 0.f};
                    const LAS bf16_t* qr = st + SC_QD + (16 * mt + fr) * 136 + 4 * fq;
#pragma unroll
                    for (int ks = 0; ks < 4; ++ks) o = __builtin_amdgcn_mfma_f32_16x16x32_bf16(ld2(qr + 32 * ks, qr + 32 * ks + 16), sb[ks], o, 0, 0, 0);
                    const LAS bf16_t* ar = st + SC_AT + (16 * mt + fr) * 72 + 4 * fq;
#pragma unroll
                    for (int kc = 0; kc < 2; ++kc) o = __builtin_amdgcn_mfma_f32_16x16x32_bf16(ld2(ar + 32 * kc, ar + 32 * kc + 16), vb[kc], o, 0, 0, 0);
#pragma unroll
                    for (int jj = 0; jj < 4; ++jj) {
                        const int row = rbase + rstep * (16 * mt + 4 * fq + jj);
                        O[((size_t)dir * T + row) * 1024 + h * 128 + sl * 16 + fr] = f2bf(o[jj]);
                    }
                }
#pragma unroll
                for (int t = 0; t < 8; ++t) {
                    f32x4 a = S[t] * egl;
                    const LAS bf16_t* kr = st + SC_KD + (16 * t + fr) * 72 + 4 * fq;
#pragma unroll
                    for (int kc = 0; kc < 2; ++kc) a = __builtin_amdgcn_mfma_f32_16x16x32_bf16(ld2(kr + 32 * kc, kr + 32 * kc + 16), vb[kc], a, 0, 0, 0);
                    S[t] = a;
                }
            }
            lds_barrier();
        }
    }
}
PF void dn_finish(const KC& k, int j) {
    const int tid = TID(), lane = tid & 63, wave = tid >> 6;
    const bf16_t* O = (const bf16_t*)(k.ws + AR_PB);
    const bf16_t* Z = (const bf16_t*)k.out;
    bf16_t* U = (bf16_t*)(k.ws + AR_UBUF);
    const float* on = k.dn_out_norm + j * 128;
    for (int r = blockIdx.x * 8 + wave; r < T; r += gridDim.x * 8) {
        float o[16];
#pragma unroll
        for (int m = 0; m < 16; ++m) o[m] = bf2f(O[(size_t)r * 1024 + lane + 64 * m]) + bf2f(O[((size_t)T + r) * 1024 + lane + 64 * m]);
#pragma unroll
        for (int hh = 0; hh < 8; ++hh) {
            const float ss = wsum(o[2 * hh] * o[2 * hh] + o[2 * hh + 1] * o[2 * hh + 1]);
            const float rs = rsqrtf(ss * (1.0f / 128.0f) + EPS);
#pragma unroll
            for (int q = 0; q < 2; ++q) {
                const int m = 2 * hh + q, col = lane + 64 * m;
                const float z = bf2f(Z[(size_t)r * 1024 + col]);
                U[(size_t)r * 1024 + col] = f2bf(o[m] * rs * on[col & 127] * siluf(z));
            }
        }
    }
}

DI float conv3g(const bf16_t* p, int j, float w0, float w1, float w2) {
    const int gc = j & 63;
    const float l = gc != 0 ? bf2f(p[j - 1]) : 0.f, c = bf2f(p[j]), r = gc != 63 ? bf2f(p[j + 1]) : 0.f;
    return w0 * l + w1 * c + w2 * r;
}
PF void hy_lat(const KC& k, int jl, LAS float* ldsf) {
    const int tid = TID();
    LAS cf* X = (LAS cf*)ldsf;
    LAS float* wf = ldsf + 32768; LAS float* wb = wf + 64;
    const bf16_t* PT = (const bf16_t*)(k.ws + AR_PB);
    bf16_t* ZT = (bf16_t*)(k.ws + AR_ZT);
    cf* scr = (cf*)(k.ws + AR_FFTS) + (size_t)blockIdx.x * 4 * 16384;
    cf* sKe = scr; cf* sKo = scr + 16384; cf* zp = scr + 2 * 16384; cf* ye = scr + 3 * 16384;
    const float* hdn = (const float*)(k.ws + WS_HDNL);
    const float* w3 = k.hy_f_w3 + (size_t)jl * 64 * 4096;
    const float* cw = k.hy_conv + (size_t)jl * 3 * 3072;
    for (int ch = blockIdx.x; ch < 1024; ch += gridDim.x) {
        const float delta = hy_delta(ch);
        {
            const bf16_t* pv = PT + (size_t)ch * T + TC;
            const float w0 = cw[ch], w1 = cw[3072 + ch], w2 = cw[6144 + ch];
            _Pragma("unroll 1") for (int m = 0; m < 32; ++m) { const int j = tid + 512 * m; cf z; z.x = conv3g(pv, j, w0, w1, w2); z.y = conv3g(pv + SEQ, j, w0, w1, w2); zp[j] = z; }
        }
        for (int n = 0; n < 2; ++n) {
            __syncthreads();
            if (tid < 64) wf[tid] = w3[(size_t)tid * 4096 + n * 2048 + ch];
            else if (tid < 128) wb[tid - 64] = w3[(size_t)(tid - 64) * 4096 + n * 2048 + 1024 + ch];
            __syncthreads();
            _Pragma("unroll 1") for (int m = 0; m < 32; ++m) {
                const int j = tid + 512 * m;
                float hf = 0.f, hb = 0.f;
                { const f32x4* hr = (const f32x4*)(hdn + (size_t)j * 64);
#pragma unroll 4
                  for (int q = 0; q < 16; ++q) { const f32x4 h4 = hr[q]; hf += h4[0] * wf[4 * q] + h4[1] * wf[4 * q + 1] + h4[2] * wf[4 * q + 2] + h4[3] * wf[4 * q + 3]; }
                  hf *= expf(-((float)j / 16383.0f) * delta); }
                asm volatile("" ::: "memory");
                if (j > 0) { const int jb = SEQ - j; const f32x4* hr = (const f32x4*)(hdn + (size_t)jb * 64);
#pragma unroll 4
                  for (int q = 0; q < 16; ++q) { const f32x4 h4 = hr[q]; hb += h4[0] * wb[4 * q] + h4[1] * wb[4 * q + 1] + h4[2] * wb[4 * q + 2] + h4[3] * wb[4 * q + 3]; }
                  hb *= expf(-((float)jb / 16383.0f) * delta); }
                float sn, cs; sincospif(-(float)j / 16384.0f, &sn, &cs);
                cf a; a.x = hf + hb; a.y = 0.f; X[j] = a;
                const float kd = hf - hb; cf o; o.x = kd * cs; o.y = kd * sn; sKo[j] = o;
            }
            __syncthreads();
            fft16k_fwd(X);
            _Pragma("unroll 1") for (int m = 0; m < 32; ++m) { const int j = tid + 512 * m; sKe[j] = X[j]; }
            __syncthreads();
            _Pragma("unroll 1") for (int m = 0; m < 32; ++m) { const int j = tid + 512 * m; X[j] = sKo[j]; }
            __syncthreads();
            fft16k_fwd(X);
            _Pragma("unroll 1") for (int m = 0; m < 32; ++m) { const int j = tid + 512 * m; sKo[j] = X[j]; }
            __syncthreads();
            _Pragma("unroll 1") for (int m = 0; m < 32; ++m) { const int j = tid + 512 * m; X[j] = zp[j]; }
            __syncthreads();
            fft16k_fwd(X);
            _Pragma("unroll 1") for (int m = 0; m < 32; ++m) { const int j = tid + 512 * m; X[j] = cmul(X[j], sKe[j]); }
            __syncthreads();
            fft16k_inv(X);
            _Pragma("unroll 1") for (int m = 0; m < 32; ++m) { const int j = tid + 512 * m; ye[j] = X[j]; }
            __syncthreads();
            _Pragma("unroll 1") for (int m = 0; m < 32; ++m) { const int j = tid + 512 * m; float sn, cs; sincospif(-(float)j / 16384.0f, &sn, &cs); cf w; w.x = cs; w.y = sn; X[j] = cmul(zp[j], w); }
            __syncthreads();
            fft16k_fwd(X);
            _Pragma("unroll 1") for (int m = 0; m < 32; ++m) { const int j = tid + 512 * m; X[j] = cmul(X[j], sKo[j]); }
            __syncthreads();
            fft16k_inv(X);
            {
                const bf16_t* pg = PT + (size_t)((n + 1) * 1024 + ch) * T + TC;
                const int gcol = (n + 1) * 1024 + ch;
                const float w0 = cw[gcol], w1 = cw[3072 + gcol], w2 = cw[6144 + gcol];
                const float bias = k.hy_bias[(size_t)jl * 2 * 1024 + n * 1024 + ch];
                _Pragma("unroll 1") for (int m = 0; m < 32; ++m) {
                    const int j = tid + 512 * m;
                    float sn, cs; sincospif((float)j / 16384.0f, &sn, &cs); cf w; w.x = cs; w.y = sn;
                    const cf yo = cmul(X[j], w); const cf e = ye[j]; const cf zprev = zp[j];
                    const float y0 = (0.5f / 16384.0f) * (e.x + yo.x), y1 = (0.5f / 16384.0f) * (e.y + yo.y);
                    cf zn; zn.x = conv3g(pg, j, w0, w1, w2) * (y0 + bias * zprev.x); zn.y = conv3g(pg + SEQ, j, w0, w1, w2) * (y1 + bias * zprev.y);
                    zp[j] = zn;
                }
            }
        }
        _Pragma("unroll 1") for (int m = 0; m < 32; ++m) { const int j = tid + 512 * m; const cf z = zp[j]; ZT[(size_t)ch * T + TC + j] = f2bf(z.x); ZT[(size_t)ch * T + TC + SEQ + j] = f2bf(z.y); }
        __syncthreads();
    }
}
PF void hy_ctx(const KC& k, int jl, LAS float* lds) {
    const int tid = TID(), t = tid & 255, hsel = tid >> 8;
    LAS float* z = lds + hsel * 768; LAS float* hf = z + 256; LAS float* hb = hf + 256;
    const bf16_t* PT = (const bf16_t*)(k.ws + AR_PB);
    bf16_t* U = (bf16_t*)(k.ws + AR_UBUF);
    const float* filtc = (const float*)(k.ws + WS_FILTC);
    const float* cw = k.hy_conv + (size_t)jl * 3 * 3072;
    for (int u = blockIdx.x; u < 1024; u += gridDim.x) {
        const int pr = u * 2 + hsel, b = pr >> 10, ch = pr & 1023;
        float zc;
        {
            const bf16_t* pv = PT + (size_t)ch * T + b * 256;
            const float l = t != 0 ? bf2f(pv[t - 1]) : 0.f, c = bf2f(pv[t]), r = t != 255 ? bf2f(pv[t + 1]) : 0.f;
            zc = cw[ch] * l + cw[3072 + ch] * c + cw[6144 + ch] * r;
        }
        for (int n = 0; n < 2; ++n) {
            __syncthreads();
            z[t] = zc; hf[t] = filtc[(size_t)t * 4096 + n * 2048 + ch]; hb[t] = filtc[(size_t)t * 4096 + n * 2048 + 1024 + ch];
            __syncthreads();
            float y = 0.f;
            for (int s = 0; s <= t; ++s) y += hf[t - s] * z[s];
            for (int s = t + 1; s < 256; ++s) y += hb[s - t] * z[s];
            const int gcol = (n + 1) * 1024 + ch;
            const bf16_t* pg = PT + (size_t)gcol * T + b * 256;
            const float l = t != 0 ? bf2f(pg[t - 1]) : 0.f, c = bf2f(pg[t]), r = t != 255 ? bf2f(pg[t + 1]) : 0.f;
            const float gate = cw[gcol] * l + cw[3072 + gcol] * c + cw[6144 + gcol] * r;
            zc = gate * (y + k.hy_bias[(size_t)jl * 2048 + n * 1024 + ch] * zc);
        }
        U[(size_t)(b * 256 + t) * 1024 + ch] = f2bf(zc);
        __syncthreads();
    }
}
PF void hy_transpose(const KC& k, LAS bf16_t* lds) {
    const int tid = TID();
    const bf16_t* ZT = (const bf16_t*)(k.ws + AR_ZT);
    bf16_t* U = (bf16_t*)(k.ws + AR_UBUF);
    for (int u = blockIdx.x; u < 16 * (TL / 64); u += gridDim.x) {
        const int c0 = (u & 15) * 64, r0 = TC + (u >> 4) * 64;
        { const int c = tid >> 3, sg = (tid & 7) * 8;
          const u32x4 v = *(const u32x4*)(ZT + (size_t)(c0 + c) * T + r0 + sg);
#pragma unroll
          for (int w = 0; w < 4; ++w) { lds[(sg + 2 * w) * 66 + c] = (bf16_t)(v[w] & 0xffff); lds[(sg + 2 * w + 1) * 66 + c] = (bf16_t)(v[w] >> 16); } }
        __syncthreads();
        { const int r = tid >> 3, sg = (tid & 7) * 8; u32x4 o;
#pragma unroll
          for (int w = 0; w < 4; ++w) o[w] = (unsigned)lds[r * 66 + sg + 2 * w] | ((unsigned)lds[r * 66 + sg + 2 * w + 1] << 16);
          *(u32x4*)(U + (size_t)(r0 + r) * 1024 + c0 + sg) = o; }
        __syncthreads();
    }
}

__global__ void __launch_bounds__(NTHR, 2) fwd_kernel(Params prm) {
    extern __shared__ __attribute__((aligned(16))) unsigned char lds_raw[];
    LAS unsigned char* lds = (LAS unsigned char*)lds_raw;
    LAS float* ldsf = (LAS float*)lds;
    LAS bf16_t* ldsh = (LAS bf16_t*)lds;
    LAS int* tb = (LAS int*)(lds + 136 * 1024);
    volatile LAS unsigned* xbw = (volatile LAS unsigned*)(lds + 139 * 1024);
    KC k;
    k.x = (const float*)(GAS const float*)prm.in[0]; k.c = (const float*)(GAS const float*)prm.in[1]; k.ctx = (const float*)(GAS const float*)prm.in[2]; k.c_ctx = (const float*)(GAS const float*)prm.in[3]; k.ada_w = (const float*)(GAS const float*)prm.in[4]; k.ada_b = (const float*)(GAS const float*)prm.in[5];
    k.norm_mix = (const float*)(GAS const float*)prm.in[6]; k.norm_ffn = (const float*)(GAS const float*)prm.in[7]; k.norm_final = (const float*)(GAS const float*)prm.in[8];
    k.dn_w_in = (const float*)(GAS const float*)prm.in[9]; k.dn_conv = (const float*)(GAS const float*)prm.in[10]; k.dn_a_log = (const float*)(GAS const float*)prm.in[11]; k.dn_dt_bias = (const float*)(GAS const float*)prm.in[12]; k.dn_out_norm = (const float*)(GAS const float*)prm.in[13]; k.dn_w_out = (const float*)(GAS const float*)prm.in[14];
    k.hy_w_in = (const float*)(GAS const float*)prm.in[15]; k.hy_conv = (const float*)(GAS const float*)prm.in[16]; k.hy_f_w1 = (const float*)(GAS const float*)prm.in[17]; k.hy_f_b1 = (const float*)(GAS const float*)prm.in[18]; k.hy_f_freq = (const float*)(GAS const float*)prm.in[19]; k.hy_f_w2 = (const float*)(GAS const float*)prm.in[20];
    k.hy_f_b2 = (const float*)(GAS const float*)prm.in[21]; k.hy_f_w3 = (const float*)(GAS const float*)prm.in[22]; k.hy_bias = (const float*)(GAS const float*)prm.in[23]; k.hy_w_out = (const float*)(GAS const float*)prm.in[24];
    k.sc_w_in = (const float*)(GAS const float*)prm.in[25]; k.sc_conv = (const float*)(GAS const float*)prm.in[26]; k.sc_w_out = (const float*)(GAS const float*)prm.in[27]; k.w_router = (const float*)(GAS const float*)prm.in[28]; k.router_bias = (const float*)(GAS const float*)prm.in[29];
    k.moe_w_gate = (const float*)(GAS const float*)prm.in[30]; k.moe_w_up = (const float*)(GAS const float*)prm.in[31]; k.moe_w_down = (const float*)(GAS const float*)prm.in[32];
    k.out = (float*)(GAS float*)prm.out; k.ws = (unsigned char*)(GAS unsigned char*)prm.ws;
    const int lo = prm.ph_lo, hi = prm.ph_hi;
    XcdBarrier bar; bar.bar = (unsigned*)(k.ws + WS_CTL); bar.x = 0; bar.st = xbw;
    if (hi - lo > 1) {
        if (threadIdx.x == 0) { xbw[0] = 0u; xbw[1] = 0u; }
        __syncthreads();
        bar = xcd_barrier_post((unsigned*)(k.ws + WS_CTL), xbw);
    }
    int ph = 0;
#define PH_BEGIN(id) if (ph >= lo && ph < hi) { for (int rep_ = 0; rep_ < (((id) == PROBE_REP) ? 2 : 1); ++rep_) { { GAS unsigned char* w_ = (GAS unsigned char*)k.ws; asm volatile("" : "+s"(w_)); k.ws = (unsigned char*)w_; }
#define PH_END   if (ph + 1 < hi) xcd_barrier(bar); } } ++ph;

    float* xs = (float*)(k.ws + WS_XS);
    const float* mod = (const float*)(k.ws + WS_MOD);

    PH_BEGIN(0)
        job_mod(k, ldsf);
        job_cvt_small(k, ldsf);
        job_hdn(k, ldsf);
    PH_END

    for (int i = 0; i < DEPTH; ++i) {
        const int kind = i % 3, j = i / 3;
        const bool last = (i == DEPTH - 1);
        PH_BEGIN(1)
            if (kind == 0) norm_phase<2>(k, i, i == 0, i > 0, k.norm_mix + i * 1024, 0, k.dn_w_in + (size_t)j * 1024 * DN_IN + 4096, DN_IN,
                                         k.dn_a_log + j * 16, k.dn_dt_bias + j * 16, last, ldsf);
            else norm_phase<0>(k, i, i == 0, i > 0, k.norm_mix + i * 1024, 0, nullptr, 0, nullptr, nullptr, last, ldsf);
            if (kind == 1) job_filtc(k, j);
        PH_END
        PH_BEGIN(2)
            if (kind == 0) { EpiDnSplit e{(bf16_t*)(k.ws + AR_PB), (bf16_t*)k.out}; gemm_dense(ldsh, (const bf16_t*)(k.ws + AR_HBUF), T, (const bf16_t*)(k.ws + WS_DNWIN) + (size_t)j * 4096 * 1024, 4096, 1024, e); }
            else if (kind == 1) { EpiBf16T e{(bf16_t*)(k.ws + AR_PB), T}; gemm_dense(ldsh, (const bf16_t*)(k.ws + AR_HBUF), T, (const bf16_t*)(k.ws + WS_HYWIN), 3072, 1024, e); }
            else { EpiBf16 e{(bf16_t*)(k.ws + AR_PB), 3072}; gemm_dense(ldsh, (const bf16_t*)(k.ws + AR_HBUF), T, (const bf16_t*)(k.ws + WS_SCWIN), 3072, 1024, e); }
        PH_END
        if (kind == 0) {
            PH_BEGIN(3) dn_chunk(k, j, lds); PH_END
            PH_BEGIN(4) dn_scan(k, lds); PH_END
            PH_BEGIN(5) dn_finish(k, j); PH_END
        } else if (kind == 1) {
            PH_BEGIN(6) hy_lat(k, j, ldsf); hy_ctx(k, j, ldsf); PH_END
            PH_BEGIN(7) hy_transpose(k, ldsh); PH_END
        } else {
            PH_BEGIN(8) sc_mix(k, j); PH_END
        }
        PH_BEGIN(9)
            const bf16_t* Wt = kind == 0 ? (const bf16_t*)(k.ws + WS_DNWOUT) + (size_t)j * 1024 * 1024 : (kind == 1 ? (const bf16_t*)(k.ws + WS_HYWOUT) : (const bf16_t*)(k.ws + WS_SCWOUT));
            EpiResid e{xs, mod, i, 2};
            gemm_dense(ldsh, (const bf16_t*)(k.ws + AR_UBUF), T, Wt, 1024, 1024, e);
        PH_END
        PH_BEGIN(10)
            norm_phase<1>(k, i, false, false, k.norm_ffn + i * 1024, 3, k.w_router, 32, k.router_bias, nullptr, last, ldsf);
        PH_END
        PH_BEGIN(11)
            moe_scatter(k, i, tb);
            job_cvt_moe(k, i, ldsf);
        PH_END
        PH_BEGIN(12) moe_gemm<0>(k, i, ldsh, tb); PH_END
        PH_BEGIN(13) moe_gemm<1>(k, i, ldsh, tb); PH_END
    }
    PH_BEGIN(14)
        norm_phase<3>(k, DEPTH, false, true, k.norm_final, 0, nullptr, 0, nullptr, nullptr, false, ldsf);
    PH_END
#undef PH_BEGIN
#undef PH_END
}
constexpr int N_PHASES = 1 + (10 + 9 + 8 + 10) + 1;

extern "C" void kernel_launch(void* const* d_in, const int* in_sizes, int n_in, void* d_out, int out_size, void* d_ws, size_t ws_size, hipStream_t stream) {
    static int grid = 0;
    if (grid == 0) {
        if (n_in != 33 || out_size != TL * D || ws_size < WS_END) { fprintf(stderr, "kernel_launch: unexpected shapes: n_in %d out %d ws %zu (need %zu)\n", n_in, out_size, ws_size, (size_t)WS_END); grid = -1; return; }
        int dev = 0, cus = 0, per_cu = 0;
        if (hipGetDevice(&dev) != hipSuccess || hipDeviceGetAttribute(&cus, hipDeviceAttributeMultiprocessorCount, dev) != hipSuccess) { grid = -1; return; }
        if (hipFuncSetAttribute((const void*)fwd_kernel, hipFuncAttributeMaxDynamicSharedMemorySize, LDS_BYTES) != hipSuccess) { fprintf(stderr, "kernel_launch: hipFuncSetAttribute failed\n"); grid = -1; return; }
        if (hipOccupancyMaxActiveBlocksPerMultiprocessor(&per_cu, (const void*)fwd_kernel, NTHR, LDS_BYTES) != hipSuccess || per_cu < 1) fprintf(stderr, "kernel_launch: occupancy query reports %d\n", per_cu);
        (void)hipGetLastError();
        grid = cus;
    }
    if (grid < 0) return;
    (void)hipMemsetAsync((char*)d_ws + WS_CTL, 0, CTL_BYTES, stream);
    Params p{};
    for (int i = 0; i < 33; ++i) p.in[i] = (const float*)d_in[i];
    p.out = (float*)d_out; p.ws = (unsigned char*)d_ws;
#if MK_MULTI
    for (int ph = 0; ph < N_PHASES; ++ph) { p.ph_lo = ph; p.ph_hi = ph + 1; hipLaunchKernelGGL(fwd_kernel, dim3(grid), dim3(NTHR), LDS_BYTES, stream, p); }
#else
    p.ph_lo = 0; p.ph_hi = N_PHASES;
    hipLaunchKernelGGL(fwd_kernel, dim3(grid), dim3(NTHR), LDS_BYTES, stream, p);
#endif
}
```

```cpp
#include <hip/hip_runtime.h>
#include <stdint.h>
#include <stdio.h>
#include <math.h>

#ifndef MK_MULTI
#define MK_MULTI 0
#endif

#ifndef PROBE_REP
#define PROBE_REP (-1)
#endif
#define LAS __attribute__((address_space(3)))
#define GAS __attribute__((address_space(1)))
#define HD __host__ __device__ __forceinline__
#define DI __device__ __forceinline__
#ifdef NOINL
#define PF __device__ __noinline__
#else
#define PF __device__ __forceinline__
#endif
typedef unsigned short bf16_t;
typedef short bf16x8 __attribute__((ext_vector_type(8)));
typedef float f32x4 __attribute__((ext_vector_type(4)));
typedef unsigned u32x4 __attribute__((ext_vector_type(4)));
typedef unsigned u32x2 __attribute__((ext_vector_type(2)));

constexpr int D = 1024, NB = 2, SEQ = 16384, CTXL = 256, DEPTH = 4;
constexpr int TC = NB * CTXL, TL = NB * SEQ, T = TC + TL, NA = 2 * T;
constexpr int NTHR = 512;
constexpr int DN_IN = 4128;
constexpr float EPS = 1e-6f;
constexpr int LDS_BYTES = 152 * 1024;

constexpr size_t AL(size_t x) { return (x + 255) & ~(size_t)255; }
constexpr size_t WS_CTL = 0;
constexpr size_t CTL_BYTES = 65536;
constexpr size_t CTL_CNT = 16384;
constexpr size_t WS_MOD = WS_CTL + CTL_BYTES;
constexpr size_t WS_HS = AL(WS_MOD + 4 * 3 * 6144 * 4);
constexpr size_t WS_W3S = AL(WS_HS + 16384 * 192 * 2);
constexpr size_t WS_HDNC = AL(WS_W3S + 4096 * 192 * 2);
constexpr size_t WS_FILTC = AL(WS_HDNC + 256 * 64 * 4);
constexpr size_t WS_DNWIN = AL(WS_FILTC + 256 * 4096 * 4);
constexpr size_t WS_DNWOUT = AL(WS_DNWIN + (size_t)2 * 4096 * 1024 * 2);
constexpr size_t WS_HYWIN = AL(WS_DNWOUT + (size_t)2 * 1024 * 1024 * 2);
constexpr size_t WS_HYWOUT = AL(WS_HYWIN + (size_t)3072 * 1024 * 2);
constexpr size_t WS_SCWIN = AL(WS_HYWOUT + (size_t)1024 * 1024 * 2);
constexpr size_t WS_SCWOUT = AL(WS_SCWIN + (size_t)3072 * 1024 * 2);
constexpr size_t WS_XS = AL(WS_SCWOUT + (size_t)1024 * 1024 * 2);
constexpr size_t WS_TOKE = AL(WS_XS + (size_t)T * 1024 * 4);
constexpr size_t WS_TOKW = AL(WS_TOKE + (size_t)T * 2 * 4);
constexpr size_t WS_TOKP = AL(WS_TOKW + (size_t)T * 2 * 4);
constexpr size_t WS_SLOT = AL(WS_TOKP + (size_t)T * 2 * 4);
constexpr size_t WS_GB = AL(WS_SLOT + (size_t)NA * 4);
constexpr size_t WS_EGL = AL(WS_GB + (size_t)T * 32 * 4);
constexpr size_t WS_AR = AL(WS_EGL + (size_t)32 * 260 * 4);
constexpr size_t AR_HBUF = WS_AR;
constexpr size_t AR_UBUF = AR_HBUF + (size_t)T * 1024 * 2;
constexpr size_t AR_PB = AR_UBUF + (size_t)T * 1024 * 2;
constexpr size_t AR_Q = AR_PB + (size_t)T * 4096 * 2;
constexpr size_t AR_CHUNK = AR_PB + (size_t)T * 3072 * 2;
constexpr size_t AR_DN_END = AR_CHUNK + (size_t)32 * 260 * 65536;
constexpr size_t AR_ZT = AR_Q;
constexpr size_t AR_FFTS = AR_ZT + (size_t)1024 * T * 2;
constexpr size_t AR_FT = AR_FFTS + (size_t)256 * 4 * 16384 * 8;
constexpr size_t AR_HY_END = AR_FT + (size_t)4096 * 16384 * 4;
constexpr size_t AR_HID = AR_PB;
constexpr size_t AR_YS = AR_HID + (size_t)NA * 512 * 2;
constexpr size_t AR_WGU = AR_YS + (size_t)NA * 1024 * 2;
constexpr size_t AR_WD = AR_WGU + (size_t)32 * 1024 * 1024 * 2;
constexpr size_t AR_MOE_END = AR_WD + (size_t)32 * 1024 * 512 * 2;
constexpr size_t WS_END = AR_DN_END > AR_HY_END ? (AR_DN_END > AR_MOE_END ? AR_DN_END : AR_MOE_END) : (AR_HY_END > AR_MOE_END ? AR_HY_END : AR_MOE_END);

#define XB_TMO      128
#define XB_XCNT(j)  (256  + 64 * (j))
#define XB_XSUB(j)  (1280 + 64 * (j))
#define XB_XGEN(j)  (2304 + 64 * (j))
#define XB_TOP      3328
#define XB_TOPGEN   3392
#define XCD_BAR_WORDS 3456
#define XB_SPIN_CAP (1u << 25)
DI unsigned xb_ld(unsigned* p)              { return __hip_atomic_load(p, __ATOMIC_RELAXED, __HIP_MEMORY_SCOPE_AGENT); }
DI unsigned xb_add(unsigned* p, unsigned v) { return __hip_atomic_fetch_add(p, v, __ATOMIC_RELAXED, __HIP_MEMORY_SCOPE_AGENT); }
DI unsigned xb_xcc_id() { return (unsigned)__builtin_amdgcn_s_getreg((3 << 11) | 20) & 0xFu; }
#define XB_SPIN(cond, bar) do { unsigned _sp = 0; while (cond) { __builtin_amdgcn_s_sleep(1); \
    if ((++_sp & 255u) == 0u) { if (xb_ld(&(bar)[XB_TMO])) break; if (_sp > XB_SPIN_CAP) { atomicAdd(&(bar)[XB_TMO], 1u); break; } } } } while (0)
struct XcdBarrier { unsigned* bar; unsigned x; volatile LAS unsigned* st; };
DI XcdBarrier xcd_barrier_post(unsigned* bar, volatile LAS unsigned* st) {
    XcdBarrier b; b.bar = bar; b.x = xb_xcc_id(); b.st = st;
    if (threadIdx.x == 0) (void)xb_add(&bar[XB_XCNT(b.x)], 1u);
    return b;
}
DI void xcd_barrier_complete(unsigned* bar, unsigned x, unsigned& nloc, unsigned& nx) {
    const unsigned G = gridDim.x * gridDim.y * gridDim.z;
    unsigned sum, cnt, mine, sp = 0u;
    for (;;) {
        sum = 0u; cnt = 0u; mine = 0u;
#pragma unroll
        for (unsigned j = 0; j < 16; ++j) { const unsigned c = xb_ld(&bar[XB_XCNT(j)]); sum += c; cnt += (c > 0u) ? 1u : 0u; mine = (j == x) ? c : mine; }
        if (sum == G) break;
        __builtin_amdgcn_s_sleep(1);
        if ((++sp & 255u) == 0u) { if (xb_ld(&bar[XB_TMO])) break; if (sp > XB_SPIN_CAP) { atomicAdd(&bar[XB_TMO], 1u); break; } }
    }
    nloc = mine > 0u ? mine : 1u; nx = cnt > 0u ? cnt : 1u;
}
DI void xcd_barrier(const XcdBarrier& b) {
    asm volatile("s_waitcnt vmcnt(0)" ::: "memory");
    __syncthreads();
    if (threadIdx.x == 0) {
        unsigned* bar = b.bar;
        __builtin_amdgcn_s_waitcnt(0);
        unsigned nloc = b.st[0], nx = b.st[1];
        if (nloc == 0u) { xcd_barrier_complete(bar, b.x, nloc, nx); b.st[0] = nloc; b.st[1] = nx; }
        const unsigned old = xb_add(&bar[XB_XSUB(b.x)], 1u);
        const unsigned gen = old / nloc;
        if (old + 1u == (gen + 1u) * nloc) {
            __builtin_amdgcn_fence(__ATOMIC_RELEASE, "agent");
            asm volatile("s_waitcnt vmcnt(0)" ::: "memory");
            const unsigned og = xb_add(&bar[XB_TOP], 1u);
            const unsigned tg = og / nx;
            if (og + 1u == (tg + 1u) * nx) xb_add(&bar[XB_TOPGEN], 1u);
            else XB_SPIN(xb_ld(&bar[XB_TOPGEN]) == tg, bar);
            __builtin_amdgcn_fence(__ATOMIC_ACQUIRE, "agent");
            xb_add(&bar[XB_XGEN(b.x)], 1u);
            asm volatile("s_waitcnt vmcnt(0)" ::: "memory");
        } else {
            XB_SPIN(xb_ld(&bar[XB_XGEN(b.x)]) == gen, bar);
            __builtin_amdgcn_fence(__ATOMIC_ACQUIRE, "agent");
            asm volatile("s_waitcnt vmcnt(0)" ::: "memory");
        }
    }
    __syncthreads();
}

DI bf16_t f2bf(float f) { unsigned u = __float_as_uint(f); u += 0x7fffu + ((u >> 16) & 1u); return (bf16_t)(u >> 16); }
DI float bf2f(bf16_t b) { return __uint_as_float(((unsigned)b) << 16); }
DI unsigned pk2(float lo, float hi) { return (unsigned)f2bf(lo) | ((unsigned)f2bf(hi) << 16); }
DI float siluf(float x) { return x / (1.0f + __expf(-x)); }
DI float sigmf(float x) { return 1.0f / (1.0f + __expf(-x)); }
DI float wsum(float v) {
#pragma unroll
    for (int m = 32; m >= 1; m >>= 1) v += __shfl_xor(v, m);
    return v;
}
DI void lds_barrier() { asm volatile("s_waitcnt lgkmcnt(0)\n\ts_barrier" ::: "memory"); }
DI int TID() { int t = threadIdx.x; asm volatile("" : "+v"(t)); return t; }
DI int modrow(int r) { return r < TC ? 0 : 1 + (r - TC) / SEQ; }

typedef float cf __attribute__((ext_vector_type(2)));
HD cf cmul(cf a, cf b) { cf r; r.x = a.x * b.x - a.y * b.y; r.y = a.x * b.y + a.y * b.x; return r; }
HD cf cadd(cf a, cf b) { cf r; r.x = a.x + b.x; r.y = a.y + b.y; return r; }
HD cf csub(cf a, cf b) { cf r; r.x = a.x - b.x; r.y = a.y - b.y; return r; }
template <int R> HD constexpr int brev(int i) { int r = 0; for (int b = 1, t = R >> 1; b < R; b <<= 1, t >>= 1) if (i & b) r |= t; return r; }
#define FFT_C32 {1.0f, 0.98078528040323044913f, 0.92387953251128675613f, 0.83146961230254523708f, 0.70710678118654752440f, 0.55557023301960222474f, 0.38268343236508977173f, 0.19509032201612826785f, 0.0f, -0.19509032201612826785f, -0.38268343236508977173f, -0.55557023301960222474f, -0.70710678118654752440f, -0.83146961230254523708f, -0.92387953251128675613f, -0.98078528040323044913f}
#define FFT_S32 {0.0f, 0.19509032201612826785f, 0.38268343236508977173f, 0.55557023301960222474f, 0.70710678118654752440f, 0.83146961230254523708f, 0.92387953251128675613f, 0.98078528040323044913f, 1.0f, 0.98078528040323044913f, 0.92387953251128675613f, 0.83146961230254523708f, 0.70710678118654752440f, 0.55557023301960222474f, 0.38268343236508977173f, 0.19509032201612826785f}
template <int R> HD constexpr int ilog2c() { int l = 0; for (int r = R; r > 1; r >>= 1) ++l; return l; }
template <int R> HD void dft_fwd(cf (&v)[R]) {
    constexpr float C[16] = FFT_C32; constexpr float S[16] = FFT_S32;
    constexpr int LG = ilog2c<R>();
#pragma unroll
    for (int st = 0; st < LG; ++st) {
#pragma unroll
        for (int i = 0; i < R / 2; ++i) {
            const int len = R >> st, half = len >> 1, blk = i / half, j = i % half, i0 = blk * len + j, i1 = i0 + half;
            const cf a = v[i0], c = v[i1];
            v[i0] = cadd(a, c);
            const cf d = csub(a, c);
            const int ti = j * (32 / len);
            cf w; w.x = C[ti]; w.y = -S[ti];
            v[i1] = (ti == 0) ? d : cmul(d, w);
        }
    }
}
template <int R> HD void dft_inv(cf (&v)[R]) {
    constexpr float C[16] = FFT_C32; constexpr float S[16] = FFT_S32;
    constexpr int LG = ilog2c<R>();
#pragma unroll
    for (int st = LG - 1; st >= 0; --st) {
#pragma unroll
        for (int i = 0; i < R / 2; ++i) {
            const int len = R >> st, half = len >> 1, blk = i / half, j = i % half, i0 = blk * len + j, i1 = i0 + half;
            const int ti = j * (32 / len);
            cf w; w.x = C[ti]; w.y = S[ti];
            const cf a = v[i0];
            const cf c = (ti == 0) ? v[i1] : cmul(v[i1], w);
            v[i0] = cadd(a, c);
            v[i1] = csub(a, c);
        }
    }
}
#define PIDX(a) ((a) + (((a) >> 6) << 2))
template <int R> DI void fft_pass_fwd(LAS cf* X, const LAS cf* tw, int n, int g) {
    const int s = n / R, q = g / s, p = g - q * s, base = q * n + p;
    cf v[R];
#pragma unroll
    for (int k = 0; k < R; ++k) v[k] = X[PIDX(base + k * s)];
    dft_fwd<R>(v);
    if (s > 1) {
        int pp = p * (16384 / n); asm volatile("" : "+v"(pp));
        const cf w1 = tw[pp]; cf w = w1;
#pragma unroll
        for (int m = 1; m < R; ++m) { v[brev<R>(m)] = cmul(v[brev<R>(m)], w); w = cmul(w, w1); }
    }
#pragma unroll
    for (int k = 0; k < R; ++k) X[PIDX(base + k * s)] = v[k];
}
template <int R> DI void fft_pass_inv(LAS cf* X, const LAS cf* tw, int n, int g) {
    const int s = n / R, q = g / s, p = g - q * s, base = q * n + p;
    cf v[R];
#pragma unroll
    for (int k = 0; k < R; ++k) v[k] = X[PIDX(base + k * s)];
    if (s > 1) {
        int pp = p * (16384 / n); asm volatile("" : "+v"(pp));
        cf w1 = tw[pp]; w1.y = -w1.y; cf w = w1;
#pragma unroll
        for (int m = 1; m < R; ++m) { v[brev<R>(m)] = cmul(v[brev<R>(m)], w); w = cmul(w, w1); }
    }
    dft_inv<R>(v);
#pragma unroll
    for (int k = 0; k < R; ++k) X[PIDX(base + k * s)] = v[k];
}
DI void fft16k_fwd(LAS cf* X, const LAS cf* tw) {
    const int t = TID();
#pragma unroll 1
    for (int g = 0; g < 2; ++g) fft_pass_fwd<16>(X, tw, 16384, t + 512 * g);
    __syncthreads();
#pragma unroll 1
    for (int g = 0; g < 2; ++g) fft_pass_fwd<16>(X, tw, 1024, t + 512 * g);
    __syncthreads();
#pragma unroll 1
    for (int g = 0; g < 2; ++g) fft_pass_fwd<16>(X, tw, 64, t + 512 * g);
    __syncthreads();
#pragma unroll 1
    for (int g = 0; g < 8; ++g) fft_pass_fwd<4>(X, tw, 4, t + 512 * g);
    __syncthreads();
}
DI void fft16k_inv(LAS cf* X, const LAS cf* tw) {
    const int t = TID();
#pragma unroll 1
    for (int g = 0; g < 8; ++g) fft_pass_inv<4>(X, tw, 4, t + 512 * g);
    __syncthreads();
#pragma unroll 1
    for (int g = 0; g < 2; ++g) fft_pass_inv<16>(X, tw, 64, t + 512 * g);
    __syncthreads();
#pragma unroll 1
    for (int g = 0; g < 2; ++g) fft_pass_inv<16>(X, tw, 1024, t + 512 * g);
    __syncthreads();
#pragma unroll 1
    for (int g = 0; g < 2; ++g) fft_pass_inv<16>(X, tw, 16384, t + 512 * g);
    __syncthreads();
}

struct Params { const float* in[33]; float* out; unsigned char* ws; int ph_lo, ph_hi; };
struct KC {
    const float *x, *c, *ctx, *c_ctx, *ada_w, *ada_b, *norm_mix, *norm_ffn, *norm_final;
    const float *dn_w_in, *dn_conv, *dn_a_log, *dn_dt_bias, *dn_out_norm, *dn_w_out;
    const float *hy_w_in, *hy_conv, *hy_f_w1, *hy_f_b1, *hy_f_freq, *hy_f_w2, *hy_f_b2, *hy_f_w3, *hy_bias, *hy_w_out;
    const float *sc_w_in, *sc_conv, *sc_w_out, *w_router, *router_bias, *moe_w_gate, *moe_w_up, *moe_w_down;
    float* out; unsigned char* ws;
};

PF void job_mod(const KC& k, LAS float* lds) {
    const int tid = TID(), cj = tid & 63, kq = tid >> 6;
    float* mod = (float*)(k.ws + WS_MOD);
    for (int u = blockIdx.x; u < DEPTH * 96; u += gridDim.x) {
        const int l = u / 96, cc = u % 96, col = cc * 64 + cj;
        const float* W = k.ada_w + (size_t)l * 1024 * 6144;
        float a0 = 0.f, a1 = 0.f, a2 = 0.f;
        for (int kk = kq * 128; kk < kq * 128 + 128; ++kk) {
            const float w = W[(size_t)kk * 6144 + col];
            a0 += siluf(k.c_ctx[kk]) * w; a1 += siluf(k.c[kk]) * w; a2 += siluf(k.c[1024 + kk]) * w;
        }
        lds[(kq * 3 + 0) * 64 + cj] = a0; lds[(kq * 3 + 1) * 64 + cj] = a1; lds[(kq * 3 + 2) * 64 + cj] = a2;
        __syncthreads();
        if (tid < 192) {
            const int r = tid >> 6, j = tid & 63;
            float s = 0.f;
            for (int q = 0; q < 8; ++q) s += lds[(q * 3 + r) * 64 + j];
            mod[(size_t)(l * 3 + r) * 6144 + cc * 64 + j] = s + k.ada_b[l * 6144 + cc * 64 + j];
        }
        __syncthreads();
    }
}
DI void cvt_tile(const float* __restrict__ src, int ld, bf16_t* __restrict__ dst, int ldd, int k0, int n0, int mapmode, LAS float* lds) {
    const int tid = TID();
    { const int r = tid >> 4, c4 = (tid & 15) * 4;
#pragma unroll
      for (int h = 0; h < 2; ++h) {
          const f32x4 v = *(const f32x4*)(src + (size_t)(k0 + r + 32 * h) * ld + n0 + c4);
          LAS float* p = lds + (r + 32 * h) * 65 + c4; p[0] = v[0]; p[1] = v[1]; p[2] = v[2]; p[3] = v[3];
      } }
    __syncthreads();
    { const int nn = tid >> 3, ks = (tid & 7) * 8; const int n = n0 + nn;
      const int row = mapmode == 0 ? n : (32 * (n >> 4) + (n & 15) + (mapmode == 2 ? 16 : 0));
      u32x4 o;
      o[0] = pk2(lds[(ks + 0) * 65 + nn], lds[(ks + 1) * 65 + nn]); o[1] = pk2(lds[(ks + 2) * 65 + nn], lds[(ks + 3) * 65 + nn]);
      o[2] = pk2(lds[(ks + 4) * 65 + nn], lds[(ks + 5) * 65 + nn]); o[3] = pk2(lds[(ks + 6) * 65 + nn], lds[(ks + 7) * 65 + nn]);
      *(u32x4*)(dst + (size_t)row * ldd + k0 + ks) = o; }
    __syncthreads();
}
DI void cvt_matrix(const float* src, int ld, size_t sstride, int K, int N, int nmat, bf16_t* dst, int ldd, size_t dstride, int mapmode, LAS float* lds) {
    const int tk = K / 64, tn = N / 64, per = tk * tn;
    for (int u = blockIdx.x; u < per * nmat; u += gridDim.x) {
        const int m = u / per, t = u % per;
        cvt_tile(src + (size_t)m * sstride, ld, dst + (size_t)m * dstride, ldd, (t / tn) * 64, (t % tn) * 64, mapmode, lds);
    }
}
PF void job_cvt_small(const KC& k, LAS float* lds) {
    cvt_matrix(k.dn_w_in, DN_IN, (size_t)1024 * DN_IN, 1024, 4096, 2, (bf16_t*)(k.ws + WS_DNWIN), 1024, (size_t)4096 * 1024, 0, lds);
    cvt_matrix(k.dn_w_out, 1024, (size_t)1024 * 1024, 1024, 1024, 2, (bf16_t*)(k.ws + WS_DNWOUT), 1024, (size_t)1024 * 1024, 0, lds);
    cvt_matrix(k.hy_w_in, 3072, 0, 1024, 3072, 1, (bf16_t*)(k.ws + WS_HYWIN), 1024, 0, 0, lds);
    cvt_matrix(k.hy_w_out, 1024, 0, 1024, 1024, 1, (bf16_t*)(k.ws + WS_HYWOUT), 1024, 0, 0, lds);
    cvt_matrix(k.sc_w_in, 3072, 0, 1024, 3072, 1, (bf16_t*)(k.ws + WS_SCWIN), 1024, 0, 0, lds);
    cvt_matrix(k.sc_w_out, 1024, 0, 1024, 1024, 1, (bf16_t*)(k.ws + WS_SCWOUT), 1024, 0, 0, lds);
}
PF void job_cvt_moe(const KC& k, int layer, LAS float* lds) {
    const size_t lo = (size_t)layer * 32 * 1024 * 512;
    cvt_matrix(k.moe_w_gate + lo, 512, (size_t)1024 * 512, 1024, 512, 32, (bf16_t*)(k.ws + AR_WGU), 1024, (size_t)1024 * 1024, 1, lds);
    cvt_matrix(k.moe_w_up + lo, 512, (size_t)1024 * 512, 1024, 512, 32, (bf16_t*)(k.ws + AR_WGU), 1024, (size_t)1024 * 1024, 2, lds);
    cvt_matrix(k.moe_w_down + lo, 1024, (size_t)512 * 1024, 512, 1024, 32, (bf16_t*)(k.ws + AR_WD), 512, (size_t)1024 * 512, 0, lds);
}
PF void job_hdn(const KC& k, LAS float* lds) {
    const int tid = TID(), lane = tid & 63, wave = tid >> 6;
    LAS float* feat = lds + wave * 128; LAS float* h1 = feat + 64;
    const float fr = k.hy_f_freq[lane], b1 = k.hy_f_b1[lane], b2 = k.hy_f_b2[lane];
    for (int u0 = blockIdx.x * 8; u0 < 16384 + 256; u0 += gridDim.x * 8) {
        const int u = u0 + wave;
        int l, pos; float* dst;
        if (u < 16384) { l = 16384; pos = u; dst = nullptr; }
        else { l = 256; pos = u - 16384; dst = (float*)(k.ws + WS_HDNC) + (size_t)pos * 64; }
        const float t = (float)pos / (float)(l - 1);
        float f = 0.f;
        if (lane == 0) f = t;
        else if (lane <= 32) {
            const int bi = (lane - 1) & 15;
            const float band = 1e-4f + (float)bi * ((15.0f - 1e-4f) / 15.0f);
            const float ang = (6.283185307179586f / (float)l) * (float)pos * band;
            f = lane <= 16 ? cosf(ang) : -sinf(ang);
        }
        feat[lane] = f;
        __syncthreads();
        float a = b1;
        for (int i = 0; i < 33; ++i) a += feat[i] * k.hy_f_w1[i * 64 + lane];
        h1[lane] = sinf(fr * a);
        __syncthreads();
        float a2 = b2;
        for (int j = 0; j < 64; ++j) a2 += h1[j] * k.hy_f_w2[j * 64 + lane];
        const float hv = sinf(fr * a2);
        if (dst) dst[lane] = hv;
        else { bf16_t* hs = (bf16_t*)(k.ws + WS_HS) + (size_t)pos * 192; const bf16_t hi = f2bf(hv), lo = f2bf(hv - bf2f(hi)); hs[lane] = hi; hs[64 + lane] = lo; hs[128 + lane] = hi; }
        __syncthreads();
    }
}
PF void job_w3s(const KC& k) {
    bf16_t* W = (bf16_t*)(k.ws + WS_W3S);
    const int tq = TID();
    for (int idx = blockIdx.x * NTHR + tq; idx < 64 * 4096; idx += gridDim.x * NTHR) {
        const int j = idx >> 12, col = idx & 4095;
        const float w = k.hy_f_w3[idx]; const bf16_t hi = f2bf(w), lo = f2bf(w - bf2f(hi));
        W[(size_t)col * 192 + j] = hi; W[(size_t)col * 192 + 64 + j] = hi; W[(size_t)col * 192 + 128 + j] = lo;
    }
}
DI float hy_delta(int ch) {
    const float lo = -4.605170185988091f / 1.5f, hi = -4.605170185988091f / 0.3f;
    return fabsf(lo + (float)ch * ((hi - lo) / 1023.0f));
}
PF void job_filtc(const KC& k, int j) {
    const float* hdn = (const float*)(k.ws + WS_HDNC);
    const float* w3 = k.hy_f_w3 + (size_t)j * 64 * 4096;
    float* filtc = (float*)(k.ws + WS_FILTC);
    const int tq = TID();
    for (int u = blockIdx.x; u < 256 * 8; u += gridDim.x) {
        const int l = u >> 3, col = (u & 7) * 512 + tq;
        float a = 0.f;
        for (int q = 0; q < 64; ++q) a += hdn[l * 64 + q] * w3[(size_t)q * 4096 + col];
        const float t = (float)l / 255.0f;
        filtc[(size_t)l * 4096 + col] = a * expf(-t * hy_delta(col & 1023));
    }
}

template <int MODE>
PF void norm_phase(const KC& k, int layer, bool first, bool combine, const float* __restrict__ gain, int mb, const float* __restrict__ Wsk, int ldw,
                   const float* __restrict__ aux0, const float* __restrict__ aux1, bool last, LAS float* lds, bool flush = true) {
    const int tid = TID(), lane = tid & 63, wave = tid >> 6;
    float* xs = (float*)(k.ws + WS_XS);
    bf16_t* hbuf = (bf16_t*)(k.ws + AR_HBUF);
    const float* mod = (const float*)(k.ws + WS_MOD);
    const bf16_t* ys = (const bf16_t*)(k.ws + AR_YS);
    const int* tokp = (const int*)(k.ws + WS_TOKP);
    const float* tokw = (const float*)(k.ws + WS_TOKW);
    LAS int* lcnt = (LAS int*)(lds + 32768);
    if (MODE == 1 && tid < 32) lcnt[tid] = 0;
    if (MODE == 1 || MODE == 2) {
        for (int idx = tid; idx < 1024 * 32; idx += NTHR) {
            const int kk = idx >> 5, n = idx & 31;
            lds[kk * 32 + (((n >> 2) ^ ((kk >> 1) & 7)) << 2) + (n & 3)] = Wsk[(size_t)kk * ldw + n];
        }
        __syncthreads();
    }
    const int rbeg = (MODE == 3) ? TC : 0;
    for (int r = rbeg + blockIdx.x * 8 + wave; r < T; r += gridDim.x * 8) {
        const int mr = modrow(r);
        const float* src = first ? (r < TC ? k.ctx + (size_t)r * 1024 : k.x + (size_t)(r - TC) * 1024) : xs + (size_t)r * 1024;
        float x[16];
#pragma unroll
        for (int m = 0; m < 16; ++m) x[m] = src[lane + 64 * m];
        if (combine) {
            const int p0 = tokp[2 * r], p1 = tokp[2 * r + 1];
            const float w0 = tokw[2 * r], w1 = tokw[2 * r + 1];
            const float* g5 = mod + ((size_t)((layer - 1) * 3 + mr) * 6 + 5) * 1024;
#pragma unroll
            for (int m = 0; m < 16; ++m) {
                const int col = lane + 64 * m;
                x[m] += g5[col] * (w0 * bf2f(ys[(size_t)p0 * 1024 + col]) + w1 * bf2f(ys[(size_t)p1 * 1024 + col]));
            }
        }
        if (first || combine) {
#pragma unroll
            for (int m = 0; m < 16; ++m) xs[(size_t)r * 1024 + lane + 64 * m] = x[m];
        }
        float ss = 0.f;
#pragma unroll
        for (int m = 0; m < 16; ++m) ss += x[m] * x[m];
        ss = wsum(ss);
        const float rstd = rsqrtf(ss * (1.0f / 1024.0f) + EPS);
        if (MODE == 3) {
#pragma unroll
            for (int m = 0; m < 16; ++m) { const int col = lane + 64 * m; k.out[(size_t)(r - TC) * 1024 + col] = x[m] * rstd * gain[col]; }
            continue;
        }
        const float* shift = mod + ((size_t)(layer * 3 + mr) * 6 + mb) * 1024;
        const float* scale = shift + 1024;
        float y[16];
#pragma unroll
        for (int m = 0; m < 16; ++m) {
            const int col = lane + 64 * m;
            y[m] = x[m] * rstd * gain[col] * (1.0f + scale[col]) + shift[col];
            hbuf[(size_t)r * 1024 + col] = f2bf(y[m]);
        }
        if (MODE == 1 || MODE == 2) {
            float acc[32];
#pragma unroll
            for (int n = 0; n < 32; ++n) acc[n] = 0.f;
#pragma unroll
            for (int m = 0; m < 16; ++m) {
                asm volatile("" ::: "memory");
                const int c = lane + 64 * m;
                const LAS float* wr = lds + c * 32; const int sw = (c >> 1) & 7;
#pragma unroll
                for (int q = 0; q < 8; ++q) {
                    const f32x4 w4 = *(const LAS f32x4*)(wr + ((q ^ sw) << 2));
                    acc[4 * q + 0] += y[m] * w4[0]; acc[4 * q + 1] += y[m] * w4[1]; acc[4 * q + 2] += y[m] * w4[2]; acc[4 * q + 3] += y[m] * w4[3];
                }
            }
            float val;
            {
                float a16[16], a8[8], a4[4], a2[2];
                const bool b5 = (lane & 32) != 0, b4 = (lane & 16) != 0, b3 = (lane & 8) != 0, b2 = (lane & 4) != 0, b1 = (lane & 2) != 0;
#pragma unroll
                for (int i = 0; i < 16; ++i) { const float send = b5 ? acc[i] : acc[i + 16], keep = b5 ? acc[i + 16] : acc[i]; a16[i] = keep + __shfl_xor(send, 32); }
#pragma unroll
                for (int i = 0; i < 8; ++i) { const float send = b4 ? a16[i] : a16[i + 8], keep = b4 ? a16[i + 8] : a16[i]; a8[i] = keep + __shfl_xor(send, 16); }
#pragma unroll
                for (int i = 0; i < 4; ++i) { const float send = b3 ? a8[i] : a8[i + 4], keep = b3 ? a8[i + 4] : a8[i]; a4[i] = keep + __shfl_xor(send, 8); }
#pragma unroll
                for (int i = 0; i < 2; ++i) { const float send = b2 ? a4[i] : a4[i + 2], keep = b2 ? a4[i + 2] : a4[i]; a2[i] = keep + __shfl_xor(send, 4); }
                { const float send = b1 ? a2[0] : a2[1], keep = b1 ? a2[1] : a2[0]; val = keep + __shfl_xor(send, 2); }
                val += __shfl_xor(val, 1);
            }
            const int n = lane >> 1;
            if (MODE == 1) {
                int* toke = (int*)(k.ws + WS_TOKE); float* tokwW = (float*)(k.ws + WS_TOKW);
                if (last && r < TC) { if (lane == 0) { toke[2 * r] = -1; toke[2 * r + 1] = -1; } continue; }
                const float sc = 1.0f / (1.0f + expf(-val)), ch = sc + aux0[n];
                const int gl = lane & ~7;
                const float ca = __shfl(ch, gl), cb = __shfl(ch, gl + 2), cc = __shfl(ch, gl + 4), cd = __shfl(ch, gl + 6);
                const float hi1 = fmaxf(ca, cb), lo1 = fminf(ca, cb), hi2 = fmaxf(cc, cd), lo2 = fminf(cc, cd);
                float gs = fmaxf(hi1, hi2) + fmaxf(fminf(hi1, hi2), fmaxf(lo1, lo2));
                int gi = lane >> 3;
#pragma unroll
                for (int m = 8; m <= 32; m <<= 1) {
                    const float og = __shfl_xor(gs, m); const int oi = __shfl_xor(gi, m);
                    if (og > gs || (og == gs && oi < gi)) { gs = og; gi = oi; }
                }
                float c4[4], s4[4];
#pragma unroll
                for (int i = 0; i < 4; ++i) { c4[i] = __shfl(ch, gi * 8 + 2 * i); s4[i] = __shfl(sc, gi * 8 + 2 * i); }
                int i1 = 0; float b1v = c4[0];
#pragma unroll
                for (int i = 1; i < 4; ++i) if (c4[i] > b1v) { b1v = c4[i]; i1 = i; }
                int i2 = -1; float b2v = -1e30f;
#pragma unroll
                for (int i = 0; i < 4; ++i) if (i != i1 && c4[i] > b2v) { b2v = c4[i]; i2 = i; }
                float w1v = 0.f, w2v = 0.f;
#pragma unroll
                for (int i = 0; i < 4; ++i) { if (i == i1) w1v = s4[i]; if (i == i2) w2v = s4[i]; }
                const float inv = 1.0f / (w1v + w2v);
                if (lane == 0) {
                    const int e1 = gi * 4 + i1, e2 = gi * 4 + i2;
                    toke[2 * r] = e1; toke[2 * r + 1] = e2; tokwW[2 * r] = w1v * inv; tokwW[2 * r + 1] = w2v * inv;
                    __hip_atomic_fetch_add(lcnt + e1, 1, __ATOMIC_RELAXED, __HIP_MEMORY_SCOPE_WORKGROUP);
                    __hip_atomic_fetch_add(lcnt + e2, 1, __ATOMIC_RELAXED, __HIP_MEMORY_SCOPE_WORKGROUP);
                }
            } else {
                float* gb = (float*)(k.ws + WS_GB);
                if ((lane & 1) == 0) {
                    if (n < 16) {
                        const float z = val + aux1[n];
                        const float sp = z > 20.f ? z : log1pf(expf(z));
                        gb[(size_t)r * 32 + n] = -expf(aux0[n]) * sp;
                    } else {
                        gb[(size_t)r * 32 + n] = 1.0f / (1.0f + expf(-val));
                    }
                }
            }
        }
    }
    if (MODE == 1) {
        __syncthreads();
        int* cnt = (int*)(k.ws + WS_CTL + CTL_CNT) + layer * 32;
        if (flush && tid < 32 && lcnt[tid] > 0) atomicAdd(&cnt[tid], lcnt[tid]);
    }
}

template <class Epi>
DI void gemm_tile(LAS bf16_t* lds, const bf16_t* __restrict__ A, int lda, const int* __restrict__ rowidx, int m0, int mrows,
                  const bf16_t* __restrict__ Bt, int K, int n0, const Epi& epi) {
    const int tid = TID(), lane = tid & 63, wave = tid >> 6, wr = wave >> 2, wc = wave & 3, fr = lane & 15, fq = lane >> 4;
    LAS bf16_t* As = lds; LAS bf16_t* Bs = lds + 128 * 72;
    const int seg = tid & 7, r0 = tid >> 3;
    const int ra0 = r0 < mrows ? r0 : 0, ra1 = (r0 + 64) < mrows ? (r0 + 64) : 0;
    size_t ar0, ar1;
    if (rowidx) { ar0 = (size_t)rowidx[m0 + ra0]; ar1 = (size_t)rowidx[m0 + ra1]; } else { ar0 = (size_t)(m0 + ra0); ar1 = (size_t)(m0 + ra1); }
    const bf16_t* pa0 = A + ar0 * lda + seg * 8; const bf16_t* pa1 = A + ar1 * lda + seg * 8;
    const bf16_t* pb0 = Bt + (size_t)(n0 + r0) * K + seg * 8; const bf16_t* pb1 = Bt + (size_t)(n0 + r0 + 64) * K + seg * 8;
    u32x4 ga0 = *(const u32x4*)pa0, ga1 = *(const u32x4*)pa1, gb0 = *(const u32x4*)pb0, gb1 = *(const u32x4*)pb1;
    f32x4 acc[4][2];
#pragma unroll
    for (int m = 0; m < 4; ++m)
#pragma unroll
        for (int n = 0; n < 2; ++n) acc[m][n] = (f32x4){0.f, 0.f, 0.f, 0.f};
    const int nk = K >> 6;
    for (int kt = 0; kt < nk; ++kt) {
        __syncthreads();
        *(LAS u32x4*)(As + r0 * 72 + seg * 8) = ga0; *(LAS u32x4*)(As + (r0 + 64) * 72 + seg * 8) = ga1;
        *(LAS u32x4*)(Bs + r0 * 72 + seg * 8) = gb0; *(LAS u32x4*)(Bs + (r0 + 64) * 72 + seg * 8) = gb1;
        __syncthreads();
        if (kt + 1 < nk) {
            const int ko = (kt + 1) * 64;
            ga0 = *(const u32x4*)(pa0 + ko); ga1 = *(const u32x4*)(pa1 + ko); gb0 = *(const u32x4*)(pb0 + ko); gb1 = *(const u32x4*)(pb1 + ko);
        }
#pragma unroll
        for (int kk = 0; kk < 2; ++kk) {
            bf16x8 af[4], bfv[2];
#pragma unroll
            for (int m = 0; m < 4; ++m) af[m] = *(const LAS bf16x8*)(As + (wr * 64 + m * 16 + fr) * 72 + kk * 32 + fq * 8);
#pragma unroll
            for (int n = 0; n < 2; ++n) bfv[n] = *(const LAS bf16x8*)(Bs + (wc * 32 + n * 16 + fr) * 72 + kk * 32 + fq * 8);
#pragma unroll
            for (int m = 0; m < 4; ++m)
#pragma unroll
                for (int n = 0; n < 2; ++n) acc[m][n] = __builtin_amdgcn_mfma_f32_16x16x32_bf16(af[m], bfv[n], acc[m][n], 0, 0, 0);
        }
    }
    epi(acc, m0, mrows, n0, wr, wc, fr, fq);
}
struct EpiBf16 {
    bf16_t* C; int ldc;
    DI void operator()(const f32x4 (&acc)[4][2], int m0, int mrows, int n0, int wr, int wc, int fr, int fq) const {
#pragma unroll
        for (int m = 0; m < 4; ++m)
#pragma unroll
            for (int j = 0; j < 4; ++j) {
                const int rl = wr * 64 + m * 16 + fq * 4 + j;
                if (rl < mrows) {
#pragma unroll
                    for (int n = 0; n < 2; ++n) C[(size_t)(m0 + rl) * ldc + n0 + wc * 32 + n * 16 + fr] = f2bf(acc[m][n][j]);
                }
            }
    }
};
struct EpiDnSplit {
    bf16_t* P; bf16_t* Z;
    DI void operator()(const f32x4 (&acc)[4][2], int m0, int mrows, int n0, int wr, int wc, int fr, int fq) const {
        bf16_t* base; int ldc, cb;
        if (n0 < 3072) { base = P; ldc = 3072; cb = n0; } else { base = Z; ldc = 1024; cb = n0 - 3072; }
#pragma unroll
        for (int m = 0; m < 4; ++m)
#pragma unroll
            for (int j = 0; j < 4; ++j) {
                const int rl = wr * 64 + m * 16 + fq * 4 + j;
#pragma unroll
                for (int n = 0; n < 2; ++n) base[(size_t)(m0 + rl) * ldc + cb + wc * 32 + n * 16 + fr] = f2bf(acc[m][n][j]);
            }
    }
};
struct EpiBf16T {
    bf16_t* C; int ldc;
    DI void operator()(const f32x4 (&acc)[4][2], int m0, int mrows, int n0, int wr, int wc, int fr, int fq) const {
#pragma unroll
        for (int m = 0; m < 4; ++m)
#pragma unroll
            for (int n = 0; n < 2; ++n) {
                const int row = m0 + wr * 64 + m * 16 + fq * 4, col = n0 + wc * 32 + n * 16 + fr;
                u32x2 o; o[0] = pk2(acc[m][n][0], acc[m][n][1]); o[1] = pk2(acc[m][n][2], acc[m][n][3]);
                *(u32x2*)(C + (size_t)col * ldc + row) = o;
            }
    }
};
struct EpiTaps {
    float* FT;
    DI void operator()(const f32x4 (&acc)[4][2], int m0, int mrows, int n0, int wr, int wc, int fr, int fq) const {
#pragma unroll
        for (int m = 0; m < 4; ++m)
#pragma unroll
            for (int j = 0; j < 4; ++j) {
                const int col = m0 + wr * 64 + m * 16 + fq * 4 + j; const float dl = hy_delta(col & 1023) * (1.0f / 16383.0f);
#pragma unroll
                for (int n = 0; n < 2; ++n) { const int l = n0 + wc * 32 + n * 16 + fr; FT[(size_t)col * 16384 + l] = acc[m][n][j] * expf(-(float)l * dl); }
            }
    }
};
struct EpiResid {
    float* xs; const float* mod; int layer; int chunk;
    DI void operator()(const f32x4 (&acc)[4][2], int m0, int mrows, int n0, int wr, int wc, int fr, int fq) const {
        const float* g = mod + ((size_t)(layer * 3 + modrow(m0)) * 6 + chunk) * 1024;
#pragma unroll
        for (int n = 0; n < 2; ++n) {
            const int col = n0 + wc * 32 + n * 16 + fr; const float gv = g[col];
#pragma unroll
            for (int m = 0; m < 4; ++m)
#pragma unroll
                for (int j = 0; j < 4; ++j) { float* p = xs + (size_t)(m0 + wr * 64 + m * 16 + fq * 4 + j) * 1024 + col; *p = *p + gv * acc[m][n][j]; }
        }
    }
};
struct EpiGateUp {
    bf16_t* hid;
    DI void operator()(const f32x4 (&acc)[4][2], int m0, int mrows, int n0, int wr, int wc, int fr, int fq) const {
        const int hc = ((n0 + wc * 32) >> 1) + fr;
#pragma unroll
        for (int m = 0; m < 4; ++m)
#pragma unroll
            for (int j = 0; j < 4; ++j) {
                const int rl = wr * 64 + m * 16 + fq * 4 + j;
                if (rl < mrows) { const float g = acc[m][0][j]; hid[(size_t)(m0 + rl) * 512 + hc] = f2bf(siluf(g) * acc[m][1][j]); }
            }
    }
};
template <class Epi>
PF void gemm_dense(LAS bf16_t* lds, const bf16_t* A, int M, const bf16_t* Bt, int N, int K, const Epi& epi) {
    const int tn = N / 128, tm = M / 128;
    for (int u = blockIdx.x; u < tm * tn; u += gridDim.x) {
        const int mt = u / tn, nt = u % tn;
        gemm_tile(lds, A, K, (const int*)nullptr, mt * 128, 128, Bt, K, nt * 128, epi);
    }
}
DI void moe_table(const KC& k, int layer, LAS int* tb) {
    const int* cnt = (const int*)(k.ws + WS_CTL + CTL_CNT) + layer * 32;
    __syncthreads();
    const int tq = TID();
    if (tq < 32) tb[tq] = __hip_atomic_load(cnt + tq, __ATOMIC_RELAXED, __HIP_MEMORY_SCOPE_AGENT);
    __syncthreads();
    if (tq == 0) {
        int s = 0, tp = 0;
        for (int e = 0; e < 32; ++e) { tb[32 + e] = s; tb[65 + e] = tp; s += tb[e]; tp += (tb[e] + 127) >> 7; }
        tb[64] = s; tb[97] = tp;
    }
    __syncthreads();
}
template <int WHICH>
PF void moe_gemm(const KC& k, int layer, LAS bf16_t* lds, LAS int* tb) {
    moe_table(k, layer, tb);
    const int ntile = tb[97];
    for (int u = blockIdx.x; u < ntile * 8; u += gridDim.x) {
        const int tile = u >> 3, nt = u & 7;
        int e = 0;
        for (int q = 1; q < 32; ++q) if (tb[65 + q] <= tile) e = q;
        const int lt = tile - tb[65 + e], m0 = tb[32 + e] + lt * 128;
        int mrows = tb[e] - lt * 128; mrows = mrows > 128 ? 128 : mrows;
        if (WHICH == 0) {
            EpiGateUp epi{(bf16_t*)(k.ws + AR_HID)};
            gemm_tile(lds, (const bf16_t*)(k.ws + AR_HBUF), 1024, (const int*)(k.ws + WS_SLOT), m0, mrows,
                      (const bf16_t*)(k.ws + AR_WGU) + (size_t)e * 1024 * 1024, 1024, nt * 128, epi);
        } else {
            EpiBf16 epi{(bf16_t*)(k.ws + AR_YS), 1024};
            gemm_tile(lds, (const bf16_t*)(k.ws + AR_HID), 512, (const int*)nullptr, m0, mrows,
                      (const bf16_t*)(k.ws + AR_WD) + (size_t)e * 1024 * 512, 512, nt * 128, epi);
        }
    }
}
PF void moe_scatter(const KC& k, int layer, LAS int* tb) {
    moe_table(k, layer, tb);
    const int* toke = (const int*)(k.ws + WS_TOKE);
    int* tokp = (int*)(k.ws + WS_TOKP); int* slot = (int*)(k.ws + WS_SLOT);
    int* cur = (int*)(k.ws + WS_CTL + CTL_CNT) + 128 + layer * 32;
    LAS int* lc = tb + 128; LAS int* lb = tb + 160;
    const int tid = TID();
    for (int r0 = blockIdx.x * NTHR; r0 < T; r0 += gridDim.x * NTHR) {
        const int r = r0 + tid;
        __syncthreads();
        if (tid < 32) lc[tid] = 0;
        __syncthreads();
        const int e0 = toke[2 * r], e1 = toke[2 * r + 1];
        int k0 = 0, k1 = 0;
        if (e0 >= 0) { k0 = __hip_atomic_fetch_add(lc + e0, 1, __ATOMIC_RELAXED, __HIP_MEMORY_SCOPE_WORKGROUP); k1 = __hip_atomic_fetch_add(lc + e1, 1, __ATOMIC_RELAXED, __HIP_MEMORY_SCOPE_WORKGROUP); }
        __syncthreads();
        if (tid < 32) lb[tid] = lc[tid] > 0 ? atomicAdd(&cur[tid], lc[tid]) : 0;
        __syncthreads();
        if (e0 >= 0) {
            const int p0 = tb[32 + e0] + lb[e0] + k0, p1 = tb[32 + e1] + lb[e1] + k1;
            slot[p0] = r; slot[p1] = r; tokp[2 * r] = p0; tokp[2 * r + 1] = p1;
        }
    }
}

PF void sc_mix(const KC& k, int j) {
    const int tid = TID(), lane = tid & 63, wave = tid >> 6;
    const bf16_t* P = (const bf16_t*)(k.ws + AR_PB);
    bf16_t* U = (bf16_t*)(k.ws + AR_UBUF);
    const float* cw = k.sc_conv + (size_t)j * 3 * 1024;
    for (int r = blockIdx.x * 8 + wave; r < T; r += gridDim.x * 8) {
        bool lok, rok;
        if (r < TC) { const int t = r & 255; lok = t != 0; rok = t != 255; } else { const int t = (r - TC) & 63; lok = t != 0; rok = t != 63; }
        const bf16_t* p = P + (size_t)r * 3072;
#pragma unroll 4
        for (int m = 0; m < 16; ++m) {
            const int col = lane + 64 * m;
            const float bg = bf2f(p[col]);
            const float mc = bf2f(p[1024 + col]) * bf2f(p[2048 + col]);
            const float ml = lok ? bf2f(p[-3072 + 1024 + col]) * bf2f(p[-3072 + 2048 + col]) : 0.f;
            const float mrr = rok ? bf2f(p[3072 + 1024 + col]) * bf2f(p[3072 + 2048 + col]) : 0.f;
            U[(size_t)r * 1024 + col] = f2bf(bg * (cw[col] * ml + cw[1024 + col] * mc + cw[2048 + col] * mrr));
        }
    }
}

constexpr int DN_STEPS = 260, DN_UNITS = 32 * DN_STEPS;
DI int dn_rbase(int b, int dir, int s) {
    if (s < 4) return dir == 0 ? b * 256 + s * 64 : b * 256 + 255 - s * 64;
    const int cc = s - 4;
    return dir == 0 ? TC + b * SEQ + cc * 64 : TC + b * SEQ + SEQ - 1 - cc * 64;
}
PF void dn_chunk(const KC& k, int jl, LAS unsigned char* lds) {
    const int tid = TID(), lane = tid & 63, wave = tid >> 6, fr = lane & 15, fq = lane >> 4;
    LAS bf16_t* Kt = (LAS bf16_t*)lds;
    LAS bf16_t* Qt = Kt + 64 * 136;
    LAS bf16_t* Vt = Qt + 64 * 136;
    LAS float* Amat = (LAS float*)(Vt + 64 * 136);
    LAS bf16_t* Tb = (LAS bf16_t*)(Amat + 64 * 64);
    LAS bf16_t* VbT = Tb + 64 * 72;
    LAS bf16_t* KbT = VbT + 128 * 72;
    LAS float* gcs = (LAS float*)(KbT + 128 * 72);
    LAS float* bet = gcs + 64; LAS float* eg = bet + 64; LAS float* egr = eg + 64;
    LAS float* Tm = egr + 64;
    const bf16_t* P = (const bf16_t*)(k.ws + AR_PB);
    const float* gb = (const float*)(k.ws + WS_GB);
    const float* cw = k.dn_conv + (size_t)jl * 3 * 3072;
    bf16_t* CH = (bf16_t*)(k.ws + AR_CHUNK);
    bf16_t* ATT = (bf16_t*)(k.ws + AR_HBUF);
    float* EGL = (float*)(k.ws + WS_EGL);
    for (int u = blockIdx.x; u < DN_UNITS; u += gridDim.x) {
        const int chain = u / DN_STEPS, s = u - chain * DN_STEPS, dir = chain & 1, h = (chain >> 1) & 7, b = chain >> 4;
        const int rbase = dn_rbase(b, dir, s), rstep = dir == 0 ? 1 : -1;
        bf16_t* cW = CH + (size_t)u * 32768; bf16_t* cQd = cW + 8192; bf16_t* cKd = cQd + 8192; bf16_t* cU = cKd + 8192;
        bf16_t* cAt = ATT + (size_t)u * 4096;
        lds_barrier();
        {
            const int i = tid >> 3, sg = tid & 7, r = rbase + rstep * i;
            bool lok, rok;
            if (r < TC) { const int t = r & 255; lok = t != 0; rok = t != 255; } else { const int t = (r - TC) & 63; lok = t != 0; rok = t != 63; }
#pragma unroll 1
            for (int part = 0; part < 3; ++part) {
                const int col = part * 1024 + h * 128 + sg * 16;
                const bf16_t* pc = P + (size_t)r * 3072 + col;
                float v[16];
#pragma unroll
                for (int hf = 0; hf < 2; ++hf) {
                    const u32x4 c4 = *(const u32x4*)(pc + hf * 8);
                    u32x4 l4 = (u32x4){0u, 0u, 0u, 0u}, r4 = (u32x4){0u, 0u, 0u, 0u};
                    if (lok) l4 = *(const u32x4*)(pc - 3072 + hf * 8);
                    if (rok) r4 = *(const u32x4*)(pc + 3072 + hf * 8);
#pragma unroll
                    for (int w = 0; w < 4; ++w) {
#pragma unroll
                        for (int e = 0; e < 2; ++e) {
                            const int cc = col + hf * 8 + 2 * w + e;
                            const float lv = __uint_as_float(e ? (l4[w] & 0xffff0000u) : (l4[w] << 16));
                            const float cv = __uint_as_float(e ? (c4[w] & 0xffff0000u) : (c4[w] << 16));
                            const float rv = __uint_as_float(e ? (r4[w] & 0xffff0000u) : (r4[w] << 16));
                            v[hf * 8 + 2 * w + e] = siluf(cw[cc] * lv + cw[3072 + cc] * cv + cw[6144 + cc] * rv);
                        }
                    }
                }
                if (part < 2) {
                    float ss = 0.f;
#pragma unroll
                    for (int e = 0; e < 16; ++e) ss += v[e] * v[e];
                    ss += __shfl_xor(ss, 1); ss += __shfl_xor(ss, 2); ss += __shfl_xor(ss, 4);
                    const float sc = rsqrtf(ss + EPS) * (part == 0 ? 0.08838834764831845f : 1.0f);
#pragma unroll
                    for (int e = 0; e < 16; ++e) v[e] *= sc;
                }
                LAS bf16_t* dst = (part == 0 ? Qt : (part == 1 ? Kt : Vt)) + i * 136 + sg * 16;
                u32x4 o0, o1;
#pragma unroll
                for (int w = 0; w < 4; ++w) { o0[w] = pk2(v[2 * w], v[2 * w + 1]); o1[w] = pk2(v[8 + 2 * w], v[8 + 2 * w + 1]); }
                *(LAS u32x4*)dst = o0; *(LAS u32x4*)(dst + 8) = o1;
            }
        }
        if (wave == 0) {
            const size_t row = (size_t)(rbase + rstep * lane);
            float g = gb[row * 32 + dir * 8 + h];
            const float be = gb[row * 32 + 16 + dir * 8 + h];
#pragma unroll
            for (int d = 1; d < 64; d <<= 1) { const float o = __shfl_up(g, d); if (lane >= d) g += o; }
            const float glast = __shfl(g, 63);
            gcs[lane] = g; bet[lane] = be; eg[lane] = expf(g); egr[lane] = expf(glast - g);
            if (lane == 0) EGL[u] = expf(glast);
        }
        lds_barrier();
#pragma unroll 1
        for (int x = 0; x < 4; ++x) {
            const int t = wave + 8 * x, isq = t >> 4, mt = (t >> 2) & 3, nt = t & 3;
            f32x4 acc = (f32x4){0.f, 0.f, 0.f, 0.f};
            if (mt >= nt) {
                const LAS bf16_t* Ar = (isq ? Qt : Kt) + (16 * mt + fr) * 136 + 8 * fq;
                const LAS bf16_t* Br = Kt + (16 * nt + fr) * 136 + 8 * fq;
#pragma unroll
                for (int ks = 0; ks < 4; ++ks) acc = __builtin_amdgcn_mfma_f32_16x16x32_bf16(*(const LAS bf16x8*)(Ar + 32 * ks), *(const LAS bf16x8*)(Br + 32 * ks), acc, 0, 0, 0);
            }
            const int jc = 16 * nt + fr; const float gj = gcs[jc];
#pragma unroll
            for (int jj = 0; jj < 4; ++jj) {
                const int ir = 16 * mt + 4 * fq + jj;
                const float dec = expf(fminf(gcs[ir] - gj, 0.f));
                if (isq) cAt[ir * 64 + jc] = f2bf(ir >= jc ? acc[jj] * dec : 0.f);
                else Amat[ir * 64 + jc] = ir > jc ? bet[ir] * acc[jj] * dec : 0.f;
            }
        }
        lds_barrier();
        if (wave < 4) {
            if (lane < 16) {
                const int bo = 16 * wave;
                float tc[16];
#pragma unroll
                for (int i = 0; i < 16; ++i) {
                    float a0 = (i == lane) ? 1.f : 0.f, a1 = 0.f;
#pragma unroll
                    for (int j = 0; j < i; ++j) { const float av = Amat[(bo + i) * 64 + bo + j]; if (j & 1) a1 -= av * tc[j]; else a0 -= av * tc[j]; }
                    tc[i] = a0 + a1;
                    Tm[(bo + i) * 64 + bo + lane] = tc[i];
                }
            }
        } else {
            for (int it = tid - 256; it < 1024; it += 256) {
                const int c = it & 127, ig = it >> 7;
                float kv[8], vv[8];
#pragma unroll
                for (int e = 0; e < 8; ++e) { kv[e] = bf2f(Kt[(8 * ig + e) * 136 + c]); vv[e] = bf2f(Vt[(8 * ig + e) * 136 + c]); }
                u32x4 ov, ok, od;
#pragma unroll
                for (int w = 0; w < 4; ++w) {
                    const int i0 = 8 * ig + 2 * w, i1 = i0 + 1;
                    ov[w] = pk2(bet[i0] * vv[2 * w], bet[i1] * vv[2 * w + 1]);
                    ok[w] = pk2(bet[i0] * eg[i0] * kv[2 * w], bet[i1] * eg[i1] * kv[2 * w + 1]);
                    od[w] = pk2(egr[i0] * kv[2 * w], egr[i1] * kv[2 * w + 1]);
                }
                *(LAS u32x4*)(VbT + c * 72 + 8 * ig) = ov;
                *(LAS u32x4*)(KbT + c * 72 + 8 * ig) = ok;
                *(u32x4*)(cKd + c * 64 + 8 * ig) = od;
            }
            for (int it = tid - 256; it < 1024; it += 256) {
                const int i = it >> 4, c8 = (it & 15) * 8; const float e = eg[i];
                const u32x4 qv = *(const LAS u32x4*)(Qt + i * 136 + c8); u32x4 o;
#pragma unroll
                for (int w = 0; w < 4; ++w) o[w] = pk2(__uint_as_float(qv[w] << 16) * e, __uint_as_float(qv[w] & 0xffff0000u) * e);
                *(u32x4*)(cQd + i * 128 + c8) = o;
            }
        }
        lds_barrier();
#pragma unroll 1
        for (int d = 1; d < 4; ++d) {
            if (wave < 4 - d) {
                const int bi = wave + d, bj = wave, r = lane >> 2, c0 = 4 * (lane & 3);
                f32x4 m = (f32x4){0.f, 0.f, 0.f, 0.f};
                for (int kb = bj; kb < bi; ++kb) {
#pragma unroll
                    for (int kk = 0; kk < 16; ++kk) {
                        const float av = Amat[(16 * bi + r) * 64 + 16 * kb + kk];
                        const f32x4 tv = *(const LAS f32x4*)(Tm + (16 * kb + kk) * 64 + 16 * bj + c0);
                        m += tv * av;
                    }
                }
                *(LAS f32x4*)(Tm + (16 * bj + r) * 64 + 16 * bi + c0) = m;
                f32x4 t = (f32x4){0.f, 0.f, 0.f, 0.f};
#pragma unroll
                for (int kk = 0; kk < 16; ++kk) {
                    const float dv = Tm[(16 * bi + r) * 64 + 16 * bi + kk];
                    const f32x4 mv = *(const LAS f32x4*)(Tm + (16 * bj + kk) * 64 + 16 * bi + c0);
                    t -= mv * dv;
                }
                *(LAS f32x4*)(Tm + (16 * bi + r) * 64 + 16 * bj + c0) = t;
            }
            lds_barrier();
        }
        for (int it = tid; it < 64 * 8; it += NTHR) {
            const int i = it >> 3, c8 = (it & 7) * 8; u32x4 o;
#pragma unroll
            for (int w = 0; w < 4; ++w) {
                const int c = c8 + 2 * w;
                o[w] = pk2(c <= i ? Tm[i * 64 + c] : 0.f, c + 1 <= i ? Tm[i * 64 + c + 1] : 0.f);
            }
            *(LAS u32x4*)(Tb + i * 72 + c8) = o;
        }
        lds_barrier();
        {
            f32x4 au[4], aw[4];
#pragma unroll
            for (int mt = 0; mt < 4; ++mt) { au[mt] = (f32x4){0.f, 0.f, 0.f, 0.f}; aw[mt] = (f32x4){0.f, 0.f, 0.f, 0.f}; }
#pragma unroll
            for (int ks = 0; ks < 2; ++ks) {
                const bf16x8 bv = *(const LAS bf16x8*)(VbT + (16 * wave + fr) * 72 + 32 * ks + 8 * fq);
                const bf16x8 bk = *(const LAS bf16x8*)(KbT + (16 * wave + fr) * 72 + 32 * ks + 8 * fq);
#pragma unroll
                for (int mt = 0; mt < 4; ++mt) {
                    const bf16x8 at = *(const LAS bf16x8*)(Tb + (16 * mt + fr) * 72 + 32 * ks + 8 * fq);
                    au[mt] = __builtin_amdgcn_mfma_f32_16x16x32_bf16(at, bv, au[mt], 0, 0, 0);
                    aw[mt] = __builtin_amdgcn_mfma_f32_16x16x32_bf16(at, bk, aw[mt], 0, 0, 0);
                }
            }
#pragma unroll
            for (int mt = 0; mt < 4; ++mt)
#pragma unroll
                for (int jj = 0; jj < 4; ++jj) {
                    const int ir = 16 * mt + 4 * fq + jj, c = 16 * wave + fr;
                    cU[ir * 128 + c] = f2bf(au[mt][jj]); cW[ir * 128 + c] = f2bf(aw[mt][jj]);
                }
        }
    }
}
constexpr int SC_W = 0, SC_QD = 64 * 136, SC_KD = SC_QD + 64 * 136, SC_AT = SC_KD + 128 * 72, SC_U = SC_AT + 64 * 72, SC_STAGE = SC_U + 16 * 72;
struct ScanRegs { u32x4 v[8]; u32x4 u; };
DI void dn_scan_fetch(const bf16_t* CH, const bf16_t* ATT, int u, int sl, int lt, ScanRegs& R) {
    const bf16_t* cW = CH + (size_t)u * 32768; const bf16_t* cAt = ATT + (size_t)u * 4096;
#pragma unroll
    for (int q = 0; q < 8; ++q) {
        const int id = lt + 448 * q;
        const bf16_t* src;
        if (id < 2048) src = cW + id * 8;
        else if (id < 3072) src = cW + 16384 + (id - 2048) * 8;
        else src = cAt + (id - 3072) * 8;
        R.v[q] = *(const u32x4*)src;
    }
    if (lt < 128) R.u = *(const u32x4*)(cW + 24576 + (lt >> 1) * 128 + sl * 16 + (lt & 1) * 8);
}
DI void dn_scan_put(LAS bf16_t* st, int lt, const ScanRegs& R) {
#pragma unroll
    for (int q = 0; q < 8; ++q) {
        const int id = lt + 448 * q;
        int off;
        if (id < 2048) { const int which = id >> 10, x = id & 1023; off = (which ? SC_QD : SC_W) + (x >> 4) * 136 + (x & 15) * 8; }
        else if (id < 3072) { const int x = id - 2048; off = SC_KD + (x >> 3) * 72 + (x & 7) * 8; }
        else { const int x = id - 3072; off = SC_AT + (x >> 3) * 72 + (x & 7) * 8; }
        *(LAS u32x4*)(st + off) = R.v[q];
    }
    if (lt < 128) {
        const int i = lt >> 1, hf = lt & 1;
#pragma unroll
        for (int w = 0; w < 4; ++w) { st[SC_U + (hf * 8 + 2 * w) * 72 + i] = (bf16_t)(R.u[w] & 0xffff); st[SC_U + (hf * 8 + 2 * w + 1) * 72 + i] = (bf16_t)(R.u[w] >> 16); }
    }
}
DI bf16x8 ld2(const LAS bf16_t* p0, const LAS bf16_t* p1) {
    const u32x2 a = *(const LAS u32x2*)p0, b = *(const LAS u32x2*)p1;
    u32x4 r; r[0] = a[0]; r[1] = a[1]; r[2] = b[0]; r[3] = b[1];
    return __builtin_bit_cast(bf16x8, r);
}
DI bf16x8 pk8(f32x4 a, f32x4 b) { u32x4 r; r[0] = pk2(a[0], a[1]); r[1] = pk2(a[2], a[3]); r[2] = pk2(b[0], b[1]); r[3] = pk2(b[2], b[3]); return __builtin_bit_cast(bf16x8, r); }
PF void dn_scan(const KC& k, LAS unsigned char* lds) {
    const int tid = TID(), lane = tid & 63, wave = tid >> 6, fr = lane & 15, fq = lane >> 4;
    LAS bf16_t* ring = (LAS bf16_t*)lds;
    const bf16_t* CH = (const bf16_t*)(k.ws + AR_CHUNK);
    const bf16_t* ATT = (const bf16_t*)(k.ws + AR_HBUF);
    const float* EGL = (const float*)(k.ws + WS_EGL);
    bf16_t* O = (bf16_t*)(k.ws + AR_PB);
    for (int un0 = blockIdx.x; un0 < 256; un0 += gridDim.x) {
        const int un = (gridDim.x == 256) ? ((un0 & 7) * 32 + (un0 >> 3)) : un0;
        const int sl = un & 7, chain = un >> 3, dir = chain & 1, h = (chain >> 1) & 7, b = chain >> 4;
        const int rstep = dir == 0 ? 1 : -1;
        f32x4 S[8];
#pragma unroll
        for (int t = 0; t < 8; ++t) S[t] = (f32x4){0.f, 0.f, 0.f, 0.f};
        ScanRegs R;
        lds_barrier();
        if (wave > 0) { dn_scan_fetch(CH, ATT, chain * DN_STEPS, sl, tid - 64, R); dn_scan_put(ring, tid - 64, R); dn_scan_fetch(CH, ATT, chain * DN_STEPS + 1, sl, tid - 64, R); }
        lds_barrier();
#pragma unroll 1
        for (int s = 0; s < DN_STEPS; ++s) {
            LAS bf16_t* st = ring + (s & 1) * SC_STAGE;
            if (wave > 0) {
                if (s + 1 < DN_STEPS) dn_scan_put(ring + ((s + 1) & 1) * SC_STAGE, tid - 64, R);
                if (s + 2 < DN_STEPS) dn_scan_fetch(CH, ATT, chain * DN_STEPS + s + 2, sl, tid - 64, R);
            } else {
                const float egl = EGL[chain * DN_STEPS + s];
                bf16x8 sb[4];
#pragma unroll
                for (int ks = 0; ks < 4; ++ks) sb[ks] = pk8(S[2 * ks], S[2 * ks + 1]);
                bf16x8 vb[2]; f32x4 vn[4];
#pragma unroll
                for (int mt = 0; mt < 4; ++mt) {
                    f32x4 p = (f32x4){0.f, 0.f, 0.f, 0.f};
                    const LAS bf16_t* wr = st + SC_W + (16 * mt + fr) * 136 + 4 * fq;
#pragma unroll
                    for (int ks = 0; ks < 4; ++ks) p = __builtin_amdgcn_mfma_f32_16x16x32_bf16(ld2(wr + 32 * ks, wr + 32 * ks + 16), sb[ks], p, 0, 0, 0);
                    const u32x2 uu = *(const LAS u32x2*)(st + SC_U + fr * 72 + 16 * mt + 4 * fq);
                    vn[mt][0] = __uint_as_float(uu[0] << 16) - p[0]; vn[mt][1] = __uint_as_float(uu[0] & 0xffff0000u) - p[1];
                    vn[mt][2] = __uint_as_float(uu[1] << 16) - p[2]; vn[mt][3] = __uint_as_float(uu[1] & 0xffff0000u) - p[3];
                }
                vb[0] = pk8(vn[0], vn[1]); vb[1] = pk8(vn[2], vn[3]);
                const int rbase = dn_rbase(b, dir, s);
#pragma unroll
                for (int mt = 0; mt < 4; ++mt) {
                    f32x4 o = (f32x4){0.f, 0.f, 0.f, 0.f};
                    const LAS bf16_t* qr = st + SC_QD + (16 * mt + fr) * 136 + 4 * fq;
#pragma unroll
                    for (int ks = 0; ks < 4; ++ks) o = __builtin_amdgcn_mfma_f32_16x16x32_bf16(ld2(qr + 32 * ks, qr + 32 * ks + 16), sb[ks], o, 0, 0, 0);
                    const LAS bf16_t* ar = st + SC_AT + (16 * mt + fr) * 72 + 4 * fq;
#pragma unroll
                    for (int kc = 0; kc < 2; ++kc) o = __builtin_amdgcn_mfma_f32_16x16x32_bf16(ld2(ar + 32 * kc, ar + 32 * kc + 16), vb[kc], o, 0, 0, 0);
#pragma unroll
                    for (int jj = 0; jj < 4; ++jj) {
                        const int row = rbase + rstep * (16 * mt + 4 * fq + jj);
                        O[((size_t)dir * T + row) * 1024 + h * 128 + sl * 16 + fr] = f2bf(o[jj]);
                    }
                }
#pragma unroll
                for (int t = 0; t < 8; ++t) {
                    f32x4 a = S[t] * egl;
                    const LAS bf16_t* kr = st + SC_KD + (16 * t + fr) * 72 + 4 * fq;
#pragma unroll
                    for (int kc = 0; kc < 2; ++kc) a = __builtin_amdgcn_mfma_f32_16x16x32_bf16(ld2(kr + 32 * kc, kr + 32 * kc + 16), vb[kc], a, 0, 0, 0);
                    S[t] = a;
                }
            }
            lds_barrier();
        }
    }
}
PF void dn_finish(const KC& k, int j) {
    const int tid = TID(), lane = tid & 63, wave = tid >> 6;
    const bf16_t* O = (const bf16_t*)(k.ws + AR_PB);
    const bf16_t* Z = (const bf16_t*)k.out;
    bf16_t* U = (bf16_t*)(k.ws + AR_UBUF);
    const float* on = k.dn_out_norm + j * 128;
    for (int r = blockIdx.x * 8 + wave; r < T; r += gridDim.x * 8) {
        float o[16];
#pragma unroll
        for (int m = 0; m < 16; ++m) o[m] = bf2f(O[(size_t)r * 1024 + lane + 64 * m]) + bf2f(O[((size_t)T + r) * 1024 + lane + 64 * m]);
#pragma unroll
        for (int hh = 0; hh < 8; ++hh) {
            const float ss = wsum(o[2 * hh] * o[2 * hh] + o[2 * hh + 1] * o[2 * hh + 1]);
            const float rs = rsqrtf(ss * (1.0f / 128.0f) + EPS);
#pragma unroll
            for (int q = 0; q < 2; ++q) {
                const int m = 2 * hh + q, col = lane + 64 * m;
                const float z = bf2f(Z[(size_t)r * 1024 + col]);
                U[(size_t)r * 1024 + col] = f2bf(o[m] * rs * on[col & 127] * siluf(z));
            }
        }
    }
}

DI float conv3g(const bf16_t* p, int j, float w0, float w1, float w2) {
    const int gc = j & 63;
    const float l = gc != 0 ? bf2f(p[j - 1]) : 0.f, c = bf2f(p[j]), r = gc != 63 ? bf2f(p[j + 1]) : 0.f;
    return w0 * l + w1 * c + w2 * r;
}
PF void hy_lat(const KC& k, int jl, LAS float* ldsf) {
    const int tid = TID();
    LAS cf* X = (LAS cf*)ldsf;
    LAS cf* tw = X + 17408;
    const float* FT = (const float*)(k.ws + AR_FT);
    const bf16_t* PT = (const bf16_t*)(k.ws + AR_PB);
    bf16_t* ZT = (bf16_t*)(k.ws + AR_ZT);
    cf* scr = (cf*)(k.ws + AR_FFTS) + (size_t)blockIdx.x * 4 * 16384;
    cf* sKe = scr; cf* sKo = scr + 16384; cf* zp = scr + 2 * 16384; cf* ye = scr + 3 * 16384;
    const float* cw = k.hy_conv + (size_t)jl * 3 * 3072;
    for (int m = 0; m < 2; ++m) { const int p = tid + 512 * m; float sn, cs; sincospif(-(float)p / 8192.0f, &sn, &cs); cf w; w.x = cs; w.y = sn; tw[p] = w; }
    __syncthreads();
    for (int ch = blockIdx.x; ch < 1024; ch += gridDim.x) {
        {
            const bf16_t* pv = PT + (size_t)ch * T + TC;
            const float w0 = cw[ch], w1 = cw[3072 + ch], w2 = cw[6144 + ch];
            _Pragma("unroll 1") for (int m = 0; m < 32; ++m) { const int j = tid + 512 * m; cf z; z.x = conv3g(pv, j, w0, w1, w2); z.y = conv3g(pv + SEQ, j, w0, w1, w2); zp[j] = z; }
        }
        for (int n = 0; n < 2; ++n) {
            __syncthreads();
            const float* ftf = FT + (size_t)(n * 2048 + ch) * 16384; const float* ftb = FT + (size_t)(n * 2048 + 1024 + ch) * 16384;
            _Pragma("unroll 1") for (int m = 0; m < 32; ++m) {
                const int j = tid + 512 * m;
                const float hf = ftf[j], hb = j > 0 ? ftb[SEQ - j] : 0.f;
                float sn, cs; sincospif(-(float)j / 16384.0f, &sn, &cs);
                cf a; a.x = hf + hb; a.y = 0.f; X[PIDX(j)] = a;
                const float kd = hf - hb; cf o; o.x = kd * cs; o.y = kd * sn; sKo[j] = o;
            }
            __syncthreads();
            fft16k_fwd(X, tw);
            _Pragma("unroll 1") for (int m = 0; m < 32; ++m) { const int j = tid + 512 * m; sKe[j] = X[PIDX(j)]; }
            __syncthreads();
            _Pragma("unroll 1") for (int m = 0; m < 32; ++m) { const int j = tid + 512 * m; X[PIDX(j)] = sKo[j]; }
            __syncthreads();
            fft16k_fwd(X, tw);
            _Pragma("unroll 1") for (int m = 0; m < 32; ++m) { const int j = tid + 512 * m; sKo[j] = X[PIDX(j)]; }
            __syncthreads();
            _Pragma("unroll 1") for (int m = 0; m < 32; ++m) { const int j = tid + 512 * m; X[PIDX(j)] = zp[j]; }
            __syncthreads();
            fft16k_fwd(X, tw);
            _Pragma("unroll 1") for (int m = 0; m < 32; ++m) { const int j = tid + 512 * m; X[PIDX(j)] = cmul(X[PIDX(j)], sKe[j]); }
            __syncthreads();
            fft16k_inv(X, tw);
            _Pragma("unroll 1") for (int m = 0; m < 32; ++m) { const int j = tid + 512 * m; ye[j] = X[PIDX(j)]; }
            __syncthreads();
            _Pragma("unroll 1") for (int m = 0; m < 32; ++m) { const int j = tid + 512 * m; float sn, cs; sincospif(-(float)j / 16384.0f, &sn, &cs); cf w; w.x = cs; w.y = sn; X[PIDX(j)] = cmul(zp[j], w); }
            __syncthreads();
            fft16k_fwd(X, tw);
            _Pragma("unroll 1") for (int m = 0; m < 32; ++m) { const int j = tid + 512 * m; X[PIDX(j)] = cmul(X[PIDX(j)], sKo[j]); }
            __syncthreads();
            fft16k_inv(X, tw);
            {
                const bf16_t* pg = PT + (size_t)((n + 1) * 1024 + ch) * T + TC;
                const int gcol = (n + 1) * 1024 + ch;
                const float w0 = cw[gcol], w1 = cw[3072 + gcol], w2 = cw[6144 + gcol];
                const float bias = k.hy_bias[(size_t)jl * 2 * 1024 + n * 1024 + ch];
                _Pragma("unroll 1") for (int m = 0; m < 32; ++m) {
                    const int j = tid + 512 * m;
                    float sn, cs; sincospif((float)j / 16384.0f, &sn, &cs); cf w; w.x = cs; w.y = sn;
                    const cf yo = cmul(X[PIDX(j)], w); const cf e = ye[j]; const cf zprev = zp[j];
                    const float y0 = (0.5f / 16384.0f) * (e.x + yo.x), y1 = (0.5f / 16384.0f) * (e.y + yo.y);
                    cf zn; zn.x = conv3g(pg, j, w0, w1, w2) * (y0 + bias * zprev.x); zn.y = conv3g(pg + SEQ, j, w0, w1, w2) * (y1 + bias * zprev.y);
                    zp[j] = zn;
                }
            }
        }
        _Pragma("unroll 1") for (int m = 0; m < 32; ++m) { const int j = tid + 512 * m; const cf z = zp[j]; ZT[(size_t)ch * T + TC + j] = f2bf(z.x); ZT[(size_t)ch * T + TC + SEQ + j] = f2bf(z.y); }
        __syncthreads();
    }
}
PF void hy_ctx(const KC& k, int jl, LAS float* lds) {
    const int tid = TID(), t = tid & 255, hsel = tid >> 8;
    LAS float* z = lds + hsel * 768; LAS float* hf = z + 256; LAS float* hb = hf + 256;
    const bf16_t* PT = (const bf16_t*)(k.ws + AR_PB);
    bf16_t* U = (bf16_t*)(k.ws + AR_UBUF);
    const float* filtc = (const float*)(k.ws + WS_FILTC);
    const float* cw = k.hy_conv + (size_t)jl * 3 * 3072;
    for (int u = blockIdx.x; u < 1024; u += gridDim.x) {
        const int pr = u * 2 + hsel, b = pr >> 10, ch = pr & 1023;
        float zc;
        {
            const bf16_t* pv = PT + (size_t)ch * T + b * 256;
            const float l = t != 0 ? bf2f(pv[t - 1]) : 0.f, c = bf2f(pv[t]), r = t != 255 ? bf2f(pv[t + 1]) : 0.f;
            zc = cw[ch] * l + cw[3072 + ch] * c + cw[6144 + ch] * r;
        }
        for (int n = 0; n < 2; ++n) {
            __syncthreads();
            z[t] = zc; hf[t] = filtc[(size_t)t * 4096 + n * 2048 + ch]; hb[t] = filtc[(size_t)t * 4096 + n * 2048 + 1024 + ch];
            __syncthreads();
            float y = 0.f;
            for (int s = 0; s <= t; ++s) y += hf[t - s] * z[s];
            for (int s = t + 1; s < 256; ++s) y += hb[s - t] * z[s];
            const int gcol = (n + 1) * 1024 + ch;
            const bf16_t* pg = PT + (size_t)gcol * T + b * 256;
            const float l = t != 0 ? bf2f(pg[t - 1]) : 0.f, c = bf2f(pg[t]), r = t != 255 ? bf2f(pg[t + 1]) : 0.f;
            const float gate = cw[gcol] * l + cw[3072 + gcol] * c + cw[6144 + gcol] * r;
            zc = gate * (y + k.hy_bias[(size_t)jl * 2048 + n * 1024 + ch] * zc);
        }
        U[(size_t)(b * 256 + t) * 1024 + ch] = f2bf(zc);
        __syncthreads();
    }
}
PF void hy_transpose(const KC& k, LAS bf16_t* lds) {
    const int tid = TID();
    const bf16_t* ZT = (const bf16_t*)(k.ws + AR_ZT);
    bf16_t* U = (bf16_t*)(k.ws + AR_UBUF);
    for (int u = blockIdx.x; u < 16 * (TL / 64); u += gridDim.x) {
        const int c0 = (u & 15) * 64, r0 = TC + (u >> 4) * 64;
        { const int c = tid >> 3, sg = (tid & 7) * 8;
          const u32x4 v = *(const u32x4*)(ZT + (size_t)(c0 + c) * T + r0 + sg);
#pragma unroll
          for (int w = 0; w < 4; ++w) { lds[(sg + 2 * w) * 66 + c] = (bf16_t)(v[w] & 0xffff); lds[(sg + 2 * w + 1) * 66 + c] = (bf16_t)(v[w] >> 16); } }
        __syncthreads();
        { const int r = tid >> 3, sg = (tid & 7) * 8; u32x4 o;
#pragma unroll
          for (int w = 0; w < 4; ++w) o[w] = (unsigned)lds[r * 66 + sg + 2 * w] | ((unsigned)lds[r * 66 + sg + 2 * w + 1] << 16);
          *(u32x4*)(U + (size_t)(r0 + r) * 1024 + c0 + sg) = o; }
        __syncthreads();
    }
}

__global__ void __launch_bounds__(NTHR, 2) fwd_kernel(Params prm) {
    extern __shared__ __attribute__((aligned(16))) unsigned char lds_raw[];
    LAS unsigned char* lds = (LAS unsigned char*)lds_raw;
    LAS float* ldsf = (LAS float*)lds;
    LAS bf16_t* ldsh = (LAS bf16_t*)lds;
    LAS int* tb = (LAS int*)(lds + 150 * 1024);
    volatile LAS unsigned* xbw = (volatile LAS unsigned*)(lds + 151 * 1024 + 512);
    KC k;
    k.x = (const float*)(GAS const float*)prm.in[0]; k.c = (const float*)(GAS const float*)prm.in[1]; k.ctx = (const float*)(GAS const float*)prm.in[2]; k.c_ctx = (const float*)(GAS const float*)prm.in[3]; k.ada_w = (const float*)(GAS const float*)prm.in[4]; k.ada_b = (const float*)(GAS const float*)prm.in[5];
    k.norm_mix = (const float*)(GAS const float*)prm.in[6]; k.norm_ffn = (const float*)(GAS const float*)prm.in[7]; k.norm_final = (const float*)(GAS const float*)prm.in[8];
    k.dn_w_in = (const float*)(GAS const float*)prm.in[9]; k.dn_conv = (const float*)(GAS const float*)prm.in[10]; k.dn_a_log = (const float*)(GAS const float*)prm.in[11]; k.dn_dt_bias = (const float*)(GAS const float*)prm.in[12]; k.dn_out_norm = (const float*)(GAS const float*)prm.in[13]; k.dn_w_out = (const float*)(GAS const float*)prm.in[14];
    k.hy_w_in = (const float*)(GAS const float*)prm.in[15]; k.hy_conv = (const float*)(GAS const float*)prm.in[16]; k.hy_f_w1 = (const float*)(GAS const float*)prm.in[17]; k.hy_f_b1 = (const float*)(GAS const float*)prm.in[18]; k.hy_f_freq = (const float*)(GAS const float*)prm.in[19]; k.hy_f_w2 = (const float*)(GAS const float*)prm.in[20];
    k.hy_f_b2 = (const float*)(GAS const float*)prm.in[21]; k.hy_f_w3 = (const float*)(GAS const float*)prm.in[22]; k.hy_bias = (const float*)(GAS const float*)prm.in[23]; k.hy_w_out = (const float*)(GAS const float*)prm.in[24];
    k.sc_w_in = (const float*)(GAS const float*)prm.in[25]; k.sc_conv = (const float*)(GAS const float*)prm.in[26]; k.sc_w_out = (const float*)(GAS const float*)prm.in[27]; k.w_router = (const float*)(GAS const float*)prm.in[28]; k.router_bias = (const float*)(GAS const float*)prm.in[29];
    k.moe_w_gate = (const float*)(GAS const float*)prm.in[30]; k.moe_w_up = (const float*)(GAS const float*)prm.in[31]; k.moe_w_down = (const float*)(GAS const float*)prm.in[32];
    k.out = (float*)(GAS float*)prm.out; k.ws = (unsigned char*)(GAS unsigned char*)prm.ws;
    const int lo = prm.ph_lo, hi = prm.ph_hi;
    XcdBarrier bar; bar.bar = (unsigned*)(k.ws + WS_CTL); bar.x = 0; bar.st = xbw;
    if (hi - lo > 1) {
        if (threadIdx.x == 0) { xbw[0] = 0u; xbw[1] = 0u; }
        __syncthreads();
        bar = xcd_barrier_post((unsigned*)(k.ws + WS_CTL), xbw);
    }
    int ph = 0;
#define PROBE_OK(id) ((id) != 1 || i == 0)
    int i = 0;
#define PH_BEGIN(id) if (ph >= lo && ph < hi) { const int nrep_ = (((id) == PROBE_REP) && PROBE_OK(id)) ? 2 : 1; for (int rep_ = 0; rep_ < nrep_; ++rep_) { { GAS unsigned char* w_ = (GAS unsigned char*)k.ws; asm volatile("" : "+s"(w_)); k.ws = (unsigned char*)w_; }
#define PH_END   if (ph + 1 < hi) xcd_barrier(bar); } } ++ph;

    float* xs = (float*)(k.ws + WS_XS);
    const float* mod = (const float*)(k.ws + WS_MOD);

    PH_BEGIN(0)
        job_mod(k, ldsf);
        job_cvt_small(k, ldsf);
        job_hdn(k, ldsf);
        job_w3s(k);
    PH_END

    for (i = 0; i < DEPTH; ++i) {
        const int kind = i % 3, j = i / 3;
        const bool last = (i == DEPTH - 1);
        PH_BEGIN(1)
            if (kind == 0) norm_phase<2>(k, i, i == 0, i > 0, k.norm_mix + i * 1024, 0, k.dn_w_in + (size_t)j * 1024 * DN_IN + 4096, DN_IN,
                                         k.dn_a_log + j * 16, k.dn_dt_bias + j * 16, last, ldsf);
            else norm_phase<0>(k, i, i == 0, i > 0, k.norm_mix + i * 1024, 0, nullptr, 0, nullptr, nullptr, last, ldsf);
            if (kind == 1) job_filtc(k, j);
        PH_END
        PH_BEGIN(2)
            if (kind == 0) { EpiDnSplit e{(bf16_t*)(k.ws + AR_PB), (bf16_t*)k.out}; gemm_dense(ldsh, (const bf16_t*)(k.ws + AR_HBUF), T, (const bf16_t*)(k.ws + WS_DNWIN) + (size_t)j * 4096 * 1024, 4096, 1024, e); }
            else if (kind == 1) { EpiBf16T e{(bf16_t*)(k.ws + AR_PB), T}; gemm_dense(ldsh, (const bf16_t*)(k.ws + AR_HBUF), T, (const bf16_t*)(k.ws + WS_HYWIN), 3072, 1024, e);
                                  EpiTaps et{(float*)(k.ws + AR_FT)}; gemm_dense(ldsh, (const bf16_t*)(k.ws + WS_W3S), 4096, (const bf16_t*)(k.ws + WS_HS), 16384, 192, et); }
            else { EpiBf16 e{(bf16_t*)(k.ws + AR_PB), 3072}; gemm_dense(ldsh, (const bf16_t*)(k.ws + AR_HBUF), T, (const bf16_t*)(k.ws + WS_SCWIN), 3072, 1024, e); }
        PH_END
        if (kind == 0) {
            PH_BEGIN(3) dn_chunk(k, j, lds); PH_END
            PH_BEGIN(4) dn_scan(k, lds); PH_END
            PH_BEGIN(5) dn_finish(k, j); PH_END
        } else if (kind == 1) {
            PH_BEGIN(6) hy_lat(k, j, ldsf); hy_ctx(k, j, ldsf); PH_END
            PH_BEGIN(7) hy_transpose(k, ldsh); PH_END
        } else {
            PH_BEGIN(8) sc_mix(k, j); PH_END
        }
        PH_BEGIN(9)
            const bf16_t* Wt = kind == 0 ? (const bf16_t*)(k.ws + WS_DNWOUT) + (size_t)j * 1024 * 1024 : (kind == 1 ? (const bf16_t*)(k.ws + WS_HYWOUT) : (const bf16_t*)(k.ws + WS_SCWOUT));
            EpiResid e{xs, mod, i, 2};
            gemm_dense(ldsh, (const bf16_t*)(k.ws + AR_UBUF), T, Wt, 1024, 1024, e);
        PH_END
        PH_BEGIN(10)
            norm_phase<1>(k, i, false, false, k.norm_ffn + i * 1024, 3, k.w_router, 32, k.router_bias, nullptr, last, ldsf, rep_ == nrep_ - 1);
        PH_END
        PH_BEGIN(11)
            if (rep_ == 0) moe_scatter(k, i, tb);
            job_cvt_moe(k, i, ldsf);
        PH_END
        PH_BEGIN(12) moe_gemm<0>(k, i, ldsh, tb); PH_END
        PH_BEGIN(13) moe_gemm<1>(k, i, ldsh, tb); PH_END
    }
    PH_BEGIN(14)
        norm_phase<3>(k, DEPTH, false, true, k.norm_final, 0, nullptr, 0, nullptr, nullptr, false, ldsf);
    PH_END
#undef PH_BEGIN
#undef PH_END
}
constexpr int N_PHASES = 1 + (10 + 9 + 8 + 10) + 1;

extern "C" void kernel_launch(void* const* d_in, const int* in_sizes, int n_in, void* d_out, int out_size, void* d_ws, size_t ws_size, hipStream_t stream) {
    static int grid = 0;
    if (grid == 0) {
        if (n_in != 33 || out_size != TL * D || ws_size < WS_END) { fprintf(stderr, "kernel_launch: unexpected shapes: n_in %d out %d ws %zu (need %zu)\n", n_in, out_size, ws_size, (size_t)WS_END); grid = -1; return; }
        int dev = 0, cus = 0, per_cu = 0;
        if (hipGetDevice(&dev) != hipSuccess || hipDeviceGetAttribute(&cus, hipDeviceAttributeMultiprocessorCount, dev) != hipSuccess) { grid = -1; return; }
        if (hipFuncSetAttribute((const void*)fwd_kernel, hipFuncAttributeMaxDynamicSharedMemorySize, LDS_BYTES) != hipSuccess) { fprintf(stderr, "kernel_launch: hipFuncSetAttribute failed\n"); grid = -1; return; }
        if (hipOccupancyMaxActiveBlocksPerMultiprocessor(&per_cu, (const void*)fwd_kernel, NTHR, LDS_BYTES) != hipSuccess || per_cu < 1) fprintf(stderr, "kernel_launch: occupancy query reports %d\n", per_cu);
        (void)hipGetLastError();
        grid = cus;
    }
    if (grid < 0) return;
    (void)hipMemsetAsync((char*)d_ws + WS_CTL, 0, CTL_BYTES, stream);
    Params p{};
    for (int i = 0; i < 33; ++i) p.in[i] = (const float*)d_in[i];
    p.out = (float*)d_out; p.ws = (unsigned char*)d_ws;
#if MK_MULTI
    for (int ph = 0; ph < N_PHASES; ++ph) { p.ph_lo = ph; p.ph_hi = ph + 1; hipLaunchKernelGGL(fwd_kernel, dim3(grid), dim3(NTHR), LDS_BYTES, stream, p); }
#else
    p.ph_lo = 0; p.ph_hi = N_PHASES;
    hipLaunchKernelGGL(fwd_kernel, dim3(grid), dim3(NTHR), LDS_BYTES, stream, p);
#endif
}
```

```cpp
#include <hip/hip_runtime.h>
#include <stdint.h>
#include <stdio.h>
#include <math.h>

#ifndef MK_MULTI
#define MK_MULTI 0
#endif

#ifndef PROBE_REP
#define PROBE_REP (-1)
#endif
#define LAS __attribute__((address_space(3)))
#define GAS __attribute__((address_space(1)))
#define HD __host__ __device__ __forceinline__
#define DI __device__ __forceinline__
#ifdef NOINL
#define PF __device__ __noinline__
#else
#define PF __device__ __forceinline__
#endif
typedef unsigned short bf16_t;
typedef short bf16x8 __attribute__((ext_vector_type(8)));
typedef float f32x4 __attribute__((ext_vector_type(4)));
typedef unsigned u32x4 __attribute__((ext_vector_type(4)));
typedef unsigned u32x2 __attribute__((ext_vector_type(2)));

constexpr int D = 1024, NB = 2, SEQ = 16384, CTXL = 256, DEPTH = 4;
constexpr int TC = NB * CTXL, TL = NB * SEQ, T = TC + TL, NA = 2 * T;
constexpr int NTHR = 512;
constexpr int DN_IN = 4128;
constexpr float EPS = 1e-6f;
constexpr int LDS_BYTES = 152 * 1024;

constexpr size_t AL(size_t x) { return (x + 255) & ~(size_t)255; }
constexpr size_t WS_CTL = 0;
constexpr size_t CTL_BYTES = 65536;
constexpr size_t CTL_CNT = 16384;
constexpr size_t WS_MOD = WS_CTL + CTL_BYTES;
constexpr size_t WS_HS = AL(WS_MOD + 4 * 3 * 6144 * 4);
constexpr size_t WS_W3S = AL(WS_HS + 16384 * 256 * 2);
constexpr size_t WS_HDNC = AL(WS_W3S + 4096 * 256 * 2);
constexpr size_t WS_FILTC = AL(WS_HDNC + 256 * 64 * 4);
constexpr size_t WS_DNWIN = AL(WS_FILTC + 256 * 4096 * 4);
constexpr size_t WS_DNWOUT = AL(WS_DNWIN + (size_t)2 * 4096 * 1024 * 2);
constexpr size_t WS_HYWIN = AL(WS_DNWOUT + (size_t)2 * 1024 * 1024 * 2);
constexpr size_t WS_HYWOUT = AL(WS_HYWIN + (size_t)3072 * 1024 * 2);
constexpr size_t WS_SCWIN = AL(WS_HYWOUT + (size_t)1024 * 1024 * 2);
constexpr size_t WS_SCWOUT = AL(WS_SCWIN + (size_t)3072 * 1024 * 2);
constexpr size_t WS_XS = AL(WS_SCWOUT + (size_t)1024 * 1024 * 2);
constexpr size_t WS_TOKE = AL(WS_XS + (size_t)T * 1024 * 4);
constexpr size_t WS_TOKW = AL(WS_TOKE + (size_t)T * 2 * 4);
constexpr size_t WS_TOKP = AL(WS_TOKW + (size_t)T * 2 * 4);
constexpr size_t WS_SLOT = AL(WS_TOKP + (size_t)T * 2 * 4);
constexpr size_t WS_GB = AL(WS_SLOT + (size_t)(NA + 256) * 4);
constexpr size_t WS_EGL = AL(WS_GB + (size_t)T * 32 * 4);
constexpr size_t WS_AR = AL(WS_EGL + (size_t)32 * 260 * 4);
constexpr size_t AR_HBUF = WS_AR;
constexpr size_t AR_UBUF = AR_HBUF + (size_t)T * 1024 * 2;
constexpr size_t AR_PB = AR_UBUF + (size_t)T * 1024 * 2;
constexpr size_t AR_Q = AR_PB + (size_t)T * 4096 * 2;
constexpr size_t AR_CHUNK = AR_PB + (size_t)T * 3072 * 2;
constexpr size_t AR_DN_END = AR_CHUNK + (size_t)32 * 260 * 65536;
constexpr size_t AR_ZT = AR_Q;
constexpr size_t AR_FFTS = AR_ZT + (size_t)1024 * T * 2;
constexpr size_t AR_FT = AR_FFTS + (size_t)256 * 4 * 16384 * 8;
constexpr size_t AR_HY_END = AR_FT + (size_t)4096 * 16384 * 4;
constexpr size_t AR_HID = AR_PB;
constexpr size_t AR_YS = AR_HID + (size_t)NA * 512 * 2;
constexpr size_t AR_WGU = AR_YS + (size_t)NA * 1024 * 2;
constexpr size_t AR_WD = AR_WGU + (size_t)32 * 1024 * 1024 * 2;
constexpr size_t AR_MOE_END = AR_WD + (size_t)32 * 1024 * 512 * 2;
constexpr size_t WS_END = AR_DN_END > AR_HY_END ? (AR_DN_END > AR_MOE_END ? AR_DN_END : AR_MOE_END) : (AR_HY_END > AR_MOE_END ? AR_HY_END : AR_MOE_END);

#define XB_TMO      128
#define XB_XCNT(j)  (256  + 64 * (j))
#define XB_XSUB(j)  (1280 + 64 * (j))
#define XB_XGEN(j)  (2304 + 64 * (j))
#define XB_TOP      3328
#define XB_TOPGEN   3392
#define XCD_BAR_WORDS 3456
#define XB_SPIN_CAP (1u << 25)
DI unsigned xb_ld(unsigned* p)              { return __hip_atomic_load(p, __ATOMIC_RELAXED, __HIP_MEMORY_SCOPE_AGENT); }
DI unsigned xb_add(unsigned* p, unsigned v) { return __hip_atomic_fetch_add(p, v, __ATOMIC_RELAXED, __HIP_MEMORY_SCOPE_AGENT); }
DI unsigned xb_xcc_id() { return (unsigned)__builtin_amdgcn_s_getreg((3 << 11) | 20) & 0xFu; }
#define XB_SPIN(cond, bar) do { unsigned _sp = 0; while (cond) { __builtin_amdgcn_s_sleep(1); \
    if ((++_sp & 255u) == 0u) { if (xb_ld(&(bar)[XB_TMO])) break; if (_sp > XB_SPIN_CAP) { atomicAdd(&(bar)[XB_TMO], 1u); break; } } } } while (0)
struct XcdBarrier { unsigned* bar; unsigned x; volatile LAS unsigned* st; };
DI XcdBarrier xcd_barrier_post(unsigned* bar, volatile LAS unsigned* st) {
    XcdBarrier b; b.bar = bar; b.x = xb_xcc_id(); b.st = st;
    if (threadIdx.x == 0) (void)xb_add(&bar[XB_XCNT(b.x)], 1u);
    return b;
}
DI void xcd_barrier_complete(unsigned* bar, unsigned x, unsigned& nloc, unsigned& nx) {
    const unsigned G = gridDim.x * gridDim.y * gridDim.z;
    unsigned sum, cnt, mine, sp = 0u;
    for (;;) {
        sum = 0u; cnt = 0u; mine = 0u;
#pragma unroll
        for (unsigned j = 0; j < 16; ++j) { const unsigned c = xb_ld(&bar[XB_XCNT(j)]); sum += c; cnt += (c > 0u) ? 1u : 0u; mine = (j == x) ? c : mine; }
        if (sum == G) break;
        __builtin_amdgcn_s_sleep(1);
        if ((++sp & 255u) == 0u) { if (xb_ld(&bar[XB_TMO])) break; if (sp > XB_SPIN_CAP) { atomicAdd(&bar[XB_TMO], 1u); break; } }
    }
    nloc = mine > 0u ? mine : 1u; nx = cnt > 0u ? cnt : 1u;
}
DI void xcd_barrier(const XcdBarrier& b) {
    asm volatile("s_waitcnt vmcnt(0)" ::: "memory");
    __syncthreads();
    if (threadIdx.x == 0) {
        unsigned* bar = b.bar;
        __builtin_amdgcn_s_waitcnt(0);
        unsigned nloc = b.st[0], nx = b.st[1];
        if (nloc == 0u) { xcd_barrier_complete(bar, b.x, nloc, nx); b.st[0] = nloc; b.st[1] = nx; }
        const unsigned old = xb_add(&bar[XB_XSUB(b.x)], 1u);
        const unsigned gen = old / nloc;
        if (old + 1u == (gen + 1u) * nloc) {
            __builtin_amdgcn_fence(__ATOMIC_RELEASE, "agent");
            asm volatile("s_waitcnt vmcnt(0)" ::: "memory");
            const unsigned og = xb_add(&bar[XB_TOP], 1u);
            const unsigned tg = og / nx;
            if (og + 1u == (tg + 1u) * nx) xb_add(&bar[XB_TOPGEN], 1u);
            else XB_SPIN(xb_ld(&bar[XB_TOPGEN]) == tg, bar);
            __builtin_amdgcn_fence(__ATOMIC_ACQUIRE, "agent");
            xb_add(&bar[XB_XGEN(b.x)], 1u);
            asm volatile("s_waitcnt vmcnt(0)" ::: "memory");
        } else {
            XB_SPIN(xb_ld(&bar[XB_XGEN(b.x)]) == gen, bar);
            __builtin_amdgcn_fence(__ATOMIC_ACQUIRE, "agent");
            asm volatile("s_waitcnt vmcnt(0)" ::: "memory");
        }
    }
    __syncthreads();
}

DI bf16_t f2bf(float f) { unsigned u = __float_as_uint(f); u += 0x7fffu + ((u >> 16) & 1u); return (bf16_t)(u >> 16); }
DI float bf2f(bf16_t b) { return __uint_as_float(((unsigned)b) << 16); }
DI unsigned pk2(float lo, float hi) { return (unsigned)f2bf(lo) | ((unsigned)f2bf(hi) << 16); }
DI float siluf(float x) { return x / (1.0f + __expf(-x)); }
DI float sigmf(float x) { return 1.0f / (1.0f + __expf(-x)); }
DI float shi(float v, int src) { return __int_as_float(__builtin_amdgcn_ds_bpermute(src << 2, __float_as_int(v))); }
DI int shii(int v, int src) { return __builtin_amdgcn_ds_bpermute(src << 2, v); }
DI float shx(float v, int m, int lane) { return shi(v, lane ^ m); }
DI float wsum(float v, int lane) {
#pragma unroll
    for (int m = 32; m >= 1; m >>= 1) v += shx(v, m, lane);
    return v;
}
DI void lds_barrier() { asm volatile("s_waitcnt lgkmcnt(0)\n\ts_barrier" ::: "memory"); }
DI int TID() { int t = threadIdx.x; asm volatile("" : "+v"(t)); return t; }
DI int modrow(int r) { return r < TC ? 0 : 1 + (r - TC) / SEQ; }

typedef float cf __attribute__((ext_vector_type(2)));
HD cf cmul(cf a, cf b) { cf r; r.x = a.x * b.x - a.y * b.y; r.y = a.x * b.y + a.y * b.x; return r; }
HD cf cadd(cf a, cf b) { cf r; r.x = a.x + b.x; r.y = a.y + b.y; return r; }
HD cf csub(cf a, cf b) { cf r; r.x = a.x - b.x; r.y = a.y - b.y; return r; }
template <int R> HD constexpr int brev(int i) { int r = 0; for (int b = 1, t = R >> 1; b < R; b <<= 1, t >>= 1) if (i & b) r |= t; return r; }
#define FFT_C32 {1.0f, 0.98078528040323044913f, 0.92387953251128675613f, 0.83146961230254523708f, 0.70710678118654752440f, 0.55557023301960222474f, 0.38268343236508977173f, 0.19509032201612826785f, 0.0f, -0.19509032201612826785f, -0.38268343236508977173f, -0.55557023301960222474f, -0.70710678118654752440f, -0.83146961230254523708f, -0.92387953251128675613f, -0.98078528040323044913f}
#define FFT_S32 {0.0f, 0.19509032201612826785f, 0.38268343236508977173f, 0.55557023301960222474f, 0.70710678118654752440f, 0.83146961230254523708f, 0.92387953251128675613f, 0.98078528040323044913f, 1.0f, 0.98078528040323044913f, 0.92387953251128675613f, 0.83146961230254523708f, 0.70710678118654752440f, 0.55557023301960222474f, 0.38268343236508977173f, 0.19509032201612826785f}
template <int R> HD constexpr int ilog2c() { int l = 0; for (int r = R; r > 1; r >>= 1) ++l; return l; }
template <int R> HD void dft_fwd(cf (&v)[R]) {
    constexpr float C[16] = FFT_C32; constexpr float S[16] = FFT_S32;
    constexpr int LG = ilog2c<R>();
#pragma unroll
    for (int st = 0; st < LG; ++st) {
#pragma unroll
        for (int i = 0; i < R / 2; ++i) {
            const int len = R >> st, half = len >> 1, blk = i / half, j = i % half, i0 = blk * len + j, i1 = i0 + half;
            const cf a = v[i0], c = v[i1];
            v[i0] = cadd(a, c);
            const cf d = csub(a, c);
            const int ti = j * (32 / len);
            cf w; w.x = C[ti]; w.y = -S[ti];
            v[i1] = (ti == 0) ? d : cmul(d, w);
        }
    }
}
template <int R> HD void dft_inv(cf (&v)[R]) {
    constexpr float C[16] = FFT_C32; constexpr float S[16] = FFT_S32;
    constexpr int LG = ilog2c<R>();
#pragma unroll
    for (int st = LG - 1; st >= 0; --st) {
#pragma unroll
        for (int i = 0; i < R / 2; ++i) {
            const int len = R >> st, half = len >> 1, blk = i / half, j = i % half, i0 = blk * len + j, i1 = i0 + half;
            const int ti = j * (32 / len);
            cf w; w.x = C[ti]; w.y = S[ti];
            const cf a = v[i0];
            const cf c = (ti == 0) ? v[i1] : cmul(v[i1], w);
            v[i0] = cadd(a, c);
            v[i1] = csub(a, c);
        }
    }
}
#define PIDX(a) ((a) + (((a) >> 6) << 2))
template <int R> DI void fft_pass_fwd(LAS cf* X, const LAS cf* tw, int n, int g) {
    const int s = n / R, q = g / s, p = g - q * s, base = q * n + p;
    cf v[R];
#pragma unroll
    for (int k = 0; k < R; ++k) v[k] = X[PIDX(base + k * s)];
    dft_fwd<R>(v);
    if (s > 1) {
        int pp = p * (16384 / n); asm volatile("" : "+v"(pp));
        const cf w1 = tw[pp]; cf w = w1;
#pragma unroll
        for (int m = 1; m < R; ++m) { v[brev<R>(m)] = cmul(v[brev<R>(m)], w); w = cmul(w, w1); }
    }
#pragma unroll
    for (int k = 0; k < R; ++k) X[PIDX(base + k * s)] = v[k];
}
template <int R> DI void fft_pass_inv(LAS cf* X, const LAS cf* tw, int n, int g) {
    const int s = n / R, q = g / s, p = g - q * s, base = q * n + p;
    cf v[R];
#pragma unroll
    for (int k = 0; k < R; ++k) v[k] = X[PIDX(base + k * s)];
    if (s > 1) {
        int pp = p * (16384 / n); asm volatile("" : "+v"(pp));
        cf w1 = tw[pp]; w1.y = -w1.y; cf w = w1;
#pragma unroll
        for (int m = 1; m < R; ++m) { v[brev<R>(m)] = cmul(v[brev<R>(m)], w); w = cmul(w, w1); }
    }
    dft_inv<R>(v);
#pragma unroll
    for (int k = 0; k < R; ++k) X[PIDX(base + k * s)] = v[k];
}
DI void fft16k_fwd(LAS cf* X, const LAS cf* tw) {
    const int t = TID();
#pragma unroll 1
    for (int g = 0; g < 2; ++g) fft_pass_fwd<16>(X, tw, 16384, t + 512 * g);
    __syncthreads();
#pragma unroll 1
    for (int g = 0; g < 2; ++g) fft_pass_fwd<16>(X, tw, 1024, t + 512 * g);
    __syncthreads();
#pragma unroll 1
    for (int g = 0; g < 2; ++g) fft_pass_fwd<16>(X, tw, 64, t + 512 * g);
    __syncthreads();
#pragma unroll 1
    for (int g = 0; g < 8; ++g) fft_pass_fwd<4>(X, tw, 4, t + 512 * g);
    __syncthreads();
}
DI void fft16k_inv(LAS cf* X, const LAS cf* tw) {
    const int t = TID();
#pragma unroll 1
    for (int g = 0; g < 8; ++g) fft_pass_inv<4>(X, tw, 4, t + 512 * g);
    __syncthreads();
#pragma unroll 1
    for (int g = 0; g < 2; ++g) fft_pass_inv<16>(X, tw, 64, t + 512 * g);
    __syncthreads();
#pragma unroll 1
    for (int g = 0; g < 2; ++g) fft_pass_inv<16>(X, tw, 1024, t + 512 * g);
    __syncthreads();
#pragma unroll 1
    for (int g = 0; g < 2; ++g) fft_pass_inv<16>(X, tw, 16384, t + 512 * g);
    __syncthreads();
}

struct Params { const float* in[33]; float* out; unsigned char* ws; int ph_lo, ph_hi; };
struct KC {
    const float *x, *c, *ctx, *c_ctx, *ada_w, *ada_b, *norm_mix, *norm_ffn, *norm_final;
    const float *dn_w_in, *dn_conv, *dn_a_log, *dn_dt_bias, *dn_out_norm, *dn_w_out;
    const float *hy_w_in, *hy_conv, *hy_f_w1, *hy_f_b1, *hy_f_freq, *hy_f_w2, *hy_f_b2, *hy_f_w3, *hy_bias, *hy_w_out;
    const float *sc_w_in, *sc_conv, *sc_w_out, *w_router, *router_bias, *moe_w_gate, *moe_w_up, *moe_w_down;
    float* out; unsigned char* ws;
};

PF void job_mod(const KC& k, LAS float* lds) {
    const int tid = TID(), cj = tid & 63, kq = tid >> 6;
    float* mod = (float*)(k.ws + WS_MOD);
    for (int u = blockIdx.x; u < DEPTH * 96; u += gridDim.x) {
        const int l = u / 96, cc = u % 96, col = cc * 64 + cj;
        const float* W = k.ada_w + (size_t)l * 1024 * 6144;
        float a0 = 0.f, a1 = 0.f, a2 = 0.f;
        for (int kk = kq * 128; kk < kq * 128 + 128; ++kk) {
            const float w = W[(size_t)kk * 6144 + col];
            a0 += siluf(k.c_ctx[kk]) * w; a1 += siluf(k.c[kk]) * w; a2 += siluf(k.c[1024 + kk]) * w;
        }
        lds[(kq * 3 + 0) * 64 + cj] = a0; lds[(kq * 3 + 1) * 64 + cj] = a1; lds[(kq * 3 + 2) * 64 + cj] = a2;
        __syncthreads();
        if (tid < 192) {
            const int r = tid >> 6, j = tid & 63;
            float s = 0.f;
            for (int q = 0; q < 8; ++q) s += lds[(q * 3 + r) * 64 + j];
            mod[(size_t)(l * 3 + r) * 6144 + cc * 64 + j] = s + k.ada_b[l * 6144 + cc * 64 + j];
        }
        __syncthreads();
    }
}
DI void cvt_tile(const float* __restrict__ src, int ld, bf16_t* __restrict__ dst, int ldd, int k0, int n0, int mapmode, LAS float* lds) {
    const int tid = TID();
    { const int r = tid >> 4, c4 = (tid & 15) * 4;
#pragma unroll
      for (int h = 0; h < 2; ++h) {
          const f32x4 v = *(const f32x4*)(src + (size_t)(k0 + r + 32 * h) * ld + n0 + c4);
          LAS float* p = lds + (r + 32 * h) * 65 + c4; p[0] = v[0]; p[1] = v[1]; p[2] = v[2]; p[3] = v[3];
      } }
    __syncthreads();
    { const int nn = tid >> 3, ks = (tid & 7) * 8; const int n = n0 + nn;
      const int row = mapmode == 0 ? n : (32 * (n >> 4) + (n & 15) + (mapmode == 2 ? 16 : 0));
      u32x4 o;
      o[0] = pk2(lds[(ks + 0) * 65 + nn], lds[(ks + 1) * 65 + nn]); o[1] = pk2(lds[(ks + 2) * 65 + nn], lds[(ks + 3) * 65 + nn]);
      o[2] = pk2(lds[(ks + 4) * 65 + nn], lds[(ks + 5) * 65 + nn]); o[3] = pk2(lds[(ks + 6) * 65 + nn], lds[(ks + 7) * 65 + nn]);
      *(u32x4*)(dst + (size_t)row * ldd + k0 + ks) = o; }
    __syncthreads();
}
DI void cvt_matrix(const float* src, int ld, size_t sstride, int K, int N, int nmat, bf16_t* dst, int ldd, size_t dstride, int mapmode, LAS float* lds) {
    const int tk = K / 64, tn = N / 64, per = tk * tn;
    for (int u = blockIdx.x; u < per * nmat; u += gridDim.x) {
        const int m = u / per, t = u % per;
        cvt_tile(src + (size_t)m * sstride, ld, dst + (size_t)m * dstride, ldd, (t / tn) * 64, (t % tn) * 64, mapmode, lds);
    }
}
PF void job_cvt_small(const KC& k, LAS float* lds) {
    cvt_matrix(k.dn_w_in, DN_IN, (size_t)1024 * DN_IN, 1024, 4096, 2, (bf16_t*)(k.ws + WS_DNWIN), 1024, (size_t)4096 * 1024, 0, lds);
    cvt_matrix(k.dn_w_out, 1024, (size_t)1024 * 1024, 1024, 1024, 2, (bf16_t*)(k.ws + WS_DNWOUT), 1024, (size_t)1024 * 1024, 0, lds);
    cvt_matrix(k.hy_w_in, 3072, 0, 1024, 3072, 1, (bf16_t*)(k.ws + WS_HYWIN), 1024, 0, 0, lds);
    cvt_matrix(k.hy_w_out, 1024, 0, 1024, 1024, 1, (bf16_t*)(k.ws + WS_HYWOUT), 1024, 0, 0, lds);
    cvt_matrix(k.sc_w_in, 3072, 0, 1024, 3072, 1, (bf16_t*)(k.ws + WS_SCWIN), 1024, 0, 0, lds);
    cvt_matrix(k.sc_w_out, 1024, 0, 1024, 1024, 1, (bf16_t*)(k.ws + WS_SCWOUT), 1024, 0, 0, lds);
}
PF void job_cvt_moe(const KC& k, int layer, LAS float* lds) {
    const size_t lo = (size_t)layer * 32 * 1024 * 512;
    cvt_matrix(k.moe_w_gate + lo, 512, (size_t)1024 * 512, 1024, 512, 32, (bf16_t*)(k.ws + AR_WGU), 1024, (size_t)1024 * 1024, 1, lds);
    cvt_matrix(k.moe_w_up + lo, 512, (size_t)1024 * 512, 1024, 512, 32, (bf16_t*)(k.ws + AR_WGU), 1024, (size_t)1024 * 1024, 2, lds);
    cvt_matrix(k.moe_w_down + lo, 1024, (size_t)512 * 1024, 512, 1024, 32, (bf16_t*)(k.ws + AR_WD), 512, (size_t)1024 * 512, 0, lds);
}
PF void job_hdn(const KC& k, LAS float* lds) {
    const int tid = TID(), lane = tid & 63, wave = tid >> 6;
    LAS float* feat = lds + wave * 128; LAS float* h1 = feat + 64;
    const float fr = k.hy_f_freq[lane], b1 = k.hy_f_b1[lane], b2 = k.hy_f_b2[lane];
    for (int u0 = blockIdx.x * 8; u0 < 16384 + 256; u0 += gridDim.x * 8) {
        const int u = u0 + wave;
        int l, pos; float* dst;
        if (u < 16384) { l = 16384; pos = u; dst = nullptr; }
        else { l = 256; pos = u - 16384; dst = (float*)(k.ws + WS_HDNC) + (size_t)pos * 64; }
        const float t = (float)pos / (float)(l - 1);
        float f = 0.f;
        if (lane == 0) f = t;
        else if (lane <= 32) {
            const int bi = (lane - 1) & 15;
            const float band = 1e-4f + (float)bi * ((15.0f - 1e-4f) / 15.0f);
            const float ang = (6.283185307179586f / (float)l) * (float)pos * band;
            f = lane <= 16 ? cosf(ang) : -sinf(ang);
        }
        feat[lane] = f;
        __syncthreads();
        float a = b1;
        for (int i = 0; i < 33; ++i) a += feat[i] * k.hy_f_w1[i * 64 + lane];
        h1[lane] = sinf(fr * a);
        __syncthreads();
        float a2 = b2;
        for (int j = 0; j < 64; ++j) a2 += h1[j] * k.hy_f_w2[j * 64 + lane];
        const float hv = sinf(fr * a2);
        if (dst) dst[lane] = hv;
        else { bf16_t* hs = (bf16_t*)(k.ws + WS_HS) + (size_t)pos * 256; const bf16_t hi = f2bf(hv), lo = f2bf(hv - bf2f(hi)); hs[lane] = hi; hs[64 + lane] = lo; hs[128 + lane] = hi; hs[192 + lane] = 0; }
        __syncthreads();
    }
}
PF void job_w3s(const KC& k) {
    bf16_t* W = (bf16_t*)(k.ws + WS_W3S);
    const int tq = TID();
    for (int idx = blockIdx.x * NTHR + tq; idx < 64 * 4096; idx += gridDim.x * NTHR) {
        const int j = idx >> 12, col = idx & 4095;
        const float w = k.hy_f_w3[idx]; const bf16_t hi = f2bf(w), lo = f2bf(w - bf2f(hi));
        W[(size_t)col * 256 + j] = hi; W[(size_t)col * 256 + 64 + j] = hi; W[(size_t)col * 256 + 128 + j] = lo; W[(size_t)col * 256 + 192 + j] = 0;
    }
}
DI float hy_delta(int ch) {
    const float lo = -4.605170185988091f / 1.5f, hi = -4.605170185988091f / 0.3f;
    return fabsf(lo + (float)ch * ((hi - lo) / 1023.0f));
}
PF void job_filtc(const KC& k, int j) {
    const float* hdn = (const float*)(k.ws + WS_HDNC);
    const float* w3 = k.hy_f_w3 + (size_t)j * 64 * 4096;
    float* filtc = (float*)(k.ws + WS_FILTC);
    const int tq = TID();
    for (int u = blockIdx.x; u < 256 * 8; u += gridDim.x) {
        const int l = u >> 3, col = (u & 7) * 512 + tq;
        float a = 0.f;
        for (int q = 0; q < 64; ++q) a += hdn[l * 64 + q] * w3[(size_t)q * 4096 + col];
        const float t = (float)l / 255.0f;
        filtc[(size_t)l * 4096 + col] = a * expf(-t * hy_delta(col & 1023));
    }
}

template <int MODE>
PF void norm_phase(const KC& k, int layer, bool first, bool combine, const float* __restrict__ gain, int mb, const float* __restrict__ Wsk, int ldw,
                   const float* __restrict__ aux0, const float* __restrict__ aux1, bool last, LAS float* lds, bool flush = true) {
    const int tid = TID(), lane = tid & 63, wave = tid >> 6;
    float* xs = (float*)(k.ws + WS_XS);
    bf16_t* hbuf = (bf16_t*)(k.ws + AR_HBUF);
    const float* mod = (const float*)(k.ws + WS_MOD);
    const bf16_t* ys = (const bf16_t*)(k.ws + AR_YS);
    const int* tokp = (const int*)(k.ws + WS_TOKP);
    const float* tokw = (const float*)(k.ws + WS_TOKW);
    LAS int* lcnt = (LAS int*)(lds + 32768);
    if (MODE == 1 && tid < 32) lcnt[tid] = 0;
    if (MODE == 1 || MODE == 2) {
        for (int idx = tid; idx < 1024 * 32; idx += NTHR) {
            const int kk = idx >> 5, n = idx & 31;
            lds[kk * 32 + (((n >> 2) ^ ((kk >> 1) & 7)) << 2) + (n & 3)] = Wsk[(size_t)kk * ldw + n];
        }
        __syncthreads();
    }
    const int rbeg = (MODE == 3) ? TC : 0;
    for (int r = rbeg + blockIdx.x * 8 + wave; r < T; r += gridDim.x * 8) {
        const int mr = modrow(r);
        const float* src = first ? (r < TC ? k.ctx + (size_t)r * 1024 : k.x + (size_t)(r - TC) * 1024) : xs + (size_t)r * 1024;
        float x[16];
#pragma unroll
        for (int m = 0; m < 16; ++m) x[m] = src[lane + 64 * m];
        if (combine) {
            const int p0 = tokp[2 * r], p1 = tokp[2 * r + 1];
            const float w0 = tokw[2 * r], w1 = tokw[2 * r + 1];
            const float* g5 = mod + ((size_t)((layer - 1) * 3 + mr) * 6 + 5) * 1024;
#pragma unroll
            for (int m = 0; m < 16; ++m) {
                const int col = lane + 64 * m;
                x[m] += g5[col] * (w0 * bf2f(ys[(size_t)p0 * 1024 + col]) + w1 * bf2f(ys[(size_t)p1 * 1024 + col]));
            }
        }
        if (first || combine) {
#pragma unroll
            for (int m = 0; m < 16; ++m) xs[(size_t)r * 1024 + lane + 64 * m] = x[m];
        }
        float ss = 0.f;
#pragma unroll
        for (int m = 0; m < 16; ++m) ss += x[m] * x[m];
        ss = wsum(ss, lane);
        const float rstd = rsqrtf(ss * (1.0f / 1024.0f) + EPS);
        if (MODE == 3) {
#pragma unroll
            for (int m = 0; m < 16; ++m) { const int col = lane + 64 * m; k.out[(size_t)(r - TC) * 1024 + col] = x[m] * rstd * gain[col]; }
            continue;
        }
        const float* shift = mod + ((size_t)(layer * 3 + mr) * 6 + mb) * 1024;
        const float* scale = shift + 1024;
        float y[16];
#pragma unroll
        for (int m = 0; m < 16; ++m) {
            const int col = lane + 64 * m;
            y[m] = x[m] * rstd * gain[col] * (1.0f + scale[col]) + shift[col];
            hbuf[(size_t)r * 1024 + col] = f2bf(y[m]);
        }
        if (MODE == 1 || MODE == 2) {
            float acc[32];
#pragma unroll
            for (int n = 0; n < 32; ++n) acc[n] = 0.f;
#pragma unroll
            for (int m = 0; m < 16; ++m) {
                asm volatile("" ::: "memory");
                const int c = lane + 64 * m;
                const LAS float* wr = lds + c * 32; const int sw = (c >> 1) & 7;
#pragma unroll
                for (int q = 0; q < 8; ++q) {
                    const f32x4 w4 = *(const LAS f32x4*)(wr + ((q ^ sw) << 2));
                    acc[4 * q + 0] += y[m] * w4[0]; acc[4 * q + 1] += y[m] * w4[1]; acc[4 * q + 2] += y[m] * w4[2]; acc[4 * q + 3] += y[m] * w4[3];
                }
            }
            float val;
            {
                float a16[16], a8[8], a4[4], a2[2];
                const bool b5 = (lane & 32) != 0, b4 = (lane & 16) != 0, b3 = (lane & 8) != 0, b2 = (lane & 4) != 0, b1 = (lane & 2) != 0;
#pragma unroll
                for (int i = 0; i < 16; ++i) { const float send = b5 ? acc[i] : acc[i + 16], keep = b5 ? acc[i + 16] : acc[i]; a16[i] = keep + shx(send, 32, lane); }
#pragma unroll
                for (int i = 0; i < 8; ++i) { const float send = b4 ? a16[i] : a16[i + 8], keep = b4 ? a16[i + 8] : a16[i]; a8[i] = keep + shx(send, 16, lane); }
#pragma unroll
                for (int i = 0; i < 4; ++i) { const float send = b3 ? a8[i] : a8[i + 4], keep = b3 ? a8[i + 4] : a8[i]; a4[i] = keep + shx(send, 8, lane); }
#pragma unroll
                for (int i = 0; i < 2; ++i) { const float send = b2 ? a4[i] : a4[i + 2], keep = b2 ? a4[i + 2] : a4[i]; a2[i] = keep + shx(send, 4, lane); }
                { const float send = b1 ? a2[0] : a2[1], keep = b1 ? a2[1] : a2[0]; val = keep + shx(send, 2, lane); }
                val += shx(val, 1, lane);
            }
            const int n = lane >> 1;
            if (MODE == 1) {
                int* toke = (int*)(k.ws + WS_TOKE); float* tokwW = (float*)(k.ws + WS_TOKW);
                if (last && r < TC) { if (lane == 0) { int neg = -1; asm volatile("" : "+v"(neg)); toke[2 * r] = neg; toke[2 * r + 1] = neg; } continue; }
                const float sc = 1.0f / (1.0f + expf(-val)), ch = sc + aux0[n];
                const int gl = lane & ~7;
                const float ca = shi(ch, gl), cb = shi(ch, gl + 2), cc = shi(ch, gl + 4), cd = shi(ch, gl + 6);
                const float hi1 = fmaxf(ca, cb), lo1 = fminf(ca, cb), hi2 = fmaxf(cc, cd), lo2 = fminf(cc, cd);
                float gs = fmaxf(hi1, hi2) + fmaxf(fminf(hi1, hi2), fmaxf(lo1, lo2));
                int gi = lane >> 3;
#pragma unroll
                for (int m = 8; m <= 32; m <<= 1) {
                    const float og = shx(gs, m, lane); const int oi = shii(gi, lane ^ m);
                    if (og > gs || (og == gs && oi < gi)) { gs = og; gi = oi; }
                }
                float c4[4], s4[4];
#pragma unroll
                for (int i = 0; i < 4; ++i) { c4[i] = shi(ch, gi * 8 + 2 * i); s4[i] = shi(sc, gi * 8 + 2 * i); }
                int i1 = 0; float b1v = c4[0];
#pragma unroll
                for (int i = 1; i < 4; ++i) if (c4[i] > b1v) { b1v = c4[i]; i1 = i; }
                int i2 = -1; float b2v = -1e30f;
#pragma unroll
                for (int i = 0; i < 4; ++i) if (i != i1 && c4[i] > b2v) { b2v = c4[i]; i2 = i; }
                float w1v = 0.f, w2v = 0.f;
#pragma unroll
                for (int i = 0; i < 4; ++i) { if (i == i1) w1v = s4[i]; if (i == i2) w2v = s4[i]; }
                const float inv = 1.0f / (w1v + w2v);
                if (lane == 0) {
                    const int e1 = gi * 4 + i1, e2 = gi * 4 + i2;
                    toke[2 * r] = e1; toke[2 * r + 1] = e2; tokwW[2 * r] = w1v * inv; tokwW[2 * r + 1] = w2v * inv;
                    __hip_atomic_fetch_add(lcnt + e1, 1, __ATOMIC_RELAXED, __HIP_MEMORY_SCOPE_WORKGROUP);
                    __hip_atomic_fetch_add(lcnt + e2, 1, __ATOMIC_RELAXED, __HIP_MEMORY_SCOPE_WORKGROUP);
                }
            } else {
                float* gb = (float*)(k.ws + WS_GB);
                if ((lane & 1) == 0) {
                    if (n < 16) {
                        const float z = val + aux1[n];
                        const float ez = __expf(z); const float sp = z > 15.f ? z : (ez < 1e-4f ? ez - 0.5f * ez * ez : __logf(1.0f + ez));
                        gb[(size_t)r * 32 + n] = -expf(aux0[n]) * sp;
                    } else {
                        gb[(size_t)r * 32 + n] = 1.0f / (1.0f + expf(-val));
                    }
                }
            }
        }
    }
    if (MODE == 1) {
        __syncthreads();
        int* cnt = (int*)(k.ws + WS_CTL + CTL_CNT) + layer * 32;
        if (flush && tid < 32 && lcnt[tid] > 0) atomicAdd(&cnt[tid], lcnt[tid]);
    }
}

namespace pg8 {
constexpr int BM = 256, BK = 64, HALF = 128, HTB = HALF * BK * 2, STAGE_BYTES = 8 * HTB;
DI int lds_byte(int r, int c) { const int st = (r >> 4) * 2 + (c >> 5), rr = r & 15, cc = c & 31, ob = rr * 64 + cc * 2; return st * 1024 + (ob ^ (((ob >> 9) & 1) << 5)); }
DI void stage_rc(int b, int& R, int& C) { const int st = b / 1024, sb = b % 1024, swz = sb ^ (((sb >> 9) & 1) << 5); R = (st >> 1) * 16 + swz / 64; C = (st & 1) * 32 + (swz % 64) / 2; }
DI int perm32(int rho) { const int n = rho >> 4, i = rho & 15; return 8 * (i >> 2) + 4 * n + (i & 3); }
struct Unit { int m0, mrows, pn; size_t boff; };
template <bool GATHER, class Epi, class Sched>
DI void gemm_phase(LAS unsigned char* lds, const bf16_t* A, const int* rowidx, const bf16_t* Bt, int K, const Sched& S, const Epi& E) {
    const int tid = TID(), wid = __builtin_amdgcn_readfirstlane(tid >> 6), lane = tid & 63, wr = wid >> 2, wc = wid & 3, fr = lane & 15, fq = lane >> 4;
    const int nt = K / BK;
    unsigned voffA[2], voffB[2];
#pragma unroll
    for (int i = 0; i < 2; ++i) { int R, C; stage_rc(tid * 16 + i * 8192, R, C); const int Rb = Epi::PERM ? ((R & ~31) + perm32(R & 31)) : R;
        voffA[i] = (unsigned)(R * K + C) * 2u; voffB[i] = (unsigned)(Rb * K + C) * 2u; }
    const size_t kstep = (size_t)(BK * 2);
    const size_t hstep = (size_t)HALF * K * 2;
    const size_t tstep = 2 * hstep;
    const size_t rstep = (size_t)K * 2;
    const unsigned ldsw = (unsigned)wid * 1024u;
    const int aoff = lds_byte(wr * 64 + fr, fq * 8), boff = lds_byte(wc * 32 + fr, fq * 8);
#define PG8_SA(b, h) (((b) * 2 + (h)) * HTB)
#define PG8_SB(b, h) ((4 + (b) * 2 + (h)) * HTB)
#define PG8_STAGE(bufoff, gbase, voff) do { _Pragma("unroll") for (int _i = 0; _i < 2; ++_i) \
        __builtin_amdgcn_global_load_lds((const unsigned*)((const char*)(gbase) + (voff)[_i]), (LAS unsigned*)(lds + (bufoff) + ldsw + _i * 8192), 16, 0, 0); } while (0)
#define PG8_STAGE_A(bufoff, p, h, vG) do { if (GATHER) PG8_STAGE(bufoff, p, (vG)[h]); else PG8_STAGE(bufoff, (p) + (h) * hstep, voffA); } while (0)
#define PG8_LDA(dst, b, h) do { _Pragma("unroll") for (int m = 0; m < 4; ++m) _Pragma("unroll") for (int k = 0; k < 2; ++k) dst[m][k] = *(const LAS bf16x8*)(lds + PG8_SA(b, h) + aoff + m * 2048 + k * 1024); } while (0)
#define PG8_LDB(dst, b, h) do { _Pragma("unroll") for (int n = 0; n < 2; ++n) _Pragma("unroll") for (int k = 0; k < 2; ++k) dst[n][k] = *(const LAS bf16x8*)(lds + PG8_SB(b, h) + boff + n * 2048 + k * 1024); } while (0)
#define PG8_MMA(ai, bj, At, Bt_) do { __builtin_amdgcn_s_setprio(1); _Pragma("unroll") for (int m = 0; m < 4; ++m) _Pragma("unroll") for (int n = 0; n < 2; ++n) _Pragma("unroll") for (int k = 0; k < 2; ++k) \
        acc[ai][bj][m][n] = __builtin_amdgcn_mfma_f32_16x16x32_bf16(Bt_[n][k], At[m][k], acc[ai][bj][m][n], 0, 0, 0); __builtin_amdgcn_s_setprio(0); } while (0)
#define PG8_WAIT_V(n) asm volatile("s_waitcnt vmcnt(" #n ")" ::: "memory")
#define PG8_WAIT_L(n) asm volatile("s_waitcnt lgkmcnt(" #n ")" ::: "memory")
#define PG8_BAR __builtin_amdgcn_s_barrier()
#define PG8_SCHED __builtin_amdgcn_sched_barrier(0)
#define PG8_AOFF(dst, u) do { _Pragma("unroll") for (int _h = 0; _h < 2; ++_h) _Pragma("unroll") for (int _i = 0; _i < 2; ++_i) { int _R, _C; stage_rc(tid * 16 + _i * 8192, _R, _C); \
        dst[_h][_i] = (unsigned)(rowidx[(u).m0 + _h * HALF + _R] * K + _C) * 2u; } } while (0)
    Unit cur, nxt; int ui = 0;
    if (!S.next(0, cur)) return;
    f32x4 acc[2][2][4][2];
#pragma unroll
    for (int a = 0; a < 2; ++a)
#pragma unroll
        for (int b = 0; b < 2; ++b)
#pragma unroll
            for (int m = 0; m < 4; ++m)
#pragma unroll
                for (int n = 0; n < 2; ++n) acc[a][b][m][n] = (f32x4){0.f, 0.f, 0.f, 0.f};
    bf16x8 At[4][2], B0[2][2], B1[2][2];
    unsigned vA[2][2], vN[2][2];
    if (GATHER) PG8_AOFF(vA, cur);
    const char* cA = (const char*)A + (GATHER ? (size_t)0 : (size_t)cur.m0 * rstep);
    const char* cB = (const char*)Bt + cur.boff + (size_t)cur.pn * tstep;
    PG8_STAGE(PG8_SB(0, 0), cB, voffB); PG8_STAGE_A(PG8_SA(0, 0), cA, 0, vA); PG8_STAGE(PG8_SB(0, 1), cB + hstep, voffB); PG8_STAGE_A(PG8_SA(0, 1), cA, 1, vA);
    if (wr == 1) PG8_BAR;
    PG8_WAIT_V(4); PG8_BAR;
    PG8_STAGE(PG8_SB(1, 0), cB + kstep, voffB); PG8_STAGE_A(PG8_SA(1, 0), cA + kstep, 0, vA); PG8_STAGE(PG8_SB(1, 1), cB + hstep + kstep, voffB);
    PG8_WAIT_V(6); PG8_BAR;
    for (;;) {
        const bool has_next = S.next(ui + 1, nxt);
        const char* nA = GATHER ? cA : (has_next ? (const char*)A + (size_t)nxt.m0 * rstep : cA);
        const char* nB = has_next ? (const char*)Bt + nxt.boff + (size_t)nxt.pn * tstep : cB;
        if (GATHER) {
            if (has_next) { PG8_AOFF(vN, nxt); }
            else {
#pragma unroll
                for (int h = 0; h < 2; ++h)
#pragma unroll
                    for (int i = 0; i < 2; ++i) vN[h][i] = vA[h][i];
            }
        }
        for (int t = 0; t < nt; t += 2) {
            const bool last = (t == nt - 2);
            const char* a1 = cA + (size_t)(t + 1) * kstep;
            const char* a2 = last ? nA : cA + (size_t)(t + 2) * kstep; const char* b2 = last ? nB : cB + (size_t)(t + 2) * kstep;
            const char* a3 = a2 + kstep; const char* b3 = b2 + kstep;
            PG8_LDB(B0, 0, 0); PG8_SCHED; PG8_LDA(At, 0, 0); PG8_STAGE_A(PG8_SA(1, 1), a1, 1, vA);
            if (GATHER && last) {
#pragma unroll
                for (int h = 0; h < 2; ++h)
#pragma unroll
                    for (int i = 0; i < 2; ++i) vA[h][i] = vN[h][i];
            }
            PG8_WAIT_L(8); PG8_BAR; PG8_WAIT_L(0); PG8_MMA(0, 0, At, B0); PG8_BAR; PG8_SCHED;
            PG8_LDB(B1, 0, 1); PG8_STAGE(PG8_SB(0, 0), b2, voffB);
            PG8_BAR; PG8_WAIT_L(0); PG8_MMA(0, 1, At, B1); PG8_BAR;
            PG8_LDA(At, 0, 1); PG8_STAGE_A(PG8_SA(0, 0), a2, 0, vA);
            PG8_BAR; PG8_WAIT_L(0); PG8_MMA(1, 0, At, B0); PG8_BAR; PG8_SCHED;
            PG8_STAGE(PG8_SB(0, 1), b2 + hstep, voffB);
            PG8_WAIT_V(6); PG8_BAR; PG8_MMA(1, 1, At, B1); PG8_BAR;
            PG8_LDB(B0, 1, 0); PG8_SCHED; PG8_LDA(At, 1, 0); PG8_STAGE_A(PG8_SA(0, 1), a2, 1, vA);
            PG8_WAIT_L(8); PG8_BAR; PG8_WAIT_L(0); PG8_MMA(0, 0, At, B0); PG8_BAR; PG8_SCHED;
            PG8_LDB(B1, 1, 1); PG8_STAGE(PG8_SB(1, 0), b3, voffB);
            PG8_BAR; PG8_WAIT_L(0); PG8_MMA(0, 1, At, B1); PG8_BAR;
            PG8_LDA(At, 1, 1); PG8_STAGE_A(PG8_SA(1, 0), a3, 0, vA);
            PG8_BAR; PG8_WAIT_L(0); PG8_MMA(1, 0, At, B0); PG8_BAR; PG8_SCHED;
            PG8_STAGE(PG8_SB(1, 1), b3 + hstep, voffB);
            PG8_WAIT_V(6); PG8_BAR; PG8_MMA(1, 1, At, B1); PG8_BAR;
        }
        { const int t2 = TID(), l2 = t2 & 63; E(acc, cur, wr, wc, l2 & 15, l2 >> 4); }
        if (!has_next) break;
#pragma unroll
        for (int a = 0; a < 2; ++a)
#pragma unroll
            for (int b = 0; b < 2; ++b)
#pragma unroll
                for (int m = 0; m < 4; ++m)
#pragma unroll
                    for (int n = 0; n < 2; ++n) acc[a][b][m][n] = (f32x4){0.f, 0.f, 0.f, 0.f};
        cur = nxt; cA = nA; cB = nB; ++ui;
    }
    PG8_WAIT_V(0);
    if (wr == 0) PG8_BAR;
    PG8_BAR;
#undef PG8_SA
#undef PG8_SB
#undef PG8_STAGE
#undef PG8_STAGE_A
#undef PG8_LDA
#undef PG8_LDB
#undef PG8_MMA
#undef PG8_WAIT_V
#undef PG8_WAIT_L
#undef PG8_BAR
#undef PG8_SCHED
#undef PG8_AOFF
}
struct DenseOrder {
    int nM, nN, nwg, G, c;
    DI void init(int M, int N, int G_, int c_) { nM = M / BM; nN = N / BM; nwg = nM * nN; G = G_; c = c_; }
    DI bool next(int i, Unit& u) const {
        const long L = (long)i * G + c; if (L >= nwg) return false;
        int wgid = (int)L; { const int q = nwg / 8, r = nwg % 8, xcd = wgid % 8, off = wgid / 8; wgid = (xcd < r ? xcd * (q + 1) : r * (q + 1) + (xcd - r) * q) + off; }
        const int nig = 8 * nN, gid = wgid / nig, fm = gid * 8, gsz = (nM - fm) < 8 ? (nM - fm) : 8;
        u.m0 = (fm + ((wgid % nig) % gsz)) * BM; u.mrows = BM; u.pn = (wgid % nig) / gsz; u.boff = 0; return true;
    }
};
struct MoeOrder {
    const LAS int* tb; int G, c; size_t estride;
    DI bool next(int i, Unit& u) const {
        const int L = i * G + c; if (L >= __builtin_amdgcn_readfirstlane(tb[97]) * 4) return false;
        const int tile = L >> 2; int e = 0;
        for (int q = 1; q < 32; ++q) if (__builtin_amdgcn_readfirstlane(tb[65 + q]) <= tile) e = q;
        const int lt = tile - __builtin_amdgcn_readfirstlane(tb[65 + e]); int mr = __builtin_amdgcn_readfirstlane(tb[e]) - lt * 256; mr = mr > 256 ? 256 : mr;
        u.m0 = __builtin_amdgcn_readfirstlane(tb[32 + e]) + lt * 256; u.mrows = mr; u.pn = L & 3; u.boff = (size_t)e * estride; return true;
    }
};
}
DI unsigned cvt_pk_bf16(float lo, float hi) { unsigned r; asm volatile("v_cvt_pk_bf16_f32 %0, %1, %2" : "=v"(r) : "v"(lo), "v"(hi)); return r; }
struct EpiBf16 {
    static constexpr bool PERM = true;
    bf16_t* C; int ldc; int split_col; bf16_t* C2; int ldc2;
    DI void operator()(const f32x4 (&acc)[2][2][4][2], const pg8::Unit& u, int wr, int wc, int fr, int fq) const {
        int colt = u.pn * 256; bf16_t* base = C; int ld = ldc;
        if (colt >= split_col) { base = C2; ld = ldc2; colt -= split_col; }
#pragma unroll
        for (int ai = 0; ai < 2; ++ai)
#pragma unroll
            for (int m = 0; m < 4; ++m) {
                const int rl = ai * 128 + wr * 64 + m * 16 + fr;
                if (rl < u.mrows) {
                    bf16_t* rowp = base + (size_t)(u.m0 + rl) * ld + colt + wc * 32 + 8 * fq;
#pragma unroll
                    for (int bj = 0; bj < 2; ++bj) {
                        const f32x4 v0 = acc[ai][bj][m][0], v1 = acc[ai][bj][m][1];
                        u32x4 o; o[0] = cvt_pk_bf16(v0[0], v0[1]); o[1] = cvt_pk_bf16(v0[2], v0[3]); o[2] = cvt_pk_bf16(v1[0], v1[1]); o[3] = cvt_pk_bf16(v1[2], v1[3]);
                        *(u32x4*)(rowp + bj * 128) = o;
                    }
                }
            }
    }
};
struct EpiBf16T {
    static constexpr bool PERM = false;
    bf16_t* C; int ldc;
    DI void operator()(const f32x4 (&acc)[2][2][4][2], const pg8::Unit& u, int wr, int wc, int fr, int fq) const {
#pragma unroll
        for (int ai = 0; ai < 2; ++ai)
#pragma unroll
            for (int bj = 0; bj < 2; ++bj)
#pragma unroll
                for (int m = 0; m < 4; ++m)
#pragma unroll
                    for (int n = 0; n < 2; ++n) {
                        const int row = u.m0 + ai * 128 + wr * 64 + m * 16 + fr, col = u.pn * 256 + bj * 128 + wc * 32 + n * 16 + 4 * fq;
#pragma unroll
                        for (int e = 0; e < 4; ++e) C[(size_t)(col + e) * ldc + row] = f2bf(acc[ai][bj][m][n][e]);
                    }
    }
};
struct EpiTaps {
    static constexpr bool PERM = false;
    float* FT;
    DI void operator()(const f32x4 (&acc)[2][2][4][2], const pg8::Unit& u, int wr, int wc, int fr, int fq) const {
#pragma unroll
        for (int ai = 0; ai < 2; ++ai)
#pragma unroll
            for (int m = 0; m < 4; ++m) {
                const int row = u.m0 + ai * 128 + wr * 64 + m * 16 + fr; const float dl = hy_delta(row & 1023) * (1.0f / 16383.0f);
#pragma unroll
                for (int bj = 0; bj < 2; ++bj)
#pragma unroll
                    for (int n = 0; n < 2; ++n) {
                        const int l = u.pn * 256 + bj * 128 + wc * 32 + n * 16 + 4 * fq; f32x4 o;
#pragma unroll
                        for (int e = 0; e < 4; ++e) o[e] = acc[ai][bj][m][n][e] * expf(-(float)(l + e) * dl);
                        *(f32x4*)(FT + (size_t)row * 16384 + l) = o;
                    }
            }
    }
};
struct EpiResid {
    static constexpr bool PERM = false;
    float* xs; const float* mod; int layer; int chunk;
    DI void operator()(const f32x4 (&acc)[2][2][4][2], const pg8::Unit& u, int wr, int wc, int fr, int fq) const {
        const float* g = mod + ((size_t)(layer * 3 + modrow(u.m0)) * 6 + chunk) * 1024;
#pragma unroll
        for (int bj = 0; bj < 2; ++bj)
#pragma unroll
            for (int n = 0; n < 2; ++n) {
                const int col = u.pn * 256 + bj * 128 + wc * 32 + n * 16 + 4 * fq; const f32x4 gv = *(const f32x4*)(g + col);
#pragma unroll
                for (int ai = 0; ai < 2; ++ai)
#pragma unroll
                    for (int m = 0; m < 4; ++m) { float* p = xs + (size_t)(u.m0 + ai * 128 + wr * 64 + m * 16 + fr) * 1024 + col; *(f32x4*)p = *(const f32x4*)p + gv * acc[ai][bj][m][n]; }
            }
    }
};
struct EpiGateUp {
    static constexpr bool PERM = false;
    bf16_t* hid;
    DI void operator()(const f32x4 (&acc)[2][2][4][2], const pg8::Unit& u, int wr, int wc, int fr, int fq) const {
#pragma unroll
        for (int ai = 0; ai < 2; ++ai)
#pragma unroll
            for (int m = 0; m < 4; ++m) {
                const int rl = ai * 128 + wr * 64 + m * 16 + fr;
                if (rl < u.mrows) {
#pragma unroll
                    for (int bj = 0; bj < 2; ++bj) {
                        const int hc = ((u.pn * 256 + bj * 128 + wc * 32) >> 1) + 4 * fq;
                        const f32x4 g = acc[ai][bj][m][0], up = acc[ai][bj][m][1];
                        u32x2 o; o[0] = cvt_pk_bf16(siluf(g[0]) * up[0], siluf(g[1]) * up[1]); o[1] = cvt_pk_bf16(siluf(g[2]) * up[2], siluf(g[3]) * up[3]);
                        *(u32x2*)(hid + (size_t)(u.m0 + rl) * 512 + hc) = o;
                    }
                }
            }
    }
};
template <class Epi>
PF void gemm_dense(LAS unsigned char* lds, const bf16_t* A, int M, const bf16_t* Bt, int N, int K, const Epi& epi) {
    pg8::DenseOrder S; S.init(M, N, (int)gridDim.x, (int)blockIdx.x);
    pg8::gemm_phase<false>(lds, A, (const int*)nullptr, Bt, K, S, epi);
}
DI void moe_table(const KC& k, int layer, LAS int* tb) {
    const int* cnt = (const int*)(k.ws + WS_CTL + CTL_CNT) + layer * 32;
    __syncthreads();
    const int tq = TID();
    if (tq < 32) tb[tq] = __hip_atomic_load(cnt + tq, __ATOMIC_RELAXED, __HIP_MEMORY_SCOPE_AGENT);
    __syncthreads();
    if (tq == 0) {
        int s = 0, tp = 0;
        for (int e = 0; e < 32; ++e) { tb[32 + e] = s; tb[65 + e] = tp; s += tb[e]; tp += (tb[e] + 255) >> 8; }
        tb[64] = s; tb[97] = tp;
    }
    __syncthreads();
}
template <int WHICH>
PF void moe_gemm(const KC& k, int layer, LAS unsigned char* lds, LAS int* tb) {
    moe_table(k, layer, tb);
    if (WHICH == 0) {
        pg8::MoeOrder S{tb, (int)gridDim.x, (int)blockIdx.x, (size_t)1024 * 1024 * 2};
        EpiGateUp epi{(bf16_t*)(k.ws + AR_HID)};
        pg8::gemm_phase<true>(lds, (const bf16_t*)(k.ws + AR_HBUF), (const int*)(k.ws + WS_SLOT), (const bf16_t*)(k.ws + AR_WGU), 1024, S, epi);
    } else {
        pg8::MoeOrder S{tb, (int)gridDim.x, (int)blockIdx.x, (size_t)1024 * 512 * 2};
        EpiBf16 epi{(bf16_t*)(k.ws + AR_YS), 1024, 1 << 30, nullptr, 0};
        pg8::gemm_phase<false>(lds, (const bf16_t*)(k.ws + AR_HID), (const int*)nullptr, (const bf16_t*)(k.ws + AR_WD), 512, S, epi);
    }
}
PF void moe_scatter(const KC& k, int layer, LAS int* tb) {
    moe_table(k, layer, tb);
    const int* toke = (const int*)(k.ws + WS_TOKE);
    int* tokp = (int*)(k.ws + WS_TOKP); int* slot = (int*)(k.ws + WS_SLOT);
    int* cur = (int*)(k.ws + WS_CTL + CTL_CNT) + 128 + layer * 32;
    LAS int* lc = tb + 128; LAS int* lb = tb + 160;
    const int tid = TID();
    if (blockIdx.x == 0 && tid < 256) slot[NA + tid] = 0;
    for (int r0 = blockIdx.x * NTHR; r0 < T; r0 += gridDim.x * NTHR) {
        const int r = r0 + tid;
        __syncthreads();
        if (tid < 32) lc[tid] = 0;
        __syncthreads();
        const int e0 = toke[2 * r], e1 = toke[2 * r + 1];
        int k0 = 0, k1 = 0;
        if (e0 >= 0) { k0 = __hip_atomic_fetch_add(lc + e0, 1, __ATOMIC_RELAXED, __HIP_MEMORY_SCOPE_WORKGROUP); k1 = __hip_atomic_fetch_add(lc + e1, 1, __ATOMIC_RELAXED, __HIP_MEMORY_SCOPE_WORKGROUP); }
        __syncthreads();
        if (tid < 32) lb[tid] = lc[tid] > 0 ? atomicAdd(&cur[tid], lc[tid]) : 0;
        __syncthreads();
        if (e0 >= 0) {
            const int p0 = tb[32 + e0] + lb[e0] + k0, p1 = tb[32 + e1] + lb[e1] + k1;
            slot[p0] = r; slot[p1] = r; tokp[2 * r] = p0; tokp[2 * r + 1] = p1;
        }
    }
}

PF void sc_mix(const KC& k, int j) {
    const int tid = TID(), lane = tid & 63, wave = tid >> 6;
    const bf16_t* P = (const bf16_t*)(k.ws + AR_PB);
    bf16_t* U = (bf16_t*)(k.ws + AR_UBUF);
    const float* cw = k.sc_conv + (size_t)j * 3 * 1024;
    for (int r = blockIdx.x * 8 + wave; r < T; r += gridDim.x * 8) {
        bool lok, rok;
        if (r < TC) { const int t = r & 255; lok = t != 0; rok = t != 255; } else { const int t = (r - TC) & 63; lok = t != 0; rok = t != 63; }
        const bf16_t* p = P + (size_t)r * 3072;
#pragma unroll 4
        for (int m = 0; m < 16; ++m) {
            const int col = lane + 64 * m;
            const float bg = bf2f(p[col]);
            const float mc = bf2f(p[1024 + col]) * bf2f(p[2048 + col]);
            const float ml = lok ? bf2f(p[-3072 + 1024 + col]) * bf2f(p[-3072 + 2048 + col]) : 0.f;
            const float mrr = rok ? bf2f(p[3072 + 1024 + col]) * bf2f(p[3072 + 2048 + col]) : 0.f;
            U[(size_t)r * 1024 + col] = f2bf(bg * (cw[col] * ml + cw[1024 + col] * mc + cw[2048 + col] * mrr));
        }
    }
}

constexpr int DN_STEPS = 260, DN_UNITS = 32 * DN_STEPS;
DI int dn_rbase(int b, int dir, int s) {
    if (s < 4) return dir == 0 ? b * 256 + s * 64 : b * 256 + 255 - s * 64;
    const int cc = s - 4;
    return dir == 0 ? TC + b * SEQ + cc * 64 : TC + b * SEQ + SEQ - 1 - cc * 64;
}
PF void dn_chunk(const KC& k, int jl, LAS unsigned char* lds) {
    const int tid = TID(), lane = tid & 63, wave = tid >> 6, fr = lane & 15, fq = lane >> 4;
    LAS bf16_t* Kt = (LAS bf16_t*)lds;
    LAS bf16_t* Qt = Kt + 64 * 136;
    LAS bf16_t* Vt = Qt + 64 * 136;
    LAS float* Amat = (LAS float*)(Vt + 64 * 136);
    LAS bf16_t* Tb = (LAS bf16_t*)(Amat + 64 * 64);
    LAS bf16_t* VbT = Tb + 64 * 72;
    LAS bf16_t* KbT = VbT + 128 * 72;
    LAS float* gcs = (LAS float*)(KbT + 128 * 72);
    LAS float* bet = gcs + 64; LAS float* eg = bet + 64; LAS float* egr = eg + 64;
    LAS float* Tm = egr + 64;
    const bf16_t* P = (const bf16_t*)(k.ws + AR_PB);
    const float* gb = (const float*)(k.ws + WS_GB);
    const float* cw = k.dn_conv + (size_t)jl * 3 * 3072;
    bf16_t* CH = (bf16_t*)(k.ws + AR_CHUNK);
    bf16_t* ATT = (bf16_t*)(k.ws + AR_HBUF);
    float* EGL = (float*)(k.ws + WS_EGL);
    for (int u = blockIdx.x; u < DN_UNITS; u += gridDim.x) {
        const int chain = u / DN_STEPS, s = u - chain * DN_STEPS, dir = chain & 1, h = (chain >> 1) & 7, b = chain >> 4;
        const int rbase = dn_rbase(b, dir, s), rstep = dir == 0 ? 1 : -1;
        bf16_t* cW = CH + (size_t)u * 32768; bf16_t* cQd = cW + 8192; bf16_t* cKd = cQd + 8192; bf16_t* cU = cKd + 8192;
        bf16_t* cAt = ATT + (size_t)u * 4096;
        lds_barrier();
        {
            const int i = tid >> 3, sg = tid & 7, r = rbase + rstep * i;
            bool lok, rok;
            if (r < TC) { const int t = r & 255; lok = t != 0; rok = t != 255; } else { const int t = (r - TC) & 63; lok = t != 0; rok = t != 63; }
#pragma unroll 1
            for (int part = 0; part < 3; ++part) {
                const int col = part * 1024 + h * 128 + sg * 16;
                const bf16_t* pc = P + (size_t)r * 3072 + col;
                float v[16];
#pragma unroll
                for (int hf = 0; hf < 2; ++hf) {
                    const u32x4 c4 = *(const u32x4*)(pc + hf * 8);
                    u32x4 l4 = (u32x4){0u, 0u, 0u, 0u}, r4 = (u32x4){0u, 0u, 0u, 0u};
                    if (lok) l4 = *(const u32x4*)(pc - 3072 + hf * 8);
                    if (rok) r4 = *(const u32x4*)(pc + 3072 + hf * 8);
#pragma unroll
                    for (int w = 0; w < 4; ++w) {
#pragma unroll
                        for (int e = 0; e < 2; ++e) {
                            const int cc = col + hf * 8 + 2 * w + e;
                            const float lv = __uint_as_float(e ? (l4[w] & 0xffff0000u) : (l4[w] << 16));
                            const float cv = __uint_as_float(e ? (c4[w] & 0xffff0000u) : (c4[w] << 16));
                            const float rv = __uint_as_float(e ? (r4[w] & 0xffff0000u) : (r4[w] << 16));
                            v[hf * 8 + 2 * w + e] = siluf(cw[cc] * lv + cw[3072 + cc] * cv + cw[6144 + cc] * rv);
                        }
                    }
                }
                if (part < 2) {
                    float ss = 0.f;
#pragma unroll
                    for (int e = 0; e < 16; ++e) ss += v[e] * v[e];
                    ss += shx(ss, 1, lane); ss += shx(ss, 2, lane); ss += shx(ss, 4, lane);
                    const float sc = rsqrtf(ss + EPS) * (part == 0 ? 0.08838834764831845f : 1.0f);
#pragma unroll
                    for (int e = 0; e < 16; ++e) v[e] *= sc;
                }
                LAS bf16_t* dst = (part == 0 ? Qt : (part == 1 ? Kt : Vt)) + i * 136 + sg * 16;
                u32x4 o0, o1;
#pragma unroll
                for (int w = 0; w < 4; ++w) { o0[w] = pk2(v[2 * w], v[2 * w + 1]); o1[w] = pk2(v[8 + 2 * w], v[8 + 2 * w + 1]); }
                *(LAS u32x4*)dst = o0; *(LAS u32x4*)(dst + 8) = o1;
            }
        }
        if (wave == 0) {
            const size_t row = (size_t)(rbase + rstep * lane);
            float g = gb[row * 32 + dir * 8 + h];
            const float be = gb[row * 32 + 16 + dir * 8 + h];
#pragma unroll
            for (int d = 1; d < 64; d <<= 1) { const float o = shi(g, (lane - d) & 63); if (lane >= d) g += o; }
            const float glast = shi(g, 63);
            gcs[lane] = g; bet[lane] = be; eg[lane] = expf(g); egr[lane] = expf(glast - g);
            if (lane == 0) EGL[u] = expf(glast);
        }
        lds_barrier();
#pragma unroll 1
        for (int x = 0; x < 4; ++x) {
            const int t = wave + 8 * x, isq = t >> 4, mt = (t >> 2) & 3, nt = t & 3;
            f32x4 acc = (f32x4){0.f, 0.f, 0.f, 0.f};
            if (mt >= nt) {
                const LAS bf16_t* Ar = (isq ? Qt : Kt) + (16 * mt + fr) * 136 + 8 * fq;
                const LAS bf16_t* Br = Kt + (16 * nt + fr) * 136 + 8 * fq;
#pragma unroll
                for (int ks = 0; ks < 4; ++ks) acc = __builtin_amdgcn_mfma_f32_16x16x32_bf16(*(const LAS bf16x8*)(Ar + 32 * ks), *(const LAS bf16x8*)(Br + 32 * ks), acc, 0, 0, 0);
            }
            const int jc = 16 * nt + fr; const float gj = gcs[jc];
#pragma unroll
            for (int jj = 0; jj < 4; ++jj) {
                const int ir = 16 * mt + 4 * fq + jj;
                const float dec = expf(fminf(gcs[ir] - gj, 0.f));
                if (isq) cAt[ir * 64 + jc] = f2bf(ir >= jc ? acc[jj] * dec : 0.f);
                else Amat[ir * 64 + jc] = ir > jc ? bet[ir] * acc[jj] * dec : 0.f;
            }
        }
        lds_barrier();
        if (wave < 4) {
            if (lane < 16) {
                const int bo = 16 * wave;
                float tc[16];
#pragma unroll
                for (int i = 0; i < 16; ++i) {
                    float a0 = (i == lane) ? 1.f : 0.f, a1 = 0.f;
#pragma unroll
                    for (int j = 0; j < i; ++j) { const float av = Amat[(bo + i) * 64 + bo + j]; if (j & 1) a1 -= av * tc[j]; else a0 -= av * tc[j]; }
                    tc[i] = a0 + a1;
                    Tm[(bo + i) * 64 + bo + lane] = tc[i];
                }
            }
        } else {
            for (int it = tid - 256; it < 1024; it += 256) {
                const int c = it & 127, ig = it >> 7;
                float kv[8], vv[8];
#pragma unroll
                for (int e = 0; e < 8; ++e) { kv[e] = bf2f(Kt[(8 * ig + e) * 136 + c]); vv[e] = bf2f(Vt[(8 * ig + e) * 136 + c]); }
                u32x4 ov, ok, od;
#pragma unroll
                for (int w = 0; w < 4; ++w) {
                    const int i0 = 8 * ig + 2 * w, i1 = i0 + 1;
                    ov[w] = pk2(bet[i0] * vv[2 * w], bet[i1] * vv[2 * w + 1]);
                    ok[w] = pk2(bet[i0] * eg[i0] * kv[2 * w], bet[i1] * eg[i1] * kv[2 * w + 1]);
                    od[w] = pk2(egr[i0] * kv[2 * w], egr[i1] * kv[2 * w + 1]);
                }
                *(LAS u32x4*)(VbT + c * 72 + 8 * ig) = ov;
                *(LAS u32x4*)(KbT + c * 72 + 8 * ig) = ok;
                *(u32x4*)(cKd + c * 64 + 8 * ig) = od;
            }
            for (int it = tid - 256; it < 1024; it += 256) {
                const int i = it >> 4, c8 = (it & 15) * 8; const float e = eg[i];
                const u32x4 qv = *(const LAS u32x4*)(Qt + i * 136 + c8); u32x4 o;
#pragma unroll
                for (int w = 0; w < 4; ++w) o[w] = pk2(__uint_as_float(qv[w] << 16) * e, __uint_as_float(qv[w] & 0xffff0000u) * e);
                *(u32x4*)(cQd + i * 128 + c8) = o;
            }
        }
        lds_barrier();
#pragma unroll 1
        for (int d = 1; d < 4; ++d) {
            if (wave < 4 - d) {
                const int bi = wave + d, bj = wave, r = lane >> 2, c0 = 4 * (lane & 3);
                f32x4 m = (f32x4){0.f, 0.f, 0.f, 0.f};
                for (int kb = bj; kb < bi; ++kb) {
#pragma unroll
                    for (int kk = 0; kk < 16; ++kk) {
                        const float av = Amat[(16 * bi + r) * 64 + 16 * kb + kk];
                        const f32x4 tv = *(const LAS f32x4*)(Tm + (16 * kb + kk) * 64 + 16 * bj + c0);
                        m += tv * av;
                    }
                }
                *(LAS f32x4*)(Tm + (16 * bj + r) * 64 + 16 * bi + c0) = m;
                f32x4 t = (f32x4){0.f, 0.f, 0.f, 0.f};
#pragma unroll
                for (int kk = 0; kk < 16; ++kk) {
                    const float dv = Tm[(16 * bi + r) * 64 + 16 * bi + kk];
                    const f32x4 mv = *(const LAS f32x4*)(Tm + (16 * bj + kk) * 64 + 16 * bi + c0);
                    t -= mv * dv;
                }
                *(LAS f32x4*)(Tm + (16 * bi + r) * 64 + 16 * bj + c0) = t;
            }
            lds_barrier();
        }
        for (int it = tid; it < 64 * 8; it += NTHR) {
            const int i = it >> 3, c8 = (it & 7) * 8; u32x4 o;
#pragma unroll
            for (int w = 0; w < 4; ++w) {
                const int c = c8 + 2 * w;
                o[w] = pk2(c <= i ? Tm[i * 64 + c] : 0.f, c + 1 <= i ? Tm[i * 64 + c + 1] : 0.f);
            }
            *(LAS u32x4*)(Tb + i * 72 + c8) = o;
        }
        lds_barrier();
        {
            f32x4 au[4], aw[4];
#pragma unroll
            for (int mt = 0; mt < 4; ++mt) { au[mt] = (f32x4){0.f, 0.f, 0.f, 0.f}; aw[mt] = (f32x4){0.f, 0.f, 0.f, 0.f}; }
#pragma unroll
            for (int ks = 0; ks < 2; ++ks) {
                const bf16x8 bv = *(const LAS bf16x8*)(VbT + (16 * wave + fr) * 72 + 32 * ks + 8 * fq);
                const bf16x8 bk = *(const LAS bf16x8*)(KbT + (16 * wave + fr) * 72 + 32 * ks + 8 * fq);
#pragma unroll
                for (int mt = 0; mt < 4; ++mt) {
                    const bf16x8 at = *(const LAS bf16x8*)(Tb + (16 * mt + fr) * 72 + 32 * ks + 8 * fq);
                    au[mt] = __builtin_amdgcn_mfma_f32_16x16x32_bf16(at, bv, au[mt], 0, 0, 0);
                    aw[mt] = __builtin_amdgcn_mfma_f32_16x16x32_bf16(at, bk, aw[mt], 0, 0, 0);
                }
            }
#pragma unroll
            for (int mt = 0; mt < 4; ++mt)
#pragma unroll
                for (int jj = 0; jj < 4; ++jj) {
                    const int ir = 16 * mt + 4 * fq + jj, c = 16 * wave + fr;
                    cU[ir * 128 + c] = f2bf(au[mt][jj]); cW[ir * 128 + c] = f2bf(aw[mt][jj]);
                }
        }
    }
}
constexpr int SC_W = 0, SC_QD = 64 * 136, SC_KD = SC_QD + 64 * 136, SC_AT = SC_KD + 128 * 72, SC_U = SC_AT + 64 * 72, SC_STAGE = SC_U + 16 * 72;
struct ScanRegs { u32x4 v[8]; u32x4 u; };
DI void dn_scan_fetch(const bf16_t* CH, const bf16_t* ATT, int u, int sl, int lt, ScanRegs& R) {
    const bf16_t* cW = CH + (size_t)u * 32768; const bf16_t* cAt = ATT + (size_t)u * 4096;
#pragma unroll
    for (int q = 0; q < 8; ++q) {
        const int id = lt + 448 * q;
        const bf16_t* src;
        if (id < 2048) src = cW + id * 8;
        else if (id < 3072) src = cW + 16384 + (id - 2048) * 8;
        else src = cAt + (id - 3072) * 8;
        R.v[q] = *(const u32x4*)src;
    }
    if (lt < 128) R.u = *(const u32x4*)(cW + 24576 + (lt >> 1) * 128 + sl * 16 + (lt & 1) * 8);
}
DI void dn_scan_put(LAS bf16_t* st, int lt, const ScanRegs& R) {
#pragma unroll
    for (int q = 0; q < 8; ++q) {
        const int id = lt + 448 * q;
        int off;
        if (id < 2048) { const int which = id >> 10, x = id & 1023; off = (which ? SC_QD : SC_W) + (x >> 4) * 136 + (x & 15) * 8; }
        else if (id < 3072) { const int x = id - 2048; off = SC_KD + (x >> 3) * 72 + (x & 7) * 8; }
        else { const int x = id - 3072; off = SC_AT + (x >> 3) * 72 + (x & 7) * 8; }
        *(LAS u32x4*)(st + off) = R.v[q];
    }
    if (lt < 128) {
        const int i = lt >> 1, hf = lt & 1;
#pragma unroll
        for (int w = 0; w < 4; ++w) { st[SC_U + (hf * 8 + 2 * w) * 72 + i] = (bf16_t)(R.u[w] & 0xffff); st[SC_U + (hf * 8 + 2 * w + 1) * 72 + i] = (bf16_t)(R.u[w] >> 16); }
    }
}
DI bf16x8 ld2(const LAS bf16_t* p0, const LAS bf16_t* p1) {
    const u32x2 a = *(const LAS u32x2*)p0, b = *(const LAS u32x2*)p1;
    u32x4 r; r[0] = a[0]; r[1] = a[1]; r[2] = b[0]; r[3] = b[1];
    return __builtin_bit_cast(bf16x8, r);
}
DI bf16x8 pk8(f32x4 a, f32x4 b) { u32x4 r; r[0] = pk2(a[0], a[1]); r[1] = pk2(a[2], a[3]); r[2] = pk2(b[0], b[1]); r[3] = pk2(b[2], b[3]); return __builtin_bit_cast(bf16x8, r); }
PF void dn_scan(const KC& k, LAS unsigned char* lds) {
    const int tid = TID(), lane = tid & 63, wave = tid >> 6, fr = lane & 15, fq = lane >> 4;
    LAS bf16_t* ring = (LAS bf16_t*)lds;
    const bf16_t* CH = (const bf16_t*)(k.ws + AR_CHUNK);
    const bf16_t* ATT = (const bf16_t*)(k.ws + AR_HBUF);
    const float* EGL = (const float*)(k.ws + WS_EGL);
    bf16_t* O = (bf16_t*)(k.ws + AR_PB);
    for (int un0 = blockIdx.x; un0 < 256; un0 += gridDim.x) {
        const int un = (gridDim.x == 256) ? ((un0 & 7) * 32 + (un0 >> 3)) : un0;
        const int sl = un & 7, chain = un >> 3, dir = chain & 1, h = (chain >> 1) & 7, b = chain >> 4;
        const int rstep = dir == 0 ? 1 : -1;
        f32x4 S[8];
#pragma unroll
        for (int t = 0; t < 8; ++t) S[t] = (f32x4){0.f, 0.f, 0.f, 0.f};
        ScanRegs R;
        lds_barrier();
        if (wave > 0) { dn_scan_fetch(CH, ATT, chain * DN_STEPS, sl, tid - 64, R); dn_scan_put(ring, tid - 64, R); dn_scan_fetch(CH, ATT, chain * DN_STEPS + 1, sl, tid - 64, R); }
        lds_barrier();
#pragma unroll 1
        for (int s = 0; s < DN_STEPS; ++s) {
            LAS bf16_t* st = ring + (s & 1) * SC_STAGE;
            if (wave > 0) {
                if (s + 1 < DN_STEPS) dn_scan_put(ring + ((s + 1) & 1) * SC_STAGE, tid - 64, R);
                if (s + 2 < DN_STEPS) dn_scan_fetch(CH, ATT, chain * DN_STEPS + s + 2, sl, tid - 64, R);
            } else {
                const float egl = EGL[chain * DN_STEPS + s];
                bf16x8 sb[4];
#pragma unroll
                for (int ks = 0; ks < 4; ++ks) sb[ks] = pk8(S[2 * ks], S[2 * ks + 1]);
                bf16x8 vb[2]; f32x4 vn[4];
#pragma unroll
                for (int mt = 0; mt < 4; ++mt) {
                    f32x4 p = (f32x4){0.f, 0.f, 0.f, 0.f};
                    const LAS bf16_t* wr = st + SC_W + (16 * mt + fr) * 136 + 4 * fq;
#pragma unroll
                    for (int ks = 0; ks < 4; ++ks) p = __builtin_amdgcn_mfma_f32_16x16x32_bf16(ld2(wr + 32 * ks, wr + 32 * ks + 16), sb[ks], p, 0, 0, 0);
                    const u32x2 uu = *(const LAS u32x2*)(st + SC_U + fr * 72 + 16 * mt + 4 * fq);
                    vn[mt][0] = __uint_as_float(uu[0] << 16) - p[0]; vn[mt][1] = __uint_as_float(uu[0] & 0xffff0000u) - p[1];
                    vn[mt][2] = __uint_as_float(uu[1] << 16) - p[2]; vn[mt][3] = __uint_as_float(uu[1] & 0xffff0000u) - p[3];
                }
                vb[0] = pk8(vn[0], vn[1]); vb[1] = pk8(vn[2], vn[3]);
                const int rbase = dn_rbase(b, dir, s);
#pragma unroll
                for (int mt = 0; mt < 4; ++mt) {
                    f32x4 o = (f32x4){0.f, 0.f, 0.f, 0.f};
                    const LAS bf16_t* qr = st + SC_QD + (16 * mt + fr) * 136 + 4 * fq;
#pragma unroll
                    for (int ks = 0; ks < 4; ++ks) o = __builtin_amdgcn_mfma_f32_16x16x32_bf16(ld2(qr + 32 * ks, qr + 32 * ks + 16), sb[ks], o, 0, 0, 0);
                    const LAS bf16_t* ar = st + SC_AT + (16 * mt + fr) * 72 + 4 * fq;
#pragma unroll
                    for (int kc = 0; kc < 2; ++kc) o = __builtin_amdgcn_mfma_f32_16x16x32_bf16(ld2(ar + 32 * kc, ar + 32 * kc + 16), vb[kc], o, 0, 0, 0);
#pragma unroll
                    for (int jj = 0; jj < 4; ++jj) {
                        const int row = rbase + rstep * (16 * mt + 4 * fq + jj);
                        O[((size_t)dir * T + row) * 1024 + h * 128 + sl * 16 + fr] = f2bf(o[jj]);
                    }
                }
#pragma unroll
                for (int t = 0; t < 8; ++t) {
                    f32x4 a = S[t] * egl;
                    const LAS bf16_t* kr = st + SC_KD + (16 * t + fr) * 72 + 4 * fq;
#pragma unroll
                    for (int kc = 0; kc < 2; ++kc) a = __builtin_amdgcn_mfma_f32_16x16x32_bf16(ld2(kr + 32 * kc, kr + 32 * kc + 16), vb[kc], a, 0, 0, 0);
                    S[t] = a;
                }
            }
            lds_barrier();
        }
    }
}
PF void dn_finish(const KC& k, int j) {
    const int tid = TID(), lane = tid & 63, wave = tid >> 6;
    const bf16_t* O = (const bf16_t*)(k.ws + AR_PB);
    const bf16_t* Z = (const bf16_t*)k.out;
    bf16_t* U = (bf16_t*)(k.ws + AR_UBUF);
    const float* on = k.dn_out_norm + j * 128;
    for (int r = blockIdx.x * 8 + wave; r < T; r += gridDim.x * 8) {
        float o[16];
#pragma unroll
        for (int m = 0; m < 16; ++m) o[m] = bf2f(O[(size_t)r * 1024 + lane + 64 * m]) + bf2f(O[((size_t)T + r) * 1024 + lane + 64 * m]);
#pragma unroll
        for (int hh = 0; hh < 8; ++hh) {
            const float ss = wsum(o[2 * hh] * o[2 * hh] + o[2 * hh + 1] * o[2 * hh + 1], lane);
            const float rs = rsqrtf(ss * (1.0f / 128.0f) + EPS);
#pragma unroll
            for (int q = 0; q < 2; ++q) {
                const int m = 2 * hh + q, col = lane + 64 * m;
                const float z = bf2f(Z[(size_t)r * 1024 + col]);
                U[(size_t)r * 1024 + col] = f2bf(o[m] * rs * on[col & 127] * siluf(z));
            }
        }
    }
}

DI float conv3g(const bf16_t* p, int j, float w0, float w1, float w2) {
    const int gc = j & 63;
    const float l = gc != 0 ? bf2f(p[j - 1]) : 0.f, c = bf2f(p[j]), r = gc != 63 ? bf2f(p[j + 1]) : 0.f;
    return w0 * l + w1 * c + w2 * r;
}
PF void hy_lat(const KC& k, int jl, LAS float* ldsf) {
    const int tid = TID();
    LAS cf* X = (LAS cf*)ldsf;
    LAS cf* tw = X + 17408;
    const float* FT = (const float*)(k.ws + AR_FT);
    const bf16_t* PT = (const bf16_t*)(k.ws + AR_PB);
    bf16_t* ZT = (bf16_t*)(k.ws + AR_ZT);
    cf* scr = (cf*)(k.ws + AR_FFTS) + (size_t)blockIdx.x * 4 * 16384;
    cf* sKe = scr; cf* sKo = scr + 16384; cf* zp = scr + 2 * 16384; cf* ye = scr + 3 * 16384;
    const float* cw = k.hy_conv + (size_t)jl * 3 * 3072;
    for (int m = 0; m < 2; ++m) { const int p = tid + 512 * m; float sn, cs; sincospif(-(float)p / 8192.0f, &sn, &cs); cf w; w.x = cs; w.y = sn; tw[p] = w; }
    __syncthreads();
    for (int ch = blockIdx.x; ch < 1024; ch += gridDim.x) {
        {
            const bf16_t* pv = PT + (size_t)ch * T + TC;
            const float w0 = cw[ch], w1 = cw[3072 + ch], w2 = cw[6144 + ch];
            _Pragma("unroll 1") for (int m = 0; m < 32; ++m) { const int j = tid + 512 * m; cf z; z.x = conv3g(pv, j, w0, w1, w2); z.y = conv3g(pv + SEQ, j, w0, w1, w2); zp[j] = z; }
        }
        for (int n = 0; n < 2; ++n) {
            __syncthreads();
            const float* ftf = FT + (size_t)(n * 2048 + ch) * 16384; const float* ftb = FT + (size_t)(n * 2048 + 1024 + ch) * 16384;
            _Pragma("unroll 1") for (int m = 0; m < 32; ++m) {
                const int j = tid + 512 * m;
                const float hf = ftf[j], hb = j > 0 ? ftb[SEQ - j] : 0.f;
                float sn, cs; sincospif(-(float)j / 16384.0f, &sn, &cs);
                cf a; a.x = hf + hb; a.y = 0.f; X[PIDX(j)] = a;
                const float kd = hf - hb; cf o; o.x = kd * cs; o.y = kd * sn; sKo[j] = o;
            }
            __syncthreads();
            fft16k_fwd(X, tw);
            _Pragma("unroll 1") for (int m = 0; m < 32; ++m) { const int j = tid + 512 * m; sKe[j] = X[PIDX(j)]; }
            __syncthreads();
            _Pragma("unroll 1") for (int m = 0; m < 32; ++m) { const int j = tid + 512 * m; X[PIDX(j)] = sKo[j]; }
            __syncthreads();
            fft16k_fwd(X, tw);
            _Pragma("unroll 1") for (int m = 0; m < 32; ++m) { const int j = tid + 512 * m; sKo[j] = X[PIDX(j)]; }
            __syncthreads();
            _Pragma("unroll 1") for (int m = 0; m < 32; ++m) { const int j = tid + 512 * m; X[PIDX(j)] = zp[j]; }
            __syncthreads();
            fft16k_fwd(X, tw);
            _Pragma("unroll 1") for (int m = 0; m < 32; ++m) { const int j = tid + 512 * m; X[PIDX(j)] = cmul(X[PIDX(j)], sKe[j]); }
            __syncthreads();
            fft16k_inv(X, tw);
            _Pragma("unroll 1") for (int m = 0; m < 32; ++m) { const int j = tid + 512 * m; ye[j] = X[PIDX(j)]; }
            __syncthreads();
            _Pragma("unroll 1") for (int m = 0; m < 32; ++m) { const int j = tid + 512 * m; float sn, cs; sincospif(-(float)j / 16384.0f, &sn, &cs); cf w; w.x = cs; w.y = sn; X[PIDX(j)] = cmul(zp[j], w); }
            __syncthreads();
            fft16k_fwd(X, tw);
            _Pragma("unroll 1") for (int m = 0; m < 32; ++m) { const int j = tid + 512 * m; X[PIDX(j)] = cmul(X[PIDX(j)], sKo[j]); }
            __syncthreads();
            fft16k_inv(X, tw);
            {
                const bf16_t* pg = PT + (size_t)((n + 1) * 1024 + ch) * T + TC;
                const int gcol = (n + 1) * 1024 + ch;
                const float w0 = cw[gcol], w1 = cw[3072 + gcol], w2 = cw[6144 + gcol];
                const float bias = k.hy_bias[(size_t)jl * 2 * 1024 + n * 1024 + ch];
                _Pragma("unroll 1") for (int m = 0; m < 32; ++m) {
                    const int j = tid + 512 * m;
                    float sn, cs; sincospif((float)j / 16384.0f, &sn, &cs); cf w; w.x = cs; w.y = sn;
                    const cf yo = cmul(X[PIDX(j)], w); const cf e = ye[j]; const cf zprev = zp[j];
                    const float y0 = (0.5f / 16384.0f) * (e.x + yo.x), y1 = (0.5f / 16384.0f) * (e.y + yo.y);
                    cf zn; zn.x = conv3g(pg, j, w0, w1, w2) * (y0 + bias * zprev.x); zn.y = conv3g(pg + SEQ, j, w0, w1, w2) * (y1 + bias * zprev.y);
                    zp[j] = zn;
                }
            }
        }
        _Pragma("unroll 1") for (int m = 0; m < 32; ++m) { const int j = tid + 512 * m; const cf z = zp[j]; ZT[(size_t)ch * T + TC + j] = f2bf(z.x); ZT[(size_t)ch * T + TC + SEQ + j] = f2bf(z.y); }
        __syncthreads();
    }
}
PF void hy_ctx(const KC& k, int jl, LAS float* lds) {
    const int tid = TID(), t = tid & 255, hsel = tid >> 8;
    LAS float* z = lds + hsel * 768; LAS float* hf = z + 256; LAS float* hb = hf + 256;
    const bf16_t* PT = (const bf16_t*)(k.ws + AR_PB);
    bf16_t* U = (bf16_t*)(k.ws + AR_UBUF);
    const float* filtc = (const float*)(k.ws + WS_FILTC);
    const float* cw = k.hy_conv + (size_t)jl * 3 * 3072;
    for (int u = blockIdx.x; u < 1024; u += gridDim.x) {
        const int pr = u * 2 + hsel, b = pr >> 10, ch = pr & 1023;
        float zc;
        {
            const bf16_t* pv = PT + (size_t)ch * T + b * 256;
            const float l = t != 0 ? bf2f(pv[t - 1]) : 0.f, c = bf2f(pv[t]), r = t != 255 ? bf2f(pv[t + 1]) : 0.f;
            zc = cw[ch] * l + cw[3072 + ch] * c + cw[6144 + ch] * r;
        }
        for (int n = 0; n < 2; ++n) {
            __syncthreads();
            z[t] = zc; hf[t] = filtc[(size_t)t * 4096 + n * 2048 + ch]; hb[t] = filtc[(size_t)t * 4096 + n * 2048 + 1024 + ch];
            __syncthreads();
            float y = 0.f;
            for (int s = 0; s <= t; ++s) y += hf[t - s] * z[s];
            for (int s = t + 1; s < 256; ++s) y += hb[s - t] * z[s];
            const int gcol = (n + 1) * 1024 + ch;
            const bf16_t* pg = PT + (size_t)gcol * T + b * 256;
            const float l = t != 0 ? bf2f(pg[t - 1]) : 0.f, c = bf2f(pg[t]), r = t != 255 ? bf2f(pg[t + 1]) : 0.f;
            const float gate = cw[gcol] * l + cw[3072 + gcol] * c + cw[6144 + gcol] * r;
            zc = gate * (y + k.hy_bias[(size_t)jl * 2048 + n * 1024 + ch] * zc);
        }
        U[(size_t)(b * 256 + t) * 1024 + ch] = f2bf(zc);
        __syncthreads();
    }
}
PF void hy_transpose(const KC& k, LAS bf16_t* lds) {
    const int tid = TID();
    const bf16_t* ZT = (const bf16_t*)(k.ws + AR_ZT);
    bf16_t* U = (bf16_t*)(k.ws + AR_UBUF);
    for (int u = blockIdx.x; u < 16 * (TL / 64); u += gridDim.x) {
        const int c0 = (u & 15) * 64, r0 = TC + (u >> 4) * 64;
        { const int c = tid >> 3, sg = (tid & 7) * 8;
          const u32x4 v = *(const u32x4*)(ZT + (size_t)(c0 + c) * T + r0 + sg);
#pragma unroll
          for (int w = 0; w < 4; ++w) { lds[(sg + 2 * w) * 66 + c] = (bf16_t)(v[w] & 0xffff); lds[(sg + 2 * w + 1) * 66 + c] = (bf16_t)(v[w] >> 16); } }
        __syncthreads();
        { const int r = tid >> 3, sg = (tid & 7) * 8; u32x4 o;
#pragma unroll
          for (int w = 0; w < 4; ++w) o[w] = (unsigned)lds[r * 66 + sg + 2 * w] | ((unsigned)lds[r * 66 + sg + 2 * w + 1] << 16);
          *(u32x4*)(U + (size_t)(r0 + r) * 1024 + c0 + sg) = o; }
        __syncthreads();
    }
}

__global__ void __launch_bounds__(NTHR, 2) fwd_kernel(Params prm) {
    extern __shared__ __attribute__((aligned(16))) unsigned char lds_raw[];
    LAS unsigned char* lds = (LAS unsigned char*)lds_raw;
    LAS float* ldsf = (LAS float*)lds;
    LAS bf16_t* ldsh = (LAS bf16_t*)lds;
    LAS int* tb = (LAS int*)(lds + 150 * 1024);
    volatile LAS unsigned* xbw = (volatile LAS unsigned*)(lds + 151 * 1024 + 512);
    KC k;
    k.x = (const float*)(GAS const float*)prm.in[0]; k.c = (const float*)(GAS const float*)prm.in[1]; k.ctx = (const float*)(GAS const float*)prm.in[2]; k.c_ctx = (const float*)(GAS const float*)prm.in[3]; k.ada_w = (const float*)(GAS const float*)prm.in[4]; k.ada_b = (const float*)(GAS const float*)prm.in[5];
    k.norm_mix = (const float*)(GAS const float*)prm.in[6]; k.norm_ffn = (const float*)(GAS const float*)prm.in[7]; k.norm_final = (const float*)(GAS const float*)prm.in[8];
    k.dn_w_in = (const float*)(GAS const float*)prm.in[9]; k.dn_conv = (const float*)(GAS const float*)prm.in[10]; k.dn_a_log = (const float*)(GAS const float*)prm.in[11]; k.dn_dt_bias = (const float*)(GAS const float*)prm.in[12]; k.dn_out_norm = (const float*)(GAS const float*)prm.in[13]; k.dn_w_out = (const float*)(GAS const float*)prm.in[14];
    k.hy_w_in = (const float*)(GAS const float*)prm.in[15]; k.hy_conv = (const float*)(GAS const float*)prm.in[16]; k.hy_f_w1 = (const float*)(GAS const float*)prm.in[17]; k.hy_f_b1 = (const float*)(GAS const float*)prm.in[18]; k.hy_f_freq = (const float*)(GAS const float*)prm.in[19]; k.hy_f_w2 = (const float*)(GAS const float*)prm.in[20];
    k.hy_f_b2 = (const float*)(GAS const float*)prm.in[21]; k.hy_f_w3 = (const float*)(GAS const float*)prm.in[22]; k.hy_bias = (const float*)(GAS const float*)prm.in[23]; k.hy_w_out = (const float*)(GAS const float*)prm.in[24];
    k.sc_w_in = (const float*)(GAS const float*)prm.in[25]; k.sc_conv = (const float*)(GAS const float*)prm.in[26]; k.sc_w_out = (const float*)(GAS const float*)prm.in[27]; k.w_router = (const float*)(GAS const float*)prm.in[28]; k.router_bias = (const float*)(GAS const float*)prm.in[29];
    k.moe_w_gate = (const float*)(GAS const float*)prm.in[30]; k.moe_w_up = (const float*)(GAS const float*)prm.in[31]; k.moe_w_down = (const float*)(GAS const float*)prm.in[32];
    k.out = (float*)(GAS float*)prm.out; k.ws = (unsigned char*)(GAS unsigned char*)prm.ws;
    const int lo = prm.ph_lo, hi = prm.ph_hi;
    XcdBarrier bar; bar.bar = (unsigned*)(k.ws + WS_CTL); bar.x = 0; bar.st = xbw;
    if (hi - lo > 1) {
        if (threadIdx.x == 0) { xbw[0] = 0u; xbw[1] = 0u; }
        __syncthreads();
        bar = xcd_barrier_post((unsigned*)(k.ws + WS_CTL), xbw);
    }
    int ph = 0;
#define PROBE_OK(id) ((id) != 1 || i == 0)
    int i = 0;
#define PH_BEGIN(id) if (ph >= lo && ph < hi) { const int nrep_ = (((id) == PROBE_REP) && PROBE_OK(id)) ? 2 : 1; for (int rep_ = 0; rep_ < nrep_; ++rep_) { { GAS unsigned char* w_ = (GAS unsigned char*)k.ws; asm volatile("" : "+s"(w_)); k.ws = (unsigned char*)w_; }
#define PH_END   if (ph + 1 < hi) xcd_barrier(bar); } } ++ph;

    float* xs = (float*)(k.ws + WS_XS);
    const float* mod = (const float*)(k.ws + WS_MOD);

    PH_BEGIN(0)
        job_mod(k, ldsf);
        job_cvt_small(k, ldsf);
        job_hdn(k, ldsf);
        job_w3s(k);
    PH_END

    for (i = 0; i < DEPTH; ++i) {
        const int kind = i % 3, j = i / 3;
        const bool last = (i == DEPTH - 1);
        PH_BEGIN(1)
            if (kind == 0) norm_phase<2>(k, i, i == 0, i > 0, k.norm_mix + i * 1024, 0, k.dn_w_in + (size_t)j * 1024 * DN_IN + 4096, DN_IN,
                                         k.dn_a_log + j * 16, k.dn_dt_bias + j * 16, last, ldsf);
            else norm_phase<0>(k, i, i == 0, i > 0, k.norm_mix + i * 1024, 0, nullptr, 0, nullptr, nullptr, last, ldsf);
            if (kind == 1) job_filtc(k, j);
        PH_END
        PH_BEGIN(2)
            if (kind == 0) { EpiBf16 e{(bf16_t*)(k.ws + AR_PB), 3072, 3072, (bf16_t*)k.out, 1024}; gemm_dense(lds, (const bf16_t*)(k.ws + AR_HBUF), T, (const bf16_t*)(k.ws + WS_DNWIN) + (size_t)j * 4096 * 1024, 4096, 1024, e); }
            else if (kind == 1) { EpiBf16T e{(bf16_t*)(k.ws + AR_PB), T}; gemm_dense(lds, (const bf16_t*)(k.ws + AR_HBUF), T, (const bf16_t*)(k.ws + WS_HYWIN), 3072, 1024, e);
                                  EpiTaps et{(float*)(k.ws + AR_FT)}; gemm_dense(lds, (const bf16_t*)(k.ws + WS_W3S), 4096, (const bf16_t*)(k.ws + WS_HS), 16384, 256, et); }
            else { EpiBf16 e{(bf16_t*)(k.ws + AR_PB), 3072, 1 << 30, nullptr, 0}; gemm_dense(lds, (const bf16_t*)(k.ws + AR_HBUF), T, (const bf16_t*)(k.ws + WS_SCWIN), 3072, 1024, e); }
        PH_END
        if (kind == 0) {
            PH_BEGIN(3) dn_chunk(k, j, lds); PH_END
            PH_BEGIN(4) dn_scan(k, lds); PH_END
            PH_BEGIN(5) dn_finish(k, j); PH_END
        } else if (kind == 1) {
            PH_BEGIN(6) hy_lat(k, j, ldsf); hy_ctx(k, j, ldsf); PH_END
            PH_BEGIN(7) hy_transpose(k, ldsh); PH_END
        } else {
            PH_BEGIN(8) sc_mix(k, j); PH_END
        }
        PH_BEGIN(9)
            const bf16_t* Wt = kind == 0 ? (const bf16_t*)(k.ws + WS_DNWOUT) + (size_t)j * 1024 * 1024 : (kind == 1 ? (const bf16_t*)(k.ws + WS_HYWOUT) : (const bf16_t*)(k.ws + WS_SCWOUT));
            EpiResid e{xs, mod, i, 2};
            gemm_dense(lds, (const bf16_t*)(k.ws + AR_UBUF), T, Wt, 1024, 1024, e);
        PH_END
        PH_BEGIN(10)
            norm_phase<1>(k, i, false, false, k.norm_ffn + i * 1024, 3, k.w_router, 32, k.router_bias, nullptr, last, ldsf, rep_ == nrep_ - 1);
        PH_END
        PH_BEGIN(11)
            if (rep_ == 0) moe_scatter(k, i, tb);
            job_cvt_moe(k, i, ldsf);
        PH_END
        PH_BEGIN(12) moe_gemm<0>(k, i, lds, tb); PH_END
        PH_BEGIN(13) moe_gemm<1>(k, i, lds, tb); PH_END
    }
    PH_BEGIN(14)
        norm_phase<3>(k, DEPTH, false, true, k.norm_final, 0, nullptr, 0, nullptr, nullptr, false, ldsf);
    PH_END
#undef PH_BEGIN
#undef PH_END
}
constexpr int N_PHASES = 1 + (10 + 9 + 8 + 10) + 1;

extern "C" void kernel_launch(void* const* d_in, const int* in_sizes, int n_in, void* d_out, int out_size, void* d_ws, size_t ws_size, hipStream_t stream) {
    static int grid = 0;
    if (grid == 0) {
        if (n_in != 33 || out_size != TL * D || ws_size < WS_END) { fprintf(stderr, "kernel_launch: unexpected shapes: n_in %d out %d ws %zu (need %zu)\n", n_in, out_size, ws_size, (size_t)WS_END); grid = -1; return; }
        int dev = 0, cus = 0, per_cu = 0;
        if (hipGetDevice(&dev) != hipSuccess || hipDeviceGetAttribute(&cus, hipDeviceAttributeMultiprocessorCount, dev) != hipSuccess) { grid = -1; return; }
        if (hipFuncSetAttribute((const void*)fwd_kernel, hipFuncAttributeMaxDynamicSharedMemorySize, LDS_BYTES) != hipSuccess) { fprintf(stderr, "kernel_launch: hipFuncSetAttribute failed\n"); grid = -1; return; }
        if (hipOccupancyMaxActiveBlocksPerMultiprocessor(&per_cu, (const void*)fwd_kernel, NTHR, LDS_BYTES) != hipSuccess || per_cu < 1) fprintf(stderr, "kernel_launch: occupancy query reports %d\n", per_cu);
        (void)hipGetLastError();
        grid = cus;
    }
    if (grid < 0) return;
    (void)hipMemsetAsync((char*)d_ws + WS_CTL, 0, CTL_BYTES, stream);
    Params p{};
    for (int i = 0; i < 33; ++i) p.in[i] = (const float*)d_in[i];
    p.out = (float*)d_out; p.ws = (unsigned char*)d_ws;
#if MK_MULTI
    for (int ph = 0; ph < N_PHASES; ++ph) { p.ph_lo = ph; p.ph_hi = ph + 1; hipLaunchKernelGGL(fwd_kernel, dim3(grid), dim3(NTHR), LDS_BYTES, stream, p); }
#else
    p.ph_lo = 0; p.ph_hi = N_PHASES;
    hipLaunchKernelGGL(fwd_kernel, dim3(grid), dim3(NTHR), LDS_BYTES, stream, p);
#endif
}
```

```cpp
#include <hip/hip_runtime.h>
#include <stdint.h>
#include <stdio.h>
#include <math.h>

#ifndef MK_MULTI
#define MK_MULTI 0
#endif

#ifndef PROBE_SUB
#define PROBE_SUB (0)
#endif
#ifndef PROBE_REP
#define PROBE_REP (-1)
#endif
#define LAS __attribute__((address_space(3)))
#define GAS __attribute__((address_space(1)))
#define HD __host__ __device__ __forceinline__
#define DI __device__ __forceinline__
#ifdef NOINL
#define PF __device__ __noinline__
#else
#define PF __device__ __forceinline__
#endif
typedef unsigned short bf16_t;
typedef short bf16x8 __attribute__((ext_vector_type(8)));
typedef float f32x4 __attribute__((ext_vector_type(4)));
typedef unsigned u32x4 __attribute__((ext_vector_type(4)));
typedef unsigned u32x2 __attribute__((ext_vector_type(2)));

constexpr int D = 1024, NB = 2, SEQ = 16384, CTXL = 256, DEPTH = 4;
constexpr int TC = NB * CTXL, TL = NB * SEQ, T = TC + TL, NA = 2 * T;
constexpr int NTHR = 512;
constexpr int DN_IN = 4128;
constexpr float EPS = 1e-6f;
constexpr int LDS_BYTES = 152 * 1024;

constexpr size_t AL(size_t x) { return (x + 255) & ~(size_t)255; }
constexpr size_t WS_CTL = 0;
constexpr size_t CTL_BYTES = 65536;
constexpr size_t CTL_CNT = 16384;
constexpr size_t WS_MOD = WS_CTL + CTL_BYTES;
constexpr size_t WS_HS = AL(WS_MOD + 4 * 3 * 6144 * 4);
constexpr size_t WS_W3S = AL(WS_HS + 16384 * 256 * 2);
constexpr size_t WS_HDNC = AL(WS_W3S + 4096 * 256 * 2);
constexpr size_t WS_FILTC = AL(WS_HDNC + 256 * 64 * 4);
constexpr size_t WS_DNWIN = AL(WS_FILTC + 256 * 4096 * 4);
constexpr size_t WS_DNWOUT = AL(WS_DNWIN + (size_t)2 * 4096 * 1024 * 2);
constexpr size_t WS_HYWIN = AL(WS_DNWOUT + (size_t)2 * 1024 * 1024 * 2);
constexpr size_t WS_HYWOUT = AL(WS_HYWIN + (size_t)3072 * 1024 * 2);
constexpr size_t WS_SCWIN = AL(WS_HYWOUT + (size_t)1024 * 1024 * 2);
constexpr size_t WS_SCWOUT = AL(WS_SCWIN + (size_t)3072 * 1024 * 2);
constexpr size_t WS_XS = AL(WS_SCWOUT + (size_t)1024 * 1024 * 2);
constexpr size_t WS_TOKE = AL(WS_XS + (size_t)T * 1024 * 4);
constexpr size_t WS_TOKW = AL(WS_TOKE + (size_t)T * 2 * 4);
constexpr size_t WS_TOKP = AL(WS_TOKW + (size_t)T * 2 * 4);
constexpr size_t WS_SLOT = AL(WS_TOKP + (size_t)T * 2 * 4);
constexpr size_t WS_GB = AL(WS_SLOT + (size_t)(NA + 256) * 4);
constexpr size_t WS_EGL = AL(WS_GB + (size_t)T * 32 * 4);
constexpr size_t WS_AR = AL(WS_EGL + (size_t)32 * 260 * 4);
constexpr size_t AR_HBUF = WS_AR;
constexpr size_t AR_UBUF = AR_HBUF + (size_t)T * 1024 * 2;
constexpr size_t AR_PB = AR_UBUF + (size_t)T * 1024 * 2;
constexpr size_t AR_Q = AR_PB + (size_t)T * 4096 * 2;
constexpr size_t AR_CHUNK = AR_PB + (size_t)T * 3072 * 2;
constexpr size_t AR_DN_END = AR_CHUNK + (size_t)32 * 260 * 65536;
constexpr size_t AR_ZT = AR_Q;
constexpr size_t AR_FFTS = AR_ZT + (size_t)1024 * T * 2;
constexpr size_t AR_FT = AR_FFTS + (size_t)256 * 4 * 16384 * 8;
constexpr size_t AR_HY_END = AR_FT + (size_t)4096 * 16384 * 4;
constexpr size_t AR_HID = AR_PB;
constexpr size_t AR_YS = AR_HID + (size_t)NA * 512 * 2;
constexpr size_t AR_WGU = AR_YS + (size_t)NA * 1024 * 2;
constexpr size_t AR_WD = AR_WGU + (size_t)32 * 1024 * 1024 * 2;
constexpr size_t AR_MOE_END = AR_WD + (size_t)32 * 1024 * 512 * 2;
constexpr size_t WS_END = AR_DN_END > AR_HY_END ? (AR_DN_END > AR_MOE_END ? AR_DN_END : AR_MOE_END) : (AR_HY_END > AR_MOE_END ? AR_HY_END : AR_MOE_END);

#define XB_TMO      128
#define XB_XCNT(j)  (256  + 64 * (j))
#define XB_XSUB(j)  (1280 + 64 * (j))
#define XB_XGEN(j)  (2304 + 64 * (j))
#define XB_TOP      3328
#define XB_TOPGEN   3392
#define XCD_BAR_WORDS 3456
#define XB_SPIN_CAP (1u << 25)
DI unsigned xb_ld(unsigned* p)              { return __hip_atomic_load(p, __ATOMIC_RELAXED, __HIP_MEMORY_SCOPE_AGENT); }
DI unsigned xb_add(unsigned* p, unsigned v) { return __hip_atomic_fetch_add(p, v, __ATOMIC_RELAXED, __HIP_MEMORY_SCOPE_AGENT); }
DI unsigned xb_xcc_id() { return (unsigned)__builtin_amdgcn_s_getreg((3 << 11) | 20) & 0xFu; }
#define XB_SPIN(cond, bar) do { unsigned _sp = 0; while (cond) { __builtin_amdgcn_s_sleep(1); \
    if ((++_sp & 255u) == 0u) { if (xb_ld(&(bar)[XB_TMO])) break; if (_sp > XB_SPIN_CAP) { atomicAdd(&(bar)[XB_TMO], 1u); break; } } } } while (0)
struct XcdBarrier { unsigned* bar; unsigned x; volatile LAS unsigned* st; };
DI XcdBarrier xcd_barrier_post(unsigned* bar, volatile LAS unsigned* st) {
    XcdBarrier b; b.bar = bar; b.x = xb_xcc_id(); b.st = st;
    if (threadIdx.x == 0) (void)xb_add(&bar[XB_XCNT(b.x)], 1u);
    return b;
}
DI void xcd_barrier_complete(unsigned* bar, unsigned x, unsigned& nloc, unsigned& nx) {
    const unsigned G = gridDim.x * gridDim.y * gridDim.z;
    unsigned sum, cnt, mine, sp = 0u;
    for (;;) {
        sum = 0u; cnt = 0u; mine = 0u;
#pragma unroll
        for (unsigned j = 0; j < 16; ++j) { const unsigned c = xb_ld(&bar[XB_XCNT(j)]); sum += c; cnt += (c > 0u) ? 1u : 0u; mine = (j == x) ? c : mine; }
        if (sum == G) break;
        __builtin_amdgcn_s_sleep(1);
        if ((++sp & 255u) == 0u) { if (xb_ld(&bar[XB_TMO])) break; if (sp > XB_SPIN_CAP) { atomicAdd(&bar[XB_TMO], 1u); break; } }
    }
    nloc = mine > 0u ? mine : 1u; nx = cnt > 0u ? cnt : 1u;
}
DI void xcd_barrier(const XcdBarrier& b) {
    asm volatile("s_waitcnt vmcnt(0)" ::: "memory");
    __syncthreads();
    if (threadIdx.x == 0) {
        unsigned* bar = b.bar;
        __builtin_amdgcn_s_waitcnt(0);
        unsigned nloc = b.st[0], nx = b.st[1];
        if (nloc == 0u) { xcd_barrier_complete(bar, b.x, nloc, nx); b.st[0] = nloc; b.st[1] = nx; }
        const unsigned old = xb_add(&bar[XB_XSUB(b.x)], 1u);
        const unsigned gen = old / nloc;
        if (old + 1u == (gen + 1u) * nloc) {
            __builtin_amdgcn_fence(__ATOMIC_RELEASE, "agent");
            asm volatile("s_waitcnt vmcnt(0)" ::: "memory");
            const unsigned og = xb_add(&bar[XB_TOP], 1u);
            const unsigned tg = og / nx;
            if (og + 1u == (tg + 1u) * nx) xb_add(&bar[XB_TOPGEN], 1u);
            else XB_SPIN(xb_ld(&bar[XB_TOPGEN]) == tg, bar);
            __builtin_amdgcn_fence(__ATOMIC_ACQUIRE, "agent");
            xb_add(&bar[XB_XGEN(b.x)], 1u);
            asm volatile("s_waitcnt vmcnt(0)" ::: "memory");
        } else {
            XB_SPIN(xb_ld(&bar[XB_XGEN(b.x)]) == gen, bar);
            __builtin_amdgcn_fence(__ATOMIC_ACQUIRE, "agent");
            asm volatile("s_waitcnt vmcnt(0)" ::: "memory");
        }
    }
    __syncthreads();
}

typedef float f32x2_t __attribute__((ext_vector_type(2)));
typedef __bf16 bf16x2_t __attribute__((ext_vector_type(2)));
DI unsigned cvt_pk_bf16(float lo, float hi) { f32x2_t v; v.x = lo; v.y = hi; const bf16x2_t b = __builtin_convertvector(v, bf16x2_t); return __builtin_bit_cast(unsigned, b); }
DI bf16_t f2bf(float f) { return (bf16_t)(cvt_pk_bf16(f, f) & 0xffffu); }
DI float bf2f(bf16_t b) { return __uint_as_float(((unsigned)b) << 16); }
DI unsigned pk2(float lo, float hi) { return cvt_pk_bf16(lo, hi); }
DI float siluf(float x) { return x * __builtin_amdgcn_rcpf(1.0f + __expf(-x)); }
DI float sigmf(float x) { return 1.0f / (1.0f + __expf(-x)); }
DI float shi(float v, int src) { return __int_as_float(__builtin_amdgcn_ds_bpermute(src << 2, __float_as_int(v))); }
DI int shii(int v, int src) { return __builtin_amdgcn_ds_bpermute(src << 2, v); }
DI float shx(float v, int m, int lane) { return shi(v, lane ^ m); }
DI float wsum(float v, int lane) {
#pragma unroll
    for (int m = 32; m >= 1; m >>= 1) v += shx(v, m, lane);
    return v;
}
DI void lds_barrier() { asm volatile("s_waitcnt lgkmcnt(0)\n\ts_barrier" ::: "memory"); }
DI int TID() { int t = threadIdx.x; asm volatile("" : "+v"(t)); return t; }
DI int modrow(int r) { return r < TC ? 0 : 1 + (r - TC) / SEQ; }

typedef float cf __attribute__((ext_vector_type(2)));
HD cf cmul(cf a, cf b) { cf r; r.x = a.x * b.x - a.y * b.y; r.y = a.x * b.y + a.y * b.x; return r; }
HD cf cadd(cf a, cf b) { cf r; r.x = a.x + b.x; r.y = a.y + b.y; return r; }
HD cf csub(cf a, cf b) { cf r; r.x = a.x - b.x; r.y = a.y - b.y; return r; }
template <int R> HD constexpr int brev(int i) { int r = 0; for (int b = 1, t = R >> 1; b < R; b <<= 1, t >>= 1) if (i & b) r |= t; return r; }
#define FFT_C32 {1.0f, 0.98078528040323044913f, 0.92387953251128675613f, 0.83146961230254523708f, 0.70710678118654752440f, 0.55557023301960222474f, 0.38268343236508977173f, 0.19509032201612826785f, 0.0f, -0.19509032201612826785f, -0.38268343236508977173f, -0.55557023301960222474f, -0.70710678118654752440f, -0.83146961230254523708f, -0.92387953251128675613f, -0.98078528040323044913f}
#define FFT_S32 {0.0f, 0.19509032201612826785f, 0.38268343236508977173f, 0.55557023301960222474f, 0.70710678118654752440f, 0.83146961230254523708f, 0.92387953251128675613f, 0.98078528040323044913f, 1.0f, 0.98078528040323044913f, 0.92387953251128675613f, 0.83146961230254523708f, 0.70710678118654752440f, 0.55557023301960222474f, 0.38268343236508977173f, 0.19509032201612826785f}
template <int R> HD constexpr int ilog2c() { int l = 0; for (int r = R; r > 1; r >>= 1) ++l; return l; }
template <int R> HD void dft_fwd(cf (&v)[R]) {
    constexpr float C[16] = FFT_C32; constexpr float S[16] = FFT_S32;
    constexpr int LG = ilog2c<R>();
#pragma unroll
    for (int st = 0; st < LG; ++st) {
#pragma unroll
        for (int i = 0; i < R / 2; ++i) {
            const int len = R >> st, half = len >> 1, blk = i / half, j = i % half, i0 = blk * len + j, i1 = i0 + half;
            const cf a = v[i0], c = v[i1];
            v[i0] = cadd(a, c);
            const cf d = csub(a, c);
            const int ti = j * (32 / len);
            cf w; w.x = C[ti]; w.y = -S[ti];
            cf r;
            if (ti == 0) r = d;
            else if (ti == 8) { r.x = d.y; r.y = -d.x; }
            else if (ti == 4) { r.x = (d.x + d.y) * 0.70710678118654752440f; r.y = (d.y - d.x) * 0.70710678118654752440f; }
            else if (ti == 12) { r.x = (d.y - d.x) * 0.70710678118654752440f; r.y = -(d.x + d.y) * 0.70710678118654752440f; }
            else r = cmul(d, w);
            v[i1] = r;
        }
    }
}
template <int R> HD void dft_inv(cf (&v)[R]) {
    constexpr float C[16] = FFT_C32; constexpr float S[16] = FFT_S32;
    constexpr int LG = ilog2c<R>();
#pragma unroll
    for (int st = LG - 1; st >= 0; --st) {
#pragma unroll
        for (int i = 0; i < R / 2; ++i) {
            const int len = R >> st, half = len >> 1, blk = i / half, j = i % half, i0 = blk * len + j, i1 = i0 + half;
            const int ti = j * (32 / len);
            cf w; w.x = C[ti]; w.y = S[ti];
            const cf a = v[i0];
            const cf b1 = v[i1];
            cf c;
            if (ti == 0) c = b1;
            else if (ti == 8) { c.x = -b1.y; c.y = b1.x; }
            else if (ti == 4) { c.x = (b1.x - b1.y) * 0.70710678118654752440f; c.y = (b1.x + b1.y) * 0.70710678118654752440f; }
            else if (ti == 12) { c.x = -(b1.x + b1.y) * 0.70710678118654752440f; c.y = (b1.x - b1.y) * 0.70710678118654752440f; }
            else c = cmul(b1, w);
            v[i0] = cadd(a, c);
            v[i1] = csub(a, c);
        }
    }
}
#define PIDX(a) ((a) + (((a) >> 6) << 2))
template <int R> DI void fft_pass_fwd(LAS cf* X, const LAS cf* tw, int n, int g) {
    const int s = n / R, q = g / s, p = g - q * s, base = q * n + p;
    cf v[R];
#pragma unroll
    for (int k = 0; k < R; ++k) v[k] = X[PIDX(base + k * s)];
    dft_fwd<R>(v);
    if (s > 1) {
        int pp = p * (16384 / n); asm volatile("" : "+v"(pp));
        const cf w1 = tw[pp]; cf w = w1;
#pragma unroll
        for (int m = 1; m < R; ++m) { v[brev<R>(m)] = cmul(v[brev<R>(m)], w); w = cmul(w, w1); }
    }
#pragma unroll
    for (int k = 0; k < R; ++k) X[PIDX(base + k * s)] = v[k];
}
template <int R> DI void fft_pass_inv(LAS cf* X, const LAS cf* tw, int n, int g) {
    const int s = n / R, q = g / s, p = g - q * s, base = q * n + p;
    cf v[R];
#pragma unroll
    for (int k = 0; k < R; ++k) v[k] = X[PIDX(base + k * s)];
    if (s > 1) {
        int pp = p * (16384 / n); asm volatile("" : "+v"(pp));
        cf w1 = tw[pp]; w1.y = -w1.y; cf w = w1;
#pragma unroll
        for (int m = 1; m < R; ++m) { v[brev<R>(m)] = cmul(v[brev<R>(m)], w); w = cmul(w, w1); }
    }
    dft_inv<R>(v);
#pragma unroll
    for (int k = 0; k < R; ++k) X[PIDX(base + k * s)] = v[k];
}
DI void fft16k_fwd(LAS cf* X, const LAS cf* tw) {
    const int t = TID();
#pragma unroll 1
    for (int g = 0; g < 2; ++g) fft_pass_fwd<16>(X, tw, 16384, t + 512 * g);
    __syncthreads();
#pragma unroll 1
    for (int g = 0; g < 2; ++g) fft_pass_fwd<16>(X, tw, 1024, t + 512 * g);
    __syncthreads();
#pragma unroll 1
    for (int g = 0; g < 2; ++g) fft_pass_fwd<16>(X, tw, 64, t + 512 * g);
    __syncthreads();
#pragma unroll 1
    for (int g = 0; g < 8; ++g) fft_pass_fwd<4>(X, tw, 4, t + 512 * g);
    __syncthreads();
}
DI void fft16k_inv(LAS cf* X, const LAS cf* tw) {
    const int t = TID();
#pragma unroll 1
    for (int g = 0; g < 8; ++g) fft_pass_inv<4>(X, tw, 4, t + 512 * g);
    __syncthreads();
#pragma unroll 1
    for (int g = 0; g < 2; ++g) fft_pass_inv<16>(X, tw, 64, t + 512 * g);
    __syncthreads();
#pragma unroll 1
    for (int g = 0; g < 2; ++g) fft_pass_inv<16>(X, tw, 1024, t + 512 * g);
    __syncthreads();
#pragma unroll 1
    for (int g = 0; g < 2; ++g) fft_pass_inv<16>(X, tw, 16384, t + 512 * g);
    __syncthreads();
}

struct Params { const float* in[33]; float* out; unsigned char* ws; int ph_lo, ph_hi; };
struct KC {
    const float *x, *c, *ctx, *c_ctx, *ada_w, *ada_b, *norm_mix, *norm_ffn, *norm_final;
    const float *dn_w_in, *dn_conv, *dn_a_log, *dn_dt_bias, *dn_out_norm, *dn_w_out;
    const float *hy_w_in, *hy_conv, *hy_f_w1, *hy_f_b1, *hy_f_freq, *hy_f_w2, *hy_f_b2, *hy_f_w3, *hy_bias, *hy_w_out;
    const float *sc_w_in, *sc_conv, *sc_w_out, *w_router, *router_bias, *moe_w_gate, *moe_w_up, *moe_w_down;
    float* out; unsigned char* ws;
};

PF void job_mod(const KC& k, LAS float* lds) {
    const int tid = TID(), cj = tid & 63, kq = tid >> 6;
    float* mod = (float*)(k.ws + WS_MOD);
    for (int u = blockIdx.x; u < DEPTH * 96; u += gridDim.x) {
        const int l = u / 96, cc = u % 96, col = cc * 64 + cj;
        const float* W = k.ada_w + (size_t)l * 1024 * 6144;
        float a0 = 0.f, a1 = 0.f, a2 = 0.f;
        for (int kk = kq * 128; kk < kq * 128 + 128; ++kk) {
            const float w = W[(size_t)kk * 6144 + col];
            a0 += siluf(k.c_ctx[kk]) * w; a1 += siluf(k.c[kk]) * w; a2 += siluf(k.c[1024 + kk]) * w;
        }
        lds[(kq * 3 + 0) * 64 + cj] = a0; lds[(kq * 3 + 1) * 64 + cj] = a1; lds[(kq * 3 + 2) * 64 + cj] = a2;
        __syncthreads();
        if (tid < 192) {
            const int r = tid >> 6, j = tid & 63;
            float s = 0.f;
            for (int q = 0; q < 8; ++q) s += lds[(q * 3 + r) * 64 + j];
            mod[(size_t)(l * 3 + r) * 6144 + cc * 64 + j] = s + k.ada_b[l * 6144 + cc * 64 + j];
        }
        __syncthreads();
    }
}
DI void cvt_tile(const float* __restrict__ src, int ld, bf16_t* __restrict__ dst, int ldd, int k0, int n0, int mapmode, LAS float* lds) {
    const int tid = TID();
    { const int r = tid >> 4, c4 = (tid & 15) * 4;
#pragma unroll
      for (int h = 0; h < 2; ++h) {
          const f32x4 v = *(const f32x4*)(src + (size_t)(k0 + r + 32 * h) * ld + n0 + c4);
          LAS float* p = lds + (r + 32 * h) * 65 + c4; p[0] = v[0]; p[1] = v[1]; p[2] = v[2]; p[3] = v[3];
      } }
    __syncthreads();
    { const int nn = tid >> 3, ks = (tid & 7) * 8; const int n = n0 + nn;
      const int row = mapmode == 0 ? n : (32 * (n >> 4) + (n & 15) + (mapmode == 2 ? 16 : 0));
      u32x4 o;
      o[0] = pk2(lds[(ks + 0) * 65 + nn], lds[(ks + 1) * 65 + nn]); o[1] = pk2(lds[(ks + 2) * 65 + nn], lds[(ks + 3) * 65 + nn]);
      o[2] = pk2(lds[(ks + 4) * 65 + nn], lds[(ks + 5) * 65 + nn]); o[3] = pk2(lds[(ks + 6) * 65 + nn], lds[(ks + 7) * 65 + nn]);
      *(u32x4*)(dst + (size_t)row * ldd + k0 + ks) = o; }
    __syncthreads();
}
DI void cvt_matrix(const float* src, int ld, size_t sstride, int K, int N, int nmat, bf16_t* dst, int ldd, size_t dstride, int mapmode, LAS float* lds) {
    const int tk = K / 64, tn = N / 64, per = tk * tn;
    for (int u = blockIdx.x; u < per * nmat; u += gridDim.x) {
        const int m = u / per, t = u % per;
        cvt_tile(src + (size_t)m * sstride, ld, dst + (size_t)m * dstride, ldd, (t / tn) * 64, (t % tn) * 64, mapmode, lds);
    }
}
PF void job_cvt_small(const KC& k, LAS float* lds) {
    cvt_matrix(k.dn_w_in, DN_IN, (size_t)1024 * DN_IN, 1024, 4096, 2, (bf16_t*)(k.ws + WS_DNWIN), 1024, (size_t)4096 * 1024, 0, lds);
    cvt_matrix(k.dn_w_out, 1024, (size_t)1024 * 1024, 1024, 1024, 2, (bf16_t*)(k.ws + WS_DNWOUT), 1024, (size_t)1024 * 1024, 0, lds);
    cvt_matrix(k.hy_w_in, 3072, 0, 1024, 3072, 1, (bf16_t*)(k.ws + WS_HYWIN), 1024, 0, 0, lds);
    cvt_matrix(k.hy_w_out, 1024, 0, 1024, 1024, 1, (bf16_t*)(k.ws + WS_HYWOUT), 1024, 0, 0, lds);
    cvt_matrix(k.sc_w_in, 3072, 0, 1024, 3072, 1, (bf16_t*)(k.ws + WS_SCWIN), 1024, 0, 0, lds);
    cvt_matrix(k.sc_w_out, 1024, 0, 1024, 1024, 1, (bf16_t*)(k.ws + WS_SCWOUT), 1024, 0, 0, lds);
}
PF void job_cvt_moe(const KC& k, int layer, LAS float* lds) {
    const size_t lo = (size_t)layer * 32 * 1024 * 512;
    cvt_matrix(k.moe_w_gate + lo, 512, (size_t)1024 * 512, 1024, 512, 32, (bf16_t*)(k.ws + AR_WGU), 1024, (size_t)1024 * 1024, 1, lds);
    cvt_matrix(k.moe_w_up + lo, 512, (size_t)1024 * 512, 1024, 512, 32, (bf16_t*)(k.ws + AR_WGU), 1024, (size_t)1024 * 1024, 2, lds);
    cvt_matrix(k.moe_w_down + lo, 1024, (size_t)512 * 1024, 512, 1024, 32, (bf16_t*)(k.ws + AR_WD), 512, (size_t)1024 * 512, 0, lds);
}
PF void job_hdn(const KC& k, LAS float* lds) {
    const int tid = TID(), lane = tid & 63, wave = tid >> 6;
    LAS float* feat = lds + wave * 128; LAS float* h1 = feat + 64;
    const float fr = k.hy_f_freq[lane], b1 = k.hy_f_b1[lane], b2 = k.hy_f_b2[lane];
    for (int u0 = blockIdx.x * 8; u0 < 16384 + 256; u0 += gridDim.x * 8) {
        const int u = u0 + wave;
        int l, pos; float* dst;
        if (u < 16384) { l = 16384; pos = u; dst = nullptr; }
        else { l = 256; pos = u - 16384; dst = (float*)(k.ws + WS_HDNC) + (size_t)pos * 64; }
        const float t = (float)pos / (float)(l - 1);
        float f = 0.f;
        if (lane == 0) f = t;
        else if (lane <= 32) {
            const int bi = (lane - 1) & 15;
            const float band = 1e-4f + (float)bi * ((15.0f - 1e-4f) / 15.0f);
            const float ang = (6.283185307179586f / (float)l) * (float)pos * band;
            f = lane <= 16 ? cosf(ang) : -sinf(ang);
        }
        feat[lane] = f;
        __syncthreads();
        float a = b1;
        for (int i = 0; i < 33; ++i) a += feat[i] * k.hy_f_w1[i * 64 + lane];
        h1[lane] = sinf(fr * a);
        __syncthreads();
        float a2 = b2;
        for (int j = 0; j < 64; ++j) a2 += h1[j] * k.hy_f_w2[j * 64 + lane];
        const float hv = sinf(fr * a2);
        if (dst) dst[lane] = hv;
        else { bf16_t* hs = (bf16_t*)(k.ws + WS_HS) + (size_t)pos * 256; const bf16_t hi = f2bf(hv), lo = f2bf(hv - bf2f(hi)); hs[lane] = hi; hs[64 + lane] = lo; hs[128 + lane] = hi; hs[192 + lane] = 0; }
        __syncthreads();
    }
}
PF void job_w3s(const KC& k) {
    bf16_t* W = (bf16_t*)(k.ws + WS_W3S);
    const int tq = TID();
    for (int idx = blockIdx.x * NTHR + tq; idx < 64 * 4096; idx += gridDim.x * NTHR) {
        const int j = idx >> 12, col = idx & 4095;
        const float w = k.hy_f_w3[idx]; const bf16_t hi = f2bf(w), lo = f2bf(w - bf2f(hi));
        W[(size_t)col * 256 + j] = hi; W[(size_t)col * 256 + 64 + j] = hi; W[(size_t)col * 256 + 128 + j] = lo; W[(size_t)col * 256 + 192 + j] = 0;
    }
}
DI float hy_delta(int ch) {
    const float lo = -4.605170185988091f / 1.5f, hi = -4.605170185988091f / 0.3f;
    return fabsf(lo + (float)ch * ((hi - lo) / 1023.0f));
}
PF void job_filtc(const KC& k, int j) {
    const float* hdn = (const float*)(k.ws + WS_HDNC);
    const float* w3 = k.hy_f_w3 + (size_t)j * 64 * 4096;
    float* filtc = (float*)(k.ws + WS_FILTC);
    const int tq = TID();
    for (int u = blockIdx.x; u < 256 * 8; u += gridDim.x) {
        const int l = u >> 3, col = (u & 7) * 512 + tq;
        float a = 0.f;
        for (int q = 0; q < 64; ++q) a += hdn[l * 64 + q] * w3[(size_t)q * 4096 + col];
        const float t = (float)l / 255.0f;
        filtc[(size_t)l * 4096 + col] = a * expf(-t * hy_delta(col & 1023));
    }
}

template <int MODE>
PF void norm_phase(const KC& k, int layer, bool first, bool combine, const float* __restrict__ gain, int mb, const float* __restrict__ Wsk, int ldw,
                   const float* __restrict__ aux0, const float* __restrict__ aux1, bool last, LAS float* lds, bool flush = true) {
    const int tid = TID(), lane = tid & 63, wave = tid >> 6;
    float* xs = (float*)(k.ws + WS_XS);
    bf16_t* hbuf = (bf16_t*)(k.ws + AR_HBUF);
    const float* mod = (const float*)(k.ws + WS_MOD);
    const bf16_t* ys = (const bf16_t*)(k.ws + AR_YS);
    const int* tokp = (const int*)(k.ws + WS_TOKP);
    const float* tokw = (const float*)(k.ws + WS_TOKW);
    LAS int* lcnt = (LAS int*)(lds + 32768);
    if (MODE == 1 && tid < 32) lcnt[tid] = 0;
    if (MODE == 1 || MODE == 2) {
        for (int idx = tid; idx < 1024 * 32; idx += NTHR) {
            const int kk = idx >> 5, n = idx & 31;
            lds[kk * 32 + (((n >> 2) ^ ((kk >> 1) & 7)) << 2) + (n & 3)] = Wsk[(size_t)kk * ldw + n];
        }
        __syncthreads();
    }
    const int rbeg = (MODE == 3) ? TC : 0;
    for (int r = rbeg + blockIdx.x * 8 + wave; r < T; r += gridDim.x * 8) {
        const int mr = modrow(r);
        const float* src = first ? (r < TC ? k.ctx + (size_t)r * 1024 : k.x + (size_t)(r - TC) * 1024) : xs + (size_t)r * 1024;
        float x[16];
#pragma unroll
        for (int m = 0; m < 16; ++m) x[m] = src[lane + 64 * m];
        if (combine) {
            const int p0 = tokp[2 * r], p1 = tokp[2 * r + 1];
            const float w0 = tokw[2 * r], w1 = tokw[2 * r + 1];
            const float* g5 = mod + ((size_t)((layer - 1) * 3 + mr) * 6 + 5) * 1024;
#pragma unroll
            for (int m = 0; m < 16; ++m) {
                const int col = lane + 64 * m;
                x[m] += g5[col] * (w0 * bf2f(ys[(size_t)p0 * 1024 + col]) + w1 * bf2f(ys[(size_t)p1 * 1024 + col]));
            }
        }
        if (first || combine) {
#pragma unroll
            for (int m = 0; m < 16; ++m) xs[(size_t)r * 1024 + lane + 64 * m] = x[m];
        }
        float ss = 0.f;
#pragma unroll
        for (int m = 0; m < 16; ++m) ss += x[m] * x[m];
        ss = wsum(ss, lane);
        const float rstd = rsqrtf(ss * (1.0f / 1024.0f) + EPS);
        if (MODE == 3) {
#pragma unroll
            for (int m = 0; m < 16; ++m) { const int col = lane + 64 * m; k.out[(size_t)(r - TC) * 1024 + col] = x[m] * rstd * gain[col]; }
            continue;
        }
        const float* shift = mod + ((size_t)(layer * 3 + mr) * 6 + mb) * 1024;
        const float* scale = shift + 1024;
        float y[16];
#pragma unroll
        for (int m = 0; m < 16; ++m) {
            const int col = lane + 64 * m;
            y[m] = x[m] * rstd * gain[col] * (1.0f + scale[col]) + shift[col];
            hbuf[(size_t)r * 1024 + col] = f2bf(y[m]);
        }
        if (MODE == 1 || MODE == 2) {
            float acc[32];
#pragma unroll
            for (int n = 0; n < 32; ++n) acc[n] = 0.f;
#pragma unroll
            for (int m = 0; m < 16; ++m) {
                asm volatile("" ::: "memory");
                const int c = lane + 64 * m;
                const LAS float* wr = lds + c * 32; const int sw = (c >> 1) & 7;
#pragma unroll
                for (int q = 0; q < 8; ++q) {
                    const f32x4 w4 = *(const LAS f32x4*)(wr + ((q ^ sw) << 2));
                    acc[4 * q + 0] += y[m] * w4[0]; acc[4 * q + 1] += y[m] * w4[1]; acc[4 * q + 2] += y[m] * w4[2]; acc[4 * q + 3] += y[m] * w4[3];
                }
            }
            float val;
            {
                float a16[16], a8[8], a4[4], a2[2];
                const bool b5 = (lane & 32) != 0, b4 = (lane & 16) != 0, b3 = (lane & 8) != 0, b2 = (lane & 4) != 0, b1 = (lane & 2) != 0;
#pragma unroll
                for (int i = 0; i < 16; ++i) { const float send = b5 ? acc[i] : acc[i + 16], keep = b5 ? acc[i + 16] : acc[i]; a16[i] = keep + shx(send, 32, lane); }
#pragma unroll
                for (int i = 0; i < 8; ++i) { const float send = b4 ? a16[i] : a16[i + 8], keep = b4 ? a16[i + 8] : a16[i]; a8[i] = keep + shx(send, 16, lane); }
#pragma unroll
                for (int i = 0; i < 4; ++i) { const float send = b3 ? a8[i] : a8[i + 4], keep = b3 ? a8[i + 4] : a8[i]; a4[i] = keep + shx(send, 8, lane); }
#pragma unroll
                for (int i = 0; i < 2; ++i) { const float send = b2 ? a4[i] : a4[i + 2], keep = b2 ? a4[i + 2] : a4[i]; a2[i] = keep + shx(send, 4, lane); }
                { const float send = b1 ? a2[0] : a2[1], keep = b1 ? a2[1] : a2[0]; val = keep + shx(send, 2, lane); }
                val += shx(val, 1, lane);
            }
            const int n = lane >> 1;
            if (MODE == 1) {
                int* toke = (int*)(k.ws + WS_TOKE); float* tokwW = (float*)(k.ws + WS_TOKW);
                if (last && r < TC) { if (lane == 0) { int neg = -1; asm volatile("" : "+v"(neg)); toke[2 * r] = neg; toke[2 * r + 1] = neg; } continue; }
                const float sc = 1.0f / (1.0f + expf(-val)), ch = sc + aux0[n];
                const int gl = lane & ~7;
                const float ca = shi(ch, gl), cb = shi(ch, gl + 2), cc = shi(ch, gl + 4), cd = shi(ch, gl + 6);
                const float hi1 = fmaxf(ca, cb), lo1 = fminf(ca, cb), hi2 = fmaxf(cc, cd), lo2 = fminf(cc, cd);
                float gs = fmaxf(hi1, hi2) + fmaxf(fminf(hi1, hi2), fmaxf(lo1, lo2));
                int gi = lane >> 3;
#pragma unroll
                for (int m = 8; m <= 32; m <<= 1) {
                    const float og = shx(gs, m, lane); const int oi = shii(gi, lane ^ m);
                    if (og > gs || (og == gs && oi < gi)) { gs = og; gi = oi; }
                }
                float c4[4], s4[4];
#pragma unroll
                for (int i = 0; i < 4; ++i) { c4[i] = shi(ch, gi * 8 + 2 * i); s4[i] = shi(sc, gi * 8 + 2 * i); }
                int i1 = 0; float b1v = c4[0];
#pragma unroll
                for (int i = 1; i < 4; ++i) if (c4[i] > b1v) { b1v = c4[i]; i1 = i; }
                int i2 = -1; float b2v = -1e30f;
#pragma unroll
                for (int i = 0; i < 4; ++i) if (i != i1 && c4[i] > b2v) { b2v = c4[i]; i2 = i; }
                float w1v = 0.f, w2v = 0.f;
#pragma unroll
                for (int i = 0; i < 4; ++i) { if (i == i1) w1v = s4[i]; if (i == i2) w2v = s4[i]; }
                const float inv = 1.0f / (w1v + w2v);
                if (lane == 0) {
                    const int e1 = gi * 4 + i1, e2 = gi * 4 + i2;
                    toke[2 * r] = e1; toke[2 * r + 1] = e2; tokwW[2 * r] = w1v * inv; tokwW[2 * r + 1] = w2v * inv;
                    __hip_atomic_fetch_add(lcnt + e1, 1, __ATOMIC_RELAXED, __HIP_MEMORY_SCOPE_WORKGROUP);
                    __hip_atomic_fetch_add(lcnt + e2, 1, __ATOMIC_RELAXED, __HIP_MEMORY_SCOPE_WORKGROUP);
                }
            } else {
                float* gb = (float*)(k.ws + WS_GB);
                if ((lane & 1) == 0) {
                    if (n < 16) {
                        const float z = val + aux1[n];
                        const float ez = __expf(z); const float sp = z > 15.f ? z : (ez < 1e-4f ? ez - 0.5f * ez * ez : __logf(1.0f + ez));
                        gb[(size_t)r * 32 + n] = -expf(aux0[n]) * sp;
                    } else {
                        gb[(size_t)r * 32 + n] = 1.0f / (1.0f + expf(-val));
                    }
                }
            }
        }
    }
    if (MODE == 1) {
        __syncthreads();
        int* cnt = (int*)(k.ws + WS_CTL + CTL_CNT) + layer * 32;
        if (flush && tid < 32 && lcnt[tid] > 0) atomicAdd(&cnt[tid], lcnt[tid]);
    }
}

namespace pg8 {
constexpr int BM = 256, BK = 64, HALF = 128, HTB = HALF * BK * 2, STAGE_BYTES = 8 * HTB;
DI int lds_byte(int r, int c) { const int st = (r >> 4) * 2 + (c >> 5), rr = r & 15, cc = c & 31, ob = rr * 64 + cc * 2; return st * 1024 + (ob ^ (((ob >> 9) & 1) << 5)); }
DI void stage_rc(int b, int& R, int& C) { const int st = b / 1024, sb = b % 1024, swz = sb ^ (((sb >> 9) & 1) << 5); R = (st >> 1) * 16 + swz / 64; C = (st & 1) * 32 + (swz % 64) / 2; }
DI int perm32(int rho) { const int n = rho >> 4, i = rho & 15; return 8 * (i >> 2) + 4 * n + (i & 3); }
struct Unit { int m0, mrows, pn; size_t boff; };
template <bool GATHER, class Epi, class Sched>
DI void gemm_phase(LAS unsigned char* lds, const bf16_t* A, const int* rowidx, const bf16_t* Bt, int K, const Sched& S, const Epi& E) {
    const int tid = TID(), wid = __builtin_amdgcn_readfirstlane(tid >> 6), lane = tid & 63, wr = wid >> 2, wc = wid & 3, fr = lane & 15, fq = lane >> 4;
    const int nt = K / BK;
    unsigned voffA[2], voffB[2];
#pragma unroll
    for (int i = 0; i < 2; ++i) { int R, C; stage_rc(tid * 16 + i * 8192, R, C); const int Rb = Epi::PERM ? ((R & ~31) + perm32(R & 31)) : R;
        voffA[i] = (unsigned)(R * K + C) * 2u; voffB[i] = (unsigned)(Rb * K + C) * 2u; }
    const size_t kstep = (size_t)(BK * 2);
    const size_t hstep = (size_t)HALF * K * 2;
    const size_t tstep = 2 * hstep;
    const size_t rstep = (size_t)K * 2;
    const unsigned ldsw = (unsigned)wid * 1024u;
    const int aoff = lds_byte(wr * 64 + fr, fq * 8), boff = lds_byte(wc * 32 + fr, fq * 8);
#define PG8_SA(b, h) (((b) * 2 + (h)) * HTB)
#define PG8_SB(b, h) ((4 + (b) * 2 + (h)) * HTB)
#define PG8_STAGE(bufoff, gbase, voff) do { _Pragma("unroll") for (int _i = 0; _i < 2; ++_i) \
        __builtin_amdgcn_global_load_lds((const unsigned*)((const char*)(gbase) + (voff)[_i]), (LAS unsigned*)(lds + (bufoff) + ldsw + _i * 8192), 16, 0, 0); } while (0)
#define PG8_STAGE_A(bufoff, p, h, vG) do { if (GATHER) PG8_STAGE(bufoff, p, (vG)[h]); else PG8_STAGE(bufoff, (p) + (h) * hstep, voffA); } while (0)
#define PG8_LDA(dst, b, h) do { _Pragma("unroll") for (int m = 0; m < 4; ++m) _Pragma("unroll") for (int k = 0; k < 2; ++k) dst[m][k] = *(const LAS bf16x8*)(lds + PG8_SA(b, h) + aoff + m * 2048 + k * 1024); } while (0)
#define PG8_LDB(dst, b, h) do { _Pragma("unroll") for (int n = 0; n < 2; ++n) _Pragma("unroll") for (int k = 0; k < 2; ++k) dst[n][k] = *(const LAS bf16x8*)(lds + PG8_SB(b, h) + boff + n * 2048 + k * 1024); } while (0)
#define PG8_MMA(ai, bj, At, Bt_) do { __builtin_amdgcn_s_setprio(1); _Pragma("unroll") for (int m = 0; m < 4; ++m) _Pragma("unroll") for (int n = 0; n < 2; ++n) _Pragma("unroll") for (int k = 0; k < 2; ++k) \
        acc[ai][bj][m][n] = __builtin_amdgcn_mfma_f32_16x16x32_bf16(Bt_[n][k], At[m][k], acc[ai][bj][m][n], 0, 0, 0); __builtin_amdgcn_s_setprio(0); } while (0)
#define PG8_WAIT_V(n) asm volatile("s_waitcnt vmcnt(" #n ")" ::: "memory")
#define PG8_WAIT_L(n) asm volatile("s_waitcnt lgkmcnt(" #n ")" ::: "memory")
#define PG8_BAR __builtin_amdgcn_s_barrier()
#define PG8_SCHED __builtin_amdgcn_sched_barrier(0)
#define PG8_AOFF(dst, u) do { _Pragma("unroll") for (int _h = 0; _h < 2; ++_h) _Pragma("unroll") for (int _i = 0; _i < 2; ++_i) { int _R, _C; stage_rc(tid * 16 + _i * 8192, _R, _C); \
        dst[_h][_i] = (unsigned)(rowidx[(u).m0 + _h * HALF + _R] * K + _C) * 2u; } } while (0)
    Unit cur, nxt; int ui = 0;
    if (!S.next(0, cur)) return;
    f32x4 acc[2][2][4][2];
#pragma unroll
    for (int a = 0; a < 2; ++a)
#pragma unroll
        for (int b = 0; b < 2; ++b)
#pragma unroll
            for (int m = 0; m < 4; ++m)
#pragma unroll
                for (int n = 0; n < 2; ++n) acc[a][b][m][n] = (f32x4){0.f, 0.f, 0.f, 0.f};
    bf16x8 At[4][2], B0[2][2], B1[2][2];
    unsigned vA[2][2], vN[2][2];
    if (GATHER) PG8_AOFF(vA, cur);
    const char* cA = (const char*)A + (GATHER ? (size_t)0 : (size_t)cur.m0 * rstep);
    const char* cB = (const char*)Bt + cur.boff + (size_t)cur.pn * tstep;
    PG8_STAGE(PG8_SB(0, 0), cB, voffB); PG8_STAGE_A(PG8_SA(0, 0), cA, 0, vA); PG8_STAGE(PG8_SB(0, 1), cB + hstep, voffB); PG8_STAGE_A(PG8_SA(0, 1), cA, 1, vA);
    if (wr == 1) PG8_BAR;
    PG8_WAIT_V(4); PG8_BAR;
    PG8_STAGE(PG8_SB(1, 0), cB + kstep, voffB); PG8_STAGE_A(PG8_SA(1, 0), cA + kstep, 0, vA); PG8_STAGE(PG8_SB(1, 1), cB + hstep + kstep, voffB);
    PG8_WAIT_V(6); PG8_BAR;
    for (;;) {
        const bool has_next = S.next(ui + 1, nxt);
        const char* nA = GATHER ? cA : (has_next ? (const char*)A + (size_t)nxt.m0 * rstep : cA);
        const char* nB = has_next ? (const char*)Bt + nxt.boff + (size_t)nxt.pn * tstep : cB;
        if (GATHER) {
            if (has_next) { PG8_AOFF(vN, nxt); }
            else {
#pragma unroll
                for (int h = 0; h < 2; ++h)
#pragma unroll
                    for (int i = 0; i < 2; ++i) vN[h][i] = vA[h][i];
            }
        }
        for (int t = 0; t < nt; t += 2) {
            const bool last = (t == nt - 2);
            const char* a1 = cA + (size_t)(t + 1) * kstep;
            const char* a2 = last ? nA : cA + (size_t)(t + 2) * kstep; const char* b2 = last ? nB : cB + (size_t)(t + 2) * kstep;
            const char* a3 = a2 + kstep; const char* b3 = b2 + kstep;
            PG8_LDB(B0, 0, 0); PG8_SCHED; PG8_LDA(At, 0, 0); PG8_STAGE_A(PG8_SA(1, 1), a1, 1, vA);
            if (GATHER && last) {
#pragma unroll
                for (int h = 0; h < 2; ++h)
#pragma unroll
                    for (int i = 0; i < 2; ++i) vA[h][i] = vN[h][i];
            }
            PG8_WAIT_L(8); PG8_BAR; PG8_WAIT_L(0); PG8_MMA(0, 0, At, B0); PG8_BAR; PG8_SCHED;
            PG8_LDB(B1, 0, 1); PG8_STAGE(PG8_SB(0, 0), b2, voffB);
            PG8_BAR; PG8_WAIT_L(0); PG8_MMA(0, 1, At, B1); PG8_BAR;
            PG8_LDA(At, 0, 1); PG8_STAGE_A(PG8_SA(0, 0), a2, 0, vA);
            PG8_BAR; PG8_WAIT_L(0); PG8_MMA(1, 0, At, B0); PG8_BAR; PG8_SCHED;
            PG8_STAGE(PG8_SB(0, 1), b2 + hstep, voffB);
            PG8_WAIT_V(6); PG8_BAR; PG8_MMA(1, 1, At, B1); PG8_BAR;
            PG8_LDB(B0, 1, 0); PG8_SCHED; PG8_LDA(At, 1, 0); PG8_STAGE_A(PG8_SA(0, 1), a2, 1, vA);
            PG8_WAIT_L(8); PG8_BAR; PG8_WAIT_L(0); PG8_MMA(0, 0, At, B0); PG8_BAR; PG8_SCHED;
            PG8_LDB(B1, 1, 1); PG8_STAGE(PG8_SB(1, 0), b3, voffB);
            PG8_BAR; PG8_WAIT_L(0); PG8_MMA(0, 1, At, B1); PG8_BAR;
            PG8_LDA(At, 1, 1); PG8_STAGE_A(PG8_SA(1, 0), a3, 0, vA);
            PG8_BAR; PG8_WAIT_L(0); PG8_MMA(1, 0, At, B0); PG8_BAR; PG8_SCHED;
            PG8_STAGE(PG8_SB(1, 1), b3 + hstep, voffB);
            PG8_WAIT_V(6); PG8_BAR; PG8_MMA(1, 1, At, B1); PG8_BAR;
        }
        { const int t2 = TID(), l2 = t2 & 63; E(acc, cur, wr, wc, l2 & 15, l2 >> 4); }
        if (!has_next) break;
#pragma unroll
        for (int a = 0; a < 2; ++a)
#pragma unroll
            for (int b = 0; b < 2; ++b)
#pragma unroll
                for (int m = 0; m < 4; ++m)
#pragma unroll
                    for (int n = 0; n < 2; ++n) acc[a][b][m][n] = (f32x4){0.f, 0.f, 0.f, 0.f};
        cur = nxt; cA = nA; cB = nB; ++ui;
    }
    PG8_WAIT_V(0);
    if (wr == 0) PG8_BAR;
    PG8_BAR;
#undef PG8_SA
#undef PG8_SB
#undef PG8_STAGE
#undef PG8_STAGE_A
#undef PG8_LDA
#undef PG8_LDB
#undef PG8_MMA
#undef PG8_WAIT_V
#undef PG8_WAIT_L
#undef PG8_BAR
#undef PG8_SCHED
#undef PG8_AOFF
}
struct DenseOrder {
    int nM, nN, nwg, G, c;
    DI void init(int M, int N, int G_, int c_) { nM = M / BM; nN = N / BM; nwg = nM * nN; G = G_; c = c_; }
    DI bool next(int i, Unit& u) const {
        const long L = (long)i * G + c; if (L >= nwg) return false;
        int wgid = (int)L; { const int q = nwg / 8, r = nwg % 8, xcd = wgid % 8, off = wgid / 8; wgid = (xcd < r ? xcd * (q + 1) : r * (q + 1) + (xcd - r) * q) + off; }
        const int nig = 8 * nN, gid = wgid / nig, fm = gid * 8, gsz = (nM - fm) < 8 ? (nM - fm) : 8;
        u.m0 = (fm + ((wgid % nig) % gsz)) * BM; u.mrows = BM; u.pn = (wgid % nig) / gsz; u.boff = 0; return true;
    }
};
struct MoeOrder {
    const LAS int* tb; int G, c; size_t estride;
    DI bool next(int i, Unit& u) const {
        const int L = i * G + c; if (L >= __builtin_amdgcn_readfirstlane(tb[97]) * 4) return false;
        const int tile = L >> 2; int e = 0;
        for (int q = 1; q < 32; ++q) if (__builtin_amdgcn_readfirstlane(tb[65 + q]) <= tile) e = q;
        const int lt = tile - __builtin_amdgcn_readfirstlane(tb[65 + e]); int mr = __builtin_amdgcn_readfirstlane(tb[e]) - lt * 256; mr = mr > 256 ? 256 : mr;
        u.m0 = __builtin_amdgcn_readfirstlane(tb[32 + e]) + lt * 256; u.mrows = mr; u.pn = L & 3; u.boff = (size_t)e * estride; return true;
    }
};
}
struct EpiBf16 {
    static constexpr bool PERM = true;
    bf16_t* C; int ldc; int split_col; bf16_t* C2; int ldc2;
    DI void operator()(const f32x4 (&acc)[2][2][4][2], const pg8::Unit& u, int wr, int wc, int fr, int fq) const {
        int colt = u.pn * 256; bf16_t* base = C; int ld = ldc;
        if (colt >= split_col) { base = C2; ld = ldc2; colt -= split_col; }
#pragma unroll
        for (int ai = 0; ai < 2; ++ai)
#pragma unroll
            for (int m = 0; m < 4; ++m) {
                const int rl = ai * 128 + wr * 64 + m * 16 + fr;
                if (rl < u.mrows) {
                    bf16_t* rowp = base + (size_t)(u.m0 + rl) * ld + colt + wc * 32 + 8 * fq;
#pragma unroll
                    for (int bj = 0; bj < 2; ++bj) {
                        const f32x4 v0 = acc[ai][bj][m][0], v1 = acc[ai][bj][m][1];
                        u32x4 o; o[0] = cvt_pk_bf16(v0[0], v0[1]); o[1] = cvt_pk_bf16(v0[2], v0[3]); o[2] = cvt_pk_bf16(v1[0], v1[1]); o[3] = cvt_pk_bf16(v1[2], v1[3]);
                        *(u32x4*)(rowp + bj * 128) = o;
                    }
                }
            }
    }
};
struct EpiBf16T {
    static constexpr bool PERM = false;
    bf16_t* C; int ldc;
    DI void operator()(const f32x4 (&acc)[2][2][4][2], const pg8::Unit& u, int wr, int wc, int fr, int fq) const {
#pragma unroll
        for (int ai = 0; ai < 2; ++ai)
#pragma unroll
            for (int bj = 0; bj < 2; ++bj)
#pragma unroll
                for (int m = 0; m < 4; ++m)
#pragma unroll
                    for (int n = 0; n < 2; ++n) {
                        const int row = u.m0 + ai * 128 + wr * 64 + m * 16 + fr, col = u.pn * 256 + bj * 128 + wc * 32 + n * 16 + 4 * fq;
#pragma unroll
                        for (int e = 0; e < 4; ++e) C[(size_t)(col + e) * ldc + row] = f2bf(acc[ai][bj][m][n][e]);
                    }
    }
};
struct EpiTaps {
    static constexpr bool PERM = false;
    float* FT;
    DI void operator()(const f32x4 (&acc)[2][2][4][2], const pg8::Unit& u, int wr, int wc, int fr, int fq) const {
#pragma unroll
        for (int ai = 0; ai < 2; ++ai)
#pragma unroll
            for (int m = 0; m < 4; ++m) {
                const int row = u.m0 + ai * 128 + wr * 64 + m * 16 + fr; const float dl = hy_delta(row & 1023) * (1.0f / 16383.0f);
#pragma unroll
                for (int bj = 0; bj < 2; ++bj)
#pragma unroll
                    for (int n = 0; n < 2; ++n) {
                        const int l = u.pn * 256 + bj * 128 + wc * 32 + n * 16 + 4 * fq; f32x4 o;
#pragma unroll
                        for (int e = 0; e < 4; ++e) o[e] = acc[ai][bj][m][n][e] * expf(-(float)(l + e) * dl);
                        *(f32x4*)(FT + (size_t)row * 16384 + l) = o;
                    }
            }
    }
};
struct EpiResid {
    static constexpr bool PERM = false;
    float* xs; const float* mod; int layer; int chunk;
    DI void operator()(const f32x4 (&acc)[2][2][4][2], const pg8::Unit& u, int wr, int wc, int fr, int fq) const {
        const float* g = mod + ((size_t)(layer * 3 + modrow(u.m0)) * 6 + chunk) * 1024;
#pragma unroll
        for (int bj = 0; bj < 2; ++bj)
#pragma unroll
            for (int n = 0; n < 2; ++n) {
                const int col = u.pn * 256 + bj * 128 + wc * 32 + n * 16 + 4 * fq; const f32x4 gv = *(const f32x4*)(g + col);
#pragma unroll
                for (int ai = 0; ai < 2; ++ai)
#pragma unroll
                    for (int m = 0; m < 4; ++m) { float* p = xs + (size_t)(u.m0 + ai * 128 + wr * 64 + m * 16 + fr) * 1024 + col; *(f32x4*)p = *(const f32x4*)p + gv * acc[ai][bj][m][n]; }
            }
    }
};
struct EpiGateUp {
    static constexpr bool PERM = false;
    bf16_t* hid;
    DI void operator()(const f32x4 (&acc)[2][2][4][2], const pg8::Unit& u, int wr, int wc, int fr, int fq) const {
#pragma unroll
        for (int ai = 0; ai < 2; ++ai)
#pragma unroll
            for (int m = 0; m < 4; ++m) {
                const int rl = ai * 128 + wr * 64 + m * 16 + fr;
                if (rl < u.mrows) {
#pragma unroll
                    for (int bj = 0; bj < 2; ++bj) {
                        const int hc = ((u.pn * 256 + bj * 128 + wc * 32) >> 1) + 4 * fq;
                        const f32x4 g = acc[ai][bj][m][0], up = acc[ai][bj][m][1];
                        u32x2 o; o[0] = cvt_pk_bf16(siluf(g[0]) * up[0], siluf(g[1]) * up[1]); o[1] = cvt_pk_bf16(siluf(g[2]) * up[2], siluf(g[3]) * up[3]);
                        *(u32x2*)(hid + (size_t)(u.m0 + rl) * 512 + hc) = o;
                    }
                }
            }
    }
};
template <class Epi>
PF void gemm_dense(LAS unsigned char* lds, const bf16_t* A, int M, const bf16_t* Bt, int N, int K, const Epi& epi) {
    pg8::DenseOrder S; S.init(M, N, (int)gridDim.x, (int)blockIdx.x);
    pg8::gemm_phase<false>(lds, A, (const int*)nullptr, Bt, K, S, epi);
}
DI void moe_table(const KC& k, int layer, LAS int* tb) {
    const int* cnt = (const int*)(k.ws + WS_CTL + CTL_CNT) + layer * 32;
    __syncthreads();
    const int tq = TID();
    if (tq < 32) tb[tq] = __hip_atomic_load(cnt + tq, __ATOMIC_RELAXED, __HIP_MEMORY_SCOPE_AGENT);
    __syncthreads();
    if (tq == 0) {
        int s = 0, tp = 0;
        for (int e = 0; e < 32; ++e) { tb[32 + e] = s; tb[65 + e] = tp; s += tb[e]; tp += (tb[e] + 255) >> 8; }
        tb[64] = s; tb[97] = tp;
    }
    __syncthreads();
}
template <int WHICH>
PF void moe_gemm(const KC& k, int layer, LAS unsigned char* lds, LAS int* tb) {
    moe_table(k, layer, tb);
    if (WHICH == 0) {
        pg8::MoeOrder S{tb, (int)gridDim.x, (int)blockIdx.x, (size_t)1024 * 1024 * 2};
        EpiGateUp epi{(bf16_t*)(k.ws + AR_HID)};
        pg8::gemm_phase<true>(lds, (const bf16_t*)(k.ws + AR_HBUF), (const int*)(k.ws + WS_SLOT), (const bf16_t*)(k.ws + AR_WGU), 1024, S, epi);
    } else {
        pg8::MoeOrder S{tb, (int)gridDim.x, (int)blockIdx.x, (size_t)1024 * 512 * 2};
        EpiBf16 epi{(bf16_t*)(k.ws + AR_YS), 1024, 1 << 30, nullptr, 0};
        pg8::gemm_phase<false>(lds, (const bf16_t*)(k.ws + AR_HID), (const int*)nullptr, (const bf16_t*)(k.ws + AR_WD), 512, S, epi);
    }
}
PF void moe_scatter(const KC& k, int layer, LAS int* tb) {
    moe_table(k, layer, tb);
    const int* toke = (const int*)(k.ws + WS_TOKE);
    int* tokp = (int*)(k.ws + WS_TOKP); int* slot = (int*)(k.ws + WS_SLOT);
    int* cur = (int*)(k.ws + WS_CTL + CTL_CNT) + 128 + layer * 32;
    LAS int* lc = tb + 128; LAS int* lb = tb + 160;
    const int tid = TID();
    if (blockIdx.x == 0 && tid < 256) slot[NA + tid] = 0;
    for (int r0 = blockIdx.x * NTHR; r0 < T; r0 += gridDim.x * NTHR) {
        const int r = r0 + tid;
        __syncthreads();
        if (tid < 32) lc[tid] = 0;
        __syncthreads();
        const int e0 = toke[2 * r], e1 = toke[2 * r + 1];
        int k0 = 0, k1 = 0;
        if (e0 >= 0) { k0 = __hip_atomic_fetch_add(lc + e0, 1, __ATOMIC_RELAXED, __HIP_MEMORY_SCOPE_WORKGROUP); k1 = __hip_atomic_fetch_add(lc + e1, 1, __ATOMIC_RELAXED, __HIP_MEMORY_SCOPE_WORKGROUP); }
        __syncthreads();
        if (tid < 32) lb[tid] = lc[tid] > 0 ? atomicAdd(&cur[tid], lc[tid]) : 0;
        __syncthreads();
        if (e0 >= 0) {
            const int p0 = tb[32 + e0] + lb[e0] + k0, p1 = tb[32 + e1] + lb[e1] + k1;
            slot[p0] = r; slot[p1] = r; tokp[2 * r] = p0; tokp[2 * r + 1] = p1;
        }
    }
}

PF void sc_mix(const KC& k, int j) {
    const int tid = TID(), lane = tid & 63, wave = tid >> 6;
    const bf16_t* P = (const bf16_t*)(k.ws + AR_PB);
    bf16_t* U = (bf16_t*)(k.ws + AR_UBUF);
    const float* cw = k.sc_conv + (size_t)j * 3 * 1024;
    for (int r = blockIdx.x * 8 + wave; r < T; r += gridDim.x * 8) {
        bool lok, rok;
        if (r < TC) { const int t = r & 255; lok = t != 0; rok = t != 255; } else { const int t = (r - TC) & 63; lok = t != 0; rok = t != 63; }
        const bf16_t* p = P + (size_t)r * 3072;
#pragma unroll 4
        for (int m = 0; m < 16; ++m) {
            const int col = lane + 64 * m;
            const float bg = bf2f(p[col]);
            const float mc = bf2f(p[1024 + col]) * bf2f(p[2048 + col]);
            const float ml = lok ? bf2f(p[-3072 + 1024 + col]) * bf2f(p[-3072 + 2048 + col]) : 0.f;
            const float mrr = rok ? bf2f(p[3072 + 1024 + col]) * bf2f(p[3072 + 2048 + col]) : 0.f;
            U[(size_t)r * 1024 + col] = f2bf(bg * (cw[col] * ml + cw[1024 + col] * mc + cw[2048 + col] * mrr));
        }
    }
}

constexpr int DN_STEPS = 260, DN_UNITS = 32 * DN_STEPS;
DI int dn_rbase(int b, int dir, int s) {
    if (s < 4) return dir == 0 ? b * 256 + s * 64 : b * 256 + 255 - s * 64;
    const int cc = s - 4;
    return dir == 0 ? TC + b * SEQ + cc * 64 : TC + b * SEQ + SEQ - 1 - cc * 64;
}
PF void dn_chunk(const KC& k, int jl, LAS unsigned char* lds) {
    const int tid = TID(), lane = tid & 63, wave = tid >> 6, fr = lane & 15, fq = lane >> 4;
    LAS bf16_t* Kt = (LAS bf16_t*)lds;
    LAS bf16_t* Qt = Kt + 64 * 136;
    LAS bf16_t* Vt = Qt + 64 * 136;
    LAS float* Amat = (LAS float*)(Vt + 64 * 136);
    LAS bf16_t* Tb = (LAS bf16_t*)(Amat + 64 * 64);
    LAS bf16_t* VbT = Tb + 64 * 72;
    LAS bf16_t* KbT = VbT + 128 * 72;
    LAS float* gcs = (LAS float*)(KbT + 128 * 72);
    LAS float* bet = gcs + 64; LAS float* eg = bet + 64; LAS float* egr = eg + 64;
    LAS float* Tm = egr + 64;
    const bf16_t* P = (const bf16_t*)(k.ws + AR_PB);
    const float* gb = (const float*)(k.ws + WS_GB);
    const float* cw = k.dn_conv + (size_t)jl * 3 * 3072;
    bf16_t* CH = (bf16_t*)(k.ws + AR_CHUNK);
    bf16_t* ATT = (bf16_t*)(k.ws + AR_HBUF);
    float* EGL = (float*)(k.ws + WS_EGL);
    for (int u = blockIdx.x; u < DN_UNITS; u += gridDim.x) {
        const int chain = u / DN_STEPS, s = u - chain * DN_STEPS, dir = chain & 1, h = (chain >> 1) & 7, b = chain >> 4;
        const int rbase = dn_rbase(b, dir, s), rstep = dir == 0 ? 1 : -1;
        bf16_t* cW = CH + (size_t)u * 32768; bf16_t* cQd = cW + 8192; bf16_t* cKd = cQd + 8192; bf16_t* cU = cKd + 8192;
        bf16_t* cAt = ATT + (size_t)u * 4096;
        lds_barrier();
        for (int rpA = 0; rpA < (PROBE_SUB == 3 ? 2 : 1); ++rpA)
        {
            const int i = tid >> 3, sg = tid & 7, r = rbase + rstep * i;
            bool lok, rok;
            if (r < TC) { const int t = r & 255; lok = t != 0; rok = t != 255; } else { const int t = (r - TC) & 63; lok = t != 0; rok = t != 63; }
#pragma unroll 1
            for (int part = 0; part < 3; ++part) {
                const int col = part * 1024 + h * 128 + sg * 16;
                const bf16_t* pc = P + (size_t)r * 3072 + col;
                float v[16];
#pragma unroll
                for (int hf = 0; hf < 2; ++hf) {
                    const u32x4 c4 = *(const u32x4*)(pc + hf * 8);
                    u32x4 l4 = (u32x4){0u, 0u, 0u, 0u}, r4 = (u32x4){0u, 0u, 0u, 0u};
                    if (lok) l4 = *(const u32x4*)(pc - 3072 + hf * 8);
                    if (rok) r4 = *(const u32x4*)(pc + 3072 + hf * 8);
#pragma unroll
                    for (int w2 = 0; w2 < 2; ++w2) {
                        const int cc = col + hf * 8 + 4 * w2;
                        const f32x4 k0 = *(const f32x4*)(cw + cc), k1 = *(const f32x4*)(cw + 3072 + cc), k2 = *(const f32x4*)(cw + 6144 + cc);
#pragma unroll
                        for (int e = 0; e < 4; ++e) {
                            const int w = 2 * w2 + (e >> 1);
                            const float lv = __uint_as_float((e & 1) ? (l4[w] & 0xffff0000u) : (l4[w] << 16));
                            const float cv = __uint_as_float((e & 1) ? (c4[w] & 0xffff0000u) : (c4[w] << 16));
                            const float rv = __uint_as_float((e & 1) ? (r4[w] & 0xffff0000u) : (r4[w] << 16));
                            v[hf * 8 + 4 * w2 + e] = siluf(k0[e] * lv + k1[e] * cv + k2[e] * rv);
                        }
                    }
                }
                if (part < 2) {
                    float ss = 0.f;
#pragma unroll
                    for (int e = 0; e < 16; ++e) ss += v[e] * v[e];
                    ss += shx(ss, 1, lane); ss += shx(ss, 2, lane); ss += shx(ss, 4, lane);
                    const float sc = rsqrtf(ss + EPS) * (part == 0 ? 0.08838834764831845f : 1.0f);
#pragma unroll
                    for (int e = 0; e < 16; ++e) v[e] *= sc;
                }
                LAS bf16_t* dst = (part == 0 ? Qt : (part == 1 ? Kt : Vt)) + i * 136 + sg * 16;
                u32x4 o0, o1;
#pragma unroll
                for (int w = 0; w < 4; ++w) { o0[w] = pk2(v[2 * w], v[2 * w + 1]); o1[w] = pk2(v[8 + 2 * w], v[8 + 2 * w + 1]); }
                *(LAS u32x4*)dst = o0; *(LAS u32x4*)(dst + 8) = o1;
            }
        }
        if (wave == 0) {
            const size_t row = (size_t)(rbase + rstep * lane);
            float g = gb[row * 32 + dir * 8 + h];
            const float be = gb[row * 32 + 16 + dir * 8 + h];
#pragma unroll
            for (int d = 1; d < 64; d <<= 1) { const float o = shi(g, (lane - d) & 63); if (lane >= d) g += o; }
            const float glast = shi(g, 63);
            gcs[lane] = g; bet[lane] = be; eg[lane] = expf(g); egr[lane] = expf(glast - g);
            if (lane == 0) EGL[u] = expf(glast);
        }
        lds_barrier();
#pragma unroll 1
        for (int x = 0; x < 4; ++x) {
            const int t = wave + 8 * x, isq = t >> 4, mt = (t >> 2) & 3, nt = t & 3;
            f32x4 acc = (f32x4){0.f, 0.f, 0.f, 0.f};
            if (mt >= nt) {
                const LAS bf16_t* Ar = (isq ? Qt : Kt) + (16 * mt + fr) * 136 + 8 * fq;
                const LAS bf16_t* Br = Kt + (16 * nt + fr) * 136 + 8 * fq;
#pragma unroll
                for (int ks = 0; ks < 4; ++ks) acc = __builtin_amdgcn_mfma_f32_16x16x32_bf16(*(const LAS bf16x8*)(Ar + 32 * ks), *(const LAS bf16x8*)(Br + 32 * ks), acc, 0, 0, 0);
            }
            const int jc = 16 * nt + fr; const float gj = gcs[jc];
#pragma unroll
            for (int jj = 0; jj < 4; ++jj) {
                const int ir = 16 * mt + 4 * fq + jj;
                const float dec = expf(fminf(gcs[ir] - gj, 0.f));
                if (isq) cAt[ir * 64 + jc] = f2bf(ir >= jc ? acc[jj] * dec : 0.f);
                else Amat[ir * 64 + jc] = ir > jc ? bet[ir] * acc[jj] * dec : 0.f;
            }
        }
        lds_barrier();
        for (int rpD = 0; rpD < (PROBE_SUB == 2 ? 2 : 1); ++rpD) {
        if (rpD) lds_barrier();
        if (wave < 4) {
            if (lane < 16) {
                const int bo = 16 * wave;
                float tc[16];
#pragma unroll
                for (int i = 0; i < 16; ++i) {
                    float a0 = (i == lane) ? 1.f : 0.f, a1 = 0.f;
#pragma unroll
                    for (int j = 0; j < i; ++j) { const float av = Amat[(bo + i) * 64 + bo + j]; if (j & 1) a1 -= av * tc[j]; else a0 -= av * tc[j]; }
                    tc[i] = a0 + a1;
                    Tm[(bo + i) * 64 + bo + lane] = tc[i];
                }
            }
        } else {
            for (int it = tid - 256; it < 1024; it += 256) {
                const int c = it & 127, ig = it >> 7;
                float kv[8], vv[8];
#pragma unroll
                for (int e = 0; e < 8; ++e) { kv[e] = bf2f(Kt[(8 * ig + e) * 136 + c]); vv[e] = bf2f(Vt[(8 * ig + e) * 136 + c]); }
                u32x4 ov, ok, od;
#pragma unroll
                for (int w = 0; w < 4; ++w) {
                    const int i0 = 8 * ig + 2 * w, i1 = i0 + 1;
                    ov[w] = pk2(bet[i0] * vv[2 * w], bet[i1] * vv[2 * w + 1]);
                    ok[w] = pk2(bet[i0] * eg[i0] * kv[2 * w], bet[i1] * eg[i1] * kv[2 * w + 1]);
                    od[w] = pk2(egr[i0] * kv[2 * w], egr[i1] * kv[2 * w + 1]);
                }
                *(LAS u32x4*)(VbT + c * 72 + 8 * ig) = ov;
                *(LAS u32x4*)(KbT + c * 72 + 8 * ig) = ok;
                *(u32x4*)(cKd + c * 64 + 8 * ig) = od;
            }
            for (int it = tid - 256; it < 1024; it += 256) {
                const int i = it >> 4, c8 = (it & 15) * 8; const float e = eg[i];
                const u32x4 qv = *(const LAS u32x4*)(Qt + i * 136 + c8); u32x4 o;
#pragma unroll
                for (int w = 0; w < 4; ++w) o[w] = pk2(__uint_as_float(qv[w] << 16) * e, __uint_as_float(qv[w] & 0xffff0000u) * e);
                *(u32x4*)(cQd + i * 128 + c8) = o;
            }
        }
        lds_barrier();
#pragma unroll 1
        for (int d = 1; d < 4; ++d) {
            if (wave < 4 - d) {
                const int bi = wave + d, bj = wave, r = lane >> 2, c0 = 4 * (lane & 3);
                f32x4 m = (f32x4){0.f, 0.f, 0.f, 0.f};
                for (int kb = bj; kb < bi; ++kb) {
#pragma unroll
                    for (int kk = 0; kk < 16; ++kk) {
                        const float av = Amat[(16 * bi + r) * 64 + 16 * kb + kk];
                        const f32x4 tv = *(const LAS f32x4*)(Tm + (16 * kb + kk) * 64 + 16 * bj + c0);
                        m += tv * av;
                    }
                }
                *(LAS f32x4*)(Tm + (16 * bj + r) * 64 + 16 * bi + c0) = m;
                f32x4 t = (f32x4){0.f, 0.f, 0.f, 0.f};
#pragma unroll
                for (int kk = 0; kk < 16; ++kk) {
                    const float dv = Tm[(16 * bi + r) * 64 + 16 * bi + kk];
                    const f32x4 mv = *(const LAS f32x4*)(Tm + (16 * bj + kk) * 64 + 16 * bi + c0);
                    t -= mv * dv;
                }
                *(LAS f32x4*)(Tm + (16 * bi + r) * 64 + 16 * bj + c0) = t;
            }
            lds_barrier();
        }
        for (int it = tid; it < 64 * 8; it += NTHR) {
            const int i = it >> 3, c8 = (it & 7) * 8; u32x4 o;
#pragma unroll
            for (int w = 0; w < 4; ++w) {
                const int c = c8 + 2 * w;
                o[w] = pk2(c <= i ? Tm[i * 64 + c] : 0.f, c + 1 <= i ? Tm[i * 64 + c + 1] : 0.f);
            }
            *(LAS u32x4*)(Tb + i * 72 + c8) = o;
        }
        }
        lds_barrier();
        for (int rpE = 0; rpE < (PROBE_SUB == 4 ? 2 : 1); ++rpE)
        {
            f32x4 au[4], aw[4];
#pragma unroll
            for (int mt = 0; mt < 4; ++mt) { au[mt] = (f32x4){0.f, 0.f, 0.f, 0.f}; aw[mt] = (f32x4){0.f, 0.f, 0.f, 0.f}; }
#pragma unroll
            for (int ks = 0; ks < 2; ++ks) {
                const bf16x8 bv = *(const LAS bf16x8*)(VbT + (16 * wave + fr) * 72 + 32 * ks + 8 * fq);
                const bf16x8 bk = *(const LAS bf16x8*)(KbT + (16 * wave + fr) * 72 + 32 * ks + 8 * fq);
#pragma unroll
                for (int mt = 0; mt < 4; ++mt) {
                    const bf16x8 at = *(const LAS bf16x8*)(Tb + (16 * mt + fr) * 72 + 32 * ks + 8 * fq);
                    au[mt] = __builtin_amdgcn_mfma_f32_16x16x32_bf16(at, bv, au[mt], 0, 0, 0);
                    aw[mt] = __builtin_amdgcn_mfma_f32_16x16x32_bf16(at, bk, aw[mt], 0, 0, 0);
                }
            }
#pragma unroll
            for (int mt = 0; mt < 4; ++mt)
#pragma unroll
                for (int jj = 0; jj < 4; ++jj) {
                    const int ir = 16 * mt + 4 * fq + jj, c = 16 * wave + fr;
                    cU[ir * 128 + c] = f2bf(au[mt][jj]); cW[ir * 128 + c] = f2bf(aw[mt][jj]);
                }
        }
    }
}
constexpr int SC_W = 0, SC_QD = 64 * 136, SC_KD = SC_QD + 64 * 136, SC_AT = SC_KD + 128 * 72, SC_U = SC_AT + 64 * 72, SC_EGL = SC_U + 16 * 72, SC_STAGE = SC_EGL + 8;
struct ScanRegs { u32x4 v[8]; u32x4 u[2]; };
DI void dn_scan_fetch(const bf16_t* CH, const bf16_t* ATT, int u, int sl, int wv, int lane, ScanRegs& R) {
    const bf16_t* cW = CH + (size_t)u * 32768;
    const bf16_t* src = (wv < 6) ? cW + wv * 4096 + lane * 8 : ATT + (size_t)u * 4096 + lane * 8;
#pragma unroll
    for (int q = 0; q < 8; ++q) R.v[q] = *(const u32x4*)(src + q * 512);
    if (wv == 6) {
#pragma unroll
        for (int qq = 0; qq < 2; ++qq) { const int pid = lane + 64 * qq; R.u[qq] = *(const u32x4*)(cW + 24576 + (pid >> 1) * 128 + sl * 16 + (pid & 1) * 8); }
    }
}
DI void dn_scan_put(LAS bf16_t* st, int wv, int lane, const ScanRegs& R) {
    LAS bf16_t* dst; int qs;
    if (wv < 4) { dst = st + ((wv < 2) ? SC_W : SC_QD) + ((wv & 1) * 32 + (lane >> 4)) * 136 + (lane & 15) * 8; qs = 544; }
    else if (wv < 6) { dst = st + SC_KD + ((wv - 4) * 64 + (lane >> 3)) * 72 + (lane & 7) * 8; qs = 576; }
    else { dst = st + SC_AT + (lane >> 3) * 72 + (lane & 7) * 8; qs = 576; }
#pragma unroll
    for (int q = 0; q < 8; ++q) *(LAS u32x4*)(dst + q * qs) = R.v[q];
    if (wv == 6) {
#pragma unroll
        for (int qq = 0; qq < 2; ++qq) { const int pid = lane + 64 * qq, i = pid >> 1, hf = pid & 1;
#pragma unroll
            for (int w = 0; w < 4; ++w) { st[SC_U + (hf * 8 + 2 * w) * 72 + i] = (bf16_t)(R.u[qq][w] & 0xffff); st[SC_U + (hf * 8 + 2 * w + 1) * 72 + i] = (bf16_t)(R.u[qq][w] >> 16); } }
    }
}
DI bf16x8 ld2(const LAS bf16_t* p0, const LAS bf16_t* p1) {
    const u32x2 a = *(const LAS u32x2*)p0, b = *(const LAS u32x2*)p1;
    u32x4 r; r[0] = a[0]; r[1] = a[1]; r[2] = b[0]; r[3] = b[1];
    return __builtin_bit_cast(bf16x8, r);
}
DI bf16x8 pk8(f32x4 a, f32x4 b) { u32x4 r; r[0] = pk2(a[0], a[1]); r[1] = pk2(a[2], a[3]); r[2] = pk2(b[0], b[1]); r[3] = pk2(b[2], b[3]); return __builtin_bit_cast(bf16x8, r); }
PF void dn_scan(const KC& k, LAS unsigned char* lds) {
    const int tid = TID(), lane = tid & 63, wave = tid >> 6, fr = lane & 15, fq = lane >> 4;
    LAS bf16_t* ring = (LAS bf16_t*)lds;
    const bf16_t* CH = (const bf16_t*)(k.ws + AR_CHUNK);
    const bf16_t* ATT = (const bf16_t*)(k.ws + AR_HBUF);
    const float* EGL = (const float*)(k.ws + WS_EGL);
    bf16_t* O = (bf16_t*)(k.ws + AR_PB);
    for (int un0 = blockIdx.x; un0 < 256; un0 += gridDim.x) {
        const int un = (gridDim.x == 256) ? ((un0 & 7) * 32 + (un0 >> 3)) : un0;
        const int sl = un & 7, chain = un >> 3, dir = chain & 1, h = (chain >> 1) & 7, b = chain >> 4;
        const int rstep = dir == 0 ? 1 : -1;
        f32x4 S[8];
#pragma unroll
        for (int t = 0; t < 8; ++t) S[t] = (f32x4){0.f, 0.f, 0.f, 0.f};
        LAS float* eglL = (LAS float*)(ring + 2 * SC_STAGE);
        constexpr int NPF = 1;
        ScanRegs R[NPF];
        const int wv = wave - 1;
        lds_barrier();
        if (tid < DN_STEPS) eglL[tid] = EGL[chain * DN_STEPS + tid];
        if (wave > 0) {
            dn_scan_fetch(CH, ATT, chain * DN_STEPS, sl, wv, lane, R[0]); dn_scan_put(ring, wv, lane, R[0]);
#pragma unroll
            for (int q = 0; q < NPF; ++q) dn_scan_fetch(CH, ATT, chain * DN_STEPS + q + 1, sl, wv, lane, R[q]);
        }
        lds_barrier();
#pragma unroll 1
        for (int s4 = 0; s4 < DN_STEPS; s4 += NPF) {
#pragma unroll
          for (int q = 0; q < NPF; ++q) {
            const int s = s4 + q; if (s >= DN_STEPS) break;
            LAS bf16_t* st = ring + (s & 1) * SC_STAGE;
            if (wave > 0) {
                if (s + 1 < DN_STEPS) dn_scan_put(ring + ((s + 1) & 1) * SC_STAGE, wv, lane, R[q]);
                if (s + 1 + NPF < DN_STEPS) dn_scan_fetch(CH, ATT, chain * DN_STEPS + s + 1 + NPF, sl, wv, lane, R[q]);
            } else {
                const float egl = eglL[s];
                bf16x8 sb[4];
#pragma unroll
                for (int ks = 0; ks < 4; ++ks) sb[ks] = pk8(S[2 * ks], S[2 * ks + 1]);
                f32x4 p[4], o[4];
#pragma unroll
                for (int mt = 0; mt < 4; ++mt) { p[mt] = (f32x4){0.f, 0.f, 0.f, 0.f}; o[mt] = (f32x4){0.f, 0.f, 0.f, 0.f}; }
#pragma unroll
                for (int ks = 0; ks < 4; ++ks) {
#pragma unroll
                    for (int mt = 0; mt < 4; ++mt) {
                        const LAS bf16_t* wr = st + SC_W + (16 * mt + fr) * 136 + 4 * fq + 32 * ks;
                        p[mt] = __builtin_amdgcn_mfma_f32_16x16x32_bf16(ld2(wr, wr + 16), sb[ks], p[mt], 0, 0, 0);
                    }
#pragma unroll
                    for (int mt = 0; mt < 4; ++mt) {
                        const LAS bf16_t* qr = st + SC_QD + (16 * mt + fr) * 136 + 4 * fq + 32 * ks;
                        o[mt] = __builtin_amdgcn_mfma_f32_16x16x32_bf16(ld2(qr, qr + 16), sb[ks], o[mt], 0, 0, 0);
                    }
                }
                bf16x8 vb[2]; f32x4 vn[4];
#pragma unroll
                for (int mt = 0; mt < 4; ++mt) {
                    const u32x2 uu = *(const LAS u32x2*)(st + SC_U + fr * 72 + 16 * mt + 4 * fq);
                    vn[mt][0] = __uint_as_float(uu[0] << 16) - p[mt][0]; vn[mt][1] = __uint_as_float(uu[0] & 0xffff0000u) - p[mt][1];
                    vn[mt][2] = __uint_as_float(uu[1] << 16) - p[mt][2]; vn[mt][3] = __uint_as_float(uu[1] & 0xffff0000u) - p[mt][3];
                }
                vb[0] = pk8(vn[0], vn[1]); vb[1] = pk8(vn[2], vn[3]);
#pragma unroll
                for (int t = 0; t < 8; ++t) S[t] = S[t] * egl;
#pragma unroll
                for (int kc = 0; kc < 2; ++kc) {
#pragma unroll
                    for (int mt = 0; mt < 4; ++mt) {
                        const LAS bf16_t* ar = st + SC_AT + (16 * mt + fr) * 72 + 4 * fq + 32 * kc;
                        o[mt] = __builtin_amdgcn_mfma_f32_16x16x32_bf16(ld2(ar, ar + 16), vb[kc], o[mt], 0, 0, 0);
                    }
#pragma unroll
                    for (int t = 0; t < 8; ++t) {
                        const LAS bf16_t* kr = st + SC_KD + (16 * t + fr) * 72 + 4 * fq + 32 * kc;
                        S[t] = __builtin_amdgcn_mfma_f32_16x16x32_bf16(ld2(kr, kr + 16), vb[kc], S[t], 0, 0, 0);
                    }
                }
                const int rbase = dn_rbase(b, dir, s);
#pragma unroll
                for (int mt = 0; mt < 4; ++mt)
#pragma unroll
                    for (int jj = 0; jj < 4; ++jj) {
                        const int row = rbase + rstep * (16 * mt + 4 * fq + jj);
                        O[((size_t)dir * T + row) * 1024 + h * 128 + sl * 16 + fr] = f2bf(o[mt][jj]);
                    }
            }
            lds_barrier();
          }
        }
    }
}
PF void dn_finish(const KC& k, int j) {
    const int tid = TID(), lane = tid & 63, wave = tid >> 6;
    const bf16_t* O = (const bf16_t*)(k.ws + AR_PB);
    const bf16_t* Z = (const bf16_t*)k.out;
    bf16_t* U = (bf16_t*)(k.ws + AR_UBUF);
    const float* on = k.dn_out_norm + j * 128;
    for (int r = blockIdx.x * 8 + wave; r < T; r += gridDim.x * 8) {
        float o[16];
#pragma unroll
        for (int m = 0; m < 16; ++m) o[m] = bf2f(O[(size_t)r * 1024 + lane + 64 * m]) + bf2f(O[((size_t)T + r) * 1024 + lane + 64 * m]);
#pragma unroll
        for (int hh = 0; hh < 8; ++hh) {
            const float ss = wsum(o[2 * hh] * o[2 * hh] + o[2 * hh + 1] * o[2 * hh + 1], lane);
            const float rs = rsqrtf(ss * (1.0f / 128.0f) + EPS);
#pragma unroll
            for (int q = 0; q < 2; ++q) {
                const int m = 2 * hh + q, col = lane + 64 * m;
                const float z = bf2f(Z[(size_t)r * 1024 + col]);
                U[(size_t)r * 1024 + col] = f2bf(o[m] * rs * on[col & 127] * siluf(z));
            }
        }
    }
}

DI float conv3g(const bf16_t* p, int j, float w0, float w1, float w2) {
    const int gc = j & 63;
    const float l = gc != 0 ? bf2f(p[j - 1]) : 0.f, c = bf2f(p[j]), r = gc != 63 ? bf2f(p[j + 1]) : 0.f;
    return w0 * l + w1 * c + w2 * r;
}
DI float hy_conv_lane(float c, float w0, float w1, float w2, int lane) {
    const float l = shi(c, (lane + 63) & 63), r = shi(c, (lane + 1) & 63);
    return w0 * (lane > 0 ? l : 0.f) + w1 * c + w2 * (lane < 63 ? r : 0.f);
}
PF void hy_lat(const KC& k, int jl, LAS float* ldsf) {
    const int tid = TID();
    LAS cf* X = (LAS cf*)ldsf;
    LAS cf* tw = X + 17408;
    LAS cf* tA = tw + 1024; LAS cf* tB = tA + 128;
    const float* FT = (const float*)(k.ws + AR_FT);
    const bf16_t* PT = (const bf16_t*)(k.ws + AR_PB);
    bf16_t* ZT = (bf16_t*)(k.ws + AR_ZT);
    cf* scr = (cf*)(k.ws + AR_FFTS) + (size_t)blockIdx.x * 4 * 16384;
    cf* sKe = scr; cf* sKo = scr + 16384; cf* zp = scr + 2 * 16384; cf* ye = scr + 3 * 16384;
    const float* cw = k.hy_conv + (size_t)jl * 3 * 3072;
    for (int m = 0; m < 2; ++m) { const int p = tid + 512 * m; float sn, cs; sincospif(-(float)p / 8192.0f, &sn, &cs); cf w; w.x = cs; w.y = sn; tw[p] = w; }
    if (tid < 256) { const int a = tid & 127; float sn, cs; sincospif(-(float)(tid < 128 ? 128 * a : a) / 16384.0f, &sn, &cs); cf w; w.x = cs; w.y = sn; (tid < 128 ? tA : tB)[a] = w; }
    __syncthreads();
    const int lane = tid & 63;
#define HY_SPLIT() asm volatile("" ::: "memory")
#define HY_CONV(c, w0, w1, w2) hy_conv_lane((c), (w0), (w1), (w2), lane)
    for (int ch = blockIdx.x; ch < 1024; ch += gridDim.x) {
        {
            const bf16_t* pv = PT + (size_t)ch * T + TC;
            const float w0 = cw[ch], w1 = cw[3072 + ch], w2 = cw[6144 + ch];
            for (int m0 = 0; m0 < 32; m0 += 8) {
                bf16_t a0[8], a1[8];
#pragma unroll
                for (int q = 0; q < 8; ++q) { const int j = tid + 512 * (m0 + q); a0[q] = pv[j]; a1[q] = pv[SEQ + j]; }
                HY_SPLIT();
#pragma unroll
                for (int q = 0; q < 8; ++q) { const int j = tid + 512 * (m0 + q); const float c0 = bf2f(a0[q]), c1 = bf2f(a1[q]); cf z; z.x = HY_CONV(c0, w0, w1, w2); z.y = HY_CONV(c1, w0, w1, w2); zp[j] = z; }
            }
        }
        for (int n = 0; n < 2; ++n) {
            __syncthreads();
            const float* ftf = FT + (size_t)(n * 2048 + ch) * 16384; const float* ftb = FT + (size_t)(n * 2048 + 1024 + ch) * 16384;
            for (int m0 = 0; m0 < 32; m0 += 8) {
                float hfv[8], hbv[8];
#pragma unroll
                for (int q = 0; q < 8; ++q) { const int j = tid + 512 * (m0 + q); hfv[q] = ftf[j]; hbv[q] = ftb[j > 0 ? SEQ - j : 0]; }
                HY_SPLIT();
#pragma unroll
                for (int q = 0; q < 8; ++q) {
                    const int j = tid + 512 * (m0 + q);
                    const float hf = hfv[q], hb = j > 0 ? hbv[q] : 0.f;
                    const cf w = cmul(tA[j >> 7], tB[j & 127]);
                    cf a; a.x = hf + hb; a.y = 0.f; X[PIDX(j)] = a;
                    const float kd = hf - hb; cf o; o.x = kd * w.x; o.y = kd * w.y; sKo[j] = o;
                }
            }
            __syncthreads();
            fft16k_fwd(X, tw);
            _Pragma("unroll 8") for (int m = 0; m < 32; ++m) { const int j = tid + 512 * m; sKe[j] = X[PIDX(j)]; }
            __syncthreads();
            for (int m0 = 0; m0 < 32; m0 += 8) { cf t[8];
#pragma unroll
                for (int q = 0; q < 8; ++q) t[q] = sKo[tid + 512 * (m0 + q)];
                HY_SPLIT();
#pragma unroll
                for (int q = 0; q < 8; ++q) X[PIDX(tid + 512 * (m0 + q))] = t[q]; }
            __syncthreads();
            fft16k_fwd(X, tw);
            _Pragma("unroll 8") for (int m = 0; m < 32; ++m) { const int j = tid + 512 * m; sKo[j] = X[PIDX(j)]; }
            __syncthreads();
            for (int m0 = 0; m0 < 32; m0 += 8) { cf t[8];
#pragma unroll
                for (int q = 0; q < 8; ++q) t[q] = zp[tid + 512 * (m0 + q)];
                HY_SPLIT();
#pragma unroll
                for (int q = 0; q < 8; ++q) X[PIDX(tid + 512 * (m0 + q))] = t[q]; }
            __syncthreads();
            fft16k_fwd(X, tw);
            for (int m0 = 0; m0 < 32; m0 += 8) { cf t[8];
#pragma unroll
                for (int q = 0; q < 8; ++q) t[q] = sKe[tid + 512 * (m0 + q)];
                HY_SPLIT();
#pragma unroll
                for (int q = 0; q < 8; ++q) { const int j = tid + 512 * (m0 + q); X[PIDX(j)] = cmul(X[PIDX(j)], t[q]); } }
            __syncthreads();
            fft16k_inv(X, tw);
            _Pragma("unroll 8") for (int m = 0; m < 32; ++m) { const int j = tid + 512 * m; ye[j] = X[PIDX(j)]; }
            __syncthreads();
            for (int m0 = 0; m0 < 32; m0 += 8) { cf t[8];
#pragma unroll
                for (int q = 0; q < 8; ++q) t[q] = zp[tid + 512 * (m0 + q)];
                HY_SPLIT();
#pragma unroll
                for (int q = 0; q < 8; ++q) { const int j = tid + 512 * (m0 + q); const cf w = cmul(tA[j >> 7], tB[j & 127]); X[PIDX(j)] = cmul(t[q], w); } }
            __syncthreads();
            fft16k_fwd(X, tw);
            for (int m0 = 0; m0 < 32; m0 += 8) { cf t[8];
#pragma unroll
                for (int q = 0; q < 8; ++q) t[q] = sKo[tid + 512 * (m0 + q)];
                HY_SPLIT();
#pragma unroll
                for (int q = 0; q < 8; ++q) { const int j = tid + 512 * (m0 + q); X[PIDX(j)] = cmul(X[PIDX(j)], t[q]); } }
            __syncthreads();
            fft16k_inv(X, tw);
            {
                const bf16_t* pg = PT + (size_t)((n + 1) * 1024 + ch) * T + TC;
                const int gcol = (n + 1) * 1024 + ch;
                const float w0 = cw[gcol], w1 = cw[3072 + gcol], w2 = cw[6144 + gcol];
                const float bias = k.hy_bias[(size_t)jl * 2 * 1024 + n * 1024 + ch];
                for (int m0 = 0; m0 < 32; m0 += 8) {
                    cf te[8], tz[8]; bf16_t g0[8], g1[8];
#pragma unroll
                    for (int q = 0; q < 8; ++q) { const int j = tid + 512 * (m0 + q); te[q] = ye[j]; tz[q] = zp[j]; g0[q] = pg[j]; g1[q] = pg[SEQ + j]; }
                    HY_SPLIT();
#pragma unroll
                    for (int q = 0; q < 8; ++q) {
                        const int j = tid + 512 * (m0 + q);
                        cf w = cmul(tA[j >> 7], tB[j & 127]); w.y = -w.y;
                        const cf yo = cmul(X[PIDX(j)], w);
                        const float y0 = (0.5f / 16384.0f) * (te[q].x + yo.x), y1 = (0.5f / 16384.0f) * (te[q].y + yo.y);
                        const float c0 = bf2f(g0[q]), c1 = bf2f(g1[q]);
                        cf zn; zn.x = HY_CONV(c0, w0, w1, w2) * (y0 + bias * tz[q].x); zn.y = HY_CONV(c1, w0, w1, w2) * (y1 + bias * tz[q].y);
                        zp[j] = zn;
                    }
                }
            }
        }
        for (int m0 = 0; m0 < 32; m0 += 8) { cf t[8];
#pragma unroll
            for (int q = 0; q < 8; ++q) t[q] = zp[tid + 512 * (m0 + q)];
            HY_SPLIT();
#pragma unroll
            for (int q = 0; q < 8; ++q) { const int j = tid + 512 * (m0 + q); ZT[(size_t)ch * T + TC + j] = f2bf(t[q].x); ZT[(size_t)ch * T + TC + SEQ + j] = f2bf(t[q].y); } }
        __syncthreads();
    }
#undef HY_SPLIT
#undef HY_CONV
}
PF void hy_ctx(const KC& k, int jl, LAS float* lds) {
    const int tid = TID(), t = tid & 255, hsel = tid >> 8;
    LAS float* z = lds + hsel * 768; LAS float* hf = z + 256; LAS float* hb = hf + 256;
    const bf16_t* PT = (const bf16_t*)(k.ws + AR_PB);
    bf16_t* U = (bf16_t*)(k.ws + AR_UBUF);
    const float* filtc = (const float*)(k.ws + WS_FILTC);
    const float* cw = k.hy_conv + (size_t)jl * 3 * 3072;
    for (int u = blockIdx.x; u < 1024; u += gridDim.x) {
        const int pr = u * 2 + hsel, b = pr >> 10, ch = pr & 1023;
        float zc;
        {
            const bf16_t* pv = PT + (size_t)ch * T + b * 256;
            const float l = t != 0 ? bf2f(pv[t - 1]) : 0.f, c = bf2f(pv[t]), r = t != 255 ? bf2f(pv[t + 1]) : 0.f;
            zc = cw[ch] * l + cw[3072 + ch] * c + cw[6144 + ch] * r;
        }
        for (int n = 0; n < 2; ++n) {
            __syncthreads();
            z[t] = zc; hf[t] = filtc[(size_t)t * 4096 + n * 2048 + ch]; hb[t] = filtc[(size_t)t * 4096 + n * 2048 + 1024 + ch];
            __syncthreads();
            float y = 0.f;
            for (int s = 0; s <= t; ++s) y += hf[t - s] * z[s];
            for (int s = t + 1; s < 256; ++s) y += hb[s - t] * z[s];
            const int gcol = (n + 1) * 1024 + ch;
            const bf16_t* pg = PT + (size_t)gcol * T + b * 256;
            const float l = t != 0 ? bf2f(pg[t - 1]) : 0.f, c = bf2f(pg[t]), r = t != 255 ? bf2f(pg[t + 1]) : 0.f;
            const float gate = cw[gcol] * l + cw[3072 + gcol] * c + cw[6144 + gcol] * r;
            zc = gate * (y + k.hy_bias[(size_t)jl * 2048 + n * 1024 + ch] * zc);
        }
        U[(size_t)(b * 256 + t) * 1024 + ch] = f2bf(zc);
        __syncthreads();
    }
}
PF void hy_transpose(const KC& k, LAS bf16_t* lds) {
    const int tid = TID();
    const bf16_t* ZT = (const bf16_t*)(k.ws + AR_ZT);
    bf16_t* U = (bf16_t*)(k.ws + AR_UBUF);
    for (int u = blockIdx.x; u < 16 * (TL / 64); u += gridDim.x) {
        const int c0 = (u & 15) * 64, r0 = TC + (u >> 4) * 64;
        { const int c = tid >> 3, sg = (tid & 7) * 8;
          const u32x4 v = *(const u32x4*)(ZT + (size_t)(c0 + c) * T + r0 + sg);
#pragma unroll
          for (int w = 0; w < 4; ++w) { lds[(sg + 2 * w) * 66 + c] = (bf16_t)(v[w] & 0xffff); lds[(sg + 2 * w + 1) * 66 + c] = (bf16_t)(v[w] >> 16); } }
        __syncthreads();
        { const int r = tid >> 3, sg = (tid & 7) * 8; u32x4 o;
#pragma unroll
          for (int w = 0; w < 4; ++w) o[w] = (unsigned)lds[r * 66 + sg + 2 * w] | ((unsigned)lds[r * 66 + sg + 2 * w + 1] << 16);
          *(u32x4*)(U + (size_t)(r0 + r) * 1024 + c0 + sg) = o; }
        __syncthreads();
    }
}

__global__ void __launch_bounds__(NTHR, 2) fwd_kernel(Params prm) {
    extern __shared__ __attribute__((aligned(16))) unsigned char lds_raw[];
    LAS unsigned char* lds = (LAS unsigned char*)lds_raw;
    LAS float* ldsf = (LAS float*)lds;
    LAS bf16_t* ldsh = (LAS bf16_t*)lds;
    LAS int* tb = (LAS int*)(lds + 150 * 1024);
    volatile LAS unsigned* xbw = (volatile LAS unsigned*)(lds + 151 * 1024 + 512);
    KC k;
    k.x = (const float*)(GAS const float*)prm.in[0]; k.c = (const float*)(GAS const float*)prm.in[1]; k.ctx = (const float*)(GAS const float*)prm.in[2]; k.c_ctx = (const float*)(GAS const float*)prm.in[3]; k.ada_w = (const float*)(GAS const float*)prm.in[4]; k.ada_b = (const float*)(GAS const float*)prm.in[5];
    k.norm_mix = (const float*)(GAS const float*)prm.in[6]; k.norm_ffn = (const float*)(GAS const float*)prm.in[7]; k.norm_final = (const float*)(GAS const float*)prm.in[8];
    k.dn_w_in = (const float*)(GAS const float*)prm.in[9]; k.dn_conv = (const float*)(GAS const float*)prm.in[10]; k.dn_a_log = (const float*)(GAS const float*)prm.in[11]; k.dn_dt_bias = (const float*)(GAS const float*)prm.in[12]; k.dn_out_norm = (const float*)(GAS const float*)prm.in[13]; k.dn_w_out = (const float*)(GAS const float*)prm.in[14];
    k.hy_w_in = (const float*)(GAS const float*)prm.in[15]; k.hy_conv = (const float*)(GAS const float*)prm.in[16]; k.hy_f_w1 = (const float*)(GAS const float*)prm.in[17]; k.hy_f_b1 = (const float*)(GAS const float*)prm.in[18]; k.hy_f_freq = (const float*)(GAS const float*)prm.in[19]; k.hy_f_w2 = (const float*)(GAS const float*)prm.in[20];
    k.hy_f_b2 = (const float*)(GAS const float*)prm.in[21]; k.hy_f_w3 = (const float*)(GAS const float*)prm.in[22]; k.hy_bias = (const float*)(GAS const float*)prm.in[23]; k.hy_w_out = (const float*)(GAS const float*)prm.in[24];
    k.sc_w_in = (const float*)(GAS const float*)prm.in[25]; k.sc_conv = (const float*)(GAS const float*)prm.in[26]; k.sc_w_out = (const float*)(GAS const float*)prm.in[27]; k.w_router = (const float*)(GAS const float*)prm.in[28]; k.router_bias = (const float*)(GAS const float*)prm.in[29];
    k.moe_w_gate = (const float*)(GAS const float*)prm.in[30]; k.moe_w_up = (const float*)(GAS const float*)prm.in[31]; k.moe_w_down = (const float*)(GAS const float*)prm.in[32];
    k.out = (float*)(GAS float*)prm.out; k.ws = (unsigned char*)(GAS unsigned char*)prm.ws;
    const int lo = prm.ph_lo, hi = prm.ph_hi;
    XcdBarrier bar; bar.bar = (unsigned*)(k.ws + WS_CTL); bar.x = 0; bar.st = xbw;
    if (hi - lo > 1) {
        if (threadIdx.x == 0) { xbw[0] = 0u; xbw[1] = 0u; }
        __syncthreads();
        bar = xcd_barrier_post((unsigned*)(k.ws + WS_CTL), xbw);
    }
    int ph = 0;
#define PROBE_OK(id) ((id) != 1 || i == 0)
    int i = 0;
#define PH_BEGIN(id) if (ph >= lo && ph < hi) { const int nrep_ = (((id) == PROBE_REP) && PROBE_OK(id)) ? 2 : 1; for (int rep_ = 0; rep_ < nrep_; ++rep_) { { GAS unsigned char* w_ = (GAS unsigned char*)k.ws; asm volatile("" : "+s"(w_)); k.ws = (unsigned char*)w_; }
#define PH_END   if (ph + 1 < hi) xcd_barrier(bar); } } ++ph;

    float* xs = (float*)(k.ws + WS_XS);
    const float* mod = (const float*)(k.ws + WS_MOD);

    PH_BEGIN(0)
        job_mod(k, ldsf);
        job_cvt_small(k, ldsf);
        job_hdn(k, ldsf);
        job_w3s(k);
    PH_END

    for (i = 0; i < DEPTH; ++i) {
        const int kind = i % 3, j = i / 3;
        const bool last = (i == DEPTH - 1);
        PH_BEGIN(1)
            if (kind == 0) norm_phase<2>(k, i, i == 0, i > 0, k.norm_mix + i * 1024, 0, k.dn_w_in + (size_t)j * 1024 * DN_IN + 4096, DN_IN,
                                         k.dn_a_log + j * 16, k.dn_dt_bias + j * 16, last, ldsf);
            else norm_phase<0>(k, i, i == 0, i > 0, k.norm_mix + i * 1024, 0, nullptr, 0, nullptr, nullptr, last, ldsf);
            if (kind == 1) job_filtc(k, j);
        PH_END
        PH_BEGIN(2)
            if (kind == 0) { EpiBf16 e{(bf16_t*)(k.ws + AR_PB), 3072, 3072, (bf16_t*)k.out, 1024}; gemm_dense(lds, (const bf16_t*)(k.ws + AR_HBUF), T, (const bf16_t*)(k.ws + WS_DNWIN) + (size_t)j * 4096 * 1024, 4096, 1024, e); }
            else if (kind == 1) { EpiBf16T e{(bf16_t*)(k.ws + AR_PB), T}; gemm_dense(lds, (const bf16_t*)(k.ws + AR_HBUF), T, (const bf16_t*)(k.ws + WS_HYWIN), 3072, 1024, e);
                                  EpiTaps et{(float*)(k.ws + AR_FT)}; gemm_dense(lds, (const bf16_t*)(k.ws + WS_W3S), 4096, (const bf16_t*)(k.ws + WS_HS), 16384, 256, et); }
            else { EpiBf16 e{(bf16_t*)(k.ws + AR_PB), 3072, 1 << 30, nullptr, 0}; gemm_dense(lds, (const bf16_t*)(k.ws + AR_HBUF), T, (const bf16_t*)(k.ws + WS_SCWIN), 3072, 1024, e); }
        PH_END
        if (kind == 0) {
            PH_BEGIN(3) dn_chunk(k, j, lds); PH_END
            PH_BEGIN(4) dn_scan(k, lds); PH_END
            PH_BEGIN(5) dn_finish(k, j); PH_END
        } else if (kind == 1) {
            PH_BEGIN(6) hy_lat(k, j, ldsf); hy_ctx(k, j, ldsf); PH_END
            PH_BEGIN(7) hy_transpose(k, ldsh); PH_END
        } else {
            PH_BEGIN(8) sc_mix(k, j); PH_END
        }
        PH_BEGIN(9)
            const bf16_t* Wt = kind == 0 ? (const bf16_t*)(k.ws + WS_DNWOUT) + (size_t)j * 1024 * 1024 : (kind == 1 ? (const bf16_t*)(k.ws + WS_HYWOUT) : (const bf16_t*)(k.ws + WS_SCWOUT));
            EpiResid e{xs, mod, i, 2};
            gemm_dense(lds, (const bf16_t*)(k.ws + AR_UBUF), T, Wt, 1024, 1024, e);
        PH_END
        PH_BEGIN(10)
            norm_phase<1>(k, i, false, false, k.norm_ffn + i * 1024, 3, k.w_router, 32, k.router_bias, nullptr, last, ldsf, rep_ == nrep_ - 1);
        PH_END
        PH_BEGIN(11)
            if (rep_ == 0) moe_scatter(k, i, tb);
            job_cvt_moe(k, i, ldsf);
        PH_END
        PH_BEGIN(12) moe_gemm<0>(k, i, lds, tb); PH_END
        PH_BEGIN(13) moe_gemm<1>(k, i, lds, tb); PH_END
    }
    PH_BEGIN(14)
        norm_phase<3>(k, DEPTH, false, true, k.norm_final, 0, nullptr, 0, nullptr, nullptr, false, ldsf);
    PH_END
#undef PH_BEGIN
#undef PH_END
}
constexpr int N_PHASES = 1 + (10 + 9 + 8 + 10) + 1;

extern "C" void kernel_launch(void* const* d_in, const int* in_sizes, int n_in, void* d_out, int out_size, void* d_ws, size_t ws_size, hipStream_t stream) {
    static int grid = 0;
    if (grid == 0) {
        if (n_in != 33 || out_size != TL * D || ws_size < WS_END) { fprintf(stderr, "kernel_launch: unexpected shapes: n_in %d out %d ws %zu (need %zu)\n", n_in, out_size, ws_size, (size_t)WS_END); grid = -1; return; }
        int dev = 0, cus = 0, per_cu = 0;
        if (hipGetDevice(&dev) != hipSuccess || hipDeviceGetAttribute(&cus, hipDeviceAttributeMultiprocessorCount, dev) != hipSuccess) { grid = -1; return; }
        if (hipFuncSetAttribute((const void*)fwd_kernel, hipFuncAttributeMaxDynamicSharedMemorySize, LDS_BYTES) != hipSuccess) { fprintf(stderr, "kernel_launch: hipFuncSetAttribute failed\n"); grid = -1; return; }
        if (hipOccupancyMaxActiveBlocksPerMultiprocessor(&per_cu, (const void*)fwd_kernel, NTHR, LDS_BYTES) != hipSuccess || per_cu < 1) fprintf(stderr, "kernel_launch: occupancy query reports %d\n", per_cu);
        (void)hipGetLastError();
        grid = cus;
    }
    if (grid < 0) return;
    (void)hipMemsetAsync((char*)d_ws + WS_CTL, 0, CTL_BYTES, stream);
    Params p{};
    for (int i = 0; i < 33; ++i) p.in[i] = (const float*)d_in[i];
    p.out = (float*)d_out; p.ws = (unsigned char*)d_ws;
#if MK_MULTI
    for (int ph = 0; ph < N_PHASES; ++ph) { p.ph_lo = ph; p.ph_hi = ph + 1; hipLaunchKernelGGL(fwd_kernel, dim3(grid), dim3(NTHR), LDS_BYTES, stream, p); }
#else
    p.ph_lo = 0; p.ph_hi = N_PHASES;
    hipLaunchKernelGGL(fwd_kernel, dim3(grid), dim3(NTHR), LDS_BYTES, stream, p);
#endif
}
```

```cpp
#include <hip/hip_runtime.h>
#include <stdint.h>
#include <stdio.h>
#include <math.h>

#ifndef MK_MULTI
#define MK_MULTI 0
#endif

#ifndef PROBE_SUB
#define PROBE_SUB (0)
#endif
#ifndef PROBE_REP
#define PROBE_REP (-1)
#endif
#define LAS __attribute__((address_space(3)))
#define GAS __attribute__((address_space(1)))
#define HD __host__ __device__ __forceinline__
#define DI __device__ __forceinline__
#ifdef NOINL
#define PF __device__ __noinline__
#else
#define PF __device__ __forceinline__
#endif
typedef unsigned short bf16_t;
typedef short bf16x8 __attribute__((ext_vector_type(8)));
typedef float f32x4 __attribute__((ext_vector_type(4)));
typedef unsigned u32x4 __attribute__((ext_vector_type(4)));
typedef unsigned u32x2 __attribute__((ext_vector_type(2)));

constexpr int D = 1024, NB = 2, SEQ = 16384, CTXL = 256, DEPTH = 4;
constexpr int TC = NB * CTXL, TL = NB * SEQ, T = TC + TL, NA = 2 * T;
constexpr int NTHR = 512;
constexpr int DN_IN = 4128;
constexpr float EPS = 1e-6f;
constexpr int LDS_BYTES = 152 * 1024;

constexpr size_t AL(size_t x) { return (x + 255) & ~(size_t)255; }
constexpr size_t WS_CTL = 0;
constexpr size_t CTL_BYTES = 65536;
constexpr size_t CTL_CNT = 16384;
constexpr size_t WS_MOD = WS_CTL + CTL_BYTES;
constexpr size_t WS_HS = AL(WS_MOD + 4 * 3 * 6144 * 4);
constexpr size_t WS_W3S = AL(WS_HS + 16384 * 256 * 2);
constexpr size_t WS_HDNC = AL(WS_W3S + 4096 * 256 * 2);
constexpr size_t WS_FILTC = AL(WS_HDNC + 256 * 64 * 4);
constexpr size_t WS_DNWIN = AL(WS_FILTC + 256 * 4096 * 4);
constexpr size_t WS_DNWOUT = AL(WS_DNWIN + (size_t)2 * 4096 * 1024 * 2);
constexpr size_t WS_HYWIN = AL(WS_DNWOUT + (size_t)2 * 1024 * 1024 * 2);
constexpr size_t WS_HYWOUT = AL(WS_HYWIN + (size_t)3072 * 1024 * 2);
constexpr size_t WS_SCWIN = AL(WS_HYWOUT + (size_t)1024 * 1024 * 2);
constexpr size_t WS_SCWOUT = AL(WS_SCWIN + (size_t)3072 * 1024 * 2);
constexpr size_t WS_XS = AL(WS_SCWOUT + (size_t)1024 * 1024 * 2);
constexpr size_t WS_TOKE = AL(WS_XS + (size_t)T * 1024 * 4);
constexpr size_t WS_TOKW = AL(WS_TOKE + (size_t)T * 2 * 4);
constexpr size_t WS_TOKP = AL(WS_TOKW + (size_t)T * 2 * 4);
constexpr size_t WS_SLOT = AL(WS_TOKP + (size_t)T * 2 * 4);
constexpr size_t WS_GB = AL(WS_SLOT + (size_t)(NA + 256) * 4);
constexpr size_t WS_EGL = AL(WS_GB + (size_t)T * 32 * 4);
constexpr size_t WS_AR = AL(WS_EGL + (size_t)32 * 260 * 4);
constexpr size_t AR_HBUF = WS_AR;
constexpr size_t AR_UBUF = AR_HBUF + (size_t)T * 1024 * 2;
constexpr size_t AR_PB = AR_UBUF + (size_t)T * 1024 * 2;
constexpr size_t AR_Q = AR_PB + (size_t)T * 4096 * 2;
constexpr size_t AR_CHUNK = AR_PB + (size_t)T * 3072 * 2;
constexpr size_t AR_DN_END = AR_CHUNK + (size_t)32 * 260 * 65536;
constexpr size_t AR_ZT = AR_Q;
constexpr size_t AR_FFTS = AR_ZT + (size_t)1024 * T * 2;
constexpr size_t AR_FT = AR_FFTS + (size_t)256 * 4 * 16384 * 8;
constexpr size_t AR_HY_END = AR_FT + (size_t)4096 * 16384 * 4;
constexpr size_t AR_HID = AR_PB;
constexpr size_t AR_YS = AR_HID + (size_t)NA * 512 * 2;
constexpr size_t AR_WGU = AR_YS + (size_t)NA * 1024 * 2;
constexpr size_t AR_WD = AR_WGU + (size_t)32 * 1024 * 1024 * 2;
constexpr size_t AR_MOE_END = AR_WD + (size_t)32 * 1024 * 512 * 2;
constexpr size_t WS_END = AR_DN_END > AR_HY_END ? (AR_DN_END > AR_MOE_END ? AR_DN_END : AR_MOE_END) : (AR_HY_END > AR_MOE_END ? AR_HY_END : AR_MOE_END);

#define XB_TMO      128
#define XB_XCNT(j)  (256  + 64 * (j))
#define XB_XSUB(j)  (1280 + 64 * (j))
#define XB_XGEN(j)  (2304 + 64 * (j))
#define XB_TOP      3328
#define XB_TOPGEN   3392
#define XCD_BAR_WORDS 3456
#define XB_SPIN_CAP (1u << 25)
DI unsigned xb_ld(unsigned* p)              { return __hip_atomic_load(p, __ATOMIC_RELAXED, __HIP_MEMORY_SCOPE_AGENT); }
DI unsigned xb_add(unsigned* p, unsigned v) { return __hip_atomic_fetch_add(p, v, __ATOMIC_RELAXED, __HIP_MEMORY_SCOPE_AGENT); }
DI unsigned xb_xcc_id() { return (unsigned)__builtin_amdgcn_s_getreg((3 << 11) | 20) & 0xFu; }
#define XB_SPIN(cond, bar) do { unsigned _sp = 0; while (cond) { __builtin_amdgcn_s_sleep(1); \
    if ((++_sp & 255u) == 0u) { if (xb_ld(&(bar)[XB_TMO])) break; if (_sp > XB_SPIN_CAP) { atomicAdd(&(bar)[XB_TMO], 1u); break; } } } } while (0)
struct XcdBarrier { unsigned* bar; unsigned x; volatile LAS unsigned* st; };
DI XcdBarrier xcd_barrier_post(unsigned* bar, volatile LAS unsigned* st) {
    XcdBarrier b; b.bar = bar; b.x = xb_xcc_id(); b.st = st;
    if (threadIdx.x == 0) (void)xb_add(&bar[XB_XCNT(b.x)], 1u);
    return b;
}
DI void xcd_barrier_complete(unsigned* bar, unsigned x, unsigned& nloc, unsigned& nx) {
    const unsigned G = gridDim.x * gridDim.y * gridDim.z;
    unsigned sum, cnt, mine, sp = 0u;
    for (;;) {
        sum = 0u; cnt = 0u; mine = 0u;
#pragma unroll
        for (unsigned j = 0; j < 16; ++j) { const unsigned c = xb_ld(&bar[XB_XCNT(j)]); sum += c; cnt += (c > 0u) ? 1u : 0u; mine = (j == x) ? c : mine; }
        if (sum == G) break;
        __builtin_amdgcn_s_sleep(1);
        if ((++sp & 255u) == 0u) { if (xb_ld(&bar[XB_TMO])) break; if (sp > XB_SPIN_CAP) { atomicAdd(&bar[XB_TMO], 1u); break; } }
    }
    nloc = mine > 0u ? mine : 1u; nx = cnt > 0u ? cnt : 1u;
}
DI void xcd_barrier(const XcdBarrier& b) {
    asm volatile("s_waitcnt vmcnt(0)" ::: "memory");
    __syncthreads();
    if (threadIdx.x == 0) {
        unsigned* bar = b.bar;
        __builtin_amdgcn_s_waitcnt(0);
        unsigned nloc = b.st[0], nx = b.st[1];
        if (nloc == 0u) { xcd_barrier_complete(bar, b.x, nloc, nx); b.st[0] = nloc; b.st[1] = nx; }
        const unsigned old = xb_add(&bar[XB_XSUB(b.x)], 1u);
        const unsigned gen = old / nloc;
        if (old + 1u == (gen + 1u) * nloc) {
            __builtin_amdgcn_fence(__ATOMIC_RELEASE, "agent");
            asm volatile("s_waitcnt vmcnt(0)" ::: "memory");
            const unsigned og = xb_add(&bar[XB_TOP], 1u);
            const unsigned tg = og / nx;
            if (og + 1u == (tg + 1u) * nx) xb_add(&bar[XB_TOPGEN], 1u);
            else XB_SPIN(xb_ld(&bar[XB_TOPGEN]) == tg, bar);
            __builtin_amdgcn_fence(__ATOMIC_ACQUIRE, "agent");
            xb_add(&bar[XB_XGEN(b.x)], 1u);
            asm volatile("s_waitcnt vmcnt(0)" ::: "memory");
        } else {
            XB_SPIN(xb_ld(&bar[XB_XGEN(b.x)]) == gen, bar);
            __builtin_amdgcn_fence(__ATOMIC_ACQUIRE, "agent");
            asm volatile("s_waitcnt vmcnt(0)" ::: "memory");
        }
    }
    __syncthreads();
}

typedef float f32x2_t __attribute__((ext_vector_type(2)));
typedef __bf16 bf16x2_t __attribute__((ext_vector_type(2)));
DI unsigned cvt_pk_bf16(float lo, float hi) { f32x2_t v; v.x = lo; v.y = hi; const bf16x2_t b = __builtin_convertvector(v, bf16x2_t); return __builtin_bit_cast(unsigned, b); }
DI bf16_t f2bf(float f) { return (bf16_t)(cvt_pk_bf16(f, f) & 0xffffu); }
DI float bf2f(bf16_t b) { return __uint_as_float(((unsigned)b) << 16); }
DI unsigned pk2(float lo, float hi) { return cvt_pk_bf16(lo, hi); }
DI float siluf(float x) { return x * __builtin_amdgcn_rcpf(1.0f + __expf(-x)); }
DI float sigmf(float x) { return 1.0f / (1.0f + __expf(-x)); }
DI float shi(float v, int src) { return __int_as_float(__builtin_amdgcn_ds_bpermute(src << 2, __float_as_int(v))); }
DI int shii(int v, int src) { return __builtin_amdgcn_ds_bpermute(src << 2, v); }
DI float shx(float v, int m, int lane) { return shi(v, lane ^ m); }
DI float wsum(float v, int lane) {
#pragma unroll
    for (int m = 32; m >= 1; m >>= 1) v += shx(v, m, lane);
    return v;
}
DI void lds_barrier() { asm volatile("s_waitcnt lgkmcnt(0)\n\ts_barrier" ::: "memory"); }
DI int TID() { int t = threadIdx.x; asm volatile("" : "+v"(t)); return t; }
DI int modrow(int r) { return r < TC ? 0 : 1 + (r - TC) / SEQ; }

typedef float cf __attribute__((ext_vector_type(2)));
HD cf cmul(cf a, cf b) { cf r; r.x = a.x * b.x - a.y * b.y; r.y = a.x * b.y + a.y * b.x; return r; }
HD cf cadd(cf a, cf b) { cf r; r.x = a.x + b.x; r.y = a.y + b.y; return r; }
HD cf csub(cf a, cf b) { cf r; r.x = a.x - b.x; r.y = a.y - b.y; return r; }
template <int R> HD constexpr int brev(int i) { int r = 0; for (int b = 1, t = R >> 1; b < R; b <<= 1, t >>= 1) if (i & b) r |= t; return r; }
#define FFT_C32 {1.0f, 0.98078528040323044913f, 0.92387953251128675613f, 0.83146961230254523708f, 0.70710678118654752440f, 0.55557023301960222474f, 0.38268343236508977173f, 0.19509032201612826785f, 0.0f, -0.19509032201612826785f, -0.38268343236508977173f, -0.55557023301960222474f, -0.70710678118654752440f, -0.83146961230254523708f, -0.92387953251128675613f, -0.98078528040323044913f}
#define FFT_S32 {0.0f, 0.19509032201612826785f, 0.38268343236508977173f, 0.55557023301960222474f, 0.70710678118654752440f, 0.83146961230254523708f, 0.92387953251128675613f, 0.98078528040323044913f, 1.0f, 0.98078528040323044913f, 0.92387953251128675613f, 0.83146961230254523708f, 0.70710678118654752440f, 0.55557023301960222474f, 0.38268343236508977173f, 0.19509032201612826785f}
template <int R> HD constexpr int ilog2c() { int l = 0; for (int r = R; r > 1; r >>= 1) ++l; return l; }
template <int R> HD void dft_fwd(cf (&v)[R]) {
    constexpr float C[16] = FFT_C32; constexpr float S[16] = FFT_S32;
    constexpr int LG = ilog2c<R>();
#pragma unroll
    for (int st = 0; st < LG; ++st) {
#pragma unroll
        for (int i = 0; i < R / 2; ++i) {
            const int len = R >> st, half = len >> 1, blk = i / half, j = i % half, i0 = blk * len + j, i1 = i0 + half;
            const cf a = v[i0], c = v[i1];
            v[i0] = cadd(a, c);
            const cf d = csub(a, c);
            const int ti = j * (32 / len);
            cf w; w.x = C[ti]; w.y = -S[ti];
            cf r;
            if (ti == 0) r = d;
            else if (ti == 8) { r.x = d.y; r.y = -d.x; }
            else if (ti == 4) { r.x = (d.x + d.y) * 0.70710678118654752440f; r.y = (d.y - d.x) * 0.70710678118654752440f; }
            else if (ti == 12) { r.x = (d.y - d.x) * 0.70710678118654752440f; r.y = -(d.x + d.y) * 0.70710678118654752440f; }
            else r = cmul(d, w);
            v[i1] = r;
        }
    }
}
template <int R> HD void dft_inv(cf (&v)[R]) {
    constexpr float C[16] = FFT_C32; constexpr float S[16] = FFT_S32;
    constexpr int LG = ilog2c<R>();
#pragma unroll
    for (int st = LG - 1; st >= 0; --st) {
#pragma unroll
        for (int i = 0; i < R / 2; ++i) {
            const int len = R >> st, half = len >> 1, blk = i / half, j = i % half, i0 = blk * len + j, i1 = i0 + half;
            const int ti = j * (32 / len);
            cf w; w.x = C[ti]; w.y = S[ti];
            const cf a = v[i0];
            const cf b1 = v[i1];
            cf c;
            if (ti == 0) c = b1;
            else if (ti == 8) { c.x = -b1.y; c.y = b1.x; }
            else if (ti == 4) { c.x = (b1.x - b1.y) * 0.70710678118654752440f; c.y = (b1.x + b1.y) * 0.70710678118654752440f; }
            else if (ti == 12) { c.x = -(b1.x + b1.y) * 0.70710678118654752440f; c.y = (b1.x - b1.y) * 0.70710678118654752440f; }
            else c = cmul(b1, w);
            v[i0] = cadd(a, c);
            v[i1] = csub(a, c);
        }
    }
}
#define PIDX(a) ((a) + (((a) >> 6) << 2))
template <int R> DI void fft_pass_fwd(LAS cf* X, const LAS cf* tw, int n, int g) {
    const int s = n / R, q = g / s, p = g - q * s, base = q * n + p;
    cf v[R];
#pragma unroll
    for (int k = 0; k < R; ++k) v[k] = X[PIDX(base + k * s)];
    dft_fwd<R>(v);
    if (s > 1) {
        int pp = p * (16384 / n); asm volatile("" : "+v"(pp));
        const cf w1 = tw[pp]; cf w = w1;
#pragma unroll
        for (int m = 1; m < R; ++m) { v[brev<R>(m)] = cmul(v[brev<R>(m)], w); w = cmul(w, w1); }
    }
#pragma unroll
    for (int k = 0; k < R; ++k) X[PIDX(base + k * s)] = v[k];
}
template <int R> DI void fft_pass_inv(LAS cf* X, const LAS cf* tw, int n, int g) {
    const int s = n / R, q = g / s, p = g - q * s, base = q * n + p;
    cf v[R];
#pragma unroll
    for (int k = 0; k < R; ++k) v[k] = X[PIDX(base + k * s)];
    if (s > 1) {
        int pp = p * (16384 / n); asm volatile("" : "+v"(pp));
        cf w1 = tw[pp]; w1.y = -w1.y; cf w = w1;
#pragma unroll
        for (int m = 1; m < R; ++m) { v[brev<R>(m)] = cmul(v[brev<R>(m)], w); w = cmul(w, w1); }
    }
    dft_inv<R>(v);
#pragma unroll
    for (int k = 0; k < R; ++k) X[PIDX(base + k * s)] = v[k];
}
DI void fft16k_fwd(LAS cf* X, const LAS cf* tw) {
    const int t = TID();
#pragma unroll 1
    for (int g = 0; g < 2; ++g) fft_pass_fwd<16>(X, tw, 16384, t + 512 * g);
    __syncthreads();
#pragma unroll 1
    for (int g = 0; g < 2; ++g) fft_pass_fwd<16>(X, tw, 1024, t + 512 * g);
    __syncthreads();
#pragma unroll 1
    for (int g = 0; g < 2; ++g) fft_pass_fwd<16>(X, tw, 64, t + 512 * g);
    __syncthreads();
#pragma unroll 1
    for (int g = 0; g < 8; ++g) fft_pass_fwd<4>(X, tw, 4, t + 512 * g);
    __syncthreads();
}
DI void fft16k_inv(LAS cf* X, const LAS cf* tw) {
    const int t = TID();
#pragma unroll 1
    for (int g = 0; g < 8; ++g) fft_pass_inv<4>(X, tw, 4, t + 512 * g);
    __syncthreads();
#pragma unroll 1
    for (int g = 0; g < 2; ++g) fft_pass_inv<16>(X, tw, 64, t + 512 * g);
    __syncthreads();
#pragma unroll 1
    for (int g = 0; g < 2; ++g) fft_pass_inv<16>(X, tw, 1024, t + 512 * g);
    __syncthreads();
#pragma unroll 1
    for (int g = 0; g < 2; ++g) fft_pass_inv<16>(X, tw, 16384, t + 512 * g);
    __syncthreads();
}

struct Params { const float* in[33]; float* out; unsigned char* ws; int ph_lo, ph_hi; };
struct KC {
    const float *x, *c, *ctx, *c_ctx, *ada_w, *ada_b, *norm_mix, *norm_ffn, *norm_final;
    const float *dn_w_in, *dn_conv, *dn_a_log, *dn_dt_bias, *dn_out_norm, *dn_w_out;
    const float *hy_w_in, *hy_conv, *hy_f_w1, *hy_f_b1, *hy_f_freq, *hy_f_w2, *hy_f_b2, *hy_f_w3, *hy_bias, *hy_w_out;
    const float *sc_w_in, *sc_conv, *sc_w_out, *w_router, *router_bias, *moe_w_gate, *moe_w_up, *moe_w_down;
    float* out; unsigned char* ws;
};

PF void job_mod(const KC& k, LAS float* lds) {
    const int tid = TID(), cj = tid & 63, kq = tid >> 6;
    float* mod = (float*)(k.ws + WS_MOD);
    for (int u = blockIdx.x; u < DEPTH * 96; u += gridDim.x) {
        const int l = u / 96, cc = u % 96, col = cc * 64 + cj;
        const float* W = k.ada_w + (size_t)l * 1024 * 6144;
        float a0 = 0.f, a1 = 0.f, a2 = 0.f;
        for (int kk = kq * 128; kk < kq * 128 + 128; ++kk) {
            const float w = W[(size_t)kk * 6144 + col];
            a0 += siluf(k.c_ctx[kk]) * w; a1 += siluf(k.c[kk]) * w; a2 += siluf(k.c[1024 + kk]) * w;
        }
        lds[(kq * 3 + 0) * 64 + cj] = a0; lds[(kq * 3 + 1) * 64 + cj] = a1; lds[(kq * 3 + 2) * 64 + cj] = a2;
        __syncthreads();
        if (tid < 192) {
            const int r = tid >> 6, j = tid & 63;
            float s = 0.f;
            for (int q = 0; q < 8; ++q) s += lds[(q * 3 + r) * 64 + j];
            mod[(size_t)(l * 3 + r) * 6144 + cc * 64 + j] = s + k.ada_b[l * 6144 + cc * 64 + j];
        }
        __syncthreads();
    }
}
DI void cvt_tile(const float* __restrict__ src, int ld, bf16_t* __restrict__ dst, int ldd, int k0, int n0, int mapmode, LAS float* lds) {
    const int tid = TID();
    { const int r = tid >> 4, c4 = (tid & 15) * 4;
#pragma unroll
      for (int h = 0; h < 2; ++h) {
          const f32x4 v = *(const f32x4*)(src + (size_t)(k0 + r + 32 * h) * ld + n0 + c4);
          LAS float* p = lds + (r + 32 * h) * 65 + c4; p[0] = v[0]; p[1] = v[1]; p[2] = v[2]; p[3] = v[3];
      } }
    __syncthreads();
    { const int nn = tid >> 3, ks = (tid & 7) * 8; const int n = n0 + nn;
      const int row = mapmode == 0 ? n : (32 * (n >> 4) + (n & 15) + (mapmode == 2 ? 16 : 0));
      u32x4 o;
      o[0] = pk2(lds[(ks + 0) * 65 + nn], lds[(ks + 1) * 65 + nn]); o[1] = pk2(lds[(ks + 2) * 65 + nn], lds[(ks + 3) * 65 + nn]);
      o[2] = pk2(lds[(ks + 4) * 65 + nn], lds[(ks + 5) * 65 + nn]); o[3] = pk2(lds[(ks + 6) * 65 + nn], lds[(ks + 7) * 65 + nn]);
      *(u32x4*)(dst + (size_t)row * ldd + k0 + ks) = o; }
    __syncthreads();
}
DI void cvt_matrix(const float* src, int ld, size_t sstride, int K, int N, int nmat, bf16_t* dst, int ldd, size_t dstride, int mapmode, LAS float* lds) {
    const int tk = K / 64, tn = N / 64, per = tk * tn;
    for (int u = blockIdx.x; u < per * nmat; u += gridDim.x) {
        const int m = u / per, t = u % per;
        cvt_tile(src + (size_t)m * sstride, ld, dst + (size_t)m * dstride, ldd, (t / tn) * 64, (t % tn) * 64, mapmode, lds);
    }
}
PF void job_cvt_small(const KC& k, LAS float* lds) {
    cvt_matrix(k.dn_w_in, DN_IN, (size_t)1024 * DN_IN, 1024, 4096, 2, (bf16_t*)(k.ws + WS_DNWIN), 1024, (size_t)4096 * 1024, 0, lds);
    cvt_matrix(k.dn_w_out, 1024, (size_t)1024 * 1024, 1024, 1024, 2, (bf16_t*)(k.ws + WS_DNWOUT), 1024, (size_t)1024 * 1024, 0, lds);
    cvt_matrix(k.hy_w_in, 3072, 0, 1024, 3072, 1, (bf16_t*)(k.ws + WS_HYWIN), 1024, 0, 0, lds);
    cvt_matrix(k.hy_w_out, 1024, 0, 1024, 1024, 1, (bf16_t*)(k.ws + WS_HYWOUT), 1024, 0, 0, lds);
    cvt_matrix(k.sc_w_in, 3072, 0, 1024, 3072, 1, (bf16_t*)(k.ws + WS_SCWIN), 1024, 0, 0, lds);
    cvt_matrix(k.sc_w_out, 1024, 0, 1024, 1024, 1, (bf16_t*)(k.ws + WS_SCWOUT), 1024, 0, 0, lds);
}
PF void job_cvt_moe(const KC& k, int layer, LAS float* lds) {
    const size_t lo = (size_t)layer * 32 * 1024 * 512;
    cvt_matrix(k.moe_w_gate + lo, 512, (size_t)1024 * 512, 1024, 512, 32, (bf16_t*)(k.ws + AR_WGU), 1024, (size_t)1024 * 1024, 1, lds);
    cvt_matrix(k.moe_w_up + lo, 512, (size_t)1024 * 512, 1024, 512, 32, (bf16_t*)(k.ws + AR_WGU), 1024, (size_t)1024 * 1024, 2, lds);
    cvt_matrix(k.moe_w_down + lo, 1024, (size_t)512 * 1024, 512, 1024, 32, (bf16_t*)(k.ws + AR_WD), 512, (size_t)1024 * 512, 0, lds);
}
PF void job_hdn(const KC& k, LAS float* lds) {
    const int tid = TID(), lane = tid & 63, wave = tid >> 6;
    LAS float* feat = lds + wave * 128; LAS float* h1 = feat + 64;
    const float fr = k.hy_f_freq[lane], b1 = k.hy_f_b1[lane], b2 = k.hy_f_b2[lane];
    for (int u0 = blockIdx.x * 8; u0 < 16384 + 256; u0 += gridDim.x * 8) {
        const int u = u0 + wave;
        int l, pos; float* dst;
        if (u < 16384) { l = 16384; pos = u; dst = nullptr; }
        else { l = 256; pos = u - 16384; dst = (float*)(k.ws + WS_HDNC) + (size_t)pos * 64; }
        const float t = (float)pos / (float)(l - 1);
        float f = 0.f;
        if (lane == 0) f = t;
        else if (lane <= 32) {
            const int bi = (lane - 1) & 15;
            const float band = 1e-4f + (float)bi * ((15.0f - 1e-4f) / 15.0f);
            const float ang = (6.283185307179586f / (float)l) * (float)pos * band;
            f = lane <= 16 ? cosf(ang) : -sinf(ang);
        }
        feat[lane] = f;
        __syncthreads();
        float a = b1;
        for (int i = 0; i < 33; ++i) a += feat[i] * k.hy_f_w1[i * 64 + lane];
        h1[lane] = sinf(fr * a);
        __syncthreads();
        float a2 = b2;
        for (int j = 0; j < 64; ++j) a2 += h1[j] * k.hy_f_w2[j * 64 + lane];
        const float hv = sinf(fr * a2);
        if (dst) dst[lane] = hv;
        else { bf16_t* hs = (bf16_t*)(k.ws + WS_HS) + (size_t)pos * 256; const bf16_t hi = f2bf(hv), lo = f2bf(hv - bf2f(hi)); hs[lane] = hi; hs[64 + lane] = lo; hs[128 + lane] = hi; hs[192 + lane] = 0; }
        __syncthreads();
    }
}
PF void job_w3s(const KC& k) {
    bf16_t* W = (bf16_t*)(k.ws + WS_W3S);
    const int tq = TID();
    for (int idx = blockIdx.x * NTHR + tq; idx < 64 * 4096; idx += gridDim.x * NTHR) {
        const int j = idx >> 12, col = idx & 4095;
        const float w = k.hy_f_w3[idx]; const bf16_t hi = f2bf(w), lo = f2bf(w - bf2f(hi));
        W[(size_t)col * 256 + j] = hi; W[(size_t)col * 256 + 64 + j] = hi; W[(size_t)col * 256 + 128 + j] = lo; W[(size_t)col * 256 + 192 + j] = 0;
    }
}
DI float hy_delta(int ch) {
    const float lo = -4.605170185988091f / 1.5f, hi = -4.605170185988091f / 0.3f;
    return fabsf(lo + (float)ch * ((hi - lo) / 1023.0f));
}
PF void job_filtc(const KC& k, int j) {
    const float* hdn = (const float*)(k.ws + WS_HDNC);
    const float* w3 = k.hy_f_w3 + (size_t)j * 64 * 4096;
    float* filtc = (float*)(k.ws + WS_FILTC);
    const int tq = TID();
    for (int u = blockIdx.x; u < 256 * 8; u += gridDim.x) {
        const int l = u >> 3, col = (u & 7) * 512 + tq;
        float a = 0.f;
        for (int q = 0; q < 64; ++q) a += hdn[l * 64 + q] * w3[(size_t)q * 4096 + col];
        const float t = (float)l / 255.0f;
        filtc[(size_t)l * 4096 + col] = a * expf(-t * hy_delta(col & 1023));
    }
}

template <int MODE>
PF void norm_phase(const KC& k, int layer, bool first, bool combine, const float* __restrict__ gain, int mb, const float* __restrict__ Wsk, int ldw,
                   const float* __restrict__ aux0, const float* __restrict__ aux1, bool last, LAS float* lds, bool flush = true) {
    const int tid = TID(), lane = tid & 63, wave = tid >> 6;
    float* xs = (float*)(k.ws + WS_XS);
    bf16_t* hbuf = (bf16_t*)(k.ws + AR_HBUF);
    const float* mod = (const float*)(k.ws + WS_MOD);
    const bf16_t* ys = (const bf16_t*)(k.ws + AR_YS);
    const int* tokp = (const int*)(k.ws + WS_TOKP);
    const float* tokw = (const float*)(k.ws + WS_TOKW);
    LAS int* lcnt = (LAS int*)(lds + 32768);
    if (MODE == 1 && tid < 32) lcnt[tid] = 0;
    if (MODE == 1 || MODE == 2) {
        for (int idx = tid; idx < 1024 * 32; idx += NTHR) {
            const int kk = idx >> 5, n = idx & 31;
            lds[kk * 32 + (((n >> 2) ^ ((kk >> 1) & 7)) << 2) + (n & 3)] = Wsk[(size_t)kk * ldw + n];
        }
        __syncthreads();
    }
    const int rbeg = (MODE == 3) ? TC : 0, rstr = gridDim.x * 8;
    int cur_mr = -1; float gsv[16], shv[16], g5v[16];
    float xn[16];
    int r = rbeg + blockIdx.x * 8 + wave;
    if (r < T) {
        const float* src = first ? (r < TC ? k.ctx + (size_t)r * 1024 : k.x + (size_t)(r - TC) * 1024) : xs + (size_t)r * 1024;
#pragma unroll
        for (int m = 0; m < 16; ++m) xn[m] = src[lane + 64 * m];
    }
    for (; r < T; r += rstr) {
        const int mr = modrow(r);
        float x[16];
#pragma unroll
        for (int m = 0; m < 16; ++m) x[m] = xn[m];
        int p0 = 0, p1 = 0; float w0 = 0.f, w1 = 0.f;
        if (combine) { p0 = tokp[2 * r]; p1 = tokp[2 * r + 1]; w0 = tokw[2 * r]; w1 = tokw[2 * r + 1]; }
        {
            const int rn = r + rstr;
            if (rn < T) {
                const float* srcn = first ? (rn < TC ? k.ctx + (size_t)rn * 1024 : k.x + (size_t)(rn - TC) * 1024) : xs + (size_t)rn * 1024;
#pragma unroll
                for (int m = 0; m < 16; ++m) xn[m] = srcn[lane + 64 * m];
            }
        }
        if (mr != cur_mr) {
            cur_mr = mr;
            if (MODE != 3) {
                const float* shift = mod + ((size_t)(layer * 3 + mr) * 6 + mb) * 1024;
#pragma unroll
                for (int m = 0; m < 16; ++m) { const int col = lane + 64 * m; gsv[m] = gain[col] * (1.0f + shift[1024 + col]); shv[m] = shift[col]; }
            } else {
#pragma unroll
                for (int m = 0; m < 16; ++m) gsv[m] = gain[lane + 64 * m];
            }
            if (combine) {
                const float* g5 = mod + ((size_t)((layer - 1) * 3 + mr) * 6 + 5) * 1024;
#pragma unroll
                for (int m = 0; m < 16; ++m) g5v[m] = g5[lane + 64 * m];
            }
        }
        if (combine) {
            bf16_t ya[16], yb[16];
#pragma unroll
            for (int m = 0; m < 16; ++m) { const int col = lane + 64 * m; ya[m] = ys[(size_t)p0 * 1024 + col]; yb[m] = ys[(size_t)p1 * 1024 + col]; }
            asm volatile("" ::: "memory");
#pragma unroll
            for (int m = 0; m < 16; ++m) x[m] += g5v[m] * (w0 * bf2f(ya[m]) + w1 * bf2f(yb[m]));
        }
        if (first || combine) {
#pragma unroll
            for (int m = 0; m < 16; ++m) xs[(size_t)r * 1024 + lane + 64 * m] = x[m];
        }
        float ss = 0.f;
#pragma unroll
        for (int m = 0; m < 16; ++m) ss += x[m] * x[m];
        ss = wsum(ss, lane);
        const float rstd = rsqrtf(ss * (1.0f / 1024.0f) + EPS);
        if (MODE == 3) {
#pragma unroll
            for (int m = 0; m < 16; ++m) { const int col = lane + 64 * m; k.out[(size_t)(r - TC) * 1024 + col] = x[m] * rstd * gsv[m]; }
            continue;
        }
        float y[16];
#pragma unroll
        for (int m = 0; m < 16; ++m) {
            const int col = lane + 64 * m;
            y[m] = x[m] * rstd * gsv[m] + shv[m];
            hbuf[(size_t)r * 1024 + col] = f2bf(y[m]);
        }
        if (MODE == 1 || MODE == 2) {
            float acc[32];
#pragma unroll
            for (int n = 0; n < 32; ++n) acc[n] = 0.f;
#pragma unroll
            for (int m = 0; m < 16; ++m) {
                f32x4 wa[8];
                const int c = lane + 64 * m; const LAS float* wr = lds + c * 32; const int sw = (c >> 1) & 7;
#pragma unroll
                for (int q = 0; q < 8; ++q) wa[q] = *(const LAS f32x4*)(wr + ((q ^ sw) << 2));
                asm volatile("" ::: "memory");
#pragma unroll
                for (int q = 0; q < 8; ++q) { acc[4 * q + 0] += y[m] * wa[q][0]; acc[4 * q + 1] += y[m] * wa[q][1]; acc[4 * q + 2] += y[m] * wa[q][2]; acc[4 * q + 3] += y[m] * wa[q][3]; }
            }
            float val;
            {
                float a16[16], a8[8], a4[4], a2[2];
                const bool b5 = (lane & 32) != 0, b4 = (lane & 16) != 0, b3 = (lane & 8) != 0, b2 = (lane & 4) != 0, b1 = (lane & 2) != 0;
#pragma unroll
                for (int i = 0; i < 16; ++i) { const float send = b5 ? acc[i] : acc[i + 16], keep = b5 ? acc[i + 16] : acc[i]; a16[i] = keep + shx(send, 32, lane); }
#pragma unroll
                for (int i = 0; i < 8; ++i) { const float send = b4 ? a16[i] : a16[i + 8], keep = b4 ? a16[i + 8] : a16[i]; a8[i] = keep + shx(send, 16, lane); }
#pragma unroll
                for (int i = 0; i < 4; ++i) { const float send = b3 ? a8[i] : a8[i + 4], keep = b3 ? a8[i + 4] : a8[i]; a4[i] = keep + shx(send, 8, lane); }
#pragma unroll
                for (int i = 0; i < 2; ++i) { const float send = b2 ? a4[i] : a4[i + 2], keep = b2 ? a4[i + 2] : a4[i]; a2[i] = keep + shx(send, 4, lane); }
                { const float send = b1 ? a2[0] : a2[1], keep = b1 ? a2[1] : a2[0]; val = keep + shx(send, 2, lane); }
                val += shx(val, 1, lane);
            }
            const int n = lane >> 1;
            if (MODE == 1) {
                int* toke = (int*)(k.ws + WS_TOKE); float* tokwW = (float*)(k.ws + WS_TOKW);
                if (last && r < TC) { if (lane == 0) { int neg = -1; asm volatile("" : "+v"(neg)); toke[2 * r] = neg; toke[2 * r + 1] = neg; } continue; }
                const float sc = 1.0f / (1.0f + expf(-val)), ch = sc + aux0[n];
                const int gl = lane & ~7;
                const float ca = shi(ch, gl), cb = shi(ch, gl + 2), cc = shi(ch, gl + 4), cd = shi(ch, gl + 6);
                const float hi1 = fmaxf(ca, cb), lo1 = fminf(ca, cb), hi2 = fmaxf(cc, cd), lo2 = fminf(cc, cd);
                float gs = fmaxf(hi1, hi2) + fmaxf(fminf(hi1, hi2), fmaxf(lo1, lo2));
                int gi = lane >> 3;
#pragma unroll
                for (int m = 8; m <= 32; m <<= 1) {
                    const float og = shx(gs, m, lane); const int oi = shii(gi, lane ^ m);
                    if (og > gs || (og == gs && oi < gi)) { gs = og; gi = oi; }
                }
                float c4[4], s4[4];
#pragma unroll
                for (int i = 0; i < 4; ++i) { c4[i] = shi(ch, gi * 8 + 2 * i); s4[i] = shi(sc, gi * 8 + 2 * i); }
                int i1 = 0; float b1v = c4[0];
#pragma unroll
                for (int i = 1; i < 4; ++i) if (c4[i] > b1v) { b1v = c4[i]; i1 = i; }
                int i2 = -1; float b2v = -1e30f;
#pragma unroll
                for (int i = 0; i < 4; ++i) if (i != i1 && c4[i] > b2v) { b2v = c4[i]; i2 = i; }
                float w1v = 0.f, w2v = 0.f;
#pragma unroll
                for (int i = 0; i < 4; ++i) { if (i == i1) w1v = s4[i]; if (i == i2) w2v = s4[i]; }
                const float inv = 1.0f / (w1v + w2v);
                if (lane == 0) {
                    const int e1 = gi * 4 + i1, e2 = gi * 4 + i2;
                    toke[2 * r] = e1; toke[2 * r + 1] = e2; tokwW[2 * r] = w1v * inv; tokwW[2 * r + 1] = w2v * inv;
                    __hip_atomic_fetch_add(lcnt + e1, 1, __ATOMIC_RELAXED, __HIP_MEMORY_SCOPE_WORKGROUP);
                    __hip_atomic_fetch_add(lcnt + e2, 1, __ATOMIC_RELAXED, __HIP_MEMORY_SCOPE_WORKGROUP);
                }
            } else {
                float* gb = (float*)(k.ws + WS_GB);
                if ((lane & 1) == 0) {
                    if (n < 16) {
                        const float z = val + aux1[n];
                        const float ez = __expf(z); const float sp = z > 15.f ? z : (ez < 1e-4f ? ez - 0.5f * ez * ez : __logf(1.0f + ez));
                        gb[(size_t)r * 32 + n] = -expf(aux0[n]) * sp;
                    } else {
                        gb[(size_t)r * 32 + n] = 1.0f / (1.0f + expf(-val));
                    }
                }
            }
        }
    }
    if (MODE == 1) {
        __syncthreads();
        int* cnt = (int*)(k.ws + WS_CTL + CTL_CNT) + layer * 32;
        if (flush && tid < 32 && lcnt[tid] > 0) atomicAdd(&cnt[tid], lcnt[tid]);
    }
}

namespace pg8 {
constexpr int BM = 256, BK = 64, HALF = 128, HTB = HALF * BK * 2, STAGE_BYTES = 8 * HTB;
DI int lds_byte(int r, int c) { const int st = (r >> 4) * 2 + (c >> 5), rr = r & 15, cc = c & 31, ob = rr * 64 + cc * 2; return st * 1024 + (ob ^ (((ob >> 9) & 1) << 5)); }
DI void stage_rc(int b, int& R, int& C) { const int st = b / 1024, sb = b % 1024, swz = sb ^ (((sb >> 9) & 1) << 5); R = (st >> 1) * 16 + swz / 64; C = (st & 1) * 32 + (swz % 64) / 2; }
DI int perm32(int rho) { const int n = rho >> 4, i = rho & 15; return 8 * (i >> 2) + 4 * n + (i & 3); }
struct Unit { int m0, mrows, pn; size_t boff; };
template <bool GATHER, class Epi, class Sched>
DI void gemm_phase(LAS unsigned char* lds, const bf16_t* A, const int* rowidx, const bf16_t* Bt, int K, const Sched& S, const Epi& E) {
    const int tid = TID(), wid = __builtin_amdgcn_readfirstlane(tid >> 6), lane = tid & 63, wr = wid >> 2, wc = wid & 3, fr = lane & 15, fq = lane >> 4;
    const int nt = K / BK;
    unsigned voffA[2], voffB[2];
#pragma unroll
    for (int i = 0; i < 2; ++i) { int R, C; stage_rc(tid * 16 + i * 8192, R, C); const int Rb = Epi::PERM ? ((R & ~31) + perm32(R & 31)) : R;
        voffA[i] = (unsigned)(R * K + C) * 2u; voffB[i] = (unsigned)(Rb * K + C) * 2u; }
    const size_t kstep = (size_t)(BK * 2);
    const size_t hstep = (size_t)HALF * K * 2;
    const size_t tstep = 2 * hstep;
    const size_t rstep = (size_t)K * 2;
    const unsigned ldsw = (unsigned)wid * 1024u;
    const int aoff = lds_byte(wr * 64 + fr, fq * 8), boff = lds_byte(wc * 32 + fr, fq * 8);
#define PG8_SA(b, h) (((b) * 2 + (h)) * HTB)
#define PG8_SB(b, h) ((4 + (b) * 2 + (h)) * HTB)
#define PG8_STAGE(bufoff, gbase, voff) do { _Pragma("unroll") for (int _i = 0; _i < 2; ++_i) \
        __builtin_amdgcn_global_load_lds((const unsigned*)((const char*)(gbase) + (voff)[_i]), (LAS unsigned*)(lds + (bufoff) + ldsw + _i * 8192), 16, 0, 0); } while (0)
#define PG8_STAGE_A(bufoff, p, h, vG) do { if (GATHER) PG8_STAGE(bufoff, p, (vG)[h]); else PG8_STAGE(bufoff, (p) + (h) * hstep, voffA); } while (0)
#define PG8_LDA(dst, b, h) do { _Pragma("unroll") for (int m = 0; m < 4; ++m) _Pragma("unroll") for (int k = 0; k < 2; ++k) dst[m][k] = *(const LAS bf16x8*)(lds + PG8_SA(b, h) + aoff + m * 2048 + k * 1024); } while (0)
#define PG8_LDB(dst, b, h) do { _Pragma("unroll") for (int n = 0; n < 2; ++n) _Pragma("unroll") for (int k = 0; k < 2; ++k) dst[n][k] = *(const LAS bf16x8*)(lds + PG8_SB(b, h) + boff + n * 2048 + k * 1024); } while (0)
#define PG8_MMA(ai, bj, At, Bt_) do { __builtin_amdgcn_s_setprio(1); _Pragma("unroll") for (int m = 0; m < 4; ++m) _Pragma("unroll") for (int n = 0; n < 2; ++n) _Pragma("unroll") for (int k = 0; k < 2; ++k) \
        acc[ai][bj][m][n] = __builtin_amdgcn_mfma_f32_16x16x32_bf16(Bt_[n][k], At[m][k], acc[ai][bj][m][n], 0, 0, 0); __builtin_amdgcn_s_setprio(0); } while (0)
#define PG8_WAIT_V(n) asm volatile("s_waitcnt vmcnt(" #n ")" ::: "memory")
#define PG8_WAIT_L(n) asm volatile("s_waitcnt lgkmcnt(" #n ")" ::: "memory")
#define PG8_BAR __builtin_amdgcn_s_barrier()
#define PG8_SCHED __builtin_amdgcn_sched_barrier(0)
#define PG8_AOFF(dst, u) do { _Pragma("unroll") for (int _h = 0; _h < 2; ++_h) _Pragma("unroll") for (int _i = 0; _i < 2; ++_i) { int _R, _C; stage_rc(tid * 16 + _i * 8192, _R, _C); \
        dst[_h][_i] = (unsigned)(rowidx[(u).m0 + _h * HALF + _R] * K + _C) * 2u; } } while (0)
    Unit cur, nxt; int ui = 0;
    if (!S.next(0, cur)) return;
    f32x4 acc[2][2][4][2];
#pragma unroll
    for (int a = 0; a < 2; ++a)
#pragma unroll
        for (int b = 0; b < 2; ++b)
#pragma unroll
            for (int m = 0; m < 4; ++m)
#pragma unroll
                for (int n = 0; n < 2; ++n) acc[a][b][m][n] = (f32x4){0.f, 0.f, 0.f, 0.f};
    bf16x8 At[4][2], B0[2][2], B1[2][2];
    unsigned vA[2][2], vN[2][2];
    if (GATHER) PG8_AOFF(vA, cur);
    const char* cA = (const char*)A + (GATHER ? (size_t)0 : (size_t)cur.m0 * rstep);
    const char* cB = (const char*)Bt + cur.boff + (size_t)cur.pn * tstep;
    PG8_STAGE(PG8_SB(0, 0), cB, voffB); PG8_STAGE_A(PG8_SA(0, 0), cA, 0, vA); PG8_STAGE(PG8_SB(0, 1), cB + hstep, voffB); PG8_STAGE_A(PG8_SA(0, 1), cA, 1, vA);
    if (wr == 1) PG8_BAR;
    PG8_WAIT_V(4); PG8_BAR;
    PG8_STAGE(PG8_SB(1, 0), cB + kstep, voffB); PG8_STAGE_A(PG8_SA(1, 0), cA + kstep, 0, vA); PG8_STAGE(PG8_SB(1, 1), cB + hstep + kstep, voffB);
    PG8_WAIT_V(6); PG8_BAR;
    for (;;) {
        const bool has_next = S.next(ui + 1, nxt);
        const char* nA = GATHER ? cA : (has_next ? (const char*)A + (size_t)nxt.m0 * rstep : cA);
        const char* nB = has_next ? (const char*)Bt + nxt.boff + (size_t)nxt.pn * tstep : cB;
        if (GATHER) {
            if (has_next) { PG8_AOFF(vN, nxt); }
            else {
#pragma unroll
                for (int h = 0; h < 2; ++h)
#pragma unroll
                    for (int i = 0; i < 2; ++i) vN[h][i] = vA[h][i];
            }
        }
        for (int t = 0; t < nt; t += 2) {
            const bool last = (t == nt - 2);
            const char* a1 = cA + (size_t)(t + 1) * kstep;
            const char* a2 = last ? nA : cA + (size_t)(t + 2) * kstep; const char* b2 = last ? nB : cB + (size_t)(t + 2) * kstep;
            const char* a3 = a2 + kstep; const char* b3 = b2 + kstep;
            PG8_LDB(B0, 0, 0); PG8_SCHED; PG8_LDA(At, 0, 0); PG8_STAGE_A(PG8_SA(1, 1), a1, 1, vA);
            if (GATHER && last) {
#pragma unroll
                for (int h = 0; h < 2; ++h)
#pragma unroll
                    for (int i = 0; i < 2; ++i) vA[h][i] = vN[h][i];
            }
            PG8_WAIT_L(8); PG8_BAR; PG8_WAIT_L(0); PG8_MMA(0, 0, At, B0); PG8_BAR; PG8_SCHED;
            PG8_LDB(B1, 0, 1); PG8_STAGE(PG8_SB(0, 0), b2, voffB);
            PG8_BAR; PG8_WAIT_L(0); PG8_MMA(0, 1, At, B1); PG8_BAR;
            PG8_LDA(At, 0, 1); PG8_STAGE_A(PG8_SA(0, 0), a2, 0, vA);
            PG8_BAR; PG8_WAIT_L(0); PG8_MMA(1, 0, At, B0); PG8_BAR; PG8_SCHED;
            PG8_STAGE(PG8_SB(0, 1), b2 + hstep, voffB);
            PG8_WAIT_V(6); PG8_BAR; PG8_MMA(1, 1, At, B1); PG8_BAR;
            PG8_LDB(B0, 1, 0); PG8_SCHED; PG8_LDA(At, 1, 0); PG8_STAGE_A(PG8_SA(0, 1), a2, 1, vA);
            PG8_WAIT_L(8); PG8_BAR; PG8_WAIT_L(0); PG8_MMA(0, 0, At, B0); PG8_BAR; PG8_SCHED;
            PG8_LDB(B1, 1, 1); PG8_STAGE(PG8_SB(1, 0), b3, voffB);
            PG8_BAR; PG8_WAIT_L(0); PG8_MMA(0, 1, At, B1); PG8_BAR;
            PG8_LDA(At, 1, 1); PG8_STAGE_A(PG8_SA(1, 0), a3, 0, vA);
            PG8_BAR; PG8_WAIT_L(0); PG8_MMA(1, 0, At, B0); PG8_BAR; PG8_SCHED;
            PG8_STAGE(PG8_SB(1, 1), b3 + hstep, voffB);
            PG8_WAIT_V(6); PG8_BAR; PG8_MMA(1, 1, At, B1); PG8_BAR;
        }
        { const int t2 = TID(), l2 = t2 & 63; E(acc, cur, wr, wc, l2 & 15, l2 >> 4); }
        if (!has_next) break;
#pragma unroll
        for (int a = 0; a < 2; ++a)
#pragma unroll
            for (int b = 0; b < 2; ++b)
#pragma unroll
                for (int m = 0; m < 4; ++m)
#pragma unroll
                    for (int n = 0; n < 2; ++n) acc[a][b][m][n] = (f32x4){0.f, 0.f, 0.f, 0.f};
        cur = nxt; cA = nA; cB = nB; ++ui;
    }
    PG8_WAIT_V(0);
    if (wr == 0) PG8_BAR;
    PG8_BAR;
#undef PG8_SA
#undef PG8_SB
#undef PG8_STAGE
#undef PG8_STAGE_A
#undef PG8_LDA
#undef PG8_LDB
#undef PG8_MMA
#undef PG8_WAIT_V
#undef PG8_WAIT_L
#undef PG8_BAR
#undef PG8_SCHED
#undef PG8_AOFF
}
struct DenseOrder {
    int nM, nN, nwg, G, c;
    DI void init(int M, int N, int G_, int c_) { nM = M / BM; nN = N / BM; nwg = nM * nN; G = G_; c = c_; }
    DI bool next(int i, Unit& u) const {
        const long L = (long)i * G + c; if (L >= nwg) return false;
        int wgid = (int)L; { const int q = nwg / 8, r = nwg % 8, xcd = wgid % 8, off = wgid / 8; wgid = (xcd < r ? xcd * (q + 1) : r * (q + 1) + (xcd - r) * q) + off; }
        const int nig = 8 * nN, gid = wgid / nig, fm = gid * 8, gsz = (nM - fm) < 8 ? (nM - fm) : 8;
        u.m0 = (fm + ((wgid % nig) % gsz)) * BM; u.mrows = BM; u.pn = (wgid % nig) / gsz; u.boff = 0; return true;
    }
};
struct MoeOrder {
    const LAS int* tb; int G, c; size_t estride;
    DI bool next(int i, Unit& u) const {
        const int L = i * G + c; if (L >= __builtin_amdgcn_readfirstlane(tb[97]) * 4) return false;
        const int tile = L >> 2; int e = 0;
        for (int q = 1; q < 32; ++q) if (__builtin_amdgcn_readfirstlane(tb[65 + q]) <= tile) e = q;
        const int lt = tile - __builtin_amdgcn_readfirstlane(tb[65 + e]); int mr = __builtin_amdgcn_readfirstlane(tb[e]) - lt * 256; mr = mr > 256 ? 256 : mr;
        u.m0 = __builtin_amdgcn_readfirstlane(tb[32 + e]) + lt * 256; u.mrows = mr; u.pn = L & 3; u.boff = (size_t)e * estride; return true;
    }
};
}
struct EpiBf16 {
    static constexpr bool PERM = true;
    bf16_t* C; int ldc; int split_col; bf16_t* C2; int ldc2;
    DI void operator()(const f32x4 (&acc)[2][2][4][2], const pg8::Unit& u, int wr, int wc, int fr, int fq) const {
        int colt = u.pn * 256; bf16_t* base = C; int ld = ldc;
        if (colt >= split_col) { base = C2; ld = ldc2; colt -= split_col; }
#pragma unroll
        for (int ai = 0; ai < 2; ++ai)
#pragma unroll
            for (int m = 0; m < 4; ++m) {
                const int rl = ai * 128 + wr * 64 + m * 16 + fr;
                if (rl < u.mrows) {
                    bf16_t* rowp = base + (size_t)(u.m0 + rl) * ld + colt + wc * 32 + 8 * fq;
#pragma unroll
                    for (int bj = 0; bj < 2; ++bj) {
                        const f32x4 v0 = acc[ai][bj][m][0], v1 = acc[ai][bj][m][1];
                        u32x4 o; o[0] = cvt_pk_bf16(v0[0], v0[1]); o[1] = cvt_pk_bf16(v0[2], v0[3]); o[2] = cvt_pk_bf16(v1[0], v1[1]); o[3] = cvt_pk_bf16(v1[2], v1[3]);
                        *(u32x4*)(rowp + bj * 128) = o;
                    }
                }
            }
    }
};
struct EpiBf16T {
    static constexpr bool PERM = false;
    bf16_t* C; int ldc;
    DI void operator()(const f32x4 (&acc)[2][2][4][2], const pg8::Unit& u, int wr, int wc, int fr, int fq) const {
#pragma unroll
        for (int ai = 0; ai < 2; ++ai)
#pragma unroll
            for (int bj = 0; bj < 2; ++bj)
#pragma unroll
                for (int m = 0; m < 4; ++m)
#pragma unroll
                    for (int n = 0; n < 2; ++n) {
                        const int row = u.m0 + ai * 128 + wr * 64 + m * 16 + fr, col = u.pn * 256 + bj * 128 + wc * 32 + n * 16 + 4 * fq;
#pragma unroll
                        for (int e = 0; e < 4; ++e) C[(size_t)(col + e) * ldc + row] = f2bf(acc[ai][bj][m][n][e]);
                    }
    }
};
struct EpiTaps {
    static constexpr bool PERM = false;
    float* FT;
    DI void operator()(const f32x4 (&acc)[2][2][4][2], const pg8::Unit& u, int wr, int wc, int fr, int fq) const {
#pragma unroll
        for (int ai = 0; ai < 2; ++ai)
#pragma unroll
            for (int m = 0; m < 4; ++m) {
                const int row = u.m0 + ai * 128 + wr * 64 + m * 16 + fr; const float dl = hy_delta(row & 1023) * (1.0f / 16383.0f);
#pragma unroll
                for (int bj = 0; bj < 2; ++bj)
#pragma unroll
                    for (int n = 0; n < 2; ++n) {
                        const int l = u.pn * 256 + bj * 128 + wc * 32 + n * 16 + 4 * fq; f32x4 o;
#pragma unroll
                        for (int e = 0; e < 4; ++e) o[e] = acc[ai][bj][m][n][e] * expf(-(float)(l + e) * dl);
                        *(f32x4*)(FT + (size_t)row * 16384 + l) = o;
                    }
            }
    }
};
struct EpiResid {
    static constexpr bool PERM = false;
    float* xs; const float* mod; int layer; int chunk;
    DI void operator()(const f32x4 (&acc)[2][2][4][2], const pg8::Unit& u, int wr, int wc, int fr, int fq) const {
        const float* g = mod + ((size_t)(layer * 3 + modrow(u.m0)) * 6 + chunk) * 1024;
#pragma unroll
        for (int bj = 0; bj < 2; ++bj)
#pragma unroll
            for (int n = 0; n < 2; ++n) {
                const int col = u.pn * 256 + bj * 128 + wc * 32 + n * 16 + 4 * fq; const f32x4 gv = *(const f32x4*)(g + col);
                float* p0 = xs + (size_t)(u.m0 + wr * 64 + fr) * 1024 + col;
                f32x4 old[8];
#pragma unroll
                for (int ai = 0; ai < 2; ++ai)
#pragma unroll
                    for (int m = 0; m < 4; ++m) old[ai * 4 + m] = *(const f32x4*)(p0 + (size_t)(ai * 128 + m * 16) * 1024);
                asm volatile("" ::: "memory");
#pragma unroll
                for (int ai = 0; ai < 2; ++ai)
#pragma unroll
                    for (int m = 0; m < 4; ++m) *(f32x4*)(p0 + (size_t)(ai * 128 + m * 16) * 1024) = old[ai * 4 + m] + gv * acc[ai][bj][m][n];
            }
    }
};
struct EpiGateUp {
    static constexpr bool PERM = false;
    bf16_t* hid;
    DI void operator()(const f32x4 (&acc)[2][2][4][2], const pg8::Unit& u, int wr, int wc, int fr, int fq) const {
#pragma unroll
        for (int ai = 0; ai < 2; ++ai)
#pragma unroll
            for (int m = 0; m < 4; ++m) {
                const int rl = ai * 128 + wr * 64 + m * 16 + fr;
                if (rl < u.mrows) {
#pragma unroll
                    for (int bj = 0; bj < 2; ++bj) {
                        const int hc = ((u.pn * 256 + bj * 128 + wc * 32) >> 1) + 4 * fq;
                        const f32x4 g = acc[ai][bj][m][0], up = acc[ai][bj][m][1];
                        u32x2 o; o[0] = cvt_pk_bf16(siluf(g[0]) * up[0], siluf(g[1]) * up[1]); o[1] = cvt_pk_bf16(siluf(g[2]) * up[2], siluf(g[3]) * up[3]);
                        *(u32x2*)(hid + (size_t)(u.m0 + rl) * 512 + hc) = o;
                    }
                }
            }
    }
};
template <class Epi>
PF void gemm_dense(LAS unsigned char* lds, const bf16_t* A, int M, const bf16_t* Bt, int N, int K, const Epi& epi) {
    pg8::DenseOrder S; S.init(M, N, (int)gridDim.x, (int)blockIdx.x);
    pg8::gemm_phase<false>(lds, A, (const int*)nullptr, Bt, K, S, epi);
}
DI void moe_table(const KC& k, int layer, LAS int* tb) {
    const int* cnt = (const int*)(k.ws + WS_CTL + CTL_CNT) + layer * 32;
    __syncthreads();
    const int tq = TID();
    if (tq < 32) tb[tq] = __hip_atomic_load(cnt + tq, __ATOMIC_RELAXED, __HIP_MEMORY_SCOPE_AGENT);
    __syncthreads();
    if (tq == 0) {
        int s = 0, tp = 0;
        for (int e = 0; e < 32; ++e) { tb[32 + e] = s; tb[65 + e] = tp; s += tb[e]; tp += (tb[e] + 255) >> 8; }
        tb[64] = s; tb[97] = tp;
    }
    __syncthreads();
}
template <int WHICH>
PF void moe_gemm(const KC& k, int layer, LAS unsigned char* lds, LAS int* tb) {
    moe_table(k, layer, tb);
    if (WHICH == 0) {
        pg8::MoeOrder S{tb, (int)gridDim.x, (int)blockIdx.x, (size_t)1024 * 1024 * 2};
        EpiGateUp epi{(bf16_t*)(k.ws + AR_HID)};
        pg8::gemm_phase<true>(lds, (const bf16_t*)(k.ws + AR_HBUF), (const int*)(k.ws + WS_SLOT), (const bf16_t*)(k.ws + AR_WGU), 1024, S, epi);
    } else {
        pg8::MoeOrder S{tb, (int)gridDim.x, (int)blockIdx.x, (size_t)1024 * 512 * 2};
        EpiBf16 epi{(bf16_t*)(k.ws + AR_YS), 1024, 1 << 30, nullptr, 0};
        pg8::gemm_phase<false>(lds, (const bf16_t*)(k.ws + AR_HID), (const int*)nullptr, (const bf16_t*)(k.ws + AR_WD), 512, S, epi);
    }
}
PF void moe_scatter(const KC& k, int layer, LAS int* tb) {
    moe_table(k, layer, tb);
    const int* toke = (const int*)(k.ws + WS_TOKE);
    int* tokp = (int*)(k.ws + WS_TOKP); int* slot = (int*)(k.ws + WS_SLOT);
    int* cur = (int*)(k.ws + WS_CTL + CTL_CNT) + 128 + layer * 32;
    LAS int* lc = tb + 128; LAS int* lb = tb + 160;
    const int tid = TID();
    if (blockIdx.x == 0 && tid < 256) slot[NA + tid] = 0;
    for (int r0 = blockIdx.x * NTHR; r0 < T; r0 += gridDim.x * NTHR) {
        const int r = r0 + tid;
        __syncthreads();
        if (tid < 32) lc[tid] = 0;
        __syncthreads();
        const int e0 = toke[2 * r], e1 = toke[2 * r + 1];
        int k0 = 0, k1 = 0;
        if (e0 >= 0) { k0 = __hip_atomic_fetch_add(lc + e0, 1, __ATOMIC_RELAXED, __HIP_MEMORY_SCOPE_WORKGROUP); k1 = __hip_atomic_fetch_add(lc + e1, 1, __ATOMIC_RELAXED, __HIP_MEMORY_SCOPE_WORKGROUP); }
        __syncthreads();
        if (tid < 32) lb[tid] = lc[tid] > 0 ? atomicAdd(&cur[tid], lc[tid]) : 0;
        __syncthreads();
        if (e0 >= 0) {
            const int p0 = tb[32 + e0] + lb[e0] + k0, p1 = tb[32 + e1] + lb[e1] + k1;
            slot[p0] = r; slot[p1] = r; tokp[2 * r] = p0; tokp[2 * r + 1] = p1;
        }
    }
}

DI void unpack8(const u32x4 v, float (&f)[8]) {
#pragma unroll
    for (int w = 0; w < 4; ++w) { f[2 * w] = __uint_as_float(v[w] << 16); f[2 * w + 1] = __uint_as_float(v[w] & 0xffff0000u); }
}
PF void sc_mix(const KC& k, int j) {
    const int tid = TID(), lane = tid & 63, wave = tid >> 6;
    const bf16_t* P = (const bf16_t*)(k.ws + AR_PB);
    bf16_t* U = (bf16_t*)(k.ws + AR_UBUF);
    const float* cw = k.sc_conv + (size_t)j * 3 * 1024;
    const int c0 = lane * 16;
    float k0[16], k1[16], k2[16];
#pragma unroll
    for (int e = 0; e < 16; ++e) { k0[e] = cw[c0 + e]; k1[e] = cw[1024 + c0 + e]; k2[e] = cw[2048 + c0 + e]; }
    for (int r = blockIdx.x * 8 + wave; r < T; r += gridDim.x * 8) {
        bool lok, rok;
        if (r < TC) { const int t = r & 255; lok = t != 0; rok = t != 255; } else { const int t = (r - TC) & 63; lok = t != 0; rok = t != 63; }
        const bf16_t* p = P + (size_t)r * 3072 + c0;
        const bf16_t* pl = lok ? p - 3072 : p; const bf16_t* pr = rok ? p + 3072 : p;
        u32x4 vb[2], vc[2], vx[2], vcl[2], vxl[2], vcr[2], vxr[2];
#pragma unroll
        for (int hh = 0; hh < 2; ++hh) {
            vb[hh] = *(const u32x4*)(p + hh * 8); vc[hh] = *(const u32x4*)(p + 1024 + hh * 8); vx[hh] = *(const u32x4*)(p + 2048 + hh * 8);
            vcl[hh] = *(const u32x4*)(pl + 1024 + hh * 8); vxl[hh] = *(const u32x4*)(pl + 2048 + hh * 8);
            vcr[hh] = *(const u32x4*)(pr + 1024 + hh * 8); vxr[hh] = *(const u32x4*)(pr + 2048 + hh * 8);
        }
        asm volatile("" ::: "memory");
        const float fl = lok ? 1.f : 0.f, frr = rok ? 1.f : 0.f;
#pragma unroll
        for (int hh = 0; hh < 2; ++hh) {
            float bg[8], cg[8], xi[8], cl[8], xl[8], cr[8], xr[8];
            unpack8(vb[hh], bg); unpack8(vc[hh], cg); unpack8(vx[hh], xi); unpack8(vcl[hh], cl); unpack8(vxl[hh], xl); unpack8(vcr[hh], cr); unpack8(vxr[hh], xr);
            u32x4 o;
#pragma unroll
            for (int w = 0; w < 4; ++w) {
                float ov[2];
#pragma unroll
                for (int e = 0; e < 2; ++e) { const int i = 2 * w + e, c = hh * 8 + i; ov[e] = bg[i] * (k0[c] * fl * cl[i] * xl[i] + k1[c] * cg[i] * xi[i] + k2[c] * frr * cr[i] * xr[i]); }
                o[w] = pk2(ov[0], ov[1]);
            }
            *(u32x4*)(U + (size_t)r * 1024 + c0 + hh * 8) = o;
        }
    }
}

constexpr int DN_STEPS = 260, DN_UNITS = 32 * DN_STEPS;
DI int dn_rbase(int b, int dir, int s) {
    if (s < 4) return dir == 0 ? b * 256 + s * 64 : b * 256 + 255 - s * 64;
    const int cc = s - 4;
    return dir == 0 ? TC + b * SEQ + cc * 64 : TC + b * SEQ + SEQ - 1 - cc * 64;
}
struct DnRaw { u32x4 c[3][2], l[3][2], r[3][2]; float g, be; };
DI void dn_raw_load(const bf16_t* P, const float* gb, int u, int tid, DnRaw& R) {
    const int chain = u / DN_STEPS, s = u - chain * DN_STEPS, dir = chain & 1, h = (chain >> 1) & 7, b = chain >> 4;
    const int rbase = dn_rbase(b, dir, s), rstep = dir == 0 ? 1 : -1;
    const int i = tid >> 3, sg = tid & 7, r = rbase + rstep * i;
    bool lok, rok;
    if (r < TC) { const int t = r & 255; lok = t != 0; rok = t != 255; } else { const int t = (r - TC) & 63; lok = t != 0; rok = t != 63; }
#pragma unroll
    for (int part = 0; part < 3; ++part) {
        const bf16_t* pc = P + (size_t)r * 3072 + part * 1024 + h * 128 + sg * 16;
#pragma unroll
        for (int hf = 0; hf < 2; ++hf) {
            R.c[part][hf] = *(const u32x4*)(pc + hf * 8);
            R.l[part][hf] = (u32x4){0u, 0u, 0u, 0u}; R.r[part][hf] = (u32x4){0u, 0u, 0u, 0u};
            if (lok) R.l[part][hf] = *(const u32x4*)(pc - 3072 + hf * 8);
            if (rok) R.r[part][hf] = *(const u32x4*)(pc + 3072 + hf * 8);
        }
    }
    if (tid < 64) { const size_t row = (size_t)(rbase + rstep * tid); R.g = gb[row * 32 + dir * 8 + h]; R.be = gb[row * 32 + 16 + dir * 8 + h]; }
}
PF void dn_chunk(const KC& k, int jl, LAS unsigned char* lds) {
    const int tid = TID(), lane = tid & 63, wave = tid >> 6, fr = lane & 15, fq = lane >> 4;
    LAS bf16_t* Kt = (LAS bf16_t*)lds;
    LAS bf16_t* Qt = Kt + 64 * 136;
    LAS bf16_t* Vt = Qt + 64 * 136;
    LAS float* Amat = (LAS float*)(Vt + 64 * 136);
    LAS bf16_t* Tb = (LAS bf16_t*)(Amat + 64 * 64);
    LAS bf16_t* VbT = Tb + 64 * 72;
    LAS bf16_t* KbT = VbT + 128 * 72;
    LAS float* gcs = (LAS float*)(KbT + 128 * 72);
    LAS float* bet = gcs + 64; LAS float* eg = bet + 64; LAS float* egr = eg + 64;
    LAS float* Tm = egr + 64;
    const bf16_t* P = (const bf16_t*)(k.ws + AR_PB);
    const float* gb = (const float*)(k.ws + WS_GB);
    const float* cw = k.dn_conv + (size_t)jl * 3 * 3072;
    bf16_t* CH = (bf16_t*)(k.ws + AR_CHUNK);
    bf16_t* ATT = (bf16_t*)(k.ws + AR_HBUF);
    float* EGL = (float*)(k.ws + WS_EGL);
    for (int u = blockIdx.x; u < DN_UNITS; u += gridDim.x) {
        DnRaw Rn; dn_raw_load(P, gb, u, tid, Rn);
        const int chain = u / DN_STEPS, s = u - chain * DN_STEPS, dir = chain & 1, h = (chain >> 1) & 7, b = chain >> 4;
        const int rbase = dn_rbase(b, dir, s), rstep = dir == 0 ? 1 : -1;
        bf16_t* cW = CH + (size_t)u * 32768; bf16_t* cQd = cW + 8192; bf16_t* cKd = cQd + 8192; bf16_t* cU = cKd + 8192;
        bf16_t* cAt = ATT + (size_t)u * 4096;
        lds_barrier();
        const float g_in = Rn.g, be_in = Rn.be;
        {
            const int i = tid >> 3, sg = tid & 7;
#pragma unroll
            for (int part = 0; part < 3; ++part) {
                const int col = part * 1024 + h * 128 + sg * 16;
                float v[16];
#pragma unroll
                for (int hf = 0; hf < 2; ++hf) {
                    const u32x4 c4 = Rn.c[part][hf], l4 = Rn.l[part][hf], r4 = Rn.r[part][hf];
#pragma unroll
                    for (int w2 = 0; w2 < 2; ++w2) {
                        const int cc = col + hf * 8 + 4 * w2;
                        const f32x4 k0 = *(const f32x4*)(cw + cc), k1 = *(const f32x4*)(cw + 3072 + cc), k2 = *(const f32x4*)(cw + 6144 + cc);
#pragma unroll
                        for (int e = 0; e < 4; ++e) {
                            const int w = 2 * w2 + (e >> 1);
                            const float lv = __uint_as_float((e & 1) ? (l4[w] & 0xffff0000u) : (l4[w] << 16));
                            const float cv = __uint_as_float((e & 1) ? (c4[w] & 0xffff0000u) : (c4[w] << 16));
                            const float rv = __uint_as_float((e & 1) ? (r4[w] & 0xffff0000u) : (r4[w] << 16));
                            v[hf * 8 + 4 * w2 + e] = siluf(k0[e] * lv + k1[e] * cv + k2[e] * rv);
                        }
                    }
                }
                if (part < 2) {
                    float ss = 0.f;
#pragma unroll
                    for (int e = 0; e < 16; ++e) ss += v[e] * v[e];
                    ss += shx(ss, 1, lane); ss += shx(ss, 2, lane); ss += shx(ss, 4, lane);
                    const float sc = rsqrtf(ss + EPS) * (part == 0 ? 0.08838834764831845f : 1.0f);
#pragma unroll
                    for (int e = 0; e < 16; ++e) v[e] *= sc;
                }
                LAS bf16_t* dst = (part == 0 ? Qt : (part == 1 ? Kt : Vt)) + i * 136 + sg * 16;
                u32x4 o0, o1;
#pragma unroll
                for (int w = 0; w < 4; ++w) { o0[w] = pk2(v[2 * w], v[2 * w + 1]); o1[w] = pk2(v[8 + 2 * w], v[8 + 2 * w + 1]); }
                *(LAS u32x4*)dst = o0; *(LAS u32x4*)(dst + 8) = o1;
            }
        }
        if (wave == 0) {
            float g = g_in;
            const float be = be_in;
#pragma unroll
            for (int d = 1; d < 64; d <<= 1) { const float o = shi(g, (lane - d) & 63); if (lane >= d) g += o; }
            const float glast = shi(g, 63);
            gcs[lane] = g; bet[lane] = be; eg[lane] = expf(g); egr[lane] = expf(glast - g);
            if (lane == 0) EGL[u] = expf(glast);
        }
        lds_barrier();
#pragma unroll 1
        for (int x = 0; x < 4; ++x) {
            const int t = wave + 8 * x, isq = t >> 4, mt = (t >> 2) & 3, nt = t & 3;
            f32x4 acc = (f32x4){0.f, 0.f, 0.f, 0.f};
            const int jc = 16 * nt + fr;
            float gi4[4], bi4[4];
            const float gj = gcs[jc];
#pragma unroll
            for (int jj = 0; jj < 4; ++jj) { gi4[jj] = gcs[16 * mt + 4 * fq + jj]; bi4[jj] = bet[16 * mt + 4 * fq + jj]; }
            if (mt >= nt) {
                const LAS bf16_t* Ar = (isq ? Qt : Kt) + (16 * mt + fr) * 136 + 8 * fq;
                const LAS bf16_t* Br = Kt + (16 * nt + fr) * 136 + 8 * fq;
                bf16x8 fa4[4], fb4[4];
#pragma unroll
                for (int ks = 0; ks < 4; ++ks) { fa4[ks] = *(const LAS bf16x8*)(Ar + 32 * ks); fb4[ks] = *(const LAS bf16x8*)(Br + 32 * ks); }
                asm volatile("" ::: "memory");
#pragma unroll
                for (int ks = 0; ks < 4; ++ks) acc = __builtin_amdgcn_mfma_f32_16x16x32_bf16(fa4[ks], fb4[ks], acc, 0, 0, 0);
            }
#pragma unroll
            for (int jj = 0; jj < 4; ++jj) {
                const int ir = 16 * mt + 4 * fq + jj;
                const float dec = __expf(fminf(gi4[jj] - gj, 0.f));
                if (isq) cAt[ir * 64 + jc] = f2bf(ir >= jc ? acc[jj] * dec : 0.f);
                else Amat[ir * 64 + jc] = ir > jc ? bi4[jj] * acc[jj] * dec : 0.f;
            }
        }
        lds_barrier();
        {
        if (wave < 4) {
            if (lane < 16) {
                const int bo = 16 * wave;
                float tc[16];
#pragma unroll
                for (int i = 0; i < 16; ++i) {
                    f32x4 ar[4];
#pragma unroll
                    for (int q = 0; q < (i + 3) / 4; ++q) ar[q] = *(const LAS f32x4*)(Amat + (bo + i) * 64 + bo + 4 * q);
                    float a0 = (i == lane) ? 1.f : 0.f, a1 = 0.f;
#pragma unroll
                    for (int j = 0; j < i; ++j) { const float av = ar[j >> 2][j & 3]; if (j & 1) a1 -= av * tc[j]; else a0 -= av * tc[j]; }
                    tc[i] = a0 + a1;
                    Tm[(bo + i) * 64 + bo + lane] = tc[i];
                }
            }
        } else {
            for (int it = tid - 256; it < 1024; it += 256) {
                const int c = it & 127, ig = it >> 7;
                float kv[8], vv[8];
                { bf16_t kr[8], vr[8];
#pragma unroll
                  for (int e = 0; e < 8; ++e) { kr[e] = Kt[(8 * ig + e) * 136 + c]; vr[e] = Vt[(8 * ig + e) * 136 + c]; }
                  asm volatile("" ::: "memory");
#pragma unroll
                  for (int e = 0; e < 8; ++e) { kv[e] = bf2f(kr[e]); vv[e] = bf2f(vr[e]); } }
                u32x4 ov, ok, od;
#pragma unroll
                for (int w = 0; w < 4; ++w) {
                    const int i0 = 8 * ig + 2 * w, i1 = i0 + 1;
                    ov[w] = pk2(bet[i0] * vv[2 * w], bet[i1] * vv[2 * w + 1]);
                    ok[w] = pk2(bet[i0] * eg[i0] * kv[2 * w], bet[i1] * eg[i1] * kv[2 * w + 1]);
                    od[w] = pk2(egr[i0] * kv[2 * w], egr[i1] * kv[2 * w + 1]);
                }
                *(LAS u32x4*)(VbT + c * 72 + 8 * ig) = ov;
                *(LAS u32x4*)(KbT + c * 72 + 8 * ig) = ok;
                *(u32x4*)(cKd + c * 64 + 8 * ig) = od;
            }
            for (int it = tid - 256; it < 1024; it += 256) {
                const int i = it >> 4, c8 = (it & 15) * 8; const float e = eg[i];
                const u32x4 qv = *(const LAS u32x4*)(Qt + i * 136 + c8); u32x4 o;
#pragma unroll
                for (int w = 0; w < 4; ++w) o[w] = pk2(__uint_as_float(qv[w] << 16) * e, __uint_as_float(qv[w] & 0xffff0000u) * e);
                *(u32x4*)(cQd + i * 128 + c8) = o;
            }
        }
        lds_barrier();
#pragma unroll 1
        for (int d = 1; d < 4; ++d) {
            if (wave < 4 - d) {
                const int bi = wave + d, bj = wave, r = lane >> 2, c0 = 4 * (lane & 3);
                f32x4 m = (f32x4){0.f, 0.f, 0.f, 0.f};
                for (int kb = bj; kb < bi; ++kb) {
                    f32x4 av4[4], tv[16];
#pragma unroll
                    for (int q = 0; q < 4; ++q) av4[q] = *(const LAS f32x4*)(Amat + (16 * bi + r) * 64 + 16 * kb + 4 * q);
#pragma unroll
                    for (int kk = 0; kk < 16; ++kk) tv[kk] = *(const LAS f32x4*)(Tm + (16 * kb + kk) * 64 + 16 * bj + c0);
                    asm volatile("" ::: "memory");
#pragma unroll
                    for (int kk = 0; kk < 16; ++kk) m += tv[kk] * av4[kk >> 2][kk & 3];
                }
                *(LAS f32x4*)(Tm + (16 * bj + r) * 64 + 16 * bi + c0) = m;
                f32x4 t = (f32x4){0.f, 0.f, 0.f, 0.f};
                {
                    f32x4 dv4[4], mv[16];
#pragma unroll
                    for (int q = 0; q < 4; ++q) dv4[q] = *(const LAS f32x4*)(Tm + (16 * bi + r) * 64 + 16 * bi + 4 * q);
#pragma unroll
                    for (int kk = 0; kk < 16; ++kk) mv[kk] = *(const LAS f32x4*)(Tm + (16 * bj + kk) * 64 + 16 * bi + c0);
                    asm volatile("" ::: "memory");
#pragma unroll
                    for (int kk = 0; kk < 16; ++kk) t -= mv[kk] * dv4[kk >> 2][kk & 3];
                }
                *(LAS f32x4*)(Tm + (16 * bi + r) * 64 + 16 * bj + c0) = t;
            }
            lds_barrier();
        }
        for (int it = tid; it < 64 * 8; it += NTHR) {
            const int i = it >> 3, c8 = (it & 7) * 8; u32x4 o;
#pragma unroll
            for (int w = 0; w < 4; ++w) {
                const int c = c8 + 2 * w;
                o[w] = pk2(c <= i ? Tm[i * 64 + c] : 0.f, c + 1 <= i ? Tm[i * 64 + c + 1] : 0.f);
            }
            *(LAS u32x4*)(Tb + i * 72 + c8) = o;
        }
        }
        lds_barrier();
        {
            f32x4 au[4], aw[4];
#pragma unroll
            for (int mt = 0; mt < 4; ++mt) { au[mt] = (f32x4){0.f, 0.f, 0.f, 0.f}; aw[mt] = (f32x4){0.f, 0.f, 0.f, 0.f}; }
            bf16x8 bv[2], bk[2], at[2][4];
#pragma unroll
            for (int ks = 0; ks < 2; ++ks) {
                bv[ks] = *(const LAS bf16x8*)(VbT + (16 * wave + fr) * 72 + 32 * ks + 8 * fq);
                bk[ks] = *(const LAS bf16x8*)(KbT + (16 * wave + fr) * 72 + 32 * ks + 8 * fq);
#pragma unroll
                for (int mt = 0; mt < 4; ++mt) at[ks][mt] = *(const LAS bf16x8*)(Tb + (16 * mt + fr) * 72 + 32 * ks + 8 * fq);
            }
            asm volatile("" ::: "memory");
#pragma unroll
            for (int ks = 0; ks < 2; ++ks)
#pragma unroll
                for (int mt = 0; mt < 4; ++mt) {
                    au[mt] = __builtin_amdgcn_mfma_f32_16x16x32_bf16(at[ks][mt], bv[ks], au[mt], 0, 0, 0);
                    aw[mt] = __builtin_amdgcn_mfma_f32_16x16x32_bf16(at[ks][mt], bk[ks], aw[mt], 0, 0, 0);
                }
#pragma unroll
            for (int mt = 0; mt < 4; ++mt)
#pragma unroll
                for (int jj = 0; jj < 4; ++jj) {
                    const int ir = 16 * mt + 4 * fq + jj, c = 16 * wave + fr;
                    cU[ir * 128 + c] = f2bf(au[mt][jj]); cW[ir * 128 + c] = f2bf(aw[mt][jj]);
                }
        }
    }
}
constexpr int SC_W = 0, SC_QD = 64 * 136, SC_KD = SC_QD + 64 * 136, SC_AT = SC_KD + 128 * 72, SC_U = SC_AT + 64 * 72, SC_EGL = SC_U + 16 * 72, SC_STAGE = SC_EGL + 8;
struct ScanRegs { u32x4 v[8]; u32x4 u[2]; };
DI void dn_scan_fetch(const bf16_t* CH, const bf16_t* ATT, int u, int sl, int wv, int lane, ScanRegs& R) {
    const bf16_t* cW = CH + (size_t)u * 32768;
    const bf16_t* src = (wv < 6) ? cW + wv * 4096 + lane * 8 : ATT + (size_t)u * 4096 + lane * 8;
#pragma unroll
    for (int q = 0; q < 8; ++q) R.v[q] = *(const u32x4*)(src + q * 512);
    if (wv == 6) {
#pragma unroll
        for (int qq = 0; qq < 2; ++qq) { const int pid = lane + 64 * qq; R.u[qq] = *(const u32x4*)(cW + 24576 + (pid >> 1) * 128 + sl * 16 + (pid & 1) * 8); }
    }
}
DI void dn_scan_put(LAS bf16_t* st, int wv, int lane, const ScanRegs& R) {
    LAS bf16_t* dst; int qs;
    if (wv < 4) { dst = st + ((wv < 2) ? SC_W : SC_QD) + ((wv & 1) * 32 + (lane >> 4)) * 136 + (lane & 15) * 8; qs = 544; }
    else if (wv < 6) { dst = st + SC_KD + ((wv - 4) * 64 + (lane >> 3)) * 72 + (lane & 7) * 8; qs = 576; }
    else { dst = st + SC_AT + (lane >> 3) * 72 + (lane & 7) * 8; qs = 576; }
#pragma unroll
    for (int q = 0; q < 8; ++q) *(LAS u32x4*)(dst + q * qs) = R.v[q];
    if (wv == 6) {
#pragma unroll
        for (int qq = 0; qq < 2; ++qq) { const int pid = lane + 64 * qq, i = pid >> 1, hf = pid & 1;
#pragma unroll
            for (int w = 0; w < 4; ++w) { st[SC_U + (hf * 8 + 2 * w) * 72 + i] = (bf16_t)(R.u[qq][w] & 0xffff); st[SC_U + (hf * 8 + 2 * w + 1) * 72 + i] = (bf16_t)(R.u[qq][w] >> 16); } }
    }
}
DI bf16x8 ld2(const LAS bf16_t* p0, const LAS bf16_t* p1) {
    const u32x2 a = *(const LAS u32x2*)p0, b = *(const LAS u32x2*)p1;
    u32x4 r; r[0] = a[0]; r[1] = a[1]; r[2] = b[0]; r[3] = b[1];
    return __builtin_bit_cast(bf16x8, r);
}
DI bf16x8 pk8(f32x4 a, f32x4 b) { u32x4 r; r[0] = pk2(a[0], a[1]); r[1] = pk2(a[2], a[3]); r[2] = pk2(b[0], b[1]); r[3] = pk2(b[2], b[3]); return __builtin_bit_cast(bf16x8, r); }
PF void dn_scan(const KC& k, LAS unsigned char* lds) {
    const int tid = TID(), lane = tid & 63, wave = tid >> 6, fr = lane & 15, fq = lane >> 4;
    LAS bf16_t* ring = (LAS bf16_t*)lds;
    const bf16_t* CH = (const bf16_t*)(k.ws + AR_CHUNK);
    const bf16_t* ATT = (const bf16_t*)(k.ws + AR_HBUF);
    const float* EGL = (const float*)(k.ws + WS_EGL);
    bf16_t* O = (bf16_t*)(k.ws + AR_PB);
    for (int un0 = blockIdx.x; un0 < 256; un0 += gridDim.x) {
        const int un = (gridDim.x == 256) ? ((un0 & 7) * 32 + (un0 >> 3)) : un0;
        const int sl = un & 7, chain = un >> 3, dir = chain & 1, h = (chain >> 1) & 7, b = chain >> 4;
        const int rstep = dir == 0 ? 1 : -1;
        f32x4 S[8];
#pragma unroll
        for (int t = 0; t < 8; ++t) S[t] = (f32x4){0.f, 0.f, 0.f, 0.f};
        LAS float* eglL = (LAS float*)(ring + 2 * SC_STAGE);
        constexpr int NPF = 1;
        ScanRegs R[NPF];
        const int wv = wave - 1;
        lds_barrier();
        if (tid < DN_STEPS) eglL[tid] = EGL[chain * DN_STEPS + tid];
        if (wave > 0) {
            dn_scan_fetch(CH, ATT, chain * DN_STEPS, sl, wv, lane, R[0]); dn_scan_put(ring, wv, lane, R[0]);
#pragma unroll
            for (int q = 0; q < NPF; ++q) dn_scan_fetch(CH, ATT, chain * DN_STEPS + q + 1, sl, wv, lane, R[q]);
        }
        lds_barrier();
#pragma unroll 1
        for (int s4 = 0; s4 < DN_STEPS; s4 += NPF) {
#pragma unroll
          for (int q = 0; q < NPF; ++q) {
            const int s = s4 + q; if (s >= DN_STEPS) break;
            LAS bf16_t* st = ring + (s & 1) * SC_STAGE;
            if (wave > 0) {
                if (s + 1 < DN_STEPS) dn_scan_put(ring + ((s + 1) & 1) * SC_STAGE, wv, lane, R[q]);
                if (s + 1 + NPF < DN_STEPS) dn_scan_fetch(CH, ATT, chain * DN_STEPS + s + 1 + NPF, sl, wv, lane, R[q]);
            } else {
                const float egl = eglL[s];
                bf16x8 sb[4];
#pragma unroll
                for (int ks = 0; ks < 4; ++ks) sb[ks] = pk8(S[2 * ks], S[2 * ks + 1]);
                f32x4 p[4], o[4];
#pragma unroll
                for (int mt = 0; mt < 4; ++mt) { p[mt] = (f32x4){0.f, 0.f, 0.f, 0.f}; o[mt] = (f32x4){0.f, 0.f, 0.f, 0.f}; }
                bf16x8 fw[2][4], fq_[2][4];
#define SC_LOAD_KS(buf, ks) do { _Pragma("unroll") for (int mt = 0; mt < 4; ++mt) { \
                        const LAS bf16_t* wr_ = st + SC_W + (16 * mt + fr) * 136 + 4 * fq + 32 * (ks); const LAS bf16_t* qr_ = st + SC_QD + (16 * mt + fr) * 136 + 4 * fq + 32 * (ks); \
                        fw[buf][mt] = ld2(wr_, wr_ + 16); fq_[buf][mt] = ld2(qr_, qr_ + 16); } } while (0)
#define SC_MMA_KS(buf, ks) do { _Pragma("unroll") for (int mt = 0; mt < 4; ++mt) p[mt] = __builtin_amdgcn_mfma_f32_16x16x32_bf16(fw[buf][mt], sb[ks], p[mt], 0, 0, 0); \
                        _Pragma("unroll") for (int mt = 0; mt < 4; ++mt) o[mt] = __builtin_amdgcn_mfma_f32_16x16x32_bf16(fq_[buf][mt], sb[ks], o[mt], 0, 0, 0); } while (0)
                bf16x8 fa[2][4], fk[2][8];
#define SC_LOAD_KC(kc) do { _Pragma("unroll") for (int mt = 0; mt < 4; ++mt) { const LAS bf16_t* ar_ = st + SC_AT + (16 * mt + fr) * 72 + 4 * fq + 32 * (kc); fa[kc][mt] = ld2(ar_, ar_ + 16); } \
                        _Pragma("unroll") for (int t = 0; t < 8; ++t) { const LAS bf16_t* kr_ = st + SC_KD + (16 * t + fr) * 72 + 4 * fq + 32 * (kc); fk[kc][t] = ld2(kr_, kr_ + 16); } } while (0)
                SC_LOAD_KS(0, 0);
                SC_LOAD_KS(1, 1); asm volatile("" ::: "memory"); SC_MMA_KS(0, 0);
                SC_LOAD_KS(0, 2); asm volatile("" ::: "memory"); SC_MMA_KS(1, 1);
                SC_LOAD_KS(1, 3); asm volatile("" ::: "memory"); SC_MMA_KS(0, 2);
                SC_LOAD_KC(0);    asm volatile("" ::: "memory"); SC_MMA_KS(1, 3);
                u32x2 uu[4];
#pragma unroll
                for (int mt = 0; mt < 4; ++mt) uu[mt] = *(const LAS u32x2*)(st + SC_U + fr * 72 + 16 * mt + 4 * fq);
                SC_LOAD_KC(1);    asm volatile("" ::: "memory");
                bf16x8 vb[2]; f32x4 vn[4];
#pragma unroll
                for (int mt = 0; mt < 4; ++mt) {
                    vn[mt][0] = __uint_as_float(uu[mt][0] << 16) - p[mt][0]; vn[mt][1] = __uint_as_float(uu[mt][0] & 0xffff0000u) - p[mt][1];
                    vn[mt][2] = __uint_as_float(uu[mt][1] << 16) - p[mt][2]; vn[mt][3] = __uint_as_float(uu[mt][1] & 0xffff0000u) - p[mt][3];
                }
                vb[0] = pk8(vn[0], vn[1]); vb[1] = pk8(vn[2], vn[3]);
#pragma unroll
                for (int t = 0; t < 8; ++t) S[t] = S[t] * egl;
#pragma unroll
                for (int kc = 0; kc < 2; ++kc) {
#pragma unroll
                    for (int mt = 0; mt < 4; ++mt) o[mt] = __builtin_amdgcn_mfma_f32_16x16x32_bf16(fa[kc][mt], vb[kc], o[mt], 0, 0, 0);
#pragma unroll
                    for (int t = 0; t < 8; ++t) S[t] = __builtin_amdgcn_mfma_f32_16x16x32_bf16(fk[kc][t], vb[kc], S[t], 0, 0, 0);
                }
#undef SC_LOAD_KS
#undef SC_MMA_KS
#undef SC_LOAD_KC
                const int rbase = dn_rbase(b, dir, s);
#pragma unroll
                for (int mt = 0; mt < 4; ++mt)
#pragma unroll
                    for (int jj = 0; jj < 4; ++jj) {
                        const int row = rbase + rstep * (16 * mt + 4 * fq + jj);
                        O[((size_t)dir * T + row) * 1024 + h * 128 + sl * 16 + fr] = f2bf(o[mt][jj]);
                    }
            }
            lds_barrier();
          }
        }
    }
}
PF void dn_finish(const KC& k, int j) {
    const int tid = TID(), lane = tid & 63, wave = tid >> 6;
    const bf16_t* O = (const bf16_t*)(k.ws + AR_PB);
    const bf16_t* Z = (const bf16_t*)k.out;
    bf16_t* U = (bf16_t*)(k.ws + AR_UBUF);
    const float* on = k.dn_out_norm + j * 128;
    const int c0 = lane * 16;
    float onv[16];
#pragma unroll
    for (int e = 0; e < 16; ++e) onv[e] = on[(c0 + e) & 127];
    for (int r = blockIdx.x * 8 + wave; r < T; r += gridDim.x * 8) {
        u32x4 vf[2], vb[2], vz[2];
#pragma unroll
        for (int hh = 0; hh < 2; ++hh) {
            vf[hh] = *(const u32x4*)(O + (size_t)r * 1024 + c0 + hh * 8); vb[hh] = *(const u32x4*)(O + ((size_t)T + r) * 1024 + c0 + hh * 8);
            vz[hh] = *(const u32x4*)(Z + (size_t)r * 1024 + c0 + hh * 8);
        }
        asm volatile("" ::: "memory");
        float o[16], z[16];
#pragma unroll
        for (int hh = 0; hh < 2; ++hh) { float a[8], b2[8], zz[8]; unpack8(vf[hh], a); unpack8(vb[hh], b2); unpack8(vz[hh], zz);
#pragma unroll
            for (int i = 0; i < 8; ++i) { o[hh * 8 + i] = a[i] + b2[i]; z[hh * 8 + i] = zz[i]; } }
        float ss = 0.f;
#pragma unroll
        for (int e = 0; e < 16; ++e) ss += o[e] * o[e];
        ss += shx(ss, 1, lane); ss += shx(ss, 2, lane); ss += shx(ss, 4, lane);
        const float rs = rsqrtf(ss * (1.0f / 128.0f) + EPS);
#pragma unroll
        for (int hh = 0; hh < 2; ++hh) { u32x4 ov;
#pragma unroll
            for (int w = 0; w < 4; ++w) { const int e0 = hh * 8 + 2 * w; ov[w] = pk2(o[e0] * rs * onv[e0] * siluf(z[e0]), o[e0 + 1] * rs * onv[e0 + 1] * siluf(z[e0 + 1])); }
            *(u32x4*)(U + (size_t)r * 1024 + c0 + hh * 8) = ov; }
    }
}

DI float conv3g(const bf16_t* p, int j, float w0, float w1, float w2) {
    const int gc = j & 63;
    const float l = gc != 0 ? bf2f(p[j - 1]) : 0.f, c = bf2f(p[j]), r = gc != 63 ? bf2f(p[j + 1]) : 0.f;
    return w0 * l + w1 * c + w2 * r;
}
DI float hy_conv_lane(float c, float w0, float w1, float w2, int lane) {
    const float l = shi(c, (lane + 63) & 63), r = shi(c, (lane + 1) & 63);
    return w0 * (lane > 0 ? l : 0.f) + w1 * c + w2 * (lane < 63 ? r : 0.f);
}
PF void hy_lat(const KC& k, int jl, LAS float* ldsf) {
    const int tid = TID();
    LAS cf* X = (LAS cf*)ldsf;
    LAS cf* tw = X + 17408;
    LAS cf* tA = tw + 1024; LAS cf* tB = tA + 128;
    const float* FT = (const float*)(k.ws + AR_FT);
    const bf16_t* PT = (const bf16_t*)(k.ws + AR_PB);
    bf16_t* ZT = (bf16_t*)(k.ws + AR_ZT);
    cf* scr = (cf*)(k.ws + AR_FFTS) + (size_t)blockIdx.x * 4 * 16384;
    cf* sKe = scr; cf* sKo = scr + 16384; cf* zp = scr + 2 * 16384; cf* ye = scr + 3 * 16384;
    const float* cw = k.hy_conv + (size_t)jl * 3 * 3072;
    for (int m = 0; m < 2; ++m) { const int p = tid + 512 * m; float sn, cs; sincospif(-(float)p / 8192.0f, &sn, &cs); cf w; w.x = cs; w.y = sn; tw[p] = w; }
    if (tid < 256) { const int a = tid & 127; float sn, cs; sincospif(-(float)(tid < 128 ? 128 * a : a) / 16384.0f, &sn, &cs); cf w; w.x = cs; w.y = sn; (tid < 128 ? tA : tB)[a] = w; }
    __syncthreads();
    const int lane = tid & 63;
#define HY_SPLIT() asm volatile("" ::: "memory")
#define HY_CONV(c, w0, w1, w2) hy_conv_lane((c), (w0), (w1), (w2), lane)
    for (int ch = blockIdx.x; ch < 1024; ch += gridDim.x) {
        {
            const bf16_t* pv = PT + (size_t)ch * T + TC;
            const float w0 = cw[ch], w1 = cw[3072 + ch], w2 = cw[6144 + ch];
            for (int m0 = 0; m0 < 32; m0 += 8) {
                bf16_t a0[8], a1[8];
#pragma unroll
                for (int q = 0; q < 8; ++q) { const int j = tid + 512 * (m0 + q); a0[q] = pv[j]; a1[q] = pv[SEQ + j]; }
                HY_SPLIT();
#pragma unroll
                for (int q = 0; q < 8; ++q) { const int j = tid + 512 * (m0 + q); const float c0 = bf2f(a0[q]), c1 = bf2f(a1[q]); cf z; z.x = HY_CONV(c0, w0, w1, w2); z.y = HY_CONV(c1, w0, w1, w2); zp[j] = z; }
            }
        }
        for (int n = 0; n < 2; ++n) {
            __syncthreads();
            const float* ftf = FT + (size_t)(n * 2048 + ch) * 16384; const float* ftb = FT + (size_t)(n * 2048 + 1024 + ch) * 16384;
            for (int m0 = 0; m0 < 32; m0 += 8) {
                float hfv[8], hbv[8];
#pragma unroll
                for (int q = 0; q < 8; ++q) { const int j = tid + 512 * (m0 + q); hfv[q] = ftf[j]; hbv[q] = ftb[j > 0 ? SEQ - j : 0]; }
                HY_SPLIT();
#pragma unroll
                for (int q = 0; q < 8; ++q) {
                    const int j = tid + 512 * (m0 + q);
                    const float hf = hfv[q], hb = j > 0 ? hbv[q] : 0.f;
                    const cf w = cmul(tA[j >> 7], tB[j & 127]);
                    cf a; a.x = hf + hb; a.y = 0.f; X[PIDX(j)] = a;
                    const float kd = hf - hb; cf o; o.x = kd * w.x; o.y = kd * w.y; sKo[j] = o;
                }
            }
            __syncthreads();
            fft16k_fwd(X, tw);
            _Pragma("unroll 8") for (int m = 0; m < 32; ++m) { const int j = tid + 512 * m; sKe[j] = X[PIDX(j)]; }
            __syncthreads();
            for (int m0 = 0; m0 < 32; m0 += 8) { cf t[8];
#pragma unroll
                for (int q = 0; q < 8; ++q) t[q] = sKo[tid + 512 * (m0 + q)];
                HY_SPLIT();
#pragma unroll
                for (int q = 0; q < 8; ++q) X[PIDX(tid + 512 * (m0 + q))] = t[q]; }
            __syncthreads();
            fft16k_fwd(X, tw);
            _Pragma("unroll 8") for (int m = 0; m < 32; ++m) { const int j = tid + 512 * m; sKo[j] = X[PIDX(j)]; }
            __syncthreads();
            for (int m0 = 0; m0 < 32; m0 += 8) { cf t[8];
#pragma unroll
                for (int q = 0; q < 8; ++q) t[q] = zp[tid + 512 * (m0 + q)];
                HY_SPLIT();
#pragma unroll
                for (int q = 0; q < 8; ++q) X[PIDX(tid + 512 * (m0 + q))] = t[q]; }
            __syncthreads();
            fft16k_fwd(X, tw);
            for (int m0 = 0; m0 < 32; m0 += 8) { cf t[8];
#pragma unroll
                for (int q = 0; q < 8; ++q) t[q] = sKe[tid + 512 * (m0 + q)];
                HY_SPLIT();
#pragma unroll
                for (int q = 0; q < 8; ++q) { const int j = tid + 512 * (m0 + q); X[PIDX(j)] = cmul(X[PIDX(j)], t[q]); } }
            __syncthreads();
            fft16k_inv(X, tw);
            _Pragma("unroll 8") for (int m = 0; m < 32; ++m) { const int j = tid + 512 * m; ye[j] = X[PIDX(j)]; }
            __syncthreads();
            for (int m0 = 0; m0 < 32; m0 += 8) { cf t[8];
#pragma unroll
                for (int q = 0; q < 8; ++q) t[q] = zp[tid + 512 * (m0 + q)];
                HY_SPLIT();
#pragma unroll
                for (int q = 0; q < 8; ++q) { const int j = tid + 512 * (m0 + q); const cf w = cmul(tA[j >> 7], tB[j & 127]); X[PIDX(j)] = cmul(t[q], w); } }
            __syncthreads();
            fft16k_fwd(X, tw);
            for (int m0 = 0; m0 < 32; m0 += 8) { cf t[8];
#pragma unroll
                for (int q = 0; q < 8; ++q) t[q] = sKo[tid + 512 * (m0 + q)];
                HY_SPLIT();
#pragma unroll
                for (int q = 0; q < 8; ++q) { const int j = tid + 512 * (m0 + q); X[PIDX(j)] = cmul(X[PIDX(j)], t[q]); } }
            __syncthreads();
            fft16k_inv(X, tw);
            {
                const bf16_t* pg = PT + (size_t)((n + 1) * 1024 + ch) * T + TC;
                const int gcol = (n + 1) * 1024 + ch;
                const float w0 = cw[gcol], w1 = cw[3072 + gcol], w2 = cw[6144 + gcol];
                const float bias = k.hy_bias[(size_t)jl * 2 * 1024 + n * 1024 + ch];
                for (int m0 = 0; m0 < 32; m0 += 8) {
                    cf te[8], tz[8]; bf16_t g0[8], g1[8];
#pragma unroll
                    for (int q = 0; q < 8; ++q) { const int j = tid + 512 * (m0 + q); te[q] = ye[j]; tz[q] = zp[j]; g0[q] = pg[j]; g1[q] = pg[SEQ + j]; }
                    HY_SPLIT();
#pragma unroll
                    for (int q = 0; q < 8; ++q) {
                        const int j = tid + 512 * (m0 + q);
                        cf w = cmul(tA[j >> 7], tB[j & 127]); w.y = -w.y;
                        const cf yo = cmul(X[PIDX(j)], w);
                        const float y0 = (0.5f / 16384.0f) * (te[q].x + yo.x), y1 = (0.5f / 16384.0f) * (te[q].y + yo.y);
                        const float c0 = bf2f(g0[q]), c1 = bf2f(g1[q]);
                        cf zn; zn.x = HY_CONV(c0, w0, w1, w2) * (y0 + bias * tz[q].x); zn.y = HY_CONV(c1, w0, w1, w2) * (y1 + bias * tz[q].y);
                        zp[j] = zn;
                    }
                }
            }
        }
        for (int m0 = 0; m0 < 32; m0 += 8) { cf t[8];
#pragma unroll
            for (int q = 0; q < 8; ++q) t[q] = zp[tid + 512 * (m0 + q)];
            HY_SPLIT();
#pragma unroll
            for (int q = 0; q < 8; ++q) { const int j = tid + 512 * (m0 + q); ZT[(size_t)ch * T + TC + j] = f2bf(t[q].x); ZT[(size_t)ch * T + TC + SEQ + j] = f2bf(t[q].y); } }
        __syncthreads();
    }
#undef HY_SPLIT
#undef HY_CONV
}
PF void hy_ctx(const KC& k, int jl, LAS float* lds) {
    const int tid = TID(), t = tid & 255, hsel = tid >> 8;
    LAS float* z = lds + hsel * 768; LAS float* hf = z + 256; LAS float* hb = hf + 256;
    const bf16_t* PT = (const bf16_t*)(k.ws + AR_PB);
    bf16_t* U = (bf16_t*)(k.ws + AR_UBUF);
    const float* filtc = (const float*)(k.ws + WS_FILTC);
    const float* cw = k.hy_conv + (size_t)jl * 3 * 3072;
    for (int u = blockIdx.x; u < 1024; u += gridDim.x) {
        const int pr = u * 2 + hsel, b = pr >> 10, ch = pr & 1023;
        float zc;
        {
            const bf16_t* pv = PT + (size_t)ch * T + b * 256;
            const float l = t != 0 ? bf2f(pv[t - 1]) : 0.f, c = bf2f(pv[t]), r = t != 255 ? bf2f(pv[t + 1]) : 0.f;
            zc = cw[ch] * l + cw[3072 + ch] * c + cw[6144 + ch] * r;
        }
        for (int n = 0; n < 2; ++n) {
            __syncthreads();
            z[t] = zc; hf[t] = filtc[(size_t)t * 4096 + n * 2048 + ch]; hb[t] = filtc[(size_t)t * 4096 + n * 2048 + 1024 + ch];
            __syncthreads();
            float y = 0.f;
            for (int s = 0; s <= t; ++s) y += hf[t - s] * z[s];
            for (int s = t + 1; s < 256; ++s) y += hb[s - t] * z[s];
            const int gcol = (n + 1) * 1024 + ch;
            const bf16_t* pg = PT + (size_t)gcol * T + b * 256;
            const float l = t != 0 ? bf2f(pg[t - 1]) : 0.f, c = bf2f(pg[t]), r = t != 255 ? bf2f(pg[t + 1]) : 0.f;
            const float gate = cw[gcol] * l + cw[3072 + gcol] * c + cw[6144 + gcol] * r;
            zc = gate * (y + k.hy_bias[(size_t)jl * 2048 + n * 1024 + ch] * zc);
        }
        U[(size_t)(b * 256 + t) * 1024 + ch] = f2bf(zc);
        __syncthreads();
    }
}
PF void hy_transpose(const KC& k, LAS bf16_t* lds) {
    const int tid = TID();
    const bf16_t* ZT = (const bf16_t*)(k.ws + AR_ZT);
    bf16_t* U = (bf16_t*)(k.ws + AR_UBUF);
    for (int u = blockIdx.x; u < 16 * (TL / 64); u += gridDim.x) {
        const int c0 = (u & 15) * 64, r0 = TC + (u >> 4) * 64;
        { const int c = tid >> 3, sg = (tid & 7) * 8;
          const u32x4 v = *(const u32x4*)(ZT + (size_t)(c0 + c) * T + r0 + sg);
#pragma unroll
          for (int w = 0; w < 4; ++w) { lds[(sg + 2 * w) * 66 + c] = (bf16_t)(v[w] & 0xffff); lds[(sg + 2 * w + 1) * 66 + c] = (bf16_t)(v[w] >> 16); } }
        __syncthreads();
        { const int r = tid >> 3, sg = (tid & 7) * 8; u32x4 o;
#pragma unroll
          for (int w = 0; w < 4; ++w) o[w] = (unsigned)lds[r * 66 + sg + 2 * w] | ((unsigned)lds[r * 66 + sg + 2 * w + 1] << 16);
          *(u32x4*)(U + (size_t)(r0 + r) * 1024 + c0 + sg) = o; }
        __syncthreads();
    }
}

__global__ void __launch_bounds__(NTHR, 2) fwd_kernel(Params prm) {
    extern __shared__ __attribute__((aligned(16))) unsigned char lds_raw[];
    LAS unsigned char* lds = (LAS unsigned char*)lds_raw;
    LAS float* ldsf = (LAS float*)lds;
    LAS bf16_t* ldsh = (LAS bf16_t*)lds;
    LAS int* tb = (LAS int*)(lds + 150 * 1024);
    volatile LAS unsigned* xbw = (volatile LAS unsigned*)(lds + 151 * 1024 + 512);
    KC k;
    k.x = (const float*)(GAS const float*)prm.in[0]; k.c = (const float*)(GAS const float*)prm.in[1]; k.ctx = (const float*)(GAS const float*)prm.in[2]; k.c_ctx = (const float*)(GAS const float*)prm.in[3]; k.ada_w = (const float*)(GAS const float*)prm.in[4]; k.ada_b = (const float*)(GAS const float*)prm.in[5];
    k.norm_mix = (const float*)(GAS const float*)prm.in[6]; k.norm_ffn = (const float*)(GAS const float*)prm.in[7]; k.norm_final = (const float*)(GAS const float*)prm.in[8];
    k.dn_w_in = (const float*)(GAS const float*)prm.in[9]; k.dn_conv = (const float*)(GAS const float*)prm.in[10]; k.dn_a_log = (const float*)(GAS const float*)prm.in[11]; k.dn_dt_bias = (const float*)(GAS const float*)prm.in[12]; k.dn_out_norm = (const float*)(GAS const float*)prm.in[13]; k.dn_w_out = (const float*)(GAS const float*)prm.in[14];
    k.hy_w_in = (const float*)(GAS const float*)prm.in[15]; k.hy_conv = (const float*)(GAS const float*)prm.in[16]; k.hy_f_w1 = (const float*)(GAS const float*)prm.in[17]; k.hy_f_b1 = (const float*)(GAS const float*)prm.in[18]; k.hy_f_freq = (const float*)(GAS const float*)prm.in[19]; k.hy_f_w2 = (const float*)(GAS const float*)prm.in[20];
    k.hy_f_b2 = (const float*)(GAS const float*)prm.in[21]; k.hy_f_w3 = (const float*)(GAS const float*)prm.in[22]; k.hy_bias = (const float*)(GAS const float*)prm.in[23]; k.hy_w_out = (const float*)(GAS const float*)prm.in[24];
    k.sc_w_in = (const float*)(GAS const float*)prm.in[25]; k.sc_conv = (const float*)(GAS const float*)prm.in[26]; k.sc_w_out = (const float*)(GAS const float*)prm.in[27]; k.w_router = (const float*)(GAS const float*)prm.in[28]; k.router_bias = (const float*)(GAS const float*)prm.in[29];
    k.moe_w_gate = (const float*)(GAS const float*)prm.in[30]; k.moe_w_up = (const float*)(GAS const float*)prm.in[31]; k.moe_w_down = (const float*)(GAS const float*)prm.in[32];
    k.out = (float*)(GAS float*)prm.out; k.ws = (unsigned char*)(GAS unsigned char*)prm.ws;
    const int lo = prm.ph_lo, hi = prm.ph_hi;
    XcdBarrier bar; bar.bar = (unsigned*)(k.ws + WS_CTL); bar.x = 0; bar.st = xbw;
    if (hi - lo > 1) {
        if (threadIdx.x == 0) { xbw[0] = 0u; xbw[1] = 0u; }
        __syncthreads();
        bar = xcd_barrier_post((unsigned*)(k.ws + WS_CTL), xbw);
    }
    int ph = 0;
#define PROBE_OK(id) ((id) != 1 || i == 0)
    int i = 0;
#define PH_BEGIN(id) if (ph >= lo && ph < hi) { const int nrep_ = (((id) == PROBE_REP) && PROBE_OK(id)) ? 2 : 1; for (int rep_ = 0; rep_ < nrep_; ++rep_) { { GAS unsigned char* w_ = (GAS unsigned char*)k.ws; asm volatile("" : "+s"(w_)); k.ws = (unsigned char*)w_; }
#define PH_END   if (ph + 1 < hi) xcd_barrier(bar); } } ++ph;

    float* xs = (float*)(k.ws + WS_XS);
    const float* mod = (const float*)(k.ws + WS_MOD);

    PH_BEGIN(0)
        job_mod(k, ldsf);
        job_cvt_small(k, ldsf);
        job_hdn(k, ldsf);
        job_w3s(k);
    PH_END

    for (i = 0; i < DEPTH; ++i) {
        const int kind = i % 3, j = i / 3;
        const bool last = (i == DEPTH - 1);
        PH_BEGIN(1)
            if (kind == 0) norm_phase<2>(k, i, i == 0, i > 0, k.norm_mix + i * 1024, 0, k.dn_w_in + (size_t)j * 1024 * DN_IN + 4096, DN_IN,
                                         k.dn_a_log + j * 16, k.dn_dt_bias + j * 16, last, ldsf);
            else norm_phase<0>(k, i, i == 0, i > 0, k.norm_mix + i * 1024, 0, nullptr, 0, nullptr, nullptr, last, ldsf);
            if (kind == 1) job_filtc(k, j);
        PH_END
        PH_BEGIN(2)
            if (kind == 0) { EpiBf16 e{(bf16_t*)(k.ws + AR_PB), 3072, 3072, (bf16_t*)k.out, 1024}; gemm_dense(lds, (const bf16_t*)(k.ws + AR_HBUF), T, (const bf16_t*)(k.ws + WS_DNWIN) + (size_t)j * 4096 * 1024, 4096, 1024, e); }
            else if (kind == 1) { EpiBf16T e{(bf16_t*)(k.ws + AR_PB), T}; gemm_dense(lds, (const bf16_t*)(k.ws + AR_HBUF), T, (const bf16_t*)(k.ws + WS_HYWIN), 3072, 1024, e);
                                  EpiTaps et{(float*)(k.ws + AR_FT)}; gemm_dense(lds, (const bf16_t*)(k.ws + WS_W3S), 4096, (const bf16_t*)(k.ws + WS_HS), 16384, 256, et); }
            else { EpiBf16 e{(bf16_t*)(k.ws + AR_PB), 3072, 1 << 30, nullptr, 0}; gemm_dense(lds, (const bf16_t*)(k.ws + AR_HBUF), T, (const bf16_t*)(k.ws + WS_SCWIN), 3072, 1024, e); }
        PH_END
        if (kind == 0) {
            PH_BEGIN(3) dn_chunk(k, j, lds); PH_END
            PH_BEGIN(4) dn_scan(k, lds); PH_END
            PH_BEGIN(5) dn_finish(k, j); PH_END
        } else if (kind == 1) {
            PH_BEGIN(6) hy_lat(k, j, ldsf); hy_ctx(k, j, ldsf); PH_END
            PH_BEGIN(7) hy_transpose(k, ldsh); PH_END
        } else {
            PH_BEGIN(8) sc_mix(k, j); PH_END
        }
        PH_BEGIN(9)
            const bf16_t* Wt = kind == 0 ? (const bf16_t*)(k.ws + WS_DNWOUT) + (size_t)j * 1024 * 1024 : (kind == 1 ? (const bf16_t*)(k.ws + WS_HYWOUT) : (const bf16_t*)(k.ws + WS_SCWOUT));
            EpiResid e{xs, mod, i, 2};
            gemm_dense(lds, (const bf16_t*)(k.ws + AR_UBUF), T, Wt, 1024, 1024, e);
        PH_END
        PH_BEGIN(10)
            norm_phase<1>(k, i, false, false, k.norm_ffn + i * 1024, 3, k.w_router, 32, k.router_bias, nullptr, last, ldsf, rep_ == nrep_ - 1);
        PH_END
        PH_BEGIN(11)
            if (rep_ == 0) moe_scatter(k, i, tb);
            job_cvt_moe(k, i, ldsf);
        PH_END
        PH_BEGIN(12) moe_gemm<0>(k, i, lds, tb); PH_END
        PH_BEGIN(13) moe_gemm<1>(k, i, lds, tb); PH_END
    }
    PH_BEGIN(14)
        norm_phase<3>(k, DEPTH, false, true, k.norm_final, 0, nullptr, 0, nullptr, nullptr, false, ldsf);
    PH_END
#undef PH_BEGIN
#undef PH_END
}
constexpr int N_PHASES = 1 + (10 + 9 + 8 + 10) + 1;

extern "C" void kernel_launch(void* const* d_in, const int* in_sizes, int n_in, void* d_out, int out_size, void* d_ws, size_t ws_size, hipStream_t stream) {
    static int grid = 0;
    if (grid == 0) {
        if (n_in != 33 || out_size != TL * D || ws_size < WS_END) { fprintf(stderr, "kernel_launch: unexpected shapes: n_in %d out %d ws %zu (need %zu)\n", n_in, out_size, ws_size, (size_t)WS_END); grid = -1; return; }
        int dev = 0, cus = 0, per_cu = 0;
        if (hipGetDevice(&dev) != hipSuccess || hipDeviceGetAttribute(&cus, hipDeviceAttributeMultiprocessorCount, dev) != hipSuccess) { grid = -1; return; }
        if (hipFuncSetAttribute((const void*)fwd_kernel, hipFuncAttributeMaxDynamicSharedMemorySize, LDS_BYTES) != hipSuccess) { fprintf(stderr, "kernel_launch: hipFuncSetAttribute failed\n"); grid = -1; return; }
        if (hipOccupancyMaxActiveBlocksPerMultiprocessor(&per_cu, (const void*)fwd_kernel, NTHR, LDS_BYTES) != hipSuccess || per_cu < 1) fprintf(stderr, "kernel_launch: occupancy query reports %d\n", per_cu);
        (void)hipGetLastError();
        grid = cus;
    }
    if (grid < 0) return;
    (void)hipMemsetAsync((char*)d_ws + WS_CTL, 0, CTL_BYTES, stream);
    Params p{};
    for (int i = 0; i < 33; ++i) p.in[i] = (const float*)d_in[i];
    p.out = (float*)d_out; p.ws = (unsigned char*)d_ws;
#if MK_MULTI
    for (int ph = 0; ph < N_PHASES; ++ph) { p.ph_lo = ph; p.ph_hi = ph + 1; hipLaunchKernelGGL(fwd_kernel, dim3(grid), dim3(NTHR), LDS_BYTES, stream, p); }
#else
    p.ph_lo = 0; p.ph_hi = N_PHASES;
    hipLaunchKernelGGL(fwd_kernel, dim3(grid), dim3(NTHR), LDS_BYTES, stream, p);
#endif
}
```

```cpp
#include <hip/hip_runtime.h>
#include <stdint.h>
#include <stdio.h>
#include <math.h>

#ifndef MK_MULTI
#define MK_MULTI 0
#endif

#ifndef PROBE_SUB
#define PROBE_SUB (0)
#endif
#ifndef PROBE_REP
#define PROBE_REP (-1)
#endif
#define LAS __attribute__((address_space(3)))
#define GAS __attribute__((address_space(1)))
#define HD __host__ __device__ __forceinline__
#define DI __device__ __forceinline__
#ifdef NOINL
#define PF __device__ __noinline__
#else
#define PF __device__ __forceinline__
#endif
typedef unsigned short bf16_t;
typedef short bf16x8 __attribute__((ext_vector_type(8)));
typedef float f32x4 __attribute__((ext_vector_type(4)));
typedef unsigned u32x4 __attribute__((ext_vector_type(4)));
typedef unsigned u32x2 __attribute__((ext_vector_type(2)));

constexpr int D = 1024, NB = 2, SEQ = 16384, CTXL = 256, DEPTH = 4;
constexpr int TC = NB * CTXL, TL = NB * SEQ, T = TC + TL, NA = 2 * T;
constexpr int NTHR = 512;
constexpr int DN_IN = 4128;
constexpr float EPS = 1e-6f;
constexpr int LDS_BYTES = 152 * 1024;

constexpr size_t AL(size_t x) { return (x + 255) & ~(size_t)255; }
constexpr size_t WS_CTL = 0;
constexpr size_t CTL_BYTES = 65536;
constexpr size_t CTL_CNT = 16384;
constexpr size_t WS_MOD = WS_CTL + CTL_BYTES;
constexpr size_t WS_HS = AL(WS_MOD + 4 * 3 * 6144 * 4);
constexpr size_t WS_W3S = AL(WS_HS + 16384 * 256 * 2);
constexpr size_t WS_HDNC = AL(WS_W3S + 4096 * 256 * 2);
constexpr size_t WS_FILTC = AL(WS_HDNC + 256 * 64 * 4);
constexpr size_t WS_DNWIN = AL(WS_FILTC + 256 * 4096 * 4);
constexpr size_t WS_DNWOUT = AL(WS_DNWIN + (size_t)2 * 4096 * 1024 * 2);
constexpr size_t WS_HYWIN = AL(WS_DNWOUT + (size_t)2 * 1024 * 1024 * 2);
constexpr size_t WS_HYWOUT = AL(WS_HYWIN + (size_t)3072 * 1024 * 2);
constexpr size_t WS_SCWIN = AL(WS_HYWOUT + (size_t)1024 * 1024 * 2);
constexpr size_t WS_SCWOUT = AL(WS_SCWIN + (size_t)3072 * 1024 * 2);
constexpr size_t WS_XS = AL(WS_SCWOUT + (size_t)1024 * 1024 * 2);
constexpr size_t WS_TOKE = AL(WS_XS + (size_t)T * 1024 * 4);
constexpr size_t WS_TOKW = AL(WS_TOKE + (size_t)T * 2 * 4);
constexpr size_t WS_TOKP = AL(WS_TOKW + (size_t)T * 2 * 4);
constexpr size_t WS_SLOT = AL(WS_TOKP + (size_t)T * 2 * 4);
constexpr size_t WS_GB = AL(WS_SLOT + (size_t)(NA + 256) * 4);
constexpr size_t WS_EGL = AL(WS_GB + (size_t)T * 32 * 4);
constexpr size_t WS_AR = AL(WS_EGL + (size_t)32 * 260 * 4);
constexpr size_t AR_HBUF = WS_AR;
constexpr size_t AR_UBUF = AR_HBUF + (size_t)T * 1024 * 2;
constexpr size_t AR_PB = AR_UBUF + (size_t)T * 1024 * 2;
constexpr size_t AR_Q = AR_PB + (size_t)T * 4096 * 2;
constexpr size_t AR_CHUNK = AR_PB + (size_t)T * 3072 * 2;
constexpr size_t AR_DN_END = AR_CHUNK + (size_t)32 * 260 * 65536;
constexpr size_t AR_ZT = AR_Q;
constexpr size_t AR_FFTS = AR_ZT + (size_t)1024 * T * 2;
constexpr size_t AR_FT = AR_FFTS + (size_t)256 * 4 * 16384 * 8;
constexpr size_t AR_HY_END = AR_FT + (size_t)4096 * 16384 * 4;
constexpr size_t AR_HID = AR_PB;
constexpr size_t AR_YS = AR_HID + (size_t)NA * 512 * 2;
constexpr size_t AR_WGU = AR_YS + (size_t)NA * 1024 * 2;
constexpr size_t AR_WD = AR_WGU + (size_t)32 * 1024 * 1024 * 2;
constexpr size_t AR_MOE_END = AR_WD + (size_t)32 * 1024 * 512 * 2;
constexpr size_t WS_END = AR_DN_END > AR_HY_END ? (AR_DN_END > AR_MOE_END ? AR_DN_END : AR_MOE_END) : (AR_HY_END > AR_MOE_END ? AR_HY_END : AR_MOE_END);

#define XB_TMO      128
#define XB_XCNT(j)  (256  + 64 * (j))
#define XB_XSUB(j)  (1280 + 64 * (j))
#define XB_XGEN(j)  (2304 + 64 * (j))
#define XB_TOP      3328
#define XB_TOPGEN   3392
#define XCD_BAR_WORDS 3456
#define XB_SPIN_CAP (1u << 25)
DI unsigned xb_ld(unsigned* p)              { return __hip_atomic_load(p, __ATOMIC_RELAXED, __HIP_MEMORY_SCOPE_AGENT); }
DI unsigned xb_add(unsigned* p, unsigned v) { return __hip_atomic_fetch_add(p, v, __ATOMIC_RELAXED, __HIP_MEMORY_SCOPE_AGENT); }
DI unsigned xb_xcc_id() { return (unsigned)__builtin_amdgcn_s_getreg((3 << 11) | 20) & 0xFu; }
#define XB_SPIN(cond, bar) do { unsigned _sp = 0; while (cond) { __builtin_amdgcn_s_sleep(1); \
    if ((++_sp & 255u) == 0u) { if (xb_ld(&(bar)[XB_TMO])) break; if (_sp > XB_SPIN_CAP) { atomicAdd(&(bar)[XB_TMO], 1u); break; } } } } while (0)
struct XcdBarrier { unsigned* bar; unsigned x; volatile LAS unsigned* st; };
DI XcdBarrier xcd_barrier_post(unsigned* bar, volatile LAS unsigned* st) {
    XcdBarrier b; b.bar = bar; b.x = xb_xcc_id(); b.st = st;
    if (threadIdx.x == 0) (void)xb_add(&bar[XB_XCNT(b.x)], 1u);
    return b;
}
DI void xcd_barrier_complete(unsigned* bar, unsigned x, unsigned& nloc, unsigned& nx) {
    const unsigned G = gridDim.x * gridDim.y * gridDim.z;
    unsigned sum, cnt, mine, sp = 0u;
    for (;;) {
        sum = 0u; cnt = 0u; mine = 0u;
#pragma unroll
        for (unsigned j = 0; j < 16; ++j) { const unsigned c = xb_ld(&bar[XB_XCNT(j)]); sum += c; cnt += (c > 0u) ? 1u : 0u; mine = (j == x) ? c : mine; }
        if (sum == G) break;
        __builtin_amdgcn_s_sleep(1);
        if ((++sp & 255u) == 0u) { if (xb_ld(&bar[XB_TMO])) break; if (sp > XB_SPIN_CAP) { atomicAdd(&bar[XB_TMO], 1u); break; } }
    }
    nloc = mine > 0u ? mine : 1u; nx = cnt > 0u ? cnt : 1u;
}
DI void xcd_barrier(const XcdBarrier& b) {
    asm volatile("s_waitcnt vmcnt(0)" ::: "memory");
    __syncthreads();
    if (threadIdx.x == 0) {
        unsigned* bar = b.bar;
        __builtin_amdgcn_s_waitcnt(0);
        unsigned nloc = b.st[0], nx = b.st[1];
        if (nloc == 0u) { xcd_barrier_complete(bar, b.x, nloc, nx); b.st[0] = nloc; b.st[1] = nx; }
        const unsigned old = xb_add(&bar[XB_XSUB(b.x)], 1u);
        const unsigned gen = old / nloc;
        if (old + 1u == (gen + 1u) * nloc) {
            __builtin_amdgcn_fence(__ATOMIC_RELEASE, "agent");
            asm volatile("s_waitcnt vmcnt(0)" ::: "memory");
            const unsigned og = xb_add(&bar[XB_TOP], 1u);
            const unsigned tg = og / nx;
            if (og + 1u == (tg + 1u) * nx) xb_add(&bar[XB_TOPGEN], 1u);
            else XB_SPIN(xb_ld(&bar[XB_TOPGEN]) == tg, bar);
            __builtin_amdgcn_fence(__ATOMIC_ACQUIRE, "agent");
            xb_add(&bar[XB_XGEN(b.x)], 1u);
            asm volatile("s_waitcnt vmcnt(0)" ::: "memory");
        } else {
            XB_SPIN(xb_ld(&bar[XB_XGEN(b.x)]) == gen, bar);
            __builtin_amdgcn_fence(__ATOMIC_ACQUIRE, "agent");
            asm volatile("s_waitcnt vmcnt(0)" ::: "memory");
        }
    }
    __syncthreads();
}

typedef float f32x2_t __attribute__((ext_vector_type(2)));
typedef __bf16 bf16x2_t __attribute__((ext_vector_type(2)));
DI unsigned cvt_pk_bf16(float lo, float hi) { f32x2_t v; v.x = lo; v.y = hi; const bf16x2_t b = __builtin_convertvector(v, bf16x2_t); return __builtin_bit_cast(unsigned, b); }
DI bf16_t f2bf(float f) { return (bf16_t)(cvt_pk_bf16(f, f) & 0xffffu); }
DI float bf2f(bf16_t b) { return __uint_as_float(((unsigned)b) << 16); }
DI unsigned pk2(float lo, float hi) { return cvt_pk_bf16(lo, hi); }
DI float siluf(float x) { return x * __builtin_amdgcn_rcpf(1.0f + __expf(-x)); }
DI float sigmf(float x) { return 1.0f / (1.0f + __expf(-x)); }
DI float shi(float v, int src) { return __int_as_float(__builtin_amdgcn_ds_bpermute(src << 2, __float_as_int(v))); }
DI int shii(int v, int src) { return __builtin_amdgcn_ds_bpermute(src << 2, v); }
DI float shx(float v, int m, int lane) { return shi(v, lane ^ m); }
DI float wsum(float v, int lane) {
#pragma unroll
    for (int m = 32; m >= 1; m >>= 1) v += shx(v, m, lane);
    return v;
}
DI void lds_barrier() { asm volatile("s_waitcnt lgkmcnt(0)\n\ts_barrier" ::: "memory"); }
DI int TID() { int t = threadIdx.x; asm volatile("" : "+v"(t)); return t; }
DI int modrow(int r) { return r < TC ? 0 : 1 + (r - TC) / SEQ; }

typedef float cf __attribute__((ext_vector_type(2)));
HD cf cmul(cf a, cf b) { cf r; r.x = a.x * b.x - a.y * b.y; r.y = a.x * b.y + a.y * b.x; return r; }
HD cf cadd(cf a, cf b) { cf r; r.x = a.x + b.x; r.y = a.y + b.y; return r; }
HD cf csub(cf a, cf b) { cf r; r.x = a.x - b.x; r.y = a.y - b.y; return r; }
template <int R> HD constexpr int brev(int i) { int r = 0; for (int b = 1, t = R >> 1; b < R; b <<= 1, t >>= 1) if (i & b) r |= t; return r; }
#define FFT_C32 {1.0f, 0.98078528040323044913f, 0.92387953251128675613f, 0.83146961230254523708f, 0.70710678118654752440f, 0.55557023301960222474f, 0.38268343236508977173f, 0.19509032201612826785f, 0.0f, -0.19509032201612826785f, -0.38268343236508977173f, -0.55557023301960222474f, -0.70710678118654752440f, -0.83146961230254523708f, -0.92387953251128675613f, -0.98078528040323044913f}
#define FFT_S32 {0.0f, 0.19509032201612826785f, 0.38268343236508977173f, 0.55557023301960222474f, 0.70710678118654752440f, 0.83146961230254523708f, 0.92387953251128675613f, 0.98078528040323044913f, 1.0f, 0.98078528040323044913f, 0.92387953251128675613f, 0.83146961230254523708f, 0.70710678118654752440f, 0.55557023301960222474f, 0.38268343236508977173f, 0.19509032201612826785f}
template <int R> HD constexpr int ilog2c() { int l = 0; for (int r = R; r > 1; r >>= 1) ++l; return l; }
template <int R> HD void dft_fwd(cf (&v)[R]) {
    constexpr float C[16] = FFT_C32; constexpr float S[16] = FFT_S32;
    constexpr int LG = ilog2c<R>();
#pragma unroll
    for (int st = 0; st < LG; ++st) {
#pragma unroll
        for (int i = 0; i < R / 2; ++i) {
            const int len = R >> st, half = len >> 1, blk = i / half, j = i % half, i0 = blk * len + j, i1 = i0 + half;
            const cf a = v[i0], c = v[i1];
            v[i0] = cadd(a, c);
            const cf d = csub(a, c);
            const int ti = j * (32 / len);
            cf w; w.x = C[ti]; w.y = -S[ti];
            cf r;
            if (ti == 0) r = d;
            else if (ti == 8) { r.x = d.y; r.y = -d.x; }
            else if (ti == 4) { r.x = (d.x + d.y) * 0.70710678118654752440f; r.y = (d.y - d.x) * 0.70710678118654752440f; }
            else if (ti == 12) { r.x = (d.y - d.x) * 0.70710678118654752440f; r.y = -(d.x + d.y) * 0.70710678118654752440f; }
            else r = cmul(d, w);
            v[i1] = r;
        }
    }
}
template <int R> HD void dft_inv(cf (&v)[R]) {
    constexpr float C[16] = FFT_C32; constexpr float S[16] = FFT_S32;
    constexpr int LG = ilog2c<R>();
#pragma unroll
    for (int st = LG - 1; st >= 0; --st) {
#pragma unroll
        for (int i = 0; i < R / 2; ++i) {
            const int len = R >> st, half = len >> 1, blk = i / half, j = i % half, i0 = blk * len + j, i1 = i0 + half;
            const int ti = j * (32 / len);
            cf w; w.x = C[ti]; w.y = S[ti];
            const cf a = v[i0];
            const cf b1 = v[i1];
            cf c;
            if (ti == 0) c = b1;
            else if (ti == 8) { c.x = -b1.y; c.y = b1.x; }
            else if (ti == 4) { c.x = (b1.x - b1.y) * 0.70710678118654752440f; c.y = (b1.x + b1.y) * 0.70710678118654752440f; }
            else if (ti == 12) { c.x = -(b1.x + b1.y) * 0.70710678118654752440f; c.y = (b1.x - b1.y) * 0.70710678118654752440f; }
            else c = cmul(b1, w);
            v[i0] = cadd(a, c);
            v[i1] = csub(a, c);
        }
    }
}
#define PIDX(a) ((a) + (((a) >> 6) << 2))
template <int R> DI void fft_pass_fwd(LAS cf* X, const LAS cf* tw, int n, int g) {
    const int s = n / R, q = g / s, p = g - q * s, base = q * n + p;
    cf v[R];
#pragma unroll
    for (int k = 0; k < R; ++k) v[k] = X[PIDX(base + k * s)];
    dft_fwd<R>(v);
    if (s > 1) {
        int pp = p * (16384 / n); asm volatile("" : "+v"(pp));
        const cf w1 = tw[pp]; cf w = w1;
#pragma unroll
        for (int m = 1; m < R; ++m) { v[brev<R>(m)] = cmul(v[brev<R>(m)], w); w = cmul(w, w1); }
    }
#pragma unroll
    for (int k = 0; k < R; ++k) X[PIDX(base + k * s)] = v[k];
}
template <int R> DI void fft_pass_inv(LAS cf* X, const LAS cf* tw, int n, int g) {
    const int s = n / R, q = g / s, p = g - q * s, base = q * n + p;
    cf v[R];
#pragma unroll
    for (int k = 0; k < R; ++k) v[k] = X[PIDX(base + k * s)];
    if (s > 1) {
        int pp = p * (16384 / n); asm volatile("" : "+v"(pp));
        cf w1 = tw[pp]; w1.y = -w1.y; cf w = w1;
#pragma unroll
        for (int m = 1; m < R; ++m) { v[brev<R>(m)] = cmul(v[brev<R>(m)], w); w = cmul(w, w1); }
    }
    dft_inv<R>(v);
#pragma unroll
    for (int k = 0; k < R; ++k) X[PIDX(base + k * s)] = v[k];
}
DI void fft16k_fwd(LAS cf* X, const LAS cf* tw) {
    const int t = TID();
#pragma unroll 1
    for (int g = 0; g < 2; ++g) fft_pass_fwd<16>(X, tw, 16384, t + 512 * g);
    __syncthreads();
#pragma unroll 1
    for (int g = 0; g < 2; ++g) fft_pass_fwd<16>(X, tw, 1024, t + 512 * g);
    __syncthreads();
#pragma unroll 1
    for (int g = 0; g < 2; ++g) fft_pass_fwd<16>(X, tw, 64, t + 512 * g);
    __syncthreads();
#pragma unroll 1
    for (int g = 0; g < 8; ++g) fft_pass_fwd<4>(X, tw, 4, t + 512 * g);
    __syncthreads();
}
DI void fft16k_inv(LAS cf* X, const LAS cf* tw) {
    const int t = TID();
#pragma unroll 1
    for (int g = 0; g < 8; ++g) fft_pass_inv<4>(X, tw, 4, t + 512 * g);
    __syncthreads();
#pragma unroll 1
    for (int g = 0; g < 2; ++g) fft_pass_inv<16>(X, tw, 64, t + 512 * g);
    __syncthreads();
#pragma unroll 1
    for (int g = 0; g < 2; ++g) fft_pass_inv<16>(X, tw, 1024, t + 512 * g);
    __syncthreads();
#pragma unroll 1
    for (int g = 0; g < 2; ++g) fft_pass_inv<16>(X, tw, 16384, t + 512 * g);
    __syncthreads();
}

struct Params { const float* in[33]; float* out; unsigned char* ws; int ph_lo, ph_hi; };
struct KC {
    const float *x, *c, *ctx, *c_ctx, *ada_w, *ada_b, *norm_mix, *norm_ffn, *norm_final;
    const float *dn_w_in, *dn_conv, *dn_a_log, *dn_dt_bias, *dn_out_norm, *dn_w_out;
    const float *hy_w_in, *hy_conv, *hy_f_w1, *hy_f_b1, *hy_f_freq, *hy_f_w2, *hy_f_b2, *hy_f_w3, *hy_bias, *hy_w_out;
    const float *sc_w_in, *sc_conv, *sc_w_out, *w_router, *router_bias, *moe_w_gate, *moe_w_up, *moe_w_down;
    float* out; unsigned char* ws;
};

PF void job_mod(const KC& k, LAS float* lds) {
    const int tid = TID(), cj = tid & 63, kq = tid >> 6;
    float* mod = (float*)(k.ws + WS_MOD);
    for (int u = blockIdx.x; u < DEPTH * 96; u += gridDim.x) {
        const int l = u / 96, cc = u % 96, col = cc * 64 + cj;
        const float* W = k.ada_w + (size_t)l * 1024 * 6144;
        float a0 = 0.f, a1 = 0.f, a2 = 0.f;
        for (int kk = kq * 128; kk < kq * 128 + 128; ++kk) {
            const float w = W[(size_t)kk * 6144 + col];
            a0 += siluf(k.c_ctx[kk]) * w; a1 += siluf(k.c[kk]) * w; a2 += siluf(k.c[1024 + kk]) * w;
        }
        lds[(kq * 3 + 0) * 64 + cj] = a0; lds[(kq * 3 + 1) * 64 + cj] = a1; lds[(kq * 3 + 2) * 64 + cj] = a2;
        __syncthreads();
        if (tid < 192) {
            const int r = tid >> 6, j = tid & 63;
            float s = 0.f;
            for (int q = 0; q < 8; ++q) s += lds[(q * 3 + r) * 64 + j];
            mod[(size_t)(l * 3 + r) * 6144 + cc * 64 + j] = s + k.ada_b[l * 6144 + cc * 64 + j];
        }
        __syncthreads();
    }
}
DI void cvt_matrix(const float* src, int ld, size_t sstride, int K, int N, int nmat, bf16_t* dst, int ldd, size_t dstride, int mapmode, LAS float* lds) {
    const int tk = K / 64, tn = N / 64, per = tk * tn, tid = TID();
    const int r = tid >> 4, c4 = (tid & 15) * 4;
    f32x4 v0, v1;
    int u = blockIdx.x;
    if (u < per * nmat) { const int m = u / per, t = u % per; const float* sp = src + (size_t)m * sstride + (size_t)((t / tn) * 64 + r) * ld + (t % tn) * 64 + c4; v0 = *(const f32x4*)sp; v1 = *(const f32x4*)(sp + (size_t)32 * ld); }
    for (; u < per * nmat; u += gridDim.x) {
        const int m = u / per, t = u % per, k0 = (t / tn) * 64, n0 = (t % tn) * 64;
        { LAS float* p = lds + r * 65 + c4; p[0] = v0[0]; p[1] = v0[1]; p[2] = v0[2]; p[3] = v0[3];
          LAS float* p2 = lds + (r + 32) * 65 + c4; p2[0] = v1[0]; p2[1] = v1[1]; p2[2] = v1[2]; p2[3] = v1[3]; }
        { const int un = u + gridDim.x;
          if (un < per * nmat) { const int mn = un / per, tn_ = un % per; const float* sp = src + (size_t)mn * sstride + (size_t)((tn_ / tn) * 64 + r) * ld + (tn_ % tn) * 64 + c4; v0 = *(const f32x4*)sp; v1 = *(const f32x4*)(sp + (size_t)32 * ld); } }
        lds_barrier();
        { const int nn = tid >> 3, ks = (tid & 7) * 8; const int n = n0 + nn;
          const int row = mapmode == 0 ? n : (32 * (n >> 4) + (n & 15) + (mapmode == 2 ? 16 : 0));
          float f[8];
#pragma unroll
          for (int e = 0; e < 8; ++e) f[e] = lds[(ks + e) * 65 + nn];
          u32x4 o; o[0] = pk2(f[0], f[1]); o[1] = pk2(f[2], f[3]); o[2] = pk2(f[4], f[5]); o[3] = pk2(f[6], f[7]);
          *(u32x4*)(dst + (size_t)m * dstride + (size_t)row * ldd + k0 + ks) = o; }
        lds_barrier();
    }
}
PF void job_cvt_small(const KC& k, LAS float* lds) {
    cvt_matrix(k.dn_w_in, DN_IN, (size_t)1024 * DN_IN, 1024, 4096, 2, (bf16_t*)(k.ws + WS_DNWIN), 1024, (size_t)4096 * 1024, 0, lds);
    cvt_matrix(k.dn_w_out, 1024, (size_t)1024 * 1024, 1024, 1024, 2, (bf16_t*)(k.ws + WS_DNWOUT), 1024, (size_t)1024 * 1024, 0, lds);
    cvt_matrix(k.hy_w_in, 3072, 0, 1024, 3072, 1, (bf16_t*)(k.ws + WS_HYWIN), 1024, 0, 0, lds);
    cvt_matrix(k.hy_w_out, 1024, 0, 1024, 1024, 1, (bf16_t*)(k.ws + WS_HYWOUT), 1024, 0, 0, lds);
    cvt_matrix(k.sc_w_in, 3072, 0, 1024, 3072, 1, (bf16_t*)(k.ws + WS_SCWIN), 1024, 0, 0, lds);
    cvt_matrix(k.sc_w_out, 1024, 0, 1024, 1024, 1, (bf16_t*)(k.ws + WS_SCWOUT), 1024, 0, 0, lds);
}
PF void job_cvt_moe(const KC& k, int layer, LAS float* lds) {
    const size_t lo = (size_t)layer * 32 * 1024 * 512;
    cvt_matrix(k.moe_w_gate + lo, 512, (size_t)1024 * 512, 1024, 512, 32, (bf16_t*)(k.ws + AR_WGU), 1024, (size_t)1024 * 1024, 1, lds);
    cvt_matrix(k.moe_w_up + lo, 512, (size_t)1024 * 512, 1024, 512, 32, (bf16_t*)(k.ws + AR_WGU), 1024, (size_t)1024 * 1024, 2, lds);
    cvt_matrix(k.moe_w_down + lo, 1024, (size_t)512 * 1024, 512, 1024, 32, (bf16_t*)(k.ws + AR_WD), 512, (size_t)1024 * 512, 0, lds);
}
PF void job_hdn(const KC& k, LAS float* lds) {
    const int tid = TID(), lane = tid & 63, wave = tid >> 6;
    LAS float* feat = lds + wave * 128; LAS float* h1 = feat + 64;
    const float fr = k.hy_f_freq[lane], b1 = k.hy_f_b1[lane], b2 = k.hy_f_b2[lane];
    for (int u0 = blockIdx.x * 8; u0 < 16384 + 256; u0 += gridDim.x * 8) {
        const int u = u0 + wave;
        int l, pos; float* dst;
        if (u < 16384) { l = 16384; pos = u; dst = nullptr; }
        else { l = 256; pos = u - 16384; dst = (float*)(k.ws + WS_HDNC) + (size_t)pos * 64; }
        const float t = (float)pos / (float)(l - 1);
        float f = 0.f;
        if (lane == 0) f = t;
        else if (lane <= 32) {
            const int bi = (lane - 1) & 15;
            const float band = 1e-4f + (float)bi * ((15.0f - 1e-4f) / 15.0f);
            const float ang = (6.283185307179586f / (float)l) * (float)pos * band;
            f = lane <= 16 ? cosf(ang) : -sinf(ang);
        }
        feat[lane] = f;
        __syncthreads();
        float a = b1;
        for (int i = 0; i < 33; ++i) a += feat[i] * k.hy_f_w1[i * 64 + lane];
        h1[lane] = sinf(fr * a);
        __syncthreads();
        float a2 = b2;
        for (int j = 0; j < 64; ++j) a2 += h1[j] * k.hy_f_w2[j * 64 + lane];
        const float hv = sinf(fr * a2);
        if (dst) dst[lane] = hv;
        else { bf16_t* hs = (bf16_t*)(k.ws + WS_HS) + (size_t)pos * 256; const bf16_t hi = f2bf(hv), lo = f2bf(hv - bf2f(hi)); hs[lane] = hi; hs[64 + lane] = lo; hs[128 + lane] = hi; hs[192 + lane] = 0; }
        __syncthreads();
    }
}
PF void job_w3s(const KC& k) {
    bf16_t* W = (bf16_t*)(k.ws + WS_W3S);
    const int tq = TID();
    for (int idx = blockIdx.x * NTHR + tq; idx < 64 * 4096; idx += gridDim.x * NTHR) {
        const int j = idx >> 12, col = idx & 4095;
        const float w = k.hy_f_w3[idx]; const bf16_t hi = f2bf(w), lo = f2bf(w - bf2f(hi));
        W[(size_t)col * 256 + j] = hi; W[(size_t)col * 256 + 64 + j] = hi; W[(size_t)col * 256 + 128 + j] = lo; W[(size_t)col * 256 + 192 + j] = 0;
    }
}
DI float hy_delta(int ch) {
    const float lo = -4.605170185988091f / 1.5f, hi = -4.605170185988091f / 0.3f;
    return fabsf(lo + (float)ch * ((hi - lo) / 1023.0f));
}
PF void job_filtc(const KC& k, int j) {
    const float* hdn = (const float*)(k.ws + WS_HDNC);
    const float* w3 = k.hy_f_w3 + (size_t)j * 64 * 4096;
    float* filtc = (float*)(k.ws + WS_FILTC);
    const int tq = TID();
    for (int u = blockIdx.x; u < 256 * 8; u += gridDim.x) {
        const int l = u >> 3, col = (u & 7) * 512 + tq;
        float a = 0.f;
        for (int q = 0; q < 64; ++q) a += hdn[l * 64 + q] * w3[(size_t)q * 4096 + col];
        const float t = (float)l / 255.0f;
        filtc[(size_t)l * 4096 + col] = a * expf(-t * hy_delta(col & 1023));
    }
}

template <int MODE>
PF void norm_phase(const KC& k, int layer, bool first, bool combine, const float* __restrict__ gain, int mb, const float* __restrict__ Wsk, int ldw,
                   const float* __restrict__ aux0, const float* __restrict__ aux1, bool last, LAS float* lds, bool flush = true) {
    const int tid = TID(), lane = tid & 63, wave = tid >> 6;
    float* xs = (float*)(k.ws + WS_XS);
    bf16_t* hbuf = (bf16_t*)(k.ws + AR_HBUF);
    const float* mod = (const float*)(k.ws + WS_MOD);
    const bf16_t* ys = (const bf16_t*)(k.ws + AR_YS);
    const int* tokp = (const int*)(k.ws + WS_TOKP);
    const float* tokw = (const float*)(k.ws + WS_TOKW);
    LAS int* lcnt = (LAS int*)(lds + 32768);
    if (MODE == 1 && tid < 32) lcnt[tid] = 0;
    if (MODE == 1 || MODE == 2) {
        for (int idx = tid; idx < 1024 * 32; idx += NTHR) {
            const int kk = idx >> 5, n = idx & 31;
            lds[kk * 32 + (((n >> 2) ^ ((kk >> 1) & 7)) << 2) + (n & 3)] = Wsk[(size_t)kk * ldw + n];
        }
        __syncthreads();
    }
    const int rbeg = (MODE == 3) ? TC : 0, rstr = gridDim.x * 8;
    int cur_mr = -1; float gsv[16], shv[16], g5v[16];
    float xn[16];
    int r = rbeg + blockIdx.x * 8 + wave;
    if (r < T) {
        const float* src = first ? (r < TC ? k.ctx + (size_t)r * 1024 : k.x + (size_t)(r - TC) * 1024) : xs + (size_t)r * 1024;
#pragma unroll
        for (int m = 0; m < 16; ++m) xn[m] = src[lane + 64 * m];
    }
    for (; r < T; r += rstr) {
        const int mr = modrow(r);
        float x[16];
#pragma unroll
        for (int m = 0; m < 16; ++m) x[m] = xn[m];
        int p0 = 0, p1 = 0; float w0 = 0.f, w1 = 0.f;
        if (combine) { p0 = tokp[2 * r]; p1 = tokp[2 * r + 1]; w0 = tokw[2 * r]; w1 = tokw[2 * r + 1]; }
        {
            const int rn = r + rstr;
            if (rn < T) {
                const float* srcn = first ? (rn < TC ? k.ctx + (size_t)rn * 1024 : k.x + (size_t)(rn - TC) * 1024) : xs + (size_t)rn * 1024;
#pragma unroll
                for (int m = 0; m < 16; ++m) xn[m] = srcn[lane + 64 * m];
            }
        }
        if (mr != cur_mr) {
            cur_mr = mr;
            if (MODE != 3) {
                const float* shift = mod + ((size_t)(layer * 3 + mr) * 6 + mb) * 1024;
#pragma unroll
                for (int m = 0; m < 16; ++m) { const int col = lane + 64 * m; gsv[m] = gain[col] * (1.0f + shift[1024 + col]); shv[m] = shift[col]; }
            } else {
#pragma unroll
                for (int m = 0; m < 16; ++m) gsv[m] = gain[lane + 64 * m];
            }
            if (combine) {
                const float* g5 = mod + ((size_t)((layer - 1) * 3 + mr) * 6 + 5) * 1024;
#pragma unroll
                for (int m = 0; m < 16; ++m) g5v[m] = g5[lane + 64 * m];
            }
        }
        if (combine) {
            bf16_t ya[16], yb[16];
#pragma unroll
            for (int m = 0; m < 16; ++m) { const int col = lane + 64 * m; ya[m] = ys[(size_t)p0 * 1024 + col]; yb[m] = ys[(size_t)p1 * 1024 + col]; }
            asm volatile("" ::: "memory");
#pragma unroll
            for (int m = 0; m < 16; ++m) x[m] += g5v[m] * (w0 * bf2f(ya[m]) + w1 * bf2f(yb[m]));
        }
        if (first || combine) {
#pragma unroll
            for (int m = 0; m < 16; ++m) xs[(size_t)r * 1024 + lane + 64 * m] = x[m];
        }
        float ss = 0.f;
#pragma unroll
        for (int m = 0; m < 16; ++m) ss += x[m] * x[m];
        ss = wsum(ss, lane);
        const float rstd = rsqrtf(ss * (1.0f / 1024.0f) + EPS);
        if (MODE == 3) {
#pragma unroll
            for (int m = 0; m < 16; ++m) { const int col = lane + 64 * m; k.out[(size_t)(r - TC) * 1024 + col] = x[m] * rstd * gsv[m]; }
            continue;
        }
        float y[16];
#pragma unroll
        for (int m = 0; m < 16; ++m) {
            const int col = lane + 64 * m;
            y[m] = x[m] * rstd * gsv[m] + shv[m];
            hbuf[(size_t)r * 1024 + col] = f2bf(y[m]);
        }
        if (MODE == 1 || MODE == 2) {
            float acc[32];
#pragma unroll
            for (int n = 0; n < 32; ++n) acc[n] = 0.f;
#pragma unroll
            for (int m = 0; m < 16; ++m) {
                f32x4 wa[8];
                const int c = lane + 64 * m; const LAS float* wr = lds + c * 32; const int sw = (c >> 1) & 7;
#pragma unroll
                for (int q = 0; q < 8; ++q) wa[q] = *(const LAS f32x4*)(wr + ((q ^ sw) << 2));
                asm volatile("" ::: "memory");
#pragma unroll
                for (int q = 0; q < 8; ++q) { acc[4 * q + 0] += y[m] * wa[q][0]; acc[4 * q + 1] += y[m] * wa[q][1]; acc[4 * q + 2] += y[m] * wa[q][2]; acc[4 * q + 3] += y[m] * wa[q][3]; }
            }
            float val;
            {
                float a16[16], a8[8], a4[4], a2[2];
                const bool b5 = (lane & 32) != 0, b4 = (lane & 16) != 0, b3 = (lane & 8) != 0, b2 = (lane & 4) != 0, b1 = (lane & 2) != 0;
#pragma unroll
                for (int i = 0; i < 16; ++i) { const float send = b5 ? acc[i] : acc[i + 16], keep = b5 ? acc[i + 16] : acc[i]; a16[i] = keep + shx(send, 32, lane); }
#pragma unroll
                for (int i = 0; i < 8; ++i) { const float send = b4 ? a16[i] : a16[i + 8], keep = b4 ? a16[i + 8] : a16[i]; a8[i] = keep + shx(send, 16, lane); }
#pragma unroll
                for (int i = 0; i < 4; ++i) { const float send = b3 ? a8[i] : a8[i + 4], keep = b3 ? a8[i + 4] : a8[i]; a4[i] = keep + shx(send, 8, lane); }
#pragma unroll
                for (int i = 0; i < 2; ++i) { const float send = b2 ? a4[i] : a4[i + 2], keep = b2 ? a4[i + 2] : a4[i]; a2[i] = keep + shx(send, 4, lane); }
                { const float send = b1 ? a2[0] : a2[1], keep = b1 ? a2[1] : a2[0]; val = keep + shx(send, 2, lane); }
                val += shx(val, 1, lane);
            }
            const int n = lane >> 1;
            if (MODE == 1) {
                int* toke = (int*)(k.ws + WS_TOKE); float* tokwW = (float*)(k.ws + WS_TOKW);
                if (last && r < TC) { if (lane == 0) { int neg = -1; asm volatile("" : "+v"(neg)); toke[2 * r] = neg; toke[2 * r + 1] = neg; } continue; }
                const float sc = 1.0f / (1.0f + expf(-val)), ch = sc + aux0[n];
                const int gl = lane & ~7;
                const float ca = shi(ch, gl), cb = shi(ch, gl + 2), cc = shi(ch, gl + 4), cd = shi(ch, gl + 6);
                const float hi1 = fmaxf(ca, cb), lo1 = fminf(ca, cb), hi2 = fmaxf(cc, cd), lo2 = fminf(cc, cd);
                float gs = fmaxf(hi1, hi2) + fmaxf(fminf(hi1, hi2), fmaxf(lo1, lo2));
                int gi = lane >> 3;
#pragma unroll
                for (int m = 8; m <= 32; m <<= 1) {
                    const float og = shx(gs, m, lane); const int oi = shii(gi, lane ^ m);
                    if (og > gs || (og == gs && oi < gi)) { gs = og; gi = oi; }
                }
                float c4[4], s4[4];
#pragma unroll
                for (int i = 0; i < 4; ++i) { c4[i] = shi(ch, gi * 8 + 2 * i); s4[i] = shi(sc, gi * 8 + 2 * i); }
                int i1 = 0; float b1v = c4[0];
#pragma unroll
                for (int i = 1; i < 4; ++i) if (c4[i] > b1v) { b1v = c4[i]; i1 = i; }
                int i2 = -1; float b2v = -1e30f;
#pragma unroll
                for (int i = 0; i < 4; ++i) if (i != i1 && c4[i] > b2v) { b2v = c4[i]; i2 = i; }
                float w1v = 0.f, w2v = 0.f;
#pragma unroll
                for (int i = 0; i < 4; ++i) { if (i == i1) w1v = s4[i]; if (i == i2) w2v = s4[i]; }
                const float inv = 1.0f / (w1v + w2v);
                if (lane == 0) {
                    const int e1 = gi * 4 + i1, e2 = gi * 4 + i2;
                    toke[2 * r] = e1; toke[2 * r + 1] = e2; tokwW[2 * r] = w1v * inv; tokwW[2 * r + 1] = w2v * inv;
                    __hip_atomic_fetch_add(lcnt + e1, 1, __ATOMIC_RELAXED, __HIP_MEMORY_SCOPE_WORKGROUP);
                    __hip_atomic_fetch_add(lcnt + e2, 1, __ATOMIC_RELAXED, __HIP_MEMORY_SCOPE_WORKGROUP);
                }
            } else {
                float* gb = (float*)(k.ws + WS_GB);
                if ((lane & 1) == 0) {
                    if (n < 16) {
                        const float z = val + aux1[n];
                        const float ez = __expf(z); const float sp = z > 15.f ? z : (ez < 1e-4f ? ez - 0.5f * ez * ez : __logf(1.0f + ez));
                        gb[(size_t)r * 32 + n] = -expf(aux0[n]) * sp;
                    } else {
                        gb[(size_t)r * 32 + n] = 1.0f / (1.0f + expf(-val));
                    }
                }
            }
        }
    }
    if (MODE == 1) {
        __syncthreads();
        int* cnt = (int*)(k.ws + WS_CTL + CTL_CNT) + layer * 32;
        if (flush && tid < 32 && lcnt[tid] > 0) atomicAdd(&cnt[tid], lcnt[tid]);
    }
}

namespace pg8 {
constexpr int BM = 256, BK = 64, HALF = 128, HTB = HALF * BK * 2, STAGE_BYTES = 8 * HTB;
DI int lds_byte(int r, int c) { const int st = (r >> 4) * 2 + (c >> 5), rr = r & 15, cc = c & 31, ob = rr * 64 + cc * 2; return st * 1024 + (ob ^ (((ob >> 9) & 1) << 5)); }
DI void stage_rc(int b, int& R, int& C) { const int st = b / 1024, sb = b % 1024, swz = sb ^ (((sb >> 9) & 1) << 5); R = (st >> 1) * 16 + swz / 64; C = (st & 1) * 32 + (swz % 64) / 2; }
DI int perm32(int rho) { const int n = rho >> 4, i = rho & 15; return 8 * (i >> 2) + 4 * n + (i & 3); }
struct Unit { int m0, mrows, pn; size_t boff; };
template <bool GATHER, class Epi, class Sched>
DI void gemm_phase(LAS unsigned char* lds, const bf16_t* A, const int* rowidx, const bf16_t* Bt, int K, const Sched& S, const Epi& E) {
    const int tid = TID(), wid = __builtin_amdgcn_readfirstlane(tid >> 6), lane = tid & 63, wr = wid >> 2, wc = wid & 3, fr = lane & 15, fq = lane >> 4;
    const int nt = K / BK;
    unsigned voffA[2], voffB[2];
#pragma unroll
    for (int i = 0; i < 2; ++i) { int R, C; stage_rc(tid * 16 + i * 8192, R, C); const int Rb = Epi::PERM ? ((R & ~31) + perm32(R & 31)) : R;
        voffA[i] = (unsigned)(R * K + C) * 2u; voffB[i] = (unsigned)(Rb * K + C) * 2u; }
    const size_t kstep = (size_t)(BK * 2);
    const size_t hstep = (size_t)HALF * K * 2;
    const size_t tstep = 2 * hstep;
    const size_t rstep = (size_t)K * 2;
    const unsigned ldsw = (unsigned)wid * 1024u;
    const int aoff = lds_byte(wr * 64 + fr, fq * 8), boff = lds_byte(wc * 32 + fr, fq * 8);
#define PG8_SA(b, h) (((b) * 2 + (h)) * HTB)
#define PG8_SB(b, h) ((4 + (b) * 2 + (h)) * HTB)
#define PG8_STAGE(bufoff, gbase, voff) do { _Pragma("unroll") for (int _i = 0; _i < 2; ++_i) \
        __builtin_amdgcn_global_load_lds((const unsigned*)((const char*)(gbase) + (voff)[_i]), (LAS unsigned*)(lds + (bufoff) + ldsw + _i * 8192), 16, 0, 0); } while (0)
#define PG8_STAGE_A(bufoff, p, h, vG) do { if (GATHER) PG8_STAGE(bufoff, p, (vG)[h]); else PG8_STAGE(bufoff, (p) + (h) * hstep, voffA); } while (0)
#define PG8_LDA(dst, b, h) do { _Pragma("unroll") for (int m = 0; m < 4; ++m) _Pragma("unroll") for (int k = 0; k < 2; ++k) dst[m][k] = *(const LAS bf16x8*)(lds + PG8_SA(b, h) + aoff + m * 2048 + k * 1024); } while (0)
#define PG8_LDB(dst, b, h) do { _Pragma("unroll") for (int n = 0; n < 2; ++n) _Pragma("unroll") for (int k = 0; k < 2; ++k) dst[n][k] = *(const LAS bf16x8*)(lds + PG8_SB(b, h) + boff + n * 2048 + k * 1024); } while (0)
#define PG8_MMA(ai, bj, At, Bt_) do { __builtin_amdgcn_s_setprio(1); _Pragma("unroll") for (int m = 0; m < 4; ++m) _Pragma("unroll") for (int n = 0; n < 2; ++n) _Pragma("unroll") for (int k = 0; k < 2; ++k) \
        acc[ai][bj][m][n] = __builtin_amdgcn_mfma_f32_16x16x32_bf16(Bt_[n][k], At[m][k], acc[ai][bj][m][n], 0, 0, 0); __builtin_amdgcn_s_setprio(0); } while (0)
#define PG8_WAIT_V(n) asm volatile("s_waitcnt vmcnt(" #n ")" ::: "memory")
#define PG8_WAIT_L(n) asm volatile("s_waitcnt lgkmcnt(" #n ")" ::: "memory")
#define PG8_BAR __builtin_amdgcn_s_barrier()
#define PG8_SCHED __builtin_amdgcn_sched_barrier(0)
#define PG8_AOFF(dst, u) do { _Pragma("unroll") for (int _h = 0; _h < 2; ++_h) _Pragma("unroll") for (int _i = 0; _i < 2; ++_i) { int _R, _C; stage_rc(tid * 16 + _i * 8192, _R, _C); \
        dst[_h][_i] = (unsigned)(rowidx[(u).m0 + _h * HALF + _R] * K + _C) * 2u; } } while (0)
    Unit cur, nxt; int ui = 0;
    if (!S.next(0, cur)) return;
    f32x4 acc[2][2][4][2];
#pragma unroll
    for (int a = 0; a < 2; ++a)
#pragma unroll
        for (int b = 0; b < 2; ++b)
#pragma unroll
            for (int m = 0; m < 4; ++m)
#pragma unroll
                for (int n = 0; n < 2; ++n) acc[a][b][m][n] = (f32x4){0.f, 0.f, 0.f, 0.f};
    bf16x8 At[4][2], B0[2][2], B1[2][2];
    unsigned vA[2][2], vN[2][2];
    if (GATHER) PG8_AOFF(vA, cur);
    const char* cA = (const char*)A + (GATHER ? (size_t)0 : (size_t)cur.m0 * rstep);
    const char* cB = (const char*)Bt + cur.boff + (size_t)cur.pn * tstep;
    PG8_STAGE(PG8_SB(0, 0), cB, voffB); PG8_STAGE_A(PG8_SA(0, 0), cA, 0, vA); PG8_STAGE(PG8_SB(0, 1), cB + hstep, voffB); PG8_STAGE_A(PG8_SA(0, 1), cA, 1, vA);
    if (wr == 1) PG8_BAR;
    PG8_WAIT_V(4); PG8_BAR;
    PG8_STAGE(PG8_SB(1, 0), cB + kstep, voffB); PG8_STAGE_A(PG8_SA(1, 0), cA + kstep, 0, vA); PG8_STAGE(PG8_SB(1, 1), cB + hstep + kstep, voffB);
    PG8_WAIT_V(6); PG8_BAR;
    for (;;) {
        const bool has_next = S.next(ui + 1, nxt);
        const char* nA = GATHER ? cA : (has_next ? (const char*)A + (size_t)nxt.m0 * rstep : cA);
        const char* nB = has_next ? (const char*)Bt + nxt.boff + (size_t)nxt.pn * tstep : cB;
        if (GATHER) {
            if (has_next) { PG8_AOFF(vN, nxt); }
            else {
#pragma unroll
                for (int h = 0; h < 2; ++h)
#pragma unroll
                    for (int i = 0; i < 2; ++i) vN[h][i] = vA[h][i];
            }
        }
        for (int t = 0; t < nt; t += 2) {
            const bool last = (t == nt - 2);
            const char* a1 = cA + (size_t)(t + 1) * kstep;
            const char* a2 = last ? nA : cA + (size_t)(t + 2) * kstep; const char* b2 = last ? nB : cB + (size_t)(t + 2) * kstep;
            const char* a3 = a2 + kstep; const char* b3 = b2 + kstep;
            PG8_LDB(B0, 0, 0); PG8_SCHED; PG8_LDA(At, 0, 0); PG8_STAGE_A(PG8_SA(1, 1), a1, 1, vA);
            if (GATHER && last) {
#pragma unroll
                for (int h = 0; h < 2; ++h)
#pragma unroll
                    for (int i = 0; i < 2; ++i) vA[h][i] = vN[h][i];
            }
            PG8_WAIT_L(8); PG8_BAR; PG8_WAIT_L(0); PG8_MMA(0, 0, At, B0); PG8_BAR; PG8_SCHED;
            PG8_LDB(B1, 0, 1); PG8_STAGE(PG8_SB(0, 0), b2, voffB);
            PG8_BAR; PG8_WAIT_L(0); PG8_MMA(0, 1, At, B1); PG8_BAR;
            PG8_LDA(At, 0, 1); PG8_STAGE_A(PG8_SA(0, 0), a2, 0, vA);
            PG8_BAR; PG8_WAIT_L(0); PG8_MMA(1, 0, At, B0); PG8_BAR; PG8_SCHED;
            PG8_STAGE(PG8_SB(0, 1), b2 + hstep, voffB);
            PG8_WAIT_V(6); PG8_BAR; PG8_MMA(1, 1, At, B1); PG8_BAR;
            PG8_LDB(B0, 1, 0); PG8_SCHED; PG8_LDA(At, 1, 0); PG8_STAGE_A(PG8_SA(0, 1), a2, 1, vA);
            PG8_WAIT_L(8); PG8_BAR; PG8_WAIT_L(0); PG8_MMA(0, 0, At, B0); PG8_BAR; PG8_SCHED;
            PG8_LDB(B1, 1, 1); PG8_STAGE(PG8_SB(1, 0), b3, voffB);
            PG8_BAR; PG8_WAIT_L(0); PG8_MMA(0, 1, At, B1); PG8_BAR;
            PG8_LDA(At, 1, 1); PG8_STAGE_A(PG8_SA(1, 0), a3, 0, vA);
            PG8_BAR; PG8_WAIT_L(0); PG8_MMA(1, 0, At, B0); PG8_BAR; PG8_SCHED;
            PG8_STAGE(PG8_SB(1, 1), b3 + hstep, voffB);
            PG8_WAIT_V(6); PG8_BAR; PG8_MMA(1, 1, At, B1); PG8_BAR;
        }
        { const int t2 = TID(), l2 = t2 & 63; E(acc, cur, wr, wc, l2 & 15, l2 >> 4); }
        if (!has_next) break;
#pragma unroll
        for (int a = 0; a < 2; ++a)
#pragma unroll
            for (int b = 0; b < 2; ++b)
#pragma unroll
                for (int m = 0; m < 4; ++m)
#pragma unroll
                    for (int n = 0; n < 2; ++n) acc[a][b][m][n] = (f32x4){0.f, 0.f, 0.f, 0.f};
        cur = nxt; cA = nA; cB = nB; ++ui;
    }
    PG8_WAIT_V(0);
    if (wr == 0) PG8_BAR;
    PG8_BAR;
#undef PG8_SA
#undef PG8_SB
#undef PG8_STAGE
#undef PG8_STAGE_A
#undef PG8_LDA
#undef PG8_LDB
#undef PG8_MMA
#undef PG8_WAIT_V
#undef PG8_WAIT_L
#undef PG8_BAR
#undef PG8_SCHED
#undef PG8_AOFF
}
struct DenseOrder {
    int nM, nN, nwg, G, c;
    DI void init(int M, int N, int G_, int c_) { nM = M / BM; nN = N / BM; nwg = nM * nN; G = G_; c = c_; }
    DI bool next(int i, Unit& u) const {
        const long L = (long)i * G + c; if (L >= nwg) return false;
        int wgid = (int)L; { const int q = nwg / 8, r = nwg % 8, xcd = wgid % 8, off = wgid / 8; wgid = (xcd < r ? xcd * (q + 1) : r * (q + 1) + (xcd - r) * q) + off; }
        const int nig = 8 * nN, gid = wgid / nig, fm = gid * 8, gsz = (nM - fm) < 8 ? (nM - fm) : 8;
        u.m0 = (fm + ((wgid % nig) % gsz)) * BM; u.mrows = BM; u.pn = (wgid % nig) / gsz; u.boff = 0; return true;
    }
};
struct MoeOrder {
    const LAS int* tb; int G, c; size_t estride; int lane;
    DI bool next(int i, Unit& u) const {
        const int L = i * G + c; if (L >= __builtin_amdgcn_readfirstlane(tb[97]) * 4) return false;
        const int tile = L >> 2;
        const int pre = tb[65 + (lane & 31)];
        const unsigned long long m = __ballot(lane < 32 && pre <= tile);
        const int e = __popcll(m) - 1;
        const int lt = tile - __builtin_amdgcn_readfirstlane(tb[65 + e]); int mr = __builtin_amdgcn_readfirstlane(tb[e]) - lt * 256; mr = mr > 256 ? 256 : mr;
        u.m0 = __builtin_amdgcn_readfirstlane(tb[32 + e]) + lt * 256; u.mrows = mr; u.pn = L & 3; u.boff = (size_t)e * estride; return true;
    }
};
}
struct EpiBf16 {
    static constexpr bool PERM = true;
    bf16_t* C; int ldc; int split_col; bf16_t* C2; int ldc2;
    DI void operator()(const f32x4 (&acc)[2][2][4][2], const pg8::Unit& u, int wr, int wc, int fr, int fq) const {
        int colt = u.pn * 256; bf16_t* base = C; int ld = ldc;
        if (colt >= split_col) { base = C2; ld = ldc2; colt -= split_col; }
#pragma unroll
        for (int ai = 0; ai < 2; ++ai)
#pragma unroll
            for (int m = 0; m < 4; ++m) {
                const int rl = ai * 128 + wr * 64 + m * 16 + fr;
                if (rl < u.mrows) {
                    bf16_t* rowp = base + (size_t)(u.m0 + rl) * ld + colt + wc * 32 + 8 * fq;
#pragma unroll
                    for (int bj = 0; bj < 2; ++bj) {
                        const f32x4 v0 = acc[ai][bj][m][0], v1 = acc[ai][bj][m][1];
                        u32x4 o; o[0] = cvt_pk_bf16(v0[0], v0[1]); o[1] = cvt_pk_bf16(v0[2], v0[3]); o[2] = cvt_pk_bf16(v1[0], v1[1]); o[3] = cvt_pk_bf16(v1[2], v1[3]);
                        *(u32x4*)(rowp + bj * 128) = o;
                    }
                }
            }
    }
};
struct EpiBf16T {
    static constexpr bool PERM = false;
    bf16_t* C; int ldc;
    DI void operator()(const f32x4 (&acc)[2][2][4][2], const pg8::Unit& u, int wr, int wc, int fr, int fq) const {
#pragma unroll
        for (int ai = 0; ai < 2; ++ai)
#pragma unroll
            for (int bj = 0; bj < 2; ++bj)
#pragma unroll
                for (int m = 0; m < 4; ++m)
#pragma unroll
                    for (int n = 0; n < 2; ++n) {
                        const int row = u.m0 + ai * 128 + wr * 64 + m * 16 + fr, col = u.pn * 256 + bj * 128 + wc * 32 + n * 16 + 4 * fq;
#pragma unroll
                        for (int e = 0; e < 4; ++e) C[(size_t)(col + e) * ldc + row] = f2bf(acc[ai][bj][m][n][e]);
                    }
    }
};
struct EpiTaps {
    static constexpr bool PERM = false;
    float* FT;
    DI void operator()(const f32x4 (&acc)[2][2][4][2], const pg8::Unit& u, int wr, int wc, int fr, int fq) const {
#pragma unroll
        for (int ai = 0; ai < 2; ++ai)
#pragma unroll
            for (int m = 0; m < 4; ++m) {
                const int row = u.m0 + ai * 128 + wr * 64 + m * 16 + fr; const float dl = hy_delta(row & 1023) * (1.0f / 16383.0f);
#pragma unroll
                for (int bj = 0; bj < 2; ++bj)
#pragma unroll
                    for (int n = 0; n < 2; ++n) {
                        const int l = u.pn * 256 + bj * 128 + wc * 32 + n * 16 + 4 * fq; f32x4 o;
#pragma unroll
                        for (int e = 0; e < 4; ++e) o[e] = acc[ai][bj][m][n][e] * expf(-(float)(l + e) * dl);
                        *(f32x4*)(FT + (size_t)row * 16384 + l) = o;
                    }
            }
    }
};
struct EpiResid {
    static constexpr bool PERM = false;
    float* xs; const float* mod; int layer; int chunk;
    DI void operator()(const f32x4 (&acc)[2][2][4][2], const pg8::Unit& u, int wr, int wc, int fr, int fq) const {
        const float* g = mod + ((size_t)(layer * 3 + modrow(u.m0)) * 6 + chunk) * 1024;
#pragma unroll
        for (int bj = 0; bj < 2; ++bj)
#pragma unroll
            for (int n = 0; n < 2; ++n) {
                const int col = u.pn * 256 + bj * 128 + wc * 32 + n * 16 + 4 * fq; const f32x4 gv = *(const f32x4*)(g + col);
                float* p0 = xs + (size_t)(u.m0 + wr * 64 + fr) * 1024 + col;
                f32x4 old[8];
#pragma unroll
                for (int ai = 0; ai < 2; ++ai)
#pragma unroll
                    for (int m = 0; m < 4; ++m) old[ai * 4 + m] = *(const f32x4*)(p0 + (size_t)(ai * 128 + m * 16) * 1024);
                asm volatile("" ::: "memory");
#pragma unroll
                for (int ai = 0; ai < 2; ++ai)
#pragma unroll
                    for (int m = 0; m < 4; ++m) *(f32x4*)(p0 + (size_t)(ai * 128 + m * 16) * 1024) = old[ai * 4 + m] + gv * acc[ai][bj][m][n];
            }
    }
};
struct EpiGateUp {
    static constexpr bool PERM = false;
    bf16_t* hid;
    DI void operator()(const f32x4 (&acc)[2][2][4][2], const pg8::Unit& u, int wr, int wc, int fr, int fq) const {
#pragma unroll
        for (int ai = 0; ai < 2; ++ai)
#pragma unroll
            for (int m = 0; m < 4; ++m) {
                const int rl = ai * 128 + wr * 64 + m * 16 + fr;
                if (rl < u.mrows) {
#pragma unroll
                    for (int bj = 0; bj < 2; ++bj) {
                        const int hc = ((u.pn * 256 + bj * 128 + wc * 32) >> 1) + 4 * fq;
                        const f32x4 g = acc[ai][bj][m][0], up = acc[ai][bj][m][1];
                        u32x2 o; o[0] = cvt_pk_bf16(siluf(g[0]) * up[0], siluf(g[1]) * up[1]); o[1] = cvt_pk_bf16(siluf(g[2]) * up[2], siluf(g[3]) * up[3]);
                        *(u32x2*)(hid + (size_t)(u.m0 + rl) * 512 + hc) = o;
                    }
                }
            }
    }
};
template <class Epi>
PF void gemm_dense(LAS unsigned char* lds, const bf16_t* A, int M, const bf16_t* Bt, int N, int K, const Epi& epi) {
    pg8::DenseOrder S; S.init(M, N, (int)gridDim.x, (int)blockIdx.x);
    pg8::gemm_phase<false>(lds, A, (const int*)nullptr, Bt, K, S, epi);
}
DI void moe_table(const KC& k, int layer, LAS int* tb) {
    const int* cnt = (const int*)(k.ws + WS_CTL + CTL_CNT) + layer * 32;
    __syncthreads();
    const int tq = TID();
    if (tq < 32) tb[tq] = __hip_atomic_load(cnt + tq, __ATOMIC_RELAXED, __HIP_MEMORY_SCOPE_AGENT);
    __syncthreads();
    if (tq == 0) {
        int s = 0, tp = 0;
        for (int e = 0; e < 32; ++e) { tb[32 + e] = s; tb[65 + e] = tp; s += tb[e]; tp += (tb[e] + 255) >> 8; }
        tb[64] = s; tb[97] = tp;
    }
    __syncthreads();
}
template <int WHICH>
PF void moe_gemm(const KC& k, int layer, LAS unsigned char* lds, LAS int* tb) {
    moe_table(k, layer, tb);
    if (WHICH == 0) {
        pg8::MoeOrder S{tb, (int)gridDim.x, (int)blockIdx.x, (size_t)1024 * 1024 * 2, TID() & 63};
        EpiGateUp epi{(bf16_t*)(k.ws + AR_HID)};
        pg8::gemm_phase<true>(lds, (const bf16_t*)(k.ws + AR_HBUF), (const int*)(k.ws + WS_SLOT), (const bf16_t*)(k.ws + AR_WGU), 1024, S, epi);
    } else {
        pg8::MoeOrder S{tb, (int)gridDim.x, (int)blockIdx.x, (size_t)1024 * 512 * 2, TID() & 63};
        EpiBf16 epi{(bf16_t*)(k.ws + AR_YS), 1024, 1 << 30, nullptr, 0};
        pg8::gemm_phase<false>(lds, (const bf16_t*)(k.ws + AR_HID), (const int*)nullptr, (const bf16_t*)(k.ws + AR_WD), 512, S, epi);
    }
}
PF void moe_scatter(const KC& k, int layer, LAS int* tb) {
    moe_table(k, layer, tb);
    const int* toke = (const int*)(k.ws + WS_TOKE);
    int* tokp = (int*)(k.ws + WS_TOKP); int* slot = (int*)(k.ws + WS_SLOT);
    int* cur = (int*)(k.ws + WS_CTL + CTL_CNT) + 128 + layer * 32;
    LAS int* lc = tb + 128; LAS int* lb = tb + 160;
    const int tid = TID();
    if (blockIdx.x == 0 && tid < 256) slot[NA + tid] = 0;
    for (int r0 = blockIdx.x * NTHR; r0 < T; r0 += gridDim.x * NTHR) {
        const int r = r0 + tid;
        __syncthreads();
        if (tid < 32) lc[tid] = 0;
        __syncthreads();
        const int e0 = toke[2 * r], e1 = toke[2 * r + 1];
        int k0 = 0, k1 = 0;
        if (e0 >= 0) { k0 = __hip_atomic_fetch_add(lc + e0, 1, __ATOMIC_RELAXED, __HIP_MEMORY_SCOPE_WORKGROUP); k1 = __hip_atomic_fetch_add(lc + e1, 1, __ATOMIC_RELAXED, __HIP_MEMORY_SCOPE_WORKGROUP); }
        __syncthreads();
        if (tid < 32) lb[tid] = lc[tid] > 0 ? atomicAdd(&cur[tid], lc[tid]) : 0;
        __syncthreads();
        if (e0 >= 0) {
            const int p0 = tb[32 + e0] + lb[e0] + k0, p1 = tb[32 + e1] + lb[e1] + k1;
            slot[p0] = r; slot[p1] = r; tokp[2 * r] = p0; tokp[2 * r + 1] = p1;
        }
    }
}

DI void unpack8(const u32x4 v, float (&f)[8]) {
#pragma unroll
    for (int w = 0; w < 4; ++w) { f[2 * w] = __uint_as_float(v[w] << 16); f[2 * w + 1] = __uint_as_float(v[w] & 0xffff0000u); }
}
PF void sc_mix(const KC& k, int j) {
    const int tid = TID(), lane = tid & 63, wave = tid >> 6;
    const bf16_t* P = (const bf16_t*)(k.ws + AR_PB);
    bf16_t* U = (bf16_t*)(k.ws + AR_UBUF);
    const float* cw = k.sc_conv + (size_t)j * 3 * 1024;
    const int c0 = lane * 16;
    float k0[16], k1[16], k2[16];
#pragma unroll
    for (int e = 0; e < 16; ++e) { k0[e] = cw[c0 + e]; k1[e] = cw[1024 + c0 + e]; k2[e] = cw[2048 + c0 + e]; }
    for (int r = blockIdx.x * 8 + wave; r < T; r += gridDim.x * 8) {
        bool lok, rok;
        if (r < TC) { const int t = r & 255; lok = t != 0; rok = t != 255; } else { const int t = (r - TC) & 63; lok = t != 0; rok = t != 63; }
        const bf16_t* p = P + (size_t)r * 3072 + c0;
        const bf16_t* pl = lok ? p - 3072 : p; const bf16_t* pr = rok ? p + 3072 : p;
        u32x4 vb[2], vc[2], vx[2], vcl[2], vxl[2], vcr[2], vxr[2];
#pragma unroll
        for (int hh = 0; hh < 2; ++hh) {
            vb[hh] = *(const u32x4*)(p + hh * 8); vc[hh] = *(const u32x4*)(p + 1024 + hh * 8); vx[hh] = *(const u32x4*)(p + 2048 + hh * 8);
            vcl[hh] = *(const u32x4*)(pl + 1024 + hh * 8); vxl[hh] = *(const u32x4*)(pl + 2048 + hh * 8);
            vcr[hh] = *(const u32x4*)(pr + 1024 + hh * 8); vxr[hh] = *(const u32x4*)(pr + 2048 + hh * 8);
        }
        asm volatile("" ::: "memory");
        const float fl = lok ? 1.f : 0.f, frr = rok ? 1.f : 0.f;
#pragma unroll
        for (int hh = 0; hh < 2; ++hh) {
            float bg[8], cg[8], xi[8], cl[8], xl[8], cr[8], xr[8];
            unpack8(vb[hh], bg); unpack8(vc[hh], cg); unpack8(vx[hh], xi); unpack8(vcl[hh], cl); unpack8(vxl[hh], xl); unpack8(vcr[hh], cr); unpack8(vxr[hh], xr);
            u32x4 o;
#pragma unroll
            for (int w = 0; w < 4; ++w) {
                float ov[2];
#pragma unroll
                for (int e = 0; e < 2; ++e) { const int i = 2 * w + e, c = hh * 8 + i; ov[e] = bg[i] * (k0[c] * fl * cl[i] * xl[i] + k1[c] * cg[i] * xi[i] + k2[c] * frr * cr[i] * xr[i]); }
                o[w] = pk2(ov[0], ov[1]);
            }
            *(u32x4*)(U + (size_t)r * 1024 + c0 + hh * 8) = o;
        }
    }
}

constexpr int DN_STEPS = 260, DN_UNITS = 32 * DN_STEPS;
DI int dn_rbase(int b, int dir, int s) {
    if (s < 4) return dir == 0 ? b * 256 + s * 64 : b * 256 + 255 - s * 64;
    const int cc = s - 4;
    return dir == 0 ? TC + b * SEQ + cc * 64 : TC + b * SEQ + SEQ - 1 - cc * 64;
}
struct DnRaw { u32x4 c[3][2], l[3][2], r[3][2]; float g, be; };
DI void dn_raw_load(const bf16_t* P, const float* gb, int u, int tid, DnRaw& R) {
    const int chain = u / DN_STEPS, s = u - chain * DN_STEPS, dir = chain & 1, h = (chain >> 1) & 7, b = chain >> 4;
    const int rbase = dn_rbase(b, dir, s), rstep = dir == 0 ? 1 : -1;
    const int i = tid >> 3, sg = tid & 7, r = rbase + rstep * i;
    bool lok, rok;
    if (r < TC) { const int t = r & 255; lok = t != 0; rok = t != 255; } else { const int t = (r - TC) & 63; lok = t != 0; rok = t != 63; }
#pragma unroll
    for (int part = 0; part < 3; ++part) {
        const bf16_t* pc = P + (size_t)r * 3072 + part * 1024 + h * 128 + sg * 16;
#pragma unroll
        for (int hf = 0; hf < 2; ++hf) {
            R.c[part][hf] = *(const u32x4*)(pc + hf * 8);
            R.l[part][hf] = (u32x4){0u, 0u, 0u, 0u}; R.r[part][hf] = (u32x4){0u, 0u, 0u, 0u};
            if (lok) R.l[part][hf] = *(const u32x4*)(pc - 3072 + hf * 8);
            if (rok) R.r[part][hf] = *(const u32x4*)(pc + 3072 + hf * 8);
        }
    }
    if (tid < 64) { const size_t row = (size_t)(rbase + rstep * tid); R.g = gb[row * 32 + dir * 8 + h]; R.be = gb[row * 32 + 16 + dir * 8 + h]; }
}
PF void dn_chunk(const KC& k, int jl, LAS unsigned char* lds) {
    const int tid = TID(), lane = tid & 63, wave = tid >> 6, fr = lane & 15, fq = lane >> 4;
    LAS bf16_t* Kt = (LAS bf16_t*)lds;
    LAS bf16_t* Qt = Kt + 64 * 136;
    LAS bf16_t* Vt = Qt + 64 * 136;
    LAS float* Amat = (LAS float*)(Vt + 64 * 136);
    LAS bf16_t* Tb = (LAS bf16_t*)(Amat + 64 * 64);
    LAS bf16_t* VbT = Tb + 64 * 72;
    LAS bf16_t* KbT = VbT + 128 * 72;
    LAS float* gcs = (LAS float*)(KbT + 128 * 72);
    LAS float* bet = gcs + 64; LAS float* eg = bet + 64; LAS float* egr = eg + 64;
    LAS float* Tm = egr + 64;
    const bf16_t* P = (const bf16_t*)(k.ws + AR_PB);
    const float* gb = (const float*)(k.ws + WS_GB);
    const float* cw = k.dn_conv + (size_t)jl * 3 * 3072;
    bf16_t* CH = (bf16_t*)(k.ws + AR_CHUNK);
    bf16_t* ATT = (bf16_t*)(k.ws + AR_HBUF);
    float* EGL = (float*)(k.ws + WS_EGL);
    for (int u = blockIdx.x; u < DN_UNITS; u += gridDim.x) {
        DnRaw Rn; dn_raw_load(P, gb, u, tid, Rn);
        const int chain = u / DN_STEPS, s = u - chain * DN_STEPS, dir = chain & 1, h = (chain >> 1) & 7, b = chain >> 4;
        const int rbase = dn_rbase(b, dir, s), rstep = dir == 0 ? 1 : -1;
        bf16_t* cW = CH + (size_t)u * 32768; bf16_t* cQd = cW + 8192; bf16_t* cKd = cQd + 8192; bf16_t* cU = cKd + 8192;
        bf16_t* cAt = ATT + (size_t)u * 4096;
        lds_barrier();
        const float g_in = Rn.g, be_in = Rn.be;
        {
            const int i = tid >> 3, sg = tid & 7;
#pragma unroll
            for (int part = 0; part < 3; ++part) {
                const int col = part * 1024 + h * 128 + sg * 16;
                float v[16];
#pragma unroll
                for (int hf = 0; hf < 2; ++hf) {
                    const u32x4 c4 = Rn.c[part][hf], l4 = Rn.l[part][hf], r4 = Rn.r[part][hf];
#pragma unroll
                    for (int w2 = 0; w2 < 2; ++w2) {
                        const int cc = col + hf * 8 + 4 * w2;
                        const f32x4 k0 = *(const f32x4*)(cw + cc), k1 = *(const f32x4*)(cw + 3072 + cc), k2 = *(const f32x4*)(cw + 6144 + cc);
#pragma unroll
                        for (int e = 0; e < 4; ++e) {
                            const int w = 2 * w2 + (e >> 1);
                            const float lv = __uint_as_float((e & 1) ? (l4[w] & 0xffff0000u) : (l4[w] << 16));
                            const float cv = __uint_as_float((e & 1) ? (c4[w] & 0xffff0000u) : (c4[w] << 16));
                            const float rv = __uint_as_float((e & 1) ? (r4[w] & 0xffff0000u) : (r4[w] << 16));
                            v[hf * 8 + 4 * w2 + e] = siluf(k0[e] * lv + k1[e] * cv + k2[e] * rv);
                        }
                    }
                }
                if (part < 2) {
                    float ss = 0.f;
#pragma unroll
                    for (int e = 0; e < 16; ++e) ss += v[e] * v[e];
                    ss += shx(ss, 1, lane); ss += shx(ss, 2, lane); ss += shx(ss, 4, lane);
                    const float sc = rsqrtf(ss + EPS) * (part == 0 ? 0.08838834764831845f : 1.0f);
#pragma unroll
                    for (int e = 0; e < 16; ++e) v[e] *= sc;
                }
                LAS bf16_t* dst = (part == 0 ? Qt : (part == 1 ? Kt : Vt)) + i * 136 + sg * 16;
                u32x4 o0, o1;
#pragma unroll
                for (int w = 0; w < 4; ++w) { o0[w] = pk2(v[2 * w], v[2 * w + 1]); o1[w] = pk2(v[8 + 2 * w], v[8 + 2 * w + 1]); }
                *(LAS u32x4*)dst = o0; *(LAS u32x4*)(dst + 8) = o1;
            }
        }
        if (wave == 0) {
            float g = g_in;
            const float be = be_in;
#pragma unroll
            for (int d = 1; d < 64; d <<= 1) { const float o = shi(g, (lane - d) & 63); if (lane >= d) g += o; }
            const float glast = shi(g, 63);
            gcs[lane] = g; bet[lane] = be; eg[lane] = expf(g); egr[lane] = expf(glast - g);
            if (lane == 0) EGL[u] = expf(glast);
        }
        lds_barrier();
#pragma unroll 1
        for (int x = 0; x < 4; ++x) {
            const int t = wave + 8 * x, isq = t >> 4, mt = (t >> 2) & 3, nt = t & 3;
            f32x4 acc = (f32x4){0.f, 0.f, 0.f, 0.f};
            const int jc = 16 * nt + fr;
            float gi4[4], bi4[4];
            const float gj = gcs[jc];
#pragma unroll
            for (int jj = 0; jj < 4; ++jj) { gi4[jj] = gcs[16 * mt + 4 * fq + jj]; bi4[jj] = bet[16 * mt + 4 * fq + jj]; }
            if (mt >= nt) {
                const LAS bf16_t* Ar = (isq ? Qt : Kt) + (16 * mt + fr) * 136 + 8 * fq;
                const LAS bf16_t* Br = Kt + (16 * nt + fr) * 136 + 8 * fq;
                bf16x8 fa4[4], fb4[4];
#pragma unroll
                for (int ks = 0; ks < 4; ++ks) { fa4[ks] = *(const LAS bf16x8*)(Ar + 32 * ks); fb4[ks] = *(const LAS bf16x8*)(Br + 32 * ks); }
                asm volatile("" ::: "memory");
#pragma unroll
                for (int ks = 0; ks < 4; ++ks) acc = __builtin_amdgcn_mfma_f32_16x16x32_bf16(fa4[ks], fb4[ks], acc, 0, 0, 0);
            }
#pragma unroll
            for (int jj = 0; jj < 4; ++jj) {
                const int ir = 16 * mt + 4 * fq + jj;
                const float dec = __expf(fminf(gi4[jj] - gj, 0.f));
                if (isq) cAt[ir * 64 + jc] = f2bf(ir >= jc ? acc[jj] * dec : 0.f);
                else Amat[ir * 64 + jc] = ir > jc ? bi4[jj] * acc[jj] * dec : 0.f;
            }
        }
        lds_barrier();
        {
        if (wave < 4) {
            if (lane < 16) {
                const int bo = 16 * wave;
                float tc[16];
#pragma unroll
                for (int i = 0; i < 16; ++i) {
                    f32x4 ar[4];
#pragma unroll
                    for (int q = 0; q < (i + 3) / 4; ++q) ar[q] = *(const LAS f32x4*)(Amat + (bo + i) * 64 + bo + 4 * q);
                    float a0 = (i == lane) ? 1.f : 0.f, a1 = 0.f;
#pragma unroll
                    for (int j = 0; j < i; ++j) { const float av = ar[j >> 2][j & 3]; if (j & 1) a1 -= av * tc[j]; else a0 -= av * tc[j]; }
                    tc[i] = a0 + a1;
                    Tm[(bo + i) * 64 + bo + lane] = tc[i];
                }
            }
        } else {
            for (int it = tid - 256; it < 1024; it += 256) {
                const int c = it & 127, ig = it >> 7;
                float kv[8], vv[8];
                { bf16_t kr[8], vr[8];
#pragma unroll
                  for (int e = 0; e < 8; ++e) { kr[e] = Kt[(8 * ig + e) * 136 + c]; vr[e] = Vt[(8 * ig + e) * 136 + c]; }
                  asm volatile("" ::: "memory");
#pragma unroll
                  for (int e = 0; e < 8; ++e) { kv[e] = bf2f(kr[e]); vv[e] = bf2f(vr[e]); } }
                u32x4 ov, ok, od;
#pragma unroll
                for (int w = 0; w < 4; ++w) {
                    const int i0 = 8 * ig + 2 * w, i1 = i0 + 1;
                    ov[w] = pk2(bet[i0] * vv[2 * w], bet[i1] * vv[2 * w + 1]);
                    ok[w] = pk2(bet[i0] * eg[i0] * kv[2 * w], bet[i1] * eg[i1] * kv[2 * w + 1]);
                    od[w] = pk2(egr[i0] * kv[2 * w], egr[i1] * kv[2 * w + 1]);
                }
                *(LAS u32x4*)(VbT + c * 72 + 8 * ig) = ov;
                *(LAS u32x4*)(KbT + c * 72 + 8 * ig) = ok;
                *(u32x4*)(cKd + c * 64 + 8 * ig) = od;
            }
            for (int it = tid - 256; it < 1024; it += 256) {
                const int i = it >> 4, c8 = (it & 15) * 8; const float e = eg[i];
                const u32x4 qv = *(const LAS u32x4*)(Qt + i * 136 + c8); u32x4 o;
#pragma unroll
                for (int w = 0; w < 4; ++w) o[w] = pk2(__uint_as_float(qv[w] << 16) * e, __uint_as_float(qv[w] & 0xffff0000u) * e);
                *(u32x4*)(cQd + i * 128 + c8) = o;
            }
        }
        lds_barrier();
#pragma unroll 1
        for (int d = 1; d < 4; ++d) {
            if (wave < 4 - d) {
                const int bi = wave + d, bj = wave, r = lane >> 2, c0 = 4 * (lane & 3);
                f32x4 m = (f32x4){0.f, 0.f, 0.f, 0.f};
                for (int kb = bj; kb < bi; ++kb) {
                    f32x4 av4[4], tv[16];
#pragma unroll
                    for (int q = 0; q < 4; ++q) av4[q] = *(const LAS f32x4*)(Amat + (16 * bi + r) * 64 + 16 * kb + 4 * q);
#pragma unroll
                    for (int kk = 0; kk < 16; ++kk) tv[kk] = *(const LAS f32x4*)(Tm + (16 * kb + kk) * 64 + 16 * bj + c0);
                    asm volatile("" ::: "memory");
#pragma unroll
                    for (int kk = 0; kk < 16; ++kk) m += tv[kk] * av4[kk >> 2][kk & 3];
                }
                *(LAS f32x4*)(Tm + (16 * bj + r) * 64 + 16 * bi + c0) = m;
                f32x4 t = (f32x4){0.f, 0.f, 0.f, 0.f};
                {
                    f32x4 dv4[4], mv[16];
#pragma unroll
                    for (int q = 0; q < 4; ++q) dv4[q] = *(const LAS f32x4*)(Tm + (16 * bi + r) * 64 + 16 * bi + 4 * q);
#pragma unroll
                    for (int kk = 0; kk < 16; ++kk) mv[kk] = *(const LAS f32x4*)(Tm + (16 * bj + kk) * 64 + 16 * bi + c0);
                    asm volatile("" ::: "memory");
#pragma unroll
                    for (int kk = 0; kk < 16; ++kk) t -= mv[kk] * dv4[kk >> 2][kk & 3];
                }
                *(LAS f32x4*)(Tm + (16 * bi + r) * 64 + 16 * bj + c0) = t;
            }
            lds_barrier();
        }
        for (int it = tid; it < 64 * 8; it += NTHR) {
            const int i = it >> 3, c8 = (it & 7) * 8; u32x4 o;
#pragma unroll
            for (int w = 0; w < 4; ++w) {
                const int c = c8 + 2 * w;
                o[w] = pk2(c <= i ? Tm[i * 64 + c] : 0.f, c + 1 <= i ? Tm[i * 64 + c + 1] : 0.f);
            }
            *(LAS u32x4*)(Tb + i * 72 + c8) = o;
        }
        }
        lds_barrier();
        {
            f32x4 au[4], aw[4];
#pragma unroll
            for (int mt = 0; mt < 4; ++mt) { au[mt] = (f32x4){0.f, 0.f, 0.f, 0.f}; aw[mt] = (f32x4){0.f, 0.f, 0.f, 0.f}; }
            bf16x8 bv[2], bk[2], at[2][4];
#pragma unroll
            for (int ks = 0; ks < 2; ++ks) {
                bv[ks] = *(const LAS bf16x8*)(VbT + (16 * wave + fr) * 72 + 32 * ks + 8 * fq);
                bk[ks] = *(const LAS bf16x8*)(KbT + (16 * wave + fr) * 72 + 32 * ks + 8 * fq);
#pragma unroll
                for (int mt = 0; mt < 4; ++mt) at[ks][mt] = *(const LAS bf16x8*)(Tb + (16 * mt + fr) * 72 + 32 * ks + 8 * fq);
            }
            asm volatile("" ::: "memory");
#pragma unroll
            for (int ks = 0; ks < 2; ++ks)
#pragma unroll
                for (int mt = 0; mt < 4; ++mt) {
                    au[mt] = __builtin_amdgcn_mfma_f32_16x16x32_bf16(at[ks][mt], bv[ks], au[mt], 0, 0, 0);
                    aw[mt] = __builtin_amdgcn_mfma_f32_16x16x32_bf16(at[ks][mt], bk[ks], aw[mt], 0, 0, 0);
                }
#pragma unroll
            for (int mt = 0; mt < 4; ++mt)
#pragma unroll
                for (int jj = 0; jj < 4; ++jj) {
                    const int ir = 16 * mt + 4 * fq + jj, c = 16 * wave + fr;
                    cU[ir * 128 + c] = f2bf(au[mt][jj]); cW[ir * 128 + c] = f2bf(aw[mt][jj]);
                }
        }
    }
}
constexpr int SC_W = 0, SC_QD = 64 * 136, SC_KD = SC_QD + 64 * 136, SC_AT = SC_KD + 128 * 72, SC_U = SC_AT + 64 * 72, SC_EGL = SC_U + 16 * 72, SC_STAGE = SC_EGL + 8;
struct ScanRegs { u32x4 v[8]; u32x4 u[2]; };
DI void dn_scan_fetch(const bf16_t* CH, const bf16_t* ATT, int u, int sl, int wv, int lane, ScanRegs& R) {
    const bf16_t* cW = CH + (size_t)u * 32768;
    const bf16_t* src = (wv < 6) ? cW + wv * 4096 + lane * 8 : ATT + (size_t)u * 4096 + lane * 8;
#pragma unroll
    for (int q = 0; q < 8; ++q) R.v[q] = *(const u32x4*)(src + q * 512);
    if (wv == 6) {
#pragma unroll
        for (int qq = 0; qq < 2; ++qq) { const int pid = lane + 64 * qq; R.u[qq] = *(const u32x4*)(cW + 24576 + (pid >> 1) * 128 + sl * 16 + (pid & 1) * 8); }
    }
}
DI void dn_scan_put(LAS bf16_t* st, int wv, int lane, const ScanRegs& R) {
    LAS bf16_t* dst; int qs;
    if (wv < 4) { dst = st + ((wv < 2) ? SC_W : SC_QD) + ((wv & 1) * 32 + (lane >> 4)) * 136 + (lane & 15) * 8; qs = 544; }
    else if (wv < 6) { dst = st + SC_KD + ((wv - 4) * 64 + (lane >> 3)) * 72 + (lane & 7) * 8; qs = 576; }
    else { dst = st + SC_AT + (lane >> 3) * 72 + (lane & 7) * 8; qs = 576; }
#pragma unroll
    for (int q = 0; q < 8; ++q) *(LAS u32x4*)(dst + q * qs) = R.v[q];
    if (wv == 6) {
#pragma unroll
        for (int qq = 0; qq < 2; ++qq) { const int pid = lane + 64 * qq, i = pid >> 1, hf = pid & 1;
#pragma unroll
            for (int w = 0; w < 4; ++w) { st[SC_U + (hf * 8 + 2 * w) * 72 + i] = (bf16_t)(R.u[qq][w] & 0xffff); st[SC_U + (hf * 8 + 2 * w + 1) * 72 + i] = (bf16_t)(R.u[qq][w] >> 16); } }
    }
}
DI bf16x8 ld2(const LAS bf16_t* p0, const LAS bf16_t* p1) {
    const u32x2 a = *(const LAS u32x2*)p0, b = *(const LAS u32x2*)p1;
    u32x4 r; r[0] = a[0]; r[1] = a[1]; r[2] = b[0]; r[3] = b[1];
    return __builtin_bit_cast(bf16x8, r);
}
DI bf16x8 pk8(f32x4 a, f32x4 b) { u32x4 r; r[0] = pk2(a[0], a[1]); r[1] = pk2(a[2], a[3]); r[2] = pk2(b[0], b[1]); r[3] = pk2(b[2], b[3]); return __builtin_bit_cast(bf16x8, r); }
PF void dn_scan(const KC& k, LAS unsigned char* lds) {
    const int tid = TID(), lane = tid & 63, wave = tid >> 6, fr = lane & 15, fq = lane >> 4;
    LAS bf16_t* ring = (LAS bf16_t*)lds;
    const bf16_t* CH = (const bf16_t*)(k.ws + AR_CHUNK);
    const bf16_t* ATT = (const bf16_t*)(k.ws + AR_HBUF);
    const float* EGL = (const float*)(k.ws + WS_EGL);
    bf16_t* O = (bf16_t*)(k.ws + AR_PB);
    for (int un0 = blockIdx.x; un0 < 256; un0 += gridDim.x) {
        const int un = (gridDim.x == 256) ? ((un0 & 7) * 32 + (un0 >> 3)) : un0;
        const int sl = un & 7, chain = un >> 3, dir = chain & 1, h = (chain >> 1) & 7, b = chain >> 4;
        const int rstep = dir == 0 ? 1 : -1;
        f32x4 S[8];
#pragma unroll
        for (int t = 0; t < 8; ++t) S[t] = (f32x4){0.f, 0.f, 0.f, 0.f};
        LAS float* eglL = (LAS float*)(ring + 2 * SC_STAGE);
        constexpr int NPF = 1;
        ScanRegs R[NPF];
        const int wv = wave - 1;
        lds_barrier();
        if (tid < DN_STEPS) eglL[tid] = EGL[chain * DN_STEPS + tid];
        if (wave > 0) {
            dn_scan_fetch(CH, ATT, chain * DN_STEPS, sl, wv, lane, R[0]); dn_scan_put(ring, wv, lane, R[0]);
#pragma unroll
            for (int q = 0; q < NPF; ++q) dn_scan_fetch(CH, ATT, chain * DN_STEPS + q + 1, sl, wv, lane, R[q]);
        }
        lds_barrier();
#pragma unroll 1
        for (int s4 = 0; s4 < DN_STEPS; s4 += NPF) {
#pragma unroll
          for (int q = 0; q < NPF; ++q) {
            const int s = s4 + q; if (s >= DN_STEPS) break;
            LAS bf16_t* st = ring + (s & 1) * SC_STAGE;
            if (wave > 0) {
                if (s + 1 < DN_STEPS) dn_scan_put(ring + ((s + 1) & 1) * SC_STAGE, wv, lane, R[q]);
                if (s + 1 + NPF < DN_STEPS) dn_scan_fetch(CH, ATT, chain * DN_STEPS + s + 1 + NPF, sl, wv, lane, R[q]);
            } else {
                const float egl = eglL[s];
                bf16x8 sb[4];
#pragma unroll
                for (int ks = 0; ks < 4; ++ks) sb[ks] = pk8(S[2 * ks], S[2 * ks + 1]);
                f32x4 p[4], o[4];
#pragma unroll
                for (int mt = 0; mt < 4; ++mt) { p[mt] = (f32x4){0.f, 0.f, 0.f, 0.f}; o[mt] = (f32x4){0.f, 0.f, 0.f, 0.f}; }
                bf16x8 fw[2][4], fq_[2][4];
#define SC_LOAD_KS(buf, ks) do { _Pragma("unroll") for (int mt = 0; mt < 4; ++mt) { \
                        const LAS bf16_t* wr_ = st + SC_W + (16 * mt + fr) * 136 + 4 * fq + 32 * (ks); const LAS bf16_t* qr_ = st + SC_QD + (16 * mt + fr) * 136 + 4 * fq + 32 * (ks); \
                        fw[buf][mt] = ld2(wr_, wr_ + 16); fq_[buf][mt] = ld2(qr_, qr_ + 16); } } while (0)
#define SC_MMA_KS(buf, ks) do { _Pragma("unroll") for (int mt = 0; mt < 4; ++mt) p[mt] = __builtin_amdgcn_mfma_f32_16x16x32_bf16(fw[buf][mt], sb[ks], p[mt], 0, 0, 0); \
                        _Pragma("unroll") for (int mt = 0; mt < 4; ++mt) o[mt] = __builtin_amdgcn_mfma_f32_16x16x32_bf16(fq_[buf][mt], sb[ks], o[mt], 0, 0, 0); } while (0)
                bf16x8 fa[2][4], fk[2][8];
#define SC_LOAD_KC(kc) do { _Pragma("unroll") for (int mt = 0; mt < 4; ++mt) { const LAS bf16_t* ar_ = st + SC_AT + (16 * mt + fr) * 72 + 4 * fq + 32 * (kc); fa[kc][mt] = ld2(ar_, ar_ + 16); } \
                        _Pragma("unroll") for (int t = 0; t < 8; ++t) { const LAS bf16_t* kr_ = st + SC_KD + (16 * t + fr) * 72 + 4 * fq + 32 * (kc); fk[kc][t] = ld2(kr_, kr_ + 16); } } while (0)
                SC_LOAD_KS(0, 0);
                SC_LOAD_KS(1, 1); asm volatile("" ::: "memory"); SC_MMA_KS(0, 0);
                SC_LOAD_KS(0, 2); asm volatile("" ::: "memory"); SC_MMA_KS(1, 1);
                SC_LOAD_KS(1, 3); asm volatile("" ::: "memory"); SC_MMA_KS(0, 2);
                SC_LOAD_KC(0);    asm volatile("" ::: "memory"); SC_MMA_KS(1, 3);
                u32x2 uu[4];
#pragma unroll
                for (int mt = 0; mt < 4; ++mt) uu[mt] = *(const LAS u32x2*)(st + SC_U + fr * 72 + 16 * mt + 4 * fq);
                SC_LOAD_KC(1);    asm volatile("" ::: "memory");
                bf16x8 vb[2]; f32x4 vn[4];
#pragma unroll
                for (int mt = 0; mt < 4; ++mt) {
                    vn[mt][0] = __uint_as_float(uu[mt][0] << 16) - p[mt][0]; vn[mt][1] = __uint_as_float(uu[mt][0] & 0xffff0000u) - p[mt][1];
                    vn[mt][2] = __uint_as_float(uu[mt][1] << 16) - p[mt][2]; vn[mt][3] = __uint_as_float(uu[mt][1] & 0xffff0000u) - p[mt][3];
                }
                vb[0] = pk8(vn[0], vn[1]); vb[1] = pk8(vn[2], vn[3]);
#pragma unroll
                for (int t = 0; t < 8; ++t) S[t] = S[t] * egl;
#pragma unroll
                for (int kc = 0; kc < 2; ++kc) {
#pragma unroll
                    for (int mt = 0; mt < 4; ++mt) o[mt] = __builtin_amdgcn_mfma_f32_16x16x32_bf16(fa[kc][mt], vb[kc], o[mt], 0, 0, 0);
#pragma unroll
                    for (int t = 0; t < 8; ++t) S[t] = __builtin_amdgcn_mfma_f32_16x16x32_bf16(fk[kc][t], vb[kc], S[t], 0, 0, 0);
                }
#undef SC_LOAD_KS
#undef SC_MMA_KS
#undef SC_LOAD_KC
                const int rbase = dn_rbase(b, dir, s);
#pragma unroll
                for (int mt = 0; mt < 4; ++mt)
#pragma unroll
                    for (int jj = 0; jj < 4; ++jj) {
                        const int row = rbase + rstep * (16 * mt + 4 * fq + jj);
                        O[((size_t)dir * T + row) * 1024 + h * 128 + sl * 16 + fr] = f2bf(o[mt][jj]);
                    }
            }
            lds_barrier();
          }
        }
    }
}
PF void dn_finish(const KC& k, int j) {
    const int tid = TID(), lane = tid & 63, wave = tid >> 6;
    const bf16_t* O = (const bf16_t*)(k.ws + AR_PB);
    const bf16_t* Z = (const bf16_t*)k.out;
    bf16_t* U = (bf16_t*)(k.ws + AR_UBUF);
    const float* on = k.dn_out_norm + j * 128;
    const int c0 = lane * 16;
    float onv[16];
#pragma unroll
    for (int e = 0; e < 16; ++e) onv[e] = on[(c0 + e) & 127];
    for (int r = blockIdx.x * 8 + wave; r < T; r += gridDim.x * 8) {
        u32x4 vf[2], vb[2], vz[2];
#pragma unroll
        for (int hh = 0; hh < 2; ++hh) {
            vf[hh] = *(const u32x4*)(O + (size_t)r * 1024 + c0 + hh * 8); vb[hh] = *(const u32x4*)(O + ((size_t)T + r) * 1024 + c0 + hh * 8);
            vz[hh] = *(const u32x4*)(Z + (size_t)r * 1024 + c0 + hh * 8);
        }
        asm volatile("" ::: "memory");
        float o[16], z[16];
#pragma unroll
        for (int hh = 0; hh < 2; ++hh) { float a[8], b2[8], zz[8]; unpack8(vf[hh], a); unpack8(vb[hh], b2); unpack8(vz[hh], zz);
#pragma unroll
            for (int i = 0; i < 8; ++i) { o[hh * 8 + i] = a[i] + b2[i]; z[hh * 8 + i] = zz[i]; } }
        float ss = 0.f;
#pragma unroll
        for (int e = 0; e < 16; ++e) ss += o[e] * o[e];
        ss += shx(ss, 1, lane); ss += shx(ss, 2, lane); ss += shx(ss, 4, lane);
        const float rs = rsqrtf(ss * (1.0f / 128.0f) + EPS);
#pragma unroll
        for (int hh = 0; hh < 2; ++hh) { u32x4 ov;
#pragma unroll
            for (int w = 0; w < 4; ++w) { const int e0 = hh * 8 + 2 * w; ov[w] = pk2(o[e0] * rs * onv[e0] * siluf(z[e0]), o[e0 + 1] * rs * onv[e0 + 1] * siluf(z[e0 + 1])); }
            *(u32x4*)(U + (size_t)r * 1024 + c0 + hh * 8) = ov; }
    }
}

DI float conv3g(const bf16_t* p, int j, float w0, float w1, float w2) {
    const int gc = j & 63;
    const float l = gc != 0 ? bf2f(p[j - 1]) : 0.f, c = bf2f(p[j]), r = gc != 63 ? bf2f(p[j + 1]) : 0.f;
    return w0 * l + w1 * c + w2 * r;
}
DI float hy_conv_lane(float c, float w0, float w1, float w2, int lane) {
    const float l = shi(c, (lane + 63) & 63), r = shi(c, (lane + 1) & 63);
    return w0 * (lane > 0 ? l : 0.f) + w1 * c + w2 * (lane < 63 ? r : 0.f);
}
PF void hy_lat(const KC& k, int jl, LAS float* ldsf) {
    const int tid = TID();
    LAS cf* X = (LAS cf*)ldsf;
    LAS cf* tw = X + 17408;
    LAS cf* tA = tw + 1024; LAS cf* tB = tA + 128;
    const float* FT = (const float*)(k.ws + AR_FT);
    const bf16_t* PT = (const bf16_t*)(k.ws + AR_PB);
    bf16_t* ZT = (bf16_t*)(k.ws + AR_ZT);
    unsigned* scr = (unsigned*)(k.ws + AR_FFTS) + (size_t)blockIdx.x * 4 * 16384;
    unsigned* sKe = scr; unsigned* sKo = scr + 16384; unsigned* zp = scr + 2 * 16384; unsigned* ye = scr + 3 * 16384;
#define CPK(v) pk2((v).x, (v).y)
#define CUP(u_) ((cf){__uint_as_float((u_) << 16), __uint_as_float((u_) & 0xffff0000u)})
    const float* cw = k.hy_conv + (size_t)jl * 3 * 3072;
    for (int m = 0; m < 2; ++m) { const int p = tid + 512 * m; float sn, cs; sincospif(-(float)p / 8192.0f, &sn, &cs); cf w; w.x = cs; w.y = sn; tw[p] = w; }
    if (tid < 256) { const int a = tid & 127; float sn, cs; sincospif(-(float)(tid < 128 ? 128 * a : a) / 16384.0f, &sn, &cs); cf w; w.x = cs; w.y = sn; (tid < 128 ? tA : tB)[a] = w; }
    __syncthreads();
    const int lane = tid & 63;
#define HY_SPLIT() asm volatile("" ::: "memory")
#define HY_CONV(c, w0, w1, w2) hy_conv_lane((c), (w0), (w1), (w2), lane)
    for (int ch = blockIdx.x; ch < 1024; ch += gridDim.x) {
        {
            const bf16_t* pv = PT + (size_t)ch * T + TC;
            const float w0 = cw[ch], w1 = cw[3072 + ch], w2 = cw[6144 + ch];
            for (int m0 = 0; m0 < 32; m0 += 8) {
                bf16_t a0[8], a1[8];
#pragma unroll
                for (int q = 0; q < 8; ++q) { const int j = tid + 512 * (m0 + q); a0[q] = pv[j]; a1[q] = pv[SEQ + j]; }
                HY_SPLIT();
#pragma unroll
                for (int q = 0; q < 8; ++q) { const int j = tid + 512 * (m0 + q); const float c0 = bf2f(a0[q]), c1 = bf2f(a1[q]); cf z; z.x = HY_CONV(c0, w0, w1, w2); z.y = HY_CONV(c1, w0, w1, w2); zp[j] = CPK(z); }
            }
        }
        for (int n = 0; n < 2; ++n) {
            __syncthreads();
            const float* ftf = FT + (size_t)(n * 2048 + ch) * 16384; const float* ftb = FT + (size_t)(n * 2048 + 1024 + ch) * 16384;
            for (int m0 = 0; m0 < 32; m0 += 8) {
                float hfv[8], hbv[8];
#pragma unroll
                for (int q = 0; q < 8; ++q) { const int j = tid + 512 * (m0 + q); hfv[q] = ftf[j]; hbv[q] = ftb[j > 0 ? SEQ - j : 0]; }
                HY_SPLIT();
#pragma unroll
                for (int q = 0; q < 8; ++q) {
                    const int j = tid + 512 * (m0 + q);
                    const float hf = hfv[q], hb = j > 0 ? hbv[q] : 0.f;
                    const cf w = cmul(tA[j >> 7], tB[j & 127]);
                    cf a; a.x = hf + hb; a.y = 0.f; X[PIDX(j)] = a;
                    const float kd = hf - hb; cf o; o.x = kd * w.x; o.y = kd * w.y; sKo[j] = CPK(o);
                }
            }
            __syncthreads();
            fft16k_fwd(X, tw);
            _Pragma("unroll 8") for (int m = 0; m < 32; ++m) { const int j = tid + 512 * m; const cf t_ = X[PIDX(j)]; sKe[j] = CPK(t_); }
            __syncthreads();
            for (int m0 = 0; m0 < 32; m0 += 8) { unsigned t[8];
#pragma unroll
                for (int q = 0; q < 8; ++q) t[q] = sKo[tid + 512 * (m0 + q)];
                HY_SPLIT();
#pragma unroll
                for (int q = 0; q < 8; ++q) X[PIDX(tid + 512 * (m0 + q))] = CUP(t[q]); }
            __syncthreads();
            fft16k_fwd(X, tw);
            _Pragma("unroll 8") for (int m = 0; m < 32; ++m) { const int j = tid + 512 * m; const cf t_ = X[PIDX(j)]; sKo[j] = CPK(t_); }
            __syncthreads();
            for (int m0 = 0; m0 < 32; m0 += 8) { unsigned t[8];
#pragma unroll
                for (int q = 0; q < 8; ++q) t[q] = zp[tid + 512 * (m0 + q)];
                HY_SPLIT();
#pragma unroll
                for (int q = 0; q < 8; ++q) X[PIDX(tid + 512 * (m0 + q))] = CUP(t[q]); }
            __syncthreads();
            fft16k_fwd(X, tw);
            for (int m0 = 0; m0 < 32; m0 += 8) { unsigned t[8];
#pragma unroll
                for (int q = 0; q < 8; ++q) t[q] = sKe[tid + 512 * (m0 + q)];
                HY_SPLIT();
#pragma unroll
                for (int q = 0; q < 8; ++q) { const int j = tid + 512 * (m0 + q); X[PIDX(j)] = cmul(X[PIDX(j)], CUP(t[q])); } }
            __syncthreads();
            fft16k_inv(X, tw);
            _Pragma("unroll 8") for (int m = 0; m < 32; ++m) { const int j = tid + 512 * m; const cf t_ = X[PIDX(j)]; ye[j] = CPK(t_); }
            __syncthreads();
            for (int m0 = 0; m0 < 32; m0 += 8) { unsigned t[8];
#pragma unroll
                for (int q = 0; q < 8; ++q) t[q] = zp[tid + 512 * (m0 + q)];
                HY_SPLIT();
#pragma unroll
                for (int q = 0; q < 8; ++q) { const int j = tid + 512 * (m0 + q); const cf w = cmul(tA[j >> 7], tB[j & 127]); X[PIDX(j)] = cmul(CUP(t[q]), w); } }
            __syncthreads();
            fft16k_fwd(X, tw);
            for (int m0 = 0; m0 < 32; m0 += 8) { unsigned t[8];
#pragma unroll
                for (int q = 0; q < 8; ++q) t[q] = sKo[tid + 512 * (m0 + q)];
                HY_SPLIT();
#pragma unroll
                for (int q = 0; q < 8; ++q) { const int j = tid + 512 * (m0 + q); X[PIDX(j)] = cmul(X[PIDX(j)], CUP(t[q])); } }
            __syncthreads();
            fft16k_inv(X, tw);
            {
                const bf16_t* pg = PT + (size_t)((n + 1) * 1024 + ch) * T + TC;
                const int gcol = (n + 1) * 1024 + ch;
                const float w0 = cw[gcol], w1 = cw[3072 + gcol], w2 = cw[6144 + gcol];
                const float bias = k.hy_bias[(size_t)jl * 2 * 1024 + n * 1024 + ch];
                for (int m0 = 0; m0 < 32; m0 += 8) {
                    unsigned te_[8], tz_[8]; bf16_t g0[8], g1[8];
#pragma unroll
                    for (int q = 0; q < 8; ++q) { const int j = tid + 512 * (m0 + q); te_[q] = ye[j]; tz_[q] = zp[j]; g0[q] = pg[j]; g1[q] = pg[SEQ + j]; }
                    HY_SPLIT();
#pragma unroll
                    for (int q = 0; q < 8; ++q) {
                        const int j = tid + 512 * (m0 + q);
                        cf w = cmul(tA[j >> 7], tB[j & 127]); w.y = -w.y;
                        const cf yo = cmul(X[PIDX(j)], w);
                        const cf te = CUP(te_[q]), tz = CUP(tz_[q]);
                        const float y0 = (0.5f / 16384.0f) * (te.x + yo.x), y1 = (0.5f / 16384.0f) * (te.y + yo.y);
                        const float c0 = bf2f(g0[q]), c1 = bf2f(g1[q]);
                        cf zn; zn.x = HY_CONV(c0, w0, w1, w2) * (y0 + bias * tz.x); zn.y = HY_CONV(c1, w0, w1, w2) * (y1 + bias * tz.y);
                        zp[j] = CPK(zn);
                    }
                }
            }
        }
        for (int m0 = 0; m0 < 32; m0 += 8) { unsigned t[8];
#pragma unroll
            for (int q = 0; q < 8; ++q) t[q] = zp[tid + 512 * (m0 + q)];
            HY_SPLIT();
#pragma unroll
            for (int q = 0; q < 8; ++q) { const int j = tid + 512 * (m0 + q); ZT[(size_t)ch * T + TC + j] = (bf16_t)(t[q] & 0xffffu); ZT[(size_t)ch * T + TC + SEQ + j] = (bf16_t)(t[q] >> 16); } }
        __syncthreads();
    }
#undef CPK
#undef CUP
#undef HY_SPLIT
#undef HY_CONV
}
PF void hy_ctx(const KC& k, int jl, LAS float* lds) {
    const int tid = TID(), t = tid & 255, hsel = tid >> 8;
    LAS float* z = lds + hsel * 768; LAS float* hf = z + 256; LAS float* hb = hf + 256;
    const bf16_t* PT = (const bf16_t*)(k.ws + AR_PB);
    bf16_t* U = (bf16_t*)(k.ws + AR_UBUF);
    const float* filtc = (const float*)(k.ws + WS_FILTC);
    const float* cw = k.hy_conv + (size_t)jl * 3 * 3072;
    for (int u = blockIdx.x; u < 1024; u += gridDim.x) {
        const int pr = u * 2 + hsel, b = pr >> 10, ch = pr & 1023;
        float zc;
        {
            const bf16_t* pv = PT + (size_t)ch * T + b * 256;
            const float l = t != 0 ? bf2f(pv[t - 1]) : 0.f, c = bf2f(pv[t]), r = t != 255 ? bf2f(pv[t + 1]) : 0.f;
            zc = cw[ch] * l + cw[3072 + ch] * c + cw[6144 + ch] * r;
        }
        for (int n = 0; n < 2; ++n) {
            __syncthreads();
            z[t] = zc; hf[t] = filtc[(size_t)t * 4096 + n * 2048 + ch]; hb[t] = filtc[(size_t)t * 4096 + n * 2048 + 1024 + ch];
            __syncthreads();
            float y = 0.f;
            for (int s = 0; s <= t; ++s) y += hf[t - s] * z[s];
            for (int s = t + 1; s < 256; ++s) y += hb[s - t] * z[s];
            const int gcol = (n + 1) * 1024 + ch;
            const bf16_t* pg = PT + (size_t)gcol * T + b * 256;
            const float l = t != 0 ? bf2f(pg[t - 1]) : 0.f, c = bf2f(pg[t]), r = t != 255 ? bf2f(pg[t + 1]) : 0.f;
            const float gate = cw[gcol] * l + cw[3072 + gcol] * c + cw[6144 + gcol] * r;
            zc = gate * (y + k.hy_bias[(size_t)jl * 2048 + n * 1024 + ch] * zc);
        }
        U[(size_t)(b * 256 + t) * 1024 + ch] = f2bf(zc);
        __syncthreads();
    }
}
PF void hy_transpose(const KC& k, LAS bf16_t* lds) {
    const int tid = TID();
    const bf16_t* ZT = (const bf16_t*)(k.ws + AR_ZT);
    bf16_t* U = (bf16_t*)(k.ws + AR_UBUF);
    for (int u = blockIdx.x; u < 16 * (TL / 64); u += gridDim.x) {
        const int c0 = (u & 15) * 64, r0 = TC + (u >> 4) * 64;
        { const int c = tid >> 3, sg = (tid & 7) * 8;
          const u32x4 v = *(const u32x4*)(ZT + (size_t)(c0 + c) * T + r0 + sg);
#pragma unroll
          for (int w = 0; w < 4; ++w) { lds[(sg + 2 * w) * 66 + c] = (bf16_t)(v[w] & 0xffff); lds[(sg + 2 * w + 1) * 66 + c] = (bf16_t)(v[w] >> 16); } }
        __syncthreads();
        { const int r = tid >> 3, sg = (tid & 7) * 8; u32x4 o;
#pragma unroll
          for (int w = 0; w < 4; ++w) o[w] = (unsigned)lds[r * 66 + sg + 2 * w] | ((unsigned)lds[r * 66 + sg + 2 * w + 1] << 16);
          *(u32x4*)(U + (size_t)(r0 + r) * 1024 + c0 + sg) = o; }
        __syncthreads();
    }
}

__global__ void __launch_bounds__(NTHR, 2) fwd_kernel(Params prm) {
    extern __shared__ __attribute__((aligned(16))) unsigned char lds_raw[];
    LAS unsigned char* lds = (LAS unsigned char*)lds_raw;
    LAS float* ldsf = (LAS float*)lds;
    LAS bf16_t* ldsh = (LAS bf16_t*)lds;
    LAS int* tb = (LAS int*)(lds + 150 * 1024);
    volatile LAS unsigned* xbw = (volatile LAS unsigned*)(lds + 151 * 1024 + 512);
    KC k;
    k.x = (const float*)(GAS const float*)prm.in[0]; k.c = (const float*)(GAS const float*)prm.in[1]; k.ctx = (const float*)(GAS const float*)prm.in[2]; k.c_ctx = (const float*)(GAS const float*)prm.in[3]; k.ada_w = (const float*)(GAS const float*)prm.in[4]; k.ada_b = (const float*)(GAS const float*)prm.in[5];
    k.norm_mix = (const float*)(GAS const float*)prm.in[6]; k.norm_ffn = (const float*)(GAS const float*)prm.in[7]; k.norm_final = (const float*)(GAS const float*)prm.in[8];
    k.dn_w_in = (const float*)(GAS const float*)prm.in[9]; k.dn_conv = (const float*)(GAS const float*)prm.in[10]; k.dn_a_log = (const float*)(GAS const float*)prm.in[11]; k.dn_dt_bias = (const float*)(GAS const float*)prm.in[12]; k.dn_out_norm = (const float*)(GAS const float*)prm.in[13]; k.dn_w_out = (const float*)(GAS const float*)prm.in[14];
    k.hy_w_in = (const float*)(GAS const float*)prm.in[15]; k.hy_conv = (const float*)(GAS const float*)prm.in[16]; k.hy_f_w1 = (const float*)(GAS const float*)prm.in[17]; k.hy_f_b1 = (const float*)(GAS const float*)prm.in[18]; k.hy_f_freq = (const float*)(GAS const float*)prm.in[19]; k.hy_f_w2 = (const float*)(GAS const float*)prm.in[20];
    k.hy_f_b2 = (const float*)(GAS const float*)prm.in[21]; k.hy_f_w3 = (const float*)(GAS const float*)prm.in[22]; k.hy_bias = (const float*)(GAS const float*)prm.in[23]; k.hy_w_out = (const float*)(GAS const float*)prm.in[24];
    k.sc_w_in = (const float*)(GAS const float*)prm.in[25]; k.sc_conv = (const float*)(GAS const float*)prm.in[26]; k.sc_w_out = (const float*)(GAS const float*)prm.in[27]; k.w_router = (const float*)(GAS const float*)prm.in[28]; k.router_bias = (const float*)(GAS const float*)prm.in[29];
    k.moe_w_gate = (const float*)(GAS const float*)prm.in[30]; k.moe_w_up = (const float*)(GAS const float*)prm.in[31]; k.moe_w_down = (const float*)(GAS const float*)prm.in[32];
    k.out = (float*)(GAS float*)prm.out; k.ws = (unsigned char*)(GAS unsigned char*)prm.ws;
    const int lo = prm.ph_lo, hi = prm.ph_hi;
    XcdBarrier bar; bar.bar = (unsigned*)(k.ws + WS_CTL); bar.x = 0; bar.st = xbw;
    if (hi - lo > 1) {
        if (threadIdx.x == 0) { xbw[0] = 0u; xbw[1] = 0u; }
        __syncthreads();
        bar = xcd_barrier_post((unsigned*)(k.ws + WS_CTL), xbw);
    }
    int ph = 0;
#define PROBE_OK(id) ((id) != 1 || i == 0)
    int i = 0;
#define PH_BEGIN(id) if (ph >= lo && ph < hi) { const int nrep_ = (((id) == PROBE_REP) && PROBE_OK(id)) ? 2 : 1; for (int rep_ = 0; rep_ < nrep_; ++rep_) { { GAS unsigned char* w_ = (GAS unsigned char*)k.ws; asm volatile("" : "+s"(w_)); k.ws = (unsigned char*)w_; }
#define PH_END   if (ph + 1 < hi) xcd_barrier(bar); } } ++ph;

    float* xs = (float*)(k.ws + WS_XS);
    const float* mod = (const float*)(k.ws + WS_MOD);

    PH_BEGIN(0)
        job_mod(k, ldsf);
        job_cvt_small(k, ldsf);
        job_hdn(k, ldsf);
        job_w3s(k);
    PH_END

    for (i = 0; i < DEPTH; ++i) {
        const int kind = i % 3, j = i / 3;
        const bool last = (i == DEPTH - 1);
        PH_BEGIN(1)
            if (kind == 0) norm_phase<2>(k, i, i == 0, i > 0, k.norm_mix + i * 1024, 0, k.dn_w_in + (size_t)j * 1024 * DN_IN + 4096, DN_IN,
                                         k.dn_a_log + j * 16, k.dn_dt_bias + j * 16, last, ldsf);
            else norm_phase<0>(k, i, i == 0, i > 0, k.norm_mix + i * 1024, 0, nullptr, 0, nullptr, nullptr, last, ldsf);
            if (kind == 1) job_filtc(k, j);
        PH_END
        PH_BEGIN(2)
            if (kind == 0) { EpiBf16 e{(bf16_t*)(k.ws + AR_PB), 3072, 3072, (bf16_t*)k.out, 1024}; gemm_dense(lds, (const bf16_t*)(k.ws + AR_HBUF), T, (const bf16_t*)(k.ws + WS_DNWIN) + (size_t)j * 4096 * 1024, 4096, 1024, e); }
            else if (kind == 1) { EpiBf16T e{(bf16_t*)(k.ws + AR_PB), T}; gemm_dense(lds, (const bf16_t*)(k.ws + AR_HBUF), T, (const bf16_t*)(k.ws + WS_HYWIN), 3072, 1024, e);
                                  EpiTaps et{(float*)(k.ws + AR_FT)}; gemm_dense(lds, (const bf16_t*)(k.ws + WS_W3S), 4096, (const bf16_t*)(k.ws + WS_HS), 16384, 256, et); }
            else { EpiBf16 e{(bf16_t*)(k.ws + AR_PB), 3072, 1 << 30, nullptr, 0}; gemm_dense(lds, (const bf16_t*)(k.ws + AR_HBUF), T, (const bf16_t*)(k.ws + WS_SCWIN), 3072, 1024, e); }
        PH_END
        if (kind == 0) {
            PH_BEGIN(3) dn_chunk(k, j, lds); PH_END
            PH_BEGIN(4) dn_scan(k, lds); PH_END
            PH_BEGIN(5) dn_finish(k, j); PH_END
        } else if (kind == 1) {
            PH_BEGIN(6) hy_lat(k, j, ldsf); hy_ctx(k, j, ldsf); PH_END
            PH_BEGIN(7) hy_transpose(k, ldsh); PH_END
        } else {
            PH_BEGIN(8) sc_mix(k, j); PH_END
        }
        PH_BEGIN(9)
            const bf16_t* Wt = kind == 0 ? (const bf16_t*)(k.ws + WS_DNWOUT) + (size_t)j * 1024 * 1024 : (kind == 1 ? (const bf16_t*)(k.ws + WS_HYWOUT) : (const bf16_t*)(k.ws + WS_SCWOUT));
            EpiResid e{xs, mod, i, 2};
            gemm_dense(lds, (const bf16_t*)(k.ws + AR_UBUF), T, Wt, 1024, 1024, e);
        PH_END
        PH_BEGIN(10)
            norm_phase<1>(k, i, false, false, k.norm_ffn + i * 1024, 3, k.w_router, 32, k.router_bias, nullptr, last, ldsf, rep_ == nrep_ - 1);
        PH_END
        PH_BEGIN(11)
            if (rep_ == 0) moe_scatter(k, i, tb);
            job_cvt_moe(k, i, ldsf);
        PH_END
        PH_BEGIN(12) moe_gemm<0>(k, i, lds, tb); PH_END
        PH_BEGIN(13) moe_gemm<1>(k, i, lds, tb); PH_END
    }
    PH_BEGIN(14)
        norm_phase<3>(k, DEPTH, false, true, k.norm_final, 0, nullptr, 0, nullptr, nullptr, false, ldsf);
    PH_END
#undef PH_BEGIN
#undef PH_END
}
constexpr int N_PHASES = 1 + (10 + 9 + 8 + 10) + 1;

extern "C" void kernel_launch(void* const* d_in, const int* in_sizes, int n_in, void* d_out, int out_size, void* d_ws, size_t ws_size, hipStream_t stream) {
    static int grid = 0;
    if (grid == 0) {
        if (n_in != 33 || out_size != TL * D || ws_size < WS_END) { fprintf(stderr, "kernel_launch: unexpected shapes: n_in %d out %d ws %zu (need %zu)\n", n_in, out_size, ws_size, (size_t)WS_END); grid = -1; return; }
        int dev = 0, cus = 0, per_cu = 0;
        if (hipGetDevice(&dev) != hipSuccess || hipDeviceGetAttribute(&cus, hipDeviceAttributeMultiprocessorCount, dev) != hipSuccess) { grid = -1; return; }
        if (hipFuncSetAttribute((const void*)fwd_kernel, hipFuncAttributeMaxDynamicSharedMemorySize, LDS_BYTES) != hipSuccess) { fprintf(stderr, "kernel_launch: hipFuncSetAttribute failed\n"); grid = -1; return; }
        if (hipOccupancyMaxActiveBlocksPerMultiprocessor(&per_cu, (const void*)fwd_kernel, NTHR, LDS_BYTES) != hipSuccess || per_cu < 1) fprintf(stderr, "kernel_launch: occupancy query reports %d\n", per_cu);
        (void)hipGetLastError();
        grid = cus;
    }
    if (grid < 0) return;
    (void)hipMemsetAsync((char*)d_ws + WS_CTL, 0, CTL_BYTES, stream);
    Params p{};
    for (int i = 0; i < 33; ++i) p.in[i] = (const float*)d_in[i];
    p.out = (float*)d_out; p.ws = (unsigned char*)d_ws;
#if MK_MULTI
    for (int ph = 0; ph < N_PHASES; ++ph) { p.ph_lo = ph; p.ph_hi = ph + 1; hipLaunchKernelGGL(fwd_kernel, dim3(grid), dim3(NTHR), LDS_BYTES, stream, p); }
#else
    p.ph_lo = 0; p.ph_hi = N_PHASES;
    hipLaunchKernelGGL(fwd_kernel, dim3(grid), dim3(NTHR), LDS_BYTES, stream, p);
#endif
}
```

```cpp
#include <hip/hip_runtime.h>
#include <stdint.h>
#include <stdio.h>
#include <math.h>

#ifndef MK_MULTI
#define MK_MULTI 0
#endif

#ifndef PROBE_SUB
#define PROBE_SUB (0)
#endif
#ifndef PROBE_REP
#define PROBE_REP (-1)
#endif
#define LAS __attribute__((address_space(3)))
#define GAS __attribute__((address_space(1)))
#define HD __host__ __device__ __forceinline__
#define DI __device__ __forceinline__
#ifdef NOINL
#define PF __device__ __noinline__
#else
#define PF __device__ __forceinline__
#endif
typedef unsigned short bf16_t;
typedef short bf16x8 __attribute__((ext_vector_type(8)));
typedef float f32x4 __attribute__((ext_vector_type(4)));
typedef unsigned u32x4 __attribute__((ext_vector_type(4)));
typedef unsigned u32x2 __attribute__((ext_vector_type(2)));

constexpr int D = 1024, NB = 2, SEQ = 16384, CTXL = 256, DEPTH = 4;
constexpr int TC = NB * CTXL, TL = NB * SEQ, T = TC + TL, NA = 2 * T;
constexpr int NTHR = 512;
constexpr int DN_IN = 4128;
constexpr float EPS = 1e-6f;
constexpr int LDS_BYTES = 152 * 1024;

constexpr size_t AL(size_t x) { return (x + 255) & ~(size_t)255; }
constexpr size_t WS_CTL = 0;
constexpr size_t CTL_BYTES = 65536;
constexpr size_t CTL_CNT = 16384;
constexpr size_t WS_MOD = WS_CTL + CTL_BYTES;
constexpr size_t WS_HS = AL(WS_MOD + 4 * 3 * 6144 * 4);
constexpr size_t WS_W3S = AL(WS_HS + 16384 * 256 * 2);
constexpr size_t WS_HDNC = AL(WS_W3S + 4096 * 256 * 2);
constexpr size_t WS_FILTC = AL(WS_HDNC + 256 * 64 * 4);
constexpr size_t WS_DNWIN = AL(WS_FILTC + 256 * 4096 * 4);
constexpr size_t WS_DNWOUT = AL(WS_DNWIN + (size_t)2 * 4096 * 1024 * 2);
constexpr size_t WS_HYWIN = AL(WS_DNWOUT + (size_t)2 * 1024 * 1024 * 2);
constexpr size_t WS_HYWOUT = AL(WS_HYWIN + (size_t)3072 * 1024 * 2);
constexpr size_t WS_SCWIN = AL(WS_HYWOUT + (size_t)1024 * 1024 * 2);
constexpr size_t WS_SCWOUT = AL(WS_SCWIN + (size_t)3072 * 1024 * 2);
constexpr size_t WS_XS = AL(WS_SCWOUT + (size_t)1024 * 1024 * 2);
constexpr size_t WS_TOKE = AL(WS_XS + (size_t)T * 1024 * 4);
constexpr size_t WS_TOKW = AL(WS_TOKE + (size_t)T * 2 * 4);
constexpr size_t WS_TOKP = AL(WS_TOKW + (size_t)T * 2 * 4);
constexpr size_t WS_SLOT = AL(WS_TOKP + (size_t)T * 2 * 4);
constexpr size_t WS_GB = AL(WS_SLOT + (size_t)(NA + 256) * 4);
constexpr size_t WS_EGL = AL(WS_GB + (size_t)T * 32 * 4);
constexpr size_t WS_AR = AL(WS_EGL + (size_t)32 * 260 * 4);
constexpr size_t AR_HBUF = WS_AR;
constexpr size_t AR_UBUF = AR_HBUF + (size_t)T * 1024 * 2;
constexpr size_t AR_PB = AR_UBUF + (size_t)T * 1024 * 2;
constexpr size_t AR_Q = AR_PB + (size_t)T * 4096 * 2;
constexpr size_t AR_CHUNK = AR_PB + (size_t)T * 3072 * 2;
constexpr size_t AR_DN_END = AR_CHUNK + (size_t)32 * 260 * 65536;
constexpr size_t AR_ZT = AR_Q;
constexpr size_t AR_FFTS = AR_ZT + (size_t)1024 * T * 2;
constexpr size_t AR_FT = AR_FFTS + (size_t)256 * 4 * 16384 * 8;
constexpr size_t AR_HY_END = AR_FT + (size_t)4096 * 16384 * 4;
constexpr size_t AR_HID = AR_PB;
constexpr size_t AR_YS = AR_HID + (size_t)NA * 512 * 2;
constexpr size_t AR_WGU = AR_YS + (size_t)NA * 1024 * 2;
constexpr size_t AR_WD = AR_WGU + (size_t)32 * 1024 * 1024 * 2;
constexpr size_t AR_MOE_END = AR_WD + (size_t)32 * 1024 * 512 * 2;
constexpr size_t WS_END = AR_DN_END > AR_HY_END ? (AR_DN_END > AR_MOE_END ? AR_DN_END : AR_MOE_END) : (AR_HY_END > AR_MOE_END ? AR_HY_END : AR_MOE_END);

#define XB_TMO      128
#define XB_XCNT(j)  (256  + 64 * (j))
#define XB_XSUB(j)  (1280 + 64 * (j))
#define XB_XGEN(j)  (2304 + 64 * (j))
#define XB_TOP      3328
#define XB_TOPGEN   3392
#define XCD_BAR_WORDS 3456
#define XB_SPIN_CAP (1u << 25)
DI unsigned xb_ld(unsigned* p)              { return __hip_atomic_load(p, __ATOMIC_RELAXED, __HIP_MEMORY_SCOPE_AGENT); }
DI unsigned xb_add(unsigned* p, unsigned v) { return __hip_atomic_fetch_add(p, v, __ATOMIC_RELAXED, __HIP_MEMORY_SCOPE_AGENT); }
DI unsigned xb_xcc_id() { return (unsigned)__builtin_amdgcn_s_getreg((3 << 11) | 20) & 0xFu; }
#define XB_SPIN(cond, bar) do { unsigned _sp = 0; while (cond) { __builtin_amdgcn_s_sleep(1); \
    if ((++_sp & 255u) == 0u) { if (xb_ld(&(bar)[XB_TMO])) break; if (_sp > XB_SPIN_CAP) { atomicAdd(&(bar)[XB_TMO], 1u); break; } } } } while (0)
struct XcdBarrier { unsigned* bar; unsigned x; volatile LAS unsigned* st; };
DI XcdBarrier xcd_barrier_post(unsigned* bar, volatile LAS unsigned* st) {
    XcdBarrier b; b.bar = bar; b.x = xb_xcc_id(); b.st = st;
    if (threadIdx.x == 0) (void)xb_add(&bar[XB_XCNT(b.x)], 1u);
    return b;
}
DI void xcd_barrier_complete(unsigned* bar, unsigned x, unsigned& nloc, unsigned& nx) {
    const unsigned G = gridDim.x * gridDim.y * gridDim.z;
    unsigned sum, cnt, mine, sp = 0u;
    for (;;) {
        sum = 0u; cnt = 0u; mine = 0u;
#pragma unroll
        for (unsigned j = 0; j < 16; ++j) { const unsigned c = xb_ld(&bar[XB_XCNT(j)]); sum += c; cnt += (c > 0u) ? 1u : 0u; mine = (j == x) ? c : mine; }
        if (sum == G) break;
        __builtin_amdgcn_s_sleep(1);
        if ((++sp & 255u) == 0u) { if (xb_ld(&bar[XB_TMO])) break; if (sp > XB_SPIN_CAP) { atomicAdd(&bar[XB_TMO], 1u); break; } }
    }
    nloc = mine > 0u ? mine : 1u; nx = cnt > 0u ? cnt : 1u;
}
DI void xcd_barrier(const XcdBarrier& b) {
    asm volatile("s_waitcnt vmcnt(0)" ::: "memory");
    __syncthreads();
    if (threadIdx.x == 0) {
        unsigned* bar = b.bar;
        __builtin_amdgcn_s_waitcnt(0);
        unsigned nloc = b.st[0], nx = b.st[1];
        if (nloc == 0u) { xcd_barrier_complete(bar, b.x, nloc, nx); b.st[0] = nloc; b.st[1] = nx; }
        const unsigned old = xb_add(&bar[XB_XSUB(b.x)], 1u);
        const unsigned gen = old / nloc;
        if (old + 1u == (gen + 1u) * nloc) {
            __builtin_amdgcn_fence(__ATOMIC_RELEASE, "agent");
            asm volatile("s_waitcnt vmcnt(0)" ::: "memory");
            const unsigned og = xb_add(&bar[XB_TOP], 1u);
            const unsigned tg = og / nx;
            if (og + 1u == (tg + 1u) * nx) xb_add(&bar[XB_TOPGEN], 1u);
            else XB_SPIN(xb_ld(&bar[XB_TOPGEN]) == tg, bar);
            __builtin_amdgcn_fence(__ATOMIC_ACQUIRE, "agent");
            xb_add(&bar[XB_XGEN(b.x)], 1u);
            asm volatile("s_waitcnt vmcnt(0)" ::: "memory");
        } else {
            XB_SPIN(xb_ld(&bar[XB_XGEN(b.x)]) == gen, bar);
            __builtin_amdgcn_fence(__ATOMIC_ACQUIRE, "agent");
            asm volatile("s_waitcnt vmcnt(0)" ::: "memory");
        }
    }
    __syncthreads();
}

typedef float f32x2_t __attribute__((ext_vector_type(2)));
typedef __bf16 bf16x2_t __attribute__((ext_vector_type(2)));
DI unsigned cvt_pk_bf16(float lo, float hi) { f32x2_t v; v.x = lo; v.y = hi; const bf16x2_t b = __builtin_convertvector(v, bf16x2_t); return __builtin_bit_cast(unsigned, b); }
DI bf16_t f2bf(float f) { return (bf16_t)(cvt_pk_bf16(f, f) & 0xffffu); }
DI float bf2f(bf16_t b) { return __uint_as_float(((unsigned)b) << 16); }
DI unsigned pk2(float lo, float hi) { return cvt_pk_bf16(lo, hi); }
DI float siluf(float x) { return x * __builtin_amdgcn_rcpf(1.0f + __expf(-x)); }
DI float sigmf(float x) { return 1.0f / (1.0f + __expf(-x)); }
DI float shi(float v, int src) { return __int_as_float(__builtin_amdgcn_ds_bpermute(src << 2, __float_as_int(v))); }
DI int shii(int v, int src) { return __builtin_amdgcn_ds_bpermute(src << 2, v); }
DI float shx(float v, int m, int lane) { return shi(v, lane ^ m); }
DI float wsum(float v, int lane) {
#pragma unroll
    for (int m = 32; m >= 1; m >>= 1) v += shx(v, m, lane);
    return v;
}
DI void lds_barrier() { asm volatile("s_waitcnt lgkmcnt(0)\n\ts_barrier" ::: "memory"); }
DI int TID() { int t = threadIdx.x; asm volatile("" : "+v"(t)); return t; }
DI int modrow(int r) { return r < TC ? 0 : 1 + (r - TC) / SEQ; }

typedef float cf __attribute__((ext_vector_type(2)));
HD cf cmul(cf a, cf b) { cf r; r.x = a.x * b.x - a.y * b.y; r.y = a.x * b.y + a.y * b.x; return r; }
HD cf cadd(cf a, cf b) { cf r; r.x = a.x + b.x; r.y = a.y + b.y; return r; }
HD cf csub(cf a, cf b) { cf r; r.x = a.x - b.x; r.y = a.y - b.y; return r; }
template <int R> HD constexpr int brev(int i) { int r = 0; for (int b = 1, t = R >> 1; b < R; b <<= 1, t >>= 1) if (i & b) r |= t; return r; }
#define FFT_C32 {1.0f, 0.98078528040323044913f, 0.92387953251128675613f, 0.83146961230254523708f, 0.70710678118654752440f, 0.55557023301960222474f, 0.38268343236508977173f, 0.19509032201612826785f, 0.0f, -0.19509032201612826785f, -0.38268343236508977173f, -0.55557023301960222474f, -0.70710678118654752440f, -0.83146961230254523708f, -0.92387953251128675613f, -0.98078528040323044913f}
#define FFT_S32 {0.0f, 0.19509032201612826785f, 0.38268343236508977173f, 0.55557023301960222474f, 0.70710678118654752440f, 0.83146961230254523708f, 0.92387953251128675613f, 0.98078528040323044913f, 1.0f, 0.98078528040323044913f, 0.92387953251128675613f, 0.83146961230254523708f, 0.70710678118654752440f, 0.55557023301960222474f, 0.38268343236508977173f, 0.19509032201612826785f}
template <int R> HD constexpr int ilog2c() { int l = 0; for (int r = R; r > 1; r >>= 1) ++l; return l; }
template <int R> HD void dft_fwd(cf (&v)[R]) {
    constexpr float C[16] = FFT_C32; constexpr float S[16] = FFT_S32;
    constexpr int LG = ilog2c<R>();
#pragma unroll
    for (int st = 0; st < LG; ++st) {
#pragma unroll
        for (int i = 0; i < R / 2; ++i) {
            const int len = R >> st, half = len >> 1, blk = i / half, j = i % half, i0 = blk * len + j, i1 = i0 + half;
            const cf a = v[i0], c = v[i1];
            v[i0] = cadd(a, c);
            const cf d = csub(a, c);
            const int ti = j * (32 / len);
            cf w; w.x = C[ti]; w.y = -S[ti];
            cf r;
            if (ti == 0) r = d;
            else if (ti == 8) { r.x = d.y; r.y = -d.x; }
            else if (ti == 4) { r.x = (d.x + d.y) * 0.70710678118654752440f; r.y = (d.y - d.x) * 0.70710678118654752440f; }
            else if (ti == 12) { r.x = (d.y - d.x) * 0.70710678118654752440f; r.y = -(d.x + d.y) * 0.70710678118654752440f; }
            else r = cmul(d, w);
            v[i1] = r;
        }
    }
}
template <int R> HD void dft_inv(cf (&v)[R]) {
    constexpr float C[16] = FFT_C32; constexpr float S[16] = FFT_S32;
    constexpr int LG = ilog2c<R>();
#pragma unroll
    for (int st = LG - 1; st >= 0; --st) {
#pragma unroll
        for (int i = 0; i < R / 2; ++i) {
            const int len = R >> st, half = len >> 1, blk = i / half, j = i % half, i0 = blk * len + j, i1 = i0 + half;
            const int ti = j * (32 / len);
            cf w; w.x = C[ti]; w.y = S[ti];
            const cf a = v[i0];
            const cf b1 = v[i1];
            cf c;
            if (ti == 0) c = b1;
            else if (ti == 8) { c.x = -b1.y; c.y = b1.x; }
            else if (ti == 4) { c.x = (b1.x - b1.y) * 0.70710678118654752440f; c.y = (b1.x + b1.y) * 0.70710678118654752440f; }
            else if (ti == 12) { c.x = -(b1.x + b1.y) * 0.70710678118654752440f; c.y = (b1.x - b1.y) * 0.70710678118654752440f; }
            else c = cmul(b1, w);
            v[i0] = cadd(a, c);
            v[i1] = csub(a, c);
        }
    }
}
#define PIDX(a) ((a) + (((a) >> 6) << 2))
template <int R> DI void fft_pass_fwd(LAS cf* X, const LAS cf* tw, int n, int g) {
    const int s = n / R, q = g / s, p = g - q * s, base = q * n + p;
    cf v[R];
#pragma unroll
    for (int k = 0; k < R; ++k) v[k] = X[PIDX(base + k * s)];
    dft_fwd<R>(v);
    if (s > 1) {
        int pp = p * (16384 / n); asm volatile("" : "+v"(pp));
        const cf w1 = tw[pp]; cf w = w1;
#pragma unroll
        for (int m = 1; m < R; ++m) { v[brev<R>(m)] = cmul(v[brev<R>(m)], w); w = cmul(w, w1); }
    }
#pragma unroll
    for (int k = 0; k < R; ++k) X[PIDX(base + k * s)] = v[k];
}
template <int R> DI void fft_pass_inv(LAS cf* X, const LAS cf* tw, int n, int g) {
    const int s = n / R, q = g / s, p = g - q * s, base = q * n + p;
    cf v[R];
#pragma unroll
    for (int k = 0; k < R; ++k) v[k] = X[PIDX(base + k * s)];
    if (s > 1) {
        int pp = p * (16384 / n); asm volatile("" : "+v"(pp));
        cf w1 = tw[pp]; w1.y = -w1.y; cf w = w1;
#pragma unroll
        for (int m = 1; m < R; ++m) { v[brev<R>(m)] = cmul(v[brev<R>(m)], w); w = cmul(w, w1); }
    }
    dft_inv<R>(v);
#pragma unroll
    for (int k = 0; k < R; ++k) X[PIDX(base + k * s)] = v[k];
}
DI void fft16k_fwd(LAS cf* X, const LAS cf* tw) {
    const int t = TID();
#pragma unroll 1
    for (int g = 0; g < 2; ++g) fft_pass_fwd<16>(X, tw, 16384, t + 512 * g);
    __syncthreads();
#pragma unroll 1
    for (int g = 0; g < 2; ++g) fft_pass_fwd<16>(X, tw, 1024, t + 512 * g);
    __syncthreads();
#pragma unroll 1
    for (int g = 0; g < 2; ++g) fft_pass_fwd<16>(X, tw, 64, t + 512 * g);
    __syncthreads();
#pragma unroll 1
    for (int g = 0; g < 8; ++g) fft_pass_fwd<4>(X, tw, 4, t + 512 * g);
    __syncthreads();
}
DI void fft16k_inv(LAS cf* X, const LAS cf* tw) {
    const int t = TID();
#pragma unroll 1
    for (int g = 0; g < 8; ++g) fft_pass_inv<4>(X, tw, 4, t + 512 * g);
    __syncthreads();
#pragma unroll 1
    for (int g = 0; g < 2; ++g) fft_pass_inv<16>(X, tw, 64, t + 512 * g);
    __syncthreads();
#pragma unroll 1
    for (int g = 0; g < 2; ++g) fft_pass_inv<16>(X, tw, 1024, t + 512 * g);
    __syncthreads();
#pragma unroll 1
    for (int g = 0; g < 2; ++g) fft_pass_inv<16>(X, tw, 16384, t + 512 * g);
    __syncthreads();
}

struct Params { const float* in[33]; float* out; unsigned char* ws; int ph_lo, ph_hi; };
struct KC {
    const float *x, *c, *ctx, *c_ctx, *ada_w, *ada_b, *norm_mix, *norm_ffn, *norm_final;
    const float *dn_w_in, *dn_conv, *dn_a_log, *dn_dt_bias, *dn_out_norm, *dn_w_out;
    const float *hy_w_in, *hy_conv, *hy_f_w1, *hy_f_b1, *hy_f_freq, *hy_f_w2, *hy_f_b2, *hy_f_w3, *hy_bias, *hy_w_out;
    const float *sc_w_in, *sc_conv, *sc_w_out, *w_router, *router_bias, *moe_w_gate, *moe_w_up, *moe_w_down;
    float* out; unsigned char* ws;
};

PF void job_mod(const KC& k, LAS float* lds) {
    const int tid = TID(), cj = tid & 63, kq = tid >> 6;
    float* mod = (float*)(k.ws + WS_MOD);
    for (int u = blockIdx.x; u < DEPTH * 96; u += gridDim.x) {
        const int l = u / 96, cc = u % 96, col = cc * 64 + cj;
        const float* W = k.ada_w + (size_t)l * 1024 * 6144;
        float a0 = 0.f, a1 = 0.f, a2 = 0.f;
        for (int kk = kq * 128; kk < kq * 128 + 128; ++kk) {
            const float w = W[(size_t)kk * 6144 + col];
            a0 += siluf(k.c_ctx[kk]) * w; a1 += siluf(k.c[kk]) * w; a2 += siluf(k.c[1024 + kk]) * w;
        }
        lds[(kq * 3 + 0) * 64 + cj] = a0; lds[(kq * 3 + 1) * 64 + cj] = a1; lds[(kq * 3 + 2) * 64 + cj] = a2;
        __syncthreads();
        if (tid < 192) {
            const int r = tid >> 6, j = tid & 63;
            float s = 0.f;
            for (int q = 0; q < 8; ++q) s += lds[(q * 3 + r) * 64 + j];
            mod[(size_t)(l * 3 + r) * 6144 + cc * 64 + j] = s + k.ada_b[l * 6144 + cc * 64 + j];
        }
        __syncthreads();
    }
}
DI void cvt_matrix(const float* src, int ld, size_t sstride, int K, int N, int nmat, bf16_t* dst, int ldd, size_t dstride, int mapmode, LAS float* lds, int bid, int nb) {
    const int tk = K / 64, tn = N / 64, per = tk * tn, tid = TID();
    const int r = tid >> 4, c4 = (tid & 15) * 4;
    f32x4 v0, v1;
    int u = bid;
    if (u < per * nmat) { const int m = u / per, t = u % per; const float* sp = src + (size_t)m * sstride + (size_t)((t / tn) * 64 + r) * ld + (t % tn) * 64 + c4; v0 = *(const f32x4*)sp; v1 = *(const f32x4*)(sp + (size_t)32 * ld); }
    for (; u < per * nmat; u += nb) {
        const int m = u / per, t = u % per, k0 = (t / tn) * 64, n0 = (t % tn) * 64;
        { LAS float* p = lds + r * 65 + c4; p[0] = v0[0]; p[1] = v0[1]; p[2] = v0[2]; p[3] = v0[3];
          LAS float* p2 = lds + (r + 32) * 65 + c4; p2[0] = v1[0]; p2[1] = v1[1]; p2[2] = v1[2]; p2[3] = v1[3]; }
        { const int un = u + nb;
          if (un < per * nmat) { const int mn = un / per, tn_ = un % per; const float* sp = src + (size_t)mn * sstride + (size_t)((tn_ / tn) * 64 + r) * ld + (tn_ % tn) * 64 + c4; v0 = *(const f32x4*)sp; v1 = *(const f32x4*)(sp + (size_t)32 * ld); } }
        lds_barrier();
        { const int nn = tid >> 3, ks = (tid & 7) * 8; const int n = n0 + nn;
          const int row = mapmode == 0 ? n : (32 * (n >> 4) + (n & 15) + (mapmode == 2 ? 16 : 0));
          float f[8];
#pragma unroll
          for (int e = 0; e < 8; ++e) f[e] = lds[(ks + e) * 65 + nn];
          u32x4 o; o[0] = pk2(f[0], f[1]); o[1] = pk2(f[2], f[3]); o[2] = pk2(f[4], f[5]); o[3] = pk2(f[6], f[7]);
          *(u32x4*)(dst + (size_t)m * dstride + (size_t)row * ldd + k0 + ks) = o; }
        lds_barrier();
    }
}
PF void job_cvt_small(const KC& k, LAS float* lds) {
    cvt_matrix(k.dn_w_in, DN_IN, (size_t)1024 * DN_IN, 1024, 4096, 2, (bf16_t*)(k.ws + WS_DNWIN), 1024, (size_t)4096 * 1024, 0, lds, (int)blockIdx.x, (int)gridDim.x);
    cvt_matrix(k.dn_w_out, 1024, (size_t)1024 * 1024, 1024, 1024, 2, (bf16_t*)(k.ws + WS_DNWOUT), 1024, (size_t)1024 * 1024, 0, lds, (int)blockIdx.x, (int)gridDim.x);
    cvt_matrix(k.hy_w_in, 3072, 0, 1024, 3072, 1, (bf16_t*)(k.ws + WS_HYWIN), 1024, 0, 0, lds, (int)blockIdx.x, (int)gridDim.x);
    cvt_matrix(k.hy_w_out, 1024, 0, 1024, 1024, 1, (bf16_t*)(k.ws + WS_HYWOUT), 1024, 0, 0, lds, (int)blockIdx.x, (int)gridDim.x);
    cvt_matrix(k.sc_w_in, 3072, 0, 1024, 3072, 1, (bf16_t*)(k.ws + WS_SCWIN), 1024, 0, 0, lds, (int)blockIdx.x, (int)gridDim.x);
    cvt_matrix(k.sc_w_out, 1024, 0, 1024, 1024, 1, (bf16_t*)(k.ws + WS_SCWOUT), 1024, 0, 0, lds, (int)blockIdx.x, (int)gridDim.x);
}
PF void job_cvt_moe(const KC& k, int layer, LAS float* lds, int bid, int nb) {
    if (bid < 0) return;
    const size_t lo = (size_t)layer * 32 * 1024 * 512;
    cvt_matrix(k.moe_w_gate + lo, 512, (size_t)1024 * 512, 1024, 512, 32, (bf16_t*)(k.ws + AR_WGU), 1024, (size_t)1024 * 1024, 1, lds, bid, nb);
    cvt_matrix(k.moe_w_up + lo, 512, (size_t)1024 * 512, 1024, 512, 32, (bf16_t*)(k.ws + AR_WGU), 1024, (size_t)1024 * 1024, 2, lds, bid, nb);
    cvt_matrix(k.moe_w_down + lo, 1024, (size_t)512 * 1024, 512, 1024, 32, (bf16_t*)(k.ws + AR_WD), 512, (size_t)1024 * 512, 0, lds, bid, nb);
}
PF void job_hdn(const KC& k, LAS float* lds) {
    const int tid = TID(), lane = tid & 63, wave = tid >> 6;
    LAS float* feat = lds + wave * 128; LAS float* h1 = feat + 64;
    const float fr = k.hy_f_freq[lane], b1 = k.hy_f_b1[lane], b2 = k.hy_f_b2[lane];
    for (int u0 = blockIdx.x * 8; u0 < 16384 + 256; u0 += gridDim.x * 8) {
        const int u = u0 + wave;
        int l, pos; float* dst;
        if (u < 16384) { l = 16384; pos = u; dst = nullptr; }
        else { l = 256; pos = u - 16384; dst = (float*)(k.ws + WS_HDNC) + (size_t)pos * 64; }
        const float t = (float)pos / (float)(l - 1);
        float f = 0.f;
        if (lane == 0) f = t;
        else if (lane <= 32) {
            const int bi = (lane - 1) & 15;
            const float band = 1e-4f + (float)bi * ((15.0f - 1e-4f) / 15.0f);
            const float ang = (6.283185307179586f / (float)l) * (float)pos * band;
            f = lane <= 16 ? cosf(ang) : -sinf(ang);
        }
        feat[lane] = f;
        __syncthreads();
        float a = b1;
        for (int i = 0; i < 33; ++i) a += feat[i] * k.hy_f_w1[i * 64 + lane];
        h1[lane] = sinf(fr * a);
        __syncthreads();
        float a2 = b2;
        for (int j = 0; j < 64; ++j) a2 += h1[j] * k.hy_f_w2[j * 64 + lane];
        const float hv = sinf(fr * a2);
        if (dst) dst[lane] = hv;
        else { bf16_t* hs = (bf16_t*)(k.ws + WS_HS) + (size_t)pos * 256; const bf16_t hi = f2bf(hv), lo = f2bf(hv - bf2f(hi)); hs[lane] = hi; hs[64 + lane] = lo; hs[128 + lane] = hi; hs[192 + lane] = 0; }
        __syncthreads();
    }
}
PF void job_w3s(const KC& k) {
    bf16_t* W = (bf16_t*)(k.ws + WS_W3S);
    const int tq = TID();
    for (int idx = blockIdx.x * NTHR + tq; idx < 64 * 4096; idx += gridDim.x * NTHR) {
        const int j = idx >> 12, col = idx & 4095;
        const float w = k.hy_f_w3[idx]; const bf16_t hi = f2bf(w), lo = f2bf(w - bf2f(hi));
        W[(size_t)col * 256 + j] = hi; W[(size_t)col * 256 + 64 + j] = hi; W[(size_t)col * 256 + 128 + j] = lo; W[(size_t)col * 256 + 192 + j] = 0;
    }
}
DI float hy_delta(int ch) {
    const float lo = -4.605170185988091f / 1.5f, hi = -4.605170185988091f / 0.3f;
    return fabsf(lo + (float)ch * ((hi - lo) / 1023.0f));
}
PF void job_filtc(const KC& k, int j) {
    const float* hdn = (const float*)(k.ws + WS_HDNC);
    const float* w3 = k.hy_f_w3 + (size_t)j * 64 * 4096;
    float* filtc = (float*)(k.ws + WS_FILTC);
    const int tq = TID();
    for (int u = blockIdx.x; u < 256 * 8; u += gridDim.x) {
        const int l = u >> 3, col = (u & 7) * 512 + tq;
        float a = 0.f;
        for (int q = 0; q < 64; ++q) a += hdn[l * 64 + q] * w3[(size_t)q * 4096 + col];
        const float t = (float)l / 255.0f;
        filtc[(size_t)l * 4096 + col] = a * expf(-t * hy_delta(col & 1023));
    }
}

template <int MODE>
PF void norm_phase(const KC& k, int layer, bool first, bool combine, const float* __restrict__ gain, int mb, const float* __restrict__ Wsk, int ldw,
                   const float* __restrict__ aux0, const float* __restrict__ aux1, bool last, LAS float* lds, bool flush = true) {
    const int tid = TID(), lane = tid & 63, wave = tid >> 6;
    float* xs = (float*)(k.ws + WS_XS);
    bf16_t* hbuf = (bf16_t*)(k.ws + AR_HBUF);
    const float* mod = (const float*)(k.ws + WS_MOD);
    const bf16_t* ys = (const bf16_t*)(k.ws + AR_YS);
    const int* tokp = (const int*)(k.ws + WS_TOKP);
    const float* tokw = (const float*)(k.ws + WS_TOKW);
    LAS int* lcnt = (LAS int*)(lds + 32768);
    if (MODE == 1 && tid < 32) lcnt[tid] = 0;
    if (MODE == 1 || MODE == 2) {
        for (int idx = tid; idx < 1024 * 32; idx += NTHR) {
            const int kk = idx >> 5, n = idx & 31;
            lds[kk * 32 + (((n >> 2) ^ ((kk >> 1) & 7)) << 2) + (n & 3)] = Wsk[(size_t)kk * ldw + n];
        }
        __syncthreads();
    }
    const int rbeg = (MODE == 3) ? TC : 0, rstr = gridDim.x * 8;
    int cur_mr = -1; float gsv[16], shv[16], g5v[16];
    float xn[16];
    int r = rbeg + blockIdx.x * 8 + wave;
    if (r < T) {
        const float* src = first ? (r < TC ? k.ctx + (size_t)r * 1024 : k.x + (size_t)(r - TC) * 1024) : xs + (size_t)r * 1024;
#pragma unroll
        for (int m = 0; m < 16; ++m) xn[m] = src[lane + 64 * m];
    }
    for (; r < T; r += rstr) {
        const int mr = modrow(r);
        float x[16];
#pragma unroll
        for (int m = 0; m < 16; ++m) x[m] = xn[m];
        int p0 = 0, p1 = 0; float w0 = 0.f, w1 = 0.f;
        if (combine) { p0 = tokp[2 * r]; p1 = tokp[2 * r + 1]; w0 = tokw[2 * r]; w1 = tokw[2 * r + 1]; }
        {
            const int rn = r + rstr;
            if (rn < T) {
                const float* srcn = first ? (rn < TC ? k.ctx + (size_t)rn * 1024 : k.x + (size_t)(rn - TC) * 1024) : xs + (size_t)rn * 1024;
#pragma unroll
                for (int m = 0; m < 16; ++m) xn[m] = srcn[lane + 64 * m];
            }
        }
        if (mr != cur_mr) {
            cur_mr = mr;
            if (MODE != 3) {
                const float* shift = mod + ((size_t)(layer * 3 + mr) * 6 + mb) * 1024;
#pragma unroll
                for (int m = 0; m < 16; ++m) { const int col = lane + 64 * m; gsv[m] = gain[col] * (1.0f + shift[1024 + col]); shv[m] = shift[col]; }
            } else {
#pragma unroll
                for (int m = 0; m < 16; ++m) gsv[m] = gain[lane + 64 * m];
            }
            if (combine) {
                const float* g5 = mod + ((size_t)((layer - 1) * 3 + mr) * 6 + 5) * 1024;
#pragma unroll
                for (int m = 0; m < 16; ++m) g5v[m] = g5[lane + 64 * m];
            }
        }
        if (combine) {
            bf16_t ya[16], yb[16];
#pragma unroll
            for (int m = 0; m < 16; ++m) { const int col = lane + 64 * m; ya[m] = ys[(size_t)p0 * 1024 + col]; yb[m] = ys[(size_t)p1 * 1024 + col]; }
            asm volatile("" ::: "memory");
#pragma unroll
            for (int m = 0; m < 16; ++m) x[m] += g5v[m] * (w0 * bf2f(ya[m]) + w1 * bf2f(yb[m]));
        }
        if (first || combine) {
#pragma unroll
            for (int m = 0; m < 16; ++m) xs[(size_t)r * 1024 + lane + 64 * m] = x[m];
        }
        float ss = 0.f;
#pragma unroll
        for (int m = 0; m < 16; ++m) ss += x[m] * x[m];
        ss = wsum(ss, lane);
        const float rstd = rsqrtf(ss * (1.0f / 1024.0f) + EPS);
        if (MODE == 3) {
#pragma unroll
            for (int m = 0; m < 16; ++m) { const int col = lane + 64 * m; k.out[(size_t)(r - TC) * 1024 + col] = x[m] * rstd * gsv[m]; }
            continue;
        }
        float y[16];
#pragma unroll
        for (int m = 0; m < 16; ++m) {
            const int col = lane + 64 * m;
            y[m] = x[m] * rstd * gsv[m] + shv[m];
            hbuf[(size_t)r * 1024 + col] = f2bf(y[m]);
        }
        if (MODE == 1 || MODE == 2) {
            float acc[32];
#pragma unroll
            for (int n = 0; n < 32; ++n) acc[n] = 0.f;
#pragma unroll
            for (int m = 0; m < 16; ++m) {
                f32x4 wa[8];
                const int c = lane + 64 * m; const LAS float* wr = lds + c * 32; const int sw = (c >> 1) & 7;
#pragma unroll
                for (int q = 0; q < 8; ++q) wa[q] = *(const LAS f32x4*)(wr + ((q ^ sw) << 2));
                asm volatile("" ::: "memory");
#pragma unroll
                for (int q = 0; q < 8; ++q) { acc[4 * q + 0] += y[m] * wa[q][0]; acc[4 * q + 1] += y[m] * wa[q][1]; acc[4 * q + 2] += y[m] * wa[q][2]; acc[4 * q + 3] += y[m] * wa[q][3]; }
            }
            float val;
            {
                float a16[16], a8[8], a4[4], a2[2];
                const bool b5 = (lane & 32) != 0, b4 = (lane & 16) != 0, b3 = (lane & 8) != 0, b2 = (lane & 4) != 0, b1 = (lane & 2) != 0;
#pragma unroll
                for (int i = 0; i < 16; ++i) { const float send = b5 ? acc[i] : acc[i + 16], keep = b5 ? acc[i + 16] : acc[i]; a16[i] = keep + shx(send, 32, lane); }
#pragma unroll
                for (int i = 0; i < 8; ++i) { const float send = b4 ? a16[i] : a16[i + 8], keep = b4 ? a16[i + 8] : a16[i]; a8[i] = keep + shx(send, 16, lane); }
#pragma unroll
                for (int i = 0; i < 4; ++i) { const float send = b3 ? a8[i] : a8[i + 4], keep = b3 ? a8[i + 4] : a8[i]; a4[i] = keep + shx(send, 8, lane); }
#pragma unroll
                for (int i = 0; i < 2; ++i) { const float send = b2 ? a4[i] : a4[i + 2], keep = b2 ? a4[i + 2] : a4[i]; a2[i] = keep + shx(send, 4, lane); }
                { const float send = b1 ? a2[0] : a2[1], keep = b1 ? a2[1] : a2[0]; val = keep + shx(send, 2, lane); }
                val += shx(val, 1, lane);
            }
            const int n = lane >> 1;
            if (MODE == 1) {
                int* toke = (int*)(k.ws + WS_TOKE); float* tokwW = (float*)(k.ws + WS_TOKW);
                if (last && r < TC) { if (lane == 0) { int neg = -1; asm volatile("" : "+v"(neg)); toke[2 * r] = neg; toke[2 * r + 1] = neg; } continue; }
                const float sc = 1.0f / (1.0f + expf(-val)), ch = sc + aux0[n];
                const int gl = lane & ~7;
                const float ca = shi(ch, gl), cb = shi(ch, gl + 2), cc = shi(ch, gl + 4), cd = shi(ch, gl + 6);
                const float hi1 = fmaxf(ca, cb), lo1 = fminf(ca, cb), hi2 = fmaxf(cc, cd), lo2 = fminf(cc, cd);
                float gs = fmaxf(hi1, hi2) + fmaxf(fminf(hi1, hi2), fmaxf(lo1, lo2));
                int gi = lane >> 3;
#pragma unroll
                for (int m = 8; m <= 32; m <<= 1) {
                    const float og = shx(gs, m, lane); const int oi = shii(gi, lane ^ m);
                    if (og > gs || (og == gs && oi < gi)) { gs = og; gi = oi; }
                }
                float c4[4], s4[4];
#pragma unroll
                for (int i = 0; i < 4; ++i) { c4[i] = shi(ch, gi * 8 + 2 * i); s4[i] = shi(sc, gi * 8 + 2 * i); }
                int i1 = 0; float b1v = c4[0];
#pragma unroll
                for (int i = 1; i < 4; ++i) if (c4[i] > b1v) { b1v = c4[i]; i1 = i; }
                int i2 = -1; float b2v = -1e30f;
#pragma unroll
                for (int i = 0; i < 4; ++i) if (i != i1 && c4[i] > b2v) { b2v = c4[i]; i2 = i; }
                float w1v = 0.f, w2v = 0.f;
#pragma unroll
                for (int i = 0; i < 4; ++i) { if (i == i1) w1v = s4[i]; if (i == i2) w2v = s4[i]; }
                const float inv = 1.0f / (w1v + w2v);
                if (lane == 0) {
                    const int e1 = gi * 4 + i1, e2 = gi * 4 + i2;
                    toke[2 * r] = e1; toke[2 * r + 1] = e2; tokwW[2 * r] = w1v * inv; tokwW[2 * r + 1] = w2v * inv;
                    __hip_atomic_fetch_add(lcnt + e1, 1, __ATOMIC_RELAXED, __HIP_MEMORY_SCOPE_WORKGROUP);
                    __hip_atomic_fetch_add(lcnt + e2, 1, __ATOMIC_RELAXED, __HIP_MEMORY_SCOPE_WORKGROUP);
                }
            } else {
                float* gb = (float*)(k.ws + WS_GB);
                if ((lane & 1) == 0) {
                    if (n < 16) {
                        const float z = val + aux1[n];
                        const float ez = __expf(z); const float sp = z > 15.f ? z : (ez < 1e-4f ? ez - 0.5f * ez * ez : __logf(1.0f + ez));
                        gb[(size_t)r * 32 + n] = -expf(aux0[n]) * sp;
                    } else {
                        gb[(size_t)r * 32 + n] = 1.0f / (1.0f + expf(-val));
                    }
                }
            }
        }
    }
    if (MODE == 1) {
        __syncthreads();
        int* cnt = (int*)(k.ws + WS_CTL + CTL_CNT) + layer * 32;
        if (flush && tid < 32 && lcnt[tid] > 0) atomicAdd(&cnt[tid], lcnt[tid]);
    }
}

namespace pg8 {
constexpr int BM = 256, BK = 64, HALF = 128, HTB = HALF * BK * 2, STAGE_BYTES = 8 * HTB;
DI int lds_byte(int r, int c) { const int st = (r >> 4) * 2 + (c >> 5), rr = r & 15, cc = c & 31, ob = rr * 64 + cc * 2; return st * 1024 + (ob ^ (((ob >> 9) & 1) << 5)); }
DI void stage_rc(int b, int& R, int& C) { const int st = b / 1024, sb = b % 1024, swz = sb ^ (((sb >> 9) & 1) << 5); R = (st >> 1) * 16 + swz / 64; C = (st & 1) * 32 + (swz % 64) / 2; }
DI int perm32(int rho) { const int n = rho >> 4, i = rho & 15; return 8 * (i >> 2) + 4 * n + (i & 3); }
struct Unit { int m0, mrows, pn; size_t boff; };
template <bool GATHER, class Epi, class Sched>
DI void gemm_phase(LAS unsigned char* lds, const bf16_t* A, const int* rowidx, const bf16_t* Bt, int K, const Sched& S, const Epi& E) {
    const int tid = TID(), wid = __builtin_amdgcn_readfirstlane(tid >> 6), lane = tid & 63, wr = wid >> 2, wc = wid & 3, fr = lane & 15, fq = lane >> 4;
    const int nt = K / BK;
    unsigned voffA[2], voffB[2];
#pragma unroll
    for (int i = 0; i < 2; ++i) { int R, C; stage_rc(tid * 16 + i * 8192, R, C); const int Rb = Epi::PERM ? ((R & ~31) + perm32(R & 31)) : R;
        voffA[i] = (unsigned)(R * K + C) * 2u; voffB[i] = (unsigned)(Rb * K + C) * 2u; }
    const size_t kstep = (size_t)(BK * 2);
    const size_t hstep = (size_t)HALF * K * 2;
    const size_t tstep = 2 * hstep;
    const size_t rstep = (size_t)K * 2;
    const unsigned ldsw = (unsigned)wid * 1024u;
    const int aoff = lds_byte(wr * 64 + fr, fq * 8), boff = lds_byte(wc * 32 + fr, fq * 8);
#define PG8_SA(b, h) (((b) * 2 + (h)) * HTB)
#define PG8_SB(b, h) ((4 + (b) * 2 + (h)) * HTB)
#define PG8_STAGE(bufoff, gbase, voff) do { _Pragma("unroll") for (int _i = 0; _i < 2; ++_i) \
        __builtin_amdgcn_global_load_lds((const unsigned*)((const char*)(gbase) + (voff)[_i]), (LAS unsigned*)(lds + (bufoff) + ldsw + _i * 8192), 16, 0, 0); } while (0)
#define PG8_STAGE_A(bufoff, p, h, vG) do { if (GATHER) PG8_STAGE(bufoff, p, (vG)[h]); else PG8_STAGE(bufoff, (p) + (h) * hstep, voffA); } while (0)
#define PG8_LDA(dst, b, h) do { _Pragma("unroll") for (int m = 0; m < 4; ++m) _Pragma("unroll") for (int k = 0; k < 2; ++k) dst[m][k] = *(const LAS bf16x8*)(lds + PG8_SA(b, h) + aoff + m * 2048 + k * 1024); } while (0)
#define PG8_LDB(dst, b, h) do { _Pragma("unroll") for (int n = 0; n < 2; ++n) _Pragma("unroll") for (int k = 0; k < 2; ++k) dst[n][k] = *(const LAS bf16x8*)(lds + PG8_SB(b, h) + boff + n * 2048 + k * 1024); } while (0)
#define PG8_MMA(ai, bj, At, Bt_) do { __builtin_amdgcn_s_setprio(1); _Pragma("unroll") for (int m = 0; m < 4; ++m) _Pragma("unroll") for (int n = 0; n < 2; ++n) _Pragma("unroll") for (int k = 0; k < 2; ++k) \
        acc[ai][bj][m][n] = __builtin_amdgcn_mfma_f32_16x16x32_bf16(Bt_[n][k], At[m][k], acc[ai][bj][m][n], 0, 0, 0); __builtin_amdgcn_s_setprio(0); } while (0)
#define PG8_WAIT_V(n) asm volatile("s_waitcnt vmcnt(" #n ")" ::: "memory")
#define PG8_WAIT_L(n) asm volatile("s_waitcnt lgkmcnt(" #n ")" ::: "memory")
#define PG8_BAR __builtin_amdgcn_s_barrier()
#define PG8_SCHED __builtin_amdgcn_sched_barrier(0)
#define PG8_AOFF(dst, u) do { _Pragma("unroll") for (int _h = 0; _h < 2; ++_h) _Pragma("unroll") for (int _i = 0; _i < 2; ++_i) { int _R, _C; stage_rc(tid * 16 + _i * 8192, _R, _C); \
        dst[_h][_i] = (unsigned)(rowidx[(u).m0 + _h * HALF + _R] * K + _C) * 2u; } } while (0)
    Unit cur, nxt; int ui = 0;
    if (!S.next(0, cur)) return;
    f32x4 acc[2][2][4][2];
#pragma unroll
    for (int a = 0; a < 2; ++a)
#pragma unroll
        for (int b = 0; b < 2; ++b)
#pragma unroll
            for (int m = 0; m < 4; ++m)
#pragma unroll
                for (int n = 0; n < 2; ++n) acc[a][b][m][n] = (f32x4){0.f, 0.f, 0.f, 0.f};
    bf16x8 At[4][2], B0[2][2], B1[2][2];
    unsigned vA[2][2], vN[2][2];
    if (GATHER) PG8_AOFF(vA, cur);
    const char* cA = (const char*)A + (GATHER ? (size_t)0 : (size_t)cur.m0 * rstep);
    const char* cB = (const char*)Bt + cur.boff + (size_t)cur.pn * tstep;
    PG8_STAGE(PG8_SB(0, 0), cB, voffB); PG8_STAGE_A(PG8_SA(0, 0), cA, 0, vA); PG8_STAGE(PG8_SB(0, 1), cB + hstep, voffB); PG8_STAGE_A(PG8_SA(0, 1), cA, 1, vA);
    if (wr == 1) PG8_BAR;
    PG8_WAIT_V(4); PG8_BAR;
    PG8_STAGE(PG8_SB(1, 0), cB + kstep, voffB); PG8_STAGE_A(PG8_SA(1, 0), cA + kstep, 0, vA); PG8_STAGE(PG8_SB(1, 1), cB + hstep + kstep, voffB);
    PG8_WAIT_V(6); PG8_BAR;
    for (;;) {
        const bool has_next = S.next(ui + 1, nxt);
        const char* nA = GATHER ? cA : (has_next ? (const char*)A + (size_t)nxt.m0 * rstep : cA);
        const char* nB = has_next ? (const char*)Bt + nxt.boff + (size_t)nxt.pn * tstep : cB;
        if (GATHER) {
            if (has_next) { PG8_AOFF(vN, nxt); }
            else {
#pragma unroll
                for (int h = 0; h < 2; ++h)
#pragma unroll
                    for (int i = 0; i < 2; ++i) vN[h][i] = vA[h][i];
            }
        }
        for (int t = 0; t < nt; t += 2) {
            const bool last = (t == nt - 2);
            const char* a1 = cA + (size_t)(t + 1) * kstep;
            const char* a2 = last ? nA : cA + (size_t)(t + 2) * kstep; const char* b2 = last ? nB : cB + (size_t)(t + 2) * kstep;
            const char* a3 = a2 + kstep; const char* b3 = b2 + kstep;
            PG8_LDB(B0, 0, 0); PG8_SCHED; PG8_LDA(At, 0, 0); PG8_STAGE_A(PG8_SA(1, 1), a1, 1, vA);
            if (GATHER && last) {
#pragma unroll
                for (int h = 0; h < 2; ++h)
#pragma unroll
                    for (int i = 0; i < 2; ++i) vA[h][i] = vN[h][i];
            }
            PG8_WAIT_L(8); PG8_BAR; PG8_WAIT_L(0); PG8_MMA(0, 0, At, B0); PG8_BAR; PG8_SCHED;
            PG8_LDB(B1, 0, 1); PG8_STAGE(PG8_SB(0, 0), b2, voffB);
            PG8_BAR; PG8_WAIT_L(0); PG8_MMA(0, 1, At, B1); PG8_BAR;
            PG8_LDA(At, 0, 1); PG8_STAGE_A(PG8_SA(0, 0), a2, 0, vA);
            PG8_BAR; PG8_WAIT_L(0); PG8_MMA(1, 0, At, B0); PG8_BAR; PG8_SCHED;
            PG8_STAGE(PG8_SB(0, 1), b2 + hstep, voffB);
            PG8_WAIT_V(6); PG8_BAR; PG8_MMA(1, 1, At, B1); PG8_BAR;
            PG8_LDB(B0, 1, 0); PG8_SCHED; PG8_LDA(At, 1, 0); PG8_STAGE_A(PG8_SA(0, 1), a2, 1, vA);
            PG8_WAIT_L(8); PG8_BAR; PG8_WAIT_L(0); PG8_MMA(0, 0, At, B0); PG8_BAR; PG8_SCHED;
            PG8_LDB(B1, 1, 1); PG8_STAGE(PG8_SB(1, 0), b3, voffB);
            PG8_BAR; PG8_WAIT_L(0); PG8_MMA(0, 1, At, B1); PG8_BAR;
            PG8_LDA(At, 1, 1); PG8_STAGE_A(PG8_SA(1, 0), a3, 0, vA);
            PG8_BAR; PG8_WAIT_L(0); PG8_MMA(1, 0, At, B0); PG8_BAR; PG8_SCHED;
            PG8_STAGE(PG8_SB(1, 1), b3 + hstep, voffB);
            PG8_WAIT_V(6); PG8_BAR; PG8_MMA(1, 1, At, B1); PG8_BAR;
        }
        { const int t2 = TID(), l2 = t2 & 63; E(acc, cur, wr, wc, l2 & 15, l2 >> 4); }
        if (!has_next) break;
#pragma unroll
        for (int a = 0; a < 2; ++a)
#pragma unroll
            for (int b = 0; b < 2; ++b)
#pragma unroll
                for (int m = 0; m < 4; ++m)
#pragma unroll
                    for (int n = 0; n < 2; ++n) acc[a][b][m][n] = (f32x4){0.f, 0.f, 0.f, 0.f};
        cur = nxt; cA = nA; cB = nB; ++ui;
    }
    PG8_WAIT_V(0);
    if (wr == 0) PG8_BAR;
    PG8_BAR;
#undef PG8_SA
#undef PG8_SB
#undef PG8_STAGE
#undef PG8_STAGE_A
#undef PG8_LDA
#undef PG8_LDB
#undef PG8_MMA
#undef PG8_WAIT_V
#undef PG8_WAIT_L
#undef PG8_BAR
#undef PG8_SCHED
#undef PG8_AOFF
}
struct DenseOrder {
    int nM, nN, nwg, G, c;
    DI void init(int M, int N, int G_, int c_) { nM = M / BM; nN = N / BM; nwg = nM * nN; G = G_; c = c_; }
    DI bool next(int i, Unit& u) const {
        const long L = (long)i * G + c; if (L >= nwg) return false;
        int wgid = (int)L; { const int q = nwg / 8, r = nwg % 8, xcd = wgid % 8, off = wgid / 8; wgid = (xcd < r ? xcd * (q + 1) : r * (q + 1) + (xcd - r) * q) + off; }
        const int nig = 8 * nN, gid = wgid / nig, fm = gid * 8, gsz = (nM - fm) < 8 ? (nM - fm) : 8;
        u.m0 = (fm + ((wgid % nig) % gsz)) * BM; u.mrows = BM; u.pn = (wgid % nig) / gsz; u.boff = 0; return true;
    }
};
struct MoeOrder {
    const LAS int* tb; int G, c; size_t estride; int lane;
    DI bool next(int i, Unit& u) const {
        const int L = i * G + c; if (L >= __builtin_amdgcn_readfirstlane(tb[97]) * 4) return false;
        const int tile = L >> 2;
        const int pre = tb[65 + (lane & 31)];
        const unsigned long long m = __ballot(lane < 32 && pre <= tile);
        const int e = __popcll(m) - 1;
        const int lt = tile - __builtin_amdgcn_readfirstlane(tb[65 + e]); int mr = __builtin_amdgcn_readfirstlane(tb[e]) - lt * 256; mr = mr > 256 ? 256 : mr;
        u.m0 = __builtin_amdgcn_readfirstlane(tb[32 + e]) + lt * 256; u.mrows = mr; u.pn = L & 3; u.boff = (size_t)e * estride; return true;
    }
};
}
struct EpiBf16 {
    static constexpr bool PERM = true;
    bf16_t* C; int ldc; int split_col; bf16_t* C2; int ldc2;
    DI void operator()(const f32x4 (&acc)[2][2][4][2], const pg8::Unit& u, int wr, int wc, int fr, int fq) const {
        int colt = u.pn * 256; bf16_t* base = C; int ld = ldc;
        if (colt >= split_col) { base = C2; ld = ldc2; colt -= split_col; }
#pragma unroll
        for (int ai = 0; ai < 2; ++ai)
#pragma unroll
            for (int m = 0; m < 4; ++m) {
                const int rl = ai * 128 + wr * 64 + m * 16 + fr;
                if (rl < u.mrows) {
                    bf16_t* rowp = base + (size_t)(u.m0 + rl) * ld + colt + wc * 32 + 8 * fq;
#pragma unroll
                    for (int bj = 0; bj < 2; ++bj) {
                        const f32x4 v0 = acc[ai][bj][m][0], v1 = acc[ai][bj][m][1];
                        u32x4 o; o[0] = cvt_pk_bf16(v0[0], v0[1]); o[1] = cvt_pk_bf16(v0[2], v0[3]); o[2] = cvt_pk_bf16(v1[0], v1[1]); o[3] = cvt_pk_bf16(v1[2], v1[3]);
                        *(u32x4*)(rowp + bj * 128) = o;
                    }
                }
            }
    }
};
struct EpiBf16T {
    static constexpr bool PERM = false;
    bf16_t* C; int ldc;
    DI void operator()(const f32x4 (&acc)[2][2][4][2], const pg8::Unit& u, int wr, int wc, int fr, int fq) const {
#pragma unroll
        for (int ai = 0; ai < 2; ++ai)
#pragma unroll
            for (int bj = 0; bj < 2; ++bj)
#pragma unroll
                for (int m = 0; m < 4; ++m)
#pragma unroll
                    for (int n = 0; n < 2; ++n) {
                        const int row = u.m0 + ai * 128 + wr * 64 + m * 16 + fr, col = u.pn * 256 + bj * 128 + wc * 32 + n * 16 + 4 * fq;
#pragma unroll
                        for (int e = 0; e < 4; ++e) C[(size_t)(col + e) * ldc + row] = f2bf(acc[ai][bj][m][n][e]);
                    }
    }
};
struct EpiTaps {
    static constexpr bool PERM = false;
    float* FT;
    DI void operator()(const f32x4 (&acc)[2][2][4][2], const pg8::Unit& u, int wr, int wc, int fr, int fq) const {
#pragma unroll
        for (int ai = 0; ai < 2; ++ai)
#pragma unroll
            for (int m = 0; m < 4; ++m) {
                const int row = u.m0 + ai * 128 + wr * 64 + m * 16 + fr; const float dl = hy_delta(row & 1023) * (1.0f / 16383.0f);
#pragma unroll
                for (int bj = 0; bj < 2; ++bj)
#pragma unroll
                    for (int n = 0; n < 2; ++n) {
                        const int l = u.pn * 256 + bj * 128 + wc * 32 + n * 16 + 4 * fq; f32x4 o;
#pragma unroll
                        for (int e = 0; e < 4; ++e) o[e] = acc[ai][bj][m][n][e] * expf(-(float)(l + e) * dl);
                        *(f32x4*)(FT + (size_t)row * 16384 + l) = o;
                    }
            }
    }
};
struct EpiResid {
    static constexpr bool PERM = false;
    float* xs; const float* mod; int layer; int chunk;
    DI void operator()(const f32x4 (&acc)[2][2][4][2], const pg8::Unit& u, int wr, int wc, int fr, int fq) const {
        const float* g = mod + ((size_t)(layer * 3 + modrow(u.m0)) * 6 + chunk) * 1024;
#pragma unroll
        for (int bj = 0; bj < 2; ++bj)
#pragma unroll
            for (int n = 0; n < 2; ++n) {
                const int col = u.pn * 256 + bj * 128 + wc * 32 + n * 16 + 4 * fq; const f32x4 gv = *(const f32x4*)(g + col);
                float* p0 = xs + (size_t)(u.m0 + wr * 64 + fr) * 1024 + col;
                f32x4 old[8];
#pragma unroll
                for (int ai = 0; ai < 2; ++ai)
#pragma unroll
                    for (int m = 0; m < 4; ++m) old[ai * 4 + m] = *(const f32x4*)(p0 + (size_t)(ai * 128 + m * 16) * 1024);
                asm volatile("" ::: "memory");
#pragma unroll
                for (int ai = 0; ai < 2; ++ai)
#pragma unroll
                    for (int m = 0; m < 4; ++m) *(f32x4*)(p0 + (size_t)(ai * 128 + m * 16) * 1024) = old[ai * 4 + m] + gv * acc[ai][bj][m][n];
            }
    }
};
struct EpiGateUp {
    static constexpr bool PERM = false;
    bf16_t* hid;
    DI void operator()(const f32x4 (&acc)[2][2][4][2], const pg8::Unit& u, int wr, int wc, int fr, int fq) const {
#pragma unroll
        for (int ai = 0; ai < 2; ++ai)
#pragma unroll
            for (int m = 0; m < 4; ++m) {
                const int rl = ai * 128 + wr * 64 + m * 16 + fr;
                if (rl < u.mrows) {
#pragma unroll
                    for (int bj = 0; bj < 2; ++bj) {
                        const int hc = ((u.pn * 256 + bj * 128 + wc * 32) >> 1) + 4 * fq;
                        const f32x4 g = acc[ai][bj][m][0], up = acc[ai][bj][m][1];
                        u32x2 o; o[0] = cvt_pk_bf16(siluf(g[0]) * up[0], siluf(g[1]) * up[1]); o[1] = cvt_pk_bf16(siluf(g[2]) * up[2], siluf(g[3]) * up[3]);
                        *(u32x2*)(hid + (size_t)(u.m0 + rl) * 512 + hc) = o;
                    }
                }
            }
    }
};
template <class Epi>
PF void gemm_dense(LAS unsigned char* lds, const bf16_t* A, int M, const bf16_t* Bt, int N, int K, const Epi& epi) {
    pg8::DenseOrder S; S.init(M, N, (int)gridDim.x, (int)blockIdx.x);
    pg8::gemm_phase<false>(lds, A, (const int*)nullptr, Bt, K, S, epi);
}
DI void moe_table(const KC& k, int layer, LAS int* tb) {
    const int* cnt = (const int*)(k.ws + WS_CTL + CTL_CNT) + layer * 32;
    __syncthreads();
    const int tq = TID();
    if (tq < 32) tb[tq] = __hip_atomic_load(cnt + tq, __ATOMIC_RELAXED, __HIP_MEMORY_SCOPE_AGENT);
    __syncthreads();
    if (tq == 0) {
        int s = 0, tp = 0;
        for (int e = 0; e < 32; ++e) { tb[32 + e] = s; tb[65 + e] = tp; s += tb[e]; tp += (tb[e] + 255) >> 8; }
        tb[64] = s; tb[97] = tp;
    }
    __syncthreads();
}
template <int WHICH>
PF void moe_gemm(const KC& k, int layer, LAS unsigned char* lds, LAS int* tb) {
    moe_table(k, layer, tb);
    if (WHICH == 0) {
        pg8::MoeOrder S{tb, (int)gridDim.x, (int)blockIdx.x, (size_t)1024 * 1024 * 2, TID() & 63};
        EpiGateUp epi{(bf16_t*)(k.ws + AR_HID)};
        pg8::gemm_phase<true>(lds, (const bf16_t*)(k.ws + AR_HBUF), (const int*)(k.ws + WS_SLOT), (const bf16_t*)(k.ws + AR_WGU), 1024, S, epi);
    } else {
        pg8::MoeOrder S{tb, (int)gridDim.x, (int)blockIdx.x, (size_t)1024 * 512 * 2, TID() & 63};
        EpiBf16 epi{(bf16_t*)(k.ws + AR_YS), 1024, 1 << 30, nullptr, 0};
        pg8::gemm_phase<false>(lds, (const bf16_t*)(k.ws + AR_HID), (const int*)nullptr, (const bf16_t*)(k.ws + AR_WD), 512, S, epi);
    }
}
PF void moe_scatter(const KC& k, int layer, LAS int* tb) {
    moe_table(k, layer, tb);
    const int* toke = (const int*)(k.ws + WS_TOKE);
    int* tokp = (int*)(k.ws + WS_TOKP); int* slot = (int*)(k.ws + WS_SLOT);
    int* cur = (int*)(k.ws + WS_CTL + CTL_CNT) + 128 + layer * 32;
    LAS int* lc = tb + 128; LAS int* lb = tb + 160;
    const int tid = TID();
    if (blockIdx.x == 0 && tid < 256) slot[NA + tid] = 0;
    for (int r0 = blockIdx.x * NTHR; r0 < T; r0 += gridDim.x * NTHR) {
        const int r = r0 + tid;
        __syncthreads();
        if (tid < 32) lc[tid] = 0;
        __syncthreads();
        const int e0 = toke[2 * r], e1 = toke[2 * r + 1];
        int k0 = 0, k1 = 0;
        if (e0 >= 0) { k0 = __hip_atomic_fetch_add(lc + e0, 1, __ATOMIC_RELAXED, __HIP_MEMORY_SCOPE_WORKGROUP); k1 = __hip_atomic_fetch_add(lc + e1, 1, __ATOMIC_RELAXED, __HIP_MEMORY_SCOPE_WORKGROUP); }
        __syncthreads();
        if (tid < 32) lb[tid] = lc[tid] > 0 ? atomicAdd(&cur[tid], lc[tid]) : 0;
        __syncthreads();
        if (e0 >= 0) {
            const int p0 = tb[32 + e0] + lb[e0] + k0, p1 = tb[32 + e1] + lb[e1] + k1;
            slot[p0] = r; slot[p1] = r; tokp[2 * r] = p0; tokp[2 * r + 1] = p1;
        }
    }
}

DI void unpack8(const u32x4 v, float (&f)[8]) {
#pragma unroll
    for (int w = 0; w < 4; ++w) { f[2 * w] = __uint_as_float(v[w] << 16); f[2 * w + 1] = __uint_as_float(v[w] & 0xffff0000u); }
}
PF void sc_mix(const KC& k, int j) {
    const int tid = TID(), lane = tid & 63, wave = tid >> 6;
    const bf16_t* P = (const bf16_t*)(k.ws + AR_PB);
    bf16_t* U = (bf16_t*)(k.ws + AR_UBUF);
    const float* cw = k.sc_conv + (size_t)j * 3 * 1024;
    const int c0 = lane * 16;
    float k0[16], k1[16], k2[16];
#pragma unroll
    for (int e = 0; e < 16; ++e) { k0[e] = cw[c0 + e]; k1[e] = cw[1024 + c0 + e]; k2[e] = cw[2048 + c0 + e]; }
    for (int r = blockIdx.x * 8 + wave; r < T; r += gridDim.x * 8) {
        bool lok, rok;
        if (r < TC) { const int t = r & 255; lok = t != 0; rok = t != 255; } else { const int t = (r - TC) & 63; lok = t != 0; rok = t != 63; }
        const bf16_t* p = P + (size_t)r * 3072 + c0;
        const bf16_t* pl = lok ? p - 3072 : p; const bf16_t* pr = rok ? p + 3072 : p;
        u32x4 vb[2], vc[2], vx[2], vcl[2], vxl[2], vcr[2], vxr[2];
#pragma unroll
        for (int hh = 0; hh < 2; ++hh) {
            vb[hh] = *(const u32x4*)(p + hh * 8); vc[hh] = *(const u32x4*)(p + 1024 + hh * 8); vx[hh] = *(const u32x4*)(p + 2048 + hh * 8);
            vcl[hh] = *(const u32x4*)(pl + 1024 + hh * 8); vxl[hh] = *(const u32x4*)(pl + 2048 + hh * 8);
            vcr[hh] = *(const u32x4*)(pr + 1024 + hh * 8); vxr[hh] = *(const u32x4*)(pr + 2048 + hh * 8);
        }
        asm volatile("" ::: "memory");
        const float fl = lok ? 1.f : 0.f, frr = rok ? 1.f : 0.f;
#pragma unroll
        for (int hh = 0; hh < 2; ++hh) {
            float bg[8], cg[8], xi[8], cl[8], xl[8], cr[8], xr[8];
            unpack8(vb[hh], bg); unpack8(vc[hh], cg); unpack8(vx[hh], xi); unpack8(vcl[hh], cl); unpack8(vxl[hh], xl); unpack8(vcr[hh], cr); unpack8(vxr[hh], xr);
            u32x4 o;
#pragma unroll
            for (int w = 0; w < 4; ++w) {
                float ov[2];
#pragma unroll
                for (int e = 0; e < 2; ++e) { const int i = 2 * w + e, c = hh * 8 + i; ov[e] = bg[i] * (k0[c] * fl * cl[i] * xl[i] + k1[c] * cg[i] * xi[i] + k2[c] * frr * cr[i] * xr[i]); }
                o[w] = pk2(ov[0], ov[1]);
            }
            *(u32x4*)(U + (size_t)r * 1024 + c0 + hh * 8) = o;
        }
    }
}

constexpr int DN_STEPS = 260, DN_UNITS = 32 * DN_STEPS;
DI int dn_rbase(int b, int dir, int s) {
    if (s < 4) return dir == 0 ? b * 256 + s * 64 : b * 256 + 255 - s * 64;
    const int cc = s - 4;
    return dir == 0 ? TC + b * SEQ + cc * 64 : TC + b * SEQ + SEQ - 1 - cc * 64;
}
struct DnRaw { u32x4 c[3][2], l[3][2], r[3][2]; float g, be; };
DI void dn_raw_load(const bf16_t* P, const float* gb, int u, int tid, DnRaw& R) {
    const int chain = u / DN_STEPS, s = u - chain * DN_STEPS, dir = chain & 1, h = (chain >> 1) & 7, b = chain >> 4;
    const int rbase = dn_rbase(b, dir, s), rstep = dir == 0 ? 1 : -1;
    const int i = tid >> 3, sg = tid & 7, r = rbase + rstep * i;
    bool lok, rok;
    if (r < TC) { const int t = r & 255; lok = t != 0; rok = t != 255; } else { const int t = (r - TC) & 63; lok = t != 0; rok = t != 63; }
#pragma unroll
    for (int part = 0; part < 3; ++part) {
        const bf16_t* pc = P + (size_t)r * 3072 + part * 1024 + h * 128 + sg * 16;
#pragma unroll
        for (int hf = 0; hf < 2; ++hf) {
            R.c[part][hf] = *(const u32x4*)(pc + hf * 8);
            R.l[part][hf] = (u32x4){0u, 0u, 0u, 0u}; R.r[part][hf] = (u32x4){0u, 0u, 0u, 0u};
            if (lok) R.l[part][hf] = *(const u32x4*)(pc - 3072 + hf * 8);
            if (rok) R.r[part][hf] = *(const u32x4*)(pc + 3072 + hf * 8);
        }
    }
    if (tid < 64) { const size_t row = (size_t)(rbase + rstep * tid); R.g = gb[row * 32 + dir * 8 + h]; R.be = gb[row * 32 + 16 + dir * 8 + h]; }
}
PF void dn_chunk(const KC& k, int jl, LAS unsigned char* lds) {
    const int tid = TID(), lane = tid & 63, wave = tid >> 6, fr = lane & 15, fq = lane >> 4;
    LAS bf16_t* Kt = (LAS bf16_t*)lds;
    LAS bf16_t* Qt = Kt + 64 * 136;
    LAS bf16_t* Vt = Qt + 64 * 136;
    LAS float* Amat = (LAS float*)(Vt + 64 * 136);
    LAS bf16_t* Tb = (LAS bf16_t*)(Amat + 64 * 64);
    LAS bf16_t* VbT = Tb + 64 * 72;
    LAS bf16_t* KbT = VbT + 128 * 72;
    LAS float* gcs = (LAS float*)(KbT + 128 * 72);
    LAS float* bet = gcs + 64; LAS float* eg = bet + 64; LAS float* egr = eg + 64;
    LAS float* Tm = egr + 64;
    const bf16_t* P = (const bf16_t*)(k.ws + AR_PB);
    const float* gb = (const float*)(k.ws + WS_GB);
    const float* cw = k.dn_conv + (size_t)jl * 3 * 3072;
    bf16_t* CH = (bf16_t*)(k.ws + AR_CHUNK);
    bf16_t* ATT = (bf16_t*)(k.ws + AR_HBUF);
    float* EGL = (float*)(k.ws + WS_EGL);
    for (int u = blockIdx.x; u < DN_UNITS; u += gridDim.x) {
        DnRaw Rn; dn_raw_load(P, gb, u, tid, Rn);
        const int chain = u / DN_STEPS, s = u - chain * DN_STEPS, dir = chain & 1, h = (chain >> 1) & 7, b = chain >> 4;
        const int rbase = dn_rbase(b, dir, s), rstep = dir == 0 ? 1 : -1;
        bf16_t* cW = CH + (size_t)u * 32768; bf16_t* cQd = cW + 8192; bf16_t* cKd = cQd + 8192; bf16_t* cU = cKd + 8192;
        bf16_t* cAt = ATT + (size_t)u * 4096;
        lds_barrier();
        const float g_in = Rn.g, be_in = Rn.be;
        {
            const int i = tid >> 3, sg = tid & 7;
#pragma unroll
            for (int part = 0; part < 3; ++part) {
                const int col = part * 1024 + h * 128 + sg * 16;
                float v[16];
#pragma unroll
                for (int hf = 0; hf < 2; ++hf) {
                    const u32x4 c4 = Rn.c[part][hf], l4 = Rn.l[part][hf], r4 = Rn.r[part][hf];
#pragma unroll
                    for (int w2 = 0; w2 < 2; ++w2) {
                        const int cc = col + hf * 8 + 4 * w2;
                        const f32x4 k0 = *(const f32x4*)(cw + cc), k1 = *(const f32x4*)(cw + 3072 + cc), k2 = *(const f32x4*)(cw + 6144 + cc);
#pragma unroll
                        for (int e = 0; e < 4; ++e) {
                            const int w = 2 * w2 + (e >> 1);
                            const float lv = __uint_as_float((e & 1) ? (l4[w] & 0xffff0000u) : (l4[w] << 16));
                            const float cv = __uint_as_float((e & 1) ? (c4[w] & 0xffff0000u) : (c4[w] << 16));
                            const float rv = __uint_as_float((e & 1) ? (r4[w] & 0xffff0000u) : (r4[w] << 16));
                            v[hf * 8 + 4 * w2 + e] = siluf(k0[e] * lv + k1[e] * cv + k2[e] * rv);
                        }
                    }
                }
                if (part < 2) {
                    float ss = 0.f;
#pragma unroll
                    for (int e = 0; e < 16; ++e) ss += v[e] * v[e];
                    ss += shx(ss, 1, lane); ss += shx(ss, 2, lane); ss += shx(ss, 4, lane);
                    const float sc = rsqrtf(ss + EPS) * (part == 0 ? 0.08838834764831845f : 1.0f);
#pragma unroll
                    for (int e = 0; e < 16; ++e) v[e] *= sc;
                }
                LAS bf16_t* dst = (part == 0 ? Qt : (part == 1 ? Kt : Vt)) + i * 136 + sg * 16;
                u32x4 o0, o1;
#pragma unroll
                for (int w = 0; w < 4; ++w) { o0[w] = pk2(v[2 * w], v[2 * w + 1]); o1[w] = pk2(v[8 + 2 * w], v[8 + 2 * w + 1]); }
                *(LAS u32x4*)dst = o0; *(LAS u32x4*)(dst + 8) = o1;
            }
        }
        if (wave == 0) {
            float g = g_in;
            const float be = be_in;
#pragma unroll
            for (int d = 1; d < 64; d <<= 1) { const float o = shi(g, (lane - d) & 63); if (lane >= d) g += o; }
            const float glast = shi(g, 63);
            gcs[lane] = g; bet[lane] = be; eg[lane] = expf(g); egr[lane] = expf(glast - g);
            if (lane == 0) EGL[u] = expf(glast);
        }
        lds_barrier();
#pragma unroll 1
        for (int x = 0; x < 4; ++x) {
            const int t = wave + 8 * x, isq = t >> 4, mt = (t >> 2) & 3, nt = t & 3;
            f32x4 acc = (f32x4){0.f, 0.f, 0.f, 0.f};
            const int jc = 16 * nt + fr;
            float gi4[4], bi4[4];
            const float gj = gcs[jc];
#pragma unroll
            for (int jj = 0; jj < 4; ++jj) { gi4[jj] = gcs[16 * mt + 4 * fq + jj]; bi4[jj] = bet[16 * mt + 4 * fq + jj]; }
            if (mt >= nt) {
                const LAS bf16_t* Ar = (isq ? Qt : Kt) + (16 * mt + fr) * 136 + 8 * fq;
                const LAS bf16_t* Br = Kt + (16 * nt + fr) * 136 + 8 * fq;
                bf16x8 fa4[4], fb4[4];
#pragma unroll
                for (int ks = 0; ks < 4; ++ks) { fa4[ks] = *(const LAS bf16x8*)(Ar + 32 * ks); fb4[ks] = *(const LAS bf16x8*)(Br + 32 * ks); }
                asm volatile("" ::: "memory");
#pragma unroll
                for (int ks = 0; ks < 4; ++ks) acc = __builtin_amdgcn_mfma_f32_16x16x32_bf16(fa4[ks], fb4[ks], acc, 0, 0, 0);
            }
#pragma unroll
            for (int jj = 0; jj < 4; ++jj) {
                const int ir = 16 * mt + 4 * fq + jj;
                const float dec = __expf(fminf(gi4[jj] - gj, 0.f));
                if (isq) cAt[ir * 64 + jc] = f2bf(ir >= jc ? acc[jj] * dec : 0.f);
                else Amat[ir * 64 + jc] = ir > jc ? bi4[jj] * acc[jj] * dec : 0.f;
            }
        }
        lds_barrier();
        {
        if (wave < 4) {
            if (lane < 16) {
                const int bo = 16 * wave;
                float tc[16];
#pragma unroll
                for (int i = 0; i < 16; ++i) {
                    f32x4 ar[4];
#pragma unroll
                    for (int q = 0; q < (i + 3) / 4; ++q) ar[q] = *(const LAS f32x4*)(Amat + (bo + i) * 64 + bo + 4 * q);
                    float a0 = (i == lane) ? 1.f : 0.f, a1 = 0.f;
#pragma unroll
                    for (int j = 0; j < i; ++j) { const float av = ar[j >> 2][j & 3]; if (j & 1) a1 -= av * tc[j]; else a0 -= av * tc[j]; }
                    tc[i] = a0 + a1;
                    Tm[(bo + i) * 64 + bo + lane] = tc[i];
                }
            }
        } else {
            for (int it = tid - 256; it < 1024; it += 256) {
                const int c = it & 127, ig = it >> 7;
                float kv[8], vv[8];
                { bf16_t kr[8], vr[8];
#pragma unroll
                  for (int e = 0; e < 8; ++e) { kr[e] = Kt[(8 * ig + e) * 136 + c]; vr[e] = Vt[(8 * ig + e) * 136 + c]; }
                  asm volatile("" ::: "memory");
#pragma unroll
                  for (int e = 0; e < 8; ++e) { kv[e] = bf2f(kr[e]); vv[e] = bf2f(vr[e]); } }
                u32x4 ov, ok, od;
#pragma unroll
                for (int w = 0; w < 4; ++w) {
                    const int i0 = 8 * ig + 2 * w, i1 = i0 + 1;
                    ov[w] = pk2(bet[i0] * vv[2 * w], bet[i1] * vv[2 * w + 1]);
                    ok[w] = pk2(bet[i0] * eg[i0] * kv[2 * w], bet[i1] * eg[i1] * kv[2 * w + 1]);
                    od[w] = pk2(egr[i0] * kv[2 * w], egr[i1] * kv[2 * w + 1]);
                }
                *(LAS u32x4*)(VbT + c * 72 + 8 * ig) = ov;
                *(LAS u32x4*)(KbT + c * 72 + 8 * ig) = ok;
                *(u32x4*)(cKd + c * 64 + 8 * ig) = od;
            }
            for (int it = tid - 256; it < 1024; it += 256) {
                const int i = it >> 4, c8 = (it & 15) * 8; const float e = eg[i];
                const u32x4 qv = *(const LAS u32x4*)(Qt + i * 136 + c8); u32x4 o;
#pragma unroll
                for (int w = 0; w < 4; ++w) o[w] = pk2(__uint_as_float(qv[w] << 16) * e, __uint_as_float(qv[w] & 0xffff0000u) * e);
                *(u32x4*)(cQd + i * 128 + c8) = o;
            }
        }
        lds_barrier();
#pragma unroll 1
        for (int d = 1; d < 4; ++d) {
            if (wave < 4 - d) {
                const int bi = wave + d, bj = wave, r = lane >> 2, c0 = 4 * (lane & 3);
                f32x4 m = (f32x4){0.f, 0.f, 0.f, 0.f};
                for (int kb = bj; kb < bi; ++kb) {
                    f32x4 av4[4], tv[16];
#pragma unroll
                    for (int q = 0; q < 4; ++q) av4[q] = *(const LAS f32x4*)(Amat + (16 * bi + r) * 64 + 16 * kb + 4 * q);
#pragma unroll
                    for (int kk = 0; kk < 16; ++kk) tv[kk] = *(const LAS f32x4*)(Tm + (16 * kb + kk) * 64 + 16 * bj + c0);
                    asm volatile("" ::: "memory");
#pragma unroll
                    for (int kk = 0; kk < 16; ++kk) m += tv[kk] * av4[kk >> 2][kk & 3];
                }
                *(LAS f32x4*)(Tm + (16 * bj + r) * 64 + 16 * bi + c0) = m;
                f32x4 t = (f32x4){0.f, 0.f, 0.f, 0.f};
                {
                    f32x4 dv4[4], mv[16];
#pragma unroll
                    for (int q = 0; q < 4; ++q) dv4[q] = *(const LAS f32x4*)(Tm + (16 * bi + r) * 64 + 16 * bi + 4 * q);
#pragma unroll
                    for (int kk = 0; kk < 16; ++kk) mv[kk] = *(const LAS f32x4*)(Tm + (16 * bj + kk) * 64 + 16 * bi + c0);
                    asm volatile("" ::: "memory");
#pragma unroll
                    for (int kk = 0; kk < 16; ++kk) t -= mv[kk] * dv4[kk >> 2][kk & 3];
                }
                *(LAS f32x4*)(Tm + (16 * bi + r) * 64 + 16 * bj + c0) = t;
            }
            lds_barrier();
        }
        for (int it = tid; it < 64 * 8; it += NTHR) {
            const int i = it >> 3, c8 = (it & 7) * 8; u32x4 o;
#pragma unroll
            for (int w = 0; w < 4; ++w) {
                const int c = c8 + 2 * w;
                o[w] = pk2(c <= i ? Tm[i * 64 + c] : 0.f, c + 1 <= i ? Tm[i * 64 + c + 1] : 0.f);
            }
            *(LAS u32x4*)(Tb + i * 72 + c8) = o;
        }
        }
        lds_barrier();
        {
            f32x4 au[4], aw[4];
#pragma unroll
            for (int mt = 0; mt < 4; ++mt) { au[mt] = (f32x4){0.f, 0.f, 0.f, 0.f}; aw[mt] = (f32x4){0.f, 0.f, 0.f, 0.f}; }
            bf16x8 bv[2], bk[2], at[2][4];
#pragma unroll
            for (int ks = 0; ks < 2; ++ks) {
                bv[ks] = *(const LAS bf16x8*)(VbT + (16 * wave + fr) * 72 + 32 * ks + 8 * fq);
                bk[ks] = *(const LAS bf16x8*)(KbT + (16 * wave + fr) * 72 + 32 * ks + 8 * fq);
#pragma unroll
                for (int mt = 0; mt < 4; ++mt) at[ks][mt] = *(const LAS bf16x8*)(Tb + (16 * mt + fr) * 72 + 32 * ks + 8 * fq);
            }
            asm volatile("" ::: "memory");
#pragma unroll
            for (int ks = 0; ks < 2; ++ks)
#pragma unroll
                for (int mt = 0; mt < 4; ++mt) {
                    au[mt] = __builtin_amdgcn_mfma_f32_16x16x32_bf16(at[ks][mt], bv[ks], au[mt], 0, 0, 0);
                    aw[mt] = __builtin_amdgcn_mfma_f32_16x16x32_bf16(at[ks][mt], bk[ks], aw[mt], 0, 0, 0);
                }
#pragma unroll
            for (int mt = 0; mt < 4; ++mt)
#pragma unroll
                for (int jj = 0; jj < 4; ++jj) {
                    const int ir = 16 * mt + 4 * fq + jj, c = 16 * wave + fr;
                    cU[ir * 128 + c] = f2bf(au[mt][jj]); cW[ir * 128 + c] = f2bf(aw[mt][jj]);
                }
        }
    }
}
constexpr int SC_W = 0, SC_QD = 64 * 136, SC_KD = SC_QD + 64 * 136, SC_AT = SC_KD + 128 * 72, SC_U = SC_AT + 64 * 72, SC_EGL = SC_U + 16 * 72, SC_STAGE = SC_EGL + 8;
struct ScanRegs { u32x4 v[8]; u32x4 u[2]; };
DI void dn_scan_fetch(const bf16_t* CH, const bf16_t* ATT, int u, int sl, int wv, int lane, ScanRegs& R) {
    const bf16_t* cW = CH + (size_t)u * 32768;
    const bf16_t* src = (wv < 6) ? cW + wv * 4096 + lane * 8 : ATT + (size_t)u * 4096 + lane * 8;
#pragma unroll
    for (int q = 0; q < 8; ++q) R.v[q] = *(const u32x4*)(src + q * 512);
    if (wv == 6) {
#pragma unroll
        for (int qq = 0; qq < 2; ++qq) { const int pid = lane + 64 * qq; R.u[qq] = *(const u32x4*)(cW + 24576 + (pid >> 1) * 128 + sl * 16 + (pid & 1) * 8); }
    }
}
DI void dn_scan_put(LAS bf16_t* st, int wv, int lane, const ScanRegs& R) {
    LAS bf16_t* dst; int qs;
    if (wv < 4) { dst = st + ((wv < 2) ? SC_W : SC_QD) + ((wv & 1) * 32 + (lane >> 4)) * 136 + (lane & 15) * 8; qs = 544; }
    else if (wv < 6) { dst = st + SC_KD + ((wv - 4) * 64 + (lane >> 3)) * 72 + (lane & 7) * 8; qs = 576; }
    else { dst = st + SC_AT + (lane >> 3) * 72 + (lane & 7) * 8; qs = 576; }
#pragma unroll
    for (int q = 0; q < 8; ++q) *(LAS u32x4*)(dst + q * qs) = R.v[q];
    if (wv == 6) {
#pragma unroll
        for (int qq = 0; qq < 2; ++qq) { const int pid = lane + 64 * qq, i = pid >> 1, hf = pid & 1;
#pragma unroll
            for (int w = 0; w < 4; ++w) { st[SC_U + (hf * 8 + 2 * w) * 72 + i] = (bf16_t)(R.u[qq][w] & 0xffff); st[SC_U + (hf * 8 + 2 * w + 1) * 72 + i] = (bf16_t)(R.u[qq][w] >> 16); } }
    }
}
DI bf16x8 ld2(const LAS bf16_t* p0, const LAS bf16_t* p1) {
    const u32x2 a = *(const LAS u32x2*)p0, b = *(const LAS u32x2*)p1;
    u32x4 r; r[0] = a[0]; r[1] = a[1]; r[2] = b[0]; r[3] = b[1];
    return __builtin_bit_cast(bf16x8, r);
}
DI bf16x8 pk8(f32x4 a, f32x4 b) { u32x4 r; r[0] = pk2(a[0], a[1]); r[1] = pk2(a[2], a[3]); r[2] = pk2(b[0], b[1]); r[3] = pk2(b[2], b[3]); return __builtin_bit_cast(bf16x8, r); }
PF void dn_scan(const KC& k, LAS unsigned char* lds) {
    const int tid = TID(), lane = tid & 63, wave = tid >> 6, fr = lane & 15, fq = lane >> 4;
    LAS bf16_t* ring = (LAS bf16_t*)lds;
    const bf16_t* CH = (const bf16_t*)(k.ws + AR_CHUNK);
    const bf16_t* ATT = (const bf16_t*)(k.ws + AR_HBUF);
    const float* EGL = (const float*)(k.ws + WS_EGL);
    bf16_t* O = (bf16_t*)(k.ws + AR_PB);
    for (int un0 = blockIdx.x; un0 < 256; un0 += gridDim.x) {
        const int un = (gridDim.x == 256) ? ((un0 & 7) * 32 + (un0 >> 3)) : un0;
        const int sl = un & 7, chain = un >> 3, dir = chain & 1, h = (chain >> 1) & 7, b = chain >> 4;
        const int rstep = dir == 0 ? 1 : -1;
        f32x4 S[8];
#pragma unroll
        for (int t = 0; t < 8; ++t) S[t] = (f32x4){0.f, 0.f, 0.f, 0.f};
        LAS float* eglL = (LAS float*)(ring + 2 * SC_STAGE);
        constexpr int NPF = 1;
        ScanRegs R[NPF];
        const int wv = wave - 1;
        lds_barrier();
        if (tid < DN_STEPS) eglL[tid] = EGL[chain * DN_STEPS + tid];
        if (wave > 0) {
            dn_scan_fetch(CH, ATT, chain * DN_STEPS, sl, wv, lane, R[0]); dn_scan_put(ring, wv, lane, R[0]);
#pragma unroll
            for (int q = 0; q < NPF; ++q) dn_scan_fetch(CH, ATT, chain * DN_STEPS + q + 1, sl, wv, lane, R[q]);
        }
        lds_barrier();
#pragma unroll 1
        for (int s4 = 0; s4 < DN_STEPS; s4 += NPF) {
#pragma unroll
          for (int q = 0; q < NPF; ++q) {
            const int s = s4 + q; if (s >= DN_STEPS) break;
            LAS bf16_t* st = ring + (s & 1) * SC_STAGE;
            if (wave > 0) {
                if (s + 1 < DN_STEPS) dn_scan_put(ring + ((s + 1) & 1) * SC_STAGE, wv, lane, R[q]);
                if (s + 1 + NPF < DN_STEPS) dn_scan_fetch(CH, ATT, chain * DN_STEPS + s + 1 + NPF, sl, wv, lane, R[q]);
            } else {
                const float egl = eglL[s];
                bf16x8 sb[4];
#pragma unroll
                for (int ks = 0; ks < 4; ++ks) sb[ks] = pk8(S[2 * ks], S[2 * ks + 1]);
                f32x4 p[4], o[4];
#pragma unroll
                for (int mt = 0; mt < 4; ++mt) { p[mt] = (f32x4){0.f, 0.f, 0.f, 0.f}; o[mt] = (f32x4){0.f, 0.f, 0.f, 0.f}; }
                bf16x8 fw[2][4], fq_[2][4];
#define SC_LOAD_KS(buf, ks) do { _Pragma("unroll") for (int mt = 0; mt < 4; ++mt) { \
                        const LAS bf16_t* wr_ = st + SC_W + (16 * mt + fr) * 136 + 4 * fq + 32 * (ks); const LAS bf16_t* qr_ = st + SC_QD + (16 * mt + fr) * 136 + 4 * fq + 32 * (ks); \
                        fw[buf][mt] = ld2(wr_, wr_ + 16); fq_[buf][mt] = ld2(qr_, qr_ + 16); } } while (0)
#define SC_MMA_KS(buf, ks) do { _Pragma("unroll") for (int mt = 0; mt < 4; ++mt) p[mt] = __builtin_amdgcn_mfma_f32_16x16x32_bf16(fw[buf][mt], sb[ks], p[mt], 0, 0, 0); \
                        _Pragma("unroll") for (int mt = 0; mt < 4; ++mt) o[mt] = __builtin_amdgcn_mfma_f32_16x16x32_bf16(fq_[buf][mt], sb[ks], o[mt], 0, 0, 0); } while (0)
                bf16x8 fa[2][4], fk[2][8];
#define SC_LOAD_KC(kc) do { _Pragma("unroll") for (int mt = 0; mt < 4; ++mt) { const LAS bf16_t* ar_ = st + SC_AT + (16 * mt + fr) * 72 + 4 * fq + 32 * (kc); fa[kc][mt] = ld2(ar_, ar_ + 16); } \
                        _Pragma("unroll") for (int t = 0; t < 8; ++t) { const LAS bf16_t* kr_ = st + SC_KD + (16 * t + fr) * 72 + 4 * fq + 32 * (kc); fk[kc][t] = ld2(kr_, kr_ + 16); } } while (0)
                SC_LOAD_KS(0, 0);
                SC_LOAD_KS(1, 1); asm volatile("" ::: "memory"); SC_MMA_KS(0, 0);
                SC_LOAD_KS(0, 2); asm volatile("" ::: "memory"); SC_MMA_KS(1, 1);
                SC_LOAD_KS(1, 3); asm volatile("" ::: "memory"); SC_MMA_KS(0, 2);
                SC_LOAD_KC(0);    asm volatile("" ::: "memory"); SC_MMA_KS(1, 3);
                u32x2 uu[4];
#pragma unroll
                for (int mt = 0; mt < 4; ++mt) uu[mt] = *(const LAS u32x2*)(st + SC_U + fr * 72 + 16 * mt + 4 * fq);
                SC_LOAD_KC(1);    asm volatile("" ::: "memory");
                bf16x8 vb[2]; f32x4 vn[4];
#pragma unroll
                for (int mt = 0; mt < 4; ++mt) {
                    vn[mt][0] = __uint_as_float(uu[mt][0] << 16) - p[mt][0]; vn[mt][1] = __uint_as_float(uu[mt][0] & 0xffff0000u) - p[mt][1];
                    vn[mt][2] = __uint_as_float(uu[mt][1] << 16) - p[mt][2]; vn[mt][3] = __uint_as_float(uu[mt][1] & 0xffff0000u) - p[mt][3];
                }
                vb[0] = pk8(vn[0], vn[1]); vb[1] = pk8(vn[2], vn[3]);
#pragma unroll
                for (int t = 0; t < 8; ++t) S[t] = S[t] * egl;
#pragma unroll
                for (int kc = 0; kc < 2; ++kc) {
#pragma unroll
                    for (int mt = 0; mt < 4; ++mt) o[mt] = __builtin_amdgcn_mfma_f32_16x16x32_bf16(fa[kc][mt], vb[kc], o[mt], 0, 0, 0);
#pragma unroll
                    for (int t = 0; t < 8; ++t) S[t] = __builtin_amdgcn_mfma_f32_16x16x32_bf16(fk[kc][t], vb[kc], S[t], 0, 0, 0);
                }
#undef SC_LOAD_KS
#undef SC_MMA_KS
#undef SC_LOAD_KC
                const int rbase = dn_rbase(b, dir, s);
#pragma unroll
                for (int mt = 0; mt < 4; ++mt)
#pragma unroll
                    for (int jj = 0; jj < 4; ++jj) {
                        const int row = rbase + rstep * (16 * mt + 4 * fq + jj);
                        O[((size_t)dir * T + row) * 1024 + h * 128 + sl * 16 + fr] = f2bf(o[mt][jj]);
                    }
            }
            lds_barrier();
          }
        }
    }
}
PF void dn_finish(const KC& k, int j) {
    const int tid = TID(), lane = tid & 63, wave = tid >> 6;
    const bf16_t* O = (const bf16_t*)(k.ws + AR_PB);
    const bf16_t* Z = (const bf16_t*)k.out;
    bf16_t* U = (bf16_t*)(k.ws + AR_UBUF);
    const float* on = k.dn_out_norm + j * 128;
    const int c0 = lane * 16;
    float onv[16];
#pragma unroll
    for (int e = 0; e < 16; ++e) onv[e] = on[(c0 + e) & 127];
    for (int r = blockIdx.x * 8 + wave; r < T; r += gridDim.x * 8) {
        u32x4 vf[2], vb[2], vz[2];
#pragma unroll
        for (int hh = 0; hh < 2; ++hh) {
            vf[hh] = *(const u32x4*)(O + (size_t)r * 1024 + c0 + hh * 8); vb[hh] = *(const u32x4*)(O + ((size_t)T + r) * 1024 + c0 + hh * 8);
            vz[hh] = *(const u32x4*)(Z + (size_t)r * 1024 + c0 + hh * 8);
        }
        asm volatile("" ::: "memory");
        float o[16], z[16];
#pragma unroll
        for (int hh = 0; hh < 2; ++hh) { float a[8], b2[8], zz[8]; unpack8(vf[hh], a); unpack8(vb[hh], b2); unpack8(vz[hh], zz);
#pragma unroll
            for (int i = 0; i < 8; ++i) { o[hh * 8 + i] = a[i] + b2[i]; z[hh * 8 + i] = zz[i]; } }
        float ss = 0.f;
#pragma unroll
        for (int e = 0; e < 16; ++e) ss += o[e] * o[e];
        ss += shx(ss, 1, lane); ss += shx(ss, 2, lane); ss += shx(ss, 4, lane);
        const float rs = rsqrtf(ss * (1.0f / 128.0f) + EPS);
#pragma unroll
        for (int hh = 0; hh < 2; ++hh) { u32x4 ov;
#pragma unroll
            for (int w = 0; w < 4; ++w) { const int e0 = hh * 8 + 2 * w; ov[w] = pk2(o[e0] * rs * onv[e0] * siluf(z[e0]), o[e0 + 1] * rs * onv[e0 + 1] * siluf(z[e0 + 1])); }
            *(u32x4*)(U + (size_t)r * 1024 + c0 + hh * 8) = ov; }
    }
}

DI float conv3g(const bf16_t* p, int j, float w0, float w1, float w2) {
    const int gc = j & 63;
    const float l = gc != 0 ? bf2f(p[j - 1]) : 0.f, c = bf2f(p[j]), r = gc != 63 ? bf2f(p[j + 1]) : 0.f;
    return w0 * l + w1 * c + w2 * r;
}
DI float hy_conv_lane(float c, float w0, float w1, float w2, int lane) {
    const float l = shi(c, (lane + 63) & 63), r = shi(c, (lane + 1) & 63);
    return w0 * (lane > 0 ? l : 0.f) + w1 * c + w2 * (lane < 63 ? r : 0.f);
}
PF void hy_lat(const KC& k, int jl, LAS float* ldsf) {
    const int tid = TID();
    LAS cf* X = (LAS cf*)ldsf;
    LAS cf* tw = X + 17408;
    LAS cf* tA = tw + 1024; LAS cf* tB = tA + 128;
    const float* FT = (const float*)(k.ws + AR_FT);
    const bf16_t* PT = (const bf16_t*)(k.ws + AR_PB);
    bf16_t* ZT = (bf16_t*)(k.ws + AR_ZT);
    unsigned* scr = (unsigned*)(k.ws + AR_FFTS) + (size_t)blockIdx.x * 4 * 16384;
    unsigned* sKe = scr; unsigned* sKo = scr + 16384; unsigned* zp = scr + 2 * 16384; unsigned* ye = scr + 3 * 16384;
#define CPK(v) pk2((v).x, (v).y)
#define CUP(u_) ((cf){__uint_as_float((u_) << 16), __uint_as_float((u_) & 0xffff0000u)})
    const float* cw = k.hy_conv + (size_t)jl * 3 * 3072;
    for (int m = 0; m < 2; ++m) { const int p = tid + 512 * m; float sn, cs; sincospif(-(float)p / 8192.0f, &sn, &cs); cf w; w.x = cs; w.y = sn; tw[p] = w; }
    if (tid < 256) { const int a = tid & 127; float sn, cs; sincospif(-(float)(tid < 128 ? 128 * a : a) / 16384.0f, &sn, &cs); cf w; w.x = cs; w.y = sn; (tid < 128 ? tA : tB)[a] = w; }
    __syncthreads();
    const int lane = tid & 63;
#define HY_SPLIT() asm volatile("" ::: "memory")
#define HY_CONV(c, w0, w1, w2) hy_conv_lane((c), (w0), (w1), (w2), lane)
    for (int ch = blockIdx.x; ch < 1024; ch += gridDim.x) {
        {
            const bf16_t* pv = PT + (size_t)ch * T + TC;
            const float w0 = cw[ch], w1 = cw[3072 + ch], w2 = cw[6144 + ch];
            for (int m0 = 0; m0 < 32; m0 += 8) {
                bf16_t a0[8], a1[8];
#pragma unroll
                for (int q = 0; q < 8; ++q) { const int j = tid + 512 * (m0 + q); a0[q] = pv[j]; a1[q] = pv[SEQ + j]; }
                HY_SPLIT();
#pragma unroll
                for (int q = 0; q < 8; ++q) { const int j = tid + 512 * (m0 + q); const float c0 = bf2f(a0[q]), c1 = bf2f(a1[q]); cf z; z.x = HY_CONV(c0, w0, w1, w2); z.y = HY_CONV(c1, w0, w1, w2); zp[j] = CPK(z); }
            }
        }
        for (int n = 0; n < 2; ++n) {
            __syncthreads();
            const float* ftf = FT + (size_t)(n * 2048 + ch) * 16384; const float* ftb = FT + (size_t)(n * 2048 + 1024 + ch) * 16384;
            for (int m0 = 0; m0 < 32; m0 += 8) {
                float hfv[8], hbv[8];
#pragma unroll
                for (int q = 0; q < 8; ++q) { const int j = tid + 512 * (m0 + q); hfv[q] = ftf[j]; hbv[q] = ftb[j > 0 ? SEQ - j : 0]; }
                HY_SPLIT();
#pragma unroll
                for (int q = 0; q < 8; ++q) {
                    const int j = tid + 512 * (m0 + q);
                    const float hf = hfv[q], hb = j > 0 ? hbv[q] : 0.f;
                    const cf w = cmul(tA[j >> 7], tB[j & 127]);
                    cf a; a.x = hf + hb; a.y = 0.f; X[PIDX(j)] = a;
                    const float kd = hf - hb; cf o; o.x = kd * w.x; o.y = kd * w.y; sKo[j] = CPK(o);
                }
            }
            __syncthreads();
            fft16k_fwd(X, tw);
            _Pragma("unroll 8") for (int m = 0; m < 32; ++m) { const int j = tid + 512 * m; const cf t_ = X[PIDX(j)]; sKe[j] = CPK(t_); }
            __syncthreads();
            for (int m0 = 0; m0 < 32; m0 += 8) { unsigned t[8];
#pragma unroll
                for (int q = 0; q < 8; ++q) t[q] = sKo[tid + 512 * (m0 + q)];
                HY_SPLIT();
#pragma unroll
                for (int q = 0; q < 8; ++q) X[PIDX(tid + 512 * (m0 + q))] = CUP(t[q]); }
            __syncthreads();
            fft16k_fwd(X, tw);
            _Pragma("unroll 8") for (int m = 0; m < 32; ++m) { const int j = tid + 512 * m; const cf t_ = X[PIDX(j)]; sKo[j] = CPK(t_); }
            __syncthreads();
            for (int m0 = 0; m0 < 32; m0 += 8) { unsigned t[8];
#pragma unroll
                for (int q = 0; q < 8; ++q) t[q] = zp[tid + 512 * (m0 + q)];
                HY_SPLIT();
#pragma unroll
                for (int q = 0; q < 8; ++q) X[PIDX(tid + 512 * (m0 + q))] = CUP(t[q]); }
            __syncthreads();
            fft16k_fwd(X, tw);
            for (int m0 = 0; m0 < 32; m0 += 8) { unsigned t[8];
#pragma unroll
                for (int q = 0; q < 8; ++q) t[q] = sKe[tid + 512 * (m0 + q)];
                HY_SPLIT();
#pragma unroll
                for (int q = 0; q < 8; ++q) { const int j = tid + 512 * (m0 + q); X[PIDX(j)] = cmul(X[PIDX(j)], CUP(t[q])); } }
            __syncthreads();
            fft16k_inv(X, tw);
            _Pragma("unroll 8") for (int m = 0; m < 32; ++m) { const int j = tid + 512 * m; const cf t_ = X[PIDX(j)]; ye[j] = CPK(t_); }
            __syncthreads();
            for (int m0 = 0; m0 < 32; m0 += 8) { unsigned t[8];
#pragma unroll
                for (int q = 0; q < 8; ++q) t[q] = zp[tid + 512 * (m0 + q)];
                HY_SPLIT();
#pragma unroll
                for (int q = 0; q < 8; ++q) { const int j = tid + 512 * (m0 + q); const cf w = cmul(tA[j >> 7], tB[j & 127]); X[PIDX(j)] = cmul(CUP(t[q]), w); } }
            __syncthreads();
            fft16k_fwd(X, tw);
            for (int m0 = 0; m0 < 32; m0 += 8) { unsigned t[8];
#pragma unroll
                for (int q = 0; q < 8; ++q) t[q] = sKo[tid + 512 * (m0 + q)];
                HY_SPLIT();
#pragma unroll
                for (int q = 0; q < 8; ++q) { const int j = tid + 512 * (m0 + q); X[PIDX(j)] = cmul(X[PIDX(j)], CUP(t[q])); } }
            __syncthreads();
            fft16k_inv(X, tw);
            {
                const bf16_t* pg = PT + (size_t)((n + 1) * 1024 + ch) * T + TC;
                const int gcol = (n + 1) * 1024 + ch;
                const float w0 = cw[gcol], w1 = cw[3072 + gcol], w2 = cw[6144 + gcol];
                const float bias = k.hy_bias[(size_t)jl * 2 * 1024 + n * 1024 + ch];
                for (int m0 = 0; m0 < 32; m0 += 8) {
                    unsigned te_[8], tz_[8]; bf16_t g0[8], g1[8];
#pragma unroll
                    for (int q = 0; q < 8; ++q) { const int j = tid + 512 * (m0 + q); te_[q] = ye[j]; tz_[q] = zp[j]; g0[q] = pg[j]; g1[q] = pg[SEQ + j]; }
                    HY_SPLIT();
#pragma unroll
                    for (int q = 0; q < 8; ++q) {
                        const int j = tid + 512 * (m0 + q);
                        cf w = cmul(tA[j >> 7], tB[j & 127]); w.y = -w.y;
                        const cf yo = cmul(X[PIDX(j)], w);
                        const cf te = CUP(te_[q]), tz = CUP(tz_[q]);
                        const float y0 = (0.5f / 16384.0f) * (te.x + yo.x), y1 = (0.5f / 16384.0f) * (te.y + yo.y);
                        const float c0 = bf2f(g0[q]), c1 = bf2f(g1[q]);
                        cf zn; zn.x = HY_CONV(c0, w0, w1, w2) * (y0 + bias * tz.x); zn.y = HY_CONV(c1, w0, w1, w2) * (y1 + bias * tz.y);
                        zp[j] = CPK(zn);
                    }
                }
            }
        }
        for (int m0 = 0; m0 < 32; m0 += 8) { unsigned t[8];
#pragma unroll
            for (int q = 0; q < 8; ++q) t[q] = zp[tid + 512 * (m0 + q)];
            HY_SPLIT();
#pragma unroll
            for (int q = 0; q < 8; ++q) { const int j = tid + 512 * (m0 + q); ZT[(size_t)ch * T + TC + j] = (bf16_t)(t[q] & 0xffffu); ZT[(size_t)ch * T + TC + SEQ + j] = (bf16_t)(t[q] >> 16); } }
        __syncthreads();
    }
#undef CPK
#undef CUP
#undef HY_SPLIT
#undef HY_CONV
}
PF void hy_ctx(const KC& k, int jl, LAS float* lds) {
    const int tid = TID(), t = tid & 255, hsel = tid >> 8;
    LAS float* z = lds + hsel * 768; LAS float* hf = z + 256; LAS float* hb = hf + 256;
    const bf16_t* PT = (const bf16_t*)(k.ws + AR_PB);
    bf16_t* U = (bf16_t*)(k.ws + AR_UBUF);
    const float* filtc = (const float*)(k.ws + WS_FILTC);
    const float* cw = k.hy_conv + (size_t)jl * 3 * 3072;
    for (int u = blockIdx.x; u < 1024; u += gridDim.x) {
        const int pr = u * 2 + hsel, b = pr >> 10, ch = pr & 1023;
        float zc;
        {
            const bf16_t* pv = PT + (size_t)ch * T + b * 256;
            const float l = t != 0 ? bf2f(pv[t - 1]) : 0.f, c = bf2f(pv[t]), r = t != 255 ? bf2f(pv[t + 1]) : 0.f;
            zc = cw[ch] * l + cw[3072 + ch] * c + cw[6144 + ch] * r;
        }
        for (int n = 0; n < 2; ++n) {
            __syncthreads();
            z[t] = zc; hf[t] = filtc[(size_t)t * 4096 + n * 2048 + ch]; hb[t] = filtc[(size_t)t * 4096 + n * 2048 + 1024 + ch];
            __syncthreads();
            float y = 0.f;
            for (int s = 0; s <= t; ++s) y += hf[t - s] * z[s];
            for (int s = t + 1; s < 256; ++s) y += hb[s - t] * z[s];
            const int gcol = (n + 1) * 1024 + ch;
            const bf16_t* pg = PT + (size_t)gcol * T + b * 256;
            const float l = t != 0 ? bf2f(pg[t - 1]) : 0.f, c = bf2f(pg[t]), r = t != 255 ? bf2f(pg[t + 1]) : 0.f;
            const float gate = cw[gcol] * l + cw[3072 + gcol] * c + cw[6144 + gcol] * r;
            zc = gate * (y + k.hy_bias[(size_t)jl * 2048 + n * 1024 + ch] * zc);
        }
        U[(size_t)(b * 256 + t) * 1024 + ch] = f2bf(zc);
        __syncthreads();
    }
}
PF void hy_transpose(const KC& k, LAS bf16_t* lds) {
    const int tid = TID();
    const bf16_t* ZT = (const bf16_t*)(k.ws + AR_ZT);
    bf16_t* U = (bf16_t*)(k.ws + AR_UBUF);
    for (int u = blockIdx.x; u < 16 * (TL / 64); u += gridDim.x) {
        const int c0 = (u & 15) * 64, r0 = TC + (u >> 4) * 64;
        { const int c = tid >> 3, sg = (tid & 7) * 8;
          const u32x4 v = *(const u32x4*)(ZT + (size_t)(c0 + c) * T + r0 + sg);
#pragma unroll
          for (int w = 0; w < 4; ++w) { lds[(sg + 2 * w) * 66 + c] = (bf16_t)(v[w] & 0xffff); lds[(sg + 2 * w + 1) * 66 + c] = (bf16_t)(v[w] >> 16); } }
        __syncthreads();
        { const int r = tid >> 3, sg = (tid & 7) * 8; u32x4 o;
#pragma unroll
          for (int w = 0; w < 4; ++w) o[w] = (unsigned)lds[r * 66 + sg + 2 * w] | ((unsigned)lds[r * 66 + sg + 2 * w + 1] << 16);
          *(u32x4*)(U + (size_t)(r0 + r) * 1024 + c0 + sg) = o; }
        __syncthreads();
    }
}

__global__ void __launch_bounds__(NTHR, 2) fwd_kernel(Params prm) {
    extern __shared__ __attribute__((aligned(16))) unsigned char lds_raw[];
    LAS unsigned char* lds = (LAS unsigned char*)lds_raw;
    LAS float* ldsf = (LAS float*)lds;
    LAS bf16_t* ldsh = (LAS bf16_t*)lds;
    LAS int* tb = (LAS int*)(lds + 150 * 1024);
    volatile LAS unsigned* xbw = (volatile LAS unsigned*)(lds + 151 * 1024 + 512);
    KC k;
    k.x = (const float*)(GAS const float*)prm.in[0]; k.c = (const float*)(GAS const float*)prm.in[1]; k.ctx = (const float*)(GAS const float*)prm.in[2]; k.c_ctx = (const float*)(GAS const float*)prm.in[3]; k.ada_w = (const float*)(GAS const float*)prm.in[4]; k.ada_b = (const float*)(GAS const float*)prm.in[5];
    k.norm_mix = (const float*)(GAS const float*)prm.in[6]; k.norm_ffn = (const float*)(GAS const float*)prm.in[7]; k.norm_final = (const float*)(GAS const float*)prm.in[8];
    k.dn_w_in = (const float*)(GAS const float*)prm.in[9]; k.dn_conv = (const float*)(GAS const float*)prm.in[10]; k.dn_a_log = (const float*)(GAS const float*)prm.in[11]; k.dn_dt_bias = (const float*)(GAS const float*)prm.in[12]; k.dn_out_norm = (const float*)(GAS const float*)prm.in[13]; k.dn_w_out = (const float*)(GAS const float*)prm.in[14];
    k.hy_w_in = (const float*)(GAS const float*)prm.in[15]; k.hy_conv = (const float*)(GAS const float*)prm.in[16]; k.hy_f_w1 = (const float*)(GAS const float*)prm.in[17]; k.hy_f_b1 = (const float*)(GAS const float*)prm.in[18]; k.hy_f_freq = (const float*)(GAS const float*)prm.in[19]; k.hy_f_w2 = (const float*)(GAS const float*)prm.in[20];
    k.hy_f_b2 = (const float*)(GAS const float*)prm.in[21]; k.hy_f_w3 = (const float*)(GAS const float*)prm.in[22]; k.hy_bias = (const float*)(GAS const float*)prm.in[23]; k.hy_w_out = (const float*)(GAS const float*)prm.in[24];
    k.sc_w_in = (const float*)(GAS const float*)prm.in[25]; k.sc_conv = (const float*)(GAS const float*)prm.in[26]; k.sc_w_out = (const float*)(GAS const float*)prm.in[27]; k.w_router = (const float*)(GAS const float*)prm.in[28]; k.router_bias = (const float*)(GAS const float*)prm.in[29];
    k.moe_w_gate = (const float*)(GAS const float*)prm.in[30]; k.moe_w_up = (const float*)(GAS const float*)prm.in[31]; k.moe_w_down = (const float*)(GAS const float*)prm.in[32];
    k.out = (float*)(GAS float*)prm.out; k.ws = (unsigned char*)(GAS unsigned char*)prm.ws;
    const int lo = prm.ph_lo, hi = prm.ph_hi;
    XcdBarrier bar; bar.bar = (unsigned*)(k.ws + WS_CTL); bar.x = 0; bar.st = xbw;
    if (hi - lo > 1) {
        if (threadIdx.x == 0) { xbw[0] = 0u; xbw[1] = 0u; }
        __syncthreads();
        bar = xcd_barrier_post((unsigned*)(k.ws + WS_CTL), xbw);
    }
    int ph = 0;
#define PROBE_OK(id) ((id) != 1 || i == 0)
    int i = 0;
#define PH_BEGIN(id) if (ph >= lo && ph < hi) { const int nrep_ = (((id) == PROBE_REP) && PROBE_OK(id)) ? 2 : 1; for (int rep_ = 0; rep_ < nrep_; ++rep_) { { GAS unsigned char* w_ = (GAS unsigned char*)k.ws; asm volatile("" : "+s"(w_)); k.ws = (unsigned char*)w_; }
#define PH_END   if (ph + 1 < hi) xcd_barrier(bar); } } ++ph;

    float* xs = (float*)(k.ws + WS_XS);
    const float* mod = (const float*)(k.ws + WS_MOD);

    PH_BEGIN(0)
        job_mod(k, ldsf);
        job_cvt_small(k, ldsf);
        job_hdn(k, ldsf);
        job_w3s(k);
    PH_END

    for (i = 0; i < DEPTH; ++i) {
        const int kind = i % 3, j = i / 3;
        const bool last = (i == DEPTH - 1);
        PH_BEGIN(1)
            if (kind == 0) norm_phase<2>(k, i, i == 0, i > 0, k.norm_mix + i * 1024, 0, k.dn_w_in + (size_t)j * 1024 * DN_IN + 4096, DN_IN,
                                         k.dn_a_log + j * 16, k.dn_dt_bias + j * 16, last, ldsf);
            else norm_phase<0>(k, i, i == 0, i > 0, k.norm_mix + i * 1024, 0, nullptr, 0, nullptr, nullptr, last, ldsf);
            if (kind == 1) job_filtc(k, j);
        PH_END
        PH_BEGIN(2)
            if (kind == 0) { EpiBf16 e{(bf16_t*)(k.ws + AR_PB), 3072, 3072, (bf16_t*)k.out, 1024}; gemm_dense(lds, (const bf16_t*)(k.ws + AR_HBUF), T, (const bf16_t*)(k.ws + WS_DNWIN) + (size_t)j * 4096 * 1024, 4096, 1024, e); }
            else if (kind == 1) { EpiBf16T e{(bf16_t*)(k.ws + AR_PB), T}; gemm_dense(lds, (const bf16_t*)(k.ws + AR_HBUF), T, (const bf16_t*)(k.ws + WS_HYWIN), 3072, 1024, e);
                                  EpiTaps et{(float*)(k.ws + AR_FT)}; gemm_dense(lds, (const bf16_t*)(k.ws + WS_W3S), 4096, (const bf16_t*)(k.ws + WS_HS), 16384, 256, et); }
            else { EpiBf16 e{(bf16_t*)(k.ws + AR_PB), 3072, 1 << 30, nullptr, 0}; gemm_dense(lds, (const bf16_t*)(k.ws + AR_HBUF), T, (const bf16_t*)(k.ws + WS_SCWIN), 3072, 1024, e); }
        PH_END
        if (kind == 0) {
            PH_BEGIN(3) dn_chunk(k, j, lds); PH_END
            PH_BEGIN(4) dn_scan(k, lds); PH_END
            PH_BEGIN(5) dn_finish(k, j); PH_END
        } else if (kind == 1) {
            PH_BEGIN(6) hy_lat(k, j, ldsf); hy_ctx(k, j, ldsf); PH_END
            PH_BEGIN(7) hy_transpose(k, ldsh); PH_END
        } else {
            PH_BEGIN(8) sc_mix(k, j); PH_END
        }
        PH_BEGIN(9)
            const bf16_t* Wt = kind == 0 ? (const bf16_t*)(k.ws + WS_DNWOUT) + (size_t)j * 1024 * 1024 : (kind == 1 ? (const bf16_t*)(k.ws + WS_HYWOUT) : (const bf16_t*)(k.ws + WS_SCWOUT));
            EpiResid e{xs, mod, i, 2};
            gemm_dense(lds, (const bf16_t*)(k.ws + AR_UBUF), T, Wt, 1024, 1024, e);
            if (gridDim.x == 256) job_cvt_moe(k, i, ldsf, (int)blockIdx.x - 8, 248); else job_cvt_moe(k, i, ldsf, (int)blockIdx.x, (int)gridDim.x);
        PH_END
        PH_BEGIN(10)
            norm_phase<1>(k, i, false, false, k.norm_ffn + i * 1024, 3, k.w_router, 32, k.router_bias, nullptr, last, ldsf, rep_ == nrep_ - 1);
        PH_END
        PH_BEGIN(11)
            moe_scatter(k, i, tb);
        PH_END
        PH_BEGIN(12) moe_gemm<0>(k, i, lds, tb); PH_END
        PH_BEGIN(13) moe_gemm<1>(k, i, lds, tb); PH_END
    }
    PH_BEGIN(14)
        norm_phase<3>(k, DEPTH, false, true, k.norm_final, 0, nullptr, 0, nullptr, nullptr, false, ldsf);
    PH_END
#undef PH_BEGIN
#undef PH_END
}
constexpr int N_PHASES = 1 + (10 + 9 + 8 + 10) + 1;

extern "C" void kernel_launch(void* const* d_in, const int* in_sizes, int n_in, void* d_out, int out_size, void* d_ws, size_t ws_size, hipStream_t stream) {
    static int grid = 0;
    if (grid == 0) {
        if (n_in != 33 || out_size != TL * D || ws_size < WS_END) { fprintf(stderr, "kernel_launch: unexpected shapes: n_in %d out %d ws %zu (need %zu)\n", n_in, out_size, ws_size, (size_t)WS_END); grid = -1; return; }
        int dev = 0, cus = 0, per_cu = 0;
        if (hipGetDevice(&dev) != hipSuccess || hipDeviceGetAttribute(&cus, hipDeviceAttributeMultiprocessorCount, dev) != hipSuccess) { grid = -1; return; }
        if (hipFuncSetAttribute((const void*)fwd_kernel, hipFuncAttributeMaxDynamicSharedMemorySize, LDS_BYTES) != hipSuccess) { fprintf(stderr, "kernel_launch: hipFuncSetAttribute failed\n"); grid = -1; return; }
        if (hipOccupancyMaxActiveBlocksPerMultiprocessor(&per_cu, (const void*)fwd_kernel, NTHR, LDS_BYTES) != hipSuccess || per_cu < 1) fprintf(stderr, "kernel_launch: occupancy query reports %d\n", per_cu);
        (void)hipGetLastError();
        grid = cus;
    }
    if (grid < 0) return;
    (void)hipMemsetAsync((char*)d_ws + WS_CTL, 0, CTL_BYTES, stream);
    Params p{};
    for (int i = 0; i < 33; ++i) p.in[i] = (const float*)d_in[i];
    p.out = (float*)d_out; p.ws = (unsigned char*)d_ws;
#if MK_MULTI
    for (int ph = 0; ph < N_PHASES; ++ph) { p.ph_lo = ph; p.ph_hi = ph + 1; hipLaunchKernelGGL(fwd_kernel, dim3(grid), dim3(NTHR), LDS_BYTES, stream, p); }
#else
    p.ph_lo = 0; p.ph_hi = N_PHASES;
    hipLaunchKernelGGL(fwd_kernel, dim3(grid), dim3(NTHR), LDS_BYTES, stream, p);
#endif
}
```

```cpp
#include <hip/hip_runtime.h>
#include <stdint.h>
#include <stdio.h>
#include <math.h>

#ifndef MK_MULTI
#define MK_MULTI 0
#endif

#ifndef PROBE_SUB
#define PROBE_SUB (0)
#endif
#ifndef PROBE_REP
#define PROBE_REP (-1)
#endif
#define LAS __attribute__((address_space(3)))
#define GAS __attribute__((address_space(1)))
#define HD __host__ __device__ __forceinline__
#define DI __device__ __forceinline__
#ifdef NOINL
#define PF __device__ __noinline__
#else
#define PF __device__ __forceinline__
#endif
typedef unsigned short bf16_t;
typedef short bf16x8 __attribute__((ext_vector_type(8)));
typedef float f32x4 __attribute__((ext_vector_type(4)));
typedef unsigned u32x4 __attribute__((ext_vector_type(4)));
typedef unsigned u32x2 __attribute__((ext_vector_type(2)));

constexpr int D = 1024, NB = 2, SEQ = 16384, CTXL = 256, DEPTH = 4;
constexpr int TC = NB * CTXL, TL = NB * SEQ, T = TC + TL, NA = 2 * T;
constexpr int NTHR = 512;
constexpr int DN_IN = 4128;
constexpr float EPS = 1e-6f;
constexpr int LDS_BYTES = 152 * 1024;

constexpr size_t AL(size_t x) { return (x + 255) & ~(size_t)255; }
constexpr size_t WS_CTL = 0;
constexpr size_t CTL_BYTES = 65536;
constexpr size_t CTL_CNT = 16384;
constexpr size_t WS_MOD = WS_CTL + CTL_BYTES;
constexpr size_t WS_HS = AL(WS_MOD + 4 * 3 * 6144 * 4);
constexpr size_t WS_W3S = AL(WS_HS + 16384 * 256 * 2);
constexpr size_t WS_HDNC = AL(WS_W3S + 4096 * 256 * 2);
constexpr size_t WS_FILTC = AL(WS_HDNC + 256 * 64 * 4);
constexpr size_t WS_DNWIN = AL(WS_FILTC + 256 * 4096 * 4);
constexpr size_t WS_DNWOUT = AL(WS_DNWIN + (size_t)2 * 4096 * 1024 * 2);
constexpr size_t WS_HYWIN = AL(WS_DNWOUT + (size_t)2 * 1024 * 1024 * 2);
constexpr size_t WS_HYWOUT = AL(WS_HYWIN + (size_t)3072 * 1024 * 2);
constexpr size_t WS_SCWIN = AL(WS_HYWOUT + (size_t)1024 * 1024 * 2);
constexpr size_t WS_SCWOUT = AL(WS_SCWIN + (size_t)3072 * 1024 * 2);
constexpr size_t WS_XS = AL(WS_SCWOUT + (size_t)1024 * 1024 * 2);
constexpr size_t WS_TOKE = AL(WS_XS + (size_t)T * 1024 * 4);
constexpr size_t WS_TOKW = AL(WS_TOKE + (size_t)T * 2 * 4);
constexpr size_t WS_TOKP = AL(WS_TOKW + (size_t)T * 2 * 4);
constexpr size_t WS_SLOT = AL(WS_TOKP + (size_t)T * 2 * 4);
constexpr size_t WS_GB = AL(WS_SLOT + (size_t)(NA + 256) * 4);
constexpr size_t WS_EGL = AL(WS_GB + (size_t)T * 32 * 4);
constexpr size_t WS_AR = AL(WS_EGL + (size_t)32 * 260 * 4);
constexpr size_t AR_HBUF = WS_AR;
constexpr size_t AR_UBUF = AR_HBUF + (size_t)T * 1024 * 2;
constexpr size_t AR_PB = AR_UBUF + (size_t)T * 1024 * 2;
constexpr size_t AR_Q = AR_PB + (size_t)T * 4096 * 2;
constexpr size_t AR_CHUNK = AR_PB + (size_t)T * 3072 * 2;
constexpr size_t AR_DN_END = AR_CHUNK + (size_t)32 * 260 * 65536;
constexpr size_t AR_ZT = AR_Q;
constexpr size_t AR_FFTS = AR_ZT + (size_t)1024 * T * 2;
constexpr size_t AR_FT = AR_FFTS + (size_t)256 * 4 * 16384 * 8;
constexpr size_t AR_HY_END = AR_FT + (size_t)4096 * 16384 * 4;
constexpr size_t AR_HID = AR_PB;
constexpr size_t AR_YS = AR_HID + (size_t)NA * 512 * 2;
constexpr size_t AR_WGU = AR_YS + (size_t)NA * 1024 * 2;
constexpr size_t AR_WD = AR_WGU + (size_t)32 * 1024 * 1024 * 2;
constexpr size_t AR_MOE_END = AR_WD + (size_t)32 * 1024 * 512 * 2;
constexpr size_t WS_END = AR_DN_END > AR_HY_END ? (AR_DN_END > AR_MOE_END ? AR_DN_END : AR_MOE_END) : (AR_HY_END > AR_MOE_END ? AR_HY_END : AR_MOE_END);

#define XB_TMO      128
#define XB_XCNT(j)  (256  + 64 * (j))
#define XB_XSUB(j)  (1280 + 64 * (j))
#define XB_XGEN(j)  (2304 + 64 * (j))
#define XB_TOP      3328
#define XB_TOPGEN   3392
#define XCD_BAR_WORDS 3456
#define XB_SPIN_CAP (1u << 25)
DI unsigned xb_ld(unsigned* p)              { return __hip_atomic_load(p, __ATOMIC_RELAXED, __HIP_MEMORY_SCOPE_AGENT); }
DI unsigned xb_add(unsigned* p, unsigned v) { return __hip_atomic_fetch_add(p, v, __ATOMIC_RELAXED, __HIP_MEMORY_SCOPE_AGENT); }
DI unsigned xb_xcc_id() { return (unsigned)__builtin_amdgcn_s_getreg((3 << 11) | 20) & 0xFu; }
#define XB_SPIN(cond, bar) do { unsigned _sp = 0; while (cond) { __builtin_amdgcn_s_sleep(1); \
    if ((++_sp & 255u) == 0u) { if (xb_ld(&(bar)[XB_TMO])) break; if (_sp > XB_SPIN_CAP) { atomicAdd(&(bar)[XB_TMO], 1u); break; } } } } while (0)
struct XcdBarrier { unsigned* bar; unsigned x; volatile LAS unsigned* st; };
DI XcdBarrier xcd_barrier_post(unsigned* bar, volatile LAS unsigned* st) {
    XcdBarrier b; b.bar = bar; b.x = xb_xcc_id(); b.st = st;
    if (threadIdx.x == 0) (void)xb_add(&bar[XB_XCNT(b.x)], 1u);
    return b;
}
DI void xcd_barrier_complete(unsigned* bar, unsigned x, unsigned& nloc, unsigned& nx) {
    const unsigned G = gridDim.x * gridDim.y * gridDim.z;
    unsigned sum, cnt, mine, sp = 0u;
    for (;;) {
        sum = 0u; cnt = 0u; mine = 0u;
#pragma unroll
        for (unsigned j = 0; j < 16; ++j) { const unsigned c = xb_ld(&bar[XB_XCNT(j)]); sum += c; cnt += (c > 0u) ? 1u : 0u; mine = (j == x) ? c : mine; }
        if (sum == G) break;
        __builtin_amdgcn_s_sleep(1);
        if ((++sp & 255u) == 0u) { if (xb_ld(&bar[XB_TMO])) break; if (sp > XB_SPIN_CAP) { atomicAdd(&bar[XB_TMO], 1u); break; } }
    }
    nloc = mine > 0u ? mine : 1u; nx = cnt > 0u ? cnt : 1u;
}
DI void xcd_barrier(const XcdBarrier& b) {
    asm volatile("s_waitcnt vmcnt(0)" ::: "memory");
    __syncthreads();
    if (threadIdx.x == 0) {
        unsigned* bar = b.bar;
        __builtin_amdgcn_s_waitcnt(0);
        unsigned nloc = b.st[0], nx = b.st[1];
        if (nloc == 0u) { xcd_barrier_complete(bar, b.x, nloc, nx); b.st[0] = nloc; b.st[1] = nx; }
        const unsigned old = xb_add(&bar[XB_XSUB(b.x)], 1u);
        const unsigned gen = old / nloc;
        if (old + 1u == (gen + 1u) * nloc) {
            __builtin_amdgcn_fence(__ATOMIC_RELEASE, "agent");
            asm volatile("s_waitcnt vmcnt(0)" ::: "memory");
            const unsigned og = xb_add(&bar[XB_TOP], 1u);
            const unsigned tg = og / nx;
            if (og + 1u == (tg + 1u) * nx) xb_add(&bar[XB_TOPGEN], 1u);
            else XB_SPIN(xb_ld(&bar[XB_TOPGEN]) == tg, bar);
            __builtin_amdgcn_fence(__ATOMIC_ACQUIRE, "agent");
            xb_add(&bar[XB_XGEN(b.x)], 1u);
            asm volatile("s_waitcnt vmcnt(0)" ::: "memory");
        } else {
            XB_SPIN(xb_ld(&bar[XB_XGEN(b.x)]) == gen, bar);
            __builtin_amdgcn_fence(__ATOMIC_ACQUIRE, "agent");
            asm volatile("s_waitcnt vmcnt(0)" ::: "memory");
        }
    }
    __syncthreads();
}

typedef float f32x2_t __attribute__((ext_vector_type(2)));
typedef __bf16 bf16x2_t __attribute__((ext_vector_type(2)));
DI unsigned cvt_pk_bf16(float lo, float hi) { f32x2_t v; v.x = lo; v.y = hi; const bf16x2_t b = __builtin_convertvector(v, bf16x2_t); return __builtin_bit_cast(unsigned, b); }
DI bf16_t f2bf(float f) { return (bf16_t)(cvt_pk_bf16(f, f) & 0xffffu); }
DI float bf2f(bf16_t b) { return __uint_as_float(((unsigned)b) << 16); }
DI unsigned pk2(float lo, float hi) { return cvt_pk_bf16(lo, hi); }
DI float siluf(float x) { return x * __builtin_amdgcn_rcpf(1.0f + __expf(-x)); }
DI float sigmf(float x) { return 1.0f / (1.0f + __expf(-x)); }
DI float shi(float v, int src) { return __int_as_float(__builtin_amdgcn_ds_bpermute(src << 2, __float_as_int(v))); }
DI int shii(int v, int src) { return __builtin_amdgcn_ds_bpermute(src << 2, v); }
DI float shx(float v, int m, int lane) { return shi(v, lane ^ m); }
DI float wsum(float v, int lane) {
#pragma unroll
    for (int m = 32; m >= 1; m >>= 1) v += shx(v, m, lane);
    return v;
}
DI void lds_barrier() { asm volatile("s_waitcnt lgkmcnt(0)\n\ts_barrier" ::: "memory"); }
DI int TID() { int t = threadIdx.x; asm volatile("" : "+v"(t)); return t; }
DI int modrow(int r) { return r < TC ? 0 : 1 + (r - TC) / SEQ; }

typedef float cf __attribute__((ext_vector_type(2)));
HD cf cmul(cf a, cf b) { cf r; r.x = a.x * b.x - a.y * b.y; r.y = a.x * b.y + a.y * b.x; return r; }
HD cf cadd(cf a, cf b) { cf r; r.x = a.x + b.x; r.y = a.y + b.y; return r; }
HD cf csub(cf a, cf b) { cf r; r.x = a.x - b.x; r.y = a.y - b.y; return r; }
template <int R> HD constexpr int brev(int i) { int r = 0; for (int b = 1, t = R >> 1; b < R; b <<= 1, t >>= 1) if (i & b) r |= t; return r; }
#define FFT_C32 {1.0f, 0.98078528040323044913f, 0.92387953251128675613f, 0.83146961230254523708f, 0.70710678118654752440f, 0.55557023301960222474f, 0.38268343236508977173f, 0.19509032201612826785f, 0.0f, -0.19509032201612826785f, -0.38268343236508977173f, -0.55557023301960222474f, -0.70710678118654752440f, -0.83146961230254523708f, -0.92387953251128675613f, -0.98078528040323044913f}
#define FFT_S32 {0.0f, 0.19509032201612826785f, 0.38268343236508977173f, 0.55557023301960222474f, 0.70710678118654752440f, 0.83146961230254523708f, 0.92387953251128675613f, 0.98078528040323044913f, 1.0f, 0.98078528040323044913f, 0.92387953251128675613f, 0.83146961230254523708f, 0.70710678118654752440f, 0.55557023301960222474f, 0.38268343236508977173f, 0.19509032201612826785f}
template <int R> HD constexpr int ilog2c() { int l = 0; for (int r = R; r > 1; r >>= 1) ++l; return l; }
template <int R> HD void dft_fwd(cf (&v)[R]) {
    constexpr float C[16] = FFT_C32; constexpr float S[16] = FFT_S32;
    constexpr int LG = ilog2c<R>();
#pragma unroll
    for (int st = 0; st < LG; ++st) {
#pragma unroll
        for (int i = 0; i < R / 2; ++i) {
            const int len = R >> st, half = len >> 1, blk = i / half, j = i % half, i0 = blk * len + j, i1 = i0 + half;
            const cf a = v[i0], c = v[i1];
            v[i0] = cadd(a, c);
            const cf d = csub(a, c);
            const int ti = j * (32 / len);
            cf w; w.x = C[ti]; w.y = -S[ti];
            cf r;
            if (ti == 0) r = d;
            else if (ti == 8) { r.x = d.y; r.y = -d.x; }
            else if (ti == 4) { r.x = (d.x + d.y) * 0.70710678118654752440f; r.y = (d.y - d.x) * 0.70710678118654752440f; }
            else if (ti == 12) { r.x = (d.y - d.x) * 0.70710678118654752440f; r.y = -(d.x + d.y) * 0.70710678118654752440f; }
            else r = cmul(d, w);
            v[i1] = r;
        }
    }
}
template <int R> HD void dft_inv(cf (&v)[R]) {
    constexpr float C[16] = FFT_C32; constexpr float S[16] = FFT_S32;
    constexpr int LG = ilog2c<R>();
#pragma unroll
    for (int st = LG - 1; st >= 0; --st) {
#pragma unroll
        for (int i = 0; i < R / 2; ++i) {
            const int len = R >> st, half = len >> 1, blk = i / half, j = i % half, i0 = blk * len + j, i1 = i0 + half;
            const int ti = j * (32 / len);
            cf w; w.x = C[ti]; w.y = S[ti];
            const cf a = v[i0];
            const cf b1 = v[i1];
            cf c;
            if (ti == 0) c = b1;
            else if (ti == 8) { c.x = -b1.y; c.y = b1.x; }
            else if (ti == 4) { c.x = (b1.x - b1.y) * 0.70710678118654752440f; c.y = (b1.x + b1.y) * 0.70710678118654752440f; }
            else if (ti == 12) { c.x = -(b1.x + b1.y) * 0.70710678118654752440f; c.y = (b1.x - b1.y) * 0.70710678118654752440f; }
            else c = cmul(b1, w);
            v[i0] = cadd(a, c);
            v[i1] = csub(a, c);
        }
    }
}
#define PIDX(a) ((a) + (((a) >> 6) << 2))
template <int R> DI void fft_pass_fwd(LAS cf* X, const LAS cf* tw, int n, int g) {
    const int s = n / R, q = g / s, p = g - q * s, base = q * n + p;
    cf v[R];
#pragma unroll
    for (int k = 0; k < R; ++k) v[k] = X[PIDX(base + k * s)];
    dft_fwd<R>(v);
    if (s > 1) {
        int pp = p * (16384 / n); asm volatile("" : "+v"(pp));
        const cf w1 = tw[pp]; cf w = w1;
#pragma unroll
        for (int m = 1; m < R; ++m) { v[brev<R>(m)] = cmul(v[brev<R>(m)], w); w = cmul(w, w1); }
    }
#pragma unroll
    for (int k = 0; k < R; ++k) X[PIDX(base + k * s)] = v[k];
}
template <int R> DI void fft_pass_inv(LAS cf* X, const LAS cf* tw, int n, int g) {
    const int s = n / R, q = g / s, p = g - q * s, base = q * n + p;
    cf v[R];
#pragma unroll
    for (int k = 0; k < R; ++k) v[k] = X[PIDX(base + k * s)];
    if (s > 1) {
        int pp = p * (16384 / n); asm volatile("" : "+v"(pp));
        cf w1 = tw[pp]; w1.y = -w1.y; cf w = w1;
#pragma unroll
        for (int m = 1; m < R; ++m) { v[brev<R>(m)] = cmul(v[brev<R>(m)], w); w = cmul(w, w1); }
    }
    dft_inv<R>(v);
#pragma unroll
    for (int k = 0; k < R; ++k) X[PIDX(base + k * s)] = v[k];
}
DI void fft16k_fwd(LAS cf* X, const LAS cf* tw) {
    const int t = TID();
#pragma unroll 1
    for (int g = 0; g < 2; ++g) fft_pass_fwd<16>(X, tw, 16384, t + 512 * g);
    __syncthreads();
#pragma unroll 1
    for (int g = 0; g < 2; ++g) fft_pass_fwd<16>(X, tw, 1024, t + 512 * g);
    __syncthreads();
#pragma unroll 1
    for (int g = 0; g < 2; ++g) fft_pass_fwd<16>(X, tw, 64, t + 512 * g);
    __syncthreads();
#pragma unroll 1
    for (int g = 0; g < 8; ++g) fft_pass_fwd<4>(X, tw, 4, t + 512 * g);
    __syncthreads();
}
DI void fft16k_inv(LAS cf* X, const LAS cf* tw) {
    const int t = TID();
#pragma unroll 1
    for (int g = 0; g < 8; ++g) fft_pass_inv<4>(X, tw, 4, t + 512 * g);
    __syncthreads();
#pragma unroll 1
    for (int g = 0; g < 2; ++g) fft_pass_inv<16>(X, tw, 64, t + 512 * g);
    __syncthreads();
#pragma unroll 1
    for (int g = 0; g < 2; ++g) fft_pass_inv<16>(X, tw, 1024, t + 512 * g);
    __syncthreads();
#pragma unroll 1
    for (int g = 0; g < 2; ++g) fft_pass_inv<16>(X, tw, 16384, t + 512 * g);
    __syncthreads();
}

struct Params { const float* in[33]; float* out; unsigned char* ws; int ph_lo, ph_hi; };
struct KC {
    const float *x, *c, *ctx, *c_ctx, *ada_w, *ada_b, *norm_mix, *norm_ffn, *norm_final;
    const float *dn_w_in, *dn_conv, *dn_a_log, *dn_dt_bias, *dn_out_norm, *dn_w_out;
    const float *hy_w_in, *hy_conv, *hy_f_w1, *hy_f_b1, *hy_f_freq, *hy_f_w2, *hy_f_b2, *hy_f_w3, *hy_bias, *hy_w_out;
    const float *sc_w_in, *sc_conv, *sc_w_out, *w_router, *router_bias, *moe_w_gate, *moe_w_up, *moe_w_down;
    float* out; unsigned char* ws;
};

PF void job_mod(const KC& k, LAS float* lds) {
    const int tid = TID(), cj = tid & 63, kq = tid >> 6;
    float* mod = (float*)(k.ws + WS_MOD);
    LAS float* sl = lds + 2048;
    for (int i = tid; i < 3072; i += NTHR) { const float v = i < 1024 ? k.c_ctx[i] : k.c[i - 1024]; sl[i] = siluf(v); }
    __syncthreads();
    for (int u = blockIdx.x; u < DEPTH * 96; u += gridDim.x) {
        const int l = u / 96, cc = u % 96, col = cc * 64 + cj;
        const float* W = k.ada_w + (size_t)l * 1024 * 6144 + col;
        float a0 = 0.f, a1 = 0.f, a2 = 0.f;
        for (int k0 = kq * 128; k0 < kq * 128 + 128; k0 += 16) {
            float w[16];
#pragma unroll
            for (int e = 0; e < 16; ++e) w[e] = W[(size_t)(k0 + e) * 6144];
            asm volatile("" ::: "memory");
#pragma unroll
            for (int e = 0; e < 16; ++e) { a0 += sl[k0 + e] * w[e]; a1 += sl[1024 + k0 + e] * w[e]; a2 += sl[2048 + k0 + e] * w[e]; }
        }
        lds[(kq * 3 + 0) * 64 + cj] = a0; lds[(kq * 3 + 1) * 64 + cj] = a1; lds[(kq * 3 + 2) * 64 + cj] = a2;
        __syncthreads();
        if (tid < 192) {
            const int r = tid >> 6, j = tid & 63;
            float sacc = 0.f;
            for (int q = 0; q < 8; ++q) sacc += lds[(q * 3 + r) * 64 + j];
            mod[(size_t)(l * 3 + r) * 6144 + cc * 64 + j] = sacc + k.ada_b[l * 6144 + cc * 64 + j];
        }
        __syncthreads();
    }
}
DI void cvt_matrix(const float* src, int ld, size_t sstride, int K, int N, int nmat, bf16_t* dst, int ldd, size_t dstride, int mapmode, LAS float* lds, int bid, int nb) {
    const int tk = K / 64, tn = N / 64, per = tk * tn, tid = TID();
    const int r = tid >> 4, c4 = (tid & 15) * 4;
    f32x4 v0, v1;
    int u = bid;
    if (u < per * nmat) { const int m = u / per, t = u % per; const float* sp = src + (size_t)m * sstride + (size_t)((t / tn) * 64 + r) * ld + (t % tn) * 64 + c4; v0 = *(const f32x4*)sp; v1 = *(const f32x4*)(sp + (size_t)32 * ld); }
    for (; u < per * nmat; u += nb) {
        const int m = u / per, t = u % per, k0 = (t / tn) * 64, n0 = (t % tn) * 64;
        { LAS float* p = lds + r * 65 + c4; p[0] = v0[0]; p[1] = v0[1]; p[2] = v0[2]; p[3] = v0[3];
          LAS float* p2 = lds + (r + 32) * 65 + c4; p2[0] = v1[0]; p2[1] = v1[1]; p2[2] = v1[2]; p2[3] = v1[3]; }
        { const int un = u + nb;
          if (un < per * nmat) { const int mn = un / per, tn_ = un % per; const float* sp = src + (size_t)mn * sstride + (size_t)((tn_ / tn) * 64 + r) * ld + (tn_ % tn) * 64 + c4; v0 = *(const f32x4*)sp; v1 = *(const f32x4*)(sp + (size_t)32 * ld); } }
        lds_barrier();
        { const int nn = tid >> 3, ks = (tid & 7) * 8; const int n = n0 + nn;
          const int row = mapmode == 0 ? n : (32 * (n >> 4) + (n & 15) + (mapmode == 2 ? 16 : 0));
          float f[8];
#pragma unroll
          for (int e = 0; e < 8; ++e) f[e] = lds[(ks + e) * 65 + nn];
          u32x4 o; o[0] = pk2(f[0], f[1]); o[1] = pk2(f[2], f[3]); o[2] = pk2(f[4], f[5]); o[3] = pk2(f[6], f[7]);
          *(u32x4*)(dst + (size_t)m * dstride + (size_t)row * ldd + k0 + ks) = o; }
        lds_barrier();
    }
}
PF void job_cvt_small(const KC& k, LAS float* lds) {
    cvt_matrix(k.dn_w_in, DN_IN, (size_t)1024 * DN_IN, 1024, 4096, 2, (bf16_t*)(k.ws + WS_DNWIN), 1024, (size_t)4096 * 1024, 0, lds, (int)blockIdx.x, (int)gridDim.x);
    cvt_matrix(k.dn_w_out, 1024, (size_t)1024 * 1024, 1024, 1024, 2, (bf16_t*)(k.ws + WS_DNWOUT), 1024, (size_t)1024 * 1024, 0, lds, (int)blockIdx.x, (int)gridDim.x);
    cvt_matrix(k.hy_w_in, 3072, 0, 1024, 3072, 1, (bf16_t*)(k.ws + WS_HYWIN), 1024, 0, 0, lds, (int)blockIdx.x, (int)gridDim.x);
    cvt_matrix(k.hy_w_out, 1024, 0, 1024, 1024, 1, (bf16_t*)(k.ws + WS_HYWOUT), 1024, 0, 0, lds, (int)blockIdx.x, (int)gridDim.x);
    cvt_matrix(k.sc_w_in, 3072, 0, 1024, 3072, 1, (bf16_t*)(k.ws + WS_SCWIN), 1024, 0, 0, lds, (int)blockIdx.x, (int)gridDim.x);
    cvt_matrix(k.sc_w_out, 1024, 0, 1024, 1024, 1, (bf16_t*)(k.ws + WS_SCWOUT), 1024, 0, 0, lds, (int)blockIdx.x, (int)gridDim.x);
}
PF void job_cvt_moe(const KC& k, int layer, LAS float* lds, int bid, int nb) {
    if (bid < 0) return;
    const size_t lo = (size_t)layer * 32 * 1024 * 512;
    cvt_matrix(k.moe_w_gate + lo, 512, (size_t)1024 * 512, 1024, 512, 32, (bf16_t*)(k.ws + AR_WGU), 1024, (size_t)1024 * 1024, 1, lds, bid, nb);
    cvt_matrix(k.moe_w_up + lo, 512, (size_t)1024 * 512, 1024, 512, 32, (bf16_t*)(k.ws + AR_WGU), 1024, (size_t)1024 * 1024, 2, lds, bid, nb);
    cvt_matrix(k.moe_w_down + lo, 1024, (size_t)512 * 1024, 512, 1024, 32, (bf16_t*)(k.ws + AR_WD), 512, (size_t)1024 * 512, 0, lds, bid, nb);
}
PF void job_hdn(const KC& k, LAS float* lds) {
    const int tid = TID(), lane = tid & 63, wave = tid >> 6;
    LAS float* feat = lds + wave * 128; LAS float* h1 = feat + 64;
    const float fr = k.hy_f_freq[lane], b1 = k.hy_f_b1[lane], b2 = k.hy_f_b2[lane];
    for (int u0 = blockIdx.x * 8; u0 < 16384 + 256; u0 += gridDim.x * 8) {
        const int u = u0 + wave;
        int l, pos; float* dst;
        if (u < 16384) { l = 16384; pos = u; dst = nullptr; }
        else { l = 256; pos = u - 16384; dst = (float*)(k.ws + WS_HDNC) + (size_t)pos * 64; }
        const float t = (float)pos / (float)(l - 1);
        float f = 0.f;
        if (lane == 0) f = t;
        else if (lane <= 32) {
            const int bi = (lane - 1) & 15;
            const float band = 1e-4f + (float)bi * ((15.0f - 1e-4f) / 15.0f);
            const float ang = (6.283185307179586f / (float)l) * (float)pos * band;
            f = lane <= 16 ? cosf(ang) : -sinf(ang);
        }
        feat[lane] = f;
        __syncthreads();
        float a = b1;
        for (int i = 0; i < 33; ++i) a += feat[i] * k.hy_f_w1[i * 64 + lane];
        h1[lane] = sinf(fr * a);
        __syncthreads();
        float a2 = b2;
        for (int j = 0; j < 64; ++j) a2 += h1[j] * k.hy_f_w2[j * 64 + lane];
        const float hv = sinf(fr * a2);
        if (dst) dst[lane] = hv;
        else { bf16_t* hs = (bf16_t*)(k.ws + WS_HS) + (size_t)pos * 256; const bf16_t hi = f2bf(hv), lo = f2bf(hv - bf2f(hi)); hs[lane] = hi; hs[64 + lane] = lo; hs[128 + lane] = hi; hs[192 + lane] = 0; }
        __syncthreads();
    }
}
PF void job_w3s(const KC& k) {
    bf16_t* W = (bf16_t*)(k.ws + WS_W3S);
    const int tq = TID();
    for (int idx = blockIdx.x * NTHR + tq; idx < 64 * 4096; idx += gridDim.x * NTHR) {
        const int j = idx >> 12, col = idx & 4095;
        const float w = k.hy_f_w3[idx]; const bf16_t hi = f2bf(w), lo = f2bf(w - bf2f(hi));
        W[(size_t)col * 256 + j] = hi; W[(size_t)col * 256 + 64 + j] = hi; W[(size_t)col * 256 + 128 + j] = lo; W[(size_t)col * 256 + 192 + j] = 0;
    }
}
DI float hy_delta(int ch) {
    const float lo = -4.605170185988091f / 1.5f, hi = -4.605170185988091f / 0.3f;
    return fabsf(lo + (float)ch * ((hi - lo) / 1023.0f));
}
PF void job_filtc(const KC& k, int j) {
    const float* hdn = (const float*)(k.ws + WS_HDNC);
    const float* w3 = k.hy_f_w3 + (size_t)j * 64 * 4096;
    float* filtc = (float*)(k.ws + WS_FILTC);
    const int tq = TID();
    for (int u = blockIdx.x; u < 256 * 8; u += gridDim.x) {
        const int l = u >> 3, col = (u & 7) * 512 + tq;
        float a = 0.f;
        for (int q = 0; q < 64; ++q) a += hdn[l * 64 + q] * w3[(size_t)q * 4096 + col];
        const float t = (float)l / 255.0f;
        filtc[(size_t)l * 4096 + col] = a * expf(-t * hy_delta(col & 1023));
    }
}

template <int MODE>
PF void norm_phase(const KC& k, int layer, bool first, bool combine, const float* __restrict__ gain, int mb, const float* __restrict__ Wsk, int ldw,
                   const float* __restrict__ aux0, const float* __restrict__ aux1, bool last, LAS float* lds, bool flush = true) {
    const int tid = TID(), lane = tid & 63, wave = tid >> 6;
    float* xs = (float*)(k.ws + WS_XS);
    bf16_t* hbuf = (bf16_t*)(k.ws + AR_HBUF);
    const float* mod = (const float*)(k.ws + WS_MOD);
    const bf16_t* ys = (const bf16_t*)(k.ws + AR_YS);
    const int* tokp = (const int*)(k.ws + WS_TOKP);
    const float* tokw = (const float*)(k.ws + WS_TOKW);
    LAS int* lcnt = (LAS int*)(lds + 32768);
    if (MODE == 1 && tid < 32) lcnt[tid] = 0;
    if (MODE == 1 || MODE == 2) {
        for (int idx = tid; idx < 1024 * 32; idx += NTHR) {
            const int kk = idx >> 5, n = idx & 31;
            lds[kk * 32 + (((n >> 2) ^ ((kk >> 1) & 7)) << 2) + (n & 3)] = Wsk[(size_t)kk * ldw + n];
        }
        __syncthreads();
    }
    const int rbeg = (MODE == 3) ? TC : 0, rstr = gridDim.x * 8;
    int cur_mr = -1; float gsv[16], shv[16], g5v[16];
    float xn[16];
    int r = rbeg + blockIdx.x * 8 + wave;
    if (r < T) {
        const float* src = first ? (r < TC ? k.ctx + (size_t)r * 1024 : k.x + (size_t)(r - TC) * 1024) : xs + (size_t)r * 1024;
#pragma unroll
        for (int m = 0; m < 16; ++m) xn[m] = src[lane + 64 * m];
    }
    for (; r < T; r += rstr) {
        const int mr = modrow(r);
        float x[16];
#pragma unroll
        for (int m = 0; m < 16; ++m) x[m] = xn[m];
        int p0 = 0, p1 = 0; float w0 = 0.f, w1 = 0.f;
        if (combine) { p0 = tokp[2 * r]; p1 = tokp[2 * r + 1]; w0 = tokw[2 * r]; w1 = tokw[2 * r + 1]; }
        {
            const int rn = r + rstr;
            if (rn < T) {
                const float* srcn = first ? (rn < TC ? k.ctx + (size_t)rn * 1024 : k.x + (size_t)(rn - TC) * 1024) : xs + (size_t)rn * 1024;
#pragma unroll
                for (int m = 0; m < 16; ++m) xn[m] = srcn[lane + 64 * m];
            }
        }
        if (mr != cur_mr) {
            cur_mr = mr;
            if (MODE != 3) {
                const float* shift = mod + ((size_t)(layer * 3 + mr) * 6 + mb) * 1024;
#pragma unroll
                for (int m = 0; m < 16; ++m) { const int col = lane + 64 * m; gsv[m] = gain[col] * (1.0f + shift[1024 + col]); shv[m] = shift[col]; }
            } else {
#pragma unroll
                for (int m = 0; m < 16; ++m) gsv[m] = gain[lane + 64 * m];
            }
            if (combine) {
                const float* g5 = mod + ((size_t)((layer - 1) * 3 + mr) * 6 + 5) * 1024;
#pragma unroll
                for (int m = 0; m < 16; ++m) g5v[m] = g5[lane + 64 * m];
            }
        }
        if (combine) {
            bf16_t ya[16], yb[16];
#pragma unroll
            for (int m = 0; m < 16; ++m) { const int col = lane + 64 * m; ya[m] = ys[(size_t)p0 * 1024 + col]; yb[m] = ys[(size_t)p1 * 1024 + col]; }
            asm volatile("" ::: "memory");
#pragma unroll
            for (int m = 0; m < 16; ++m) x[m] += g5v[m] * (w0 * bf2f(ya[m]) + w1 * bf2f(yb[m]));
        }
        if (first || combine) {
#pragma unroll
            for (int m = 0; m < 16; ++m) xs[(size_t)r * 1024 + lane + 64 * m] = x[m];
        }
        float ss = 0.f;
#pragma unroll
        for (int m = 0; m < 16; ++m) ss += x[m] * x[m];
        ss = wsum(ss, lane);
        const float rstd = rsqrtf(ss * (1.0f / 1024.0f) + EPS);
        if (MODE == 3) {
#pragma unroll
            for (int m = 0; m < 16; ++m) { const int col = lane + 64 * m; k.out[(size_t)(r - TC) * 1024 + col] = x[m] * rstd * gsv[m]; }
            continue;
        }
        float y[16];
#pragma unroll
        for (int m = 0; m < 16; ++m) {
            const int col = lane + 64 * m;
            y[m] = x[m] * rstd * gsv[m] + shv[m];
            hbuf[(size_t)r * 1024 + col] = f2bf(y[m]);
        }
        if (MODE == 1 || MODE == 2) {
            float acc[32];
#pragma unroll
            for (int n = 0; n < 32; ++n) acc[n] = 0.f;
#pragma unroll
            for (int m = 0; m < 16; ++m) {
                f32x4 wa[8];
                const int c = lane + 64 * m; const LAS float* wr = lds + c * 32; const int sw = (c >> 1) & 7;
#pragma unroll
                for (int q = 0; q < 8; ++q) wa[q] = *(const LAS f32x4*)(wr + ((q ^ sw) << 2));
                asm volatile("" ::: "memory");
#pragma unroll
                for (int q = 0; q < 8; ++q) { acc[4 * q + 0] += y[m] * wa[q][0]; acc[4 * q + 1] += y[m] * wa[q][1]; acc[4 * q + 2] += y[m] * wa[q][2]; acc[4 * q + 3] += y[m] * wa[q][3]; }
            }
            float val;
            {
                float a16[16], a8[8], a4[4], a2[2];
                const bool b5 = (lane & 32) != 0, b4 = (lane & 16) != 0, b3 = (lane & 8) != 0, b2 = (lane & 4) != 0, b1 = (lane & 2) != 0;
#pragma unroll
                for (int i = 0; i < 16; ++i) { const float send = b5 ? acc[i] : acc[i + 16], keep = b5 ? acc[i + 16] : acc[i]; a16[i] = keep + shx(send, 32, lane); }
#pragma unroll
                for (int i = 0; i < 8; ++i) { const float send = b4 ? a16[i] : a16[i + 8], keep = b4 ? a16[i + 8] : a16[i]; a8[i] = keep + shx(send, 16, lane); }
#pragma unroll
                for (int i = 0; i < 4; ++i) { const float send = b3 ? a8[i] : a8[i + 4], keep = b3 ? a8[i + 4] : a8[i]; a4[i] = keep + shx(send, 8, lane); }
#pragma unroll
                for (int i = 0; i < 2; ++i) { const float send = b2 ? a4[i] : a4[i + 2], keep = b2 ? a4[i + 2] : a4[i]; a2[i] = keep + shx(send, 4, lane); }
                { const float send = b1 ? a2[0] : a2[1], keep = b1 ? a2[1] : a2[0]; val = keep + shx(send, 2, lane); }
                val += shx(val, 1, lane);
            }
            const int n = lane >> 1;
            if (MODE == 1) {
                int* toke = (int*)(k.ws + WS_TOKE); float* tokwW = (float*)(k.ws + WS_TOKW);
                if (last && r < TC) { if (lane == 0) { int neg = -1; asm volatile("" : "+v"(neg)); toke[2 * r] = neg; toke[2 * r + 1] = neg; } continue; }
                const float sc = 1.0f / (1.0f + expf(-val)), ch = sc + aux0[n];
                const int gl = lane & ~7;
                const float ca = shi(ch, gl), cb = shi(ch, gl + 2), cc = shi(ch, gl + 4), cd = shi(ch, gl + 6);
                const float hi1 = fmaxf(ca, cb), lo1 = fminf(ca, cb), hi2 = fmaxf(cc, cd), lo2 = fminf(cc, cd);
                float gs = fmaxf(hi1, hi2) + fmaxf(fminf(hi1, hi2), fmaxf(lo1, lo2));
                int gi = lane >> 3;
#pragma unroll
                for (int m = 8; m <= 32; m <<= 1) {
                    const float og = shx(gs, m, lane); const int oi = shii(gi, lane ^ m);
                    if (og > gs || (og == gs && oi < gi)) { gs = og; gi = oi; }
                }
                float c4[4], s4[4];
#pragma unroll
                for (int i = 0; i < 4; ++i) { c4[i] = shi(ch, gi * 8 + 2 * i); s4[i] = shi(sc, gi * 8 + 2 * i); }
                int i1 = 0; float b1v = c4[0];
#pragma unroll
                for (int i = 1; i < 4; ++i) if (c4[i] > b1v) { b1v = c4[i]; i1 = i; }
                int i2 = -1; float b2v = -1e30f;
#pragma unroll
                for (int i = 0; i < 4; ++i) if (i != i1 && c4[i] > b2v) { b2v = c4[i]; i2 = i; }
                float w1v = 0.f, w2v = 0.f;
#pragma unroll
                for (int i = 0; i < 4; ++i) { if (i == i1) w1v = s4[i]; if (i == i2) w2v = s4[i]; }
                const float inv = 1.0f / (w1v + w2v);
                if (lane == 0) {
                    const int e1 = gi * 4 + i1, e2 = gi * 4 + i2;
                    toke[2 * r] = e1; toke[2 * r + 1] = e2; tokwW[2 * r] = w1v * inv; tokwW[2 * r + 1] = w2v * inv;
                    __hip_atomic_fetch_add(lcnt + e1, 1, __ATOMIC_RELAXED, __HIP_MEMORY_SCOPE_WORKGROUP);
                    __hip_atomic_fetch_add(lcnt + e2, 1, __ATOMIC_RELAXED, __HIP_MEMORY_SCOPE_WORKGROUP);
                }
            } else {
                float* gb = (float*)(k.ws + WS_GB);
                if ((lane & 1) == 0) {
                    if (n < 16) {
                        const float z = val + aux1[n];
                        const float ez = __expf(z); const float sp = z > 15.f ? z : (ez < 1e-4f ? ez - 0.5f * ez * ez : __logf(1.0f + ez));
                        gb[(size_t)r * 32 + n] = -expf(aux0[n]) * sp;
                    } else {
                        gb[(size_t)r * 32 + n] = 1.0f / (1.0f + expf(-val));
                    }
                }
            }
        }
    }
    if (MODE == 1) {
        __syncthreads();
        int* cnt = (int*)(k.ws + WS_CTL + CTL_CNT) + layer * 32;
        if (flush && tid < 32 && lcnt[tid] > 0) atomicAdd(&cnt[tid], lcnt[tid]);
    }
}

constexpr int NM_WLD = 1032;
template <int MODE>
PF void norm_mfma(const KC& k, int layer, bool first, bool combine, const float* __restrict__ gain, int mb, const float* __restrict__ Wsk, int ldw,
                  const float* __restrict__ aux0, const float* __restrict__ aux1, bool last, LAS unsigned char* lds, bool flush = true) {
    const int tid = TID(), lane = tid & 63, wave = __builtin_amdgcn_readfirstlane(tid >> 6), row = lane & 15, q = lane >> 4;
    LAS bf16_t* WtH = (LAS bf16_t*)lds; LAS bf16_t* WtL = WtH + 32 * NM_WLD;
    LAS float* red = (LAS float*)(WtL + 32 * NM_WLD);
    LAS float* lg = red + 128;
    LAS int* lcnt = (LAS int*)(lg + 8 * 16 * 32);
    float* xs = (float*)(k.ws + WS_XS);
    bf16_t* hbuf = (bf16_t*)(k.ws + AR_HBUF);
    const float* mod = (const float*)(k.ws + WS_MOD);
    const bf16_t* ys = (const bf16_t*)(k.ws + AR_YS);
    const int* tokp = (const int*)(k.ws + WS_TOKP); const float* tokw = (const float*)(k.ws + WS_TOKW);
    if (MODE == 1 && tid < 32) lcnt[tid] = 0;
    for (int idx = tid; idx < 1024 * 32; idx += NTHR) {
        const int kk = idx >> 5, n = idx & 31;
        const float w = Wsk[(size_t)kk * ldw + n]; const bf16_t hi = f2bf(w);
        WtH[n * NM_WLD + kk] = hi; WtL[n * NM_WLD + kk] = f2bf(w - bf2f(hi));
    }
    __syncthreads();
    const int cbase = 128 * wave + 8 * q;
    f32x4 xn[8];
    int bt = blockIdx.x;
    if (bt < T / 16) {
        const float* sb = first ? (16 * bt < TC ? k.ctx : k.x - (size_t)TC * 1024) : xs;
        const unsigned off = (unsigned)(16 * bt + row) * 1024u + (unsigned)cbase;
#pragma unroll
        for (int kk = 0; kk < 4; ++kk) { xn[2 * kk] = *(const f32x4*)(sb + off + 32 * kk); xn[2 * kk + 1] = *(const f32x4*)(sb + off + 32 * kk + 4); }
    }
    for (; bt < T / 16; bt += gridDim.x) {
        const int r = 16 * bt + row, mr = modrow(16 * bt);
        const unsigned roff = (unsigned)r * 1024u + (unsigned)cbase;
        float x[32];
#pragma unroll
        for (int i = 0; i < 8; ++i) { x[4 * i] = xn[i][0]; x[4 * i + 1] = xn[i][1]; x[4 * i + 2] = xn[i][2]; x[4 * i + 3] = xn[i][3]; }
        int p0 = 0, p1 = 0; float w0 = 0.f, w1 = 0.f;
        if (combine) { p0 = tokp[2 * r]; p1 = tokp[2 * r + 1]; w0 = tokw[2 * r]; w1 = tokw[2 * r + 1]; }
        {
            const int bn = bt + gridDim.x;
            if (bn < T / 16) {
                const float* sb = first ? (16 * bn < TC ? k.ctx : k.x - (size_t)TC * 1024) : xs;
                const unsigned off = (unsigned)(16 * bn + row) * 1024u + (unsigned)cbase;
#pragma unroll
                for (int kk = 0; kk < 4; ++kk) { xn[2 * kk] = *(const f32x4*)(sb + off + 32 * kk); xn[2 * kk + 1] = *(const f32x4*)(sb + off + 32 * kk + 4); }
            }
        }
        const float* shift = mod + ((size_t)(layer * 3 + mr) * 6 + mb) * 1024;
        if (combine) {
            const float* g5 = mod + ((size_t)((layer - 1) * 3 + mr) * 6 + 5) * 1024;
            u32x4 ya[4], yb[4]; float g5v[32];
#pragma unroll
            for (int kk = 0; kk < 4; ++kk) { ya[kk] = *(const u32x4*)(ys + (size_t)p0 * 1024 + cbase + 32 * kk); yb[kk] = *(const u32x4*)(ys + (size_t)p1 * 1024 + cbase + 32 * kk);
                const f32x4 ga = *(const f32x4*)(g5 + cbase + 32 * kk), gb2 = *(const f32x4*)(g5 + cbase + 32 * kk + 4);
#pragma unroll
                for (int e = 0; e < 4; ++e) { g5v[8 * kk + e] = ga[e]; g5v[8 * kk + 4 + e] = gb2[e]; } }
            asm volatile("" ::: "memory");
#pragma unroll
            for (int kk = 0; kk < 4; ++kk)
#pragma unroll
                for (int w = 0; w < 4; ++w) {
                    x[8 * kk + 2 * w] += g5v[8 * kk + 2 * w] * (w0 * __uint_as_float(ya[kk][w] << 16) + w1 * __uint_as_float(yb[kk][w] << 16));
                    x[8 * kk + 2 * w + 1] += g5v[8 * kk + 2 * w + 1] * (w0 * __uint_as_float(ya[kk][w] & 0xffff0000u) + w1 * __uint_as_float(yb[kk][w] & 0xffff0000u));
                }
        }
        if (first || combine) {
#pragma unroll
            for (int kk = 0; kk < 4; ++kk) {
                *(f32x4*)(xs + roff + 32 * kk) = (f32x4){x[8 * kk], x[8 * kk + 1], x[8 * kk + 2], x[8 * kk + 3]};
                *(f32x4*)(xs + roff + 32 * kk + 4) = (f32x4){x[8 * kk + 4], x[8 * kk + 5], x[8 * kk + 6], x[8 * kk + 7]};
            }
        }
        float ss = 0.f;
#pragma unroll
        for (int i = 0; i < 32; ++i) ss += x[i] * x[i];
        ss += shx(ss, 16, lane); ss += shx(ss, 32, lane);
        if (q == 0) red[wave * 16 + row] = ss;
        __syncthreads();
        float tot = 0.f;
#pragma unroll
        for (int w = 0; w < 8; ++w) tot += red[w * 16 + row];
        const float rstd = rsqrtf(tot * (1.0f / 1024.0f) + EPS);
        f32x4 acc[2]; acc[0] = (f32x4){0.f, 0.f, 0.f, 0.f}; acc[1] = (f32x4){0.f, 0.f, 0.f, 0.f};
#pragma unroll
        for (int kk = 0; kk < 4; ++kk) {
            float y[8]; u32x4 ah, al;
            {
                const unsigned co = (unsigned)cbase + 32u * kk;
                const f32x4 g0 = *(const f32x4*)(gain + co), g1 = *(const f32x4*)(gain + co + 4), s0 = *(const f32x4*)(shift + 1024 + co), s1 = *(const f32x4*)(shift + 1024 + co + 4),
                            h0 = *(const f32x4*)(shift + co), h1 = *(const f32x4*)(shift + co + 4);
#pragma unroll
                for (int e = 0; e < 4; ++e) { y[e] = x[8 * kk + e] * rstd * g0[e] * (1.0f + s0[e]) + h0[e]; y[4 + e] = x[8 * kk + 4 + e] * rstd * g1[e] * (1.0f + s1[e]) + h1[e]; }
            }
#pragma unroll
            for (int w = 0; w < 4; ++w) {
                ah[w] = pk2(y[2 * w], y[2 * w + 1]);
                al[w] = pk2(y[2 * w] - __uint_as_float(ah[w] << 16), y[2 * w + 1] - __uint_as_float(ah[w] & 0xffff0000u));
            }
            *(u32x4*)(hbuf + roff + 32 * kk) = ah;
            const bf16x8 fah = __builtin_bit_cast(bf16x8, ah), fal = __builtin_bit_cast(bf16x8, al);
            bf16x8 bh[2], bl[2];
#pragma unroll
            for (int nt = 0; nt < 2; ++nt) {
                bh[nt] = *(const LAS bf16x8*)(WtH + (16 * nt + row) * NM_WLD + cbase + 32 * kk);
                bl[nt] = *(const LAS bf16x8*)(WtL + (16 * nt + row) * NM_WLD + cbase + 32 * kk);
            }
            asm volatile("" ::: "memory");
#pragma unroll
            for (int nt = 0; nt < 2; ++nt) {
                acc[nt] = __builtin_amdgcn_mfma_f32_16x16x32_bf16(fah, bh[nt], acc[nt], 0, 0, 0);
                acc[nt] = __builtin_amdgcn_mfma_f32_16x16x32_bf16(fal, bh[nt], acc[nt], 0, 0, 0);
                acc[nt] = __builtin_amdgcn_mfma_f32_16x16x32_bf16(fah, bl[nt], acc[nt], 0, 0, 0);
            }
        }
#pragma unroll
        for (int nt = 0; nt < 2; ++nt)
#pragma unroll
            for (int j = 0; j < 4; ++j) lg[(wave * 16 + 4 * q + j) * 32 + 16 * nt + row] = acc[nt][j];
        __syncthreads();
        {
            const int prow = tid >> 5, n = tid & 31, rr = 16 * bt + prow, hb = lane & 32;
            float val = 0.f;
#pragma unroll
            for (int w = 0; w < 8; ++w) val += lg[(w * 16 + prow) * 32 + n];
            if (MODE == 1) {
                int* toke = (int*)(k.ws + WS_TOKE); float* tokwW = (float*)(k.ws + WS_TOKW);
                const bool unrouted = last && rr < TC;
                const float sc = 1.0f / (1.0f + expf(-val)), ch = sc + aux0[n];
                const int gl = hb + (n & ~3);
                const float ca = shi(ch, gl), cb = shi(ch, gl + 1), cc = shi(ch, gl + 2), cd = shi(ch, gl + 3);
                const float hi1 = fmaxf(ca, cb), lo1 = fminf(ca, cb), hi2 = fmaxf(cc, cd), lo2 = fminf(cc, cd);
                float gs = fmaxf(hi1, hi2) + fmaxf(fminf(hi1, hi2), fmaxf(lo1, lo2));
                int gi = n >> 2;
#pragma unroll
                for (int m = 4; m <= 16; m <<= 1) {
                    const float og = shx(gs, m, lane); const int oi = shii(gi, lane ^ m);
                    if (og > gs || (og == gs && oi < gi)) { gs = og; gi = oi; }
                }
                float c4[4], s4[4];
#pragma unroll
                for (int i = 0; i < 4; ++i) { c4[i] = shi(ch, hb + gi * 4 + i); s4[i] = shi(sc, hb + gi * 4 + i); }
                int i1 = 0; float b1v = c4[0];
#pragma unroll
                for (int i = 1; i < 4; ++i) if (c4[i] > b1v) { b1v = c4[i]; i1 = i; }
                int i2 = -1; float b2v = -1e30f;
#pragma unroll
                for (int i = 0; i < 4; ++i) if (i != i1 && c4[i] > b2v) { b2v = c4[i]; i2 = i; }
                float w1v = 0.f, w2v = 0.f;
#pragma unroll
                for (int i = 0; i < 4; ++i) { if (i == i1) w1v = s4[i]; if (i == i2) w2v = s4[i]; }
                const float inv = 1.0f / (w1v + w2v);
                if (n == 0) {
                    if (unrouted) { int neg = -1; asm volatile("" : "+v"(neg)); toke[2 * rr] = neg; toke[2 * rr + 1] = neg; }
                    else {
                        const int e1 = gi * 4 + i1, e2 = gi * 4 + i2;
                        toke[2 * rr] = e1; toke[2 * rr + 1] = e2; tokwW[2 * rr] = w1v * inv; tokwW[2 * rr + 1] = w2v * inv;
                        __hip_atomic_fetch_add(lcnt + e1, 1, __ATOMIC_RELAXED, __HIP_MEMORY_SCOPE_WORKGROUP);
                        __hip_atomic_fetch_add(lcnt + e2, 1, __ATOMIC_RELAXED, __HIP_MEMORY_SCOPE_WORKGROUP);
                    }
                }
            } else {
                float* gb = (float*)(k.ws + WS_GB);
                if (n < 16) {
                    const float z = val + aux1[n];
                    const float ez = __expf(z); const float sp = z > 15.f ? z : (ez < 1e-4f ? ez - 0.5f * ez * ez : __logf(1.0f + ez));
                    gb[(size_t)rr * 32 + n] = -expf(aux0[n]) * sp;
                } else {
                    gb[(size_t)rr * 32 + n] = 1.0f / (1.0f + expf(-val));
                }
            }
        }
        __syncthreads();
    }
    if (MODE == 1) {
        __syncthreads();
        int* cnt = (int*)(k.ws + WS_CTL + CTL_CNT) + layer * 32;
        if (flush && tid < 32 && lcnt[tid] > 0) atomicAdd(&cnt[tid], lcnt[tid]);
    }
}

namespace pg8 {
constexpr int BM = 256, BK = 64, HALF = 128, HTB = HALF * BK * 2, STAGE_BYTES = 8 * HTB;
DI int lds_byte(int r, int c) { const int st = (r >> 4) * 2 + (c >> 5), rr = r & 15, cc = c & 31, ob = rr * 64 + cc * 2; return st * 1024 + (ob ^ (((ob >> 9) & 1) << 5)); }
DI void stage_rc(int b, int& R, int& C) { const int st = b / 1024, sb = b % 1024, swz = sb ^ (((sb >> 9) & 1) << 5); R = (st >> 1) * 16 + swz / 64; C = (st & 1) * 32 + (swz % 64) / 2; }
DI int perm32(int rho) { const int n = rho >> 4, i = rho & 15; return 8 * (i >> 2) + 4 * n + (i & 3); }
struct Unit { int m0, mrows, pn; size_t boff; };
template <bool GATHER, class Epi, class Sched>
DI void gemm_phase(LAS unsigned char* lds, const bf16_t* A, const int* rowidx, const bf16_t* Bt, int K, const Sched& S, const Epi& E) {
    const int tid = TID(), wid = __builtin_amdgcn_readfirstlane(tid >> 6), lane = tid & 63, wr = wid >> 2, wc = wid & 3, fr = lane & 15, fq = lane >> 4;
    const int nt = K / BK;
    unsigned voffA[2], voffB[2];
#pragma unroll
    for (int i = 0; i < 2; ++i) { int R, C; stage_rc(tid * 16 + i * 8192, R, C); const int Rb = Epi::PERM ? ((R & ~31) + perm32(R & 31)) : R;
        voffA[i] = (unsigned)(R * K + C) * 2u; voffB[i] = (unsigned)(Rb * K + C) * 2u; }
    const size_t kstep = (size_t)(BK * 2);
    const size_t hstep = (size_t)HALF * K * 2;
    const size_t tstep = 2 * hstep;
    const size_t rstep = (size_t)K * 2;
    const unsigned ldsw = (unsigned)wid * 1024u;
    const int aoff = lds_byte(wr * 64 + fr, fq * 8), boff = lds_byte(wc * 32 + fr, fq * 8);
#define PG8_SA(b, h) (((b) * 2 + (h)) * HTB)
#define PG8_SB(b, h) ((4 + (b) * 2 + (h)) * HTB)
#define PG8_STAGE(bufoff, gbase, voff) do { _Pragma("unroll") for (int _i = 0; _i < 2; ++_i) \
        __builtin_amdgcn_global_load_lds((const unsigned*)((const char*)(gbase) + (voff)[_i]), (LAS unsigned*)(lds + (bufoff) + ldsw + _i * 8192), 16, 0, 0); } while (0)
#define PG8_STAGE_A(bufoff, p, h, vG) do { if (GATHER) PG8_STAGE(bufoff, p, (vG)[h]); else PG8_STAGE(bufoff, (p) + (h) * hstep, voffA); } while (0)
#define PG8_LDA(dst, b, h) do { _Pragma("unroll") for (int m = 0; m < 4; ++m) _Pragma("unroll") for (int k = 0; k < 2; ++k) dst[m][k] = *(const LAS bf16x8*)(lds + PG8_SA(b, h) + aoff + m * 2048 + k * 1024); } while (0)
#define PG8_LDB(dst, b, h) do { _Pragma("unroll") for (int n = 0; n < 2; ++n) _Pragma("unroll") for (int k = 0; k < 2; ++k) dst[n][k] = *(const LAS bf16x8*)(lds + PG8_SB(b, h) + boff + n * 2048 + k * 1024); } while (0)
#define PG8_MMA(ai, bj, At, Bt_) do { __builtin_amdgcn_s_setprio(1); _Pragma("unroll") for (int m = 0; m < 4; ++m) _Pragma("unroll") for (int n = 0; n < 2; ++n) _Pragma("unroll") for (int k = 0; k < 2; ++k) \
        acc[ai][bj][m][n] = __builtin_amdgcn_mfma_f32_16x16x32_bf16(Bt_[n][k], At[m][k], acc[ai][bj][m][n], 0, 0, 0); __builtin_amdgcn_s_setprio(0); } while (0)
#define PG8_WAIT_V(n) asm volatile("s_waitcnt vmcnt(" #n ")" ::: "memory")
#define PG8_WAIT_L(n) asm volatile("s_waitcnt lgkmcnt(" #n ")" ::: "memory")
#define PG8_BAR __builtin_amdgcn_s_barrier()
#define PG8_SCHED __builtin_amdgcn_sched_barrier(0)
#define PG8_AOFF(dst, u) do { _Pragma("unroll") for (int _h = 0; _h < 2; ++_h) _Pragma("unroll") for (int _i = 0; _i < 2; ++_i) { int _R, _C; stage_rc(tid * 16 + _i * 8192, _R, _C); \
        dst[_h][_i] = (unsigned)(rowidx[(u).m0 + _h * HALF + _R] * K + _C) * 2u; } } while (0)
    Unit cur, nxt; int ui = 0;
    if (!S.next(0, cur)) return;
    f32x4 acc[2][2][4][2];
#pragma unroll
    for (int a = 0; a < 2; ++a)
#pragma unroll
        for (int b = 0; b < 2; ++b)
#pragma unroll
            for (int m = 0; m < 4; ++m)
#pragma unroll
                for (int n = 0; n < 2; ++n) acc[a][b][m][n] = (f32x4){0.f, 0.f, 0.f, 0.f};
    bf16x8 At[4][2], B0[2][2], B1[2][2];
    unsigned vA[2][2], vN[2][2];
    if (GATHER) PG8_AOFF(vA, cur);
    const char* cA = (const char*)A + (GATHER ? (size_t)0 : (size_t)cur.m0 * rstep);
    const char* cB = (const char*)Bt + cur.boff + (size_t)cur.pn * tstep;
    PG8_STAGE(PG8_SB(0, 0), cB, voffB); PG8_STAGE_A(PG8_SA(0, 0), cA, 0, vA); PG8_STAGE(PG8_SB(0, 1), cB + hstep, voffB); PG8_STAGE_A(PG8_SA(0, 1), cA, 1, vA);
    if (wr == 1) PG8_BAR;
    PG8_WAIT_V(4); PG8_BAR;
    PG8_STAGE(PG8_SB(1, 0), cB + kstep, voffB); PG8_STAGE_A(PG8_SA(1, 0), cA + kstep, 0, vA); PG8_STAGE(PG8_SB(1, 1), cB + hstep + kstep, voffB);
    PG8_WAIT_V(6); PG8_BAR;
    for (;;) {
        const bool has_next = S.next(ui + 1, nxt);
        const char* nA = GATHER ? cA : (has_next ? (const char*)A + (size_t)nxt.m0 * rstep : cA);
        const char* nB = has_next ? (const char*)Bt + nxt.boff + (size_t)nxt.pn * tstep : cB;
        if (GATHER) {
            if (has_next) { PG8_AOFF(vN, nxt); }
            else {
#pragma unroll
                for (int h = 0; h < 2; ++h)
#pragma unroll
                    for (int i = 0; i < 2; ++i) vN[h][i] = vA[h][i];
            }
        }
        for (int t = 0; t < nt; t += 2) {
            const bool last = (t == nt - 2);
            const char* a1 = cA + (size_t)(t + 1) * kstep;
            const char* a2 = last ? nA : cA + (size_t)(t + 2) * kstep; const char* b2 = last ? nB : cB + (size_t)(t + 2) * kstep;
            const char* a3 = a2 + kstep; const char* b3 = b2 + kstep;
            PG8_LDB(B0, 0, 0); PG8_SCHED; PG8_LDA(At, 0, 0); PG8_STAGE_A(PG8_SA(1, 1), a1, 1, vA);
            if (GATHER && last) {
#pragma unroll
                for (int h = 0; h < 2; ++h)
#pragma unroll
                    for (int i = 0; i < 2; ++i) vA[h][i] = vN[h][i];
            }
            PG8_WAIT_L(8); PG8_BAR; PG8_WAIT_L(0); PG8_MMA(0, 0, At, B0); PG8_BAR; PG8_SCHED;
            PG8_LDB(B1, 0, 1); PG8_STAGE(PG8_SB(0, 0), b2, voffB);
            PG8_BAR; PG8_WAIT_L(0); PG8_MMA(0, 1, At, B1); PG8_BAR;
            PG8_LDA(At, 0, 1); PG8_STAGE_A(PG8_SA(0, 0), a2, 0, vA);
            PG8_BAR; PG8_WAIT_L(0); PG8_MMA(1, 0, At, B0); PG8_BAR; PG8_SCHED;
            PG8_STAGE(PG8_SB(0, 1), b2 + hstep, voffB);
            PG8_WAIT_V(6); PG8_BAR; PG8_MMA(1, 1, At, B1); PG8_BAR;
            PG8_LDB(B0, 1, 0); PG8_SCHED; PG8_LDA(At, 1, 0); PG8_STAGE_A(PG8_SA(0, 1), a2, 1, vA);
            PG8_WAIT_L(8); PG8_BAR; PG8_WAIT_L(0); PG8_MMA(0, 0, At, B0); PG8_BAR; PG8_SCHED;
            PG8_LDB(B1, 1, 1); PG8_STAGE(PG8_SB(1, 0), b3, voffB);
            PG8_BAR; PG8_WAIT_L(0); PG8_MMA(0, 1, At, B1); PG8_BAR;
            PG8_LDA(At, 1, 1); PG8_STAGE_A(PG8_SA(1, 0), a3, 0, vA);
            PG8_BAR; PG8_WAIT_L(0); PG8_MMA(1, 0, At, B0); PG8_BAR; PG8_SCHED;
            PG8_STAGE(PG8_SB(1, 1), b3 + hstep, voffB);
            PG8_WAIT_V(6); PG8_BAR; PG8_MMA(1, 1, At, B1); PG8_BAR;
        }
        { const int t2 = TID(), l2 = t2 & 63; E(acc, cur, wr, wc, l2 & 15, l2 >> 4); }
        if (!has_next) break;
#pragma unroll
        for (int a = 0; a < 2; ++a)
#pragma unroll
            for (int b = 0; b < 2; ++b)
#pragma unroll
                for (int m = 0; m < 4; ++m)
#pragma unroll
                    for (int n = 0; n < 2; ++n) acc[a][b][m][n] = (f32x4){0.f, 0.f, 0.f, 0.f};
        cur = nxt; cA = nA; cB = nB; ++ui;
    }
    PG8_WAIT_V(0);
    if (wr == 0) PG8_BAR;
    PG8_BAR;
#undef PG8_SA
#undef PG8_SB
#undef PG8_STAGE
#undef PG8_STAGE_A
#undef PG8_LDA
#undef PG8_LDB
#undef PG8_MMA
#undef PG8_WAIT_V
#undef PG8_WAIT_L
#undef PG8_BAR
#undef PG8_SCHED
#undef PG8_AOFF
}
struct DenseOrder {
    int nM, nN, nwg, G, c;
    DI void init(int M, int N, int G_, int c_) { nM = M / BM; nN = N / BM; nwg = nM * nN; G = G_; c = c_; }
    DI bool next(int i, Unit& u) const {
        const long L = (long)i * G + c; if (L >= nwg) return false;
        int wgid = (int)L; { const int q = nwg / 8, r = nwg % 8, xcd = wgid % 8, off = wgid / 8; wgid = (xcd < r ? xcd * (q + 1) : r * (q + 1) + (xcd - r) * q) + off; }
        const int nig = 8 * nN, gid = wgid / nig, fm = gid * 8, gsz = (nM - fm) < 8 ? (nM - fm) : 8;
        u.m0 = (fm + ((wgid % nig) % gsz)) * BM; u.mrows = BM; u.pn = (wgid % nig) / gsz; u.boff = 0; return true;
    }
};
struct MoeOrder {
    const LAS int* tb; int G, c; size_t estride; int lane;
    DI bool next(int i, Unit& u) const {
        const int L = i * G + c; if (L >= __builtin_amdgcn_readfirstlane(tb[97]) * 4) return false;
        const int tile = L >> 2;
        const int pre = tb[65 + (lane & 31)];
        const unsigned long long m = __ballot(lane < 32 && pre <= tile);
        const int e = __popcll(m) - 1;
        const int lt = tile - __builtin_amdgcn_readfirstlane(tb[65 + e]); int mr = __builtin_amdgcn_readfirstlane(tb[e]) - lt * 256; mr = mr > 256 ? 256 : mr;
        u.m0 = __builtin_amdgcn_readfirstlane(tb[32 + e]) + lt * 256; u.mrows = mr; u.pn = L & 3; u.boff = (size_t)e * estride; return true;
    }
};
}
struct EpiBf16 {
    static constexpr bool PERM = true;
    bf16_t* C; int ldc; int split_col; bf16_t* C2; int ldc2;
    DI void operator()(const f32x4 (&acc)[2][2][4][2], const pg8::Unit& u, int wr, int wc, int fr, int fq) const {
        int colt = u.pn * 256; bf16_t* base = C; int ld = ldc;
        if (colt >= split_col) { base = C2; ld = ldc2; colt -= split_col; }
#pragma unroll
        for (int ai = 0; ai < 2; ++ai)
#pragma unroll
            for (int m = 0; m < 4; ++m) {
                const int rl = ai * 128 + wr * 64 + m * 16 + fr;
                if (rl < u.mrows) {
                    bf16_t* rowp = base + (size_t)(u.m0 + rl) * ld + colt + wc * 32 + 8 * fq;
#pragma unroll
                    for (int bj = 0; bj < 2; ++bj) {
                        const f32x4 v0 = acc[ai][bj][m][0], v1 = acc[ai][bj][m][1];
                        u32x4 o; o[0] = cvt_pk_bf16(v0[0], v0[1]); o[1] = cvt_pk_bf16(v0[2], v0[3]); o[2] = cvt_pk_bf16(v1[0], v1[1]); o[3] = cvt_pk_bf16(v1[2], v1[3]);
                        *(u32x4*)(rowp + bj * 128) = o;
                    }
                }
            }
    }
};
struct EpiBf16T {
    static constexpr bool PERM = false;
    bf16_t* C; int ldc;
    DI void operator()(const f32x4 (&acc)[2][2][4][2], const pg8::Unit& u, int wr, int wc, int fr, int fq) const {
#pragma unroll
        for (int ai = 0; ai < 2; ++ai)
#pragma unroll
            for (int bj = 0; bj < 2; ++bj)
#pragma unroll
                for (int m = 0; m < 4; ++m)
#pragma unroll
                    for (int n = 0; n < 2; ++n) {
                        const int row = u.m0 + ai * 128 + wr * 64 + m * 16 + fr, col = u.pn * 256 + bj * 128 + wc * 32 + n * 16 + 4 * fq;
#pragma unroll
                        for (int e = 0; e < 4; ++e) C[(size_t)(col + e) * ldc + row] = f2bf(acc[ai][bj][m][n][e]);
                    }
    }
};
struct EpiTaps {
    static constexpr bool PERM = false;
    float* FT;
    DI void operator()(const f32x4 (&acc)[2][2][4][2], const pg8::Unit& u, int wr, int wc, int fr, int fq) const {
#pragma unroll
        for (int ai = 0; ai < 2; ++ai)
#pragma unroll
            for (int m = 0; m < 4; ++m) {
                const int row = u.m0 + ai * 128 + wr * 64 + m * 16 + fr; const float dl = hy_delta(row & 1023) * (1.0f / 16383.0f);
#pragma unroll
                for (int bj = 0; bj < 2; ++bj)
#pragma unroll
                    for (int n = 0; n < 2; ++n) {
                        const int l = u.pn * 256 + bj * 128 + wc * 32 + n * 16 + 4 * fq; f32x4 o;
#pragma unroll
                        for (int e = 0; e < 4; ++e) o[e] = acc[ai][bj][m][n][e] * expf(-(float)(l + e) * dl);
                        *(f32x4*)(FT + (size_t)row * 16384 + l) = o;
                    }
            }
    }
};
struct EpiResid {
    static constexpr bool PERM = false;
    float* xs; const float* mod; int layer; int chunk;
    DI void operator()(const f32x4 (&acc)[2][2][4][2], const pg8::Unit& u, int wr, int wc, int fr, int fq) const {
        const float* g = mod + ((size_t)(layer * 3 + modrow(u.m0)) * 6 + chunk) * 1024;
#pragma unroll
        for (int bj = 0; bj < 2; ++bj)
#pragma unroll
            for (int n = 0; n < 2; ++n) {
                const int col = u.pn * 256 + bj * 128 + wc * 32 + n * 16 + 4 * fq; const f32x4 gv = *(const f32x4*)(g + col);
                float* p0 = xs + (size_t)(u.m0 + wr * 64 + fr) * 1024 + col;
                f32x4 old[8];
#pragma unroll
                for (int ai = 0; ai < 2; ++ai)
#pragma unroll
                    for (int m = 0; m < 4; ++m) old[ai * 4 + m] = *(const f32x4*)(p0 + (size_t)(ai * 128 + m * 16) * 1024);
                asm volatile("" ::: "memory");
#pragma unroll
                for (int ai = 0; ai < 2; ++ai)
#pragma unroll
                    for (int m = 0; m < 4; ++m) *(f32x4*)(p0 + (size_t)(ai * 128 + m * 16) * 1024) = old[ai * 4 + m] + gv * acc[ai][bj][m][n];
            }
    }
};
struct EpiGateUp {
    static constexpr bool PERM = false;
    bf16_t* hid;
    DI void operator()(const f32x4 (&acc)[2][2][4][2], const pg8::Unit& u, int wr, int wc, int fr, int fq) const {
#pragma unroll
        for (int ai = 0; ai < 2; ++ai)
#pragma unroll
            for (int m = 0; m < 4; ++m) {
                const int rl = ai * 128 + wr * 64 + m * 16 + fr;
                if (rl < u.mrows) {
#pragma unroll
                    for (int bj = 0; bj < 2; ++bj) {
                        const int hc = ((u.pn * 256 + bj * 128 + wc * 32) >> 1) + 4 * fq;
                        const f32x4 g = acc[ai][bj][m][0], up = acc[ai][bj][m][1];
                        u32x2 o; o[0] = cvt_pk_bf16(siluf(g[0]) * up[0], siluf(g[1]) * up[1]); o[1] = cvt_pk_bf16(siluf(g[2]) * up[2], siluf(g[3]) * up[3]);
                        *(u32x2*)(hid + (size_t)(u.m0 + rl) * 512 + hc) = o;
                    }
                }
            }
    }
};
template <class Epi>
PF void gemm_dense(LAS unsigned char* lds, const bf16_t* A, int M, const bf16_t* Bt, int N, int K, const Epi& epi) {
    pg8::DenseOrder S; S.init(M, N, (int)gridDim.x, (int)blockIdx.x);
    pg8::gemm_phase<false>(lds, A, (const int*)nullptr, Bt, K, S, epi);
}
DI void moe_table(const KC& k, int layer, LAS int* tb) {
    const int* cnt = (const int*)(k.ws + WS_CTL + CTL_CNT) + layer * 32;
    __syncthreads();
    const int tq = TID();
    if (tq < 32) tb[tq] = __hip_atomic_load(cnt + tq, __ATOMIC_RELAXED, __HIP_MEMORY_SCOPE_AGENT);
    __syncthreads();
    if (tq == 0) {
        int s = 0, tp = 0;
        for (int e = 0; e < 32; ++e) { tb[32 + e] = s; tb[65 + e] = tp; s += tb[e]; tp += (tb[e] + 255) >> 8; }
        tb[64] = s; tb[97] = tp;
    }
    __syncthreads();
}
template <int WHICH>
PF void moe_gemm(const KC& k, int layer, LAS unsigned char* lds, LAS int* tb) {
    moe_table(k, layer, tb);
    if (WHICH == 0) {
        pg8::MoeOrder S{tb, (int)gridDim.x, (int)blockIdx.x, (size_t)1024 * 1024 * 2, TID() & 63};
        EpiGateUp epi{(bf16_t*)(k.ws + AR_HID)};
        pg8::gemm_phase<true>(lds, (const bf16_t*)(k.ws + AR_HBUF), (const int*)(k.ws + WS_SLOT), (const bf16_t*)(k.ws + AR_WGU), 1024, S, epi);
    } else {
        pg8::MoeOrder S{tb, (int)gridDim.x, (int)blockIdx.x, (size_t)1024 * 512 * 2, TID() & 63};
        EpiBf16 epi{(bf16_t*)(k.ws + AR_YS), 1024, 1 << 30, nullptr, 0};
        pg8::gemm_phase<false>(lds, (const bf16_t*)(k.ws + AR_HID), (const int*)nullptr, (const bf16_t*)(k.ws + AR_WD), 512, S, epi);
    }
}
PF void moe_scatter(const KC& k, int layer, LAS int* tb) {
    moe_table(k, layer, tb);
    const int* toke = (const int*)(k.ws + WS_TOKE);
    int* tokp = (int*)(k.ws + WS_TOKP); int* slot = (int*)(k.ws + WS_SLOT);
    int* cur = (int*)(k.ws + WS_CTL + CTL_CNT) + 128 + layer * 32;
    LAS int* lc = tb + 128; LAS int* lb = tb + 160;
    const int tid = TID();
    if (blockIdx.x == 0 && tid < 256) slot[NA + tid] = 0;
    for (int r0 = blockIdx.x * NTHR; r0 < T; r0 += gridDim.x * NTHR) {
        const int r = r0 + tid;
        __syncthreads();
        if (tid < 32) lc[tid] = 0;
        __syncthreads();
        const int e0 = toke[2 * r], e1 = toke[2 * r + 1];
        int k0 = 0, k1 = 0;
        if (e0 >= 0) { k0 = __hip_atomic_fetch_add(lc + e0, 1, __ATOMIC_RELAXED, __HIP_MEMORY_SCOPE_WORKGROUP); k1 = __hip_atomic_fetch_add(lc + e1, 1, __ATOMIC_RELAXED, __HIP_MEMORY_SCOPE_WORKGROUP); }
        __syncthreads();
        if (tid < 32) lb[tid] = lc[tid] > 0 ? atomicAdd(&cur[tid], lc[tid]) : 0;
        __syncthreads();
        if (e0 >= 0) {
            const int p0 = tb[32 + e0] + lb[e0] + k0, p1 = tb[32 + e1] + lb[e1] + k1;
            slot[p0] = r; slot[p1] = r; tokp[2 * r] = p0; tokp[2 * r + 1] = p1;
        }
    }
}

DI void unpack8(const u32x4 v, float (&f)[8]) {
#pragma unroll
    for (int w = 0; w < 4; ++w) { f[2 * w] = __uint_as_float(v[w] << 16); f[2 * w + 1] = __uint_as_float(v[w] & 0xffff0000u); }
}
PF void sc_mix(const KC& k, int j) {
    const int tid = TID(), lane = tid & 63, wave = tid >> 6;
    const bf16_t* P = (const bf16_t*)(k.ws + AR_PB);
    bf16_t* U = (bf16_t*)(k.ws + AR_UBUF);
    const float* cw = k.sc_conv + (size_t)j * 3 * 1024;
    const int c0 = lane * 16;
    float k0[16], k1[16], k2[16];
#pragma unroll
    for (int e = 0; e < 16; ++e) { k0[e] = cw[c0 + e]; k1[e] = cw[1024 + c0 + e]; k2[e] = cw[2048 + c0 + e]; }
    for (int r = blockIdx.x * 8 + wave; r < T; r += gridDim.x * 8) {
        bool lok, rok;
        if (r < TC) { const int t = r & 255; lok = t != 0; rok = t != 255; } else { const int t = (r - TC) & 63; lok = t != 0; rok = t != 63; }
        const bf16_t* p = P + (size_t)r * 3072 + c0;
        const bf16_t* pl = lok ? p - 3072 : p; const bf16_t* pr = rok ? p + 3072 : p;
        u32x4 vb[2], vc[2], vx[2], vcl[2], vxl[2], vcr[2], vxr[2];
#pragma unroll
        for (int hh = 0; hh < 2; ++hh) {
            vb[hh] = *(const u32x4*)(p + hh * 8); vc[hh] = *(const u32x4*)(p + 1024 + hh * 8); vx[hh] = *(const u32x4*)(p + 2048 + hh * 8);
            vcl[hh] = *(const u32x4*)(pl + 1024 + hh * 8); vxl[hh] = *(const u32x4*)(pl + 2048 + hh * 8);
            vcr[hh] = *(const u32x4*)(pr + 1024 + hh * 8); vxr[hh] = *(const u32x4*)(pr + 2048 + hh * 8);
        }
        asm volatile("" ::: "memory");
        const float fl = lok ? 1.f : 0.f, frr = rok ? 1.f : 0.f;
#pragma unroll
        for (int hh = 0; hh < 2; ++hh) {
            float bg[8], cg[8], xi[8], cl[8], xl[8], cr[8], xr[8];
            unpack8(vb[hh], bg); unpack8(vc[hh], cg); unpack8(vx[hh], xi); unpack8(vcl[hh], cl); unpack8(vxl[hh], xl); unpack8(vcr[hh], cr); unpack8(vxr[hh], xr);
            u32x4 o;
#pragma unroll
            for (int w = 0; w < 4; ++w) {
                float ov[2];
#pragma unroll
                for (int e = 0; e < 2; ++e) { const int i = 2 * w + e, c = hh * 8 + i; ov[e] = bg[i] * (k0[c] * fl * cl[i] * xl[i] + k1[c] * cg[i] * xi[i] + k2[c] * frr * cr[i] * xr[i]); }
                o[w] = pk2(ov[0], ov[1]);
            }
            *(u32x4*)(U + (size_t)r * 1024 + c0 + hh * 8) = o;
        }
    }
}

constexpr int DN_STEPS = 260, DN_UNITS = 32 * DN_STEPS;
DI int dn_rbase(int b, int dir, int s) {
    if (s < 4) return dir == 0 ? b * 256 + s * 64 : b * 256 + 255 - s * 64;
    const int cc = s - 4;
    return dir == 0 ? TC + b * SEQ + cc * 64 : TC + b * SEQ + SEQ - 1 - cc * 64;
}
struct DnRaw { u32x4 c[3][2], l[3][2], r[3][2]; float g, be; };
DI void dn_raw_load(const bf16_t* P, const float* gb, int u, int tid, DnRaw& R) {
    const int chain = u / DN_STEPS, s = u - chain * DN_STEPS, dir = chain & 1, h = (chain >> 1) & 7, b = chain >> 4;
    const int rbase = dn_rbase(b, dir, s), rstep = dir == 0 ? 1 : -1;
    const int i = tid >> 3, sg = tid & 7, r = rbase + rstep * i;
    bool lok, rok;
    if (r < TC) { const int t = r & 255; lok = t != 0; rok = t != 255; } else { const int t = (r - TC) & 63; lok = t != 0; rok = t != 63; }
#pragma unroll
    for (int part = 0; part < 3; ++part) {
        const bf16_t* pc = P + (size_t)r * 3072 + part * 1024 + h * 128 + sg * 16;
#pragma unroll
        for (int hf = 0; hf < 2; ++hf) {
            R.c[part][hf] = *(const u32x4*)(pc + hf * 8);
            R.l[part][hf] = (u32x4){0u, 0u, 0u, 0u}; R.r[part][hf] = (u32x4){0u, 0u, 0u, 0u};
            if (lok) R.l[part][hf] = *(const u32x4*)(pc - 3072 + hf * 8);
            if (rok) R.r[part][hf] = *(const u32x4*)(pc + 3072 + hf * 8);
        }
    }
    if (tid < 64) { const size_t row = (size_t)(rbase + rstep * tid); R.g = gb[row * 32 + dir * 8 + h]; R.be = gb[row * 32 + 16 + dir * 8 + h]; }
}
PF void dn_chunk(const KC& k, int jl, LAS unsigned char* lds) {
    const int tid = TID(), lane = tid & 63, wave = tid >> 6, fr = lane & 15, fq = lane >> 4;
    LAS bf16_t* Kt = (LAS bf16_t*)lds;
    LAS bf16_t* Qt = Kt + 64 * 136;
    LAS bf16_t* Vt = Qt + 64 * 136;
    LAS float* Amat = (LAS float*)(Vt + 64 * 136);
    LAS bf16_t* Tb = (LAS bf16_t*)(Amat + 64 * 64);
    LAS bf16_t* VbT = Tb + 64 * 72;
    LAS bf16_t* KbT = VbT + 128 * 72;
    LAS float* gcs = (LAS float*)(KbT + 128 * 72);
    LAS float* bet = gcs + 64; LAS float* eg = bet + 64; LAS float* egr = eg + 64;
    LAS float* Tm = egr + 64;
    const bf16_t* P = (const bf16_t*)(k.ws + AR_PB);
    const float* gb = (const float*)(k.ws + WS_GB);
    const float* cw = k.dn_conv + (size_t)jl * 3 * 3072;
    bf16_t* CH = (bf16_t*)(k.ws + AR_CHUNK);
    bf16_t* ATT = (bf16_t*)(k.ws + AR_HBUF);
    float* EGL = (float*)(k.ws + WS_EGL);
    for (int u = blockIdx.x; u < DN_UNITS; u += gridDim.x) {
        DnRaw Rn; dn_raw_load(P, gb, u, tid, Rn);
        const int chain = u / DN_STEPS, s = u - chain * DN_STEPS, dir = chain & 1, h = (chain >> 1) & 7, b = chain >> 4;
        const int rbase = dn_rbase(b, dir, s), rstep = dir == 0 ? 1 : -1;
        bf16_t* cW = CH + (size_t)u * 32768; bf16_t* cQd = cW + 8192; bf16_t* cKd = cQd + 8192; bf16_t* cU = cKd + 8192;
        bf16_t* cAt = ATT + (size_t)u * 4096;
        lds_barrier();
        const float g_in = Rn.g, be_in = Rn.be;
        {
            const int i = tid >> 3, sg = tid & 7;
#pragma unroll
            for (int part = 0; part < 3; ++part) {
                const int col = part * 1024 + h * 128 + sg * 16;
                float v[16];
#pragma unroll
                for (int hf = 0; hf < 2; ++hf) {
                    const u32x4 c4 = Rn.c[part][hf], l4 = Rn.l[part][hf], r4 = Rn.r[part][hf];
#pragma unroll
                    for (int w2 = 0; w2 < 2; ++w2) {
                        const int cc = col + hf * 8 + 4 * w2;
                        const f32x4 k0 = *(const f32x4*)(cw + cc), k1 = *(const f32x4*)(cw + 3072 + cc), k2 = *(const f32x4*)(cw + 6144 + cc);
#pragma unroll
                        for (int e = 0; e < 4; ++e) {
                            const int w = 2 * w2 + (e >> 1);
                            const float lv = __uint_as_float((e & 1) ? (l4[w] & 0xffff0000u) : (l4[w] << 16));
                            const float cv = __uint_as_float((e & 1) ? (c4[w] & 0xffff0000u) : (c4[w] << 16));
                            const float rv = __uint_as_float((e & 1) ? (r4[w] & 0xffff0000u) : (r4[w] << 16));
                            v[hf * 8 + 4 * w2 + e] = siluf(k0[e] * lv + k1[e] * cv + k2[e] * rv);
                        }
                    }
                }
                if (part < 2) {
                    float ss = 0.f;
#pragma unroll
                    for (int e = 0; e < 16; ++e) ss += v[e] * v[e];
                    ss += shx(ss, 1, lane); ss += shx(ss, 2, lane); ss += shx(ss, 4, lane);
                    const float sc = rsqrtf(ss + EPS) * (part == 0 ? 0.08838834764831845f : 1.0f);
#pragma unroll
                    for (int e = 0; e < 16; ++e) v[e] *= sc;
                }
                LAS bf16_t* dst = (part == 0 ? Qt : (part == 1 ? Kt : Vt)) + i * 136 + sg * 16;
                u32x4 o0, o1;
#pragma unroll
                for (int w = 0; w < 4; ++w) { o0[w] = pk2(v[2 * w], v[2 * w + 1]); o1[w] = pk2(v[8 + 2 * w], v[8 + 2 * w + 1]); }
                *(LAS u32x4*)dst = o0; *(LAS u32x4*)(dst + 8) = o1;
            }
        }
        if (wave == 0) {
            float g = g_in;
            const float be = be_in;
#pragma unroll
            for (int d = 1; d < 64; d <<= 1) { const float o = shi(g, (lane - d) & 63); if (lane >= d) g += o; }
            const float glast = shi(g, 63);
            gcs[lane] = g; bet[lane] = be; eg[lane] = expf(g); egr[lane] = expf(glast - g);
            if (lane == 0) EGL[u] = expf(glast);
        }
        lds_barrier();
#pragma unroll 1
        for (int x = 0; x < 4; ++x) {
            const int t = wave + 8 * x, isq = t >> 4, mt = (t >> 2) & 3, nt = t & 3;
            f32x4 acc = (f32x4){0.f, 0.f, 0.f, 0.f};
            const int jc = 16 * nt + fr;
            float gi4[4], bi4[4];
            const float gj = gcs[jc];
#pragma unroll
            for (int jj = 0; jj < 4; ++jj) { gi4[jj] = gcs[16 * mt + 4 * fq + jj]; bi4[jj] = bet[16 * mt + 4 * fq + jj]; }
            if (mt >= nt) {
                const LAS bf16_t* Ar = (isq ? Qt : Kt) + (16 * mt + fr) * 136 + 8 * fq;
                const LAS bf16_t* Br = Kt + (16 * nt + fr) * 136 + 8 * fq;
                bf16x8 fa4[4], fb4[4];
#pragma unroll
                for (int ks = 0; ks < 4; ++ks) { fa4[ks] = *(const LAS bf16x8*)(Ar + 32 * ks); fb4[ks] = *(const LAS bf16x8*)(Br + 32 * ks); }
                asm volatile("" ::: "memory");
#pragma unroll
                for (int ks = 0; ks < 4; ++ks) acc = __builtin_amdgcn_mfma_f32_16x16x32_bf16(fa4[ks], fb4[ks], acc, 0, 0, 0);
            }
#pragma unroll
            for (int jj = 0; jj < 4; ++jj) {
                const int ir = 16 * mt + 4 * fq + jj;
                const float dec = __expf(fminf(gi4[jj] - gj, 0.f));
                if (isq) cAt[ir * 64 + jc] = f2bf(ir >= jc ? acc[jj] * dec : 0.f);
                else Amat[ir * 64 + jc] = ir > jc ? bi4[jj] * acc[jj] * dec : 0.f;
            }
        }
        lds_barrier();
        {
        if (wave < 4) {
            if (lane < 16) {
                const int bo = 16 * wave;
                float tc[16];
#pragma unroll
                for (int i = 0; i < 16; ++i) {
                    f32x4 ar[4];
#pragma unroll
                    for (int q = 0; q < (i + 3) / 4; ++q) ar[q] = *(const LAS f32x4*)(Amat + (bo + i) * 64 + bo + 4 * q);
                    float a0 = (i == lane) ? 1.f : 0.f, a1 = 0.f;
#pragma unroll
                    for (int j = 0; j < i; ++j) { const float av = ar[j >> 2][j & 3]; if (j & 1) a1 -= av * tc[j]; else a0 -= av * tc[j]; }
                    tc[i] = a0 + a1;
                    Tm[(bo + i) * 64 + bo + lane] = tc[i];
                }
            }
        } else {
            for (int it = tid - 256; it < 1024; it += 256) {
                const int c = it & 127, ig = it >> 7;
                float kv[8], vv[8];
                { bf16_t kr[8], vr[8];
#pragma unroll
                  for (int e = 0; e < 8; ++e) { kr[e] = Kt[(8 * ig + e) * 136 + c]; vr[e] = Vt[(8 * ig + e) * 136 + c]; }
                  asm volatile("" ::: "memory");
#pragma unroll
                  for (int e = 0; e < 8; ++e) { kv[e] = bf2f(kr[e]); vv[e] = bf2f(vr[e]); } }
                u32x4 ov, ok, od;
#pragma unroll
                for (int w = 0; w < 4; ++w) {
                    const int i0 = 8 * ig + 2 * w, i1 = i0 + 1;
                    ov[w] = pk2(bet[i0] * vv[2 * w], bet[i1] * vv[2 * w + 1]);
                    ok[w] = pk2(bet[i0] * eg[i0] * kv[2 * w], bet[i1] * eg[i1] * kv[2 * w + 1]);
                    od[w] = pk2(egr[i0] * kv[2 * w], egr[i1] * kv[2 * w + 1]);
                }
                *(LAS u32x4*)(VbT + c * 72 + 8 * ig) = ov;
                *(LAS u32x4*)(KbT + c * 72 + 8 * ig) = ok;
                *(u32x4*)(cKd + c * 64 + 8 * ig) = od;
            }
            for (int it = tid - 256; it < 1024; it += 256) {
                const int i = it >> 4, c8 = (it & 15) * 8; const float e = eg[i];
                const u32x4 qv = *(const LAS u32x4*)(Qt + i * 136 + c8); u32x4 o;
#pragma unroll
                for (int w = 0; w < 4; ++w) o[w] = pk2(__uint_as_float(qv[w] << 16) * e, __uint_as_float(qv[w] & 0xffff0000u) * e);
                *(u32x4*)(cQd + i * 128 + c8) = o;
            }
        }
        lds_barrier();
#pragma unroll 1
        for (int d = 1; d < 4; ++d) {
            if (wave < 4 - d) {
                const int bi = wave + d, bj = wave, r = lane >> 2, c0 = 4 * (lane & 3);
                f32x4 m = (f32x4){0.f, 0.f, 0.f, 0.f};
                for (int kb = bj; kb < bi; ++kb) {
                    f32x4 av4[4], tv[16];
#pragma unroll
                    for (int q = 0; q < 4; ++q) av4[q] = *(const LAS f32x4*)(Amat + (16 * bi + r) * 64 + 16 * kb + 4 * q);
#pragma unroll
                    for (int kk = 0; kk < 16; ++kk) tv[kk] = *(const LAS f32x4*)(Tm + (16 * kb + kk) * 64 + 16 * bj + c0);
                    asm volatile("" ::: "memory");
#pragma unroll
                    for (int kk = 0; kk < 16; ++kk) m += tv[kk] * av4[kk >> 2][kk & 3];
                }
                *(LAS f32x4*)(Tm + (16 * bj + r) * 64 + 16 * bi + c0) = m;
                f32x4 t = (f32x4){0.f, 0.f, 0.f, 0.f};
                {
                    f32x4 dv4[4], mv[16];
#pragma unroll
                    for (int q = 0; q < 4; ++q) dv4[q] = *(const LAS f32x4*)(Tm + (16 * bi + r) * 64 + 16 * bi + 4 * q);
#pragma unroll
                    for (int kk = 0; kk < 16; ++kk) mv[kk] = *(const LAS f32x4*)(Tm + (16 * bj + kk) * 64 + 16 * bi + c0);
                    asm volatile("" ::: "memory");
#pragma unroll
                    for (int kk = 0; kk < 16; ++kk) t -= mv[kk] * dv4[kk >> 2][kk & 3];
                }
                *(LAS f32x4*)(Tm + (16 * bi + r) * 64 + 16 * bj + c0) = t;
            }
            lds_barrier();
        }
        for (int it = tid; it < 64 * 8; it += NTHR) {
            const int i = it >> 3, c8 = (it & 7) * 8; u32x4 o;
#pragma unroll
            for (int w = 0; w < 4; ++w) {
                const int c = c8 + 2 * w;
                o[w] = pk2(c <= i ? Tm[i * 64 + c] : 0.f, c + 1 <= i ? Tm[i * 64 + c + 1] : 0.f);
            }
            *(LAS u32x4*)(Tb + i * 72 + c8) = o;
        }
        }
        lds_barrier();
        {
            f32x4 au[4], aw[4];
#pragma unroll
            for (int mt = 0; mt < 4; ++mt) { au[mt] = (f32x4){0.f, 0.f, 0.f, 0.f}; aw[mt] = (f32x4){0.f, 0.f, 0.f, 0.f}; }
            bf16x8 bv[2], bk[2], at[2][4];
#pragma unroll
            for (int ks = 0; ks < 2; ++ks) {
                bv[ks] = *(const LAS bf16x8*)(VbT + (16 * wave + fr) * 72 + 32 * ks + 8 * fq);
                bk[ks] = *(const LAS bf16x8*)(KbT + (16 * wave + fr) * 72 + 32 * ks + 8 * fq);
#pragma unroll
                for (int mt = 0; mt < 4; ++mt) at[ks][mt] = *(const LAS bf16x8*)(Tb + (16 * mt + fr) * 72 + 32 * ks + 8 * fq);
            }
            asm volatile("" ::: "memory");
#pragma unroll
            for (int ks = 0; ks < 2; ++ks)
#pragma unroll
                for (int mt = 0; mt < 4; ++mt) {
                    au[mt] = __builtin_amdgcn_mfma_f32_16x16x32_bf16(at[ks][mt], bv[ks], au[mt], 0, 0, 0);
                    aw[mt] = __builtin_amdgcn_mfma_f32_16x16x32_bf16(at[ks][mt], bk[ks], aw[mt], 0, 0, 0);
                }
#pragma unroll
            for (int mt = 0; mt < 4; ++mt)
#pragma unroll
                for (int jj = 0; jj < 4; ++jj) {
                    const int ir = 16 * mt + 4 * fq + jj, c = 16 * wave + fr;
                    cU[ir * 128 + c] = f2bf(au[mt][jj]); cW[ir * 128 + c] = f2bf(aw[mt][jj]);
                }
        }
    }
}
constexpr int SC_W = 0, SC_QD = 64 * 136, SC_KD = SC_QD + 64 * 136, SC_AT = SC_KD + 128 * 72, SC_U = SC_AT + 64 * 72, SC_EGL = SC_U + 16 * 72, SC_STAGE = SC_EGL + 8;
struct ScanRegs { u32x4 v[8]; u32x4 u[2]; };
DI void dn_scan_fetch(const bf16_t* CH, const bf16_t* ATT, int u, int sl, int wv, int lane, ScanRegs& R) {
    const bf16_t* cW = CH + (size_t)u * 32768;
    const bf16_t* src = (wv < 6) ? cW + wv * 4096 + lane * 8 : ATT + (size_t)u * 4096 + lane * 8;
#pragma unroll
    for (int q = 0; q < 8; ++q) R.v[q] = *(const u32x4*)(src + q * 512);
    if (wv == 6) {
#pragma unroll
        for (int qq = 0; qq < 2; ++qq) { const int pid = lane + 64 * qq; R.u[qq] = *(const u32x4*)(cW + 24576 + (pid >> 1) * 128 + sl * 16 + (pid & 1) * 8); }
    }
}
DI void dn_scan_put(LAS bf16_t* st, int wv, int lane, const ScanRegs& R) {
    LAS bf16_t* dst; int qs;
    if (wv < 4) { dst = st + ((wv < 2) ? SC_W : SC_QD) + ((wv & 1) * 32 + (lane >> 4)) * 136 + (lane & 15) * 8; qs = 544; }
    else if (wv < 6) { dst = st + SC_KD + ((wv - 4) * 64 + (lane >> 3)) * 72 + (lane & 7) * 8; qs = 576; }
    else { dst = st + SC_AT + (lane >> 3) * 72 + (lane & 7) * 8; qs = 576; }
#pragma unroll
    for (int q = 0; q < 8; ++q) *(LAS u32x4*)(dst + q * qs) = R.v[q];
    if (wv == 6) {
#pragma unroll
        for (int qq = 0; qq < 2; ++qq) { const int pid = lane + 64 * qq, i = pid >> 1, hf = pid & 1;
#pragma unroll
            for (int w = 0; w < 4; ++w) { st[SC_U + (hf * 8 + 2 * w) * 72 + i] = (bf16_t)(R.u[qq][w] & 0xffff); st[SC_U + (hf * 8 + 2 * w + 1) * 72 + i] = (bf16_t)(R.u[qq][w] >> 16); } }
    }
}
DI bf16x8 ld2(const LAS bf16_t* p0, const LAS bf16_t* p1) {
    const u32x2 a = *(const LAS u32x2*)p0, b = *(const LAS u32x2*)p1;
    u32x4 r; r[0] = a[0]; r[1] = a[1]; r[2] = b[0]; r[3] = b[1];
    return __builtin_bit_cast(bf16x8, r);
}
DI bf16x8 pk8(f32x4 a, f32x4 b) { u32x4 r; r[0] = pk2(a[0], a[1]); r[1] = pk2(a[2], a[3]); r[2] = pk2(b[0], b[1]); r[3] = pk2(b[2], b[3]); return __builtin_bit_cast(bf16x8, r); }
PF void dn_scan(const KC& k, LAS unsigned char* lds) {
    const int tid = TID(), lane = tid & 63, wave = tid >> 6, fr = lane & 15, fq = lane >> 4;
    LAS bf16_t* ring = (LAS bf16_t*)lds;
    const bf16_t* CH = (const bf16_t*)(k.ws + AR_CHUNK);
    const bf16_t* ATT = (const bf16_t*)(k.ws + AR_HBUF);
    const float* EGL = (const float*)(k.ws + WS_EGL);
    bf16_t* O = (bf16_t*)(k.ws + AR_PB);
    for (int un0 = blockIdx.x; un0 < 256; un0 += gridDim.x) {
        const int un = (gridDim.x == 256) ? ((un0 & 7) * 32 + (un0 >> 3)) : un0;
        const int sl = un & 7, chain = un >> 3, dir = chain & 1, h = (chain >> 1) & 7, b = chain >> 4;
        const int rstep = dir == 0 ? 1 : -1;
        f32x4 S[8];
#pragma unroll
        for (int t = 0; t < 8; ++t) S[t] = (f32x4){0.f, 0.f, 0.f, 0.f};
        LAS float* eglL = (LAS float*)(ring + 2 * SC_STAGE);
        constexpr int NPF = 1;
        ScanRegs R[NPF];
        const int wv = wave - 1;
        lds_barrier();
        if (tid < DN_STEPS) eglL[tid] = EGL[chain * DN_STEPS + tid];
        if (wave > 0) {
            dn_scan_fetch(CH, ATT, chain * DN_STEPS, sl, wv, lane, R[0]); dn_scan_put(ring, wv, lane, R[0]);
#pragma unroll
            for (int q = 0; q < NPF; ++q) dn_scan_fetch(CH, ATT, chain * DN_STEPS + q + 1, sl, wv, lane, R[q]);
        }
        lds_barrier();
#pragma unroll 1
        for (int s4 = 0; s4 < DN_STEPS; s4 += NPF) {
#pragma unroll
          for (int q = 0; q < NPF; ++q) {
            const int s = s4 + q; if (s >= DN_STEPS) break;
            LAS bf16_t* st = ring + (s & 1) * SC_STAGE;
            if (wave > 0) {
                if (s + 1 < DN_STEPS) dn_scan_put(ring + ((s + 1) & 1) * SC_STAGE, wv, lane, R[q]);
                if (s + 1 + NPF < DN_STEPS) dn_scan_fetch(CH, ATT, chain * DN_STEPS + s + 1 + NPF, sl, wv, lane, R[q]);
            } else {
                const float egl = eglL[s];
                bf16x8 sb[4];
#pragma unroll
                for (int ks = 0; ks < 4; ++ks) sb[ks] = pk8(S[2 * ks], S[2 * ks + 1]);
                f32x4 p[4], o[4];
#pragma unroll
                for (int mt = 0; mt < 4; ++mt) { p[mt] = (f32x4){0.f, 0.f, 0.f, 0.f}; o[mt] = (f32x4){0.f, 0.f, 0.f, 0.f}; }
                bf16x8 fw[2][4], fq_[2][4];
#define SC_LOAD_KS(buf, ks) do { _Pragma("unroll") for (int mt = 0; mt < 4; ++mt) { \
                        const LAS bf16_t* wr_ = st + SC_W + (16 * mt + fr) * 136 + 4 * fq + 32 * (ks); const LAS bf16_t* qr_ = st + SC_QD + (16 * mt + fr) * 136 + 4 * fq + 32 * (ks); \
                        fw[buf][mt] = ld2(wr_, wr_ + 16); fq_[buf][mt] = ld2(qr_, qr_ + 16); } } while (0)
#define SC_MMA_KS(buf, ks) do { _Pragma("unroll") for (int mt = 0; mt < 4; ++mt) p[mt] = __builtin_amdgcn_mfma_f32_16x16x32_bf16(fw[buf][mt], sb[ks], p[mt], 0, 0, 0); \
                        _Pragma("unroll") for (int mt = 0; mt < 4; ++mt) o[mt] = __builtin_amdgcn_mfma_f32_16x16x32_bf16(fq_[buf][mt], sb[ks], o[mt], 0, 0, 0); } while (0)
                bf16x8 fa[2][4], fk[2][8];
#define SC_LOAD_KC(kc) do { _Pragma("unroll") for (int mt = 0; mt < 4; ++mt) { const LAS bf16_t* ar_ = st + SC_AT + (16 * mt + fr) * 72 + 4 * fq + 32 * (kc); fa[kc][mt] = ld2(ar_, ar_ + 16); } \
                        _Pragma("unroll") for (int t = 0; t < 8; ++t) { const LAS bf16_t* kr_ = st + SC_KD + (16 * t + fr) * 72 + 4 * fq + 32 * (kc); fk[kc][t] = ld2(kr_, kr_ + 16); } } while (0)
                SC_LOAD_KS(0, 0);
                SC_LOAD_KS(1, 1); asm volatile("" ::: "memory"); SC_MMA_KS(0, 0);
                SC_LOAD_KS(0, 2); asm volatile("" ::: "memory"); SC_MMA_KS(1, 1);
                SC_LOAD_KS(1, 3); asm volatile("" ::: "memory"); SC_MMA_KS(0, 2);
                SC_LOAD_KC(0);    asm volatile("" ::: "memory"); SC_MMA_KS(1, 3);
                u32x2 uu[4];
#pragma unroll
                for (int mt = 0; mt < 4; ++mt) uu[mt] = *(const LAS u32x2*)(st + SC_U + fr * 72 + 16 * mt + 4 * fq);
                SC_LOAD_KC(1);    asm volatile("" ::: "memory");
                bf16x8 vb[2]; f32x4 vn[4];
#pragma unroll
                for (int mt = 0; mt < 4; ++mt) {
                    vn[mt][0] = __uint_as_float(uu[mt][0] << 16) - p[mt][0]; vn[mt][1] = __uint_as_float(uu[mt][0] & 0xffff0000u) - p[mt][1];
                    vn[mt][2] = __uint_as_float(uu[mt][1] << 16) - p[mt][2]; vn[mt][3] = __uint_as_float(uu[mt][1] & 0xffff0000u) - p[mt][3];
                }
                vb[0] = pk8(vn[0], vn[1]); vb[1] = pk8(vn[2], vn[3]);
#pragma unroll
                for (int t = 0; t < 8; ++t) S[t] = S[t] * egl;
#pragma unroll
                for (int kc = 0; kc < 2; ++kc) {
#pragma unroll
                    for (int mt = 0; mt < 4; ++mt) o[mt] = __builtin_amdgcn_mfma_f32_16x16x32_bf16(fa[kc][mt], vb[kc], o[mt], 0, 0, 0);
#pragma unroll
                    for (int t = 0; t < 8; ++t) S[t] = __builtin_amdgcn_mfma_f32_16x16x32_bf16(fk[kc][t], vb[kc], S[t], 0, 0, 0);
                }
#undef SC_LOAD_KS
#undef SC_MMA_KS
#undef SC_LOAD_KC
                const int rbase = dn_rbase(b, dir, s);
#pragma unroll
                for (int mt = 0; mt < 4; ++mt)
#pragma unroll
                    for (int jj = 0; jj < 4; ++jj) {
                        const int row = rbase + rstep * (16 * mt + 4 * fq + jj);
                        O[((size_t)dir * T + row) * 1024 + h * 128 + sl * 16 + fr] = f2bf(o[mt][jj]);
                    }
            }
            lds_barrier();
          }
        }
    }
}
PF void dn_finish(const KC& k, int j) {
    const int tid = TID(), lane = tid & 63, wave = tid >> 6;
    const bf16_t* O = (const bf16_t*)(k.ws + AR_PB);
    const bf16_t* Z = (const bf16_t*)k.out;
    bf16_t* U = (bf16_t*)(k.ws + AR_UBUF);
    const float* on = k.dn_out_norm + j * 128;
    const int c0 = lane * 16;
    float onv[16];
#pragma unroll
    for (int e = 0; e < 16; ++e) onv[e] = on[(c0 + e) & 127];
    for (int r = blockIdx.x * 8 + wave; r < T; r += gridDim.x * 8) {
        u32x4 vf[2], vb[2], vz[2];
#pragma unroll
        for (int hh = 0; hh < 2; ++hh) {
            vf[hh] = *(const u32x4*)(O + (size_t)r * 1024 + c0 + hh * 8); vb[hh] = *(const u32x4*)(O + ((size_t)T + r) * 1024 + c0 + hh * 8);
            vz[hh] = *(const u32x4*)(Z + (size_t)r * 1024 + c0 + hh * 8);
        }
        asm volatile("" ::: "memory");
        float o[16], z[16];
#pragma unroll
        for (int hh = 0; hh < 2; ++hh) { float a[8], b2[8], zz[8]; unpack8(vf[hh], a); unpack8(vb[hh], b2); unpack8(vz[hh], zz);
#pragma unroll
            for (int i = 0; i < 8; ++i) { o[hh * 8 + i] = a[i] + b2[i]; z[hh * 8 + i] = zz[i]; } }
        float ss = 0.f;
#pragma unroll
        for (int e = 0; e < 16; ++e) ss += o[e] * o[e];
        ss += shx(ss, 1, lane); ss += shx(ss, 2, lane); ss += shx(ss, 4, lane);
        const float rs = rsqrtf(ss * (1.0f / 128.0f) + EPS);
#pragma unroll
        for (int hh = 0; hh < 2; ++hh) { u32x4 ov;
#pragma unroll
            for (int w = 0; w < 4; ++w) { const int e0 = hh * 8 + 2 * w; ov[w] = pk2(o[e0] * rs * onv[e0] * siluf(z[e0]), o[e0 + 1] * rs * onv[e0 + 1] * siluf(z[e0 + 1])); }
            *(u32x4*)(U + (size_t)r * 1024 + c0 + hh * 8) = ov; }
    }
}

DI float conv3g(const bf16_t* p, int j, float w0, float w1, float w2) {
    const int gc = j & 63;
    const float l = gc != 0 ? bf2f(p[j - 1]) : 0.f, c = bf2f(p[j]), r = gc != 63 ? bf2f(p[j + 1]) : 0.f;
    return w0 * l + w1 * c + w2 * r;
}
DI float hy_conv_lane(float c, float w0, float w1, float w2, int lane) {
    const float l = shi(c, (lane + 63) & 63), r = shi(c, (lane + 1) & 63);
    return w0 * (lane > 0 ? l : 0.f) + w1 * c + w2 * (lane < 63 ? r : 0.f);
}
PF void hy_lat(const KC& k, int jl, LAS float* ldsf) {
    const int tid = TID();
    LAS cf* X = (LAS cf*)ldsf;
    LAS cf* tw = X + 17408;
    LAS cf* tA = tw + 1024; LAS cf* tB = tA + 128;
    const float* FT = (const float*)(k.ws + AR_FT);
    const bf16_t* PT = (const bf16_t*)(k.ws + AR_PB);
    bf16_t* ZT = (bf16_t*)(k.ws + AR_ZT);
    unsigned* scr = (unsigned*)(k.ws + AR_FFTS) + (size_t)blockIdx.x * 4 * 16384;
    unsigned* sKe = scr; unsigned* sKo = scr + 16384; unsigned* zp = scr + 2 * 16384; unsigned* ye = scr + 3 * 16384;
#define CPK(v) pk2((v).x, (v).y)
#define CUP(u_) ((cf){__uint_as_float((u_) << 16), __uint_as_float((u_) & 0xffff0000u)})
    const float* cw = k.hy_conv + (size_t)jl * 3 * 3072;
    for (int m = 0; m < 2; ++m) { const int p = tid + 512 * m; float sn, cs; sincospif(-(float)p / 8192.0f, &sn, &cs); cf w; w.x = cs; w.y = sn; tw[p] = w; }
    if (tid < 256) { const int a = tid & 127; float sn, cs; sincospif(-(float)(tid < 128 ? 128 * a : a) / 16384.0f, &sn, &cs); cf w; w.x = cs; w.y = sn; (tid < 128 ? tA : tB)[a] = w; }
    __syncthreads();
    const int lane = tid & 63;
#define HY_SPLIT() asm volatile("" ::: "memory")
#define HY_CONV(c, w0, w1, w2) hy_conv_lane((c), (w0), (w1), (w2), lane)
    for (int ch = blockIdx.x; ch < 1024; ch += gridDim.x) {
        {
            const bf16_t* pv = PT + (size_t)ch * T + TC;
            const float w0 = cw[ch], w1 = cw[3072 + ch], w2 = cw[6144 + ch];
            for (int m0 = 0; m0 < 32; m0 += 8) {
                bf16_t a0[8], a1[8];
#pragma unroll
                for (int q = 0; q < 8; ++q) { const int j = tid + 512 * (m0 + q); a0[q] = pv[j]; a1[q] = pv[SEQ + j]; }
                HY_SPLIT();
#pragma unroll
                for (int q = 0; q < 8; ++q) { const int j = tid + 512 * (m0 + q); const float c0 = bf2f(a0[q]), c1 = bf2f(a1[q]); cf z; z.x = HY_CONV(c0, w0, w1, w2); z.y = HY_CONV(c1, w0, w1, w2); zp[j] = CPK(z); }
            }
        }
        for (int n = 0; n < 2; ++n) {
            __syncthreads();
            const float* ftf = FT + (size_t)(n * 2048 + ch) * 16384; const float* ftb = FT + (size_t)(n * 2048 + 1024 + ch) * 16384;
            for (int m0 = 0; m0 < 32; m0 += 8) {
                float hfv[8], hbv[8];
#pragma unroll
                for (int q = 0; q < 8; ++q) { const int j = tid + 512 * (m0 + q); hfv[q] = ftf[j]; hbv[q] = ftb[j > 0 ? SEQ - j : 0]; }
                HY_SPLIT();
#pragma unroll
                for (int q = 0; q < 8; ++q) {
                    const int j = tid + 512 * (m0 + q);
                    const float hf = hfv[q], hb = j > 0 ? hbv[q] : 0.f;
                    const cf w = cmul(tA[j >> 7], tB[j & 127]);
                    cf a; a.x = hf + hb; a.y = 0.f; X[PIDX(j)] = a;
                    const float kd = hf - hb; cf o; o.x = kd * w.x; o.y = kd * w.y; sKo[j] = CPK(o);
                }
            }
            __syncthreads();
            fft16k_fwd(X, tw);
            _Pragma("unroll 8") for (int m = 0; m < 32; ++m) { const int j = tid + 512 * m; const cf t_ = X[PIDX(j)]; sKe[j] = CPK(t_); }
            __syncthreads();
            for (int m0 = 0; m0 < 32; m0 += 8) { unsigned t[8];
#pragma unroll
                for (int q = 0; q < 8; ++q) t[q] = sKo[tid + 512 * (m0 + q)];
                HY_SPLIT();
#pragma unroll
                for (int q = 0; q < 8; ++q) X[PIDX(tid + 512 * (m0 + q))] = CUP(t[q]); }
            __syncthreads();
            fft16k_fwd(X, tw);
            _Pragma("unroll 8") for (int m = 0; m < 32; ++m) { const int j = tid + 512 * m; const cf t_ = X[PIDX(j)]; sKo[j] = CPK(t_); }
            __syncthreads();
            for (int m0 = 0; m0 < 32; m0 += 8) { unsigned t[8];
#pragma unroll
                for (int q = 0; q < 8; ++q) t[q] = zp[tid + 512 * (m0 + q)];
                HY_SPLIT();
#pragma unroll
                for (int q = 0; q < 8; ++q) X[PIDX(tid + 512 * (m0 + q))] = CUP(t[q]); }
            __syncthreads();
            fft16k_fwd(X, tw);
            for (int m0 = 0; m0 < 32; m0 += 8) { unsigned t[8];
#pragma unroll
                for (int q = 0; q < 8; ++q) t[q] = sKe[tid + 512 * (m0 + q)];
                HY_SPLIT();
#pragma unroll
                for (int q = 0; q < 8; ++q) { const int j = tid + 512 * (m0 + q); X[PIDX(j)] = cmul(X[PIDX(j)], CUP(t[q])); } }
            __syncthreads();
            fft16k_inv(X, tw);
            _Pragma("unroll 8") for (int m = 0; m < 32; ++m) { const int j = tid + 512 * m; const cf t_ = X[PIDX(j)]; ye[j] = CPK(t_); }
            __syncthreads();
            for (int m0 = 0; m0 < 32; m0 += 8) { unsigned t[8];
#pragma unroll
                for (int q = 0; q < 8; ++q) t[q] = zp[tid + 512 * (m0 + q)];
                HY_SPLIT();
#pragma unroll
                for (int q = 0; q < 8; ++q) { const int j = tid + 512 * (m0 + q); const cf w = cmul(tA[j >> 7], tB[j & 127]); X[PIDX(j)] = cmul(CUP(t[q]), w); } }
            __syncthreads();
            fft16k_fwd(X, tw);
            for (int m0 = 0; m0 < 32; m0 += 8) { unsigned t[8];
#pragma unroll
                for (int q = 0; q < 8; ++q) t[q] = sKo[tid + 512 * (m0 + q)];
                HY_SPLIT();
#pragma unroll
                for (int q = 0; q < 8; ++q) { const int j = tid + 512 * (m0 + q); X[PIDX(j)] = cmul(X[PIDX(j)], CUP(t[q])); } }
            __syncthreads();
            fft16k_inv(X, tw);
            {
                const bf16_t* pg = PT + (size_t)((n + 1) * 1024 + ch) * T + TC;
                const int gcol = (n + 1) * 1024 + ch;
                const float w0 = cw[gcol], w1 = cw[3072 + gcol], w2 = cw[6144 + gcol];
                const float bias = k.hy_bias[(size_t)jl * 2 * 1024 + n * 1024 + ch];
                for (int m0 = 0; m0 < 32; m0 += 8) {
                    unsigned te_[8], tz_[8]; bf16_t g0[8], g1[8];
#pragma unroll
                    for (int q = 0; q < 8; ++q) { const int j = tid + 512 * (m0 + q); te_[q] = ye[j]; tz_[q] = zp[j]; g0[q] = pg[j]; g1[q] = pg[SEQ + j]; }
                    HY_SPLIT();
#pragma unroll
                    for (int q = 0; q < 8; ++q) {
                        const int j = tid + 512 * (m0 + q);
                        cf w = cmul(tA[j >> 7], tB[j & 127]); w.y = -w.y;
                        const cf yo = cmul(X[PIDX(j)], w);
                        const cf te = CUP(te_[q]), tz = CUP(tz_[q]);
                        const float y0 = (0.5f / 16384.0f) * (te.x + yo.x), y1 = (0.5f / 16384.0f) * (te.y + yo.y);
                        const float c0 = bf2f(g0[q]), c1 = bf2f(g1[q]);
                        cf zn; zn.x = HY_CONV(c0, w0, w1, w2) * (y0 + bias * tz.x); zn.y = HY_CONV(c1, w0, w1, w2) * (y1 + bias * tz.y);
                        zp[j] = CPK(zn);
                    }
                }
            }
        }
        for (int m0 = 0; m0 < 32; m0 += 8) { unsigned t[8];
#pragma unroll
            for (int q = 0; q < 8; ++q) t[q] = zp[tid + 512 * (m0 + q)];
            HY_SPLIT();
#pragma unroll
            for (int q = 0; q < 8; ++q) { const int j = tid + 512 * (m0 + q); ZT[(size_t)ch * T + TC + j] = (bf16_t)(t[q] & 0xffffu); ZT[(size_t)ch * T + TC + SEQ + j] = (bf16_t)(t[q] >> 16); } }
        __syncthreads();
    }
#undef CPK
#undef CUP
#undef HY_SPLIT
#undef HY_CONV
}
PF void hy_ctx(const KC& k, int jl, LAS float* lds) {
    const int tid = TID(), t = tid & 255, hsel = tid >> 8;
    LAS float* z = lds + hsel * 768; LAS float* hf = z + 256; LAS float* hb = hf + 256;
    const bf16_t* PT = (const bf16_t*)(k.ws + AR_PB);
    bf16_t* U = (bf16_t*)(k.ws + AR_UBUF);
    const float* filtc = (const float*)(k.ws + WS_FILTC);
    const float* cw = k.hy_conv + (size_t)jl * 3 * 3072;
    for (int u = blockIdx.x; u < 1024; u += gridDim.x) {
        const int pr = u * 2 + hsel, b = pr >> 10, ch = pr & 1023;
        float zc;
        {
            const bf16_t* pv = PT + (size_t)ch * T + b * 256;
            const float l = t != 0 ? bf2f(pv[t - 1]) : 0.f, c = bf2f(pv[t]), r = t != 255 ? bf2f(pv[t + 1]) : 0.f;
            zc = cw[ch] * l + cw[3072 + ch] * c + cw[6144 + ch] * r;
        }
        for (int n = 0; n < 2; ++n) {
            __syncthreads();
            z[t] = zc; hf[t] = filtc[(size_t)t * 4096 + n * 2048 + ch]; hb[t] = filtc[(size_t)t * 4096 + n * 2048 + 1024 + ch];
            __syncthreads();
            float y = 0.f;
            for (int s = 0; s <= t; ++s) y += hf[t - s] * z[s];
            for (int s = t + 1; s < 256; ++s) y += hb[s - t] * z[s];
            const int gcol = (n + 1) * 1024 + ch;
            const bf16_t* pg = PT + (size_t)gcol * T + b * 256;
            const float l = t != 0 ? bf2f(pg[t - 1]) : 0.f, c = bf2f(pg[t]), r = t != 255 ? bf2f(pg[t + 1]) : 0.f;
            const float gate = cw[gcol] * l + cw[3072 + gcol] * c + cw[6144 + gcol] * r;
            zc = gate * (y + k.hy_bias[(size_t)jl * 2048 + n * 1024 + ch] * zc);
        }
        U[(size_t)(b * 256 + t) * 1024 + ch] = f2bf(zc);
        __syncthreads();
    }
}
PF void hy_transpose(const KC& k, LAS bf16_t* lds) {
    const int tid = TID();
    const bf16_t* ZT = (const bf16_t*)(k.ws + AR_ZT);
    bf16_t* U = (bf16_t*)(k.ws + AR_UBUF);
    for (int u = blockIdx.x; u < 16 * (TL / 64); u += gridDim.x) {
        const int c0 = (u & 15) * 64, r0 = TC + (u >> 4) * 64;
        { const int c = tid >> 3, sg = (tid & 7) * 8;
          const u32x4 v = *(const u32x4*)(ZT + (size_t)(c0 + c) * T + r0 + sg);
#pragma unroll
          for (int w = 0; w < 4; ++w) { lds[(sg + 2 * w) * 66 + c] = (bf16_t)(v[w] & 0xffff); lds[(sg + 2 * w + 1) * 66 + c] = (bf16_t)(v[w] >> 16); } }
        __syncthreads();
        { const int r = tid >> 3, sg = (tid & 7) * 8; u32x4 o;
#pragma unroll
          for (int w = 0; w < 4; ++w) o[w] = (unsigned)lds[r * 66 + sg + 2 * w] | ((unsigned)lds[r * 66 + sg + 2 * w + 1] << 16);
          *(u32x4*)(U + (size_t)(r0 + r) * 1024 + c0 + sg) = o; }
        __syncthreads();
    }
}

__global__ void __launch_bounds__(NTHR, 2) fwd_kernel(Params prm) {
    extern __shared__ __attribute__((aligned(16))) unsigned char lds_raw[];
    LAS unsigned char* lds = (LAS unsigned char*)lds_raw;
    LAS float* ldsf = (LAS float*)lds;
    LAS bf16_t* ldsh = (LAS bf16_t*)lds;
    LAS int* tb = (LAS int*)(lds + 150 * 1024);
    volatile LAS unsigned* xbw = (volatile LAS unsigned*)(lds + 151 * 1024 + 512);
    KC k;
    k.x = (const float*)(GAS const float*)prm.in[0]; k.c = (const float*)(GAS const float*)prm.in[1]; k.ctx = (const float*)(GAS const float*)prm.in[2]; k.c_ctx = (const float*)(GAS const float*)prm.in[3]; k.ada_w = (const float*)(GAS const float*)prm.in[4]; k.ada_b = (const float*)(GAS const float*)prm.in[5];
    k.norm_mix = (const float*)(GAS const float*)prm.in[6]; k.norm_ffn = (const float*)(GAS const float*)prm.in[7]; k.norm_final = (const float*)(GAS const float*)prm.in[8];
    k.dn_w_in = (const float*)(GAS const float*)prm.in[9]; k.dn_conv = (const float*)(GAS const float*)prm.in[10]; k.dn_a_log = (const float*)(GAS const float*)prm.in[11]; k.dn_dt_bias = (const float*)(GAS const float*)prm.in[12]; k.dn_out_norm = (const float*)(GAS const float*)prm.in[13]; k.dn_w_out = (const float*)(GAS const float*)prm.in[14];
    k.hy_w_in = (const float*)(GAS const float*)prm.in[15]; k.hy_conv = (const float*)(GAS const float*)prm.in[16]; k.hy_f_w1 = (const float*)(GAS const float*)prm.in[17]; k.hy_f_b1 = (const float*)(GAS const float*)prm.in[18]; k.hy_f_freq = (const float*)(GAS const float*)prm.in[19]; k.hy_f_w2 = (const float*)(GAS const float*)prm.in[20];
    k.hy_f_b2 = (const float*)(GAS const float*)prm.in[21]; k.hy_f_w3 = (const float*)(GAS const float*)prm.in[22]; k.hy_bias = (const float*)(GAS const float*)prm.in[23]; k.hy_w_out = (const float*)(GAS const float*)prm.in[24];
    k.sc_w_in = (const float*)(GAS const float*)prm.in[25]; k.sc_conv = (const float*)(GAS const float*)prm.in[26]; k.sc_w_out = (const float*)(GAS const float*)prm.in[27]; k.w_router = (const float*)(GAS const float*)prm.in[28]; k.router_bias = (const float*)(GAS const float*)prm.in[29];
    k.moe_w_gate = (const float*)(GAS const float*)prm.in[30]; k.moe_w_up = (const float*)(GAS const float*)prm.in[31]; k.moe_w_down = (const float*)(GAS const float*)prm.in[32];
    k.out = (float*)(GAS float*)prm.out; k.ws = (unsigned char*)(GAS unsigned char*)prm.ws;
    const int lo = prm.ph_lo, hi = prm.ph_hi;
    XcdBarrier bar; bar.bar = (unsigned*)(k.ws + WS_CTL); bar.x = 0; bar.st = xbw;
    if (hi - lo > 1) {
        if (threadIdx.x == 0) { xbw[0] = 0u; xbw[1] = 0u; }
        __syncthreads();
        bar = xcd_barrier_post((unsigned*)(k.ws + WS_CTL), xbw);
    }
    int ph = 0;
#define PROBE_OK(id) ((id) != 1 || i == 0)
    int i = 0;
#define PH_BEGIN(id) if (ph >= lo && ph < hi) { const int nrep_ = (((id) == PROBE_REP) && PROBE_OK(id)) ? 2 : 1; for (int rep_ = 0; rep_ < nrep_; ++rep_) { { GAS unsigned char* w_ = (GAS unsigned char*)k.ws; asm volatile("" : "+s"(w_)); k.ws = (unsigned char*)w_; }
#define PH_END   if (ph + 1 < hi) xcd_barrier(bar); } } ++ph;

    float* xs = (float*)(k.ws + WS_XS);
    const float* mod = (const float*)(k.ws + WS_MOD);

    PH_BEGIN(0)
        job_mod(k, ldsf);
        job_cvt_small(k, ldsf);
        job_hdn(k, ldsf);
        job_w3s(k);
    PH_END

    for (i = 0; i < DEPTH; ++i) {
        const int kind = i % 3, j = i / 3;
        const bool last = (i == DEPTH - 1);
        PH_BEGIN(1)
            if (kind == 0) norm_mfma<2>(k, i, i == 0, i > 0, k.norm_mix + i * 1024, 0, k.dn_w_in + (size_t)j * 1024 * DN_IN + 4096, DN_IN,
                                        k.dn_a_log + j * 16, k.dn_dt_bias + j * 16, last, lds);
            else norm_phase<0>(k, i, i == 0, i > 0, k.norm_mix + i * 1024, 0, nullptr, 0, nullptr, nullptr, last, ldsf);
            if (kind == 1) job_filtc(k, j);
        PH_END
        PH_BEGIN(2)
            if (kind == 0) { EpiBf16 e{(bf16_t*)(k.ws + AR_PB), 3072, 3072, (bf16_t*)k.out, 1024}; gemm_dense(lds, (const bf16_t*)(k.ws + AR_HBUF), T, (const bf16_t*)(k.ws + WS_DNWIN) + (size_t)j * 4096 * 1024, 4096, 1024, e); }
            else if (kind == 1) { EpiBf16T e{(bf16_t*)(k.ws + AR_PB), T}; gemm_dense(lds, (const bf16_t*)(k.ws + AR_HBUF), T, (const bf16_t*)(k.ws + WS_HYWIN), 3072, 1024, e);
                                  EpiTaps et{(float*)(k.ws + AR_FT)}; gemm_dense(lds, (const bf16_t*)(k.ws + WS_W3S), 4096, (const bf16_t*)(k.ws + WS_HS), 16384, 256, et); }
            else { EpiBf16 e{(bf16_t*)(k.ws + AR_PB), 3072, 1 << 30, nullptr, 0}; gemm_dense(lds, (const bf16_t*)(k.ws + AR_HBUF), T, (const bf16_t*)(k.ws + WS_SCWIN), 3072, 1024, e); }
        PH_END
        if (kind == 0) {
            PH_BEGIN(3) dn_chunk(k, j, lds); PH_END
            PH_BEGIN(4) dn_scan(k, lds); PH_END
            PH_BEGIN(5) dn_finish(k, j); PH_END
        } else if (kind == 1) {
            PH_BEGIN(6) hy_lat(k, j, ldsf); hy_ctx(k, j, ldsf); PH_END
            PH_BEGIN(7) hy_transpose(k, ldsh); PH_END
        } else {
            PH_BEGIN(8) sc_mix(k, j); PH_END
        }
        PH_BEGIN(9)
            const bf16_t* Wt = kind == 0 ? (const bf16_t*)(k.ws + WS_DNWOUT) + (size_t)j * 1024 * 1024 : (kind == 1 ? (const bf16_t*)(k.ws + WS_HYWOUT) : (const bf16_t*)(k.ws + WS_SCWOUT));
            EpiResid e{xs, mod, i, 2};
            gemm_dense(lds, (const bf16_t*)(k.ws + AR_UBUF), T, Wt, 1024, 1024, e);
            if (gridDim.x == 256) job_cvt_moe(k, i, ldsf, (int)blockIdx.x - 8, 248); else job_cvt_moe(k, i, ldsf, (int)blockIdx.x, (int)gridDim.x);
        PH_END
        PH_BEGIN(10)
            norm_mfma<1>(k, i, false, false, k.norm_ffn + i * 1024, 3, k.w_router, 32, k.router_bias, nullptr, last, lds, rep_ == nrep_ - 1);
        PH_END
        PH_BEGIN(11)
            moe_scatter(k, i, tb);
        PH_END
        PH_BEGIN(12) moe_gemm<0>(k, i, lds, tb); PH_END
        PH_BEGIN(13) moe_gemm<1>(k, i, lds, tb); PH_END
    }
    PH_BEGIN(14)
        norm_phase<3>(k, DEPTH, false, true, k.norm_final, 0, nullptr, 0, nullptr, nullptr, false, ldsf);
    PH_END
#undef PH_BEGIN
#undef PH_END
}
constexpr int N_PHASES = 1 + (10 + 9 + 8 + 10) + 1;

extern "C" void kernel_launch(void* const* d_in, const int* in_sizes, int n_in, void* d_out, int out_size, void* d_ws, size_t ws_size, hipStream_t stream) {
    static int grid = 0;
    if (grid == 0) {
        if (n_in != 33 || out_size != TL * D || ws_size < WS_END) { fprintf(stderr, "kernel_launch: unexpected shapes: n_in %d out %d ws %zu (need %zu)\n", n_in, out_size, ws_size, (size_t)WS_END); grid = -1; return; }
        int dev = 0, cus = 0, per_cu = 0;
        if (hipGetDevice(&dev) != hipSuccess || hipDeviceGetAttribute(&cus, hipDeviceAttributeMultiprocessorCount, dev) != hipSuccess) { grid = -1; return; }
        if (hipFuncSetAttribute((const void*)fwd_kernel, hipFuncAttributeMaxDynamicSharedMemorySize, LDS_BYTES) != hipSuccess) { fprintf(stderr, "kernel_launch: hipFuncSetAttribute failed\n"); grid = -1; return; }
        if (hipOccupancyMaxActiveBlocksPerMultiprocessor(&per_cu, (const void*)fwd_kernel, NTHR, LDS_BYTES) != hipSuccess || per_cu < 1) fprintf(stderr, "kernel_launch: occupancy query reports %d\n", per_cu);
        (void)hipGetLastError();
        grid = cus;
    }
    if (grid < 0) return;
    (void)hipMemsetAsync((char*)d_ws + WS_CTL, 0, CTL_BYTES, stream);
    Params p{};
    for (int i = 0; i < 33; ++i) p.in[i] = (const float*)d_in[i];
    p.out = (float*)d_out; p.ws = (unsigned char*)d_ws;
#if MK_MULTI
    for (int ph = 0; ph < N_PHASES; ++ph) { p.ph_lo = ph; p.ph_hi = ph + 1; hipLaunchKernelGGL(fwd_kernel, dim3(grid), dim3(NTHR), LDS_BYTES, stream, p); }
#else
    p.ph_lo = 0; p.ph_hi = N_PHASES;
    hipLaunchKernelGGL(fwd_kernel, dim3(grid), dim3(NTHR), LDS_BYTES, stream, p);
#endif
}
```

```cpp
#include <hip/hip_runtime.h>
#include <stdint.h>
#include <stdio.h>
#include <math.h>

#ifndef MK_MULTI
#define MK_MULTI 0
#endif

#ifndef PROBE_SUB
#define PROBE_SUB (0)
#endif
#ifndef PROBE_REP
#define PROBE_REP (-1)
#endif
#define LAS __attribute__((address_space(3)))
#define GAS __attribute__((address_space(1)))
#define HD __host__ __device__ __forceinline__
#define DI __device__ __forceinline__
#ifdef NOINL
#define PF __device__ __noinline__
#else
#define PF __device__ __forceinline__
#endif
typedef unsigned short bf16_t;
typedef short bf16x8 __attribute__((ext_vector_type(8)));
typedef float f32x4 __attribute__((ext_vector_type(4)));
typedef unsigned u32x4 __attribute__((ext_vector_type(4)));
typedef unsigned u32x2 __attribute__((ext_vector_type(2)));

constexpr int D = 1024, NB = 2, SEQ = 16384, CTXL = 256, DEPTH = 4;
constexpr int TC = NB * CTXL, TL = NB * SEQ, T = TC + TL, NA = 2 * T;
constexpr int NTHR = 512;
constexpr int DN_IN = 4128;
constexpr float EPS = 1e-6f;
constexpr int LDS_BYTES = 152 * 1024;

constexpr size_t AL(size_t x) { return (x + 255) & ~(size_t)255; }
constexpr size_t WS_CTL = 0;
constexpr size_t CTL_BYTES = 65536;
constexpr size_t CTL_CNT = 16384;
constexpr size_t WS_MOD = WS_CTL + CTL_BYTES;
constexpr size_t WS_HS = AL(WS_MOD + 4 * 3 * 6144 * 4);
constexpr size_t WS_W3S = AL(WS_HS + 16384 * 256 * 2);
constexpr size_t WS_HDNC = AL(WS_W3S + 4096 * 256 * 2);
constexpr size_t WS_FILTC = AL(WS_HDNC + 256 * 64 * 4);
constexpr size_t WS_DNWIN = AL(WS_FILTC + 256 * 4096 * 4);
constexpr size_t WS_DNWOUT = AL(WS_DNWIN + (size_t)2 * 4096 * 1024 * 2);
constexpr size_t WS_HYWIN = AL(WS_DNWOUT + (size_t)2 * 1024 * 1024 * 2);
constexpr size_t WS_HYWOUT = AL(WS_HYWIN + (size_t)3072 * 1024 * 2);
constexpr size_t WS_SCWIN = AL(WS_HYWOUT + (size_t)1024 * 1024 * 2);
constexpr size_t WS_SCWOUT = AL(WS_SCWIN + (size_t)3072 * 1024 * 2);
constexpr size_t WS_XS = AL(WS_SCWOUT + (size_t)1024 * 1024 * 2);
constexpr size_t WS_TOKE = AL(WS_XS + (size_t)T * 1024 * 4);
constexpr size_t WS_TOKW = AL(WS_TOKE + (size_t)T * 2 * 4);
constexpr size_t WS_TOKP = AL(WS_TOKW + (size_t)T * 2 * 4);
constexpr size_t WS_SLOT = AL(WS_TOKP + (size_t)T * 2 * 4);
constexpr size_t WS_GB = AL(WS_SLOT + (size_t)(NA + 256) * 4);
constexpr size_t WS_EGL = AL(WS_GB + (size_t)T * 32 * 4);
constexpr size_t WS_AR = AL(WS_EGL + (size_t)32 * 260 * 4);
constexpr size_t AR_HBUF = WS_AR;
constexpr size_t AR_UBUF = AR_HBUF + (size_t)T * 1024 * 2;
constexpr size_t AR_PB = AR_UBUF + (size_t)T * 1024 * 2;
constexpr size_t AR_Q = AR_PB + (size_t)T * 4096 * 2;
constexpr size_t AR_CHUNK = AR_PB + (size_t)T * 3072 * 2;
constexpr size_t AR_DN_END = AR_CHUNK + (size_t)32 * 260 * 65536;
constexpr size_t AR_ZT = AR_Q;
constexpr size_t AR_FFTS = AR_ZT + (size_t)1024 * T * 2;
constexpr size_t AR_FT = AR_FFTS + (size_t)256 * 4 * 16384 * 8;
constexpr size_t AR_HY_END = AR_FT + (size_t)4096 * 16384 * 4;
constexpr size_t AR_HID = AR_PB;
constexpr size_t AR_YS = AR_HID + (size_t)NA * 512 * 2;
constexpr size_t AR_WGU = AR_YS + (size_t)NA * 1024 * 2;
constexpr size_t AR_WD = AR_WGU + (size_t)32 * 1024 * 1024 * 2;
constexpr size_t AR_MOE_END = AR_WD + (size_t)32 * 1024 * 512 * 2;
constexpr size_t WS_END = AR_DN_END > AR_HY_END ? (AR_DN_END > AR_MOE_END ? AR_DN_END : AR_MOE_END) : (AR_HY_END > AR_MOE_END ? AR_HY_END : AR_MOE_END);

#define XB_TMO      128
#define XB_XCNT(j)  (256  + 64 * (j))
#define XB_XSUB(j)  (1280 + 64 * (j))
#define XB_XGEN(j)  (2304 + 64 * (j))
#define XB_TOP      3328
#define XB_TOPGEN   3392
#define XCD_BAR_WORDS 3456
#define XB_SPIN_CAP (1u << 25)
DI unsigned xb_ld(unsigned* p)              { return __hip_atomic_load(p, __ATOMIC_RELAXED, __HIP_MEMORY_SCOPE_AGENT); }
DI unsigned xb_add(unsigned* p, unsigned v) { return __hip_atomic_fetch_add(p, v, __ATOMIC_RELAXED, __HIP_MEMORY_SCOPE_AGENT); }
DI unsigned xb_xcc_id() { return (unsigned)__builtin_amdgcn_s_getreg((3 << 11) | 20) & 0xFu; }
#define XB_SPIN(cond, bar) do { unsigned _sp = 0; while (cond) { __builtin_amdgcn_s_sleep(1); \
    if ((++_sp & 255u) == 0u) { if (xb_ld(&(bar)[XB_TMO])) break; if (_sp > XB_SPIN_CAP) { atomicAdd(&(bar)[XB_TMO], 1u); break; } } } } while (0)
struct XcdBarrier { unsigned* bar; unsigned x; volatile LAS unsigned* st; };
DI XcdBarrier xcd_barrier_post(unsigned* bar, volatile LAS unsigned* st) {
    XcdBarrier b; b.bar = bar; b.x = xb_xcc_id(); b.st = st;
    if (threadIdx.x == 0) (void)xb_add(&bar[XB_XCNT(b.x)], 1u);
    return b;
}
DI void xcd_barrier_complete(unsigned* bar, unsigned x, unsigned& nloc, unsigned& nx) {
    const unsigned G = gridDim.x * gridDim.y * gridDim.z;
    unsigned sum, cnt, mine, sp = 0u;
    for (;;) {
        sum = 0u; cnt = 0u; mine = 0u;
#pragma unroll
        for (unsigned j = 0; j < 16; ++j) { const unsigned c = xb_ld(&bar[XB_XCNT(j)]); sum += c; cnt += (c > 0u) ? 1u : 0u; mine = (j == x) ? c : mine; }
        if (sum == G) break;
        __builtin_amdgcn_s_sleep(1);
        if ((++sp & 255u) == 0u) { if (xb_ld(&bar[XB_TMO])) break; if (sp > XB_SPIN_CAP) { atomicAdd(&bar[XB_TMO], 1u); break; } }
    }
    nloc = mine > 0u ? mine : 1u; nx = cnt > 0u ? cnt : 1u;
}
DI void xcd_barrier(const XcdBarrier& b) {
    asm volatile("s_waitcnt vmcnt(0)" ::: "memory");
    __syncthreads();
    if (threadIdx.x == 0) {
        unsigned* bar = b.bar;
        __builtin_amdgcn_s_waitcnt(0);
        unsigned nloc = b.st[0], nx = b.st[1];
        if (nloc == 0u) { xcd_barrier_complete(bar, b.x, nloc, nx); b.st[0] = nloc; b.st[1] = nx; }
        const unsigned old = xb_add(&bar[XB_XSUB(b.x)], 1u);
        const unsigned gen = old / nloc;
        if (old + 1u == (gen + 1u) * nloc) {
            __builtin_amdgcn_fence(__ATOMIC_RELEASE, "agent");
            asm volatile("s_waitcnt vmcnt(0)" ::: "memory");
            const unsigned og = xb_add(&bar[XB_TOP], 1u);
            const unsigned tg = og / nx;
            if (og + 1u == (tg + 1u) * nx) xb_add(&bar[XB_TOPGEN], 1u);
            else XB_SPIN(xb_ld(&bar[XB_TOPGEN]) == tg, bar);
            __builtin_amdgcn_fence(__ATOMIC_ACQUIRE, "agent");
            xb_add(&bar[XB_XGEN(b.x)], 1u);
            asm volatile("s_waitcnt vmcnt(0)" ::: "memory");
        } else {
            XB_SPIN(xb_ld(&bar[XB_XGEN(b.x)]) == gen, bar);
            __builtin_amdgcn_fence(__ATOMIC_ACQUIRE, "agent");
            asm volatile("s_waitcnt vmcnt(0)" ::: "memory");
        }
    }
    __syncthreads();
}

typedef float f32x2_t __attribute__((ext_vector_type(2)));
typedef __bf16 bf16x2_t __attribute__((ext_vector_type(2)));
DI unsigned cvt_pk_bf16(float lo, float hi) { f32x2_t v; v.x = lo; v.y = hi; const bf16x2_t b = __builtin_convertvector(v, bf16x2_t); return __builtin_bit_cast(unsigned, b); }
DI bf16_t f2bf(float f) { return (bf16_t)(cvt_pk_bf16(f, f) & 0xffffu); }
DI float bf2f(bf16_t b) { return __uint_as_float(((unsigned)b) << 16); }
DI unsigned pk2(float lo, float hi) { return cvt_pk_bf16(lo, hi); }
DI float siluf(float x) { return x * __builtin_amdgcn_rcpf(1.0f + __expf(-x)); }
DI float sigmf(float x) { return 1.0f / (1.0f + __expf(-x)); }
DI float shi(float v, int src) { return __int_as_float(__builtin_amdgcn_ds_bpermute(src << 2, __float_as_int(v))); }
DI int shii(int v, int src) { return __builtin_amdgcn_ds_bpermute(src << 2, v); }
DI float shx(float v, int m, int lane) { return shi(v, lane ^ m); }
DI float wsum(float v, int lane) {
#pragma unroll
    for (int m = 32; m >= 1; m >>= 1) v += shx(v, m, lane);
    return v;
}
DI void lds_barrier() { asm volatile("s_waitcnt lgkmcnt(0)\n\ts_barrier" ::: "memory"); }
DI int TID() { int t = threadIdx.x; asm volatile("" : "+v"(t)); return t; }
DI int modrow(int r) { return r < TC ? 0 : 1 + (r - TC) / SEQ; }

typedef float cf __attribute__((ext_vector_type(2)));
HD cf cmul(cf a, cf b) { cf r; r.x = a.x * b.x - a.y * b.y; r.y = a.x * b.y + a.y * b.x; return r; }
HD cf cadd(cf a, cf b) { cf r; r.x = a.x + b.x; r.y = a.y + b.y; return r; }
HD cf csub(cf a, cf b) { cf r; r.x = a.x - b.x; r.y = a.y - b.y; return r; }
template <int R> HD constexpr int brev(int i) { int r = 0; for (int b = 1, t = R >> 1; b < R; b <<= 1, t >>= 1) if (i & b) r |= t; return r; }
#define FFT_C32 {1.0f, 0.98078528040323044913f, 0.92387953251128675613f, 0.83146961230254523708f, 0.70710678118654752440f, 0.55557023301960222474f, 0.38268343236508977173f, 0.19509032201612826785f, 0.0f, -0.19509032201612826785f, -0.38268343236508977173f, -0.55557023301960222474f, -0.70710678118654752440f, -0.83146961230254523708f, -0.92387953251128675613f, -0.98078528040323044913f}
#define FFT_S32 {0.0f, 0.19509032201612826785f, 0.38268343236508977173f, 0.55557023301960222474f, 0.70710678118654752440f, 0.83146961230254523708f, 0.92387953251128675613f, 0.98078528040323044913f, 1.0f, 0.98078528040323044913f, 0.92387953251128675613f, 0.83146961230254523708f, 0.70710678118654752440f, 0.55557023301960222474f, 0.38268343236508977173f, 0.19509032201612826785f}
template <int R> HD constexpr int ilog2c() { int l = 0; for (int r = R; r > 1; r >>= 1) ++l; return l; }
template <int R> HD void dft_fwd(cf (&v)[R]) {
    constexpr float C[16] = FFT_C32; constexpr float S[16] = FFT_S32;
    constexpr int LG = ilog2c<R>();
#pragma unroll
    for (int st = 0; st < LG; ++st) {
#pragma unroll
        for (int i = 0; i < R / 2; ++i) {
            const int len = R >> st, half = len >> 1, blk = i / half, j = i % half, i0 = blk * len + j, i1 = i0 + half;
            const cf a = v[i0], c = v[i1];
            v[i0] = cadd(a, c);
            const cf d = csub(a, c);
            const int ti = j * (32 / len);
            cf w; w.x = C[ti]; w.y = -S[ti];
            cf r;
            if (ti == 0) r = d;
            else if (ti == 8) { r.x = d.y; r.y = -d.x; }
            else if (ti == 4) { r.x = (d.x + d.y) * 0.70710678118654752440f; r.y = (d.y - d.x) * 0.70710678118654752440f; }
            else if (ti == 12) { r.x = (d.y - d.x) * 0.70710678118654752440f; r.y = -(d.x + d.y) * 0.70710678118654752440f; }
            else r = cmul(d, w);
            v[i1] = r;
        }
    }
}
template <int R> HD void dft_inv(cf (&v)[R]) {
    constexpr float C[16] = FFT_C32; constexpr float S[16] = FFT_S32;
    constexpr int LG = ilog2c<R>();
#pragma unroll
    for (int st = LG - 1; st >= 0; --st) {
#pragma unroll
        for (int i = 0; i < R / 2; ++i) {
            const int len = R >> st, half = len >> 1, blk = i / half, j = i % half, i0 = blk * len + j, i1 = i0 + half;
            const int ti = j * (32 / len);
            cf w; w.x = C[ti]; w.y = S[ti];
            const cf a = v[i0];
            const cf b1 = v[i1];
            cf c;
            if (ti == 0) c = b1;
            else if (ti == 8) { c.x = -b1.y; c.y = b1.x; }
            else if (ti == 4) { c.x = (b1.x - b1.y) * 0.70710678118654752440f; c.y = (b1.x + b1.y) * 0.70710678118654752440f; }
            else if (ti == 12) { c.x = -(b1.x + b1.y) * 0.70710678118654752440f; c.y = (b1.x - b1.y) * 0.70710678118654752440f; }
            else c = cmul(b1, w);
            v[i0] = cadd(a, c);
            v[i1] = csub(a, c);
        }
    }
}
#define PIDX(a) ((a) + (((a) >> 6) << 2))
template <int R> DI void fft_pass_fwd(LAS cf* X, const LAS cf* tw, int n, int g) {
    const int s = n / R, q = g / s, p = g - q * s, base = q * n + p;
    cf v[R];
#pragma unroll
    for (int k = 0; k < R; ++k) v[k] = X[PIDX(base + k * s)];
    dft_fwd<R>(v);
    if (s > 1) {
        int pp = p * (16384 / n); asm volatile("" : "+v"(pp));
        const cf w1 = tw[pp]; cf w = w1;
#pragma unroll
        for (int m = 1; m < R; ++m) { v[brev<R>(m)] = cmul(v[brev<R>(m)], w); w = cmul(w, w1); }
    }
#pragma unroll
    for (int k = 0; k < R; ++k) X[PIDX(base + k * s)] = v[k];
}
template <int R> DI void fft_pass_inv(LAS cf* X, const LAS cf* tw, int n, int g) {
    const int s = n / R, q = g / s, p = g - q * s, base = q * n + p;
    cf v[R];
#pragma unroll
    for (int k = 0; k < R; ++k) v[k] = X[PIDX(base + k * s)];
    if (s > 1) {
        int pp = p * (16384 / n); asm volatile("" : "+v"(pp));
        cf w1 = tw[pp]; w1.y = -w1.y; cf w = w1;
#pragma unroll
        for (int m = 1; m < R; ++m) { v[brev<R>(m)] = cmul(v[brev<R>(m)], w); w = cmul(w, w1); }
    }
    dft_inv<R>(v);
#pragma unroll
    for (int k = 0; k < R; ++k) X[PIDX(base + k * s)] = v[k];
}
DI void fft16k_fwd(LAS cf* X, const LAS cf* tw) {
    const int t = TID();
#pragma unroll 1
    for (int g = 0; g < 2; ++g) fft_pass_fwd<16>(X, tw, 16384, t + 512 * g);
    __syncthreads();
#pragma unroll 1
    for (int g = 0; g < 2; ++g) fft_pass_fwd<16>(X, tw, 1024, t + 512 * g);
    __syncthreads();
#pragma unroll 1
    for (int g = 0; g < 2; ++g) fft_pass_fwd<16>(X, tw, 64, t + 512 * g);
    __syncthreads();
#pragma unroll 1
    for (int g = 0; g < 8; ++g) fft_pass_fwd<4>(X, tw, 4, t + 512 * g);
    __syncthreads();
}
DI void fft16k_inv(LAS cf* X, const LAS cf* tw) {
    const int t = TID();
#pragma unroll 1
    for (int g = 0; g < 8; ++g) fft_pass_inv<4>(X, tw, 4, t + 512 * g);
    __syncthreads();
#pragma unroll 1
    for (int g = 0; g < 2; ++g) fft_pass_inv<16>(X, tw, 64, t + 512 * g);
    __syncthreads();
#pragma unroll 1
    for (int g = 0; g < 2; ++g) fft_pass_inv<16>(X, tw, 1024, t + 512 * g);
    __syncthreads();
#pragma unroll 1
    for (int g = 0; g < 2; ++g) fft_pass_inv<16>(X, tw, 16384, t + 512 * g);
    __syncthreads();
}

struct Params { const float* in[33]; float* out; unsigned char* ws; int ph_lo, ph_hi; };
struct KC {
    const float *x, *c, *ctx, *c_ctx, *ada_w, *ada_b, *norm_mix, *norm_ffn, *norm_final;
    const float *dn_w_in, *dn_conv, *dn_a_log, *dn_dt_bias, *dn_out_norm, *dn_w_out;
    const float *hy_w_in, *hy_conv, *hy_f_w1, *hy_f_b1, *hy_f_freq, *hy_f_w2, *hy_f_b2, *hy_f_w3, *hy_bias, *hy_w_out;
    const float *sc_w_in, *sc_conv, *sc_w_out, *w_router, *router_bias, *moe_w_gate, *moe_w_up, *moe_w_down;
    float* out; unsigned char* ws;
};

PF void job_mod(const KC& k, LAS float* lds) {
    const int tid = TID(), cj = tid & 63, kq = tid >> 6;
    float* mod = (float*)(k.ws + WS_MOD);
    LAS float* sl = lds + 2048;
    for (int i = tid; i < 3072; i += NTHR) { const float v = i < 1024 ? k.c_ctx[i] : k.c[i - 1024]; sl[i] = siluf(v); }
    __syncthreads();
    for (int u = blockIdx.x; u < DEPTH * 96; u += gridDim.x) {
        const int l = u / 96, cc = u % 96, col = cc * 64 + cj;
        const float* W = k.ada_w + (size_t)l * 1024 * 6144 + col;
        float a0 = 0.f, a1 = 0.f, a2 = 0.f;
        for (int k0 = kq * 128; k0 < kq * 128 + 128; k0 += 16) {
            float w[16];
#pragma unroll
            for (int e = 0; e < 16; ++e) w[e] = W[(size_t)(k0 + e) * 6144];
            asm volatile("" ::: "memory");
#pragma unroll
            for (int e = 0; e < 16; ++e) { a0 += sl[k0 + e] * w[e]; a1 += sl[1024 + k0 + e] * w[e]; a2 += sl[2048 + k0 + e] * w[e]; }
        }
        lds[(kq * 3 + 0) * 64 + cj] = a0; lds[(kq * 3 + 1) * 64 + cj] = a1; lds[(kq * 3 + 2) * 64 + cj] = a2;
        __syncthreads();
        if (tid < 192) {
            const int r = tid >> 6, j = tid & 63;
            float sacc = 0.f;
            for (int q = 0; q < 8; ++q) sacc += lds[(q * 3 + r) * 64 + j];
            mod[(size_t)(l * 3 + r) * 6144 + cc * 64 + j] = sacc + k.ada_b[l * 6144 + cc * 64 + j];
        }
        __syncthreads();
    }
}
DI void cvt_matrix(const float* src, int ld, size_t sstride, int K, int N, int nmat, bf16_t* dst, int ldd, size_t dstride, int mapmode, LAS float* lds, int bid, int nb) {
    const int tk = K / 64, tn = N / 64, per = tk * tn, tid = TID();
    const int r = tid >> 4, c4 = (tid & 15) * 4;
    f32x4 v0, v1;
    int u = bid;
    if (u < per * nmat) { const int m = u / per, t = u % per; const float* sp = src + (size_t)m * sstride + (size_t)((t / tn) * 64 + r) * ld + (t % tn) * 64 + c4; v0 = *(const f32x4*)sp; v1 = *(const f32x4*)(sp + (size_t)32 * ld); }
    for (; u < per * nmat; u += nb) {
        const int m = u / per, t = u % per, k0 = (t / tn) * 64, n0 = (t % tn) * 64;
        { LAS float* p = lds + r * 65 + c4; p[0] = v0[0]; p[1] = v0[1]; p[2] = v0[2]; p[3] = v0[3];
          LAS float* p2 = lds + (r + 32) * 65 + c4; p2[0] = v1[0]; p2[1] = v1[1]; p2[2] = v1[2]; p2[3] = v1[3]; }
        { const int un = u + nb;
          if (un < per * nmat) { const int mn = un / per, tn_ = un % per; const float* sp = src + (size_t)mn * sstride + (size_t)((tn_ / tn) * 64 + r) * ld + (tn_ % tn) * 64 + c4; v0 = *(const f32x4*)sp; v1 = *(const f32x4*)(sp + (size_t)32 * ld); } }
        lds_barrier();
        { const int nn = tid >> 3, ks = (tid & 7) * 8; const int n = n0 + nn;
          const int row = mapmode == 0 ? n : (32 * (n >> 4) + (n & 15) + (mapmode == 2 ? 16 : 0));
          float f[8];
#pragma unroll
          for (int e = 0; e < 8; ++e) f[e] = lds[(ks + e) * 65 + nn];
          u32x4 o; o[0] = pk2(f[0], f[1]); o[1] = pk2(f[2], f[3]); o[2] = pk2(f[4], f[5]); o[3] = pk2(f[6], f[7]);
          *(u32x4*)(dst + (size_t)m * dstride + (size_t)row * ldd + k0 + ks) = o; }
        lds_barrier();
    }
}
PF void job_cvt_small(const KC& k, LAS float* lds) {
    cvt_matrix(k.dn_w_in, DN_IN, (size_t)1024 * DN_IN, 1024, 4096, 2, (bf16_t*)(k.ws + WS_DNWIN), 1024, (size_t)4096 * 1024, 0, lds, (int)blockIdx.x, (int)gridDim.x);
    cvt_matrix(k.dn_w_out, 1024, (size_t)1024 * 1024, 1024, 1024, 2, (bf16_t*)(k.ws + WS_DNWOUT), 1024, (size_t)1024 * 1024, 0, lds, (int)blockIdx.x, (int)gridDim.x);
    cvt_matrix(k.hy_w_in, 3072, 0, 1024, 3072, 1, (bf16_t*)(k.ws + WS_HYWIN), 1024, 0, 0, lds, (int)blockIdx.x, (int)gridDim.x);
    cvt_matrix(k.hy_w_out, 1024, 0, 1024, 1024, 1, (bf16_t*)(k.ws + WS_HYWOUT), 1024, 0, 0, lds, (int)blockIdx.x, (int)gridDim.x);
    cvt_matrix(k.sc_w_in, 3072, 0, 1024, 3072, 1, (bf16_t*)(k.ws + WS_SCWIN), 1024, 0, 0, lds, (int)blockIdx.x, (int)gridDim.x);
    cvt_matrix(k.sc_w_out, 1024, 0, 1024, 1024, 1, (bf16_t*)(k.ws + WS_SCWOUT), 1024, 0, 0, lds, (int)blockIdx.x, (int)gridDim.x);
}
PF void job_cvt_moe(const KC& k, int layer, LAS float* lds, int bid, int nb) {
    if (bid < 0) return;
    const size_t lo = (size_t)layer * 32 * 1024 * 512;
    cvt_matrix(k.moe_w_gate + lo, 512, (size_t)1024 * 512, 1024, 512, 32, (bf16_t*)(k.ws + AR_WGU), 1024, (size_t)1024 * 1024, 1, lds, bid, nb);
    cvt_matrix(k.moe_w_up + lo, 512, (size_t)1024 * 512, 1024, 512, 32, (bf16_t*)(k.ws + AR_WGU), 1024, (size_t)1024 * 1024, 2, lds, bid, nb);
    cvt_matrix(k.moe_w_down + lo, 1024, (size_t)512 * 1024, 512, 1024, 32, (bf16_t*)(k.ws + AR_WD), 512, (size_t)1024 * 512, 0, lds, bid, nb);
}
PF void job_hdn(const KC& k, LAS float* lds) {
    const int tid = TID(), lane = tid & 63, wave = tid >> 6;
    LAS float* feat = lds + wave * 128; LAS float* h1 = feat + 64;
    const float fr = k.hy_f_freq[lane], b1 = k.hy_f_b1[lane], b2 = k.hy_f_b2[lane];
    for (int u0 = blockIdx.x * 8; u0 < 16384 + 256; u0 += gridDim.x * 8) {
        const int u = u0 + wave;
        int l, pos; float* dst;
        if (u < 16384) { l = 16384; pos = u; dst = nullptr; }
        else { l = 256; pos = u - 16384; dst = (float*)(k.ws + WS_HDNC) + (size_t)pos * 64; }
        const float t = (float)pos / (float)(l - 1);
        float f = 0.f;
        if (lane == 0) f = t;
        else if (lane <= 32) {
            const int bi = (lane - 1) & 15;
            const float band = 1e-4f + (float)bi * ((15.0f - 1e-4f) / 15.0f);
            const float ang = (6.283185307179586f / (float)l) * (float)pos * band;
            f = lane <= 16 ? cosf(ang) : -sinf(ang);
        }
        feat[lane] = f;
        __syncthreads();
        float a = b1;
        for (int i = 0; i < 33; ++i) a += feat[i] * k.hy_f_w1[i * 64 + lane];
        h1[lane] = sinf(fr * a);
        __syncthreads();
        float a2 = b2;
        for (int j = 0; j < 64; ++j) a2 += h1[j] * k.hy_f_w2[j * 64 + lane];
        const float hv = sinf(fr * a2);
        if (dst) dst[lane] = hv;
        else { bf16_t* hs = (bf16_t*)(k.ws + WS_HS) + (size_t)pos * 256; const bf16_t hi = f2bf(hv), lo = f2bf(hv - bf2f(hi)); hs[lane] = hi; hs[64 + lane] = lo; hs[128 + lane] = hi; hs[192 + lane] = 0; }
        __syncthreads();
    }
}
PF void job_w3s(const KC& k) {
    bf16_t* W = (bf16_t*)(k.ws + WS_W3S);
    const int tq = TID();
    for (int idx = blockIdx.x * NTHR + tq; idx < 64 * 4096; idx += gridDim.x * NTHR) {
        const int j = idx >> 12, col = idx & 4095;
        const float w = k.hy_f_w3[idx]; const bf16_t hi = f2bf(w), lo = f2bf(w - bf2f(hi));
        W[(size_t)col * 256 + j] = hi; W[(size_t)col * 256 + 64 + j] = hi; W[(size_t)col * 256 + 128 + j] = lo; W[(size_t)col * 256 + 192 + j] = 0;
    }
}
DI float hy_delta(int ch) {
    const float lo = -4.605170185988091f / 1.5f, hi = -4.605170185988091f / 0.3f;
    return fabsf(lo + (float)ch * ((hi - lo) / 1023.0f));
}
PF void job_filtc(const KC& k, int j) {
    const float* hdn = (const float*)(k.ws + WS_HDNC);
    const float* w3 = k.hy_f_w3 + (size_t)j * 64 * 4096;
    float* filtc = (float*)(k.ws + WS_FILTC);
    const int tq = TID();
    for (int u = blockIdx.x; u < 256 * 8; u += gridDim.x) {
        const int l = u >> 3, col = (u & 7) * 512 + tq;
        float a = 0.f;
        for (int q = 0; q < 64; ++q) a += hdn[l * 64 + q] * w3[(size_t)q * 4096 + col];
        const float t = (float)l / 255.0f;
        filtc[(size_t)l * 4096 + col] = a * expf(-t * hy_delta(col & 1023));
    }
}

template <int MODE>
PF void norm_phase(const KC& k, int layer, bool first, bool combine, const float* __restrict__ gain, int mb, const float* __restrict__ Wsk, int ldw,
                   const float* __restrict__ aux0, const float* __restrict__ aux1, bool last, LAS float* lds, bool flush = true) {
    const int tid = TID(), lane = tid & 63, wave = tid >> 6;
    float* xs = (float*)(k.ws + WS_XS);
    bf16_t* hbuf = (bf16_t*)(k.ws + AR_HBUF);
    const float* mod = (const float*)(k.ws + WS_MOD);
    const bf16_t* ys = (const bf16_t*)(k.ws + AR_YS);
    const int* tokp = (const int*)(k.ws + WS_TOKP);
    const float* tokw = (const float*)(k.ws + WS_TOKW);
    LAS int* lcnt = (LAS int*)(lds + 32768);
    if (MODE == 1 && tid < 32) lcnt[tid] = 0;
    if (MODE == 1 || MODE == 2) {
        for (int idx = tid; idx < 1024 * 32; idx += NTHR) {
            const int kk = idx >> 5, n = idx & 31;
            lds[kk * 32 + (((n >> 2) ^ ((kk >> 1) & 7)) << 2) + (n & 3)] = Wsk[(size_t)kk * ldw + n];
        }
        __syncthreads();
    }
    const int rbeg = (MODE == 3) ? TC : 0, rstr = gridDim.x * 8;
    int cur_mr = -1; float gsv[16], shv[16], g5v[16];
    float xn[16];
    int r = rbeg + blockIdx.x * 8 + wave;
    if (r < T) {
        const float* src = first ? (r < TC ? k.ctx + (size_t)r * 1024 : k.x + (size_t)(r - TC) * 1024) : xs + (size_t)r * 1024;
#pragma unroll
        for (int m = 0; m < 16; ++m) xn[m] = src[lane + 64 * m];
    }
    for (; r < T; r += rstr) {
        const int mr = modrow(r);
        float x[16];
#pragma unroll
        for (int m = 0; m < 16; ++m) x[m] = xn[m];
        int p0 = 0, p1 = 0; float w0 = 0.f, w1 = 0.f;
        if (combine) { p0 = tokp[2 * r]; p1 = tokp[2 * r + 1]; w0 = tokw[2 * r]; w1 = tokw[2 * r + 1]; }
        {
            const int rn = r + rstr;
            if (rn < T) {
                const float* srcn = first ? (rn < TC ? k.ctx + (size_t)rn * 1024 : k.x + (size_t)(rn - TC) * 1024) : xs + (size_t)rn * 1024;
#pragma unroll
                for (int m = 0; m < 16; ++m) xn[m] = srcn[lane + 64 * m];
            }
        }
        if (mr != cur_mr) {
            cur_mr = mr;
            if (MODE != 3) {
                const float* shift = mod + ((size_t)(layer * 3 + mr) * 6 + mb) * 1024;
#pragma unroll
                for (int m = 0; m < 16; ++m) { const int col = lane + 64 * m; gsv[m] = gain[col] * (1.0f + shift[1024 + col]); shv[m] = shift[col]; }
            } else {
#pragma unroll
                for (int m = 0; m < 16; ++m) gsv[m] = gain[lane + 64 * m];
            }
            if (combine) {
                const float* g5 = mod + ((size_t)((layer - 1) * 3 + mr) * 6 + 5) * 1024;
#pragma unroll
                for (int m = 0; m < 16; ++m) g5v[m] = g5[lane + 64 * m];
            }
        }
        if (combine) {
            bf16_t ya[16], yb[16];
#pragma unroll
            for (int m = 0; m < 16; ++m) { const int col = lane + 64 * m; ya[m] = ys[(size_t)p0 * 1024 + col]; yb[m] = ys[(size_t)p1 * 1024 + col]; }
            asm volatile("" ::: "memory");
#pragma unroll
            for (int m = 0; m < 16; ++m) x[m] += g5v[m] * (w0 * bf2f(ya[m]) + w1 * bf2f(yb[m]));
        }
        if (first || combine) {
#pragma unroll
            for (int m = 0; m < 16; ++m) xs[(size_t)r * 1024 + lane + 64 * m] = x[m];
        }
        float ss = 0.f;
#pragma unroll
        for (int m = 0; m < 16; ++m) ss += x[m] * x[m];
        ss = wsum(ss, lane);
        const float rstd = rsqrtf(ss * (1.0f / 1024.0f) + EPS);
        if (MODE == 3) {
#pragma unroll
            for (int m = 0; m < 16; ++m) { const int col = lane + 64 * m; k.out[(size_t)(r - TC) * 1024 + col] = x[m] * rstd * gsv[m]; }
            continue;
        }
        float y[16];
#pragma unroll
        for (int m = 0; m < 16; ++m) {
            const int col = lane + 64 * m;
            y[m] = x[m] * rstd * gsv[m] + shv[m];
            hbuf[(size_t)r * 1024 + col] = f2bf(y[m]);
        }
        if (MODE == 1 || MODE == 2) {
            float acc[32];
#pragma unroll
            for (int n = 0; n < 32; ++n) acc[n] = 0.f;
#pragma unroll
            for (int m = 0; m < 16; ++m) {
                f32x4 wa[8];
                const int c = lane + 64 * m; const LAS float* wr = lds + c * 32; const int sw = (c >> 1) & 7;
#pragma unroll
                for (int q = 0; q < 8; ++q) wa[q] = *(const LAS f32x4*)(wr + ((q ^ sw) << 2));
                asm volatile("" ::: "memory");
#pragma unroll
                for (int q = 0; q < 8; ++q) { acc[4 * q + 0] += y[m] * wa[q][0]; acc[4 * q + 1] += y[m] * wa[q][1]; acc[4 * q + 2] += y[m] * wa[q][2]; acc[4 * q + 3] += y[m] * wa[q][3]; }
            }
            float val;
            {
                float a16[16], a8[8], a4[4], a2[2];
                const bool b5 = (lane & 32) != 0, b4 = (lane & 16) != 0, b3 = (lane & 8) != 0, b2 = (lane & 4) != 0, b1 = (lane & 2) != 0;
#pragma unroll
                for (int i = 0; i < 16; ++i) { const float send = b5 ? acc[i] : acc[i + 16], keep = b5 ? acc[i + 16] : acc[i]; a16[i] = keep + shx(send, 32, lane); }
#pragma unroll
                for (int i = 0; i < 8; ++i) { const float send = b4 ? a16[i] : a16[i + 8], keep = b4 ? a16[i + 8] : a16[i]; a8[i] = keep + shx(send, 16, lane); }
#pragma unroll
                for (int i = 0; i < 4; ++i) { const float send = b3 ? a8[i] : a8[i + 4], keep = b3 ? a8[i + 4] : a8[i]; a4[i] = keep + shx(send, 8, lane); }
#pragma unroll
                for (int i = 0; i < 2; ++i) { const float send = b2 ? a4[i] : a4[i + 2], keep = b2 ? a4[i + 2] : a4[i]; a2[i] = keep + shx(send, 4, lane); }
                { const float send = b1 ? a2[0] : a2[1], keep = b1 ? a2[1] : a2[0]; val = keep + shx(send, 2, lane); }
                val += shx(val, 1, lane);
            }
            const int n = lane >> 1;
            if (MODE == 1) {
                int* toke = (int*)(k.ws + WS_TOKE); float* tokwW = (float*)(k.ws + WS_TOKW);
                if (last && r < TC) { if (lane == 0) { int neg = -1; asm volatile("" : "+v"(neg)); toke[2 * r] = neg; toke[2 * r + 1] = neg; } continue; }
                const float sc = 1.0f / (1.0f + expf(-val)), ch = sc + aux0[n];
                const int gl = lane & ~7;
                const float ca = shi(ch, gl), cb = shi(ch, gl + 2), cc = shi(ch, gl + 4), cd = shi(ch, gl + 6);
                const float hi1 = fmaxf(ca, cb), lo1 = fminf(ca, cb), hi2 = fmaxf(cc, cd), lo2 = fminf(cc, cd);
                float gs = fmaxf(hi1, hi2) + fmaxf(fminf(hi1, hi2), fmaxf(lo1, lo2));
                int gi = lane >> 3;
#pragma unroll
                for (int m = 8; m <= 32; m <<= 1) {
                    const float og = shx(gs, m, lane); const int oi = shii(gi, lane ^ m);
                    if (og > gs || (og == gs && oi < gi)) { gs = og; gi = oi; }
                }
                float c4[4], s4[4];
#pragma unroll
                for (int i = 0; i < 4; ++i) { c4[i] = shi(ch, gi * 8 + 2 * i); s4[i] = shi(sc, gi * 8 + 2 * i); }
                int i1 = 0; float b1v = c4[0];
#pragma unroll
                for (int i = 1; i < 4; ++i) if (c4[i] > b1v) { b1v = c4[i]; i1 = i; }
                int i2 = -1; float b2v = -1e30f;
#pragma unroll
                for (int i = 0; i < 4; ++i) if (i != i1 && c4[i] > b2v) { b2v = c4[i]; i2 = i; }
                float w1v = 0.f, w2v = 0.f;
#pragma unroll
                for (int i = 0; i < 4; ++i) { if (i == i1) w1v = s4[i]; if (i == i2) w2v = s4[i]; }
                const float inv = 1.0f / (w1v + w2v);
                if (lane == 0) {
                    const int e1 = gi * 4 + i1, e2 = gi * 4 + i2;
                    toke[2 * r] = e1; toke[2 * r + 1] = e2; tokwW[2 * r] = w1v * inv; tokwW[2 * r + 1] = w2v * inv;
                    __hip_atomic_fetch_add(lcnt + e1, 1, __ATOMIC_RELAXED, __HIP_MEMORY_SCOPE_WORKGROUP);
                    __hip_atomic_fetch_add(lcnt + e2, 1, __ATOMIC_RELAXED, __HIP_MEMORY_SCOPE_WORKGROUP);
                }
            } else {
                float* gb = (float*)(k.ws + WS_GB);
                if ((lane & 1) == 0) {
                    if (n < 16) {
                        const float z = val + aux1[n];
                        const float ez = __expf(z); const float sp = z > 15.f ? z : (ez < 1e-4f ? ez - 0.5f * ez * ez : __logf(1.0f + ez));
                        gb[(size_t)r * 32 + n] = -expf(aux0[n]) * sp;
                    } else {
                        gb[(size_t)r * 32 + n] = 1.0f / (1.0f + expf(-val));
                    }
                }
            }
        }
    }
    if (MODE == 1) {
        __syncthreads();
        int* cnt = (int*)(k.ws + WS_CTL + CTL_CNT) + layer * 32;
        if (flush && tid < 32 && lcnt[tid] > 0) atomicAdd(&cnt[tid], lcnt[tid]);
    }
}

constexpr int NM_WLD = 1032;
template <int MODE>
PF void norm_mfma(const KC& k, int layer, bool first, bool combine, const float* __restrict__ gain, int mb, const float* __restrict__ Wsk, int ldw,
                  const float* __restrict__ aux0, const float* __restrict__ aux1, bool last, LAS unsigned char* lds, bool flush = true) {
    const int tid = TID(), lane = tid & 63, wave = __builtin_amdgcn_readfirstlane(tid >> 6), row = lane & 15, q = lane >> 4;
    LAS bf16_t* WtH = (LAS bf16_t*)lds; LAS bf16_t* WtL = WtH + 32 * NM_WLD;
    LAS float* red = (LAS float*)(WtL + 32 * NM_WLD);
    LAS float* lg = red + 128;
    LAS int* lcnt = (LAS int*)(lg + 8 * 16 * 32);
    float* xs = (float*)(k.ws + WS_XS);
    bf16_t* hbuf = (bf16_t*)(k.ws + AR_HBUF);
    const float* mod = (const float*)(k.ws + WS_MOD);
    const bf16_t* ys = (const bf16_t*)(k.ws + AR_YS);
    const int* tokp = (const int*)(k.ws + WS_TOKP); const float* tokw = (const float*)(k.ws + WS_TOKW);
    if (MODE == 1 && tid < 32) lcnt[tid] = 0;
    for (int idx = tid; idx < 1024 * 32; idx += NTHR) {
        const int kk = idx >> 5, n = idx & 31;
        const float w = Wsk[(size_t)kk * ldw + n]; const bf16_t hi = f2bf(w);
        WtH[n * NM_WLD + kk] = hi; WtL[n * NM_WLD + kk] = f2bf(w - bf2f(hi));
    }
    __syncthreads();
    const int cbase = 128 * wave + 8 * q;
    f32x4 xn[8];
    int bt = blockIdx.x;
    if (bt < T / 16) {
        const float* sb = first ? (16 * bt < TC ? k.ctx : k.x - (size_t)TC * 1024) : xs;
        const unsigned off = (unsigned)(16 * bt + row) * 1024u + (unsigned)cbase;
#pragma unroll
        for (int kk = 0; kk < 4; ++kk) { xn[2 * kk] = *(const f32x4*)(sb + off + 32 * kk); xn[2 * kk + 1] = *(const f32x4*)(sb + off + 32 * kk + 4); }
    }
    for (; bt < T / 16; bt += gridDim.x) {
        const int r = 16 * bt + row, mr = modrow(16 * bt);
        const unsigned roff = (unsigned)r * 1024u + (unsigned)cbase;
        float x[32];
#pragma unroll
        for (int i = 0; i < 8; ++i) { x[4 * i] = xn[i][0]; x[4 * i + 1] = xn[i][1]; x[4 * i + 2] = xn[i][2]; x[4 * i + 3] = xn[i][3]; }
        int p0 = 0, p1 = 0; float w0 = 0.f, w1 = 0.f;
        if (combine) { p0 = tokp[2 * r]; p1 = tokp[2 * r + 1]; w0 = tokw[2 * r]; w1 = tokw[2 * r + 1]; }
        {
            const int bn = bt + gridDim.x;
            if (bn < T / 16) {
                const float* sb = first ? (16 * bn < TC ? k.ctx : k.x - (size_t)TC * 1024) : xs;
                const unsigned off = (unsigned)(16 * bn + row) * 1024u + (unsigned)cbase;
#pragma unroll
                for (int kk = 0; kk < 4; ++kk) { xn[2 * kk] = *(const f32x4*)(sb + off + 32 * kk); xn[2 * kk + 1] = *(const f32x4*)(sb + off + 32 * kk + 4); }
            }
        }
        const float* shift = mod + ((size_t)(layer * 3 + mr) * 6 + mb) * 1024;
        if (combine) {
            const float* g5 = mod + ((size_t)((layer - 1) * 3 + mr) * 6 + 5) * 1024;
            u32x4 ya[4], yb[4]; float g5v[32];
#pragma unroll
            for (int kk = 0; kk < 4; ++kk) { ya[kk] = *(const u32x4*)(ys + (size_t)p0 * 1024 + cbase + 32 * kk); yb[kk] = *(const u32x4*)(ys + (size_t)p1 * 1024 + cbase + 32 * kk);
                const f32x4 ga = *(const f32x4*)(g5 + cbase + 32 * kk), gb2 = *(const f32x4*)(g5 + cbase + 32 * kk + 4);
#pragma unroll
                for (int e = 0; e < 4; ++e) { g5v[8 * kk + e] = ga[e]; g5v[8 * kk + 4 + e] = gb2[e]; } }
            asm volatile("" ::: "memory");
#pragma unroll
            for (int kk = 0; kk < 4; ++kk)
#pragma unroll
                for (int w = 0; w < 4; ++w) {
                    x[8 * kk + 2 * w] += g5v[8 * kk + 2 * w] * (w0 * __uint_as_float(ya[kk][w] << 16) + w1 * __uint_as_float(yb[kk][w] << 16));
                    x[8 * kk + 2 * w + 1] += g5v[8 * kk + 2 * w + 1] * (w0 * __uint_as_float(ya[kk][w] & 0xffff0000u) + w1 * __uint_as_float(yb[kk][w] & 0xffff0000u));
                }
        }
        if (first || combine) {
#pragma unroll
            for (int kk = 0; kk < 4; ++kk) {
                *(f32x4*)(xs + roff + 32 * kk) = (f32x4){x[8 * kk], x[8 * kk + 1], x[8 * kk + 2], x[8 * kk + 3]};
                *(f32x4*)(xs + roff + 32 * kk + 4) = (f32x4){x[8 * kk + 4], x[8 * kk + 5], x[8 * kk + 6], x[8 * kk + 7]};
            }
        }
        float ss = 0.f;
#pragma unroll
        for (int i = 0; i < 32; ++i) ss += x[i] * x[i];
        ss += shx(ss, 16, lane); ss += shx(ss, 32, lane);
        if (q == 0) red[wave * 16 + row] = ss;
        __syncthreads();
        float tot = 0.f;
#pragma unroll
        for (int w = 0; w < 8; ++w) tot += red[w * 16 + row];
        const float rstd = rsqrtf(tot * (1.0f / 1024.0f) + EPS);
        f32x4 acc[2]; acc[0] = (f32x4){0.f, 0.f, 0.f, 0.f}; acc[1] = (f32x4){0.f, 0.f, 0.f, 0.f};
#pragma unroll
        for (int kk = 0; kk < 4; ++kk) {
            float y[8]; u32x4 ah, al;
            {
                const unsigned co = (unsigned)cbase + 32u * kk;
                const f32x4 g0 = *(const f32x4*)(gain + co), g1 = *(const f32x4*)(gain + co + 4), s0 = *(const f32x4*)(shift + 1024 + co), s1 = *(const f32x4*)(shift + 1024 + co + 4),
                            h0 = *(const f32x4*)(shift + co), h1 = *(const f32x4*)(shift + co + 4);
#pragma unroll
                for (int e = 0; e < 4; ++e) { y[e] = x[8 * kk + e] * rstd * g0[e] * (1.0f + s0[e]) + h0[e]; y[4 + e] = x[8 * kk + 4 + e] * rstd * g1[e] * (1.0f + s1[e]) + h1[e]; }
            }
#pragma unroll
            for (int w = 0; w < 4; ++w) {
                ah[w] = pk2(y[2 * w], y[2 * w + 1]);
                al[w] = pk2(y[2 * w] - __uint_as_float(ah[w] << 16), y[2 * w + 1] - __uint_as_float(ah[w] & 0xffff0000u));
            }
            *(u32x4*)(hbuf + roff + 32 * kk) = ah;
            const bf16x8 fah = __builtin_bit_cast(bf16x8, ah), fal = __builtin_bit_cast(bf16x8, al);
            bf16x8 bh[2], bl[2];
#pragma unroll
            for (int nt = 0; nt < 2; ++nt) {
                bh[nt] = *(const LAS bf16x8*)(WtH + (16 * nt + row) * NM_WLD + cbase + 32 * kk);
                bl[nt] = *(const LAS bf16x8*)(WtL + (16 * nt + row) * NM_WLD + cbase + 32 * kk);
            }
            asm volatile("" ::: "memory");
#pragma unroll
            for (int nt = 0; nt < 2; ++nt) {
                acc[nt] = __builtin_amdgcn_mfma_f32_16x16x32_bf16(fah, bh[nt], acc[nt], 0, 0, 0);
                acc[nt] = __builtin_amdgcn_mfma_f32_16x16x32_bf16(fal, bh[nt], acc[nt], 0, 0, 0);
                acc[nt] = __builtin_amdgcn_mfma_f32_16x16x32_bf16(fah, bl[nt], acc[nt], 0, 0, 0);
            }
        }
#pragma unroll
        for (int nt = 0; nt < 2; ++nt)
#pragma unroll
            for (int j = 0; j < 4; ++j) lg[(wave * 16 + 4 * q + j) * 32 + 16 * nt + row] = acc[nt][j];
        __syncthreads();
        {
            const int prow = tid >> 5, n = tid & 31, rr = 16 * bt + prow, hb = lane & 32;
            float val = 0.f;
#pragma unroll
            for (int w = 0; w < 8; ++w) val += lg[(w * 16 + prow) * 32 + n];
            if (MODE == 1) {
                int* toke = (int*)(k.ws + WS_TOKE); float* tokwW = (float*)(k.ws + WS_TOKW);
                const bool unrouted = last && rr < TC;
                const float sc = 1.0f / (1.0f + expf(-val)), ch = sc + aux0[n];
                const int gl = hb + (n & ~3);
                const float ca = shi(ch, gl), cb = shi(ch, gl + 1), cc = shi(ch, gl + 2), cd = shi(ch, gl + 3);
                const float hi1 = fmaxf(ca, cb), lo1 = fminf(ca, cb), hi2 = fmaxf(cc, cd), lo2 = fminf(cc, cd);
                float gs = fmaxf(hi1, hi2) + fmaxf(fminf(hi1, hi2), fmaxf(lo1, lo2));
                int gi = n >> 2;
#pragma unroll
                for (int m = 4; m <= 16; m <<= 1) {
                    const float og = shx(gs, m, lane); const int oi = shii(gi, lane ^ m);
                    if (og > gs || (og == gs && oi < gi)) { gs = og; gi = oi; }
                }
                float c4[4], s4[4];
#pragma unroll
                for (int i = 0; i < 4; ++i) { c4[i] = shi(ch, hb + gi * 4 + i); s4[i] = shi(sc, hb + gi * 4 + i); }
                int i1 = 0; float b1v = c4[0];
#pragma unroll
                for (int i = 1; i < 4; ++i) if (c4[i] > b1v) { b1v = c4[i]; i1 = i; }
                int i2 = -1; float b2v = -1e30f;
#pragma unroll
                for (int i = 0; i < 4; ++i) if (i != i1 && c4[i] > b2v) { b2v = c4[i]; i2 = i; }
                float w1v = 0.f, w2v = 0.f;
#pragma unroll
                for (int i = 0; i < 4; ++i) { if (i == i1) w1v = s4[i]; if (i == i2) w2v = s4[i]; }
                const float inv = 1.0f / (w1v + w2v);
                if (n == 0) {
                    if (unrouted) { int neg = -1; asm volatile("" : "+v"(neg)); toke[2 * rr] = neg; toke[2 * rr + 1] = neg; }
                    else {
                        const int e1 = gi * 4 + i1, e2 = gi * 4 + i2;
                        toke[2 * rr] = e1; toke[2 * rr + 1] = e2; tokwW[2 * rr] = w1v * inv; tokwW[2 * rr + 1] = w2v * inv;
                        __hip_atomic_fetch_add(lcnt + e1, 1, __ATOMIC_RELAXED, __HIP_MEMORY_SCOPE_WORKGROUP);
                        __hip_atomic_fetch_add(lcnt + e2, 1, __ATOMIC_RELAXED, __HIP_MEMORY_SCOPE_WORKGROUP);
                    }
                }
            } else {
                float* gb = (float*)(k.ws + WS_GB);
                if (n < 16) {
                    const float z = val + aux1[n];
                    const float ez = __expf(z); const float sp = z > 15.f ? z : (ez < 1e-4f ? ez - 0.5f * ez * ez : __logf(1.0f + ez));
                    gb[(size_t)rr * 32 + n] = -expf(aux0[n]) * sp;
                } else {
                    gb[(size_t)rr * 32 + n] = 1.0f / (1.0f + expf(-val));
                }
            }
        }
        __syncthreads();
    }
    if (MODE == 1) {
        __syncthreads();
        int* cnt = (int*)(k.ws + WS_CTL + CTL_CNT) + layer * 32;
        if (flush && tid < 32 && lcnt[tid] > 0) atomicAdd(&cnt[tid], lcnt[tid]);
    }
}

namespace pg8 {
constexpr int BM = 256, BK = 64, HALF = 128, HTB = HALF * BK * 2, STAGE_BYTES = 8 * HTB;
DI int lds_byte(int r, int c) { const int st = (r >> 4) * 2 + (c >> 5), rr = r & 15, cc = c & 31, ob = rr * 64 + cc * 2; return st * 1024 + (ob ^ (((ob >> 9) & 1) << 5)); }
DI void stage_rc(int b, int& R, int& C) { const int st = b / 1024, sb = b % 1024, swz = sb ^ (((sb >> 9) & 1) << 5); R = (st >> 1) * 16 + swz / 64; C = (st & 1) * 32 + (swz % 64) / 2; }
DI int perm32(int rho) { const int n = rho >> 4, i = rho & 15; return 8 * (i >> 2) + 4 * n + (i & 3); }
struct Unit { int m0, mrows, pn; size_t boff; };
template <bool GATHER, class Epi, class Sched>
DI void gemm_phase(LAS unsigned char* lds, const bf16_t* A, const int* rowidx, const bf16_t* Bt, int K, const Sched& S, const Epi& E) {
    const int tid = TID(), wid = __builtin_amdgcn_readfirstlane(tid >> 6), lane = tid & 63, wr = wid >> 2, wc = wid & 3, fr = lane & 15, fq = lane >> 4;
    const int nt = K / BK;
    unsigned voffA[2], voffB[2];
#pragma unroll
    for (int i = 0; i < 2; ++i) { int R, C; stage_rc(tid * 16 + i * 8192, R, C); const int Rb = Epi::PERM ? ((R & ~31) + perm32(R & 31)) : R;
        voffA[i] = (unsigned)(R * K + C) * 2u; voffB[i] = (unsigned)(Rb * K + C) * 2u; }
    const size_t kstep = (size_t)(BK * 2);
    const size_t hstep = (size_t)HALF * K * 2;
    const size_t tstep = 2 * hstep;
    const size_t rstep = (size_t)K * 2;
    const unsigned ldsw = (unsigned)wid * 1024u;
    const int aoff = lds_byte(wr * 64 + fr, fq * 8), boff = lds_byte(wc * 32 + fr, fq * 8);
#define PG8_SA(b, h) (((b) * 2 + (h)) * HTB)
#define PG8_SB(b, h) ((4 + (b) * 2 + (h)) * HTB)
#define PG8_STAGE(bufoff, gbase, voff) do { _Pragma("unroll") for (int _i = 0; _i < 2; ++_i) \
        __builtin_amdgcn_global_load_lds((const unsigned*)((const char*)(gbase) + (voff)[_i]), (LAS unsigned*)(lds + (bufoff) + ldsw + _i * 8192), 16, 0, 0); } while (0)
#define PG8_STAGE_A(bufoff, p, h, vG) do { if (GATHER) PG8_STAGE(bufoff, p, (vG)[h]); else PG8_STAGE(bufoff, (p) + (h) * hstep, voffA); } while (0)
#define PG8_LDA(dst, b, h) do { _Pragma("unroll") for (int m = 0; m < 4; ++m) _Pragma("unroll") for (int k = 0; k < 2; ++k) dst[m][k] = *(const LAS bf16x8*)(lds + PG8_SA(b, h) + aoff + m * 2048 + k * 1024); } while (0)
#define PG8_LDB(dst, b, h) do { _Pragma("unroll") for (int n = 0; n < 2; ++n) _Pragma("unroll") for (int k = 0; k < 2; ++k) dst[n][k] = *(const LAS bf16x8*)(lds + PG8_SB(b, h) + boff + n * 2048 + k * 1024); } while (0)
#define PG8_MMA(ai, bj, At, Bt_) do { __builtin_amdgcn_s_setprio(1); _Pragma("unroll") for (int m = 0; m < 4; ++m) _Pragma("unroll") for (int n = 0; n < 2; ++n) _Pragma("unroll") for (int k = 0; k < 2; ++k) \
        acc[ai][bj][m][n] = __builtin_amdgcn_mfma_f32_16x16x32_bf16(Bt_[n][k], At[m][k], acc[ai][bj][m][n], 0, 0, 0); __builtin_amdgcn_s_setprio(0); } while (0)
#define PG8_WAIT_V(n) asm volatile("s_waitcnt vmcnt(" #n ")" ::: "memory")
#define PG8_WAIT_L(n) asm volatile("s_waitcnt lgkmcnt(" #n ")" ::: "memory")
#define PG8_BAR __builtin_amdgcn_s_barrier()
#define PG8_SCHED __builtin_amdgcn_sched_barrier(0)
#define PG8_AOFF(dst, u) do { _Pragma("unroll") for (int _h = 0; _h < 2; ++_h) _Pragma("unroll") for (int _i = 0; _i < 2; ++_i) { int _R, _C; stage_rc(tid * 16 + _i * 8192, _R, _C); \
        dst[_h][_i] = (unsigned)(rowidx[(u).m0 + _h * HALF + _R] * K + _C) * 2u; } } while (0)
    Unit cur, nxt; int ui = 0;
    if (!S.next(0, cur)) return;
    f32x4 acc[2][2][4][2];
#pragma unroll
    for (int a = 0; a < 2; ++a)
#pragma unroll
        for (int b = 0; b < 2; ++b)
#pragma unroll
            for (int m = 0; m < 4; ++m)
#pragma unroll
                for (int n = 0; n < 2; ++n) acc[a][b][m][n] = (f32x4){0.f, 0.f, 0.f, 0.f};
    bf16x8 At[4][2], B0[2][2], B1[2][2];
    unsigned vA[2][2], vN[2][2];
    if (GATHER) PG8_AOFF(vA, cur);
    const char* cA = (const char*)A + (GATHER ? (size_t)0 : (size_t)cur.m0 * rstep);
    const char* cB = (const char*)Bt + cur.boff + (size_t)cur.pn * tstep;
    PG8_STAGE(PG8_SB(0, 0), cB, voffB); PG8_STAGE_A(PG8_SA(0, 0), cA, 0, vA); PG8_STAGE(PG8_SB(0, 1), cB + hstep, voffB); PG8_STAGE_A(PG8_SA(0, 1), cA, 1, vA);
    if (wr == 1) PG8_BAR;
    PG8_WAIT_V(4); PG8_BAR;
    PG8_STAGE(PG8_SB(1, 0), cB + kstep, voffB); PG8_STAGE_A(PG8_SA(1, 0), cA + kstep, 0, vA); PG8_STAGE(PG8_SB(1, 1), cB + hstep + kstep, voffB);
    PG8_WAIT_V(6); PG8_BAR;
    for (;;) {
        const bool has_next = S.next(ui + 1, nxt);
        const char* nA = GATHER ? cA : (has_next ? (const char*)A + (size_t)nxt.m0 * rstep : cA);
        const char* nB = has_next ? (const char*)Bt + nxt.boff + (size_t)nxt.pn * tstep : cB;
        if (GATHER) {
            if (has_next) { PG8_AOFF(vN, nxt); }
            else {
#pragma unroll
                for (int h = 0; h < 2; ++h)
#pragma unroll
                    for (int i = 0; i < 2; ++i) vN[h][i] = vA[h][i];
            }
        }
        for (int t = 0; t < nt; t += 2) {
            const bool last = (t == nt - 2);
            const char* a1 = cA + (size_t)(t + 1) * kstep;
            const char* a2 = last ? nA : cA + (size_t)(t + 2) * kstep; const char* b2 = last ? nB : cB + (size_t)(t + 2) * kstep;
            const char* a3 = a2 + kstep; const char* b3 = b2 + kstep;
            PG8_LDB(B0, 0, 0); PG8_SCHED; PG8_LDA(At, 0, 0); PG8_STAGE_A(PG8_SA(1, 1), a1, 1, vA);
            if (GATHER && last) {
#pragma unroll
                for (int h = 0; h < 2; ++h)
#pragma unroll
                    for (int i = 0; i < 2; ++i) vA[h][i] = vN[h][i];
            }
            PG8_WAIT_L(8); PG8_BAR; PG8_WAIT_L(0); PG8_MMA(0, 0, At, B0); PG8_BAR; PG8_SCHED;
            PG8_LDB(B1, 0, 1); PG8_STAGE(PG8_SB(0, 0), b2, voffB);
            PG8_BAR; PG8_WAIT_L(0); PG8_MMA(0, 1, At, B1); PG8_BAR;
            PG8_LDA(At, 0, 1); PG8_STAGE_A(PG8_SA(0, 0), a2, 0, vA);
            PG8_BAR; PG8_WAIT_L(0); PG8_MMA(1, 0, At, B0); PG8_BAR; PG8_SCHED;
            PG8_STAGE(PG8_SB(0, 1), b2 + hstep, voffB);
            PG8_WAIT_V(6); PG8_BAR; PG8_MMA(1, 1, At, B1); PG8_BAR;
            PG8_LDB(B0, 1, 0); PG8_SCHED; PG8_LDA(At, 1, 0); PG8_STAGE_A(PG8_SA(0, 1), a2, 1, vA);
            PG8_WAIT_L(8); PG8_BAR; PG8_WAIT_L(0); PG8_MMA(0, 0, At, B0); PG8_BAR; PG8_SCHED;
            PG8_LDB(B1, 1, 1); PG8_STAGE(PG8_SB(1, 0), b3, voffB);
            PG8_BAR; PG8_WAIT_L(0); PG8_MMA(0, 1, At, B1); PG8_BAR;
            PG8_LDA(At, 1, 1); PG8_STAGE_A(PG8_SA(1, 0), a3, 0, vA);
            PG8_BAR; PG8_WAIT_L(0); PG8_MMA(1, 0, At, B0); PG8_BAR; PG8_SCHED;
            PG8_STAGE(PG8_SB(1, 1), b3 + hstep, voffB);
            PG8_WAIT_V(6); PG8_BAR; PG8_MMA(1, 1, At, B1); PG8_BAR;
        }
        { const int t2 = TID(), l2 = t2 & 63; E(acc, cur, wr, wc, l2 & 15, l2 >> 4); }
        if (!has_next) break;
#pragma unroll
        for (int a = 0; a < 2; ++a)
#pragma unroll
            for (int b = 0; b < 2; ++b)
#pragma unroll
                for (int m = 0; m < 4; ++m)
#pragma unroll
                    for (int n = 0; n < 2; ++n) acc[a][b][m][n] = (f32x4){0.f, 0.f, 0.f, 0.f};
        cur = nxt; cA = nA; cB = nB; ++ui;
    }
    PG8_WAIT_V(0);
    if (wr == 0) PG8_BAR;
    PG8_BAR;
#undef PG8_SA
#undef PG8_SB
#undef PG8_STAGE
#undef PG8_STAGE_A
#undef PG8_LDA
#undef PG8_LDB
#undef PG8_MMA
#undef PG8_WAIT_V
#undef PG8_WAIT_L
#undef PG8_BAR
#undef PG8_SCHED
#undef PG8_AOFF
}
struct DenseOrder {
    int nM, nN, nwg, G, c;
    DI void init(int M, int N, int G_, int c_) { nM = M / BM; nN = N / BM; nwg = nM * nN; G = G_; c = c_; }
    DI bool next(int i, Unit& u) const {
        const long L = (long)i * G + c; if (L >= nwg) return false;
        int wgid = (int)L; { const int q = nwg / 8, r = nwg % 8, xcd = wgid % 8, off = wgid / 8; wgid = (xcd < r ? xcd * (q + 1) : r * (q + 1) + (xcd - r) * q) + off; }
        const int nig = 8 * nN, gid = wgid / nig, fm = gid * 8, gsz = (nM - fm) < 8 ? (nM - fm) : 8;
        u.m0 = (fm + ((wgid % nig) % gsz)) * BM; u.mrows = BM; u.pn = (wgid % nig) / gsz; u.boff = 0; return true;
    }
};
struct MoeOrder {
    const LAS int* tb; int G, c; size_t estride; int lane;
    DI bool next(int i, Unit& u) const {
        const int L = i * G + c; if (L >= __builtin_amdgcn_readfirstlane(tb[97]) * 4) return false;
        const int tile = L >> 2;
        const int pre = tb[65 + (lane & 31)];
        const unsigned long long m = __ballot(lane < 32 && pre <= tile);
        const int e = __popcll(m) - 1;
        const int lt = tile - __builtin_amdgcn_readfirstlane(tb[65 + e]); int mr = __builtin_amdgcn_readfirstlane(tb[e]) - lt * 256; mr = mr > 256 ? 256 : mr;
        u.m0 = __builtin_amdgcn_readfirstlane(tb[32 + e]) + lt * 256; u.mrows = mr; u.pn = L & 3; u.boff = (size_t)e * estride; return true;
    }
};
}
struct EpiBf16 {
    static constexpr bool PERM = true;
    bf16_t* C; int ldc; int split_col; bf16_t* C2; int ldc2;
    DI void operator()(const f32x4 (&acc)[2][2][4][2], const pg8::Unit& u, int wr, int wc, int fr, int fq) const {
        int colt = u.pn * 256; bf16_t* base = C; int ld = ldc;
        if (colt >= split_col) { base = C2; ld = ldc2; colt -= split_col; }
#pragma unroll
        for (int ai = 0; ai < 2; ++ai)
#pragma unroll
            for (int m = 0; m < 4; ++m) {
                const int rl = ai * 128 + wr * 64 + m * 16 + fr;
                if (rl < u.mrows) {
                    bf16_t* rowp = base + (size_t)(u.m0 + rl) * ld + colt + wc * 32 + 8 * fq;
#pragma unroll
                    for (int bj = 0; bj < 2; ++bj) {
                        const f32x4 v0 = acc[ai][bj][m][0], v1 = acc[ai][bj][m][1];
                        u32x4 o; o[0] = cvt_pk_bf16(v0[0], v0[1]); o[1] = cvt_pk_bf16(v0[2], v0[3]); o[2] = cvt_pk_bf16(v1[0], v1[1]); o[3] = cvt_pk_bf16(v1[2], v1[3]);
                        *(u32x4*)(rowp + bj * 128) = o;
                    }
                }
            }
    }
};
struct EpiBf16T {
    static constexpr bool PERM = false;
    bf16_t* C; int ldc;
    DI void operator()(const f32x4 (&acc)[2][2][4][2], const pg8::Unit& u, int wr, int wc, int fr, int fq) const {
#pragma unroll
        for (int ai = 0; ai < 2; ++ai)
#pragma unroll
            for (int bj = 0; bj < 2; ++bj)
#pragma unroll
                for (int m = 0; m < 4; ++m)
#pragma unroll
                    for (int n = 0; n < 2; ++n) {
                        const int row = u.m0 + ai * 128 + wr * 64 + m * 16 + fr, col = u.pn * 256 + bj * 128 + wc * 32 + n * 16 + 4 * fq;
#pragma unroll
                        for (int e = 0; e < 4; ++e) C[(size_t)(col + e) * ldc + row] = f2bf(acc[ai][bj][m][n][e]);
                    }
    }
};
struct EpiTaps {
    static constexpr bool PERM = false;
    float* FT;
    DI void operator()(const f32x4 (&acc)[2][2][4][2], const pg8::Unit& u, int wr, int wc, int fr, int fq) const {
#pragma unroll
        for (int ai = 0; ai < 2; ++ai)
#pragma unroll
            for (int m = 0; m < 4; ++m) {
                const int row = u.m0 + ai * 128 + wr * 64 + m * 16 + fr; const float dl = hy_delta(row & 1023) * (1.0f / 16383.0f);
#pragma unroll
                for (int bj = 0; bj < 2; ++bj)
#pragma unroll
                    for (int n = 0; n < 2; ++n) {
                        const int l = u.pn * 256 + bj * 128 + wc * 32 + n * 16 + 4 * fq; f32x4 o;
#pragma unroll
                        for (int e = 0; e < 4; ++e) o[e] = acc[ai][bj][m][n][e] * expf(-(float)(l + e) * dl);
                        *(f32x4*)(FT + (size_t)row * 16384 + l) = o;
                    }
            }
    }
};
struct EpiResid {
    static constexpr bool PERM = false;
    float* xs; const float* mod; int layer; int chunk;
    DI void operator()(const f32x4 (&acc)[2][2][4][2], const pg8::Unit& u, int wr, int wc, int fr, int fq) const {
        const float* g = mod + ((size_t)(layer * 3 + modrow(u.m0)) * 6 + chunk) * 1024;
#pragma unroll
        for (int bj = 0; bj < 2; ++bj)
#pragma unroll
            for (int n = 0; n < 2; ++n) {
                const int col = u.pn * 256 + bj * 128 + wc * 32 + n * 16 + 4 * fq; const f32x4 gv = *(const f32x4*)(g + col);
                float* p0 = xs + (size_t)(u.m0 + wr * 64 + fr) * 1024 + col;
                f32x4 old[8];
#pragma unroll
                for (int ai = 0; ai < 2; ++ai)
#pragma unroll
                    for (int m = 0; m < 4; ++m) old[ai * 4 + m] = *(const f32x4*)(p0 + (size_t)(ai * 128 + m * 16) * 1024);
                asm volatile("" ::: "memory");
#pragma unroll
                for (int ai = 0; ai < 2; ++ai)
#pragma unroll
                    for (int m = 0; m < 4; ++m) *(f32x4*)(p0 + (size_t)(ai * 128 + m * 16) * 1024) = old[ai * 4 + m] + gv * acc[ai][bj][m][n];
            }
    }
};
struct EpiGateUp {
    static constexpr bool PERM = false;
    bf16_t* hid;
    DI void operator()(const f32x4 (&acc)[2][2][4][2], const pg8::Unit& u, int wr, int wc, int fr, int fq) const {
#pragma unroll
        for (int ai = 0; ai < 2; ++ai)
#pragma unroll
            for (int m = 0; m < 4; ++m) {
                const int rl = ai * 128 + wr * 64 + m * 16 + fr;
                if (rl < u.mrows) {
#pragma unroll
                    for (int bj = 0; bj < 2; ++bj) {
                        const int hc = ((u.pn * 256 + bj * 128 + wc * 32) >> 1) + 4 * fq;
                        const f32x4 g = acc[ai][bj][m][0], up = acc[ai][bj][m][1];
                        u32x2 o; o[0] = cvt_pk_bf16(siluf(g[0]) * up[0], siluf(g[1]) * up[1]); o[1] = cvt_pk_bf16(siluf(g[2]) * up[2], siluf(g[3]) * up[3]);
                        *(u32x2*)(hid + (size_t)(u.m0 + rl) * 512 + hc) = o;
                    }
                }
            }
    }
};
template <class Epi>
PF void gemm_dense(LAS unsigned char* lds, const bf16_t* A, int M, const bf16_t* Bt, int N, int K, const Epi& epi) {
    pg8::DenseOrder S; S.init(M, N, (int)gridDim.x, (int)blockIdx.x);
    pg8::gemm_phase<false>(lds, A, (const int*)nullptr, Bt, K, S, epi);
}
DI void moe_table(const KC& k, int layer, LAS int* tb) {
    const int* cnt = (const int*)(k.ws + WS_CTL + CTL_CNT) + layer * 32;
    __syncthreads();
    const int tq = TID();
    if (tq < 32) tb[tq] = __hip_atomic_load(cnt + tq, __ATOMIC_RELAXED, __HIP_MEMORY_SCOPE_AGENT);
    __syncthreads();
    if (tq == 0) {
        int s = 0, tp = 0;
        for (int e = 0; e < 32; ++e) { tb[32 + e] = s; tb[65 + e] = tp; s += tb[e]; tp += (tb[e] + 255) >> 8; }
        tb[64] = s; tb[97] = tp;
    }
    __syncthreads();
}
template <int WHICH>
PF void moe_gemm(const KC& k, int layer, LAS unsigned char* lds, LAS int* tb) {
    moe_table(k, layer, tb);
    if (WHICH == 0) {
        pg8::MoeOrder S{tb, (int)gridDim.x, (int)blockIdx.x, (size_t)1024 * 1024 * 2, TID() & 63};
        EpiGateUp epi{(bf16_t*)(k.ws + AR_HID)};
        pg8::gemm_phase<true>(lds, (const bf16_t*)(k.ws + AR_HBUF), (const int*)(k.ws + WS_SLOT), (const bf16_t*)(k.ws + AR_WGU), 1024, S, epi);
    } else {
        pg8::MoeOrder S{tb, (int)gridDim.x, (int)blockIdx.x, (size_t)1024 * 512 * 2, TID() & 63};
        EpiBf16 epi{(bf16_t*)(k.ws + AR_YS), 1024, 1 << 30, nullptr, 0};
        pg8::gemm_phase<false>(lds, (const bf16_t*)(k.ws + AR_HID), (const int*)nullptr, (const bf16_t*)(k.ws + AR_WD), 512, S, epi);
    }
}
PF void moe_scatter(const KC& k, int layer, LAS int* tb) {
    moe_table(k, layer, tb);
    const int* toke = (const int*)(k.ws + WS_TOKE);
    int* tokp = (int*)(k.ws + WS_TOKP); int* slot = (int*)(k.ws + WS_SLOT);
    int* cur = (int*)(k.ws + WS_CTL + CTL_CNT) + 128 + layer * 32;
    LAS int* lc = tb + 128; LAS int* lb = tb + 160;
    const int tid = TID();
    if (blockIdx.x == 0 && tid < 256) slot[NA + tid] = 0;
    for (int r0 = blockIdx.x * NTHR; r0 < T; r0 += gridDim.x * NTHR) {
        const int r = r0 + tid;
        __syncthreads();
        if (tid < 32) lc[tid] = 0;
        __syncthreads();
        const int e0 = toke[2 * r], e1 = toke[2 * r + 1];
        int k0 = 0, k1 = 0;
        if (e0 >= 0) { k0 = __hip_atomic_fetch_add(lc + e0, 1, __ATOMIC_RELAXED, __HIP_MEMORY_SCOPE_WORKGROUP); k1 = __hip_atomic_fetch_add(lc + e1, 1, __ATOMIC_RELAXED, __HIP_MEMORY_SCOPE_WORKGROUP); }
        __syncthreads();
        if (tid < 32) lb[tid] = lc[tid] > 0 ? atomicAdd(&cur[tid], lc[tid]) : 0;
        __syncthreads();
        if (e0 >= 0) {
            const int p0 = tb[32 + e0] + lb[e0] + k0, p1 = tb[32 + e1] + lb[e1] + k1;
            slot[p0] = r; slot[p1] = r; tokp[2 * r] = p0; tokp[2 * r + 1] = p1;
        }
    }
}

DI void unpack8(const u32x4 v, float (&f)[8]) {
#pragma unroll
    for (int w = 0; w < 4; ++w) { f[2 * w] = __uint_as_float(v[w] << 16); f[2 * w + 1] = __uint_as_float(v[w] & 0xffff0000u); }
}
PF void sc_mix(const KC& k, int j) {
    const int tid = TID(), lane = tid & 63, wave = tid >> 6;
    const bf16_t* P = (const bf16_t*)(k.ws + AR_PB);
    bf16_t* U = (bf16_t*)(k.ws + AR_UBUF);
    const float* cw = k.sc_conv + (size_t)j * 3 * 1024;
    const int c0 = lane * 16;
    float k0[16], k1[16], k2[16];
#pragma unroll
    for (int e = 0; e < 16; ++e) { k0[e] = cw[c0 + e]; k1[e] = cw[1024 + c0 + e]; k2[e] = cw[2048 + c0 + e]; }
    for (int r = blockIdx.x * 8 + wave; r < T; r += gridDim.x * 8) {
        bool lok, rok;
        if (r < TC) { const int t = r & 255; lok = t != 0; rok = t != 255; } else { const int t = (r - TC) & 63; lok = t != 0; rok = t != 63; }
        const bf16_t* p = P + (size_t)r * 3072 + c0;
        const bf16_t* pl = lok ? p - 3072 : p; const bf16_t* pr = rok ? p + 3072 : p;
        u32x4 vb[2], vc[2], vx[2], vcl[2], vxl[2], vcr[2], vxr[2];
#pragma unroll
        for (int hh = 0; hh < 2; ++hh) {
            vb[hh] = *(const u32x4*)(p + hh * 8); vc[hh] = *(const u32x4*)(p + 1024 + hh * 8); vx[hh] = *(const u32x4*)(p + 2048 + hh * 8);
            vcl[hh] = *(const u32x4*)(pl + 1024 + hh * 8); vxl[hh] = *(const u32x4*)(pl + 2048 + hh * 8);
            vcr[hh] = *(const u32x4*)(pr + 1024 + hh * 8); vxr[hh] = *(const u32x4*)(pr + 2048 + hh * 8);
        }
        asm volatile("" ::: "memory");
        const float fl = lok ? 1.f : 0.f, frr = rok ? 1.f : 0.f;
#pragma unroll
        for (int hh = 0; hh < 2; ++hh) {
            float bg[8], cg[8], xi[8], cl[8], xl[8], cr[8], xr[8];
            unpack8(vb[hh], bg); unpack8(vc[hh], cg); unpack8(vx[hh], xi); unpack8(vcl[hh], cl); unpack8(vxl[hh], xl); unpack8(vcr[hh], cr); unpack8(vxr[hh], xr);
            u32x4 o;
#pragma unroll
            for (int w = 0; w < 4; ++w) {
                float ov[2];
#pragma unroll
                for (int e = 0; e < 2; ++e) { const int i = 2 * w + e, c = hh * 8 + i; ov[e] = bg[i] * (k0[c] * fl * cl[i] * xl[i] + k1[c] * cg[i] * xi[i] + k2[c] * frr * cr[i] * xr[i]); }
                o[w] = pk2(ov[0], ov[1]);
            }
            *(u32x4*)(U + (size_t)r * 1024 + c0 + hh * 8) = o;
        }
    }
}

constexpr int DN_STEPS = 260, DN_UNITS = 32 * DN_STEPS;
DI int dn_rbase(int b, int dir, int s) {
    if (s < 4) return dir == 0 ? b * 256 + s * 64 : b * 256 + 255 - s * 64;
    const int cc = s - 4;
    return dir == 0 ? TC + b * SEQ + cc * 64 : TC + b * SEQ + SEQ - 1 - cc * 64;
}
struct DnRaw { u32x4 c[3][2], l[3][2], r[3][2]; float g, be; };
DI void dn_raw_load(const bf16_t* P, const float* gb, int u, int tid, DnRaw& R) {
    const int chain = u / DN_STEPS, s = u - chain * DN_STEPS, dir = chain & 1, h = (chain >> 1) & 7, b = chain >> 4;
    const int rbase = dn_rbase(b, dir, s), rstep = dir == 0 ? 1 : -1;
    const int i = tid >> 3, sg = tid & 7, r = rbase + rstep * i;
    bool lok, rok;
    if (r < TC) { const int t = r & 255; lok = t != 0; rok = t != 255; } else { const int t = (r - TC) & 63; lok = t != 0; rok = t != 63; }
#pragma unroll
    for (int part = 0; part < 3; ++part) {
        const bf16_t* pc = P + (size_t)r * 3072 + part * 1024 + h * 128 + sg * 16;
#pragma unroll
        for (int hf = 0; hf < 2; ++hf) {
            R.c[part][hf] = *(const u32x4*)(pc + hf * 8);
            R.l[part][hf] = (u32x4){0u, 0u, 0u, 0u}; R.r[part][hf] = (u32x4){0u, 0u, 0u, 0u};
            if (lok) R.l[part][hf] = *(const u32x4*)(pc - 3072 + hf * 8);
            if (rok) R.r[part][hf] = *(const u32x4*)(pc + 3072 + hf * 8);
        }
    }
    if (tid < 64) { const size_t row = (size_t)(rbase + rstep * tid); R.g = gb[row * 32 + dir * 8 + h]; R.be = gb[row * 32 + 16 + dir * 8 + h]; }
}
PF void dn_chunk(const KC& k, int jl, LAS unsigned char* lds) {
    const int tid = TID(), lane = tid & 63, wave = tid >> 6, fr = lane & 15, fq = lane >> 4;
    LAS bf16_t* Kt = (LAS bf16_t*)lds;
    LAS bf16_t* Qt = Kt + 64 * 136;
    LAS bf16_t* Vt = Qt + 64 * 136;
    LAS float* Amat = (LAS float*)(Vt + 64 * 136);
    LAS bf16_t* Tb = (LAS bf16_t*)(Amat + 64 * 64);
    LAS bf16_t* VbT = Tb + 64 * 72;
    LAS bf16_t* KbT = VbT + 128 * 72;
    LAS float* gcs = (LAS float*)(KbT + 128 * 72);
    LAS float* bet = gcs + 64; LAS float* eg = bet + 64; LAS float* egr = eg + 64;
    LAS float* Tm = egr + 64;
    const bf16_t* P = (const bf16_t*)(k.ws + AR_PB);
    const float* gb = (const float*)(k.ws + WS_GB);
    const float* cw = k.dn_conv + (size_t)jl * 3 * 3072;
    bf16_t* CH = (bf16_t*)(k.ws + AR_CHUNK);
    bf16_t* ATT = (bf16_t*)(k.ws + AR_HBUF);
    float* EGL = (float*)(k.ws + WS_EGL);
    for (int u = blockIdx.x; u < DN_UNITS; u += gridDim.x) {
        DnRaw Rn; dn_raw_load(P, gb, u, tid, Rn);
        const int chain = u / DN_STEPS, s = u - chain * DN_STEPS, dir = chain & 1, h = (chain >> 1) & 7, b = chain >> 4;
        const int rbase = dn_rbase(b, dir, s), rstep = dir == 0 ? 1 : -1;
        bf16_t* cW = CH + (size_t)u * 32768; bf16_t* cQd = cW + 8192; bf16_t* cKd = cQd + 8192; bf16_t* cU = cKd + 8192;
        bf16_t* cAt = ATT + (size_t)u * 4096;
        lds_barrier();
        const float g_in = Rn.g, be_in = Rn.be;
        {
            const int i = tid >> 3, sg = tid & 7;
#pragma unroll
            for (int part = 0; part < 3; ++part) {
                const int col = part * 1024 + h * 128 + sg * 16;
                float v[16];
#pragma unroll
                for (int hf = 0; hf < 2; ++hf) {
                    const u32x4 c4 = Rn.c[part][hf], l4 = Rn.l[part][hf], r4 = Rn.r[part][hf];
#pragma unroll
                    for (int w2 = 0; w2 < 2; ++w2) {
                        const int cc = col + hf * 8 + 4 * w2;
                        const f32x4 k0 = *(const f32x4*)(cw + cc), k1 = *(const f32x4*)(cw + 3072 + cc), k2 = *(const f32x4*)(cw + 6144 + cc);
#pragma unroll
                        for (int e = 0; e < 4; ++e) {
                            const int w = 2 * w2 + (e >> 1);
                            const float lv = __uint_as_float((e & 1) ? (l4[w] & 0xffff0000u) : (l4[w] << 16));
                            const float cv = __uint_as_float((e & 1) ? (c4[w] & 0xffff0000u) : (c4[w] << 16));
                            const float rv = __uint_as_float((e & 1) ? (r4[w] & 0xffff0000u) : (r4[w] << 16));
                            v[hf * 8 + 4 * w2 + e] = siluf(k0[e] * lv + k1[e] * cv + k2[e] * rv);
                        }
                    }
                }
                if (part < 2) {
                    float ss = 0.f;
#pragma unroll
                    for (int e = 0; e < 16; ++e) ss += v[e] * v[e];
                    ss += shx(ss, 1, lane); ss += shx(ss, 2, lane); ss += shx(ss, 4, lane);
                    const float sc = rsqrtf(ss + EPS) * (part == 0 ? 0.08838834764831845f : 1.0f);
#pragma unroll
                    for (int e = 0; e < 16; ++e) v[e] *= sc;
                }
                LAS bf16_t* dst = (part == 0 ? Qt : (part == 1 ? Kt : Vt)) + i * 136 + sg * 16;
                u32x4 o0, o1;
#pragma unroll
                for (int w = 0; w < 4; ++w) { o0[w] = pk2(v[2 * w], v[2 * w + 1]); o1[w] = pk2(v[8 + 2 * w], v[8 + 2 * w + 1]); }
                *(LAS u32x4*)dst = o0; *(LAS u32x4*)(dst + 8) = o1;
            }
        }
        if (wave == 0) {
            float g = g_in;
            const float be = be_in;
#pragma unroll
            for (int d = 1; d < 64; d <<= 1) { const float o = shi(g, (lane - d) & 63); if (lane >= d) g += o; }
            const float glast = shi(g, 63);
            gcs[lane] = g; bet[lane] = be; eg[lane] = expf(g); egr[lane] = expf(glast - g);
            if (lane == 0) EGL[u] = expf(glast);
        }
        lds_barrier();
#pragma unroll 1
        for (int x = 0; x < 4; ++x) {
            const int t = wave + 8 * x, isq = t >> 4, mt = (t >> 2) & 3, nt = t & 3;
            f32x4 acc = (f32x4){0.f, 0.f, 0.f, 0.f};
            const int jc = 16 * nt + fr;
            float gi4[4], bi4[4];
            const float gj = gcs[jc];
#pragma unroll
            for (int jj = 0; jj < 4; ++jj) { gi4[jj] = gcs[16 * mt + 4 * fq + jj]; bi4[jj] = bet[16 * mt + 4 * fq + jj]; }
            if (mt >= nt) {
                const LAS bf16_t* Ar = (isq ? Qt : Kt) + (16 * mt + fr) * 136 + 8 * fq;
                const LAS bf16_t* Br = Kt + (16 * nt + fr) * 136 + 8 * fq;
                bf16x8 fa4[4], fb4[4];
#pragma unroll
                for (int ks = 0; ks < 4; ++ks) { fa4[ks] = *(const LAS bf16x8*)(Ar + 32 * ks); fb4[ks] = *(const LAS bf16x8*)(Br + 32 * ks); }
                asm volatile("" ::: "memory");
#pragma unroll
                for (int ks = 0; ks < 4; ++ks) acc = __builtin_amdgcn_mfma_f32_16x16x32_bf16(fa4[ks], fb4[ks], acc, 0, 0, 0);
            }
#pragma unroll
            for (int jj = 0; jj < 4; ++jj) {
                const int ir = 16 * mt + 4 * fq + jj;
                const float dec = __expf(fminf(gi4[jj] - gj, 0.f));
                if (isq) cAt[ir * 64 + jc] = f2bf(ir >= jc ? acc[jj] * dec : 0.f);
                else Amat[ir * 64 + jc] = ir > jc ? bi4[jj] * acc[jj] * dec : 0.f;
            }
        }
        lds_barrier();
        {
        if (wave < 4) {
            if (lane < 16) {
                const int bo = 16 * wave;
                float tc[16];
#pragma unroll
                for (int i = 0; i < 16; ++i) {
                    f32x4 ar[4];
#pragma unroll
                    for (int q = 0; q < (i + 3) / 4; ++q) ar[q] = *(const LAS f32x4*)(Amat + (bo + i) * 64 + bo + 4 * q);
                    float a0 = (i == lane) ? 1.f : 0.f, a1 = 0.f;
#pragma unroll
                    for (int j = 0; j < i; ++j) { const float av = ar[j >> 2][j & 3]; if (j & 1) a1 -= av * tc[j]; else a0 -= av * tc[j]; }
                    tc[i] = a0 + a1;
                    Tm[(bo + i) * 64 + bo + lane] = tc[i];
                }
            }
        } else {
            for (int it = tid - 256; it < 1024; it += 256) {
                const int c = it & 127, ig = it >> 7;
                float kv[8], vv[8];
                { bf16_t kr[8], vr[8];
#pragma unroll
                  for (int e = 0; e < 8; ++e) { kr[e] = Kt[(8 * ig + e) * 136 + c]; vr[e] = Vt[(8 * ig + e) * 136 + c]; }
                  asm volatile("" ::: "memory");
#pragma unroll
                  for (int e = 0; e < 8; ++e) { kv[e] = bf2f(kr[e]); vv[e] = bf2f(vr[e]); } }
                u32x4 ov, ok, od;
#pragma unroll
                for (int w = 0; w < 4; ++w) {
                    const int i0 = 8 * ig + 2 * w, i1 = i0 + 1;
                    ov[w] = pk2(bet[i0] * vv[2 * w], bet[i1] * vv[2 * w + 1]);
                    ok[w] = pk2(bet[i0] * eg[i0] * kv[2 * w], bet[i1] * eg[i1] * kv[2 * w + 1]);
                    od[w] = pk2(egr[i0] * kv[2 * w], egr[i1] * kv[2 * w + 1]);
                }
                *(LAS u32x4*)(VbT + c * 72 + 8 * ig) = ov;
                *(LAS u32x4*)(KbT + c * 72 + 8 * ig) = ok;
                *(u32x4*)(cKd + c * 64 + 8 * ig) = od;
            }
            for (int it = tid - 256; it < 1024; it += 256) {
                const int i = it >> 4, c8 = (it & 15) * 8; const float e = eg[i];
                const u32x4 qv = *(const LAS u32x4*)(Qt + i * 136 + c8); u32x4 o;
#pragma unroll
                for (int w = 0; w < 4; ++w) o[w] = pk2(__uint_as_float(qv[w] << 16) * e, __uint_as_float(qv[w] & 0xffff0000u) * e);
                *(u32x4*)(cQd + i * 128 + c8) = o;
            }
        }
        lds_barrier();
#pragma unroll 1
        for (int d = 1; d < 4; ++d) {
            if (wave < 4 - d) {
                const int bi = wave + d, bj = wave, r = lane >> 2, c0 = 4 * (lane & 3);
                f32x4 m = (f32x4){0.f, 0.f, 0.f, 0.f};
                for (int kb = bj; kb < bi; ++kb) {
                    f32x4 av4[4], tv[16];
#pragma unroll
                    for (int q = 0; q < 4; ++q) av4[q] = *(const LAS f32x4*)(Amat + (16 * bi + r) * 64 + 16 * kb + 4 * q);
#pragma unroll
                    for (int kk = 0; kk < 16; ++kk) tv[kk] = *(const LAS f32x4*)(Tm + (16 * kb + kk) * 64 + 16 * bj + c0);
                    asm volatile("" ::: "memory");
#pragma unroll
                    for (int kk = 0; kk < 16; ++kk) m += tv[kk] * av4[kk >> 2][kk & 3];
                }
                *(LAS f32x4*)(Tm + (16 * bj + r) * 64 + 16 * bi + c0) = m;
                f32x4 t = (f32x4){0.f, 0.f, 0.f, 0.f};
                {
                    f32x4 dv4[4], mv[16];
#pragma unroll
                    for (int q = 0; q < 4; ++q) dv4[q] = *(const LAS f32x4*)(Tm + (16 * bi + r) * 64 + 16 * bi + 4 * q);
#pragma unroll
                    for (int kk = 0; kk < 16; ++kk) mv[kk] = *(const LAS f32x4*)(Tm + (16 * bj + kk) * 64 + 16 * bi + c0);
                    asm volatile("" ::: "memory");
#pragma unroll
                    for (int kk = 0; kk < 16; ++kk) t -= mv[kk] * dv4[kk >> 2][kk & 3];
                }
                *(LAS f32x4*)(Tm + (16 * bi + r) * 64 + 16 * bj + c0) = t;
            }
            lds_barrier();
        }
        for (int it = tid; it < 64 * 8; it += NTHR) {
            const int i = it >> 3, c8 = (it & 7) * 8; u32x4 o;
#pragma unroll
            for (int w = 0; w < 4; ++w) {
                const int c = c8 + 2 * w;
                o[w] = pk2(c <= i ? Tm[i * 64 + c] : 0.f, c + 1 <= i ? Tm[i * 64 + c + 1] : 0.f);
            }
            *(LAS u32x4*)(Tb + i * 72 + c8) = o;
        }
        }
        lds_barrier();
        {
            f32x4 au[4], aw[4];
#pragma unroll
            for (int mt = 0; mt < 4; ++mt) { au[mt] = (f32x4){0.f, 0.f, 0.f, 0.f}; aw[mt] = (f32x4){0.f, 0.f, 0.f, 0.f}; }
            bf16x8 bv[2], bk[2], at[2][4];
#pragma unroll
            for (int ks = 0; ks < 2; ++ks) {
                bv[ks] = *(const LAS bf16x8*)(VbT + (16 * wave + fr) * 72 + 32 * ks + 8 * fq);
                bk[ks] = *(const LAS bf16x8*)(KbT + (16 * wave + fr) * 72 + 32 * ks + 8 * fq);
#pragma unroll
                for (int mt = 0; mt < 4; ++mt) at[ks][mt] = *(const LAS bf16x8*)(Tb + (16 * mt + fr) * 72 + 32 * ks + 8 * fq);
            }
            asm volatile("" ::: "memory");
#pragma unroll
            for (int ks = 0; ks < 2; ++ks)
#pragma unroll
                for (int mt = 0; mt < 4; ++mt) {
                    au[mt] = __builtin_amdgcn_mfma_f32_16x16x32_bf16(at[ks][mt], bv[ks], au[mt], 0, 0, 0);
                    aw[mt] = __builtin_amdgcn_mfma_f32_16x16x32_bf16(at[ks][mt], bk[ks], aw[mt], 0, 0, 0);
                }
#pragma unroll
            for (int mt = 0; mt < 4; ++mt)
#pragma unroll
                for (int jj = 0; jj < 4; ++jj) {
                    const int ir = 16 * mt + 4 * fq + jj, c = 16 * wave + fr;
                    cU[ir * 128 + c] = f2bf(au[mt][jj]); cW[ir * 128 + c] = f2bf(aw[mt][jj]);
                }
        }
    }
}
constexpr int SC_W = 0, SC_QD = 64 * 136, SC_KD = SC_QD + 64 * 136, SC_AT = SC_KD + 128 * 72, SC_U = SC_AT + 64 * 72, SC_EGL = SC_U + 16 * 72, SC_STAGE = SC_EGL + 8;
struct ScanRegs { u32x4 v[8]; u32x4 u[2]; };
DI void dn_scan_fetch(const bf16_t* CH, const bf16_t* ATT, int u, int sl, int wv, int lane, ScanRegs& R) {
    const bf16_t* cW = CH + (size_t)u * 32768;
    const bf16_t* src = (wv < 6) ? cW + wv * 4096 + lane * 8 : ATT + (size_t)u * 4096 + lane * 8;
#pragma unroll
    for (int q = 0; q < 8; ++q) R.v[q] = *(const u32x4*)(src + q * 512);
    if (wv == 6) {
#pragma unroll
        for (int qq = 0; qq < 2; ++qq) { const int pid = lane + 64 * qq; R.u[qq] = *(const u32x4*)(cW + 24576 + (pid >> 1) * 128 + sl * 16 + (pid & 1) * 8); }
    }
}
DI void dn_scan_put(LAS bf16_t* st, int wv, int lane, const ScanRegs& R) {
    LAS bf16_t* dst; int qs;
    if (wv < 4) { dst = st + ((wv < 2) ? SC_W : SC_QD) + ((wv & 1) * 32 + (lane >> 4)) * 136 + (lane & 15) * 8; qs = 544; }
    else if (wv < 6) { dst = st + SC_KD + ((wv - 4) * 64 + (lane >> 3)) * 72 + (lane & 7) * 8; qs = 576; }
    else { dst = st + SC_AT + (lane >> 3) * 72 + (lane & 7) * 8; qs = 576; }
#pragma unroll
    for (int q = 0; q < 8; ++q) *(LAS u32x4*)(dst + q * qs) = R.v[q];
    if (wv == 6) {
#pragma unroll
        for (int qq = 0; qq < 2; ++qq) { const int pid = lane + 64 * qq, i = pid >> 1, hf = pid & 1;
#pragma unroll
            for (int w = 0; w < 4; ++w) { st[SC_U + (hf * 8 + 2 * w) * 72 + i] = (bf16_t)(R.u[qq][w] & 0xffff); st[SC_U + (hf * 8 + 2 * w + 1) * 72 + i] = (bf16_t)(R.u[qq][w] >> 16); } }
    }
}
DI bf16x8 ld2(const LAS bf16_t* p0, const LAS bf16_t* p1) {
    const u32x2 a = *(const LAS u32x2*)p0, b = *(const LAS u32x2*)p1;
    u32x4 r; r[0] = a[0]; r[1] = a[1]; r[2] = b[0]; r[3] = b[1];
    return __builtin_bit_cast(bf16x8, r);
}
DI bf16x8 pk8(f32x4 a, f32x4 b) { u32x4 r; r[0] = pk2(a[0], a[1]); r[1] = pk2(a[2], a[3]); r[2] = pk2(b[0], b[1]); r[3] = pk2(b[2], b[3]); return __builtin_bit_cast(bf16x8, r); }
PF void dn_scan(const KC& k, LAS unsigned char* lds) {
    const int tid = TID(), lane = tid & 63, wave = tid >> 6, fr = lane & 15, fq = lane >> 4;
    LAS bf16_t* ring = (LAS bf16_t*)lds;
    const bf16_t* CH = (const bf16_t*)(k.ws + AR_CHUNK);
    const bf16_t* ATT = (const bf16_t*)(k.ws + AR_HBUF);
    const float* EGL = (const float*)(k.ws + WS_EGL);
    bf16_t* O = (bf16_t*)(k.ws + AR_PB);
    for (int un0 = blockIdx.x; un0 < 256; un0 += gridDim.x) {
        const int un = (gridDim.x == 256) ? ((un0 & 7) * 32 + (un0 >> 3)) : un0;
        const int sl = un & 7, chain = un >> 3, dir = chain & 1, h = (chain >> 1) & 7, b = chain >> 4;
        const int rstep = dir == 0 ? 1 : -1;
        f32x4 S[8];
#pragma unroll
        for (int t = 0; t < 8; ++t) S[t] = (f32x4){0.f, 0.f, 0.f, 0.f};
        LAS float* eglL = (LAS float*)(ring + 2 * SC_STAGE);
        constexpr int NPF = 1;
        ScanRegs R[NPF];
        const int wv = wave - 1;
        lds_barrier();
        if (tid < DN_STEPS) eglL[tid] = EGL[chain * DN_STEPS + tid];
        if (wave > 0) {
            dn_scan_fetch(CH, ATT, chain * DN_STEPS, sl, wv, lane, R[0]); dn_scan_put(ring, wv, lane, R[0]);
#pragma unroll
            for (int q = 0; q < NPF; ++q) dn_scan_fetch(CH, ATT, chain * DN_STEPS + q + 1, sl, wv, lane, R[q]);
        }
        lds_barrier();
#pragma unroll 1
        for (int s4 = 0; s4 < DN_STEPS; s4 += NPF) {
#pragma unroll
          for (int q = 0; q < NPF; ++q) {
            const int s = s4 + q; if (s >= DN_STEPS) break;
            LAS bf16_t* st = ring + (s & 1) * SC_STAGE;
            if (wave > 0) {
                if (s + 1 < DN_STEPS) dn_scan_put(ring + ((s + 1) & 1) * SC_STAGE, wv, lane, R[q]);
                if (s + 1 + NPF < DN_STEPS) dn_scan_fetch(CH, ATT, chain * DN_STEPS + s + 1 + NPF, sl, wv, lane, R[q]);
            } else {
                const float egl = eglL[s];
                bf16x8 sb[4];
#pragma unroll
                for (int ks = 0; ks < 4; ++ks) sb[ks] = pk8(S[2 * ks], S[2 * ks + 1]);
                f32x4 p[4], o[4];
#pragma unroll
                for (int mt = 0; mt < 4; ++mt) { p[mt] = (f32x4){0.f, 0.f, 0.f, 0.f}; o[mt] = (f32x4){0.f, 0.f, 0.f, 0.f}; }
                bf16x8 fw[2][4], fq_[2][4];
#define SC_LOAD_KS(buf, ks) do { _Pragma("unroll") for (int mt = 0; mt < 4; ++mt) { \
                        const LAS bf16_t* wr_ = st + SC_W + (16 * mt + fr) * 136 + 4 * fq + 32 * (ks); const LAS bf16_t* qr_ = st + SC_QD + (16 * mt + fr) * 136 + 4 * fq + 32 * (ks); \
                        fw[buf][mt] = ld2(wr_, wr_ + 16); fq_[buf][mt] = ld2(qr_, qr_ + 16); } } while (0)
#define SC_MMA_KS(buf, ks) do { _Pragma("unroll") for (int mt = 0; mt < 4; ++mt) p[mt] = __builtin_amdgcn_mfma_f32_16x16x32_bf16(fw[buf][mt], sb[ks], p[mt], 0, 0, 0); \
                        _Pragma("unroll") for (int mt = 0; mt < 4; ++mt) o[mt] = __builtin_amdgcn_mfma_f32_16x16x32_bf16(fq_[buf][mt], sb[ks], o[mt], 0, 0, 0); } while (0)
                bf16x8 fa[2][4], fk[2][8];
#define SC_LOAD_KC(kc) do { _Pragma("unroll") for (int mt = 0; mt < 4; ++mt) { const LAS bf16_t* ar_ = st + SC_AT + (16 * mt + fr) * 72 + 4 * fq + 32 * (kc); fa[kc][mt] = ld2(ar_, ar_ + 16); } \
                        _Pragma("unroll") for (int t = 0; t < 8; ++t) { const LAS bf16_t* kr_ = st + SC_KD + (16 * t + fr) * 72 + 4 * fq + 32 * (kc); fk[kc][t] = ld2(kr_, kr_ + 16); } } while (0)
                SC_LOAD_KS(0, 0);
                SC_LOAD_KS(1, 1); asm volatile("" ::: "memory"); SC_MMA_KS(0, 0);
                SC_LOAD_KS(0, 2); asm volatile("" ::: "memory"); SC_MMA_KS(1, 1);
                SC_LOAD_KS(1, 3); asm volatile("" ::: "memory"); SC_MMA_KS(0, 2);
                SC_LOAD_KC(0);    asm volatile("" ::: "memory"); SC_MMA_KS(1, 3);
                u32x2 uu[4];
#pragma unroll
                for (int mt = 0; mt < 4; ++mt) uu[mt] = *(const LAS u32x2*)(st + SC_U + fr * 72 + 16 * mt + 4 * fq);
                SC_LOAD_KC(1);    asm volatile("" ::: "memory");
                bf16x8 vb[2]; f32x4 vn[4];
#pragma unroll
                for (int mt = 0; mt < 4; ++mt) {
                    vn[mt][0] = __uint_as_float(uu[mt][0] << 16) - p[mt][0]; vn[mt][1] = __uint_as_float(uu[mt][0] & 0xffff0000u) - p[mt][1];
                    vn[mt][2] = __uint_as_float(uu[mt][1] << 16) - p[mt][2]; vn[mt][3] = __uint_as_float(uu[mt][1] & 0xffff0000u) - p[mt][3];
                }
                vb[0] = pk8(vn[0], vn[1]); vb[1] = pk8(vn[2], vn[3]);
#pragma unroll
                for (int t = 0; t < 8; ++t) S[t] = S[t] * egl;
#pragma unroll
                for (int kc = 0; kc < 2; ++kc) {
#pragma unroll
                    for (int mt = 0; mt < 4; ++mt) o[mt] = __builtin_amdgcn_mfma_f32_16x16x32_bf16(fa[kc][mt], vb[kc], o[mt], 0, 0, 0);
#pragma unroll
                    for (int t = 0; t < 8; ++t) S[t] = __builtin_amdgcn_mfma_f32_16x16x32_bf16(fk[kc][t], vb[kc], S[t], 0, 0, 0);
                }
#undef SC_LOAD_KS
#undef SC_MMA_KS
#undef SC_LOAD_KC
                const int rbase = dn_rbase(b, dir, s);
#pragma unroll
                for (int mt = 0; mt < 4; ++mt)
#pragma unroll
                    for (int jj = 0; jj < 4; ++jj) {
                        const int row = rbase + rstep * (16 * mt + 4 * fq + jj);
                        O[((size_t)dir * T + row) * 1024 + h * 128 + sl * 16 + fr] = f2bf(o[mt][jj]);
                    }
            }
            lds_barrier();
          }
        }
    }
}
PF void dn_finish(const KC& k, int j) {
    const int tid = TID(), lane = tid & 63, wave = tid >> 6;
    const bf16_t* O = (const bf16_t*)(k.ws + AR_PB);
    const bf16_t* Z = (const bf16_t*)k.out;
    bf16_t* U = (bf16_t*)(k.ws + AR_UBUF);
    const float* on = k.dn_out_norm + j * 128;
    const int c0 = lane * 16;
    float onv[16];
#pragma unroll
    for (int e = 0; e < 16; ++e) onv[e] = on[(c0 + e) & 127];
    for (int r = blockIdx.x * 8 + wave; r < T; r += gridDim.x * 8) {
        u32x4 vf[2], vb[2], vz[2];
#pragma unroll
        for (int hh = 0; hh < 2; ++hh) {
            vf[hh] = *(const u32x4*)(O + (size_t)r * 1024 + c0 + hh * 8); vb[hh] = *(const u32x4*)(O + ((size_t)T + r) * 1024 + c0 + hh * 8);
            vz[hh] = *(const u32x4*)(Z + (size_t)r * 1024 + c0 + hh * 8);
        }
        asm volatile("" ::: "memory");
        float o[16], z[16];
#pragma unroll
        for (int hh = 0; hh < 2; ++hh) { float a[8], b2[8], zz[8]; unpack8(vf[hh], a); unpack8(vb[hh], b2); unpack8(vz[hh], zz);
#pragma unroll
            for (int i = 0; i < 8; ++i) { o[hh * 8 + i] = a[i] + b2[i]; z[hh * 8 + i] = zz[i]; } }
        float ss = 0.f;
#pragma unroll
        for (int e = 0; e < 16; ++e) ss += o[e] * o[e];
        ss += shx(ss, 1, lane); ss += shx(ss, 2, lane); ss += shx(ss, 4, lane);
        const float rs = rsqrtf(ss * (1.0f / 128.0f) + EPS);
#pragma unroll
        for (int hh = 0; hh < 2; ++hh) { u32x4 ov;
#pragma unroll
            for (int w = 0; w < 4; ++w) { const int e0 = hh * 8 + 2 * w; ov[w] = pk2(o[e0] * rs * onv[e0] * siluf(z[e0]), o[e0 + 1] * rs * onv[e0 + 1] * siluf(z[e0 + 1])); }
            *(u32x4*)(U + (size_t)r * 1024 + c0 + hh * 8) = ov; }
    }
}

DI float conv3g(const bf16_t* p, int j, float w0, float w1, float w2) {
    const int gc = j & 63;
    const float l = gc != 0 ? bf2f(p[j - 1]) : 0.f, c = bf2f(p[j]), r = gc != 63 ? bf2f(p[j + 1]) : 0.f;
    return w0 * l + w1 * c + w2 * r;
}
DI float hy_conv_lane(float c, float w0, float w1, float w2, int lane) {
    const float l = shi(c, (lane + 63) & 63), r = shi(c, (lane + 1) & 63);
    return w0 * (lane > 0 ? l : 0.f) + w1 * c + w2 * (lane < 63 ? r : 0.f);
}
PF void hy_lat(const KC& k, int jl, LAS float* ldsf) {
    const int tid = TID();
    LAS cf* X = (LAS cf*)ldsf;
    LAS cf* tw = X + 17408;
    LAS cf* tA = tw + 1024; LAS cf* tB = tA + 128;
    const float* FT = (const float*)(k.ws + AR_FT);
    const bf16_t* PT = (const bf16_t*)(k.ws + AR_PB);
    bf16_t* ZT = (bf16_t*)(k.ws + AR_ZT);
    unsigned* scr = (unsigned*)(k.ws + AR_FFTS) + (size_t)blockIdx.x * 4 * 16384;
    unsigned* sKe = scr; unsigned* sKo = scr + 16384; unsigned* zp = scr + 2 * 16384; unsigned* ye = scr + 3 * 16384;
#define CPK(v) pk2((v).x, (v).y)
#define CUP(u_) ((cf){__uint_as_float((u_) << 16), __uint_as_float((u_) & 0xffff0000u)})
    const float* cw = k.hy_conv + (size_t)jl * 3 * 3072;
    for (int m = 0; m < 2; ++m) { const int p = tid + 512 * m; float sn, cs; sincospif(-(float)p / 8192.0f, &sn, &cs); cf w; w.x = cs; w.y = sn; tw[p] = w; }
    if (tid < 256) { const int a = tid & 127; float sn, cs; sincospif(-(float)(tid < 128 ? 128 * a : a) / 16384.0f, &sn, &cs); cf w; w.x = cs; w.y = sn; (tid < 128 ? tA : tB)[a] = w; }
    __syncthreads();
    const int lane = tid & 63;
#define HY_SPLIT() asm volatile("" ::: "memory")
#define HY_CONV(c, w0, w1, w2) hy_conv_lane((c), (w0), (w1), (w2), lane)
    for (int ch = blockIdx.x; ch < 1024; ch += gridDim.x) {
        {
            const bf16_t* pv = PT + (size_t)ch * T + TC;
            const float w0 = cw[ch], w1 = cw[3072 + ch], w2 = cw[6144 + ch];
            for (int m0 = 0; m0 < 32; m0 += 8) {
                bf16_t a0[8], a1[8];
#pragma unroll
                for (int q = 0; q < 8; ++q) { const int j = tid + 512 * (m0 + q); a0[q] = pv[j]; a1[q] = pv[SEQ + j]; }
                HY_SPLIT();
#pragma unroll
                for (int q = 0; q < 8; ++q) { const int j = tid + 512 * (m0 + q); const float c0 = bf2f(a0[q]), c1 = bf2f(a1[q]); cf z; z.x = HY_CONV(c0, w0, w1, w2); z.y = HY_CONV(c1, w0, w1, w2); zp[j] = CPK(z); }
            }
        }
        for (int n = 0; n < 2; ++n) {
            __syncthreads();
            const float* ftf = FT + (size_t)(n * 2048 + ch) * 16384; const float* ftb = FT + (size_t)(n * 2048 + 1024 + ch) * 16384;
            for (int m0 = 0; m0 < 32; m0 += 8) {
                float hfv[8], hbv[8];
#pragma unroll
                for (int q = 0; q < 8; ++q) { const int j = tid + 512 * (m0 + q); hfv[q] = ftf[j]; hbv[q] = ftb[j > 0 ? SEQ - j : 0]; }
                HY_SPLIT();
#pragma unroll
                for (int q = 0; q < 8; ++q) {
                    const int j = tid + 512 * (m0 + q);
                    const float hf = hfv[q], hb = j > 0 ? hbv[q] : 0.f;
                    const cf w = cmul(tA[j >> 7], tB[j & 127]);
                    cf a; a.x = hf + hb; a.y = 0.f; X[PIDX(j)] = a;
                    const float kd = hf - hb; cf o; o.x = kd * w.x; o.y = kd * w.y; sKo[j] = CPK(o);
                }
            }
            __syncthreads();
            fft16k_fwd(X, tw);
            unsigned Ker[32];
#pragma unroll
            for (int m = 0; m < 32; ++m) { const cf t_ = X[PIDX(tid + 512 * m)]; Ker[m] = CPK(t_); }
            __syncthreads();
            for (int m0 = 0; m0 < 32; m0 += 8) { unsigned t[8];
#pragma unroll
                for (int q = 0; q < 8; ++q) t[q] = sKo[tid + 512 * (m0 + q)];
                HY_SPLIT();
#pragma unroll
                for (int q = 0; q < 8; ++q) X[PIDX(tid + 512 * (m0 + q))] = CUP(t[q]); }
            __syncthreads();
            fft16k_fwd(X, tw);
            _Pragma("unroll 8") for (int m = 0; m < 32; ++m) { const int j = tid + 512 * m; const cf t_ = X[PIDX(j)]; sKo[j] = CPK(t_); }
            __syncthreads();
            for (int m0 = 0; m0 < 32; m0 += 8) { unsigned t[8];
#pragma unroll
                for (int q = 0; q < 8; ++q) t[q] = zp[tid + 512 * (m0 + q)];
                HY_SPLIT();
#pragma unroll
                for (int q = 0; q < 8; ++q) X[PIDX(tid + 512 * (m0 + q))] = CUP(t[q]); }
            __syncthreads();
            fft16k_fwd(X, tw);
#pragma unroll
            for (int m = 0; m < 32; ++m) { const int j = tid + 512 * m; X[PIDX(j)] = cmul(X[PIDX(j)], CUP(Ker[m])); }
            __syncthreads();
            fft16k_inv(X, tw);
            _Pragma("unroll 8") for (int m = 0; m < 32; ++m) { const int j = tid + 512 * m; const cf t_ = X[PIDX(j)]; ye[j] = CPK(t_); }
            __syncthreads();
            for (int m0 = 0; m0 < 32; m0 += 8) { unsigned t[8];
#pragma unroll
                for (int q = 0; q < 8; ++q) t[q] = zp[tid + 512 * (m0 + q)];
                HY_SPLIT();
#pragma unroll
                for (int q = 0; q < 8; ++q) { const int j = tid + 512 * (m0 + q); const cf w = cmul(tA[j >> 7], tB[j & 127]); X[PIDX(j)] = cmul(CUP(t[q]), w); } }
            __syncthreads();
            fft16k_fwd(X, tw);
            for (int m0 = 0; m0 < 32; m0 += 8) { unsigned t[8];
#pragma unroll
                for (int q = 0; q < 8; ++q) t[q] = sKo[tid + 512 * (m0 + q)];
                HY_SPLIT();
#pragma unroll
                for (int q = 0; q < 8; ++q) { const int j = tid + 512 * (m0 + q); X[PIDX(j)] = cmul(X[PIDX(j)], CUP(t[q])); } }
            __syncthreads();
            fft16k_inv(X, tw);
            {
                const bf16_t* pg = PT + (size_t)((n + 1) * 1024 + ch) * T + TC;
                const int gcol = (n + 1) * 1024 + ch;
                const float w0 = cw[gcol], w1 = cw[3072 + gcol], w2 = cw[6144 + gcol];
                const float bias = k.hy_bias[(size_t)jl * 2 * 1024 + n * 1024 + ch];
                for (int m0 = 0; m0 < 32; m0 += 8) {
                    unsigned te_[8], tz_[8]; bf16_t g0[8], g1[8];
#pragma unroll
                    for (int q = 0; q < 8; ++q) { const int j = tid + 512 * (m0 + q); te_[q] = ye[j]; tz_[q] = zp[j]; g0[q] = pg[j]; g1[q] = pg[SEQ + j]; }
                    HY_SPLIT();
#pragma unroll
                    for (int q = 0; q < 8; ++q) {
                        const int j = tid + 512 * (m0 + q);
                        cf w = cmul(tA[j >> 7], tB[j & 127]); w.y = -w.y;
                        const cf yo = cmul(X[PIDX(j)], w);
                        const cf te = CUP(te_[q]), tz = CUP(tz_[q]);
                        const float y0 = (0.5f / 16384.0f) * (te.x + yo.x), y1 = (0.5f / 16384.0f) * (te.y + yo.y);
                        const float c0 = bf2f(g0[q]), c1 = bf2f(g1[q]);
                        cf zn; zn.x = HY_CONV(c0, w0, w1, w2) * (y0 + bias * tz.x); zn.y = HY_CONV(c1, w0, w1, w2) * (y1 + bias * tz.y);
                        zp[j] = CPK(zn);
                    }
                }
            }
        }
        for (int m0 = 0; m0 < 32; m0 += 8) { unsigned t[8];
#pragma unroll
            for (int q = 0; q < 8; ++q) t[q] = zp[tid + 512 * (m0 + q)];
            HY_SPLIT();
#pragma unroll
            for (int q = 0; q < 8; ++q) { const int j = tid + 512 * (m0 + q); ZT[(size_t)ch * T + TC + j] = (bf16_t)(t[q] & 0xffffu); ZT[(size_t)ch * T + TC + SEQ + j] = (bf16_t)(t[q] >> 16); } }
        __syncthreads();
    }
#undef CPK
#undef CUP
#undef HY_SPLIT
#undef HY_CONV
}
PF void hy_ctx(const KC& k, int jl, LAS float* lds) {
    const int tid = TID(), t = tid & 255, hsel = tid >> 8;
    LAS float* z = lds + hsel * 768; LAS float* hf = z + 256; LAS float* hb = hf + 256;
    const bf16_t* PT = (const bf16_t*)(k.ws + AR_PB);
    bf16_t* U = (bf16_t*)(k.ws + AR_UBUF);
    const float* filtc = (const float*)(k.ws + WS_FILTC);
    const float* cw = k.hy_conv + (size_t)jl * 3 * 3072;
    for (int u = blockIdx.x; u < 1024; u += gridDim.x) {
        const int pr = u * 2 + hsel, b = pr >> 10, ch = pr & 1023;
        float zc;
        {
            const bf16_t* pv = PT + (size_t)ch * T + b * 256;
            const float l = t != 0 ? bf2f(pv[t - 1]) : 0.f, c = bf2f(pv[t]), r = t != 255 ? bf2f(pv[t + 1]) : 0.f;
            zc = cw[ch] * l + cw[3072 + ch] * c + cw[6144 + ch] * r;
        }
        for (int n = 0; n < 2; ++n) {
            __syncthreads();
            z[t] = zc; hf[t] = filtc[(size_t)t * 4096 + n * 2048 + ch]; hb[t] = filtc[(size_t)t * 4096 + n * 2048 + 1024 + ch];
            __syncthreads();
            float y = 0.f;
            for (int s = 0; s <= t; ++s) y += hf[t - s] * z[s];
            for (int s = t + 1; s < 256; ++s) y += hb[s - t] * z[s];
            const int gcol = (n + 1) * 1024 + ch;
            const bf16_t* pg = PT + (size_t)gcol * T + b * 256;
            const float l = t != 0 ? bf2f(pg[t - 1]) : 0.f, c = bf2f(pg[t]), r = t != 255 ? bf2f(pg[t + 1]) : 0.f;
            const float gate = cw[gcol] * l + cw[3072 + gcol] * c + cw[6144 + gcol] * r;
            zc = gate * (y + k.hy_bias[(size_t)jl * 2048 + n * 1024 + ch] * zc);
        }
        U[(size_t)(b * 256 + t) * 1024 + ch] = f2bf(zc);
        __syncthreads();
    }
}
PF void hy_transpose(const KC& k, LAS bf16_t* lds) {
    const int tid = TID();
    const bf16_t* ZT = (const bf16_t*)(k.ws + AR_ZT);
    bf16_t* U = (bf16_t*)(k.ws + AR_UBUF);
    for (int u = blockIdx.x; u < 16 * (TL / 64); u += gridDim.x) {
        const int c0 = (u & 15) * 64, r0 = TC + (u >> 4) * 64;
        { const int c = tid >> 3, sg = (tid & 7) * 8;
          const u32x4 v = *(const u32x4*)(ZT + (size_t)(c0 + c) * T + r0 + sg);
#pragma unroll
          for (int w = 0; w < 4; ++w) { lds[(sg + 2 * w) * 66 + c] = (bf16_t)(v[w] & 0xffff); lds[(sg + 2 * w + 1) * 66 + c] = (bf16_t)(v[w] >> 16); } }
        __syncthreads();
        { const int r = tid >> 3, sg = (tid & 7) * 8; u32x4 o;
#pragma unroll
          for (int w = 0; w < 4; ++w) o[w] = (unsigned)lds[r * 66 + sg + 2 * w] | ((unsigned)lds[r * 66 + sg + 2 * w + 1] << 16);
          *(u32x4*)(U + (size_t)(r0 + r) * 1024 + c0 + sg) = o; }
        __syncthreads();
    }
}

__global__ void __launch_bounds__(NTHR, 2) fwd_kernel(Params prm) {
    extern __shared__ __attribute__((aligned(16))) unsigned char lds_raw[];
    LAS unsigned char* lds = (LAS unsigned char*)lds_raw;
    LAS float* ldsf = (LAS float*)lds;
    LAS bf16_t* ldsh = (LAS bf16_t*)lds;
    LAS int* tb = (LAS int*)(lds + 150 * 1024);
    volatile LAS unsigned* xbw = (volatile LAS unsigned*)(lds + 151 * 1024 + 512);
    KC k;
    k.x = (const float*)(GAS const float*)prm.in[0]; k.c = (const float*)(GAS const float*)prm.in[1]; k.ctx = (const float*)(GAS const float*)prm.in[2]; k.c_ctx = (const float*)(GAS const float*)prm.in[3]; k.ada_w = (const float*)(GAS const float*)prm.in[4]; k.ada_b = (const float*)(GAS const float*)prm.in[5];
    k.norm_mix = (const float*)(GAS const float*)prm.in[6]; k.norm_ffn = (const float*)(GAS const float*)prm.in[7]; k.norm_final = (const float*)(GAS const float*)prm.in[8];
    k.dn_w_in = (const float*)(GAS const float*)prm.in[9]; k.dn_conv = (const float*)(GAS const float*)prm.in[10]; k.dn_a_log = (const float*)(GAS const float*)prm.in[11]; k.dn_dt_bias = (const float*)(GAS const float*)prm.in[12]; k.dn_out_norm = (const float*)(GAS const float*)prm.in[13]; k.dn_w_out = (const float*)(GAS const float*)prm.in[14];
    k.hy_w_in = (const float*)(GAS const float*)prm.in[15]; k.hy_conv = (const float*)(GAS const float*)prm.in[16]; k.hy_f_w1 = (const float*)(GAS const float*)prm.in[17]; k.hy_f_b1 = (const float*)(GAS const float*)prm.in[18]; k.hy_f_freq = (const float*)(GAS const float*)prm.in[19]; k.hy_f_w2 = (const float*)(GAS const float*)prm.in[20];
    k.hy_f_b2 = (const float*)(GAS const float*)prm.in[21]; k.hy_f_w3 = (const float*)(GAS const float*)prm.in[22]; k.hy_bias = (const float*)(GAS const float*)prm.in[23]; k.hy_w_out = (const float*)(GAS const float*)prm.in[24];
    k.sc_w_in = (const float*)(GAS const float*)prm.in[25]; k.sc_conv = (const float*)(GAS const float*)prm.in[26]; k.sc_w_out = (const float*)(GAS const float*)prm.in[27]; k.w_router = (const float*)(GAS const float*)prm.in[28]; k.router_bias = (const float*)(GAS const float*)prm.in[29];
    k.moe_w_gate = (const float*)(GAS const float*)prm.in[30]; k.moe_w_up = (const float*)(GAS const float*)prm.in[31]; k.moe_w_down = (const float*)(GAS const float*)prm.in[32];
    k.out = (float*)(GAS float*)prm.out; k.ws = (unsigned char*)(GAS unsigned char*)prm.ws;
    const int lo = prm.ph_lo, hi = prm.ph_hi;
    XcdBarrier bar; bar.bar = (unsigned*)(k.ws + WS_CTL); bar.x = 0; bar.st = xbw;
    if (hi - lo > 1) {
        if (threadIdx.x == 0) { xbw[0] = 0u; xbw[1] = 0u; }
        __syncthreads();
        bar = xcd_barrier_post((unsigned*)(k.ws + WS_CTL), xbw);
    }
    int ph = 0;
#define PROBE_OK(id) ((id) != 1 || i == 0)
    int i = 0;
#define PH_BEGIN(id) if (ph >= lo && ph < hi) { const int nrep_ = (((id) == PROBE_REP) && PROBE_OK(id)) ? 2 : 1; for (int rep_ = 0; rep_ < nrep_; ++rep_) { { GAS unsigned char* w_ = (GAS unsigned char*)k.ws; asm volatile("" : "+s"(w_)); k.ws = (unsigned char*)w_; }
#define PH_END   if (ph + 1 < hi) xcd_barrier(bar); } } ++ph;

    float* xs = (float*)(k.ws + WS_XS);
    const float* mod = (const float*)(k.ws + WS_MOD);

    PH_BEGIN(0)
        job_mod(k, ldsf);
        job_cvt_small(k, ldsf);
        job_hdn(k, ldsf);
        job_w3s(k);
    PH_END

    for (i = 0; i < DEPTH; ++i) {
        const int kind = i % 3, j = i / 3;
        const bool last = (i == DEPTH - 1);
        PH_BEGIN(1)
            if (kind == 0) norm_mfma<2>(k, i, i == 0, i > 0, k.norm_mix + i * 1024, 0, k.dn_w_in + (size_t)j * 1024 * DN_IN + 4096, DN_IN,
                                        k.dn_a_log + j * 16, k.dn_dt_bias + j * 16, last, lds);
            else norm_phase<0>(k, i, i == 0, i > 0, k.norm_mix + i * 1024, 0, nullptr, 0, nullptr, nullptr, last, ldsf);
            if (kind == 1) job_filtc(k, j);
        PH_END
        PH_BEGIN(2)
            if (kind == 0) { EpiBf16 e{(bf16_t*)(k.ws + AR_PB), 3072, 3072, (bf16_t*)k.out, 1024}; gemm_dense(lds, (const bf16_t*)(k.ws + AR_HBUF), T, (const bf16_t*)(k.ws + WS_DNWIN) + (size_t)j * 4096 * 1024, 4096, 1024, e); }
            else if (kind == 1) { EpiBf16T e{(bf16_t*)(k.ws + AR_PB), T}; gemm_dense(lds, (const bf16_t*)(k.ws + AR_HBUF), T, (const bf16_t*)(k.ws + WS_HYWIN), 3072, 1024, e);
                                  EpiTaps et{(float*)(k.ws + AR_FT)}; gemm_dense(lds, (const bf16_t*)(k.ws + WS_W3S), 4096, (const bf16_t*)(k.ws + WS_HS), 16384, 256, et); }
            else { EpiBf16 e{(bf16_t*)(k.ws + AR_PB), 3072, 1 << 30, nullptr, 0}; gemm_dense(lds, (const bf16_t*)(k.ws + AR_HBUF), T, (const bf16_t*)(k.ws + WS_SCWIN), 3072, 1024, e); }
        PH_END
        if (kind == 0) {
            PH_BEGIN(3) dn_chunk(k, j, lds); PH_END
            PH_BEGIN(4) dn_scan(k, lds); PH_END
            PH_BEGIN(5) dn_finish(k, j); PH_END
        } else if (kind == 1) {
            PH_BEGIN(6) hy_lat(k, j, ldsf); hy_ctx(k, j, ldsf); PH_END
            PH_BEGIN(7) hy_transpose(k, ldsh); PH_END
        } else {
            PH_BEGIN(8) sc_mix(k, j); PH_END
        }
        PH_BEGIN(9)
            const bf16_t* Wt = kind == 0 ? (const bf16_t*)(k.ws + WS_DNWOUT) + (size_t)j * 1024 * 1024 : (kind == 1 ? (const bf16_t*)(k.ws + WS_HYWOUT) : (const bf16_t*)(k.ws + WS_SCWOUT));
            EpiResid e{xs, mod, i, 2};
            gemm_dense(lds, (const bf16_t*)(k.ws + AR_UBUF), T, Wt, 1024, 1024, e);
            if (gridDim.x == 256) job_cvt_moe(k, i, ldsf, (int)blockIdx.x - 8, 248); else job_cvt_moe(k, i, ldsf, (int)blockIdx.x, (int)gridDim.x);
        PH_END
        PH_BEGIN(10)
            norm_mfma<1>(k, i, false, false, k.norm_ffn + i * 1024, 3, k.w_router, 32, k.router_bias, nullptr, last, lds, rep_ == nrep_ - 1);
        PH_END
        PH_BEGIN(11)
            moe_scatter(k, i, tb);
        PH_END
        PH_BEGIN(12) moe_gemm<0>(k, i, lds, tb); PH_END
        PH_BEGIN(13) moe_gemm<1>(k, i, lds, tb); PH_END
    }
    PH_BEGIN(14)
        norm_phase<3>(k, DEPTH, false, true, k.norm_final, 0, nullptr, 0, nullptr, nullptr, false, ldsf);
    PH_END
#undef PH_BEGIN
#undef PH_END
}
constexpr int N_PHASES = 1 + (10 + 9 + 8 + 10) + 1;

extern "C" void kernel_launch(void* const* d_in, const int* in_sizes, int n_in, void* d_out, int out_size, void* d_ws, size_t ws_size, hipStream_t stream) {
    static int grid = 0;
    if (grid == 0) {
        if (n_in != 33 || out_size != TL * D || ws_size < WS_END) { fprintf(stderr, "kernel_launch: unexpected shapes: n_in %d out %d ws %zu (need %zu)\n", n_in, out_size, ws_size, (size_t)WS_END); grid = -1; return; }
        int dev = 0, cus = 0, per_cu = 0;
        if (hipGetDevice(&dev) != hipSuccess || hipDeviceGetAttribute(&cus, hipDeviceAttributeMultiprocessorCount, dev) != hipSuccess) { grid = -1; return; }
        if (hipFuncSetAttribute((const void*)fwd_kernel, hipFuncAttributeMaxDynamicSharedMemorySize, LDS_BYTES) != hipSuccess) { fprintf(stderr, "kernel_launch: hipFuncSetAttribute failed\n"); grid = -1; return; }
        if (hipOccupancyMaxActiveBlocksPerMultiprocessor(&per_cu, (const void*)fwd_kernel, NTHR, LDS_BYTES) != hipSuccess || per_cu < 1) fprintf(stderr, "kernel_launch: occupancy query reports %d\n", per_cu);
        (void)hipGetLastError();
        grid = cus;
    }
    if (grid < 0) return;
    (void)hipMemsetAsync((char*)d_ws + WS_CTL, 0, CTL_BYTES, stream);
    Params p{};
    for (int i = 0; i < 33; ++i) p.in[i] = (const float*)d_in[i];
    p.out = (float*)d_out; p.ws = (unsigned char*)d_ws;
#if MK_MULTI
    for (int ph = 0; ph < N_PHASES; ++ph) { p.ph_lo = ph; p.ph_hi = ph + 1; hipLaunchKernelGGL(fwd_kernel, dim3(grid), dim3(NTHR), LDS_BYTES, stream, p); }
#else
    p.ph_lo = 0; p.ph_hi = N_PHASES;
    hipLaunchKernelGGL(fwd_kernel, dim3(grid), dim3(NTHR), LDS_BYTES, stream, p);
#endif
}
```

```cpp
#include <hip/hip_runtime.h>
#include <stdint.h>
#include <stdio.h>
#include <math.h>

#ifndef MK_MULTI
#define MK_MULTI 0
#endif

#ifndef PROBE_SUB
#define PROBE_SUB (0)
#endif
#ifndef PROBE_REP
#define PROBE_REP (-1)
#endif
#define LAS __attribute__((address_space(3)))
#define GAS __attribute__((address_space(1)))
#define HD __host__ __device__ __forceinline__
#define DI __device__ __forceinline__
#ifdef NOINL
#define PF __device__ __noinline__
#else
#define PF __device__ __forceinline__
#endif
typedef unsigned short bf16_t;
typedef short bf16x8 __attribute__((ext_vector_type(8)));
typedef float f32x4 __attribute__((ext_vector_type(4)));
typedef unsigned u32x4 __attribute__((ext_vector_type(4)));
typedef unsigned u32x2 __attribute__((ext_vector_type(2)));

constexpr int D = 1024, NB = 2, SEQ = 16384, CTXL = 256, DEPTH = 4;
constexpr int TC = NB * CTXL, TL = NB * SEQ, T = TC + TL, NA = 2 * T;
constexpr int NTHR = 512;
constexpr int DN_IN = 4128;
constexpr float EPS = 1e-6f;
constexpr int LDS_BYTES = 152 * 1024;

constexpr size_t AL(size_t x) { return (x + 255) & ~(size_t)255; }
constexpr size_t WS_CTL = 0;
constexpr size_t CTL_BYTES = 65536;
constexpr size_t CTL_CNT = 16384;
constexpr size_t WS_MOD = WS_CTL + CTL_BYTES;
constexpr size_t WS_HS = AL(WS_MOD + 4 * 3 * 6144 * 4);
constexpr size_t WS_W3S = AL(WS_HS + 16384 * 256 * 2);
constexpr size_t WS_HDNC = AL(WS_W3S + 4096 * 256 * 2);
constexpr size_t WS_FILTC = AL(WS_HDNC + 256 * 64 * 4);
constexpr size_t WS_DNWIN = AL(WS_FILTC + 256 * 4096 * 4);
constexpr size_t WS_DNWOUT = AL(WS_DNWIN + (size_t)2 * 4096 * 1024 * 2);
constexpr size_t WS_HYWIN = AL(WS_DNWOUT + (size_t)2 * 1024 * 1024 * 2);
constexpr size_t WS_HYWOUT = AL(WS_HYWIN + (size_t)3072 * 1024 * 2);
constexpr size_t WS_SCWIN = AL(WS_HYWOUT + (size_t)1024 * 1024 * 2);
constexpr size_t WS_SCWOUT = AL(WS_SCWIN + (size_t)3072 * 1024 * 2);
constexpr size_t WS_XS = AL(WS_SCWOUT + (size_t)1024 * 1024 * 2);
constexpr size_t WS_TOKE = AL(WS_XS + (size_t)T * 1024 * 4);
constexpr size_t WS_TOKW = AL(WS_TOKE + (size_t)T * 2 * 4);
constexpr size_t WS_TOKP = AL(WS_TOKW + (size_t)T * 2 * 4);
constexpr size_t WS_SLOT = AL(WS_TOKP + (size_t)T * 2 * 4);
constexpr size_t WS_GB = AL(WS_SLOT + (size_t)(NA + 256) * 4);
constexpr size_t WS_EGL = AL(WS_GB + (size_t)T * 32 * 4);
constexpr size_t WS_AR = AL(WS_EGL + (size_t)32 * 260 * 4);
constexpr size_t AR_HBUF = WS_AR;
constexpr size_t AR_UBUF = AR_HBUF + (size_t)T * 1024 * 2;
constexpr size_t AR_PB = AR_UBUF + (size_t)T * 1024 * 2;
constexpr size_t AR_Q = AR_PB + (size_t)T * 4096 * 2;
constexpr size_t AR_CHUNK = AR_PB + (size_t)T * 3072 * 2;
constexpr size_t AR_DN_END = AR_CHUNK + (size_t)32 * 260 * 65536;
constexpr size_t AR_ZT = AR_Q;
constexpr size_t AR_FFTS = AR_ZT + (size_t)1024 * T * 2;
constexpr size_t AR_FT = AR_FFTS + (size_t)256 * 4 * 16384 * 8;
constexpr size_t AR_HY_END = AR_FT + (size_t)4096 * 16384 * 4;
constexpr size_t AR_HID = AR_PB;
constexpr size_t AR_YS = AR_HID + (size_t)NA * 512 * 2;
constexpr size_t AR_WGU = AR_YS + (size_t)NA * 1024 * 2;
constexpr size_t AR_WD = AR_WGU + (size_t)32 * 1024 * 1024 * 2;
constexpr size_t AR_MOE_END = AR_WD + (size_t)32 * 1024 * 512 * 2;
constexpr size_t WS_END = AR_DN_END > AR_HY_END ? (AR_DN_END > AR_MOE_END ? AR_DN_END : AR_MOE_END) : (AR_HY_END > AR_MOE_END ? AR_HY_END : AR_MOE_END);

#define XB_TMO      128
#define XB_XCNT(j)  (256  + 64 * (j))
#define XB_XSUB(j)  (1280 + 64 * (j))
#define XB_XGEN(j)  (2304 + 64 * (j))
#define XB_TOP      3328
#define XB_TOPGEN   3392
#define XCD_BAR_WORDS 3456
#define XB_SPIN_CAP (1u << 25)
DI unsigned xb_ld(unsigned* p)              { return __hip_atomic_load(p, __ATOMIC_RELAXED, __HIP_MEMORY_SCOPE_AGENT); }
DI unsigned xb_add(unsigned* p, unsigned v) { return __hip_atomic_fetch_add(p, v, __ATOMIC_RELAXED, __HIP_MEMORY_SCOPE_AGENT); }
DI unsigned xb_xcc_id() { return (unsigned)__builtin_amdgcn_s_getreg((3 << 11) | 20) & 0xFu; }
#define XB_SPIN(cond, bar) do { unsigned _sp = 0; while (cond) { __builtin_amdgcn_s_sleep(1); \
    if ((++_sp & 255u) == 0u) { if (xb_ld(&(bar)[XB_TMO])) break; if (_sp > XB_SPIN_CAP) { atomicAdd(&(bar)[XB_TMO], 1u); break; } } } } while (0)
struct XcdBarrier { unsigned* bar; unsigned x; volatile LAS unsigned* st; };
DI XcdBarrier xcd_barrier_post(unsigned* bar, volatile LAS unsigned* st) {
    XcdBarrier b; b.bar = bar; b.x = xb_xcc_id(); b.st = st;
    if (threadIdx.x == 0) (void)xb_add(&bar[XB_XCNT(b.x)], 1u);
    return b;
}
DI void xcd_barrier_complete(unsigned* bar, unsigned x, unsigned& nloc, unsigned& nx) {
    const unsigned G = gridDim.x * gridDim.y * gridDim.z;
    unsigned sum, cnt, mine, sp = 0u;
    for (;;) {
        sum = 0u; cnt = 0u; mine = 0u;
#pragma unroll
        for (unsigned j = 0; j < 16; ++j) { const unsigned c = xb_ld(&bar[XB_XCNT(j)]); sum += c; cnt += (c > 0u) ? 1u : 0u; mine = (j == x) ? c : mine; }
        if (sum == G) break;
        __builtin_amdgcn_s_sleep(1);
        if ((++sp & 255u) == 0u) { if (xb_ld(&bar[XB_TMO])) break; if (sp > XB_SPIN_CAP) { atomicAdd(&bar[XB_TMO], 1u); break; } }
    }
    nloc = mine > 0u ? mine : 1u; nx = cnt > 0u ? cnt : 1u;
}
DI void xcd_barrier(const XcdBarrier& b) {
    asm volatile("s_waitcnt vmcnt(0)" ::: "memory");
    __syncthreads();
    if (threadIdx.x == 0) {
        unsigned* bar = b.bar;
        __builtin_amdgcn_s_waitcnt(0);
        unsigned nloc = b.st[0], nx = b.st[1];
        if (nloc == 0u) { xcd_barrier_complete(bar, b.x, nloc, nx); b.st[0] = nloc; b.st[1] = nx; }
        const unsigned old = xb_add(&bar[XB_XSUB(b.x)], 1u);
        const unsigned gen = old / nloc;
        if (old + 1u == (gen + 1u) * nloc) {
            __builtin_amdgcn_fence(__ATOMIC_RELEASE, "agent");
            asm volatile("s_waitcnt vmcnt(0)" ::: "memory");
            const unsigned og = xb_add(&bar[XB_TOP], 1u);
            const unsigned tg = og / nx;
            if (og + 1u == (tg + 1u) * nx) xb_add(&bar[XB_TOPGEN], 1u);
            else XB_SPIN(xb_ld(&bar[XB_TOPGEN]) == tg, bar);
            __builtin_amdgcn_fence(__ATOMIC_ACQUIRE, "agent");
            xb_add(&bar[XB_XGEN(b.x)], 1u);
            asm volatile("s_waitcnt vmcnt(0)" ::: "memory");
        } else {
            XB_SPIN(xb_ld(&bar[XB_XGEN(b.x)]) == gen, bar);
            __builtin_amdgcn_fence(__ATOMIC_ACQUIRE, "agent");
            asm volatile("s_waitcnt vmcnt(0)" ::: "memory");
        }
    }
    __syncthreads();
}

typedef float f32x2_t __attribute__((ext_vector_type(2)));
typedef __bf16 bf16x2_t __attribute__((ext_vector_type(2)));
DI unsigned cvt_pk_bf16(float lo, float hi) { f32x2_t v; v.x = lo; v.y = hi; const bf16x2_t b = __builtin_convertvector(v, bf16x2_t); return __builtin_bit_cast(unsigned, b); }
DI bf16_t f2bf(float f) { return (bf16_t)(cvt_pk_bf16(f, f) & 0xffffu); }
DI float bf2f(bf16_t b) { return __uint_as_float(((unsigned)b) << 16); }
DI unsigned pk2(float lo, float hi) { return cvt_pk_bf16(lo, hi); }
DI float siluf(float x) { return x * __builtin_amdgcn_rcpf(1.0f + __expf(-x)); }
DI float sigmf(float x) { return 1.0f / (1.0f + __expf(-x)); }
DI float shi(float v, int src) { return __int_as_float(__builtin_amdgcn_ds_bpermute(src << 2, __float_as_int(v))); }
DI int shii(int v, int src) { return __builtin_amdgcn_ds_bpermute(src << 2, v); }
DI float shx(float v, int m, int lane) { return shi(v, lane ^ m); }
DI float wsum(float v, int lane) {
#pragma unroll
    for (int m = 32; m >= 1; m >>= 1) v += shx(v, m, lane);
    return v;
}
DI void lds_barrier() { asm volatile("s_waitcnt lgkmcnt(0)\n\ts_barrier" ::: "memory"); }
DI int TID() { int t = threadIdx.x; asm volatile("" : "+v"(t)); return t; }
DI int modrow(int r) { return r < TC ? 0 : 1 + (r - TC) / SEQ; }

typedef float cf __attribute__((ext_vector_type(2)));
HD cf cmul(cf a, cf b) { cf r; r.x = a.x * b.x - a.y * b.y; r.y = a.x * b.y + a.y * b.x; return r; }
HD cf cadd(cf a, cf b) { cf r; r.x = a.x + b.x; r.y = a.y + b.y; return r; }
HD cf csub(cf a, cf b) { cf r; r.x = a.x - b.x; r.y = a.y - b.y; return r; }
template <int R> HD constexpr int brev(int i) { int r = 0; for (int b = 1, t = R >> 1; b < R; b <<= 1, t >>= 1) if (i & b) r |= t; return r; }
#define FFT_C32 {1.0f, 0.98078528040323044913f, 0.92387953251128675613f, 0.83146961230254523708f, 0.70710678118654752440f, 0.55557023301960222474f, 0.38268343236508977173f, 0.19509032201612826785f, 0.0f, -0.19509032201612826785f, -0.38268343236508977173f, -0.55557023301960222474f, -0.70710678118654752440f, -0.83146961230254523708f, -0.92387953251128675613f, -0.98078528040323044913f}
#define FFT_S32 {0.0f, 0.19509032201612826785f, 0.38268343236508977173f, 0.55557023301960222474f, 0.70710678118654752440f, 0.83146961230254523708f, 0.92387953251128675613f, 0.98078528040323044913f, 1.0f, 0.98078528040323044913f, 0.92387953251128675613f, 0.83146961230254523708f, 0.70710678118654752440f, 0.55557023301960222474f, 0.38268343236508977173f, 0.19509032201612826785f}
template <int R> HD constexpr int ilog2c() { int l = 0; for (int r = R; r > 1; r >>= 1) ++l; return l; }
template <int R> HD void dft_fwd(cf (&v)[R]) {
    constexpr float C[16] = FFT_C32; constexpr float S[16] = FFT_S32;
    constexpr int LG = ilog2c<R>();
#pragma unroll
    for (int st = 0; st < LG; ++st) {
#pragma unroll
        for (int i = 0; i < R / 2; ++i) {
            const int len = R >> st, half = len >> 1, blk = i / half, j = i % half, i0 = blk * len + j, i1 = i0 + half;
            const cf a = v[i0], c = v[i1];
            v[i0] = cadd(a, c);
            const cf d = csub(a, c);
            const int ti = j * (32 / len);
            cf w; w.x = C[ti]; w.y = -S[ti];
            cf r;
            if (ti == 0) r = d;
            else if (ti == 8) { r.x = d.y; r.y = -d.x; }
            else if (ti == 4) { r.x = (d.x + d.y) * 0.70710678118654752440f; r.y = (d.y - d.x) * 0.70710678118654752440f; }
            else if (ti == 12) { r.x = (d.y - d.x) * 0.70710678118654752440f; r.y = -(d.x + d.y) * 0.70710678118654752440f; }
            else r = cmul(d, w);
            v[i1] = r;
        }
    }
}
template <int R> HD void dft_inv(cf (&v)[R]) {
    constexpr float C[16] = FFT_C32; constexpr float S[16] = FFT_S32;
    constexpr int LG = ilog2c<R>();
#pragma unroll
    for (int st = LG - 1; st >= 0; --st) {
#pragma unroll
        for (int i = 0; i < R / 2; ++i) {
            const int len = R >> st, half = len >> 1, blk = i / half, j = i % half, i0 = blk * len + j, i1 = i0 + half;
            const int ti = j * (32 / len);
            cf w; w.x = C[ti]; w.y = S[ti];
            const cf a = v[i0];
            const cf b1 = v[i1];
            cf c;
            if (ti == 0) c = b1;
            else if (ti == 8) { c.x = -b1.y; c.y = b1.x; }
            else if (ti == 4) { c.x = (b1.x - b1.y) * 0.70710678118654752440f; c.y = (b1.x + b1.y) * 0.70710678118654752440f; }
            else if (ti == 12) { c.x = -(b1.x + b1.y) * 0.70710678118654752440f; c.y = (b1.x - b1.y) * 0.70710678118654752440f; }
            else c = cmul(b1, w);
            v[i0] = cadd(a, c);
            v[i1] = csub(a, c);
        }
    }
}
#define PIDX(a) ((a) + (((a) >> 6) << 2))
template <int R> DI void fft_pass_fwd(LAS cf* X, const LAS cf* tw, int n, int g) {
    const int s = n / R, q = g / s, p = g - q * s, base = q * n + p;
    cf v[R];
#pragma unroll
    for (int k = 0; k < R; ++k) v[k] = X[PIDX(base + k * s)];
    dft_fwd<R>(v);
    if (s > 1) {
        int pp = p * (16384 / n); asm volatile("" : "+v"(pp));
        const cf w1 = tw[pp]; cf w = w1;
#pragma unroll
        for (int m = 1; m < R; ++m) { v[brev<R>(m)] = cmul(v[brev<R>(m)], w); w = cmul(w, w1); }
    }
#pragma unroll
    for (int k = 0; k < R; ++k) X[PIDX(base + k * s)] = v[k];
}
template <int R> DI void fft_pass_inv(LAS cf* X, const LAS cf* tw, int n, int g) {
    const int s = n / R, q = g / s, p = g - q * s, base = q * n + p;
    cf v[R];
#pragma unroll
    for (int k = 0; k < R; ++k) v[k] = X[PIDX(base + k * s)];
    if (s > 1) {
        int pp = p * (16384 / n); asm volatile("" : "+v"(pp));
        cf w1 = tw[pp]; w1.y = -w1.y; cf w = w1;
#pragma unroll
        for (int m = 1; m < R; ++m) { v[brev<R>(m)] = cmul(v[brev<R>(m)], w); w = cmul(w, w1); }
    }
    dft_inv<R>(v);
#pragma unroll
    for (int k = 0; k < R; ++k) X[PIDX(base + k * s)] = v[k];
}
DI void fft16k_fwd(LAS cf* X, const LAS cf* tw) {
    const int t = TID();
#pragma unroll 1
    for (int g = 0; g < 2; ++g) fft_pass_fwd<16>(X, tw, 16384, t + 512 * g);
    __syncthreads();
#pragma unroll 1
    for (int g = 0; g < 2; ++g) fft_pass_fwd<16>(X, tw, 1024, t + 512 * g);
    __syncthreads();
#pragma unroll 1
    for (int g = 0; g < 2; ++g) fft_pass_fwd<16>(X, tw, 64, t + 512 * g);
    __syncthreads();
#pragma unroll 1
    for (int g = 0; g < 8; ++g) fft_pass_fwd<4>(X, tw, 4, t + 512 * g);
    __syncthreads();
}
DI void fft16k_inv(LAS cf* X, const LAS cf* tw) {
    const int t = TID();
#pragma unroll 1
    for (int g = 0; g < 8; ++g) fft_pass_inv<4>(X, tw, 4, t + 512 * g);
    __syncthreads();
#pragma unroll 1
    for (int g = 0; g < 2; ++g) fft_pass_inv<16>(X, tw, 64, t + 512 * g);
    __syncthreads();
#pragma unroll 1
    for (int g = 0; g < 2; ++g) fft_pass_inv<16>(X, tw, 1024, t + 512 * g);
    __syncthreads();
#pragma unroll 1
    for (int g = 0; g < 2; ++g) fft_pass_inv<16>(X, tw, 16384, t + 512 * g);
    __syncthreads();
}

struct Params { const float* in[33]; float* out; unsigned char* ws; int ph_lo, ph_hi; };
struct KC {
    const float *x, *c, *ctx, *c_ctx, *ada_w, *ada_b, *norm_mix, *norm_ffn, *norm_final;
    const float *dn_w_in, *dn_conv, *dn_a_log, *dn_dt_bias, *dn_out_norm, *dn_w_out;
    const float *hy_w_in, *hy_conv, *hy_f_w1, *hy_f_b1, *hy_f_freq, *hy_f_w2, *hy_f_b2, *hy_f_w3, *hy_bias, *hy_w_out;
    const float *sc_w_in, *sc_conv, *sc_w_out, *w_router, *router_bias, *moe_w_gate, *moe_w_up, *moe_w_down;
    float* out; unsigned char* ws;
};

PF void job_mod(const KC& k, LAS float* lds) {
    const int tid = TID(), cj = tid & 63, kq = tid >> 6;
    float* mod = (float*)(k.ws + WS_MOD);
    LAS float* sl = lds + 2048;
    for (int i = tid; i < 3072; i += NTHR) { const float v = i < 1024 ? k.c_ctx[i] : k.c[i - 1024]; sl[i] = siluf(v); }
    __syncthreads();
    for (int u = blockIdx.x; u < DEPTH * 96; u += gridDim.x) {
        const int l = u / 96, cc = u % 96, col = cc * 64 + cj;
        const float* W = k.ada_w + (size_t)l * 1024 * 6144 + col;
        float a0 = 0.f, a1 = 0.f, a2 = 0.f;
        for (int k0 = kq * 128; k0 < kq * 128 + 128; k0 += 16) {
            float w[16];
#pragma unroll
            for (int e = 0; e < 16; ++e) w[e] = W[(size_t)(k0 + e) * 6144];
            asm volatile("" ::: "memory");
#pragma unroll
            for (int e = 0; e < 16; ++e) { a0 += sl[k0 + e] * w[e]; a1 += sl[1024 + k0 + e] * w[e]; a2 += sl[2048 + k0 + e] * w[e]; }
        }
        lds[(kq * 3 + 0) * 64 + cj] = a0; lds[(kq * 3 + 1) * 64 + cj] = a1; lds[(kq * 3 + 2) * 64 + cj] = a2;
        __syncthreads();
        if (tid < 192) {
            const int r = tid >> 6, j = tid & 63;
            float sacc = 0.f;
            for (int q = 0; q < 8; ++q) sacc += lds[(q * 3 + r) * 64 + j];
            mod[(size_t)(l * 3 + r) * 6144 + cc * 64 + j] = sacc + k.ada_b[l * 6144 + cc * 64 + j];
        }
        __syncthreads();
    }
}
DI void cvt_matrix(const float* src, int ld, size_t sstride, int K, int N, int nmat, bf16_t* dst, int ldd, size_t dstride, int mapmode, LAS float* lds, int bid, int nb) {
    const int tk = K / 64, tn = N / 64, per = tk * tn, tid = TID();
    const int r = tid >> 4, c4 = (tid & 15) * 4;
    f32x4 v0, v1;
    int u = bid;
    if (u < per * nmat) { const int m = u / per, t = u % per; const float* sp = src + (size_t)m * sstride + (size_t)((t / tn) * 64 + r) * ld + (t % tn) * 64 + c4; v0 = *(const f32x4*)sp; v1 = *(const f32x4*)(sp + (size_t)32 * ld); }
    for (; u < per * nmat; u += nb) {
        const int m = u / per, t = u % per, k0 = (t / tn) * 64, n0 = (t % tn) * 64;
        { LAS float* p = lds + r * 65 + c4; p[0] = v0[0]; p[1] = v0[1]; p[2] = v0[2]; p[3] = v0[3];
          LAS float* p2 = lds + (r + 32) * 65 + c4; p2[0] = v1[0]; p2[1] = v1[1]; p2[2] = v1[2]; p2[3] = v1[3]; }
        { const int un = u + nb;
          if (un < per * nmat) { const int mn = un / per, tn_ = un % per; const float* sp = src + (size_t)mn * sstride + (size_t)((tn_ / tn) * 64 + r) * ld + (tn_ % tn) * 64 + c4; v0 = *(const f32x4*)sp; v1 = *(const f32x4*)(sp + (size_t)32 * ld); } }
        lds_barrier();
        { const int nn = tid >> 3, ks = (tid & 7) * 8; const int n = n0 + nn;
          const int row = mapmode == 0 ? n : (32 * (n >> 4) + (n & 15) + (mapmode == 2 ? 16 : 0));
          float f[8];
#pragma unroll
          for (int e = 0; e < 8; ++e) f[e] = lds[(ks + e) * 65 + nn];
          u32x4 o; o[0] = pk2(f[0], f[1]); o[1] = pk2(f[2], f[3]); o[2] = pk2(f[4], f[5]); o[3] = pk2(f[6], f[7]);
          *(u32x4*)(dst + (size_t)m * dstride + (size_t)row * ldd + k0 + ks) = o; }
        lds_barrier();
    }
}
PF void job_cvt_small(const KC& k, LAS float* lds) {
    cvt_matrix(k.dn_w_in, DN_IN, (size_t)1024 * DN_IN, 1024, 4096, 2, (bf16_t*)(k.ws + WS_DNWIN), 1024, (size_t)4096 * 1024, 0, lds, (int)blockIdx.x, (int)gridDim.x);
    cvt_matrix(k.dn_w_out, 1024, (size_t)1024 * 1024, 1024, 1024, 2, (bf16_t*)(k.ws + WS_DNWOUT), 1024, (size_t)1024 * 1024, 0, lds, (int)blockIdx.x, (int)gridDim.x);
    cvt_matrix(k.hy_w_in, 3072, 0, 1024, 3072, 1, (bf16_t*)(k.ws + WS_HYWIN), 1024, 0, 0, lds, (int)blockIdx.x, (int)gridDim.x);
    cvt_matrix(k.hy_w_out, 1024, 0, 1024, 1024, 1, (bf16_t*)(k.ws + WS_HYWOUT), 1024, 0, 0, lds, (int)blockIdx.x, (int)gridDim.x);
    cvt_matrix(k.sc_w_in, 3072, 0, 1024, 3072, 1, (bf16_t*)(k.ws + WS_SCWIN), 1024, 0, 0, lds, (int)blockIdx.x, (int)gridDim.x);
    cvt_matrix(k.sc_w_out, 1024, 0, 1024, 1024, 1, (bf16_t*)(k.ws + WS_SCWOUT), 1024, 0, 0, lds, (int)blockIdx.x, (int)gridDim.x);
}
PF void job_cvt_moe(const KC& k, int layer, LAS float* lds, int bid, int nb) {
    if (bid < 0) return;
    const size_t lo = (size_t)layer * 32 * 1024 * 512;
    cvt_matrix(k.moe_w_gate + lo, 512, (size_t)1024 * 512, 1024, 512, 32, (bf16_t*)(k.ws + AR_WGU), 1024, (size_t)1024 * 1024, 1, lds, bid, nb);
    cvt_matrix(k.moe_w_up + lo, 512, (size_t)1024 * 512, 1024, 512, 32, (bf16_t*)(k.ws + AR_WGU), 1024, (size_t)1024 * 1024, 2, lds, bid, nb);
    cvt_matrix(k.moe_w_down + lo, 1024, (size_t)512 * 1024, 512, 1024, 32, (bf16_t*)(k.ws + AR_WD), 512, (size_t)1024 * 512, 0, lds, bid, nb);
}
PF void job_hdn(const KC& k, LAS float* lds) {
    const int tid = TID(), lane = tid & 63, wave = tid >> 6;
    LAS float* feat = lds + wave * 128; LAS float* h1 = feat + 64;
    const float fr = k.hy_f_freq[lane], b1 = k.hy_f_b1[lane], b2 = k.hy_f_b2[lane];
    for (int u0 = blockIdx.x * 8; u0 < 16384 + 256; u0 += gridDim.x * 8) {
        const int u = u0 + wave;
        int l, pos; float* dst;
        if (u < 16384) { l = 16384; pos = u; dst = nullptr; }
        else { l = 256; pos = u - 16384; dst = (float*)(k.ws + WS_HDNC) + (size_t)pos * 64; }
        const float t = (float)pos / (float)(l - 1);
        float f = 0.f;
        if (lane == 0) f = t;
        else if (lane <= 32) {
            const int bi = (lane - 1) & 15;
            const float band = 1e-4f + (float)bi * ((15.0f - 1e-4f) / 15.0f);
            const float ang = (6.283185307179586f / (float)l) * (float)pos * band;
            f = lane <= 16 ? cosf(ang) : -sinf(ang);
        }
        feat[lane] = f;
        __syncthreads();
        float a = b1;
        for (int i = 0; i < 33; ++i) a += feat[i] * k.hy_f_w1[i * 64 + lane];
        h1[lane] = sinf(fr * a);
        __syncthreads();
        float a2 = b2;
        for (int j = 0; j < 64; ++j) a2 += h1[j] * k.hy_f_w2[j * 64 + lane];
        const float hv = sinf(fr * a2);
        if (dst) dst[lane] = hv;
        else { bf16_t* hs = (bf16_t*)(k.ws + WS_HS) + (size_t)pos * 256; const bf16_t hi = f2bf(hv), lo = f2bf(hv - bf2f(hi)); hs[lane] = hi; hs[64 + lane] = lo; hs[128 + lane] = hi; hs[192 + lane] = 0; }
        __syncthreads();
    }
}
PF void job_w3s(const KC& k) {
    bf16_t* W = (bf16_t*)(k.ws + WS_W3S);
    const int tq = TID();
    for (int idx = blockIdx.x * NTHR + tq; idx < 64 * 4096; idx += gridDim.x * NTHR) {
        const int j = idx >> 12, col = idx & 4095;
        const float w = k.hy_f_w3[idx]; const bf16_t hi = f2bf(w), lo = f2bf(w - bf2f(hi));
        W[(size_t)col * 256 + j] = hi; W[(size_t)col * 256 + 64 + j] = hi; W[(size_t)col * 256 + 128 + j] = lo; W[(size_t)col * 256 + 192 + j] = 0;
    }
}
DI float hy_delta(int ch) {
    const float lo = -4.605170185988091f / 1.5f, hi = -4.605170185988091f / 0.3f;
    return fabsf(lo + (float)ch * ((hi - lo) / 1023.0f));
}
PF void job_filtc(const KC& k, int j) {
    const float* hdn = (const float*)(k.ws + WS_HDNC);
    const float* w3 = k.hy_f_w3 + (size_t)j * 64 * 4096;
    float* filtc = (float*)(k.ws + WS_FILTC);
    const int tq = TID();
    for (int u = blockIdx.x; u < 256 * 8; u += gridDim.x) {
        const int l = u >> 3, col = (u & 7) * 512 + tq;
        float a = 0.f;
        for (int q = 0; q < 64; ++q) a += hdn[l * 64 + q] * w3[(size_t)q * 4096 + col];
        const float t = (float)l / 255.0f;
        filtc[(size_t)l * 4096 + col] = a * expf(-t * hy_delta(col & 1023));
    }
}

template <int MODE>
PF void norm_phase(const KC& k, int layer, bool first, bool combine, const float* __restrict__ gain, int mb, const float* __restrict__ Wsk, int ldw,
                   const float* __restrict__ aux0, const float* __restrict__ aux1, bool last, LAS float* lds, bool flush = true) {
    const int tid = TID(), lane = tid & 63, wave = tid >> 6;
    float* xs = (float*)(k.ws + WS_XS);
    bf16_t* hbuf = (bf16_t*)(k.ws + AR_HBUF);
    const float* mod = (const float*)(k.ws + WS_MOD);
    const bf16_t* ys = (const bf16_t*)(k.ws + AR_YS);
    const int* tokp = (const int*)(k.ws + WS_TOKP);
    const float* tokw = (const float*)(k.ws + WS_TOKW);
    LAS int* lcnt = (LAS int*)(lds + 32768);
    if (MODE == 1 && tid < 32) lcnt[tid] = 0;
    if (MODE == 1 || MODE == 2) {
        for (int idx = tid; idx < 1024 * 32; idx += NTHR) {
            const int kk = idx >> 5, n = idx & 31;
            lds[kk * 32 + (((n >> 2) ^ ((kk >> 1) & 7)) << 2) + (n & 3)] = Wsk[(size_t)kk * ldw + n];
        }
        __syncthreads();
    }
    const int rbeg = (MODE == 3) ? TC : 0, rstr = gridDim.x * 8;
    int cur_mr = -1; float gsv[16], shv[16], g5v[16];
    float xn[16];
    int r = rbeg + blockIdx.x * 8 + wave;
    if (r < T) {
        const float* src = first ? (r < TC ? k.ctx + (size_t)r * 1024 : k.x + (size_t)(r - TC) * 1024) : xs + (size_t)r * 1024;
#pragma unroll
        for (int m = 0; m < 16; ++m) xn[m] = src[lane + 64 * m];
    }
    for (; r < T; r += rstr) {
        const int mr = modrow(r);
        float x[16];
#pragma unroll
        for (int m = 0; m < 16; ++m) x[m] = xn[m];
        int p0 = 0, p1 = 0; float w0 = 0.f, w1 = 0.f;
        if (combine) { p0 = tokp[2 * r]; p1 = tokp[2 * r + 1]; w0 = tokw[2 * r]; w1 = tokw[2 * r + 1]; }
        {
            const int rn = r + rstr;
            if (rn < T) {
                const float* srcn = first ? (rn < TC ? k.ctx + (size_t)rn * 1024 : k.x + (size_t)(rn - TC) * 1024) : xs + (size_t)rn * 1024;
#pragma unroll
                for (int m = 0; m < 16; ++m) xn[m] = srcn[lane + 64 * m];
            }
        }
        if (mr != cur_mr) {
            cur_mr = mr;
            if (MODE != 3) {
                const float* shift = mod + ((size_t)(layer * 3 + mr) * 6 + mb) * 1024;
#pragma unroll
                for (int m = 0; m < 16; ++m) { const int col = lane + 64 * m; gsv[m] = gain[col] * (1.0f + shift[1024 + col]); shv[m] = shift[col]; }
            } else {
#pragma unroll
                for (int m = 0; m < 16; ++m) gsv[m] = gain[lane + 64 * m];
            }
            if (combine) {
                const float* g5 = mod + ((size_t)((layer - 1) * 3 + mr) * 6 + 5) * 1024;
#pragma unroll
                for (int m = 0; m < 16; ++m) g5v[m] = g5[lane + 64 * m];
            }
        }
        if (combine) {
            bf16_t ya[16], yb[16];
#pragma unroll
            for (int m = 0; m < 16; ++m) { const int col = lane + 64 * m; ya[m] = ys[(size_t)p0 * 1024 + col]; yb[m] = ys[(size_t)p1 * 1024 + col]; }
            asm volatile("" ::: "memory");
#pragma unroll
            for (int m = 0; m < 16; ++m) x[m] += g5v[m] * (w0 * bf2f(ya[m]) + w1 * bf2f(yb[m]));
        }
        if (first || combine) {
#pragma unroll
            for (int m = 0; m < 16; ++m) xs[(size_t)r * 1024 + lane + 64 * m] = x[m];
        }
        float ss = 0.f;
#pragma unroll
        for (int m = 0; m < 16; ++m) ss += x[m] * x[m];
        ss = wsum(ss, lane);
        const float rstd = rsqrtf(ss * (1.0f / 1024.0f) + EPS);
        if (MODE == 3) {
#pragma unroll
            for (int m = 0; m < 16; ++m) { const int col = lane + 64 * m; k.out[(size_t)(r - TC) * 1024 + col] = x[m] * rstd * gsv[m]; }
            continue;
        }
        float y[16];
#pragma unroll
        for (int m = 0; m < 16; ++m) {
            const int col = lane + 64 * m;
            y[m] = x[m] * rstd * gsv[m] + shv[m];
            hbuf[(size_t)r * 1024 + col] = f2bf(y[m]);
        }
        if (MODE == 1 || MODE == 2) {
            float acc[32];
#pragma unroll
            for (int n = 0; n < 32; ++n) acc[n] = 0.f;
#pragma unroll
            for (int m = 0; m < 16; ++m) {
                f32x4 wa[8];
                const int c = lane + 64 * m; const LAS float* wr = lds + c * 32; const int sw = (c >> 1) & 7;
#pragma unroll
                for (int q = 0; q < 8; ++q) wa[q] = *(const LAS f32x4*)(wr + ((q ^ sw) << 2));
                asm volatile("" ::: "memory");
#pragma unroll
                for (int q = 0; q < 8; ++q) { acc[4 * q + 0] += y[m] * wa[q][0]; acc[4 * q + 1] += y[m] * wa[q][1]; acc[4 * q + 2] += y[m] * wa[q][2]; acc[4 * q + 3] += y[m] * wa[q][3]; }
            }
            float val;
            {
                float a16[16], a8[8], a4[4], a2[2];
                const bool b5 = (lane & 32) != 0, b4 = (lane & 16) != 0, b3 = (lane & 8) != 0, b2 = (lane & 4) != 0, b1 = (lane & 2) != 0;
#pragma unroll
                for (int i = 0; i < 16; ++i) { const float send = b5 ? acc[i] : acc[i + 16], keep = b5 ? acc[i + 16] : acc[i]; a16[i] = keep + shx(send, 32, lane); }
#pragma unroll
                for (int i = 0; i < 8; ++i) { const float send = b4 ? a16[i] : a16[i + 8], keep = b4 ? a16[i + 8] : a16[i]; a8[i] = keep + shx(send, 16, lane); }
#pragma unroll
                for (int i = 0; i < 4; ++i) { const float send = b3 ? a8[i] : a8[i + 4], keep = b3 ? a8[i + 4] : a8[i]; a4[i] = keep + shx(send, 8, lane); }
#pragma unroll
                for (int i = 0; i < 2; ++i) { const float send = b2 ? a4[i] : a4[i + 2], keep = b2 ? a4[i + 2] : a4[i]; a2[i] = keep + shx(send, 4, lane); }
                { const float send = b1 ? a2[0] : a2[1], keep = b1 ? a2[1] : a2[0]; val = keep + shx(send, 2, lane); }
                val += shx(val, 1, lane);
            }
            const int n = lane >> 1;
            if (MODE == 1) {
                int* toke = (int*)(k.ws + WS_TOKE); float* tokwW = (float*)(k.ws + WS_TOKW);
                if (last && r < TC) { if (lane == 0) { int neg = -1; asm volatile("" : "+v"(neg)); toke[2 * r] = neg; toke[2 * r + 1] = neg; } continue; }
                const float sc = 1.0f / (1.0f + expf(-val)), ch = sc + aux0[n];
                const int gl = lane & ~7;
                const float ca = shi(ch, gl), cb = shi(ch, gl + 2), cc = shi(ch, gl + 4), cd = shi(ch, gl + 6);
                const float hi1 = fmaxf(ca, cb), lo1 = fminf(ca, cb), hi2 = fmaxf(cc, cd), lo2 = fminf(cc, cd);
                float gs = fmaxf(hi1, hi2) + fmaxf(fminf(hi1, hi2), fmaxf(lo1, lo2));
                int gi = lane >> 3;
#pragma unroll
                for (int m = 8; m <= 32; m <<= 1) {
                    const float og = shx(gs, m, lane); const int oi = shii(gi, lane ^ m);
                    if (og > gs || (og == gs && oi < gi)) { gs = og; gi = oi; }
                }
                float c4[4], s4[4];
#pragma unroll
                for (int i = 0; i < 4; ++i) { c4[i] = shi(ch, gi * 8 + 2 * i); s4[i] = shi(sc, gi * 8 + 2 * i); }
                int i1 = 0; float b1v = c4[0];
#pragma unroll
                for (int i = 1; i < 4; ++i) if (c4[i] > b1v) { b1v = c4[i]; i1 = i; }
                int i2 = -1; float b2v = -1e30f;
#pragma unroll
                for (int i = 0; i < 4; ++i) if (i != i1 && c4[i] > b2v) { b2v = c4[i]; i2 = i; }
                float w1v = 0.f, w2v = 0.f;
#pragma unroll
                for (int i = 0; i < 4; ++i) { if (i == i1) w1v = s4[i]; if (i == i2) w2v = s4[i]; }
                const float inv = 1.0f / (w1v + w2v);
                if (lane == 0) {
                    const int e1 = gi * 4 + i1, e2 = gi * 4 + i2;
                    toke[2 * r] = e1; toke[2 * r + 1] = e2; tokwW[2 * r] = w1v * inv; tokwW[2 * r + 1] = w2v * inv;
                    __hip_atomic_fetch_add(lcnt + e1, 1, __ATOMIC_RELAXED, __HIP_MEMORY_SCOPE_WORKGROUP);
                    __hip_atomic_fetch_add(lcnt + e2, 1, __ATOMIC_RELAXED, __HIP_MEMORY_SCOPE_WORKGROUP);
                }
            } else {
                float* gb = (float*)(k.ws + WS_GB);
                if ((lane & 1) == 0) {
                    if (n < 16) {
                        const float z = val + aux1[n];
                        const float ez = __expf(z); const float sp = z > 15.f ? z : (ez < 1e-4f ? ez - 0.5f * ez * ez : __logf(1.0f + ez));
                        gb[(size_t)r * 32 + n] = -expf(aux0[n]) * sp;
                    } else {
                        gb[(size_t)r * 32 + n] = 1.0f / (1.0f + expf(-val));
                    }
                }
            }
        }
    }
    if (MODE == 1) {
        __syncthreads();
        int* cnt = (int*)(k.ws + WS_CTL + CTL_CNT) + layer * 32;
        if (flush && tid < 32 && lcnt[tid] > 0) atomicAdd(&cnt[tid], lcnt[tid]);
    }
}

constexpr int NM_WLD = 1032;
template <int MODE>
PF void norm_mfma(const KC& k, int layer, bool first, bool combine, const float* __restrict__ gain, int mb, const float* __restrict__ Wsk, int ldw,
                  const float* __restrict__ aux0, const float* __restrict__ aux1, bool last, LAS unsigned char* lds, bool flush = true) {
    const int tid = TID(), lane = tid & 63, wave = __builtin_amdgcn_readfirstlane(tid >> 6), row = lane & 15, q = lane >> 4;
    LAS bf16_t* WtH = (LAS bf16_t*)lds; LAS bf16_t* WtL = WtH + 32 * NM_WLD;
    LAS float* red = (LAS float*)(WtL + 32 * NM_WLD);
    LAS float* lg = red + 128;
    LAS int* lcnt = (LAS int*)(lg + 8 * 16 * 32);
    float* xs = (float*)(k.ws + WS_XS);
    bf16_t* hbuf = (bf16_t*)(k.ws + AR_HBUF);
    const float* mod = (const float*)(k.ws + WS_MOD);
    const bf16_t* ys = (const bf16_t*)(k.ws + AR_YS);
    const int* tokp = (const int*)(k.ws + WS_TOKP); const float* tokw = (const float*)(k.ws + WS_TOKW);
    if (MODE == 1 && tid < 32) lcnt[tid] = 0;
    for (int idx = tid; idx < 1024 * 32; idx += NTHR) {
        const int kk = idx >> 5, n = idx & 31;
        const float w = Wsk[(size_t)kk * ldw + n]; const bf16_t hi = f2bf(w);
        WtH[n * NM_WLD + kk] = hi; WtL[n * NM_WLD + kk] = f2bf(w - bf2f(hi));
    }
    __syncthreads();
    const int cbase = 128 * wave + 8 * q;
    f32x4 xn[8];
    int bt = blockIdx.x;
    if (bt < T / 16) {
        const float* sb = first ? (16 * bt < TC ? k.ctx : k.x - (size_t)TC * 1024) : xs;
        const unsigned off = (unsigned)(16 * bt + row) * 1024u + (unsigned)cbase;
#pragma unroll
        for (int kk = 0; kk < 4; ++kk) { xn[2 * kk] = *(const f32x4*)(sb + off + 32 * kk); xn[2 * kk + 1] = *(const f32x4*)(sb + off + 32 * kk + 4); }
    }
    for (; bt < T / 16; bt += gridDim.x) {
        const int r = 16 * bt + row, mr = modrow(16 * bt);
        const unsigned roff = (unsigned)r * 1024u + (unsigned)cbase;
        float x[32];
#pragma unroll
        for (int i = 0; i < 8; ++i) { x[4 * i] = xn[i][0]; x[4 * i + 1] = xn[i][1]; x[4 * i + 2] = xn[i][2]; x[4 * i + 3] = xn[i][3]; }
        int p0 = 0, p1 = 0; float w0 = 0.f, w1 = 0.f;
        if (combine) { p0 = tokp[2 * r]; p1 = tokp[2 * r + 1]; w0 = tokw[2 * r]; w1 = tokw[2 * r + 1]; }
        {
            const int bn = bt + gridDim.x;
            if (bn < T / 16) {
                const float* sb = first ? (16 * bn < TC ? k.ctx : k.x - (size_t)TC * 1024) : xs;
                const unsigned off = (unsigned)(16 * bn + row) * 1024u + (unsigned)cbase;
#pragma unroll
                for (int kk = 0; kk < 4; ++kk) { xn[2 * kk] = *(const f32x4*)(sb + off + 32 * kk); xn[2 * kk + 1] = *(const f32x4*)(sb + off + 32 * kk + 4); }
            }
        }
        const float* shift = mod + ((size_t)(layer * 3 + mr) * 6 + mb) * 1024;
        if (combine) {
            const float* g5 = mod + ((size_t)((layer - 1) * 3 + mr) * 6 + 5) * 1024;
            u32x4 ya[4], yb[4]; float g5v[32];
#pragma unroll
            for (int kk = 0; kk < 4; ++kk) { ya[kk] = *(const u32x4*)(ys + (size_t)p0 * 1024 + cbase + 32 * kk); yb[kk] = *(const u32x4*)(ys + (size_t)p1 * 1024 + cbase + 32 * kk);
                const f32x4 ga = *(const f32x4*)(g5 + cbase + 32 * kk), gb2 = *(const f32x4*)(g5 + cbase + 32 * kk + 4);
#pragma unroll
                for (int e = 0; e < 4; ++e) { g5v[8 * kk + e] = ga[e]; g5v[8 * kk + 4 + e] = gb2[e]; } }
            asm volatile("" ::: "memory");
#pragma unroll
            for (int kk = 0; kk < 4; ++kk)
#pragma unroll
                for (int w = 0; w < 4; ++w) {
                    x[8 * kk + 2 * w] += g5v[8 * kk + 2 * w] * (w0 * __uint_as_float(ya[kk][w] << 16) + w1 * __uint_as_float(yb[kk][w] << 16));
                    x[8 * kk + 2 * w + 1] += g5v[8 * kk + 2 * w + 1] * (w0 * __uint_as_float(ya[kk][w] & 0xffff0000u) + w1 * __uint_as_float(yb[kk][w] & 0xffff0000u));
                }
        }
        if (first || combine) {
#pragma unroll
            for (int kk = 0; kk < 4; ++kk) {
                *(f32x4*)(xs + roff + 32 * kk) = (f32x4){x[8 * kk], x[8 * kk + 1], x[8 * kk + 2], x[8 * kk + 3]};
                *(f32x4*)(xs + roff + 32 * kk + 4) = (f32x4){x[8 * kk + 4], x[8 * kk + 5], x[8 * kk + 6], x[8 * kk + 7]};
            }
        }
        float ss = 0.f;
#pragma unroll
        for (int i = 0; i < 32; ++i) ss += x[i] * x[i];
        ss += shx(ss, 16, lane); ss += shx(ss, 32, lane);
        if (q == 0) red[wave * 16 + row] = ss;
        __syncthreads();
        float tot = 0.f;
#pragma unroll
        for (int w = 0; w < 8; ++w) tot += red[w * 16 + row];
        const float rstd = rsqrtf(tot * (1.0f / 1024.0f) + EPS);
        f32x4 acc[2]; acc[0] = (f32x4){0.f, 0.f, 0.f, 0.f}; acc[1] = (f32x4){0.f, 0.f, 0.f, 0.f};
#pragma unroll
        for (int kk = 0; kk < 4; ++kk) {
            float y[8]; u32x4 ah, al;
            {
                const unsigned co = (unsigned)cbase + 32u * kk;
                const f32x4 g0 = *(const f32x4*)(gain + co), g1 = *(const f32x4*)(gain + co + 4), s0 = *(const f32x4*)(shift + 1024 + co), s1 = *(const f32x4*)(shift + 1024 + co + 4),
                            h0 = *(const f32x4*)(shift + co), h1 = *(const f32x4*)(shift + co + 4);
#pragma unroll
                for (int e = 0; e < 4; ++e) { y[e] = x[8 * kk + e] * rstd * g0[e] * (1.0f + s0[e]) + h0[e]; y[4 + e] = x[8 * kk + 4 + e] * rstd * g1[e] * (1.0f + s1[e]) + h1[e]; }
            }
#pragma unroll
            for (int w = 0; w < 4; ++w) {
                ah[w] = pk2(y[2 * w], y[2 * w + 1]);
                al[w] = pk2(y[2 * w] - __uint_as_float(ah[w] << 16), y[2 * w + 1] - __uint_as_float(ah[w] & 0xffff0000u));
            }
            *(u32x4*)(hbuf + roff + 32 * kk) = ah;
            const bf16x8 fah = __builtin_bit_cast(bf16x8, ah), fal = __builtin_bit_cast(bf16x8, al);
            bf16x8 bh[2], bl[2];
#pragma unroll
            for (int nt = 0; nt < 2; ++nt) {
                bh[nt] = *(const LAS bf16x8*)(WtH + (16 * nt + row) * NM_WLD + cbase + 32 * kk);
                bl[nt] = *(const LAS bf16x8*)(WtL + (16 * nt + row) * NM_WLD + cbase + 32 * kk);
            }
            asm volatile("" ::: "memory");
#pragma unroll
            for (int nt = 0; nt < 2; ++nt) {
                acc[nt] = __builtin_amdgcn_mfma_f32_16x16x32_bf16(fah, bh[nt], acc[nt], 0, 0, 0);
                acc[nt] = __builtin_amdgcn_mfma_f32_16x16x32_bf16(fal, bh[nt], acc[nt], 0, 0, 0);
                acc[nt] = __builtin_amdgcn_mfma_f32_16x16x32_bf16(fah, bl[nt], acc[nt], 0, 0, 0);
            }
        }
#pragma unroll
        for (int nt = 0; nt < 2; ++nt)
#pragma unroll
            for (int j = 0; j < 4; ++j) lg[(wave * 16 + 4 * q + j) * 32 + 16 * nt + row] = acc[nt][j];
        __syncthreads();
        {
            const int prow = tid >> 5, n = tid & 31, rr = 16 * bt + prow, hb = lane & 32;
            float val = 0.f;
#pragma unroll
            for (int w = 0; w < 8; ++w) val += lg[(w * 16 + prow) * 32 + n];
            if (MODE == 1) {
                int* toke = (int*)(k.ws + WS_TOKE); float* tokwW = (float*)(k.ws + WS_TOKW);
                const bool unrouted = last && rr < TC;
                const float sc = 1.0f / (1.0f + expf(-val)), ch = sc + aux0[n];
                const int gl = hb + (n & ~3);
                const float ca = shi(ch, gl), cb = shi(ch, gl + 1), cc = shi(ch, gl + 2), cd = shi(ch, gl + 3);
                const float hi1 = fmaxf(ca, cb), lo1 = fminf(ca, cb), hi2 = fmaxf(cc, cd), lo2 = fminf(cc, cd);
                float gs = fmaxf(hi1, hi2) + fmaxf(fminf(hi1, hi2), fmaxf(lo1, lo2));
                int gi = n >> 2;
#pragma unroll
                for (int m = 4; m <= 16; m <<= 1) {
                    const float og = shx(gs, m, lane); const int oi = shii(gi, lane ^ m);
                    if (og > gs || (og == gs && oi < gi)) { gs = og; gi = oi; }
                }
                float c4[4], s4[4];
#pragma unroll
                for (int i = 0; i < 4; ++i) { c4[i] = shi(ch, hb + gi * 4 + i); s4[i] = shi(sc, hb + gi * 4 + i); }
                int i1 = 0; float b1v = c4[0];
#pragma unroll
                for (int i = 1; i < 4; ++i) if (c4[i] > b1v) { b1v = c4[i]; i1 = i; }
                int i2 = -1; float b2v = -1e30f;
#pragma unroll
                for (int i = 0; i < 4; ++i) if (i != i1 && c4[i] > b2v) { b2v = c4[i]; i2 = i; }
                float w1v = 0.f, w2v = 0.f;
#pragma unroll
                for (int i = 0; i < 4; ++i) { if (i == i1) w1v = s4[i]; if (i == i2) w2v = s4[i]; }
                const float inv = 1.0f / (w1v + w2v);
                if (n == 0) {
                    if (unrouted) { int neg = -1; asm volatile("" : "+v"(neg)); toke[2 * rr] = neg; toke[2 * rr + 1] = neg; }
                    else {
                        const int e1 = gi * 4 + i1, e2 = gi * 4 + i2;
                        toke[2 * rr] = e1; toke[2 * rr + 1] = e2; tokwW[2 * rr] = w1v * inv; tokwW[2 * rr + 1] = w2v * inv;
                        __hip_atomic_fetch_add(lcnt + e1, 1, __ATOMIC_RELAXED, __HIP_MEMORY_SCOPE_WORKGROUP);
                        __hip_atomic_fetch_add(lcnt + e2, 1, __ATOMIC_RELAXED, __HIP_MEMORY_SCOPE_WORKGROUP);
                    }
                }
            } else {
                float* gb = (float*)(k.ws + WS_GB);
                if (n < 16) {
                    const float z = val + aux1[n];
                    const float ez = __expf(z); const float sp = z > 15.f ? z : (ez < 1e-4f ? ez - 0.5f * ez * ez : __logf(1.0f + ez));
                    gb[(size_t)rr * 32 + n] = -expf(aux0[n]) * sp;
                } else {
                    gb[(size_t)rr * 32 + n] = 1.0f / (1.0f + expf(-val));
                }
            }
        }
        __syncthreads();
    }
    if (MODE == 1) {
        __syncthreads();
        int* cnt = (int*)(k.ws + WS_CTL + CTL_CNT) + layer * 32;
        if (flush && tid < 32 && lcnt[tid] > 0) atomicAdd(&cnt[tid], lcnt[tid]);
    }
}

namespace pg8 {
constexpr int BM = 256, BK = 64, HALF = 128, HTB = HALF * BK * 2, STAGE_BYTES = 8 * HTB;
DI int lds_byte(int r, int c) { const int st = (r >> 4) * 2 + (c >> 5), rr = r & 15, cc = c & 31, ob = rr * 64 + cc * 2; return st * 1024 + (ob ^ (((ob >> 9) & 1) << 5)); }
DI void stage_rc(int b, int& R, int& C) { const int st = b / 1024, sb = b % 1024, swz = sb ^ (((sb >> 9) & 1) << 5); R = (st >> 1) * 16 + swz / 64; C = (st & 1) * 32 + (swz % 64) / 2; }
DI int perm32(int rho) { const int n = rho >> 4, i = rho & 15; return 8 * (i >> 2) + 4 * n + (i & 3); }
struct Unit { int m0, mrows, pn; size_t boff; };
template <bool GATHER, class Epi, class Sched>
DI void gemm_phase(LAS unsigned char* lds, const bf16_t* A, const int* rowidx, const bf16_t* Bt, int K, const Sched& S, const Epi& E) {
    const int tid = TID(), wid = __builtin_amdgcn_readfirstlane(tid >> 6), lane = tid & 63, wr = wid >> 2, wc = wid & 3, fr = lane & 15, fq = lane >> 4;
    const int nt = K / BK;
    unsigned voffA[2], voffB[2];
#pragma unroll
    for (int i = 0; i < 2; ++i) { int R, C; stage_rc(tid * 16 + i * 8192, R, C); const int Rb = Epi::PERM ? ((R & ~31) + perm32(R & 31)) : R;
        voffA[i] = (unsigned)(R * K + C) * 2u; voffB[i] = (unsigned)(Rb * K + C) * 2u; }
    const size_t kstep = (size_t)(BK * 2);
    const size_t hstep = (size_t)HALF * K * 2;
    const size_t tstep = 2 * hstep;
    const size_t rstep = (size_t)K * 2;
    const unsigned ldsw = (unsigned)wid * 1024u;
    const int aoff = lds_byte(wr * 64 + fr, fq * 8), boff = lds_byte(wc * 32 + fr, fq * 8);
#define PG8_SA(b, h) (((b) * 2 + (h)) * HTB)
#define PG8_SB(b, h) ((4 + (b) * 2 + (h)) * HTB)
#define PG8_STAGE(bufoff, gbase, voff) do { _Pragma("unroll") for (int _i = 0; _i < 2; ++_i) \
        __builtin_amdgcn_global_load_lds((const unsigned*)((const char*)(gbase) + (voff)[_i]), (LAS unsigned*)(lds + (bufoff) + ldsw + _i * 8192), 16, 0, 0); } while (0)
#define PG8_STAGE_A(bufoff, p, h, vG) do { if (GATHER) PG8_STAGE(bufoff, p, (vG)[h]); else PG8_STAGE(bufoff, (p) + (h) * hstep, voffA); } while (0)
#define PG8_LDA(dst, b, h) do { _Pragma("unroll") for (int m = 0; m < 4; ++m) _Pragma("unroll") for (int k = 0; k < 2; ++k) dst[m][k] = *(const LAS bf16x8*)(lds + PG8_SA(b, h) + aoff + m * 2048 + k * 1024); } while (0)
#define PG8_LDB(dst, b, h) do { _Pragma("unroll") for (int n = 0; n < 2; ++n) _Pragma("unroll") for (int k = 0; k < 2; ++k) dst[n][k] = *(const LAS bf16x8*)(lds + PG8_SB(b, h) + boff + n * 2048 + k * 1024); } while (0)
#define PG8_MMA(ai, bj, At, Bt_) do { __builtin_amdgcn_s_setprio(1); _Pragma("unroll") for (int m = 0; m < 4; ++m) _Pragma("unroll") for (int n = 0; n < 2; ++n) _Pragma("unroll") for (int k = 0; k < 2; ++k) \
        acc[ai][bj][m][n] = __builtin_amdgcn_mfma_f32_16x16x32_bf16(Bt_[n][k], At[m][k], acc[ai][bj][m][n], 0, 0, 0); __builtin_amdgcn_s_setprio(0); } while (0)
#define PG8_WAIT_V(n) asm volatile("s_waitcnt vmcnt(" #n ")" ::: "memory")
#define PG8_WAIT_L(n) asm volatile("s_waitcnt lgkmcnt(" #n ")" ::: "memory")
#define PG8_BAR __builtin_amdgcn_s_barrier()
#define PG8_SCHED __builtin_amdgcn_sched_barrier(0)
#define PG8_AOFF(dst, u) do { _Pragma("unroll") for (int _h = 0; _h < 2; ++_h) _Pragma("unroll") for (int _i = 0; _i < 2; ++_i) { int _R, _C; stage_rc(tid * 16 + _i * 8192, _R, _C); \
        dst[_h][_i] = (unsigned)(rowidx[(u).m0 + _h * HALF + _R] * K + _C) * 2u; } } while (0)
    Unit cur, nxt; int ui = 0;
    if (!S.next(0, cur)) return;
    f32x4 acc[2][2][4][2];
#pragma unroll
    for (int a = 0; a < 2; ++a)
#pragma unroll
        for (int b = 0; b < 2; ++b)
#pragma unroll
            for (int m = 0; m < 4; ++m)
#pragma unroll
                for (int n = 0; n < 2; ++n) acc[a][b][m][n] = (f32x4){0.f, 0.f, 0.f, 0.f};
    bf16x8 At[4][2], B0[2][2], B1[2][2];
    unsigned vA[2][2], vN[2][2];
    if (GATHER) PG8_AOFF(vA, cur);
    const char* cA = (const char*)A + (GATHER ? (size_t)0 : (size_t)cur.m0 * rstep);
    const char* cB = (const char*)Bt + cur.boff + (size_t)cur.pn * tstep;
    PG8_STAGE(PG8_SB(0, 0), cB, voffB); PG8_STAGE_A(PG8_SA(0, 0), cA, 0, vA); PG8_STAGE(PG8_SB(0, 1), cB + hstep, voffB); PG8_STAGE_A(PG8_SA(0, 1), cA, 1, vA);
    if (wr == 1) PG8_BAR;
    PG8_WAIT_V(4); PG8_BAR;
    PG8_STAGE(PG8_SB(1, 0), cB + kstep, voffB); PG8_STAGE_A(PG8_SA(1, 0), cA + kstep, 0, vA); PG8_STAGE(PG8_SB(1, 1), cB + hstep + kstep, voffB);
    PG8_WAIT_V(6); PG8_BAR;
    for (;;) {
        const bool has_next = S.next(ui + 1, nxt);
        const char* nA = GATHER ? cA : (has_next ? (const char*)A + (size_t)nxt.m0 * rstep : cA);
        const char* nB = has_next ? (const char*)Bt + nxt.boff + (size_t)nxt.pn * tstep : cB;
        if (GATHER) {
            if (has_next) { PG8_AOFF(vN, nxt); }
            else {
#pragma unroll
                for (int h = 0; h < 2; ++h)
#pragma unroll
                    for (int i = 0; i < 2; ++i) vN[h][i] = vA[h][i];
            }
        }
        for (int t = 0; t < nt; t += 2) {
            const bool last = (t == nt - 2);
            const char* a1 = cA + (size_t)(t + 1) * kstep;
            const char* a2 = last ? nA : cA + (size_t)(t + 2) * kstep; const char* b2 = last ? nB : cB + (size_t)(t + 2) * kstep;
            const char* a3 = a2 + kstep; const char* b3 = b2 + kstep;
            PG8_LDB(B0, 0, 0); PG8_SCHED; PG8_LDA(At, 0, 0); PG8_STAGE_A(PG8_SA(1, 1), a1, 1, vA);
            if (GATHER && last) {
#pragma unroll
                for (int h = 0; h < 2; ++h)
#pragma unroll
                    for (int i = 0; i < 2; ++i) vA[h][i] = vN[h][i];
            }
            PG8_WAIT_L(8); PG8_BAR; PG8_WAIT_L(0); PG8_MMA(0, 0, At, B0); PG8_BAR; PG8_SCHED;
            PG8_LDB(B1, 0, 1); PG8_STAGE(PG8_SB(0, 0), b2, voffB);
            PG8_BAR; PG8_WAIT_L(0); PG8_MMA(0, 1, At, B1); PG8_BAR;
            PG8_LDA(At, 0, 1); PG8_STAGE_A(PG8_SA(0, 0), a2, 0, vA);
            PG8_BAR; PG8_WAIT_L(0); PG8_MMA(1, 0, At, B0); PG8_BAR; PG8_SCHED;
            PG8_STAGE(PG8_SB(0, 1), b2 + hstep, voffB);
            PG8_WAIT_V(6); PG8_BAR; PG8_MMA(1, 1, At, B1); PG8_BAR;
            PG8_LDB(B0, 1, 0); PG8_SCHED; PG8_LDA(At, 1, 0); PG8_STAGE_A(PG8_SA(0, 1), a2, 1, vA);
            PG8_WAIT_L(8); PG8_BAR; PG8_WAIT_L(0); PG8_MMA(0, 0, At, B0); PG8_BAR; PG8_SCHED;
            PG8_LDB(B1, 1, 1); PG8_STAGE(PG8_SB(1, 0), b3, voffB);
            PG8_BAR; PG8_WAIT_L(0); PG8_MMA(0, 1, At, B1); PG8_BAR;
            PG8_LDA(At, 1, 1); PG8_STAGE_A(PG8_SA(1, 0), a3, 0, vA);
            PG8_BAR; PG8_WAIT_L(0); PG8_MMA(1, 0, At, B0); PG8_BAR; PG8_SCHED;
            PG8_STAGE(PG8_SB(1, 1), b3 + hstep, voffB);
            PG8_WAIT_V(6); PG8_BAR; PG8_MMA(1, 1, At, B1); PG8_BAR;
        }
        { const int t2 = TID(), l2 = t2 & 63; E(acc, cur, wr, wc, l2 & 15, l2 >> 4); }
        if (!has_next) break;
#pragma unroll
        for (int a = 0; a < 2; ++a)
#pragma unroll
            for (int b = 0; b < 2; ++b)
#pragma unroll
                for (int m = 0; m < 4; ++m)
#pragma unroll
                    for (int n = 0; n < 2; ++n) acc[a][b][m][n] = (f32x4){0.f, 0.f, 0.f, 0.f};
        cur = nxt; cA = nA; cB = nB; ++ui;
    }
    PG8_WAIT_V(0);
    if (wr == 0) PG8_BAR;
    PG8_BAR;
#undef PG8_SA
#undef PG8_SB
#undef PG8_STAGE
#undef PG8_STAGE_A
#undef PG8_LDA
#undef PG8_LDB
#undef PG8_MMA
#undef PG8_WAIT_V
#undef PG8_WAIT_L
#undef PG8_BAR
#undef PG8_SCHED
#undef PG8_AOFF
}
struct DenseOrder {
    int nM, nN, nwg, G, c;
    DI void init(int M, int N, int G_, int c_) { nM = M / BM; nN = N / BM; nwg = nM * nN; G = G_; c = c_; }
    DI bool next(int i, Unit& u) const {
        const long L = (long)i * G + c; if (L >= nwg) return false;
        int wgid = (int)L; { const int q = nwg / 8, r = nwg % 8, xcd = wgid % 8, off = wgid / 8; wgid = (xcd < r ? xcd * (q + 1) : r * (q + 1) + (xcd - r) * q) + off; }
        const int nig = 8 * nN, gid = wgid / nig, fm = gid * 8, gsz = (nM - fm) < 8 ? (nM - fm) : 8;
        u.m0 = (fm + ((wgid % nig) % gsz)) * BM; u.mrows = BM; u.pn = (wgid % nig) / gsz; u.boff = 0; return true;
    }
};
struct MoeOrder {
    const LAS int* tb; int G, c; size_t estride; int lane;
    DI bool next(int i, Unit& u) const {
        const int L = i * G + c; if (L >= __builtin_amdgcn_readfirstlane(tb[97]) * 4) return false;
        const int tile = L >> 2;
        const int pre = tb[65 + (lane & 31)];
        const unsigned long long m = __ballot(lane < 32 && pre <= tile);
        const int e = __popcll(m) - 1;
        const int lt = tile - __builtin_amdgcn_readfirstlane(tb[65 + e]); int mr = __builtin_amdgcn_readfirstlane(tb[e]) - lt * 256; mr = mr > 256 ? 256 : mr;
        u.m0 = __builtin_amdgcn_readfirstlane(tb[32 + e]) + lt * 256; u.mrows = mr; u.pn = L & 3; u.boff = (size_t)e * estride; return true;
    }
};
}
struct EpiBf16 {
    static constexpr bool PERM = true;
    bf16_t* C; int ldc; int split_col; bf16_t* C2; int ldc2;
    DI void operator()(const f32x4 (&acc)[2][2][4][2], const pg8::Unit& u, int wr, int wc, int fr, int fq) const {
        int colt = u.pn * 256; bf16_t* base = C; int ld = ldc;
        if (colt >= split_col) { base = C2; ld = ldc2; colt -= split_col; }
#pragma unroll
        for (int ai = 0; ai < 2; ++ai)
#pragma unroll
            for (int m = 0; m < 4; ++m) {
                const int rl = ai * 128 + wr * 64 + m * 16 + fr;
                if (rl < u.mrows) {
                    bf16_t* rowp = base + (size_t)(u.m0 + rl) * ld + colt + wc * 32 + 8 * fq;
#pragma unroll
                    for (int bj = 0; bj < 2; ++bj) {
                        const f32x4 v0 = acc[ai][bj][m][0], v1 = acc[ai][bj][m][1];
                        u32x4 o; o[0] = cvt_pk_bf16(v0[0], v0[1]); o[1] = cvt_pk_bf16(v0[2], v0[3]); o[2] = cvt_pk_bf16(v1[0], v1[1]); o[3] = cvt_pk_bf16(v1[2], v1[3]);
                        *(u32x4*)(rowp + bj * 128) = o;
                    }
                }
            }
    }
};
struct EpiBf16T {
    static constexpr bool PERM = false;
    bf16_t* C; int ldc;
    DI void operator()(const f32x4 (&acc)[2][2][4][2], const pg8::Unit& u, int wr, int wc, int fr, int fq) const {
#pragma unroll
        for (int ai = 0; ai < 2; ++ai)
#pragma unroll
            for (int bj = 0; bj < 2; ++bj)
#pragma unroll
                for (int m = 0; m < 4; ++m)
#pragma unroll
                    for (int n = 0; n < 2; ++n) {
                        const int row = u.m0 + ai * 128 + wr * 64 + m * 16 + fr, col = u.pn * 256 + bj * 128 + wc * 32 + n * 16 + 4 * fq;
#pragma unroll
                        for (int e = 0; e < 4; ++e) C[(size_t)(col + e) * ldc + row] = f2bf(acc[ai][bj][m][n][e]);
                    }
    }
};
struct EpiTaps {
    static constexpr bool PERM = false;
    bf16_t* FT;
    DI void operator()(const f32x4 (&acc)[2][2][4][2], const pg8::Unit& u, int wr, int wc, int fr, int fq) const {
#pragma unroll
        for (int ai = 0; ai < 2; ++ai)
#pragma unroll
            for (int m = 0; m < 4; ++m) {
                const int row = u.m0 + ai * 128 + wr * 64 + m * 16 + fr; const float dl = hy_delta(row & 1023) * (1.0f / 16383.0f);
#pragma unroll
                for (int bj = 0; bj < 2; ++bj)
#pragma unroll
                    for (int n = 0; n < 2; ++n) {
                        const int l = u.pn * 256 + bj * 128 + wc * 32 + n * 16 + 4 * fq; float o[4];
#pragma unroll
                        for (int e = 0; e < 4; ++e) o[e] = acc[ai][bj][m][n][e] * __expf(-(float)(l + e) * dl);
                        u32x2 pk; pk[0] = pk2(o[0], o[1]); pk[1] = pk2(o[2], o[3]);
                        *(u32x2*)(FT + (size_t)row * 16384 + l) = pk;
                    }
            }
    }
};
struct EpiResid {
    static constexpr bool PERM = false;
    float* xs; const float* mod; int layer; int chunk;
    DI void operator()(const f32x4 (&acc)[2][2][4][2], const pg8::Unit& u, int wr, int wc, int fr, int fq) const {
        const float* g = mod + ((size_t)(layer * 3 + modrow(u.m0)) * 6 + chunk) * 1024;
#pragma unroll
        for (int bj = 0; bj < 2; ++bj)
#pragma unroll
            for (int n = 0; n < 2; ++n) {
                const int col = u.pn * 256 + bj * 128 + wc * 32 + n * 16 + 4 * fq; const f32x4 gv = *(const f32x4*)(g + col);
                float* p0 = xs + (size_t)(u.m0 + wr * 64 + fr) * 1024 + col;
                f32x4 old[8];
#pragma unroll
                for (int ai = 0; ai < 2; ++ai)
#pragma unroll
                    for (int m = 0; m < 4; ++m) old[ai * 4 + m] = *(const f32x4*)(p0 + (size_t)(ai * 128 + m * 16) * 1024);
                asm volatile("" ::: "memory");
#pragma unroll
                for (int ai = 0; ai < 2; ++ai)
#pragma unroll
                    for (int m = 0; m < 4; ++m) *(f32x4*)(p0 + (size_t)(ai * 128 + m * 16) * 1024) = old[ai * 4 + m] + gv * acc[ai][bj][m][n];
            }
    }
};
struct EpiGateUp {
    static constexpr bool PERM = false;
    bf16_t* hid;
    DI void operator()(const f32x4 (&acc)[2][2][4][2], const pg8::Unit& u, int wr, int wc, int fr, int fq) const {
#pragma unroll
        for (int ai = 0; ai < 2; ++ai)
#pragma unroll
            for (int m = 0; m < 4; ++m) {
                const int rl = ai * 128 + wr * 64 + m * 16 + fr;
                if (rl < u.mrows) {
#pragma unroll
                    for (int bj = 0; bj < 2; ++bj) {
                        const int hc = ((u.pn * 256 + bj * 128 + wc * 32) >> 1) + 4 * fq;
                        const f32x4 g = acc[ai][bj][m][0], up = acc[ai][bj][m][1];
                        u32x2 o; o[0] = cvt_pk_bf16(siluf(g[0]) * up[0], siluf(g[1]) * up[1]); o[1] = cvt_pk_bf16(siluf(g[2]) * up[2], siluf(g[3]) * up[3]);
                        *(u32x2*)(hid + (size_t)(u.m0 + rl) * 512 + hc) = o;
                    }
                }
            }
    }
};
template <class Epi>
PF void gemm_dense(LAS unsigned char* lds, const bf16_t* A, int M, const bf16_t* Bt, int N, int K, const Epi& epi) {
    pg8::DenseOrder S; S.init(M, N, (int)gridDim.x, (int)blockIdx.x);
    pg8::gemm_phase<false>(lds, A, (const int*)nullptr, Bt, K, S, epi);
}
DI void moe_table(const KC& k, int layer, LAS int* tb) {
    const int* cnt = (const int*)(k.ws + WS_CTL + CTL_CNT) + layer * 32;
    __syncthreads();
    const int tq = TID();
    if (tq < 32) tb[tq] = __hip_atomic_load(cnt + tq, __ATOMIC_RELAXED, __HIP_MEMORY_SCOPE_AGENT);
    __syncthreads();
    if (tq == 0) {
        int s = 0, tp = 0;
        for (int e = 0; e < 32; ++e) { tb[32 + e] = s; tb[65 + e] = tp; s += tb[e]; tp += (tb[e] + 255) >> 8; }
        tb[64] = s; tb[97] = tp;
    }
    __syncthreads();
}
template <int WHICH>
PF void moe_gemm(const KC& k, int layer, LAS unsigned char* lds, LAS int* tb) {
    moe_table(k, layer, tb);
    if (WHICH == 0) {
        pg8::MoeOrder S{tb, (int)gridDim.x, (int)blockIdx.x, (size_t)1024 * 1024 * 2, TID() & 63};
        EpiGateUp epi{(bf16_t*)(k.ws + AR_HID)};
        pg8::gemm_phase<true>(lds, (const bf16_t*)(k.ws + AR_HBUF), (const int*)(k.ws + WS_SLOT), (const bf16_t*)(k.ws + AR_WGU), 1024, S, epi);
    } else {
        pg8::MoeOrder S{tb, (int)gridDim.x, (int)blockIdx.x, (size_t)1024 * 512 * 2, TID() & 63};
        EpiBf16 epi{(bf16_t*)(k.ws + AR_YS), 1024, 1 << 30, nullptr, 0};
        pg8::gemm_phase<false>(lds, (const bf16_t*)(k.ws + AR_HID), (const int*)nullptr, (const bf16_t*)(k.ws + AR_WD), 512, S, epi);
    }
}
PF void moe_scatter(const KC& k, int layer, LAS int* tb) {
    moe_table(k, layer, tb);
    const int* toke = (const int*)(k.ws + WS_TOKE);
    int* tokp = (int*)(k.ws + WS_TOKP); int* slot = (int*)(k.ws + WS_SLOT);
    int* cur = (int*)(k.ws + WS_CTL + CTL_CNT) + 128 + layer * 32;
    LAS int* lc = tb + 128; LAS int* lb = tb + 160;
    const int tid = TID();
    if (blockIdx.x == 0 && tid < 256) slot[NA + tid] = 0;
    for (int r0 = blockIdx.x * NTHR; r0 < T; r0 += gridDim.x * NTHR) {
        const int r = r0 + tid;
        __syncthreads();
        if (tid < 32) lc[tid] = 0;
        __syncthreads();
        const int e0 = toke[2 * r], e1 = toke[2 * r + 1];
        int k0 = 0, k1 = 0;
        if (e0 >= 0) { k0 = __hip_atomic_fetch_add(lc + e0, 1, __ATOMIC_RELAXED, __HIP_MEMORY_SCOPE_WORKGROUP); k1 = __hip_atomic_fetch_add(lc + e1, 1, __ATOMIC_RELAXED, __HIP_MEMORY_SCOPE_WORKGROUP); }
        __syncthreads();
        if (tid < 32) lb[tid] = lc[tid] > 0 ? atomicAdd(&cur[tid], lc[tid]) : 0;
        __syncthreads();
        if (e0 >= 0) {
            const int p0 = tb[32 + e0] + lb[e0] + k0, p1 = tb[32 + e1] + lb[e1] + k1;
            slot[p0] = r; slot[p1] = r; tokp[2 * r] = p0; tokp[2 * r + 1] = p1;
        }
    }
}

DI void unpack8(const u32x4 v, float (&f)[8]) {
#pragma unroll
    for (int w = 0; w < 4; ++w) { f[2 * w] = __uint_as_float(v[w] << 16); f[2 * w + 1] = __uint_as_float(v[w] & 0xffff0000u); }
}
PF void sc_mix(const KC& k, int j) {
    const int tid = TID(), lane = tid & 63, wave = tid >> 6;
    const bf16_t* P = (const bf16_t*)(k.ws + AR_PB);
    bf16_t* U = (bf16_t*)(k.ws + AR_UBUF);
    const float* cw = k.sc_conv + (size_t)j * 3 * 1024;
    const int c0 = lane * 16;
    float k0[16], k1[16], k2[16];
#pragma unroll
    for (int e = 0; e < 16; ++e) { k0[e] = cw[c0 + e]; k1[e] = cw[1024 + c0 + e]; k2[e] = cw[2048 + c0 + e]; }
    for (int r = blockIdx.x * 8 + wave; r < T; r += gridDim.x * 8) {
        bool lok, rok;
        if (r < TC) { const int t = r & 255; lok = t != 0; rok = t != 255; } else { const int t = (r - TC) & 63; lok = t != 0; rok = t != 63; }
        const bf16_t* p = P + (size_t)r * 3072 + c0;
        const bf16_t* pl = lok ? p - 3072 : p; const bf16_t* pr = rok ? p + 3072 : p;
        u32x4 vb[2], vc[2], vx[2], vcl[2], vxl[2], vcr[2], vxr[2];
#pragma unroll
        for (int hh = 0; hh < 2; ++hh) {
            vb[hh] = *(const u32x4*)(p + hh * 8); vc[hh] = *(const u32x4*)(p + 1024 + hh * 8); vx[hh] = *(const u32x4*)(p + 2048 + hh * 8);
            vcl[hh] = *(const u32x4*)(pl + 1024 + hh * 8); vxl[hh] = *(const u32x4*)(pl + 2048 + hh * 8);
            vcr[hh] = *(const u32x4*)(pr + 1024 + hh * 8); vxr[hh] = *(const u32x4*)(pr + 2048 + hh * 8);
        }
        asm volatile("" ::: "memory");
        const float fl = lok ? 1.f : 0.f, frr = rok ? 1.f : 0.f;
#pragma unroll
        for (int hh = 0; hh < 2; ++hh) {
            float bg[8], cg[8], xi[8], cl[8], xl[8], cr[8], xr[8];
            unpack8(vb[hh], bg); unpack8(vc[hh], cg); unpack8(vx[hh], xi); unpack8(vcl[hh], cl); unpack8(vxl[hh], xl); unpack8(vcr[hh], cr); unpack8(vxr[hh], xr);
            u32x4 o;
#pragma unroll
            for (int w = 0; w < 4; ++w) {
                float ov[2];
#pragma unroll
                for (int e = 0; e < 2; ++e) { const int i = 2 * w + e, c = hh * 8 + i; ov[e] = bg[i] * (k0[c] * fl * cl[i] * xl[i] + k1[c] * cg[i] * xi[i] + k2[c] * frr * cr[i] * xr[i]); }
                o[w] = pk2(ov[0], ov[1]);
            }
            *(u32x4*)(U + (size_t)r * 1024 + c0 + hh * 8) = o;
        }
    }
}

constexpr int DN_STEPS = 260, DN_UNITS = 32 * DN_STEPS;
DI int dn_rbase(int b, int dir, int s) {
    if (s < 4) return dir == 0 ? b * 256 + s * 64 : b * 256 + 255 - s * 64;
    const int cc = s - 4;
    return dir == 0 ? TC + b * SEQ + cc * 64 : TC + b * SEQ + SEQ - 1 - cc * 64;
}
struct DnRaw { u32x4 c[3][2], l[3][2], r[3][2]; float g, be; };
DI void dn_raw_load(const bf16_t* P, const float* gb, int u, int tid, DnRaw& R) {
    const int chain = u / DN_STEPS, s = u - chain * DN_STEPS, dir = chain & 1, h = (chain >> 1) & 7, b = chain >> 4;
    const int rbase = dn_rbase(b, dir, s), rstep = dir == 0 ? 1 : -1;
    const int i = tid >> 3, sg = tid & 7, r = rbase + rstep * i;
    bool lok, rok;
    if (r < TC) { const int t = r & 255; lok = t != 0; rok = t != 255; } else { const int t = (r - TC) & 63; lok = t != 0; rok = t != 63; }
#pragma unroll
    for (int part = 0; part < 3; ++part) {
        const bf16_t* pc = P + (size_t)r * 3072 + part * 1024 + h * 128 + sg * 16;
#pragma unroll
        for (int hf = 0; hf < 2; ++hf) {
            R.c[part][hf] = *(const u32x4*)(pc + hf * 8);
            R.l[part][hf] = (u32x4){0u, 0u, 0u, 0u}; R.r[part][hf] = (u32x4){0u, 0u, 0u, 0u};
            if (lok) R.l[part][hf] = *(const u32x4*)(pc - 3072 + hf * 8);
            if (rok) R.r[part][hf] = *(const u32x4*)(pc + 3072 + hf * 8);
        }
    }
    if (tid < 64) { const size_t row = (size_t)(rbase + rstep * tid); R.g = gb[row * 32 + dir * 8 + h]; R.be = gb[row * 32 + 16 + dir * 8 + h]; }
}
PF void dn_chunk(const KC& k, int jl, LAS unsigned char* lds) {
    const int tid = TID(), lane = tid & 63, wave = tid >> 6, fr = lane & 15, fq = lane >> 4;
    LAS bf16_t* Kt = (LAS bf16_t*)lds;
    LAS bf16_t* Qt = Kt + 64 * 136;
    LAS bf16_t* Vt = Qt + 64 * 136;
    LAS float* Amat = (LAS float*)(Vt + 64 * 136);
    LAS bf16_t* Tb = (LAS bf16_t*)(Amat + 64 * 64);
    LAS bf16_t* VbT = Tb + 64 * 72;
    LAS bf16_t* KbT = VbT + 128 * 72;
    LAS float* gcs = (LAS float*)(KbT + 128 * 72);
    LAS float* bet = gcs + 64; LAS float* eg = bet + 64; LAS float* egr = eg + 64;
    LAS float* Tm = egr + 64;
    const bf16_t* P = (const bf16_t*)(k.ws + AR_PB);
    const float* gb = (const float*)(k.ws + WS_GB);
    const float* cw = k.dn_conv + (size_t)jl * 3 * 3072;
    bf16_t* CH = (bf16_t*)(k.ws + AR_CHUNK);
    bf16_t* ATT = (bf16_t*)(k.ws + AR_HBUF);
    float* EGL = (float*)(k.ws + WS_EGL);
    for (int u = blockIdx.x; u < DN_UNITS; u += gridDim.x) {
        DnRaw Rn; dn_raw_load(P, gb, u, tid, Rn);
        const int chain = u / DN_STEPS, s = u - chain * DN_STEPS, dir = chain & 1, h = (chain >> 1) & 7, b = chain >> 4;
        const int rbase = dn_rbase(b, dir, s), rstep = dir == 0 ? 1 : -1;
        bf16_t* cW = CH + (size_t)u * 32768; bf16_t* cQd = cW + 8192; bf16_t* cKd = cQd + 8192; bf16_t* cU = cKd + 8192;
        bf16_t* cAt = ATT + (size_t)u * 4096;
        lds_barrier();
        const float g_in = Rn.g, be_in = Rn.be;
        {
            const int i = tid >> 3, sg = tid & 7;
#pragma unroll
            for (int part = 0; part < 3; ++part) {
                const int col = part * 1024 + h * 128 + sg * 16;
                float v[16];
#pragma unroll
                for (int hf = 0; hf < 2; ++hf) {
                    const u32x4 c4 = Rn.c[part][hf], l4 = Rn.l[part][hf], r4 = Rn.r[part][hf];
#pragma unroll
                    for (int w2 = 0; w2 < 2; ++w2) {
                        const int cc = col + hf * 8 + 4 * w2;
                        const f32x4 k0 = *(const f32x4*)(cw + cc), k1 = *(const f32x4*)(cw + 3072 + cc), k2 = *(const f32x4*)(cw + 6144 + cc);
#pragma unroll
                        for (int e = 0; e < 4; ++e) {
                            const int w = 2 * w2 + (e >> 1);
                            const float lv = __uint_as_float((e & 1) ? (l4[w] & 0xffff0000u) : (l4[w] << 16));
                            const float cv = __uint_as_float((e & 1) ? (c4[w] & 0xffff0000u) : (c4[w] << 16));
                            const float rv = __uint_as_float((e & 1) ? (r4[w] & 0xffff0000u) : (r4[w] << 16));
                            v[hf * 8 + 4 * w2 + e] = siluf(k0[e] * lv + k1[e] * cv + k2[e] * rv);
                        }
                    }
                }
                if (part < 2) {
                    float ss = 0.f;
#pragma unroll
                    for (int e = 0; e < 16; ++e) ss += v[e] * v[e];
                    ss += shx(ss, 1, lane); ss += shx(ss, 2, lane); ss += shx(ss, 4, lane);
                    const float sc = rsqrtf(ss + EPS) * (part == 0 ? 0.08838834764831845f : 1.0f);
#pragma unroll
                    for (int e = 0; e < 16; ++e) v[e] *= sc;
                }
                LAS bf16_t* dst = (part == 0 ? Qt : (part == 1 ? Kt : Vt)) + i * 136 + sg * 16;
                u32x4 o0, o1;
#pragma unroll
                for (int w = 0; w < 4; ++w) { o0[w] = pk2(v[2 * w], v[2 * w + 1]); o1[w] = pk2(v[8 + 2 * w], v[8 + 2 * w + 1]); }
                *(LAS u32x4*)dst = o0; *(LAS u32x4*)(dst + 8) = o1;
            }
        }
        if (wave == 0) {
            float g = g_in;
            const float be = be_in;
#pragma unroll
            for (int d = 1; d < 64; d <<= 1) { const float o = shi(g, (lane - d) & 63); if (lane >= d) g += o; }
            const float glast = shi(g, 63);
            gcs[lane] = g; bet[lane] = be; eg[lane] = expf(g); egr[lane] = expf(glast - g);
            if (lane == 0) EGL[u] = expf(glast);
        }
        lds_barrier();
#pragma unroll 1
        for (int x = 0; x < 4; ++x) {
            const int t = wave + 8 * x, isq = t >> 4, mt = (t >> 2) & 3, nt = t & 3;
            f32x4 acc = (f32x4){0.f, 0.f, 0.f, 0.f};
            const int jc = 16 * nt + fr;
            float gi4[4], bi4[4];
            const float gj = gcs[jc];
#pragma unroll
            for (int jj = 0; jj < 4; ++jj) { gi4[jj] = gcs[16 * mt + 4 * fq + jj]; bi4[jj] = bet[16 * mt + 4 * fq + jj]; }
            if (mt >= nt) {
                const LAS bf16_t* Ar = (isq ? Qt : Kt) + (16 * mt + fr) * 136 + 8 * fq;
                const LAS bf16_t* Br = Kt + (16 * nt + fr) * 136 + 8 * fq;
                bf16x8 fa4[4], fb4[4];
#pragma unroll
                for (int ks = 0; ks < 4; ++ks) { fa4[ks] = *(const LAS bf16x8*)(Ar + 32 * ks); fb4[ks] = *(const LAS bf16x8*)(Br + 32 * ks); }
                asm volatile("" ::: "memory");
#pragma unroll
                for (int ks = 0; ks < 4; ++ks) acc = __builtin_amdgcn_mfma_f32_16x16x32_bf16(fa4[ks], fb4[ks], acc, 0, 0, 0);
            }
#pragma unroll
            for (int jj = 0; jj < 4; ++jj) {
                const int ir = 16 * mt + 4 * fq + jj;
                const float dec = __expf(fminf(gi4[jj] - gj, 0.f));
                if (isq) cAt[ir * 64 + jc] = f2bf(ir >= jc ? acc[jj] * dec : 0.f);
                else Amat[ir * 64 + jc] = ir > jc ? bi4[jj] * acc[jj] * dec : 0.f;
            }
        }
        lds_barrier();
        {
        if (wave < 4) {
            if (lane < 16) {
                const int bo = 16 * wave;
                float tc[16];
#pragma unroll
                for (int i = 0; i < 16; ++i) {
                    f32x4 ar[4];
#pragma unroll
                    for (int q = 0; q < (i + 3) / 4; ++q) ar[q] = *(const LAS f32x4*)(Amat + (bo + i) * 64 + bo + 4 * q);
                    float a0 = (i == lane) ? 1.f : 0.f, a1 = 0.f;
#pragma unroll
                    for (int j = 0; j < i; ++j) { const float av = ar[j >> 2][j & 3]; if (j & 1) a1 -= av * tc[j]; else a0 -= av * tc[j]; }
                    tc[i] = a0 + a1;
                    Tm[(bo + i) * 64 + bo + lane] = tc[i];
                }
            }
        } else {
            for (int it = tid - 256; it < 1024; it += 256) {
                const int c = it & 127, ig = it >> 7;
                float kv[8], vv[8];
                { bf16_t kr[8], vr[8];
#pragma unroll
                  for (int e = 0; e < 8; ++e) { kr[e] = Kt[(8 * ig + e) * 136 + c]; vr[e] = Vt[(8 * ig + e) * 136 + c]; }
                  asm volatile("" ::: "memory");
#pragma unroll
                  for (int e = 0; e < 8; ++e) { kv[e] = bf2f(kr[e]); vv[e] = bf2f(vr[e]); } }
                u32x4 ov, ok, od;
#pragma unroll
                for (int w = 0; w < 4; ++w) {
                    const int i0 = 8 * ig + 2 * w, i1 = i0 + 1;
                    ov[w] = pk2(bet[i0] * vv[2 * w], bet[i1] * vv[2 * w + 1]);
                    ok[w] = pk2(bet[i0] * eg[i0] * kv[2 * w], bet[i1] * eg[i1] * kv[2 * w + 1]);
                    od[w] = pk2(egr[i0] * kv[2 * w], egr[i1] * kv[2 * w + 1]);
                }
                *(LAS u32x4*)(VbT + c * 72 + 8 * ig) = ov;
                *(LAS u32x4*)(KbT + c * 72 + 8 * ig) = ok;
                *(u32x4*)(cKd + c * 64 + 8 * ig) = od;
            }
            for (int it = tid - 256; it < 1024; it += 256) {
                const int i = it >> 4, c8 = (it & 15) * 8; const float e = eg[i];
                const u32x4 qv = *(const LAS u32x4*)(Qt + i * 136 + c8); u32x4 o;
#pragma unroll
                for (int w = 0; w < 4; ++w) o[w] = pk2(__uint_as_float(qv[w] << 16) * e, __uint_as_float(qv[w] & 0xffff0000u) * e);
                *(u32x4*)(cQd + i * 128 + c8) = o;
            }
        }
        lds_barrier();
#pragma unroll 1
        for (int d = 1; d < 4; ++d) {
            if (wave < 4 - d) {
                const int bi = wave + d, bj = wave, r = lane >> 2, c0 = 4 * (lane & 3);
                f32x4 m = (f32x4){0.f, 0.f, 0.f, 0.f};
                for (int kb = bj; kb < bi; ++kb) {
                    f32x4 av4[4], tv[16];
#pragma unroll
                    for (int q = 0; q < 4; ++q) av4[q] = *(const LAS f32x4*)(Amat + (16 * bi + r) * 64 + 16 * kb + 4 * q);
#pragma unroll
                    for (int kk = 0; kk < 16; ++kk) tv[kk] = *(const LAS f32x4*)(Tm + (16 * kb + kk) * 64 + 16 * bj + c0);
                    asm volatile("" ::: "memory");
#pragma unroll
                    for (int kk = 0; kk < 16; ++kk) m += tv[kk] * av4[kk >> 2][kk & 3];
                }
                *(LAS f32x4*)(Tm + (16 * bj + r) * 64 + 16 * bi + c0) = m;
                f32x4 t = (f32x4){0.f, 0.f, 0.f, 0.f};
                {
                    f32x4 dv4[4], mv[16];
#pragma unroll
                    for (int q = 0; q < 4; ++q) dv4[q] = *(const LAS f32x4*)(Tm + (16 * bi + r) * 64 + 16 * bi + 4 * q);
#pragma unroll
                    for (int kk = 0; kk < 16; ++kk) mv[kk] = *(const LAS f32x4*)(Tm + (16 * bj + kk) * 64 + 16 * bi + c0);
                    asm volatile("" ::: "memory");
#pragma unroll
                    for (int kk = 0; kk < 16; ++kk) t -= mv[kk] * dv4[kk >> 2][kk & 3];
                }
                *(LAS f32x4*)(Tm + (16 * bi + r) * 64 + 16 * bj + c0) = t;
            }
            lds_barrier();
        }
        for (int it = tid; it < 64 * 8; it += NTHR) {
            const int i = it >> 3, c8 = (it & 7) * 8; u32x4 o;
#pragma unroll
            for (int w = 0; w < 4; ++w) {
                const int c = c8 + 2 * w;
                o[w] = pk2(c <= i ? Tm[i * 64 + c] : 0.f, c + 1 <= i ? Tm[i * 64 + c + 1] : 0.f);
            }
            *(LAS u32x4*)(Tb + i * 72 + c8) = o;
        }
        }
        lds_barrier();
        {
            f32x4 au[4], aw[4];
#pragma unroll
            for (int mt = 0; mt < 4; ++mt) { au[mt] = (f32x4){0.f, 0.f, 0.f, 0.f}; aw[mt] = (f32x4){0.f, 0.f, 0.f, 0.f}; }
            bf16x8 bv[2], bk[2], at[2][4];
#pragma unroll
            for (int ks = 0; ks < 2; ++ks) {
                bv[ks] = *(const LAS bf16x8*)(VbT + (16 * wave + fr) * 72 + 32 * ks + 8 * fq);
                bk[ks] = *(const LAS bf16x8*)(KbT + (16 * wave + fr) * 72 + 32 * ks + 8 * fq);
#pragma unroll
                for (int mt = 0; mt < 4; ++mt) at[ks][mt] = *(const LAS bf16x8*)(Tb + (16 * mt + fr) * 72 + 32 * ks + 8 * fq);
            }
            asm volatile("" ::: "memory");
#pragma unroll
            for (int ks = 0; ks < 2; ++ks)
#pragma unroll
                for (int mt = 0; mt < 4; ++mt) {
                    au[mt] = __builtin_amdgcn_mfma_f32_16x16x32_bf16(at[ks][mt], bv[ks], au[mt], 0, 0, 0);
                    aw[mt] = __builtin_amdgcn_mfma_f32_16x16x32_bf16(at[ks][mt], bk[ks], aw[mt], 0, 0, 0);
                }
#pragma unroll
            for (int mt = 0; mt < 4; ++mt)
#pragma unroll
                for (int jj = 0; jj < 4; ++jj) {
                    const int ir = 16 * mt + 4 * fq + jj, c = 16 * wave + fr;
                    cU[ir * 128 + c] = f2bf(au[mt][jj]); cW[ir * 128 + c] = f2bf(aw[mt][jj]);
                }
        }
    }
}
constexpr int SC_W = 0, SC_QD = 64 * 136, SC_KD = SC_QD + 64 * 136, SC_AT = SC_KD + 128 * 72, SC_U = SC_AT + 64 * 72, SC_EGL = SC_U + 16 * 72, SC_STAGE = SC_EGL + 8;
struct ScanRegs { u32x4 v[8]; u32x4 u[2]; };
DI void dn_scan_fetch(const bf16_t* CH, const bf16_t* ATT, int u, int sl, int wv, int lane, ScanRegs& R) {
    const bf16_t* cW = CH + (size_t)u * 32768;
    const bf16_t* src = (wv < 6) ? cW + wv * 4096 + lane * 8 : ATT + (size_t)u * 4096 + lane * 8;
#pragma unroll
    for (int q = 0; q < 8; ++q) R.v[q] = *(const u32x4*)(src + q * 512);
    if (wv == 6) {
#pragma unroll
        for (int qq = 0; qq < 2; ++qq) { const int pid = lane + 64 * qq; R.u[qq] = *(const u32x4*)(cW + 24576 + (pid >> 1) * 128 + sl * 16 + (pid & 1) * 8); }
    }
}
DI void dn_scan_put(LAS bf16_t* st, int wv, int lane, const ScanRegs& R) {
    LAS bf16_t* dst; int qs;
    if (wv < 4) { dst = st + ((wv < 2) ? SC_W : SC_QD) + ((wv & 1) * 32 + (lane >> 4)) * 136 + (lane & 15) * 8; qs = 544; }
    else if (wv < 6) { dst = st + SC_KD + ((wv - 4) * 64 + (lane >> 3)) * 72 + (lane & 7) * 8; qs = 576; }
    else { dst = st + SC_AT + (lane >> 3) * 72 + (lane & 7) * 8; qs = 576; }
#pragma unroll
    for (int q = 0; q < 8; ++q) *(LAS u32x4*)(dst + q * qs) = R.v[q];
    if (wv == 6) {
#pragma unroll
        for (int qq = 0; qq < 2; ++qq) { const int pid = lane + 64 * qq, i = pid >> 1, hf = pid & 1;
#pragma unroll
            for (int w = 0; w < 4; ++w) { st[SC_U + (hf * 8 + 2 * w) * 72 + i] = (bf16_t)(R.u[qq][w] & 0xffff); st[SC_U + (hf * 8 + 2 * w + 1) * 72 + i] = (bf16_t)(R.u[qq][w] >> 16); } }
    }
}
DI bf16x8 ld2(const LAS bf16_t* p0, const LAS bf16_t* p1) {
    const u32x2 a = *(const LAS u32x2*)p0, b = *(const LAS u32x2*)p1;
    u32x4 r; r[0] = a[0]; r[1] = a[1]; r[2] = b[0]; r[3] = b[1];
    return __builtin_bit_cast(bf16x8, r);
}
DI bf16x8 pk8(f32x4 a, f32x4 b) { u32x4 r; r[0] = pk2(a[0], a[1]); r[1] = pk2(a[2], a[3]); r[2] = pk2(b[0], b[1]); r[3] = pk2(b[2], b[3]); return __builtin_bit_cast(bf16x8, r); }
PF void dn_scan(const KC& k, LAS unsigned char* lds) {
    const int tid = TID(), lane = tid & 63, wave = tid >> 6, fr = lane & 15, fq = lane >> 4;
    LAS bf16_t* ring = (LAS bf16_t*)lds;
    const bf16_t* CH = (const bf16_t*)(k.ws + AR_CHUNK);
    const bf16_t* ATT = (const bf16_t*)(k.ws + AR_HBUF);
    const float* EGL = (const float*)(k.ws + WS_EGL);
    bf16_t* O = (bf16_t*)(k.ws + AR_PB);
    for (int un0 = blockIdx.x; un0 < 256; un0 += gridDim.x) {
        const int un = (gridDim.x == 256) ? ((un0 & 7) * 32 + (un0 >> 3)) : un0;
        const int sl = un & 7, chain = un >> 3, dir = chain & 1, h = (chain >> 1) & 7, b = chain >> 4;
        const int rstep = dir == 0 ? 1 : -1;
        f32x4 S[8];
#pragma unroll
        for (int t = 0; t < 8; ++t) S[t] = (f32x4){0.f, 0.f, 0.f, 0.f};
        LAS float* eglL = (LAS float*)(ring + 2 * SC_STAGE);
        constexpr int NPF = 1;
        ScanRegs R[NPF];
        const int wv = wave - 1;
        lds_barrier();
        if (tid < DN_STEPS) eglL[tid] = EGL[chain * DN_STEPS + tid];
        if (wave > 0) {
            dn_scan_fetch(CH, ATT, chain * DN_STEPS, sl, wv, lane, R[0]); dn_scan_put(ring, wv, lane, R[0]);
#pragma unroll
            for (int q = 0; q < NPF; ++q) dn_scan_fetch(CH, ATT, chain * DN_STEPS + q + 1, sl, wv, lane, R[q]);
        }
        lds_barrier();
#pragma unroll 1
        for (int s4 = 0; s4 < DN_STEPS; s4 += NPF) {
#pragma unroll
          for (int q = 0; q < NPF; ++q) {
            const int s = s4 + q; if (s >= DN_STEPS) break;
            LAS bf16_t* st = ring + (s & 1) * SC_STAGE;
            if (wave > 0) {
                if (s + 1 < DN_STEPS) dn_scan_put(ring + ((s + 1) & 1) * SC_STAGE, wv, lane, R[q]);
                if (s + 1 + NPF < DN_STEPS) dn_scan_fetch(CH, ATT, chain * DN_STEPS + s + 1 + NPF, sl, wv, lane, R[q]);
            } else {
                const float egl = eglL[s];
                bf16x8 sb[4];
#pragma unroll
                for (int ks = 0; ks < 4; ++ks) sb[ks] = pk8(S[2 * ks], S[2 * ks + 1]);
                f32x4 p[4], o[4];
#pragma unroll
                for (int mt = 0; mt < 4; ++mt) { p[mt] = (f32x4){0.f, 0.f, 0.f, 0.f}; o[mt] = (f32x4){0.f, 0.f, 0.f, 0.f}; }
                bf16x8 fw[2][4], fq_[2][4];
#define SC_LOAD_KS(buf, ks) do { _Pragma("unroll") for (int mt = 0; mt < 4; ++mt) { \
                        const LAS bf16_t* wr_ = st + SC_W + (16 * mt + fr) * 136 + 4 * fq + 32 * (ks); const LAS bf16_t* qr_ = st + SC_QD + (16 * mt + fr) * 136 + 4 * fq + 32 * (ks); \
                        fw[buf][mt] = ld2(wr_, wr_ + 16); fq_[buf][mt] = ld2(qr_, qr_ + 16); } } while (0)
#define SC_MMA_KS(buf, ks) do { _Pragma("unroll") for (int mt = 0; mt < 4; ++mt) p[mt] = __builtin_amdgcn_mfma_f32_16x16x32_bf16(fw[buf][mt], sb[ks], p[mt], 0, 0, 0); \
                        _Pragma("unroll") for (int mt = 0; mt < 4; ++mt) o[mt] = __builtin_amdgcn_mfma_f32_16x16x32_bf16(fq_[buf][mt], sb[ks], o[mt], 0, 0, 0); } while (0)
                bf16x8 fa[2][4], fk[2][8];
#define SC_LOAD_KC(kc) do { _Pragma("unroll") for (int mt = 0; mt < 4; ++mt) { const LAS bf16_t* ar_ = st + SC_AT + (16 * mt + fr) * 72 + 4 * fq + 32 * (kc); fa[kc][mt] = ld2(ar_, ar_ + 16); } \
                        _Pragma("unroll") for (int t = 0; t < 8; ++t) { const LAS bf16_t* kr_ = st + SC_KD + (16 * t + fr) * 72 + 4 * fq + 32 * (kc); fk[kc][t] = ld2(kr_, kr_ + 16); } } while (0)
                SC_LOAD_KS(0, 0);
                SC_LOAD_KS(1, 1); asm volatile("" ::: "memory"); SC_MMA_KS(0, 0);
                SC_LOAD_KS(0, 2); asm volatile("" ::: "memory"); SC_MMA_KS(1, 1);
                SC_LOAD_KS(1, 3); asm volatile("" ::: "memory"); SC_MMA_KS(0, 2);
                SC_LOAD_KC(0);    asm volatile("" ::: "memory"); SC_MMA_KS(1, 3);
                u32x2 uu[4];
#pragma unroll
                for (int mt = 0; mt < 4; ++mt) uu[mt] = *(const LAS u32x2*)(st + SC_U + fr * 72 + 16 * mt + 4 * fq);
                SC_LOAD_KC(1);    asm volatile("" ::: "memory");
                bf16x8 vb[2]; f32x4 vn[4];
#pragma unroll
                for (int mt = 0; mt < 4; ++mt) {
                    vn[mt][0] = __uint_as_float(uu[mt][0] << 16) - p[mt][0]; vn[mt][1] = __uint_as_float(uu[mt][0] & 0xffff0000u) - p[mt][1];
                    vn[mt][2] = __uint_as_float(uu[mt][1] << 16) - p[mt][2]; vn[mt][3] = __uint_as_float(uu[mt][1] & 0xffff0000u) - p[mt][3];
                }
                vb[0] = pk8(vn[0], vn[1]); vb[1] = pk8(vn[2], vn[3]);
#pragma unroll
                for (int t = 0; t < 8; ++t) S[t] = S[t] * egl;
#pragma unroll
                for (int kc = 0; kc < 2; ++kc) {
#pragma unroll
                    for (int mt = 0; mt < 4; ++mt) o[mt] = __builtin_amdgcn_mfma_f32_16x16x32_bf16(fa[kc][mt], vb[kc], o[mt], 0, 0, 0);
#pragma unroll
                    for (int t = 0; t < 8; ++t) S[t] = __builtin_amdgcn_mfma_f32_16x16x32_bf16(fk[kc][t], vb[kc], S[t], 0, 0, 0);
                }
#undef SC_LOAD_KS
#undef SC_MMA_KS
#undef SC_LOAD_KC
                const int rbase = dn_rbase(b, dir, s);
#pragma unroll
                for (int mt = 0; mt < 4; ++mt)
#pragma unroll
                    for (int jj = 0; jj < 4; ++jj) {
                        const int row = rbase + rstep * (16 * mt + 4 * fq + jj);
                        O[((size_t)dir * T + row) * 1024 + h * 128 + sl * 16 + fr] = f2bf(o[mt][jj]);
                    }
            }
            lds_barrier();
          }
        }
    }
}
PF void dn_finish(const KC& k, int j) {
    const int tid = TID(), lane = tid & 63, wave = tid >> 6;
    const bf16_t* O = (const bf16_t*)(k.ws + AR_PB);
    const bf16_t* Z = (const bf16_t*)k.out;
    bf16_t* U = (bf16_t*)(k.ws + AR_UBUF);
    const float* on = k.dn_out_norm + j * 128;
    const int c0 = lane * 16;
    float onv[16];
#pragma unroll
    for (int e = 0; e < 16; ++e) onv[e] = on[(c0 + e) & 127];
    for (int r = blockIdx.x * 8 + wave; r < T; r += gridDim.x * 8) {
        u32x4 vf[2], vb[2], vz[2];
#pragma unroll
        for (int hh = 0; hh < 2; ++hh) {
            vf[hh] = *(const u32x4*)(O + (size_t)r * 1024 + c0 + hh * 8); vb[hh] = *(const u32x4*)(O + ((size_t)T + r) * 1024 + c0 + hh * 8);
            vz[hh] = *(const u32x4*)(Z + (size_t)r * 1024 + c0 + hh * 8);
        }
        asm volatile("" ::: "memory");
        float o[16], z[16];
#pragma unroll
        for (int hh = 0; hh < 2; ++hh) { float a[8], b2[8], zz[8]; unpack8(vf[hh], a); unpack8(vb[hh], b2); unpack8(vz[hh], zz);
#pragma unroll
            for (int i = 0; i < 8; ++i) { o[hh * 8 + i] = a[i] + b2[i]; z[hh * 8 + i] = zz[i]; } }
        float ss = 0.f;
#pragma unroll
        for (int e = 0; e < 16; ++e) ss += o[e] * o[e];
        ss += shx(ss, 1, lane); ss += shx(ss, 2, lane); ss += shx(ss, 4, lane);
        const float rs = rsqrtf(ss * (1.0f / 128.0f) + EPS);
#pragma unroll
        for (int hh = 0; hh < 2; ++hh) { u32x4 ov;
#pragma unroll
            for (int w = 0; w < 4; ++w) { const int e0 = hh * 8 + 2 * w; ov[w] = pk2(o[e0] * rs * onv[e0] * siluf(z[e0]), o[e0 + 1] * rs * onv[e0 + 1] * siluf(z[e0 + 1])); }
            *(u32x4*)(U + (size_t)r * 1024 + c0 + hh * 8) = ov; }
    }
}

DI float conv3g(const bf16_t* p, int j, float w0, float w1, float w2) {
    const int gc = j & 63;
    const float l = gc != 0 ? bf2f(p[j - 1]) : 0.f, c = bf2f(p[j]), r = gc != 63 ? bf2f(p[j + 1]) : 0.f;
    return w0 * l + w1 * c + w2 * r;
}
DI float hy_conv_lane(float c, float w0, float w1, float w2, int lane) {
    const float l = shi(c, (lane + 63) & 63), r = shi(c, (lane + 1) & 63);
    return w0 * (lane > 0 ? l : 0.f) + w1 * c + w2 * (lane < 63 ? r : 0.f);
}
PF void hy_lat(const KC& k, int jl, LAS float* ldsf) {
    const int tid = TID();
    LAS cf* X = (LAS cf*)ldsf;
    LAS cf* tw = X + 17408;
    LAS cf* tA = tw + 1024; LAS cf* tB = tA + 128;
    const bf16_t* FT = (const bf16_t*)(k.ws + AR_FT);
    const bf16_t* PT = (const bf16_t*)(k.ws + AR_PB);
    bf16_t* ZT = (bf16_t*)(k.ws + AR_ZT);
    unsigned* scr = (unsigned*)(k.ws + AR_FFTS) + (size_t)blockIdx.x * 4 * 16384;
    unsigned* sKe = scr; unsigned* sKo = scr + 16384; unsigned* zp = scr + 2 * 16384; unsigned* ye = scr + 3 * 16384;
#define CPK(v) pk2((v).x, (v).y)
#define CUP(u_) ((cf){__uint_as_float((u_) << 16), __uint_as_float((u_) & 0xffff0000u)})
    const float* cw = k.hy_conv + (size_t)jl * 3 * 3072;
    for (int m = 0; m < 2; ++m) { const int p = tid + 512 * m; float sn, cs; sincospif(-(float)p / 8192.0f, &sn, &cs); cf w; w.x = cs; w.y = sn; tw[p] = w; }
    if (tid < 256) { const int a = tid & 127; float sn, cs; sincospif(-(float)(tid < 128 ? 128 * a : a) / 16384.0f, &sn, &cs); cf w; w.x = cs; w.y = sn; (tid < 128 ? tA : tB)[a] = w; }
    __syncthreads();
    const int lane = tid & 63;
#define HY_SPLIT() asm volatile("" ::: "memory")
#define HY_CONV(c, w0, w1, w2) hy_conv_lane((c), (w0), (w1), (w2), lane)
    for (int ch = blockIdx.x; ch < 1024; ch += gridDim.x) {
        {
            const bf16_t* pv = PT + (size_t)ch * T + TC;
            const float w0 = cw[ch], w1 = cw[3072 + ch], w2 = cw[6144 + ch];
            for (int m0 = 0; m0 < 32; m0 += 8) {
                bf16_t a0[8], a1[8];
#pragma unroll
                for (int q = 0; q < 8; ++q) { const int j = tid + 512 * (m0 + q); a0[q] = pv[j]; a1[q] = pv[SEQ + j]; }
                HY_SPLIT();
#pragma unroll
                for (int q = 0; q < 8; ++q) { const int j = tid + 512 * (m0 + q); const float c0 = bf2f(a0[q]), c1 = bf2f(a1[q]); cf z; z.x = HY_CONV(c0, w0, w1, w2); z.y = HY_CONV(c1, w0, w1, w2); zp[j] = CPK(z); }
            }
        }
        for (int n = 0; n < 2; ++n) {
            __syncthreads();
            const bf16_t* ftf = FT + (size_t)(n * 2048 + ch) * 16384; const bf16_t* ftb = FT + (size_t)(n * 2048 + 1024 + ch) * 16384;
            for (int m0 = 0; m0 < 32; m0 += 8) {
                bf16_t hfv[8], hbv[8];
#pragma unroll
                for (int q = 0; q < 8; ++q) { const int j = tid + 512 * (m0 + q); hfv[q] = ftf[j]; hbv[q] = ftb[j > 0 ? SEQ - j : 0]; }
                HY_SPLIT();
#pragma unroll
                for (int q = 0; q < 8; ++q) {
                    const int j = tid + 512 * (m0 + q);
                    const float hf = bf2f(hfv[q]), hb = j > 0 ? bf2f(hbv[q]) : 0.f;
                    const cf w = cmul(tA[j >> 7], tB[j & 127]);
                    cf a; a.x = hf + hb; a.y = 0.f; X[PIDX(j)] = a;
                    const float kd = hf - hb; cf o; o.x = kd * w.x; o.y = kd * w.y; sKo[j] = CPK(o);
                }
            }
            __syncthreads();
            fft16k_fwd(X, tw);
            unsigned Ker[32];
#pragma unroll
            for (int m = 0; m < 32; ++m) { const cf t_ = X[PIDX(tid + 512 * m)]; Ker[m] = CPK(t_); }
            __syncthreads();
            for (int m0 = 0; m0 < 32; m0 += 8) { unsigned t[8];
#pragma unroll
                for (int q = 0; q < 8; ++q) t[q] = sKo[tid + 512 * (m0 + q)];
                HY_SPLIT();
#pragma unroll
                for (int q = 0; q < 8; ++q) X[PIDX(tid + 512 * (m0 + q))] = CUP(t[q]); }
            __syncthreads();
            fft16k_fwd(X, tw);
            _Pragma("unroll 8") for (int m = 0; m < 32; ++m) { const int j = tid + 512 * m; const cf t_ = X[PIDX(j)]; sKo[j] = CPK(t_); }
            __syncthreads();
            for (int m0 = 0; m0 < 32; m0 += 8) { unsigned t[8];
#pragma unroll
                for (int q = 0; q < 8; ++q) t[q] = zp[tid + 512 * (m0 + q)];
                HY_SPLIT();
#pragma unroll
                for (int q = 0; q < 8; ++q) X[PIDX(tid + 512 * (m0 + q))] = CUP(t[q]); }
            __syncthreads();
            fft16k_fwd(X, tw);
#pragma unroll
            for (int m = 0; m < 32; ++m) { const int j = tid + 512 * m; X[PIDX(j)] = cmul(X[PIDX(j)], CUP(Ker[m])); }
            __syncthreads();
            fft16k_inv(X, tw);
            _Pragma("unroll 8") for (int m = 0; m < 32; ++m) { const int j = tid + 512 * m; const cf t_ = X[PIDX(j)]; ye[j] = CPK(t_); }
            __syncthreads();
            for (int m0 = 0; m0 < 32; m0 += 8) { unsigned t[8];
#pragma unroll
                for (int q = 0; q < 8; ++q) t[q] = zp[tid + 512 * (m0 + q)];
                HY_SPLIT();
#pragma unroll
                for (int q = 0; q < 8; ++q) { const int j = tid + 512 * (m0 + q); const cf w = cmul(tA[j >> 7], tB[j & 127]); X[PIDX(j)] = cmul(CUP(t[q]), w); } }
            __syncthreads();
            fft16k_fwd(X, tw);
            for (int m0 = 0; m0 < 32; m0 += 8) { unsigned t[8];
#pragma unroll
                for (int q = 0; q < 8; ++q) t[q] = sKo[tid + 512 * (m0 + q)];
                HY_SPLIT();
#pragma unroll
                for (int q = 0; q < 8; ++q) { const int j = tid + 512 * (m0 + q); X[PIDX(j)] = cmul(X[PIDX(j)], CUP(t[q])); } }
            __syncthreads();
            fft16k_inv(X, tw);
            {
                const bf16_t* pg = PT + (size_t)((n + 1) * 1024 + ch) * T + TC;
                const int gcol = (n + 1) * 1024 + ch;
                const float w0 = cw[gcol], w1 = cw[3072 + gcol], w2 = cw[6144 + gcol];
                const float bias = k.hy_bias[(size_t)jl * 2 * 1024 + n * 1024 + ch];
                for (int m0 = 0; m0 < 32; m0 += 8) {
                    unsigned te_[8], tz_[8]; bf16_t g0[8], g1[8];
#pragma unroll
                    for (int q = 0; q < 8; ++q) { const int j = tid + 512 * (m0 + q); te_[q] = ye[j]; tz_[q] = zp[j]; g0[q] = pg[j]; g1[q] = pg[SEQ + j]; }
                    HY_SPLIT();
#pragma unroll
                    for (int q = 0; q < 8; ++q) {
                        const int j = tid + 512 * (m0 + q);
                        cf w = cmul(tA[j >> 7], tB[j & 127]); w.y = -w.y;
                        const cf yo = cmul(X[PIDX(j)], w);
                        const cf te = CUP(te_[q]), tz = CUP(tz_[q]);
                        const float y0 = (0.5f / 16384.0f) * (te.x + yo.x), y1 = (0.5f / 16384.0f) * (te.y + yo.y);
                        const float c0 = bf2f(g0[q]), c1 = bf2f(g1[q]);
                        cf zn; zn.x = HY_CONV(c0, w0, w1, w2) * (y0 + bias * tz.x); zn.y = HY_CONV(c1, w0, w1, w2) * (y1 + bias * tz.y);
                        zp[j] = CPK(zn);
                    }
                }
            }
        }
        for (int m0 = 0; m0 < 32; m0 += 8) { unsigned t[8];
#pragma unroll
            for (int q = 0; q < 8; ++q) t[q] = zp[tid + 512 * (m0 + q)];
            HY_SPLIT();
#pragma unroll
            for (int q = 0; q < 8; ++q) { const int j = tid + 512 * (m0 + q); ZT[(size_t)ch * T + TC + j] = (bf16_t)(t[q] & 0xffffu); ZT[(size_t)ch * T + TC + SEQ + j] = (bf16_t)(t[q] >> 16); } }
        __syncthreads();
    }
#undef CPK
#undef CUP
#undef HY_SPLIT
#undef HY_CONV
}
PF void hy_ctx(const KC& k, int jl, LAS float* lds) {
    const int tid = TID(), t = tid & 255, hsel = tid >> 8;
    LAS float* z = lds + hsel * 768; LAS float* hf = z + 256; LAS float* hb = hf + 256;
    const bf16_t* PT = (const bf16_t*)(k.ws + AR_PB);
    bf16_t* U = (bf16_t*)(k.ws + AR_UBUF);
    const float* filtc = (const float*)(k.ws + WS_FILTC);
    const float* cw = k.hy_conv + (size_t)jl * 3 * 3072;
    for (int u = blockIdx.x; u < 1024; u += gridDim.x) {
        const int pr = u * 2 + hsel, b = pr >> 10, ch = pr & 1023;
        float zc;
        {
            const bf16_t* pv = PT + (size_t)ch * T + b * 256;
            const float l = t != 0 ? bf2f(pv[t - 1]) : 0.f, c = bf2f(pv[t]), r = t != 255 ? bf2f(pv[t + 1]) : 0.f;
            zc = cw[ch] * l + cw[3072 + ch] * c + cw[6144 + ch] * r;
        }
        for (int n = 0; n < 2; ++n) {
            __syncthreads();
            z[t] = zc; hf[t] = filtc[(size_t)t * 4096 + n * 2048 + ch]; hb[t] = filtc[(size_t)t * 4096 + n * 2048 + 1024 + ch];
            __syncthreads();
            float y = 0.f;
            for (int s = 0; s <= t; ++s) y += hf[t - s] * z[s];
            for (int s = t + 1; s < 256; ++s) y += hb[s - t] * z[s];
            const int gcol = (n + 1) * 1024 + ch;
            const bf16_t* pg = PT + (size_t)gcol * T + b * 256;
            const float l = t != 0 ? bf2f(pg[t - 1]) : 0.f, c = bf2f(pg[t]), r = t != 255 ? bf2f(pg[t + 1]) : 0.f;
            const float gate = cw[gcol] * l + cw[3072 + gcol] * c + cw[6144 + gcol] * r;
            zc = gate * (y + k.hy_bias[(size_t)jl * 2048 + n * 1024 + ch] * zc);
        }
        U[(size_t)(b * 256 + t) * 1024 + ch] = f2bf(zc);
        __syncthreads();
    }
}
PF void hy_transpose(const KC& k, LAS bf16_t* lds) {
    const int tid = TID();
    const bf16_t* ZT = (const bf16_t*)(k.ws + AR_ZT);
    bf16_t* U = (bf16_t*)(k.ws + AR_UBUF);
    for (int u = blockIdx.x; u < 16 * (TL / 64); u += gridDim.x) {
        const int c0 = (u & 15) * 64, r0 = TC + (u >> 4) * 64;
        { const int c = tid >> 3, sg = (tid & 7) * 8;
          const u32x4 v = *(const u32x4*)(ZT + (size_t)(c0 + c) * T + r0 + sg);
#pragma unroll
          for (int w = 0; w < 4; ++w) { lds[(sg + 2 * w) * 66 + c] = (bf16_t)(v[w] & 0xffff); lds[(sg + 2 * w + 1) * 66 + c] = (bf16_t)(v[w] >> 16); } }
        __syncthreads();
        { const int r = tid >> 3, sg = (tid & 7) * 8; u32x4 o;
#pragma unroll
          for (int w = 0; w < 4; ++w) o[w] = (unsigned)lds[r * 66 + sg + 2 * w] | ((unsigned)lds[r * 66 + sg + 2 * w + 1] << 16);
          *(u32x4*)(U + (size_t)(r0 + r) * 1024 + c0 + sg) = o; }
        __syncthreads();
    }
}

__global__ void __launch_bounds__(NTHR, 2) fwd_kernel(Params prm) {
    extern __shared__ __attribute__((aligned(16))) unsigned char lds_raw[];
    LAS unsigned char* lds = (LAS unsigned char*)lds_raw;
    LAS float* ldsf = (LAS float*)lds;
    LAS bf16_t* ldsh = (LAS bf16_t*)lds;
    LAS int* tb = (LAS int*)(lds + 150 * 1024);
    volatile LAS unsigned* xbw = (volatile LAS unsigned*)(lds + 151 * 1024 + 512);
    KC k;
    k.x = (const float*)(GAS const float*)prm.in[0]; k.c = (const float*)(GAS const float*)prm.in[1]; k.ctx = (const float*)(GAS const float*)prm.in[2]; k.c_ctx = (const float*)(GAS const float*)prm.in[3]; k.ada_w = (const float*)(GAS const float*)prm.in[4]; k.ada_b = (const float*)(GAS const float*)prm.in[5];
    k.norm_mix = (const float*)(GAS const float*)prm.in[6]; k.norm_ffn = (const float*)(GAS const float*)prm.in[7]; k.norm_final = (const float*)(GAS const float*)prm.in[8];
    k.dn_w_in = (const float*)(GAS const float*)prm.in[9]; k.dn_conv = (const float*)(GAS const float*)prm.in[10]; k.dn_a_log = (const float*)(GAS const float*)prm.in[11]; k.dn_dt_bias = (const float*)(GAS const float*)prm.in[12]; k.dn_out_norm = (const float*)(GAS const float*)prm.in[13]; k.dn_w_out = (const float*)(GAS const float*)prm.in[14];
    k.hy_w_in = (const float*)(GAS const float*)prm.in[15]; k.hy_conv = (const float*)(GAS const float*)prm.in[16]; k.hy_f_w1 = (const float*)(GAS const float*)prm.in[17]; k.hy_f_b1 = (const float*)(GAS const float*)prm.in[18]; k.hy_f_freq = (const float*)(GAS const float*)prm.in[19]; k.hy_f_w2 = (const float*)(GAS const float*)prm.in[20];
    k.hy_f_b2 = (const float*)(GAS const float*)prm.in[21]; k.hy_f_w3 = (const float*)(GAS const float*)prm.in[22]; k.hy_bias = (const float*)(GAS const float*)prm.in[23]; k.hy_w_out = (const float*)(GAS const float*)prm.in[24];
    k.sc_w_in = (const float*)(GAS const float*)prm.in[25]; k.sc_conv = (const float*)(GAS const float*)prm.in[26]; k.sc_w_out = (const float*)(GAS const float*)prm.in[27]; k.w_router = (const float*)(GAS const float*)prm.in[28]; k.router_bias = (const float*)(GAS const float*)prm.in[29];
    k.moe_w_gate = (const float*)(GAS const float*)prm.in[30]; k.moe_w_up = (const float*)(GAS const float*)prm.in[31]; k.moe_w_down = (const float*)(GAS const float*)prm.in[32];
    k.out = (float*)(GAS float*)prm.out; k.ws = (unsigned char*)(GAS unsigned char*)prm.ws;
    const int lo = prm.ph_lo, hi = prm.ph_hi;
    XcdBarrier bar; bar.bar = (unsigned*)(k.ws + WS_CTL); bar.x = 0; bar.st = xbw;
    if (hi - lo > 1) {
        if (threadIdx.x == 0) { xbw[0] = 0u; xbw[1] = 0u; }
        __syncthreads();
        bar = xcd_barrier_post((unsigned*)(k.ws + WS_CTL), xbw);
    }
    int ph = 0;
#define PROBE_OK(id) ((id) != 1 || i == 0)
    int i = 0;
#define PH_BEGIN(id) if (ph >= lo && ph < hi) { const int nrep_ = (((id) == PROBE_REP) && PROBE_OK(id)) ? 2 : 1; for (int rep_ = 0; rep_ < nrep_; ++rep_) { { GAS unsigned char* w_ = (GAS unsigned char*)k.ws; asm volatile("" : "+s"(w_)); k.ws = (unsigned char*)w_; }
#define PH_END   if (ph + 1 < hi) xcd_barrier(bar); } } ++ph;

    float* xs = (float*)(k.ws + WS_XS);
    const float* mod = (const float*)(k.ws + WS_MOD);

    PH_BEGIN(0)
        job_mod(k, ldsf);
        job_cvt_small(k, ldsf);
        job_hdn(k, ldsf);
        job_w3s(k);
    PH_END

    for (i = 0; i < DEPTH; ++i) {
        const int kind = i % 3, j = i / 3;
        const bool last = (i == DEPTH - 1);
        PH_BEGIN(1)
            if (kind == 0) norm_mfma<2>(k, i, i == 0, i > 0, k.norm_mix + i * 1024, 0, k.dn_w_in + (size_t)j * 1024 * DN_IN + 4096, DN_IN,
                                        k.dn_a_log + j * 16, k.dn_dt_bias + j * 16, last, lds);
            else norm_phase<0>(k, i, i == 0, i > 0, k.norm_mix + i * 1024, 0, nullptr, 0, nullptr, nullptr, last, ldsf);
            if (kind == 1) job_filtc(k, j);
        PH_END
        PH_BEGIN(2)
            if (kind == 0) { EpiBf16 e{(bf16_t*)(k.ws + AR_PB), 3072, 3072, (bf16_t*)k.out, 1024}; gemm_dense(lds, (const bf16_t*)(k.ws + AR_HBUF), T, (const bf16_t*)(k.ws + WS_DNWIN) + (size_t)j * 4096 * 1024, 4096, 1024, e); }
            else if (kind == 1) { EpiBf16T e{(bf16_t*)(k.ws + AR_PB), T}; gemm_dense(lds, (const bf16_t*)(k.ws + AR_HBUF), T, (const bf16_t*)(k.ws + WS_HYWIN), 3072, 1024, e);
                                  EpiTaps et{(bf16_t*)(k.ws + AR_FT)}; gemm_dense(lds, (const bf16_t*)(k.ws + WS_W3S), 4096, (const bf16_t*)(k.ws + WS_HS), 16384, 256, et); }
            else { EpiBf16 e{(bf16_t*)(k.ws + AR_PB), 3072, 1 << 30, nullptr, 0}; gemm_dense(lds, (const bf16_t*)(k.ws + AR_HBUF), T, (const bf16_t*)(k.ws + WS_SCWIN), 3072, 1024, e); }
        PH_END
        if (kind == 0) {
            PH_BEGIN(3) dn_chunk(k, j, lds); PH_END
            PH_BEGIN(4) dn_scan(k, lds); PH_END
            PH_BEGIN(5) dn_finish(k, j); PH_END
        } else if (kind == 1) {
            PH_BEGIN(6) hy_lat(k, j, ldsf); hy_ctx(k, j, ldsf); PH_END
            PH_BEGIN(7) hy_transpose(k, ldsh); PH_END
        } else {
            PH_BEGIN(8) sc_mix(k, j); PH_END
        }
        PH_BEGIN(9)
            const bf16_t* Wt = kind == 0 ? (const bf16_t*)(k.ws + WS_DNWOUT) + (size_t)j * 1024 * 1024 : (kind == 1 ? (const bf16_t*)(k.ws + WS_HYWOUT) : (const bf16_t*)(k.ws + WS_SCWOUT));
            EpiResid e{xs, mod, i, 2};
            gemm_dense(lds, (const bf16_t*)(k.ws + AR_UBUF), T, Wt, 1024, 1024, e);
            if (gridDim.x == 256) job_cvt_moe(k, i, ldsf, (int)blockIdx.x - 8, 248); else job_cvt_moe(k, i, ldsf, (int)blockIdx.x, (int)gridDim.x);
        PH_END
        PH_BEGIN(10)
            norm_mfma<1>(k, i, false, false, k.norm_ffn + i * 1024, 3, k.w_router, 32, k.router_bias, nullptr, last, lds, rep_ == nrep_ - 1);
        PH_END
        PH_BEGIN(11)
            moe_scatter(k, i, tb);
        PH_END
        PH_BEGIN(12) moe_gemm<0>(k, i, lds, tb); PH_END
        PH_BEGIN(13) moe_gemm<1>(k, i, lds, tb); PH_END
    }
    PH_BEGIN(14)
        norm_phase<3>(k, DEPTH, false, true, k.norm_final, 0, nullptr, 0, nullptr, nullptr, false, ldsf);
    PH_END
#undef PH_BEGIN
#undef PH_END
}
constexpr int N_PHASES = 1 + (10 + 9 + 8 + 10) + 1;

extern "C" void kernel_launch(void* const* d_in, const int* in_sizes, int n_in, void* d_out, int out_size, void* d_ws, size_t ws_size, hipStream_t stream) {
    static int grid = 0;
    if (grid == 0) {
        if (n_in != 33 || out_size != TL * D || ws_size < WS_END) { fprintf(stderr, "kernel_launch: unexpected shapes: n_in %d out %d ws %zu (need %zu)\n", n_in, out_size, ws_size, (size_t)WS_END); grid = -1; return; }
        int dev = 0, cus = 0, per_cu = 0;
        if (hipGetDevice(&dev) != hipSuccess || hipDeviceGetAttribute(&cus, hipDeviceAttributeMultiprocessorCount, dev) != hipSuccess) { grid = -1; return; }
        if (hipFuncSetAttribute((const void*)fwd_kernel, hipFuncAttributeMaxDynamicSharedMemorySize, LDS_BYTES) != hipSuccess) { fprintf(stderr, "kernel_launch: hipFuncSetAttribute failed\n"); grid = -1; return; }
        if (hipOccupancyMaxActiveBlocksPerMultiprocessor(&per_cu, (const void*)fwd_kernel, NTHR, LDS_BYTES) != hipSuccess || per_cu < 1) fprintf(stderr, "kernel_launch: occupancy query reports %d\n", per_cu);
        (void)hipGetLastError();
        grid = cus;
    }
    if (grid < 0) return;
    (void)hipMemsetAsync((char*)d_ws + WS_CTL, 0, CTL_BYTES, stream);
    Params p{};
    for (int i = 0; i < 33; ++i) p.in[i] = (const float*)d_in[i];
    p.out = (float*)d_out; p.ws = (unsigned char*)d_ws;
#if MK_MULTI
    for (int ph = 0; ph < N_PHASES; ++ph) { p.ph_lo = ph; p.ph_hi = ph + 1; hipLaunchKernelGGL(fwd_kernel, dim3(grid), dim3(NTHR), LDS_BYTES, stream, p); }
#else
    p.ph_lo = 0; p.ph_hi = N_PHASES;
    hipLaunchKernelGGL(fwd_kernel, dim3(grid), dim3(NTHR), LDS_BYTES, stream, p);
#endif
}
```

```cpp
#include <hip/hip_runtime.h>
#include <stdint.h>
#include <stdio.h>
#include <math.h>

#ifndef MK_MULTI
#define MK_MULTI 0
#endif

#ifndef PROBE_SUB
#define PROBE_SUB (0)
#endif
#ifndef PROBE_MODE
#define PROBE_MODE (1)
#endif
#ifndef PROBE_REP
#define PROBE_REP (-1)
#endif
#define LAS __attribute__((address_space(3)))
#define GAS __attribute__((address_space(1)))
#define HD __host__ __device__ __forceinline__
#define DI __device__ __forceinline__
#ifdef NOINL
#define PF __device__ __noinline__
#else
#define PF __device__ __forceinline__
#endif
typedef unsigned short bf16_t;
typedef short bf16x8 __attribute__((ext_vector_type(8)));
typedef float f32x4 __attribute__((ext_vector_type(4)));
typedef unsigned u32x4 __attribute__((ext_vector_type(4)));
typedef unsigned u32x2 __attribute__((ext_vector_type(2)));

constexpr int D = 1024, NB = 2, SEQ = 16384, CTXL = 256, DEPTH = 4;
constexpr int TC = NB * CTXL, TL = NB * SEQ, T = TC + TL, NA = 2 * T;
constexpr int NTHR = 512;
constexpr int DN_IN = 4128;
constexpr float EPS = 1e-6f;
constexpr int LDS_BYTES = 152 * 1024;

constexpr size_t AL(size_t x) { return (x + 255) & ~(size_t)255; }
constexpr size_t WS_CTL = 0;
constexpr size_t CTL_BYTES = 65536;
constexpr size_t CTL_CNT = 16384;
constexpr size_t WS_MOD = WS_CTL + CTL_BYTES;
constexpr size_t WS_HS = AL(WS_MOD + 4 * 3 * 6144 * 4);
constexpr size_t WS_W3S = AL(WS_HS + 16384 * 256 * 2);
constexpr size_t WS_HDNC = AL(WS_W3S + 4096 * 256 * 2);
constexpr size_t WS_FILTC = AL(WS_HDNC + 256 * 64 * 4);
constexpr size_t WS_DNWIN = AL(WS_FILTC + 256 * 4096 * 4);
constexpr size_t WS_DNWOUT = AL(WS_DNWIN + (size_t)2 * 4096 * 1024 * 2);
constexpr size_t WS_HYWIN = AL(WS_DNWOUT + (size_t)2 * 1024 * 1024 * 2);
constexpr size_t WS_HYWOUT = AL(WS_HYWIN + (size_t)3072 * 1024 * 2);
constexpr size_t WS_SCWIN = AL(WS_HYWOUT + (size_t)1024 * 1024 * 2);
constexpr size_t WS_SCWOUT = AL(WS_SCWIN + (size_t)3072 * 1024 * 2);
constexpr size_t WS_XS = AL(WS_SCWOUT + (size_t)1024 * 1024 * 2);
constexpr size_t WS_TOKE = AL(WS_XS + (size_t)T * 1024 * 4);
constexpr size_t WS_TOKW = AL(WS_TOKE + (size_t)T * 2 * 4);
constexpr size_t WS_TOKP = AL(WS_TOKW + (size_t)T * 2 * 4);
constexpr size_t WS_SLOT = AL(WS_TOKP + (size_t)T * 2 * 4);
constexpr size_t WS_GB = AL(WS_SLOT + (size_t)(NA + 256) * 4);
constexpr size_t WS_EGL = AL(WS_GB + (size_t)T * 32 * 4);
constexpr size_t WS_AR = AL(WS_EGL + (size_t)32 * 260 * 4);
constexpr size_t AR_HBUF = WS_AR;
constexpr size_t AR_UBUF = AR_HBUF + (size_t)T * 1024 * 2;
constexpr size_t AR_PB = AR_UBUF + (size_t)T * 1024 * 2;
constexpr size_t AR_Q = AR_PB + (size_t)T * 4096 * 2;
constexpr size_t AR_CHUNK = AR_PB + (size_t)T * 3072 * 2;
constexpr size_t AR_DN_END = AR_CHUNK + (size_t)32 * 260 * 65536;
constexpr size_t AR_ZT = AR_Q;
constexpr size_t AR_FFTS = AR_ZT + (size_t)1024 * T * 2;
constexpr size_t AR_FT = AR_FFTS + (size_t)256 * 4 * 16384 * 8;
constexpr size_t AR_HY_END = AR_FT + (size_t)4096 * 16384 * 4;
constexpr size_t AR_HID = AR_PB;
constexpr size_t AR_YS = AR_HID + (size_t)NA * 512 * 2;
constexpr size_t AR_WGU = AR_YS + (size_t)NA * 1024 * 2;
constexpr size_t AR_WD = AR_WGU + (size_t)32 * 1024 * 1024 * 2;
constexpr size_t AR_MOE_END = AR_WD + (size_t)32 * 1024 * 512 * 2;
constexpr size_t WS_END = AR_DN_END > AR_HY_END ? (AR_DN_END > AR_MOE_END ? AR_DN_END : AR_MOE_END) : (AR_HY_END > AR_MOE_END ? AR_HY_END : AR_MOE_END);

#define XB_TMO      128
#define XB_XCNT(j)  (256  + 64 * (j))
#define XB_XSUB(j)  (1280 + 64 * (j))
#define XB_XGEN(j)  (2304 + 64 * (j))
#define XB_TOP      3328
#define XB_TOPGEN   3392
#define XCD_BAR_WORDS 3456
#define XB_SPIN_CAP (1u << 25)
DI unsigned xb_ld(unsigned* p)              { return __hip_atomic_load(p, __ATOMIC_RELAXED, __HIP_MEMORY_SCOPE_AGENT); }
DI unsigned xb_add(unsigned* p, unsigned v) { return __hip_atomic_fetch_add(p, v, __ATOMIC_RELAXED, __HIP_MEMORY_SCOPE_AGENT); }
DI unsigned xb_xcc_id() { return (unsigned)__builtin_amdgcn_s_getreg((3 << 11) | 20) & 0xFu; }
#define XB_SPIN(cond, bar) do { unsigned _sp = 0; while (cond) { __builtin_amdgcn_s_sleep(1); \
    if ((++_sp & 255u) == 0u) { if (xb_ld(&(bar)[XB_TMO])) break; if (_sp > XB_SPIN_CAP) { atomicAdd(&(bar)[XB_TMO], 1u); break; } } } } while (0)
struct XcdBarrier { unsigned* bar; unsigned x; volatile LAS unsigned* st; };
DI XcdBarrier xcd_barrier_post(unsigned* bar, volatile LAS unsigned* st) {
    XcdBarrier b; b.bar = bar; b.x = xb_xcc_id(); b.st = st;
    if (threadIdx.x == 0) (void)xb_add(&bar[XB_XCNT(b.x)], 1u);
    return b;
}
DI void xcd_barrier_complete(unsigned* bar, unsigned x, unsigned& nloc, unsigned& nx) {
    const unsigned G = gridDim.x * gridDim.y * gridDim.z;
    unsigned sum, cnt, mine, sp = 0u;
    for (;;) {
        sum = 0u; cnt = 0u; mine = 0u;
#pragma unroll
        for (unsigned j = 0; j < 16; ++j) { const unsigned c = xb_ld(&bar[XB_XCNT(j)]); sum += c; cnt += (c > 0u) ? 1u : 0u; mine = (j == x) ? c : mine; }
        if (sum == G) break;
        __builtin_amdgcn_s_sleep(1);
        if ((++sp & 255u) == 0u) { if (xb_ld(&bar[XB_TMO])) break; if (sp > XB_SPIN_CAP) { atomicAdd(&bar[XB_TMO], 1u); break; } }
    }
    nloc = mine > 0u ? mine : 1u; nx = cnt > 0u ? cnt : 1u;
}
DI void xcd_barrier(const XcdBarrier& b) {
    asm volatile("s_waitcnt vmcnt(0)" ::: "memory");
    __syncthreads();
    if (threadIdx.x == 0) {
        unsigned* bar = b.bar;
        __builtin_amdgcn_s_waitcnt(0);
        unsigned nloc = b.st[0], nx = b.st[1];
        if (nloc == 0u) { xcd_barrier_complete(bar, b.x, nloc, nx); b.st[0] = nloc; b.st[1] = nx; }
        const unsigned old = xb_add(&bar[XB_XSUB(b.x)], 1u);
        const unsigned gen = old / nloc;
        if (old + 1u == (gen + 1u) * nloc) {
            __builtin_amdgcn_fence(__ATOMIC_RELEASE, "agent");
            asm volatile("s_waitcnt vmcnt(0)" ::: "memory");
            const unsigned og = xb_add(&bar[XB_TOP], 1u);
            const unsigned tg = og / nx;
            if (og + 1u == (tg + 1u) * nx) xb_add(&bar[XB_TOPGEN], 1u);
            else XB_SPIN(xb_ld(&bar[XB_TOPGEN]) == tg, bar);
            __builtin_amdgcn_fence(__ATOMIC_ACQUIRE, "agent");
            xb_add(&bar[XB_XGEN(b.x)], 1u);
            asm volatile("s_waitcnt vmcnt(0)" ::: "memory");
        } else {
            XB_SPIN(xb_ld(&bar[XB_XGEN(b.x)]) == gen, bar);
            __builtin_amdgcn_fence(__ATOMIC_ACQUIRE, "agent");
            asm volatile("s_waitcnt vmcnt(0)" ::: "memory");
        }
    }
    __syncthreads();
}

typedef float f32x2_t __attribute__((ext_vector_type(2)));
typedef __bf16 bf16x2_t __attribute__((ext_vector_type(2)));
DI unsigned cvt_pk_bf16(float lo, float hi) { f32x2_t v; v.x = lo; v.y = hi; const bf16x2_t b = __builtin_convertvector(v, bf16x2_t); return __builtin_bit_cast(unsigned, b); }
DI bf16_t f2bf(float f) { return (bf16_t)(cvt_pk_bf16(f, f) & 0xffffu); }
DI float bf2f(bf16_t b) { return __uint_as_float(((unsigned)b) << 16); }
DI unsigned pk2(float lo, float hi) { return cvt_pk_bf16(lo, hi); }
DI float siluf(float x) { return x * __builtin_amdgcn_rcpf(1.0f + __expf(-x)); }
DI float sigmf(float x) { return 1.0f / (1.0f + __expf(-x)); }
DI float shi(float v, int src) { return __int_as_float(__builtin_amdgcn_ds_bpermute(src << 2, __float_as_int(v))); }
DI int shii(int v, int src) { return __builtin_amdgcn_ds_bpermute(src << 2, v); }
DI float shx(float v, int m, int lane) { return shi(v, lane ^ m); }
DI float wsum(float v, int lane) {
#pragma unroll
    for (int m = 32; m >= 1; m >>= 1) v += shx(v, m, lane);
    return v;
}
DI void lds_barrier() { asm volatile("s_waitcnt lgkmcnt(0)\n\ts_barrier" ::: "memory"); }
DI int TID() { int t = threadIdx.x; asm volatile("" : "+v"(t)); return t; }
DI int modrow(int r) { return r < TC ? 0 : 1 + (r - TC) / SEQ; }

typedef float cf __attribute__((ext_vector_type(2)));
HD cf cmul(cf a, cf b) { cf r; r.x = a.x * b.x - a.y * b.y; r.y = a.x * b.y + a.y * b.x; return r; }
HD cf cadd(cf a, cf b) { cf r; r.x = a.x + b.x; r.y = a.y + b.y; return r; }
HD cf csub(cf a, cf b) { cf r; r.x = a.x - b.x; r.y = a.y - b.y; return r; }
template <int R> HD constexpr int brev(int i) { int r = 0; for (int b = 1, t = R >> 1; b < R; b <<= 1, t >>= 1) if (i & b) r |= t; return r; }
#define FFT_C32 {1.0f, 0.98078528040323044913f, 0.92387953251128675613f, 0.83146961230254523708f, 0.70710678118654752440f, 0.55557023301960222474f, 0.38268343236508977173f, 0.19509032201612826785f, 0.0f, -0.19509032201612826785f, -0.38268343236508977173f, -0.55557023301960222474f, -0.70710678118654752440f, -0.83146961230254523708f, -0.92387953251128675613f, -0.98078528040323044913f}
#define FFT_S32 {0.0f, 0.19509032201612826785f, 0.38268343236508977173f, 0.55557023301960222474f, 0.70710678118654752440f, 0.83146961230254523708f, 0.92387953251128675613f, 0.98078528040323044913f, 1.0f, 0.98078528040323044913f, 0.92387953251128675613f, 0.83146961230254523708f, 0.70710678118654752440f, 0.55557023301960222474f, 0.38268343236508977173f, 0.19509032201612826785f}
template <int R> HD constexpr int ilog2c() { int l = 0; for (int r = R; r > 1; r >>= 1) ++l; return l; }
template <int R> HD void dft_fwd(cf (&v)[R]) {
    constexpr float C[16] = FFT_C32; constexpr float S[16] = FFT_S32;
    constexpr int LG = ilog2c<R>();
#pragma unroll
    for (int st = 0; st < LG; ++st) {
#pragma unroll
        for (int i = 0; i < R / 2; ++i) {
            const int len = R >> st, half = len >> 1, blk = i / half, j = i % half, i0 = blk * len + j, i1 = i0 + half;
            const cf a = v[i0], c = v[i1];
            v[i0] = cadd(a, c);
            const cf d = csub(a, c);
            const int ti = j * (32 / len);
            cf w; w.x = C[ti]; w.y = -S[ti];
            cf r;
            if (ti == 0) r = d;
            else if (ti == 8) { r.x = d.y; r.y = -d.x; }
            else if (ti == 4) { r.x = (d.x + d.y) * 0.70710678118654752440f; r.y = (d.y - d.x) * 0.70710678118654752440f; }
            else if (ti == 12) { r.x = (d.y - d.x) * 0.70710678118654752440f; r.y = -(d.x + d.y) * 0.70710678118654752440f; }
            else r = cmul(d, w);
            v[i1] = r;
        }
    }
}
template <int R> HD void dft_inv(cf (&v)[R]) {
    constexpr float C[16] = FFT_C32; constexpr float S[16] = FFT_S32;
    constexpr int LG = ilog2c<R>();
#pragma unroll
    for (int st = LG - 1; st >= 0; --st) {
#pragma unroll
        for (int i = 0; i < R / 2; ++i) {
            const int len = R >> st, half = len >> 1, blk = i / half, j = i % half, i0 = blk * len + j, i1 = i0 + half;
            const int ti = j * (32 / len);
            cf w; w.x = C[ti]; w.y = S[ti];
            const cf a = v[i0];
            const cf b1 = v[i1];
            cf c;
            if (ti == 0) c = b1;
            else if (ti == 8) { c.x = -b1.y; c.y = b1.x; }
            else if (ti == 4) { c.x = (b1.x - b1.y) * 0.70710678118654752440f; c.y = (b1.x + b1.y) * 0.70710678118654752440f; }
            else if (ti == 12) { c.x = -(b1.x + b1.y) * 0.70710678118654752440f; c.y = (b1.x - b1.y) * 0.70710678118654752440f; }
            else c = cmul(b1, w);
            v[i0] = cadd(a, c);
            v[i1] = csub(a, c);
        }
    }
}
#define PIDX(a) ((a) + (((a) >> 6) << 2))
template <int R> DI void fft_pass_fwd(LAS cf* X, const LAS cf* tw, int n, int g) {
    const int s = n / R, q = g / s, p = g - q * s, base = q * n + p;
    cf v[R];
#pragma unroll
    for (int k = 0; k < R; ++k) v[k] = X[PIDX(base + k * s)];
    dft_fwd<R>(v);
    if (s > 1) {
        int pp = p * (16384 / n); asm volatile("" : "+v"(pp));
        const cf w1 = tw[pp]; cf w = w1;
#pragma unroll
        for (int m = 1; m < R; ++m) { v[brev<R>(m)] = cmul(v[brev<R>(m)], w); w = cmul(w, w1); }
    }
#pragma unroll
    for (int k = 0; k < R; ++k) X[PIDX(base + k * s)] = v[k];
}
template <int R> DI void fft_pass_inv(LAS cf* X, const LAS cf* tw, int n, int g) {
    const int s = n / R, q = g / s, p = g - q * s, base = q * n + p;
    cf v[R];
#pragma unroll
    for (int k = 0; k < R; ++k) v[k] = X[PIDX(base + k * s)];
    if (s > 1) {
        int pp = p * (16384 / n); asm volatile("" : "+v"(pp));
        cf w1 = tw[pp]; w1.y = -w1.y; cf w = w1;
#pragma unroll
        for (int m = 1; m < R; ++m) { v[brev<R>(m)] = cmul(v[brev<R>(m)], w); w = cmul(w, w1); }
    }
    dft_inv<R>(v);
#pragma unroll
    for (int k = 0; k < R; ++k) X[PIDX(base + k * s)] = v[k];
}
DI void fft16k_fwd(LAS cf* X, const LAS cf* tw) {
    const int t = TID();
#pragma unroll 1
    for (int g = 0; g < 2; ++g) fft_pass_fwd<16>(X, tw, 16384, t + 512 * g);
    __syncthreads();
#pragma unroll 1
    for (int g = 0; g < 2; ++g) fft_pass_fwd<16>(X, tw, 1024, t + 512 * g);
    __syncthreads();
#pragma unroll 1
    for (int g = 0; g < 2; ++g) fft_pass_fwd<16>(X, tw, 64, t + 512 * g);
    __syncthreads();
#pragma unroll 1
    for (int g = 0; g < 8; ++g) fft_pass_fwd<4>(X, tw, 4, t + 512 * g);
    __syncthreads();
}
DI void fft16k_inv(LAS cf* X, const LAS cf* tw) {
    const int t = TID();
#pragma unroll 1
    for (int g = 0; g < 8; ++g) fft_pass_inv<4>(X, tw, 4, t + 512 * g);
    __syncthreads();
#pragma unroll 1
    for (int g = 0; g < 2; ++g) fft_pass_inv<16>(X, tw, 64, t + 512 * g);
    __syncthreads();
#pragma unroll 1
    for (int g = 0; g < 2; ++g) fft_pass_inv<16>(X, tw, 1024, t + 512 * g);
    __syncthreads();
#pragma unroll 1
    for (int g = 0; g < 2; ++g) fft_pass_inv<16>(X, tw, 16384, t + 512 * g);
    __syncthreads();
}

struct Params { const float* in[33]; float* out; unsigned char* ws; int ph_lo, ph_hi; };
struct KC {
    const float *x, *c, *ctx, *c_ctx, *ada_w, *ada_b, *norm_mix, *norm_ffn, *norm_final;
    const float *dn_w_in, *dn_conv, *dn_a_log, *dn_dt_bias, *dn_out_norm, *dn_w_out;
    const float *hy_w_in, *hy_conv, *hy_f_w1, *hy_f_b1, *hy_f_freq, *hy_f_w2, *hy_f_b2, *hy_f_w3, *hy_bias, *hy_w_out;
    const float *sc_w_in, *sc_conv, *sc_w_out, *w_router, *router_bias, *moe_w_gate, *moe_w_up, *moe_w_down;
    float* out; unsigned char* ws;
};

PF void job_mod(const KC& k, LAS float* lds) {
    const int tid = TID(), cj = tid & 63, kq = tid >> 6;
    float* mod = (float*)(k.ws + WS_MOD);
    LAS float* sl = lds + 2048;
    for (int i = tid; i < 3072; i += NTHR) { const float v = i < 1024 ? k.c_ctx[i] : k.c[i - 1024]; sl[i] = siluf(v); }
    __syncthreads();
    for (int u = blockIdx.x; u < DEPTH * 96; u += gridDim.x) {
        const int l = u / 96, cc = u % 96, col = cc * 64 + cj;
        const float* W = k.ada_w + (size_t)l * 1024 * 6144 + col;
        float a0 = 0.f, a1 = 0.f, a2 = 0.f;
        for (int k0 = kq * 128; k0 < kq * 128 + 128; k0 += 16) {
            float w[16];
#pragma unroll
            for (int e = 0; e < 16; ++e) w[e] = W[(size_t)(k0 + e) * 6144];
            asm volatile("" ::: "memory");
#pragma unroll
            for (int e = 0; e < 16; ++e) { a0 += sl[k0 + e] * w[e]; a1 += sl[1024 + k0 + e] * w[e]; a2 += sl[2048 + k0 + e] * w[e]; }
        }
        lds[(kq * 3 + 0) * 64 + cj] = a0; lds[(kq * 3 + 1) * 64 + cj] = a1; lds[(kq * 3 + 2) * 64 + cj] = a2;
        __syncthreads();
        if (tid < 192) {
            const int r = tid >> 6, j = tid & 63;
            float sacc = 0.f;
            for (int q = 0; q < 8; ++q) sacc += lds[(q * 3 + r) * 64 + j];
            mod[(size_t)(l * 3 + r) * 6144 + cc * 64 + j] = sacc + k.ada_b[l * 6144 + cc * 64 + j];
        }
        __syncthreads();
    }
}
DI void cvt_matrix(const float* src, int ld, size_t sstride, int K, int N, int nmat, bf16_t* dst, int ldd, size_t dstride, int mapmode, LAS float* lds, int bid, int nb) {
    const int tk = K / 64, tn = N / 64, per = tk * tn, tid = TID();
    const int r = tid >> 4, c4 = (tid & 15) * 4;
    f32x4 v0, v1;
    int u = bid;
    if (u < per * nmat) { const int m = u / per, t = u % per; const float* sp = src + (size_t)m * sstride + (size_t)((t / tn) * 64 + r) * ld + (t % tn) * 64 + c4; v0 = *(const f32x4*)sp; v1 = *(const f32x4*)(sp + (size_t)32 * ld); }
    for (; u < per * nmat; u += nb) {
        const int m = u / per, t = u % per, k0 = (t / tn) * 64, n0 = (t % tn) * 64;
        { LAS float* p = lds + r * 65 + c4; p[0] = v0[0]; p[1] = v0[1]; p[2] = v0[2]; p[3] = v0[3];
          LAS float* p2 = lds + (r + 32) * 65 + c4; p2[0] = v1[0]; p2[1] = v1[1]; p2[2] = v1[2]; p2[3] = v1[3]; }
        { const int un = u + nb;
          if (un < per * nmat) { const int mn = un / per, tn_ = un % per; const float* sp = src + (size_t)mn * sstride + (size_t)((tn_ / tn) * 64 + r) * ld + (tn_ % tn) * 64 + c4; v0 = *(const f32x4*)sp; v1 = *(const f32x4*)(sp + (size_t)32 * ld); } }
        lds_barrier();
        { const int nn = tid >> 3, ks = (tid & 7) * 8; const int n = n0 + nn;
          const int row = mapmode == 0 ? n : (32 * (n >> 4) + (n & 15) + (mapmode == 2 ? 16 : 0));
          float f[8];
#pragma unroll
          for (int e = 0; e < 8; ++e) f[e] = lds[(ks + e) * 65 + nn];
          u32x4 o; o[0] = pk2(f[0], f[1]); o[1] = pk2(f[2], f[3]); o[2] = pk2(f[4], f[5]); o[3] = pk2(f[6], f[7]);
          *(u32x4*)(dst + (size_t)m * dstride + (size_t)row * ldd + k0 + ks) = o; }
        lds_barrier();
    }
}
PF void job_cvt_small(const KC& k, LAS float* lds) {
    cvt_matrix(k.dn_w_in, DN_IN, (size_t)1024 * DN_IN, 1024, 4096, 2, (bf16_t*)(k.ws + WS_DNWIN), 1024, (size_t)4096 * 1024, 0, lds, (int)blockIdx.x, (int)gridDim.x);
    cvt_matrix(k.dn_w_out, 1024, (size_t)1024 * 1024, 1024, 1024, 2, (bf16_t*)(k.ws + WS_DNWOUT), 1024, (size_t)1024 * 1024, 0, lds, (int)blockIdx.x, (int)gridDim.x);
    cvt_matrix(k.hy_w_in, 3072, 0, 1024, 3072, 1, (bf16_t*)(k.ws + WS_HYWIN), 1024, 0, 0, lds, (int)blockIdx.x, (int)gridDim.x);
    cvt_matrix(k.hy_w_out, 1024, 0, 1024, 1024, 1, (bf16_t*)(k.ws + WS_HYWOUT), 1024, 0, 0, lds, (int)blockIdx.x, (int)gridDim.x);
    cvt_matrix(k.sc_w_in, 3072, 0, 1024, 3072, 1, (bf16_t*)(k.ws + WS_SCWIN), 1024, 0, 0, lds, (int)blockIdx.x, (int)gridDim.x);
    cvt_matrix(k.sc_w_out, 1024, 0, 1024, 1024, 1, (bf16_t*)(k.ws + WS_SCWOUT), 1024, 0, 0, lds, (int)blockIdx.x, (int)gridDim.x);
}
PF void job_cvt_moe(const KC& k, int layer, LAS float* lds, int bid, int nb) {
    if (bid < 0) return;
    const size_t lo = (size_t)layer * 32 * 1024 * 512;
    cvt_matrix(k.moe_w_gate + lo, 512, (size_t)1024 * 512, 1024, 512, 32, (bf16_t*)(k.ws + AR_WGU), 1024, (size_t)1024 * 1024, 1, lds, bid, nb);
    cvt_matrix(k.moe_w_up + lo, 512, (size_t)1024 * 512, 1024, 512, 32, (bf16_t*)(k.ws + AR_WGU), 1024, (size_t)1024 * 1024, 2, lds, bid, nb);
    cvt_matrix(k.moe_w_down + lo, 1024, (size_t)512 * 1024, 512, 1024, 32, (bf16_t*)(k.ws + AR_WD), 512, (size_t)1024 * 512, 0, lds, bid, nb);
}
PF void job_hdn(const KC& k, LAS float* lds) {
    const int tid = TID(), lane = tid & 63, wave = tid >> 6;
    LAS float* feat = lds + wave * 128; LAS float* h1 = feat + 64;
    const float fr = k.hy_f_freq[lane], b1 = k.hy_f_b1[lane], b2 = k.hy_f_b2[lane];
    for (int u0 = blockIdx.x * 8; u0 < 16384 + 256; u0 += gridDim.x * 8) {
        const int u = u0 + wave;
        int l, pos; float* dst;
        if (u < 16384) { l = 16384; pos = u; dst = nullptr; }
        else { l = 256; pos = u - 16384; dst = (float*)(k.ws + WS_HDNC) + (size_t)pos * 64; }
        const float t = (float)pos / (float)(l - 1);
        float f = 0.f;
        if (lane == 0) f = t;
        else if (lane <= 32) {
            const int bi = (lane - 1) & 15;
            const float band = 1e-4f + (float)bi * ((15.0f - 1e-4f) / 15.0f);
            const float ang = (6.283185307179586f / (float)l) * (float)pos * band;
            f = lane <= 16 ? cosf(ang) : -sinf(ang);
        }
        feat[lane] = f;
        __syncthreads();
        float a = b1;
        for (int i = 0; i < 33; ++i) a += feat[i] * k.hy_f_w1[i * 64 + lane];
        h1[lane] = sinf(fr * a);
        __syncthreads();
        float a2 = b2;
        for (int j = 0; j < 64; ++j) a2 += h1[j] * k.hy_f_w2[j * 64 + lane];
        const float hv = sinf(fr * a2);
        if (dst) dst[lane] = hv;
        else { bf16_t* hs = (bf16_t*)(k.ws + WS_HS) + (size_t)pos * 256; const bf16_t hi = f2bf(hv), lo = f2bf(hv - bf2f(hi)); hs[lane] = hi; hs[64 + lane] = lo; hs[128 + lane] = hi; hs[192 + lane] = 0; }
        __syncthreads();
    }
}
PF void job_w3s(const KC& k) {
    bf16_t* W = (bf16_t*)(k.ws + WS_W3S);
    const int tq = TID();
    for (int idx = blockIdx.x * NTHR + tq; idx < 64 * 4096; idx += gridDim.x * NTHR) {
        const int j = idx >> 12, col = idx & 4095;
        const float w = k.hy_f_w3[idx]; const bf16_t hi = f2bf(w), lo = f2bf(w - bf2f(hi));
        W[(size_t)col * 256 + j] = hi; W[(size_t)col * 256 + 64 + j] = hi; W[(size_t)col * 256 + 128 + j] = lo; W[(size_t)col * 256 + 192 + j] = 0;
    }
}
DI float hy_delta(int ch) {
    const float lo = -4.605170185988091f / 1.5f, hi = -4.605170185988091f / 0.3f;
    return fabsf(lo + (float)ch * ((hi - lo) / 1023.0f));
}
PF void job_filtc(const KC& k, int j) {
    const float* hdn = (const float*)(k.ws + WS_HDNC);
    const float* w3 = k.hy_f_w3 + (size_t)j * 64 * 4096;
    float* filtc = (float*)(k.ws + WS_FILTC);
    const int tq = TID();
    for (int u = blockIdx.x; u < 256 * 8; u += gridDim.x) {
        const int l = u >> 3, col = (u & 7) * 512 + tq;
        float a = 0.f;
        for (int q = 0; q < 64; ++q) a += hdn[l * 64 + q] * w3[(size_t)q * 4096 + col];
        const float t = (float)l / 255.0f;
        filtc[(size_t)l * 4096 + col] = a * expf(-t * hy_delta(col & 1023));
    }
}

template <int MODE>
PF void norm_phase(const KC& k, int layer, bool first, bool combine, const float* __restrict__ gain, int mb, const float* __restrict__ Wsk, int ldw,
                   const float* __restrict__ aux0, const float* __restrict__ aux1, bool last, LAS float* lds, bool flush = true) {
    const int tid = TID(), lane = tid & 63, wave = tid >> 6;
    float* xs = (float*)(k.ws + WS_XS);
    bf16_t* hbuf = (bf16_t*)(k.ws + AR_HBUF);
    const float* mod = (const float*)(k.ws + WS_MOD);
    const bf16_t* ys = (const bf16_t*)(k.ws + AR_YS);
    const int* tokp = (const int*)(k.ws + WS_TOKP);
    const float* tokw = (const float*)(k.ws + WS_TOKW);
    LAS int* lcnt = (LAS int*)(lds + 32768);
    if (MODE == 1 && tid < 32) lcnt[tid] = 0;
    if (MODE == 1 || MODE == 2) {
        for (int idx = tid; idx < 1024 * 32; idx += NTHR) {
            const int kk = idx >> 5, n = idx & 31;
            lds[kk * 32 + (((n >> 2) ^ ((kk >> 1) & 7)) << 2) + (n & 3)] = Wsk[(size_t)kk * ldw + n];
        }
        __syncthreads();
    }
    const int rbeg = (MODE == 3) ? TC : 0, rstr = gridDim.x * 8;
    int cur_mr = -1; float gsv[16], shv[16], g5v[16];
    float xn[16];
    int r = rbeg + blockIdx.x * 8 + wave;
    if (r < T) {
        const float* src = first ? (r < TC ? k.ctx + (size_t)r * 1024 : k.x + (size_t)(r - TC) * 1024) : xs + (size_t)r * 1024;
#pragma unroll
        for (int m = 0; m < 16; ++m) xn[m] = src[lane + 64 * m];
    }
    for (; r < T; r += rstr) {
        const int mr = modrow(r);
        float x[16];
#pragma unroll
        for (int m = 0; m < 16; ++m) x[m] = xn[m];
        int p0 = 0, p1 = 0; float w0 = 0.f, w1 = 0.f;
        if (combine) { p0 = tokp[2 * r]; p1 = tokp[2 * r + 1]; w0 = tokw[2 * r]; w1 = tokw[2 * r + 1]; }
        {
            const int rn = r + rstr;
            if (rn < T) {
                const float* srcn = first ? (rn < TC ? k.ctx + (size_t)rn * 1024 : k.x + (size_t)(rn - TC) * 1024) : xs + (size_t)rn * 1024;
#pragma unroll
                for (int m = 0; m < 16; ++m) xn[m] = srcn[lane + 64 * m];
            }
        }
        if (mr != cur_mr) {
            cur_mr = mr;
            if (MODE != 3) {
                const float* shift = mod + ((size_t)(layer * 3 + mr) * 6 + mb) * 1024;
#pragma unroll
                for (int m = 0; m < 16; ++m) { const int col = lane + 64 * m; gsv[m] = gain[col] * (1.0f + shift[1024 + col]); shv[m] = shift[col]; }
            } else {
#pragma unroll
                for (int m = 0; m < 16; ++m) gsv[m] = gain[lane + 64 * m];
            }
            if (combine) {
                const float* g5 = mod + ((size_t)((layer - 1) * 3 + mr) * 6 + 5) * 1024;
#pragma unroll
                for (int m = 0; m < 16; ++m) g5v[m] = g5[lane + 64 * m];
            }
        }
        if (combine) {
            bf16_t ya[16], yb[16];
#pragma unroll
            for (int m = 0; m < 16; ++m) { const int col = lane + 64 * m; ya[m] = ys[(size_t)p0 * 1024 + col]; yb[m] = ys[(size_t)p1 * 1024 + col]; }
            asm volatile("" ::: "memory");
#pragma unroll
            for (int m = 0; m < 16; ++m) x[m] += g5v[m] * (w0 * bf2f(ya[m]) + w1 * bf2f(yb[m]));
        }
        if (first || combine) {
#pragma unroll
            for (int m = 0; m < 16; ++m) xs[(size_t)r * 1024 + lane + 64 * m] = x[m];
        }
        float ss = 0.f;
#pragma unroll
        for (int m = 0; m < 16; ++m) ss += x[m] * x[m];
        ss = wsum(ss, lane);
        const float rstd = rsqrtf(ss * (1.0f / 1024.0f) + EPS);
        if (MODE == 3) {
#pragma unroll
            for (int m = 0; m < 16; ++m) { const int col = lane + 64 * m; k.out[(size_t)(r - TC) * 1024 + col] = x[m] * rstd * gsv[m]; }
            continue;
        }
        float y[16];
#pragma unroll
        for (int m = 0; m < 16; ++m) {
            const int col = lane + 64 * m;
            y[m] = x[m] * rstd * gsv[m] + shv[m];
            hbuf[(size_t)r * 1024 + col] = f2bf(y[m]);
        }
        if (MODE == 1 || MODE == 2) {
            float acc[32];
#pragma unroll
            for (int n = 0; n < 32; ++n) acc[n] = 0.f;
#pragma unroll
            for (int m = 0; m < 16; ++m) {
                f32x4 wa[8];
                const int c = lane + 64 * m; const LAS float* wr = lds + c * 32; const int sw = (c >> 1) & 7;
#pragma unroll
                for (int q = 0; q < 8; ++q) wa[q] = *(const LAS f32x4*)(wr + ((q ^ sw) << 2));
                asm volatile("" ::: "memory");
#pragma unroll
                for (int q = 0; q < 8; ++q) { acc[4 * q + 0] += y[m] * wa[q][0]; acc[4 * q + 1] += y[m] * wa[q][1]; acc[4 * q + 2] += y[m] * wa[q][2]; acc[4 * q + 3] += y[m] * wa[q][3]; }
            }
            float val;
            {
                float a16[16], a8[8], a4[4], a2[2];
                const bool b5 = (lane & 32) != 0, b4 = (lane & 16) != 0, b3 = (lane & 8) != 0, b2 = (lane & 4) != 0, b1 = (lane & 2) != 0;
#pragma unroll
                for (int i = 0; i < 16; ++i) { const float send = b5 ? acc[i] : acc[i + 16], keep = b5 ? acc[i + 16] : acc[i]; a16[i] = keep + shx(send, 32, lane); }
#pragma unroll
                for (int i = 0; i < 8; ++i) { const float send = b4 ? a16[i] : a16[i + 8], keep = b4 ? a16[i + 8] : a16[i]; a8[i] = keep + shx(send, 16, lane); }
#pragma unroll
                for (int i = 0; i < 4; ++i) { const float send = b3 ? a8[i] : a8[i + 4], keep = b3 ? a8[i + 4] : a8[i]; a4[i] = keep + shx(send, 8, lane); }
#pragma unroll
                for (int i = 0; i < 2; ++i) { const float send = b2 ? a4[i] : a4[i + 2], keep = b2 ? a4[i + 2] : a4[i]; a2[i] = keep + shx(send, 4, lane); }
                { const float send = b1 ? a2[0] : a2[1], keep = b1 ? a2[1] : a2[0]; val = keep + shx(send, 2, lane); }
                val += shx(val, 1, lane);
            }
            const int n = lane >> 1;
            if (MODE == 1) {
                int* toke = (int*)(k.ws + WS_TOKE); float* tokwW = (float*)(k.ws + WS_TOKW);
                if (last && r < TC) { if (lane == 0) { int neg = -1; asm volatile("" : "+v"(neg)); toke[2 * r] = neg; toke[2 * r + 1] = neg; } continue; }
                const float sc = 1.0f / (1.0f + expf(-val)), ch = sc + aux0[n];
                const int gl = lane & ~7;
                const float ca = shi(ch, gl), cb = shi(ch, gl + 2), cc = shi(ch, gl + 4), cd = shi(ch, gl + 6);
                const float hi1 = fmaxf(ca, cb), lo1 = fminf(ca, cb), hi2 = fmaxf(cc, cd), lo2 = fminf(cc, cd);
                float gs = fmaxf(hi1, hi2) + fmaxf(fminf(hi1, hi2), fmaxf(lo1, lo2));
                int gi = lane >> 3;
#pragma unroll
                for (int m = 8; m <= 32; m <<= 1) {
                    const float og = shx(gs, m, lane); const int oi = shii(gi, lane ^ m);
                    if (og > gs || (og == gs && oi < gi)) { gs = og; gi = oi; }
                }
                float c4[4], s4[4];
#pragma unroll
                for (int i = 0; i < 4; ++i) { c4[i] = shi(ch, gi * 8 + 2 * i); s4[i] = shi(sc, gi * 8 + 2 * i); }
                int i1 = 0; float b1v = c4[0];
#pragma unroll
                for (int i = 1; i < 4; ++i) if (c4[i] > b1v) { b1v = c4[i]; i1 = i; }
                int i2 = -1; float b2v = -1e30f;
#pragma unroll
                for (int i = 0; i < 4; ++i) if (i != i1 && c4[i] > b2v) { b2v = c4[i]; i2 = i; }
                float w1v = 0.f, w2v = 0.f;
#pragma unroll
                for (int i = 0; i < 4; ++i) { if (i == i1) w1v = s4[i]; if (i == i2) w2v = s4[i]; }
                const float inv = 1.0f / (w1v + w2v);
                if (lane == 0) {
                    const int e1 = gi * 4 + i1, e2 = gi * 4 + i2;
                    toke[2 * r] = e1; toke[2 * r + 1] = e2; tokwW[2 * r] = w1v * inv; tokwW[2 * r + 1] = w2v * inv;
                    __hip_atomic_fetch_add(lcnt + e1, 1, __ATOMIC_RELAXED, __HIP_MEMORY_SCOPE_WORKGROUP);
                    __hip_atomic_fetch_add(lcnt + e2, 1, __ATOMIC_RELAXED, __HIP_MEMORY_SCOPE_WORKGROUP);
                }
            } else {
                float* gb = (float*)(k.ws + WS_GB);
                if ((lane & 1) == 0) {
                    if (n < 16) {
                        const float z = val + aux1[n];
                        const float ez = __expf(z); const float sp = z > 15.f ? z : (ez < 1e-4f ? ez - 0.5f * ez * ez : __logf(1.0f + ez));
                        gb[(size_t)r * 32 + n] = -expf(aux0[n]) * sp;
                    } else {
                        gb[(size_t)r * 32 + n] = 1.0f / (1.0f + expf(-val));
                    }
                }
            }
        }
    }
    if (MODE == 1) {
        __syncthreads();
        int* cnt = (int*)(k.ws + WS_CTL + CTL_CNT) + layer * 32;
        if (flush && tid < 32 && lcnt[tid] > 0) atomicAdd(&cnt[tid], lcnt[tid]);
    }
}

constexpr int NM_WLD = 1032;
template <int MODE>
PF void norm_mfma(const KC& k, int layer, bool first, bool combine, const float* __restrict__ gain, int mb, const float* __restrict__ Wsk, int ldw,
                  const float* __restrict__ aux0, const float* __restrict__ aux1, bool last, LAS unsigned char* lds, bool flush = true) {
    const int tid = TID(), lane = tid & 63, wave = __builtin_amdgcn_readfirstlane(tid >> 6), row = lane & 15, q = lane >> 4;
    LAS bf16_t* WtH = (LAS bf16_t*)lds; LAS bf16_t* WtL = WtH + 32 * NM_WLD;
    LAS float* red = (LAS float*)(WtL + 32 * NM_WLD);
    LAS float* lg = red + 128;
    LAS int* lcnt = (LAS int*)(lg + 8 * 16 * 32);
    float* xs = (float*)(k.ws + WS_XS);
    bf16_t* hbuf = (bf16_t*)(k.ws + AR_HBUF);
    const float* mod = (const float*)(k.ws + WS_MOD);
    const bf16_t* ys = (const bf16_t*)(k.ws + AR_YS);
    const int* tokp = (const int*)(k.ws + WS_TOKP); const float* tokw = (const float*)(k.ws + WS_TOKW);
    if (MODE == 1 && tid < 32) lcnt[tid] = 0;
    for (int idx = tid; idx < 1024 * 32; idx += NTHR) {
        const int kk = idx >> 5, n = idx & 31;
        const float w = Wsk[(size_t)kk * ldw + n]; const bf16_t hi = f2bf(w);
        WtH[n * NM_WLD + kk] = hi; WtL[n * NM_WLD + kk] = f2bf(w - bf2f(hi));
    }
    __syncthreads();
    const int cbase = 128 * wave + 8 * q;
    f32x4 xn[8];
    int bt = blockIdx.x;
    if (bt < T / 16) {
        const float* sb = first ? (16 * bt < TC ? k.ctx : k.x - (size_t)TC * 1024) : xs;
        const unsigned off = (unsigned)(16 * bt + row) * 1024u + (unsigned)cbase;
#pragma unroll
        for (int kk = 0; kk < 4; ++kk) { xn[2 * kk] = *(const f32x4*)(sb + off + 32 * kk); xn[2 * kk + 1] = *(const f32x4*)(sb + off + 32 * kk + 4); }
    }
    for (; bt < T / 16; bt += gridDim.x) {
        const int r = 16 * bt + row, mr = modrow(16 * bt);
        const unsigned roff = (unsigned)r * 1024u + (unsigned)cbase;
        float x[32];
#pragma unroll
        for (int i = 0; i < 8; ++i) { x[4 * i] = xn[i][0]; x[4 * i + 1] = xn[i][1]; x[4 * i + 2] = xn[i][2]; x[4 * i + 3] = xn[i][3]; }
        int p0 = 0, p1 = 0; float w0 = 0.f, w1 = 0.f;
        if (combine) { p0 = tokp[2 * r]; p1 = tokp[2 * r + 1]; w0 = tokw[2 * r]; w1 = tokw[2 * r + 1]; }
        {
            const int bn = bt + gridDim.x;
            if (bn < T / 16) {
                const float* sb = first ? (16 * bn < TC ? k.ctx : k.x - (size_t)TC * 1024) : xs;
                const unsigned off = (unsigned)(16 * bn + row) * 1024u + (unsigned)cbase;
#pragma unroll
                for (int kk = 0; kk < 4; ++kk) { xn[2 * kk] = *(const f32x4*)(sb + off + 32 * kk); xn[2 * kk + 1] = *(const f32x4*)(sb + off + 32 * kk + 4); }
            }
        }
        const float* shift = mod + ((size_t)(layer * 3 + mr) * 6 + mb) * 1024;
        if (combine) {
            const float* g5 = mod + ((size_t)((layer - 1) * 3 + mr) * 6 + 5) * 1024;
            u32x4 ya[4], yb[4]; float g5v[32];
#pragma unroll
            for (int kk = 0; kk < 4; ++kk) { ya[kk] = *(const u32x4*)(ys + (size_t)p0 * 1024 + cbase + 32 * kk); yb[kk] = *(const u32x4*)(ys + (size_t)p1 * 1024 + cbase + 32 * kk);
                const f32x4 ga = *(const f32x4*)(g5 + cbase + 32 * kk), gb2 = *(const f32x4*)(g5 + cbase + 32 * kk + 4);
#pragma unroll
                for (int e = 0; e < 4; ++e) { g5v[8 * kk + e] = ga[e]; g5v[8 * kk + 4 + e] = gb2[e]; } }
            asm volatile("" ::: "memory");
#pragma unroll
            for (int kk = 0; kk < 4; ++kk)
#pragma unroll
                for (int w = 0; w < 4; ++w) {
                    x[8 * kk + 2 * w] += g5v[8 * kk + 2 * w] * (w0 * __uint_as_float(ya[kk][w] << 16) + w1 * __uint_as_float(yb[kk][w] << 16));
                    x[8 * kk + 2 * w + 1] += g5v[8 * kk + 2 * w + 1] * (w0 * __uint_as_float(ya[kk][w] & 0xffff0000u) + w1 * __uint_as_float(yb[kk][w] & 0xffff0000u));
                }
        }
        if (first || combine) {
#pragma unroll
            for (int kk = 0; kk < 4; ++kk) {
                *(f32x4*)(xs + roff + 32 * kk) = (f32x4){x[8 * kk], x[8 * kk + 1], x[8 * kk + 2], x[8 * kk + 3]};
                *(f32x4*)(xs + roff + 32 * kk + 4) = (f32x4){x[8 * kk + 4], x[8 * kk + 5], x[8 * kk + 6], x[8 * kk + 7]};
            }
        }
        float ss = 0.f;
#pragma unroll
        for (int i = 0; i < 32; ++i) ss += x[i] * x[i];
        ss += shx(ss, 16, lane); ss += shx(ss, 32, lane);
        if (q == 0) red[wave * 16 + row] = ss;
        __syncthreads();
        float tot = 0.f;
#pragma unroll
        for (int w = 0; w < 8; ++w) tot += red[w * 16 + row];
        const float rstd = rsqrtf(tot * (1.0f / 1024.0f) + EPS);
        f32x4 acc[2]; acc[0] = (f32x4){0.f, 0.f, 0.f, 0.f}; acc[1] = (f32x4){0.f, 0.f, 0.f, 0.f};
#pragma unroll
        for (int kk = 0; kk < 4; ++kk) {
            float y[8]; u32x4 ah, al;
            {
                const unsigned co = (unsigned)cbase + 32u * kk;
                const f32x4 g0 = *(const f32x4*)(gain + co), g1 = *(const f32x4*)(gain + co + 4), s0 = *(const f32x4*)(shift + 1024 + co), s1 = *(const f32x4*)(shift + 1024 + co + 4),
                            h0 = *(const f32x4*)(shift + co), h1 = *(const f32x4*)(shift + co + 4);
#pragma unroll
                for (int e = 0; e < 4; ++e) { y[e] = x[8 * kk + e] * rstd * g0[e] * (1.0f + s0[e]) + h0[e]; y[4 + e] = x[8 * kk + 4 + e] * rstd * g1[e] * (1.0f + s1[e]) + h1[e]; }
            }
#pragma unroll
            for (int w = 0; w < 4; ++w) {
                ah[w] = pk2(y[2 * w], y[2 * w + 1]);
                al[w] = pk2(y[2 * w] - __uint_as_float(ah[w] << 16), y[2 * w + 1] - __uint_as_float(ah[w] & 0xffff0000u));
            }
            *(u32x4*)(hbuf + roff + 32 * kk) = ah;
            const bf16x8 fah = __builtin_bit_cast(bf16x8, ah), fal = __builtin_bit_cast(bf16x8, al);
            bf16x8 bh[2], bl[2];
#pragma unroll
            for (int nt = 0; nt < 2; ++nt) {
                bh[nt] = *(const LAS bf16x8*)(WtH + (16 * nt + row) * NM_WLD + cbase + 32 * kk);
                bl[nt] = *(const LAS bf16x8*)(WtL + (16 * nt + row) * NM_WLD + cbase + 32 * kk);
            }
            asm volatile("" ::: "memory");
#pragma unroll
            for (int nt = 0; nt < 2; ++nt) {
                acc[nt] = __builtin_amdgcn_mfma_f32_16x16x32_bf16(fah, bh[nt], acc[nt], 0, 0, 0);
                acc[nt] = __builtin_amdgcn_mfma_f32_16x16x32_bf16(fal, bh[nt], acc[nt], 0, 0, 0);
                acc[nt] = __builtin_amdgcn_mfma_f32_16x16x32_bf16(fah, bl[nt], acc[nt], 0, 0, 0);
            }
        }
#pragma unroll
        for (int nt = 0; nt < 2; ++nt)
#pragma unroll
            for (int j = 0; j < 4; ++j) lg[(wave * 16 + 4 * q + j) * 32 + 16 * nt + row] = acc[nt][j];
        __syncthreads();
        {
            const int prow = tid >> 5, n = tid & 31, rr = 16 * bt + prow, hb = lane & 32;
            float val = 0.f;
#pragma unroll
            for (int w = 0; w < 8; ++w) val += lg[(w * 16 + prow) * 32 + n];
            if (MODE == 1) {
                int* toke = (int*)(k.ws + WS_TOKE); float* tokwW = (float*)(k.ws + WS_TOKW);
                const bool unrouted = last && rr < TC;
                const float sc = 1.0f / (1.0f + expf(-val)), ch = sc + aux0[n];
                const int gl = hb + (n & ~3);
                const float ca = shi(ch, gl), cb = shi(ch, gl + 1), cc = shi(ch, gl + 2), cd = shi(ch, gl + 3);
                const float hi1 = fmaxf(ca, cb), lo1 = fminf(ca, cb), hi2 = fmaxf(cc, cd), lo2 = fminf(cc, cd);
                float gs = fmaxf(hi1, hi2) + fmaxf(fminf(hi1, hi2), fmaxf(lo1, lo2));
                int gi = n >> 2;
#pragma unroll
                for (int m = 4; m <= 16; m <<= 1) {
                    const float og = shx(gs, m, lane); const int oi = shii(gi, lane ^ m);
                    if (og > gs || (og == gs && oi < gi)) { gs = og; gi = oi; }
                }
                float c4[4], s4[4];
#pragma unroll
                for (int i = 0; i < 4; ++i) { c4[i] = shi(ch, hb + gi * 4 + i); s4[i] = shi(sc, hb + gi * 4 + i); }
                int i1 = 0; float b1v = c4[0];
#pragma unroll
                for (int i = 1; i < 4; ++i) if (c4[i] > b1v) { b1v = c4[i]; i1 = i; }
                int i2 = -1; float b2v = -1e30f;
#pragma unroll
                for (int i = 0; i < 4; ++i) if (i != i1 && c4[i] > b2v) { b2v = c4[i]; i2 = i; }
                float w1v = 0.f, w2v = 0.f;
#pragma unroll
                for (int i = 0; i < 4; ++i) { if (i == i1) w1v = s4[i]; if (i == i2) w2v = s4[i]; }
                const float inv = 1.0f / (w1v + w2v);
                if (n == 0) {
                    if (unrouted) { int neg = -1; asm volatile("" : "+v"(neg)); toke[2 * rr] = neg; toke[2 * rr + 1] = neg; }
                    else {
                        const int e1 = gi * 4 + i1, e2 = gi * 4 + i2;
                        toke[2 * rr] = e1; toke[2 * rr + 1] = e2; tokwW[2 * rr] = w1v * inv; tokwW[2 * rr + 1] = w2v * inv;
                        __hip_atomic_fetch_add(lcnt + e1, 1, __ATOMIC_RELAXED, __HIP_MEMORY_SCOPE_WORKGROUP);
                        __hip_atomic_fetch_add(lcnt + e2, 1, __ATOMIC_RELAXED, __HIP_MEMORY_SCOPE_WORKGROUP);
                    }
                }
            } else {
                float* gb = (float*)(k.ws + WS_GB);
                if (n < 16) {
                    const float z = val + aux1[n];
                    const float ez = __expf(z); const float sp = z > 15.f ? z : (ez < 1e-4f ? ez - 0.5f * ez * ez : __logf(1.0f + ez));
                    gb[(size_t)rr * 32 + n] = -expf(aux0[n]) * sp;
                } else {
                    gb[(size_t)rr * 32 + n] = 1.0f / (1.0f + expf(-val));
                }
            }
        }
        __syncthreads();
    }
    if (MODE == 1) {
        __syncthreads();
        int* cnt = (int*)(k.ws + WS_CTL + CTL_CNT) + layer * 32;
        if (flush && tid < 32 && lcnt[tid] > 0) atomicAdd(&cnt[tid], lcnt[tid]);
    }
}

namespace pg8 {
constexpr int BM = 256, BK = 64, HALF = 128, HTB = HALF * BK * 2, STAGE_BYTES = 8 * HTB;
DI int lds_byte(int r, int c) { const int st = (r >> 4) * 2 + (c >> 5), rr = r & 15, cc = c & 31, ob = rr * 64 + cc * 2; return st * 1024 + (ob ^ (((ob >> 9) & 1) << 5)); }
DI void stage_rc(int b, int& R, int& C) { const int st = b / 1024, sb = b % 1024, swz = sb ^ (((sb >> 9) & 1) << 5); R = (st >> 1) * 16 + swz / 64; C = (st & 1) * 32 + (swz % 64) / 2; }
DI int perm32(int rho) { const int n = rho >> 4, i = rho & 15; return 8 * (i >> 2) + 4 * n + (i & 3); }
struct Unit { int m0, mrows, pn; size_t boff; };
template <bool GATHER, class Epi, class Sched>
DI void gemm_phase(LAS unsigned char* lds, const bf16_t* A, const int* rowidx, const bf16_t* Bt, int K, const Sched& S, const Epi& E) {
    const int tid = TID(), wid = __builtin_amdgcn_readfirstlane(tid >> 6), lane = tid & 63, wr = wid >> 2, wc = wid & 3, fr = lane & 15, fq = lane >> 4;
    const int nt = K / BK;
    unsigned voffA[2], voffB[2];
#pragma unroll
    for (int i = 0; i < 2; ++i) { int R, C; stage_rc(tid * 16 + i * 8192, R, C); const int Rb = Epi::PERM ? ((R & ~31) + perm32(R & 31)) : R;
        voffA[i] = (unsigned)(R * K + C) * 2u; voffB[i] = (unsigned)(Rb * K + C) * 2u; }
    const size_t kstep = (size_t)(BK * 2);
    const size_t hstep = (size_t)HALF * K * 2;
    const size_t tstep = 2 * hstep;
    const size_t rstep = (size_t)K * 2;
    const unsigned ldsw = (unsigned)wid * 1024u;
    const int aoff = lds_byte(wr * 64 + fr, fq * 8), boff = lds_byte(wc * 32 + fr, fq * 8);
#define PG8_SA(b, h) (((b) * 2 + (h)) * HTB)
#define PG8_SB(b, h) ((4 + (b) * 2 + (h)) * HTB)
#define PG8_STAGE(bufoff, gbase, voff) do { _Pragma("unroll") for (int _i = 0; _i < 2; ++_i) \
        __builtin_amdgcn_global_load_lds((const unsigned*)((const char*)(gbase) + (voff)[_i]), (LAS unsigned*)(lds + (bufoff) + ldsw + _i * 8192), 16, 0, 0); } while (0)
#define PG8_STAGE_A(bufoff, p, h, vG) do { if (GATHER) PG8_STAGE(bufoff, p, (vG)[h]); else PG8_STAGE(bufoff, (p) + (h) * hstep, voffA); } while (0)
#define PG8_LDA(dst, b, h) do { _Pragma("unroll") for (int m = 0; m < 4; ++m) _Pragma("unroll") for (int k = 0; k < 2; ++k) dst[m][k] = *(const LAS bf16x8*)(lds + PG8_SA(b, h) + aoff + m * 2048 + k * 1024); } while (0)
#define PG8_LDB(dst, b, h) do { _Pragma("unroll") for (int n = 0; n < 2; ++n) _Pragma("unroll") for (int k = 0; k < 2; ++k) dst[n][k] = *(const LAS bf16x8*)(lds + PG8_SB(b, h) + boff + n * 2048 + k * 1024); } while (0)
#define PG8_MMA(ai, bj, At, Bt_) do { __builtin_amdgcn_s_setprio(1); _Pragma("unroll") for (int m = 0; m < 4; ++m) _Pragma("unroll") for (int n = 0; n < 2; ++n) _Pragma("unroll") for (int k = 0; k < 2; ++k) \
        acc[ai][bj][m][n] = __builtin_amdgcn_mfma_f32_16x16x32_bf16(Bt_[n][k], At[m][k], acc[ai][bj][m][n], 0, 0, 0); __builtin_amdgcn_s_setprio(0); } while (0)
#define PG8_WAIT_V(n) asm volatile("s_waitcnt vmcnt(" #n ")" ::: "memory")
#define PG8_WAIT_L(n) asm volatile("s_waitcnt lgkmcnt(" #n ")" ::: "memory")
#define PG8_BAR __builtin_amdgcn_s_barrier()
#define PG8_SCHED __builtin_amdgcn_sched_barrier(0)
#define PG8_AOFF(dst, u) do { _Pragma("unroll") for (int _h = 0; _h < 2; ++_h) _Pragma("unroll") for (int _i = 0; _i < 2; ++_i) { int _R, _C; stage_rc(tid * 16 + _i * 8192, _R, _C); \
        dst[_h][_i] = (unsigned)(rowidx[(u).m0 + _h * HALF + _R] * K + _C) * 2u; } } while (0)
    Unit cur, nxt; int ui = 0;
    if (!S.next(0, cur)) return;
    f32x4 acc[2][2][4][2];
#pragma unroll
    for (int a = 0; a < 2; ++a)
#pragma unroll
        for (int b = 0; b < 2; ++b)
#pragma unroll
            for (int m = 0; m < 4; ++m)
#pragma unroll
                for (int n = 0; n < 2; ++n) acc[a][b][m][n] = (f32x4){0.f, 0.f, 0.f, 0.f};
    bf16x8 At[4][2], B0[2][2], B1[2][2];
    unsigned vA[2][2], vN[2][2];
    if (GATHER) PG8_AOFF(vA, cur);
    const char* cA = (const char*)A + (GATHER ? (size_t)0 : (size_t)cur.m0 * rstep);
    const char* cB = (const char*)Bt + cur.boff + (size_t)cur.pn * tstep;
    PG8_STAGE(PG8_SB(0, 0), cB, voffB); PG8_STAGE_A(PG8_SA(0, 0), cA, 0, vA); PG8_STAGE(PG8_SB(0, 1), cB + hstep, voffB); PG8_STAGE_A(PG8_SA(0, 1), cA, 1, vA);
    if (wr == 1) PG8_BAR;
    PG8_WAIT_V(4); PG8_BAR;
    PG8_STAGE(PG8_SB(1, 0), cB + kstep, voffB); PG8_STAGE_A(PG8_SA(1, 0), cA + kstep, 0, vA); PG8_STAGE(PG8_SB(1, 1), cB + hstep + kstep, voffB);
    PG8_WAIT_V(6); PG8_BAR;
    for (;;) {
        const bool has_next = S.next(ui + 1, nxt);
        const char* nA = GATHER ? cA : (has_next ? (const char*)A + (size_t)nxt.m0 * rstep : cA);
        const char* nB = has_next ? (const char*)Bt + nxt.boff + (size_t)nxt.pn * tstep : cB;
        if (GATHER) {
            if (has_next) { PG8_AOFF(vN, nxt); }
            else {
#pragma unroll
                for (int h = 0; h < 2; ++h)
#pragma unroll
                    for (int i = 0; i < 2; ++i) vN[h][i] = vA[h][i];
            }
        }
        for (int t = 0; t < nt; t += 2) {
            const bool last = (t == nt - 2);
            const char* a1 = cA + (size_t)(t + 1) * kstep;
            const char* a2 = last ? nA : cA + (size_t)(t + 2) * kstep; const char* b2 = last ? nB : cB + (size_t)(t + 2) * kstep;
            const char* a3 = a2 + kstep; const char* b3 = b2 + kstep;
            PG8_LDB(B0, 0, 0); PG8_SCHED; PG8_LDA(At, 0, 0); PG8_STAGE_A(PG8_SA(1, 1), a1, 1, vA);
            if (GATHER && last) {
#pragma unroll
                for (int h = 0; h < 2; ++h)
#pragma unroll
                    for (int i = 0; i < 2; ++i) vA[h][i] = vN[h][i];
            }
            PG8_WAIT_L(8); PG8_BAR; PG8_WAIT_L(0); PG8_MMA(0, 0, At, B0); PG8_BAR; PG8_SCHED;
            PG8_LDB(B1, 0, 1); PG8_STAGE(PG8_SB(0, 0), b2, voffB);
            PG8_BAR; PG8_WAIT_L(0); PG8_MMA(0, 1, At, B1); PG8_BAR;
            PG8_LDA(At, 0, 1); PG8_STAGE_A(PG8_SA(0, 0), a2, 0, vA);
            PG8_BAR; PG8_WAIT_L(0); PG8_MMA(1, 0, At, B0); PG8_BAR; PG8_SCHED;
            PG8_STAGE(PG8_SB(0, 1), b2 + hstep, voffB);
            PG8_WAIT_V(6); PG8_BAR; PG8_MMA(1, 1, At, B1); PG8_BAR;
            PG8_LDB(B0, 1, 0); PG8_SCHED; PG8_LDA(At, 1, 0); PG8_STAGE_A(PG8_SA(0, 1), a2, 1, vA);
            PG8_WAIT_L(8); PG8_BAR; PG8_WAIT_L(0); PG8_MMA(0, 0, At, B0); PG8_BAR; PG8_SCHED;
            PG8_LDB(B1, 1, 1); PG8_STAGE(PG8_SB(1, 0), b3, voffB);
            PG8_BAR; PG8_WAIT_L(0); PG8_MMA(0, 1, At, B1); PG8_BAR;
            PG8_LDA(At, 1, 1); PG8_STAGE_A(PG8_SA(1, 0), a3, 0, vA);
            PG8_BAR; PG8_WAIT_L(0); PG8_MMA(1, 0, At, B0); PG8_BAR; PG8_SCHED;
            PG8_STAGE(PG8_SB(1, 1), b3 + hstep, voffB);
            PG8_WAIT_V(6); PG8_BAR; PG8_MMA(1, 1, At, B1); PG8_BAR;
        }
        { const int t2 = TID(), l2 = t2 & 63; E(acc, cur, wr, wc, l2 & 15, l2 >> 4); }
        if (!has_next) break;
#pragma unroll
        for (int a = 0; a < 2; ++a)
#pragma unroll
            for (int b = 0; b < 2; ++b)
#pragma unroll
                for (int m = 0; m < 4; ++m)
#pragma unroll
                    for (int n = 0; n < 2; ++n) acc[a][b][m][n] = (f32x4){0.f, 0.f, 0.f, 0.f};
        cur = nxt; cA = nA; cB = nB; ++ui;
    }
    PG8_WAIT_V(0);
    if (wr == 0) PG8_BAR;
    PG8_BAR;
#undef PG8_SA
#undef PG8_SB
#undef PG8_STAGE
#undef PG8_STAGE_A
#undef PG8_LDA
#undef PG8_LDB
#undef PG8_MMA
#undef PG8_WAIT_V
#undef PG8_WAIT_L
#undef PG8_BAR
#undef PG8_SCHED
#undef PG8_AOFF
}
struct DenseOrder {
    int nM, nN, nwg, G, c;
    DI void init(int M, int N, int G_, int c_) { nM = M / BM; nN = N / BM; nwg = nM * nN; G = G_; c = c_; }
    DI bool next(int i, Unit& u) const {
        const long L = (long)i * G + c; if (L >= nwg) return false;
        int wgid = (int)L; { const int q = nwg / 8, r = nwg % 8, xcd = wgid % 8, off = wgid / 8; wgid = (xcd < r ? xcd * (q + 1) : r * (q + 1) + (xcd - r) * q) + off; }
        const int nig = 8 * nN, gid = wgid / nig, fm = gid * 8, gsz = (nM - fm) < 8 ? (nM - fm) : 8;
        u.m0 = (fm + ((wgid % nig) % gsz)) * BM; u.mrows = BM; u.pn = (wgid % nig) / gsz; u.boff = 0; return true;
    }
};
struct MoeOrder {
    const LAS int* tb; int G, c; size_t estride; int lane;
    DI bool next(int i, Unit& u) const {
        const int L = i * G + c; if (L >= __builtin_amdgcn_readfirstlane(tb[97]) * 4) return false;
        const int tile = L >> 2;
        const int pre = tb[65 + (lane & 31)];
        const unsigned long long m = __ballot(lane < 32 && pre <= tile);
        const int e = __popcll(m) - 1;
        const int lt = tile - __builtin_amdgcn_readfirstlane(tb[65 + e]); int mr = __builtin_amdgcn_readfirstlane(tb[e]) - lt * 256; mr = mr > 256 ? 256 : mr;
        u.m0 = __builtin_amdgcn_readfirstlane(tb[32 + e]) + lt * 256; u.mrows = mr; u.pn = L & 3; u.boff = (size_t)e * estride; return true;
    }
};
}
struct EpiBf16 {
    static constexpr bool PERM = true;
    bf16_t* C; int ldc; int split_col; bf16_t* C2; int ldc2;
    DI void operator()(const f32x4 (&acc)[2][2][4][2], const pg8::Unit& u, int wr, int wc, int fr, int fq) const {
        int colt = u.pn * 256; bf16_t* base = C; int ld = ldc;
        if (colt >= split_col) { base = C2; ld = ldc2; colt -= split_col; }
#pragma unroll
        for (int ai = 0; ai < 2; ++ai)
#pragma unroll
            for (int m = 0; m < 4; ++m) {
                const int rl = ai * 128 + wr * 64 + m * 16 + fr;
                if (rl < u.mrows) {
                    bf16_t* rowp = base + (size_t)(u.m0 + rl) * ld + colt + wc * 32 + 8 * fq;
#pragma unroll
                    for (int bj = 0; bj < 2; ++bj) {
                        const f32x4 v0 = acc[ai][bj][m][0], v1 = acc[ai][bj][m][1];
                        u32x4 o; o[0] = cvt_pk_bf16(v0[0], v0[1]); o[1] = cvt_pk_bf16(v0[2], v0[3]); o[2] = cvt_pk_bf16(v1[0], v1[1]); o[3] = cvt_pk_bf16(v1[2], v1[3]);
                        *(u32x4*)(rowp + bj * 128) = o;
                    }
                }
            }
    }
};
struct EpiBf16T {
    static constexpr bool PERM = false;
    bf16_t* C; int ldc;
    DI void operator()(const f32x4 (&acc)[2][2][4][2], const pg8::Unit& u, int wr, int wc, int fr, int fq) const {
#pragma unroll
        for (int ai = 0; ai < 2; ++ai)
#pragma unroll
            for (int bj = 0; bj < 2; ++bj)
#pragma unroll
                for (int m = 0; m < 4; ++m)
#pragma unroll
                    for (int n = 0; n < 2; ++n) {
                        const int row = u.m0 + ai * 128 + wr * 64 + m * 16 + fr, col = u.pn * 256 + bj * 128 + wc * 32 + n * 16 + 4 * fq;
#pragma unroll
                        for (int e = 0; e < 4; ++e) C[(size_t)(col + e) * ldc + row] = f2bf(acc[ai][bj][m][n][e]);
                    }
    }
};
struct EpiTaps {
    static constexpr bool PERM = false;
    bf16_t* FT;
    DI void operator()(const f32x4 (&acc)[2][2][4][2], const pg8::Unit& u, int wr, int wc, int fr, int fq) const {
#pragma unroll
        for (int ai = 0; ai < 2; ++ai)
#pragma unroll
            for (int m = 0; m < 4; ++m) {
                const int row = u.m0 + ai * 128 + wr * 64 + m * 16 + fr; const float dl = hy_delta(row & 1023) * (1.0f / 16383.0f);
#pragma unroll
                for (int bj = 0; bj < 2; ++bj)
#pragma unroll
                    for (int n = 0; n < 2; ++n) {
                        const int l = u.pn * 256 + bj * 128 + wc * 32 + n * 16 + 4 * fq; float o[4];
#pragma unroll
                        for (int e = 0; e < 4; ++e) o[e] = acc[ai][bj][m][n][e] * __expf(-(float)(l + e) * dl);
                        u32x2 pk; pk[0] = pk2(o[0], o[1]); pk[1] = pk2(o[2], o[3]);
                        *(u32x2*)(FT + (size_t)row * 16384 + l) = pk;
                    }
            }
    }
};
struct EpiResid {
    static constexpr bool PERM = false;
    float* xs; const float* mod; int layer; int chunk;
    DI void operator()(const f32x4 (&acc)[2][2][4][2], const pg8::Unit& u, int wr, int wc, int fr, int fq) const {
        const float* g = mod + ((size_t)(layer * 3 + modrow(u.m0)) * 6 + chunk) * 1024;
#pragma unroll
        for (int bj = 0; bj < 2; ++bj)
#pragma unroll
            for (int n = 0; n < 2; ++n) {
                const int col = u.pn * 256 + bj * 128 + wc * 32 + n * 16 + 4 * fq; const f32x4 gv = *(const f32x4*)(g + col);
                float* p0 = xs + (size_t)(u.m0 + wr * 64 + fr) * 1024 + col;
                f32x4 old[8];
#pragma unroll
                for (int ai = 0; ai < 2; ++ai)
#pragma unroll
                    for (int m = 0; m < 4; ++m) old[ai * 4 + m] = *(const f32x4*)(p0 + (size_t)(ai * 128 + m * 16) * 1024);
                asm volatile("" ::: "memory");
#pragma unroll
                for (int ai = 0; ai < 2; ++ai)
#pragma unroll
                    for (int m = 0; m < 4; ++m) *(f32x4*)(p0 + (size_t)(ai * 128 + m * 16) * 1024) = old[ai * 4 + m] + gv * acc[ai][bj][m][n];
            }
    }
};
struct EpiGateUp {
    static constexpr bool PERM = false;
    bf16_t* hid;
    DI void operator()(const f32x4 (&acc)[2][2][4][2], const pg8::Unit& u, int wr, int wc, int fr, int fq) const {
#pragma unroll
        for (int ai = 0; ai < 2; ++ai)
#pragma unroll
            for (int m = 0; m < 4; ++m) {
                const int rl = ai * 128 + wr * 64 + m * 16 + fr;
                if (rl < u.mrows) {
#pragma unroll
                    for (int bj = 0; bj < 2; ++bj) {
                        const int hc = ((u.pn * 256 + bj * 128 + wc * 32) >> 1) + 4 * fq;
                        const f32x4 g = acc[ai][bj][m][0], up = acc[ai][bj][m][1];
                        u32x2 o; o[0] = cvt_pk_bf16(siluf(g[0]) * up[0], siluf(g[1]) * up[1]); o[1] = cvt_pk_bf16(siluf(g[2]) * up[2], siluf(g[3]) * up[3]);
                        *(u32x2*)(hid + (size_t)(u.m0 + rl) * 512 + hc) = o;
                    }
                }
            }
    }
};
template <class Epi>
PF void gemm_dense(LAS unsigned char* lds, const bf16_t* A, int M, const bf16_t* Bt, int N, int K, const Epi& epi) {
    pg8::DenseOrder S; S.init(M, N, (int)gridDim.x, (int)blockIdx.x);
    pg8::gemm_phase<false>(lds, A, (const int*)nullptr, Bt, K, S, epi);
}
DI void moe_table(const KC& k, int layer, LAS int* tb) {
    const int* cnt = (const int*)(k.ws + WS_CTL + CTL_CNT) + layer * 32;
    __syncthreads();
    const int tq = TID();
    if (tq < 32) tb[tq] = __hip_atomic_load(cnt + tq, __ATOMIC_RELAXED, __HIP_MEMORY_SCOPE_AGENT);
    __syncthreads();
    if (tq == 0) {
        int s = 0, tp = 0;
        for (int e = 0; e < 32; ++e) { tb[32 + e] = s; tb[65 + e] = tp; s += tb[e]; tp += (tb[e] + 255) >> 8; }
        tb[64] = s; tb[97] = tp;
    }
    __syncthreads();
}
template <int WHICH>
PF void moe_gemm(const KC& k, int layer, LAS unsigned char* lds, LAS int* tb) {
    moe_table(k, layer, tb);
    if (WHICH == 0) {
        pg8::MoeOrder S{tb, (int)gridDim.x, (int)blockIdx.x, (size_t)1024 * 1024 * 2, TID() & 63};
        EpiGateUp epi{(bf16_t*)(k.ws + AR_HID)};
        pg8::gemm_phase<true>(lds, (const bf16_t*)(k.ws + AR_HBUF), (const int*)(k.ws + WS_SLOT), (const bf16_t*)(k.ws + AR_WGU), 1024, S, epi);
    } else {
        pg8::MoeOrder S{tb, (int)gridDim.x, (int)blockIdx.x, (size_t)1024 * 512 * 2, TID() & 63};
        EpiBf16 epi{(bf16_t*)(k.ws + AR_YS), 1024, 1 << 30, nullptr, 0};
        pg8::gemm_phase<false>(lds, (const bf16_t*)(k.ws + AR_HID), (const int*)nullptr, (const bf16_t*)(k.ws + AR_WD), 512, S, epi);
    }
}
PF void moe_scatter(const KC& k, int layer, LAS int* tb) {
    moe_table(k, layer, tb);
    const int* toke = (const int*)(k.ws + WS_TOKE);
    int* tokp = (int*)(k.ws + WS_TOKP); int* slot = (int*)(k.ws + WS_SLOT);
    int* cur = (int*)(k.ws + WS_CTL + CTL_CNT) + 128 + layer * 32;
    LAS int* lc = tb + 128; LAS int* lb = tb + 160;
    const int tid = TID();
    if (blockIdx.x == 0 && tid < 256) slot[NA + tid] = 0;
    for (int r0 = blockIdx.x * NTHR; r0 < T; r0 += gridDim.x * NTHR) {
        const int r = r0 + tid;
        __syncthreads();
        if (tid < 32) lc[tid] = 0;
        __syncthreads();
        const int e0 = toke[2 * r], e1 = toke[2 * r + 1];
        int k0 = 0, k1 = 0;
        if (e0 >= 0) { k0 = __hip_atomic_fetch_add(lc + e0, 1, __ATOMIC_RELAXED, __HIP_MEMORY_SCOPE_WORKGROUP); k1 = __hip_atomic_fetch_add(lc + e1, 1, __ATOMIC_RELAXED, __HIP_MEMORY_SCOPE_WORKGROUP); }
        __syncthreads();
        if (tid < 32) lb[tid] = lc[tid] > 0 ? atomicAdd(&cur[tid], lc[tid]) : 0;
        __syncthreads();
        if (e0 >= 0) {
            const int p0 = tb[32 + e0] + lb[e0] + k0, p1 = tb[32 + e1] + lb[e1] + k1;
            slot[p0] = r; slot[p1] = r; tokp[2 * r] = p0; tokp[2 * r + 1] = p1;
        }
    }
}

DI void unpack8(const u32x4 v, float (&f)[8]) {
#pragma unroll
    for (int w = 0; w < 4; ++w) { f[2 * w] = __uint_as_float(v[w] << 16); f[2 * w + 1] = __uint_as_float(v[w] & 0xffff0000u); }
}
PF void sc_mix(const KC& k, int j) {
    const int tid = TID(), lane = tid & 63, wave = tid >> 6;
    const bf16_t* P = (const bf16_t*)(k.ws + AR_PB);
    bf16_t* U = (bf16_t*)(k.ws + AR_UBUF);
    const float* cw = k.sc_conv + (size_t)j * 3 * 1024;
    const int c0 = lane * 16;
    float k0[16], k1[16], k2[16];
#pragma unroll
    for (int e = 0; e < 16; ++e) { k0[e] = cw[c0 + e]; k1[e] = cw[1024 + c0 + e]; k2[e] = cw[2048 + c0 + e]; }
    for (int r = blockIdx.x * 8 + wave; r < T; r += gridDim.x * 8) {
        bool lok, rok;
        if (r < TC) { const int t = r & 255; lok = t != 0; rok = t != 255; } else { const int t = (r - TC) & 63; lok = t != 0; rok = t != 63; }
        const bf16_t* p = P + (size_t)r * 3072 + c0;
        const bf16_t* pl = lok ? p - 3072 : p; const bf16_t* pr = rok ? p + 3072 : p;
        u32x4 vb[2], vc[2], vx[2], vcl[2], vxl[2], vcr[2], vxr[2];
#pragma unroll
        for (int hh = 0; hh < 2; ++hh) {
            vb[hh] = *(const u32x4*)(p + hh * 8); vc[hh] = *(const u32x4*)(p + 1024 + hh * 8); vx[hh] = *(const u32x4*)(p + 2048 + hh * 8);
            vcl[hh] = *(const u32x4*)(pl + 1024 + hh * 8); vxl[hh] = *(const u32x4*)(pl + 2048 + hh * 8);
            vcr[hh] = *(const u32x4*)(pr + 1024 + hh * 8); vxr[hh] = *(const u32x4*)(pr + 2048 + hh * 8);
        }
        asm volatile("" ::: "memory");
        const float fl = lok ? 1.f : 0.f, frr = rok ? 1.f : 0.f;
#pragma unroll
        for (int hh = 0; hh < 2; ++hh) {
            float bg[8], cg[8], xi[8], cl[8], xl[8], cr[8], xr[8];
            unpack8(vb[hh], bg); unpack8(vc[hh], cg); unpack8(vx[hh], xi); unpack8(vcl[hh], cl); unpack8(vxl[hh], xl); unpack8(vcr[hh], cr); unpack8(vxr[hh], xr);
            u32x4 o;
#pragma unroll
            for (int w = 0; w < 4; ++w) {
                float ov[2];
#pragma unroll
                for (int e = 0; e < 2; ++e) { const int i = 2 * w + e, c = hh * 8 + i; ov[e] = bg[i] * (k0[c] * fl * cl[i] * xl[i] + k1[c] * cg[i] * xi[i] + k2[c] * frr * cr[i] * xr[i]); }
                o[w] = pk2(ov[0], ov[1]);
            }
            *(u32x4*)(U + (size_t)r * 1024 + c0 + hh * 8) = o;
        }
    }
}

constexpr int DN_STEPS = 260, DN_UNITS = 32 * DN_STEPS;
DI int dn_rbase(int b, int dir, int s) {
    if (s < 4) return dir == 0 ? b * 256 + s * 64 : b * 256 + 255 - s * 64;
    const int cc = s - 4;
    return dir == 0 ? TC + b * SEQ + cc * 64 : TC + b * SEQ + SEQ - 1 - cc * 64;
}
struct DnRaw { u32x4 c[3][2], l[3][2], r[3][2]; float g, be; };
DI void dn_raw_load(const bf16_t* P, const float* gb, int u, int tid, DnRaw& R) {
    const int chain = u / DN_STEPS, s = u - chain * DN_STEPS, dir = chain & 1, h = (chain >> 1) & 7, b = chain >> 4;
    const int rbase = dn_rbase(b, dir, s), rstep = dir == 0 ? 1 : -1;
    const int i = tid >> 3, sg = tid & 7, r = rbase + rstep * i;
    bool lok, rok;
    if (r < TC) { const int t = r & 255; lok = t != 0; rok = t != 255; } else { const int t = (r - TC) & 63; lok = t != 0; rok = t != 63; }
#pragma unroll
    for (int part = 0; part < 3; ++part) {
        const bf16_t* pc = P + (size_t)r * 3072 + part * 1024 + h * 128 + sg * 16;
#pragma unroll
        for (int hf = 0; hf < 2; ++hf) {
            R.c[part][hf] = *(const u32x4*)(pc + hf * 8);
            R.l[part][hf] = (u32x4){0u, 0u, 0u, 0u}; R.r[part][hf] = (u32x4){0u, 0u, 0u, 0u};
            if (lok) R.l[part][hf] = *(const u32x4*)(pc - 3072 + hf * 8);
            if (rok) R.r[part][hf] = *(const u32x4*)(pc + 3072 + hf * 8);
        }
    }
    if (tid < 64) { const size_t row = (size_t)(rbase + rstep * tid); R.g = gb[row * 32 + dir * 8 + h]; R.be = gb[row * 32 + 16 + dir * 8 + h]; }
}
PF void dn_chunk(const KC& k, int jl, LAS unsigned char* lds) {
    const int tid = TID(), lane = tid & 63, wave = tid >> 6, fr = lane & 15, fq = lane >> 4;
    LAS bf16_t* Kt = (LAS bf16_t*)lds;
    LAS bf16_t* Qt = Kt + 64 * 136;
    LAS bf16_t* Vt = Qt + 64 * 136;
    LAS float* Amat = (LAS float*)(Vt + 64 * 136);
    LAS bf16_t* Tb = (LAS bf16_t*)(Amat + 64 * 64);
    LAS bf16_t* VbT = Tb + 64 * 72;
    LAS bf16_t* KbT = VbT + 128 * 72;
    LAS float* gcs = (LAS float*)(KbT + 128 * 72);
    LAS float* bet = gcs + 64; LAS float* eg = bet + 64; LAS float* egr = eg + 64;
    LAS float* Tm = egr + 64;
    const bf16_t* P = (const bf16_t*)(k.ws + AR_PB);
    const float* gb = (const float*)(k.ws + WS_GB);
    const float* cw = k.dn_conv + (size_t)jl * 3 * 3072;
    bf16_t* CH = (bf16_t*)(k.ws + AR_CHUNK);
    bf16_t* ATT = (bf16_t*)(k.ws + AR_HBUF);
    float* EGL = (float*)(k.ws + WS_EGL);
    for (int u = blockIdx.x; u < DN_UNITS; u += gridDim.x) {
        DnRaw Rn; dn_raw_load(P, gb, u, tid, Rn);
        const int chain = u / DN_STEPS, s = u - chain * DN_STEPS, dir = chain & 1, h = (chain >> 1) & 7, b = chain >> 4;
        const int rbase = dn_rbase(b, dir, s), rstep = dir == 0 ? 1 : -1;
        bf16_t* cW = CH + (size_t)u * 32768; bf16_t* cQd = cW + 8192; bf16_t* cKd = cQd + 8192; bf16_t* cU = cKd + 8192;
        bf16_t* cAt = ATT + (size_t)u * 4096;
        lds_barrier();
        const float g_in = Rn.g, be_in = Rn.be;
        {
            const int i = tid >> 3, sg = tid & 7;
#pragma unroll
            for (int part = 0; part < 3; ++part) {
                const int col = part * 1024 + h * 128 + sg * 16;
                float v[16];
#pragma unroll
                for (int hf = 0; hf < 2; ++hf) {
                    const u32x4 c4 = Rn.c[part][hf], l4 = Rn.l[part][hf], r4 = Rn.r[part][hf];
#pragma unroll
                    for (int w2 = 0; w2 < 2; ++w2) {
                        const int cc = col + hf * 8 + 4 * w2;
                        const f32x4 k0 = *(const f32x4*)(cw + cc), k1 = *(const f32x4*)(cw + 3072 + cc), k2 = *(const f32x4*)(cw + 6144 + cc);
#pragma unroll
                        for (int e = 0; e < 4; ++e) {
                            const int w = 2 * w2 + (e >> 1);
                            const float lv = __uint_as_float((e & 1) ? (l4[w] & 0xffff0000u) : (l4[w] << 16));
                            const float cv = __uint_as_float((e & 1) ? (c4[w] & 0xffff0000u) : (c4[w] << 16));
                            const float rv = __uint_as_float((e & 1) ? (r4[w] & 0xffff0000u) : (r4[w] << 16));
                            v[hf * 8 + 4 * w2 + e] = siluf(k0[e] * lv + k1[e] * cv + k2[e] * rv);
                        }
                    }
                }
                if (part < 2) {
                    float ss = 0.f;
#pragma unroll
                    for (int e = 0; e < 16; ++e) ss += v[e] * v[e];
                    ss += shx(ss, 1, lane); ss += shx(ss, 2, lane); ss += shx(ss, 4, lane);
                    const float sc = rsqrtf(ss + EPS) * (part == 0 ? 0.08838834764831845f : 1.0f);
#pragma unroll
                    for (int e = 0; e < 16; ++e) v[e] *= sc;
                }
                LAS bf16_t* dst = (part == 0 ? Qt : (part == 1 ? Kt : Vt)) + i * 136 + sg * 16;
                u32x4 o0, o1;
#pragma unroll
                for (int w = 0; w < 4; ++w) { o0[w] = pk2(v[2 * w], v[2 * w + 1]); o1[w] = pk2(v[8 + 2 * w], v[8 + 2 * w + 1]); }
                *(LAS u32x4*)dst = o0; *(LAS u32x4*)(dst + 8) = o1;
            }
        }
        if (wave == 0) {
            float g = g_in;
            const float be = be_in;
#pragma unroll
            for (int d = 1; d < 64; d <<= 1) { const float o = shi(g, (lane - d) & 63); if (lane >= d) g += o; }
            const float glast = shi(g, 63);
            gcs[lane] = g; bet[lane] = be; eg[lane] = expf(g); egr[lane] = expf(glast - g);
            if (lane == 0) EGL[u] = expf(glast);
        }
        lds_barrier();
#pragma unroll 1
        for (int x = 0; x < 4; ++x) {
            const int t = wave + 8 * x, isq = t >> 4, mt = (t >> 2) & 3, nt = t & 3;
            f32x4 acc = (f32x4){0.f, 0.f, 0.f, 0.f};
            const int jc = 16 * nt + fr;
            float gi4[4], bi4[4];
            const float gj = gcs[jc];
#pragma unroll
            for (int jj = 0; jj < 4; ++jj) { gi4[jj] = gcs[16 * mt + 4 * fq + jj]; bi4[jj] = bet[16 * mt + 4 * fq + jj]; }
            if (mt >= nt) {
                const LAS bf16_t* Ar = (isq ? Qt : Kt) + (16 * mt + fr) * 136 + 8 * fq;
                const LAS bf16_t* Br = Kt + (16 * nt + fr) * 136 + 8 * fq;
                bf16x8 fa4[4], fb4[4];
#pragma unroll
                for (int ks = 0; ks < 4; ++ks) { fa4[ks] = *(const LAS bf16x8*)(Ar + 32 * ks); fb4[ks] = *(const LAS bf16x8*)(Br + 32 * ks); }
                asm volatile("" ::: "memory");
#pragma unroll
                for (int ks = 0; ks < 4; ++ks) acc = __builtin_amdgcn_mfma_f32_16x16x32_bf16(fa4[ks], fb4[ks], acc, 0, 0, 0);
            }
#pragma unroll
            for (int jj = 0; jj < 4; ++jj) {
                const int ir = 16 * mt + 4 * fq + jj;
                const float dec = __expf(fminf(gi4[jj] - gj, 0.f));
                if (isq) cAt[((mt * 2 + (nt >> 1)) * 64 + (fr >> 2) * 16 + 4 * fq + jj) * 8 + (nt & 1) * 4 + (fr & 3)] = f2bf(ir >= jc ? acc[jj] * dec : 0.f);
                else Amat[ir * 64 + jc] = ir > jc ? bi4[jj] * acc[jj] * dec : 0.f;
            }
        }
        lds_barrier();
        {
        if (wave < 4) {
            if (lane < 16) {
                const int bo = 16 * wave;
                float tc[16];
#pragma unroll
                for (int i = 0; i < 16; ++i) {
                    f32x4 ar[4];
#pragma unroll
                    for (int q = 0; q < (i + 3) / 4; ++q) ar[q] = *(const LAS f32x4*)(Amat + (bo + i) * 64 + bo + 4 * q);
                    float a0 = (i == lane) ? 1.f : 0.f, a1 = 0.f;
#pragma unroll
                    for (int j = 0; j < i; ++j) { const float av = ar[j >> 2][j & 3]; if (j & 1) a1 -= av * tc[j]; else a0 -= av * tc[j]; }
                    tc[i] = a0 + a1;
                    Tm[(bo + i) * 64 + bo + lane] = tc[i];
                }
            }
        } else {
            for (int it = tid - 256; it < 1024; it += 256) {
                const int c = it & 127, ig = it >> 7;
                float kv[8], vv[8];
                { bf16_t kr[8], vr[8];
#pragma unroll
                  for (int e = 0; e < 8; ++e) { kr[e] = Kt[(8 * ig + e) * 136 + c]; vr[e] = Vt[(8 * ig + e) * 136 + c]; }
                  asm volatile("" ::: "memory");
#pragma unroll
                  for (int e = 0; e < 8; ++e) { kv[e] = bf2f(kr[e]); vv[e] = bf2f(vr[e]); } }
                u32x4 ov, ok, od;
#pragma unroll
                for (int w = 0; w < 4; ++w) {
                    const int i0 = 8 * ig + 2 * w, i1 = i0 + 1;
                    ov[w] = pk2(bet[i0] * vv[2 * w], bet[i1] * vv[2 * w + 1]);
                    ok[w] = pk2(bet[i0] * eg[i0] * kv[2 * w], bet[i1] * eg[i1] * kv[2 * w + 1]);
                    od[w] = pk2(egr[i0] * kv[2 * w], egr[i1] * kv[2 * w + 1]);
                }
                *(LAS u32x4*)(VbT + c * 72 + 8 * ig) = ov;
                *(LAS u32x4*)(KbT + c * 72 + 8 * ig) = ok;
                { bf16_t* kd0 = cKd + (((c >> 4) * 2 + (ig >> 2)) * 64 + (2 * (ig & 1)) * 16 + (c & 15)) * 8 + ((ig & 3) >> 1) * 4;
                  *(u32x2*)kd0 = (u32x2){od[0], od[1]}; *(u32x2*)(kd0 + 128) = (u32x2){od[2], od[3]}; }
            }
            for (int it = tid - 256; it < 1024; it += 256) {
                const int i = it >> 4, c8 = (it & 15) * 8; const float e = eg[i];
                const u32x4 qv = *(const LAS u32x4*)(Qt + i * 136 + c8); u32x4 o;
#pragma unroll
                for (int w = 0; w < 4; ++w) o[w] = pk2(__uint_as_float(qv[w] << 16) * e, __uint_as_float(qv[w] & 0xffff0000u) * e);
                { const int k8 = it & 15; bf16_t* qd0 = cQd + (((i >> 4) * 4 + (k8 >> 2)) * 64 + (2 * (k8 & 1)) * 16 + (i & 15)) * 8 + ((k8 & 3) >> 1) * 4;
                  *(u32x2*)qd0 = (u32x2){o[0], o[1]}; *(u32x2*)(qd0 + 128) = (u32x2){o[2], o[3]}; }
            }
        }
        lds_barrier();
#pragma unroll 1
        for (int d = 1; d < 4; ++d) {
            if (wave < 4 - d) {
                const int bi = wave + d, bj = wave, r = lane >> 2, c0 = 4 * (lane & 3);
                f32x4 m = (f32x4){0.f, 0.f, 0.f, 0.f};
                for (int kb = bj; kb < bi; ++kb) {
                    f32x4 av4[4], tv[16];
#pragma unroll
                    for (int q = 0; q < 4; ++q) av4[q] = *(const LAS f32x4*)(Amat + (16 * bi + r) * 64 + 16 * kb + 4 * q);
#pragma unroll
                    for (int kk = 0; kk < 16; ++kk) tv[kk] = *(const LAS f32x4*)(Tm + (16 * kb + kk) * 64 + 16 * bj + c0);
                    asm volatile("" ::: "memory");
#pragma unroll
                    for (int kk = 0; kk < 16; ++kk) m += tv[kk] * av4[kk >> 2][kk & 3];
                }
                *(LAS f32x4*)(Tm + (16 * bj + r) * 64 + 16 * bi + c0) = m;
                f32x4 t = (f32x4){0.f, 0.f, 0.f, 0.f};
                {
                    f32x4 dv4[4], mv[16];
#pragma unroll
                    for (int q = 0; q < 4; ++q) dv4[q] = *(const LAS f32x4*)(Tm + (16 * bi + r) * 64 + 16 * bi + 4 * q);
#pragma unroll
                    for (int kk = 0; kk < 16; ++kk) mv[kk] = *(const LAS f32x4*)(Tm + (16 * bj + kk) * 64 + 16 * bi + c0);
                    asm volatile("" ::: "memory");
#pragma unroll
                    for (int kk = 0; kk < 16; ++kk) t -= mv[kk] * dv4[kk >> 2][kk & 3];
                }
                *(LAS f32x4*)(Tm + (16 * bi + r) * 64 + 16 * bj + c0) = t;
            }
            lds_barrier();
        }
        for (int it = tid; it < 64 * 8; it += NTHR) {
            const int i = it >> 3, c8 = (it & 7) * 8; u32x4 o;
#pragma unroll
            for (int w = 0; w < 4; ++w) {
                const int c = c8 + 2 * w;
                o[w] = pk2(c <= i ? Tm[i * 64 + c] : 0.f, c + 1 <= i ? Tm[i * 64 + c + 1] : 0.f);
            }
            *(LAS u32x4*)(Tb + i * 72 + c8) = o;
        }
        }
        lds_barrier();
        {
            f32x4 au[4], aw[4];
#pragma unroll
            for (int mt = 0; mt < 4; ++mt) { au[mt] = (f32x4){0.f, 0.f, 0.f, 0.f}; aw[mt] = (f32x4){0.f, 0.f, 0.f, 0.f}; }
            bf16x8 bv[2], bk[2], at[2][4];
#pragma unroll
            for (int ks = 0; ks < 2; ++ks) {
                bv[ks] = *(const LAS bf16x8*)(VbT + (16 * wave + fr) * 72 + 32 * ks + 8 * fq);
                bk[ks] = *(const LAS bf16x8*)(KbT + (16 * wave + fr) * 72 + 32 * ks + 8 * fq);
#pragma unroll
                for (int mt = 0; mt < 4; ++mt) at[ks][mt] = *(const LAS bf16x8*)(Tb + (16 * mt + fr) * 72 + 32 * ks + 8 * fq);
            }
            asm volatile("" ::: "memory");
#pragma unroll
            for (int ks = 0; ks < 2; ++ks)
#pragma unroll
                for (int mt = 0; mt < 4; ++mt) {
                    au[mt] = __builtin_amdgcn_mfma_f32_16x16x32_bf16(at[ks][mt], bv[ks], au[mt], 0, 0, 0);
                    aw[mt] = __builtin_amdgcn_mfma_f32_16x16x32_bf16(at[ks][mt], bk[ks], aw[mt], 0, 0, 0);
                }
#pragma unroll
            for (int mt = 0; mt < 4; ++mt)
#pragma unroll
                for (int jj = 0; jj < 4; ++jj)
                    cW[((mt * 4 + (wave >> 1)) * 64 + (fr >> 2) * 16 + 4 * fq + jj) * 8 + (wave & 1) * 4 + (fr & 3)] = f2bf(aw[mt][jj]);
            {
                u32x4 u0, u1;
                u0[0] = pk2(au[0][0], au[0][1]); u0[1] = pk2(au[0][2], au[0][3]); u0[2] = pk2(au[1][0], au[1][1]); u0[3] = pk2(au[1][2], au[1][3]);
                u1[0] = pk2(au[2][0], au[2][1]); u1[1] = pk2(au[2][2], au[2][3]); u1[2] = pk2(au[3][0], au[3][1]); u1[3] = pk2(au[3][2], au[3][3]);
                bf16_t* ud = cU + (wave * 64 + lane) * 16;
                *(u32x4*)ud = u0; *(u32x4*)(ud + 8) = u1;
            }
        }
    }
}
DI bf16x8 pk8(f32x4 a, f32x4 b) { u32x4 r; r[0] = pk2(a[0], a[1]); r[1] = pk2(a[2], a[3]); r[2] = pk2(b[0], b[1]); r[3] = pk2(b[2], b[3]); return __builtin_bit_cast(bf16x8, r); }
constexpr int SC_PFD = 3;
DI bf16x8 ldfrag(const bf16_t* p) { return __builtin_bit_cast(bf16x8, *(const u32x4*)p); }
PF void dn_scan(const KC& k, LAS unsigned char* lds, int pm) {
    const int tid = TID(), lane = tid & 63, fr = lane & 15, fq = lane >> 4;
    const int wave = __builtin_amdgcn_readfirstlane(tid >> 6);
    const bf16_t* CH = (const bf16_t*)(k.ws + AR_CHUNK);
    const bf16_t* ATT = (const bf16_t*)(k.ws + AR_HBUF);
    const float* EGL = (const float*)(k.ws + WS_EGL);
    bf16_t* O = (bf16_t*)(k.ws + (pm ? AR_UBUF : AR_PB));
    LAS float* eglL = (LAS float*)lds;
    LAS u32x4* sbx = (LAS u32x4*)(eglL + 272);
    LAS u32x4* vbx = sbx + 512;
    volatile LAS int* vflag = (volatile LAS int*)(vbx + 256);
    for (int un0 = blockIdx.x; un0 < 256; un0 += gridDim.x) {
        if ((pm == 2 && ((un0 >> 3) & 1)) || (pm == 3 && (un0 & 1))) continue;
        const int un = (gridDim.x == 256) ? ((un0 & 7) * 32 + (un0 >> 3)) : un0;
        const int sl = un & 7, chain = un >> 3, dir = chain & 1, h = (chain >> 1) & 7, b = chain >> 4;
        const int rstep = dir == 0 ? 1 : -1;
        const bf16_t* U0 = CH + (size_t)(chain * DN_STEPS) * 32768 + lane * 8;
        const bf16_t* A0 = ATT + (size_t)(chain * DN_STEPS) * 4096 + lane * 8;
        lds_barrier();
        if (tid < DN_STEPS) eglL[tid] = EGL[chain * DN_STEPS + tid];
        if (tid == 0) *vflag = 0;
        if (wave == 0) {
            f32x4 S[8];
#pragma unroll
            for (int t = 0; t < 8; ++t) S[t] = (f32x4){0.f, 0.f, 0.f, 0.f};
            bf16x8 fw[16], fk[16]; u32x4 uc[2];
#pragma unroll
            for (int i = 0; i < 16; ++i) { fw[i] = ldfrag(U0 + i * 512); fk[i] = ldfrag(U0 + 16384 + i * 512); }
            { const bf16_t* up = U0 - lane * 8 + 24576 + (sl * 64 + lane) * 16; uc[0] = *(const u32x4*)up; uc[1] = *(const u32x4*)(up + 8); }
#pragma unroll
            for (int ks = 0; ks < 4; ++ks) sbx[ks * 64 + lane] = (u32x4){0u, 0u, 0u, 0u};
#pragma unroll
            for (int i = 0; i < 16; ++i) { asm volatile("" :: "v"(__builtin_bit_cast(u32x4, fw[i]))); asm volatile("" :: "v"(__builtin_bit_cast(u32x4, fk[i]))); }
            asm volatile("" :: "v"(uc[0]), "v"(uc[1]));
            lds_barrier();
#pragma unroll 1
            for (int s = 0; s < DN_STEPS; ++s) {
                const int sn = pm == 1 ? 0 : s + 1 < DN_STEPS ? s + 1 : s;
                const bf16_t* Un = U0 + (size_t)sn * 32768;
                const float egl = eglL[s];
                bf16x8 sb[4];
#pragma unroll
                for (int ks = 0; ks < 4; ++ks) sb[ks] = pk8(S[2 * ks], S[2 * ks + 1]);
                f32x4 p[4];
#pragma unroll
                for (int mt = 0; mt < 4; ++mt) p[mt] = (f32x4){0.f, 0.f, 0.f, 0.f};
#pragma unroll
                for (int ks = 0; ks < 4; ++ks)
#pragma unroll
                    for (int mt = 0; mt < 4; ++mt) {
                        p[mt] = __builtin_amdgcn_mfma_f32_16x16x32_bf16(fw[mt * 4 + ks], sb[ks], p[mt], 0, 0, 0);
                        fw[mt * 4 + ks] = ldfrag(Un + (mt * 4 + ks) * 512);
                    }
#pragma unroll
                for (int mt = 0; mt < 4; ++mt) {
                    const unsigned ua = uc[mt >> 1][(mt & 1) * 2], ub = uc[mt >> 1][(mt & 1) * 2 + 1];
                    p[mt][0] = __uint_as_float(ua << 16) - p[mt][0]; p[mt][1] = __uint_as_float(ua & 0xffff0000u) - p[mt][1];
                    p[mt][2] = __uint_as_float(ub << 16) - p[mt][2]; p[mt][3] = __uint_as_float(ub & 0xffff0000u) - p[mt][3];
                }
                { const bf16_t* up = Un - lane * 8 + 24576 + (sl * 64 + lane) * 16; uc[0] = *(const u32x4*)up; uc[1] = *(const u32x4*)(up + 8); }
                bf16x8 vb[2];
                vb[0] = pk8(p[0], p[1]); vb[1] = pk8(p[2], p[3]);
                vbx[(s & 1) * 64 + lane] = __builtin_bit_cast(u32x4, vb[0]); vbx[(s & 1) * 64 + 128 + lane] = __builtin_bit_cast(u32x4, vb[1]);
                asm volatile("s_waitcnt lgkmcnt(0)" ::: "memory");
                if (lane == 0) *vflag = s + 1;
#pragma unroll
                for (int t = 0; t < 8; ++t) S[t] = S[t] * egl;
#pragma unroll
                for (int kc = 0; kc < 2; ++kc)
#pragma unroll
                    for (int t = 0; t < 8; ++t) {
                        S[t] = __builtin_amdgcn_mfma_f32_16x16x32_bf16(fk[t * 2 + kc], vb[kc], S[t], 0, 0, 0);
                        fk[t * 2 + kc] = ldfrag(Un + 16384 + (t * 2 + kc) * 512);
                    }
#pragma unroll
                for (int ks = 0; ks < 4; ++ks) sbx[((s + 1) & 1) * 256 + ks * 64 + lane] = __builtin_bit_cast(u32x4, pk8(S[2 * ks], S[2 * ks + 1]));
                lds_barrier();
            }
        } else if (wave == 1) {
            bf16x8 fqd[16], fat[8];
#pragma unroll
            for (int i = 0; i < 16; ++i) fqd[i] = ldfrag(U0 + 8192 + i * 512);
#pragma unroll
            for (int i = 0; i < 8; ++i) fat[i] = ldfrag(A0 + i * 512);
#pragma unroll
            for (int i = 0; i < 16; ++i) asm volatile("" :: "v"(__builtin_bit_cast(u32x4, fqd[i])));
#pragma unroll
            for (int i = 0; i < 8; ++i) asm volatile("" :: "v"(__builtin_bit_cast(u32x4, fat[i])));
            f32x4 op[4];
#pragma unroll
            for (int mt = 0; mt < 4; ++mt) op[mt] = (f32x4){0.f, 0.f, 0.f, 0.f};
            lds_barrier();
#pragma unroll 1
            for (int s = 0; s < DN_STEPS; ++s) {
                const int sn = pm == 1 ? 0 : s + 1 < DN_STEPS ? s + 1 : s;
                const bf16_t* Un = U0 + (size_t)sn * 32768; const bf16_t* An = A0 + (size_t)sn * 4096;
                bf16x8 sb[4];
#pragma unroll
                for (int ks = 0; ks < 4; ++ks) sb[ks] = __builtin_bit_cast(bf16x8, sbx[(s & 1) * 256 + ks * 64 + lane]);
                {
                    const int sp = s > 0 ? s - 1 : 0; const int rbase = dn_rbase(b, dir, sp);
#pragma unroll
                    for (int mt = 0; mt < 4; ++mt)
#pragma unroll
                        for (int jj = 0; jj < 4; ++jj) {
                            const int row = rbase + rstep * (16 * mt + 4 * fq + jj);
                            O[((size_t)(pm ? 0 : dir) * T + row) * 1024 + h * 128 + sl * 16 + fr] = f2bf(op[mt][jj]);
                        }
                }
                f32x4 o[4];
#pragma unroll
                for (int mt = 0; mt < 4; ++mt) o[mt] = (f32x4){0.f, 0.f, 0.f, 0.f};
#pragma unroll
                for (int ks = 0; ks < 4; ++ks)
#pragma unroll
                    for (int mt = 0; mt < 4; ++mt) {
                        o[mt] = __builtin_amdgcn_mfma_f32_16x16x32_bf16(fqd[mt * 4 + ks], sb[ks], o[mt], 0, 0, 0);
                        fqd[mt * 4 + ks] = ldfrag(Un + 8192 + (mt * 4 + ks) * 512);
                    }
                while (*vflag < s + 1) __builtin_amdgcn_s_sleep(1);
                asm volatile("" ::: "memory");
                bf16x8 vb[2];
                vb[0] = __builtin_bit_cast(bf16x8, vbx[(s & 1) * 64 + lane]); vb[1] = __builtin_bit_cast(bf16x8, vbx[(s & 1) * 64 + 128 + lane]);
#pragma unroll
                for (int kc = 0; kc < 2; ++kc)
#pragma unroll
                    for (int mt = 0; mt < 4; ++mt) {
                        o[mt] = __builtin_amdgcn_mfma_f32_16x16x32_bf16(fat[mt * 2 + kc], vb[kc], o[mt], 0, 0, 0);
                        fat[mt * 2 + kc] = ldfrag(An + (mt * 2 + kc) * 512);
                    }
#pragma unroll
                for (int mt = 0; mt < 4; ++mt) op[mt] = o[mt];
                lds_barrier();
            }
            {
                const int rbase = dn_rbase(b, dir, DN_STEPS - 1);
#pragma unroll
                for (int mt = 0; mt < 4; ++mt)
#pragma unroll
                    for (int jj = 0; jj < 4; ++jj) {
                        const int row = rbase + rstep * (16 * mt + 4 * fq + jj);
                        O[((size_t)(pm ? 0 : dir) * T + row) * 1024 + h * 128 + sl * 16 + fr] = f2bf(op[mt][jj]);
                    }
            }
        } else if (wave == 2) {
            const unsigned char* P0 = (const unsigned char*)(CH + (size_t)(chain * DN_STEPS) * 32768 + sl * 4096) + lane * 64;
            const unsigned char* Q0 = (const unsigned char*)(ATT + (size_t)(chain * DN_STEPS) * 4096 + sl * 512) + (lane & 15) * 64;
            unsigned d0 = 0u, d1 = 0u, d2 = 0u;
            lds_barrier();
#pragma unroll 1
            for (int s = 0; s < DN_STEPS; ++s) {
                const int sp = pm == 1 ? 0 : s + SC_PFD < DN_STEPS ? s + SC_PFD : DN_STEPS - 1;
                const unsigned char* pa = P0 + (size_t)sp * 65536; const unsigned char* pb = pa + 4096; const unsigned char* qa = Q0 + (size_t)sp * 8192;
                asm volatile("global_load_dword %0, %3, off\n\tglobal_load_dword %1, %4, off\n\tglobal_load_dword %2, %5, off"
                             : "+v"(d0), "+v"(d1), "+v"(d2) : "v"(pa), "v"(pb), "v"(qa) : "memory");
                lds_barrier();
            }
            asm volatile("s_waitcnt vmcnt(0)" : "+v"(d0), "+v"(d1), "+v"(d2) :: "memory");
        } else {
            lds_barrier();
#pragma unroll 1
            for (int s = 0; s < DN_STEPS; ++s) lds_barrier();
        }
    }
}
PF void dn_finish(const KC& k, int j) {
    const int tid = TID(), lane = tid & 63, wave = tid >> 6;
    const bf16_t* O = (const bf16_t*)(k.ws + AR_PB);
    const bf16_t* Z = (const bf16_t*)k.out;
    bf16_t* U = (bf16_t*)(k.ws + AR_UBUF);
    const float* on = k.dn_out_norm + j * 128;
    const int c0 = lane * 16;
    float onv[16];
#pragma unroll
    for (int e = 0; e < 16; ++e) onv[e] = on[(c0 + e) & 127];
    for (int r = blockIdx.x * 8 + wave; r < T; r += gridDim.x * 8) {
        u32x4 vf[2], vb[2], vz[2];
#pragma unroll
        for (int hh = 0; hh < 2; ++hh) {
            vf[hh] = *(const u32x4*)(O + (size_t)r * 1024 + c0 + hh * 8); vb[hh] = *(const u32x4*)(O + ((size_t)T + r) * 1024 + c0 + hh * 8);
            vz[hh] = *(const u32x4*)(Z + (size_t)r * 1024 + c0 + hh * 8);
        }
        asm volatile("" ::: "memory");
        float o[16], z[16];
#pragma unroll
        for (int hh = 0; hh < 2; ++hh) { float a[8], b2[8], zz[8]; unpack8(vf[hh], a); unpack8(vb[hh], b2); unpack8(vz[hh], zz);
#pragma unroll
            for (int i = 0; i < 8; ++i) { o[hh * 8 + i] = a[i] + b2[i]; z[hh * 8 + i] = zz[i]; } }
        float ss = 0.f;
#pragma unroll
        for (int e = 0; e < 16; ++e) ss += o[e] * o[e];
        ss += shx(ss, 1, lane); ss += shx(ss, 2, lane); ss += shx(ss, 4, lane);
        const float rs = rsqrtf(ss * (1.0f / 128.0f) + EPS);
#pragma unroll
        for (int hh = 0; hh < 2; ++hh) { u32x4 ov;
#pragma unroll
            for (int w = 0; w < 4; ++w) { const int e0 = hh * 8 + 2 * w; ov[w] = pk2(o[e0] * rs * onv[e0] * siluf(z[e0]), o[e0 + 1] * rs * onv[e0 + 1] * siluf(z[e0 + 1])); }
            *(u32x4*)(U + (size_t)r * 1024 + c0 + hh * 8) = ov; }
    }
}

DI float conv3g(const bf16_t* p, int j, float w0, float w1, float w2) {
    const int gc = j & 63;
    const float l = gc != 0 ? bf2f(p[j - 1]) : 0.f, c = bf2f(p[j]), r = gc != 63 ? bf2f(p[j + 1]) : 0.f;
    return w0 * l + w1 * c + w2 * r;
}
DI float hy_conv_lane(float c, float w0, float w1, float w2, int lane) {
    const float l = shi(c, (lane + 63) & 63), r = shi(c, (lane + 1) & 63);
    return w0 * (lane > 0 ? l : 0.f) + w1 * c + w2 * (lane < 63 ? r : 0.f);
}
PF void hy_lat(const KC& k, int jl, LAS float* ldsf) {
    const int tid = TID();
    LAS cf* X = (LAS cf*)ldsf;
    LAS cf* tw = X + 17408;
    LAS cf* tA = tw + 1024; LAS cf* tB = tA + 128;
    const bf16_t* FT = (const bf16_t*)(k.ws + AR_FT);
    const bf16_t* PT = (const bf16_t*)(k.ws + AR_PB);
    bf16_t* ZT = (bf16_t*)(k.ws + AR_ZT);
    unsigned* scr = (unsigned*)(k.ws + AR_FFTS) + (size_t)blockIdx.x * 4 * 16384;
    unsigned* sKe = scr; unsigned* sKo = scr + 16384; unsigned* zp = scr + 2 * 16384; unsigned* ye = scr + 3 * 16384;
#define CPK(v) pk2((v).x, (v).y)
#define CUP(u_) ((cf){__uint_as_float((u_) << 16), __uint_as_float((u_) & 0xffff0000u)})
    const float* cw = k.hy_conv + (size_t)jl * 3 * 3072;
    for (int m = 0; m < 2; ++m) { const int p = tid + 512 * m; float sn, cs; sincospif(-(float)p / 8192.0f, &sn, &cs); cf w; w.x = cs; w.y = sn; tw[p] = w; }
    if (tid < 256) { const int a = tid & 127; float sn, cs; sincospif(-(float)(tid < 128 ? 128 * a : a) / 16384.0f, &sn, &cs); cf w; w.x = cs; w.y = sn; (tid < 128 ? tA : tB)[a] = w; }
    __syncthreads();
    const int lane = tid & 63;
#define HY_SPLIT() asm volatile("" ::: "memory")
#define HY_CONV(c, w0, w1, w2) hy_conv_lane((c), (w0), (w1), (w2), lane)
    for (int ch = blockIdx.x; ch < 1024; ch += gridDim.x) {
        {
            const bf16_t* pv = PT + (size_t)ch * T + TC;
            const float w0 = cw[ch], w1 = cw[3072 + ch], w2 = cw[6144 + ch];
            for (int m0 = 0; m0 < 32; m0 += 8) {
                bf16_t a0[8], a1[8];
#pragma unroll
                for (int q = 0; q < 8; ++q) { const int j = tid + 512 * (m0 + q); a0[q] = pv[j]; a1[q] = pv[SEQ + j]; }
                HY_SPLIT();
#pragma unroll
                for (int q = 0; q < 8; ++q) { const int j = tid + 512 * (m0 + q); const float c0 = bf2f(a0[q]), c1 = bf2f(a1[q]); cf z; z.x = HY_CONV(c0, w0, w1, w2); z.y = HY_CONV(c1, w0, w1, w2); zp[j] = CPK(z); }
            }
        }
        for (int n = 0; n < 2; ++n) {
            __syncthreads();
            const bf16_t* ftf = FT + (size_t)(n * 2048 + ch) * 16384; const bf16_t* ftb = FT + (size_t)(n * 2048 + 1024 + ch) * 16384;
            for (int m0 = 0; m0 < 32; m0 += 8) {
                bf16_t hfv[8], hbv[8];
#pragma unroll
                for (int q = 0; q < 8; ++q) { const int j = tid + 512 * (m0 + q); hfv[q] = ftf[j]; hbv[q] = ftb[j > 0 ? SEQ - j : 0]; }
                HY_SPLIT();
#pragma unroll
                for (int q = 0; q < 8; ++q) {
                    const int j = tid + 512 * (m0 + q);
                    const float hf = bf2f(hfv[q]), hb = j > 0 ? bf2f(hbv[q]) : 0.f;
                    const cf w = cmul(tA[j >> 7], tB[j & 127]);
                    cf a; a.x = hf + hb; a.y = 0.f; X[PIDX(j)] = a;
                    const float kd = hf - hb; cf o; o.x = kd * w.x; o.y = kd * w.y; sKo[j] = CPK(o);
                }
            }
            __syncthreads();
            fft16k_fwd(X, tw);
            unsigned Ker[32];
#pragma unroll
            for (int m = 0; m < 32; ++m) { const cf t_ = X[PIDX(tid + 512 * m)]; Ker[m] = CPK(t_); }
            __syncthreads();
            for (int m0 = 0; m0 < 32; m0 += 8) { unsigned t[8];
#pragma unroll
                for (int q = 0; q < 8; ++q) t[q] = sKo[tid + 512 * (m0 + q)];
                HY_SPLIT();
#pragma unroll
                for (int q = 0; q < 8; ++q) X[PIDX(tid + 512 * (m0 + q))] = CUP(t[q]); }
            __syncthreads();
            fft16k_fwd(X, tw);
            _Pragma("unroll 8") for (int m = 0; m < 32; ++m) { const int j = tid + 512 * m; const cf t_ = X[PIDX(j)]; sKo[j] = CPK(t_); }
            __syncthreads();
            for (int m0 = 0; m0 < 32; m0 += 8) { unsigned t[8];
#pragma unroll
                for (int q = 0; q < 8; ++q) t[q] = zp[tid + 512 * (m0 + q)];
                HY_SPLIT();
#pragma unroll
                for (int q = 0; q < 8; ++q) X[PIDX(tid + 512 * (m0 + q))] = CUP(t[q]); }
            __syncthreads();
            fft16k_fwd(X, tw);
#pragma unroll
            for (int m = 0; m < 32; ++m) { const int j = tid + 512 * m; X[PIDX(j)] = cmul(X[PIDX(j)], CUP(Ker[m])); }
            __syncthreads();
            fft16k_inv(X, tw);
            _Pragma("unroll 8") for (int m = 0; m < 32; ++m) { const int j = tid + 512 * m; const cf t_ = X[PIDX(j)]; ye[j] = CPK(t_); }
            __syncthreads();
            for (int m0 = 0; m0 < 32; m0 += 8) { unsigned t[8];
#pragma unroll
                for (int q = 0; q < 8; ++q) t[q] = zp[tid + 512 * (m0 + q)];
                HY_SPLIT();
#pragma unroll
                for (int q = 0; q < 8; ++q) { const int j = tid + 512 * (m0 + q); const cf w = cmul(tA[j >> 7], tB[j & 127]); X[PIDX(j)] = cmul(CUP(t[q]), w); } }
            __syncthreads();
            fft16k_fwd(X, tw);
            for (int m0 = 0; m0 < 32; m0 += 8) { unsigned t[8];
#pragma unroll
                for (int q = 0; q < 8; ++q) t[q] = sKo[tid + 512 * (m0 + q)];
                HY_SPLIT();
#pragma unroll
                for (int q = 0; q < 8; ++q) { const int j = tid + 512 * (m0 + q); X[PIDX(j)] = cmul(X[PIDX(j)], CUP(t[q])); } }
            __syncthreads();
            fft16k_inv(X, tw);
            {
                const bf16_t* pg = PT + (size_t)((n + 1) * 1024 + ch) * T + TC;
                const int gcol = (n + 1) * 1024 + ch;
                const float w0 = cw[gcol], w1 = cw[3072 + gcol], w2 = cw[6144 + gcol];
                const float bias = k.hy_bias[(size_t)jl * 2 * 1024 + n * 1024 + ch];
                for (int m0 = 0; m0 < 32; m0 += 8) {
                    unsigned te_[8], tz_[8]; bf16_t g0[8], g1[8];
#pragma unroll
                    for (int q = 0; q < 8; ++q) { const int j = tid + 512 * (m0 + q); te_[q] = ye[j]; tz_[q] = zp[j]; g0[q] = pg[j]; g1[q] = pg[SEQ + j]; }
                    HY_SPLIT();
#pragma unroll
                    for (int q = 0; q < 8; ++q) {
                        const int j = tid + 512 * (m0 + q);
                        cf w = cmul(tA[j >> 7], tB[j & 127]); w.y = -w.y;
                        const cf yo = cmul(X[PIDX(j)], w);
                        const cf te = CUP(te_[q]), tz = CUP(tz_[q]);
                        const float y0 = (0.5f / 16384.0f) * (te.x + yo.x), y1 = (0.5f / 16384.0f) * (te.y + yo.y);
                        const float c0 = bf2f(g0[q]), c1 = bf2f(g1[q]);
                        cf zn; zn.x = HY_CONV(c0, w0, w1, w2) * (y0 + bias * tz.x); zn.y = HY_CONV(c1, w0, w1, w2) * (y1 + bias * tz.y);
                        zp[j] = CPK(zn);
                    }
                }
            }
        }
        for (int m0 = 0; m0 < 32; m0 += 8) { unsigned t[8];
#pragma unroll
            for (int q = 0; q < 8; ++q) t[q] = zp[tid + 512 * (m0 + q)];
            HY_SPLIT();
#pragma unroll
            for (int q = 0; q < 8; ++q) { const int j = tid + 512 * (m0 + q); ZT[(size_t)ch * T + TC + j] = (bf16_t)(t[q] & 0xffffu); ZT[(size_t)ch * T + TC + SEQ + j] = (bf16_t)(t[q] >> 16); } }
        __syncthreads();
    }
#undef CPK
#undef CUP
#undef HY_SPLIT
#undef HY_CONV
}
PF void hy_ctx(const KC& k, int jl, LAS float* lds) {
    const int tid = TID(), t = tid & 255, hsel = tid >> 8;
    LAS float* z = lds + hsel * 768; LAS float* hf = z + 256; LAS float* hb = hf + 256;
    const bf16_t* PT = (const bf16_t*)(k.ws + AR_PB);
    bf16_t* U = (bf16_t*)(k.ws + AR_UBUF);
    const float* filtc = (const float*)(k.ws + WS_FILTC);
    const float* cw = k.hy_conv + (size_t)jl * 3 * 3072;
    for (int u = blockIdx.x; u < 1024; u += gridDim.x) {
        const int pr = u * 2 + hsel, b = pr >> 10, ch = pr & 1023;
        float zc;
        {
            const bf16_t* pv = PT + (size_t)ch * T + b * 256;
            const float l = t != 0 ? bf2f(pv[t - 1]) : 0.f, c = bf2f(pv[t]), r = t != 255 ? bf2f(pv[t + 1]) : 0.f;
            zc = cw[ch] * l + cw[3072 + ch] * c + cw[6144 + ch] * r;
        }
        for (int n = 0; n < 2; ++n) {
            __syncthreads();
            z[t] = zc; hf[t] = filtc[(size_t)t * 4096 + n * 2048 + ch]; hb[t] = filtc[(size_t)t * 4096 + n * 2048 + 1024 + ch];
            __syncthreads();
            float y = 0.f;
            for (int s = 0; s <= t; ++s) y += hf[t - s] * z[s];
            for (int s = t + 1; s < 256; ++s) y += hb[s - t] * z[s];
            const int gcol = (n + 1) * 1024 + ch;
            const bf16_t* pg = PT + (size_t)gcol * T + b * 256;
            const float l = t != 0 ? bf2f(pg[t - 1]) : 0.f, c = bf2f(pg[t]), r = t != 255 ? bf2f(pg[t + 1]) : 0.f;
            const float gate = cw[gcol] * l + cw[3072 + gcol] * c + cw[6144 + gcol] * r;
            zc = gate * (y + k.hy_bias[(size_t)jl * 2048 + n * 1024 + ch] * zc);
        }
        U[(size_t)(b * 256 + t) * 1024 + ch] = f2bf(zc);
        __syncthreads();
    }
}
PF void hy_transpose(const KC& k, LAS bf16_t* lds) {
    const int tid = TID();
    const bf16_t* ZT = (const bf16_t*)(k.ws + AR_ZT);
    bf16_t* U = (bf16_t*)(k.ws + AR_UBUF);
    for (int u = blockIdx.x; u < 16 * (TL / 64); u += gridDim.x) {
        const int c0 = (u & 15) * 64, r0 = TC + (u >> 4) * 64;
        { const int c = tid >> 3, sg = (tid & 7) * 8;
          const u32x4 v = *(const u32x4*)(ZT + (size_t)(c0 + c) * T + r0 + sg);
#pragma unroll
          for (int w = 0; w < 4; ++w) { lds[(sg + 2 * w) * 66 + c] = (bf16_t)(v[w] & 0xffff); lds[(sg + 2 * w + 1) * 66 + c] = (bf16_t)(v[w] >> 16); } }
        __syncthreads();
        { const int r = tid >> 3, sg = (tid & 7) * 8; u32x4 o;
#pragma unroll
          for (int w = 0; w < 4; ++w) o[w] = (unsigned)lds[r * 66 + sg + 2 * w] | ((unsigned)lds[r * 66 + sg + 2 * w + 1] << 16);
          *(u32x4*)(U + (size_t)(r0 + r) * 1024 + c0 + sg) = o; }
        __syncthreads();
    }
}

__global__ void __launch_bounds__(NTHR, 2) fwd_kernel(Params prm) {
    extern __shared__ __attribute__((aligned(16))) unsigned char lds_raw[];
    LAS unsigned char* lds = (LAS unsigned char*)lds_raw;
    LAS float* ldsf = (LAS float*)lds;
    LAS bf16_t* ldsh = (LAS bf16_t*)lds;
    LAS int* tb = (LAS int*)(lds + 150 * 1024);
    volatile LAS unsigned* xbw = (volatile LAS unsigned*)(lds + 151 * 1024 + 512);
    KC k;
    k.x = (const float*)(GAS const float*)prm.in[0]; k.c = (const float*)(GAS const float*)prm.in[1]; k.ctx = (const float*)(GAS const float*)prm.in[2]; k.c_ctx = (const float*)(GAS const float*)prm.in[3]; k.ada_w = (const float*)(GAS const float*)prm.in[4]; k.ada_b = (const float*)(GAS const float*)prm.in[5];
    k.norm_mix = (const float*)(GAS const float*)prm.in[6]; k.norm_ffn = (const float*)(GAS const float*)prm.in[7]; k.norm_final = (const float*)(GAS const float*)prm.in[8];
    k.dn_w_in = (const float*)(GAS const float*)prm.in[9]; k.dn_conv = (const float*)(GAS const float*)prm.in[10]; k.dn_a_log = (const float*)(GAS const float*)prm.in[11]; k.dn_dt_bias = (const float*)(GAS const float*)prm.in[12]; k.dn_out_norm = (const float*)(GAS const float*)prm.in[13]; k.dn_w_out = (const float*)(GAS const float*)prm.in[14];
    k.hy_w_in = (const float*)(GAS const float*)prm.in[15]; k.hy_conv = (const float*)(GAS const float*)prm.in[16]; k.hy_f_w1 = (const float*)(GAS const float*)prm.in[17]; k.hy_f_b1 = (const float*)(GAS const float*)prm.in[18]; k.hy_f_freq = (const float*)(GAS const float*)prm.in[19]; k.hy_f_w2 = (const float*)(GAS const float*)prm.in[20];
    k.hy_f_b2 = (const float*)(GAS const float*)prm.in[21]; k.hy_f_w3 = (const float*)(GAS const float*)prm.in[22]; k.hy_bias = (const float*)(GAS const float*)prm.in[23]; k.hy_w_out = (const float*)(GAS const float*)prm.in[24];
    k.sc_w_in = (const float*)(GAS const float*)prm.in[25]; k.sc_conv = (const float*)(GAS const float*)prm.in[26]; k.sc_w_out = (const float*)(GAS const float*)prm.in[27]; k.w_router = (const float*)(GAS const float*)prm.in[28]; k.router_bias = (const float*)(GAS const float*)prm.in[29];
    k.moe_w_gate = (const float*)(GAS const float*)prm.in[30]; k.moe_w_up = (const float*)(GAS const float*)prm.in[31]; k.moe_w_down = (const float*)(GAS const float*)prm.in[32];
    k.out = (float*)(GAS float*)prm.out; k.ws = (unsigned char*)(GAS unsigned char*)prm.ws;
    const int lo = prm.ph_lo, hi = prm.ph_hi;
    XcdBarrier bar; bar.bar = (unsigned*)(k.ws + WS_CTL); bar.x = 0; bar.st = xbw;
    if (hi - lo > 1) {
        if (threadIdx.x == 0) { xbw[0] = 0u; xbw[1] = 0u; }
        __syncthreads();
        bar = xcd_barrier_post((unsigned*)(k.ws + WS_CTL), xbw);
    }
    int ph = 0;
#define PROBE_OK(id) ((id) != 1 || i == 0)
    int i = 0;
#define PH_BEGIN(id) if (ph >= lo && ph < hi) { const int nrep_ = (((id) == PROBE_REP) && PROBE_OK(id)) ? 2 : 1; for (int rep_ = 0; rep_ < nrep_; ++rep_) { { GAS unsigned char* w_ = (GAS unsigned char*)k.ws; asm volatile("" : "+s"(w_)); k.ws = (unsigned char*)w_; }
#define PH_END   if (ph + 1 < hi) xcd_barrier(bar); } } ++ph;

    float* xs = (float*)(k.ws + WS_XS);
    const float* mod = (const float*)(k.ws + WS_MOD);

    PH_BEGIN(0)
        job_mod(k, ldsf);
        job_cvt_small(k, ldsf);
        job_hdn(k, ldsf);
        job_w3s(k);
    PH_END

    for (i = 0; i < DEPTH; ++i) {
        const int kind = i % 3, j = i / 3;
        const bool last = (i == DEPTH - 1);
        PH_BEGIN(1)
            if (kind == 0) norm_mfma<2>(k, i, i == 0, i > 0, k.norm_mix + i * 1024, 0, k.dn_w_in + (size_t)j * 1024 * DN_IN + 4096, DN_IN,
                                        k.dn_a_log + j * 16, k.dn_dt_bias + j * 16, last, lds);
            else norm_phase<0>(k, i, i == 0, i > 0, k.norm_mix + i * 1024, 0, nullptr, 0, nullptr, nullptr, last, ldsf);
            if (kind == 1) job_filtc(k, j);
        PH_END
        PH_BEGIN(2)
            if (kind == 0) { EpiBf16 e{(bf16_t*)(k.ws + AR_PB), 3072, 3072, (bf16_t*)k.out, 1024}; gemm_dense(lds, (const bf16_t*)(k.ws + AR_HBUF), T, (const bf16_t*)(k.ws + WS_DNWIN) + (size_t)j * 4096 * 1024, 4096, 1024, e); }
            else if (kind == 1) { EpiBf16T e{(bf16_t*)(k.ws + AR_PB), T}; gemm_dense(lds, (const bf16_t*)(k.ws + AR_HBUF), T, (const bf16_t*)(k.ws + WS_HYWIN), 3072, 1024, e);
                                  EpiTaps et{(bf16_t*)(k.ws + AR_FT)}; gemm_dense(lds, (const bf16_t*)(k.ws + WS_W3S), 4096, (const bf16_t*)(k.ws + WS_HS), 16384, 256, et); }
            else { EpiBf16 e{(bf16_t*)(k.ws + AR_PB), 3072, 1 << 30, nullptr, 0}; gemm_dense(lds, (const bf16_t*)(k.ws + AR_HBUF), T, (const bf16_t*)(k.ws + WS_SCWIN), 3072, 1024, e); }
        PH_END
        if (kind == 0) {
            PH_BEGIN(3) dn_chunk(k, j, lds); PH_END
            PH_BEGIN(4) dn_scan(k, lds, rep_ ? PROBE_MODE : 0); PH_END
            PH_BEGIN(5) dn_finish(k, j); PH_END
        } else if (kind == 1) {
            PH_BEGIN(6) hy_lat(k, j, ldsf); hy_ctx(k, j, ldsf); PH_END
            PH_BEGIN(7) hy_transpose(k, ldsh); PH_END
        } else {
            PH_BEGIN(8) sc_mix(k, j); PH_END
        }
        PH_BEGIN(9)
            const bf16_t* Wt = kind == 0 ? (const bf16_t*)(k.ws + WS_DNWOUT) + (size_t)j * 1024 * 1024 : (kind == 1 ? (const bf16_t*)(k.ws + WS_HYWOUT) : (const bf16_t*)(k.ws + WS_SCWOUT));
            EpiResid e{xs, mod, i, 2};
            gemm_dense(lds, (const bf16_t*)(k.ws + AR_UBUF), T, Wt, 1024, 1024, e);
            if (gridDim.x == 256) job_cvt_moe(k, i, ldsf, (int)blockIdx.x - 8, 248); else job_cvt_moe(k, i, ldsf, (int)blockIdx.x, (int)gridDim.x);
        PH_END
        PH_BEGIN(10)
            norm_mfma<1>(k, i, false, false, k.norm_ffn + i * 1024, 3, k.w_router, 32, k.router_bias, nullptr, last, lds, rep_ == nrep_ - 1);
        PH_END
        PH_BEGIN(11)
            moe_scatter(k, i, tb);
        PH_END
        PH_BEGIN(12) moe_gemm<0>(k, i, lds, tb); PH_END
        PH_BEGIN(13) moe_gemm<1>(k, i, lds, tb); PH_END
    }
    PH_BEGIN(14)
        norm_phase<3>(k, DEPTH, false, true, k.norm_final, 0, nullptr, 0, nullptr, nullptr, false, ldsf);
    PH_END
#undef PH_BEGIN
#undef PH_END
}
constexpr int N_PHASES = 1 + (10 + 9 + 8 + 10) + 1;

extern "C" void kernel_launch(void* const* d_in, const int* in_sizes, int n_in, void* d_out, int out_size, void* d_ws, size_t ws_size, hipStream_t stream) {
    static int grid = 0;
    if (grid == 0) {
        if (n_in != 33 || out_size != TL * D || ws_size < WS_END) { fprintf(stderr, "kernel_launch: unexpected shapes: n_in %d out %d ws %zu (need %zu)\n", n_in, out_size, ws_size, (size_t)WS_END); grid = -1; return; }
        int dev = 0, cus = 0, per_cu = 0;
        if (hipGetDevice(&dev) != hipSuccess || hipDeviceGetAttribute(&cus, hipDeviceAttributeMultiprocessorCount, dev) != hipSuccess) { grid = -1; return; }
        if (hipFuncSetAttribute((const void*)fwd_kernel, hipFuncAttributeMaxDynamicSharedMemorySize, LDS_BYTES) != hipSuccess) { fprintf(stderr, "kernel_launch: hipFuncSetAttribute failed\n"); grid = -1; return; }
        if (hipOccupancyMaxActiveBlocksPerMultiprocessor(&per_cu, (const void*)fwd_kernel, NTHR, LDS_BYTES) != hipSuccess || per_cu < 1) fprintf(stderr, "kernel_launch: occupancy query reports %d\n", per_cu);
        (void)hipGetLastError();
        grid = cus;
    }
    if (grid < 0) return;
    (void)hipMemsetAsync((char*)d_ws + WS_CTL, 0, CTL_BYTES, stream);
    Params p{};
    for (int i = 0; i < 33; ++i) p.in[i] = (const float*)d_in[i];
    p.out = (float*)d_out; p.ws = (unsigned char*)d_ws;
#if MK_MULTI
    for (int ph = 0; ph < N_PHASES; ++ph) { p.ph_lo = ph; p.ph_hi = ph + 1; hipLaunchKernelGGL(fwd_kernel, dim3(grid), dim3(NTHR), LDS_BYTES, stream, p); }
#else
    p.ph_lo = 0; p.ph_hi = N_PHASES;
    hipLaunchKernelGGL(fwd_kernel, dim3(grid), dim3(NTHR), LDS_BYTES, stream, p);
#endif
}
```

```cpp
#include <hip/hip_runtime.h>
#include <stdint.h>
#include <stdio.h>
#include <math.h>

#ifndef MK_MULTI
#define MK_MULTI 0
#endif

#ifndef PROBE_SUB
#define PROBE_SUB (0)
#endif
#ifndef PROBE_MODE
#define PROBE_MODE (1)
#endif
#ifndef PROBE_REP
#define PROBE_REP (-1)
#endif
#define LAS __attribute__((address_space(3)))
#define GAS __attribute__((address_space(1)))
#define HD __host__ __device__ __forceinline__
#define DI __device__ __forceinline__
#ifdef NOINL
#define PF __device__ __noinline__
#else
#define PF __device__ __forceinline__
#endif
typedef unsigned short bf16_t;
typedef short bf16x8 __attribute__((ext_vector_type(8)));
typedef float f32x4 __attribute__((ext_vector_type(4)));
typedef unsigned u32x4 __attribute__((ext_vector_type(4)));
typedef unsigned u32x2 __attribute__((ext_vector_type(2)));

constexpr int D = 1024, NB = 2, SEQ = 16384, CTXL = 256, DEPTH = 4;
constexpr int TC = NB * CTXL, TL = NB * SEQ, T = TC + TL, NA = 2 * T;
constexpr int NTHR = 512;
constexpr int DN_IN = 4128;
constexpr float EPS = 1e-6f;
constexpr int LDS_BYTES = 152 * 1024;

constexpr size_t AL(size_t x) { return (x + 255) & ~(size_t)255; }
constexpr size_t WS_CTL = 0;
constexpr size_t CTL_BYTES = 65536;
constexpr size_t CTL_CNT = 16384;
constexpr size_t WS_MOD = WS_CTL + CTL_BYTES;
constexpr size_t WS_HS = AL(WS_MOD + 4 * 3 * 6144 * 4);
constexpr size_t WS_W3S = AL(WS_HS + 16384 * 256 * 2);
constexpr size_t WS_HDNC = AL(WS_W3S + 4096 * 256 * 2);
constexpr size_t WS_FILTC = AL(WS_HDNC + 256 * 64 * 4);
constexpr size_t WS_DNWIN = AL(WS_FILTC + 256 * 4096 * 4);
constexpr size_t WS_DNWOUT = AL(WS_DNWIN + (size_t)2 * 4096 * 1024 * 2);
constexpr size_t WS_HYWIN = AL(WS_DNWOUT + (size_t)2 * 1024 * 1024 * 2);
constexpr size_t WS_HYWOUT = AL(WS_HYWIN + (size_t)3072 * 1024 * 2);
constexpr size_t WS_SCWIN = AL(WS_HYWOUT + (size_t)1024 * 1024 * 2);
constexpr size_t WS_SCWOUT = AL(WS_SCWIN + (size_t)3072 * 1024 * 2);
constexpr size_t WS_XS = AL(WS_SCWOUT + (size_t)1024 * 1024 * 2);
constexpr size_t WS_TOKE = AL(WS_XS + (size_t)T * 1024 * 4);
constexpr size_t WS_TOKW = AL(WS_TOKE + (size_t)T * 2 * 4);
constexpr size_t WS_TOKP = AL(WS_TOKW + (size_t)T * 2 * 4);
constexpr size_t WS_SLOT = AL(WS_TOKP + (size_t)T * 2 * 4);
constexpr size_t WS_GB = AL(WS_SLOT + (size_t)(NA + 256) * 4);
constexpr size_t WS_EGL = AL(WS_GB + (size_t)T * 32 * 4);
constexpr size_t WS_AR = AL(WS_EGL + (size_t)32 * 260 * 4);
constexpr size_t AR_HBUF = WS_AR;
constexpr size_t AR_UBUF = AR_HBUF + (size_t)T * 1024 * 2;
constexpr size_t AR_PB = AR_UBUF + (size_t)T * 1024 * 2;
constexpr size_t AR_Q = AR_PB + (size_t)T * 4096 * 2;
constexpr size_t AR_CHUNK = AR_PB + (size_t)T * 3072 * 2;
constexpr size_t AR_DN_END = AR_CHUNK + (size_t)32 * 260 * 65536;
constexpr size_t AR_ZT = AR_Q;
constexpr size_t AR_FFTS = AR_ZT + (size_t)1024 * T * 2;
constexpr size_t AR_FT = AR_FFTS + (size_t)256 * 4 * 16384 * 8;
constexpr size_t AR_HY_END = AR_FT + (size_t)4096 * 16384 * 4;
constexpr size_t AR_HID = AR_PB;
constexpr size_t AR_YS = AR_HID + (size_t)NA * 512 * 2;
constexpr size_t AR_WGU = AR_YS + (size_t)NA * 1024 * 2;
constexpr size_t AR_WD = AR_WGU + (size_t)32 * 1024 * 1024 * 2;
constexpr size_t AR_MOE_END = AR_WD + (size_t)32 * 1024 * 512 * 2;
constexpr size_t WS_END = AR_DN_END > AR_HY_END ? (AR_DN_END > AR_MOE_END ? AR_DN_END : AR_MOE_END) : (AR_HY_END > AR_MOE_END ? AR_HY_END : AR_MOE_END);

#define XB_TMO      128
#define XB_XCNT(j)  (256  + 64 * (j))
#define XB_XSUB(j)  (1280 + 64 * (j))
#define XB_XGEN(j)  (2304 + 64 * (j))
#define XB_TOP      3328
#define XB_TOPGEN   3392
#define XCD_BAR_WORDS 3456
#define XB_SPIN_CAP (1u << 25)
DI unsigned xb_ld(unsigned* p)              { return __hip_atomic_load(p, __ATOMIC_RELAXED, __HIP_MEMORY_SCOPE_AGENT); }
DI unsigned xb_add(unsigned* p, unsigned v) { return __hip_atomic_fetch_add(p, v, __ATOMIC_RELAXED, __HIP_MEMORY_SCOPE_AGENT); }
DI unsigned xb_xcc_id() { return (unsigned)__builtin_amdgcn_s_getreg((3 << 11) | 20) & 0xFu; }
#define XB_SPIN(cond, bar) do { unsigned _sp = 0; while (cond) { __builtin_amdgcn_s_sleep(1); \
    if ((++_sp & 255u) == 0u) { if (xb_ld(&(bar)[XB_TMO])) break; if (_sp > XB_SPIN_CAP) { atomicAdd(&(bar)[XB_TMO], 1u); break; } } } } while (0)
struct XcdBarrier { unsigned* bar; unsigned x; volatile LAS unsigned* st; };
DI XcdBarrier xcd_barrier_post(unsigned* bar, volatile LAS unsigned* st) {
    XcdBarrier b; b.bar = bar; b.x = xb_xcc_id(); b.st = st;
    if (threadIdx.x == 0) (void)xb_add(&bar[XB_XCNT(b.x)], 1u);
    return b;
}
DI void xcd_barrier_complete(unsigned* bar, unsigned x, unsigned& nloc, unsigned& nx) {
    const unsigned G = gridDim.x * gridDim.y * gridDim.z;
    unsigned sum, cnt, mine, sp = 0u;
    for (;;) {
        sum = 0u; cnt = 0u; mine = 0u;
#pragma unroll
        for (unsigned j = 0; j < 16; ++j) { const unsigned c = xb_ld(&bar[XB_XCNT(j)]); sum += c; cnt += (c > 0u) ? 1u : 0u; mine = (j == x) ? c : mine; }
        if (sum == G) break;
        __builtin_amdgcn_s_sleep(1);
        if ((++sp & 255u) == 0u) { if (xb_ld(&bar[XB_TMO])) break; if (sp > XB_SPIN_CAP) { atomicAdd(&bar[XB_TMO], 1u); break; } }
    }
    nloc = mine > 0u ? mine : 1u; nx = cnt > 0u ? cnt : 1u;
}
DI void xcd_barrier(const XcdBarrier& b) {
    asm volatile("s_waitcnt vmcnt(0)" ::: "memory");
    __syncthreads();
    if (threadIdx.x == 0) {
        unsigned* bar = b.bar;
        __builtin_amdgcn_s_waitcnt(0);
        unsigned nloc = b.st[0], nx = b.st[1];
        if (nloc == 0u) { xcd_barrier_complete(bar, b.x, nloc, nx); b.st[0] = nloc; b.st[1] = nx; }
        const unsigned old = xb_add(&bar[XB_XSUB(b.x)], 1u);
        const unsigned gen = old / nloc;
        if (old + 1u == (gen + 1u) * nloc) {
            __builtin_amdgcn_fence(__ATOMIC_RELEASE, "agent");
            asm volatile("s_waitcnt vmcnt(0)" ::: "memory");
            const unsigned og = xb_add(&bar[XB_TOP], 1u);
            const unsigned tg = og / nx;
            if (og + 1u == (tg + 1u) * nx) xb_add(&bar[XB_TOPGEN], 1u);
            else XB_SPIN(xb_ld(&bar[XB_TOPGEN]) == tg, bar);
            __builtin_amdgcn_fence(__ATOMIC_ACQUIRE, "agent");
            xb_add(&bar[XB_XGEN(b.x)], 1u);
            asm volatile("s_waitcnt vmcnt(0)" ::: "memory");
        } else {
            XB_SPIN(xb_ld(&bar[XB_XGEN(b.x)]) == gen, bar);
            __builtin_amdgcn_fence(__ATOMIC_ACQUIRE, "agent");
            asm volatile("s_waitcnt vmcnt(0)" ::: "memory");
        }
    }
    __syncthreads();
}

typedef float f32x2_t __attribute__((ext_vector_type(2)));
typedef __bf16 bf16x2_t __attribute__((ext_vector_type(2)));
DI unsigned cvt_pk_bf16(float lo, float hi) { f32x2_t v; v.x = lo; v.y = hi; const bf16x2_t b = __builtin_convertvector(v, bf16x2_t); return __builtin_bit_cast(unsigned, b); }
DI bf16_t f2bf(float f) { return (bf16_t)(cvt_pk_bf16(f, f) & 0xffffu); }
DI float bf2f(bf16_t b) { return __uint_as_float(((unsigned)b) << 16); }
DI unsigned pk2(float lo, float hi) { return cvt_pk_bf16(lo, hi); }
DI float siluf(float x) { return x * __builtin_amdgcn_rcpf(1.0f + __expf(-x)); }
DI float sigmf(float x) { return 1.0f / (1.0f + __expf(-x)); }
DI float shi(float v, int src) { return __int_as_float(__builtin_amdgcn_ds_bpermute(src << 2, __float_as_int(v))); }
DI int shii(int v, int src) { return __builtin_amdgcn_ds_bpermute(src << 2, v); }
DI float shx(float v, int m, int lane) { return shi(v, lane ^ m); }
DI float wsum(float v, int lane) {
#pragma unroll
    for (int m = 32; m >= 1; m >>= 1) v += shx(v, m, lane);
    return v;
}
DI void lds_barrier() { asm volatile("s_waitcnt lgkmcnt(0)\n\ts_barrier" ::: "memory"); }
DI int TID() { int t = threadIdx.x; asm volatile("" : "+v"(t)); return t; }
DI int modrow(int r) { return r < TC ? 0 : 1 + (r - TC) / SEQ; }

typedef float cf __attribute__((ext_vector_type(2)));
HD cf cmul(cf a, cf b) { cf r; r.x = a.x * b.x - a.y * b.y; r.y = a.x * b.y + a.y * b.x; return r; }
HD cf cadd(cf a, cf b) { cf r; r.x = a.x + b.x; r.y = a.y + b.y; return r; }
HD cf csub(cf a, cf b) { cf r; r.x = a.x - b.x; r.y = a.y - b.y; return r; }
template <int R> HD constexpr int brev(int i) { int r = 0; for (int b = 1, t = R >> 1; b < R; b <<= 1, t >>= 1) if (i & b) r |= t; return r; }
#define FFT_C32 {1.0f, 0.98078528040323044913f, 0.92387953251128675613f, 0.83146961230254523708f, 0.70710678118654752440f, 0.55557023301960222474f, 0.38268343236508977173f, 0.19509032201612826785f, 0.0f, -0.19509032201612826785f, -0.38268343236508977173f, -0.55557023301960222474f, -0.70710678118654752440f, -0.83146961230254523708f, -0.92387953251128675613f, -0.98078528040323044913f}
#define FFT_S32 {0.0f, 0.19509032201612826785f, 0.38268343236508977173f, 0.55557023301960222474f, 0.70710678118654752440f, 0.83146961230254523708f, 0.92387953251128675613f, 0.98078528040323044913f, 1.0f, 0.98078528040323044913f, 0.92387953251128675613f, 0.83146961230254523708f, 0.70710678118654752440f, 0.55557023301960222474f, 0.38268343236508977173f, 0.19509032201612826785f}
template <int R> HD constexpr int ilog2c() { int l = 0; for (int r = R; r > 1; r >>= 1) ++l; return l; }
template <int R> HD void dft_fwd(cf (&v)[R]) {
    constexpr float C[16] = FFT_C32; constexpr float S[16] = FFT_S32;
    constexpr int LG = ilog2c<R>();
#pragma unroll
    for (int st = 0; st < LG; ++st) {
#pragma unroll
        for (int i = 0; i < R / 2; ++i) {
            const int len = R >> st, half = len >> 1, blk = i / half, j = i % half, i0 = blk * len + j, i1 = i0 + half;
            const cf a = v[i0], c = v[i1];
            v[i0] = cadd(a, c);
            const cf d = csub(a, c);
            const int ti = j * (32 / len);
            cf w; w.x = C[ti]; w.y = -S[ti];
            cf r;
            if (ti == 0) r = d;
            else if (ti == 8) { r.x = d.y; r.y = -d.x; }
            else if (ti == 4) { r.x = (d.x + d.y) * 0.70710678118654752440f; r.y = (d.y - d.x) * 0.70710678118654752440f; }
            else if (ti == 12) { r.x = (d.y - d.x) * 0.70710678118654752440f; r.y = -(d.x + d.y) * 0.70710678118654752440f; }
            else r = cmul(d, w);
            v[i1] = r;
        }
    }
}
template <int R> HD void dft_inv(cf (&v)[R]) {
    constexpr float C[16] = FFT_C32; constexpr float S[16] = FFT_S32;
    constexpr int LG = ilog2c<R>();
#pragma unroll
    for (int st = LG - 1; st >= 0; --st) {
#pragma unroll
        for (int i = 0; i < R / 2; ++i) {
            const int len = R >> st, half = len >> 1, blk = i / half, j = i % half, i0 = blk * len + j, i1 = i0 + half;
            const int ti = j * (32 / len);
            cf w; w.x = C[ti]; w.y = S[ti];
            const cf a = v[i0];
            const cf b1 = v[i1];
            cf c;
            if (ti == 0) c = b1;
            else if (ti == 8) { c.x = -b1.y; c.y = b1.x; }
            else if (ti == 4) { c.x = (b1.x - b1.y) * 0.70710678118654752440f; c.y = (b1.x + b1.y) * 0.70710678118654752440f; }
            else if (ti == 12) { c.x = -(b1.x + b1.y) * 0.70710678118654752440f; c.y = (b1.x - b1.y) * 0.70710678118654752440f; }
            else c = cmul(b1, w);
            v[i0] = cadd(a, c);
            v[i1] = csub(a, c);
        }
    }
}
#define PIDX(a) ((a) + (((a) >> 6) << 2))
template <int R> DI void fft_pass_fwd(LAS cf* X, const LAS cf* tw, int n, int g) {
    const int s = n / R, q = g / s, p = g - q * s, base = q * n + p;
    cf v[R];
#pragma unroll
    for (int k = 0; k < R; ++k) v[k] = X[PIDX(base + k * s)];
    dft_fwd<R>(v);
    if (s > 1) {
        int pp = p * (16384 / n); asm volatile("" : "+v"(pp));
        const cf w1 = tw[pp]; cf w = w1;
#pragma unroll
        for (int m = 1; m < R; ++m) { v[brev<R>(m)] = cmul(v[brev<R>(m)], w); w = cmul(w, w1); }
    }
#pragma unroll
    for (int k = 0; k < R; ++k) X[PIDX(base + k * s)] = v[k];
}
template <int R> DI void fft_pass_inv(LAS cf* X, const LAS cf* tw, int n, int g) {
    const int s = n / R, q = g / s, p = g - q * s, base = q * n + p;
    cf v[R];
#pragma unroll
    for (int k = 0; k < R; ++k) v[k] = X[PIDX(base + k * s)];
    if (s > 1) {
        int pp = p * (16384 / n); asm volatile("" : "+v"(pp));
        cf w1 = tw[pp]; w1.y = -w1.y; cf w = w1;
#pragma unroll
        for (int m = 1; m < R; ++m) { v[brev<R>(m)] = cmul(v[brev<R>(m)], w); w = cmul(w, w1); }
    }
    dft_inv<R>(v);
#pragma unroll
    for (int k = 0; k < R; ++k) X[PIDX(base + k * s)] = v[k];
}
DI void fft16k_fwd(LAS cf* X, const LAS cf* tw) {
    const int t = TID();
#pragma unroll 1
    for (int g = 0; g < 2; ++g) fft_pass_fwd<16>(X, tw, 16384, t + 512 * g);
    __syncthreads();
#pragma unroll 1
    for (int g = 0; g < 2; ++g) fft_pass_fwd<16>(X, tw, 1024, t + 512 * g);
    __syncthreads();
#pragma unroll 1
    for (int g = 0; g < 2; ++g) fft_pass_fwd<16>(X, tw, 64, t + 512 * g);
    __syncthreads();
#pragma unroll 1
    for (int g = 0; g < 8; ++g) fft_pass_fwd<4>(X, tw, 4, t + 512 * g);
    __syncthreads();
}
DI void fft16k_inv(LAS cf* X, const LAS cf* tw) {
    const int t = TID();
#pragma unroll 1
    for (int g = 0; g < 8; ++g) fft_pass_inv<4>(X, tw, 4, t + 512 * g);
    __syncthreads();
#pragma unroll 1
    for (int g = 0; g < 2; ++g) fft_pass_inv<16>(X, tw, 64, t + 512 * g);
    __syncthreads();
#pragma unroll 1
    for (int g = 0; g < 2; ++g) fft_pass_inv<16>(X, tw, 1024, t + 512 * g);
    __syncthreads();
#pragma unroll 1
    for (int g = 0; g < 2; ++g) fft_pass_inv<16>(X, tw, 16384, t + 512 * g);
    __syncthreads();
}

struct Params { const float* in[33]; float* out; unsigned char* ws; int ph_lo, ph_hi; };
struct KC {
    const float *x, *c, *ctx, *c_ctx, *ada_w, *ada_b, *norm_mix, *norm_ffn, *norm_final;
    const float *dn_w_in, *dn_conv, *dn_a_log, *dn_dt_bias, *dn_out_norm, *dn_w_out;
    const float *hy_w_in, *hy_conv, *hy_f_w1, *hy_f_b1, *hy_f_freq, *hy_f_w2, *hy_f_b2, *hy_f_w3, *hy_bias, *hy_w_out;
    const float *sc_w_in, *sc_conv, *sc_w_out, *w_router, *router_bias, *moe_w_gate, *moe_w_up, *moe_w_down;
    float* out; unsigned char* ws;
};

PF void job_mod(const KC& k, LAS float* lds) {
    const int tid = TID(), cj = tid & 63, kq = tid >> 6;
    float* mod = (float*)(k.ws + WS_MOD);
    LAS float* sl = lds + 2048;
    for (int i = tid; i < 3072; i += NTHR) { const float v = i < 1024 ? k.c_ctx[i] : k.c[i - 1024]; sl[i] = siluf(v); }
    __syncthreads();
    for (int u = blockIdx.x; u < DEPTH * 96; u += gridDim.x) {
        const int l = u / 96, cc = u % 96, col = cc * 64 + cj;
        const float* W = k.ada_w + (size_t)l * 1024 * 6144 + col;
        float a0 = 0.f, a1 = 0.f, a2 = 0.f;
        for (int k0 = kq * 128; k0 < kq * 128 + 128; k0 += 16) {
            float w[16];
#pragma unroll
            for (int e = 0; e < 16; ++e) w[e] = W[(size_t)(k0 + e) * 6144];
            asm volatile("" ::: "memory");
#pragma unroll
            for (int e = 0; e < 16; ++e) { a0 += sl[k0 + e] * w[e]; a1 += sl[1024 + k0 + e] * w[e]; a2 += sl[2048 + k0 + e] * w[e]; }
        }
        lds[(kq * 3 + 0) * 64 + cj] = a0; lds[(kq * 3 + 1) * 64 + cj] = a1; lds[(kq * 3 + 2) * 64 + cj] = a2;
        __syncthreads();
        if (tid < 192) {
            const int r = tid >> 6, j = tid & 63;
            float sacc = 0.f;
            for (int q = 0; q < 8; ++q) sacc += lds[(q * 3 + r) * 64 + j];
            mod[(size_t)(l * 3 + r) * 6144 + cc * 64 + j] = sacc + k.ada_b[l * 6144 + cc * 64 + j];
        }
        __syncthreads();
    }
}
DI void cvt_matrix(const float* src, int ld, size_t sstride, int K, int N, int nmat, bf16_t* dst, int ldd, size_t dstride, int mapmode, LAS float* lds, int bid, int nb) {
    const int tk = K / 64, tn = N / 64, per = tk * tn, tid = TID();
    const int r = tid >> 4, c4 = (tid & 15) * 4;
    f32x4 v0, v1;
    int u = bid;
    if (u < per * nmat) { const int m = u / per, t = u % per; const float* sp = src + (size_t)m * sstride + (size_t)((t / tn) * 64 + r) * ld + (t % tn) * 64 + c4; v0 = *(const f32x4*)sp; v1 = *(const f32x4*)(sp + (size_t)32 * ld); }
    for (; u < per * nmat; u += nb) {
        const int m = u / per, t = u % per, k0 = (t / tn) * 64, n0 = (t % tn) * 64;
        { LAS float* p = lds + r * 65 + c4; p[0] = v0[0]; p[1] = v0[1]; p[2] = v0[2]; p[3] = v0[3];
          LAS float* p2 = lds + (r + 32) * 65 + c4; p2[0] = v1[0]; p2[1] = v1[1]; p2[2] = v1[2]; p2[3] = v1[3]; }
        { const int un = u + nb;
          if (un < per * nmat) { const int mn = un / per, tn_ = un % per; const float* sp = src + (size_t)mn * sstride + (size_t)((tn_ / tn) * 64 + r) * ld + (tn_ % tn) * 64 + c4; v0 = *(const f32x4*)sp; v1 = *(const f32x4*)(sp + (size_t)32 * ld); } }
        lds_barrier();
        { const int nn = tid >> 3, ks = (tid & 7) * 8; const int n = n0 + nn;
          const int row = mapmode == 0 ? n : (32 * (n >> 4) + (n & 15) + (mapmode == 2 ? 16 : 0));
          float f[8];
#pragma unroll
          for (int e = 0; e < 8; ++e) f[e] = lds[(ks + e) * 65 + nn];
          u32x4 o; o[0] = pk2(f[0], f[1]); o[1] = pk2(f[2], f[3]); o[2] = pk2(f[4], f[5]); o[3] = pk2(f[6], f[7]);
          *(u32x4*)(dst + (size_t)m * dstride + (size_t)row * ldd + k0 + ks) = o; }
        lds_barrier();
    }
}
PF void job_cvt_small(const KC& k, LAS float* lds) {
    cvt_matrix(k.dn_w_in, DN_IN, (size_t)1024 * DN_IN, 1024, 4096, 2, (bf16_t*)(k.ws + WS_DNWIN), 1024, (size_t)4096 * 1024, 0, lds, (int)blockIdx.x, (int)gridDim.x);
    cvt_matrix(k.dn_w_out, 1024, (size_t)1024 * 1024, 1024, 1024, 2, (bf16_t*)(k.ws + WS_DNWOUT), 1024, (size_t)1024 * 1024, 0, lds, (int)blockIdx.x, (int)gridDim.x);
    cvt_matrix(k.hy_w_in, 3072, 0, 1024, 3072, 1, (bf16_t*)(k.ws + WS_HYWIN), 1024, 0, 0, lds, (int)blockIdx.x, (int)gridDim.x);
    cvt_matrix(k.hy_w_out, 1024, 0, 1024, 1024, 1, (bf16_t*)(k.ws + WS_HYWOUT), 1024, 0, 0, lds, (int)blockIdx.x, (int)gridDim.x);
    cvt_matrix(k.sc_w_in, 3072, 0, 1024, 3072, 1, (bf16_t*)(k.ws + WS_SCWIN), 1024, 0, 0, lds, (int)blockIdx.x, (int)gridDim.x);
    cvt_matrix(k.sc_w_out, 1024, 0, 1024, 1024, 1, (bf16_t*)(k.ws + WS_SCWOUT), 1024, 0, 0, lds, (int)blockIdx.x, (int)gridDim.x);
}
PF void job_cvt_moe(const KC& k, int layer, LAS float* lds, int bid, int nb) {
    if (bid < 0) return;
    const size_t lo = (size_t)layer * 32 * 1024 * 512;
    cvt_matrix(k.moe_w_gate + lo, 512, (size_t)1024 * 512, 1024, 512, 32, (bf16_t*)(k.ws + AR_WGU), 1024, (size_t)1024 * 1024, 1, lds, bid, nb);
    cvt_matrix(k.moe_w_up + lo, 512, (size_t)1024 * 512, 1024, 512, 32, (bf16_t*)(k.ws + AR_WGU), 1024, (size_t)1024 * 1024, 2, lds, bid, nb);
    cvt_matrix(k.moe_w_down + lo, 1024, (size_t)512 * 1024, 512, 1024, 32, (bf16_t*)(k.ws + AR_WD), 512, (size_t)1024 * 512, 0, lds, bid, nb);
}
PF void job_hdn(const KC& k, LAS float* lds) {
    const int tid = TID(), lane = tid & 63, wave = tid >> 6;
    LAS float* feat = lds + wave * 128; LAS float* h1 = feat + 64;
    const float fr = k.hy_f_freq[lane], b1 = k.hy_f_b1[lane], b2 = k.hy_f_b2[lane];
    for (int u0 = blockIdx.x * 8; u0 < 16384 + 256; u0 += gridDim.x * 8) {
        const int u = u0 + wave;
        int l, pos; float* dst;
        if (u < 16384) { l = 16384; pos = u; dst = nullptr; }
        else { l = 256; pos = u - 16384; dst = (float*)(k.ws + WS_HDNC) + (size_t)pos * 64; }
        const float t = (float)pos / (float)(l - 1);
        float f = 0.f;
        if (lane == 0) f = t;
        else if (lane <= 32) {
            const int bi = (lane - 1) & 15;
            const float band = 1e-4f + (float)bi * ((15.0f - 1e-4f) / 15.0f);
            const float ang = (6.283185307179586f / (float)l) * (float)pos * band;
            f = lane <= 16 ? cosf(ang) : -sinf(ang);
        }
        feat[lane] = f;
        __syncthreads();
        float a = b1;
        for (int i = 0; i < 33; ++i) a += feat[i] * k.hy_f_w1[i * 64 + lane];
        h1[lane] = sinf(fr * a);
        __syncthreads();
        float a2 = b2;
        for (int j = 0; j < 64; ++j) a2 += h1[j] * k.hy_f_w2[j * 64 + lane];
        const float hv = sinf(fr * a2);
        if (dst) dst[lane] = hv;
        else { bf16_t* hs = (bf16_t*)(k.ws + WS_HS) + (size_t)pos * 256; const bf16_t hi = f2bf(hv), lo = f2bf(hv - bf2f(hi)); hs[lane] = hi; hs[64 + lane] = lo; hs[128 + lane] = hi; hs[192 + lane] = 0; }
        __syncthreads();
    }
}
PF void job_w3s(const KC& k) {
    bf16_t* W = (bf16_t*)(k.ws + WS_W3S);
    const int tq = TID();
    for (int idx = blockIdx.x * NTHR + tq; idx < 64 * 4096; idx += gridDim.x * NTHR) {
        const int j = idx >> 12, col = idx & 4095;
        const float w = k.hy_f_w3[idx]; const bf16_t hi = f2bf(w), lo = f2bf(w - bf2f(hi));
        W[(size_t)col * 256 + j] = hi; W[(size_t)col * 256 + 64 + j] = hi; W[(size_t)col * 256 + 128 + j] = lo; W[(size_t)col * 256 + 192 + j] = 0;
    }
}
DI float hy_delta(int ch) {
    const float lo = -4.605170185988091f / 1.5f, hi = -4.605170185988091f / 0.3f;
    return fabsf(lo + (float)ch * ((hi - lo) / 1023.0f));
}
PF void job_filtc(const KC& k, int j) {
    const float* hdn = (const float*)(k.ws + WS_HDNC);
    const float* w3 = k.hy_f_w3 + (size_t)j * 64 * 4096;
    float* filtc = (float*)(k.ws + WS_FILTC);
    const int tq = TID();
    for (int u = blockIdx.x; u < 256 * 8; u += gridDim.x) {
        const int l = u >> 3, col = (u & 7) * 512 + tq;
        float a = 0.f;
        for (int q = 0; q < 64; ++q) a += hdn[l * 64 + q] * w3[(size_t)q * 4096 + col];
        const float t = (float)l / 255.0f;
        filtc[(size_t)l * 4096 + col] = a * expf(-t * hy_delta(col & 1023));
    }
}

template <int MODE>
PF void norm_vec(const KC& k, int layer, const float* __restrict__ gain, int mb) {
    const int tid = TID(), lane = tid & 63, wave = tid >> 6;
    float* xs = (float*)(k.ws + WS_XS);
    bf16_t* hbuf = (bf16_t*)(k.ws + AR_HBUF);
    const float* mod = (const float*)(k.ws + WS_MOD);
    const bf16_t* ys = (const bf16_t*)(k.ws + AR_YS);
    const int* tokp = (const int*)(k.ws + WS_TOKP);
    const float* tokw = (const float*)(k.ws + WS_TOKW);
    const int rbeg = (MODE == 3) ? TC : 0, rstr = gridDim.x * 8, c0 = 4 * lane;
    int cur_mr = -1; f32x4 gsv[4], shv[4], g5v[4];
    int r = rbeg + blockIdx.x * 8 + wave;
    if (r >= T) return;
    f32x4 xn[4]; u32x2 yan[4], ybn[4]; float w0n, w1n, w0f, w1f; int p0f, p1f;
    {
        const int p0 = tokp[2 * r], p1 = tokp[2 * r + 1]; w0n = tokw[2 * r]; w1n = tokw[2 * r + 1];
        const int r2 = r + rstr < T ? r + rstr : T - 1;
        p0f = tokp[2 * r2]; p1f = tokp[2 * r2 + 1]; w0f = tokw[2 * r2]; w1f = tokw[2 * r2 + 1];
#pragma unroll
        for (int j = 0; j < 4; ++j) {
            xn[j] = *(const f32x4*)(xs + (size_t)r * 1024 + 256 * j + c0);
            yan[j] = *(const u32x2*)(ys + (size_t)p0 * 1024 + 256 * j + c0); ybn[j] = *(const u32x2*)(ys + (size_t)p1 * 1024 + 256 * j + c0);
        }
    }
    for (; r < T; r += rstr) {
        const int mr = modrow(r);
        f32x4 x[4]; u32x2 ya[4], yb[4];
#pragma unroll
        for (int j = 0; j < 4; ++j) { x[j] = xn[j]; ya[j] = yan[j]; yb[j] = ybn[j]; }
        const float w0 = w0n, w1 = w1n;
        {
            const int rn = r + rstr < T ? r + rstr : T - 1, rf = r + 2 * rstr < T ? r + 2 * rstr : T - 1;
#pragma unroll
            for (int j = 0; j < 4; ++j) {
                xn[j] = *(const f32x4*)(xs + (size_t)rn * 1024 + 256 * j + c0);
                yan[j] = *(const u32x2*)(ys + (size_t)p0f * 1024 + 256 * j + c0); ybn[j] = *(const u32x2*)(ys + (size_t)p1f * 1024 + 256 * j + c0);
            }
            w0n = w0f; w1n = w1f;
            p0f = tokp[2 * rf]; p1f = tokp[2 * rf + 1]; w0f = tokw[2 * rf]; w1f = tokw[2 * rf + 1];
        }
        if (mr != cur_mr) {
            cur_mr = mr;
            const float* shift = mod + ((size_t)(layer * 3 + mr) * 6 + mb) * 1024;
            const float* g5 = mod + ((size_t)((layer - 1) * 3 + mr) * 6 + 5) * 1024;
#pragma unroll
            for (int j = 0; j < 4; ++j) {
                const int col = 256 * j + c0;
                const f32x4 gn = *(const f32x4*)(gain + col);
                if (MODE != 3) { const f32x4 sc = *(const f32x4*)(shift + 1024 + col); shv[j] = *(const f32x4*)(shift + col);
#pragma unroll
                    for (int e = 0; e < 4; ++e) gsv[j][e] = gn[e] * (1.0f + sc[e]); }
                else gsv[j] = gn;
                g5v[j] = *(const f32x4*)(g5 + col);
            }
        }
        float ss = 0.f;
#pragma unroll
        for (int j = 0; j < 4; ++j) {
            const float a0 = __uint_as_float(ya[j][0] << 16), a1 = __uint_as_float(ya[j][0] & 0xffff0000u), a2 = __uint_as_float(ya[j][1] << 16), a3 = __uint_as_float(ya[j][1] & 0xffff0000u);
            const float b0 = __uint_as_float(yb[j][0] << 16), b1 = __uint_as_float(yb[j][0] & 0xffff0000u), b2 = __uint_as_float(yb[j][1] << 16), b3 = __uint_as_float(yb[j][1] & 0xffff0000u);
            x[j][0] += g5v[j][0] * (w0 * a0 + w1 * b0); x[j][1] += g5v[j][1] * (w0 * a1 + w1 * b1);
            x[j][2] += g5v[j][2] * (w0 * a2 + w1 * b2); x[j][3] += g5v[j][3] * (w0 * a3 + w1 * b3);
            if (MODE != 3) *(f32x4*)(xs + (size_t)r * 1024 + 256 * j + c0) = x[j];
            ss += x[j][0] * x[j][0] + x[j][1] * x[j][1] + x[j][2] * x[j][2] + x[j][3] * x[j][3];
        }
        ss = wsum(ss, lane);
        const float rstd = rsqrtf(ss * (1.0f / 1024.0f) + EPS);
#pragma unroll
        for (int j = 0; j < 4; ++j) {
            if (MODE == 3) {
                f32x4 o;
#pragma unroll
                for (int e = 0; e < 4; ++e) o[e] = x[j][e] * rstd * gsv[j][e];
                *(f32x4*)(k.out + (size_t)(r - TC) * 1024 + 256 * j + c0) = o;
            } else {
                u32x2 o;
                o[0] = pk2(x[j][0] * rstd * gsv[j][0] + shv[j][0], x[j][1] * rstd * gsv[j][1] + shv[j][1]);
                o[1] = pk2(x[j][2] * rstd * gsv[j][2] + shv[j][2], x[j][3] * rstd * gsv[j][3] + shv[j][3]);
                *(u32x2*)(hbuf + (size_t)r * 1024 + 256 * j + c0) = o;
            }
        }
    }
}

template <int MODE>
PF void norm_phase(const KC& k, int layer, bool first, bool combine, const float* __restrict__ gain, int mb, const float* __restrict__ Wsk, int ldw,
                   const float* __restrict__ aux0, const float* __restrict__ aux1, bool last, LAS float* lds, bool flush = true) {
    const int tid = TID(), lane = tid & 63, wave = tid >> 6;
    float* xs = (float*)(k.ws + WS_XS);
    bf16_t* hbuf = (bf16_t*)(k.ws + AR_HBUF);
    const float* mod = (const float*)(k.ws + WS_MOD);
    const bf16_t* ys = (const bf16_t*)(k.ws + AR_YS);
    const int* tokp = (const int*)(k.ws + WS_TOKP);
    const float* tokw = (const float*)(k.ws + WS_TOKW);
    LAS int* lcnt = (LAS int*)(lds + 32768);
    if (MODE == 1 && tid < 32) lcnt[tid] = 0;
    if (MODE == 1 || MODE == 2) {
        for (int idx = tid; idx < 1024 * 32; idx += NTHR) {
            const int kk = idx >> 5, n = idx & 31;
            lds[kk * 32 + (((n >> 2) ^ ((kk >> 1) & 7)) << 2) + (n & 3)] = Wsk[(size_t)kk * ldw + n];
        }
        __syncthreads();
    }
    const int rbeg = (MODE == 3) ? TC : 0, rstr = gridDim.x * 8;
    int cur_mr = -1; float gsv[16], shv[16], g5v[16];
    float xn[16];
    int r = rbeg + blockIdx.x * 8 + wave;
    if (r < T) {
        const float* src = first ? (r < TC ? k.ctx + (size_t)r * 1024 : k.x + (size_t)(r - TC) * 1024) : xs + (size_t)r * 1024;
#pragma unroll
        for (int m = 0; m < 16; ++m) xn[m] = src[lane + 64 * m];
    }
    for (; r < T; r += rstr) {
        const int mr = modrow(r);
        float x[16];
#pragma unroll
        for (int m = 0; m < 16; ++m) x[m] = xn[m];
        int p0 = 0, p1 = 0; float w0 = 0.f, w1 = 0.f;
        if (combine) { p0 = tokp[2 * r]; p1 = tokp[2 * r + 1]; w0 = tokw[2 * r]; w1 = tokw[2 * r + 1]; }
        {
            const int rn = r + rstr;
            if (rn < T) {
                const float* srcn = first ? (rn < TC ? k.ctx + (size_t)rn * 1024 : k.x + (size_t)(rn - TC) * 1024) : xs + (size_t)rn * 1024;
#pragma unroll
                for (int m = 0; m < 16; ++m) xn[m] = srcn[lane + 64 * m];
            }
        }
        if (mr != cur_mr) {
            cur_mr = mr;
            if (MODE != 3) {
                const float* shift = mod + ((size_t)(layer * 3 + mr) * 6 + mb) * 1024;
#pragma unroll
                for (int m = 0; m < 16; ++m) { const int col = lane + 64 * m; gsv[m] = gain[col] * (1.0f + shift[1024 + col]); shv[m] = shift[col]; }
            } else {
#pragma unroll
                for (int m = 0; m < 16; ++m) gsv[m] = gain[lane + 64 * m];
            }
            if (combine) {
                const float* g5 = mod + ((size_t)((layer - 1) * 3 + mr) * 6 + 5) * 1024;
#pragma unroll
                for (int m = 0; m < 16; ++m) g5v[m] = g5[lane + 64 * m];
            }
        }
        if (combine) {
            bf16_t ya[16], yb[16];
#pragma unroll
            for (int m = 0; m < 16; ++m) { const int col = lane + 64 * m; ya[m] = ys[(size_t)p0 * 1024 + col]; yb[m] = ys[(size_t)p1 * 1024 + col]; }
            asm volatile("" ::: "memory");
#pragma unroll
            for (int m = 0; m < 16; ++m) x[m] += g5v[m] * (w0 * bf2f(ya[m]) + w1 * bf2f(yb[m]));
        }
        if (first || combine) {
#pragma unroll
            for (int m = 0; m < 16; ++m) xs[(size_t)r * 1024 + lane + 64 * m] = x[m];
        }
        float ss = 0.f;
#pragma unroll
        for (int m = 0; m < 16; ++m) ss += x[m] * x[m];
        ss = wsum(ss, lane);
        const float rstd = rsqrtf(ss * (1.0f / 1024.0f) + EPS);
        if (MODE == 3) {
#pragma unroll
            for (int m = 0; m < 16; ++m) { const int col = lane + 64 * m; k.out[(size_t)(r - TC) * 1024 + col] = x[m] * rstd * gsv[m]; }
            continue;
        }
        float y[16];
#pragma unroll
        for (int m = 0; m < 16; ++m) {
            const int col = lane + 64 * m;
            y[m] = x[m] * rstd * gsv[m] + shv[m];
            hbuf[(size_t)r * 1024 + col] = f2bf(y[m]);
        }
        if (MODE == 1 || MODE == 2) {
            float acc[32];
#pragma unroll
            for (int n = 0; n < 32; ++n) acc[n] = 0.f;
#pragma unroll
            for (int m = 0; m < 16; ++m) {
                f32x4 wa[8];
                const int c = lane + 64 * m; const LAS float* wr = lds + c * 32; const int sw = (c >> 1) & 7;
#pragma unroll
                for (int q = 0; q < 8; ++q) wa[q] = *(const LAS f32x4*)(wr + ((q ^ sw) << 2));
                asm volatile("" ::: "memory");
#pragma unroll
                for (int q = 0; q < 8; ++q) { acc[4 * q + 0] += y[m] * wa[q][0]; acc[4 * q + 1] += y[m] * wa[q][1]; acc[4 * q + 2] += y[m] * wa[q][2]; acc[4 * q + 3] += y[m] * wa[q][3]; }
            }
            float val;
            {
                float a16[16], a8[8], a4[4], a2[2];
                const bool b5 = (lane & 32) != 0, b4 = (lane & 16) != 0, b3 = (lane & 8) != 0, b2 = (lane & 4) != 0, b1 = (lane & 2) != 0;
#pragma unroll
                for (int i = 0; i < 16; ++i) { const float send = b5 ? acc[i] : acc[i + 16], keep = b5 ? acc[i + 16] : acc[i]; a16[i] = keep + shx(send, 32, lane); }
#pragma unroll
                for (int i = 0; i < 8; ++i) { const float send = b4 ? a16[i] : a16[i + 8], keep = b4 ? a16[i + 8] : a16[i]; a8[i] = keep + shx(send, 16, lane); }
#pragma unroll
                for (int i = 0; i < 4; ++i) { const float send = b3 ? a8[i] : a8[i + 4], keep = b3 ? a8[i + 4] : a8[i]; a4[i] = keep + shx(send, 8, lane); }
#pragma unroll
                for (int i = 0; i < 2; ++i) { const float send = b2 ? a4[i] : a4[i + 2], keep = b2 ? a4[i + 2] : a4[i]; a2[i] = keep + shx(send, 4, lane); }
                { const float send = b1 ? a2[0] : a2[1], keep = b1 ? a2[1] : a2[0]; val = keep + shx(send, 2, lane); }
                val += shx(val, 1, lane);
            }
            const int n = lane >> 1;
            if (MODE == 1) {
                int* toke = (int*)(k.ws + WS_TOKE); float* tokwW = (float*)(k.ws + WS_TOKW);
                if (last && r < TC) { if (lane == 0) { int neg = -1; asm volatile("" : "+v"(neg)); toke[2 * r] = neg; toke[2 * r + 1] = neg; } continue; }
                const float sc = 1.0f / (1.0f + expf(-val)), ch = sc + aux0[n];
                const int gl = lane & ~7;
                const float ca = shi(ch, gl), cb = shi(ch, gl + 2), cc = shi(ch, gl + 4), cd = shi(ch, gl + 6);
                const float hi1 = fmaxf(ca, cb), lo1 = fminf(ca, cb), hi2 = fmaxf(cc, cd), lo2 = fminf(cc, cd);
                float gs = fmaxf(hi1, hi2) + fmaxf(fminf(hi1, hi2), fmaxf(lo1, lo2));
                int gi = lane >> 3;
#pragma unroll
                for (int m = 8; m <= 32; m <<= 1) {
                    const float og = shx(gs, m, lane); const int oi = shii(gi, lane ^ m);
                    if (og > gs || (og == gs && oi < gi)) { gs = og; gi = oi; }
                }
                float c4[4], s4[4];
#pragma unroll
                for (int i = 0; i < 4; ++i) { c4[i] = shi(ch, gi * 8 + 2 * i); s4[i] = shi(sc, gi * 8 + 2 * i); }
                int i1 = 0; float b1v = c4[0];
#pragma unroll
                for (int i = 1; i < 4; ++i) if (c4[i] > b1v) { b1v = c4[i]; i1 = i; }
                int i2 = -1; float b2v = -1e30f;
#pragma unroll
                for (int i = 0; i < 4; ++i) if (i != i1 && c4[i] > b2v) { b2v = c4[i]; i2 = i; }
                float w1v = 0.f, w2v = 0.f;
#pragma unroll
                for (int i = 0; i < 4; ++i) { if (i == i1) w1v = s4[i]; if (i == i2) w2v = s4[i]; }
                const float inv = 1.0f / (w1v + w2v);
                if (lane == 0) {
                    const int e1 = gi * 4 + i1, e2 = gi * 4 + i2;
                    toke[2 * r] = e1; toke[2 * r + 1] = e2; tokwW[2 * r] = w1v * inv; tokwW[2 * r + 1] = w2v * inv;
                    __hip_atomic_fetch_add(lcnt + e1, 1, __ATOMIC_RELAXED, __HIP_MEMORY_SCOPE_WORKGROUP);
                    __hip_atomic_fetch_add(lcnt + e2, 1, __ATOMIC_RELAXED, __HIP_MEMORY_SCOPE_WORKGROUP);
                }
            } else {
                float* gb = (float*)(k.ws + WS_GB);
                if ((lane & 1) == 0) {
                    if (n < 16) {
                        const float z = val + aux1[n];
                        const float ez = __expf(z); const float sp = z > 15.f ? z : (ez < 1e-4f ? ez - 0.5f * ez * ez : __logf(1.0f + ez));
                        gb[(size_t)r * 32 + n] = -expf(aux0[n]) * sp;
                    } else {
                        gb[(size_t)r * 32 + n] = 1.0f / (1.0f + expf(-val));
                    }
                }
            }
        }
    }
    if (MODE == 1) {
        __syncthreads();
        int* cnt = (int*)(k.ws + WS_CTL + CTL_CNT) + layer * 32;
        if (flush && tid < 32 && lcnt[tid] > 0) atomicAdd(&cnt[tid], lcnt[tid]);
    }
}

constexpr int NM_WLD = 1032;
template <int MODE>
PF void norm_mfma(const KC& k, int layer, bool first, bool combine, const float* __restrict__ gain, int mb, const float* __restrict__ Wsk, int ldw,
                  const float* __restrict__ aux0, const float* __restrict__ aux1, bool last, LAS unsigned char* lds, bool flush = true) {
    const int tid = TID(), lane = tid & 63, wave = __builtin_amdgcn_readfirstlane(tid >> 6), row = lane & 15, q = lane >> 4;
    LAS bf16_t* WtH = (LAS bf16_t*)lds; LAS bf16_t* WtL = WtH + 32 * NM_WLD;
    LAS float* red = (LAS float*)(WtL + 32 * NM_WLD);
    LAS float* lg = red + 128;
    LAS int* lcnt = (LAS int*)(lg + 8 * 16 * 32);
    float* xs = (float*)(k.ws + WS_XS);
    bf16_t* hbuf = (bf16_t*)(k.ws + AR_HBUF);
    const float* mod = (const float*)(k.ws + WS_MOD);
    const bf16_t* ys = (const bf16_t*)(k.ws + AR_YS);
    const int* tokp = (const int*)(k.ws + WS_TOKP); const float* tokw = (const float*)(k.ws + WS_TOKW);
    if (MODE == 1 && tid < 32) lcnt[tid] = 0;
    for (int idx = tid; idx < 1024 * 32; idx += NTHR) {
        const int kk = idx >> 5, n = idx & 31;
        const float w = Wsk[(size_t)kk * ldw + n]; const bf16_t hi = f2bf(w);
        WtH[n * NM_WLD + kk] = hi; WtL[n * NM_WLD + kk] = f2bf(w - bf2f(hi));
    }
    __syncthreads();
    const int cbase = 128 * wave + 8 * q;
    f32x4 xn[8];
    int bt = blockIdx.x;
    if (bt < T / 16) {
        const float* sb = first ? (16 * bt < TC ? k.ctx : k.x - (size_t)TC * 1024) : xs;
        const unsigned off = (unsigned)(16 * bt + row) * 1024u + (unsigned)cbase;
#pragma unroll
        for (int kk = 0; kk < 4; ++kk) { xn[2 * kk] = *(const f32x4*)(sb + off + 32 * kk); xn[2 * kk + 1] = *(const f32x4*)(sb + off + 32 * kk + 4); }
    }
    for (; bt < T / 16; bt += gridDim.x) {
        const int r = 16 * bt + row, mr = modrow(16 * bt);
        const unsigned roff = (unsigned)r * 1024u + (unsigned)cbase;
        float x[32];
#pragma unroll
        for (int i = 0; i < 8; ++i) { x[4 * i] = xn[i][0]; x[4 * i + 1] = xn[i][1]; x[4 * i + 2] = xn[i][2]; x[4 * i + 3] = xn[i][3]; }
        int p0 = 0, p1 = 0; float w0 = 0.f, w1 = 0.f;
        if (combine) { p0 = tokp[2 * r]; p1 = tokp[2 * r + 1]; w0 = tokw[2 * r]; w1 = tokw[2 * r + 1]; }
        {
            const int bn = bt + gridDim.x;
            if (bn < T / 16) {
                const float* sb = first ? (16 * bn < TC ? k.ctx : k.x - (size_t)TC * 1024) : xs;
                const unsigned off = (unsigned)(16 * bn + row) * 1024u + (unsigned)cbase;
#pragma unroll
                for (int kk = 0; kk < 4; ++kk) { xn[2 * kk] = *(const f32x4*)(sb + off + 32 * kk); xn[2 * kk + 1] = *(const f32x4*)(sb + off + 32 * kk + 4); }
            }
        }
        const float* shift = mod + ((size_t)(layer * 3 + mr) * 6 + mb) * 1024;
        if (combine) {
            const float* g5 = mod + ((size_t)((layer - 1) * 3 + mr) * 6 + 5) * 1024;
            u32x4 ya[4], yb[4]; float g5v[32];
#pragma unroll
            for (int kk = 0; kk < 4; ++kk) { ya[kk] = *(const u32x4*)(ys + (size_t)p0 * 1024 + cbase + 32 * kk); yb[kk] = *(const u32x4*)(ys + (size_t)p1 * 1024 + cbase + 32 * kk);
                const f32x4 ga = *(const f32x4*)(g5 + cbase + 32 * kk), gb2 = *(const f32x4*)(g5 + cbase + 32 * kk + 4);
#pragma unroll
                for (int e = 0; e < 4; ++e) { g5v[8 * kk + e] = ga[e]; g5v[8 * kk + 4 + e] = gb2[e]; } }
            asm volatile("" ::: "memory");
#pragma unroll
            for (int kk = 0; kk < 4; ++kk)
#pragma unroll
                for (int w = 0; w < 4; ++w) {
                    x[8 * kk + 2 * w] += g5v[8 * kk + 2 * w] * (w0 * __uint_as_float(ya[kk][w] << 16) + w1 * __uint_as_float(yb[kk][w] << 16));
                    x[8 * kk + 2 * w + 1] += g5v[8 * kk + 2 * w + 1] * (w0 * __uint_as_float(ya[kk][w] & 0xffff0000u) + w1 * __uint_as_float(yb[kk][w] & 0xffff0000u));
                }
        }
        if (first || combine) {
#pragma unroll
            for (int kk = 0; kk < 4; ++kk) {
                *(f32x4*)(xs + roff + 32 * kk) = (f32x4){x[8 * kk], x[8 * kk + 1], x[8 * kk + 2], x[8 * kk + 3]};
                *(f32x4*)(xs + roff + 32 * kk + 4) = (f32x4){x[8 * kk + 4], x[8 * kk + 5], x[8 * kk + 6], x[8 * kk + 7]};
            }
        }
        float ss = 0.f;
#pragma unroll
        for (int i = 0; i < 32; ++i) ss += x[i] * x[i];
        ss += shx(ss, 16, lane); ss += shx(ss, 32, lane);
        if (q == 0) red[wave * 16 + row] = ss;
        __syncthreads();
        float tot = 0.f;
#pragma unroll
        for (int w = 0; w < 8; ++w) tot += red[w * 16 + row];
        const float rstd = rsqrtf(tot * (1.0f / 1024.0f) + EPS);
        f32x4 acc[2]; acc[0] = (f32x4){0.f, 0.f, 0.f, 0.f}; acc[1] = (f32x4){0.f, 0.f, 0.f, 0.f};
#pragma unroll
        for (int kk = 0; kk < 4; ++kk) {
            float y[8]; u32x4 ah, al;
            {
                const unsigned co = (unsigned)cbase + 32u * kk;
                const f32x4 g0 = *(const f32x4*)(gain + co), g1 = *(const f32x4*)(gain + co + 4), s0 = *(const f32x4*)(shift + 1024 + co), s1 = *(const f32x4*)(shift + 1024 + co + 4),
                            h0 = *(const f32x4*)(shift + co), h1 = *(const f32x4*)(shift + co + 4);
#pragma unroll
                for (int e = 0; e < 4; ++e) { y[e] = x[8 * kk + e] * rstd * g0[e] * (1.0f + s0[e]) + h0[e]; y[4 + e] = x[8 * kk + 4 + e] * rstd * g1[e] * (1.0f + s1[e]) + h1[e]; }
            }
#pragma unroll
            for (int w = 0; w < 4; ++w) {
                ah[w] = pk2(y[2 * w], y[2 * w + 1]);
                al[w] = pk2(y[2 * w] - __uint_as_float(ah[w] << 16), y[2 * w + 1] - __uint_as_float(ah[w] & 0xffff0000u));
            }
            *(u32x4*)(hbuf + roff + 32 * kk) = ah;
            const bf16x8 fah = __builtin_bit_cast(bf16x8, ah), fal = __builtin_bit_cast(bf16x8, al);
            bf16x8 bh[2], bl[2];
#pragma unroll
            for (int nt = 0; nt < 2; ++nt) {
                bh[nt] = *(const LAS bf16x8*)(WtH + (16 * nt + row) * NM_WLD + cbase + 32 * kk);
                bl[nt] = *(const LAS bf16x8*)(WtL + (16 * nt + row) * NM_WLD + cbase + 32 * kk);
            }
            asm volatile("" ::: "memory");
#pragma unroll
            for (int nt = 0; nt < 2; ++nt) {
                acc[nt] = __builtin_amdgcn_mfma_f32_16x16x32_bf16(fah, bh[nt], acc[nt], 0, 0, 0);
                acc[nt] = __builtin_amdgcn_mfma_f32_16x16x32_bf16(fal, bh[nt], acc[nt], 0, 0, 0);
                acc[nt] = __builtin_amdgcn_mfma_f32_16x16x32_bf16(fah, bl[nt], acc[nt], 0, 0, 0);
            }
        }
#pragma unroll
        for (int nt = 0; nt < 2; ++nt)
#pragma unroll
            for (int j = 0; j < 4; ++j) lg[(wave * 16 + 4 * q + j) * 32 + 16 * nt + row] = acc[nt][j];
        __syncthreads();
        {
            const int prow = tid >> 5, n = tid & 31, rr = 16 * bt + prow, hb = lane & 32;
            float val = 0.f;
#pragma unroll
            for (int w = 0; w < 8; ++w) val += lg[(w * 16 + prow) * 32 + n];
            if (MODE == 1) {
                int* toke = (int*)(k.ws + WS_TOKE); float* tokwW = (float*)(k.ws + WS_TOKW);
                const bool unrouted = last && rr < TC;
                const float sc = 1.0f / (1.0f + expf(-val)), ch = sc + aux0[n];
                const int gl = hb + (n & ~3);
                const float ca = shi(ch, gl), cb = shi(ch, gl + 1), cc = shi(ch, gl + 2), cd = shi(ch, gl + 3);
                const float hi1 = fmaxf(ca, cb), lo1 = fminf(ca, cb), hi2 = fmaxf(cc, cd), lo2 = fminf(cc, cd);
                float gs = fmaxf(hi1, hi2) + fmaxf(fminf(hi1, hi2), fmaxf(lo1, lo2));
                int gi = n >> 2;
#pragma unroll
                for (int m = 4; m <= 16; m <<= 1) {
                    const float og = shx(gs, m, lane); const int oi = shii(gi, lane ^ m);
                    if (og > gs || (og == gs && oi < gi)) { gs = og; gi = oi; }
                }
                float c4[4], s4[4];
#pragma unroll
                for (int i = 0; i < 4; ++i) { c4[i] = shi(ch, hb + gi * 4 + i); s4[i] = shi(sc, hb + gi * 4 + i); }
                int i1 = 0; float b1v = c4[0];
#pragma unroll
                for (int i = 1; i < 4; ++i) if (c4[i] > b1v) { b1v = c4[i]; i1 = i; }
                int i2 = -1; float b2v = -1e30f;
#pragma unroll
                for (int i = 0; i < 4; ++i) if (i != i1 && c4[i] > b2v) { b2v = c4[i]; i2 = i; }
                float w1v = 0.f, w2v = 0.f;
#pragma unroll
                for (int i = 0; i < 4; ++i) { if (i == i1) w1v = s4[i]; if (i == i2) w2v = s4[i]; }
                const float inv = 1.0f / (w1v + w2v);
                if (n == 0) {
                    if (unrouted) { int neg = -1; asm volatile("" : "+v"(neg)); toke[2 * rr] = neg; toke[2 * rr + 1] = neg; }
                    else {
                        const int e1 = gi * 4 + i1, e2 = gi * 4 + i2;
                        toke[2 * rr] = e1; toke[2 * rr + 1] = e2; tokwW[2 * rr] = w1v * inv; tokwW[2 * rr + 1] = w2v * inv;
                        __hip_atomic_fetch_add(lcnt + e1, 1, __ATOMIC_RELAXED, __HIP_MEMORY_SCOPE_WORKGROUP);
                        __hip_atomic_fetch_add(lcnt + e2, 1, __ATOMIC_RELAXED, __HIP_MEMORY_SCOPE_WORKGROUP);
                    }
                }
            } else {
                float* gb = (float*)(k.ws + WS_GB);
                if (n < 16) {
                    const float z = val + aux1[n];
                    const float ez = __expf(z); const float sp = z > 15.f ? z : (ez < 1e-4f ? ez - 0.5f * ez * ez : __logf(1.0f + ez));
                    gb[(size_t)rr * 32 + n] = -expf(aux0[n]) * sp;
                } else {
                    gb[(size_t)rr * 32 + n] = 1.0f / (1.0f + expf(-val));
                }
            }
        }
        __syncthreads();
    }
    if (MODE == 1) {
        __syncthreads();
        int* cnt = (int*)(k.ws + WS_CTL + CTL_CNT) + layer * 32;
        if (flush && tid < 32 && lcnt[tid] > 0) atomicAdd(&cnt[tid], lcnt[tid]);
    }
}

namespace pg8 {
constexpr int BM = 256, BK = 64, HALF = 128, HTB = HALF * BK * 2, STAGE_BYTES = 8 * HTB;
DI int lds_byte(int r, int c) { const int st = (r >> 4) * 2 + (c >> 5), rr = r & 15, cc = c & 31, ob = rr * 64 + cc * 2; return st * 1024 + (ob ^ (((ob >> 9) & 1) << 5)); }
DI void stage_rc(int b, int& R, int& C) { const int st = b / 1024, sb = b % 1024, swz = sb ^ (((sb >> 9) & 1) << 5); R = (st >> 1) * 16 + swz / 64; C = (st & 1) * 32 + (swz % 64) / 2; }
DI int perm32(int rho) { const int n = rho >> 4, i = rho & 15; return 8 * (i >> 2) + 4 * n + (i & 3); }
struct Unit { int m0, mrows, pn; size_t boff; };
template <bool GATHER, class Epi, class Sched>
DI void gemm_phase(LAS unsigned char* lds, const bf16_t* A, const int* rowidx, const bf16_t* Bt, int K, const Sched& S, const Epi& E) {
    const int tid = TID(), wid = __builtin_amdgcn_readfirstlane(tid >> 6), lane = tid & 63, wr = wid >> 2, wc = wid & 3, fr = lane & 15, fq = lane >> 4;
    const int nt = K / BK;
    unsigned voffA[2], voffB[2];
#pragma unroll
    for (int i = 0; i < 2; ++i) { int R, C; stage_rc(tid * 16 + i * 8192, R, C); const int Rb = Epi::PERM ? ((R & ~31) + perm32(R & 31)) : R;
        voffA[i] = (unsigned)(R * K + C) * 2u; voffB[i] = (unsigned)(Rb * K + C) * 2u; }
    const size_t kstep = (size_t)(BK * 2);
    const size_t hstep = (size_t)HALF * K * 2;
    const size_t tstep = 2 * hstep;
    const size_t rstep = (size_t)K * 2;
    const unsigned ldsw = (unsigned)wid * 1024u;
    const int aoff = lds_byte(wr * 64 + fr, fq * 8), boff = lds_byte(wc * 32 + fr, fq * 8);
#define PG8_SA(b, h) (((b) * 2 + (h)) * HTB)
#define PG8_SB(b, h) ((4 + (b) * 2 + (h)) * HTB)
#define PG8_STAGE(bufoff, gbase, voff) do { _Pragma("unroll") for (int _i = 0; _i < 2; ++_i) \
        __builtin_amdgcn_global_load_lds((const unsigned*)((const char*)(gbase) + (voff)[_i]), (LAS unsigned*)(lds + (bufoff) + ldsw + _i * 8192), 16, 0, 0); } while (0)
#define PG8_STAGE_A(bufoff, p, h, vG) do { if (GATHER) PG8_STAGE(bufoff, p, (vG)[h]); else PG8_STAGE(bufoff, (p) + (h) * hstep, voffA); } while (0)
#define PG8_LDA(dst, b, h) do { _Pragma("unroll") for (int m = 0; m < 4; ++m) _Pragma("unroll") for (int k = 0; k < 2; ++k) dst[m][k] = *(const LAS bf16x8*)(lds + PG8_SA(b, h) + aoff + m * 2048 + k * 1024); } while (0)
#define PG8_LDB(dst, b, h) do { _Pragma("unroll") for (int n = 0; n < 2; ++n) _Pragma("unroll") for (int k = 0; k < 2; ++k) dst[n][k] = *(const LAS bf16x8*)(lds + PG8_SB(b, h) + boff + n * 2048 + k * 1024); } while (0)
#define PG8_MMA(ai, bj, At, Bt_) do { __builtin_amdgcn_s_setprio(1); _Pragma("unroll") for (int m = 0; m < 4; ++m) _Pragma("unroll") for (int n = 0; n < 2; ++n) _Pragma("unroll") for (int k = 0; k < 2; ++k) \
        acc[ai][bj][m][n] = __builtin_amdgcn_mfma_f32_16x16x32_bf16(Bt_[n][k], At[m][k], acc[ai][bj][m][n], 0, 0, 0); __builtin_amdgcn_s_setprio(0); } while (0)
#define PG8_WAIT_V(n) asm volatile("s_waitcnt vmcnt(" #n ")" ::: "memory")
#define PG8_WAIT_L(n) asm volatile("s_waitcnt lgkmcnt(" #n ")" ::: "memory")
#define PG8_BAR __builtin_amdgcn_s_barrier()
#define PG8_SCHED __builtin_amdgcn_sched_barrier(0)
#define PG8_AOFF(dst, u) do { _Pragma("unroll") for (int _h = 0; _h < 2; ++_h) _Pragma("unroll") for (int _i = 0; _i < 2; ++_i) { int _R, _C; stage_rc(tid * 16 + _i * 8192, _R, _C); \
        dst[_h][_i] = (unsigned)(rowidx[(u).m0 + _h * HALF + _R] * K + _C) * 2u; } } while (0)
    Unit cur, nxt; int ui = 0;
    if (!S.next(0, cur)) return;
    f32x4 acc[2][2][4][2];
#pragma unroll
    for (int a = 0; a < 2; ++a)
#pragma unroll
        for (int b = 0; b < 2; ++b)
#pragma unroll
            for (int m = 0; m < 4; ++m)
#pragma unroll
                for (int n = 0; n < 2; ++n) acc[a][b][m][n] = (f32x4){0.f, 0.f, 0.f, 0.f};
    bf16x8 At[4][2], B0[2][2], B1[2][2];
    unsigned vA[2][2], vN[2][2];
    if (GATHER) PG8_AOFF(vA, cur);
    const char* cA = (const char*)A + (GATHER ? (size_t)0 : (size_t)cur.m0 * rstep);
    const char* cB = (const char*)Bt + cur.boff + (size_t)cur.pn * tstep;
    PG8_STAGE(PG8_SB(0, 0), cB, voffB); PG8_STAGE_A(PG8_SA(0, 0), cA, 0, vA); PG8_STAGE(PG8_SB(0, 1), cB + hstep, voffB); PG8_STAGE_A(PG8_SA(0, 1), cA, 1, vA);
    if (wr == 1) PG8_BAR;
    PG8_WAIT_V(4); PG8_BAR;
    PG8_STAGE(PG8_SB(1, 0), cB + kstep, voffB); PG8_STAGE_A(PG8_SA(1, 0), cA + kstep, 0, vA); PG8_STAGE(PG8_SB(1, 1), cB + hstep + kstep, voffB);
    PG8_WAIT_V(6); PG8_BAR;
    for (;;) {
        const bool has_next = S.next(ui + 1, nxt);
        const char* nA = GATHER ? cA : (has_next ? (const char*)A + (size_t)nxt.m0 * rstep : cA);
        const char* nB = has_next ? (const char*)Bt + nxt.boff + (size_t)nxt.pn * tstep : cB;
        if (GATHER) {
            if (has_next) { PG8_AOFF(vN, nxt); }
            else {
#pragma unroll
                for (int h = 0; h < 2; ++h)
#pragma unroll
                    for (int i = 0; i < 2; ++i) vN[h][i] = vA[h][i];
            }
        }
        for (int t = 0; t < nt; t += 2) {
            const bool last = (t == nt - 2);
            const char* a1 = cA + (size_t)(t + 1) * kstep;
            const char* a2 = last ? nA : cA + (size_t)(t + 2) * kstep; const char* b2 = last ? nB : cB + (size_t)(t + 2) * kstep;
            const char* a3 = a2 + kstep; const char* b3 = b2 + kstep;
            PG8_LDB(B0, 0, 0); PG8_SCHED; PG8_LDA(At, 0, 0); PG8_STAGE_A(PG8_SA(1, 1), a1, 1, vA);
            if (GATHER && last) {
#pragma unroll
                for (int h = 0; h < 2; ++h)
#pragma unroll
                    for (int i = 0; i < 2; ++i) vA[h][i] = vN[h][i];
            }
            PG8_WAIT_L(8); PG8_BAR; PG8_WAIT_L(0); PG8_MMA(0, 0, At, B0); PG8_BAR; PG8_SCHED;
            PG8_LDB(B1, 0, 1); PG8_STAGE(PG8_SB(0, 0), b2, voffB);
            PG8_BAR; PG8_WAIT_L(0); PG8_MMA(0, 1, At, B1); PG8_BAR;
            PG8_LDA(At, 0, 1); PG8_STAGE_A(PG8_SA(0, 0), a2, 0, vA);
            PG8_BAR; PG8_WAIT_L(0); PG8_MMA(1, 0, At, B0); PG8_BAR; PG8_SCHED;
            PG8_STAGE(PG8_SB(0, 1), b2 + hstep, voffB);
            PG8_WAIT_V(6); PG8_BAR; PG8_MMA(1, 1, At, B1); PG8_BAR;
            PG8_LDB(B0, 1, 0); PG8_SCHED; PG8_LDA(At, 1, 0); PG8_STAGE_A(PG8_SA(0, 1), a2, 1, vA);
            PG8_WAIT_L(8); PG8_BAR; PG8_WAIT_L(0); PG8_MMA(0, 0, At, B0); PG8_BAR; PG8_SCHED;
            PG8_LDB(B1, 1, 1); PG8_STAGE(PG8_SB(1, 0), b3, voffB);
            PG8_BAR; PG8_WAIT_L(0); PG8_MMA(0, 1, At, B1); PG8_BAR;
            PG8_LDA(At, 1, 1); PG8_STAGE_A(PG8_SA(1, 0), a3, 0, vA);
            PG8_BAR; PG8_WAIT_L(0); PG8_MMA(1, 0, At, B0); PG8_BAR; PG8_SCHED;
            PG8_STAGE(PG8_SB(1, 1), b3 + hstep, voffB);
            PG8_WAIT_V(6); PG8_BAR; PG8_MMA(1, 1, At, B1); PG8_BAR;
        }
        { const int t2 = TID(), l2 = t2 & 63; E(acc, cur, wr, wc, l2 & 15, l2 >> 4); }
        if (!has_next) break;
#pragma unroll
        for (int a = 0; a < 2; ++a)
#pragma unroll
            for (int b = 0; b < 2; ++b)
#pragma unroll
                for (int m = 0; m < 4; ++m)
#pragma unroll
                    for (int n = 0; n < 2; ++n) acc[a][b][m][n] = (f32x4){0.f, 0.f, 0.f, 0.f};
        cur = nxt; cA = nA; cB = nB; ++ui;
    }
    PG8_WAIT_V(0);
    if (wr == 0) PG8_BAR;
    PG8_BAR;
#undef PG8_SA
#undef PG8_SB
#undef PG8_STAGE
#undef PG8_STAGE_A
#undef PG8_LDA
#undef PG8_LDB
#undef PG8_MMA
#undef PG8_WAIT_V
#undef PG8_WAIT_L
#undef PG8_BAR
#undef PG8_SCHED
#undef PG8_AOFF
}
struct DenseOrder {
    int nM, nN, nwg, G, c;
    DI void init(int M, int N, int G_, int c_) { nM = M / BM; nN = N / BM; nwg = nM * nN; G = G_; c = c_; }
    DI bool next(int i, Unit& u) const {
        const long L = (long)i * G + c; if (L >= nwg) return false;
        int wgid = (int)L; { const int q = nwg / 8, r = nwg % 8, xcd = wgid % 8, off = wgid / 8; wgid = (xcd < r ? xcd * (q + 1) : r * (q + 1) + (xcd - r) * q) + off; }
        const int nig = 8 * nN, gid = wgid / nig, fm = gid * 8, gsz = (nM - fm) < 8 ? (nM - fm) : 8;
        u.m0 = (fm + ((wgid % nig) % gsz)) * BM; u.mrows = BM; u.pn = (wgid % nig) / gsz; u.boff = 0; return true;
    }
};
struct MoeOrder {
    const LAS int* tb; int G, c; size_t estride; int lane;
    DI bool next(int i, Unit& u) const {
        const int L = i * G + c; if (L >= __builtin_amdgcn_readfirstlane(tb[97]) * 4) return false;
        const int tile = L >> 2;
        const int pre = tb[65 + (lane & 31)];
        const unsigned long long m = __ballot(lane < 32 && pre <= tile);
        const int e = __popcll(m) - 1;
        const int lt = tile - __builtin_amdgcn_readfirstlane(tb[65 + e]); int mr = __builtin_amdgcn_readfirstlane(tb[e]) - lt * 256; mr = mr > 256 ? 256 : mr;
        u.m0 = __builtin_amdgcn_readfirstlane(tb[32 + e]) + lt * 256; u.mrows = mr; u.pn = L & 3; u.boff = (size_t)e * estride; return true;
    }
};
}
struct EpiBf16 {
    static constexpr bool PERM = true;
    bf16_t* C; int ldc; int split_col; bf16_t* C2; int ldc2;
    DI void operator()(const f32x4 (&acc)[2][2][4][2], const pg8::Unit& u, int wr, int wc, int fr, int fq) const {
        int colt = u.pn * 256; bf16_t* base = C; int ld = ldc;
        if (colt >= split_col) { base = C2; ld = ldc2; colt -= split_col; }
#pragma unroll
        for (int ai = 0; ai < 2; ++ai)
#pragma unroll
            for (int m = 0; m < 4; ++m) {
                const int rl = ai * 128 + wr * 64 + m * 16 + fr;
                if (rl < u.mrows) {
                    bf16_t* rowp = base + (size_t)(u.m0 + rl) * ld + colt + wc * 32 + 8 * fq;
#pragma unroll
                    for (int bj = 0; bj < 2; ++bj) {
                        const f32x4 v0 = acc[ai][bj][m][0], v1 = acc[ai][bj][m][1];
                        u32x4 o; o[0] = cvt_pk_bf16(v0[0], v0[1]); o[1] = cvt_pk_bf16(v0[2], v0[3]); o[2] = cvt_pk_bf16(v1[0], v1[1]); o[3] = cvt_pk_bf16(v1[2], v1[3]);
                        *(u32x4*)(rowp + bj * 128) = o;
                    }
                }
            }
    }
};
struct EpiBf16T {
    static constexpr bool PERM = false;
    bf16_t* C; int ldc;
    DI void operator()(const f32x4 (&acc)[2][2][4][2], const pg8::Unit& u, int wr, int wc, int fr, int fq) const {
#pragma unroll
        for (int ai = 0; ai < 2; ++ai)
#pragma unroll
            for (int bj = 0; bj < 2; ++bj)
#pragma unroll
                for (int m = 0; m < 4; ++m)
#pragma unroll
                    for (int n = 0; n < 2; ++n) {
                        const int row = u.m0 + ai * 128 + wr * 64 + m * 16 + fr, col = u.pn * 256 + bj * 128 + wc * 32 + n * 16 + 4 * fq;
#pragma unroll
                        for (int e = 0; e < 4; ++e) C[(size_t)(col + e) * ldc + row] = f2bf(acc[ai][bj][m][n][e]);
                    }
    }
};
struct EpiTaps {
    static constexpr bool PERM = false;
    bf16_t* FT;
    DI void operator()(const f32x4 (&acc)[2][2][4][2], const pg8::Unit& u, int wr, int wc, int fr, int fq) const {
#pragma unroll
        for (int ai = 0; ai < 2; ++ai)
#pragma unroll
            for (int m = 0; m < 4; ++m) {
                const int row = u.m0 + ai * 128 + wr * 64 + m * 16 + fr; const float dl = hy_delta(row & 1023) * (1.0f / 16383.0f);
#pragma unroll
                for (int bj = 0; bj < 2; ++bj)
#pragma unroll
                    for (int n = 0; n < 2; ++n) {
                        const int l = u.pn * 256 + bj * 128 + wc * 32 + n * 16 + 4 * fq; float o[4];
#pragma unroll
                        for (int e = 0; e < 4; ++e) o[e] = acc[ai][bj][m][n][e] * __expf(-(float)(l + e) * dl);
                        u32x2 pk; pk[0] = pk2(o[0], o[1]); pk[1] = pk2(o[2], o[3]);
                        *(u32x2*)(FT + (size_t)row * 16384 + l) = pk;
                    }
            }
    }
};
struct EpiResid {
    static constexpr bool PERM = false;
    float* xs; const float* mod; int layer; int chunk;
    DI void operator()(const f32x4 (&acc)[2][2][4][2], const pg8::Unit& u, int wr, int wc, int fr, int fq) const {
        const float* g = mod + ((size_t)(layer * 3 + modrow(u.m0)) * 6 + chunk) * 1024;
#pragma unroll
        for (int bj = 0; bj < 2; ++bj)
#pragma unroll
            for (int n = 0; n < 2; ++n) {
                const int col = u.pn * 256 + bj * 128 + wc * 32 + n * 16 + 4 * fq; const f32x4 gv = *(const f32x4*)(g + col);
                float* p0 = xs + (size_t)(u.m0 + wr * 64 + fr) * 1024 + col;
                f32x4 old[8];
#pragma unroll
                for (int ai = 0; ai < 2; ++ai)
#pragma unroll
                    for (int m = 0; m < 4; ++m) old[ai * 4 + m] = *(const f32x4*)(p0 + (size_t)(ai * 128 + m * 16) * 1024);
                asm volatile("" ::: "memory");
#pragma unroll
                for (int ai = 0; ai < 2; ++ai)
#pragma unroll
                    for (int m = 0; m < 4; ++m) *(f32x4*)(p0 + (size_t)(ai * 128 + m * 16) * 1024) = old[ai * 4 + m] + gv * acc[ai][bj][m][n];
            }
    }
};
struct EpiGateUp {
    static constexpr bool PERM = false;
    bf16_t* hid;
    DI void operator()(const f32x4 (&acc)[2][2][4][2], const pg8::Unit& u, int wr, int wc, int fr, int fq) const {
#pragma unroll
        for (int ai = 0; ai < 2; ++ai)
#pragma unroll
            for (int m = 0; m < 4; ++m) {
                const int rl = ai * 128 + wr * 64 + m * 16 + fr;
                if (rl < u.mrows) {
#pragma unroll
                    for (int bj = 0; bj < 2; ++bj) {
                        const int hc = ((u.pn * 256 + bj * 128 + wc * 32) >> 1) + 4 * fq;
                        const f32x4 g = acc[ai][bj][m][0], up = acc[ai][bj][m][1];
                        u32x2 o; o[0] = cvt_pk_bf16(siluf(g[0]) * up[0], siluf(g[1]) * up[1]); o[1] = cvt_pk_bf16(siluf(g[2]) * up[2], siluf(g[3]) * up[3]);
                        *(u32x2*)(hid + (size_t)(u.m0 + rl) * 512 + hc) = o;
                    }
                }
            }
    }
};
template <class Epi>
PF void gemm_dense(LAS unsigned char* lds, const bf16_t* A, int M, const bf16_t* Bt, int N, int K, const Epi& epi) {
    pg8::DenseOrder S; S.init(M, N, (int)gridDim.x, (int)blockIdx.x);
    pg8::gemm_phase<false>(lds, A, (const int*)nullptr, Bt, K, S, epi);
}
DI void moe_table(const KC& k, int layer, LAS int* tb) {
    const int* cnt = (const int*)(k.ws + WS_CTL + CTL_CNT) + layer * 32;
    __syncthreads();
    const int tq = TID();
    if (tq < 32) tb[tq] = __hip_atomic_load(cnt + tq, __ATOMIC_RELAXED, __HIP_MEMORY_SCOPE_AGENT);
    __syncthreads();
    if (tq == 0) {
        int s = 0, tp = 0;
        for (int e = 0; e < 32; ++e) { tb[32 + e] = s; tb[65 + e] = tp; s += tb[e]; tp += (tb[e] + 255) >> 8; }
        tb[64] = s; tb[97] = tp;
    }
    __syncthreads();
}
template <int WHICH>
PF void moe_gemm(const KC& k, int layer, LAS unsigned char* lds, LAS int* tb) {
    moe_table(k, layer, tb);
    if (WHICH == 0) {
        pg8::MoeOrder S{tb, (int)gridDim.x, (int)blockIdx.x, (size_t)1024 * 1024 * 2, TID() & 63};
        EpiGateUp epi{(bf16_t*)(k.ws + AR_HID)};
        pg8::gemm_phase<true>(lds, (const bf16_t*)(k.ws + AR_HBUF), (const int*)(k.ws + WS_SLOT), (const bf16_t*)(k.ws + AR_WGU), 1024, S, epi);
    } else {
        pg8::MoeOrder S{tb, (int)gridDim.x, (int)blockIdx.x, (size_t)1024 * 512 * 2, TID() & 63};
        EpiBf16 epi{(bf16_t*)(k.ws + AR_YS), 1024, 1 << 30, nullptr, 0};
        pg8::gemm_phase<false>(lds, (const bf16_t*)(k.ws + AR_HID), (const int*)nullptr, (const bf16_t*)(k.ws + AR_WD), 512, S, epi);
    }
}
PF void moe_scatter(const KC& k, int layer, LAS int* tb) {
    moe_table(k, layer, tb);
    const int* toke = (const int*)(k.ws + WS_TOKE);
    int* tokp = (int*)(k.ws + WS_TOKP); int* slot = (int*)(k.ws + WS_SLOT);
    int* cur = (int*)(k.ws + WS_CTL + CTL_CNT) + 128 + layer * 32;
    LAS int* lc = tb + 128; LAS int* lb = tb + 160;
    const int tid = TID();
    if (blockIdx.x == 0 && tid < 256) slot[NA + tid] = 0;
    for (int r0 = blockIdx.x * NTHR; r0 < T; r0 += gridDim.x * NTHR) {
        const int r = r0 + tid;
        __syncthreads();
        if (tid < 32) lc[tid] = 0;
        __syncthreads();
        const int e0 = toke[2 * r], e1 = toke[2 * r + 1];
        int k0 = 0, k1 = 0;
        if (e0 >= 0) { k0 = __hip_atomic_fetch_add(lc + e0, 1, __ATOMIC_RELAXED, __HIP_MEMORY_SCOPE_WORKGROUP); k1 = __hip_atomic_fetch_add(lc + e1, 1, __ATOMIC_RELAXED, __HIP_MEMORY_SCOPE_WORKGROUP); }
        __syncthreads();
        if (tid < 32) lb[tid] = lc[tid] > 0 ? atomicAdd(&cur[tid], lc[tid]) : 0;
        __syncthreads();
        if (e0 >= 0) {
            const int p0 = tb[32 + e0] + lb[e0] + k0, p1 = tb[32 + e1] + lb[e1] + k1;
            slot[p0] = r; slot[p1] = r; tokp[2 * r] = p0; tokp[2 * r + 1] = p1;
        }
    }
}

DI void unpack8(const u32x4 v, float (&f)[8]) {
#pragma unroll
    for (int w = 0; w < 4; ++w) { f[2 * w] = __uint_as_float(v[w] << 16); f[2 * w + 1] = __uint_as_float(v[w] & 0xffff0000u); }
}
PF void sc_mix(const KC& k, int j) {
    const int tid = TID(), lane = tid & 63, wave = tid >> 6;
    const bf16_t* P = (const bf16_t*)(k.ws + AR_PB);
    bf16_t* U = (bf16_t*)(k.ws + AR_UBUF);
    const float* cw = k.sc_conv + (size_t)j * 3 * 1024;
    const int c0 = lane * 16;
    float k0[16], k1[16], k2[16];
#pragma unroll
    for (int e = 0; e < 16; ++e) { k0[e] = cw[c0 + e]; k1[e] = cw[1024 + c0 + e]; k2[e] = cw[2048 + c0 + e]; }
    for (int r = blockIdx.x * 8 + wave; r < T; r += gridDim.x * 8) {
        bool lok, rok;
        if (r < TC) { const int t = r & 255; lok = t != 0; rok = t != 255; } else { const int t = (r - TC) & 63; lok = t != 0; rok = t != 63; }
        const bf16_t* p = P + (size_t)r * 3072 + c0;
        const bf16_t* pl = lok ? p - 3072 : p; const bf16_t* pr = rok ? p + 3072 : p;
        u32x4 vb[2], vc[2], vx[2], vcl[2], vxl[2], vcr[2], vxr[2];
#pragma unroll
        for (int hh = 0; hh < 2; ++hh) {
            vb[hh] = *(const u32x4*)(p + hh * 8); vc[hh] = *(const u32x4*)(p + 1024 + hh * 8); vx[hh] = *(const u32x4*)(p + 2048 + hh * 8);
            vcl[hh] = *(const u32x4*)(pl + 1024 + hh * 8); vxl[hh] = *(const u32x4*)(pl + 2048 + hh * 8);
            vcr[hh] = *(const u32x4*)(pr + 1024 + hh * 8); vxr[hh] = *(const u32x4*)(pr + 2048 + hh * 8);
        }
        asm volatile("" ::: "memory");
        const float fl = lok ? 1.f : 0.f, frr = rok ? 1.f : 0.f;
#pragma unroll
        for (int hh = 0; hh < 2; ++hh) {
            float bg[8], cg[8], xi[8], cl[8], xl[8], cr[8], xr[8];
            unpack8(vb[hh], bg); unpack8(vc[hh], cg); unpack8(vx[hh], xi); unpack8(vcl[hh], cl); unpack8(vxl[hh], xl); unpack8(vcr[hh], cr); unpack8(vxr[hh], xr);
            u32x4 o;
#pragma unroll
            for (int w = 0; w < 4; ++w) {
                float ov[2];
#pragma unroll
                for (int e = 0; e < 2; ++e) { const int i = 2 * w + e, c = hh * 8 + i; ov[e] = bg[i] * (k0[c] * fl * cl[i] * xl[i] + k1[c] * cg[i] * xi[i] + k2[c] * frr * cr[i] * xr[i]); }
                o[w] = pk2(ov[0], ov[1]);
            }
            *(u32x4*)(U + (size_t)r * 1024 + c0 + hh * 8) = o;
        }
    }
}

constexpr int DN_STEPS = 260, DN_UNITS = 32 * DN_STEPS;
DI int dn_rbase(int b, int dir, int s) {
    if (s < 4) return dir == 0 ? b * 256 + s * 64 : b * 256 + 255 - s * 64;
    const int cc = s - 4;
    return dir == 0 ? TC + b * SEQ + cc * 64 : TC + b * SEQ + SEQ - 1 - cc * 64;
}
struct DnRaw { u32x4 c[3][2], l[3][2], r[3][2]; float g, be; };
DI void dn_raw_load(const bf16_t* P, const float* gb, int u, int tid, DnRaw& R) {
    const int chain = u / DN_STEPS, s = u - chain * DN_STEPS, dir = chain & 1, h = (chain >> 1) & 7, b = chain >> 4;
    const int rbase = dn_rbase(b, dir, s), rstep = dir == 0 ? 1 : -1;
    const int i = tid >> 3, sg = tid & 7, r = rbase + rstep * i;
    bool lok, rok;
    if (r < TC) { const int t = r & 255; lok = t != 0; rok = t != 255; } else { const int t = (r - TC) & 63; lok = t != 0; rok = t != 63; }
#pragma unroll
    for (int part = 0; part < 3; ++part) {
        const bf16_t* pc = P + (size_t)r * 3072 + part * 1024 + h * 128 + sg * 16;
#pragma unroll
        for (int hf = 0; hf < 2; ++hf) {
            R.c[part][hf] = *(const u32x4*)(pc + hf * 8);
            R.l[part][hf] = (u32x4){0u, 0u, 0u, 0u}; R.r[part][hf] = (u32x4){0u, 0u, 0u, 0u};
            if (lok) R.l[part][hf] = *(const u32x4*)(pc - 3072 + hf * 8);
            if (rok) R.r[part][hf] = *(const u32x4*)(pc + 3072 + hf * 8);
        }
    }
    if (tid < 64) { const size_t row = (size_t)(rbase + rstep * tid); R.g = gb[row * 32 + dir * 8 + h]; R.be = gb[row * 32 + 16 + dir * 8 + h]; }
}
PF void dn_chunk(const KC& k, int jl, LAS unsigned char* lds) {
    const int tid = TID(), lane = tid & 63, wave = tid >> 6, fr = lane & 15, fq = lane >> 4;
    LAS bf16_t* Kt = (LAS bf16_t*)lds;
    LAS bf16_t* Qt = Kt + 64 * 136;
    LAS bf16_t* Vt = Qt + 64 * 136;
    LAS float* Amat = (LAS float*)(Vt + 64 * 136);
    LAS bf16_t* Tb = (LAS bf16_t*)(Amat + 64 * 64);
    LAS bf16_t* VbT = Tb + 64 * 72;
    LAS bf16_t* KbT = VbT + 128 * 72;
    LAS float* gcs = (LAS float*)(KbT + 128 * 72);
    LAS float* bet = gcs + 64; LAS float* eg = bet + 64; LAS float* egr = eg + 64;
    LAS float* Tm = egr + 64;
    const bf16_t* P = (const bf16_t*)(k.ws + AR_PB);
    const float* gb = (const float*)(k.ws + WS_GB);
    const float* cw = k.dn_conv + (size_t)jl * 3 * 3072;
    bf16_t* CH = (bf16_t*)(k.ws + AR_CHUNK);
    bf16_t* ATT = (bf16_t*)(k.ws + AR_HBUF);
    float* EGL = (float*)(k.ws + WS_EGL);
    for (int u = blockIdx.x; u < DN_UNITS; u += gridDim.x) {
        DnRaw Rn; dn_raw_load(P, gb, u, tid, Rn);
        const int chain = u / DN_STEPS, s = u - chain * DN_STEPS, dir = chain & 1, h = (chain >> 1) & 7, b = chain >> 4;
        const int rbase = dn_rbase(b, dir, s), rstep = dir == 0 ? 1 : -1;
        bf16_t* cW = CH + (size_t)u * 32768; bf16_t* cQd = cW + 8192; bf16_t* cKd = cQd + 8192; bf16_t* cU = cKd + 8192;
        bf16_t* cAt = ATT + (size_t)u * 4096;
        lds_barrier();
        const float g_in = Rn.g, be_in = Rn.be;
        {
            const int i = tid >> 3, sg = tid & 7;
#pragma unroll
            for (int part = 0; part < 3; ++part) {
                const int col = part * 1024 + h * 128 + sg * 16;
                float v[16];
#pragma unroll
                for (int hf = 0; hf < 2; ++hf) {
                    const u32x4 c4 = Rn.c[part][hf], l4 = Rn.l[part][hf], r4 = Rn.r[part][hf];
#pragma unroll
                    for (int w2 = 0; w2 < 2; ++w2) {
                        const int cc = col + hf * 8 + 4 * w2;
                        const f32x4 k0 = *(const f32x4*)(cw + cc), k1 = *(const f32x4*)(cw + 3072 + cc), k2 = *(const f32x4*)(cw + 6144 + cc);
#pragma unroll
                        for (int e = 0; e < 4; ++e) {
                            const int w = 2 * w2 + (e >> 1);
                            const float lv = __uint_as_float((e & 1) ? (l4[w] & 0xffff0000u) : (l4[w] << 16));
                            const float cv = __uint_as_float((e & 1) ? (c4[w] & 0xffff0000u) : (c4[w] << 16));
                            const float rv = __uint_as_float((e & 1) ? (r4[w] & 0xffff0000u) : (r4[w] << 16));
                            v[hf * 8 + 4 * w2 + e] = siluf(k0[e] * lv + k1[e] * cv + k2[e] * rv);
                        }
                    }
                }
                if (part < 2) {
                    float ss = 0.f;
#pragma unroll
                    for (int e = 0; e < 16; ++e) ss += v[e] * v[e];
                    ss += shx(ss, 1, lane); ss += shx(ss, 2, lane); ss += shx(ss, 4, lane);
                    const float sc = rsqrtf(ss + EPS) * (part == 0 ? 0.08838834764831845f : 1.0f);
#pragma unroll
                    for (int e = 0; e < 16; ++e) v[e] *= sc;
                }
                LAS bf16_t* dst = (part == 0 ? Qt : (part == 1 ? Kt : Vt)) + i * 136 + sg * 16;
                u32x4 o0, o1;
#pragma unroll
                for (int w = 0; w < 4; ++w) { o0[w] = pk2(v[2 * w], v[2 * w + 1]); o1[w] = pk2(v[8 + 2 * w], v[8 + 2 * w + 1]); }
                *(LAS u32x4*)dst = o0; *(LAS u32x4*)(dst + 8) = o1;
            }
        }
        if (wave == 0) {
            float g = g_in;
            const float be = be_in;
#pragma unroll
            for (int d = 1; d < 64; d <<= 1) { const float o = shi(g, (lane - d) & 63); if (lane >= d) g += o; }
            const float glast = shi(g, 63);
            gcs[lane] = g; bet[lane] = be; eg[lane] = expf(g); egr[lane] = expf(glast - g);
            if (lane == 0) EGL[u] = expf(glast);
        }
        lds_barrier();
#pragma unroll 1
        for (int x = 0; x < 4; ++x) {
            const int t = wave + 8 * x, isq = t >> 4, mt = (t >> 2) & 3, nt = t & 3;
            f32x4 acc = (f32x4){0.f, 0.f, 0.f, 0.f};
            const int jc = 16 * nt + fr;
            float gi4[4], bi4[4];
            const float gj = gcs[jc];
#pragma unroll
            for (int jj = 0; jj < 4; ++jj) { gi4[jj] = gcs[16 * mt + 4 * fq + jj]; bi4[jj] = bet[16 * mt + 4 * fq + jj]; }
            if (mt >= nt) {
                const LAS bf16_t* Ar = (isq ? Qt : Kt) + (16 * mt + fr) * 136 + 8 * fq;
                const LAS bf16_t* Br = Kt + (16 * nt + fr) * 136 + 8 * fq;
                bf16x8 fa4[4], fb4[4];
#pragma unroll
                for (int ks = 0; ks < 4; ++ks) { fa4[ks] = *(const LAS bf16x8*)(Ar + 32 * ks); fb4[ks] = *(const LAS bf16x8*)(Br + 32 * ks); }
                asm volatile("" ::: "memory");
#pragma unroll
                for (int ks = 0; ks < 4; ++ks) acc = __builtin_amdgcn_mfma_f32_16x16x32_bf16(fa4[ks], fb4[ks], acc, 0, 0, 0);
            }
#pragma unroll
            for (int jj = 0; jj < 4; ++jj) {
                const int ir = 16 * mt + 4 * fq + jj;
                const float dec = __expf(fminf(gi4[jj] - gj, 0.f));
                if (isq) cAt[((mt * 2 + (nt >> 1)) * 64 + (fr >> 2) * 16 + 4 * fq + jj) * 8 + (nt & 1) * 4 + (fr & 3)] = f2bf(ir >= jc ? acc[jj] * dec : 0.f);
                else Amat[ir * 64 + jc] = ir > jc ? bi4[jj] * acc[jj] * dec : 0.f;
            }
        }
        {
            const int un = u + (int)gridDim.x < DN_UNITS ? u + (int)gridDim.x : u;
            const int chn = un / DN_STEPS, stn = un - chn * DN_STEPS, dirn = chn & 1, hn = (chn >> 1) & 7, bn = chn >> 4;
            const int rbn = dn_rbase(bn, dirn, stn), rsn = dirn == 0 ? 1 : -1;
            const unsigned char* pa;
            if (tid < 396) { const int seg = tid >> 1, ri = seg / 3, part = seg - 3 * ri; int r = rbn + rsn * (ri - 1); r = r < 0 ? 0 : r > T - 1 ? T - 1 : r;
                             pa = (const unsigned char*)(P + (size_t)r * 3072 + part * 1024 + hn * 128 + (tid & 1) * 64); }
            else { const int j = tid < 460 ? tid - 396 : 0; pa = (const unsigned char*)(gb + (size_t)(rbn + rsn * j) * 32); }
            __builtin_amdgcn_global_load_lds((const unsigned*)pa, (LAS unsigned*)(lds + 143360), 4, 0, 0);
        }
        lds_barrier();
        {
        if (wave < 4) {
            if (lane < 16) {
                const int bo = 16 * wave;
                float tc[16];
#pragma unroll
                for (int i = 0; i < 16; ++i) {
                    f32x4 ar[4];
#pragma unroll
                    for (int q = 0; q < (i + 3) / 4; ++q) ar[q] = *(const LAS f32x4*)(Amat + (bo + i) * 64 + bo + 4 * q);
                    float a0 = (i == lane) ? 1.f : 0.f, a1 = 0.f;
#pragma unroll
                    for (int j = 0; j < i; ++j) { const float av = ar[j >> 2][j & 3]; if (j & 1) a1 -= av * tc[j]; else a0 -= av * tc[j]; }
                    tc[i] = a0 + a1;
                    Tm[(bo + i) * 64 + bo + lane] = tc[i];
                }
            }
        } else {
            for (int it = tid - 256; it < 1024; it += 256) {
                const int c = it & 127, ig = it >> 7;
                float kv[8], vv[8];
                { bf16_t kr[8], vr[8];
#pragma unroll
                  for (int e = 0; e < 8; ++e) { kr[e] = Kt[(8 * ig + e) * 136 + c]; vr[e] = Vt[(8 * ig + e) * 136 + c]; }
                  asm volatile("" ::: "memory");
#pragma unroll
                  for (int e = 0; e < 8; ++e) { kv[e] = bf2f(kr[e]); vv[e] = bf2f(vr[e]); } }
                u32x4 ov, ok, od;
#pragma unroll
                for (int w = 0; w < 4; ++w) {
                    const int i0 = 8 * ig + 2 * w, i1 = i0 + 1;
                    ov[w] = pk2(bet[i0] * vv[2 * w], bet[i1] * vv[2 * w + 1]);
                    ok[w] = pk2(bet[i0] * eg[i0] * kv[2 * w], bet[i1] * eg[i1] * kv[2 * w + 1]);
                    od[w] = pk2(egr[i0] * kv[2 * w], egr[i1] * kv[2 * w + 1]);
                }
                *(LAS u32x4*)(VbT + c * 72 + 8 * ig) = ov;
                *(LAS u32x4*)(KbT + c * 72 + 8 * ig) = ok;
                { bf16_t* kd0 = cKd + (((c >> 4) * 2 + (ig >> 2)) * 64 + (2 * (ig & 1)) * 16 + (c & 15)) * 8 + ((ig & 3) >> 1) * 4;
                  *(u32x2*)kd0 = (u32x2){od[0], od[1]}; *(u32x2*)(kd0 + 128) = (u32x2){od[2], od[3]}; }
            }
            for (int it = tid - 256; it < 1024; it += 256) {
                const int i = it >> 4, c8 = (it & 15) * 8; const float e = eg[i];
                const u32x4 qv = *(const LAS u32x4*)(Qt + i * 136 + c8); u32x4 o;
#pragma unroll
                for (int w = 0; w < 4; ++w) o[w] = pk2(__uint_as_float(qv[w] << 16) * e, __uint_as_float(qv[w] & 0xffff0000u) * e);
                { const int k8 = it & 15; bf16_t* qd0 = cQd + (((i >> 4) * 4 + (k8 >> 2)) * 64 + (2 * (k8 & 1)) * 16 + (i & 15)) * 8 + ((k8 & 3) >> 1) * 4;
                  *(u32x2*)qd0 = (u32x2){o[0], o[1]}; *(u32x2*)(qd0 + 128) = (u32x2){o[2], o[3]}; }
            }
        }
        lds_barrier();
#pragma unroll 1
        for (int d = 1; d < 4; ++d) {
            if (wave < 4 - d) {
                const int bi = wave + d, bj = wave, r = lane >> 2, c0 = 4 * (lane & 3);
                f32x4 m = (f32x4){0.f, 0.f, 0.f, 0.f};
                for (int kb = bj; kb < bi; ++kb) {
                    f32x4 av4[4], tv[16];
#pragma unroll
                    for (int q = 0; q < 4; ++q) av4[q] = *(const LAS f32x4*)(Amat + (16 * bi + r) * 64 + 16 * kb + 4 * q);
#pragma unroll
                    for (int kk = 0; kk < 16; ++kk) tv[kk] = *(const LAS f32x4*)(Tm + (16 * kb + kk) * 64 + 16 * bj + c0);
                    asm volatile("" ::: "memory");
#pragma unroll
                    for (int kk = 0; kk < 16; ++kk) m += tv[kk] * av4[kk >> 2][kk & 3];
                }
                *(LAS f32x4*)(Tm + (16 * bj + r) * 64 + 16 * bi + c0) = m;
                f32x4 t = (f32x4){0.f, 0.f, 0.f, 0.f};
                {
                    f32x4 dv4[4], mv[16];
#pragma unroll
                    for (int q = 0; q < 4; ++q) dv4[q] = *(const LAS f32x4*)(Tm + (16 * bi + r) * 64 + 16 * bi + 4 * q);
#pragma unroll
                    for (int kk = 0; kk < 16; ++kk) mv[kk] = *(const LAS f32x4*)(Tm + (16 * bj + kk) * 64 + 16 * bi + c0);
                    asm volatile("" ::: "memory");
#pragma unroll
                    for (int kk = 0; kk < 16; ++kk) t -= mv[kk] * dv4[kk >> 2][kk & 3];
                }
                *(LAS f32x4*)(Tm + (16 * bi + r) * 64 + 16 * bj + c0) = t;
            }
            lds_barrier();
        }
        for (int it = tid; it < 64 * 8; it += NTHR) {
            const int i = it >> 3, c8 = (it & 7) * 8; u32x4 o;
#pragma unroll
            for (int w = 0; w < 4; ++w) {
                const int c = c8 + 2 * w;
                o[w] = pk2(c <= i ? Tm[i * 64 + c] : 0.f, c + 1 <= i ? Tm[i * 64 + c + 1] : 0.f);
            }
            *(LAS u32x4*)(Tb + i * 72 + c8) = o;
        }
        }
        lds_barrier();
        {
            f32x4 au[4], aw[4];
#pragma unroll
            for (int mt = 0; mt < 4; ++mt) { au[mt] = (f32x4){0.f, 0.f, 0.f, 0.f}; aw[mt] = (f32x4){0.f, 0.f, 0.f, 0.f}; }
            bf16x8 bv[2], bk[2], at[2][4];
#pragma unroll
            for (int ks = 0; ks < 2; ++ks) {
                bv[ks] = *(const LAS bf16x8*)(VbT + (16 * wave + fr) * 72 + 32 * ks + 8 * fq);
                bk[ks] = *(const LAS bf16x8*)(KbT + (16 * wave + fr) * 72 + 32 * ks + 8 * fq);
#pragma unroll
                for (int mt = 0; mt < 4; ++mt) at[ks][mt] = *(const LAS bf16x8*)(Tb + (16 * mt + fr) * 72 + 32 * ks + 8 * fq);
            }
            asm volatile("" ::: "memory");
#pragma unroll
            for (int ks = 0; ks < 2; ++ks)
#pragma unroll
                for (int mt = 0; mt < 4; ++mt) {
                    au[mt] = __builtin_amdgcn_mfma_f32_16x16x32_bf16(at[ks][mt], bv[ks], au[mt], 0, 0, 0);
                    aw[mt] = __builtin_amdgcn_mfma_f32_16x16x32_bf16(at[ks][mt], bk[ks], aw[mt], 0, 0, 0);
                }
#pragma unroll
            for (int mt = 0; mt < 4; ++mt)
#pragma unroll
                for (int jj = 0; jj < 4; ++jj)
                    cW[((mt * 4 + (wave >> 1)) * 64 + (fr >> 2) * 16 + 4 * fq + jj) * 8 + (wave & 1) * 4 + (fr & 3)] = f2bf(aw[mt][jj]);
            {
                u32x4 u0, u1;
                u0[0] = pk2(au[0][0], au[0][1]); u0[1] = pk2(au[0][2], au[0][3]); u0[2] = pk2(au[1][0], au[1][1]); u0[3] = pk2(au[1][2], au[1][3]);
                u1[0] = pk2(au[2][0], au[2][1]); u1[1] = pk2(au[2][2], au[2][3]); u1[2] = pk2(au[3][0], au[3][1]); u1[3] = pk2(au[3][2], au[3][3]);
                bf16_t* ud = cU + (wave * 64 + lane) * 16;
                *(u32x4*)ud = u0; *(u32x4*)(ud + 8) = u1;
            }
        }
    }
}
DI bf16x8 pk8(f32x4 a, f32x4 b) { u32x4 r; r[0] = pk2(a[0], a[1]); r[1] = pk2(a[2], a[3]); r[2] = pk2(b[0], b[1]); r[3] = pk2(b[2], b[3]); return __builtin_bit_cast(bf16x8, r); }
constexpr int SC_PFD = 3;
DI bf16x8 ldfrag(const bf16_t* p) { return __builtin_bit_cast(bf16x8, *(const u32x4*)p); }
PF void dn_scan(const KC& k, LAS unsigned char* lds, int pm) {
    const int tid = TID(), lane = tid & 63, fr = lane & 15, fq = lane >> 4;
    const int wave = __builtin_amdgcn_readfirstlane(tid >> 6);
    const bf16_t* CH = (const bf16_t*)(k.ws + AR_CHUNK);
    const bf16_t* ATT = (const bf16_t*)(k.ws + AR_HBUF);
    const float* EGL = (const float*)(k.ws + WS_EGL);
    bf16_t* O = (bf16_t*)(k.ws + (pm ? AR_UBUF : AR_PB));
    LAS float* eglL = (LAS float*)lds;
    LAS u32x4* sbx = (LAS u32x4*)(eglL + 272);
    LAS u32x4* vbx = sbx + 512;
    volatile LAS int* vflag = (volatile LAS int*)(vbx + 256);
    for (int un0 = blockIdx.x; un0 < 256; un0 += gridDim.x) {
        if ((pm == 2 && ((un0 >> 3) & 1)) || (pm == 3 && (un0 & 1))) continue;
        const int un = (gridDim.x == 256) ? ((un0 & 7) * 32 + (un0 >> 3)) : un0;
        const int sl = un & 7, chain = un >> 3, dir = chain & 1, h = (chain >> 1) & 7, b = chain >> 4;
        const int rstep = dir == 0 ? 1 : -1;
        const bf16_t* U0 = CH + (size_t)(chain * DN_STEPS) * 32768 + lane * 8;
        const bf16_t* A0 = ATT + (size_t)(chain * DN_STEPS) * 4096 + lane * 8;
        lds_barrier();
        if (tid < DN_STEPS) eglL[tid] = EGL[chain * DN_STEPS + tid];
        if (tid == 0) *vflag = 0;
        if (wave == 0) {
            f32x4 S[8];
#pragma unroll
            for (int t = 0; t < 8; ++t) S[t] = (f32x4){0.f, 0.f, 0.f, 0.f};
            bf16x8 fw[16], fk[16]; u32x4 uc[2];
#pragma unroll
            for (int i = 0; i < 16; ++i) { fw[i] = ldfrag(U0 + i * 512); fk[i] = ldfrag(U0 + 16384 + i * 512); }
            { const bf16_t* up = U0 - lane * 8 + 24576 + (sl * 64 + lane) * 16; uc[0] = *(const u32x4*)up; uc[1] = *(const u32x4*)(up + 8); }
#pragma unroll
            for (int ks = 0; ks < 4; ++ks) sbx[ks * 64 + lane] = (u32x4){0u, 0u, 0u, 0u};
#pragma unroll
            for (int i = 0; i < 16; ++i) { asm volatile("" :: "v"(__builtin_bit_cast(u32x4, fw[i]))); asm volatile("" :: "v"(__builtin_bit_cast(u32x4, fk[i]))); }
            asm volatile("" :: "v"(uc[0]), "v"(uc[1]));
            lds_barrier();
#pragma unroll 1
            for (int s = 0; s < DN_STEPS; ++s) {
                const int sn = pm == 1 ? 0 : s + 1 < DN_STEPS ? s + 1 : s;
                const bf16_t* Un = U0 + (size_t)sn * 32768;
                const float egl = eglL[s];
                bf16x8 sb[4];
#pragma unroll
                for (int ks = 0; ks < 4; ++ks) sb[ks] = pk8(S[2 * ks], S[2 * ks + 1]);
                f32x4 p[4];
#pragma unroll
                for (int mt = 0; mt < 4; ++mt) p[mt] = (f32x4){0.f, 0.f, 0.f, 0.f};
#pragma unroll
                for (int ks = 0; ks < 4; ++ks)
#pragma unroll
                    for (int mt = 0; mt < 4; ++mt) {
                        p[mt] = __builtin_amdgcn_mfma_f32_16x16x32_bf16(fw[mt * 4 + ks], sb[ks], p[mt], 0, 0, 0);
                        fw[mt * 4 + ks] = ldfrag(Un + (mt * 4 + ks) * 512);
                    }
#pragma unroll
                for (int mt = 0; mt < 4; ++mt) {
                    const unsigned ua = uc[mt >> 1][(mt & 1) * 2], ub = uc[mt >> 1][(mt & 1) * 2 + 1];
                    p[mt][0] = __uint_as_float(ua << 16) - p[mt][0]; p[mt][1] = __uint_as_float(ua & 0xffff0000u) - p[mt][1];
                    p[mt][2] = __uint_as_float(ub << 16) - p[mt][2]; p[mt][3] = __uint_as_float(ub & 0xffff0000u) - p[mt][3];
                }
                { const bf16_t* up = Un - lane * 8 + 24576 + (sl * 64 + lane) * 16; uc[0] = *(const u32x4*)up; uc[1] = *(const u32x4*)(up + 8); }
                bf16x8 vb[2];
                vb[0] = pk8(p[0], p[1]); vb[1] = pk8(p[2], p[3]);
                vbx[(s & 1) * 64 + lane] = __builtin_bit_cast(u32x4, vb[0]); vbx[(s & 1) * 64 + 128 + lane] = __builtin_bit_cast(u32x4, vb[1]);
                asm volatile("s_waitcnt lgkmcnt(0)" ::: "memory");
                if (lane == 0) *vflag = s + 1;
#pragma unroll
                for (int t = 0; t < 8; ++t) S[t] = S[t] * egl;
#pragma unroll
                for (int kc = 0; kc < 2; ++kc)
#pragma unroll
                    for (int t = 0; t < 8; ++t) {
                        S[t] = __builtin_amdgcn_mfma_f32_16x16x32_bf16(fk[t * 2 + kc], vb[kc], S[t], 0, 0, 0);
                        fk[t * 2 + kc] = ldfrag(Un + 16384 + (t * 2 + kc) * 512);
                    }
#pragma unroll
                for (int ks = 0; ks < 4; ++ks) sbx[((s + 1) & 1) * 256 + ks * 64 + lane] = __builtin_bit_cast(u32x4, pk8(S[2 * ks], S[2 * ks + 1]));
                lds_barrier();
            }
        } else if (wave == 1) {
            bf16x8 fqd[16], fat[8];
#pragma unroll
            for (int i = 0; i < 16; ++i) fqd[i] = ldfrag(U0 + 8192 + i * 512);
#pragma unroll
            for (int i = 0; i < 8; ++i) fat[i] = ldfrag(A0 + i * 512);
#pragma unroll
            for (int i = 0; i < 16; ++i) asm volatile("" :: "v"(__builtin_bit_cast(u32x4, fqd[i])));
#pragma unroll
            for (int i = 0; i < 8; ++i) asm volatile("" :: "v"(__builtin_bit_cast(u32x4, fat[i])));
            f32x4 op[4];
#pragma unroll
            for (int mt = 0; mt < 4; ++mt) op[mt] = (f32x4){0.f, 0.f, 0.f, 0.f};
            lds_barrier();
#pragma unroll 1
            for (int s = 0; s < DN_STEPS; ++s) {
                const int sn = pm == 1 ? 0 : s + 1 < DN_STEPS ? s + 1 : s;
                const bf16_t* Un = U0 + (size_t)sn * 32768; const bf16_t* An = A0 + (size_t)sn * 4096;
                bf16x8 sb[4];
#pragma unroll
                for (int ks = 0; ks < 4; ++ks) sb[ks] = __builtin_bit_cast(bf16x8, sbx[(s & 1) * 256 + ks * 64 + lane]);
                {
                    const int sp = s > 0 ? s - 1 : 0; const int rbase = dn_rbase(b, dir, sp);
#pragma unroll
                    for (int mt = 0; mt < 4; ++mt)
#pragma unroll
                        for (int jj = 0; jj < 4; ++jj) {
                            const int row = rbase + rstep * (16 * mt + 4 * fq + jj);
                            O[((size_t)(pm ? 0 : dir) * T + row) * 1024 + h * 128 + sl * 16 + fr] = f2bf(op[mt][jj]);
                        }
                }
                f32x4 o[4];
#pragma unroll
                for (int mt = 0; mt < 4; ++mt) o[mt] = (f32x4){0.f, 0.f, 0.f, 0.f};
#pragma unroll
                for (int ks = 0; ks < 4; ++ks)
#pragma unroll
                    for (int mt = 0; mt < 4; ++mt) {
                        o[mt] = __builtin_amdgcn_mfma_f32_16x16x32_bf16(fqd[mt * 4 + ks], sb[ks], o[mt], 0, 0, 0);
                        fqd[mt * 4 + ks] = ldfrag(Un + 8192 + (mt * 4 + ks) * 512);
                    }
                while (*vflag < s + 1) __builtin_amdgcn_s_sleep(1);
                asm volatile("" ::: "memory");
                bf16x8 vb[2];
                vb[0] = __builtin_bit_cast(bf16x8, vbx[(s & 1) * 64 + lane]); vb[1] = __builtin_bit_cast(bf16x8, vbx[(s & 1) * 64 + 128 + lane]);
#pragma unroll
                for (int kc = 0; kc < 2; ++kc)
#pragma unroll
                    for (int mt = 0; mt < 4; ++mt) {
                        o[mt] = __builtin_amdgcn_mfma_f32_16x16x32_bf16(fat[mt * 2 + kc], vb[kc], o[mt], 0, 0, 0);
                        fat[mt * 2 + kc] = ldfrag(An + (mt * 2 + kc) * 512);
                    }
#pragma unroll
                for (int mt = 0; mt < 4; ++mt) op[mt] = o[mt];
                lds_barrier();
            }
            {
                const int rbase = dn_rbase(b, dir, DN_STEPS - 1);
#pragma unroll
                for (int mt = 0; mt < 4; ++mt)
#pragma unroll
                    for (int jj = 0; jj < 4; ++jj) {
                        const int row = rbase + rstep * (16 * mt + 4 * fq + jj);
                        O[((size_t)(pm ? 0 : dir) * T + row) * 1024 + h * 128 + sl * 16 + fr] = f2bf(op[mt][jj]);
                    }
            }
        } else if (wave == 2) {
            const unsigned char* P0 = (const unsigned char*)(CH + (size_t)(chain * DN_STEPS) * 32768 + sl * 4096) + lane * 64;
            const unsigned char* Q0 = (const unsigned char*)(ATT + (size_t)(chain * DN_STEPS) * 4096 + sl * 512) + (lane & 15) * 64;
            unsigned d0 = 0u, d1 = 0u, d2 = 0u;
            lds_barrier();
#pragma unroll 1
            for (int s = 0; s < DN_STEPS; ++s) {
                const int sp = pm == 1 ? 0 : s + SC_PFD < DN_STEPS ? s + SC_PFD : DN_STEPS - 1;
                const unsigned char* pa = P0 + (size_t)sp * 65536; const unsigned char* pb = pa + 4096; const unsigned char* qa = Q0 + (size_t)sp * 8192;
                asm volatile("global_load_dword %0, %3, off\n\tglobal_load_dword %1, %4, off\n\tglobal_load_dword %2, %5, off"
                             : "+v"(d0), "+v"(d1), "+v"(d2) : "v"(pa), "v"(pb), "v"(qa) : "memory");
                lds_barrier();
            }
            asm volatile("s_waitcnt vmcnt(0)" : "+v"(d0), "+v"(d1), "+v"(d2) :: "memory");
        } else {
            lds_barrier();
#pragma unroll 1
            for (int s = 0; s < DN_STEPS; ++s) lds_barrier();
        }
    }
}
PF void dn_finish(const KC& k, int j) {
    const int tid = TID(), lane = tid & 63, wave = tid >> 6;
    const bf16_t* O = (const bf16_t*)(k.ws + AR_PB);
    const bf16_t* Z = (const bf16_t*)k.out;
    bf16_t* U = (bf16_t*)(k.ws + AR_UBUF);
    const float* on = k.dn_out_norm + j * 128;
    const int c0 = lane * 16;
    float onv[16];
#pragma unroll
    for (int e = 0; e < 16; ++e) onv[e] = on[(c0 + e) & 127];
    for (int r = blockIdx.x * 8 + wave; r < T; r += gridDim.x * 8) {
        u32x4 vf[2], vb[2], vz[2];
#pragma unroll
        for (int hh = 0; hh < 2; ++hh) {
            vf[hh] = *(const u32x4*)(O + (size_t)r * 1024 + c0 + hh * 8); vb[hh] = *(const u32x4*)(O + ((size_t)T + r) * 1024 + c0 + hh * 8);
            vz[hh] = *(const u32x4*)(Z + (size_t)r * 1024 + c0 + hh * 8);
        }
        asm volatile("" ::: "memory");
        float o[16], z[16];
#pragma unroll
        for (int hh = 0; hh < 2; ++hh) { float a[8], b2[8], zz[8]; unpack8(vf[hh], a); unpack8(vb[hh], b2); unpack8(vz[hh], zz);
#pragma unroll
            for (int i = 0; i < 8; ++i) { o[hh * 8 + i] = a[i] + b2[i]; z[hh * 8 + i] = zz[i]; } }
        float ss = 0.f;
#pragma unroll
        for (int e = 0; e < 16; ++e) ss += o[e] * o[e];
        ss += shx(ss, 1, lane); ss += shx(ss, 2, lane); ss += shx(ss, 4, lane);
        const float rs = rsqrtf(ss * (1.0f / 128.0f) + EPS);
#pragma unroll
        for (int hh = 0; hh < 2; ++hh) { u32x4 ov;
#pragma unroll
            for (int w = 0; w < 4; ++w) { const int e0 = hh * 8 + 2 * w; ov[w] = pk2(o[e0] * rs * onv[e0] * siluf(z[e0]), o[e0 + 1] * rs * onv[e0 + 1] * siluf(z[e0 + 1])); }
            *(u32x4*)(U + (size_t)r * 1024 + c0 + hh * 8) = ov; }
    }
}

DI float conv3g(const bf16_t* p, int j, float w0, float w1, float w2) {
    const int gc = j & 63;
    const float l = gc != 0 ? bf2f(p[j - 1]) : 0.f, c = bf2f(p[j]), r = gc != 63 ? bf2f(p[j + 1]) : 0.f;
    return w0 * l + w1 * c + w2 * r;
}
DI float hy_conv_lane(float c, float w0, float w1, float w2, int lane) {
    const float l = shi(c, (lane + 63) & 63), r = shi(c, (lane + 1) & 63);
    return w0 * (lane > 0 ? l : 0.f) + w1 * c + w2 * (lane < 63 ? r : 0.f);
}
PF void hy_lat(const KC& k, int jl, LAS float* ldsf) {
    const int tid = TID();
    LAS cf* X = (LAS cf*)ldsf;
    LAS cf* tw = X + 17408;
    LAS cf* tA = tw + 1024; LAS cf* tB = tA + 128;
    const bf16_t* FT = (const bf16_t*)(k.ws + AR_FT);
    const bf16_t* PT = (const bf16_t*)(k.ws + AR_PB);
    bf16_t* ZT = (bf16_t*)(k.ws + AR_ZT);
    unsigned* scr = (unsigned*)(k.ws + AR_FFTS) + (size_t)blockIdx.x * 4 * 16384;
    unsigned* sKe = scr; unsigned* sKo = scr + 16384; unsigned* zp = scr + 2 * 16384; unsigned* ye = scr + 3 * 16384;
#define CPK(v) pk2((v).x, (v).y)
#define CUP(u_) ((cf){__uint_as_float((u_) << 16), __uint_as_float((u_) & 0xffff0000u)})
    const float* cw = k.hy_conv + (size_t)jl * 3 * 3072;
    for (int m = 0; m < 2; ++m) { const int p = tid + 512 * m; float sn, cs; sincospif(-(float)p / 8192.0f, &sn, &cs); cf w; w.x = cs; w.y = sn; tw[p] = w; }
    if (tid < 256) { const int a = tid & 127; float sn, cs; sincospif(-(float)(tid < 128 ? 128 * a : a) / 16384.0f, &sn, &cs); cf w; w.x = cs; w.y = sn; (tid < 128 ? tA : tB)[a] = w; }
    __syncthreads();
    const int lane = tid & 63;
#define HY_SPLIT() asm volatile("" ::: "memory")
#define HY_CONV(c, w0, w1, w2) hy_conv_lane((c), (w0), (w1), (w2), lane)
    for (int ch = blockIdx.x; ch < 1024; ch += gridDim.x) {
        {
            const bf16_t* pv = PT + (size_t)ch * T + TC;
            const float w0 = cw[ch], w1 = cw[3072 + ch], w2 = cw[6144 + ch];
            for (int m0 = 0; m0 < 32; m0 += 8) {
                bf16_t a0[8], a1[8];
#pragma unroll
                for (int q = 0; q < 8; ++q) { const int j = tid + 512 * (m0 + q); a0[q] = pv[j]; a1[q] = pv[SEQ + j]; }
                HY_SPLIT();
#pragma unroll
                for (int q = 0; q < 8; ++q) { const int j = tid + 512 * (m0 + q); const float c0 = bf2f(a0[q]), c1 = bf2f(a1[q]); cf z; z.x = HY_CONV(c0, w0, w1, w2); z.y = HY_CONV(c1, w0, w1, w2); zp[j] = CPK(z); }
            }
        }
        for (int n = 0; n < 2; ++n) {
            __syncthreads();
            const bf16_t* ftf = FT + (size_t)(n * 2048 + ch) * 16384; const bf16_t* ftb = FT + (size_t)(n * 2048 + 1024 + ch) * 16384;
            for (int m0 = 0; m0 < 32; m0 += 8) {
                bf16_t hfv[8], hbv[8];
#pragma unroll
                for (int q = 0; q < 8; ++q) { const int j = tid + 512 * (m0 + q); hfv[q] = ftf[j]; hbv[q] = ftb[j > 0 ? SEQ - j : 0]; }
                HY_SPLIT();
#pragma unroll
                for (int q = 0; q < 8; ++q) {
                    const int j = tid + 512 * (m0 + q);
                    const float hf = bf2f(hfv[q]), hb = j > 0 ? bf2f(hbv[q]) : 0.f;
                    const cf w = cmul(tA[j >> 7], tB[j & 127]);
                    cf a; a.x = hf + hb; a.y = 0.f; X[PIDX(j)] = a;
                    const float kd = hf - hb; cf o; o.x = kd * w.x; o.y = kd * w.y; sKo[j] = CPK(o);
                }
            }
            __syncthreads();
            fft16k_fwd(X, tw);
            unsigned Ker[32];
#pragma unroll
            for (int m = 0; m < 32; ++m) { const cf t_ = X[PIDX(tid + 512 * m)]; Ker[m] = CPK(t_); }
            __syncthreads();
            for (int m0 = 0; m0 < 32; m0 += 8) { unsigned t[8];
#pragma unroll
                for (int q = 0; q < 8; ++q) t[q] = sKo[tid + 512 * (m0 + q)];
                HY_SPLIT();
#pragma unroll
                for (int q = 0; q < 8; ++q) X[PIDX(tid + 512 * (m0 + q))] = CUP(t[q]); }
            __syncthreads();
            fft16k_fwd(X, tw);
            _Pragma("unroll 8") for (int m = 0; m < 32; ++m) { const int j = tid + 512 * m; const cf t_ = X[PIDX(j)]; sKo[j] = CPK(t_); }
            __syncthreads();
            for (int m0 = 0; m0 < 32; m0 += 8) { unsigned t[8];
#pragma unroll
                for (int q = 0; q < 8; ++q) t[q] = zp[tid + 512 * (m0 + q)];
                HY_SPLIT();
#pragma unroll
                for (int q = 0; q < 8; ++q) X[PIDX(tid + 512 * (m0 + q))] = CUP(t[q]); }
            __syncthreads();
            fft16k_fwd(X, tw);
#pragma unroll
            for (int m = 0; m < 32; ++m) { const int j = tid + 512 * m; X[PIDX(j)] = cmul(X[PIDX(j)], CUP(Ker[m])); }
            __syncthreads();
            fft16k_inv(X, tw);
            _Pragma("unroll 8") for (int m = 0; m < 32; ++m) { const int j = tid + 512 * m; const cf t_ = X[PIDX(j)]; ye[j] = CPK(t_); }
            __syncthreads();
            for (int m0 = 0; m0 < 32; m0 += 8) { unsigned t[8];
#pragma unroll
                for (int q = 0; q < 8; ++q) t[q] = zp[tid + 512 * (m0 + q)];
                HY_SPLIT();
#pragma unroll
                for (int q = 0; q < 8; ++q) { const int j = tid + 512 * (m0 + q); const cf w = cmul(tA[j >> 7], tB[j & 127]); X[PIDX(j)] = cmul(CUP(t[q]), w); } }
            __syncthreads();
            fft16k_fwd(X, tw);
            for (int m0 = 0; m0 < 32; m0 += 8) { unsigned t[8];
#pragma unroll
                for (int q = 0; q < 8; ++q) t[q] = sKo[tid + 512 * (m0 + q)];
                HY_SPLIT();
#pragma unroll
                for (int q = 0; q < 8; ++q) { const int j = tid + 512 * (m0 + q); X[PIDX(j)] = cmul(X[PIDX(j)], CUP(t[q])); } }
            __syncthreads();
            fft16k_inv(X, tw);
            {
                const bf16_t* pg = PT + (size_t)((n + 1) * 1024 + ch) * T + TC;
                const int gcol = (n + 1) * 1024 + ch;
                const float w0 = cw[gcol], w1 = cw[3072 + gcol], w2 = cw[6144 + gcol];
                const float bias = k.hy_bias[(size_t)jl * 2 * 1024 + n * 1024 + ch];
                for (int m0 = 0; m0 < 32; m0 += 8) {
                    unsigned te_[8], tz_[8]; bf16_t g0[8], g1[8];
#pragma unroll
                    for (int q = 0; q < 8; ++q) { const int j = tid + 512 * (m0 + q); te_[q] = ye[j]; tz_[q] = zp[j]; g0[q] = pg[j]; g1[q] = pg[SEQ + j]; }
                    HY_SPLIT();
#pragma unroll
                    for (int q = 0; q < 8; ++q) {
                        const int j = tid + 512 * (m0 + q);
                        cf w = cmul(tA[j >> 7], tB[j & 127]); w.y = -w.y;
                        const cf yo = cmul(X[PIDX(j)], w);
                        const cf te = CUP(te_[q]), tz = CUP(tz_[q]);
                        const float y0 = (0.5f / 16384.0f) * (te.x + yo.x), y1 = (0.5f / 16384.0f) * (te.y + yo.y);
                        const float c0 = bf2f(g0[q]), c1 = bf2f(g1[q]);
                        cf zn; zn.x = HY_CONV(c0, w0, w1, w2) * (y0 + bias * tz.x); zn.y = HY_CONV(c1, w0, w1, w2) * (y1 + bias * tz.y);
                        zp[j] = CPK(zn);
                    }
                }
            }
        }
        for (int m0 = 0; m0 < 32; m0 += 8) { unsigned t[8];
#pragma unroll
            for (int q = 0; q < 8; ++q) t[q] = zp[tid + 512 * (m0 + q)];
            HY_SPLIT();
#pragma unroll
            for (int q = 0; q < 8; ++q) { const int j = tid + 512 * (m0 + q); ZT[(size_t)ch * T + TC + j] = (bf16_t)(t[q] & 0xffffu); ZT[(size_t)ch * T + TC + SEQ + j] = (bf16_t)(t[q] >> 16); } }
        __syncthreads();
    }
#undef CPK
#undef CUP
#undef HY_SPLIT
#undef HY_CONV
}
PF void hy_ctx(const KC& k, int jl, LAS float* lds) {
    const int tid = TID(), t = tid & 255, hsel = tid >> 8;
    LAS float* z = lds + hsel * 768; LAS float* hf = z + 256; LAS float* hb = hf + 256;
    const bf16_t* PT = (const bf16_t*)(k.ws + AR_PB);
    bf16_t* U = (bf16_t*)(k.ws + AR_UBUF);
    const float* filtc = (const float*)(k.ws + WS_FILTC);
    const float* cw = k.hy_conv + (size_t)jl * 3 * 3072;
    for (int u = blockIdx.x; u < 1024; u += gridDim.x) {
        const int pr = u * 2 + hsel, b = pr >> 10, ch = pr & 1023;
        float zc;
        {
            const bf16_t* pv = PT + (size_t)ch * T + b * 256;
            const float l = t != 0 ? bf2f(pv[t - 1]) : 0.f, c = bf2f(pv[t]), r = t != 255 ? bf2f(pv[t + 1]) : 0.f;
            zc = cw[ch] * l + cw[3072 + ch] * c + cw[6144 + ch] * r;
        }
        for (int n = 0; n < 2; ++n) {
            __syncthreads();
            z[t] = zc; hf[t] = filtc[(size_t)t * 4096 + n * 2048 + ch]; hb[t] = filtc[(size_t)t * 4096 + n * 2048 + 1024 + ch];
            __syncthreads();
            float y = 0.f;
            for (int s = 0; s <= t; ++s) y += hf[t - s] * z[s];
            for (int s = t + 1; s < 256; ++s) y += hb[s - t] * z[s];
            const int gcol = (n + 1) * 1024 + ch;
            const bf16_t* pg = PT + (size_t)gcol * T + b * 256;
            const float l = t != 0 ? bf2f(pg[t - 1]) : 0.f, c = bf2f(pg[t]), r = t != 255 ? bf2f(pg[t + 1]) : 0.f;
            const float gate = cw[gcol] * l + cw[3072 + gcol] * c + cw[6144 + gcol] * r;
            zc = gate * (y + k.hy_bias[(size_t)jl * 2048 + n * 1024 + ch] * zc);
        }
        U[(size_t)(b * 256 + t) * 1024 + ch] = f2bf(zc);
        __syncthreads();
    }
}
PF void hy_transpose(const KC& k, LAS bf16_t* lds) {
    const int tid = TID();
    const bf16_t* ZT = (const bf16_t*)(k.ws + AR_ZT);
    bf16_t* U = (bf16_t*)(k.ws + AR_UBUF);
    for (int u = blockIdx.x; u < 16 * (TL / 64); u += gridDim.x) {
        const int c0 = (u & 15) * 64, r0 = TC + (u >> 4) * 64;
        { const int c = tid >> 3, sg = (tid & 7) * 8;
          const u32x4 v = *(const u32x4*)(ZT + (size_t)(c0 + c) * T + r0 + sg);
#pragma unroll
          for (int w = 0; w < 4; ++w) { lds[(sg + 2 * w) * 66 + c] = (bf16_t)(v[w] & 0xffff); lds[(sg + 2 * w + 1) * 66 + c] = (bf16_t)(v[w] >> 16); } }
        __syncthreads();
        { const int r = tid >> 3, sg = (tid & 7) * 8; u32x4 o;
#pragma unroll
          for (int w = 0; w < 4; ++w) o[w] = (unsigned)lds[r * 66 + sg + 2 * w] | ((unsigned)lds[r * 66 + sg + 2 * w + 1] << 16);
          *(u32x4*)(U + (size_t)(r0 + r) * 1024 + c0 + sg) = o; }
        __syncthreads();
    }
}

__global__ void __launch_bounds__(NTHR, 2) fwd_kernel(Params prm) {
    extern __shared__ __attribute__((aligned(16))) unsigned char lds_raw[];
    LAS unsigned char* lds = (LAS unsigned char*)lds_raw;
    LAS float* ldsf = (LAS float*)lds;
    LAS bf16_t* ldsh = (LAS bf16_t*)lds;
    LAS int* tb = (LAS int*)(lds + 150 * 1024);
    volatile LAS unsigned* xbw = (volatile LAS unsigned*)(lds + 151 * 1024 + 512);
    KC k;
    k.x = (const float*)(GAS const float*)prm.in[0]; k.c = (const float*)(GAS const float*)prm.in[1]; k.ctx = (const float*)(GAS const float*)prm.in[2]; k.c_ctx = (const float*)(GAS const float*)prm.in[3]; k.ada_w = (const float*)(GAS const float*)prm.in[4]; k.ada_b = (const float*)(GAS const float*)prm.in[5];
    k.norm_mix = (const float*)(GAS const float*)prm.in[6]; k.norm_ffn = (const float*)(GAS const float*)prm.in[7]; k.norm_final = (const float*)(GAS const float*)prm.in[8];
    k.dn_w_in = (const float*)(GAS const float*)prm.in[9]; k.dn_conv = (const float*)(GAS const float*)prm.in[10]; k.dn_a_log = (const float*)(GAS const float*)prm.in[11]; k.dn_dt_bias = (const float*)(GAS const float*)prm.in[12]; k.dn_out_norm = (const float*)(GAS const float*)prm.in[13]; k.dn_w_out = (const float*)(GAS const float*)prm.in[14];
    k.hy_w_in = (const float*)(GAS const float*)prm.in[15]; k.hy_conv = (const float*)(GAS const float*)prm.in[16]; k.hy_f_w1 = (const float*)(GAS const float*)prm.in[17]; k.hy_f_b1 = (const float*)(GAS const float*)prm.in[18]; k.hy_f_freq = (const float*)(GAS const float*)prm.in[19]; k.hy_f_w2 = (const float*)(GAS const float*)prm.in[20];
    k.hy_f_b2 = (const float*)(GAS const float*)prm.in[21]; k.hy_f_w3 = (const float*)(GAS const float*)prm.in[22]; k.hy_bias = (const float*)(GAS const float*)prm.in[23]; k.hy_w_out = (const float*)(GAS const float*)prm.in[24];
    k.sc_w_in = (const float*)(GAS const float*)prm.in[25]; k.sc_conv = (const float*)(GAS const float*)prm.in[26]; k.sc_w_out = (const float*)(GAS const float*)prm.in[27]; k.w_router = (const float*)(GAS const float*)prm.in[28]; k.router_bias = (const float*)(GAS const float*)prm.in[29];
    k.moe_w_gate = (const float*)(GAS const float*)prm.in[30]; k.moe_w_up = (const float*)(GAS const float*)prm.in[31]; k.moe_w_down = (const float*)(GAS const float*)prm.in[32];
    k.out = (float*)(GAS float*)prm.out; k.ws = (unsigned char*)(GAS unsigned char*)prm.ws;
    const int lo = prm.ph_lo, hi = prm.ph_hi;
    XcdBarrier bar; bar.bar = (unsigned*)(k.ws + WS_CTL); bar.x = 0; bar.st = xbw;
    if (hi - lo > 1) {
        if (threadIdx.x == 0) { xbw[0] = 0u; xbw[1] = 0u; }
        __syncthreads();
        bar = xcd_barrier_post((unsigned*)(k.ws + WS_CTL), xbw);
    }
    int ph = 0;
#define PROBE_OK(id) ((id) != 1 || i == 0)
    int i = 0;
#define PH_BEGIN(id) if (ph >= lo && ph < hi) { const int nrep_ = (((id) == PROBE_REP) && PROBE_OK(id)) ? 2 : 1; for (int rep_ = 0; rep_ < nrep_; ++rep_) { { GAS unsigned char* w_ = (GAS unsigned char*)k.ws; asm volatile("" : "+s"(w_)); k.ws = (unsigned char*)w_; }
#define PH_END   if (ph + 1 < hi) xcd_barrier(bar); } } ++ph;

    float* xs = (float*)(k.ws + WS_XS);
    const float* mod = (const float*)(k.ws + WS_MOD);

    PH_BEGIN(0)
        job_mod(k, ldsf);
        job_cvt_small(k, ldsf);
        job_hdn(k, ldsf);
        job_w3s(k);
    PH_END

    for (i = 0; i < DEPTH; ++i) {
        const int kind = i % 3, j = i / 3;
        const bool last = (i == DEPTH - 1);
        PH_BEGIN(1)
            if (kind == 0) norm_mfma<2>(k, i, i == 0, i > 0, k.norm_mix + i * 1024, 0, k.dn_w_in + (size_t)j * 1024 * DN_IN + 4096, DN_IN,
                                        k.dn_a_log + j * 16, k.dn_dt_bias + j * 16, last, lds);
            else norm_vec<0>(k, i, k.norm_mix + i * 1024, 0);
            if (kind == 1) job_filtc(k, j);
        PH_END
        PH_BEGIN(2)
            if (kind == 0) { EpiBf16 e{(bf16_t*)(k.ws + AR_PB), 3072, 3072, (bf16_t*)k.out, 1024}; gemm_dense(lds, (const bf16_t*)(k.ws + AR_HBUF), T, (const bf16_t*)(k.ws + WS_DNWIN) + (size_t)j * 4096 * 1024, 4096, 1024, e); }
            else if (kind == 1) { EpiBf16T e{(bf16_t*)(k.ws + AR_PB), T}; gemm_dense(lds, (const bf16_t*)(k.ws + AR_HBUF), T, (const bf16_t*)(k.ws + WS_HYWIN), 3072, 1024, e);
                                  EpiTaps et{(bf16_t*)(k.ws + AR_FT)}; gemm_dense(lds, (const bf16_t*)(k.ws + WS_W3S), 4096, (const bf16_t*)(k.ws + WS_HS), 16384, 256, et); }
            else { EpiBf16 e{(bf16_t*)(k.ws + AR_PB), 3072, 1 << 30, nullptr, 0}; gemm_dense(lds, (const bf16_t*)(k.ws + AR_HBUF), T, (const bf16_t*)(k.ws + WS_SCWIN), 3072, 1024, e); }
        PH_END
        if (kind == 0) {
            PH_BEGIN(3) dn_chunk(k, j, lds); PH_END
            PH_BEGIN(4) dn_scan(k, lds, rep_ ? PROBE_MODE : 0); PH_END
            PH_BEGIN(5) dn_finish(k, j); PH_END
        } else if (kind == 1) {
            PH_BEGIN(6) hy_lat(k, j, ldsf); hy_ctx(k, j, ldsf); PH_END
            PH_BEGIN(7) hy_transpose(k, ldsh); PH_END
        } else {
            PH_BEGIN(8) sc_mix(k, j); PH_END
        }
        PH_BEGIN(9)
            const bf16_t* Wt = kind == 0 ? (const bf16_t*)(k.ws + WS_DNWOUT) + (size_t)j * 1024 * 1024 : (kind == 1 ? (const bf16_t*)(k.ws + WS_HYWOUT) : (const bf16_t*)(k.ws + WS_SCWOUT));
            EpiResid e{xs, mod, i, 2};
            gemm_dense(lds, (const bf16_t*)(k.ws + AR_UBUF), T, Wt, 1024, 1024, e);
            if (gridDim.x == 256) job_cvt_moe(k, i, ldsf, (int)blockIdx.x - 8, 248); else job_cvt_moe(k, i, ldsf, (int)blockIdx.x, (int)gridDim.x);
        PH_END
        PH_BEGIN(10)
            norm_mfma<1>(k, i, false, false, k.norm_ffn + i * 1024, 3, k.w_router, 32, k.router_bias, nullptr, last, lds, rep_ == nrep_ - 1);
        PH_END
        PH_BEGIN(11)
            moe_scatter(k, i, tb);
        PH_END
        PH_BEGIN(12) moe_gemm<0>(k, i, lds, tb); PH_END
        PH_BEGIN(13) moe_gemm<1>(k, i, lds, tb); PH_END
    }
    PH_BEGIN(14)
        norm_vec<3>(k, DEPTH, k.norm_final, 0);
    PH_END
#undef PH_BEGIN
#undef PH_END
}
constexpr int N_PHASES = 1 + (10 + 9 + 8 + 10) + 1;

extern "C" void kernel_launch(void* const* d_in, const int* in_sizes, int n_in, void* d_out, int out_size, void* d_ws, size_t ws_size, hipStream_t stream) {
    static int grid = 0;
    if (grid == 0) {
        if (n_in != 33 || out_size != TL * D || ws_size < WS_END) { fprintf(stderr, "kernel_launch: unexpected shapes: n_in %d out %d ws %zu (need %zu)\n", n_in, out_size, ws_size, (size_t)WS_END); grid = -1; return; }
        int dev = 0, cus = 0, per_cu = 0;
        if (hipGetDevice(&dev) != hipSuccess || hipDeviceGetAttribute(&cus, hipDeviceAttributeMultiprocessorCount, dev) != hipSuccess) { grid = -1; return; }
        if (hipFuncSetAttribute((const void*)fwd_kernel, hipFuncAttributeMaxDynamicSharedMemorySize, LDS_BYTES) != hipSuccess) { fprintf(stderr, "kernel_launch: hipFuncSetAttribute failed\n"); grid = -1; return; }
        if (hipOccupancyMaxActiveBlocksPerMultiprocessor(&per_cu, (const void*)fwd_kernel, NTHR, LDS_BYTES) != hipSuccess || per_cu < 1) fprintf(stderr, "kernel_launch: occupancy query reports %d\n", per_cu);
        (void)hipGetLastError();
        grid = cus;
    }
    if (grid < 0) return;
    (void)hipMemsetAsync((char*)d_ws + WS_CTL, 0, CTL_BYTES, stream);
    Params p{};
    for (int i = 0; i < 33; ++i) p.in[i] = (const float*)d_in[i];
    p.out = (float*)d_out; p.ws = (unsigned char*)d_ws;
#if MK_MULTI
    for (int ph = 0; ph < N_PHASES; ++ph) { p.ph_lo = ph; p.ph_hi = ph + 1; hipLaunchKernelGGL(fwd_kernel, dim3(grid), dim3(NTHR), LDS_BYTES, stream, p); }
#else
    p.ph_lo = 0; p.ph_hi = N_PHASES;
    hipLaunchKernelGGL(fwd_kernel, dim3(grid), dim3(NTHR), LDS_BYTES, stream, p);
#endif
}
```

```cpp
#include <hip/hip_runtime.h>
#include <stdint.h>
#include <stdio.h>
#include <math.h>

#ifndef MK_MULTI
#define MK_MULTI 0
#endif

#ifndef PROBE_SUB
#define PROBE_SUB (0)
#endif
#ifndef PROBE_MODE
#define PROBE_MODE (1)
#endif
#ifndef PROBE_REP
#define PROBE_REP (-1)
#endif
#define LAS __attribute__((address_space(3)))
#define GAS __attribute__((address_space(1)))
#define HD __host__ __device__ __forceinline__
#define DI __device__ __forceinline__
#ifdef NOINL
#define PF __device__ __noinline__
#else
#define PF __device__ __forceinline__
#endif
typedef unsigned short bf16_t;
typedef short bf16x8 __attribute__((ext_vector_type(8)));
typedef float f32x4 __attribute__((ext_vector_type(4)));
typedef unsigned u32x4 __attribute__((ext_vector_type(4)));
typedef unsigned u32x2 __attribute__((ext_vector_type(2)));

constexpr int D = 1024, NB = 2, SEQ = 16384, CTXL = 256, DEPTH = 4;
constexpr int TC = NB * CTXL, TL = NB * SEQ, T = TC + TL, NA = 2 * T;
constexpr int NTHR = 512;
constexpr int DN_IN = 4128;
constexpr float EPS = 1e-6f;
constexpr int LDS_BYTES = 152 * 1024;

constexpr size_t AL(size_t x) { return (x + 255) & ~(size_t)255; }
constexpr size_t WS_CTL = 0;
constexpr size_t CTL_BYTES = 65536;
constexpr size_t CTL_CNT = 16384;
constexpr size_t WS_MOD = WS_CTL + CTL_BYTES;
constexpr size_t WS_HS = AL(WS_MOD + 4 * 3 * 6144 * 4);
constexpr size_t WS_W3S = AL(WS_HS + 16384 * 256 * 2);
constexpr size_t WS_HDNC = AL(WS_W3S + 4096 * 256 * 2);
constexpr size_t WS_FILTC = AL(WS_HDNC + 256 * 64 * 4);
constexpr size_t WS_DNWIN = AL(WS_FILTC + 256 * 4096 * 4);
constexpr size_t WS_DNWOUT = AL(WS_DNWIN + (size_t)2 * 4096 * 1024 * 2);
constexpr size_t WS_HYWIN = AL(WS_DNWOUT + (size_t)2 * 1024 * 1024 * 2);
constexpr size_t WS_HYWOUT = AL(WS_HYWIN + (size_t)3072 * 1024 * 2);
constexpr size_t WS_SCWIN = AL(WS_HYWOUT + (size_t)1024 * 1024 * 2);
constexpr size_t WS_SCWOUT = AL(WS_SCWIN + (size_t)3072 * 1024 * 2);
constexpr size_t WS_XS = AL(WS_SCWOUT + (size_t)1024 * 1024 * 2);
constexpr size_t WS_TOKE = AL(WS_XS + (size_t)T * 1024 * 4);
constexpr size_t WS_TOKW = AL(WS_TOKE + (size_t)T * 2 * 4);
constexpr size_t WS_TOKP = AL(WS_TOKW + (size_t)T * 2 * 4);
constexpr size_t WS_SLOT = AL(WS_TOKP + (size_t)T * 2 * 4);
constexpr size_t WS_GB = AL(WS_SLOT + (size_t)(NA + 256) * 4);
constexpr size_t WS_EGL = AL(WS_GB + (size_t)T * 32 * 4);
constexpr size_t WS_AR = AL(WS_EGL + (size_t)32 * 260 * 4);
constexpr size_t AR_HBUF = WS_AR;
constexpr size_t AR_UBUF = AR_HBUF + (size_t)T * 1024 * 2;
constexpr size_t AR_PB = AR_UBUF + (size_t)T * 1024 * 2;
constexpr size_t AR_Q = AR_PB + (size_t)T * 4096 * 2;
constexpr size_t AR_CHUNK = AR_PB + (size_t)T * 3072 * 2;
constexpr size_t AR_DN_END = AR_CHUNK + (size_t)32 * 260 * 65536;
constexpr size_t AR_ZT = AR_Q;
constexpr size_t AR_FFTS = AR_ZT + (size_t)1024 * T * 2;
constexpr size_t AR_FT = AR_FFTS + (size_t)256 * 4 * 16384 * 8;
constexpr size_t AR_HY_END = AR_FT + (size_t)4096 * 16384 * 4;
constexpr size_t AR_HID = AR_PB;
constexpr size_t AR_YS = AR_HID + (size_t)NA * 512 * 2;
constexpr size_t AR_WGU = AR_YS + (size_t)NA * 1024 * 2;
constexpr size_t AR_WD = AR_WGU + (size_t)32 * 1024 * 1024 * 2;
constexpr size_t AR_MOE_END = AR_WD + (size_t)32 * 1024 * 512 * 2;
constexpr size_t WS_END = AR_DN_END > AR_HY_END ? (AR_DN_END > AR_MOE_END ? AR_DN_END : AR_MOE_END) : (AR_HY_END > AR_MOE_END ? AR_HY_END : AR_MOE_END);

#define XB_TMO      128
#define XB_XCNT(j)  (256  + 64 * (j))
#define XB_XSUB(j)  (1280 + 64 * (j))
#define XB_XGEN(j)  (2304 + 64 * (j))
#define XB_TOP      3328
#define XB_TOPGEN   3392
#define XCD_BAR_WORDS 3456
#define XB_SPIN_CAP (1u << 25)
DI unsigned xb_ld(unsigned* p)              { return __hip_atomic_load(p, __ATOMIC_RELAXED, __HIP_MEMORY_SCOPE_AGENT); }
DI unsigned xb_add(unsigned* p, unsigned v) { return __hip_atomic_fetch_add(p, v, __ATOMIC_RELAXED, __HIP_MEMORY_SCOPE_AGENT); }
DI unsigned xb_xcc_id() { return (unsigned)__builtin_amdgcn_s_getreg((3 << 11) | 20) & 0xFu; }
#define XB_SPIN(cond, bar) do { unsigned _sp = 0; while (cond) { __builtin_amdgcn_s_sleep(1); \
    if ((++_sp & 255u) == 0u) { if (xb_ld(&(bar)[XB_TMO])) break; if (_sp > XB_SPIN_CAP) { atomicAdd(&(bar)[XB_TMO], 1u); break; } } } } while (0)
struct XcdBarrier { unsigned* bar; unsigned x; volatile LAS unsigned* st; };
DI XcdBarrier xcd_barrier_post(unsigned* bar, volatile LAS unsigned* st) {
    XcdBarrier b; b.bar = bar; b.x = xb_xcc_id(); b.st = st;
    if (threadIdx.x == 0) (void)xb_add(&bar[XB_XCNT(b.x)], 1u);
    return b;
}
DI void xcd_barrier_complete(unsigned* bar, unsigned x, unsigned& nloc, unsigned& nx) {
    const unsigned G = gridDim.x * gridDim.y * gridDim.z;
    unsigned sum, cnt, mine, sp = 0u;
    for (;;) {
        sum = 0u; cnt = 0u; mine = 0u;
#pragma unroll
        for (unsigned j = 0; j < 16; ++j) { const unsigned c = xb_ld(&bar[XB_XCNT(j)]); sum += c; cnt += (c > 0u) ? 1u : 0u; mine = (j == x) ? c : mine; }
        if (sum == G) break;
        __builtin_amdgcn_s_sleep(1);
        if ((++sp & 255u) == 0u) { if (xb_ld(&bar[XB_TMO])) break; if (sp > XB_SPIN_CAP) { atomicAdd(&bar[XB_TMO], 1u); break; } }
    }
    nloc = mine > 0u ? mine : 1u; nx = cnt > 0u ? cnt : 1u;
}
DI void xcd_barrier(const XcdBarrier& b) {
    asm volatile("s_waitcnt vmcnt(0)" ::: "memory");
    __syncthreads();
    if (threadIdx.x == 0) {
        unsigned* bar = b.bar;
        __builtin_amdgcn_s_waitcnt(0);
        unsigned nloc = b.st[0], nx = b.st[1];
        if (nloc == 0u) { xcd_barrier_complete(bar, b.x, nloc, nx); b.st[0] = nloc; b.st[1] = nx; }
        const unsigned old = xb_add(&bar[XB_XSUB(b.x)], 1u);
        const unsigned gen = old / nloc;
        if (old + 1u == (gen + 1u) * nloc) {
            __builtin_amdgcn_fence(__ATOMIC_RELEASE, "agent");
            asm volatile("s_waitcnt vmcnt(0)" ::: "memory");
            const unsigned og = xb_add(&bar[XB_TOP], 1u);
            const unsigned tg = og / nx;
            if (og + 1u == (tg + 1u) * nx) xb_add(&bar[XB_TOPGEN], 1u);
            else XB_SPIN(xb_ld(&bar[XB_TOPGEN]) == tg, bar);
            __builtin_amdgcn_fence(__ATOMIC_ACQUIRE, "agent");
            xb_add(&bar[XB_XGEN(b.x)], 1u);
            asm volatile("s_waitcnt vmcnt(0)" ::: "memory");
        } else {
            XB_SPIN(xb_ld(&bar[XB_XGEN(b.x)]) == gen, bar);
            __builtin_amdgcn_fence(__ATOMIC_ACQUIRE, "agent");
            asm volatile("s_waitcnt vmcnt(0)" ::: "memory");
        }
    }
    __syncthreads();
}

typedef float f32x2_t __attribute__((ext_vector_type(2)));
typedef __bf16 bf16x2_t __attribute__((ext_vector_type(2)));
DI unsigned cvt_pk_bf16(float lo, float hi) { f32x2_t v; v.x = lo; v.y = hi; const bf16x2_t b = __builtin_convertvector(v, bf16x2_t); return __builtin_bit_cast(unsigned, b); }
DI bf16_t f2bf(float f) { return (bf16_t)(cvt_pk_bf16(f, f) & 0xffffu); }
DI float bf2f(bf16_t b) { return __uint_as_float(((unsigned)b) << 16); }
DI unsigned pk2(float lo, float hi) { return cvt_pk_bf16(lo, hi); }
DI float siluf(float x) { return x * __builtin_amdgcn_rcpf(1.0f + __expf(-x)); }
DI float sigmf(float x) { return 1.0f / (1.0f + __expf(-x)); }
DI float shi(float v, int src) { return __int_as_float(__builtin_amdgcn_ds_bpermute(src << 2, __float_as_int(v))); }
DI int shii(int v, int src) { return __builtin_amdgcn_ds_bpermute(src << 2, v); }
DI float shx(float v, int m, int lane) { return shi(v, lane ^ m); }
DI float wsum(float v, int lane) {
#pragma unroll
    for (int m = 32; m >= 1; m >>= 1) v += shx(v, m, lane);
    return v;
}
DI void lds_barrier() { asm volatile("s_waitcnt lgkmcnt(0)\n\ts_barrier" ::: "memory"); }
DI int TID() { int t = threadIdx.x; asm volatile("" : "+v"(t)); return t; }
DI int modrow(int r) { return r < TC ? 0 : 1 + (r - TC) / SEQ; }

typedef float cf __attribute__((ext_vector_type(2)));
HD cf cmul(cf a, cf b) { cf r; r.x = a.x * b.x - a.y * b.y; r.y = a.x * b.y + a.y * b.x; return r; }
HD cf cadd(cf a, cf b) { cf r; r.x = a.x + b.x; r.y = a.y + b.y; return r; }
HD cf csub(cf a, cf b) { cf r; r.x = a.x - b.x; r.y = a.y - b.y; return r; }
template <int R> HD constexpr int brev(int i) { int r = 0; for (int b = 1, t = R >> 1; b < R; b <<= 1, t >>= 1) if (i & b) r |= t; return r; }
#define FFT_C32 {1.0f, 0.98078528040323044913f, 0.92387953251128675613f, 0.83146961230254523708f, 0.70710678118654752440f, 0.55557023301960222474f, 0.38268343236508977173f, 0.19509032201612826785f, 0.0f, -0.19509032201612826785f, -0.38268343236508977173f, -0.55557023301960222474f, -0.70710678118654752440f, -0.83146961230254523708f, -0.92387953251128675613f, -0.98078528040323044913f}
#define FFT_S32 {0.0f, 0.19509032201612826785f, 0.38268343236508977173f, 0.55557023301960222474f, 0.70710678118654752440f, 0.83146961230254523708f, 0.92387953251128675613f, 0.98078528040323044913f, 1.0f, 0.98078528040323044913f, 0.92387953251128675613f, 0.83146961230254523708f, 0.70710678118654752440f, 0.55557023301960222474f, 0.38268343236508977173f, 0.19509032201612826785f}
template <int R> HD constexpr int ilog2c() { int l = 0; for (int r = R; r > 1; r >>= 1) ++l; return l; }
template <int R> HD void dft_fwd(cf (&v)[R]) {
    constexpr float C[16] = FFT_C32; constexpr float S[16] = FFT_S32;
    constexpr int LG = ilog2c<R>();
#pragma unroll
    for (int st = 0; st < LG; ++st) {
#pragma unroll
        for (int i = 0; i < R / 2; ++i) {
            const int len = R >> st, half = len >> 1, blk = i / half, j = i % half, i0 = blk * len + j, i1 = i0 + half;
            const cf a = v[i0], c = v[i1];
            v[i0] = cadd(a, c);
            const cf d = csub(a, c);
            const int ti = j * (32 / len);
            cf w; w.x = C[ti]; w.y = -S[ti];
            cf r;
            if (ti == 0) r = d;
            else if (ti == 8) { r.x = d.y; r.y = -d.x; }
            else if (ti == 4) { r.x = (d.x + d.y) * 0.70710678118654752440f; r.y = (d.y - d.x) * 0.70710678118654752440f; }
            else if (ti == 12) { r.x = (d.y - d.x) * 0.70710678118654752440f; r.y = -(d.x + d.y) * 0.70710678118654752440f; }
            else r = cmul(d, w);
            v[i1] = r;
        }
    }
}
template <int R> HD void dft_inv(cf (&v)[R]) {
    constexpr float C[16] = FFT_C32; constexpr float S[16] = FFT_S32;
    constexpr int LG = ilog2c<R>();
#pragma unroll
    for (int st = LG - 1; st >= 0; --st) {
#pragma unroll
        for (int i = 0; i < R / 2; ++i) {
            const int len = R >> st, half = len >> 1, blk = i / half, j = i % half, i0 = blk * len + j, i1 = i0 + half;
            const int ti = j * (32 / len);
            cf w; w.x = C[ti]; w.y = S[ti];
            const cf a = v[i0];
            const cf b1 = v[i1];
            cf c;
            if (ti == 0) c = b1;
            else if (ti == 8) { c.x = -b1.y; c.y = b1.x; }
            else if (ti == 4) { c.x = (b1.x - b1.y) * 0.70710678118654752440f; c.y = (b1.x + b1.y) * 0.70710678118654752440f; }
            else if (ti == 12) { c.x = -(b1.x + b1.y) * 0.70710678118654752440f; c.y = (b1.x - b1.y) * 0.70710678118654752440f; }
            else c = cmul(b1, w);
            v[i0] = cadd(a, c);
            v[i1] = csub(a, c);
        }
    }
}
#define PIDX(a) ((a) + (((a) >> 6) << 2))
template <int R> DI void fft_pass_fwd(LAS cf* X, const LAS cf* tw, int n, int g) {
    const int s = n / R, q = g / s, p = g - q * s, base = q * n + p;
    cf v[R];
#pragma unroll
    for (int k = 0; k < R; ++k) v[k] = X[PIDX(base + k * s)];
    dft_fwd<R>(v);
    if (s > 1) {
        int pp = p * (16384 / n); asm volatile("" : "+v"(pp));
        const cf w1 = tw[pp]; cf w = w1;
#pragma unroll
        for (int m = 1; m < R; ++m) { v[brev<R>(m)] = cmul(v[brev<R>(m)], w); w = cmul(w, w1); }
    }
#pragma unroll
    for (int k = 0; k < R; ++k) X[PIDX(base + k * s)] = v[k];
}
template <int R> DI void fft_pass_inv(LAS cf* X, const LAS cf* tw, int n, int g) {
    const int s = n / R, q = g / s, p = g - q * s, base = q * n + p;
    cf v[R];
#pragma unroll
    for (int k = 0; k < R; ++k) v[k] = X[PIDX(base + k * s)];
    if (s > 1) {
        int pp = p * (16384 / n); asm volatile("" : "+v"(pp));
        cf w1 = tw[pp]; w1.y = -w1.y; cf w = w1;
#pragma unroll
        for (int m = 1; m < R; ++m) { v[brev<R>(m)] = cmul(v[brev<R>(m)], w); w = cmul(w, w1); }
    }
    dft_inv<R>(v);
#pragma unroll
    for (int k = 0; k < R; ++k) X[PIDX(base + k * s)] = v[k];
}
DI void fft16k_fwd(LAS cf* X, const LAS cf* tw) {
    const int t = TID();
#pragma unroll 1
    for (int g = 0; g < 2; ++g) fft_pass_fwd<16>(X, tw, 16384, t + 512 * g);
    __syncthreads();
#pragma unroll 1
    for (int g = 0; g < 2; ++g) fft_pass_fwd<16>(X, tw, 1024, t + 512 * g);
    __syncthreads();
#pragma unroll 1
    for (int g = 0; g < 2; ++g) fft_pass_fwd<16>(X, tw, 64, t + 512 * g);
    __syncthreads();
#pragma unroll 1
    for (int g = 0; g < 8; ++g) fft_pass_fwd<4>(X, tw, 4, t + 512 * g);
    __syncthreads();
}
DI void fft16k_inv(LAS cf* X, const LAS cf* tw) {
    const int t = TID();
#pragma unroll 1
    for (int g = 0; g < 8; ++g) fft_pass_inv<4>(X, tw, 4, t + 512 * g);
    __syncthreads();
#pragma unroll 1
    for (int g = 0; g < 2; ++g) fft_pass_inv<16>(X, tw, 64, t + 512 * g);
    __syncthreads();
#pragma unroll 1
    for (int g = 0; g < 2; ++g) fft_pass_inv<16>(X, tw, 1024, t + 512 * g);
    __syncthreads();
#pragma unroll 1
    for (int g = 0; g < 2; ++g) fft_pass_inv<16>(X, tw, 16384, t + 512 * g);
    __syncthreads();
}

struct Params { const float* in[33]; float* out; unsigned char* ws; int ph_lo, ph_hi; };
struct KC {
    const float *x, *c, *ctx, *c_ctx, *ada_w, *ada_b, *norm_mix, *norm_ffn, *norm_final;
    const float *dn_w_in, *dn_conv, *dn_a_log, *dn_dt_bias, *dn_out_norm, *dn_w_out;
    const float *hy_w_in, *hy_conv, *hy_f_w1, *hy_f_b1, *hy_f_freq, *hy_f_w2, *hy_f_b2, *hy_f_w3, *hy_bias, *hy_w_out;
    const float *sc_w_in, *sc_conv, *sc_w_out, *w_router, *router_bias, *moe_w_gate, *moe_w_up, *moe_w_down;
    float* out; unsigned char* ws;
};

PF void job_mod(const KC& k, LAS float* lds) {
    const int tid = TID(), cj = tid & 63, kq = tid >> 6;
    float* mod = (float*)(k.ws + WS_MOD);
    LAS float* sl = lds + 2048;
    for (int i = tid; i < 3072; i += NTHR) { const float v = i < 1024 ? k.c_ctx[i] : k.c[i - 1024]; sl[i] = siluf(v); }
    __syncthreads();
    for (int u = blockIdx.x; u < DEPTH * 96; u += gridDim.x) {
        const int l = u / 96, cc = u % 96, col = cc * 64 + cj;
        const float* W = k.ada_w + (size_t)l * 1024 * 6144 + col;
        float a0 = 0.f, a1 = 0.f, a2 = 0.f;
        for (int k0 = kq * 128; k0 < kq * 128 + 128; k0 += 16) {
            float w[16];
#pragma unroll
            for (int e = 0; e < 16; ++e) w[e] = W[(size_t)(k0 + e) * 6144];
            asm volatile("" ::: "memory");
#pragma unroll
            for (int e = 0; e < 16; ++e) { a0 += sl[k0 + e] * w[e]; a1 += sl[1024 + k0 + e] * w[e]; a2 += sl[2048 + k0 + e] * w[e]; }
        }
        lds[(kq * 3 + 0) * 64 + cj] = a0; lds[(kq * 3 + 1) * 64 + cj] = a1; lds[(kq * 3 + 2) * 64 + cj] = a2;
        __syncthreads();
        if (tid < 192) {
            const int r = tid >> 6, j = tid & 63;
            float sacc = 0.f;
            for (int q = 0; q < 8; ++q) sacc += lds[(q * 3 + r) * 64 + j];
            mod[(size_t)(l * 3 + r) * 6144 + cc * 64 + j] = sacc + k.ada_b[l * 6144 + cc * 64 + j];
        }
        __syncthreads();
    }
}
DI void cvt_matrix(const float* src, int ld, size_t sstride, int K, int N, int nmat, bf16_t* dst, int ldd, size_t dstride, int mapmode, LAS float* lds, int bid, int nb) {
    const int tk = K / 64, tn = N / 64, per = tk * tn, tid = TID();
    const int r = tid >> 4, c4 = (tid & 15) * 4;
    f32x4 v0, v1;
    int u = bid;
    if (u < per * nmat) { const int m = u / per, t = u % per; const float* sp = src + (size_t)m * sstride + (size_t)((t / tn) * 64 + r) * ld + (t % tn) * 64 + c4; v0 = *(const f32x4*)sp; v1 = *(const f32x4*)(sp + (size_t)32 * ld); }
    for (; u < per * nmat; u += nb) {
        const int m = u / per, t = u % per, k0 = (t / tn) * 64, n0 = (t % tn) * 64;
        { LAS float* p = lds + r * 65 + c4; p[0] = v0[0]; p[1] = v0[1]; p[2] = v0[2]; p[3] = v0[3];
          LAS float* p2 = lds + (r + 32) * 65 + c4; p2[0] = v1[0]; p2[1] = v1[1]; p2[2] = v1[2]; p2[3] = v1[3]; }
        { const int un = u + nb;
          if (un < per * nmat) { const int mn = un / per, tn_ = un % per; const float* sp = src + (size_t)mn * sstride + (size_t)((tn_ / tn) * 64 + r) * ld + (tn_ % tn) * 64 + c4; v0 = *(const f32x4*)sp; v1 = *(const f32x4*)(sp + (size_t)32 * ld); } }
        lds_barrier();
        { const int nn = tid >> 3, ks = (tid & 7) * 8; const int n = n0 + nn;
          const int row = mapmode == 0 ? n : (32 * (n >> 4) + (n & 15) + (mapmode == 2 ? 16 : 0));
          float f[8];
#pragma unroll
          for (int e = 0; e < 8; ++e) f[e] = lds[(ks + e) * 65 + nn];
          u32x4 o; o[0] = pk2(f[0], f[1]); o[1] = pk2(f[2], f[3]); o[2] = pk2(f[4], f[5]); o[3] = pk2(f[6], f[7]);
          *(u32x4*)(dst + (size_t)m * dstride + (size_t)row * ldd + k0 + ks) = o; }
        lds_barrier();
    }
}
PF void job_cvt_small(const KC& k, LAS float* lds) {
    cvt_matrix(k.dn_w_in, DN_IN, (size_t)1024 * DN_IN, 1024, 4096, 2, (bf16_t*)(k.ws + WS_DNWIN), 1024, (size_t)4096 * 1024, 0, lds, (int)blockIdx.x, (int)gridDim.x);
    cvt_matrix(k.dn_w_out, 1024, (size_t)1024 * 1024, 1024, 1024, 2, (bf16_t*)(k.ws + WS_DNWOUT), 1024, (size_t)1024 * 1024, 0, lds, (int)blockIdx.x, (int)gridDim.x);
    cvt_matrix(k.hy_w_in, 3072, 0, 1024, 3072, 1, (bf16_t*)(k.ws + WS_HYWIN), 1024, 0, 0, lds, (int)blockIdx.x, (int)gridDim.x);
    cvt_matrix(k.hy_w_out, 1024, 0, 1024, 1024, 1, (bf16_t*)(k.ws + WS_HYWOUT), 1024, 0, 0, lds, (int)blockIdx.x, (int)gridDim.x);
    cvt_matrix(k.sc_w_in, 3072, 0, 1024, 3072, 1, (bf16_t*)(k.ws + WS_SCWIN), 1024, 0, 0, lds, (int)blockIdx.x, (int)gridDim.x);
    cvt_matrix(k.sc_w_out, 1024, 0, 1024, 1024, 1, (bf16_t*)(k.ws + WS_SCWOUT), 1024, 0, 0, lds, (int)blockIdx.x, (int)gridDim.x);
}
PF void job_cvt_moe(const KC& k, int layer, LAS float* lds, int bid, int nb) {
    if (bid < 0) return;
    const size_t lo = (size_t)layer * 32 * 1024 * 512;
    cvt_matrix(k.moe_w_gate + lo, 512, (size_t)1024 * 512, 1024, 512, 32, (bf16_t*)(k.ws + AR_WGU), 1024, (size_t)1024 * 1024, 1, lds, bid, nb);
    cvt_matrix(k.moe_w_up + lo, 512, (size_t)1024 * 512, 1024, 512, 32, (bf16_t*)(k.ws + AR_WGU), 1024, (size_t)1024 * 1024, 2, lds, bid, nb);
    cvt_matrix(k.moe_w_down + lo, 1024, (size_t)512 * 1024, 512, 1024, 32, (bf16_t*)(k.ws + AR_WD), 512, (size_t)1024 * 512, 0, lds, bid, nb);
}
PF void job_hdn(const KC& k, LAS float* lds) {
    const int tid = TID(), lane = tid & 63, wave = tid >> 6;
    LAS float* feat = lds + wave * 128; LAS float* h1 = feat + 64;
    const float fr = k.hy_f_freq[lane], b1 = k.hy_f_b1[lane], b2 = k.hy_f_b2[lane];
    for (int u0 = blockIdx.x * 8; u0 < 16384 + 256; u0 += gridDim.x * 8) {
        const int u = u0 + wave;
        int l, pos; float* dst;
        if (u < 16384) { l = 16384; pos = u; dst = nullptr; }
        else { l = 256; pos = u - 16384; dst = (float*)(k.ws + WS_HDNC) + (size_t)pos * 64; }
        const float t = (float)pos / (float)(l - 1);
        float f = 0.f;
        if (lane == 0) f = t;
        else if (lane <= 32) {
            const int bi = (lane - 1) & 15;
            const float band = 1e-4f + (float)bi * ((15.0f - 1e-4f) / 15.0f);
            const float ang = (6.283185307179586f / (float)l) * (float)pos * band;
            f = lane <= 16 ? cosf(ang) : -sinf(ang);
        }
        feat[lane] = f;
        __syncthreads();
        float a = b1;
        for (int i = 0; i < 33; ++i) a += feat[i] * k.hy_f_w1[i * 64 + lane];
        h1[lane] = sinf(fr * a);
        __syncthreads();
        float a2 = b2;
        for (int j = 0; j < 64; ++j) a2 += h1[j] * k.hy_f_w2[j * 64 + lane];
        const float hv = sinf(fr * a2);
        if (dst) dst[lane] = hv;
        else { bf16_t* hs = (bf16_t*)(k.ws + WS_HS) + (size_t)pos * 256; const bf16_t hi = f2bf(hv), lo = f2bf(hv - bf2f(hi)); hs[lane] = hi; hs[64 + lane] = lo; hs[128 + lane] = hi; hs[192 + lane] = 0; }
        __syncthreads();
    }
}
PF void job_w3s(const KC& k) {
    bf16_t* W = (bf16_t*)(k.ws + WS_W3S);
    const int tq = TID();
    for (int idx = blockIdx.x * NTHR + tq; idx < 64 * 4096; idx += gridDim.x * NTHR) {
        const int j = idx >> 12, col = idx & 4095;
        const float w = k.hy_f_w3[idx]; const bf16_t hi = f2bf(w), lo = f2bf(w - bf2f(hi));
        W[(size_t)col * 256 + j] = hi; W[(size_t)col * 256 + 64 + j] = hi; W[(size_t)col * 256 + 128 + j] = lo; W[(size_t)col * 256 + 192 + j] = 0;
    }
}
DI float hy_delta(int ch) {
    const float lo = -4.605170185988091f / 1.5f, hi = -4.605170185988091f / 0.3f;
    return fabsf(lo + (float)ch * ((hi - lo) / 1023.0f));
}
PF void job_filtc(const KC& k, int j) {
    const float* hdn = (const float*)(k.ws + WS_HDNC);
    const float* w3 = k.hy_f_w3 + (size_t)j * 64 * 4096;
    float* filtc = (float*)(k.ws + WS_FILTC);
    const int tq = TID();
    for (int u = blockIdx.x; u < 256 * 8; u += gridDim.x) {
        const int l = u >> 3, col = (u & 7) * 512 + tq;
        float a = 0.f;
        for (int q = 0; q < 64; ++q) a += hdn[l * 64 + q] * w3[(size_t)q * 4096 + col];
        const float t = (float)l / 255.0f;
        filtc[(size_t)l * 4096 + col] = a * expf(-t * hy_delta(col & 1023));
    }
}

template <int MODE>
PF void norm_vec(const KC& k, int layer, const float* __restrict__ gain, int mb) {
    const int tid = TID(), lane = tid & 63, wave = tid >> 6;
    float* xs = (float*)(k.ws + WS_XS);
    bf16_t* hbuf = (bf16_t*)(k.ws + AR_HBUF);
    const float* mod = (const float*)(k.ws + WS_MOD);
    const bf16_t* ys = (const bf16_t*)(k.ws + AR_YS);
    const int* tokp = (const int*)(k.ws + WS_TOKP);
    const float* tokw = (const float*)(k.ws + WS_TOKW);
    const int rbeg = (MODE == 3) ? TC : 0, rstr = gridDim.x * 8, c0 = 4 * lane;
    int cur_mr = -1; f32x4 gsv[4], shv[4], g5v[4];
    int r = rbeg + blockIdx.x * 8 + wave;
    if (r >= T) return;
    f32x4 xn[4]; u32x2 yan[4], ybn[4]; float w0n, w1n, w0f, w1f; int p0f, p1f;
    {
        const int p0 = tokp[2 * r], p1 = tokp[2 * r + 1]; w0n = tokw[2 * r]; w1n = tokw[2 * r + 1];
        const int r2 = r + rstr < T ? r + rstr : T - 1;
        p0f = tokp[2 * r2]; p1f = tokp[2 * r2 + 1]; w0f = tokw[2 * r2]; w1f = tokw[2 * r2 + 1];
#pragma unroll
        for (int j = 0; j < 4; ++j) {
            xn[j] = *(const f32x4*)(xs + (size_t)r * 1024 + 256 * j + c0);
            yan[j] = *(const u32x2*)(ys + (size_t)p0 * 1024 + 256 * j + c0); ybn[j] = *(const u32x2*)(ys + (size_t)p1 * 1024 + 256 * j + c0);
        }
    }
    for (; r < T; r += rstr) {
        const int mr = modrow(r);
        f32x4 x[4]; u32x2 ya[4], yb[4];
#pragma unroll
        for (int j = 0; j < 4; ++j) { x[j] = xn[j]; ya[j] = yan[j]; yb[j] = ybn[j]; }
        const float w0 = w0n, w1 = w1n;
        {
            const int rn = r + rstr < T ? r + rstr : T - 1, rf = r + 2 * rstr < T ? r + 2 * rstr : T - 1;
#pragma unroll
            for (int j = 0; j < 4; ++j) {
                xn[j] = *(const f32x4*)(xs + (size_t)rn * 1024 + 256 * j + c0);
                yan[j] = *(const u32x2*)(ys + (size_t)p0f * 1024 + 256 * j + c0); ybn[j] = *(const u32x2*)(ys + (size_t)p1f * 1024 + 256 * j + c0);
            }
            w0n = w0f; w1n = w1f;
            p0f = tokp[2 * rf]; p1f = tokp[2 * rf + 1]; w0f = tokw[2 * rf]; w1f = tokw[2 * rf + 1];
        }
        if (mr != cur_mr) {
            cur_mr = mr;
            const float* shift = mod + ((size_t)(layer * 3 + mr) * 6 + mb) * 1024;
            const float* g5 = mod + ((size_t)((layer - 1) * 3 + mr) * 6 + 5) * 1024;
#pragma unroll
            for (int j = 0; j < 4; ++j) {
                const int col = 256 * j + c0;
                const f32x4 gn = *(const f32x4*)(gain + col);
                if (MODE != 3) { const f32x4 sc = *(const f32x4*)(shift + 1024 + col); shv[j] = *(const f32x4*)(shift + col);
#pragma unroll
                    for (int e = 0; e < 4; ++e) gsv[j][e] = gn[e] * (1.0f + sc[e]); }
                else gsv[j] = gn;
                g5v[j] = *(const f32x4*)(g5 + col);
            }
        }
        float ss = 0.f;
#pragma unroll
        for (int j = 0; j < 4; ++j) {
            const float a0 = __uint_as_float(ya[j][0] << 16), a1 = __uint_as_float(ya[j][0] & 0xffff0000u), a2 = __uint_as_float(ya[j][1] << 16), a3 = __uint_as_float(ya[j][1] & 0xffff0000u);
            const float b0 = __uint_as_float(yb[j][0] << 16), b1 = __uint_as_float(yb[j][0] & 0xffff0000u), b2 = __uint_as_float(yb[j][1] << 16), b3 = __uint_as_float(yb[j][1] & 0xffff0000u);
            x[j][0] += g5v[j][0] * (w0 * a0 + w1 * b0); x[j][1] += g5v[j][1] * (w0 * a1 + w1 * b1);
            x[j][2] += g5v[j][2] * (w0 * a2 + w1 * b2); x[j][3] += g5v[j][3] * (w0 * a3 + w1 * b3);
            if (MODE != 3) *(f32x4*)(xs + (size_t)r * 1024 + 256 * j + c0) = x[j];
            ss += x[j][0] * x[j][0] + x[j][1] * x[j][1] + x[j][2] * x[j][2] + x[j][3] * x[j][3];
        }
        ss = wsum(ss, lane);
        const float rstd = rsqrtf(ss * (1.0f / 1024.0f) + EPS);
#pragma unroll
        for (int j = 0; j < 4; ++j) {
            if (MODE == 3) {
                f32x4 o;
#pragma unroll
                for (int e = 0; e < 4; ++e) o[e] = x[j][e] * rstd * gsv[j][e];
                *(f32x4*)(k.out + (size_t)(r - TC) * 1024 + 256 * j + c0) = o;
            } else {
                u32x2 o;
                o[0] = pk2(x[j][0] * rstd * gsv[j][0] + shv[j][0], x[j][1] * rstd * gsv[j][1] + shv[j][1]);
                o[1] = pk2(x[j][2] * rstd * gsv[j][2] + shv[j][2], x[j][3] * rstd * gsv[j][3] + shv[j][3]);
                *(u32x2*)(hbuf + (size_t)r * 1024 + 256 * j + c0) = o;
            }
        }
    }
}

template <int MODE>
PF void norm_phase(const KC& k, int layer, bool first, bool combine, const float* __restrict__ gain, int mb, const float* __restrict__ Wsk, int ldw,
                   const float* __restrict__ aux0, const float* __restrict__ aux1, bool last, LAS float* lds, bool flush = true) {
    const int tid = TID(), lane = tid & 63, wave = tid >> 6;
    float* xs = (float*)(k.ws + WS_XS);
    bf16_t* hbuf = (bf16_t*)(k.ws + AR_HBUF);
    const float* mod = (const float*)(k.ws + WS_MOD);
    const bf16_t* ys = (const bf16_t*)(k.ws + AR_YS);
    const int* tokp = (const int*)(k.ws + WS_TOKP);
    const float* tokw = (const float*)(k.ws + WS_TOKW);
    LAS int* lcnt = (LAS int*)(lds + 32768);
    if (MODE == 1 && tid < 32) lcnt[tid] = 0;
    if (MODE == 1 || MODE == 2) {
        for (int idx = tid; idx < 1024 * 32; idx += NTHR) {
            const int kk = idx >> 5, n = idx & 31;
            lds[kk * 32 + (((n >> 2) ^ ((kk >> 1) & 7)) << 2) + (n & 3)] = Wsk[(size_t)kk * ldw + n];
        }
        __syncthreads();
    }
    const int rbeg = (MODE == 3) ? TC : 0, rstr = gridDim.x * 8;
    int cur_mr = -1; float gsv[16], shv[16], g5v[16];
    float xn[16];
    int r = rbeg + blockIdx.x * 8 + wave;
    if (r < T) {
        const float* src = first ? (r < TC ? k.ctx + (size_t)r * 1024 : k.x + (size_t)(r - TC) * 1024) : xs + (size_t)r * 1024;
#pragma unroll
        for (int m = 0; m < 16; ++m) xn[m] = src[lane + 64 * m];
    }
    for (; r < T; r += rstr) {
        const int mr = modrow(r);
        float x[16];
#pragma unroll
        for (int m = 0; m < 16; ++m) x[m] = xn[m];
        int p0 = 0, p1 = 0; float w0 = 0.f, w1 = 0.f;
        if (combine) { p0 = tokp[2 * r]; p1 = tokp[2 * r + 1]; w0 = tokw[2 * r]; w1 = tokw[2 * r + 1]; }
        {
            const int rn = r + rstr;
            if (rn < T) {
                const float* srcn = first ? (rn < TC ? k.ctx + (size_t)rn * 1024 : k.x + (size_t)(rn - TC) * 1024) : xs + (size_t)rn * 1024;
#pragma unroll
                for (int m = 0; m < 16; ++m) xn[m] = srcn[lane + 64 * m];
            }
        }
        if (mr != cur_mr) {
            cur_mr = mr;
            if (MODE != 3) {
                const float* shift = mod + ((size_t)(layer * 3 + mr) * 6 + mb) * 1024;
#pragma unroll
                for (int m = 0; m < 16; ++m) { const int col = lane + 64 * m; gsv[m] = gain[col] * (1.0f + shift[1024 + col]); shv[m] = shift[col]; }
            } else {
#pragma unroll
                for (int m = 0; m < 16; ++m) gsv[m] = gain[lane + 64 * m];
            }
            if (combine) {
                const float* g5 = mod + ((size_t)((layer - 1) * 3 + mr) * 6 + 5) * 1024;
#pragma unroll
                for (int m = 0; m < 16; ++m) g5v[m] = g5[lane + 64 * m];
            }
        }
        if (combine) {
            bf16_t ya[16], yb[16];
#pragma unroll
            for (int m = 0; m < 16; ++m) { const int col = lane + 64 * m; ya[m] = ys[(size_t)p0 * 1024 + col]; yb[m] = ys[(size_t)p1 * 1024 + col]; }
            asm volatile("" ::: "memory");
#pragma unroll
            for (int m = 0; m < 16; ++m) x[m] += g5v[m] * (w0 * bf2f(ya[m]) + w1 * bf2f(yb[m]));
        }
        if (first || combine) {
#pragma unroll
            for (int m = 0; m < 16; ++m) xs[(size_t)r * 1024 + lane + 64 * m] = x[m];
        }
        float ss = 0.f;
#pragma unroll
        for (int m = 0; m < 16; ++m) ss += x[m] * x[m];
        ss = wsum(ss, lane);
        const float rstd = rsqrtf(ss * (1.0f / 1024.0f) + EPS);
        if (MODE == 3) {
#pragma unroll
            for (int m = 0; m < 16; ++m) { const int col = lane + 64 * m; k.out[(size_t)(r - TC) * 1024 + col] = x[m] * rstd * gsv[m]; }
            continue;
        }
        float y[16];
#pragma unroll
        for (int m = 0; m < 16; ++m) {
            const int col = lane + 64 * m;
            y[m] = x[m] * rstd * gsv[m] + shv[m];
            hbuf[(size_t)r * 1024 + col] = f2bf(y[m]);
        }
        if (MODE == 1 || MODE == 2) {
            float acc[32];
#pragma unroll
            for (int n = 0; n < 32; ++n) acc[n] = 0.f;
#pragma unroll
            for (int m = 0; m < 16; ++m) {
                f32x4 wa[8];
                const int c = lane + 64 * m; const LAS float* wr = lds + c * 32; const int sw = (c >> 1) & 7;
#pragma unroll
                for (int q = 0; q < 8; ++q) wa[q] = *(const LAS f32x4*)(wr + ((q ^ sw) << 2));
                asm volatile("" ::: "memory");
#pragma unroll
                for (int q = 0; q < 8; ++q) { acc[4 * q + 0] += y[m] * wa[q][0]; acc[4 * q + 1] += y[m] * wa[q][1]; acc[4 * q + 2] += y[m] * wa[q][2]; acc[4 * q + 3] += y[m] * wa[q][3]; }
            }
            float val;
            {
                float a16[16], a8[8], a4[4], a2[2];
                const bool b5 = (lane & 32) != 0, b4 = (lane & 16) != 0, b3 = (lane & 8) != 0, b2 = (lane & 4) != 0, b1 = (lane & 2) != 0;
#pragma unroll
                for (int i = 0; i < 16; ++i) { const float send = b5 ? acc[i] : acc[i + 16], keep = b5 ? acc[i + 16] : acc[i]; a16[i] = keep + shx(send, 32, lane); }
#pragma unroll
                for (int i = 0; i < 8; ++i) { const float send = b4 ? a16[i] : a16[i + 8], keep = b4 ? a16[i + 8] : a16[i]; a8[i] = keep + shx(send, 16, lane); }
#pragma unroll
                for (int i = 0; i < 4; ++i) { const float send = b3 ? a8[i] : a8[i + 4], keep = b3 ? a8[i + 4] : a8[i]; a4[i] = keep + shx(send, 8, lane); }
#pragma unroll
                for (int i = 0; i < 2; ++i) { const float send = b2 ? a4[i] : a4[i + 2], keep = b2 ? a4[i + 2] : a4[i]; a2[i] = keep + shx(send, 4, lane); }
                { const float send = b1 ? a2[0] : a2[1], keep = b1 ? a2[1] : a2[0]; val = keep + shx(send, 2, lane); }
                val += shx(val, 1, lane);
            }
            const int n = lane >> 1;
            if (MODE == 1) {
                int* toke = (int*)(k.ws + WS_TOKE); float* tokwW = (float*)(k.ws + WS_TOKW);
                if (last && r < TC) { if (lane == 0) { int neg = -1; asm volatile("" : "+v"(neg)); toke[2 * r] = neg; toke[2 * r + 1] = neg; } continue; }
                const float sc = 1.0f / (1.0f + expf(-val)), ch = sc + aux0[n];
                const int gl = lane & ~7;
                const float ca = shi(ch, gl), cb = shi(ch, gl + 2), cc = shi(ch, gl + 4), cd = shi(ch, gl + 6);
                const float hi1 = fmaxf(ca, cb), lo1 = fminf(ca, cb), hi2 = fmaxf(cc, cd), lo2 = fminf(cc, cd);
                float gs = fmaxf(hi1, hi2) + fmaxf(fminf(hi1, hi2), fmaxf(lo1, lo2));
                int gi = lane >> 3;
#pragma unroll
                for (int m = 8; m <= 32; m <<= 1) {
                    const float og = shx(gs, m, lane); const int oi = shii(gi, lane ^ m);
                    if (og > gs || (og == gs && oi < gi)) { gs = og; gi = oi; }
                }
                float c4[4], s4[4];
#pragma unroll
                for (int i = 0; i < 4; ++i) { c4[i] = shi(ch, gi * 8 + 2 * i); s4[i] = shi(sc, gi * 8 + 2 * i); }
                int i1 = 0; float b1v = c4[0];
#pragma unroll
                for (int i = 1; i < 4; ++i) if (c4[i] > b1v) { b1v = c4[i]; i1 = i; }
                int i2 = -1; float b2v = -1e30f;
#pragma unroll
                for (int i = 0; i < 4; ++i) if (i != i1 && c4[i] > b2v) { b2v = c4[i]; i2 = i; }
                float w1v = 0.f, w2v = 0.f;
#pragma unroll
                for (int i = 0; i < 4; ++i) { if (i == i1) w1v = s4[i]; if (i == i2) w2v = s4[i]; }
                const float inv = 1.0f / (w1v + w2v);
                if (lane == 0) {
                    const int e1 = gi * 4 + i1, e2 = gi * 4 + i2;
                    toke[2 * r] = e1; toke[2 * r + 1] = e2; tokwW[2 * r] = w1v * inv; tokwW[2 * r + 1] = w2v * inv;
                    __hip_atomic_fetch_add(lcnt + e1, 1, __ATOMIC_RELAXED, __HIP_MEMORY_SCOPE_WORKGROUP);
                    __hip_atomic_fetch_add(lcnt + e2, 1, __ATOMIC_RELAXED, __HIP_MEMORY_SCOPE_WORKGROUP);
                }
            } else {
                float* gb = (float*)(k.ws + WS_GB);
                if ((lane & 1) == 0) {
                    if (n < 16) {
                        const float z = val + aux1[n];
                        const float ez = __expf(z); const float sp = z > 15.f ? z : (ez < 1e-4f ? ez - 0.5f * ez * ez : __logf(1.0f + ez));
                        gb[(size_t)r * 32 + n] = -expf(aux0[n]) * sp;
                    } else {
                        gb[(size_t)r * 32 + n] = 1.0f / (1.0f + expf(-val));
                    }
                }
            }
        }
    }
    if (MODE == 1) {
        __syncthreads();
        int* cnt = (int*)(k.ws + WS_CTL + CTL_CNT) + layer * 32;
        if (flush && tid < 32 && lcnt[tid] > 0) atomicAdd(&cnt[tid], lcnt[tid]);
    }
}

constexpr int NM_WLD = 1032;
template <int MODE>
PF void norm_mfma(const KC& k, int layer, bool first, bool combine, const float* __restrict__ gain, int mb, const float* __restrict__ Wsk, int ldw,
                  const float* __restrict__ aux0, const float* __restrict__ aux1, bool last, LAS unsigned char* lds, bool flush = true) {
    const int tid = TID(), lane = tid & 63, wave = __builtin_amdgcn_readfirstlane(tid >> 6), row = lane & 15, q = lane >> 4;
    LAS bf16_t* WtH = (LAS bf16_t*)lds; LAS bf16_t* WtL = WtH + 32 * NM_WLD;
    LAS float* red = (LAS float*)(WtL + 32 * NM_WLD);
    LAS float* lg = red + 128;
    LAS int* lcnt = (LAS int*)(lg + 8 * 16 * 32);
    float* xs = (float*)(k.ws + WS_XS);
    bf16_t* hbuf = (bf16_t*)(k.ws + AR_HBUF);
    const float* mod = (const float*)(k.ws + WS_MOD);
    const bf16_t* ys = (const bf16_t*)(k.ws + AR_YS);
    const int* tokp = (const int*)(k.ws + WS_TOKP); const float* tokw = (const float*)(k.ws + WS_TOKW);
    if (MODE == 1 && tid < 32) lcnt[tid] = 0;
    for (int idx = tid; idx < 1024 * 32; idx += NTHR) {
        const int kk = idx >> 5, n = idx & 31;
        const float w = Wsk[(size_t)kk * ldw + n]; const bf16_t hi = f2bf(w);
        WtH[n * NM_WLD + kk] = hi; WtL[n * NM_WLD + kk] = f2bf(w - bf2f(hi));
    }
    __syncthreads();
    const int cbase = 128 * wave + 8 * q;
    f32x4 xn[8];
    int bt = blockIdx.x;
    if (bt < T / 16) {
        const float* sb = first ? (16 * bt < TC ? k.ctx : k.x - (size_t)TC * 1024) : xs;
        const unsigned off = (unsigned)(16 * bt + row) * 1024u + (unsigned)cbase;
#pragma unroll
        for (int kk = 0; kk < 4; ++kk) { xn[2 * kk] = *(const f32x4*)(sb + off + 32 * kk); xn[2 * kk + 1] = *(const f32x4*)(sb + off + 32 * kk + 4); }
    }
    for (; bt < T / 16; bt += gridDim.x) {
        const int r = 16 * bt + row, mr = modrow(16 * bt);
        const unsigned roff = (unsigned)r * 1024u + (unsigned)cbase;
        float x[32];
#pragma unroll
        for (int i = 0; i < 8; ++i) { x[4 * i] = xn[i][0]; x[4 * i + 1] = xn[i][1]; x[4 * i + 2] = xn[i][2]; x[4 * i + 3] = xn[i][3]; }
        int p0 = 0, p1 = 0; float w0 = 0.f, w1 = 0.f;
        if (combine) { p0 = tokp[2 * r]; p1 = tokp[2 * r + 1]; w0 = tokw[2 * r]; w1 = tokw[2 * r + 1]; }
        {
            const int bn = bt + gridDim.x;
            if (bn < T / 16) {
                const float* sb = first ? (16 * bn < TC ? k.ctx : k.x - (size_t)TC * 1024) : xs;
                const unsigned off = (unsigned)(16 * bn + row) * 1024u + (unsigned)cbase;
#pragma unroll
                for (int kk = 0; kk < 4; ++kk) { xn[2 * kk] = *(const f32x4*)(sb + off + 32 * kk); xn[2 * kk + 1] = *(const f32x4*)(sb + off + 32 * kk + 4); }
            }
        }
        const float* shift = mod + ((size_t)(layer * 3 + mr) * 6 + mb) * 1024;
        if (combine) {
            const float* g5 = mod + ((size_t)((layer - 1) * 3 + mr) * 6 + 5) * 1024;
            u32x4 ya[4], yb[4]; float g5v[32];
#pragma unroll
            for (int kk = 0; kk < 4; ++kk) { ya[kk] = *(const u32x4*)(ys + (size_t)p0 * 1024 + cbase + 32 * kk); yb[kk] = *(const u32x4*)(ys + (size_t)p1 * 1024 + cbase + 32 * kk);
                const f32x4 ga = *(const f32x4*)(g5 + cbase + 32 * kk), gb2 = *(const f32x4*)(g5 + cbase + 32 * kk + 4);
#pragma unroll
                for (int e = 0; e < 4; ++e) { g5v[8 * kk + e] = ga[e]; g5v[8 * kk + 4 + e] = gb2[e]; } }
            asm volatile("" ::: "memory");
#pragma unroll
            for (int kk = 0; kk < 4; ++kk)
#pragma unroll
                for (int w = 0; w < 4; ++w) {
                    x[8 * kk + 2 * w] += g5v[8 * kk + 2 * w] * (w0 * __uint_as_float(ya[kk][w] << 16) + w1 * __uint_as_float(yb[kk][w] << 16));
                    x[8 * kk + 2 * w + 1] += g5v[8 * kk + 2 * w + 1] * (w0 * __uint_as_float(ya[kk][w] & 0xffff0000u) + w1 * __uint_as_float(yb[kk][w] & 0xffff0000u));
                }
        }
        if (first || combine) {
#pragma unroll
            for (int kk = 0; kk < 4; ++kk) {
                *(f32x4*)(xs + roff + 32 * kk) = (f32x4){x[8 * kk], x[8 * kk + 1], x[8 * kk + 2], x[8 * kk + 3]};
                *(f32x4*)(xs + roff + 32 * kk + 4) = (f32x4){x[8 * kk + 4], x[8 * kk + 5], x[8 * kk + 6], x[8 * kk + 7]};
            }
        }
        float ss = 0.f;
#pragma unroll
        for (int i = 0; i < 32; ++i) ss += x[i] * x[i];
        ss += shx(ss, 16, lane); ss += shx(ss, 32, lane);
        if (q == 0) red[wave * 16 + row] = ss;
        __syncthreads();
        float tot = 0.f;
#pragma unroll
        for (int w = 0; w < 8; ++w) tot += red[w * 16 + row];
        const float rstd = rsqrtf(tot * (1.0f / 1024.0f) + EPS);
        f32x4 acc[2]; acc[0] = (f32x4){0.f, 0.f, 0.f, 0.f}; acc[1] = (f32x4){0.f, 0.f, 0.f, 0.f};
#pragma unroll
        for (int kk = 0; kk < 4; ++kk) {
            float y[8]; u32x4 ah, al;
            {
                const unsigned co = (unsigned)cbase + 32u * kk;
                const f32x4 g0 = *(const f32x4*)(gain + co), g1 = *(const f32x4*)(gain + co + 4), s0 = *(const f32x4*)(shift + 1024 + co), s1 = *(const f32x4*)(shift + 1024 + co + 4),
                            h0 = *(const f32x4*)(shift + co), h1 = *(const f32x4*)(shift + co + 4);
#pragma unroll
                for (int e = 0; e < 4; ++e) { y[e] = x[8 * kk + e] * rstd * g0[e] * (1.0f + s0[e]) + h0[e]; y[4 + e] = x[8 * kk + 4 + e] * rstd * g1[e] * (1.0f + s1[e]) + h1[e]; }
            }
#pragma unroll
            for (int w = 0; w < 4; ++w) {
                ah[w] = pk2(y[2 * w], y[2 * w + 1]);
                al[w] = pk2(y[2 * w] - __uint_as_float(ah[w] << 16), y[2 * w + 1] - __uint_as_float(ah[w] & 0xffff0000u));
            }
            *(u32x4*)(hbuf + roff + 32 * kk) = ah;
            const bf16x8 fah = __builtin_bit_cast(bf16x8, ah), fal = __builtin_bit_cast(bf16x8, al);
            bf16x8 bh[2], bl[2];
#pragma unroll
            for (int nt = 0; nt < 2; ++nt) {
                bh[nt] = *(const LAS bf16x8*)(WtH + (16 * nt + row) * NM_WLD + cbase + 32 * kk);
                bl[nt] = *(const LAS bf16x8*)(WtL + (16 * nt + row) * NM_WLD + cbase + 32 * kk);
            }
            asm volatile("" ::: "memory");
#pragma unroll
            for (int nt = 0; nt < 2; ++nt) {
                acc[nt] = __builtin_amdgcn_mfma_f32_16x16x32_bf16(fah, bh[nt], acc[nt], 0, 0, 0);
                acc[nt] = __builtin_amdgcn_mfma_f32_16x16x32_bf16(fal, bh[nt], acc[nt], 0, 0, 0);
                acc[nt] = __builtin_amdgcn_mfma_f32_16x16x32_bf16(fah, bl[nt], acc[nt], 0, 0, 0);
            }
        }
#pragma unroll
        for (int nt = 0; nt < 2; ++nt)
#pragma unroll
            for (int j = 0; j < 4; ++j) lg[(wave * 16 + 4 * q + j) * 32 + 16 * nt + row] = acc[nt][j];
        __syncthreads();
        {
            const int prow = tid >> 5, n = tid & 31, rr = 16 * bt + prow, hb = lane & 32;
            float val = 0.f;
#pragma unroll
            for (int w = 0; w < 8; ++w) val += lg[(w * 16 + prow) * 32 + n];
            if (MODE == 1) {
                int* toke = (int*)(k.ws + WS_TOKE); float* tokwW = (float*)(k.ws + WS_TOKW);
                const bool unrouted = last && rr < TC;
                const float sc = 1.0f / (1.0f + expf(-val)), ch = sc + aux0[n];
                const int gl = hb + (n & ~3);
                const float ca = shi(ch, gl), cb = shi(ch, gl + 1), cc = shi(ch, gl + 2), cd = shi(ch, gl + 3);
                const float hi1 = fmaxf(ca, cb), lo1 = fminf(ca, cb), hi2 = fmaxf(cc, cd), lo2 = fminf(cc, cd);
                float gs = fmaxf(hi1, hi2) + fmaxf(fminf(hi1, hi2), fmaxf(lo1, lo2));
                int gi = n >> 2;
#pragma unroll
                for (int m = 4; m <= 16; m <<= 1) {
                    const float og = shx(gs, m, lane); const int oi = shii(gi, lane ^ m);
                    if (og > gs || (og == gs && oi < gi)) { gs = og; gi = oi; }
                }
                float c4[4], s4[4];
#pragma unroll
                for (int i = 0; i < 4; ++i) { c4[i] = shi(ch, hb + gi * 4 + i); s4[i] = shi(sc, hb + gi * 4 + i); }
                int i1 = 0; float b1v = c4[0];
#pragma unroll
                for (int i = 1; i < 4; ++i) if (c4[i] > b1v) { b1v = c4[i]; i1 = i; }
                int i2 = -1; float b2v = -1e30f;
#pragma unroll
                for (int i = 0; i < 4; ++i) if (i != i1 && c4[i] > b2v) { b2v = c4[i]; i2 = i; }
                float w1v = 0.f, w2v = 0.f;
#pragma unroll
                for (int i = 0; i < 4; ++i) { if (i == i1) w1v = s4[i]; if (i == i2) w2v = s4[i]; }
                const float inv = 1.0f / (w1v + w2v);
                if (n == 0) {
                    if (unrouted) { int neg = -1; asm volatile("" : "+v"(neg)); toke[2 * rr] = neg; toke[2 * rr + 1] = neg; }
                    else {
                        const int e1 = gi * 4 + i1, e2 = gi * 4 + i2;
                        toke[2 * rr] = e1; toke[2 * rr + 1] = e2; tokwW[2 * rr] = w1v * inv; tokwW[2 * rr + 1] = w2v * inv;
                        __hip_atomic_fetch_add(lcnt + e1, 1, __ATOMIC_RELAXED, __HIP_MEMORY_SCOPE_WORKGROUP);
                        __hip_atomic_fetch_add(lcnt + e2, 1, __ATOMIC_RELAXED, __HIP_MEMORY_SCOPE_WORKGROUP);
                    }
                }
            } else {
                float* gb = (float*)(k.ws + WS_GB);
                if (n < 16) {
                    const float z = val + aux1[n];
                    const float ez = __expf(z); const float sp = z > 15.f ? z : (ez < 1e-4f ? ez - 0.5f * ez * ez : __logf(1.0f + ez));
                    gb[(size_t)rr * 32 + n] = -expf(aux0[n]) * sp;
                } else {
                    gb[(size_t)rr * 32 + n] = 1.0f / (1.0f + expf(-val));
                }
            }
        }
        __syncthreads();
    }
    if (MODE == 1) {
        __syncthreads();
        int* cnt = (int*)(k.ws + WS_CTL + CTL_CNT) + layer * 32;
        if (flush && tid < 32 && lcnt[tid] > 0) atomicAdd(&cnt[tid], lcnt[tid]);
    }
}

namespace pg8 {
constexpr int BM = 256, BK = 64, HALF = 128, HTB = HALF * BK * 2, STAGE_BYTES = 8 * HTB;
DI int lds_byte(int r, int c) { const int st = (r >> 4) * 2 + (c >> 5), rr = r & 15, cc = c & 31, ob = rr * 64 + cc * 2; return st * 1024 + (ob ^ (((ob >> 9) & 1) << 5)); }
DI void stage_rc(int b, int& R, int& C) { const int st = b / 1024, sb = b % 1024, swz = sb ^ (((sb >> 9) & 1) << 5); R = (st >> 1) * 16 + swz / 64; C = (st & 1) * 32 + (swz % 64) / 2; }
DI int perm32(int rho) { const int n = rho >> 4, i = rho & 15; return 8 * (i >> 2) + 4 * n + (i & 3); }
struct Unit { int m0, mrows, pn; size_t boff; };
template <bool GATHER, class Epi, class Sched>
DI void gemm_phase(LAS unsigned char* lds, const bf16_t* A, const int* rowidx, const bf16_t* Bt, int K, const Sched& S, const Epi& E) {
    const int tid = TID(), wid = __builtin_amdgcn_readfirstlane(tid >> 6), lane = tid & 63, wr = wid >> 2, wc = wid & 3, fr = lane & 15, fq = lane >> 4;
    const int nt = K / BK;
    unsigned voffA[2], voffB[2];
#pragma unroll
    for (int i = 0; i < 2; ++i) { int R, C; stage_rc(tid * 16 + i * 8192, R, C); const int Rb = Epi::PERM ? ((R & ~31) + perm32(R & 31)) : R;
        voffA[i] = (unsigned)(R * K + C) * 2u; voffB[i] = (unsigned)(Rb * K + C) * 2u; }
    const size_t kstep = (size_t)(BK * 2);
    const size_t hstep = (size_t)HALF * K * 2;
    const size_t tstep = 2 * hstep;
    const size_t rstep = (size_t)K * 2;
    const unsigned ldsw = (unsigned)wid * 1024u;
    const int aoff = lds_byte(wr * 64 + fr, fq * 8), boff = lds_byte(wc * 32 + fr, fq * 8);
#define PG8_SA(b, h) (((b) * 2 + (h)) * HTB)
#define PG8_SB(b, h) ((4 + (b) * 2 + (h)) * HTB)
#define PG8_STAGE(bufoff, gbase, voff) do { _Pragma("unroll") for (int _i = 0; _i < 2; ++_i) \
        __builtin_amdgcn_global_load_lds((const unsigned*)((const char*)(gbase) + (voff)[_i]), (LAS unsigned*)(lds + (bufoff) + ldsw + _i * 8192), 16, 0, 0); } while (0)
#define PG8_STAGE_A(bufoff, p, h, vG) do { if (GATHER) PG8_STAGE(bufoff, p, (vG)[h]); else PG8_STAGE(bufoff, (p) + (h) * hstep, voffA); } while (0)
#define PG8_LDA(dst, b, h) do { _Pragma("unroll") for (int m = 0; m < 4; ++m) _Pragma("unroll") for (int k = 0; k < 2; ++k) dst[m][k] = *(const LAS bf16x8*)(lds + PG8_SA(b, h) + aoff + m * 2048 + k * 1024); } while (0)
#define PG8_LDB(dst, b, h) do { _Pragma("unroll") for (int n = 0; n < 2; ++n) _Pragma("unroll") for (int k = 0; k < 2; ++k) dst[n][k] = *(const LAS bf16x8*)(lds + PG8_SB(b, h) + boff + n * 2048 + k * 1024); } while (0)
#define PG8_MMA(ai, bj, At, Bt_) do { __builtin_amdgcn_s_setprio(1); _Pragma("unroll") for (int m = 0; m < 4; ++m) _Pragma("unroll") for (int n = 0; n < 2; ++n) _Pragma("unroll") for (int k = 0; k < 2; ++k) \
        acc[ai][bj][m][n] = __builtin_amdgcn_mfma_f32_16x16x32_bf16(Bt_[n][k], At[m][k], acc[ai][bj][m][n], 0, 0, 0); __builtin_amdgcn_s_setprio(0); } while (0)
#define PG8_WAIT_V(n) asm volatile("s_waitcnt vmcnt(" #n ")" ::: "memory")
#define PG8_WAIT_L(n) asm volatile("s_waitcnt lgkmcnt(" #n ")" ::: "memory")
#define PG8_BAR __builtin_amdgcn_s_barrier()
#define PG8_SCHED __builtin_amdgcn_sched_barrier(0)
#define PG8_AOFF(dst, u) do { _Pragma("unroll") for (int _h = 0; _h < 2; ++_h) _Pragma("unroll") for (int _i = 0; _i < 2; ++_i) { int _R, _C; stage_rc(tid * 16 + _i * 8192, _R, _C); \
        dst[_h][_i] = (unsigned)(rowidx[(u).m0 + _h * HALF + _R] * K + _C) * 2u; } } while (0)
    Unit cur, nxt; int ui = 0;
    if (!S.next(0, cur)) return;
    f32x4 acc[2][2][4][2];
#pragma unroll
    for (int a = 0; a < 2; ++a)
#pragma unroll
        for (int b = 0; b < 2; ++b)
#pragma unroll
            for (int m = 0; m < 4; ++m)
#pragma unroll
                for (int n = 0; n < 2; ++n) acc[a][b][m][n] = (f32x4){0.f, 0.f, 0.f, 0.f};
    bf16x8 At[4][2], B0[2][2], B1[2][2];
    unsigned vA[2][2], vN[2][2];
    if (GATHER) PG8_AOFF(vA, cur);
    const char* cA = (const char*)A + (GATHER ? (size_t)0 : (size_t)cur.m0 * rstep);
    const char* cB = (const char*)Bt + cur.boff + (size_t)cur.pn * tstep;
    PG8_STAGE(PG8_SB(0, 0), cB, voffB); PG8_STAGE_A(PG8_SA(0, 0), cA, 0, vA); PG8_STAGE(PG8_SB(0, 1), cB + hstep, voffB); PG8_STAGE_A(PG8_SA(0, 1), cA, 1, vA);
    if (wr == 1) PG8_BAR;
    PG8_WAIT_V(4); PG8_BAR;
    PG8_STAGE(PG8_SB(1, 0), cB + kstep, voffB); PG8_STAGE_A(PG8_SA(1, 0), cA + kstep, 0, vA); PG8_STAGE(PG8_SB(1, 1), cB + hstep + kstep, voffB);
    PG8_WAIT_V(6); PG8_BAR;
    for (;;) {
        const bool has_next = S.next(ui + 1, nxt);
        const char* nA = GATHER ? cA : (has_next ? (const char*)A + (size_t)nxt.m0 * rstep : cA);
        const char* nB = has_next ? (const char*)Bt + nxt.boff + (size_t)nxt.pn * tstep : cB;
        if (GATHER) {
            if (has_next) { PG8_AOFF(vN, nxt); }
            else {
#pragma unroll
                for (int h = 0; h < 2; ++h)
#pragma unroll
                    for (int i = 0; i < 2; ++i) vN[h][i] = vA[h][i];
            }
        }
        for (int t = 0; t < nt; t += 2) {
            const bool last = (t == nt - 2);
            const char* a1 = cA + (size_t)(t + 1) * kstep;
            const char* a2 = last ? nA : cA + (size_t)(t + 2) * kstep; const char* b2 = last ? nB : cB + (size_t)(t + 2) * kstep;
            const char* a3 = a2 + kstep; const char* b3 = b2 + kstep;
            PG8_LDB(B0, 0, 0); PG8_SCHED; PG8_LDA(At, 0, 0); PG8_STAGE_A(PG8_SA(1, 1), a1, 1, vA);
            if (GATHER && last) {
#pragma unroll
                for (int h = 0; h < 2; ++h)
#pragma unroll
                    for (int i = 0; i < 2; ++i) vA[h][i] = vN[h][i];
            }
            PG8_WAIT_L(8); PG8_BAR; PG8_WAIT_L(0); PG8_MMA(0, 0, At, B0); PG8_BAR; PG8_SCHED;
            PG8_LDB(B1, 0, 1); PG8_STAGE(PG8_SB(0, 0), b2, voffB);
            PG8_BAR; PG8_WAIT_L(0); PG8_MMA(0, 1, At, B1); PG8_BAR;
            PG8_LDA(At, 0, 1); PG8_STAGE_A(PG8_SA(0, 0), a2, 0, vA);
            PG8_BAR; PG8_WAIT_L(0); PG8_MMA(1, 0, At, B0); PG8_BAR; PG8_SCHED;
            PG8_STAGE(PG8_SB(0, 1), b2 + hstep, voffB);
            PG8_WAIT_V(6); PG8_BAR; PG8_MMA(1, 1, At, B1); PG8_BAR;
            PG8_LDB(B0, 1, 0); PG8_SCHED; PG8_LDA(At, 1, 0); PG8_STAGE_A(PG8_SA(0, 1), a2, 1, vA);
            PG8_WAIT_L(8); PG8_BAR; PG8_WAIT_L(0); PG8_MMA(0, 0, At, B0); PG8_BAR; PG8_SCHED;
            PG8_LDB(B1, 1, 1); PG8_STAGE(PG8_SB(1, 0), b3, voffB);
            PG8_BAR; PG8_WAIT_L(0); PG8_MMA(0, 1, At, B1); PG8_BAR;
            PG8_LDA(At, 1, 1); PG8_STAGE_A(PG8_SA(1, 0), a3, 0, vA);
            PG8_BAR; PG8_WAIT_L(0); PG8_MMA(1, 0, At, B0); PG8_BAR; PG8_SCHED;
            PG8_STAGE(PG8_SB(1, 1), b3 + hstep, voffB);
            PG8_WAIT_V(6); PG8_BAR; PG8_MMA(1, 1, At, B1); PG8_BAR;
        }
        { const int t2 = TID(), l2 = t2 & 63; E(acc, cur, wr, wc, l2 & 15, l2 >> 4); }
        if (!has_next) break;
#pragma unroll
        for (int a = 0; a < 2; ++a)
#pragma unroll
            for (int b = 0; b < 2; ++b)
#pragma unroll
                for (int m = 0; m < 4; ++m)
#pragma unroll
                    for (int n = 0; n < 2; ++n) acc[a][b][m][n] = (f32x4){0.f, 0.f, 0.f, 0.f};
        cur = nxt; cA = nA; cB = nB; ++ui;
    }
    PG8_WAIT_V(0);
    if (wr == 0) PG8_BAR;
    PG8_BAR;
#undef PG8_SA
#undef PG8_SB
#undef PG8_STAGE
#undef PG8_STAGE_A
#undef PG8_LDA
#undef PG8_LDB
#undef PG8_MMA
#undef PG8_WAIT_V
#undef PG8_WAIT_L
#undef PG8_BAR
#undef PG8_SCHED
#undef PG8_AOFF
}
struct DenseOrder {
    int nM, nN, nwg, G, c;
    DI void init(int M, int N, int G_, int c_) { nM = M / BM; nN = N / BM; nwg = nM * nN; G = G_; c = c_; }
    DI bool next(int i, Unit& u) const {
        const long L = (long)i * G + c; if (L >= nwg) return false;
        int wgid = (int)L; { const int q = nwg / 8, r = nwg % 8, xcd = wgid % 8, off = wgid / 8; wgid = (xcd < r ? xcd * (q + 1) : r * (q + 1) + (xcd - r) * q) + off; }
        const int nig = 8 * nN, gid = wgid / nig, fm = gid * 8, gsz = (nM - fm) < 8 ? (nM - fm) : 8;
        u.m0 = (fm + ((wgid % nig) % gsz)) * BM; u.mrows = BM; u.pn = (wgid % nig) / gsz; u.boff = 0; return true;
    }
};
struct MoeOrder {
    const LAS int* tb; int G, c; size_t estride; int lane;
    DI bool next(int i, Unit& u) const {
        const int L = i * G + c; if (L >= __builtin_amdgcn_readfirstlane(tb[97]) * 4) return false;
        const int tile = L >> 2;
        const int pre = tb[65 + (lane & 31)];
        const unsigned long long m = __ballot(lane < 32 && pre <= tile);
        const int e = __popcll(m) - 1;
        const int lt = tile - __builtin_amdgcn_readfirstlane(tb[65 + e]); int mr = __builtin_amdgcn_readfirstlane(tb[e]) - lt * 256; mr = mr > 256 ? 256 : mr;
        u.m0 = __builtin_amdgcn_readfirstlane(tb[32 + e]) + lt * 256; u.mrows = mr; u.pn = L & 3; u.boff = (size_t)e * estride; return true;
    }
};
}
struct EpiBf16 {
    static constexpr bool PERM = true;
    bf16_t* C; int ldc; int split_col; bf16_t* C2; int ldc2;
    DI void operator()(const f32x4 (&acc)[2][2][4][2], const pg8::Unit& u, int wr, int wc, int fr, int fq) const {
        int colt = u.pn * 256; bf16_t* base = C; int ld = ldc;
        if (colt >= split_col) { base = C2; ld = ldc2; colt -= split_col; }
#pragma unroll
        for (int ai = 0; ai < 2; ++ai)
#pragma unroll
            for (int m = 0; m < 4; ++m) {
                const int rl = ai * 128 + wr * 64 + m * 16 + fr;
                if (rl < u.mrows) {
                    bf16_t* rowp = base + (size_t)(u.m0 + rl) * ld + colt + wc * 32 + 8 * fq;
#pragma unroll
                    for (int bj = 0; bj < 2; ++bj) {
                        const f32x4 v0 = acc[ai][bj][m][0], v1 = acc[ai][bj][m][1];
                        u32x4 o; o[0] = cvt_pk_bf16(v0[0], v0[1]); o[1] = cvt_pk_bf16(v0[2], v0[3]); o[2] = cvt_pk_bf16(v1[0], v1[1]); o[3] = cvt_pk_bf16(v1[2], v1[3]);
                        *(u32x4*)(rowp + bj * 128) = o;
                    }
                }
            }
    }
};
struct EpiBf16T {
    static constexpr bool PERM = false;
    bf16_t* C; int ldc;
    DI void operator()(const f32x4 (&acc)[2][2][4][2], const pg8::Unit& u, int wr, int wc, int fr, int fq) const {
#pragma unroll
        for (int ai = 0; ai < 2; ++ai)
#pragma unroll
            for (int bj = 0; bj < 2; ++bj)
#pragma unroll
                for (int m = 0; m < 4; ++m)
#pragma unroll
                    for (int n = 0; n < 2; ++n) {
                        const int row = u.m0 + ai * 128 + wr * 64 + m * 16 + fr, col = u.pn * 256 + bj * 128 + wc * 32 + n * 16 + 4 * fq;
#pragma unroll
                        for (int e = 0; e < 4; ++e) C[(size_t)(col + e) * ldc + row] = f2bf(acc[ai][bj][m][n][e]);
                    }
    }
};
struct EpiTaps {
    static constexpr bool PERM = false;
    bf16_t* FT;
    DI void operator()(const f32x4 (&acc)[2][2][4][2], const pg8::Unit& u, int wr, int wc, int fr, int fq) const {
#pragma unroll
        for (int ai = 0; ai < 2; ++ai)
#pragma unroll
            for (int m = 0; m < 4; ++m) {
                const int row = u.m0 + ai * 128 + wr * 64 + m * 16 + fr; const float dl = hy_delta(row & 1023) * (1.0f / 16383.0f);
#pragma unroll
                for (int bj = 0; bj < 2; ++bj)
#pragma unroll
                    for (int n = 0; n < 2; ++n) {
                        const int l = u.pn * 256 + bj * 128 + wc * 32 + n * 16 + 4 * fq; float o[4];
#pragma unroll
                        for (int e = 0; e < 4; ++e) o[e] = acc[ai][bj][m][n][e] * __expf(-(float)(l + e) * dl);
                        u32x2 pk; pk[0] = pk2(o[0], o[1]); pk[1] = pk2(o[2], o[3]);
                        *(u32x2*)(FT + (size_t)row * 16384 + l) = pk;
                    }
            }
    }
};
struct EpiResid {
    static constexpr bool PERM = false;
    float* xs; const float* mod; int layer; int chunk;
    DI void operator()(const f32x4 (&acc)[2][2][4][2], const pg8::Unit& u, int wr, int wc, int fr, int fq) const {
        const float* g = mod + ((size_t)(layer * 3 + modrow(u.m0)) * 6 + chunk) * 1024;
#pragma unroll
        for (int bj = 0; bj < 2; ++bj)
#pragma unroll
            for (int n = 0; n < 2; ++n) {
                const int col = u.pn * 256 + bj * 128 + wc * 32 + n * 16 + 4 * fq; const f32x4 gv = *(const f32x4*)(g + col);
                float* p0 = xs + (size_t)(u.m0 + wr * 64 + fr) * 1024 + col;
                f32x4 old[8];
#pragma unroll
                for (int ai = 0; ai < 2; ++ai)
#pragma unroll
                    for (int m = 0; m < 4; ++m) old[ai * 4 + m] = *(const f32x4*)(p0 + (size_t)(ai * 128 + m * 16) * 1024);
                asm volatile("" ::: "memory");
#pragma unroll
                for (int ai = 0; ai < 2; ++ai)
#pragma unroll
                    for (int m = 0; m < 4; ++m) *(f32x4*)(p0 + (size_t)(ai * 128 + m * 16) * 1024) = old[ai * 4 + m] + gv * acc[ai][bj][m][n];
            }
    }
};
struct EpiGateUp {
    static constexpr bool PERM = false;
    bf16_t* hid;
    DI void operator()(const f32x4 (&acc)[2][2][4][2], const pg8::Unit& u, int wr, int wc, int fr, int fq) const {
#pragma unroll
        for (int ai = 0; ai < 2; ++ai)
#pragma unroll
            for (int m = 0; m < 4; ++m) {
                const int rl = ai * 128 + wr * 64 + m * 16 + fr;
                if (rl < u.mrows) {
#pragma unroll
                    for (int bj = 0; bj < 2; ++bj) {
                        const int hc = ((u.pn * 256 + bj * 128 + wc * 32) >> 1) + 4 * fq;
                        const f32x4 g = acc[ai][bj][m][0], up = acc[ai][bj][m][1];
                        u32x2 o; o[0] = cvt_pk_bf16(siluf(g[0]) * up[0], siluf(g[1]) * up[1]); o[1] = cvt_pk_bf16(siluf(g[2]) * up[2], siluf(g[3]) * up[3]);
                        *(u32x2*)(hid + (size_t)(u.m0 + rl) * 512 + hc) = o;
                    }
                }
            }
    }
};
template <class Epi>
PF void gemm_dense(LAS unsigned char* lds, const bf16_t* A, int M, const bf16_t* Bt, int N, int K, const Epi& epi) {
    pg8::DenseOrder S; S.init(M, N, (int)gridDim.x, (int)blockIdx.x);
    pg8::gemm_phase<false>(lds, A, (const int*)nullptr, Bt, K, S, epi);
}
DI void moe_table(const KC& k, int layer, LAS int* tb) {
    const int* cnt = (const int*)(k.ws + WS_CTL + CTL_CNT) + layer * 32;
    __syncthreads();
    const int tq = TID();
    if (tq < 32) tb[tq] = __hip_atomic_load(cnt + tq, __ATOMIC_RELAXED, __HIP_MEMORY_SCOPE_AGENT);
    __syncthreads();
    if (tq == 0) {
        int s = 0, tp = 0;
        for (int e = 0; e < 32; ++e) { tb[32 + e] = s; tb[65 + e] = tp; s += tb[e]; tp += (tb[e] + 255) >> 8; }
        tb[64] = s; tb[97] = tp;
    }
    __syncthreads();
}
template <int WHICH>
PF void moe_gemm(const KC& k, int layer, LAS unsigned char* lds, LAS int* tb) {
    moe_table(k, layer, tb);
    if (WHICH == 0) {
        pg8::MoeOrder S{tb, (int)gridDim.x, (int)blockIdx.x, (size_t)1024 * 1024 * 2, TID() & 63};
        EpiGateUp epi{(bf16_t*)(k.ws + AR_HID)};
        pg8::gemm_phase<true>(lds, (const bf16_t*)(k.ws + AR_HBUF), (const int*)(k.ws + WS_SLOT), (const bf16_t*)(k.ws + AR_WGU), 1024, S, epi);
    } else {
        pg8::MoeOrder S{tb, (int)gridDim.x, (int)blockIdx.x, (size_t)1024 * 512 * 2, TID() & 63};
        EpiBf16 epi{(bf16_t*)(k.ws + AR_YS), 1024, 1 << 30, nullptr, 0};
        pg8::gemm_phase<false>(lds, (const bf16_t*)(k.ws + AR_HID), (const int*)nullptr, (const bf16_t*)(k.ws + AR_WD), 512, S, epi);
    }
}
PF void moe_scatter(const KC& k, int layer, LAS int* tb) {
    moe_table(k, layer, tb);
    const int* toke = (const int*)(k.ws + WS_TOKE);
    int* tokp = (int*)(k.ws + WS_TOKP); int* slot = (int*)(k.ws + WS_SLOT);
    int* cur = (int*)(k.ws + WS_CTL + CTL_CNT) + 128 + layer * 32;
    LAS int* lc = tb + 128; LAS int* lb = tb + 160;
    const int tid = TID();
    if (blockIdx.x == 0 && tid < 256) slot[NA + tid] = 0;
    for (int r0 = blockIdx.x * NTHR; r0 < T; r0 += gridDim.x * NTHR) {
        const int r = r0 + tid;
        __syncthreads();
        if (tid < 32) lc[tid] = 0;
        __syncthreads();
        const int e0 = toke[2 * r], e1 = toke[2 * r + 1];
        int k0 = 0, k1 = 0;
        if (e0 >= 0) { k0 = __hip_atomic_fetch_add(lc + e0, 1, __ATOMIC_RELAXED, __HIP_MEMORY_SCOPE_WORKGROUP); k1 = __hip_atomic_fetch_add(lc + e1, 1, __ATOMIC_RELAXED, __HIP_MEMORY_SCOPE_WORKGROUP); }
        __syncthreads();
        if (tid < 32) lb[tid] = lc[tid] > 0 ? atomicAdd(&cur[tid], lc[tid]) : 0;
        __syncthreads();
        if (e0 >= 0) {
            const int p0 = tb[32 + e0] + lb[e0] + k0, p1 = tb[32 + e1] + lb[e1] + k1;
            slot[p0] = r; slot[p1] = r; tokp[2 * r] = p0; tokp[2 * r + 1] = p1;
        }
    }
}

DI void unpack8(const u32x4 v, float (&f)[8]) {
#pragma unroll
    for (int w = 0; w < 4; ++w) { f[2 * w] = __uint_as_float(v[w] << 16); f[2 * w + 1] = __uint_as_float(v[w] & 0xffff0000u); }
}
PF void sc_mix(const KC& k, int j) {
    const int tid = TID(), lane = tid & 63, wave = tid >> 6;
    const bf16_t* P = (const bf16_t*)(k.ws + AR_PB);
    bf16_t* U = (bf16_t*)(k.ws + AR_UBUF);
    const float* cw = k.sc_conv + (size_t)j * 3 * 1024;
    const int c0 = lane * 16;
    float k0[16], k1[16], k2[16];
#pragma unroll
    for (int e = 0; e < 16; ++e) { k0[e] = cw[c0 + e]; k1[e] = cw[1024 + c0 + e]; k2[e] = cw[2048 + c0 + e]; }
    for (int r = blockIdx.x * 8 + wave; r < T; r += gridDim.x * 8) {
        bool lok, rok;
        if (r < TC) { const int t = r & 255; lok = t != 0; rok = t != 255; } else { const int t = (r - TC) & 63; lok = t != 0; rok = t != 63; }
        const bf16_t* p = P + (size_t)r * 3072 + c0;
        const bf16_t* pl = lok ? p - 3072 : p; const bf16_t* pr = rok ? p + 3072 : p;
        u32x4 vb[2], vc[2], vx[2], vcl[2], vxl[2], vcr[2], vxr[2];
#pragma unroll
        for (int hh = 0; hh < 2; ++hh) {
            vb[hh] = *(const u32x4*)(p + hh * 8); vc[hh] = *(const u32x4*)(p + 1024 + hh * 8); vx[hh] = *(const u32x4*)(p + 2048 + hh * 8);
            vcl[hh] = *(const u32x4*)(pl + 1024 + hh * 8); vxl[hh] = *(const u32x4*)(pl + 2048 + hh * 8);
            vcr[hh] = *(const u32x4*)(pr + 1024 + hh * 8); vxr[hh] = *(const u32x4*)(pr + 2048 + hh * 8);
        }
        asm volatile("" ::: "memory");
        const float fl = lok ? 1.f : 0.f, frr = rok ? 1.f : 0.f;
#pragma unroll
        for (int hh = 0; hh < 2; ++hh) {
            float bg[8], cg[8], xi[8], cl[8], xl[8], cr[8], xr[8];
            unpack8(vb[hh], bg); unpack8(vc[hh], cg); unpack8(vx[hh], xi); unpack8(vcl[hh], cl); unpack8(vxl[hh], xl); unpack8(vcr[hh], cr); unpack8(vxr[hh], xr);
            u32x4 o;
#pragma unroll
            for (int w = 0; w < 4; ++w) {
                float ov[2];
#pragma unroll
                for (int e = 0; e < 2; ++e) { const int i = 2 * w + e, c = hh * 8 + i; ov[e] = bg[i] * (k0[c] * fl * cl[i] * xl[i] + k1[c] * cg[i] * xi[i] + k2[c] * frr * cr[i] * xr[i]); }
                o[w] = pk2(ov[0], ov[1]);
            }
            *(u32x4*)(U + (size_t)r * 1024 + c0 + hh * 8) = o;
        }
    }
}

constexpr int DN_STEPS = 260, DN_UNITS = 32 * DN_STEPS;
DI int dn_rbase(int b, int dir, int s) {
    if (s < 4) return dir == 0 ? b * 256 + s * 64 : b * 256 + 255 - s * 64;
    const int cc = s - 4;
    return dir == 0 ? TC + b * SEQ + cc * 64 : TC + b * SEQ + SEQ - 1 - cc * 64;
}
struct DnRaw { u32x4 c[3][2], l[3][2], r[3][2]; float g, be; };
DI void dn_raw_load(const bf16_t* P, const float* gb, int u, int tid, DnRaw& R) {
    const int chain = u / DN_STEPS, s = u - chain * DN_STEPS, dir = chain & 1, h = (chain >> 1) & 7, b = chain >> 4;
    const int rbase = dn_rbase(b, dir, s), rstep = dir == 0 ? 1 : -1;
    const int i = tid >> 3, sg = tid & 7, r = rbase + rstep * i;
    bool lok, rok;
    if (r < TC) { const int t = r & 255; lok = t != 0; rok = t != 255; } else { const int t = (r - TC) & 63; lok = t != 0; rok = t != 63; }
#pragma unroll
    for (int part = 0; part < 3; ++part) {
        const bf16_t* pc = P + (size_t)r * 3072 + part * 1024 + h * 128 + sg * 16;
#pragma unroll
        for (int hf = 0; hf < 2; ++hf) {
            R.c[part][hf] = *(const u32x4*)(pc + hf * 8);
            R.l[part][hf] = (u32x4){0u, 0u, 0u, 0u}; R.r[part][hf] = (u32x4){0u, 0u, 0u, 0u};
            if (lok) R.l[part][hf] = *(const u32x4*)(pc - 3072 + hf * 8);
            if (rok) R.r[part][hf] = *(const u32x4*)(pc + 3072 + hf * 8);
        }
    }
    if (tid < 64) { const size_t row = (size_t)(rbase + rstep * tid); R.g = gb[row * 32 + dir * 8 + h]; R.be = gb[row * 32 + 16 + dir * 8 + h]; }
}
PF void dn_chunk(const KC& k, int jl, LAS unsigned char* lds) {
    const int tid = TID(), lane = tid & 63, wave = tid >> 6, fr = lane & 15, fq = lane >> 4;
    LAS bf16_t* Kt = (LAS bf16_t*)lds;
    LAS bf16_t* Qt = Kt + 64 * 136;
    LAS bf16_t* Vt = Qt + 64 * 136;
    LAS float* Amat = (LAS float*)(Vt + 64 * 136);
    LAS bf16_t* Tb = (LAS bf16_t*)(Amat + 64 * 64);
    LAS bf16_t* VbT = Tb + 64 * 72;
    LAS bf16_t* KbT = VbT + 128 * 72;
    LAS float* gcs = (LAS float*)(KbT + 128 * 72);
    LAS float* bet = gcs + 64; LAS float* eg = bet + 64; LAS float* egr = eg + 64;
    LAS float* Tm = egr + 64;
    LAS float* Wc = Tm + 64 * 64;
    const bf16_t* P = (const bf16_t*)(k.ws + AR_PB);
    const float* gb = (const float*)(k.ws + WS_GB);
    const float* cw = k.dn_conv + (size_t)jl * 3 * 3072;
    bf16_t* CH = (bf16_t*)(k.ws + AR_CHUNK);
    bf16_t* ATT = (bf16_t*)(k.ws + AR_HBUF);
    float* EGL = (float*)(k.ws + WS_EGL);
    for (int u = blockIdx.x; u < DN_UNITS; u += gridDim.x) {
        DnRaw Rn; dn_raw_load(P, gb, u, tid, Rn);
        const int chain = u / DN_STEPS, s = u - chain * DN_STEPS, dir = chain & 1, h = (chain >> 1) & 7, b = chain >> 4;
        const int wti = tid < 288 ? tid : 0, wtap = wti / 96, wrem = wti - wtap * 96;
        const f32x4 wcv = *(const f32x4*)(cw + wtap * 3072 + (wrem >> 5) * 1024 + h * 128 + (wrem & 31) * 4);
        const int rbase = dn_rbase(b, dir, s), rstep = dir == 0 ? 1 : -1;
        bf16_t* cW = CH + (size_t)u * 32768; bf16_t* cQd = cW + 8192; bf16_t* cKd = cQd + 8192; bf16_t* cU = cKd + 8192;
        bf16_t* cAt = ATT + (size_t)u * 4096;
        lds_barrier();
        if (tid < 288) *(LAS f32x4*)(Wc + wtap * 384 + wrem * 4) = wcv;
        lds_barrier();
        const float g_in = Rn.g, be_in = Rn.be;
        {
            const int i = tid >> 3, sg = tid & 7;
#pragma unroll
            for (int part = 0; part < 3; ++part) {
                const int col = part * 1024 + h * 128 + sg * 16;
                float v[16];
#pragma unroll
                for (int hf = 0; hf < 2; ++hf) {
                    const u32x4 c4 = Rn.c[part][hf], l4 = Rn.l[part][hf], r4 = Rn.r[part][hf];
#pragma unroll
                    for (int w2 = 0; w2 < 2; ++w2) {
                        const LAS float* wp = Wc + part * 128 + sg * 16 + hf * 8 + 4 * w2;
                        const f32x4 k0 = *(const LAS f32x4*)wp, k1 = *(const LAS f32x4*)(wp + 384), k2 = *(const LAS f32x4*)(wp + 768);
#pragma unroll
                        for (int e = 0; e < 4; ++e) {
                            const int w = 2 * w2 + (e >> 1);
                            const float lv = __uint_as_float((e & 1) ? (l4[w] & 0xffff0000u) : (l4[w] << 16));
                            const float cv = __uint_as_float((e & 1) ? (c4[w] & 0xffff0000u) : (c4[w] << 16));
                            const float rv = __uint_as_float((e & 1) ? (r4[w] & 0xffff0000u) : (r4[w] << 16));
                            v[hf * 8 + 4 * w2 + e] = siluf(k0[e] * lv + k1[e] * cv + k2[e] * rv);
                        }
                    }
                }
                if (part < 2) {
                    float ss = 0.f;
#pragma unroll
                    for (int e = 0; e < 16; ++e) ss += v[e] * v[e];
                    ss += shx(ss, 1, lane); ss += shx(ss, 2, lane); ss += shx(ss, 4, lane);
                    const float sc = rsqrtf(ss + EPS) * (part == 0 ? 0.08838834764831845f : 1.0f);
#pragma unroll
                    for (int e = 0; e < 16; ++e) v[e] *= sc;
                }
                LAS bf16_t* dst = (part == 0 ? Qt : (part == 1 ? Kt : Vt)) + i * 136 + sg * 16;
                u32x4 o0, o1;
#pragma unroll
                for (int w = 0; w < 4; ++w) { o0[w] = pk2(v[2 * w], v[2 * w + 1]); o1[w] = pk2(v[8 + 2 * w], v[8 + 2 * w + 1]); }
                *(LAS u32x4*)dst = o0; *(LAS u32x4*)(dst + 8) = o1;
            }
        }
        if (wave == 0) {
            float g = g_in;
            const float be = be_in;
#pragma unroll
            for (int d = 1; d < 64; d <<= 1) { const float o = shi(g, (lane - d) & 63); if (lane >= d) g += o; }
            const float glast = shi(g, 63);
            gcs[lane] = g; bet[lane] = be; eg[lane] = expf(g); egr[lane] = expf(glast - g);
            if (lane == 0) EGL[u] = expf(glast);
        }
        lds_barrier();
#pragma unroll 1
        for (int x = 0; x < 4; ++x) {
            const int t = wave + 8 * x, isq = t >> 4, mt = (t >> 2) & 3, nt = t & 3;
            f32x4 acc = (f32x4){0.f, 0.f, 0.f, 0.f};
            const int jc = 16 * nt + fr;
            float gi4[4], bi4[4];
            const float gj = gcs[jc];
#pragma unroll
            for (int jj = 0; jj < 4; ++jj) { gi4[jj] = gcs[16 * mt + 4 * fq + jj]; bi4[jj] = bet[16 * mt + 4 * fq + jj]; }
            if (mt >= nt) {
                const LAS bf16_t* Ar = (isq ? Qt : Kt) + (16 * mt + fr) * 136 + 8 * fq;
                const LAS bf16_t* Br = Kt + (16 * nt + fr) * 136 + 8 * fq;
                bf16x8 fa4[4], fb4[4];
#pragma unroll
                for (int ks = 0; ks < 4; ++ks) { fa4[ks] = *(const LAS bf16x8*)(Ar + 32 * ks); fb4[ks] = *(const LAS bf16x8*)(Br + 32 * ks); }
                asm volatile("" ::: "memory");
#pragma unroll
                for (int ks = 0; ks < 4; ++ks) acc = __builtin_amdgcn_mfma_f32_16x16x32_bf16(fa4[ks], fb4[ks], acc, 0, 0, 0);
            }
#pragma unroll
            for (int jj = 0; jj < 4; ++jj) {
                const int ir = 16 * mt + 4 * fq + jj;
                const float dec = __expf(fminf(gi4[jj] - gj, 0.f));
                if (isq) cAt[((mt * 2 + (nt >> 1)) * 64 + (fr >> 2) * 16 + 4 * fq + jj) * 8 + (nt & 1) * 4 + (fr & 3)] = f2bf(ir >= jc ? acc[jj] * dec : 0.f);
                else Amat[ir * 64 + jc] = ir > jc ? bi4[jj] * acc[jj] * dec : 0.f;
            }
        }
        {
            const int un = u + (int)gridDim.x < DN_UNITS ? u + (int)gridDim.x : u;
            const int chn = un / DN_STEPS, stn = un - chn * DN_STEPS, dirn = chn & 1, hn = (chn >> 1) & 7, bn = chn >> 4;
            const int rbn = dn_rbase(bn, dirn, stn), rsn = dirn == 0 ? 1 : -1;
            const unsigned char* pa;
            if (tid < 396) { const int seg = tid >> 1, ri = seg / 3, part = seg - 3 * ri; int r = rbn + rsn * (ri - 1); r = r < 0 ? 0 : r > T - 1 ? T - 1 : r;
                             pa = (const unsigned char*)(P + (size_t)r * 3072 + part * 1024 + hn * 128 + (tid & 1) * 64); }
            else { const int j = tid < 460 ? tid - 396 : 0; pa = (const unsigned char*)(gb + (size_t)(rbn + rsn * j) * 32); }
            __builtin_amdgcn_global_load_lds((const unsigned*)pa, (LAS unsigned*)(lds + 143360), 4, 0, 0);
        }
        lds_barrier();
        {
        if (wave < 4) {
            if (lane < 16) {
                const int bo = 16 * wave;
                float tc[16];
#pragma unroll
                for (int i = 0; i < 16; ++i) {
                    f32x4 ar[4];
#pragma unroll
                    for (int q = 0; q < (i + 3) / 4; ++q) ar[q] = *(const LAS f32x4*)(Amat + (bo + i) * 64 + bo + 4 * q);
                    float a0 = (i == lane) ? 1.f : 0.f, a1 = 0.f;
#pragma unroll
                    for (int j = 0; j < i; ++j) { const float av = ar[j >> 2][j & 3]; if (j & 1) a1 -= av * tc[j]; else a0 -= av * tc[j]; }
                    tc[i] = a0 + a1;
                    Tm[(bo + i) * 64 + bo + lane] = tc[i];
                }
            }
        } else {
            for (int it = tid - 256; it < 1024; it += 256) {
                const int c = it & 127, ig = it >> 7;
                float kv[8], vv[8];
                { bf16_t kr[8], vr[8];
#pragma unroll
                  for (int e = 0; e < 8; ++e) { kr[e] = Kt[(8 * ig + e) * 136 + c]; vr[e] = Vt[(8 * ig + e) * 136 + c]; }
                  asm volatile("" ::: "memory");
#pragma unroll
                  for (int e = 0; e < 8; ++e) { kv[e] = bf2f(kr[e]); vv[e] = bf2f(vr[e]); } }
                u32x4 ov, ok, od;
#pragma unroll
                for (int w = 0; w < 4; ++w) {
                    const int i0 = 8 * ig + 2 * w, i1 = i0 + 1;
                    ov[w] = pk2(bet[i0] * vv[2 * w], bet[i1] * vv[2 * w + 1]);
                    ok[w] = pk2(bet[i0] * eg[i0] * kv[2 * w], bet[i1] * eg[i1] * kv[2 * w + 1]);
                    od[w] = pk2(egr[i0] * kv[2 * w], egr[i1] * kv[2 * w + 1]);
                }
                *(LAS u32x4*)(VbT + c * 72 + 8 * ig) = ov;
                *(LAS u32x4*)(KbT + c * 72 + 8 * ig) = ok;
                { bf16_t* kd0 = cKd + (((c >> 4) * 2 + (ig >> 2)) * 64 + (2 * (ig & 1)) * 16 + (c & 15)) * 8 + ((ig & 3) >> 1) * 4;
                  *(u32x2*)kd0 = (u32x2){od[0], od[1]}; *(u32x2*)(kd0 + 128) = (u32x2){od[2], od[3]}; }
            }
            for (int it = tid - 256; it < 1024; it += 256) {
                const int i = it >> 4, c8 = (it & 15) * 8; const float e = eg[i];
                const u32x4 qv = *(const LAS u32x4*)(Qt + i * 136 + c8); u32x4 o;
#pragma unroll
                for (int w = 0; w < 4; ++w) o[w] = pk2(__uint_as_float(qv[w] << 16) * e, __uint_as_float(qv[w] & 0xffff0000u) * e);
                { const int k8 = it & 15; bf16_t* qd0 = cQd + (((i >> 4) * 4 + (k8 >> 2)) * 64 + (2 * (k8 & 1)) * 16 + (i & 15)) * 8 + ((k8 & 3) >> 1) * 4;
                  *(u32x2*)qd0 = (u32x2){o[0], o[1]}; *(u32x2*)(qd0 + 128) = (u32x2){o[2], o[3]}; }
            }
        }
        lds_barrier();
#pragma unroll 1
        for (int d = 1; d < 4; ++d) {
            if (wave < 4 - d) {
                const int bi = wave + d, bj = wave, r = lane >> 2, c0 = 4 * (lane & 3);
                f32x4 m = (f32x4){0.f, 0.f, 0.f, 0.f};
                for (int kb = bj; kb < bi; ++kb) {
                    f32x4 av4[4], tv[16];
#pragma unroll
                    for (int q = 0; q < 4; ++q) av4[q] = *(const LAS f32x4*)(Amat + (16 * bi + r) * 64 + 16 * kb + 4 * q);
#pragma unroll
                    for (int kk = 0; kk < 16; ++kk) tv[kk] = *(const LAS f32x4*)(Tm + (16 * kb + kk) * 64 + 16 * bj + c0);
                    asm volatile("" ::: "memory");
#pragma unroll
                    for (int kk = 0; kk < 16; ++kk) m += tv[kk] * av4[kk >> 2][kk & 3];
                }
                *(LAS f32x4*)(Tm + (16 * bj + r) * 64 + 16 * bi + c0) = m;
                f32x4 t = (f32x4){0.f, 0.f, 0.f, 0.f};
                {
                    f32x4 dv4[4], mv[16];
#pragma unroll
                    for (int q = 0; q < 4; ++q) dv4[q] = *(const LAS f32x4*)(Tm + (16 * bi + r) * 64 + 16 * bi + 4 * q);
#pragma unroll
                    for (int kk = 0; kk < 16; ++kk) mv[kk] = *(const LAS f32x4*)(Tm + (16 * bj + kk) * 64 + 16 * bi + c0);
                    asm volatile("" ::: "memory");
#pragma unroll
                    for (int kk = 0; kk < 16; ++kk) t -= mv[kk] * dv4[kk >> 2][kk & 3];
                }
                *(LAS f32x4*)(Tm + (16 * bi + r) * 64 + 16 * bj + c0) = t;
            }
            lds_barrier();
        }
        for (int it = tid; it < 64 * 8; it += NTHR) {
            const int i = it >> 3, c8 = (it & 7) * 8; u32x4 o;
#pragma unroll
            for (int w = 0; w < 4; ++w) {
                const int c = c8 + 2 * w;
                o[w] = pk2(c <= i ? Tm[i * 64 + c] : 0.f, c + 1 <= i ? Tm[i * 64 + c + 1] : 0.f);
            }
            *(LAS u32x4*)(Tb + i * 72 + c8) = o;
        }
        }
        lds_barrier();
        {
            f32x4 au[4], aw[4];
#pragma unroll
            for (int mt = 0; mt < 4; ++mt) { au[mt] = (f32x4){0.f, 0.f, 0.f, 0.f}; aw[mt] = (f32x4){0.f, 0.f, 0.f, 0.f}; }
            bf16x8 bv[2], bk[2], at[2][4];
#pragma unroll
            for (int ks = 0; ks < 2; ++ks) {
                bv[ks] = *(const LAS bf16x8*)(VbT + (16 * wave + fr) * 72 + 32 * ks + 8 * fq);
                bk[ks] = *(const LAS bf16x8*)(KbT + (16 * wave + fr) * 72 + 32 * ks + 8 * fq);
#pragma unroll
                for (int mt = 0; mt < 4; ++mt) at[ks][mt] = *(const LAS bf16x8*)(Tb + (16 * mt + fr) * 72 + 32 * ks + 8 * fq);
            }
            asm volatile("" ::: "memory");
#pragma unroll
            for (int ks = 0; ks < 2; ++ks)
#pragma unroll
                for (int mt = 0; mt < 4; ++mt) {
                    au[mt] = __builtin_amdgcn_mfma_f32_16x16x32_bf16(at[ks][mt], bv[ks], au[mt], 0, 0, 0);
                    aw[mt] = __builtin_amdgcn_mfma_f32_16x16x32_bf16(at[ks][mt], bk[ks], aw[mt], 0, 0, 0);
                }
#pragma unroll
            for (int mt = 0; mt < 4; ++mt)
#pragma unroll
                for (int jj = 0; jj < 4; ++jj)
                    cW[((mt * 4 + (wave >> 1)) * 64 + (fr >> 2) * 16 + 4 * fq + jj) * 8 + (wave & 1) * 4 + (fr & 3)] = f2bf(aw[mt][jj]);
            {
                u32x4 u0, u1;
                u0[0] = pk2(au[0][0], au[0][1]); u0[1] = pk2(au[0][2], au[0][3]); u0[2] = pk2(au[1][0], au[1][1]); u0[3] = pk2(au[1][2], au[1][3]);
                u1[0] = pk2(au[2][0], au[2][1]); u1[1] = pk2(au[2][2], au[2][3]); u1[2] = pk2(au[3][0], au[3][1]); u1[3] = pk2(au[3][2], au[3][3]);
                bf16_t* ud = cU + (wave * 64 + lane) * 16;
                *(u32x4*)ud = u0; *(u32x4*)(ud + 8) = u1;
            }
        }
    }
}
DI bf16x8 pk8(f32x4 a, f32x4 b) { u32x4 r; r[0] = pk2(a[0], a[1]); r[1] = pk2(a[2], a[3]); r[2] = pk2(b[0], b[1]); r[3] = pk2(b[2], b[3]); return __builtin_bit_cast(bf16x8, r); }
constexpr int SC_PFD = 3;
DI bf16x8 ldfrag(const bf16_t* p) { return __builtin_bit_cast(bf16x8, *(const u32x4*)p); }
PF void dn_scan(const KC& k, LAS unsigned char* lds, int pm) {
    const int tid = TID(), lane = tid & 63, fr = lane & 15, fq = lane >> 4;
    const int wave = __builtin_amdgcn_readfirstlane(tid >> 6);
    const bf16_t* CH = (const bf16_t*)(k.ws + AR_CHUNK);
    const bf16_t* ATT = (const bf16_t*)(k.ws + AR_HBUF);
    const float* EGL = (const float*)(k.ws + WS_EGL);
    bf16_t* O = (bf16_t*)(k.ws + (pm ? AR_UBUF : AR_PB));
    LAS float* eglL = (LAS float*)lds;
    LAS u32x4* sbx = (LAS u32x4*)(eglL + 272);
    LAS u32x4* vbx = sbx + 512;
    volatile LAS int* vflag = (volatile LAS int*)(vbx + 256);
    for (int un0 = blockIdx.x; un0 < 256; un0 += gridDim.x) {
        if ((pm == 2 && ((un0 >> 3) & 1)) || (pm == 3 && (un0 & 1))) continue;
        const int un = (gridDim.x == 256) ? ((un0 & 7) * 32 + (un0 >> 3)) : un0;
        const int sl = un & 7, chain = un >> 3, dir = chain & 1, h = (chain >> 1) & 7, b = chain >> 4;
        const int rstep = dir == 0 ? 1 : -1;
        const bf16_t* U0 = CH + (size_t)(chain * DN_STEPS) * 32768 + lane * 8;
        const bf16_t* A0 = ATT + (size_t)(chain * DN_STEPS) * 4096 + lane * 8;
        lds_barrier();
        if (tid < DN_STEPS) eglL[tid] = EGL[chain * DN_STEPS + tid];
        if (tid == 0) *vflag = 0;
        if (wave == 0) {
            f32x4 S[8];
#pragma unroll
            for (int t = 0; t < 8; ++t) S[t] = (f32x4){0.f, 0.f, 0.f, 0.f};
            bf16x8 fw[16], fk[16]; u32x4 uc[2];
#pragma unroll
            for (int i = 0; i < 16; ++i) { fw[i] = ldfrag(U0 + i * 512); fk[i] = ldfrag(U0 + 16384 + i * 512); }
            { const bf16_t* up = U0 - lane * 8 + 24576 + (sl * 64 + lane) * 16; uc[0] = *(const u32x4*)up; uc[1] = *(const u32x4*)(up + 8); }
#pragma unroll
            for (int ks = 0; ks < 4; ++ks) sbx[ks * 64 + lane] = (u32x4){0u, 0u, 0u, 0u};
#pragma unroll
            for (int i = 0; i < 16; ++i) { asm volatile("" :: "v"(__builtin_bit_cast(u32x4, fw[i]))); asm volatile("" :: "v"(__builtin_bit_cast(u32x4, fk[i]))); }
            asm volatile("" :: "v"(uc[0]), "v"(uc[1]));
            lds_barrier();
#pragma unroll 1
            for (int s = 0; s < DN_STEPS; ++s) {
                const int sn = pm == 1 ? 0 : s + 1 < DN_STEPS ? s + 1 : s;
                const bf16_t* Un = U0 + (size_t)sn * 32768;
                const float egl = eglL[s];
                bf16x8 sb[4];
#pragma unroll
                for (int ks = 0; ks < 4; ++ks) sb[ks] = pk8(S[2 * ks], S[2 * ks + 1]);
                f32x4 p[4];
#pragma unroll
                for (int mt = 0; mt < 4; ++mt) p[mt] = (f32x4){0.f, 0.f, 0.f, 0.f};
#pragma unroll
                for (int ks = 0; ks < 4; ++ks)
#pragma unroll
                    for (int mt = 0; mt < 4; ++mt) {
                        p[mt] = __builtin_amdgcn_mfma_f32_16x16x32_bf16(fw[mt * 4 + ks], sb[ks], p[mt], 0, 0, 0);
                        fw[mt * 4 + ks] = ldfrag(Un + (mt * 4 + ks) * 512);
                    }
#pragma unroll
                for (int mt = 0; mt < 4; ++mt) {
                    const unsigned ua = uc[mt >> 1][(mt & 1) * 2], ub = uc[mt >> 1][(mt & 1) * 2 + 1];
                    p[mt][0] = __uint_as_float(ua << 16) - p[mt][0]; p[mt][1] = __uint_as_float(ua & 0xffff0000u) - p[mt][1];
                    p[mt][2] = __uint_as_float(ub << 16) - p[mt][2]; p[mt][3] = __uint_as_float(ub & 0xffff0000u) - p[mt][3];
                }
                { const bf16_t* up = Un - lane * 8 + 24576 + (sl * 64 + lane) * 16; uc[0] = *(const u32x4*)up; uc[1] = *(const u32x4*)(up + 8); }
                bf16x8 vb[2];
                vb[0] = pk8(p[0], p[1]); vb[1] = pk8(p[2], p[3]);
                vbx[(s & 1) * 64 + lane] = __builtin_bit_cast(u32x4, vb[0]); vbx[(s & 1) * 64 + 128 + lane] = __builtin_bit_cast(u32x4, vb[1]);
                asm volatile("s_waitcnt lgkmcnt(0)" ::: "memory");
                if (lane == 0) *vflag = s + 1;
#pragma unroll
                for (int t = 0; t < 8; ++t) S[t] = S[t] * egl;
#pragma unroll
                for (int kc = 0; kc < 2; ++kc)
#pragma unroll
                    for (int t = 0; t < 8; ++t) {
                        S[t] = __builtin_amdgcn_mfma_f32_16x16x32_bf16(fk[t * 2 + kc], vb[kc], S[t], 0, 0, 0);
                        fk[t * 2 + kc] = ldfrag(Un + 16384 + (t * 2 + kc) * 512);
                    }
#pragma unroll
                for (int ks = 0; ks < 4; ++ks) sbx[((s + 1) & 1) * 256 + ks * 64 + lane] = __builtin_bit_cast(u32x4, pk8(S[2 * ks], S[2 * ks + 1]));
                lds_barrier();
            }
        } else if (wave == 1) {
            bf16x8 fqd[16], fat[8];
#pragma unroll
            for (int i = 0; i < 16; ++i) fqd[i] = ldfrag(U0 + 8192 + i * 512);
#pragma unroll
            for (int i = 0; i < 8; ++i) fat[i] = ldfrag(A0 + i * 512);
#pragma unroll
            for (int i = 0; i < 16; ++i) asm volatile("" :: "v"(__builtin_bit_cast(u32x4, fqd[i])));
#pragma unroll
            for (int i = 0; i < 8; ++i) asm volatile("" :: "v"(__builtin_bit_cast(u32x4, fat[i])));
            f32x4 op[4];
#pragma unroll
            for (int mt = 0; mt < 4; ++mt) op[mt] = (f32x4){0.f, 0.f, 0.f, 0.f};
            lds_barrier();
#pragma unroll 1
            for (int s = 0; s < DN_STEPS; ++s) {
                const int sn = pm == 1 ? 0 : s + 1 < DN_STEPS ? s + 1 : s;
                const bf16_t* Un = U0 + (size_t)sn * 32768; const bf16_t* An = A0 + (size_t)sn * 4096;
                bf16x8 sb[4];
#pragma unroll
                for (int ks = 0; ks < 4; ++ks) sb[ks] = __builtin_bit_cast(bf16x8, sbx[(s & 1) * 256 + ks * 64 + lane]);
                {
                    const int sp = s > 0 ? s - 1 : 0; const int rbase = dn_rbase(b, dir, sp);
#pragma unroll
                    for (int mt = 0; mt < 4; ++mt)
#pragma unroll
                        for (int jj = 0; jj < 4; ++jj) {
                            const int row = rbase + rstep * (16 * mt + 4 * fq + jj);
                            O[((size_t)(pm ? 0 : dir) * T + row) * 1024 + h * 128 + sl * 16 + fr] = f2bf(op[mt][jj]);
                        }
                }
                f32x4 o[4];
#pragma unroll
                for (int mt = 0; mt < 4; ++mt) o[mt] = (f32x4){0.f, 0.f, 0.f, 0.f};
#pragma unroll
                for (int ks = 0; ks < 4; ++ks)
#pragma unroll
                    for (int mt = 0; mt < 4; ++mt) {
                        o[mt] = __builtin_amdgcn_mfma_f32_16x16x32_bf16(fqd[mt * 4 + ks], sb[ks], o[mt], 0, 0, 0);
                        fqd[mt * 4 + ks] = ldfrag(Un + 8192 + (mt * 4 + ks) * 512);
                    }
                while (*vflag < s + 1) __builtin_amdgcn_s_sleep(1);
                asm volatile("" ::: "memory");
                bf16x8 vb[2];
                vb[0] = __builtin_bit_cast(bf16x8, vbx[(s & 1) * 64 + lane]); vb[1] = __builtin_bit_cast(bf16x8, vbx[(s & 1) * 64 + 128 + lane]);
#pragma unroll
                for (int kc = 0; kc < 2; ++kc)
#pragma unroll
                    for (int mt = 0; mt < 4; ++mt) {
                        o[mt] = __builtin_amdgcn_mfma_f32_16x16x32_bf16(fat[mt * 2 + kc], vb[kc], o[mt], 0, 0, 0);
                        fat[mt * 2 + kc] = ldfrag(An + (mt * 2 + kc) * 512);
                    }
#pragma unroll
                for (int mt = 0; mt < 4; ++mt) op[mt] = o[mt];
                lds_barrier();
            }
            {
                const int rbase = dn_rbase(b, dir, DN_STEPS - 1);
#pragma unroll
                for (int mt = 0; mt < 4; ++mt)
#pragma unroll
                    for (int jj = 0; jj < 4; ++jj) {
                        const int row = rbase + rstep * (16 * mt + 4 * fq + jj);
                        O[((size_t)(pm ? 0 : dir) * T + row) * 1024 + h * 128 + sl * 16 + fr] = f2bf(op[mt][jj]);
                    }
            }
        } else if (wave == 2) {
            const unsigned char* P0 = (const unsigned char*)(CH + (size_t)(chain * DN_STEPS) * 32768 + sl * 4096) + lane * 64;
            const unsigned char* Q0 = (const unsigned char*)(ATT + (size_t)(chain * DN_STEPS) * 4096 + sl * 512) + (lane & 15) * 64;
            unsigned d0 = 0u, d1 = 0u, d2 = 0u;
            lds_barrier();
#pragma unroll 1
            for (int s = 0; s < DN_STEPS; ++s) {
                const int sp = pm == 1 ? 0 : s + SC_PFD < DN_STEPS ? s + SC_PFD : DN_STEPS - 1;
                const unsigned char* pa = P0 + (size_t)sp * 65536; const unsigned char* pb = pa + 4096; const unsigned char* qa = Q0 + (size_t)sp * 8192;
                asm volatile("global_load_dword %0, %3, off\n\tglobal_load_dword %1, %4, off\n\tglobal_load_dword %2, %5, off"
                             : "+v"(d0), "+v"(d1), "+v"(d2) : "v"(pa), "v"(pb), "v"(qa) : "memory");
                lds_barrier();
            }
            asm volatile("s_waitcnt vmcnt(0)" : "+v"(d0), "+v"(d1), "+v"(d2) :: "memory");
        } else {
            lds_barrier();
#pragma unroll 1
            for (int s = 0; s < DN_STEPS; ++s) lds_barrier();
        }
    }
}
PF void dn_finish(const KC& k, int j) {
    const int tid = TID(), lane = tid & 63, wave = tid >> 6;
    const bf16_t* O = (const bf16_t*)(k.ws + AR_PB);
    const bf16_t* Z = (const bf16_t*)k.out;
    bf16_t* U = (bf16_t*)(k.ws + AR_UBUF);
    const float* on = k.dn_out_norm + j * 128;
    const int c0 = lane * 16;
    float onv[16];
#pragma unroll
    for (int e = 0; e < 16; ++e) onv[e] = on[(c0 + e) & 127];
    for (int r = blockIdx.x * 8 + wave; r < T; r += gridDim.x * 8) {
        u32x4 vf[2], vb[2], vz[2];
#pragma unroll
        for (int hh = 0; hh < 2; ++hh) {
            vf[hh] = *(const u32x4*)(O + (size_t)r * 1024 + c0 + hh * 8); vb[hh] = *(const u32x4*)(O + ((size_t)T + r) * 1024 + c0 + hh * 8);
            vz[hh] = *(const u32x4*)(Z + (size_t)r * 1024 + c0 + hh * 8);
        }
        asm volatile("" ::: "memory");
        float o[16], z[16];
#pragma unroll
        for (int hh = 0; hh < 2; ++hh) { float a[8], b2[8], zz[8]; unpack8(vf[hh], a); unpack8(vb[hh], b2); unpack8(vz[hh], zz);
#pragma unroll
            for (int i = 0; i < 8; ++i) { o[hh * 8 + i] = a[i] + b2[i]; z[hh * 8 + i] = zz[i]; } }
        float ss = 0.f;
#pragma unroll
        for (int e = 0; e < 16; ++e) ss += o[e] * o[e];
        ss += shx(ss, 1, lane); ss += shx(ss, 2, lane); ss += shx(ss, 4, lane);
        const float rs = rsqrtf(ss * (1.0f / 128.0f) + EPS);
#pragma unroll
        for (int hh = 0; hh < 2; ++hh) { u32x4 ov;
#pragma unroll
            for (int w = 0; w < 4; ++w) { const int e0 = hh * 8 + 2 * w; ov[w] = pk2(o[e0] * rs * onv[e0] * siluf(z[e0]), o[e0 + 1] * rs * onv[e0 + 1] * siluf(z[e0 + 1])); }
            *(u32x4*)(U + (size_t)r * 1024 + c0 + hh * 8) = ov; }
    }
}

DI float conv3g(const bf16_t* p, int j, float w0, float w1, float w2) {
    const int gc = j & 63;
    const float l = gc != 0 ? bf2f(p[j - 1]) : 0.f, c = bf2f(p[j]), r = gc != 63 ? bf2f(p[j + 1]) : 0.f;
    return w0 * l + w1 * c + w2 * r;
}
DI float hy_conv_lane(float c, float w0, float w1, float w2, int lane) {
    const float l = shi(c, (lane + 63) & 63), r = shi(c, (lane + 1) & 63);
    return w0 * (lane > 0 ? l : 0.f) + w1 * c + w2 * (lane < 63 ? r : 0.f);
}
PF void hy_lat(const KC& k, int jl, LAS float* ldsf) {
    const int tid = TID();
    LAS cf* X = (LAS cf*)ldsf;
    LAS cf* tw = X + 17408;
    LAS cf* tA = tw + 1024; LAS cf* tB = tA + 128;
    const bf16_t* FT = (const bf16_t*)(k.ws + AR_FT);
    const bf16_t* PT = (const bf16_t*)(k.ws + AR_PB);
    bf16_t* ZT = (bf16_t*)(k.ws + AR_ZT);
    unsigned* scr = (unsigned*)(k.ws + AR_FFTS) + (size_t)blockIdx.x * 4 * 16384;
    unsigned* sKe = scr; unsigned* sKo = scr + 16384; unsigned* zp = scr + 2 * 16384; unsigned* ye = scr + 3 * 16384;
#define CPK(v) pk2((v).x, (v).y)
#define CUP(u_) ((cf){__uint_as_float((u_) << 16), __uint_as_float((u_) & 0xffff0000u)})
    const float* cw = k.hy_conv + (size_t)jl * 3 * 3072;
    for (int m = 0; m < 2; ++m) { const int p = tid + 512 * m; float sn, cs; sincospif(-(float)p / 8192.0f, &sn, &cs); cf w; w.x = cs; w.y = sn; tw[p] = w; }
    if (tid < 256) { const int a = tid & 127; float sn, cs; sincospif(-(float)(tid < 128 ? 128 * a : a) / 16384.0f, &sn, &cs); cf w; w.x = cs; w.y = sn; (tid < 128 ? tA : tB)[a] = w; }
    __syncthreads();
    const int lane = tid & 63;
#define HY_SPLIT() asm volatile("" ::: "memory")
#define HY_CONV(c, w0, w1, w2) hy_conv_lane((c), (w0), (w1), (w2), lane)
    for (int ch = blockIdx.x; ch < 1024; ch += gridDim.x) {
        {
            const bf16_t* pv = PT + (size_t)ch * T + TC;
            const float w0 = cw[ch], w1 = cw[3072 + ch], w2 = cw[6144 + ch];
            for (int m0 = 0; m0 < 32; m0 += 8) {
                bf16_t a0[8], a1[8];
#pragma unroll
                for (int q = 0; q < 8; ++q) { const int j = tid + 512 * (m0 + q); a0[q] = pv[j]; a1[q] = pv[SEQ + j]; }
                HY_SPLIT();
#pragma unroll
                for (int q = 0; q < 8; ++q) { const int j = tid + 512 * (m0 + q); const float c0 = bf2f(a0[q]), c1 = bf2f(a1[q]); cf z; z.x = HY_CONV(c0, w0, w1, w2); z.y = HY_CONV(c1, w0, w1, w2); zp[j] = CPK(z); }
            }
        }
        for (int n = 0; n < 2; ++n) {
            __syncthreads();
            const bf16_t* ftf = FT + (size_t)(n * 2048 + ch) * 16384; const bf16_t* ftb = FT + (size_t)(n * 2048 + 1024 + ch) * 16384;
            for (int m0 = 0; m0 < 32; m0 += 8) {
                bf16_t hfv[8], hbv[8];
#pragma unroll
                for (int q = 0; q < 8; ++q) { const int j = tid + 512 * (m0 + q); hfv[q] = ftf[j]; hbv[q] = ftb[j > 0 ? SEQ - j : 0]; }
                HY_SPLIT();
#pragma unroll
                for (int q = 0; q < 8; ++q) {
                    const int j = tid + 512 * (m0 + q);
                    const float hf = bf2f(hfv[q]), hb = j > 0 ? bf2f(hbv[q]) : 0.f;
                    const cf w = cmul(tA[j >> 7], tB[j & 127]);
                    cf a; a.x = hf + hb; a.y = 0.f; X[PIDX(j)] = a;
                    const float kd = hf - hb; cf o; o.x = kd * w.x; o.y = kd * w.y; sKo[j] = CPK(o);
                }
            }
            __syncthreads();
            fft16k_fwd(X, tw);
            unsigned Ker[32];
#pragma unroll
            for (int m = 0; m < 32; ++m) { const cf t_ = X[PIDX(tid + 512 * m)]; Ker[m] = CPK(t_); }
            __syncthreads();
            for (int m0 = 0; m0 < 32; m0 += 8) { unsigned t[8];
#pragma unroll
                for (int q = 0; q < 8; ++q) t[q] = sKo[tid + 512 * (m0 + q)];
                HY_SPLIT();
#pragma unroll
                for (int q = 0; q < 8; ++q) X[PIDX(tid + 512 * (m0 + q))] = CUP(t[q]); }
            __syncthreads();
            fft16k_fwd(X, tw);
            _Pragma("unroll 8") for (int m = 0; m < 32; ++m) { const int j = tid + 512 * m; const cf t_ = X[PIDX(j)]; sKo[j] = CPK(t_); }
            __syncthreads();
            for (int m0 = 0; m0 < 32; m0 += 8) { unsigned t[8];
#pragma unroll
                for (int q = 0; q < 8; ++q) t[q] = zp[tid + 512 * (m0 + q)];
                HY_SPLIT();
#pragma unroll
                for (int q = 0; q < 8; ++q) X[PIDX(tid + 512 * (m0 + q))] = CUP(t[q]); }
            __syncthreads();
            fft16k_fwd(X, tw);
#pragma unroll
            for (int m = 0; m < 32; ++m) { const int j = tid + 512 * m; X[PIDX(j)] = cmul(X[PIDX(j)], CUP(Ker[m])); }
            __syncthreads();
            fft16k_inv(X, tw);
            _Pragma("unroll 8") for (int m = 0; m < 32; ++m) { const int j = tid + 512 * m; const cf t_ = X[PIDX(j)]; ye[j] = CPK(t_); }
            __syncthreads();
            for (int m0 = 0; m0 < 32; m0 += 8) { unsigned t[8];
#pragma unroll
                for (int q = 0; q < 8; ++q) t[q] = zp[tid + 512 * (m0 + q)];
                HY_SPLIT();
#pragma unroll
                for (int q = 0; q < 8; ++q) { const int j = tid + 512 * (m0 + q); const cf w = cmul(tA[j >> 7], tB[j & 127]); X[PIDX(j)] = cmul(CUP(t[q]), w); } }
            __syncthreads();
            fft16k_fwd(X, tw);
            for (int m0 = 0; m0 < 32; m0 += 8) { unsigned t[8];
#pragma unroll
                for (int q = 0; q < 8; ++q) t[q] = sKo[tid + 512 * (m0 + q)];
                HY_SPLIT();
#pragma unroll
                for (int q = 0; q < 8; ++q) { const int j = tid + 512 * (m0 + q); X[PIDX(j)] = cmul(X[PIDX(j)], CUP(t[q])); } }
            __syncthreads();
            fft16k_inv(X, tw);
            {
                const bf16_t* pg = PT + (size_t)((n + 1) * 1024 + ch) * T + TC;
                const int gcol = (n + 1) * 1024 + ch;
                const float w0 = cw[gcol], w1 = cw[3072 + gcol], w2 = cw[6144 + gcol];
                const float bias = k.hy_bias[(size_t)jl * 2 * 1024 + n * 1024 + ch];
                for (int m0 = 0; m0 < 32; m0 += 8) {
                    unsigned te_[8], tz_[8]; bf16_t g0[8], g1[8];
#pragma unroll
                    for (int q = 0; q < 8; ++q) { const int j = tid + 512 * (m0 + q); te_[q] = ye[j]; tz_[q] = zp[j]; g0[q] = pg[j]; g1[q] = pg[SEQ + j]; }
                    HY_SPLIT();
#pragma unroll
                    for (int q = 0; q < 8; ++q) {
                        const int j = tid + 512 * (m0 + q);
                        cf w = cmul(tA[j >> 7], tB[j & 127]); w.y = -w.y;
                        const cf yo = cmul(X[PIDX(j)], w);
                        const cf te = CUP(te_[q]), tz = CUP(tz_[q]);
                        const float y0 = (0.5f / 16384.0f) * (te.x + yo.x), y1 = (0.5f / 16384.0f) * (te.y + yo.y);
                        const float c0 = bf2f(g0[q]), c1 = bf2f(g1[q]);
                        cf zn; zn.x = HY_CONV(c0, w0, w1, w2) * (y0 + bias * tz.x); zn.y = HY_CONV(c1, w0, w1, w2) * (y1 + bias * tz.y);
                        zp[j] = CPK(zn);
                    }
                }
            }
        }
        for (int m0 = 0; m0 < 32; m0 += 8) { unsigned t[8];
#pragma unroll
            for (int q = 0; q < 8; ++q) t[q] = zp[tid + 512 * (m0 + q)];
            HY_SPLIT();
#pragma unroll
            for (int q = 0; q < 8; ++q) { const int j = tid + 512 * (m0 + q); ZT[(size_t)ch * T + TC + j] = (bf16_t)(t[q] & 0xffffu); ZT[(size_t)ch * T + TC + SEQ + j] = (bf16_t)(t[q] >> 16); } }
        __syncthreads();
    }
#undef CPK
#undef CUP
#undef HY_SPLIT
#undef HY_CONV
}
PF void hy_ctx(const KC& k, int jl, LAS float* lds) {
    const int tid = TID(), t = tid & 255, hsel = tid >> 8;
    LAS float* z = lds + hsel * 768; LAS float* hf = z + 256; LAS float* hb = hf + 256;
    const bf16_t* PT = (const bf16_t*)(k.ws + AR_PB);
    bf16_t* U = (bf16_t*)(k.ws + AR_UBUF);
    const float* filtc = (const float*)(k.ws + WS_FILTC);
    const float* cw = k.hy_conv + (size_t)jl * 3 * 3072;
    for (int u = blockIdx.x; u < 1024; u += gridDim.x) {
        const int pr = u * 2 + hsel, b = pr >> 10, ch = pr & 1023;
        float zc;
        {
            const bf16_t* pv = PT + (size_t)ch * T + b * 256;
            const float l = t != 0 ? bf2f(pv[t - 1]) : 0.f, c = bf2f(pv[t]), r = t != 255 ? bf2f(pv[t + 1]) : 0.f;
            zc = cw[ch] * l + cw[3072 + ch] * c + cw[6144 + ch] * r;
        }
        for (int n = 0; n < 2; ++n) {
            __syncthreads();
            z[t] = zc; hf[t] = filtc[(size_t)t * 4096 + n * 2048 + ch]; hb[t] = filtc[(size_t)t * 4096 + n * 2048 + 1024 + ch];
            __syncthreads();
            float y = 0.f;
            for (int s = 0; s <= t; ++s) y += hf[t - s] * z[s];
            for (int s = t + 1; s < 256; ++s) y += hb[s - t] * z[s];
            const int gcol = (n + 1) * 1024 + ch;
            const bf16_t* pg = PT + (size_t)gcol * T + b * 256;
            const float l = t != 0 ? bf2f(pg[t - 1]) : 0.f, c = bf2f(pg[t]), r = t != 255 ? bf2f(pg[t + 1]) : 0.f;
            const float gate = cw[gcol] * l + cw[3072 + gcol] * c + cw[6144 + gcol] * r;
            zc = gate * (y + k.hy_bias[(size_t)jl * 2048 + n * 1024 + ch] * zc);
        }
        U[(size_t)(b * 256 + t) * 1024 + ch] = f2bf(zc);
        __syncthreads();
    }
}
PF void hy_transpose(const KC& k, LAS bf16_t* lds) {
    const int tid = TID();
    const bf16_t* ZT = (const bf16_t*)(k.ws + AR_ZT);
    bf16_t* U = (bf16_t*)(k.ws + AR_UBUF);
    for (int u = blockIdx.x; u < 16 * (TL / 64); u += gridDim.x) {
        const int c0 = (u & 15) * 64, r0 = TC + (u >> 4) * 64;
        { const int c = tid >> 3, sg = (tid & 7) * 8;
          const u32x4 v = *(const u32x4*)(ZT + (size_t)(c0 + c) * T + r0 + sg);
#pragma unroll
          for (int w = 0; w < 4; ++w) { lds[(sg + 2 * w) * 66 + c] = (bf16_t)(v[w] & 0xffff); lds[(sg + 2 * w + 1) * 66 + c] = (bf16_t)(v[w] >> 16); } }
        __syncthreads();
        { const int r = tid >> 3, sg = (tid & 7) * 8; u32x4 o;
#pragma unroll
          for (int w = 0; w < 4; ++w) o[w] = (unsigned)lds[r * 66 + sg + 2 * w] | ((unsigned)lds[r * 66 + sg + 2 * w + 1] << 16);
          *(u32x4*)(U + (size_t)(r0 + r) * 1024 + c0 + sg) = o; }
        __syncthreads();
    }
}

__global__ void __launch_bounds__(NTHR, 2) fwd_kernel(Params prm) {
    extern __shared__ __attribute__((aligned(16))) unsigned char lds_raw[];
    LAS unsigned char* lds = (LAS unsigned char*)lds_raw;
    LAS float* ldsf = (LAS float*)lds;
    LAS bf16_t* ldsh = (LAS bf16_t*)lds;
    LAS int* tb = (LAS int*)(lds + 150 * 1024);
    volatile LAS unsigned* xbw = (volatile LAS unsigned*)(lds + 151 * 1024 + 512);
    KC k;
    k.x = (const float*)(GAS const float*)prm.in[0]; k.c = (const float*)(GAS const float*)prm.in[1]; k.ctx = (const float*)(GAS const float*)prm.in[2]; k.c_ctx = (const float*)(GAS const float*)prm.in[3]; k.ada_w = (const float*)(GAS const float*)prm.in[4]; k.ada_b = (const float*)(GAS const float*)prm.in[5];
    k.norm_mix = (const float*)(GAS const float*)prm.in[6]; k.norm_ffn = (const float*)(GAS const float*)prm.in[7]; k.norm_final = (const float*)(GAS const float*)prm.in[8];
    k.dn_w_in = (const float*)(GAS const float*)prm.in[9]; k.dn_conv = (const float*)(GAS const float*)prm.in[10]; k.dn_a_log = (const float*)(GAS const float*)prm.in[11]; k.dn_dt_bias = (const float*)(GAS const float*)prm.in[12]; k.dn_out_norm = (const float*)(GAS const float*)prm.in[13]; k.dn_w_out = (const float*)(GAS const float*)prm.in[14];
    k.hy_w_in = (const float*)(GAS const float*)prm.in[15]; k.hy_conv = (const float*)(GAS const float*)prm.in[16]; k.hy_f_w1 = (const float*)(GAS const float*)prm.in[17]; k.hy_f_b1 = (const float*)(GAS const float*)prm.in[18]; k.hy_f_freq = (const float*)(GAS const float*)prm.in[19]; k.hy_f_w2 = (const float*)(GAS const float*)prm.in[20];
    k.hy_f_b2 = (const float*)(GAS const float*)prm.in[21]; k.hy_f_w3 = (const float*)(GAS const float*)prm.in[22]; k.hy_bias = (const float*)(GAS const float*)prm.in[23]; k.hy_w_out = (const float*)(GAS const float*)prm.in[24];
    k.sc_w_in = (const float*)(GAS const float*)prm.in[25]; k.sc_conv = (const float*)(GAS const float*)prm.in[26]; k.sc_w_out = (const float*)(GAS const float*)prm.in[27]; k.w_router = (const float*)(GAS const float*)prm.in[28]; k.router_bias = (const float*)(GAS const float*)prm.in[29];
    k.moe_w_gate = (const float*)(GAS const float*)prm.in[30]; k.moe_w_up = (const float*)(GAS const float*)prm.in[31]; k.moe_w_down = (const float*)(GAS const float*)prm.in[32];
    k.out = (float*)(GAS float*)prm.out; k.ws = (unsigned char*)(GAS unsigned char*)prm.ws;
    const int lo = prm.ph_lo, hi = prm.ph_hi;
    XcdBarrier bar; bar.bar = (unsigned*)(k.ws + WS_CTL); bar.x = 0; bar.st = xbw;
    if (hi - lo > 1) {
        if (threadIdx.x == 0) { xbw[0] = 0u; xbw[1] = 0u; }
        __syncthreads();
        bar = xcd_barrier_post((unsigned*)(k.ws + WS_CTL), xbw);
    }
    int ph = 0;
#define PROBE_OK(id) ((id) != 1 || i == 0)
    int i = 0;
#define PH_BEGIN(id) if (ph >= lo && ph < hi) { const int nrep_ = (((id) == PROBE_REP) && PROBE_OK(id)) ? 2 : 1; for (int rep_ = 0; rep_ < nrep_; ++rep_) { { GAS unsigned char* w_ = (GAS unsigned char*)k.ws; asm volatile("" : "+s"(w_)); k.ws = (unsigned char*)w_; }
#define PH_END   if (ph + 1 < hi) xcd_barrier(bar); } } ++ph;

    float* xs = (float*)(k.ws + WS_XS);
    const float* mod = (const float*)(k.ws + WS_MOD);

    PH_BEGIN(0)
        job_mod(k, ldsf);
        job_cvt_small(k, ldsf);
        job_hdn(k, ldsf);
        job_w3s(k);
    PH_END

    for (i = 0; i < DEPTH; ++i) {
        const int kind = i % 3, j = i / 3;
        const bool last = (i == DEPTH - 1);
        PH_BEGIN(1)
            if (kind == 0) norm_mfma<2>(k, i, i == 0, i > 0, k.norm_mix + i * 1024, 0, k.dn_w_in + (size_t)j * 1024 * DN_IN + 4096, DN_IN,
                                        k.dn_a_log + j * 16, k.dn_dt_bias + j * 16, last, lds);
            else norm_vec<0>(k, i, k.norm_mix + i * 1024, 0);
            if (kind == 1) job_filtc(k, j);
        PH_END
        PH_BEGIN(2)
            if (kind == 0) { EpiBf16 e{(bf16_t*)(k.ws + AR_PB), 3072, 3072, (bf16_t*)k.out, 1024}; gemm_dense(lds, (const bf16_t*)(k.ws + AR_HBUF), T, (const bf16_t*)(k.ws + WS_DNWIN) + (size_t)j * 4096 * 1024, 4096, 1024, e); }
            else if (kind == 1) { EpiBf16T e{(bf16_t*)(k.ws + AR_PB), T}; gemm_dense(lds, (const bf16_t*)(k.ws + AR_HBUF), T, (const bf16_t*)(k.ws + WS_HYWIN), 3072, 1024, e);
                                  EpiTaps et{(bf16_t*)(k.ws + AR_FT)}; gemm_dense(lds, (const bf16_t*)(k.ws + WS_W3S), 4096, (const bf16_t*)(k.ws + WS_HS), 16384, 256, et); }
            else { EpiBf16 e{(bf16_t*)(k.ws + AR_PB), 3072, 1 << 30, nullptr, 0}; gemm_dense(lds, (const bf16_t*)(k.ws + AR_HBUF), T, (const bf16_t*)(k.ws + WS_SCWIN), 3072, 1024, e); }
        PH_END
        if (kind == 0) {
            PH_BEGIN(3) dn_chunk(k, j, lds); PH_END
            PH_BEGIN(4) dn_scan(k, lds, rep_ ? PROBE_MODE : 0); PH_END
            PH_BEGIN(5) dn_finish(k, j); PH_END
        } else if (kind == 1) {
            PH_BEGIN(6) hy_lat(k, j, ldsf); hy_ctx(k, j, ldsf); PH_END
            PH_BEGIN(7) hy_transpose(k, ldsh); PH_END
        } else {
            PH_BEGIN(8) sc_mix(k, j); PH_END
        }
        PH_BEGIN(9)
            const bf16_t* Wt = kind == 0 ? (const bf16_t*)(k.ws + WS_DNWOUT) + (size_t)j * 1024 * 1024 : (kind == 1 ? (const bf16_t*)(k.ws + WS_HYWOUT) : (const bf16_t*)(k.ws + WS_SCWOUT));
            EpiResid e{xs, mod, i, 2};
            gemm_dense(lds, (const bf16_t*)(k.ws + AR_UBUF), T, Wt, 1024, 1024, e);
            if (gridDim.x == 256) job_cvt_moe(k, i, ldsf, (int)blockIdx.x - 8, 248); else job_cvt_moe(k, i, ldsf, (int)blockIdx.x, (int)gridDim.x);
        PH_END
        PH_BEGIN(10)
            norm_mfma<1>(k, i, false, false, k.norm_ffn + i * 1024, 3, k.w_router, 32, k.router_bias, nullptr, last, lds, rep_ == nrep_ - 1);
        PH_END
        PH_BEGIN(11)
            moe_scatter(k, i, tb);
        PH_END
        PH_BEGIN(12) moe_gemm<0>(k, i, lds, tb); PH_END
        PH_BEGIN(13) moe_gemm<1>(k, i, lds, tb); PH_END
    }
    PH_BEGIN(14)
        norm_vec<3>(k, DEPTH, k.norm_final, 0);
    PH_END
#undef PH_BEGIN
#undef PH_END
}
constexpr int N_PHASES = 1 + (10 + 9 + 8 + 10) + 1;

extern "C" void kernel_launch(void* const* d_in, const int* in_sizes, int n_in, void* d_out, int out_size, void* d_ws, size_t ws_size, hipStream_t stream) {
    static int grid = 0;
    if (grid == 0) {
        if (n_in != 33 || out_size != TL * D || ws_size < WS_END) { fprintf(stderr, "kernel_launch: unexpected shapes: n_in %d out %d ws %zu (need %zu)\n", n_in, out_size, ws_size, (size_t)WS_END); grid = -1; return; }
        int dev = 0, cus = 0, per_cu = 0;
        if (hipGetDevice(&dev) != hipSuccess || hipDeviceGetAttribute(&cus, hipDeviceAttributeMultiprocessorCount, dev) != hipSuccess) { grid = -1; return; }
        if (hipFuncSetAttribute((const void*)fwd_kernel, hipFuncAttributeMaxDynamicSharedMemorySize, LDS_BYTES) != hipSuccess) { fprintf(stderr, "kernel_launch: hipFuncSetAttribute failed\n"); grid = -1; return; }
        if (hipOccupancyMaxActiveBlocksPerMultiprocessor(&per_cu, (const void*)fwd_kernel, NTHR, LDS_BYTES) != hipSuccess || per_cu < 1) fprintf(stderr, "kernel_launch: occupancy query reports %d\n", per_cu);
        (void)hipGetLastError();
        grid = cus;
    }
    if (grid < 0) return;
    (void)hipMemsetAsync((char*)d_ws + WS_CTL, 0, CTL_BYTES, stream);
    Params p{};
    for (int i = 0; i < 33; ++i) p.in[i] = (const float*)d_in[i];
    p.out = (float*)d_out; p.ws = (unsigned char*)d_ws;
#if MK_MULTI
    for (int ph = 0; ph < N_PHASES; ++ph) { p.ph_lo = ph; p.ph_hi = ph + 1; hipLaunchKernelGGL(fwd_kernel, dim3(grid), dim3(NTHR), LDS_BYTES, stream, p); }
#else
    p.ph_lo = 0; p.ph_hi = N_PHASES;
    hipLaunchKernelGGL(fwd_kernel, dim3(grid), dim3(NTHR), LDS_BYTES, stream, p);
#endif
}
```

```cpp
#include <hip/hip_runtime.h>
#include <stdint.h>
#include <stdio.h>
#include <math.h>

#ifndef MK_MULTI
#define MK_MULTI 0
#endif

#ifndef PROBE_SUB
#define PROBE_SUB (0)
#endif
#ifndef PROBE_MODE
#define PROBE_MODE (1)
#endif
#ifndef PROBE_REP
#define PROBE_REP (-1)
#endif
#define LAS __attribute__((address_space(3)))
#define GAS __attribute__((address_space(1)))
#define HD __host__ __device__ __forceinline__
#define DI __device__ __forceinline__
#ifdef NOINL
#define PF __device__ __noinline__
#else
#define PF __device__ __forceinline__
#endif
typedef unsigned short bf16_t;
typedef short bf16x8 __attribute__((ext_vector_type(8)));
typedef float f32x4 __attribute__((ext_vector_type(4)));
typedef unsigned u32x4 __attribute__((ext_vector_type(4)));
typedef unsigned u32x2 __attribute__((ext_vector_type(2)));

constexpr int D = 1024, NB = 2, SEQ = 16384, CTXL = 256, DEPTH = 4;
constexpr int TC = NB * CTXL, TL = NB * SEQ, T = TC + TL, NA = 2 * T;
constexpr int NTHR = 512;
constexpr int DN_IN = 4128;
constexpr float EPS = 1e-6f;
constexpr int LDS_BYTES = 152 * 1024;

constexpr size_t AL(size_t x) { return (x + 255) & ~(size_t)255; }
constexpr size_t WS_CTL = 0;
constexpr size_t CTL_BYTES = 65536;
constexpr size_t CTL_CNT = 16384;
constexpr size_t WS_MOD = WS_CTL + CTL_BYTES;
constexpr size_t WS_HS = AL(WS_MOD + 4 * 3 * 6144 * 4);
constexpr size_t WS_W3S = AL(WS_HS + 16384 * 256 * 2);
constexpr size_t WS_HDNC = AL(WS_W3S + 4096 * 256 * 2);
constexpr size_t WS_FILTC = AL(WS_HDNC + 256 * 64 * 4);
constexpr size_t WS_DNWIN = AL(WS_FILTC + 256 * 4096 * 4);
constexpr size_t WS_DNWOUT = AL(WS_DNWIN + (size_t)2 * 4096 * 1024 * 2);
constexpr size_t WS_HYWIN = AL(WS_DNWOUT + (size_t)2 * 1024 * 1024 * 2);
constexpr size_t WS_HYWOUT = AL(WS_HYWIN + (size_t)3072 * 1024 * 2);
constexpr size_t WS_SCWIN = AL(WS_HYWOUT + (size_t)1024 * 1024 * 2);
constexpr size_t WS_SCWOUT = AL(WS_SCWIN + (size_t)3072 * 1024 * 2);
constexpr size_t WS_XS = AL(WS_SCWOUT + (size_t)1024 * 1024 * 2);
constexpr size_t WS_TOKE = AL(WS_XS + (size_t)T * 1024 * 4);
constexpr size_t WS_TOKW = AL(WS_TOKE + (size_t)T * 2 * 4);
constexpr size_t WS_TOKP = AL(WS_TOKW + (size_t)T * 2 * 4);
constexpr size_t WS_SLOT = AL(WS_TOKP + (size_t)T * 2 * 4);
constexpr size_t WS_GB = AL(WS_SLOT + (size_t)(NA + 256) * 4);
constexpr size_t WS_EGL = AL(WS_GB + (size_t)T * 32 * 4);
constexpr size_t WS_AR = AL(WS_EGL + (size_t)32 * 260 * 4);
constexpr size_t AR_HBUF = WS_AR;
constexpr size_t AR_UBUF = AR_HBUF + (size_t)T * 1024 * 2;
constexpr size_t AR_PB = AR_UBUF + (size_t)T * 1024 * 2;
constexpr size_t AR_Q = AR_PB + (size_t)T * 4096 * 2;
constexpr size_t AR_CHUNK = AR_PB + (size_t)T * 3072 * 2;
constexpr size_t AR_DN_END = AR_CHUNK + (size_t)32 * 260 * 65536;
constexpr size_t AR_ZT = AR_Q;
constexpr size_t AR_FFTS = AR_ZT + (size_t)1024 * T * 2;
constexpr size_t AR_FT = AR_FFTS + (size_t)256 * 4 * 16384 * 8;
constexpr size_t AR_HY_END = AR_FT + (size_t)4096 * 16384 * 4;
constexpr size_t AR_HID = AR_PB;
constexpr size_t AR_YS = AR_HID + (size_t)NA * 512 * 2;
constexpr size_t AR_WGU = AR_YS + (size_t)NA * 1024 * 2;
constexpr size_t AR_WD = AR_WGU + (size_t)32 * 1024 * 1024 * 2;
constexpr size_t AR_MOE_END = AR_WD + (size_t)32 * 1024 * 512 * 2;
constexpr size_t WS_END = AR_DN_END > AR_HY_END ? (AR_DN_END > AR_MOE_END ? AR_DN_END : AR_MOE_END) : (AR_HY_END > AR_MOE_END ? AR_HY_END : AR_MOE_END);

#define XB_TMO      128
#define XB_XCNT(j)  (256  + 64 * (j))
#define XB_XSUB(j)  (1280 + 64 * (j))
#define XB_XGEN(j)  (2304 + 64 * (j))
#define XB_TOP      3328
#define XB_TOPGEN   3392
#define XCD_BAR_WORDS 3456
#define XB_SPIN_CAP (1u << 25)
DI unsigned xb_ld(unsigned* p)              { return __hip_atomic_load(p, __ATOMIC_RELAXED, __HIP_MEMORY_SCOPE_AGENT); }
DI unsigned xb_add(unsigned* p, unsigned v) { return __hip_atomic_fetch_add(p, v, __ATOMIC_RELAXED, __HIP_MEMORY_SCOPE_AGENT); }
DI unsigned xb_xcc_id() { return (unsigned)__builtin_amdgcn_s_getreg((3 << 11) | 20) & 0xFu; }
#define XB_SPIN(cond, bar) do { unsigned _sp = 0; while (cond) { __builtin_amdgcn_s_sleep(1); \
    if ((++_sp & 255u) == 0u) { if (xb_ld(&(bar)[XB_TMO])) break; if (_sp > XB_SPIN_CAP) { atomicAdd(&(bar)[XB_TMO], 1u); break; } } } } while (0)
struct XcdBarrier { unsigned* bar; unsigned x; volatile LAS unsigned* st; };
DI XcdBarrier xcd_barrier_post(unsigned* bar, volatile LAS unsigned* st) {
    XcdBarrier b; b.bar = bar; b.x = xb_xcc_id(); b.st = st;
    if (threadIdx.x == 0) (void)xb_add(&bar[XB_XCNT(b.x)], 1u);
    return b;
}
DI void xcd_barrier_complete(unsigned* bar, unsigned x, unsigned& nloc, unsigned& nx) {
    const unsigned G = gridDim.x * gridDim.y * gridDim.z;
    unsigned sum, cnt, mine, sp = 0u;
    for (;;) {
        sum = 0u; cnt = 0u; mine = 0u;
#pragma unroll
        for (unsigned j = 0; j < 16; ++j) { const unsigned c = xb_ld(&bar[XB_XCNT(j)]); sum += c; cnt += (c > 0u) ? 1u : 0u; mine = (j == x) ? c : mine; }
        if (sum == G) break;
        __builtin_amdgcn_s_sleep(1);
        if ((++sp & 255u) == 0u) { if (xb_ld(&bar[XB_TMO])) break; if (sp > XB_SPIN_CAP) { atomicAdd(&bar[XB_TMO], 1u); break; } }
    }
    nloc = mine > 0u ? mine : 1u; nx = cnt > 0u ? cnt : 1u;
}
DI void xcd_barrier(const XcdBarrier& b) {
    asm volatile("s_waitcnt vmcnt(0)" ::: "memory");
    __syncthreads();
    if (threadIdx.x == 0) {
        unsigned* bar = b.bar;
        __builtin_amdgcn_s_waitcnt(0);
        unsigned nloc = b.st[0], nx = b.st[1];
        if (nloc == 0u) { xcd_barrier_complete(bar, b.x, nloc, nx); b.st[0] = nloc; b.st[1] = nx; }
        const unsigned old = xb_add(&bar[XB_XSUB(b.x)], 1u);
        const unsigned gen = old / nloc;
        if (old + 1u == (gen + 1u) * nloc) {
            __builtin_amdgcn_fence(__ATOMIC_RELEASE, "agent");
            asm volatile("s_waitcnt vmcnt(0)" ::: "memory");
            const unsigned og = xb_add(&bar[XB_TOP], 1u);
            const unsigned tg = og / nx;
            if (og + 1u == (tg + 1u) * nx) xb_add(&bar[XB_TOPGEN], 1u);
            else XB_SPIN(xb_ld(&bar[XB_TOPGEN]) == tg, bar);
            __builtin_amdgcn_fence(__ATOMIC_ACQUIRE, "agent");
            xb_add(&bar[XB_XGEN(b.x)], 1u);
            asm volatile("s_waitcnt vmcnt(0)" ::: "memory");
        } else {
            XB_SPIN(xb_ld(&bar[XB_XGEN(b.x)]) == gen, bar);
            __builtin_amdgcn_fence(__ATOMIC_ACQUIRE, "agent");
            asm volatile("s_waitcnt vmcnt(0)" ::: "memory");
        }
    }
    __syncthreads();
}

typedef float f32x2_t __attribute__((ext_vector_type(2)));
typedef __bf16 bf16x2_t __attribute__((ext_vector_type(2)));
DI unsigned cvt_pk_bf16(float lo, float hi) { f32x2_t v; v.x = lo; v.y = hi; const bf16x2_t b = __builtin_convertvector(v, bf16x2_t); return __builtin_bit_cast(unsigned, b); }
DI bf16_t f2bf(float f) { return (bf16_t)(cvt_pk_bf16(f, f) & 0xffffu); }
DI float bf2f(bf16_t b) { return __uint_as_float(((unsigned)b) << 16); }
DI unsigned pk2(float lo, float hi) { return cvt_pk_bf16(lo, hi); }
DI float siluf(float x) { return x * __builtin_amdgcn_rcpf(1.0f + __expf(-x)); }
DI float sigmf(float x) { return 1.0f / (1.0f + __expf(-x)); }
DI float shi(float v, int src) { return __int_as_float(__builtin_amdgcn_ds_bpermute(src << 2, __float_as_int(v))); }
DI int shii(int v, int src) { return __builtin_amdgcn_ds_bpermute(src << 2, v); }
DI float shx(float v, int m, int lane) { return shi(v, lane ^ m); }
DI float wsum(float v, int lane) {
#pragma unroll
    for (int m = 32; m >= 1; m >>= 1) v += shx(v, m, lane);
    return v;
}
DI void lds_barrier() { asm volatile("s_waitcnt lgkmcnt(0)\n\ts_barrier" ::: "memory"); }
DI int TID() { int t = threadIdx.x; asm volatile("" : "+v"(t)); return t; }
DI int modrow(int r) { return r < TC ? 0 : 1 + (r - TC) / SEQ; }

typedef float cf __attribute__((ext_vector_type(2)));
HD cf cmul(cf a, cf b) { cf r; r.x = a.x * b.x - a.y * b.y; r.y = a.x * b.y + a.y * b.x; return r; }
HD cf cadd(cf a, cf b) { cf r; r.x = a.x + b.x; r.y = a.y + b.y; return r; }
HD cf csub(cf a, cf b) { cf r; r.x = a.x - b.x; r.y = a.y - b.y; return r; }
template <int R> HD constexpr int brev(int i) { int r = 0; for (int b = 1, t = R >> 1; b < R; b <<= 1, t >>= 1) if (i & b) r |= t; return r; }
#define FFT_C32 {1.0f, 0.98078528040323044913f, 0.92387953251128675613f, 0.83146961230254523708f, 0.70710678118654752440f, 0.55557023301960222474f, 0.38268343236508977173f, 0.19509032201612826785f, 0.0f, -0.19509032201612826785f, -0.38268343236508977173f, -0.55557023301960222474f, -0.70710678118654752440f, -0.83146961230254523708f, -0.92387953251128675613f, -0.98078528040323044913f}
#define FFT_S32 {0.0f, 0.19509032201612826785f, 0.38268343236508977173f, 0.55557023301960222474f, 0.70710678118654752440f, 0.83146961230254523708f, 0.92387953251128675613f, 0.98078528040323044913f, 1.0f, 0.98078528040323044913f, 0.92387953251128675613f, 0.83146961230254523708f, 0.70710678118654752440f, 0.55557023301960222474f, 0.38268343236508977173f, 0.19509032201612826785f}
template <int R> HD constexpr int ilog2c() { int l = 0; for (int r = R; r > 1; r >>= 1) ++l; return l; }
template <int R> HD void dft_fwd(cf (&v)[R]) {
    constexpr float C[16] = FFT_C32; constexpr float S[16] = FFT_S32;
    constexpr int LG = ilog2c<R>();
#pragma unroll
    for (int st = 0; st < LG; ++st) {
#pragma unroll
        for (int i = 0; i < R / 2; ++i) {
            const int len = R >> st, half = len >> 1, blk = i / half, j = i % half, i0 = blk * len + j, i1 = i0 + half;
            const cf a = v[i0], c = v[i1];
            v[i0] = cadd(a, c);
            const cf d = csub(a, c);
            const int ti = j * (32 / len);
            cf w; w.x = C[ti]; w.y = -S[ti];
            cf r;
            if (ti == 0) r = d;
            else if (ti == 8) { r.x = d.y; r.y = -d.x; }
            else if (ti == 4) { r.x = (d.x + d.y) * 0.70710678118654752440f; r.y = (d.y - d.x) * 0.70710678118654752440f; }
            else if (ti == 12) { r.x = (d.y - d.x) * 0.70710678118654752440f; r.y = -(d.x + d.y) * 0.70710678118654752440f; }
            else r = cmul(d, w);
            v[i1] = r;
        }
    }
}
template <int R> HD void dft_inv(cf (&v)[R]) {
    constexpr float C[16] = FFT_C32; constexpr float S[16] = FFT_S32;
    constexpr int LG = ilog2c<R>();
#pragma unroll
    for (int st = LG - 1; st >= 0; --st) {
#pragma unroll
        for (int i = 0; i < R / 2; ++i) {
            const int len = R >> st, half = len >> 1, blk = i / half, j = i % half, i0 = blk * len + j, i1 = i0 + half;
            const int ti = j * (32 / len);
            cf w; w.x = C[ti]; w.y = S[ti];
            const cf a = v[i0];
            const cf b1 = v[i1];
            cf c;
            if (ti == 0) c = b1;
            else if (ti == 8) { c.x = -b1.y; c.y = b1.x; }
            else if (ti == 4) { c.x = (b1.x - b1.y) * 0.70710678118654752440f; c.y = (b1.x + b1.y) * 0.70710678118654752440f; }
            else if (ti == 12) { c.x = -(b1.x + b1.y) * 0.70710678118654752440f; c.y = (b1.x - b1.y) * 0.70710678118654752440f; }
            else c = cmul(b1, w);
            v[i0] = cadd(a, c);
            v[i1] = csub(a, c);
        }
    }
}
#define PIDX(a) ((a) + (((a) >> 6) << 2))
template <int R> DI void fft_pass_fwd(LAS cf* X, const LAS cf* tw, int n, int g) {
    const int s = n / R, q = g / s, p = g - q * s, base = q * n + p;
    cf v[R];
#pragma unroll
    for (int k = 0; k < R; ++k) v[k] = X[PIDX(base + k * s)];
    dft_fwd<R>(v);
    if (s > 1) {
        int pp = p * (16384 / n); asm volatile("" : "+v"(pp));
        const cf w1 = tw[pp]; cf w = w1;
#pragma unroll
        for (int m = 1; m < R; ++m) { v[brev<R>(m)] = cmul(v[brev<R>(m)], w); w = cmul(w, w1); }
    }
#pragma unroll
    for (int k = 0; k < R; ++k) X[PIDX(base + k * s)] = v[k];
}
template <int R> DI void fft_pass_inv(LAS cf* X, const LAS cf* tw, int n, int g) {
    const int s = n / R, q = g / s, p = g - q * s, base = q * n + p;
    cf v[R];
#pragma unroll
    for (int k = 0; k < R; ++k) v[k] = X[PIDX(base + k * s)];
    if (s > 1) {
        int pp = p * (16384 / n); asm volatile("" : "+v"(pp));
        cf w1 = tw[pp]; w1.y = -w1.y; cf w = w1;
#pragma unroll
        for (int m = 1; m < R; ++m) { v[brev<R>(m)] = cmul(v[brev<R>(m)], w); w = cmul(w, w1); }
    }
    dft_inv<R>(v);
#pragma unroll
    for (int k = 0; k < R; ++k) X[PIDX(base + k * s)] = v[k];
}
DI void fft16k_fwd(LAS cf* X, const LAS cf* tw) {
    const int t = TID();
#pragma unroll 1
    for (int g = 0; g < 2; ++g) fft_pass_fwd<16>(X, tw, 16384, t + 512 * g);
    __syncthreads();
#pragma unroll 1
    for (int g = 0; g < 2; ++g) fft_pass_fwd<16>(X, tw, 1024, t + 512 * g);
    __syncthreads();
#pragma unroll 1
    for (int g = 0; g < 2; ++g) fft_pass_fwd<16>(X, tw, 64, t + 512 * g);
    __syncthreads();
#pragma unroll 1
    for (int g = 0; g < 8; ++g) fft_pass_fwd<4>(X, tw, 4, t + 512 * g);
    __syncthreads();
}
DI void fft16k_inv(LAS cf* X, const LAS cf* tw) {
    const int t = TID();
#pragma unroll 1
    for (int g = 0; g < 8; ++g) fft_pass_inv<4>(X, tw, 4, t + 512 * g);
    __syncthreads();
#pragma unroll 1
    for (int g = 0; g < 2; ++g) fft_pass_inv<16>(X, tw, 64, t + 512 * g);
    __syncthreads();
#pragma unroll 1
    for (int g = 0; g < 2; ++g) fft_pass_inv<16>(X, tw, 1024, t + 512 * g);
    __syncthreads();
#pragma unroll 1
    for (int g = 0; g < 2; ++g) fft_pass_inv<16>(X, tw, 16384, t + 512 * g);
    __syncthreads();
}

struct Params { const float* in[33]; float* out; unsigned char* ws; int ph_lo, ph_hi; };
struct KC {
    const float *x, *c, *ctx, *c_ctx, *ada_w, *ada_b, *norm_mix, *norm_ffn, *norm_final;
    const float *dn_w_in, *dn_conv, *dn_a_log, *dn_dt_bias, *dn_out_norm, *dn_w_out;
    const float *hy_w_in, *hy_conv, *hy_f_w1, *hy_f_b1, *hy_f_freq, *hy_f_w2, *hy_f_b2, *hy_f_w3, *hy_bias, *hy_w_out;
    const float *sc_w_in, *sc_conv, *sc_w_out, *w_router, *router_bias, *moe_w_gate, *moe_w_up, *moe_w_down;
    float* out; unsigned char* ws;
};

PF void job_mod(const KC& k, LAS float* lds) {
    const int tid = TID(), cj = tid & 63, kq = tid >> 6;
    float* mod = (float*)(k.ws + WS_MOD);
    LAS float* sl = lds + 2048;
    for (int i = tid; i < 3072; i += NTHR) { const float v = i < 1024 ? k.c_ctx[i] : k.c[i - 1024]; sl[i] = siluf(v); }
    __syncthreads();
    for (int u = blockIdx.x; u < DEPTH * 96; u += gridDim.x) {
        const int l = u / 96, cc = u % 96, col = cc * 64 + cj;
        const float* W = k.ada_w + (size_t)l * 1024 * 6144 + col;
        float a0 = 0.f, a1 = 0.f, a2 = 0.f;
        for (int k0 = kq * 128; k0 < kq * 128 + 128; k0 += 16) {
            float w[16];
#pragma unroll
            for (int e = 0; e < 16; ++e) w[e] = W[(size_t)(k0 + e) * 6144];
            asm volatile("" ::: "memory");
#pragma unroll
            for (int e = 0; e < 16; ++e) { a0 += sl[k0 + e] * w[e]; a1 += sl[1024 + k0 + e] * w[e]; a2 += sl[2048 + k0 + e] * w[e]; }
        }
        lds[(kq * 3 + 0) * 64 + cj] = a0; lds[(kq * 3 + 1) * 64 + cj] = a1; lds[(kq * 3 + 2) * 64 + cj] = a2;
        __syncthreads();
        if (tid < 192) {
            const int r = tid >> 6, j = tid & 63;
            float sacc = 0.f;
            for (int q = 0; q < 8; ++q) sacc += lds[(q * 3 + r) * 64 + j];
            mod[(size_t)(l * 3 + r) * 6144 + cc * 64 + j] = sacc + k.ada_b[l * 6144 + cc * 64 + j];
        }
        __syncthreads();
    }
}
DI void cvt_matrix(const float* src, int ld, size_t sstride, int K, int N, int nmat, bf16_t* dst, int ldd, size_t dstride, int mapmode, LAS float* lds, int bid, int nb) {
    const int tk = K / 64, tn = N / 64, per = tk * tn, tid = TID();
    const int r = tid >> 4, c4 = (tid & 15) * 4;
    f32x4 v0, v1;
    int u = bid;
    if (u < per * nmat) { const int m = u / per, t = u % per; const float* sp = src + (size_t)m * sstride + (size_t)((t / tn) * 64 + r) * ld + (t % tn) * 64 + c4; v0 = *(const f32x4*)sp; v1 = *(const f32x4*)(sp + (size_t)32 * ld); }
    for (; u < per * nmat; u += nb) {
        const int m = u / per, t = u % per, k0 = (t / tn) * 64, n0 = (t % tn) * 64;
        { LAS float* p = lds + r * 65 + c4; p[0] = v0[0]; p[1] = v0[1]; p[2] = v0[2]; p[3] = v0[3];
          LAS float* p2 = lds + (r + 32) * 65 + c4; p2[0] = v1[0]; p2[1] = v1[1]; p2[2] = v1[2]; p2[3] = v1[3]; }
        { const int un = u + nb;
          if (un < per * nmat) { const int mn = un / per, tn_ = un % per; const float* sp = src + (size_t)mn * sstride + (size_t)((tn_ / tn) * 64 + r) * ld + (tn_ % tn) * 64 + c4; v0 = *(const f32x4*)sp; v1 = *(const f32x4*)(sp + (size_t)32 * ld); } }
        lds_barrier();
        { const int nn = tid >> 3, ks = (tid & 7) * 8; const int n = n0 + nn;
          const int row = mapmode == 0 ? n : (32 * (n >> 4) + (n & 15) + (mapmode == 2 ? 16 : 0));
          float f[8];
#pragma unroll
          for (int e = 0; e < 8; ++e) f[e] = lds[(ks + e) * 65 + nn];
          u32x4 o; o[0] = pk2(f[0], f[1]); o[1] = pk2(f[2], f[3]); o[2] = pk2(f[4], f[5]); o[3] = pk2(f[6], f[7]);
          *(u32x4*)(dst + (size_t)m * dstride + (size_t)row * ldd + k0 + ks) = o; }
        lds_barrier();
    }
}
PF void job_cvt_small(const KC& k, LAS float* lds) {
    cvt_matrix(k.dn_w_in, DN_IN, (size_t)1024 * DN_IN, 1024, 4096, 2, (bf16_t*)(k.ws + WS_DNWIN), 1024, (size_t)4096 * 1024, 0, lds, (int)blockIdx.x, (int)gridDim.x);
    cvt_matrix(k.dn_w_out, 1024, (size_t)1024 * 1024, 1024, 1024, 2, (bf16_t*)(k.ws + WS_DNWOUT), 1024, (size_t)1024 * 1024, 0, lds, (int)blockIdx.x, (int)gridDim.x);
    cvt_matrix(k.hy_w_in, 3072, 0, 1024, 3072, 1, (bf16_t*)(k.ws + WS_HYWIN), 1024, 0, 0, lds, (int)blockIdx.x, (int)gridDim.x);
    cvt_matrix(k.hy_w_out, 1024, 0, 1024, 1024, 1, (bf16_t*)(k.ws + WS_HYWOUT), 1024, 0, 0, lds, (int)blockIdx.x, (int)gridDim.x);
    cvt_matrix(k.sc_w_in, 3072, 0, 1024, 3072, 1, (bf16_t*)(k.ws + WS_SCWIN), 1024, 0, 0, lds, (int)blockIdx.x, (int)gridDim.x);
    cvt_matrix(k.sc_w_out, 1024, 0, 1024, 1024, 1, (bf16_t*)(k.ws + WS_SCWOUT), 1024, 0, 0, lds, (int)blockIdx.x, (int)gridDim.x);
}
PF void job_cvt_moe(const KC& k, int layer, LAS float* lds, int bid, int nb) {
    if (bid < 0) return;
    const size_t lo = (size_t)layer * 32 * 1024 * 512;
    cvt_matrix(k.moe_w_gate + lo, 512, (size_t)1024 * 512, 1024, 512, 32, (bf16_t*)(k.ws + AR_WGU), 1024, (size_t)1024 * 1024, 1, lds, bid, nb);
    cvt_matrix(k.moe_w_up + lo, 512, (size_t)1024 * 512, 1024, 512, 32, (bf16_t*)(k.ws + AR_WGU), 1024, (size_t)1024 * 1024, 2, lds, bid, nb);
    cvt_matrix(k.moe_w_down + lo, 1024, (size_t)512 * 1024, 512, 1024, 32, (bf16_t*)(k.ws + AR_WD), 512, (size_t)1024 * 512, 0, lds, bid, nb);
}
PF void job_hdn(const KC& k, LAS float* lds) {
    const int tid = TID(), lane = tid & 63, wave = tid >> 6;
    LAS float* feat = lds + wave * 128; LAS float* h1 = feat + 64;
    const float fr = k.hy_f_freq[lane], b1 = k.hy_f_b1[lane], b2 = k.hy_f_b2[lane];
    for (int u0 = blockIdx.x * 8; u0 < 16384 + 256; u0 += gridDim.x * 8) {
        const int u = u0 + wave;
        int l, pos; float* dst;
        if (u < 16384) { l = 16384; pos = u; dst = nullptr; }
        else { l = 256; pos = u - 16384; dst = (float*)(k.ws + WS_HDNC) + (size_t)pos * 64; }
        const float t = (float)pos / (float)(l - 1);
        float f = 0.f;
        if (lane == 0) f = t;
        else if (lane <= 32) {
            const int bi = (lane - 1) & 15;
            const float band = 1e-4f + (float)bi * ((15.0f - 1e-4f) / 15.0f);
            const float ang = (6.283185307179586f / (float)l) * (float)pos * band;
            f = lane <= 16 ? cosf(ang) : -sinf(ang);
        }
        feat[lane] = f;
        __syncthreads();
        float a = b1;
        for (int i = 0; i < 33; ++i) a += feat[i] * k.hy_f_w1[i * 64 + lane];
        h1[lane] = sinf(fr * a);
        __syncthreads();
        float a2 = b2;
        for (int j = 0; j < 64; ++j) a2 += h1[j] * k.hy_f_w2[j * 64 + lane];
        const float hv = sinf(fr * a2);
        if (dst) dst[lane] = hv;
        else { bf16_t* hs = (bf16_t*)(k.ws + WS_HS) + (size_t)pos * 256; const bf16_t hi = f2bf(hv), lo = f2bf(hv - bf2f(hi)); hs[lane] = hi; hs[64 + lane] = lo; hs[128 + lane] = hi; hs[192 + lane] = 0; }
        __syncthreads();
    }
}
PF void job_w3s(const KC& k) {
    bf16_t* W = (bf16_t*)(k.ws + WS_W3S);
    const int tq = TID();
    for (int idx = blockIdx.x * NTHR + tq; idx < 64 * 4096; idx += gridDim.x * NTHR) {
        const int j = idx >> 12, col = idx & 4095;
        const float w = k.hy_f_w3[idx]; const bf16_t hi = f2bf(w), lo = f2bf(w - bf2f(hi));
        W[(size_t)col * 256 + j] = hi; W[(size_t)col * 256 + 64 + j] = hi; W[(size_t)col * 256 + 128 + j] = lo; W[(size_t)col * 256 + 192 + j] = 0;
    }
}
DI float hy_delta(int ch) {
    const float lo = -4.605170185988091f / 1.5f, hi = -4.605170185988091f / 0.3f;
    return fabsf(lo + (float)ch * ((hi - lo) / 1023.0f));
}
PF void job_filtc(const KC& k, int j) {
    const float* hdn = (const float*)(k.ws + WS_HDNC);
    const float* w3 = k.hy_f_w3 + (size_t)j * 64 * 4096;
    float* filtc = (float*)(k.ws + WS_FILTC);
    const int tq = TID();
    for (int u = blockIdx.x; u < 256 * 8; u += gridDim.x) {
        const int l = u >> 3, col = (u & 7) * 512 + tq;
        float a = 0.f;
        for (int q = 0; q < 64; ++q) a += hdn[l * 64 + q] * w3[(size_t)q * 4096 + col];
        const float t = (float)l / 255.0f;
        filtc[(size_t)l * 4096 + col] = a * expf(-t * hy_delta(col & 1023));
    }
}

template <int MODE>
PF void norm_vec(const KC& k, int layer, const float* __restrict__ gain, int mb) {
    const int tid = TID(), lane = tid & 63, wave = tid >> 6;
    float* xs = (float*)(k.ws + WS_XS);
    bf16_t* hbuf = (bf16_t*)(k.ws + AR_HBUF);
    const float* mod = (const float*)(k.ws + WS_MOD);
    const bf16_t* ys = (const bf16_t*)(k.ws + AR_YS);
    const int* tokp = (const int*)(k.ws + WS_TOKP);
    const float* tokw = (const float*)(k.ws + WS_TOKW);
    const int rbeg = (MODE == 3) ? TC : 0, rstr = gridDim.x * 8, c0 = 4 * lane;
    int cur_mr = -1; f32x4 gsv[4], shv[4], g5v[4];
    int r = rbeg + blockIdx.x * 8 + wave;
    if (r >= T) return;
    f32x4 xn[4]; u32x2 yan[4], ybn[4]; float w0n, w1n, w0f, w1f; int p0f, p1f;
    {
        const int p0 = tokp[2 * r], p1 = tokp[2 * r + 1]; w0n = tokw[2 * r]; w1n = tokw[2 * r + 1];
        const int r2 = r + rstr < T ? r + rstr : T - 1;
        p0f = tokp[2 * r2]; p1f = tokp[2 * r2 + 1]; w0f = tokw[2 * r2]; w1f = tokw[2 * r2 + 1];
#pragma unroll
        for (int j = 0; j < 4; ++j) {
            xn[j] = *(const f32x4*)(xs + (size_t)r * 1024 + 256 * j + c0);
            yan[j] = *(const u32x2*)(ys + (size_t)p0 * 1024 + 256 * j + c0); ybn[j] = *(const u32x2*)(ys + (size_t)p1 * 1024 + 256 * j + c0);
        }
    }
    for (; r < T; r += rstr) {
        const int mr = modrow(r);
        f32x4 x[4]; u32x2 ya[4], yb[4];
#pragma unroll
        for (int j = 0; j < 4; ++j) { x[j] = xn[j]; ya[j] = yan[j]; yb[j] = ybn[j]; }
        const float w0 = w0n, w1 = w1n;
        {
            const int rn = r + rstr < T ? r + rstr : T - 1, rf = r + 2 * rstr < T ? r + 2 * rstr : T - 1;
#pragma unroll
            for (int j = 0; j < 4; ++j) {
                xn[j] = *(const f32x4*)(xs + (size_t)rn * 1024 + 256 * j + c0);
                yan[j] = *(const u32x2*)(ys + (size_t)p0f * 1024 + 256 * j + c0); ybn[j] = *(const u32x2*)(ys + (size_t)p1f * 1024 + 256 * j + c0);
            }
            w0n = w0f; w1n = w1f;
            p0f = tokp[2 * rf]; p1f = tokp[2 * rf + 1]; w0f = tokw[2 * rf]; w1f = tokw[2 * rf + 1];
        }
        if (mr != cur_mr) {
            cur_mr = mr;
            const float* shift = mod + ((size_t)(layer * 3 + mr) * 6 + mb) * 1024;
            const float* g5 = mod + ((size_t)((layer - 1) * 3 + mr) * 6 + 5) * 1024;
#pragma unroll
            for (int j = 0; j < 4; ++j) {
                const int col = 256 * j + c0;
                const f32x4 gn = *(const f32x4*)(gain + col);
                if (MODE != 3) { const f32x4 sc = *(const f32x4*)(shift + 1024 + col); shv[j] = *(const f32x4*)(shift + col);
#pragma unroll
                    for (int e = 0; e < 4; ++e) gsv[j][e] = gn[e] * (1.0f + sc[e]); }
                else gsv[j] = gn;
                g5v[j] = *(const f32x4*)(g5 + col);
            }
        }
        float ss = 0.f;
#pragma unroll
        for (int j = 0; j < 4; ++j) {
            const float a0 = __uint_as_float(ya[j][0] << 16), a1 = __uint_as_float(ya[j][0] & 0xffff0000u), a2 = __uint_as_float(ya[j][1] << 16), a3 = __uint_as_float(ya[j][1] & 0xffff0000u);
            const float b0 = __uint_as_float(yb[j][0] << 16), b1 = __uint_as_float(yb[j][0] & 0xffff0000u), b2 = __uint_as_float(yb[j][1] << 16), b3 = __uint_as_float(yb[j][1] & 0xffff0000u);
            x[j][0] += g5v[j][0] * (w0 * a0 + w1 * b0); x[j][1] += g5v[j][1] * (w0 * a1 + w1 * b1);
            x[j][2] += g5v[j][2] * (w0 * a2 + w1 * b2); x[j][3] += g5v[j][3] * (w0 * a3 + w1 * b3);
            if (MODE != 3) *(f32x4*)(xs + (size_t)r * 1024 + 256 * j + c0) = x[j];
            ss += x[j][0] * x[j][0] + x[j][1] * x[j][1] + x[j][2] * x[j][2] + x[j][3] * x[j][3];
        }
        ss = wsum(ss, lane);
        const float rstd = rsqrtf(ss * (1.0f / 1024.0f) + EPS);
#pragma unroll
        for (int j = 0; j < 4; ++j) {
            if (MODE == 3) {
                f32x4 o;
#pragma unroll
                for (int e = 0; e < 4; ++e) o[e] = x[j][e] * rstd * gsv[j][e];
                *(f32x4*)(k.out + (size_t)(r - TC) * 1024 + 256 * j + c0) = o;
            } else {
                u32x2 o;
                o[0] = pk2(x[j][0] * rstd * gsv[j][0] + shv[j][0], x[j][1] * rstd * gsv[j][1] + shv[j][1]);
                o[1] = pk2(x[j][2] * rstd * gsv[j][2] + shv[j][2], x[j][3] * rstd * gsv[j][3] + shv[j][3]);
                *(u32x2*)(hbuf + (size_t)r * 1024 + 256 * j + c0) = o;
            }
        }
    }
}

template <int MODE>
PF void norm_phase(const KC& k, int layer, bool first, bool combine, const float* __restrict__ gain, int mb, const float* __restrict__ Wsk, int ldw,
                   const float* __restrict__ aux0, const float* __restrict__ aux1, bool last, LAS float* lds, bool flush = true) {
    const int tid = TID(), lane = tid & 63, wave = tid >> 6;
    float* xs = (float*)(k.ws + WS_XS);
    bf16_t* hbuf = (bf16_t*)(k.ws + AR_HBUF);
    const float* mod = (const float*)(k.ws + WS_MOD);
    const bf16_t* ys = (const bf16_t*)(k.ws + AR_YS);
    const int* tokp = (const int*)(k.ws + WS_TOKP);
    const float* tokw = (const float*)(k.ws + WS_TOKW);
    LAS int* lcnt = (LAS int*)(lds + 32768);
    if (MODE == 1 && tid < 32) lcnt[tid] = 0;
    if (MODE == 1 || MODE == 2) {
        for (int idx = tid; idx < 1024 * 32; idx += NTHR) {
            const int kk = idx >> 5, n = idx & 31;
            lds[kk * 32 + (((n >> 2) ^ ((kk >> 1) & 7)) << 2) + (n & 3)] = Wsk[(size_t)kk * ldw + n];
        }
        __syncthreads();
    }
    const int rbeg = (MODE == 3) ? TC : 0, rstr = gridDim.x * 8;
    int cur_mr = -1; float gsv[16], shv[16], g5v[16];
    float xn[16];
    int r = rbeg + blockIdx.x * 8 + wave;
    if (r < T) {
        const float* src = first ? (r < TC ? k.ctx + (size_t)r * 1024 : k.x + (size_t)(r - TC) * 1024) : xs + (size_t)r * 1024;
#pragma unroll
        for (int m = 0; m < 16; ++m) xn[m] = src[lane + 64 * m];
    }
    for (; r < T; r += rstr) {
        const int mr = modrow(r);
        float x[16];
#pragma unroll
        for (int m = 0; m < 16; ++m) x[m] = xn[m];
        int p0 = 0, p1 = 0; float w0 = 0.f, w1 = 0.f;
        if (combine) { p0 = tokp[2 * r]; p1 = tokp[2 * r + 1]; w0 = tokw[2 * r]; w1 = tokw[2 * r + 1]; }
        {
            const int rn = r + rstr;
            if (rn < T) {
                const float* srcn = first ? (rn < TC ? k.ctx + (size_t)rn * 1024 : k.x + (size_t)(rn - TC) * 1024) : xs + (size_t)rn * 1024;
#pragma unroll
                for (int m = 0; m < 16; ++m) xn[m] = srcn[lane + 64 * m];
            }
        }
        if (mr != cur_mr) {
            cur_mr = mr;
            if (MODE != 3) {
                const float* shift = mod + ((size_t)(layer * 3 + mr) * 6 + mb) * 1024;
#pragma unroll
                for (int m = 0; m < 16; ++m) { const int col = lane + 64 * m; gsv[m] = gain[col] * (1.0f + shift[1024 + col]); shv[m] = shift[col]; }
            } else {
#pragma unroll
                for (int m = 0; m < 16; ++m) gsv[m] = gain[lane + 64 * m];
            }
            if (combine) {
                const float* g5 = mod + ((size_t)((layer - 1) * 3 + mr) * 6 + 5) * 1024;
#pragma unroll
                for (int m = 0; m < 16; ++m) g5v[m] = g5[lane + 64 * m];
            }
        }
        if (combine) {
            bf16_t ya[16], yb[16];
#pragma unroll
            for (int m = 0; m < 16; ++m) { const int col = lane + 64 * m; ya[m] = ys[(size_t)p0 * 1024 + col]; yb[m] = ys[(size_t)p1 * 1024 + col]; }
            asm volatile("" ::: "memory");
#pragma unroll
            for (int m = 0; m < 16; ++m) x[m] += g5v[m] * (w0 * bf2f(ya[m]) + w1 * bf2f(yb[m]));
        }
        if (first || combine) {
#pragma unroll
            for (int m = 0; m < 16; ++m) xs[(size_t)r * 1024 + lane + 64 * m] = x[m];
        }
        float ss = 0.f;
#pragma unroll
        for (int m = 0; m < 16; ++m) ss += x[m] * x[m];
        ss = wsum(ss, lane);
        const float rstd = rsqrtf(ss * (1.0f / 1024.0f) + EPS);
        if (MODE == 3) {
#pragma unroll
            for (int m = 0; m < 16; ++m) { const int col = lane + 64 * m; k.out[(size_t)(r - TC) * 1024 + col] = x[m] * rstd * gsv[m]; }
            continue;
        }
        float y[16];
#pragma unroll
        for (int m = 0; m < 16; ++m) {
            const int col = lane + 64 * m;
            y[m] = x[m] * rstd * gsv[m] + shv[m];
            hbuf[(size_t)r * 1024 + col] = f2bf(y[m]);
        }
        if (MODE == 1 || MODE == 2) {
            float acc[32];
#pragma unroll
            for (int n = 0; n < 32; ++n) acc[n] = 0.f;
#pragma unroll
            for (int m = 0; m < 16; ++m) {
                f32x4 wa[8];
                const int c = lane + 64 * m; const LAS float* wr = lds + c * 32; const int sw = (c >> 1) & 7;
#pragma unroll
                for (int q = 0; q < 8; ++q) wa[q] = *(const LAS f32x4*)(wr + ((q ^ sw) << 2));
                asm volatile("" ::: "memory");
#pragma unroll
                for (int q = 0; q < 8; ++q) { acc[4 * q + 0] += y[m] * wa[q][0]; acc[4 * q + 1] += y[m] * wa[q][1]; acc[4 * q + 2] += y[m] * wa[q][2]; acc[4 * q + 3] += y[m] * wa[q][3]; }
            }
            float val;
            {
                float a16[16], a8[8], a4[4], a2[2];
                const bool b5 = (lane & 32) != 0, b4 = (lane & 16) != 0, b3 = (lane & 8) != 0, b2 = (lane & 4) != 0, b1 = (lane & 2) != 0;
#pragma unroll
                for (int i = 0; i < 16; ++i) { const float send = b5 ? acc[i] : acc[i + 16], keep = b5 ? acc[i + 16] : acc[i]; a16[i] = keep + shx(send, 32, lane); }
#pragma unroll
                for (int i = 0; i < 8; ++i) { const float send = b4 ? a16[i] : a16[i + 8], keep = b4 ? a16[i + 8] : a16[i]; a8[i] = keep + shx(send, 16, lane); }
#pragma unroll
                for (int i = 0; i < 4; ++i) { const float send = b3 ? a8[i] : a8[i + 4], keep = b3 ? a8[i + 4] : a8[i]; a4[i] = keep + shx(send, 8, lane); }
#pragma unroll
                for (int i = 0; i < 2; ++i) { const float send = b2 ? a4[i] : a4[i + 2], keep = b2 ? a4[i + 2] : a4[i]; a2[i] = keep + shx(send, 4, lane); }
                { const float send = b1 ? a2[0] : a2[1], keep = b1 ? a2[1] : a2[0]; val = keep + shx(send, 2, lane); }
                val += shx(val, 1, lane);
            }
            const int n = lane >> 1;
            if (MODE == 1) {
                int* toke = (int*)(k.ws + WS_TOKE); float* tokwW = (float*)(k.ws + WS_TOKW);
                if (last && r < TC) { if (lane == 0) { int neg = -1; asm volatile("" : "+v"(neg)); toke[2 * r] = neg; toke[2 * r + 1] = neg; } continue; }
                const float sc = 1.0f / (1.0f + expf(-val)), ch = sc + aux0[n];
                const int gl = lane & ~7;
                const float ca = shi(ch, gl), cb = shi(ch, gl + 2), cc = shi(ch, gl + 4), cd = shi(ch, gl + 6);
                const float hi1 = fmaxf(ca, cb), lo1 = fminf(ca, cb), hi2 = fmaxf(cc, cd), lo2 = fminf(cc, cd);
                float gs = fmaxf(hi1, hi2) + fmaxf(fminf(hi1, hi2), fmaxf(lo1, lo2));
                int gi = lane >> 3;
#pragma unroll
                for (int m = 8; m <= 32; m <<= 1) {
                    const float og = shx(gs, m, lane); const int oi = shii(gi, lane ^ m);
                    if (og > gs || (og == gs && oi < gi)) { gs = og; gi = oi; }
                }
                float c4[4], s4[4];
#pragma unroll
                for (int i = 0; i < 4; ++i) { c4[i] = shi(ch, gi * 8 + 2 * i); s4[i] = shi(sc, gi * 8 + 2 * i); }
                int i1 = 0; float b1v = c4[0];
#pragma unroll
                for (int i = 1; i < 4; ++i) if (c4[i] > b1v) { b1v = c4[i]; i1 = i; }
                int i2 = -1; float b2v = -1e30f;
#pragma unroll
                for (int i = 0; i < 4; ++i) if (i != i1 && c4[i] > b2v) { b2v = c4[i]; i2 = i; }
                float w1v = 0.f, w2v = 0.f;
#pragma unroll
                for (int i = 0; i < 4; ++i) { if (i == i1) w1v = s4[i]; if (i == i2) w2v = s4[i]; }
                const float inv = 1.0f / (w1v + w2v);
                if (lane == 0) {
                    const int e1 = gi * 4 + i1, e2 = gi * 4 + i2;
                    toke[2 * r] = e1; toke[2 * r + 1] = e2; tokwW[2 * r] = w1v * inv; tokwW[2 * r + 1] = w2v * inv;
                    __hip_atomic_fetch_add(lcnt + e1, 1, __ATOMIC_RELAXED, __HIP_MEMORY_SCOPE_WORKGROUP);
                    __hip_atomic_fetch_add(lcnt + e2, 1, __ATOMIC_RELAXED, __HIP_MEMORY_SCOPE_WORKGROUP);
                }
            } else {
                float* gb = (float*)(k.ws + WS_GB);
                if ((lane & 1) == 0) {
                    if (n < 16) {
                        const float z = val + aux1[n];
                        const float ez = __expf(z); const float sp = z > 15.f ? z : (ez < 1e-4f ? ez - 0.5f * ez * ez : __logf(1.0f + ez));
                        gb[(size_t)r * 32 + n] = -expf(aux0[n]) * sp;
                    } else {
                        gb[(size_t)r * 32 + n] = 1.0f / (1.0f + expf(-val));
                    }
                }
            }
        }
    }
    if (MODE == 1) {
        __syncthreads();
        int* cnt = (int*)(k.ws + WS_CTL + CTL_CNT) + layer * 32;
        if (flush && tid < 32 && lcnt[tid] > 0) atomicAdd(&cnt[tid], lcnt[tid]);
    }
}

constexpr int NM_WLD = 1032;
template <int MODE>
PF void norm_mfma(const KC& k, int layer, bool first, bool combine, const float* __restrict__ gain, int mb, const float* __restrict__ Wsk, int ldw,
                  const float* __restrict__ aux0, const float* __restrict__ aux1, bool last, LAS unsigned char* lds, bool flush = true) {
    const int tid = TID(), lane = tid & 63, wave = __builtin_amdgcn_readfirstlane(tid >> 6), row = lane & 15, q = lane >> 4;
    LAS bf16_t* WtH = (LAS bf16_t*)lds; LAS bf16_t* WtL = WtH + 32 * NM_WLD;
    LAS float* red = (LAS float*)(WtL + 32 * NM_WLD);
    LAS float* lg = red + 128;
    LAS int* lcnt = (LAS int*)(lg + 8 * 16 * 32);
    float* xs = (float*)(k.ws + WS_XS);
    bf16_t* hbuf = (bf16_t*)(k.ws + AR_HBUF);
    const float* mod = (const float*)(k.ws + WS_MOD);
    const bf16_t* ys = (const bf16_t*)(k.ws + AR_YS);
    const int* tokp = (const int*)(k.ws + WS_TOKP); const float* tokw = (const float*)(k.ws + WS_TOKW);
    if (MODE == 1 && tid < 32) lcnt[tid] = 0;
    for (int idx = tid; idx < 1024 * 32; idx += NTHR) {
        const int kk = idx >> 5, n = idx & 31;
        const float w = Wsk[(size_t)kk * ldw + n]; const bf16_t hi = f2bf(w);
        WtH[n * NM_WLD + kk] = hi; WtL[n * NM_WLD + kk] = f2bf(w - bf2f(hi));
    }
    __syncthreads();
    const int cbase = 128 * wave + 8 * q;
    f32x4 xn[8];
    int bt = blockIdx.x;
    if (bt < T / 16) {
        const float* sb = first ? (16 * bt < TC ? k.ctx : k.x - (size_t)TC * 1024) : xs;
        const unsigned off = (unsigned)(16 * bt + row) * 1024u + (unsigned)cbase;
#pragma unroll
        for (int kk = 0; kk < 4; ++kk) { xn[2 * kk] = *(const f32x4*)(sb + off + 32 * kk); xn[2 * kk + 1] = *(const f32x4*)(sb + off + 32 * kk + 4); }
    }
    const float tail0 = (MODE == 1) ? aux0[tid & 31] : -expf(aux0[tid & 15]), tail1 = (MODE == 1) ? 0.f : aux1[tid & 15];
    int cur_mr = -1; float gsv[32], shv[32];
    for (; bt < T / 16; bt += gridDim.x) {
        const int r = 16 * bt + row, mr = modrow(16 * bt);
        const unsigned roff = (unsigned)r * 1024u + (unsigned)cbase;
        if (MODE == 1 && mr != cur_mr) {
            cur_mr = mr;
            const float* shift = mod + ((size_t)(layer * 3 + mr) * 6 + mb) * 1024;
#pragma unroll
            for (int kk = 0; kk < 4; ++kk) {
                const unsigned co = (unsigned)cbase + 32u * kk;
                const f32x4 g0 = *(const f32x4*)(gain + co), g1 = *(const f32x4*)(gain + co + 4), s0 = *(const f32x4*)(shift + 1024 + co), s1 = *(const f32x4*)(shift + 1024 + co + 4),
                            h0 = *(const f32x4*)(shift + co), h1 = *(const f32x4*)(shift + co + 4);
#pragma unroll
                for (int e = 0; e < 4; ++e) { gsv[8 * kk + e] = g0[e] * (1.0f + s0[e]); gsv[8 * kk + 4 + e] = g1[e] * (1.0f + s1[e]); shv[8 * kk + e] = h0[e]; shv[8 * kk + 4 + e] = h1[e]; }
            }
#pragma unroll
            for (int e = 0; e < 32; ++e) asm volatile("" :: "v"(shv[e]));
        }
        float x[32];
#pragma unroll
        for (int i = 0; i < 8; ++i) { x[4 * i] = xn[i][0]; x[4 * i + 1] = xn[i][1]; x[4 * i + 2] = xn[i][2]; x[4 * i + 3] = xn[i][3]; }
        int p0 = 0, p1 = 0; float w0 = 0.f, w1 = 0.f;
        if (combine) { p0 = tokp[2 * r]; p1 = tokp[2 * r + 1]; w0 = tokw[2 * r]; w1 = tokw[2 * r + 1]; }
        {
            const int bn = bt + gridDim.x;
            if (bn < T / 16) {
                const float* sb = first ? (16 * bn < TC ? k.ctx : k.x - (size_t)TC * 1024) : xs;
                const unsigned off = (unsigned)(16 * bn + row) * 1024u + (unsigned)cbase;
#pragma unroll
                for (int kk = 0; kk < 4; ++kk) { xn[2 * kk] = *(const f32x4*)(sb + off + 32 * kk); xn[2 * kk + 1] = *(const f32x4*)(sb + off + 32 * kk + 4); }
            }
        }
        if (combine) {
            const float* g5 = mod + ((size_t)((layer - 1) * 3 + mr) * 6 + 5) * 1024;
            u32x4 ya[4], yb[4]; float g5v[32];
#pragma unroll
            for (int kk = 0; kk < 4; ++kk) { ya[kk] = *(const u32x4*)(ys + (size_t)p0 * 1024 + cbase + 32 * kk); yb[kk] = *(const u32x4*)(ys + (size_t)p1 * 1024 + cbase + 32 * kk);
                const f32x4 ga = *(const f32x4*)(g5 + cbase + 32 * kk), gb2 = *(const f32x4*)(g5 + cbase + 32 * kk + 4);
#pragma unroll
                for (int e = 0; e < 4; ++e) { g5v[8 * kk + e] = ga[e]; g5v[8 * kk + 4 + e] = gb2[e]; } }
            asm volatile("" ::: "memory");
#pragma unroll
            for (int kk = 0; kk < 4; ++kk)
#pragma unroll
                for (int w = 0; w < 4; ++w) {
                    x[8 * kk + 2 * w] += g5v[8 * kk + 2 * w] * (w0 * __uint_as_float(ya[kk][w] << 16) + w1 * __uint_as_float(yb[kk][w] << 16));
                    x[8 * kk + 2 * w + 1] += g5v[8 * kk + 2 * w + 1] * (w0 * __uint_as_float(ya[kk][w] & 0xffff0000u) + w1 * __uint_as_float(yb[kk][w] & 0xffff0000u));
                }
        }
        if (first || combine) {
#pragma unroll
            for (int kk = 0; kk < 4; ++kk) {
                *(f32x4*)(xs + roff + 32 * kk) = (f32x4){x[8 * kk], x[8 * kk + 1], x[8 * kk + 2], x[8 * kk + 3]};
                *(f32x4*)(xs + roff + 32 * kk + 4) = (f32x4){x[8 * kk + 4], x[8 * kk + 5], x[8 * kk + 6], x[8 * kk + 7]};
            }
        }
        float ss = 0.f;
#pragma unroll
        for (int i = 0; i < 32; ++i) ss += x[i] * x[i];
        ss += shx(ss, 16, lane); ss += shx(ss, 32, lane);
        if (q == 0) red[wave * 16 + row] = ss;
        __syncthreads();
        float tot = 0.f;
#pragma unroll
        for (int w = 0; w < 8; ++w) tot += red[w * 16 + row];
        const float rstd = rsqrtf(tot * (1.0f / 1024.0f) + EPS);
        f32x4 acc[2]; acc[0] = (f32x4){0.f, 0.f, 0.f, 0.f}; acc[1] = (f32x4){0.f, 0.f, 0.f, 0.f};
#pragma unroll
        for (int kk = 0; kk < 4; ++kk) {
            float y[8]; u32x4 ah, al;
            if (MODE == 1) {
#pragma unroll
                for (int e = 0; e < 8; ++e) y[e] = x[8 * kk + e] * rstd * gsv[8 * kk + e] + shv[8 * kk + e];
            } else {
                const float* shift = mod + ((size_t)(layer * 3 + mr) * 6 + mb) * 1024;
                const unsigned co = (unsigned)cbase + 32u * kk;
                const f32x4 g0 = *(const f32x4*)(gain + co), g1 = *(const f32x4*)(gain + co + 4), s0 = *(const f32x4*)(shift + 1024 + co), s1 = *(const f32x4*)(shift + 1024 + co + 4),
                            h0 = *(const f32x4*)(shift + co), h1 = *(const f32x4*)(shift + co + 4);
#pragma unroll
                for (int e = 0; e < 4; ++e) { y[e] = x[8 * kk + e] * rstd * g0[e] * (1.0f + s0[e]) + h0[e]; y[4 + e] = x[8 * kk + 4 + e] * rstd * g1[e] * (1.0f + s1[e]) + h1[e]; }
            }
#pragma unroll
            for (int w = 0; w < 4; ++w) {
                ah[w] = pk2(y[2 * w], y[2 * w + 1]);
                al[w] = pk2(y[2 * w] - __uint_as_float(ah[w] << 16), y[2 * w + 1] - __uint_as_float(ah[w] & 0xffff0000u));
            }
            *(u32x4*)(hbuf + roff + 32 * kk) = ah;
            const bf16x8 fah = __builtin_bit_cast(bf16x8, ah), fal = __builtin_bit_cast(bf16x8, al);
            bf16x8 bh[2], bl[2];
#pragma unroll
            for (int nt = 0; nt < 2; ++nt) {
                bh[nt] = *(const LAS bf16x8*)(WtH + (16 * nt + row) * NM_WLD + cbase + 32 * kk);
                bl[nt] = *(const LAS bf16x8*)(WtL + (16 * nt + row) * NM_WLD + cbase + 32 * kk);
            }
            asm volatile("" ::: "memory");
#pragma unroll
            for (int nt = 0; nt < 2; ++nt) {
                acc[nt] = __builtin_amdgcn_mfma_f32_16x16x32_bf16(fah, bh[nt], acc[nt], 0, 0, 0);
                acc[nt] = __builtin_amdgcn_mfma_f32_16x16x32_bf16(fal, bh[nt], acc[nt], 0, 0, 0);
                acc[nt] = __builtin_amdgcn_mfma_f32_16x16x32_bf16(fah, bl[nt], acc[nt], 0, 0, 0);
            }
        }
#pragma unroll
        for (int nt = 0; nt < 2; ++nt)
#pragma unroll
            for (int j = 0; j < 4; ++j) lg[(wave * 16 + 4 * q + j) * 32 + 16 * nt + row] = acc[nt][j];
        __syncthreads();
        {
            const int prow = tid >> 5, n = tid & 31, rr = 16 * bt + prow, hb = lane & 32;
            float val = 0.f;
#pragma unroll
            for (int w = 0; w < 8; ++w) val += lg[(w * 16 + prow) * 32 + n];
            if (MODE == 1) {
                int* toke = (int*)(k.ws + WS_TOKE); float* tokwW = (float*)(k.ws + WS_TOKW);
                const bool unrouted = last && rr < TC;
                const float sc = 1.0f / (1.0f + expf(-val)), ch = sc + tail0;
                const int gl = hb + (n & ~3);
                const float ca = shi(ch, gl), cb = shi(ch, gl + 1), cc = shi(ch, gl + 2), cd = shi(ch, gl + 3);
                const float hi1 = fmaxf(ca, cb), lo1 = fminf(ca, cb), hi2 = fmaxf(cc, cd), lo2 = fminf(cc, cd);
                float gs = fmaxf(hi1, hi2) + fmaxf(fminf(hi1, hi2), fmaxf(lo1, lo2));
                int gi = n >> 2;
#pragma unroll
                for (int m = 4; m <= 16; m <<= 1) {
                    const float og = shx(gs, m, lane); const int oi = shii(gi, lane ^ m);
                    if (og > gs || (og == gs && oi < gi)) { gs = og; gi = oi; }
                }
                float c4[4], s4[4];
#pragma unroll
                for (int i = 0; i < 4; ++i) { c4[i] = shi(ch, hb + gi * 4 + i); s4[i] = shi(sc, hb + gi * 4 + i); }
                int i1 = 0; float b1v = c4[0];
#pragma unroll
                for (int i = 1; i < 4; ++i) if (c4[i] > b1v) { b1v = c4[i]; i1 = i; }
                int i2 = -1; float b2v = -1e30f;
#pragma unroll
                for (int i = 0; i < 4; ++i) if (i != i1 && c4[i] > b2v) { b2v = c4[i]; i2 = i; }
                float w1v = 0.f, w2v = 0.f;
#pragma unroll
                for (int i = 0; i < 4; ++i) { if (i == i1) w1v = s4[i]; if (i == i2) w2v = s4[i]; }
                const float inv = 1.0f / (w1v + w2v);
                if (n == 0) {
                    if (unrouted) { int neg = -1; asm volatile("" : "+v"(neg)); toke[2 * rr] = neg; toke[2 * rr + 1] = neg; }
                    else {
                        const int e1 = gi * 4 + i1, e2 = gi * 4 + i2;
                        toke[2 * rr] = e1; toke[2 * rr + 1] = e2; tokwW[2 * rr] = w1v * inv; tokwW[2 * rr + 1] = w2v * inv;
                        __hip_atomic_fetch_add(lcnt + e1, 1, __ATOMIC_RELAXED, __HIP_MEMORY_SCOPE_WORKGROUP);
                        __hip_atomic_fetch_add(lcnt + e2, 1, __ATOMIC_RELAXED, __HIP_MEMORY_SCOPE_WORKGROUP);
                    }
                }
            } else {
                float* gb = (float*)(k.ws + WS_GB);
                if (n < 16) {
                    const float z = val + tail1;
                    const float ez = __expf(z); const float sp = z > 15.f ? z : (ez < 1e-4f ? ez - 0.5f * ez * ez : __logf(1.0f + ez));
                    gb[(size_t)rr * 32 + n] = tail0 * sp;
                } else {
                    gb[(size_t)rr * 32 + n] = 1.0f / (1.0f + expf(-val));
                }
            }
        }
        __syncthreads();
    }
    if (MODE == 1) {
        __syncthreads();
        int* cnt = (int*)(k.ws + WS_CTL + CTL_CNT) + layer * 32;
        if (flush && tid < 32 && lcnt[tid] > 0) atomicAdd(&cnt[tid], lcnt[tid]);
    }
}

namespace pg8 {
constexpr int BM = 256, BK = 64, HALF = 128, HTB = HALF * BK * 2, STAGE_BYTES = 8 * HTB;
DI int lds_byte(int r, int c) { const int st = (r >> 4) * 2 + (c >> 5), rr = r & 15, cc = c & 31, ob = rr * 64 + cc * 2; return st * 1024 + (ob ^ (((ob >> 9) & 1) << 5)); }
DI void stage_rc(int b, int& R, int& C) { const int st = b / 1024, sb = b % 1024, swz = sb ^ (((sb >> 9) & 1) << 5); R = (st >> 1) * 16 + swz / 64; C = (st & 1) * 32 + (swz % 64) / 2; }
DI int perm32(int rho) { const int n = rho >> 4, i = rho & 15; return 8 * (i >> 2) + 4 * n + (i & 3); }
struct Unit { int m0, mrows, pn; size_t boff; };
template <bool GATHER, class Epi, class Sched>
DI void gemm_phase(LAS unsigned char* lds, const bf16_t* A, const int* rowidx, const bf16_t* Bt, int K, const Sched& S, const Epi& E) {
    const int tid = TID(), wid = __builtin_amdgcn_readfirstlane(tid >> 6), lane = tid & 63, wr = wid >> 2, wc = wid & 3, fr = lane & 15, fq = lane >> 4;
    const int nt = K / BK;
    unsigned voffA[2], voffB[2];
#pragma unroll
    for (int i = 0; i < 2; ++i) { int R, C; stage_rc(tid * 16 + i * 8192, R, C); const int Rb = Epi::PERM ? ((R & ~31) + perm32(R & 31)) : R;
        voffA[i] = (unsigned)(R * K + C) * 2u; voffB[i] = (unsigned)(Rb * K + C) * 2u; }
    const size_t kstep = (size_t)(BK * 2);
    const size_t hstep = (size_t)HALF * K * 2;
    const size_t tstep = 2 * hstep;
    const size_t rstep = (size_t)K * 2;
    const unsigned ldsw = (unsigned)wid * 1024u;
    const int aoff = lds_byte(wr * 64 + fr, fq * 8), boff = lds_byte(wc * 32 + fr, fq * 8);
#define PG8_SA(b, h) (((b) * 2 + (h)) * HTB)
#define PG8_SB(b, h) ((4 + (b) * 2 + (h)) * HTB)
#define PG8_STAGE(bufoff, gbase, voff) do { _Pragma("unroll") for (int _i = 0; _i < 2; ++_i) \
        __builtin_amdgcn_global_load_lds((const unsigned*)((const char*)(gbase) + (voff)[_i]), (LAS unsigned*)(lds + (bufoff) + ldsw + _i * 8192), 16, 0, 0); } while (0)
#define PG8_STAGE_A(bufoff, p, h, vG) do { if (GATHER) PG8_STAGE(bufoff, p, (vG)[h]); else PG8_STAGE(bufoff, (p) + (h) * hstep, voffA); } while (0)
#define PG8_LDA(dst, b, h) do { _Pragma("unroll") for (int m = 0; m < 4; ++m) _Pragma("unroll") for (int k = 0; k < 2; ++k) dst[m][k] = *(const LAS bf16x8*)(lds + PG8_SA(b, h) + aoff + m * 2048 + k * 1024); } while (0)
#define PG8_LDB(dst, b, h) do { _Pragma("unroll") for (int n = 0; n < 2; ++n) _Pragma("unroll") for (int k = 0; k < 2; ++k) dst[n][k] = *(const LAS bf16x8*)(lds + PG8_SB(b, h) + boff + n * 2048 + k * 1024); } while (0)
#define PG8_MMA(ai, bj, At, Bt_) do { __builtin_amdgcn_s_setprio(1); _Pragma("unroll") for (int m = 0; m < 4; ++m) _Pragma("unroll") for (int n = 0; n < 2; ++n) _Pragma("unroll") for (int k = 0; k < 2; ++k) \
        acc[ai][bj][m][n] = __builtin_amdgcn_mfma_f32_16x16x32_bf16(Bt_[n][k], At[m][k], acc[ai][bj][m][n], 0, 0, 0); __builtin_amdgcn_s_setprio(0); } while (0)
#define PG8_WAIT_V(n) asm volatile("s_waitcnt vmcnt(" #n ")" ::: "memory")
#define PG8_WAIT_L(n) asm volatile("s_waitcnt lgkmcnt(" #n ")" ::: "memory")
#define PG8_BAR __builtin_amdgcn_s_barrier()
#define PG8_SCHED __builtin_amdgcn_sched_barrier(0)
#define PG8_AOFF(dst, u) do { _Pragma("unroll") for (int _h = 0; _h < 2; ++_h) _Pragma("unroll") for (int _i = 0; _i < 2; ++_i) { int _R, _C; stage_rc(tid * 16 + _i * 8192, _R, _C); \
        dst[_h][_i] = (unsigned)(rowidx[(u).m0 + _h * HALF + _R] * K + _C) * 2u; } } while (0)
    Unit cur, nxt; int ui = 0;
    if (!S.next(0, cur)) return;
    f32x4 acc[2][2][4][2];
#pragma unroll
    for (int a = 0; a < 2; ++a)
#pragma unroll
        for (int b = 0; b < 2; ++b)
#pragma unroll
            for (int m = 0; m < 4; ++m)
#pragma unroll
                for (int n = 0; n < 2; ++n) acc[a][b][m][n] = (f32x4){0.f, 0.f, 0.f, 0.f};
    bf16x8 At[4][2], B0[2][2], B1[2][2];
    unsigned vA[2][2], vN[2][2];
    if (GATHER) PG8_AOFF(vA, cur);
    const char* cA = (const char*)A + (GATHER ? (size_t)0 : (size_t)cur.m0 * rstep);
    const char* cB = (const char*)Bt + cur.boff + (size_t)cur.pn * tstep;
    PG8_STAGE(PG8_SB(0, 0), cB, voffB); PG8_STAGE_A(PG8_SA(0, 0), cA, 0, vA); PG8_STAGE(PG8_SB(0, 1), cB + hstep, voffB); PG8_STAGE_A(PG8_SA(0, 1), cA, 1, vA);
    if (wr == 1) PG8_BAR;
    PG8_WAIT_V(4); PG8_BAR;
    PG8_STAGE(PG8_SB(1, 0), cB + kstep, voffB); PG8_STAGE_A(PG8_SA(1, 0), cA + kstep, 0, vA); PG8_STAGE(PG8_SB(1, 1), cB + hstep + kstep, voffB);
    PG8_WAIT_V(6); PG8_BAR;
    for (;;) {
        const bool has_next = S.next(ui + 1, nxt);
        const char* nA = GATHER ? cA : (has_next ? (const char*)A + (size_t)nxt.m0 * rstep : cA);
        const char* nB = has_next ? (const char*)Bt + nxt.boff + (size_t)nxt.pn * tstep : cB;
        if (GATHER) {
            if (has_next) { PG8_AOFF(vN, nxt); }
            else {
#pragma unroll
                for (int h = 0; h < 2; ++h)
#pragma unroll
                    for (int i = 0; i < 2; ++i) vN[h][i] = vA[h][i];
            }
        }
        for (int t = 0; t < nt; t += 2) {
            const bool last = (t == nt - 2);
            const char* a1 = cA + (size_t)(t + 1) * kstep;
            const char* a2 = last ? nA : cA + (size_t)(t + 2) * kstep; const char* b2 = last ? nB : cB + (size_t)(t + 2) * kstep;
            const char* a3 = a2 + kstep; const char* b3 = b2 + kstep;
            PG8_LDB(B0, 0, 0); PG8_SCHED; PG8_LDA(At, 0, 0); PG8_STAGE_A(PG8_SA(1, 1), a1, 1, vA);
            if (GATHER && last) {
#pragma unroll
                for (int h = 0; h < 2; ++h)
#pragma unroll
                    for (int i = 0; i < 2; ++i) vA[h][i] = vN[h][i];
            }
            PG8_WAIT_L(8); PG8_BAR; PG8_WAIT_L(0); PG8_MMA(0, 0, At, B0); PG8_BAR; PG8_SCHED;
            PG8_LDB(B1, 0, 1); PG8_STAGE(PG8_SB(0, 0), b2, voffB);
            PG8_BAR; PG8_WAIT_L(0); PG8_MMA(0, 1, At, B1); PG8_BAR;
            PG8_LDA(At, 0, 1); PG8_STAGE_A(PG8_SA(0, 0), a2, 0, vA);
            PG8_BAR; PG8_WAIT_L(0); PG8_MMA(1, 0, At, B0); PG8_BAR; PG8_SCHED;
            PG8_STAGE(PG8_SB(0, 1), b2 + hstep, voffB);
            PG8_WAIT_V(6); PG8_BAR; PG8_MMA(1, 1, At, B1); PG8_BAR;
            PG8_LDB(B0, 1, 0); PG8_SCHED; PG8_LDA(At, 1, 0); PG8_STAGE_A(PG8_SA(0, 1), a2, 1, vA);
            PG8_WAIT_L(8); PG8_BAR; PG8_WAIT_L(0); PG8_MMA(0, 0, At, B0); PG8_BAR; PG8_SCHED;
            PG8_LDB(B1, 1, 1); PG8_STAGE(PG8_SB(1, 0), b3, voffB);
            PG8_BAR; PG8_WAIT_L(0); PG8_MMA(0, 1, At, B1); PG8_BAR;
            PG8_LDA(At, 1, 1); PG8_STAGE_A(PG8_SA(1, 0), a3, 0, vA);
            PG8_BAR; PG8_WAIT_L(0); PG8_MMA(1, 0, At, B0); PG8_BAR; PG8_SCHED;
            PG8_STAGE(PG8_SB(1, 1), b3 + hstep, voffB);
            PG8_WAIT_V(6); PG8_BAR; PG8_MMA(1, 1, At, B1); PG8_BAR;
        }
        { const int t2 = TID(), l2 = t2 & 63; E(acc, cur, wr, wc, l2 & 15, l2 >> 4); }
        if (!has_next) break;
#pragma unroll
        for (int a = 0; a < 2; ++a)
#pragma unroll
            for (int b = 0; b < 2; ++b)
#pragma unroll
                for (int m = 0; m < 4; ++m)
#pragma unroll
                    for (int n = 0; n < 2; ++n) acc[a][b][m][n] = (f32x4){0.f, 0.f, 0.f, 0.f};
        cur = nxt; cA = nA; cB = nB; ++ui;
    }
    PG8_WAIT_V(0);
    if (wr == 0) PG8_BAR;
    PG8_BAR;
#undef PG8_SA
#undef PG8_SB
#undef PG8_STAGE
#undef PG8_STAGE_A
#undef PG8_LDA
#undef PG8_LDB
#undef PG8_MMA
#undef PG8_WAIT_V
#undef PG8_WAIT_L
#undef PG8_BAR
#undef PG8_SCHED
#undef PG8_AOFF
}
struct DenseOrder {
    int nM, nN, nwg, G, c;
    DI void init(int M, int N, int G_, int c_) { nM = M / BM; nN = N / BM; nwg = nM * nN; G = G_; c = c_; }
    DI bool next(int i, Unit& u) const {
        const long L = (long)i * G + c; if (L >= nwg) return false;
        int wgid = (int)L; { const int q = nwg / 8, r = nwg % 8, xcd = wgid % 8, off = wgid / 8; wgid = (xcd < r ? xcd * (q + 1) : r * (q + 1) + (xcd - r) * q) + off; }
        const int nig = 8 * nN, gid = wgid / nig, fm = gid * 8, gsz = (nM - fm) < 8 ? (nM - fm) : 8;
        u.m0 = (fm + ((wgid % nig) % gsz)) * BM; u.mrows = BM; u.pn = (wgid % nig) / gsz; u.boff = 0; return true;
    }
};
struct MoeOrder {
    const LAS int* tb; int G, c; size_t estride; int lane;
    DI bool next(int i, Unit& u) const {
        const int L = i * G + c; if (L >= __builtin_amdgcn_readfirstlane(tb[97]) * 4) return false;
        const int tile = L >> 2;
        const int pre = tb[65 + (lane & 31)];
        const unsigned long long m = __ballot(lane < 32 && pre <= tile);
        const int e = __popcll(m) - 1;
        const int lt = tile - __builtin_amdgcn_readfirstlane(tb[65 + e]); int mr = __builtin_amdgcn_readfirstlane(tb[e]) - lt * 256; mr = mr > 256 ? 256 : mr;
        u.m0 = __builtin_amdgcn_readfirstlane(tb[32 + e]) + lt * 256; u.mrows = mr; u.pn = L & 3; u.boff = (size_t)e * estride; return true;
    }
};
}
struct EpiBf16 {
    static constexpr bool PERM = true;
    bf16_t* C; int ldc; int split_col; bf16_t* C2; int ldc2;
    DI void operator()(const f32x4 (&acc)[2][2][4][2], const pg8::Unit& u, int wr, int wc, int fr, int fq) const {
        int colt = u.pn * 256; bf16_t* base = C; int ld = ldc;
        if (colt >= split_col) { base = C2; ld = ldc2; colt -= split_col; }
#pragma unroll
        for (int ai = 0; ai < 2; ++ai)
#pragma unroll
            for (int m = 0; m < 4; ++m) {
                const int rl = ai * 128 + wr * 64 + m * 16 + fr;
                if (rl < u.mrows) {
                    bf16_t* rowp = base + (size_t)(u.m0 + rl) * ld + colt + wc * 32 + 8 * fq;
#pragma unroll
                    for (int bj = 0; bj < 2; ++bj) {
                        const f32x4 v0 = acc[ai][bj][m][0], v1 = acc[ai][bj][m][1];
                        u32x4 o; o[0] = cvt_pk_bf16(v0[0], v0[1]); o[1] = cvt_pk_bf16(v0[2], v0[3]); o[2] = cvt_pk_bf16(v1[0], v1[1]); o[3] = cvt_pk_bf16(v1[2], v1[3]);
                        *(u32x4*)(rowp + bj * 128) = o;
                    }
                }
            }
    }
};
struct EpiBf16T {
    static constexpr bool PERM = false;
    bf16_t* C; int ldc;
    DI void operator()(const f32x4 (&acc)[2][2][4][2], const pg8::Unit& u, int wr, int wc, int fr, int fq) const {
#pragma unroll
        for (int ai = 0; ai < 2; ++ai)
#pragma unroll
            for (int bj = 0; bj < 2; ++bj)
#pragma unroll
                for (int m = 0; m < 4; ++m)
#pragma unroll
                    for (int n = 0; n < 2; ++n) {
                        const int row = u.m0 + ai * 128 + wr * 64 + m * 16 + fr, col = u.pn * 256 + bj * 128 + wc * 32 + n * 16 + 4 * fq;
#pragma unroll
                        for (int e = 0; e < 4; ++e) C[(size_t)(col + e) * ldc + row] = f2bf(acc[ai][bj][m][n][e]);
                    }
    }
};
struct EpiTaps {
    static constexpr bool PERM = false;
    bf16_t* FT;
    DI void operator()(const f32x4 (&acc)[2][2][4][2], const pg8::Unit& u, int wr, int wc, int fr, int fq) const {
#pragma unroll
        for (int ai = 0; ai < 2; ++ai)
#pragma unroll
            for (int m = 0; m < 4; ++m) {
                const int row = u.m0 + ai * 128 + wr * 64 + m * 16 + fr; const float dl = hy_delta(row & 1023) * (1.0f / 16383.0f);
#pragma unroll
                for (int bj = 0; bj < 2; ++bj)
#pragma unroll
                    for (int n = 0; n < 2; ++n) {
                        const int l = u.pn * 256 + bj * 128 + wc * 32 + n * 16 + 4 * fq; float o[4];
#pragma unroll
                        for (int e = 0; e < 4; ++e) o[e] = acc[ai][bj][m][n][e] * __expf(-(float)(l + e) * dl);
                        u32x2 pk; pk[0] = pk2(o[0], o[1]); pk[1] = pk2(o[2], o[3]);
                        *(u32x2*)(FT + (size_t)row * 16384 + l) = pk;
                    }
            }
    }
};
struct EpiResid {
    static constexpr bool PERM = false;
    float* xs; const float* mod; int layer; int chunk;
    DI void operator()(const f32x4 (&acc)[2][2][4][2], const pg8::Unit& u, int wr, int wc, int fr, int fq) const {
        const float* g = mod + ((size_t)(layer * 3 + modrow(u.m0)) * 6 + chunk) * 1024;
#pragma unroll
        for (int bj = 0; bj < 2; ++bj)
#pragma unroll
            for (int n = 0; n < 2; ++n) {
                const int col = u.pn * 256 + bj * 128 + wc * 32 + n * 16 + 4 * fq; const f32x4 gv = *(const f32x4*)(g + col);
                float* p0 = xs + (size_t)(u.m0 + wr * 64 + fr) * 1024 + col;
                f32x4 old[8];
#pragma unroll
                for (int ai = 0; ai < 2; ++ai)
#pragma unroll
                    for (int m = 0; m < 4; ++m) old[ai * 4 + m] = *(const f32x4*)(p0 + (size_t)(ai * 128 + m * 16) * 1024);
                asm volatile("" ::: "memory");
#pragma unroll
                for (int ai = 0; ai < 2; ++ai)
#pragma unroll
                    for (int m = 0; m < 4; ++m) *(f32x4*)(p0 + (size_t)(ai * 128 + m * 16) * 1024) = old[ai * 4 + m] + gv * acc[ai][bj][m][n];
            }
    }
};
struct EpiGateUp {
    static constexpr bool PERM = false;
    bf16_t* hid;
    DI void operator()(const f32x4 (&acc)[2][2][4][2], const pg8::Unit& u, int wr, int wc, int fr, int fq) const {
#pragma unroll
        for (int ai = 0; ai < 2; ++ai)
#pragma unroll
            for (int m = 0; m < 4; ++m) {
                const int rl = ai * 128 + wr * 64 + m * 16 + fr;
                if (rl < u.mrows) {
#pragma unroll
                    for (int bj = 0; bj < 2; ++bj) {
                        const int hc = ((u.pn * 256 + bj * 128 + wc * 32) >> 1) + 4 * fq;
                        const f32x4 g = acc[ai][bj][m][0], up = acc[ai][bj][m][1];
                        u32x2 o; o[0] = cvt_pk_bf16(siluf(g[0]) * up[0], siluf(g[1]) * up[1]); o[1] = cvt_pk_bf16(siluf(g[2]) * up[2], siluf(g[3]) * up[3]);
                        *(u32x2*)(hid + (size_t)(u.m0 + rl) * 512 + hc) = o;
                    }
                }
            }
    }
};
template <class Epi>
PF void gemm_dense(LAS unsigned char* lds, const bf16_t* A, int M, const bf16_t* Bt, int N, int K, const Epi& epi) {
    pg8::DenseOrder S; S.init(M, N, (int)gridDim.x, (int)blockIdx.x);
    pg8::gemm_phase<false>(lds, A, (const int*)nullptr, Bt, K, S, epi);
}
DI void moe_table(const KC& k, int layer, LAS int* tb) {
    const int* cnt = (const int*)(k.ws + WS_CTL + CTL_CNT) + layer * 32;
    __syncthreads();
    const int tq = TID();
    if (tq < 32) tb[tq] = __hip_atomic_load(cnt + tq, __ATOMIC_RELAXED, __HIP_MEMORY_SCOPE_AGENT);
    __syncthreads();
    if (tq == 0) {
        int s = 0, tp = 0;
        for (int e = 0; e < 32; ++e) { tb[32 + e] = s; tb[65 + e] = tp; s += tb[e]; tp += (tb[e] + 255) >> 8; }
        tb[64] = s; tb[97] = tp;
    }
    __syncthreads();
}
template <int WHICH>
PF void moe_gemm(const KC& k, int layer, LAS unsigned char* lds, LAS int* tb) {
    moe_table(k, layer, tb);
    if (WHICH == 0) {
        pg8::MoeOrder S{tb, (int)gridDim.x, (int)blockIdx.x, (size_t)1024 * 1024 * 2, TID() & 63};
        EpiGateUp epi{(bf16_t*)(k.ws + AR_HID)};
        pg8::gemm_phase<true>(lds, (const bf16_t*)(k.ws + AR_HBUF), (const int*)(k.ws + WS_SLOT), (const bf16_t*)(k.ws + AR_WGU), 1024, S, epi);
    } else {
        pg8::MoeOrder S{tb, (int)gridDim.x, (int)blockIdx.x, (size_t)1024 * 512 * 2, TID() & 63};
        EpiBf16 epi{(bf16_t*)(k.ws + AR_YS), 1024, 1 << 30, nullptr, 0};
        pg8::gemm_phase<false>(lds, (const bf16_t*)(k.ws + AR_HID), (const int*)nullptr, (const bf16_t*)(k.ws + AR_WD), 512, S, epi);
    }
}
PF void moe_scatter(const KC& k, int layer, LAS int* tb) {
    moe_table(k, layer, tb);
    const int* toke = (const int*)(k.ws + WS_TOKE);
    int* tokp = (int*)(k.ws + WS_TOKP); int* slot = (int*)(k.ws + WS_SLOT);
    int* cur = (int*)(k.ws + WS_CTL + CTL_CNT) + 128 + layer * 32;
    LAS int* lc = tb + 128; LAS int* lb = tb + 160;
    const int tid = TID();
    if (blockIdx.x == 0 && tid < 256) slot[NA + tid] = 0;
    for (int r0 = blockIdx.x * NTHR; r0 < T; r0 += gridDim.x * NTHR) {
        const int r = r0 + tid;
        __syncthreads();
        if (tid < 32) lc[tid] = 0;
        __syncthreads();
        const int e0 = toke[2 * r], e1 = toke[2 * r + 1];
        int k0 = 0, k1 = 0;
        if (e0 >= 0) { k0 = __hip_atomic_fetch_add(lc + e0, 1, __ATOMIC_RELAXED, __HIP_MEMORY_SCOPE_WORKGROUP); k1 = __hip_atomic_fetch_add(lc + e1, 1, __ATOMIC_RELAXED, __HIP_MEMORY_SCOPE_WORKGROUP); }
        __syncthreads();
        if (tid < 32) lb[tid] = lc[tid] > 0 ? atomicAdd(&cur[tid], lc[tid]) : 0;
        __syncthreads();
        if (e0 >= 0) {
            const int p0 = tb[32 + e0] + lb[e0] + k0, p1 = tb[32 + e1] + lb[e1] + k1;
            slot[p0] = r; slot[p1] = r; tokp[2 * r] = p0; tokp[2 * r + 1] = p1;
        }
    }
}

DI void unpack8(const u32x4 v, float (&f)[8]) {
#pragma unroll
    for (int w = 0; w < 4; ++w) { f[2 * w] = __uint_as_float(v[w] << 16); f[2 * w + 1] = __uint_as_float(v[w] & 0xffff0000u); }
}
PF void sc_mix(const KC& k, int j) {
    const int tid = TID(), lane = tid & 63, wave = tid >> 6;
    const bf16_t* P = (const bf16_t*)(k.ws + AR_PB);
    bf16_t* U = (bf16_t*)(k.ws + AR_UBUF);
    const float* cw = k.sc_conv + (size_t)j * 3 * 1024;
    const int c0 = lane * 16;
    float k0[16], k1[16], k2[16];
#pragma unroll
    for (int e = 0; e < 16; ++e) { k0[e] = cw[c0 + e]; k1[e] = cw[1024 + c0 + e]; k2[e] = cw[2048 + c0 + e]; }
    for (int r = blockIdx.x * 8 + wave; r < T; r += gridDim.x * 8) {
        bool lok, rok;
        if (r < TC) { const int t = r & 255; lok = t != 0; rok = t != 255; } else { const int t = (r - TC) & 63; lok = t != 0; rok = t != 63; }
        const bf16_t* p = P + (size_t)r * 3072 + c0;
        const bf16_t* pl = lok ? p - 3072 : p; const bf16_t* pr = rok ? p + 3072 : p;
        u32x4 vb[2], vc[2], vx[2], vcl[2], vxl[2], vcr[2], vxr[2];
#pragma unroll
        for (int hh = 0; hh < 2; ++hh) {
            vb[hh] = *(const u32x4*)(p + hh * 8); vc[hh] = *(const u32x4*)(p + 1024 + hh * 8); vx[hh] = *(const u32x4*)(p + 2048 + hh * 8);
            vcl[hh] = *(const u32x4*)(pl + 1024 + hh * 8); vxl[hh] = *(const u32x4*)(pl + 2048 + hh * 8);
            vcr[hh] = *(const u32x4*)(pr + 1024 + hh * 8); vxr[hh] = *(const u32x4*)(pr + 2048 + hh * 8);
        }
        asm volatile("" ::: "memory");
        const float fl = lok ? 1.f : 0.f, frr = rok ? 1.f : 0.f;
#pragma unroll
        for (int hh = 0; hh < 2; ++hh) {
            float bg[8], cg[8], xi[8], cl[8], xl[8], cr[8], xr[8];
            unpack8(vb[hh], bg); unpack8(vc[hh], cg); unpack8(vx[hh], xi); unpack8(vcl[hh], cl); unpack8(vxl[hh], xl); unpack8(vcr[hh], cr); unpack8(vxr[hh], xr);
            u32x4 o;
#pragma unroll
            for (int w = 0; w < 4; ++w) {
                float ov[2];
#pragma unroll
                for (int e = 0; e < 2; ++e) { const int i = 2 * w + e, c = hh * 8 + i; ov[e] = bg[i] * (k0[c] * fl * cl[i] * xl[i] + k1[c] * cg[i] * xi[i] + k2[c] * frr * cr[i] * xr[i]); }
                o[w] = pk2(ov[0], ov[1]);
            }
            *(u32x4*)(U + (size_t)r * 1024 + c0 + hh * 8) = o;
        }
    }
}

constexpr int DN_STEPS = 260, DN_UNITS = 32 * DN_STEPS;
DI int dn_rbase(int b, int dir, int s) {
    if (s < 4) return dir == 0 ? b * 256 + s * 64 : b * 256 + 255 - s * 64;
    const int cc = s - 4;
    return dir == 0 ? TC + b * SEQ + cc * 64 : TC + b * SEQ + SEQ - 1 - cc * 64;
}
struct DnRaw { u32x4 c[3][2], l[3][2], r[3][2]; float g, be; };
DI void dn_raw_load(const bf16_t* P, const float* gb, int u, int tid, DnRaw& R) {
    const int chain = u / DN_STEPS, s = u - chain * DN_STEPS, dir = chain & 1, h = (chain >> 1) & 7, b = chain >> 4;
    const int rbase = dn_rbase(b, dir, s), rstep = dir == 0 ? 1 : -1;
    const int i = tid >> 3, sg = tid & 7, r = rbase + rstep * i;
    bool lok, rok;
    if (r < TC) { const int t = r & 255; lok = t != 0; rok = t != 255; } else { const int t = (r - TC) & 63; lok = t != 0; rok = t != 63; }
#pragma unroll
    for (int part = 0; part < 3; ++part) {
        const bf16_t* pc = P + (size_t)r * 3072 + part * 1024 + h * 128 + sg * 16;
#pragma unroll
        for (int hf = 0; hf < 2; ++hf) {
            R.c[part][hf] = *(const u32x4*)(pc + hf * 8);
            R.l[part][hf] = (u32x4){0u, 0u, 0u, 0u}; R.r[part][hf] = (u32x4){0u, 0u, 0u, 0u};
            if (lok) R.l[part][hf] = *(const u32x4*)(pc - 3072 + hf * 8);
            if (rok) R.r[part][hf] = *(const u32x4*)(pc + 3072 + hf * 8);
        }
    }
    if (tid < 64) { const size_t row = (size_t)(rbase + rstep * tid); R.g = gb[row * 32 + dir * 8 + h]; R.be = gb[row * 32 + 16 + dir * 8 + h]; }
}
PF void dn_chunk(const KC& k, int jl, LAS unsigned char* lds) {
    const int tid = TID(), lane = tid & 63, wave = tid >> 6, fr = lane & 15, fq = lane >> 4;
    LAS bf16_t* Kt = (LAS bf16_t*)lds;
    LAS bf16_t* Qt = Kt + 64 * 136;
    LAS bf16_t* Vt = Qt + 64 * 136;
    LAS float* Amat = (LAS float*)(Vt + 64 * 136);
    LAS bf16_t* Tb = (LAS bf16_t*)(Amat + 64 * 64);
    LAS bf16_t* VbT = Tb + 64 * 72;
    LAS bf16_t* KbT = VbT + 128 * 72;
    LAS float* gcs = (LAS float*)(KbT + 128 * 72);
    LAS float* bet = gcs + 64; LAS float* eg = bet + 64; LAS float* egr = eg + 64;
    LAS float* Tm = egr + 64;
    LAS float* Wc = Tm + 64 * 64;
    const bf16_t* P = (const bf16_t*)(k.ws + AR_PB);
    const float* gb = (const float*)(k.ws + WS_GB);
    const float* cw = k.dn_conv + (size_t)jl * 3 * 3072;
    bf16_t* CH = (bf16_t*)(k.ws + AR_CHUNK);
    bf16_t* ATT = (bf16_t*)(k.ws + AR_HBUF);
    float* EGL = (float*)(k.ws + WS_EGL);
    for (int u = blockIdx.x; u < DN_UNITS; u += gridDim.x) {
        DnRaw Rn; dn_raw_load(P, gb, u, tid, Rn);
        const int chain = u / DN_STEPS, s = u - chain * DN_STEPS, dir = chain & 1, h = (chain >> 1) & 7, b = chain >> 4;
        const int wti = tid < 288 ? tid : 0, wtap = wti / 96, wrem = wti - wtap * 96;
        const f32x4 wcv = *(const f32x4*)(cw + wtap * 3072 + (wrem >> 5) * 1024 + h * 128 + (wrem & 31) * 4);
        const int rbase = dn_rbase(b, dir, s), rstep = dir == 0 ? 1 : -1;
        bf16_t* cW = CH + (size_t)u * 32768; bf16_t* cQd = cW + 8192; bf16_t* cKd = cQd + 8192; bf16_t* cU = cKd + 8192;
        bf16_t* cAt = ATT + (size_t)u * 4096;
        lds_barrier();
        if (tid < 288) *(LAS f32x4*)(Wc + wtap * 384 + wrem * 4) = wcv;
        lds_barrier();
        const float g_in = Rn.g, be_in = Rn.be;
        {
            const int i = tid >> 3, sg = tid & 7;
#pragma unroll
            for (int part = 0; part < 3; ++part) {
                const int col = part * 1024 + h * 128 + sg * 16;
                float v[16];
#pragma unroll
                for (int hf = 0; hf < 2; ++hf) {
                    const u32x4 c4 = Rn.c[part][hf], l4 = Rn.l[part][hf], r4 = Rn.r[part][hf];
#pragma unroll
                    for (int w2 = 0; w2 < 2; ++w2) {
                        const LAS float* wp = Wc + part * 128 + sg * 16 + hf * 8 + 4 * w2;
                        const f32x4 k0 = *(const LAS f32x4*)wp, k1 = *(const LAS f32x4*)(wp + 384), k2 = *(const LAS f32x4*)(wp + 768);
#pragma unroll
                        for (int e = 0; e < 4; ++e) {
                            const int w = 2 * w2 + (e >> 1);
                            const float lv = __uint_as_float((e & 1) ? (l4[w] & 0xffff0000u) : (l4[w] << 16));
                            const float cv = __uint_as_float((e & 1) ? (c4[w] & 0xffff0000u) : (c4[w] << 16));
                            const float rv = __uint_as_float((e & 1) ? (r4[w] & 0xffff0000u) : (r4[w] << 16));
                            v[hf * 8 + 4 * w2 + e] = siluf(k0[e] * lv + k1[e] * cv + k2[e] * rv);
                        }
                    }
                }
                if (part < 2) {
                    float ss = 0.f;
#pragma unroll
                    for (int e = 0; e < 16; ++e) ss += v[e] * v[e];
                    ss += shx(ss, 1, lane); ss += shx(ss, 2, lane); ss += shx(ss, 4, lane);
                    const float sc = rsqrtf(ss + EPS) * (part == 0 ? 0.08838834764831845f : 1.0f);
#pragma unroll
                    for (int e = 0; e < 16; ++e) v[e] *= sc;
                }
                LAS bf16_t* dst = (part == 0 ? Qt : (part == 1 ? Kt : Vt)) + i * 136 + sg * 16;
                u32x4 o0, o1;
#pragma unroll
                for (int w = 0; w < 4; ++w) { o0[w] = pk2(v[2 * w], v[2 * w + 1]); o1[w] = pk2(v[8 + 2 * w], v[8 + 2 * w + 1]); }
                *(LAS u32x4*)dst = o0; *(LAS u32x4*)(dst + 8) = o1;
            }
        }
        if (wave == 0) {
            float g = g_in;
            const float be = be_in;
#pragma unroll
            for (int d = 1; d < 64; d <<= 1) { const float o = shi(g, (lane - d) & 63); if (lane >= d) g += o; }
            const float glast = shi(g, 63);
            gcs[lane] = g; bet[lane] = be; eg[lane] = expf(g); egr[lane] = expf(glast - g);
            if (lane == 0) EGL[u] = expf(glast);
        }
        lds_barrier();
#pragma unroll 1
        for (int x = 0; x < 4; ++x) {
            const int t = wave + 8 * x, isq = t >> 4, mt = (t >> 2) & 3, nt = t & 3;
            f32x4 acc = (f32x4){0.f, 0.f, 0.f, 0.f};
            const int jc = 16 * nt + fr;
            float gi4[4], bi4[4];
            const float gj = gcs[jc];
#pragma unroll
            for (int jj = 0; jj < 4; ++jj) { gi4[jj] = gcs[16 * mt + 4 * fq + jj]; bi4[jj] = bet[16 * mt + 4 * fq + jj]; }
            if (mt >= nt) {
                const LAS bf16_t* Ar = (isq ? Qt : Kt) + (16 * mt + fr) * 136 + 8 * fq;
                const LAS bf16_t* Br = Kt + (16 * nt + fr) * 136 + 8 * fq;
                bf16x8 fa4[4], fb4[4];
#pragma unroll
                for (int ks = 0; ks < 4; ++ks) { fa4[ks] = *(const LAS bf16x8*)(Ar + 32 * ks); fb4[ks] = *(const LAS bf16x8*)(Br + 32 * ks); }
                asm volatile("" ::: "memory");
#pragma unroll
                for (int ks = 0; ks < 4; ++ks) acc = __builtin_amdgcn_mfma_f32_16x16x32_bf16(fa4[ks], fb4[ks], acc, 0, 0, 0);
            }
#pragma unroll
            for (int jj = 0; jj < 4; ++jj) {
                const int ir = 16 * mt + 4 * fq + jj;
                const float dec = __expf(fminf(gi4[jj] - gj, 0.f));
                if (isq) cAt[((mt * 2 + (nt >> 1)) * 64 + (fr >> 2) * 16 + 4 * fq + jj) * 8 + (nt & 1) * 4 + (fr & 3)] = f2bf(ir >= jc ? acc[jj] * dec : 0.f);
                else Amat[ir * 64 + jc] = ir > jc ? bi4[jj] * acc[jj] * dec : 0.f;
            }
        }
        {
            const int un = u + (int)gridDim.x < DN_UNITS ? u + (int)gridDim.x : u;
            const int chn = un / DN_STEPS, stn = un - chn * DN_STEPS, dirn = chn & 1, hn = (chn >> 1) & 7, bn = chn >> 4;
            const int rbn = dn_rbase(bn, dirn, stn), rsn = dirn == 0 ? 1 : -1;
            const unsigned char* pa;
            if (tid < 396) { const int seg = tid >> 1, ri = seg / 3, part = seg - 3 * ri; int r = rbn + rsn * (ri - 1); r = r < 0 ? 0 : r > T - 1 ? T - 1 : r;
                             pa = (const unsigned char*)(P + (size_t)r * 3072 + part * 1024 + hn * 128 + (tid & 1) * 64); }
            else { const int j = tid < 460 ? tid - 396 : 0; pa = (const unsigned char*)(gb + (size_t)(rbn + rsn * j) * 32); }
            __builtin_amdgcn_global_load_lds((const unsigned*)pa, (LAS unsigned*)(lds + 143360), 4, 0, 0);
        }
        lds_barrier();
        {
        if (wave < 4) {
            if (lane < 16) {
                const int bo = 16 * wave;
                float tc[16];
#pragma unroll
                for (int i = 0; i < 16; ++i) {
                    f32x4 ar[4];
#pragma unroll
                    for (int q = 0; q < (i + 3) / 4; ++q) ar[q] = *(const LAS f32x4*)(Amat + (bo + i) * 64 + bo + 4 * q);
                    float a0 = (i == lane) ? 1.f : 0.f, a1 = 0.f;
#pragma unroll
                    for (int j = 0; j < i; ++j) { const float av = ar[j >> 2][j & 3]; if (j & 1) a1 -= av * tc[j]; else a0 -= av * tc[j]; }
                    tc[i] = a0 + a1;
                    Tm[(bo + i) * 64 + bo + lane] = tc[i];
                }
            }
        } else {
            for (int it = tid - 256; it < 1024; it += 256) {
                const int c = it & 127, ig = it >> 7;
                float kv[8], vv[8];
                { bf16_t kr[8], vr[8];
#pragma unroll
                  for (int e = 0; e < 8; ++e) { kr[e] = Kt[(8 * ig + e) * 136 + c]; vr[e] = Vt[(8 * ig + e) * 136 + c]; }
                  asm volatile("" ::: "memory");
#pragma unroll
                  for (int e = 0; e < 8; ++e) { kv[e] = bf2f(kr[e]); vv[e] = bf2f(vr[e]); } }
                u32x4 ov, ok, od;
#pragma unroll
                for (int w = 0; w < 4; ++w) {
                    const int i0 = 8 * ig + 2 * w, i1 = i0 + 1;
                    ov[w] = pk2(bet[i0] * vv[2 * w], bet[i1] * vv[2 * w + 1]);
                    ok[w] = pk2(bet[i0] * eg[i0] * kv[2 * w], bet[i1] * eg[i1] * kv[2 * w + 1]);
                    od[w] = pk2(egr[i0] * kv[2 * w], egr[i1] * kv[2 * w + 1]);
                }
                *(LAS u32x4*)(VbT + c * 72 + 8 * ig) = ov;
                *(LAS u32x4*)(KbT + c * 72 + 8 * ig) = ok;
                { bf16_t* kd0 = cKd + (((c >> 4) * 2 + (ig >> 2)) * 64 + (2 * (ig & 1)) * 16 + (c & 15)) * 8 + ((ig & 3) >> 1) * 4;
                  *(u32x2*)kd0 = (u32x2){od[0], od[1]}; *(u32x2*)(kd0 + 128) = (u32x2){od[2], od[3]}; }
            }
            for (int it = tid - 256; it < 1024; it += 256) {
                const int i = it >> 4, c8 = (it & 15) * 8; const float e = eg[i];
                const u32x4 qv = *(const LAS u32x4*)(Qt + i * 136 + c8); u32x4 o;
#pragma unroll
                for (int w = 0; w < 4; ++w) o[w] = pk2(__uint_as_float(qv[w] << 16) * e, __uint_as_float(qv[w] & 0xffff0000u) * e);
                { const int k8 = it & 15; bf16_t* qd0 = cQd + (((i >> 4) * 4 + (k8 >> 2)) * 64 + (2 * (k8 & 1)) * 16 + (i & 15)) * 8 + ((k8 & 3) >> 1) * 4;
                  *(u32x2*)qd0 = (u32x2){o[0], o[1]}; *(u32x2*)(qd0 + 128) = (u32x2){o[2], o[3]}; }
            }
        }
        lds_barrier();
#pragma unroll 1
        for (int d = 1; d < 4; ++d) {
            if (wave < 4 - d) {
                const int bi = wave + d, bj = wave, r = lane >> 2, c0 = 4 * (lane & 3);
                f32x4 m = (f32x4){0.f, 0.f, 0.f, 0.f};
                for (int kb = bj; kb < bi; ++kb) {
                    f32x4 av4[4], tv[16];
#pragma unroll
                    for (int q = 0; q < 4; ++q) av4[q] = *(const LAS f32x4*)(Amat + (16 * bi + r) * 64 + 16 * kb + 4 * q);
#pragma unroll
                    for (int kk = 0; kk < 16; ++kk) tv[kk] = *(const LAS f32x4*)(Tm + (16 * kb + kk) * 64 + 16 * bj + c0);
                    asm volatile("" ::: "memory");
#pragma unroll
                    for (int kk = 0; kk < 16; ++kk) m += tv[kk] * av4[kk >> 2][kk & 3];
                }
                *(LAS f32x4*)(Tm + (16 * bj + r) * 64 + 16 * bi + c0) = m;
                f32x4 t = (f32x4){0.f, 0.f, 0.f, 0.f};
                {
                    f32x4 dv4[4], mv[16];
#pragma unroll
                    for (int q = 0; q < 4; ++q) dv4[q] = *(const LAS f32x4*)(Tm + (16 * bi + r) * 64 + 16 * bi + 4 * q);
#pragma unroll
                    for (int kk = 0; kk < 16; ++kk) mv[kk] = *(const LAS f32x4*)(Tm + (16 * bj + kk) * 64 + 16 * bi + c0);
                    asm volatile("" ::: "memory");
#pragma unroll
                    for (int kk = 0; kk < 16; ++kk) t -= mv[kk] * dv4[kk >> 2][kk & 3];
                }
                *(LAS f32x4*)(Tm + (16 * bi + r) * 64 + 16 * bj + c0) = t;
            }
            lds_barrier();
        }
        for (int it = tid; it < 64 * 8; it += NTHR) {
            const int i = it >> 3, c8 = (it & 7) * 8; u32x4 o;
#pragma unroll
            for (int w = 0; w < 4; ++w) {
                const int c = c8 + 2 * w;
                o[w] = pk2(c <= i ? Tm[i * 64 + c] : 0.f, c + 1 <= i ? Tm[i * 64 + c + 1] : 0.f);
            }
            *(LAS u32x4*)(Tb + i * 72 + c8) = o;
        }
        }
        lds_barrier();
        {
            f32x4 au[4], aw[4];
#pragma unroll
            for (int mt = 0; mt < 4; ++mt) { au[mt] = (f32x4){0.f, 0.f, 0.f, 0.f}; aw[mt] = (f32x4){0.f, 0.f, 0.f, 0.f}; }
            bf16x8 bv[2], bk[2], at[2][4];
#pragma unroll
            for (int ks = 0; ks < 2; ++ks) {
                bv[ks] = *(const LAS bf16x8*)(VbT + (16 * wave + fr) * 72 + 32 * ks + 8 * fq);
                bk[ks] = *(const LAS bf16x8*)(KbT + (16 * wave + fr) * 72 + 32 * ks + 8 * fq);
#pragma unroll
                for (int mt = 0; mt < 4; ++mt) at[ks][mt] = *(const LAS bf16x8*)(Tb + (16 * mt + fr) * 72 + 32 * ks + 8 * fq);
            }
            asm volatile("" ::: "memory");
#pragma unroll
            for (int ks = 0; ks < 2; ++ks)
#pragma unroll
                for (int mt = 0; mt < 4; ++mt) {
                    au[mt] = __builtin_amdgcn_mfma_f32_16x16x32_bf16(at[ks][mt], bv[ks], au[mt], 0, 0, 0);
                    aw[mt] = __builtin_amdgcn_mfma_f32_16x16x32_bf16(at[ks][mt], bk[ks], aw[mt], 0, 0, 0);
                }
#pragma unroll
            for (int mt = 0; mt < 4; ++mt)
#pragma unroll
                for (int jj = 0; jj < 4; ++jj)
                    cW[((mt * 4 + (wave >> 1)) * 64 + (fr >> 2) * 16 + 4 * fq + jj) * 8 + (wave & 1) * 4 + (fr & 3)] = f2bf(aw[mt][jj]);
            {
                u32x4 u0, u1;
                u0[0] = pk2(au[0][0], au[0][1]); u0[1] = pk2(au[0][2], au[0][3]); u0[2] = pk2(au[1][0], au[1][1]); u0[3] = pk2(au[1][2], au[1][3]);
                u1[0] = pk2(au[2][0], au[2][1]); u1[1] = pk2(au[2][2], au[2][3]); u1[2] = pk2(au[3][0], au[3][1]); u1[3] = pk2(au[3][2], au[3][3]);
                bf16_t* ud = cU + (wave * 64 + lane) * 16;
                *(u32x4*)ud = u0; *(u32x4*)(ud + 8) = u1;
            }
        }
    }
}
DI bf16x8 pk8(f32x4 a, f32x4 b) { u32x4 r; r[0] = pk2(a[0], a[1]); r[1] = pk2(a[2], a[3]); r[2] = pk2(b[0], b[1]); r[3] = pk2(b[2], b[3]); return __builtin_bit_cast(bf16x8, r); }
constexpr int SC_PFD = 3;
DI bf16x8 ldfrag(const bf16_t* p) { return __builtin_bit_cast(bf16x8, *(const u32x4*)p); }
PF void dn_scan(const KC& k, LAS unsigned char* lds, int pm) {
    const int tid = TID(), lane = tid & 63, fr = lane & 15, fq = lane >> 4;
    const int wave = __builtin_amdgcn_readfirstlane(tid >> 6);
    const bf16_t* CH = (const bf16_t*)(k.ws + AR_CHUNK);
    const bf16_t* ATT = (const bf16_t*)(k.ws + AR_HBUF);
    const float* EGL = (const float*)(k.ws + WS_EGL);
    bf16_t* O = (bf16_t*)(k.ws + (pm ? AR_UBUF : AR_PB));
    LAS float* eglL = (LAS float*)lds;
    LAS u32x4* sbx = (LAS u32x4*)(eglL + 272);
    LAS u32x4* vbx = sbx + 512;
    volatile LAS int* vflag = (volatile LAS int*)(vbx + 256);
    for (int un0 = blockIdx.x; un0 < 256; un0 += gridDim.x) {
        if ((pm == 2 && ((un0 >> 3) & 1)) || (pm == 3 && (un0 & 1))) continue;
        const int un = (gridDim.x == 256) ? ((un0 & 7) * 32 + (un0 >> 3)) : un0;
        const int sl = un & 7, chain = un >> 3, dir = chain & 1, h = (chain >> 1) & 7, b = chain >> 4;
        const int rstep = dir == 0 ? 1 : -1;
        const bf16_t* U0 = CH + (size_t)(chain * DN_STEPS) * 32768 + lane * 8;
        const bf16_t* A0 = ATT + (size_t)(chain * DN_STEPS) * 4096 + lane * 8;
        lds_barrier();
        if (tid < DN_STEPS) eglL[tid] = EGL[chain * DN_STEPS + tid];
        if (tid == 0) *vflag = 0;
        if (wave == 0) {
            f32x4 S[8];
#pragma unroll
            for (int t = 0; t < 8; ++t) S[t] = (f32x4){0.f, 0.f, 0.f, 0.f};
            bf16x8 fw[16], fk[16]; u32x4 uc[2];
#pragma unroll
            for (int i = 0; i < 16; ++i) { fw[i] = ldfrag(U0 + i * 512); fk[i] = ldfrag(U0 + 16384 + i * 512); }
            { const bf16_t* up = U0 - lane * 8 + 24576 + (sl * 64 + lane) * 16; uc[0] = *(const u32x4*)up; uc[1] = *(const u32x4*)(up + 8); }
#pragma unroll
            for (int ks = 0; ks < 4; ++ks) sbx[ks * 64 + lane] = (u32x4){0u, 0u, 0u, 0u};
#pragma unroll
            for (int i = 0; i < 16; ++i) { asm volatile("" :: "v"(__builtin_bit_cast(u32x4, fw[i]))); asm volatile("" :: "v"(__builtin_bit_cast(u32x4, fk[i]))); }
            asm volatile("" :: "v"(uc[0]), "v"(uc[1]));
            lds_barrier();
#pragma unroll 1
            for (int s = 0; s < DN_STEPS; ++s) {
                const int sn = pm == 1 ? 0 : s + 1 < DN_STEPS ? s + 1 : s;
                const bf16_t* Un = U0 + (size_t)sn * 32768;
                const float egl = eglL[s];
                bf16x8 sb[4];
#pragma unroll
                for (int ks = 0; ks < 4; ++ks) sb[ks] = pk8(S[2 * ks], S[2 * ks + 1]);
                f32x4 p[4];
#pragma unroll
                for (int mt = 0; mt < 4; ++mt) p[mt] = (f32x4){0.f, 0.f, 0.f, 0.f};
#pragma unroll
                for (int ks = 0; ks < 4; ++ks)
#pragma unroll
                    for (int mt = 0; mt < 4; ++mt) {
                        p[mt] = __builtin_amdgcn_mfma_f32_16x16x32_bf16(fw[mt * 4 + ks], sb[ks], p[mt], 0, 0, 0);
                        fw[mt * 4 + ks] = ldfrag(Un + (mt * 4 + ks) * 512);
                    }
#pragma unroll
                for (int mt = 0; mt < 4; ++mt) {
                    const unsigned ua = uc[mt >> 1][(mt & 1) * 2], ub = uc[mt >> 1][(mt & 1) * 2 + 1];
                    p[mt][0] = __uint_as_float(ua << 16) - p[mt][0]; p[mt][1] = __uint_as_float(ua & 0xffff0000u) - p[mt][1];
                    p[mt][2] = __uint_as_float(ub << 16) - p[mt][2]; p[mt][3] = __uint_as_float(ub & 0xffff0000u) - p[mt][3];
                }
                { const bf16_t* up = Un - lane * 8 + 24576 + (sl * 64 + lane) * 16; uc[0] = *(const u32x4*)up; uc[1] = *(const u32x4*)(up + 8); }
                bf16x8 vb[2];
                vb[0] = pk8(p[0], p[1]); vb[1] = pk8(p[2], p[3]);
                vbx[(s & 1) * 64 + lane] = __builtin_bit_cast(u32x4, vb[0]); vbx[(s & 1) * 64 + 128 + lane] = __builtin_bit_cast(u32x4, vb[1]);
                asm volatile("s_waitcnt lgkmcnt(0)" ::: "memory");
                if (lane == 0) *vflag = s + 1;
#pragma unroll
                for (int t = 0; t < 8; ++t) S[t] = S[t] * egl;
#pragma unroll
                for (int kc = 0; kc < 2; ++kc)
#pragma unroll
                    for (int t = 0; t < 8; ++t) {
                        S[t] = __builtin_amdgcn_mfma_f32_16x16x32_bf16(fk[t * 2 + kc], vb[kc], S[t], 0, 0, 0);
                        fk[t * 2 + kc] = ldfrag(Un + 16384 + (t * 2 + kc) * 512);
                    }
#pragma unroll
                for (int ks = 0; ks < 4; ++ks) sbx[((s + 1) & 1) * 256 + ks * 64 + lane] = __builtin_bit_cast(u32x4, pk8(S[2 * ks], S[2 * ks + 1]));
                lds_barrier();
            }
        } else if (wave == 1) {
            bf16x8 fqd[16], fat[8];
#pragma unroll
            for (int i = 0; i < 16; ++i) fqd[i] = ldfrag(U0 + 8192 + i * 512);
#pragma unroll
            for (int i = 0; i < 8; ++i) fat[i] = ldfrag(A0 + i * 512);
#pragma unroll
            for (int i = 0; i < 16; ++i) asm volatile("" :: "v"(__builtin_bit_cast(u32x4, fqd[i])));
#pragma unroll
            for (int i = 0; i < 8; ++i) asm volatile("" :: "v"(__builtin_bit_cast(u32x4, fat[i])));
            f32x4 op[4];
#pragma unroll
            for (int mt = 0; mt < 4; ++mt) op[mt] = (f32x4){0.f, 0.f, 0.f, 0.f};
            lds_barrier();
#pragma unroll 1
            for (int s = 0; s < DN_STEPS; ++s) {
                const int sn = pm == 1 ? 0 : s + 1 < DN_STEPS ? s + 1 : s;
                const bf16_t* Un = U0 + (size_t)sn * 32768; const bf16_t* An = A0 + (size_t)sn * 4096;
                bf16x8 sb[4];
#pragma unroll
                for (int ks = 0; ks < 4; ++ks) sb[ks] = __builtin_bit_cast(bf16x8, sbx[(s & 1) * 256 + ks * 64 + lane]);
                {
                    const int sp = s > 0 ? s - 1 : 0; const int rbase = dn_rbase(b, dir, sp);
#pragma unroll
                    for (int mt = 0; mt < 4; ++mt)
#pragma unroll
                        for (int jj = 0; jj < 4; ++jj) {
                            const int row = rbase + rstep * (16 * mt + 4 * fq + jj);
                            O[((size_t)(pm ? 0 : dir) * T + row) * 1024 + h * 128 + sl * 16 + fr] = f2bf(op[mt][jj]);
                        }
                }
                f32x4 o[4];
#pragma unroll
                for (int mt = 0; mt < 4; ++mt) o[mt] = (f32x4){0.f, 0.f, 0.f, 0.f};
#pragma unroll
                for (int ks = 0; ks < 4; ++ks)
#pragma unroll
                    for (int mt = 0; mt < 4; ++mt) {
                        o[mt] = __builtin_amdgcn_mfma_f32_16x16x32_bf16(fqd[mt * 4 + ks], sb[ks], o[mt], 0, 0, 0);
                        fqd[mt * 4 + ks] = ldfrag(Un + 8192 + (mt * 4 + ks) * 512);
                    }
                while (*vflag < s + 1) __builtin_amdgcn_s_sleep(1);
                asm volatile("" ::: "memory");
                bf16x8 vb[2];
                vb[0] = __builtin_bit_cast(bf16x8, vbx[(s & 1) * 64 + lane]); vb[1] = __builtin_bit_cast(bf16x8, vbx[(s & 1) * 64 + 128 + lane]);
#pragma unroll
                for (int kc = 0; kc < 2; ++kc)
#pragma unroll
                    for (int mt = 0; mt < 4; ++mt) {
                        o[mt] = __builtin_amdgcn_mfma_f32_16x16x32_bf16(fat[mt * 2 + kc], vb[kc], o[mt], 0, 0, 0);
                        fat[mt * 2 + kc] = ldfrag(An + (mt * 2 + kc) * 512);
                    }
#pragma unroll
                for (int mt = 0; mt < 4; ++mt) op[mt] = o[mt];
                lds_barrier();
            }
            {
                const int rbase = dn_rbase(b, dir, DN_STEPS - 1);
#pragma unroll
                for (int mt = 0; mt < 4; ++mt)
#pragma unroll
                    for (int jj = 0; jj < 4; ++jj) {
                        const int row = rbase + rstep * (16 * mt + 4 * fq + jj);
                        O[((size_t)(pm ? 0 : dir) * T + row) * 1024 + h * 128 + sl * 16 + fr] = f2bf(op[mt][jj]);
                    }
            }
        } else if (wave == 2) {
            const unsigned char* P0 = (const unsigned char*)(CH + (size_t)(chain * DN_STEPS) * 32768 + sl * 4096) + lane * 64;
            const unsigned char* Q0 = (const unsigned char*)(ATT + (size_t)(chain * DN_STEPS) * 4096 + sl * 512) + (lane & 15) * 64;
            unsigned d0 = 0u, d1 = 0u, d2 = 0u;
            lds_barrier();
#pragma unroll 1
            for (int s = 0; s < DN_STEPS; ++s) {
                const int sp = pm == 1 ? 0 : s + SC_PFD < DN_STEPS ? s + SC_PFD : DN_STEPS - 1;
                const unsigned char* pa = P0 + (size_t)sp * 65536; const unsigned char* pb = pa + 4096; const unsigned char* qa = Q0 + (size_t)sp * 8192;
                asm volatile("global_load_dword %0, %3, off\n\tglobal_load_dword %1, %4, off\n\tglobal_load_dword %2, %5, off"
                             : "+v"(d0), "+v"(d1), "+v"(d2) : "v"(pa), "v"(pb), "v"(qa) : "memory");
                lds_barrier();
            }
            asm volatile("s_waitcnt vmcnt(0)" : "+v"(d0), "+v"(d1), "+v"(d2) :: "memory");
        } else {
            lds_barrier();
#pragma unroll 1
            for (int s = 0; s < DN_STEPS; ++s) lds_barrier();
        }
    }
}
PF void dn_finish(const KC& k, int j) {
    const int tid = TID(), lane = tid & 63, wave = tid >> 6;
    const bf16_t* O = (const bf16_t*)(k.ws + AR_PB);
    const bf16_t* Z = (const bf16_t*)k.out;
    bf16_t* U = (bf16_t*)(k.ws + AR_UBUF);
    const float* on = k.dn_out_norm + j * 128;
    const int c0 = lane * 16;
    float onv[16];
#pragma unroll
    for (int e = 0; e < 16; ++e) onv[e] = on[(c0 + e) & 127];
    for (int r = blockIdx.x * 8 + wave; r < T; r += gridDim.x * 8) {
        u32x4 vf[2], vb[2], vz[2];
#pragma unroll
        for (int hh = 0; hh < 2; ++hh) {
            vf[hh] = *(const u32x4*)(O + (size_t)r * 1024 + c0 + hh * 8); vb[hh] = *(const u32x4*)(O + ((size_t)T + r) * 1024 + c0 + hh * 8);
            vz[hh] = *(const u32x4*)(Z + (size_t)r * 1024 + c0 + hh * 8);
        }
        asm volatile("" ::: "memory");
        float o[16], z[16];
#pragma unroll
        for (int hh = 0; hh < 2; ++hh) { float a[8], b2[8], zz[8]; unpack8(vf[hh], a); unpack8(vb[hh], b2); unpack8(vz[hh], zz);
#pragma unroll
            for (int i = 0; i < 8; ++i) { o[hh * 8 + i] = a[i] + b2[i]; z[hh * 8 + i] = zz[i]; } }
        float ss = 0.f;
#pragma unroll
        for (int e = 0; e < 16; ++e) ss += o[e] * o[e];
        ss += shx(ss, 1, lane); ss += shx(ss, 2, lane); ss += shx(ss, 4, lane);
        const float rs = rsqrtf(ss * (1.0f / 128.0f) + EPS);
#pragma unroll
        for (int hh = 0; hh < 2; ++hh) { u32x4 ov;
#pragma unroll
            for (int w = 0; w < 4; ++w) { const int e0 = hh * 8 + 2 * w; ov[w] = pk2(o[e0] * rs * onv[e0] * siluf(z[e0]), o[e0 + 1] * rs * onv[e0 + 1] * siluf(z[e0 + 1])); }
            *(u32x4*)(U + (size_t)r * 1024 + c0 + hh * 8) = ov; }
    }
}

DI float conv3g(const bf16_t* p, int j, float w0, float w1, float w2) {
    const int gc = j & 63;
    const float l = gc != 0 ? bf2f(p[j - 1]) : 0.f, c = bf2f(p[j]), r = gc != 63 ? bf2f(p[j + 1]) : 0.f;
    return w0 * l + w1 * c + w2 * r;
}
DI float hy_conv_lane(float c, float w0, float w1, float w2, int lane) {
    const float l = shi(c, (lane + 63) & 63), r = shi(c, (lane + 1) & 63);
    return w0 * (lane > 0 ? l : 0.f) + w1 * c + w2 * (lane < 63 ? r : 0.f);
}
PF void hy_lat(const KC& k, int jl, LAS float* ldsf) {
    const int tid = TID();
    LAS cf* X = (LAS cf*)ldsf;
    LAS cf* tw = X + 17408;
    LAS cf* tA = tw + 1024; LAS cf* tB = tA + 128;
    const bf16_t* FT = (const bf16_t*)(k.ws + AR_FT);
    const bf16_t* PT = (const bf16_t*)(k.ws + AR_PB);
    bf16_t* ZT = (bf16_t*)(k.ws + AR_ZT);
    unsigned* scr = (unsigned*)(k.ws + AR_FFTS) + (size_t)blockIdx.x * 4 * 16384;
    unsigned* sKe = scr; unsigned* sKo = scr + 16384; unsigned* zp = scr + 2 * 16384; unsigned* ye = scr + 3 * 16384;
#define CPK(v) pk2((v).x, (v).y)
#define CUP(u_) ((cf){__uint_as_float((u_) << 16), __uint_as_float((u_) & 0xffff0000u)})
    const float* cw = k.hy_conv + (size_t)jl * 3 * 3072;
    for (int m = 0; m < 2; ++m) { const int p = tid + 512 * m; float sn, cs; sincospif(-(float)p / 8192.0f, &sn, &cs); cf w; w.x = cs; w.y = sn; tw[p] = w; }
    if (tid < 256) { const int a = tid & 127; float sn, cs; sincospif(-(float)(tid < 128 ? 128 * a : a) / 16384.0f, &sn, &cs); cf w; w.x = cs; w.y = sn; (tid < 128 ? tA : tB)[a] = w; }
    __syncthreads();
    const int lane = tid & 63;
#define HY_SPLIT() asm volatile("" ::: "memory")
#define HY_CONV(c, w0, w1, w2) hy_conv_lane((c), (w0), (w1), (w2), lane)
    for (int ch = blockIdx.x; ch < 1024; ch += gridDim.x) {
        {
            const bf16_t* pv = PT + (size_t)ch * T + TC;
            const float w0 = cw[ch], w1 = cw[3072 + ch], w2 = cw[6144 + ch];
            for (int m0 = 0; m0 < 32; m0 += 8) {
                bf16_t a0[8], a1[8];
#pragma unroll
                for (int q = 0; q < 8; ++q) { const int j = tid + 512 * (m0 + q); a0[q] = pv[j]; a1[q] = pv[SEQ + j]; }
                HY_SPLIT();
#pragma unroll
                for (int q = 0; q < 8; ++q) { const int j = tid + 512 * (m0 + q); const float c0 = bf2f(a0[q]), c1 = bf2f(a1[q]); cf z; z.x = HY_CONV(c0, w0, w1, w2); z.y = HY_CONV(c1, w0, w1, w2); zp[j] = CPK(z); }
            }
        }
        for (int n = 0; n < 2; ++n) {
            __syncthreads();
            const bf16_t* ftf = FT + (size_t)(n * 2048 + ch) * 16384; const bf16_t* ftb = FT + (size_t)(n * 2048 + 1024 + ch) * 16384;
            for (int m0 = 0; m0 < 32; m0 += 8) {
                bf16_t hfv[8], hbv[8];
#pragma unroll
                for (int q = 0; q < 8; ++q) { const int j = tid + 512 * (m0 + q); hfv[q] = ftf[j]; hbv[q] = ftb[j > 0 ? SEQ - j : 0]; }
                HY_SPLIT();
#pragma unroll
                for (int q = 0; q < 8; ++q) {
                    const int j = tid + 512 * (m0 + q);
                    const float hf = bf2f(hfv[q]), hb = j > 0 ? bf2f(hbv[q]) : 0.f;
                    const cf w = cmul(tA[j >> 7], tB[j & 127]);
                    cf a; a.x = hf + hb; a.y = 0.f; X[PIDX(j)] = a;
                    const float kd = hf - hb; cf o; o.x = kd * w.x; o.y = kd * w.y; sKo[j] = CPK(o);
                }
            }
            __syncthreads();
            fft16k_fwd(X, tw);
            unsigned Ker[32];
#pragma unroll
            for (int m = 0; m < 32; ++m) { const cf t_ = X[PIDX(tid + 512 * m)]; Ker[m] = CPK(t_); }
            __syncthreads();
            for (int m0 = 0; m0 < 32; m0 += 8) { unsigned t[8];
#pragma unroll
                for (int q = 0; q < 8; ++q) t[q] = sKo[tid + 512 * (m0 + q)];
                HY_SPLIT();
#pragma unroll
                for (int q = 0; q < 8; ++q) X[PIDX(tid + 512 * (m0 + q))] = CUP(t[q]); }
            __syncthreads();
            fft16k_fwd(X, tw);
            _Pragma("unroll 8") for (int m = 0; m < 32; ++m) { const int j = tid + 512 * m; const cf t_ = X[PIDX(j)]; sKo[j] = CPK(t_); }
            __syncthreads();
            for (int m0 = 0; m0 < 32; m0 += 8) { unsigned t[8];
#pragma unroll
                for (int q = 0; q < 8; ++q) t[q] = zp[tid + 512 * (m0 + q)];
                HY_SPLIT();
#pragma unroll
                for (int q = 0; q < 8; ++q) X[PIDX(tid + 512 * (m0 + q))] = CUP(t[q]); }
            __syncthreads();
            fft16k_fwd(X, tw);
#pragma unroll
            for (int m = 0; m < 32; ++m) { const int j = tid + 512 * m; X[PIDX(j)] = cmul(X[PIDX(j)], CUP(Ker[m])); }
            __syncthreads();
            fft16k_inv(X, tw);
            _Pragma("unroll 8") for (int m = 0; m < 32; ++m) { const int j = tid + 512 * m; const cf t_ = X[PIDX(j)]; ye[j] = CPK(t_); }
            __syncthreads();
            for (int m0 = 0; m0 < 32; m0 += 8) { unsigned t[8];
#pragma unroll
                for (int q = 0; q < 8; ++q) t[q] = zp[tid + 512 * (m0 + q)];
                HY_SPLIT();
#pragma unroll
                for (int q = 0; q < 8; ++q) { const int j = tid + 512 * (m0 + q); const cf w = cmul(tA[j >> 7], tB[j & 127]); X[PIDX(j)] = cmul(CUP(t[q]), w); } }
            __syncthreads();
            fft16k_fwd(X, tw);
            for (int m0 = 0; m0 < 32; m0 += 8) { unsigned t[8];
#pragma unroll
                for (int q = 0; q < 8; ++q) t[q] = sKo[tid + 512 * (m0 + q)];
                HY_SPLIT();
#pragma unroll
                for (int q = 0; q < 8; ++q) { const int j = tid + 512 * (m0 + q); X[PIDX(j)] = cmul(X[PIDX(j)], CUP(t[q])); } }
            __syncthreads();
            fft16k_inv(X, tw);
            {
                const bf16_t* pg = PT + (size_t)((n + 1) * 1024 + ch) * T + TC;
                const int gcol = (n + 1) * 1024 + ch;
                const float w0 = cw[gcol], w1 = cw[3072 + gcol], w2 = cw[6144 + gcol];
                const float bias = k.hy_bias[(size_t)jl * 2 * 1024 + n * 1024 + ch];
                for (int m0 = 0; m0 < 32; m0 += 8) {
                    unsigned te_[8], tz_[8]; bf16_t g0[8], g1[8];
#pragma unroll
                    for (int q = 0; q < 8; ++q) { const int j = tid + 512 * (m0 + q); te_[q] = ye[j]; tz_[q] = zp[j]; g0[q] = pg[j]; g1[q] = pg[SEQ + j]; }
                    HY_SPLIT();
#pragma unroll
                    for (int q = 0; q < 8; ++q) {
                        const int j = tid + 512 * (m0 + q);
                        cf w = cmul(tA[j >> 7], tB[j & 127]); w.y = -w.y;
                        const cf yo = cmul(X[PIDX(j)], w);
                        const cf te = CUP(te_[q]), tz = CUP(tz_[q]);
                        const float y0 = (0.5f / 16384.0f) * (te.x + yo.x), y1 = (0.5f / 16384.0f) * (te.y + yo.y);
                        const float c0 = bf2f(g0[q]), c1 = bf2f(g1[q]);
                        cf zn; zn.x = HY_CONV(c0, w0, w1, w2) * (y0 + bias * tz.x); zn.y = HY_CONV(c1, w0, w1, w2) * (y1 + bias * tz.y);
                        zp[j] = CPK(zn);
                    }
                }
            }
        }
        for (int m0 = 0; m0 < 32; m0 += 8) { unsigned t[8];
#pragma unroll
            for (int q = 0; q < 8; ++q) t[q] = zp[tid + 512 * (m0 + q)];
            HY_SPLIT();
#pragma unroll
            for (int q = 0; q < 8; ++q) { const int j = tid + 512 * (m0 + q); ZT[(size_t)ch * T + TC + j] = (bf16_t)(t[q] & 0xffffu); ZT[(size_t)ch * T + TC + SEQ + j] = (bf16_t)(t[q] >> 16); } }
        __syncthreads();
    }
#undef CPK
#undef CUP
#undef HY_SPLIT
#undef HY_CONV
}
PF void hy_ctx(const KC& k, int jl, LAS float* lds) {
    const int tid = TID(), t = tid & 255, hsel = tid >> 8;
    LAS float* z = lds + hsel * 768; LAS float* hf = z + 256; LAS float* hb = hf + 256;
    const bf16_t* PT = (const bf16_t*)(k.ws + AR_PB);
    bf16_t* U = (bf16_t*)(k.ws + AR_UBUF);
    const float* filtc = (const float*)(k.ws + WS_FILTC);
    const float* cw = k.hy_conv + (size_t)jl * 3 * 3072;
    for (int u = blockIdx.x; u < 1024; u += gridDim.x) {
        const int pr = u * 2 + hsel, b = pr >> 10, ch = pr & 1023;
        float zc;
        {
            const bf16_t* pv = PT + (size_t)ch * T + b * 256;
            const float l = t != 0 ? bf2f(pv[t - 1]) : 0.f, c = bf2f(pv[t]), r = t != 255 ? bf2f(pv[t + 1]) : 0.f;
            zc = cw[ch] * l + cw[3072 + ch] * c + cw[6144 + ch] * r;
        }
        for (int n = 0; n < 2; ++n) {
            __syncthreads();
            z[t] = zc; hf[t] = filtc[(size_t)t * 4096 + n * 2048 + ch]; hb[t] = filtc[(size_t)t * 4096 + n * 2048 + 1024 + ch];
            __syncthreads();
            float y = 0.f;
            for (int s = 0; s <= t; ++s) y += hf[t - s] * z[s];
            for (int s = t + 1; s < 256; ++s) y += hb[s - t] * z[s];
            const int gcol = (n + 1) * 1024 + ch;
            const bf16_t* pg = PT + (size_t)gcol * T + b * 256;
            const float l = t != 0 ? bf2f(pg[t - 1]) : 0.f, c = bf2f(pg[t]), r = t != 255 ? bf2f(pg[t + 1]) : 0.f;
            const float gate = cw[gcol] * l + cw[3072 + gcol] * c + cw[6144 + gcol] * r;
            zc = gate * (y + k.hy_bias[(size_t)jl * 2048 + n * 1024 + ch] * zc);
        }
        U[(size_t)(b * 256 + t) * 1024 + ch] = f2bf(zc);
        __syncthreads();
    }
}
PF void hy_transpose(const KC& k, LAS bf16_t* lds) {
    const int tid = TID();
    const bf16_t* ZT = (const bf16_t*)(k.ws + AR_ZT);
    bf16_t* U = (bf16_t*)(k.ws + AR_UBUF);
    for (int u = blockIdx.x; u < 16 * (TL / 64); u += gridDim.x) {
        const int c0 = (u & 15) * 64, r0 = TC + (u >> 4) * 64;
        { const int c = tid >> 3, sg = (tid & 7) * 8;
          const u32x4 v = *(const u32x4*)(ZT + (size_t)(c0 + c) * T + r0 + sg);
#pragma unroll
          for (int w = 0; w < 4; ++w) { lds[(sg + 2 * w) * 66 + c] = (bf16_t)(v[w] & 0xffff); lds[(sg + 2 * w + 1) * 66 + c] = (bf16_t)(v[w] >> 16); } }
        __syncthreads();
        { const int r = tid >> 3, sg = (tid & 7) * 8; u32x4 o;
#pragma unroll
          for (int w = 0; w < 4; ++w) o[w] = (unsigned)lds[r * 66 + sg + 2 * w] | ((unsigned)lds[r * 66 + sg + 2 * w + 1] << 16);
          *(u32x4*)(U + (size_t)(r0 + r) * 1024 + c0 + sg) = o; }
        __syncthreads();
    }
}

__global__ void __launch_bounds__(NTHR, 2) fwd_kernel(Params prm) {
    extern __shared__ __attribute__((aligned(16))) unsigned char lds_raw[];
    LAS unsigned char* lds = (LAS unsigned char*)lds_raw;
    LAS float* ldsf = (LAS float*)lds;
    LAS bf16_t* ldsh = (LAS bf16_t*)lds;
    LAS int* tb = (LAS int*)(lds + 150 * 1024);
    volatile LAS unsigned* xbw = (volatile LAS unsigned*)(lds + 151 * 1024 + 512);
    KC k;
    k.x = (const float*)(GAS const float*)prm.in[0]; k.c = (const float*)(GAS const float*)prm.in[1]; k.ctx = (const float*)(GAS const float*)prm.in[2]; k.c_ctx = (const float*)(GAS const float*)prm.in[3]; k.ada_w = (const float*)(GAS const float*)prm.in[4]; k.ada_b = (const float*)(GAS const float*)prm.in[5];
    k.norm_mix = (const float*)(GAS const float*)prm.in[6]; k.norm_ffn = (const float*)(GAS const float*)prm.in[7]; k.norm_final = (const float*)(GAS const float*)prm.in[8];
    k.dn_w_in = (const float*)(GAS const float*)prm.in[9]; k.dn_conv = (const float*)(GAS const float*)prm.in[10]; k.dn_a_log = (const float*)(GAS const float*)prm.in[11]; k.dn_dt_bias = (const float*)(GAS const float*)prm.in[12]; k.dn_out_norm = (const float*)(GAS const float*)prm.in[13]; k.dn_w_out = (const float*)(GAS const float*)prm.in[14];
    k.hy_w_in = (const float*)(GAS const float*)prm.in[15]; k.hy_conv = (const float*)(GAS const float*)prm.in[16]; k.hy_f_w1 = (const float*)(GAS const float*)prm.in[17]; k.hy_f_b1 = (const float*)(GAS const float*)prm.in[18]; k.hy_f_freq = (const float*)(GAS const float*)prm.in[19]; k.hy_f_w2 = (const float*)(GAS const float*)prm.in[20];
    k.hy_f_b2 = (const float*)(GAS const float*)prm.in[21]; k.hy_f_w3 = (const float*)(GAS const float*)prm.in[22]; k.hy_bias = (const float*)(GAS const float*)prm.in[23]; k.hy_w_out = (const float*)(GAS const float*)prm.in[24];
    k.sc_w_in = (const float*)(GAS const float*)prm.in[25]; k.sc_conv = (const float*)(GAS const float*)prm.in[26]; k.sc_w_out = (const float*)(GAS const float*)prm.in[27]; k.w_router = (const float*)(GAS const float*)prm.in[28]; k.router_bias = (const float*)(GAS const float*)prm.in[29];
    k.moe_w_gate = (const float*)(GAS const float*)prm.in[30]; k.moe_w_up = (const float*)(GAS const float*)prm.in[31]; k.moe_w_down = (const float*)(GAS const float*)prm.in[32];
    k.out = (float*)(GAS float*)prm.out; k.ws = (unsigned char*)(GAS unsigned char*)prm.ws;
    const int lo = prm.ph_lo, hi = prm.ph_hi;
    XcdBarrier bar; bar.bar = (unsigned*)(k.ws + WS_CTL); bar.x = 0; bar.st = xbw;
    if (hi - lo > 1) {
        if (threadIdx.x == 0) { xbw[0] = 0u; xbw[1] = 0u; }
        __syncthreads();
        bar = xcd_barrier_post((unsigned*)(k.ws + WS_CTL), xbw);
    }
    int ph = 0;
#define PROBE_OK(id) ((id) != 1 || i == 0)
    int i = 0;
#define PH_BEGIN(id) if (ph >= lo && ph < hi) { const int nrep_ = (((id) == PROBE_REP) && PROBE_OK(id)) ? 2 : 1; for (int rep_ = 0; rep_ < nrep_; ++rep_) { { GAS unsigned char* w_ = (GAS unsigned char*)k.ws; asm volatile("" : "+s"(w_)); k.ws = (unsigned char*)w_; }
#define PH_END   if (ph + 1 < hi) xcd_barrier(bar); } } ++ph;

    float* xs = (float*)(k.ws + WS_XS);
    const float* mod = (const float*)(k.ws + WS_MOD);

    PH_BEGIN(0)
        job_mod(k, ldsf);
        job_cvt_small(k, ldsf);
        job_hdn(k, ldsf);
        job_w3s(k);
    PH_END

    for (i = 0; i < DEPTH; ++i) {
        const int kind = i % 3, j = i / 3;
        const bool last = (i == DEPTH - 1);
        PH_BEGIN(1)
            if (kind == 0) norm_mfma<2>(k, i, i == 0, i > 0, k.norm_mix + i * 1024, 0, k.dn_w_in + (size_t)j * 1024 * DN_IN + 4096, DN_IN,
                                        k.dn_a_log + j * 16, k.dn_dt_bias + j * 16, last, lds);
            else norm_vec<0>(k, i, k.norm_mix + i * 1024, 0);
            if (kind == 1) job_filtc(k, j);
        PH_END
        PH_BEGIN(2)
            if (kind == 0) { EpiBf16 e{(bf16_t*)(k.ws + AR_PB), 3072, 3072, (bf16_t*)k.out, 1024}; gemm_dense(lds, (const bf16_t*)(k.ws + AR_HBUF), T, (const bf16_t*)(k.ws + WS_DNWIN) + (size_t)j * 4096 * 1024, 4096, 1024, e); }
            else if (kind == 1) { EpiBf16T e{(bf16_t*)(k.ws + AR_PB), T}; gemm_dense(lds, (const bf16_t*)(k.ws + AR_HBUF), T, (const bf16_t*)(k.ws + WS_HYWIN), 3072, 1024, e);
                                  EpiTaps et{(bf16_t*)(k.ws + AR_FT)}; gemm_dense(lds, (const bf16_t*)(k.ws + WS_W3S), 4096, (const bf16_t*)(k.ws + WS_HS), 16384, 256, et); }
            else { EpiBf16 e{(bf16_t*)(k.ws + AR_PB), 3072, 1 << 30, nullptr, 0}; gemm_dense(lds, (const bf16_t*)(k.ws + AR_HBUF), T, (const bf16_t*)(k.ws + WS_SCWIN), 3072, 1024, e); }
        PH_END
        if (kind == 0) {
            PH_BEGIN(3) dn_chunk(k, j, lds); PH_END
            PH_BEGIN(4) dn_scan(k, lds, rep_ ? PROBE_MODE : 0); PH_END
            PH_BEGIN(5) dn_finish(k, j); PH_END
        } else if (kind == 1) {
            PH_BEGIN(6) hy_lat(k, j, ldsf); hy_ctx(k, j, ldsf); PH_END
            PH_BEGIN(7) hy_transpose(k, ldsh); PH_END
        } else {
            PH_BEGIN(8) sc_mix(k, j); PH_END
        }
        PH_BEGIN(9)
            const bf16_t* Wt = kind == 0 ? (const bf16_t*)(k.ws + WS_DNWOUT) + (size_t)j * 1024 * 1024 : (kind == 1 ? (const bf16_t*)(k.ws + WS_HYWOUT) : (const bf16_t*)(k.ws + WS_SCWOUT));
            EpiResid e{xs, mod, i, 2};
            gemm_dense(lds, (const bf16_t*)(k.ws + AR_UBUF), T, Wt, 1024, 1024, e);
            if (gridDim.x == 256) job_cvt_moe(k, i, ldsf, (int)blockIdx.x - 8, 248); else job_cvt_moe(k, i, ldsf, (int)blockIdx.x, (int)gridDim.x);
        PH_END
        PH_BEGIN(10)
            norm_mfma<1>(k, i, false, false, k.norm_ffn + i * 1024, 3, k.w_router, 32, k.router_bias, nullptr, last, lds, rep_ == nrep_ - 1);
        PH_END
        PH_BEGIN(11)
            moe_scatter(k, i, tb);
        PH_END
        PH_BEGIN(12) moe_gemm<0>(k, i, lds, tb); PH_END
        PH_BEGIN(13) moe_gemm<1>(k, i, lds, tb); PH_END
    }
    PH_BEGIN(14)
        norm_vec<3>(k, DEPTH, k.norm_final, 0);
    PH_END
#undef PH_BEGIN
#undef PH_END
}
constexpr int N_PHASES = 1 + (10 + 9 + 8 + 10) + 1;

extern "C" void kernel_launch(void* const* d_in, const int* in_sizes, int n_in, void* d_out, int out_size, void* d_ws, size_t ws_size, hipStream_t stream) {
    static int grid = 0;
    if (grid == 0) {
        if (n_in != 33 || out_size != TL * D || ws_size < WS_END) { fprintf(stderr, "kernel_launch: unexpected shapes: n_in %d out %d ws %zu (need %zu)\n", n_in, out_size, ws_size, (size_t)WS_END); grid = -1; return; }
        int dev = 0, cus = 0, per_cu = 0;
        if (hipGetDevice(&dev) != hipSuccess || hipDeviceGetAttribute(&cus, hipDeviceAttributeMultiprocessorCount, dev) != hipSuccess) { grid = -1; return; }
        if (hipFuncSetAttribute((const void*)fwd_kernel, hipFuncAttributeMaxDynamicSharedMemorySize, LDS_BYTES) != hipSuccess) { fprintf(stderr, "kernel_launch: hipFuncSetAttribute failed\n"); grid = -1; return; }
        if (hipOccupancyMaxActiveBlocksPerMultiprocessor(&per_cu, (const void*)fwd_kernel, NTHR, LDS_BYTES) != hipSuccess || per_cu < 1) fprintf(stderr, "kernel_launch: occupancy query reports %d\n", per_cu);
        (void)hipGetLastError();
        grid = cus;
    }
    if (grid < 0) return;
    (void)hipMemsetAsync((char*)d_ws + WS_CTL, 0, CTL_BYTES, stream);
    Params p{};
    for (int i = 0; i < 33; ++i) p.in[i] = (const float*)d_in[i];
    p.out = (float*)d_out; p.ws = (unsigned char*)d_ws;
#if MK_MULTI
    for (int ph = 0; ph < N_PHASES; ++ph) { p.ph_lo = ph; p.ph_hi = ph + 1; hipLaunchKernelGGL(fwd_kernel, dim3(grid), dim3(NTHR), LDS_BYTES, stream, p); }
#else
    p.ph_lo = 0; p.ph_hi = N_PHASES;
    hipLaunchKernelGGL(fwd_kernel, dim3(grid), dim3(NTHR), LDS_BYTES, stream, p);
#endif
}
```

```cpp
#include <hip/hip_runtime.h>
#include <stdint.h>
#include <stdio.h>
#include <math.h>

#ifndef MK_MULTI
#define MK_MULTI 0
#endif

#ifndef PROBE_SUB
#define PROBE_SUB (0)
#endif
#ifndef PROBE_MODE
#define PROBE_MODE (1)
#endif
#ifndef PROBE_REP
#define PROBE_REP (-1)
#endif
#define LAS __attribute__((address_space(3)))
#define GAS __attribute__((address_space(1)))
#define HD __host__ __device__ __forceinline__
#define DI __device__ __forceinline__
#ifdef NOINL
#define PF __device__ __noinline__
#else
#define PF __device__ __forceinline__
#endif
typedef unsigned short bf16_t;
typedef short bf16x8 __attribute__((ext_vector_type(8)));
typedef float f32x4 __attribute__((ext_vector_type(4)));
typedef unsigned u32x4 __attribute__((ext_vector_type(4)));
typedef unsigned u32x2 __attribute__((ext_vector_type(2)));

constexpr int D = 1024, NB = 2, SEQ = 16384, CTXL = 256, DEPTH = 4;
constexpr int TC = NB * CTXL, TL = NB * SEQ, T = TC + TL, NA = 2 * T;
constexpr int NTHR = 512;
constexpr int DN_IN = 4128;
constexpr float EPS = 1e-6f;
constexpr int LDS_BYTES = 152 * 1024;

constexpr size_t AL(size_t x) { return (x + 255) & ~(size_t)255; }
constexpr size_t WS_CTL = 0;
constexpr size_t CTL_BYTES = 65536;
constexpr size_t CTL_CNT = 16384;
constexpr size_t WS_MOD = WS_CTL + CTL_BYTES;
constexpr size_t WS_HS = AL(WS_MOD + 4 * 3 * 6144 * 4);
constexpr size_t WS_W3S = AL(WS_HS + 16384 * 256 * 2);
constexpr size_t WS_HDNC = AL(WS_W3S + 4096 * 256 * 2);
constexpr size_t WS_FILTC = AL(WS_HDNC + 256 * 64 * 4);
constexpr size_t WS_DNWIN = AL(WS_FILTC + 256 * 4096 * 4);
constexpr size_t WS_DNWOUT = AL(WS_DNWIN + (size_t)2 * 4096 * 1024 * 2);
constexpr size_t WS_HYWIN = AL(WS_DNWOUT + (size_t)2 * 1024 * 1024 * 2);
constexpr size_t WS_HYWOUT = AL(WS_HYWIN + (size_t)3072 * 1024 * 2);
constexpr size_t WS_SCWIN = AL(WS_HYWOUT + (size_t)1024 * 1024 * 2);
constexpr size_t WS_SCWOUT = AL(WS_SCWIN + (size_t)3072 * 1024 * 2);
constexpr size_t WS_XS = AL(WS_SCWOUT + (size_t)1024 * 1024 * 2);
constexpr size_t WS_TOKE = AL(WS_XS + (size_t)T * 1024 * 4);
constexpr size_t WS_TOKW = AL(WS_TOKE + (size_t)T * 2 * 4);
constexpr size_t WS_TOKP = AL(WS_TOKW + (size_t)T * 2 * 4);
constexpr size_t WS_SLOT = AL(WS_TOKP + (size_t)T * 2 * 4);
constexpr size_t WS_GB = AL(WS_SLOT + (size_t)(NA + 256) * 4);
constexpr size_t WS_EGL = AL(WS_GB + (size_t)T * 32 * 4);
constexpr size_t WS_AR = AL(WS_EGL + (size_t)32 * 260 * 4);
constexpr size_t AR_HBUF = WS_AR;
constexpr size_t AR_UBUF = AR_HBUF + (size_t)T * 1024 * 2;
constexpr size_t AR_PB = AR_UBUF + (size_t)T * 1024 * 2;
constexpr size_t AR_Q = AR_PB + (size_t)T * 4096 * 2;
constexpr size_t AR_CHUNK = AR_PB + (size_t)T * 3072 * 2;
constexpr size_t AR_DN_END = AR_CHUNK + (size_t)32 * 260 * 65536;
constexpr size_t AR_ZT = AR_Q;
constexpr size_t AR_FFTS = AR_ZT + (size_t)1024 * T * 2;
constexpr size_t AR_FT = AR_FFTS + (size_t)256 * 4 * 16384 * 8;
constexpr size_t AR_HY_END = AR_FT + (size_t)4096 * 16384 * 4;
constexpr size_t AR_HID = AR_PB;
constexpr size_t AR_YS = AR_HID + (size_t)NA * 512 * 2;
constexpr size_t AR_WGU = AR_YS + (size_t)NA * 1024 * 2;
constexpr size_t AR_WD = AR_WGU + (size_t)32 * 1024 * 1024 * 2;
constexpr size_t AR_MOE_END = AR_WD + (size_t)32 * 1024 * 512 * 2;
constexpr size_t WS_END = AR_DN_END > AR_HY_END ? (AR_DN_END > AR_MOE_END ? AR_DN_END : AR_MOE_END) : (AR_HY_END > AR_MOE_END ? AR_HY_END : AR_MOE_END);

#define XB_TMO      128
#define XB_XCNT(j)  (256  + 64 * (j))
#define XB_XSUB(j)  (1280 + 64 * (j))
#define XB_XGEN(j)  (2304 + 64 * (j))
#define XB_TOP      3328
#define XB_TOPGEN   3392
#define XCD_BAR_WORDS 3456
#define XB_SPIN_CAP (1u << 25)
DI unsigned xb_ld(unsigned* p)              { return __hip_atomic_load(p, __ATOMIC_RELAXED, __HIP_MEMORY_SCOPE_AGENT); }
DI unsigned xb_add(unsigned* p, unsigned v) { return __hip_atomic_fetch_add(p, v, __ATOMIC_RELAXED, __HIP_MEMORY_SCOPE_AGENT); }
DI unsigned xb_xcc_id() { return (unsigned)__builtin_amdgcn_s_getreg((3 << 11) | 20) & 0xFu; }
#define XB_SPIN(cond, bar) do { unsigned _sp = 0; while (cond) { __builtin_amdgcn_s_sleep(1); \
    if ((++_sp & 255u) == 0u) { if (xb_ld(&(bar)[XB_TMO])) break; if (_sp > XB_SPIN_CAP) { atomicAdd(&(bar)[XB_TMO], 1u); break; } } } } while (0)
struct XcdBarrier { unsigned* bar; unsigned x; volatile LAS unsigned* st; };
DI XcdBarrier xcd_barrier_post(unsigned* bar, volatile LAS unsigned* st) {
    XcdBarrier b; b.bar = bar; b.x = xb_xcc_id(); b.st = st;
    if (threadIdx.x == 0) (void)xb_add(&bar[XB_XCNT(b.x)], 1u);
    return b;
}
DI void xcd_barrier_complete(unsigned* bar, unsigned x, unsigned& nloc, unsigned& nx) {
    const unsigned G = gridDim.x * gridDim.y * gridDim.z;
    unsigned sum, cnt, mine, sp = 0u;
    for (;;) {
        sum = 0u; cnt = 0u; mine = 0u;
#pragma unroll
        for (unsigned j = 0; j < 16; ++j) { const unsigned c = xb_ld(&bar[XB_XCNT(j)]); sum += c; cnt += (c > 0u) ? 1u : 0u; mine = (j == x) ? c : mine; }
        if (sum == G) break;
        __builtin_amdgcn_s_sleep(1);
        if ((++sp & 255u) == 0u) { if (xb_ld(&bar[XB_TMO])) break; if (sp > XB_SPIN_CAP) { atomicAdd(&bar[XB_TMO], 1u); break; } }
    }
    nloc = mine > 0u ? mine : 1u; nx = cnt > 0u ? cnt : 1u;
}
DI void xcd_barrier(const XcdBarrier& b) {
    asm volatile("s_waitcnt vmcnt(0)" ::: "memory");
    __syncthreads();
    if (threadIdx.x == 0) {
        unsigned* bar = b.bar;
        __builtin_amdgcn_s_waitcnt(0);
        unsigned nloc = b.st[0], nx = b.st[1];
        if (nloc == 0u) { xcd_barrier_complete(bar, b.x, nloc, nx); b.st[0] = nloc; b.st[1] = nx; }
        const unsigned old = xb_add(&bar[XB_XSUB(b.x)], 1u);
        const unsigned gen = old / nloc;
        if (old + 1u == (gen + 1u) * nloc) {
            __builtin_amdgcn_fence(__ATOMIC_RELEASE, "agent");
            asm volatile("s_waitcnt vmcnt(0)" ::: "memory");
            const unsigned og = xb_add(&bar[XB_TOP], 1u);
            const unsigned tg = og / nx;
            if (og + 1u == (tg + 1u) * nx) xb_add(&bar[XB_TOPGEN], 1u);
            else XB_SPIN(xb_ld(&bar[XB_TOPGEN]) == tg, bar);
            __builtin_amdgcn_fence(__ATOMIC_ACQUIRE, "agent");
            xb_add(&bar[XB_XGEN(b.x)], 1u);
            asm volatile("s_waitcnt vmcnt(0)" ::: "memory");
        } else {
            XB_SPIN(xb_ld(&bar[XB_XGEN(b.x)]) == gen, bar);
            __builtin_amdgcn_fence(__ATOMIC_ACQUIRE, "agent");
            asm volatile("s_waitcnt vmcnt(0)" ::: "memory");
        }
    }
    __syncthreads();
}

typedef float f32x2_t __attribute__((ext_vector_type(2)));
typedef __bf16 bf16x2_t __attribute__((ext_vector_type(2)));
DI unsigned cvt_pk_bf16(float lo, float hi) { f32x2_t v; v.x = lo; v.y = hi; const bf16x2_t b = __builtin_convertvector(v, bf16x2_t); return __builtin_bit_cast(unsigned, b); }
DI bf16_t f2bf(float f) { return (bf16_t)(cvt_pk_bf16(f, f) & 0xffffu); }
DI float bf2f(bf16_t b) { return __uint_as_float(((unsigned)b) << 16); }
DI unsigned pk2(float lo, float hi) { return cvt_pk_bf16(lo, hi); }
DI float siluf(float x) { return x * __builtin_amdgcn_rcpf(1.0f + __expf(-x)); }
DI float sigmf(float x) { return 1.0f / (1.0f + __expf(-x)); }
DI float shi(float v, int src) { return __int_as_float(__builtin_amdgcn_ds_bpermute(src << 2, __float_as_int(v))); }
DI int shii(int v, int src) { return __builtin_amdgcn_ds_bpermute(src << 2, v); }
DI float shx(float v, int m, int lane) { return shi(v, lane ^ m); }
DI float wsum(float v, int lane) {
#pragma unroll
    for (int m = 32; m >= 1; m >>= 1) v += shx(v, m, lane);
    return v;
}
DI void lds_barrier() { asm volatile("s_waitcnt lgkmcnt(0)\n\ts_barrier" ::: "memory"); }
DI int TID() { int t = threadIdx.x; asm volatile("" : "+v"(t)); return t; }
DI int modrow(int r) { return r < TC ? 0 : 1 + (r - TC) / SEQ; }

typedef float cf __attribute__((ext_vector_type(2)));
HD cf cmul(cf a, cf b) { cf r; r.x = a.x * b.x - a.y * b.y; r.y = a.x * b.y + a.y * b.x; return r; }
HD cf cadd(cf a, cf b) { cf r; r.x = a.x + b.x; r.y = a.y + b.y; return r; }
HD cf csub(cf a, cf b) { cf r; r.x = a.x - b.x; r.y = a.y - b.y; return r; }
template <int R> HD constexpr int brev(int i) { int r = 0; for (int b = 1, t = R >> 1; b < R; b <<= 1, t >>= 1) if (i & b) r |= t; return r; }
#define FFT_C32 {1.0f, 0.98078528040323044913f, 0.92387953251128675613f, 0.83146961230254523708f, 0.70710678118654752440f, 0.55557023301960222474f, 0.38268343236508977173f, 0.19509032201612826785f, 0.0f, -0.19509032201612826785f, -0.38268343236508977173f, -0.55557023301960222474f, -0.70710678118654752440f, -0.83146961230254523708f, -0.92387953251128675613f, -0.98078528040323044913f}
#define FFT_S32 {0.0f, 0.19509032201612826785f, 0.38268343236508977173f, 0.55557023301960222474f, 0.70710678118654752440f, 0.83146961230254523708f, 0.92387953251128675613f, 0.98078528040323044913f, 1.0f, 0.98078528040323044913f, 0.92387953251128675613f, 0.83146961230254523708f, 0.70710678118654752440f, 0.55557023301960222474f, 0.38268343236508977173f, 0.19509032201612826785f}
template <int R> HD constexpr int ilog2c() { int l = 0; for (int r = R; r > 1; r >>= 1) ++l; return l; }
template <int R> HD void dft_fwd(cf (&v)[R]) {
    constexpr float C[16] = FFT_C32; constexpr float S[16] = FFT_S32;
    constexpr int LG = ilog2c<R>();
#pragma unroll
    for (int st = 0; st < LG; ++st) {
#pragma unroll
        for (int i = 0; i < R / 2; ++i) {
            const int len = R >> st, half = len >> 1, blk = i / half, j = i % half, i0 = blk * len + j, i1 = i0 + half;
            const cf a = v[i0], c = v[i1];
            v[i0] = cadd(a, c);
            const cf d = csub(a, c);
            const int ti = j * (32 / len);
            cf w; w.x = C[ti]; w.y = -S[ti];
            cf r;
            if (ti == 0) r = d;
            else if (ti == 8) { r.x = d.y; r.y = -d.x; }
            else if (ti == 4) { r.x = (d.x + d.y) * 0.70710678118654752440f; r.y = (d.y - d.x) * 0.70710678118654752440f; }
            else if (ti == 12) { r.x = (d.y - d.x) * 0.70710678118654752440f; r.y = -(d.x + d.y) * 0.70710678118654752440f; }
            else r = cmul(d, w);
            v[i1] = r;
        }
    }
}
template <int R> HD void dft_inv(cf (&v)[R]) {
    constexpr float C[16] = FFT_C32; constexpr float S[16] = FFT_S32;
    constexpr int LG = ilog2c<R>();
#pragma unroll
    for (int st = LG - 1; st >= 0; --st) {
#pragma unroll
        for (int i = 0; i < R / 2; ++i) {
            const int len = R >> st, half = len >> 1, blk = i / half, j = i % half, i0 = blk * len + j, i1 = i0 + half;
            const int ti = j * (32 / len);
            cf w; w.x = C[ti]; w.y = S[ti];
            const cf a = v[i0];
            const cf b1 = v[i1];
            cf c;
            if (ti == 0) c = b1;
            else if (ti == 8) { c.x = -b1.y; c.y = b1.x; }
            else if (ti == 4) { c.x = (b1.x - b1.y) * 0.70710678118654752440f; c.y = (b1.x + b1.y) * 0.70710678118654752440f; }
            else if (ti == 12) { c.x = -(b1.x + b1.y) * 0.70710678118654752440f; c.y = (b1.x - b1.y) * 0.70710678118654752440f; }
            else c = cmul(b1, w);
            v[i0] = cadd(a, c);
            v[i1] = csub(a, c);
        }
    }
}
#define PIDX(a) ((a) + (((a) >> 6) << 2))
template <int R> DI void fft_pass_fwd(LAS cf* X, const LAS cf* tw, int n, int g) {
    const int s = n / R, q = g / s, p = g - q * s, base = q * n + p;
    cf v[R];
#pragma unroll
    for (int k = 0; k < R; ++k) v[k] = X[PIDX(base + k * s)];
    dft_fwd<R>(v);
    if (s > 1) {
        int pp = p * (16384 / n); asm volatile("" : "+v"(pp));
        const cf w1 = tw[pp]; cf w = w1;
#pragma unroll
        for (int m = 1; m < R; ++m) { v[brev<R>(m)] = cmul(v[brev<R>(m)], w); w = cmul(w, w1); }
    }
#pragma unroll
    for (int k = 0; k < R; ++k) X[PIDX(base + k * s)] = v[k];
}
template <int R> DI void fft_pass_inv(LAS cf* X, const LAS cf* tw, int n, int g) {
    const int s = n / R, q = g / s, p = g - q * s, base = q * n + p;
    cf v[R];
#pragma unroll
    for (int k = 0; k < R; ++k) v[k] = X[PIDX(base + k * s)];
    if (s > 1) {
        int pp = p * (16384 / n); asm volatile("" : "+v"(pp));
        cf w1 = tw[pp]; w1.y = -w1.y; cf w = w1;
#pragma unroll
        for (int m = 1; m < R; ++m) { v[brev<R>(m)] = cmul(v[brev<R>(m)], w); w = cmul(w, w1); }
    }
    dft_inv<R>(v);
#pragma unroll
    for (int k = 0; k < R; ++k) X[PIDX(base + k * s)] = v[k];
}
DI void fft16k_fwd(LAS cf* X, const LAS cf* tw) {
    const int t = TID();
#pragma unroll 1
    for (int g = 0; g < 2; ++g) fft_pass_fwd<16>(X, tw, 16384, t + 512 * g);
    __syncthreads();
#pragma unroll 1
    for (int g = 0; g < 2; ++g) fft_pass_fwd<16>(X, tw, 1024, t + 512 * g);
    __syncthreads();
#pragma unroll 1
    for (int g = 0; g < 2; ++g) fft_pass_fwd<16>(X, tw, 64, t + 512 * g);
    __syncthreads();
#pragma unroll 1
    for (int g = 0; g < 8; ++g) fft_pass_fwd<4>(X, tw, 4, t + 512 * g);
    __syncthreads();
}
DI void fft16k_inv(LAS cf* X, const LAS cf* tw) {
    const int t = TID();
#pragma unroll 1
    for (int g = 0; g < 8; ++g) fft_pass_inv<4>(X, tw, 4, t + 512 * g);
    __syncthreads();
#pragma unroll 1
    for (int g = 0; g < 2; ++g) fft_pass_inv<16>(X, tw, 64, t + 512 * g);
    __syncthreads();
#pragma unroll 1
    for (int g = 0; g < 2; ++g) fft_pass_inv<16>(X, tw, 1024, t + 512 * g);
    __syncthreads();
#pragma unroll 1
    for (int g = 0; g < 2; ++g) fft_pass_inv<16>(X, tw, 16384, t + 512 * g);
    __syncthreads();
}

struct Params { const float* in[33]; float* out; unsigned char* ws; int ph_lo, ph_hi; };
struct KC {
    const float *x, *c, *ctx, *c_ctx, *ada_w, *ada_b, *norm_mix, *norm_ffn, *norm_final;
    const float *dn_w_in, *dn_conv, *dn_a_log, *dn_dt_bias, *dn_out_norm, *dn_w_out;
    const float *hy_w_in, *hy_conv, *hy_f_w1, *hy_f_b1, *hy_f_freq, *hy_f_w2, *hy_f_b2, *hy_f_w3, *hy_bias, *hy_w_out;
    const float *sc_w_in, *sc_conv, *sc_w_out, *w_router, *router_bias, *moe_w_gate, *moe_w_up, *moe_w_down;
    float* out; unsigned char* ws;
};

PF void job_mod(const KC& k, LAS float* lds) {
    const int tid = TID(), cj = tid & 63, kq = tid >> 6;
    float* mod = (float*)(k.ws + WS_MOD);
    LAS float* sl = lds + 2048;
    for (int i = tid; i < 3072; i += NTHR) { const float v = i < 1024 ? k.c_ctx[i] : k.c[i - 1024]; sl[i] = siluf(v); }
    __syncthreads();
    for (int u = blockIdx.x; u < DEPTH * 96; u += gridDim.x) {
        const int l = u / 96, cc = u % 96, col = cc * 64 + cj;
        const float* W = k.ada_w + (size_t)l * 1024 * 6144 + col;
        float a0 = 0.f, a1 = 0.f, a2 = 0.f;
        for (int k0 = kq * 128; k0 < kq * 128 + 128; k0 += 16) {
            float w[16];
#pragma unroll
            for (int e = 0; e < 16; ++e) w[e] = W[(size_t)(k0 + e) * 6144];
            asm volatile("" ::: "memory");
#pragma unroll
            for (int e = 0; e < 16; ++e) { a0 += sl[k0 + e] * w[e]; a1 += sl[1024 + k0 + e] * w[e]; a2 += sl[2048 + k0 + e] * w[e]; }
        }
        lds[(kq * 3 + 0) * 64 + cj] = a0; lds[(kq * 3 + 1) * 64 + cj] = a1; lds[(kq * 3 + 2) * 64 + cj] = a2;
        __syncthreads();
        if (tid < 192) {
            const int r = tid >> 6, j = tid & 63;
            float sacc = 0.f;
            for (int q = 0; q < 8; ++q) sacc += lds[(q * 3 + r) * 64 + j];
            mod[(size_t)(l * 3 + r) * 6144 + cc * 64 + j] = sacc + k.ada_b[l * 6144 + cc * 64 + j];
        }
        __syncthreads();
    }
}
DI void cvt_matrix(const float* src, int ld, size_t sstride, int K, int N, int nmat, bf16_t* dst, int ldd, size_t dstride, int mapmode, LAS float* lds, int bid, int nb) {
    const int tk = K / 64, tn = N / 64, per = tk * tn, tid = TID();
    const int r = tid >> 4, c4 = (tid & 15) * 4;
    f32x4 v0, v1;
    int u = bid;
    if (u < per * nmat) { const int m = u / per, t = u % per; const float* sp = src + (size_t)m * sstride + (size_t)((t / tn) * 64 + r) * ld + (t % tn) * 64 + c4; v0 = *(const f32x4*)sp; v1 = *(const f32x4*)(sp + (size_t)32 * ld); }
    for (; u < per * nmat; u += nb) {
        const int m = u / per, t = u % per, k0 = (t / tn) * 64, n0 = (t % tn) * 64;
        { LAS float* p = lds + r * 65 + c4; p[0] = v0[0]; p[1] = v0[1]; p[2] = v0[2]; p[3] = v0[3];
          LAS float* p2 = lds + (r + 32) * 65 + c4; p2[0] = v1[0]; p2[1] = v1[1]; p2[2] = v1[2]; p2[3] = v1[3]; }
        { const int un = u + nb;
          if (un < per * nmat) { const int mn = un / per, tn_ = un % per; const float* sp = src + (size_t)mn * sstride + (size_t)((tn_ / tn) * 64 + r) * ld + (tn_ % tn) * 64 + c4; v0 = *(const f32x4*)sp; v1 = *(const f32x4*)(sp + (size_t)32 * ld); } }
        lds_barrier();
        { const int nn = tid >> 3, ks = (tid & 7) * 8; const int n = n0 + nn;
          const int row = mapmode == 0 ? n : (32 * (n >> 4) + (n & 15) + (mapmode == 2 ? 16 : 0));
          float f[8];
#pragma unroll
          for (int e = 0; e < 8; ++e) f[e] = lds[(ks + e) * 65 + nn];
          u32x4 o; o[0] = pk2(f[0], f[1]); o[1] = pk2(f[2], f[3]); o[2] = pk2(f[4], f[5]); o[3] = pk2(f[6], f[7]);
          *(u32x4*)(dst + (size_t)m * dstride + (size_t)row * ldd + k0 + ks) = o; }
        lds_barrier();
    }
}
PF void job_cvt_small(const KC& k, LAS float* lds) {
    cvt_matrix(k.dn_w_in, DN_IN, (size_t)1024 * DN_IN, 1024, 4096, 2, (bf16_t*)(k.ws + WS_DNWIN), 1024, (size_t)4096 * 1024, 0, lds, (int)blockIdx.x, (int)gridDim.x);
    cvt_matrix(k.dn_w_out, 1024, (size_t)1024 * 1024, 1024, 1024, 2, (bf16_t*)(k.ws + WS_DNWOUT), 1024, (size_t)1024 * 1024, 0, lds, (int)blockIdx.x, (int)gridDim.x);
    cvt_matrix(k.hy_w_in, 3072, 0, 1024, 3072, 1, (bf16_t*)(k.ws + WS_HYWIN), 1024, 0, 0, lds, (int)blockIdx.x, (int)gridDim.x);
    cvt_matrix(k.hy_w_out, 1024, 0, 1024, 1024, 1, (bf16_t*)(k.ws + WS_HYWOUT), 1024, 0, 0, lds, (int)blockIdx.x, (int)gridDim.x);
    cvt_matrix(k.sc_w_in, 3072, 0, 1024, 3072, 1, (bf16_t*)(k.ws + WS_SCWIN), 1024, 0, 0, lds, (int)blockIdx.x, (int)gridDim.x);
    cvt_matrix(k.sc_w_out, 1024, 0, 1024, 1024, 1, (bf16_t*)(k.ws + WS_SCWOUT), 1024, 0, 0, lds, (int)blockIdx.x, (int)gridDim.x);
}
PF void job_cvt_moe(const KC& k, int layer, LAS float* lds, int bid, int nb) {
    if (bid < 0) return;
    const size_t lo = (size_t)layer * 32 * 1024 * 512;
    cvt_matrix(k.moe_w_gate + lo, 512, (size_t)1024 * 512, 1024, 512, 32, (bf16_t*)(k.ws + AR_WGU), 1024, (size_t)1024 * 1024, 1, lds, bid, nb);
    cvt_matrix(k.moe_w_up + lo, 512, (size_t)1024 * 512, 1024, 512, 32, (bf16_t*)(k.ws + AR_WGU), 1024, (size_t)1024 * 1024, 2, lds, bid, nb);
    cvt_matrix(k.moe_w_down + lo, 1024, (size_t)512 * 1024, 512, 1024, 32, (bf16_t*)(k.ws + AR_WD), 512, (size_t)1024 * 512, 0, lds, bid, nb);
}
PF void job_hdn(const KC& k, LAS float* lds) {
    const int tid = TID(), lane = tid & 63, wave = tid >> 6;
    LAS float* feat = lds + wave * 128; LAS float* h1 = feat + 64;
    const float fr = k.hy_f_freq[lane], b1 = k.hy_f_b1[lane], b2 = k.hy_f_b2[lane];
    for (int u0 = blockIdx.x * 8; u0 < 16384 + 256; u0 += gridDim.x * 8) {
        const int u = u0 + wave;
        int l, pos; float* dst;
        if (u < 16384) { l = 16384; pos = u; dst = nullptr; }
        else { l = 256; pos = u - 16384; dst = (float*)(k.ws + WS_HDNC) + (size_t)pos * 64; }
        const float t = (float)pos / (float)(l - 1);
        float f = 0.f;
        if (lane == 0) f = t;
        else if (lane <= 32) {
            const int bi = (lane - 1) & 15;
            const float band = 1e-4f + (float)bi * ((15.0f - 1e-4f) / 15.0f);
            const float ang = (6.283185307179586f / (float)l) * (float)pos * band;
            f = lane <= 16 ? cosf(ang) : -sinf(ang);
        }
        feat[lane] = f;
        __syncthreads();
        float a = b1;
        for (int i = 0; i < 33; ++i) a += feat[i] * k.hy_f_w1[i * 64 + lane];
        h1[lane] = sinf(fr * a);
        __syncthreads();
        float a2 = b2;
        for (int j = 0; j < 64; ++j) a2 += h1[j] * k.hy_f_w2[j * 64 + lane];
        const float hv = sinf(fr * a2);
        if (dst) dst[lane] = hv;
        else { bf16_t* hs = (bf16_t*)(k.ws + WS_HS) + (size_t)pos * 256; const bf16_t hi = f2bf(hv), lo = f2bf(hv - bf2f(hi)); hs[lane] = hi; hs[64 + lane] = lo; hs[128 + lane] = hi; hs[192 + lane] = 0; }
        __syncthreads();
    }
}
PF void job_w3s(const KC& k) {
    bf16_t* W = (bf16_t*)(k.ws + WS_W3S);
    const int tq = TID();
    for (int idx = blockIdx.x * NTHR + tq; idx < 64 * 4096; idx += gridDim.x * NTHR) {
        const int j = idx >> 12, col = idx & 4095;
        const float w = k.hy_f_w3[idx]; const bf16_t hi = f2bf(w), lo = f2bf(w - bf2f(hi));
        W[(size_t)col * 256 + j] = hi; W[(size_t)col * 256 + 64 + j] = hi; W[(size_t)col * 256 + 128 + j] = lo; W[(size_t)col * 256 + 192 + j] = 0;
    }
}
DI float hy_delta(int ch) {
    const float lo = -4.605170185988091f / 1.5f, hi = -4.605170185988091f / 0.3f;
    return fabsf(lo + (float)ch * ((hi - lo) / 1023.0f));
}
PF void job_filtc(const KC& k, int j) {
    const float* hdn = (const float*)(k.ws + WS_HDNC);
    const float* w3 = k.hy_f_w3 + (size_t)j * 64 * 4096;
    float* filtc = (float*)(k.ws + WS_FILTC);
    const int tq = TID();
    for (int u = blockIdx.x; u < 256 * 8; u += gridDim.x) {
        const int l = u >> 3, col = (u & 7) * 512 + tq;
        float a = 0.f;
        for (int q0 = 0; q0 < 64; q0 += 16) {
            float wv[16], hv[16];
#pragma unroll
            for (int q = 0; q < 16; ++q) { wv[q] = w3[(size_t)(q0 + q) * 4096 + col]; hv[q] = hdn[l * 64 + q0 + q]; }
            asm volatile("" ::: "memory");
#pragma unroll
            for (int q = 0; q < 16; ++q) a += hv[q] * wv[q];
        }
        const float t = (float)l / 255.0f;
        filtc[(size_t)l * 4096 + col] = a * expf(-t * hy_delta(col & 1023));
    }
}

template <int MODE>
PF void norm_vec(const KC& k, int layer, const float* __restrict__ gain, int mb) {
    const int tid = TID(), lane = tid & 63, wave = tid >> 6;
    float* xs = (float*)(k.ws + WS_XS);
    bf16_t* hbuf = (bf16_t*)(k.ws + AR_HBUF);
    const float* mod = (const float*)(k.ws + WS_MOD);
    const bf16_t* ys = (const bf16_t*)(k.ws + AR_YS);
    const int* tokp = (const int*)(k.ws + WS_TOKP);
    const float* tokw = (const float*)(k.ws + WS_TOKW);
    const int rbeg = (MODE == 3) ? TC : 0, rstr = gridDim.x * 8, c0 = 4 * lane;
    int cur_mr = -1; f32x4 gsv[4], shv[4], g5v[4];
    int r = rbeg + blockIdx.x * 8 + wave;
    if (r >= T) return;
    f32x4 xn[4]; u32x2 yan[4], ybn[4]; float w0n, w1n, w0f, w1f; int p0f, p1f;
    {
        const int p0 = tokp[2 * r], p1 = tokp[2 * r + 1]; w0n = tokw[2 * r]; w1n = tokw[2 * r + 1];
        const int r2 = r + rstr < T ? r + rstr : T - 1;
        p0f = tokp[2 * r2]; p1f = tokp[2 * r2 + 1]; w0f = tokw[2 * r2]; w1f = tokw[2 * r2 + 1];
#pragma unroll
        for (int j = 0; j < 4; ++j) {
            xn[j] = *(const f32x4*)(xs + (size_t)r * 1024 + 256 * j + c0);
            yan[j] = *(const u32x2*)(ys + (size_t)p0 * 1024 + 256 * j + c0); ybn[j] = *(const u32x2*)(ys + (size_t)p1 * 1024 + 256 * j + c0);
        }
    }
    for (; r < T; r += rstr) {
        const int mr = modrow(r);
        f32x4 x[4]; u32x2 ya[4], yb[4];
#pragma unroll
        for (int j = 0; j < 4; ++j) { x[j] = xn[j]; ya[j] = yan[j]; yb[j] = ybn[j]; }
        const float w0 = w0n, w1 = w1n;
        {
            const int rn = r + rstr < T ? r + rstr : T - 1, rf = r + 2 * rstr < T ? r + 2 * rstr : T - 1;
#pragma unroll
            for (int j = 0; j < 4; ++j) {
                xn[j] = *(const f32x4*)(xs + (size_t)rn * 1024 + 256 * j + c0);
                yan[j] = *(const u32x2*)(ys + (size_t)p0f * 1024 + 256 * j + c0); ybn[j] = *(const u32x2*)(ys + (size_t)p1f * 1024 + 256 * j + c0);
            }
            w0n = w0f; w1n = w1f;
            p0f = tokp[2 * rf]; p1f = tokp[2 * rf + 1]; w0f = tokw[2 * rf]; w1f = tokw[2 * rf + 1];
        }
        if (mr != cur_mr) {
            cur_mr = mr;
            const float* shift = mod + ((size_t)(layer * 3 + mr) * 6 + mb) * 1024;
            const float* g5 = mod + ((size_t)((layer - 1) * 3 + mr) * 6 + 5) * 1024;
#pragma unroll
            for (int j = 0; j < 4; ++j) {
                const int col = 256 * j + c0;
                const f32x4 gn = *(const f32x4*)(gain + col);
                if (MODE != 3) { const f32x4 sc = *(const f32x4*)(shift + 1024 + col); shv[j] = *(const f32x4*)(shift + col);
#pragma unroll
                    for (int e = 0; e < 4; ++e) gsv[j][e] = gn[e] * (1.0f + sc[e]); }
                else gsv[j] = gn;
                g5v[j] = *(const f32x4*)(g5 + col);
            }
        }
        float ss = 0.f;
#pragma unroll
        for (int j = 0; j < 4; ++j) {
            const float a0 = __uint_as_float(ya[j][0] << 16), a1 = __uint_as_float(ya[j][0] & 0xffff0000u), a2 = __uint_as_float(ya[j][1] << 16), a3 = __uint_as_float(ya[j][1] & 0xffff0000u);
            const float b0 = __uint_as_float(yb[j][0] << 16), b1 = __uint_as_float(yb[j][0] & 0xffff0000u), b2 = __uint_as_float(yb[j][1] << 16), b3 = __uint_as_float(yb[j][1] & 0xffff0000u);
            x[j][0] += g5v[j][0] * (w0 * a0 + w1 * b0); x[j][1] += g5v[j][1] * (w0 * a1 + w1 * b1);
            x[j][2] += g5v[j][2] * (w0 * a2 + w1 * b2); x[j][3] += g5v[j][3] * (w0 * a3 + w1 * b3);
            if (MODE != 3) *(f32x4*)(xs + (size_t)r * 1024 + 256 * j + c0) = x[j];
            ss += x[j][0] * x[j][0] + x[j][1] * x[j][1] + x[j][2] * x[j][2] + x[j][3] * x[j][3];
        }
        ss = wsum(ss, lane);
        const float rstd = rsqrtf(ss * (1.0f / 1024.0f) + EPS);
#pragma unroll
        for (int j = 0; j < 4; ++j) {
            if (MODE == 3) {
                f32x4 o;
#pragma unroll
                for (int e = 0; e < 4; ++e) o[e] = x[j][e] * rstd * gsv[j][e];
                *(f32x4*)(k.out + (size_t)(r - TC) * 1024 + 256 * j + c0) = o;
            } else {
                u32x2 o;
                o[0] = pk2(x[j][0] * rstd * gsv[j][0] + shv[j][0], x[j][1] * rstd * gsv[j][1] + shv[j][1]);
                o[1] = pk2(x[j][2] * rstd * gsv[j][2] + shv[j][2], x[j][3] * rstd * gsv[j][3] + shv[j][3]);
                *(u32x2*)(hbuf + (size_t)r * 1024 + 256 * j + c0) = o;
            }
        }
    }
}

template <int MODE>
PF void norm_phase(const KC& k, int layer, bool first, bool combine, const float* __restrict__ gain, int mb, const float* __restrict__ Wsk, int ldw,
                   const float* __restrict__ aux0, const float* __restrict__ aux1, bool last, LAS float* lds, bool flush = true) {
    const int tid = TID(), lane = tid & 63, wave = tid >> 6;
    float* xs = (float*)(k.ws + WS_XS);
    bf16_t* hbuf = (bf16_t*)(k.ws + AR_HBUF);
    const float* mod = (const float*)(k.ws + WS_MOD);
    const bf16_t* ys = (const bf16_t*)(k.ws + AR_YS);
    const int* tokp = (const int*)(k.ws + WS_TOKP);
    const float* tokw = (const float*)(k.ws + WS_TOKW);
    LAS int* lcnt = (LAS int*)(lds + 32768);
    if (MODE == 1 && tid < 32) lcnt[tid] = 0;
    if (MODE == 1 || MODE == 2) {
        for (int idx = tid; idx < 1024 * 32; idx += NTHR) {
            const int kk = idx >> 5, n = idx & 31;
            lds[kk * 32 + (((n >> 2) ^ ((kk >> 1) & 7)) << 2) + (n & 3)] = Wsk[(size_t)kk * ldw + n];
        }
        __syncthreads();
    }
    const int rbeg = (MODE == 3) ? TC : 0, rstr = gridDim.x * 8;
    int cur_mr = -1; float gsv[16], shv[16], g5v[16];
    float xn[16];
    int r = rbeg + blockIdx.x * 8 + wave;
    if (r < T) {
        const float* src = first ? (r < TC ? k.ctx + (size_t)r * 1024 : k.x + (size_t)(r - TC) * 1024) : xs + (size_t)r * 1024;
#pragma unroll
        for (int m = 0; m < 16; ++m) xn[m] = src[lane + 64 * m];
    }
    for (; r < T; r += rstr) {
        const int mr = modrow(r);
        float x[16];
#pragma unroll
        for (int m = 0; m < 16; ++m) x[m] = xn[m];
        int p0 = 0, p1 = 0; float w0 = 0.f, w1 = 0.f;
        if (combine) { p0 = tokp[2 * r]; p1 = tokp[2 * r + 1]; w0 = tokw[2 * r]; w1 = tokw[2 * r + 1]; }
        {
            const int rn = r + rstr;
            if (rn < T) {
                const float* srcn = first ? (rn < TC ? k.ctx + (size_t)rn * 1024 : k.x + (size_t)(rn - TC) * 1024) : xs + (size_t)rn * 1024;
#pragma unroll
                for (int m = 0; m < 16; ++m) xn[m] = srcn[lane + 64 * m];
            }
        }
        if (mr != cur_mr) {
            cur_mr = mr;
            if (MODE != 3) {
                const float* shift = mod + ((size_t)(layer * 3 + mr) * 6 + mb) * 1024;
#pragma unroll
                for (int m = 0; m < 16; ++m) { const int col = lane + 64 * m; gsv[m] = gain[col] * (1.0f + shift[1024 + col]); shv[m] = shift[col]; }
            } else {
#pragma unroll
                for (int m = 0; m < 16; ++m) gsv[m] = gain[lane + 64 * m];
            }
            if (combine) {
                const float* g5 = mod + ((size_t)((layer - 1) * 3 + mr) * 6 + 5) * 1024;
#pragma unroll
                for (int m = 0; m < 16; ++m) g5v[m] = g5[lane + 64 * m];
            }
        }
        if (combine) {
            bf16_t ya[16], yb[16];
#pragma unroll
            for (int m = 0; m < 16; ++m) { const int col = lane + 64 * m; ya[m] = ys[(size_t)p0 * 1024 + col]; yb[m] = ys[(size_t)p1 * 1024 + col]; }
            asm volatile("" ::: "memory");
#pragma unroll
            for (int m = 0; m < 16; ++m) x[m] += g5v[m] * (w0 * bf2f(ya[m]) + w1 * bf2f(yb[m]));
        }
        if (first || combine) {
#pragma unroll
            for (int m = 0; m < 16; ++m) xs[(size_t)r * 1024 + lane + 64 * m] = x[m];
        }
        float ss = 0.f;
#pragma unroll
        for (int m = 0; m < 16; ++m) ss += x[m] * x[m];
        ss = wsum(ss, lane);
        const float rstd = rsqrtf(ss * (1.0f / 1024.0f) + EPS);
        if (MODE == 3) {
#pragma unroll
            for (int m = 0; m < 16; ++m) { const int col = lane + 64 * m; k.out[(size_t)(r - TC) * 1024 + col] = x[m] * rstd * gsv[m]; }
            continue;
        }
        float y[16];
#pragma unroll
        for (int m = 0; m < 16; ++m) {
            const int col = lane + 64 * m;
            y[m] = x[m] * rstd * gsv[m] + shv[m];
            hbuf[(size_t)r * 1024 + col] = f2bf(y[m]);
        }
        if (MODE == 1 || MODE == 2) {
            float acc[32];
#pragma unroll
            for (int n = 0; n < 32; ++n) acc[n] = 0.f;
#pragma unroll
            for (int m = 0; m < 16; ++m) {
                f32x4 wa[8];
                const int c = lane + 64 * m; const LAS float* wr = lds + c * 32; const int sw = (c >> 1) & 7;
#pragma unroll
                for (int q = 0; q < 8; ++q) wa[q] = *(const LAS f32x4*)(wr + ((q ^ sw) << 2));
                asm volatile("" ::: "memory");
#pragma unroll
                for (int q = 0; q < 8; ++q) { acc[4 * q + 0] += y[m] * wa[q][0]; acc[4 * q + 1] += y[m] * wa[q][1]; acc[4 * q + 2] += y[m] * wa[q][2]; acc[4 * q + 3] += y[m] * wa[q][3]; }
            }
            float val;
            {
                float a16[16], a8[8], a4[4], a2[2];
                const bool b5 = (lane & 32) != 0, b4 = (lane & 16) != 0, b3 = (lane & 8) != 0, b2 = (lane & 4) != 0, b1 = (lane & 2) != 0;
#pragma unroll
                for (int i = 0; i < 16; ++i) { const float send = b5 ? acc[i] : acc[i + 16], keep = b5 ? acc[i + 16] : acc[i]; a16[i] = keep + shx(send, 32, lane); }
#pragma unroll
                for (int i = 0; i < 8; ++i) { const float send = b4 ? a16[i] : a16[i + 8], keep = b4 ? a16[i + 8] : a16[i]; a8[i] = keep + shx(send, 16, lane); }
#pragma unroll
                for (int i = 0; i < 4; ++i) { const float send = b3 ? a8[i] : a8[i + 4], keep = b3 ? a8[i + 4] : a8[i]; a4[i] = keep + shx(send, 8, lane); }
#pragma unroll
                for (int i = 0; i < 2; ++i) { const float send = b2 ? a4[i] : a4[i + 2], keep = b2 ? a4[i + 2] : a4[i]; a2[i] = keep + shx(send, 4, lane); }
                { const float send = b1 ? a2[0] : a2[1], keep = b1 ? a2[1] : a2[0]; val = keep + shx(send, 2, lane); }
                val += shx(val, 1, lane);
            }
            const int n = lane >> 1;
            if (MODE == 1) {
                int* toke = (int*)(k.ws + WS_TOKE); float* tokwW = (float*)(k.ws + WS_TOKW);
                if (last && r < TC) { if (lane == 0) { int neg = -1; asm volatile("" : "+v"(neg)); toke[2 * r] = neg; toke[2 * r + 1] = neg; } continue; }
                const float sc = 1.0f / (1.0f + expf(-val)), ch = sc + aux0[n];
                const int gl = lane & ~7;
                const float ca = shi(ch, gl), cb = shi(ch, gl + 2), cc = shi(ch, gl + 4), cd = shi(ch, gl + 6);
                const float hi1 = fmaxf(ca, cb), lo1 = fminf(ca, cb), hi2 = fmaxf(cc, cd), lo2 = fminf(cc, cd);
                float gs = fmaxf(hi1, hi2) + fmaxf(fminf(hi1, hi2), fmaxf(lo1, lo2));
                int gi = lane >> 3;
#pragma unroll
                for (int m = 8; m <= 32; m <<= 1) {
                    const float og = shx(gs, m, lane); const int oi = shii(gi, lane ^ m);
                    if (og > gs || (og == gs && oi < gi)) { gs = og; gi = oi; }
                }
                float c4[4], s4[4];
#pragma unroll
                for (int i = 0; i < 4; ++i) { c4[i] = shi(ch, gi * 8 + 2 * i); s4[i] = shi(sc, gi * 8 + 2 * i); }
                int i1 = 0; float b1v = c4[0];
#pragma unroll
                for (int i = 1; i < 4; ++i) if (c4[i] > b1v) { b1v = c4[i]; i1 = i; }
                int i2 = -1; float b2v = -1e30f;
#pragma unroll
                for (int i = 0; i < 4; ++i) if (i != i1 && c4[i] > b2v) { b2v = c4[i]; i2 = i; }
                float w1v = 0.f, w2v = 0.f;
#pragma unroll
                for (int i = 0; i < 4; ++i) { if (i == i1) w1v = s4[i]; if (i == i2) w2v = s4[i]; }
                const float inv = 1.0f / (w1v + w2v);
                if (lane == 0) {
                    const int e1 = gi * 4 + i1, e2 = gi * 4 + i2;
                    toke[2 * r] = e1; toke[2 * r + 1] = e2; tokwW[2 * r] = w1v * inv; tokwW[2 * r + 1] = w2v * inv;
                    __hip_atomic_fetch_add(lcnt + e1, 1, __ATOMIC_RELAXED, __HIP_MEMORY_SCOPE_WORKGROUP);
                    __hip_atomic_fetch_add(lcnt + e2, 1, __ATOMIC_RELAXED, __HIP_MEMORY_SCOPE_WORKGROUP);
                }
            } else {
                float* gb = (float*)(k.ws + WS_GB);
                if ((lane & 1) == 0) {
                    if (n < 16) {
                        const float z = val + aux1[n];
                        const float ez = __expf(z); const float sp = z > 15.f ? z : (ez < 1e-4f ? ez - 0.5f * ez * ez : __logf(1.0f + ez));
                        gb[(size_t)r * 32 + n] = -expf(aux0[n]) * sp;
                    } else {
                        gb[(size_t)r * 32 + n] = 1.0f / (1.0f + expf(-val));
                    }
                }
            }
        }
    }
    if (MODE == 1) {
        __syncthreads();
        int* cnt = (int*)(k.ws + WS_CTL + CTL_CNT) + layer * 32;
        if (flush && tid < 32 && lcnt[tid] > 0) atomicAdd(&cnt[tid], lcnt[tid]);
    }
}

constexpr int NM_WLD = 1032;
template <int MODE>
PF void norm_mfma(const KC& k, int layer, bool first, bool combine, const float* __restrict__ gain, int mb, const float* __restrict__ Wsk, int ldw,
                  const float* __restrict__ aux0, const float* __restrict__ aux1, bool last, LAS unsigned char* lds, bool flush = true) {
    const int tid = TID(), lane = tid & 63, wave = __builtin_amdgcn_readfirstlane(tid >> 6), row = lane & 15, q = lane >> 4;
    LAS bf16_t* WtH = (LAS bf16_t*)lds; LAS bf16_t* WtL = WtH + 32 * NM_WLD;
    LAS float* red = (LAS float*)(WtL + 32 * NM_WLD);
    LAS float* lg = red + 128;
    LAS int* lcnt = (LAS int*)(lg + 8 * 16 * 32);
    float* xs = (float*)(k.ws + WS_XS);
    bf16_t* hbuf = (bf16_t*)(k.ws + AR_HBUF);
    const float* mod = (const float*)(k.ws + WS_MOD);
    const bf16_t* ys = (const bf16_t*)(k.ws + AR_YS);
    const int* tokp = (const int*)(k.ws + WS_TOKP); const float* tokw = (const float*)(k.ws + WS_TOKW);
    if (MODE == 1 && tid < 32) lcnt[tid] = 0;
    for (int idx = tid; idx < 1024 * 32; idx += NTHR) {
        const int kk = idx >> 5, n = idx & 31;
        const float w = Wsk[(size_t)kk * ldw + n]; const bf16_t hi = f2bf(w);
        WtH[n * NM_WLD + kk] = hi; WtL[n * NM_WLD + kk] = f2bf(w - bf2f(hi));
    }
    __syncthreads();
    const int cbase = 128 * wave + 8 * q;
    f32x4 xn[8];
    int bt = blockIdx.x;
    if (bt < T / 16) {
        const float* sb = first ? (16 * bt < TC ? k.ctx : k.x - (size_t)TC * 1024) : xs;
        const unsigned off = (unsigned)(16 * bt + row) * 1024u + (unsigned)cbase;
#pragma unroll
        for (int kk = 0; kk < 4; ++kk) { xn[2 * kk] = *(const f32x4*)(sb + off + 32 * kk); xn[2 * kk + 1] = *(const f32x4*)(sb + off + 32 * kk + 4); }
    }
    const float tail0 = (MODE == 1) ? aux0[tid & 31] : -expf(aux0[tid & 15]), tail1 = (MODE == 1) ? 0.f : aux1[tid & 15];
    int cur_mr = -1; float gsv[32], shv[32];
    for (; bt < T / 16; bt += gridDim.x) {
        const int r = 16 * bt + row, mr = modrow(16 * bt);
        const unsigned roff = (unsigned)r * 1024u + (unsigned)cbase;
        if (MODE == 1 && mr != cur_mr) {
            cur_mr = mr;
            const float* shift = mod + ((size_t)(layer * 3 + mr) * 6 + mb) * 1024;
#pragma unroll
            for (int kk = 0; kk < 4; ++kk) {
                const unsigned co = (unsigned)cbase + 32u * kk;
                const f32x4 g0 = *(const f32x4*)(gain + co), g1 = *(const f32x4*)(gain + co + 4), s0 = *(const f32x4*)(shift + 1024 + co), s1 = *(const f32x4*)(shift + 1024 + co + 4),
                            h0 = *(const f32x4*)(shift + co), h1 = *(const f32x4*)(shift + co + 4);
#pragma unroll
                for (int e = 0; e < 4; ++e) { gsv[8 * kk + e] = g0[e] * (1.0f + s0[e]); gsv[8 * kk + 4 + e] = g1[e] * (1.0f + s1[e]); shv[8 * kk + e] = h0[e]; shv[8 * kk + 4 + e] = h1[e]; }
            }
#pragma unroll
            for (int e = 0; e < 32; ++e) asm volatile("" :: "v"(shv[e]));
        }
        float x[32];
#pragma unroll
        for (int i = 0; i < 8; ++i) { x[4 * i] = xn[i][0]; x[4 * i + 1] = xn[i][1]; x[4 * i + 2] = xn[i][2]; x[4 * i + 3] = xn[i][3]; }
        int p0 = 0, p1 = 0; float w0 = 0.f, w1 = 0.f;
        if (combine) { p0 = tokp[2 * r]; p1 = tokp[2 * r + 1]; w0 = tokw[2 * r]; w1 = tokw[2 * r + 1]; }
        {
            const int bn = bt + gridDim.x;
            if (bn < T / 16) {
                const float* sb = first ? (16 * bn < TC ? k.ctx : k.x - (size_t)TC * 1024) : xs;
                const unsigned off = (unsigned)(16 * bn + row) * 1024u + (unsigned)cbase;
#pragma unroll
                for (int kk = 0; kk < 4; ++kk) { xn[2 * kk] = *(const f32x4*)(sb + off + 32 * kk); xn[2 * kk + 1] = *(const f32x4*)(sb + off + 32 * kk + 4); }
            }
        }
        if (combine) {
            const float* g5 = mod + ((size_t)((layer - 1) * 3 + mr) * 6 + 5) * 1024;
            u32x4 ya[4], yb[4]; float g5v[32];
#pragma unroll
            for (int kk = 0; kk < 4; ++kk) { ya[kk] = *(const u32x4*)(ys + (size_t)p0 * 1024 + cbase + 32 * kk); yb[kk] = *(const u32x4*)(ys + (size_t)p1 * 1024 + cbase + 32 * kk);
                const f32x4 ga = *(const f32x4*)(g5 + cbase + 32 * kk), gb2 = *(const f32x4*)(g5 + cbase + 32 * kk + 4);
#pragma unroll
                for (int e = 0; e < 4; ++e) { g5v[8 * kk + e] = ga[e]; g5v[8 * kk + 4 + e] = gb2[e]; } }
            asm volatile("" ::: "memory");
#pragma unroll
            for (int kk = 0; kk < 4; ++kk)
#pragma unroll
                for (int w = 0; w < 4; ++w) {
                    x[8 * kk + 2 * w] += g5v[8 * kk + 2 * w] * (w0 * __uint_as_float(ya[kk][w] << 16) + w1 * __uint_as_float(yb[kk][w] << 16));
                    x[8 * kk + 2 * w + 1] += g5v[8 * kk + 2 * w + 1] * (w0 * __uint_as_float(ya[kk][w] & 0xffff0000u) + w1 * __uint_as_float(yb[kk][w] & 0xffff0000u));
                }
        }
        if (first || combine) {
#pragma unroll
            for (int kk = 0; kk < 4; ++kk) {
                *(f32x4*)(xs + roff + 32 * kk) = (f32x4){x[8 * kk], x[8 * kk + 1], x[8 * kk + 2], x[8 * kk + 3]};
                *(f32x4*)(xs + roff + 32 * kk + 4) = (f32x4){x[8 * kk + 4], x[8 * kk + 5], x[8 * kk + 6], x[8 * kk + 7]};
            }
        }
        float ss = 0.f;
#pragma unroll
        for (int i = 0; i < 32; ++i) ss += x[i] * x[i];
        ss += shx(ss, 16, lane); ss += shx(ss, 32, lane);
        if (q == 0) red[wave * 16 + row] = ss;
        __syncthreads();
        float tot = 0.f;
#pragma unroll
        for (int w = 0; w < 8; ++w) tot += red[w * 16 + row];
        const float rstd = rsqrtf(tot * (1.0f / 1024.0f) + EPS);
        f32x4 acc[2]; acc[0] = (f32x4){0.f, 0.f, 0.f, 0.f}; acc[1] = (f32x4){0.f, 0.f, 0.f, 0.f};
#pragma unroll
        for (int kk = 0; kk < 4; ++kk) {
            float y[8]; u32x4 ah, al;
            if (MODE == 1) {
#pragma unroll
                for (int e = 0; e < 8; ++e) y[e] = x[8 * kk + e] * rstd * gsv[8 * kk + e] + shv[8 * kk + e];
            } else {
                const float* shift = mod + ((size_t)(layer * 3 + mr) * 6 + mb) * 1024;
                const unsigned co = (unsigned)cbase + 32u * kk;
                const f32x4 g0 = *(const f32x4*)(gain + co), g1 = *(const f32x4*)(gain + co + 4), s0 = *(const f32x4*)(shift + 1024 + co), s1 = *(const f32x4*)(shift + 1024 + co + 4),
                            h0 = *(const f32x4*)(shift + co), h1 = *(const f32x4*)(shift + co + 4);
#pragma unroll
                for (int e = 0; e < 4; ++e) { y[e] = x[8 * kk + e] * rstd * g0[e] * (1.0f + s0[e]) + h0[e]; y[4 + e] = x[8 * kk + 4 + e] * rstd * g1[e] * (1.0f + s1[e]) + h1[e]; }
            }
#pragma unroll
            for (int w = 0; w < 4; ++w) {
                ah[w] = pk2(y[2 * w], y[2 * w + 1]);
                al[w] = pk2(y[2 * w] - __uint_as_float(ah[w] << 16), y[2 * w + 1] - __uint_as_float(ah[w] & 0xffff0000u));
            }
            *(u32x4*)(hbuf + roff + 32 * kk) = ah;
            const bf16x8 fah = __builtin_bit_cast(bf16x8, ah), fal = __builtin_bit_cast(bf16x8, al);
            bf16x8 bh[2], bl[2];
#pragma unroll
            for (int nt = 0; nt < 2; ++nt) {
                bh[nt] = *(const LAS bf16x8*)(WtH + (16 * nt + row) * NM_WLD + cbase + 32 * kk);
                bl[nt] = *(const LAS bf16x8*)(WtL + (16 * nt + row) * NM_WLD + cbase + 32 * kk);
            }
            asm volatile("" ::: "memory");
#pragma unroll
            for (int nt = 0; nt < 2; ++nt) {
                acc[nt] = __builtin_amdgcn_mfma_f32_16x16x32_bf16(fah, bh[nt], acc[nt], 0, 0, 0);
                acc[nt] = __builtin_amdgcn_mfma_f32_16x16x32_bf16(fal, bh[nt], acc[nt], 0, 0, 0);
                acc[nt] = __builtin_amdgcn_mfma_f32_16x16x32_bf16(fah, bl[nt], acc[nt], 0, 0, 0);
            }
        }
#pragma unroll
        for (int nt = 0; nt < 2; ++nt)
#pragma unroll
            for (int j = 0; j < 4; ++j) lg[(wave * 16 + 4 * q + j) * 32 + 16 * nt + row] = acc[nt][j];
        __syncthreads();
        {
            const int prow = tid >> 5, n = tid & 31, rr = 16 * bt + prow, hb = lane & 32;
            float val = 0.f;
#pragma unroll
            for (int w = 0; w < 8; ++w) val += lg[(w * 16 + prow) * 32 + n];
            if (MODE == 1) {
                int* toke = (int*)(k.ws + WS_TOKE); float* tokwW = (float*)(k.ws + WS_TOKW);
                const bool unrouted = last && rr < TC;
                const float sc = 1.0f / (1.0f + expf(-val)), ch = sc + tail0;
                const int gl = hb + (n & ~3);
                const float ca = shi(ch, gl), cb = shi(ch, gl + 1), cc = shi(ch, gl + 2), cd = shi(ch, gl + 3);
                const float hi1 = fmaxf(ca, cb), lo1 = fminf(ca, cb), hi2 = fmaxf(cc, cd), lo2 = fminf(cc, cd);
                float gs = fmaxf(hi1, hi2) + fmaxf(fminf(hi1, hi2), fmaxf(lo1, lo2));
                int gi = n >> 2;
#pragma unroll
                for (int m = 4; m <= 16; m <<= 1) {
                    const float og = shx(gs, m, lane); const int oi = shii(gi, lane ^ m);
                    if (og > gs || (og == gs && oi < gi)) { gs = og; gi = oi; }
                }
                float c4[4], s4[4];
#pragma unroll
                for (int i = 0; i < 4; ++i) { c4[i] = shi(ch, hb + gi * 4 + i); s4[i] = shi(sc, hb + gi * 4 + i); }
                int i1 = 0; float b1v = c4[0];
#pragma unroll
                for (int i = 1; i < 4; ++i) if (c4[i] > b1v) { b1v = c4[i]; i1 = i; }
                int i2 = -1; float b2v = -1e30f;
#pragma unroll
                for (int i = 0; i < 4; ++i) if (i != i1 && c4[i] > b2v) { b2v = c4[i]; i2 = i; }
                float w1v = 0.f, w2v = 0.f;
#pragma unroll
                for (int i = 0; i < 4; ++i) { if (i == i1) w1v = s4[i]; if (i == i2) w2v = s4[i]; }
                const float inv = 1.0f / (w1v + w2v);
                if (n == 0) {
                    if (unrouted) { int neg = -1; asm volatile("" : "+v"(neg)); toke[2 * rr] = neg; toke[2 * rr + 1] = neg; }
                    else {
                        const int e1 = gi * 4 + i1, e2 = gi * 4 + i2;
                        toke[2 * rr] = e1; toke[2 * rr + 1] = e2; tokwW[2 * rr] = w1v * inv; tokwW[2 * rr + 1] = w2v * inv;
                        __hip_atomic_fetch_add(lcnt + e1, 1, __ATOMIC_RELAXED, __HIP_MEMORY_SCOPE_WORKGROUP);
                        __hip_atomic_fetch_add(lcnt + e2, 1, __ATOMIC_RELAXED, __HIP_MEMORY_SCOPE_WORKGROUP);
                    }
                }
            } else {
                float* gb = (float*)(k.ws + WS_GB);
                if (n < 16) {
                    const float z = val + tail1;
                    const float ez = __expf(z); const float sp = z > 15.f ? z : (ez < 1e-4f ? ez - 0.5f * ez * ez : __logf(1.0f + ez));
                    gb[(size_t)rr * 32 + n] = tail0 * sp;
                } else {
                    gb[(size_t)rr * 32 + n] = 1.0f / (1.0f + expf(-val));
                }
            }
        }
        __syncthreads();
    }
    if (MODE == 1) {
        __syncthreads();
        int* cnt = (int*)(k.ws + WS_CTL + CTL_CNT) + layer * 32;
        if (flush && tid < 32 && lcnt[tid] > 0) atomicAdd(&cnt[tid], lcnt[tid]);
    }
}

namespace pg8 {
constexpr int BM = 256, BK = 64, HALF = 128, HTB = HALF * BK * 2, STAGE_BYTES = 8 * HTB;
DI int lds_byte(int r, int c) { const int st = (r >> 4) * 2 + (c >> 5), rr = r & 15, cc = c & 31, ob = rr * 64 + cc * 2; return st * 1024 + (ob ^ (((ob >> 9) & 1) << 5)); }
DI void stage_rc(int b, int& R, int& C) { const int st = b / 1024, sb = b % 1024, swz = sb ^ (((sb >> 9) & 1) << 5); R = (st >> 1) * 16 + swz / 64; C = (st & 1) * 32 + (swz % 64) / 2; }
DI int perm32(int rho) { const int n = rho >> 4, i = rho & 15; return 8 * (i >> 2) + 4 * n + (i & 3); }
struct Unit { int m0, mrows, pn; size_t boff; };
template <bool GATHER, class Epi, class Sched>
DI void gemm_phase(LAS unsigned char* lds, const bf16_t* A, const int* rowidx, const bf16_t* Bt, int K, const Sched& S, const Epi& E) {
    const int tid = TID(), wid = __builtin_amdgcn_readfirstlane(tid >> 6), lane = tid & 63, wr = wid >> 2, wc = wid & 3, fr = lane & 15, fq = lane >> 4;
    const int nt = K / BK;
    unsigned voffA[2], voffB[2];
#pragma unroll
    for (int i = 0; i < 2; ++i) { int R, C; stage_rc(tid * 16 + i * 8192, R, C); const int Rb = Epi::PERM ? ((R & ~31) + perm32(R & 31)) : R;
        voffA[i] = (unsigned)(R * K + C) * 2u; voffB[i] = (unsigned)(Rb * K + C) * 2u; }
    const size_t kstep = (size_t)(BK * 2);
    const size_t hstep = (size_t)HALF * K * 2;
    const size_t tstep = 2 * hstep;
    const size_t rstep = (size_t)K * 2;
    const unsigned ldsw = (unsigned)wid * 1024u;
    const int aoff = lds_byte(wr * 64 + fr, fq * 8), boff = lds_byte(wc * 32 + fr, fq * 8);
#define PG8_SA(b, h) (((b) * 2 + (h)) * HTB)
#define PG8_SB(b, h) ((4 + (b) * 2 + (h)) * HTB)
#define PG8_STAGE(bufoff, gbase, voff) do { _Pragma("unroll") for (int _i = 0; _i < 2; ++_i) \
        __builtin_amdgcn_global_load_lds((const unsigned*)((const char*)(gbase) + (voff)[_i]), (LAS unsigned*)(lds + (bufoff) + ldsw + _i * 8192), 16, 0, 0); } while (0)
#define PG8_STAGE_A(bufoff, p, h, vG) do { if (GATHER) PG8_STAGE(bufoff, p, (vG)[h]); else PG8_STAGE(bufoff, (p) + (h) * hstep, voffA); } while (0)
#define PG8_LDA(dst, b, h) do { _Pragma("unroll") for (int m = 0; m < 4; ++m) _Pragma("unroll") for (int k = 0; k < 2; ++k) dst[m][k] = *(const LAS bf16x8*)(lds + PG8_SA(b, h) + aoff + m * 2048 + k * 1024); } while (0)
#define PG8_LDB(dst, b, h) do { _Pragma("unroll") for (int n = 0; n < 2; ++n) _Pragma("unroll") for (int k = 0; k < 2; ++k) dst[n][k] = *(const LAS bf16x8*)(lds + PG8_SB(b, h) + boff + n * 2048 + k * 1024); } while (0)
#define PG8_MMA(ai, bj, At, Bt_) do { __builtin_amdgcn_s_setprio(1); _Pragma("unroll") for (int m = 0; m < 4; ++m) _Pragma("unroll") for (int n = 0; n < 2; ++n) _Pragma("unroll") for (int k = 0; k < 2; ++k) \
        acc[ai][bj][m][n] = __builtin_amdgcn_mfma_f32_16x16x32_bf16(Bt_[n][k], At[m][k], acc[ai][bj][m][n], 0, 0, 0); __builtin_amdgcn_s_setprio(0); } while (0)
#define PG8_WAIT_V(n) asm volatile("s_waitcnt vmcnt(" #n ")" ::: "memory")
#define PG8_WAIT_L(n) asm volatile("s_waitcnt lgkmcnt(" #n ")" ::: "memory")
#define PG8_BAR __builtin_amdgcn_s_barrier()
#define PG8_SCHED __builtin_amdgcn_sched_barrier(0)
#define PG8_AOFF(dst, u) do { _Pragma("unroll") for (int _h = 0; _h < 2; ++_h) _Pragma("unroll") for (int _i = 0; _i < 2; ++_i) { int _R, _C; stage_rc(tid * 16 + _i * 8192, _R, _C); \
        dst[_h][_i] = (unsigned)(rowidx[(u).m0 + _h * HALF + _R] * K + _C) * 2u; } } while (0)
    Unit cur, nxt; int ui = 0;
    if (!S.next(0, cur)) return;
    f32x4 acc[2][2][4][2];
#pragma unroll
    for (int a = 0; a < 2; ++a)
#pragma unroll
        for (int b = 0; b < 2; ++b)
#pragma unroll
            for (int m = 0; m < 4; ++m)
#pragma unroll
                for (int n = 0; n < 2; ++n) acc[a][b][m][n] = (f32x4){0.f, 0.f, 0.f, 0.f};
    bf16x8 At[4][2], B0[2][2], B1[2][2];
    unsigned vA[2][2], vN[2][2];
    if (GATHER) PG8_AOFF(vA, cur);
    const char* cA = (const char*)A + (GATHER ? (size_t)0 : (size_t)cur.m0 * rstep);
    const char* cB = (const char*)Bt + cur.boff + (size_t)cur.pn * tstep;
    PG8_STAGE(PG8_SB(0, 0), cB, voffB); PG8_STAGE_A(PG8_SA(0, 0), cA, 0, vA); PG8_STAGE(PG8_SB(0, 1), cB + hstep, voffB); PG8_STAGE_A(PG8_SA(0, 1), cA, 1, vA);
    if (wr == 1) PG8_BAR;
    PG8_WAIT_V(4); PG8_BAR;
    PG8_STAGE(PG8_SB(1, 0), cB + kstep, voffB); PG8_STAGE_A(PG8_SA(1, 0), cA + kstep, 0, vA); PG8_STAGE(PG8_SB(1, 1), cB + hstep + kstep, voffB);
    PG8_WAIT_V(6); PG8_BAR;
    for (;;) {
        const bool has_next = S.next(ui + 1, nxt);
        const char* nA = GATHER ? cA : (has_next ? (const char*)A + (size_t)nxt.m0 * rstep : cA);
        const char* nB = has_next ? (const char*)Bt + nxt.boff + (size_t)nxt.pn * tstep : cB;
        if (GATHER) {
            if (has_next) { PG8_AOFF(vN, nxt); }
            else {
#pragma unroll
                for (int h = 0; h < 2; ++h)
#pragma unroll
                    for (int i = 0; i < 2; ++i) vN[h][i] = vA[h][i];
            }
        }
        for (int t = 0; t < nt; t += 2) {
            const bool last = (t == nt - 2);
            const char* a1 = cA + (size_t)(t + 1) * kstep;
            const char* a2 = last ? nA : cA + (size_t)(t + 2) * kstep; const char* b2 = last ? nB : cB + (size_t)(t + 2) * kstep;
            const char* a3 = a2 + kstep; const char* b3 = b2 + kstep;
            PG8_LDB(B0, 0, 0); PG8_SCHED; PG8_LDA(At, 0, 0); PG8_STAGE_A(PG8_SA(1, 1), a1, 1, vA);
            if (GATHER && last) {
#pragma unroll
                for (int h = 0; h < 2; ++h)
#pragma unroll
                    for (int i = 0; i < 2; ++i) vA[h][i] = vN[h][i];
            }
            PG8_WAIT_L(8); PG8_BAR; PG8_WAIT_L(0); PG8_MMA(0, 0, At, B0); PG8_BAR; PG8_SCHED;
            PG8_LDB(B1, 0, 1); PG8_STAGE(PG8_SB(0, 0), b2, voffB);
            PG8_BAR; PG8_WAIT_L(0); PG8_MMA(0, 1, At, B1); PG8_BAR;
            PG8_LDA(At, 0, 1); PG8_STAGE_A(PG8_SA(0, 0), a2, 0, vA);
            PG8_BAR; PG8_WAIT_L(0); PG8_MMA(1, 0, At, B0); PG8_BAR; PG8_SCHED;
            PG8_STAGE(PG8_SB(0, 1), b2 + hstep, voffB);
            PG8_WAIT_V(6); PG8_BAR; PG8_MMA(1, 1, At, B1); PG8_BAR;
            PG8_LDB(B0, 1, 0); PG8_SCHED; PG8_LDA(At, 1, 0); PG8_STAGE_A(PG8_SA(0, 1), a2, 1, vA);
            PG8_WAIT_L(8); PG8_BAR; PG8_WAIT_L(0); PG8_MMA(0, 0, At, B0); PG8_BAR; PG8_SCHED;
            PG8_LDB(B1, 1, 1); PG8_STAGE(PG8_SB(1, 0), b3, voffB);
            PG8_BAR; PG8_WAIT_L(0); PG8_MMA(0, 1, At, B1); PG8_BAR;
            PG8_LDA(At, 1, 1); PG8_STAGE_A(PG8_SA(1, 0), a3, 0, vA);
            PG8_BAR; PG8_WAIT_L(0); PG8_MMA(1, 0, At, B0); PG8_BAR; PG8_SCHED;
            PG8_STAGE(PG8_SB(1, 1), b3 + hstep, voffB);
            PG8_WAIT_V(6); PG8_BAR; PG8_MMA(1, 1, At, B1); PG8_BAR;
        }
        { const int t2 = TID(), l2 = t2 & 63; E(acc, cur, wr, wc, l2 & 15, l2 >> 4); }
        if (!has_next) break;
#pragma unroll
        for (int a = 0; a < 2; ++a)
#pragma unroll
            for (int b = 0; b < 2; ++b)
#pragma unroll
                for (int m = 0; m < 4; ++m)
#pragma unroll
                    for (int n = 0; n < 2; ++n) acc[a][b][m][n] = (f32x4){0.f, 0.f, 0.f, 0.f};
        cur = nxt; cA = nA; cB = nB; ++ui;
    }
    PG8_WAIT_V(0);
    if (wr == 0) PG8_BAR;
    PG8_BAR;
#undef PG8_SA
#undef PG8_SB
#undef PG8_STAGE
#undef PG8_STAGE_A
#undef PG8_LDA
#undef PG8_LDB
#undef PG8_MMA
#undef PG8_WAIT_V
#undef PG8_WAIT_L
#undef PG8_BAR
#undef PG8_SCHED
#undef PG8_AOFF
}
struct DenseOrder {
    int nM, nN, nwg, G, c;
    DI void init(int M, int N, int G_, int c_) { nM = M / BM; nN = N / BM; nwg = nM * nN; G = G_; c = c_; }
    DI bool next(int i, Unit& u) const {
        const long L = (long)i * G + c; if (L >= nwg) return false;
        int wgid = (int)L; { const int q = nwg / 8, r = nwg % 8, xcd = wgid % 8, off = wgid / 8; wgid = (xcd < r ? xcd * (q + 1) : r * (q + 1) + (xcd - r) * q) + off; }
        const int nig = 8 * nN, gid = wgid / nig, fm = gid * 8, gsz = (nM - fm) < 8 ? (nM - fm) : 8;
        u.m0 = (fm + ((wgid % nig) % gsz)) * BM; u.mrows = BM; u.pn = (wgid % nig) / gsz; u.boff = 0; return true;
    }
};
struct MoeOrder {
    const LAS int* tb; int G, c; size_t estride; int lane;
    DI bool next(int i, Unit& u) const {
        const int L = i * G + c; if (L >= __builtin_amdgcn_readfirstlane(tb[97]) * 4) return false;
        const int tile = L >> 2;
        const int pre = tb[65 + (lane & 31)];
        const unsigned long long m = __ballot(lane < 32 && pre <= tile);
        const int e = __popcll(m) - 1;
        const int lt = tile - __builtin_amdgcn_readfirstlane(tb[65 + e]); int mr = __builtin_amdgcn_readfirstlane(tb[e]) - lt * 256; mr = mr > 256 ? 256 : mr;
        u.m0 = __builtin_amdgcn_readfirstlane(tb[32 + e]) + lt * 256; u.mrows = mr; u.pn = L & 3; u.boff = (size_t)e * estride; return true;
    }
};
}
struct EpiBf16 {
    static constexpr bool PERM = true;
    bf16_t* C; int ldc; int split_col; bf16_t* C2; int ldc2;
    DI void operator()(const f32x4 (&acc)[2][2][4][2], const pg8::Unit& u, int wr, int wc, int fr, int fq) const {
        int colt = u.pn * 256; bf16_t* base = C; int ld = ldc;
        if (colt >= split_col) { base = C2; ld = ldc2; colt -= split_col; }
#pragma unroll
        for (int ai = 0; ai < 2; ++ai)
#pragma unroll
            for (int m = 0; m < 4; ++m) {
                const int rl = ai * 128 + wr * 64 + m * 16 + fr;
                if (rl < u.mrows) {
                    bf16_t* rowp = base + (size_t)(u.m0 + rl) * ld + colt + wc * 32 + 8 * fq;
#pragma unroll
                    for (int bj = 0; bj < 2; ++bj) {
                        const f32x4 v0 = acc[ai][bj][m][0], v1 = acc[ai][bj][m][1];
                        u32x4 o; o[0] = cvt_pk_bf16(v0[0], v0[1]); o[1] = cvt_pk_bf16(v0[2], v0[3]); o[2] = cvt_pk_bf16(v1[0], v1[1]); o[3] = cvt_pk_bf16(v1[2], v1[3]);
                        *(u32x4*)(rowp + bj * 128) = o;
                    }
                }
            }
    }
};
struct EpiBf16T {
    static constexpr bool PERM = false;
    bf16_t* C; int ldc;
    DI void operator()(const f32x4 (&acc)[2][2][4][2], const pg8::Unit& u, int wr, int wc, int fr, int fq) const {
#pragma unroll
        for (int ai = 0; ai < 2; ++ai)
#pragma unroll
            for (int bj = 0; bj < 2; ++bj)
#pragma unroll
                for (int m = 0; m < 4; ++m)
#pragma unroll
                    for (int n = 0; n < 2; ++n) {
                        const int row = u.m0 + ai * 128 + wr * 64 + m * 16 + fr, col = u.pn * 256 + bj * 128 + wc * 32 + n * 16 + 4 * fq;
#pragma unroll
                        for (int e = 0; e < 4; ++e) C[(size_t)(col + e) * ldc + row] = f2bf(acc[ai][bj][m][n][e]);
                    }
    }
};
struct EpiTaps {
    static constexpr bool PERM = false;
    bf16_t* FT;
    DI void operator()(const f32x4 (&acc)[2][2][4][2], const pg8::Unit& u, int wr, int wc, int fr, int fq) const {
#pragma unroll
        for (int ai = 0; ai < 2; ++ai)
#pragma unroll
            for (int m = 0; m < 4; ++m) {
                const int row = u.m0 + ai * 128 + wr * 64 + m * 16 + fr; const float dl = hy_delta(row & 1023) * (1.0f / 16383.0f);
#pragma unroll
                for (int bj = 0; bj < 2; ++bj)
#pragma unroll
                    for (int n = 0; n < 2; ++n) {
                        const int l = u.pn * 256 + bj * 128 + wc * 32 + n * 16 + 4 * fq; float o[4];
#pragma unroll
                        for (int e = 0; e < 4; ++e) o[e] = acc[ai][bj][m][n][e] * __expf(-(float)(l + e) * dl);
                        u32x2 pk; pk[0] = pk2(o[0], o[1]); pk[1] = pk2(o[2], o[3]);
                        *(u32x2*)(FT + (size_t)row * 16384 + l) = pk;
                    }
            }
    }
};
struct EpiResid {
    static constexpr bool PERM = false;
    float* xs; const float* mod; int layer; int chunk;
    DI void operator()(const f32x4 (&acc)[2][2][4][2], const pg8::Unit& u, int wr, int wc, int fr, int fq) const {
        const float* g = mod + ((size_t)(layer * 3 + modrow(u.m0)) * 6 + chunk) * 1024;
#pragma unroll
        for (int bj = 0; bj < 2; ++bj)
#pragma unroll
            for (int n = 0; n < 2; ++n) {
                const int col = u.pn * 256 + bj * 128 + wc * 32 + n * 16 + 4 * fq; const f32x4 gv = *(const f32x4*)(g + col);
                float* p0 = xs + (size_t)(u.m0 + wr * 64 + fr) * 1024 + col;
                f32x4 old[8];
#pragma unroll
                for (int ai = 0; ai < 2; ++ai)
#pragma unroll
                    for (int m = 0; m < 4; ++m) old[ai * 4 + m] = *(const f32x4*)(p0 + (size_t)(ai * 128 + m * 16) * 1024);
                asm volatile("" ::: "memory");
#pragma unroll
                for (int ai = 0; ai < 2; ++ai)
#pragma unroll
                    for (int m = 0; m < 4; ++m) *(f32x4*)(p0 + (size_t)(ai * 128 + m * 16) * 1024) = old[ai * 4 + m] + gv * acc[ai][bj][m][n];
            }
    }
};
struct EpiGateUp {
    static constexpr bool PERM = false;
    bf16_t* hid;
    DI void operator()(const f32x4 (&acc)[2][2][4][2], const pg8::Unit& u, int wr, int wc, int fr, int fq) const {
#pragma unroll
        for (int ai = 0; ai < 2; ++ai)
#pragma unroll
            for (int m = 0; m < 4; ++m) {
                const int rl = ai * 128 + wr * 64 + m * 16 + fr;
                if (rl < u.mrows) {
#pragma unroll
                    for (int bj = 0; bj < 2; ++bj) {
                        const int hc = ((u.pn * 256 + bj * 128 + wc * 32) >> 1) + 4 * fq;
                        const f32x4 g = acc[ai][bj][m][0], up = acc[ai][bj][m][1];
                        u32x2 o; o[0] = cvt_pk_bf16(siluf(g[0]) * up[0], siluf(g[1]) * up[1]); o[1] = cvt_pk_bf16(siluf(g[2]) * up[2], siluf(g[3]) * up[3]);
                        *(u32x2*)(hid + (size_t)(u.m0 + rl) * 512 + hc) = o;
                    }
                }
            }
    }
};
template <class Epi>
PF void gemm_dense(LAS unsigned char* lds, const bf16_t* A, int M, const bf16_t* Bt, int N, int K, const Epi& epi) {
    pg8::DenseOrder S; S.init(M, N, (int)gridDim.x, (int)blockIdx.x);
    pg8::gemm_phase<false>(lds, A, (const int*)nullptr, Bt, K, S, epi);
}
DI void moe_table(const KC& k, int layer, LAS int* tb) {
    const int* cnt = (const int*)(k.ws + WS_CTL + CTL_CNT) + layer * 32;
    __syncthreads();
    const int tq = TID();
    if (tq < 32) tb[tq] = __hip_atomic_load(cnt + tq, __ATOMIC_RELAXED, __HIP_MEMORY_SCOPE_AGENT);
    __syncthreads();
    if (tq == 0) {
        int s = 0, tp = 0;
        for (int e = 0; e < 32; ++e) { tb[32 + e] = s; tb[65 + e] = tp; s += tb[e]; tp += (tb[e] + 255) >> 8; }
        tb[64] = s; tb[97] = tp;
    }
    __syncthreads();
}
template <int WHICH>
PF void moe_gemm(const KC& k, int layer, LAS unsigned char* lds, LAS int* tb) {
    moe_table(k, layer, tb);
    if (WHICH == 0) {
        pg8::MoeOrder S{tb, (int)gridDim.x, (int)blockIdx.x, (size_t)1024 * 1024 * 2, TID() & 63};
        EpiGateUp epi{(bf16_t*)(k.ws + AR_HID)};
        pg8::gemm_phase<true>(lds, (const bf16_t*)(k.ws + AR_HBUF), (const int*)(k.ws + WS_SLOT), (const bf16_t*)(k.ws + AR_WGU), 1024, S, epi);
    } else {
        pg8::MoeOrder S{tb, (int)gridDim.x, (int)blockIdx.x, (size_t)1024 * 512 * 2, TID() & 63};
        EpiBf16 epi{(bf16_t*)(k.ws + AR_YS), 1024, 1 << 30, nullptr, 0};
        pg8::gemm_phase<false>(lds, (const bf16_t*)(k.ws + AR_HID), (const int*)nullptr, (const bf16_t*)(k.ws + AR_WD), 512, S, epi);
    }
}
PF void moe_scatter(const KC& k, int layer, LAS int* tb) {
    moe_table(k, layer, tb);
    const int* toke = (const int*)(k.ws + WS_TOKE);
    int* tokp = (int*)(k.ws + WS_TOKP); int* slot = (int*)(k.ws + WS_SLOT);
    int* cur = (int*)(k.ws + WS_CTL + CTL_CNT) + 128 + layer * 32;
    LAS int* lc = tb + 128; LAS int* lb = tb + 160;
    const int tid = TID();
    if (blockIdx.x == 0 && tid < 256) slot[NA + tid] = 0;
    for (int r0 = blockIdx.x * NTHR; r0 < T; r0 += gridDim.x * NTHR) {
        const int r = r0 + tid;
        __syncthreads();
        if (tid < 32) lc[tid] = 0;
        __syncthreads();
        const int e0 = toke[2 * r], e1 = toke[2 * r + 1];
        int k0 = 0, k1 = 0;
        if (e0 >= 0) { k0 = __hip_atomic_fetch_add(lc + e0, 1, __ATOMIC_RELAXED, __HIP_MEMORY_SCOPE_WORKGROUP); k1 = __hip_atomic_fetch_add(lc + e1, 1, __ATOMIC_RELAXED, __HIP_MEMORY_SCOPE_WORKGROUP); }
        __syncthreads();
        if (tid < 32) lb[tid] = lc[tid] > 0 ? atomicAdd(&cur[tid], lc[tid]) : 0;
        __syncthreads();
        if (e0 >= 0) {
            const int p0 = tb[32 + e0] + lb[e0] + k0, p1 = tb[32 + e1] + lb[e1] + k1;
            slot[p0] = r; slot[p1] = r; tokp[2 * r] = p0; tokp[2 * r + 1] = p1;
        }
    }
}

DI void unpack8(const u32x4 v, float (&f)[8]) {
#pragma unroll
    for (int w = 0; w < 4; ++w) { f[2 * w] = __uint_as_float(v[w] << 16); f[2 * w + 1] = __uint_as_float(v[w] & 0xffff0000u); }
}
PF void sc_mix(const KC& k, int j) {
    const int tid = TID(), lane = tid & 63, wave = tid >> 6;
    const bf16_t* P = (const bf16_t*)(k.ws + AR_PB);
    bf16_t* U = (bf16_t*)(k.ws + AR_UBUF);
    const float* cw = k.sc_conv + (size_t)j * 3 * 1024;
    const int c0 = lane * 16;
    float k0[16], k1[16], k2[16];
#pragma unroll
    for (int e = 0; e < 16; ++e) { k0[e] = cw[c0 + e]; k1[e] = cw[1024 + c0 + e]; k2[e] = cw[2048 + c0 + e]; }
    for (int r = blockIdx.x * 8 + wave; r < T; r += gridDim.x * 8) {
        bool lok, rok;
        if (r < TC) { const int t = r & 255; lok = t != 0; rok = t != 255; } else { const int t = (r - TC) & 63; lok = t != 0; rok = t != 63; }
        const bf16_t* p = P + (size_t)r * 3072 + c0;
        const bf16_t* pl = lok ? p - 3072 : p; const bf16_t* pr = rok ? p + 3072 : p;
        u32x4 vb[2], vc[2], vx[2], vcl[2], vxl[2], vcr[2], vxr[2];
#pragma unroll
        for (int hh = 0; hh < 2; ++hh) {
            vb[hh] = *(const u32x4*)(p + hh * 8); vc[hh] = *(const u32x4*)(p + 1024 + hh * 8); vx[hh] = *(const u32x4*)(p + 2048 + hh * 8);
            vcl[hh] = *(const u32x4*)(pl + 1024 + hh * 8); vxl[hh] = *(const u32x4*)(pl + 2048 + hh * 8);
            vcr[hh] = *(const u32x4*)(pr + 1024 + hh * 8); vxr[hh] = *(const u32x4*)(pr + 2048 + hh * 8);
        }
        asm volatile("" ::: "memory");
        const float fl = lok ? 1.f : 0.f, frr = rok ? 1.f : 0.f;
#pragma unroll
        for (int hh = 0; hh < 2; ++hh) {
            float bg[8], cg[8], xi[8], cl[8], xl[8], cr[8], xr[8];
            unpack8(vb[hh], bg); unpack8(vc[hh], cg); unpack8(vx[hh], xi); unpack8(vcl[hh], cl); unpack8(vxl[hh], xl); unpack8(vcr[hh], cr); unpack8(vxr[hh], xr);
            u32x4 o;
#pragma unroll
            for (int w = 0; w < 4; ++w) {
                float ov[2];
#pragma unroll
                for (int e = 0; e < 2; ++e) { const int i = 2 * w + e, c = hh * 8 + i; ov[e] = bg[i] * (k0[c] * fl * cl[i] * xl[i] + k1[c] * cg[i] * xi[i] + k2[c] * frr * cr[i] * xr[i]); }
                o[w] = pk2(ov[0], ov[1]);
            }
            *(u32x4*)(U + (size_t)r * 1024 + c0 + hh * 8) = o;
        }
    }
}

constexpr int DN_STEPS = 260, DN_UNITS = 32 * DN_STEPS;
DI int dn_rbase(int b, int dir, int s) {
    if (s < 4) return dir == 0 ? b * 256 + s * 64 : b * 256 + 255 - s * 64;
    const int cc = s - 4;
    return dir == 0 ? TC + b * SEQ + cc * 64 : TC + b * SEQ + SEQ - 1 - cc * 64;
}
struct DnRaw { u32x4 c[3][2], l[3][2], r[3][2]; float g, be; };
DI void dn_raw_load(const bf16_t* P, const float* gb, int u, int tid, DnRaw& R) {
    const int chain = u / DN_STEPS, s = u - chain * DN_STEPS, dir = chain & 1, h = (chain >> 1) & 7, b = chain >> 4;
    const int rbase = dn_rbase(b, dir, s), rstep = dir == 0 ? 1 : -1;
    const int i = tid >> 3, sg = tid & 7, r = rbase + rstep * i;
    bool lok, rok;
    if (r < TC) { const int t = r & 255; lok = t != 0; rok = t != 255; } else { const int t = (r - TC) & 63; lok = t != 0; rok = t != 63; }
#pragma unroll
    for (int part = 0; part < 3; ++part) {
        const bf16_t* pc = P + (size_t)r * 3072 + part * 1024 + h * 128 + sg * 16;
#pragma unroll
        for (int hf = 0; hf < 2; ++hf) {
            R.c[part][hf] = *(const u32x4*)(pc + hf * 8);
            R.l[part][hf] = (u32x4){0u, 0u, 0u, 0u}; R.r[part][hf] = (u32x4){0u, 0u, 0u, 0u};
            if (lok) R.l[part][hf] = *(const u32x4*)(pc - 3072 + hf * 8);
            if (rok) R.r[part][hf] = *(const u32x4*)(pc + 3072 + hf * 8);
        }
    }
    if (tid < 64) { const size_t row = (size_t)(rbase + rstep * tid); R.g = gb[row * 32 + dir * 8 + h]; R.be = gb[row * 32 + 16 + dir * 8 + h]; }
}
PF void dn_chunk(const KC& k, int jl, LAS unsigned char* lds) {
    const int tid = TID(), lane = tid & 63, wave = tid >> 6, fr = lane & 15, fq = lane >> 4;
    LAS bf16_t* Kt = (LAS bf16_t*)lds;
    LAS bf16_t* Qt = Kt + 64 * 136;
    LAS bf16_t* Vt = Qt + 64 * 136;
    LAS float* Amat = (LAS float*)(Vt + 64 * 136);
    LAS bf16_t* Tb = (LAS bf16_t*)(Amat + 64 * 64);
    LAS bf16_t* VbT = Tb + 64 * 72;
    LAS bf16_t* KbT = VbT + 128 * 72;
    LAS float* gcs = (LAS float*)(KbT + 128 * 72);
    LAS float* bet = gcs + 64; LAS float* eg = bet + 64; LAS float* egr = eg + 64;
    LAS float* Tm = egr + 64;
    LAS float* Wc = Tm + 64 * 64;
    const bf16_t* P = (const bf16_t*)(k.ws + AR_PB);
    const float* gb = (const float*)(k.ws + WS_GB);
    const float* cw = k.dn_conv + (size_t)jl * 3 * 3072;
    bf16_t* CH = (bf16_t*)(k.ws + AR_CHUNK);
    bf16_t* ATT = (bf16_t*)(k.ws + AR_HBUF);
    float* EGL = (float*)(k.ws + WS_EGL);
    for (int u = blockIdx.x; u < DN_UNITS; u += gridDim.x) {
        DnRaw Rn; dn_raw_load(P, gb, u, tid, Rn);
        const int chain = u / DN_STEPS, s = u - chain * DN_STEPS, dir = chain & 1, h = (chain >> 1) & 7, b = chain >> 4;
        const int wti = tid < 288 ? tid : 0, wtap = wti / 96, wrem = wti - wtap * 96;
        const f32x4 wcv = *(const f32x4*)(cw + wtap * 3072 + (wrem >> 5) * 1024 + h * 128 + (wrem & 31) * 4);
        const int rbase = dn_rbase(b, dir, s), rstep = dir == 0 ? 1 : -1;
        bf16_t* cW = CH + (size_t)u * 32768; bf16_t* cQd = cW + 8192; bf16_t* cKd = cQd + 8192; bf16_t* cU = cKd + 8192;
        bf16_t* cAt = ATT + (size_t)u * 4096;
        lds_barrier();
        if (tid < 288) *(LAS f32x4*)(Wc + wtap * 384 + wrem * 4) = wcv;
        lds_barrier();
        const float g_in = Rn.g, be_in = Rn.be;
        {
            const int i = tid >> 3, sg = tid & 7;
#pragma unroll
            for (int part = 0; part < 3; ++part) {
                const int col = part * 1024 + h * 128 + sg * 16;
                float v[16];
#pragma unroll
                for (int hf = 0; hf < 2; ++hf) {
                    const u32x4 c4 = Rn.c[part][hf], l4 = Rn.l[part][hf], r4 = Rn.r[part][hf];
#pragma unroll
                    for (int w2 = 0; w2 < 2; ++w2) {
                        const LAS float* wp = Wc + part * 128 + sg * 16 + hf * 8 + 4 * w2;
                        const f32x4 k0 = *(const LAS f32x4*)wp, k1 = *(const LAS f32x4*)(wp + 384), k2 = *(const LAS f32x4*)(wp + 768);
#pragma unroll
                        for (int e = 0; e < 4; ++e) {
                            const int w = 2 * w2 + (e >> 1);
                            const float lv = __uint_as_float((e & 1) ? (l4[w] & 0xffff0000u) : (l4[w] << 16));
                            const float cv = __uint_as_float((e & 1) ? (c4[w] & 0xffff0000u) : (c4[w] << 16));
                            const float rv = __uint_as_float((e & 1) ? (r4[w] & 0xffff0000u) : (r4[w] << 16));
                            v[hf * 8 + 4 * w2 + e] = siluf(k0[e] * lv + k1[e] * cv + k2[e] * rv);
                        }
                    }
                }
                if (part < 2) {
                    float ss = 0.f;
#pragma unroll
                    for (int e = 0; e < 16; ++e) ss += v[e] * v[e];
                    ss += shx(ss, 1, lane); ss += shx(ss, 2, lane); ss += shx(ss, 4, lane);
                    const float sc = rsqrtf(ss + EPS) * (part == 0 ? 0.08838834764831845f : 1.0f);
#pragma unroll
                    for (int e = 0; e < 16; ++e) v[e] *= sc;
                }
                LAS bf16_t* dst = (part == 0 ? Qt : (part == 1 ? Kt : Vt)) + i * 136 + sg * 16;
                u32x4 o0, o1;
#pragma unroll
                for (int w = 0; w < 4; ++w) { o0[w] = pk2(v[2 * w], v[2 * w + 1]); o1[w] = pk2(v[8 + 2 * w], v[8 + 2 * w + 1]); }
                *(LAS u32x4*)dst = o0; *(LAS u32x4*)(dst + 8) = o1;
            }
        }
        if (wave == 0) {
            float g = g_in;
            const float be = be_in;
#pragma unroll
            for (int d = 1; d < 64; d <<= 1) { const float o = shi(g, (lane - d) & 63); if (lane >= d) g += o; }
            const float glast = shi(g, 63);
            gcs[lane] = g; bet[lane] = be; eg[lane] = expf(g); egr[lane] = expf(glast - g);
            if (lane == 0) EGL[u] = expf(glast);
        }
        lds_barrier();
#pragma unroll 1
        for (int x = 0; x < 4; ++x) {
            const int t = wave + 8 * x, isq = t >> 4, mt = (t >> 2) & 3, nt = t & 3;
            f32x4 acc = (f32x4){0.f, 0.f, 0.f, 0.f};
            const int jc = 16 * nt + fr;
            float gi4[4], bi4[4];
            const float gj = gcs[jc];
#pragma unroll
            for (int jj = 0; jj < 4; ++jj) { gi4[jj] = gcs[16 * mt + 4 * fq + jj]; bi4[jj] = bet[16 * mt + 4 * fq + jj]; }
            if (mt >= nt) {
                const LAS bf16_t* Ar = (isq ? Qt : Kt) + (16 * mt + fr) * 136 + 8 * fq;
                const LAS bf16_t* Br = Kt + (16 * nt + fr) * 136 + 8 * fq;
                bf16x8 fa4[4], fb4[4];
#pragma unroll
                for (int ks = 0; ks < 4; ++ks) { fa4[ks] = *(const LAS bf16x8*)(Ar + 32 * ks); fb4[ks] = *(const LAS bf16x8*)(Br + 32 * ks); }
                asm volatile("" ::: "memory");
#pragma unroll
                for (int ks = 0; ks < 4; ++ks) acc = __builtin_amdgcn_mfma_f32_16x16x32_bf16(fa4[ks], fb4[ks], acc, 0, 0, 0);
            }
#pragma unroll
            for (int jj = 0; jj < 4; ++jj) {
                const int ir = 16 * mt + 4 * fq + jj;
                const float dec = __expf(fminf(gi4[jj] - gj, 0.f));
                if (isq) cAt[((mt * 2 + (nt >> 1)) * 64 + (fr >> 2) * 16 + 4 * fq + jj) * 8 + (nt & 1) * 4 + (fr & 3)] = f2bf(ir >= jc ? acc[jj] * dec : 0.f);
                else Amat[ir * 64 + jc] = ir > jc ? bi4[jj] * acc[jj] * dec : 0.f;
            }
        }
        {
            const int un = u + (int)gridDim.x < DN_UNITS ? u + (int)gridDim.x : u;
            const int chn = un / DN_STEPS, stn = un - chn * DN_STEPS, dirn = chn & 1, hn = (chn >> 1) & 7, bn = chn >> 4;
            const int rbn = dn_rbase(bn, dirn, stn), rsn = dirn == 0 ? 1 : -1;
            const unsigned char* pa;
            if (tid < 396) { const int seg = tid >> 1, ri = seg / 3, part = seg - 3 * ri; int r = rbn + rsn * (ri - 1); r = r < 0 ? 0 : r > T - 1 ? T - 1 : r;
                             pa = (const unsigned char*)(P + (size_t)r * 3072 + part * 1024 + hn * 128 + (tid & 1) * 64); }
            else { const int j = tid < 460 ? tid - 396 : 0; pa = (const unsigned char*)(gb + (size_t)(rbn + rsn * j) * 32); }
            __builtin_amdgcn_global_load_lds((const unsigned*)pa, (LAS unsigned*)(lds + 143360), 4, 0, 0);
        }
        lds_barrier();
        {
        if (wave < 4) {
            if (lane < 16) {
                const int bo = 16 * wave;
                float tc[16];
#pragma unroll
                for (int i = 0; i < 16; ++i) {
                    f32x4 ar[4];
#pragma unroll
                    for (int q = 0; q < (i + 3) / 4; ++q) ar[q] = *(const LAS f32x4*)(Amat + (bo + i) * 64 + bo + 4 * q);
                    float a0 = (i == lane) ? 1.f : 0.f, a1 = 0.f;
#pragma unroll
                    for (int j = 0; j < i; ++j) { const float av = ar[j >> 2][j & 3]; if (j & 1) a1 -= av * tc[j]; else a0 -= av * tc[j]; }
                    tc[i] = a0 + a1;
                    Tm[(bo + i) * 64 + bo + lane] = tc[i];
                }
            }
        } else {
            for (int it = tid - 256; it < 1024; it += 256) {
                const int c = it & 127, ig = it >> 7;
                float kv[8], vv[8];
                { bf16_t kr[8], vr[8];
#pragma unroll
                  for (int e = 0; e < 8; ++e) { kr[e] = Kt[(8 * ig + e) * 136 + c]; vr[e] = Vt[(8 * ig + e) * 136 + c]; }
                  asm volatile("" ::: "memory");
#pragma unroll
                  for (int e = 0; e < 8; ++e) { kv[e] = bf2f(kr[e]); vv[e] = bf2f(vr[e]); } }
                u32x4 ov, ok, od;
#pragma unroll
                for (int w = 0; w < 4; ++w) {
                    const int i0 = 8 * ig + 2 * w, i1 = i0 + 1;
                    ov[w] = pk2(bet[i0] * vv[2 * w], bet[i1] * vv[2 * w + 1]);
                    ok[w] = pk2(bet[i0] * eg[i0] * kv[2 * w], bet[i1] * eg[i1] * kv[2 * w + 1]);
                    od[w] = pk2(egr[i0] * kv[2 * w], egr[i1] * kv[2 * w + 1]);
                }
                *(LAS u32x4*)(VbT + c * 72 + 8 * ig) = ov;
                *(LAS u32x4*)(KbT + c * 72 + 8 * ig) = ok;
                { bf16_t* kd0 = cKd + (((c >> 4) * 2 + (ig >> 2)) * 64 + (2 * (ig & 1)) * 16 + (c & 15)) * 8 + ((ig & 3) >> 1) * 4;
                  *(u32x2*)kd0 = (u32x2){od[0], od[1]}; *(u32x2*)(kd0 + 128) = (u32x2){od[2], od[3]}; }
            }
            for (int it = tid - 256; it < 1024; it += 256) {
                const int i = it >> 4, c8 = (it & 15) * 8; const float e = eg[i];
                const u32x4 qv = *(const LAS u32x4*)(Qt + i * 136 + c8); u32x4 o;
#pragma unroll
                for (int w = 0; w < 4; ++w) o[w] = pk2(__uint_as_float(qv[w] << 16) * e, __uint_as_float(qv[w] & 0xffff0000u) * e);
                { const int k8 = it & 15; bf16_t* qd0 = cQd + (((i >> 4) * 4 + (k8 >> 2)) * 64 + (2 * (k8 & 1)) * 16 + (i & 15)) * 8 + ((k8 & 3) >> 1) * 4;
                  *(u32x2*)qd0 = (u32x2){o[0], o[1]}; *(u32x2*)(qd0 + 128) = (u32x2){o[2], o[3]}; }
            }
        }
        lds_barrier();
#pragma unroll 1
        for (int d = 1; d < 4; ++d) {
            if (wave < 4 - d) {
                const int bi = wave + d, bj = wave, r = lane >> 2, c0 = 4 * (lane & 3);
                f32x4 m = (f32x4){0.f, 0.f, 0.f, 0.f};
                for (int kb = bj; kb < bi; ++kb) {
                    f32x4 av4[4], tv[16];
#pragma unroll
                    for (int q = 0; q < 4; ++q) av4[q] = *(const LAS f32x4*)(Amat + (16 * bi + r) * 64 + 16 * kb + 4 * q);
#pragma unroll
                    for (int kk = 0; kk < 16; ++kk) tv[kk] = *(const LAS f32x4*)(Tm + (16 * kb + kk) * 64 + 16 * bj + c0);
                    asm volatile("" ::: "memory");
#pragma unroll
                    for (int kk = 0; kk < 16; ++kk) m += tv[kk] * av4[kk >> 2][kk & 3];
                }
                *(LAS f32x4*)(Tm + (16 * bj + r) * 64 + 16 * bi + c0) = m;
                f32x4 t = (f32x4){0.f, 0.f, 0.f, 0.f};
                {
                    f32x4 dv4[4], mv[16];
#pragma unroll
                    for (int q = 0; q < 4; ++q) dv4[q] = *(const LAS f32x4*)(Tm + (16 * bi + r) * 64 + 16 * bi + 4 * q);
#pragma unroll
                    for (int kk = 0; kk < 16; ++kk) mv[kk] = *(const LAS f32x4*)(Tm + (16 * bj + kk) * 64 + 16 * bi + c0);
                    asm volatile("" ::: "memory");
#pragma unroll
                    for (int kk = 0; kk < 16; ++kk) t -= mv[kk] * dv4[kk >> 2][kk & 3];
                }
                *(LAS f32x4*)(Tm + (16 * bi + r) * 64 + 16 * bj + c0) = t;
            }
            lds_barrier();
        }
        for (int it = tid; it < 64 * 8; it += NTHR) {
            const int i = it >> 3, c8 = (it & 7) * 8; u32x4 o;
#pragma unroll
            for (int w = 0; w < 4; ++w) {
                const int c = c8 + 2 * w;
                o[w] = pk2(c <= i ? Tm[i * 64 + c] : 0.f, c + 1 <= i ? Tm[i * 64 + c + 1] : 0.f);
            }
            *(LAS u32x4*)(Tb + i * 72 + c8) = o;
        }
        }
        lds_barrier();
        {
            f32x4 au[4], aw[4];
#pragma unroll
            for (int mt = 0; mt < 4; ++mt) { au[mt] = (f32x4){0.f, 0.f, 0.f, 0.f}; aw[mt] = (f32x4){0.f, 0.f, 0.f, 0.f}; }
            bf16x8 bv[2], bk[2], at[2][4];
#pragma unroll
            for (int ks = 0; ks < 2; ++ks) {
                bv[ks] = *(const LAS bf16x8*)(VbT + (16 * wave + fr) * 72 + 32 * ks + 8 * fq);
                bk[ks] = *(const LAS bf16x8*)(KbT + (16 * wave + fr) * 72 + 32 * ks + 8 * fq);
#pragma unroll
                for (int mt = 0; mt < 4; ++mt) at[ks][mt] = *(const LAS bf16x8*)(Tb + (16 * mt + fr) * 72 + 32 * ks + 8 * fq);
            }
            asm volatile("" ::: "memory");
#pragma unroll
            for (int ks = 0; ks < 2; ++ks)
#pragma unroll
                for (int mt = 0; mt < 4; ++mt) {
                    au[mt] = __builtin_amdgcn_mfma_f32_16x16x32_bf16(at[ks][mt], bv[ks], au[mt], 0, 0, 0);
                    aw[mt] = __builtin_amdgcn_mfma_f32_16x16x32_bf16(at[ks][mt], bk[ks], aw[mt], 0, 0, 0);
                }
#pragma unroll
            for (int mt = 0; mt < 4; ++mt)
#pragma unroll
                for (int jj = 0; jj < 4; ++jj)
                    cW[((mt * 4 + (wave >> 1)) * 64 + (fr >> 2) * 16 + 4 * fq + jj) * 8 + (wave & 1) * 4 + (fr & 3)] = f2bf(aw[mt][jj]);
            {
                u32x4 u0, u1;
                u0[0] = pk2(au[0][0], au[0][1]); u0[1] = pk2(au[0][2], au[0][3]); u0[2] = pk2(au[1][0], au[1][1]); u0[3] = pk2(au[1][2], au[1][3]);
                u1[0] = pk2(au[2][0], au[2][1]); u1[1] = pk2(au[2][2], au[2][3]); u1[2] = pk2(au[3][0], au[3][1]); u1[3] = pk2(au[3][2], au[3][3]);
                bf16_t* ud = cU + (wave * 64 + lane) * 16;
                *(u32x4*)ud = u0; *(u32x4*)(ud + 8) = u1;
            }
        }
    }
}
DI bf16x8 pk8(f32x4 a, f32x4 b) { u32x4 r; r[0] = pk2(a[0], a[1]); r[1] = pk2(a[2], a[3]); r[2] = pk2(b[0], b[1]); r[3] = pk2(b[2], b[3]); return __builtin_bit_cast(bf16x8, r); }
constexpr int SC_PFD = 3;
DI bf16x8 ldfrag(const bf16_t* p) { return __builtin_bit_cast(bf16x8, *(const u32x4*)p); }
PF void dn_scan(const KC& k, LAS unsigned char* lds, int pm) {
    const int tid = TID(), lane = tid & 63, fr = lane & 15, fq = lane >> 4;
    const int wave = __builtin_amdgcn_readfirstlane(tid >> 6);
    const bf16_t* CH = (const bf16_t*)(k.ws + AR_CHUNK);
    const bf16_t* ATT = (const bf16_t*)(k.ws + AR_HBUF);
    const float* EGL = (const float*)(k.ws + WS_EGL);
    bf16_t* O = (bf16_t*)(k.ws + (pm ? AR_UBUF : AR_PB));
    LAS float* eglL = (LAS float*)lds;
    LAS u32x4* sbx = (LAS u32x4*)(eglL + 272);
    LAS u32x4* vbx = sbx + 512;
    volatile LAS int* vflag = (volatile LAS int*)(vbx + 256);
    for (int un0 = blockIdx.x; un0 < 256; un0 += gridDim.x) {
        if ((pm == 2 && ((un0 >> 3) & 1)) || (pm == 3 && (un0 & 1))) continue;
        const int un = (gridDim.x == 256) ? ((un0 & 7) * 32 + (un0 >> 3)) : un0;
        const int sl = un & 7, chain = un >> 3, dir = chain & 1, h = (chain >> 1) & 7, b = chain >> 4;
        const int rstep = dir == 0 ? 1 : -1;
        const bf16_t* U0 = CH + (size_t)(chain * DN_STEPS) * 32768 + lane * 8;
        const bf16_t* A0 = ATT + (size_t)(chain * DN_STEPS) * 4096 + lane * 8;
        lds_barrier();
        if (tid < DN_STEPS) eglL[tid] = EGL[chain * DN_STEPS + tid];
        if (tid == 0) *vflag = 0;
        if (wave == 0) {
            f32x4 S[8];
#pragma unroll
            for (int t = 0; t < 8; ++t) S[t] = (f32x4){0.f, 0.f, 0.f, 0.f};
            bf16x8 fw[16], fk[16]; u32x4 uc[2];
#pragma unroll
            for (int i = 0; i < 16; ++i) { fw[i] = ldfrag(U0 + i * 512); fk[i] = ldfrag(U0 + 16384 + i * 512); }
            { const bf16_t* up = U0 - lane * 8 + 24576 + (sl * 64 + lane) * 16; uc[0] = *(const u32x4*)up; uc[1] = *(const u32x4*)(up + 8); }
#pragma unroll
            for (int ks = 0; ks < 4; ++ks) sbx[ks * 64 + lane] = (u32x4){0u, 0u, 0u, 0u};
#pragma unroll
            for (int i = 0; i < 16; ++i) { asm volatile("" :: "v"(__builtin_bit_cast(u32x4, fw[i]))); asm volatile("" :: "v"(__builtin_bit_cast(u32x4, fk[i]))); }
            asm volatile("" :: "v"(uc[0]), "v"(uc[1]));
            lds_barrier();
#pragma unroll 1
            for (int s = 0; s < DN_STEPS; ++s) {
                const int sn = pm == 1 ? 0 : s + 1 < DN_STEPS ? s + 1 : s;
                const bf16_t* Un = U0 + (size_t)sn * 32768;
                const float egl = eglL[s];
                bf16x8 sb[4];
#pragma unroll
                for (int ks = 0; ks < 4; ++ks) sb[ks] = pk8(S[2 * ks], S[2 * ks + 1]);
                f32x4 p[4];
#pragma unroll
                for (int mt = 0; mt < 4; ++mt) p[mt] = (f32x4){0.f, 0.f, 0.f, 0.f};
#pragma unroll
                for (int ks = 0; ks < 4; ++ks)
#pragma unroll
                    for (int mt = 0; mt < 4; ++mt) {
                        p[mt] = __builtin_amdgcn_mfma_f32_16x16x32_bf16(fw[mt * 4 + ks], sb[ks], p[mt], 0, 0, 0);
                        fw[mt * 4 + ks] = ldfrag(Un + (mt * 4 + ks) * 512);
                    }
#pragma unroll
                for (int mt = 0; mt < 4; ++mt) {
                    const unsigned ua = uc[mt >> 1][(mt & 1) * 2], ub = uc[mt >> 1][(mt & 1) * 2 + 1];
                    p[mt][0] = __uint_as_float(ua << 16) - p[mt][0]; p[mt][1] = __uint_as_float(ua & 0xffff0000u) - p[mt][1];
                    p[mt][2] = __uint_as_float(ub << 16) - p[mt][2]; p[mt][3] = __uint_as_float(ub & 0xffff0000u) - p[mt][3];
                }
                { const bf16_t* up = Un - lane * 8 + 24576 + (sl * 64 + lane) * 16; uc[0] = *(const u32x4*)up; uc[1] = *(const u32x4*)(up + 8); }
                bf16x8 vb[2];
                vb[0] = pk8(p[0], p[1]); vb[1] = pk8(p[2], p[3]);
                vbx[(s & 1) * 64 + lane] = __builtin_bit_cast(u32x4, vb[0]); vbx[(s & 1) * 64 + 128 + lane] = __builtin_bit_cast(u32x4, vb[1]);
                asm volatile("s_waitcnt lgkmcnt(0)" ::: "memory");
                if (lane == 0) *vflag = s + 1;
#pragma unroll
                for (int t = 0; t < 8; ++t) S[t] = S[t] * egl;
#pragma unroll
                for (int kc = 0; kc < 2; ++kc)
#pragma unroll
                    for (int t = 0; t < 8; ++t) {
                        S[t] = __builtin_amdgcn_mfma_f32_16x16x32_bf16(fk[t * 2 + kc], vb[kc], S[t], 0, 0, 0);
                        fk[t * 2 + kc] = ldfrag(Un + 16384 + (t * 2 + kc) * 512);
                    }
#pragma unroll
                for (int ks = 0; ks < 4; ++ks) sbx[((s + 1) & 1) * 256 + ks * 64 + lane] = __builtin_bit_cast(u32x4, pk8(S[2 * ks], S[2 * ks + 1]));
                lds_barrier();
            }
        } else if (wave == 1) {
            bf16x8 fqd[16], fat[8];
#pragma unroll
            for (int i = 0; i < 16; ++i) fqd[i] = ldfrag(U0 + 8192 + i * 512);
#pragma unroll
            for (int i = 0; i < 8; ++i) fat[i] = ldfrag(A0 + i * 512);
#pragma unroll
            for (int i = 0; i < 16; ++i) asm volatile("" :: "v"(__builtin_bit_cast(u32x4, fqd[i])));
#pragma unroll
            for (int i = 0; i < 8; ++i) asm volatile("" :: "v"(__builtin_bit_cast(u32x4, fat[i])));
            f32x4 op[4];
#pragma unroll
            for (int mt = 0; mt < 4; ++mt) op[mt] = (f32x4){0.f, 0.f, 0.f, 0.f};
            lds_barrier();
#pragma unroll 1
            for (int s = 0; s < DN_STEPS; ++s) {
                const int sn = pm == 1 ? 0 : s + 1 < DN_STEPS ? s + 1 : s;
                const bf16_t* Un = U0 + (size_t)sn * 32768; const bf16_t* An = A0 + (size_t)sn * 4096;
                bf16x8 sb[4];
#pragma unroll
                for (int ks = 0; ks < 4; ++ks) sb[ks] = __builtin_bit_cast(bf16x8, sbx[(s & 1) * 256 + ks * 64 + lane]);
                {
                    const int sp = s > 0 ? s - 1 : 0; const int rbase = dn_rbase(b, dir, sp);
#pragma unroll
                    for (int mt = 0; mt < 4; ++mt)
#pragma unroll
                        for (int jj = 0; jj < 4; ++jj) {
                            const int row = rbase + rstep * (16 * mt + 4 * fq + jj);
                            O[((size_t)(pm ? 0 : dir) * T + row) * 1024 + h * 128 + sl * 16 + fr] = f2bf(op[mt][jj]);
                        }
                }
                f32x4 o[4];
#pragma unroll
                for (int mt = 0; mt < 4; ++mt) o[mt] = (f32x4){0.f, 0.f, 0.f, 0.f};
#pragma unroll
                for (int ks = 0; ks < 4; ++ks)
#pragma unroll
                    for (int mt = 0; mt < 4; ++mt) {
                        o[mt] = __builtin_amdgcn_mfma_f32_16x16x32_bf16(fqd[mt * 4 + ks], sb[ks], o[mt], 0, 0, 0);
                        fqd[mt * 4 + ks] = ldfrag(Un + 8192 + (mt * 4 + ks) * 512);
                    }
                while (*vflag < s + 1) __builtin_amdgcn_s_sleep(1);
                asm volatile("" ::: "memory");
                bf16x8 vb[2];
                vb[0] = __builtin_bit_cast(bf16x8, vbx[(s & 1) * 64 + lane]); vb[1] = __builtin_bit_cast(bf16x8, vbx[(s & 1) * 64 + 128 + lane]);
#pragma unroll
                for (int kc = 0; kc < 2; ++kc)
#pragma unroll
                    for (int mt = 0; mt < 4; ++mt) {
                        o[mt] = __builtin_amdgcn_mfma_f32_16x16x32_bf16(fat[mt * 2 + kc], vb[kc], o[mt], 0, 0, 0);
                        fat[mt * 2 + kc] = ldfrag(An + (mt * 2 + kc) * 512);
                    }
#pragma unroll
                for (int mt = 0; mt < 4; ++mt) op[mt] = o[mt];
                lds_barrier();
            }
            {
                const int rbase = dn_rbase(b, dir, DN_STEPS - 1);
#pragma unroll
                for (int mt = 0; mt < 4; ++mt)
#pragma unroll
                    for (int jj = 0; jj < 4; ++jj) {
                        const int row = rbase + rstep * (16 * mt + 4 * fq + jj);
                        O[((size_t)(pm ? 0 : dir) * T + row) * 1024 + h * 128 + sl * 16 + fr] = f2bf(op[mt][jj]);
                    }
            }
        } else if (wave == 2) {
            const unsigned char* P0 = (const unsigned char*)(CH + (size_t)(chain * DN_STEPS) * 32768 + sl * 4096) + lane * 64;
            const unsigned char* Q0 = (const unsigned char*)(ATT + (size_t)(chain * DN_STEPS) * 4096 + sl * 512) + (lane & 15) * 64;
            unsigned d0 = 0u, d1 = 0u, d2 = 0u;
            lds_barrier();
#pragma unroll 1
            for (int s = 0; s < DN_STEPS; ++s) {
                const int sp = pm == 1 ? 0 : s + SC_PFD < DN_STEPS ? s + SC_PFD : DN_STEPS - 1;
                const unsigned char* pa = P0 + (size_t)sp * 65536; const unsigned char* pb = pa + 4096; const unsigned char* qa = Q0 + (size_t)sp * 8192;
                asm volatile("global_load_dword %0, %3, off\n\tglobal_load_dword %1, %4, off\n\tglobal_load_dword %2, %5, off"
                             : "+v"(d0), "+v"(d1), "+v"(d2) : "v"(pa), "v"(pb), "v"(qa) : "memory");
                lds_barrier();
            }
            asm volatile("s_waitcnt vmcnt(0)" : "+v"(d0), "+v"(d1), "+v"(d2) :: "memory");
        } else {
            lds_barrier();
#pragma unroll 1
            for (int s = 0; s < DN_STEPS; ++s) lds_barrier();
        }
    }
}
PF void dn_finish(const KC& k, int j) {
    const int tid = TID(), lane = tid & 63, wave = tid >> 6;
    const bf16_t* O = (const bf16_t*)(k.ws + AR_PB);
    const bf16_t* Z = (const bf16_t*)k.out;
    bf16_t* U = (bf16_t*)(k.ws + AR_UBUF);
    const float* on = k.dn_out_norm + j * 128;
    const int c0 = lane * 16;
    float onv[16];
#pragma unroll
    for (int e = 0; e < 16; ++e) onv[e] = on[(c0 + e) & 127];
    for (int r = blockIdx.x * 8 + wave; r < T; r += gridDim.x * 8) {
        u32x4 vf[2], vb[2], vz[2];
#pragma unroll
        for (int hh = 0; hh < 2; ++hh) {
            vf[hh] = *(const u32x4*)(O + (size_t)r * 1024 + c0 + hh * 8); vb[hh] = *(const u32x4*)(O + ((size_t)T + r) * 1024 + c0 + hh * 8);
            vz[hh] = *(const u32x4*)(Z + (size_t)r * 1024 + c0 + hh * 8);
        }
        asm volatile("" ::: "memory");
        float o[16], z[16];
#pragma unroll
        for (int hh = 0; hh < 2; ++hh) { float a[8], b2[8], zz[8]; unpack8(vf[hh], a); unpack8(vb[hh], b2); unpack8(vz[hh], zz);
#pragma unroll
            for (int i = 0; i < 8; ++i) { o[hh * 8 + i] = a[i] + b2[i]; z[hh * 8 + i] = zz[i]; } }
        float ss = 0.f;
#pragma unroll
        for (int e = 0; e < 16; ++e) ss += o[e] * o[e];
        ss += shx(ss, 1, lane); ss += shx(ss, 2, lane); ss += shx(ss, 4, lane);
        const float rs = rsqrtf(ss * (1.0f / 128.0f) + EPS);
#pragma unroll
        for (int hh = 0; hh < 2; ++hh) { u32x4 ov;
#pragma unroll
            for (int w = 0; w < 4; ++w) { const int e0 = hh * 8 + 2 * w; ov[w] = pk2(o[e0] * rs * onv[e0] * siluf(z[e0]), o[e0 + 1] * rs * onv[e0 + 1] * siluf(z[e0 + 1])); }
            *(u32x4*)(U + (size_t)r * 1024 + c0 + hh * 8) = ov; }
    }
}

DI float conv3g(const bf16_t* p, int j, float w0, float w1, float w2) {
    const int gc = j & 63;
    const float l = gc != 0 ? bf2f(p[j - 1]) : 0.f, c = bf2f(p[j]), r = gc != 63 ? bf2f(p[j + 1]) : 0.f;
    return w0 * l + w1 * c + w2 * r;
}
DI float hy_conv_lane(float c, float w0, float w1, float w2, int lane) {
    const float l = shi(c, (lane + 63) & 63), r = shi(c, (lane + 1) & 63);
    return w0 * (lane > 0 ? l : 0.f) + w1 * c + w2 * (lane < 63 ? r : 0.f);
}
PF void hy_lat(const KC& k, int jl, LAS float* ldsf) {
    const int tid = TID();
    LAS cf* X = (LAS cf*)ldsf;
    LAS cf* tw = X + 17408;
    LAS cf* tA = tw + 1024; LAS cf* tB = tA + 128;
    const bf16_t* FT = (const bf16_t*)(k.ws + AR_FT);
    const bf16_t* PT = (const bf16_t*)(k.ws + AR_PB);
    bf16_t* ZT = (bf16_t*)(k.ws + AR_ZT);
    unsigned* scr = (unsigned*)(k.ws + AR_FFTS) + (size_t)blockIdx.x * 4 * 16384;
    unsigned* sKe = scr; unsigned* sKo = scr + 16384; unsigned* zp = scr + 2 * 16384; unsigned* ye = scr + 3 * 16384;
#define CPK(v) pk2((v).x, (v).y)
#define CUP(u_) ((cf){__uint_as_float((u_) << 16), __uint_as_float((u_) & 0xffff0000u)})
    const float* cw = k.hy_conv + (size_t)jl * 3 * 3072;
    for (int m = 0; m < 2; ++m) { const int p = tid + 512 * m; float sn, cs; sincospif(-(float)p / 8192.0f, &sn, &cs); cf w; w.x = cs; w.y = sn; tw[p] = w; }
    if (tid < 256) { const int a = tid & 127; float sn, cs; sincospif(-(float)(tid < 128 ? 128 * a : a) / 16384.0f, &sn, &cs); cf w; w.x = cs; w.y = sn; (tid < 128 ? tA : tB)[a] = w; }
    __syncthreads();
    const int lane = tid & 63;
#define HY_SPLIT() asm volatile("" ::: "memory")
#define HY_CONV(c, w0, w1, w2) hy_conv_lane((c), (w0), (w1), (w2), lane)
    for (int ch = blockIdx.x; ch < 1024; ch += gridDim.x) {
        {
            const bf16_t* pv = PT + (size_t)ch * T + TC;
            const float w0 = cw[ch], w1 = cw[3072 + ch], w2 = cw[6144 + ch];
            for (int m0 = 0; m0 < 32; m0 += 8) {
                bf16_t a0[8], a1[8];
#pragma unroll
                for (int q = 0; q < 8; ++q) { const int j = tid + 512 * (m0 + q); a0[q] = pv[j]; a1[q] = pv[SEQ + j]; }
                HY_SPLIT();
#pragma unroll
                for (int q = 0; q < 8; ++q) { const int j = tid + 512 * (m0 + q); const float c0 = bf2f(a0[q]), c1 = bf2f(a1[q]); cf z; z.x = HY_CONV(c0, w0, w1, w2); z.y = HY_CONV(c1, w0, w1, w2); zp[j] = CPK(z); }
            }
        }
        for (int n = 0; n < 2; ++n) {
            __syncthreads();
            const bf16_t* ftf = FT + (size_t)(n * 2048 + ch) * 16384; const bf16_t* ftb = FT + (size_t)(n * 2048 + 1024 + ch) * 16384;
            for (int m0 = 0; m0 < 32; m0 += 8) {
                bf16_t hfv[8], hbv[8];
#pragma unroll
                for (int q = 0; q < 8; ++q) { const int j = tid + 512 * (m0 + q); hfv[q] = ftf[j]; hbv[q] = ftb[j > 0 ? SEQ - j : 0]; }
                HY_SPLIT();
#pragma unroll
                for (int q = 0; q < 8; ++q) {
                    const int j = tid + 512 * (m0 + q);
                    const float hf = bf2f(hfv[q]), hb = j > 0 ? bf2f(hbv[q]) : 0.f;
                    const cf w = cmul(tA[j >> 7], tB[j & 127]);
                    cf a; a.x = hf + hb; a.y = 0.f; X[PIDX(j)] = a;
                    const float kd = hf - hb; cf o; o.x = kd * w.x; o.y = kd * w.y; sKo[j] = CPK(o);
                }
            }
            __syncthreads();
            fft16k_fwd(X, tw);
            unsigned Ker[32];
#pragma unroll
            for (int m = 0; m < 32; ++m) { const cf t_ = X[PIDX(tid + 512 * m)]; Ker[m] = CPK(t_); }
            __syncthreads();
            for (int m0 = 0; m0 < 32; m0 += 8) { unsigned t[8];
#pragma unroll
                for (int q = 0; q < 8; ++q) t[q] = sKo[tid + 512 * (m0 + q)];
                HY_SPLIT();
#pragma unroll
                for (int q = 0; q < 8; ++q) X[PIDX(tid + 512 * (m0 + q))] = CUP(t[q]); }
            __syncthreads();
            fft16k_fwd(X, tw);
            _Pragma("unroll 8") for (int m = 0; m < 32; ++m) { const int j = tid + 512 * m; const cf t_ = X[PIDX(j)]; sKo[j] = CPK(t_); }
            __syncthreads();
            for (int m0 = 0; m0 < 32; m0 += 8) { unsigned t[8];
#pragma unroll
                for (int q = 0; q < 8; ++q) t[q] = zp[tid + 512 * (m0 + q)];
                HY_SPLIT();
#pragma unroll
                for (int q = 0; q < 8; ++q) X[PIDX(tid + 512 * (m0 + q))] = CUP(t[q]); }
            __syncthreads();
            fft16k_fwd(X, tw);
#pragma unroll
            for (int m = 0; m < 32; ++m) { const int j = tid + 512 * m; X[PIDX(j)] = cmul(X[PIDX(j)], CUP(Ker[m])); }
            __syncthreads();
            fft16k_inv(X, tw);
            _Pragma("unroll 8") for (int m = 0; m < 32; ++m) { const int j = tid + 512 * m; const cf t_ = X[PIDX(j)]; ye[j] = CPK(t_); }
            __syncthreads();
            for (int m0 = 0; m0 < 32; m0 += 8) { unsigned t[8];
#pragma unroll
                for (int q = 0; q < 8; ++q) t[q] = zp[tid + 512 * (m0 + q)];
                HY_SPLIT();
#pragma unroll
                for (int q = 0; q < 8; ++q) { const int j = tid + 512 * (m0 + q); const cf w = cmul(tA[j >> 7], tB[j & 127]); X[PIDX(j)] = cmul(CUP(t[q]), w); } }
            __syncthreads();
            fft16k_fwd(X, tw);
            for (int m0 = 0; m0 < 32; m0 += 8) { unsigned t[8];
#pragma unroll
                for (int q = 0; q < 8; ++q) t[q] = sKo[tid + 512 * (m0 + q)];
                HY_SPLIT();
#pragma unroll
                for (int q = 0; q < 8; ++q) { const int j = tid + 512 * (m0 + q); X[PIDX(j)] = cmul(X[PIDX(j)], CUP(t[q])); } }
            __syncthreads();
            fft16k_inv(X, tw);
            {
                const bf16_t* pg = PT + (size_t)((n + 1) * 1024 + ch) * T + TC;
                const int gcol = (n + 1) * 1024 + ch;
                const float w0 = cw[gcol], w1 = cw[3072 + gcol], w2 = cw[6144 + gcol];
                const float bias = k.hy_bias[(size_t)jl * 2 * 1024 + n * 1024 + ch];
                for (int m0 = 0; m0 < 32; m0 += 8) {
                    unsigned te_[8], tz_[8]; bf16_t g0[8], g1[8];
#pragma unroll
                    for (int q = 0; q < 8; ++q) { const int j = tid + 512 * (m0 + q); te_[q] = ye[j]; tz_[q] = zp[j]; g0[q] = pg[j]; g1[q] = pg[SEQ + j]; }
                    HY_SPLIT();
#pragma unroll
                    for (int q = 0; q < 8; ++q) {
                        const int j = tid + 512 * (m0 + q);
                        cf w = cmul(tA[j >> 7], tB[j & 127]); w.y = -w.y;
                        const cf yo = cmul(X[PIDX(j)], w);
                        const cf te = CUP(te_[q]), tz = CUP(tz_[q]);
                        const float y0 = (0.5f / 16384.0f) * (te.x + yo.x), y1 = (0.5f / 16384.0f) * (te.y + yo.y);
                        const float c0 = bf2f(g0[q]), c1 = bf2f(g1[q]);
                        cf zn; zn.x = HY_CONV(c0, w0, w1, w2) * (y0 + bias * tz.x); zn.y = HY_CONV(c1, w0, w1, w2) * (y1 + bias * tz.y);
                        zp[j] = CPK(zn);
                    }
                }
            }
        }
        for (int m0 = 0; m0 < 32; m0 += 8) { unsigned t[8];
#pragma unroll
            for (int q = 0; q < 8; ++q) t[q] = zp[tid + 512 * (m0 + q)];
            HY_SPLIT();
#pragma unroll
            for (int q = 0; q < 8; ++q) { const int j = tid + 512 * (m0 + q); ZT[(size_t)ch * T + TC + j] = (bf16_t)(t[q] & 0xffffu); ZT[(size_t)ch * T + TC + SEQ + j] = (bf16_t)(t[q] >> 16); } }
        __syncthreads();
    }
#undef CPK
#undef CUP
#undef HY_SPLIT
#undef HY_CONV
}
PF void hy_ctx(const KC& k, int jl, LAS float* lds) {
    const int tid = TID(), t = tid & 255, hsel = tid >> 8;
    LAS float* z = lds + hsel * 1024; LAS float* G = z + 256;
    const bf16_t* PT = (const bf16_t*)(k.ws + AR_PB);
    bf16_t* U = (bf16_t*)(k.ws + AR_UBUF);
    const float* filtc = (const float*)(k.ws + WS_FILTC);
    const float* cw = k.hy_conv + (size_t)jl * 3 * 3072;
    const int tl = t != 0 ? t - 1 : t, tr = t != 255 ? t + 1 : t;
    for (int u = blockIdx.x; u < 1024; u += gridDim.x) {
        const int pr = u * 2 + hsel, b = pr >> 10, ch = pr & 1023;
        bf16_t v3[3][3]; float fv[2][2], cwv[3][3], bias[2];
#pragma unroll
        for (int m = 0; m < 3; ++m) {
            const bf16_t* pm = PT + (size_t)(m * 1024 + ch) * T + b * 256;
            v3[m][0] = pm[tl]; v3[m][1] = pm[t]; v3[m][2] = pm[tr];
#pragma unroll
            for (int tap = 0; tap < 3; ++tap) cwv[m][tap] = cw[tap * 3072 + m * 1024 + ch];
        }
#pragma unroll
        for (int n = 0; n < 2; ++n) {
            fv[n][0] = filtc[(size_t)t * 4096 + n * 2048 + ch]; fv[n][1] = filtc[(size_t)t * 4096 + n * 2048 + 1024 + ch];
            bias[n] = k.hy_bias[(size_t)jl * 2048 + n * 1024 + ch];
        }
        asm volatile("" ::: "memory");
        float c3[3];
#pragma unroll
        for (int m = 0; m < 3; ++m)
            c3[m] = cwv[m][0] * (t != 0 ? bf2f(v3[m][0]) : 0.f) + cwv[m][1] * bf2f(v3[m][1]) + cwv[m][2] * (t != 255 ? bf2f(v3[m][2]) : 0.f);
        float zc = c3[0];
#pragma unroll
        for (int n = 0; n < 2; ++n) {
            __syncthreads();
            z[t] = zc; G[255 + t] = fv[n][0]; if (t > 0) G[255 - t] = fv[n][1];
            __syncthreads();
            float y0 = 0.f, y1 = 0.f;
            const LAS float* gp = G + 255 + t;
#pragma unroll 2
            for (int s0 = 0; s0 < 256; s0 += 8) {
                const f32x4 za = *(const LAS f32x4*)(z + s0), zb = *(const LAS f32x4*)(z + s0 + 4);
                float gg[8];
#pragma unroll
                for (int e = 0; e < 8; ++e) gg[e] = gp[-(s0 + e)];
                y0 += gg[0] * za[0] + gg[2] * za[2] + gg[4] * zb[0] + gg[6] * zb[2];
                y1 += gg[1] * za[1] + gg[3] * za[3] + gg[5] * zb[1] + gg[7] * zb[3];
            }
            zc = c3[n + 1] * ((y0 + y1) + bias[n] * zc);
        }
        U[(size_t)(b * 256 + t) * 1024 + ch] = f2bf(zc);
        __syncthreads();
    }
}
PF void hy_transpose(const KC& k, LAS bf16_t* lds) {
    const int tid = TID();
    const bf16_t* ZT = (const bf16_t*)(k.ws + AR_ZT);
    bf16_t* U = (bf16_t*)(k.ws + AR_UBUF);
    for (int u = blockIdx.x; u < 16 * (TL / 64); u += gridDim.x) {
        const int c0 = (u & 15) * 64, r0 = TC + (u >> 4) * 64;
        { const int c = tid >> 3, sg = (tid & 7) * 8;
          const u32x4 v = *(const u32x4*)(ZT + (size_t)(c0 + c) * T + r0 + sg);
#pragma unroll
          for (int w = 0; w < 4; ++w) { lds[(sg + 2 * w) * 66 + c] = (bf16_t)(v[w] & 0xffff); lds[(sg + 2 * w + 1) * 66 + c] = (bf16_t)(v[w] >> 16); } }
        __syncthreads();
        { const int r = tid >> 3, sg = (tid & 7) * 8; u32x4 o;
#pragma unroll
          for (int w = 0; w < 4; ++w) o[w] = (unsigned)lds[r * 66 + sg + 2 * w] | ((unsigned)lds[r * 66 + sg + 2 * w + 1] << 16);
          *(u32x4*)(U + (size_t)(r0 + r) * 1024 + c0 + sg) = o; }
        __syncthreads();
    }
}

__global__ void __launch_bounds__(NTHR, 2) fwd_kernel(Params prm) {
    extern __shared__ __attribute__((aligned(16))) unsigned char lds_raw[];
    LAS unsigned char* lds = (LAS unsigned char*)lds_raw;
    LAS float* ldsf = (LAS float*)lds;
    LAS bf16_t* ldsh = (LAS bf16_t*)lds;
    LAS int* tb = (LAS int*)(lds + 150 * 1024);
    volatile LAS unsigned* xbw = (volatile LAS unsigned*)(lds + 151 * 1024 + 512);
    KC k;
    k.x = (const float*)(GAS const float*)prm.in[0]; k.c = (const float*)(GAS const float*)prm.in[1]; k.ctx = (const float*)(GAS const float*)prm.in[2]; k.c_ctx = (const float*)(GAS const float*)prm.in[3]; k.ada_w = (const float*)(GAS const float*)prm.in[4]; k.ada_b = (const float*)(GAS const float*)prm.in[5];
    k.norm_mix = (const float*)(GAS const float*)prm.in[6]; k.norm_ffn = (const float*)(GAS const float*)prm.in[7]; k.norm_final = (const float*)(GAS const float*)prm.in[8];
    k.dn_w_in = (const float*)(GAS const float*)prm.in[9]; k.dn_conv = (const float*)(GAS const float*)prm.in[10]; k.dn_a_log = (const float*)(GAS const float*)prm.in[11]; k.dn_dt_bias = (const float*)(GAS const float*)prm.in[12]; k.dn_out_norm = (const float*)(GAS const float*)prm.in[13]; k.dn_w_out = (const float*)(GAS const float*)prm.in[14];
    k.hy_w_in = (const float*)(GAS const float*)prm.in[15]; k.hy_conv = (const float*)(GAS const float*)prm.in[16]; k.hy_f_w1 = (const float*)(GAS const float*)prm.in[17]; k.hy_f_b1 = (const float*)(GAS const float*)prm.in[18]; k.hy_f_freq = (const float*)(GAS const float*)prm.in[19]; k.hy_f_w2 = (const float*)(GAS const float*)prm.in[20];
    k.hy_f_b2 = (const float*)(GAS const float*)prm.in[21]; k.hy_f_w3 = (const float*)(GAS const float*)prm.in[22]; k.hy_bias = (const float*)(GAS const float*)prm.in[23]; k.hy_w_out = (const float*)(GAS const float*)prm.in[24];
    k.sc_w_in = (const float*)(GAS const float*)prm.in[25]; k.sc_conv = (const float*)(GAS const float*)prm.in[26]; k.sc_w_out = (const float*)(GAS const float*)prm.in[27]; k.w_router = (const float*)(GAS const float*)prm.in[28]; k.router_bias = (const float*)(GAS const float*)prm.in[29];
    k.moe_w_gate = (const float*)(GAS const float*)prm.in[30]; k.moe_w_up = (const float*)(GAS const float*)prm.in[31]; k.moe_w_down = (const float*)(GAS const float*)prm.in[32];
    k.out = (float*)(GAS float*)prm.out; k.ws = (unsigned char*)(GAS unsigned char*)prm.ws;
    const int lo = prm.ph_lo, hi = prm.ph_hi;
    XcdBarrier bar; bar.bar = (unsigned*)(k.ws + WS_CTL); bar.x = 0; bar.st = xbw;
    if (hi - lo > 1) {
        if (threadIdx.x == 0) { xbw[0] = 0u; xbw[1] = 0u; }
        __syncthreads();
        bar = xcd_barrier_post((unsigned*)(k.ws + WS_CTL), xbw);
    }
    int ph = 0;
#define PROBE_OK(id) ((id) != 1 || i == 0)
    int i = 0;
#define PH_BEGIN(id) if (ph >= lo && ph < hi) { const int nrep_ = (((id) == PROBE_REP) && PROBE_OK(id)) ? 2 : 1; for (int rep_ = 0; rep_ < nrep_; ++rep_) { { GAS unsigned char* w_ = (GAS unsigned char*)k.ws; asm volatile("" : "+s"(w_)); k.ws = (unsigned char*)w_; }
#define PH_END   if (ph + 1 < hi) xcd_barrier(bar); } } ++ph;

    float* xs = (float*)(k.ws + WS_XS);
    const float* mod = (const float*)(k.ws + WS_MOD);

    PH_BEGIN(0)
        job_mod(k, ldsf);
        job_cvt_small(k, ldsf);
        job_hdn(k, ldsf);
        job_w3s(k);
    PH_END

    for (i = 0; i < DEPTH; ++i) {
        const int kind = i % 3, j = i / 3;
        const bool last = (i == DEPTH - 1);
        PH_BEGIN(1)
            if (kind == 0) norm_mfma<2>(k, i, i == 0, i > 0, k.norm_mix + i * 1024, 0, k.dn_w_in + (size_t)j * 1024 * DN_IN + 4096, DN_IN,
                                        k.dn_a_log + j * 16, k.dn_dt_bias + j * 16, last, lds);
            else norm_vec<0>(k, i, k.norm_mix + i * 1024, 0);
            if (kind == 1) job_filtc(k, j);
        PH_END
        PH_BEGIN(2)
            if (kind == 0) { EpiBf16 e{(bf16_t*)(k.ws + AR_PB), 3072, 3072, (bf16_t*)k.out, 1024}; gemm_dense(lds, (const bf16_t*)(k.ws + AR_HBUF), T, (const bf16_t*)(k.ws + WS_DNWIN) + (size_t)j * 4096 * 1024, 4096, 1024, e); }
            else if (kind == 1) { EpiBf16T e{(bf16_t*)(k.ws + AR_PB), T}; gemm_dense(lds, (const bf16_t*)(k.ws + AR_HBUF), T, (const bf16_t*)(k.ws + WS_HYWIN), 3072, 1024, e);
                                  EpiTaps et{(bf16_t*)(k.ws + AR_FT)}; gemm_dense(lds, (const bf16_t*)(k.ws + WS_W3S), 4096, (const bf16_t*)(k.ws + WS_HS), 16384, 256, et); }
            else { EpiBf16 e{(bf16_t*)(k.ws + AR_PB), 3072, 1 << 30, nullptr, 0}; gemm_dense(lds, (const bf16_t*)(k.ws + AR_HBUF), T, (const bf16_t*)(k.ws + WS_SCWIN), 3072, 1024, e); }
        PH_END
        if (kind == 0) {
            PH_BEGIN(3) dn_chunk(k, j, lds); PH_END
            PH_BEGIN(4) dn_scan(k, lds, rep_ ? PROBE_MODE : 0); PH_END
            PH_BEGIN(5) dn_finish(k, j); PH_END
        } else if (kind == 1) {
            PH_BEGIN(6) hy_lat(k, j, ldsf); hy_ctx(k, j, ldsf); PH_END
            PH_BEGIN(7) hy_transpose(k, ldsh); PH_END
        } else {
            PH_BEGIN(8) sc_mix(k, j); PH_END
        }
        PH_BEGIN(9)
            const bf16_t* Wt = kind == 0 ? (const bf16_t*)(k.ws + WS_DNWOUT) + (size_t)j * 1024 * 1024 : (kind == 1 ? (const bf16_t*)(k.ws + WS_HYWOUT) : (const bf16_t*)(k.ws + WS_SCWOUT));
            EpiResid e{xs, mod, i, 2};
            gemm_dense(lds, (const bf16_t*)(k.ws + AR_UBUF), T, Wt, 1024, 1024, e);
            if (gridDim.x == 256) job_cvt_moe(k, i, ldsf, (int)blockIdx.x - 8, 248); else job_cvt_moe(k, i, ldsf, (int)blockIdx.x, (int)gridDim.x);
        PH_END
        PH_BEGIN(10)
            norm_mfma<1>(k, i, false, false, k.norm_ffn + i * 1024, 3, k.w_router, 32, k.router_bias, nullptr, last, lds, rep_ == nrep_ - 1);
        PH_END
        PH_BEGIN(11)
            moe_scatter(k, i, tb);
        PH_END
        PH_BEGIN(12) moe_gemm<0>(k, i, lds, tb); PH_END
        PH_BEGIN(13) moe_gemm<1>(k, i, lds, tb); PH_END
    }
    PH_BEGIN(14)
        norm_vec<3>(k, DEPTH, k.norm_final, 0);
    PH_END
#undef PH_BEGIN
#undef PH_END
}
constexpr int N_PHASES = 1 + (10 + 9 + 8 + 10) + 1;

extern "C" void kernel_launch(void* const* d_in, const int* in_sizes, int n_in, void* d_out, int out_size, void* d_ws, size_t ws_size, hipStream_t stream) {
    static int grid = 0;
    if (grid == 0) {
        if (n_in != 33 || out_size != TL * D || ws_size < WS_END) { fprintf(stderr, "kernel_launch: unexpected shapes: n_in %d out %d ws %zu (need %zu)\n", n_in, out_size, ws_size, (size_t)WS_END); grid = -1; return; }
        int dev = 0, cus = 0, per_cu = 0;
        if (hipGetDevice(&dev) != hipSuccess || hipDeviceGetAttribute(&cus, hipDeviceAttributeMultiprocessorCount, dev) != hipSuccess) { grid = -1; return; }
        if (hipFuncSetAttribute((const void*)fwd_kernel, hipFuncAttributeMaxDynamicSharedMemorySize, LDS_BYTES) != hipSuccess) { fprintf(stderr, "kernel_launch: hipFuncSetAttribute failed\n"); grid = -1; return; }
        if (hipOccupancyMaxActiveBlocksPerMultiprocessor(&per_cu, (const void*)fwd_kernel, NTHR, LDS_BYTES) != hipSuccess || per_cu < 1) fprintf(stderr, "kernel_launch: occupancy query reports %d\n", per_cu);
        (void)hipGetLastError();
        grid = cus;
    }
    if (grid < 0) return;
    (void)hipMemsetAsync((char*)d_ws + WS_CTL, 0, CTL_BYTES, stream);
    Params p{};
    for (int i = 0; i < 33; ++i) p.in[i] = (const float*)d_in[i];
    p.out = (float*)d_out; p.ws = (unsigned char*)d_ws;
#if MK_MULTI
    for (int ph = 0; ph < N_PHASES; ++ph) { p.ph_lo = ph; p.ph_hi = ph + 1; hipLaunchKernelGGL(fwd_kernel, dim3(grid), dim3(NTHR), LDS_BYTES, stream, p); }
#else
    p.ph_lo = 0; p.ph_hi = N_PHASES;
    hipLaunchKernelGGL(fwd_kernel, dim3(grid), dim3(NTHR), LDS_BYTES, stream, p);
#endif
}
```

```cpp
#include <hip/hip_runtime.h>
#include <stdint.h>
#include <stdio.h>
#include <math.h>

#ifndef MK_MULTI
#define MK_MULTI 0
#endif

#ifndef PROBE_SUB
#define PROBE_SUB (0)
#endif
#ifndef PROBE_MODE
#define PROBE_MODE (1)
#endif
#ifndef PROBE_REP
#define PROBE_REP (-1)
#endif
#define LAS __attribute__((address_space(3)))
#define GAS __attribute__((address_space(1)))
#define HD __host__ __device__ __forceinline__
#define DI __device__ __forceinline__
#ifdef NOINL
#define PF __device__ __noinline__
#else
#define PF __device__ __forceinline__
#endif
typedef unsigned short bf16_t;
typedef short bf16x8 __attribute__((ext_vector_type(8)));
typedef float f32x4 __attribute__((ext_vector_type(4)));
typedef unsigned u32x4 __attribute__((ext_vector_type(4)));
typedef unsigned u32x2 __attribute__((ext_vector_type(2)));

constexpr int D = 1024, NB = 2, SEQ = 16384, CTXL = 256, DEPTH = 4;
constexpr int TC = NB * CTXL, TL = NB * SEQ, T = TC + TL, NA = 2 * T;
constexpr int NTHR = 512;
constexpr int DN_IN = 4128;
constexpr float EPS = 1e-6f;
constexpr int LDS_BYTES = 152 * 1024;

constexpr size_t AL(size_t x) { return (x + 255) & ~(size_t)255; }
constexpr size_t WS_CTL = 0;
constexpr size_t CTL_BYTES = 65536;
constexpr size_t CTL_CNT = 16384;
constexpr size_t WS_MOD = WS_CTL + CTL_BYTES;
constexpr size_t WS_HS = AL(WS_MOD + 4 * 3 * 6144 * 4);
constexpr size_t WS_W3S = AL(WS_HS + 16384 * 256 * 2);
constexpr size_t WS_HDNC = AL(WS_W3S + 4096 * 256 * 2);
constexpr size_t WS_FILTC = AL(WS_HDNC + 256 * 64 * 4);
constexpr size_t WS_DNWIN = AL(WS_FILTC + 256 * 4096 * 4);
constexpr size_t WS_DNWOUT = AL(WS_DNWIN + (size_t)2 * 4096 * 1024 * 2);
constexpr size_t WS_HYWIN = AL(WS_DNWOUT + (size_t)2 * 1024 * 1024 * 2);
constexpr size_t WS_HYWOUT = AL(WS_HYWIN + (size_t)3072 * 1024 * 2);
constexpr size_t WS_SCWIN = AL(WS_HYWOUT + (size_t)1024 * 1024 * 2);
constexpr size_t WS_SCWOUT = AL(WS_SCWIN + (size_t)3072 * 1024 * 2);
constexpr size_t WS_XS = AL(WS_SCWOUT + (size_t)1024 * 1024 * 2);
constexpr size_t WS_TOKE = AL(WS_XS + (size_t)T * 1024 * 4);
constexpr size_t WS_TOKW = AL(WS_TOKE + (size_t)T * 2 * 4);
constexpr size_t WS_TOKP = AL(WS_TOKW + (size_t)T * 2 * 4);
constexpr size_t WS_SLOT = AL(WS_TOKP + (size_t)T * 2 * 4);
constexpr size_t WS_GB = AL(WS_SLOT + (size_t)(NA + 256) * 4);
constexpr size_t WS_EGL = AL(WS_GB + (size_t)T * 32 * 4);
constexpr size_t WS_AR = AL(WS_EGL + (size_t)32 * 260 * 4);
constexpr size_t AR_HBUF = WS_AR;
constexpr size_t AR_UBUF = AR_HBUF + (size_t)T * 1024 * 2;
constexpr size_t AR_PB = AR_UBUF + (size_t)T * 1024 * 2;
constexpr size_t AR_Q = AR_PB + (size_t)T * 4096 * 2;
constexpr size_t AR_CHUNK = AR_PB + (size_t)T * 3072 * 2;
constexpr size_t AR_DN_END = AR_CHUNK + (size_t)32 * 260 * 65536;
constexpr size_t AR_ZT = AR_Q;
constexpr size_t AR_FFTS = AR_ZT + (size_t)1024 * T * 2;
constexpr size_t AR_FT = AR_FFTS + (size_t)256 * 4 * 16384 * 8;
constexpr size_t AR_HY_END = AR_FT + (size_t)4096 * 16384 * 4;
constexpr size_t AR_HID = AR_PB;
constexpr size_t AR_YS = AR_HID + (size_t)NA * 512 * 2;
constexpr size_t AR_WGU = AR_YS + (size_t)NA * 1024 * 2;
constexpr size_t AR_WD = AR_WGU + (size_t)32 * 1024 * 1024 * 2;
constexpr size_t AR_MOE_END = AR_WD + (size_t)32 * 1024 * 512 * 2;
constexpr size_t WS_END = AR_DN_END > AR_HY_END ? (AR_DN_END > AR_MOE_END ? AR_DN_END : AR_MOE_END) : (AR_HY_END > AR_MOE_END ? AR_HY_END : AR_MOE_END);

#define XB_TMO      128
#define XB_XCNT(j)  (256  + 64 * (j))
#define XB_XSUB(j)  (1280 + 64 * (j))
#define XB_XGEN(j)  (2304 + 64 * (j))
#define XB_TOP      3328
#define XB_TOPGEN   3392
#define XCD_BAR_WORDS 3456
#define XB_SPIN_CAP (1u << 25)
DI unsigned xb_ld(unsigned* p)              { return __hip_atomic_load(p, __ATOMIC_RELAXED, __HIP_MEMORY_SCOPE_AGENT); }
DI unsigned xb_add(unsigned* p, unsigned v) { return __hip_atomic_fetch_add(p, v, __ATOMIC_RELAXED, __HIP_MEMORY_SCOPE_AGENT); }
DI unsigned xb_xcc_id() { return (unsigned)__builtin_amdgcn_s_getreg((3 << 11) | 20) & 0xFu; }
#define XB_SPIN(cond, bar) do { unsigned _sp = 0; while (cond) { __builtin_amdgcn_s_sleep(1); \
    if ((++_sp & 255u) == 0u) { if (xb_ld(&(bar)[XB_TMO])) break; if (_sp > XB_SPIN_CAP) { atomicAdd(&(bar)[XB_TMO], 1u); break; } } } } while (0)
struct XcdBarrier { unsigned* bar; unsigned x; volatile LAS unsigned* st; };
DI XcdBarrier xcd_barrier_post(unsigned* bar, volatile LAS unsigned* st) {
    XcdBarrier b; b.bar = bar; b.x = xb_xcc_id(); b.st = st;
    if (threadIdx.x == 0) (void)xb_add(&bar[XB_XCNT(b.x)], 1u);
    return b;
}
DI void xcd_barrier_complete(unsigned* bar, unsigned x, unsigned& nloc, unsigned& nx) {
    const unsigned G = gridDim.x * gridDim.y * gridDim.z;
    unsigned sum, cnt, mine, sp = 0u;
    for (;;) {
        sum = 0u; cnt = 0u; mine = 0u;
#pragma unroll
        for (unsigned j = 0; j < 16; ++j) { const unsigned c = xb_ld(&bar[XB_XCNT(j)]); sum += c; cnt += (c > 0u) ? 1u : 0u; mine = (j == x) ? c : mine; }
        if (sum == G) break;
        __builtin_amdgcn_s_sleep(1);
        if ((++sp & 255u) == 0u) { if (xb_ld(&bar[XB_TMO])) break; if (sp > XB_SPIN_CAP) { atomicAdd(&bar[XB_TMO], 1u); break; } }
    }
    nloc = mine > 0u ? mine : 1u; nx = cnt > 0u ? cnt : 1u;
}
DI void xcd_barrier(const XcdBarrier& b) {
    asm volatile("s_waitcnt vmcnt(0)" ::: "memory");
    __syncthreads();
    if (threadIdx.x == 0) {
        unsigned* bar = b.bar;
        __builtin_amdgcn_s_waitcnt(0);
        unsigned nloc = b.st[0], nx = b.st[1];
        if (nloc == 0u) { xcd_barrier_complete(bar, b.x, nloc, nx); b.st[0] = nloc; b.st[1] = nx; }
        const unsigned old = xb_add(&bar[XB_XSUB(b.x)], 1u);
        const unsigned gen = old / nloc;
        if (old + 1u == (gen + 1u) * nloc) {
            __builtin_amdgcn_fence(__ATOMIC_RELEASE, "agent");
            asm volatile("s_waitcnt vmcnt(0)" ::: "memory");
            const unsigned og = xb_add(&bar[XB_TOP], 1u);
            const unsigned tg = og / nx;
            if (og + 1u == (tg + 1u) * nx) xb_add(&bar[XB_TOPGEN], 1u);
            else XB_SPIN(xb_ld(&bar[XB_TOPGEN]) == tg, bar);
            __builtin_amdgcn_fence(__ATOMIC_ACQUIRE, "agent");
            xb_add(&bar[XB_XGEN(b.x)], 1u);
            asm volatile("s_waitcnt vmcnt(0)" ::: "memory");
        } else {
            XB_SPIN(xb_ld(&bar[XB_XGEN(b.x)]) == gen, bar);
            __builtin_amdgcn_fence(__ATOMIC_ACQUIRE, "agent");
            asm volatile("s_waitcnt vmcnt(0)" ::: "memory");
        }
    }
    __syncthreads();
}

typedef float f32x2_t __attribute__((ext_vector_type(2)));
typedef __bf16 bf16x2_t __attribute__((ext_vector_type(2)));
DI unsigned cvt_pk_bf16(float lo, float hi) { f32x2_t v; v.x = lo; v.y = hi; const bf16x2_t b = __builtin_convertvector(v, bf16x2_t); return __builtin_bit_cast(unsigned, b); }
DI bf16_t f2bf(float f) { return (bf16_t)(cvt_pk_bf16(f, f) & 0xffffu); }
DI float bf2f(bf16_t b) { return __uint_as_float(((unsigned)b) << 16); }
DI unsigned pk2(float lo, float hi) { return cvt_pk_bf16(lo, hi); }
DI float siluf(float x) { return x * __builtin_amdgcn_rcpf(1.0f + __expf(-x)); }
DI float sigmf(float x) { return 1.0f / (1.0f + __expf(-x)); }
DI float shi(float v, int src) { return __int_as_float(__builtin_amdgcn_ds_bpermute(src << 2, __float_as_int(v))); }
DI int shii(int v, int src) { return __builtin_amdgcn_ds_bpermute(src << 2, v); }
DI float shx(float v, int m, int lane) { return shi(v, lane ^ m); }
DI float wsum(float v, int lane) {
#pragma unroll
    for (int m = 32; m >= 1; m >>= 1) v += shx(v, m, lane);
    return v;
}
DI void lds_barrier() { asm volatile("s_waitcnt lgkmcnt(0)\n\ts_barrier" ::: "memory"); }
DI int TID() { int t = threadIdx.x; asm volatile("" : "+v"(t)); return t; }
DI int modrow(int r) { return r < TC ? 0 : 1 + (r - TC) / SEQ; }

typedef float cf __attribute__((ext_vector_type(2)));
HD cf cmul(cf a, cf b) { cf r; r.x = a.x * b.x - a.y * b.y; r.y = a.x * b.y + a.y * b.x; return r; }
HD cf cadd(cf a, cf b) { cf r; r.x = a.x + b.x; r.y = a.y + b.y; return r; }
HD cf csub(cf a, cf b) { cf r; r.x = a.x - b.x; r.y = a.y - b.y; return r; }
template <int R> HD constexpr int brev(int i) { int r = 0; for (int b = 1, t = R >> 1; b < R; b <<= 1, t >>= 1) if (i & b) r |= t; return r; }
#define FFT_C32 {1.0f, 0.98078528040323044913f, 0.92387953251128675613f, 0.83146961230254523708f, 0.70710678118654752440f, 0.55557023301960222474f, 0.38268343236508977173f, 0.19509032201612826785f, 0.0f, -0.19509032201612826785f, -0.38268343236508977173f, -0.55557023301960222474f, -0.70710678118654752440f, -0.83146961230254523708f, -0.92387953251128675613f, -0.98078528040323044913f}
#define FFT_S32 {0.0f, 0.19509032201612826785f, 0.38268343236508977173f, 0.55557023301960222474f, 0.70710678118654752440f, 0.83146961230254523708f, 0.92387953251128675613f, 0.98078528040323044913f, 1.0f, 0.98078528040323044913f, 0.92387953251128675613f, 0.83146961230254523708f, 0.70710678118654752440f, 0.55557023301960222474f, 0.38268343236508977173f, 0.19509032201612826785f}
template <int R> HD constexpr int ilog2c() { int l = 0; for (int r = R; r > 1; r >>= 1) ++l; return l; }
template <int R> HD void dft_fwd(cf (&v)[R]) {
    constexpr float C[16] = FFT_C32; constexpr float S[16] = FFT_S32;
    constexpr int LG = ilog2c<R>();
#pragma unroll
    for (int st = 0; st < LG; ++st) {
#pragma unroll
        for (int i = 0; i < R / 2; ++i) {
            const int len = R >> st, half = len >> 1, blk = i / half, j = i % half, i0 = blk * len + j, i1 = i0 + half;
            const cf a = v[i0], c = v[i1];
            v[i0] = cadd(a, c);
            const cf d = csub(a, c);
            const int ti = j * (32 / len);
            cf w; w.x = C[ti]; w.y = -S[ti];
            cf r;
            if (ti == 0) r = d;
            else if (ti == 8) { r.x = d.y; r.y = -d.x; }
            else if (ti == 4) { r.x = (d.x + d.y) * 0.70710678118654752440f; r.y = (d.y - d.x) * 0.70710678118654752440f; }
            else if (ti == 12) { r.x = (d.y - d.x) * 0.70710678118654752440f; r.y = -(d.x + d.y) * 0.70710678118654752440f; }
            else r = cmul(d, w);
            v[i1] = r;
        }
    }
}
template <int R> HD void dft_inv(cf (&v)[R]) {
    constexpr float C[16] = FFT_C32; constexpr float S[16] = FFT_S32;
    constexpr int LG = ilog2c<R>();
#pragma unroll
    for (int st = LG - 1; st >= 0; --st) {
#pragma unroll
        for (int i = 0; i < R / 2; ++i) {
            const int len = R >> st, half = len >> 1, blk = i / half, j = i % half, i0 = blk * len + j, i1 = i0 + half;
            const int ti = j * (32 / len);
            cf w; w.x = C[ti]; w.y = S[ti];
            const cf a = v[i0];
            const cf b1 = v[i1];
            cf c;
            if (ti == 0) c = b1;
            else if (ti == 8) { c.x = -b1.y; c.y = b1.x; }
            else if (ti == 4) { c.x = (b1.x - b1.y) * 0.70710678118654752440f; c.y = (b1.x + b1.y) * 0.70710678118654752440f; }
            else if (ti == 12) { c.x = -(b1.x + b1.y) * 0.70710678118654752440f; c.y = (b1.x - b1.y) * 0.70710678118654752440f; }
            else c = cmul(b1, w);
            v[i0] = cadd(a, c);
            v[i1] = csub(a, c);
        }
    }
}
#define PIDX(a) ((a) + (((a) >> 6) << 2))
template <int R> DI void fft_pass_fwd(LAS cf* X, const LAS cf* tw, int n, int g) {
    const int s = n / R, q = g / s, p = g - q * s, base = q * n + p;
    cf v[R];
#pragma unroll
    for (int k = 0; k < R; ++k) v[k] = X[PIDX(base + k * s)];
    dft_fwd<R>(v);
    if (s > 1) {
        int pp = p * (16384 / n); asm volatile("" : "+v"(pp));
        const cf w1 = tw[pp]; cf w = w1;
#pragma unroll
        for (int m = 1; m < R; ++m) { v[brev<R>(m)] = cmul(v[brev<R>(m)], w); w = cmul(w, w1); }
    }
#pragma unroll
    for (int k = 0; k < R; ++k) X[PIDX(base + k * s)] = v[k];
}
template <int R> DI void fft_pass_inv(LAS cf* X, const LAS cf* tw, int n, int g) {
    const int s = n / R, q = g / s, p = g - q * s, base = q * n + p;
    cf v[R];
#pragma unroll
    for (int k = 0; k < R; ++k) v[k] = X[PIDX(base + k * s)];
    if (s > 1) {
        int pp = p * (16384 / n); asm volatile("" : "+v"(pp));
        cf w1 = tw[pp]; w1.y = -w1.y; cf w = w1;
#pragma unroll
        for (int m = 1; m < R; ++m) { v[brev<R>(m)] = cmul(v[brev<R>(m)], w); w = cmul(w, w1); }
    }
    dft_inv<R>(v);
#pragma unroll
    for (int k = 0; k < R; ++k) X[PIDX(base + k * s)] = v[k];
}
DI void fft16k_fwd(LAS cf* X, const LAS cf* tw) {
    const int t = TID();
#pragma unroll 1
    for (int g = 0; g < 2; ++g) fft_pass_fwd<16>(X, tw, 16384, t + 512 * g);
    __syncthreads();
#pragma unroll 1
    for (int g = 0; g < 2; ++g) fft_pass_fwd<16>(X, tw, 1024, t + 512 * g);
    __syncthreads();
#pragma unroll 1
    for (int g = 0; g < 2; ++g) fft_pass_fwd<16>(X, tw, 64, t + 512 * g);
    __syncthreads();
#pragma unroll 1
    for (int g = 0; g < 8; ++g) fft_pass_fwd<4>(X, tw, 4, t + 512 * g);
    __syncthreads();
}
DI void fft16k_inv(LAS cf* X, const LAS cf* tw) {
    const int t = TID();
#pragma unroll 1
    for (int g = 0; g < 8; ++g) fft_pass_inv<4>(X, tw, 4, t + 512 * g);
    __syncthreads();
#pragma unroll 1
    for (int g = 0; g < 2; ++g) fft_pass_inv<16>(X, tw, 64, t + 512 * g);
    __syncthreads();
#pragma unroll 1
    for (int g = 0; g < 2; ++g) fft_pass_inv<16>(X, tw, 1024, t + 512 * g);
    __syncthreads();
#pragma unroll 1
    for (int g = 0; g < 2; ++g) fft_pass_inv<16>(X, tw, 16384, t + 512 * g);
    __syncthreads();
}

struct Params { const float* in[33]; float* out; unsigned char* ws; int ph_lo, ph_hi; };
struct KC {
    const float *x, *c, *ctx, *c_ctx, *ada_w, *ada_b, *norm_mix, *norm_ffn, *norm_final;
    const float *dn_w_in, *dn_conv, *dn_a_log, *dn_dt_bias, *dn_out_norm, *dn_w_out;
    const float *hy_w_in, *hy_conv, *hy_f_w1, *hy_f_b1, *hy_f_freq, *hy_f_w2, *hy_f_b2, *hy_f_w3, *hy_bias, *hy_w_out;
    const float *sc_w_in, *sc_conv, *sc_w_out, *w_router, *router_bias, *moe_w_gate, *moe_w_up, *moe_w_down;
    float* out; unsigned char* ws;
};

PF void job_mod(const KC& k, LAS float* lds) {
    const int tid = TID(), cj = tid & 63, kq = tid >> 6;
    float* mod = (float*)(k.ws + WS_MOD);
    LAS float* sl = lds + 2048;
    for (int i = tid; i < 3072; i += NTHR) { const float v = i < 1024 ? k.c_ctx[i] : k.c[i - 1024]; sl[i] = siluf(v); }
    __syncthreads();
    for (int u = blockIdx.x; u < DEPTH * 96; u += gridDim.x) {
        const int l = u / 96, cc = u % 96, col = cc * 64 + cj;
        const float* W = k.ada_w + (size_t)l * 1024 * 6144 + col;
        float a0 = 0.f, a1 = 0.f, a2 = 0.f;
        for (int k0 = kq * 128; k0 < kq * 128 + 128; k0 += 16) {
            float w[16];
#pragma unroll
            for (int e = 0; e < 16; ++e) w[e] = W[(size_t)(k0 + e) * 6144];
            asm volatile("" ::: "memory");
#pragma unroll
            for (int e = 0; e < 16; ++e) { a0 += sl[k0 + e] * w[e]; a1 += sl[1024 + k0 + e] * w[e]; a2 += sl[2048 + k0 + e] * w[e]; }
        }
        lds[(kq * 3 + 0) * 64 + cj] = a0; lds[(kq * 3 + 1) * 64 + cj] = a1; lds[(kq * 3 + 2) * 64 + cj] = a2;
        __syncthreads();
        if (tid < 192) {
            const int r = tid >> 6, j = tid & 63;
            float sacc = 0.f;
            for (int q = 0; q < 8; ++q) sacc += lds[(q * 3 + r) * 64 + j];
            mod[(size_t)(l * 3 + r) * 6144 + cc * 64 + j] = sacc + k.ada_b[l * 6144 + cc * 64 + j];
        }
        __syncthreads();
    }
}
DI void cvt_matrix(const float* src, int ld, size_t sstride, int K, int N, int nmat, bf16_t* dst, int ldd, size_t dstride, int mapmode, LAS float* lds, int bid, int nb) {
    const int tk = K / 64, tn = N / 64, per = tk * tn, tid = TID();
    const int r = tid >> 4, c4 = (tid & 15) * 4;
    f32x4 v0, v1;
    int u = bid;
    if (u < per * nmat) { const int m = u / per, t = u % per; const float* sp = src + (size_t)m * sstride + (size_t)((t / tn) * 64 + r) * ld + (t % tn) * 64 + c4; v0 = *(const f32x4*)sp; v1 = *(const f32x4*)(sp + (size_t)32 * ld); }
    for (; u < per * nmat; u += nb) {
        const int m = u / per, t = u % per, k0 = (t / tn) * 64, n0 = (t % tn) * 64;
        { LAS float* p = lds + r * 65 + c4; p[0] = v0[0]; p[1] = v0[1]; p[2] = v0[2]; p[3] = v0[3];
          LAS float* p2 = lds + (r + 32) * 65 + c4; p2[0] = v1[0]; p2[1] = v1[1]; p2[2] = v1[2]; p2[3] = v1[3]; }
        { const int un = u + nb;
          if (un < per * nmat) { const int mn = un / per, tn_ = un % per; const float* sp = src + (size_t)mn * sstride + (size_t)((tn_ / tn) * 64 + r) * ld + (tn_ % tn) * 64 + c4; v0 = *(const f32x4*)sp; v1 = *(const f32x4*)(sp + (size_t)32 * ld); } }
        lds_barrier();
        { const int nn = tid >> 3, ks = (tid & 7) * 8; const int n = n0 + nn;
          const int row = mapmode == 0 ? n : (32 * (n >> 4) + (n & 15) + (mapmode == 2 ? 16 : 0));
          float f[8];
#pragma unroll
          for (int e = 0; e < 8; ++e) f[e] = lds[(ks + e) * 65 + nn];
          u32x4 o; o[0] = pk2(f[0], f[1]); o[1] = pk2(f[2], f[3]); o[2] = pk2(f[4], f[5]); o[3] = pk2(f[6], f[7]);
          *(u32x4*)(dst + (size_t)m * dstride + (size_t)row * ldd + k0 + ks) = o; }
        lds_barrier();
    }
}
PF void job_cvt_small(const KC& k, LAS float* lds) {
    cvt_matrix(k.dn_w_in, DN_IN, (size_t)1024 * DN_IN, 1024, 4096, 2, (bf16_t*)(k.ws + WS_DNWIN), 1024, (size_t)4096 * 1024, 0, lds, (int)blockIdx.x, (int)gridDim.x);
    cvt_matrix(k.dn_w_out, 1024, (size_t)1024 * 1024, 1024, 1024, 2, (bf16_t*)(k.ws + WS_DNWOUT), 1024, (size_t)1024 * 1024, 0, lds, (int)blockIdx.x, (int)gridDim.x);
    cvt_matrix(k.hy_w_in, 3072, 0, 1024, 3072, 1, (bf16_t*)(k.ws + WS_HYWIN), 1024, 0, 0, lds, (int)blockIdx.x, (int)gridDim.x);
    cvt_matrix(k.hy_w_out, 1024, 0, 1024, 1024, 1, (bf16_t*)(k.ws + WS_HYWOUT), 1024, 0, 0, lds, (int)blockIdx.x, (int)gridDim.x);
    cvt_matrix(k.sc_w_in, 3072, 0, 1024, 3072, 1, (bf16_t*)(k.ws + WS_SCWIN), 1024, 0, 0, lds, (int)blockIdx.x, (int)gridDim.x);
    cvt_matrix(k.sc_w_out, 1024, 0, 1024, 1024, 1, (bf16_t*)(k.ws + WS_SCWOUT), 1024, 0, 0, lds, (int)blockIdx.x, (int)gridDim.x);
}
PF void job_cvt_moe(const KC& k, int layer, LAS float* lds, int bid, int nb) {
    if (bid < 0) return;
    const size_t lo = (size_t)layer * 32 * 1024 * 512;
    cvt_matrix(k.moe_w_gate + lo, 512, (size_t)1024 * 512, 1024, 512, 32, (bf16_t*)(k.ws + AR_WGU), 1024, (size_t)1024 * 1024, 1, lds, bid, nb);
    cvt_matrix(k.moe_w_up + lo, 512, (size_t)1024 * 512, 1024, 512, 32, (bf16_t*)(k.ws + AR_WGU), 1024, (size_t)1024 * 1024, 2, lds, bid, nb);
    cvt_matrix(k.moe_w_down + lo, 1024, (size_t)512 * 1024, 512, 1024, 32, (bf16_t*)(k.ws + AR_WD), 512, (size_t)1024 * 512, 0, lds, bid, nb);
}
PF void job_hdn(const KC& k, LAS float* lds) {
    const int tid = TID(), lane = tid & 63, wave = tid >> 6;
    LAS float* feat = lds + wave * 128; LAS float* h1 = feat + 64;
    const float fr = k.hy_f_freq[lane], b1 = k.hy_f_b1[lane], b2 = k.hy_f_b2[lane];
    for (int u0 = blockIdx.x * 8; u0 < 16384 + 256; u0 += gridDim.x * 8) {
        const int u = u0 + wave;
        int l, pos; float* dst;
        if (u < 16384) { l = 16384; pos = u; dst = nullptr; }
        else { l = 256; pos = u - 16384; dst = (float*)(k.ws + WS_HDNC) + (size_t)pos * 64; }
        const float t = (float)pos / (float)(l - 1);
        float f = 0.f;
        if (lane == 0) f = t;
        else if (lane <= 32) {
            const int bi = (lane - 1) & 15;
            const float band = 1e-4f + (float)bi * ((15.0f - 1e-4f) / 15.0f);
            const float ang = (6.283185307179586f / (float)l) * (float)pos * band;
            f = lane <= 16 ? cosf(ang) : -sinf(ang);
        }
        feat[lane] = f;
        __syncthreads();
        float a = b1;
        for (int i = 0; i < 33; ++i) a += feat[i] * k.hy_f_w1[i * 64 + lane];
        h1[lane] = sinf(fr * a);
        __syncthreads();
        float a2 = b2;
        for (int j = 0; j < 64; ++j) a2 += h1[j] * k.hy_f_w2[j * 64 + lane];
        const float hv = sinf(fr * a2);
        if (dst) dst[lane] = hv;
        else { bf16_t* hs = (bf16_t*)(k.ws + WS_HS) + (size_t)pos * 256; const bf16_t hi = f2bf(hv), lo = f2bf(hv - bf2f(hi)); hs[lane] = hi; hs[64 + lane] = lo; hs[128 + lane] = hi; hs[192 + lane] = 0; }
        __syncthreads();
    }
}
PF void job_w3s(const KC& k) {
    bf16_t* W = (bf16_t*)(k.ws + WS_W3S);
    const int tq = TID();
    for (int idx = blockIdx.x * NTHR + tq; idx < 64 * 4096; idx += gridDim.x * NTHR) {
        const int j = idx >> 12, col = idx & 4095;
        const float w = k.hy_f_w3[idx]; const bf16_t hi = f2bf(w), lo = f2bf(w - bf2f(hi));
        W[(size_t)col * 256 + j] = hi; W[(size_t)col * 256 + 64 + j] = hi; W[(size_t)col * 256 + 128 + j] = lo; W[(size_t)col * 256 + 192 + j] = 0;
    }
}
DI float hy_delta(int ch) {
    const float lo = -4.605170185988091f / 1.5f, hi = -4.605170185988091f / 0.3f;
    return fabsf(lo + (float)ch * ((hi - lo) / 1023.0f));
}
PF void job_filtc(const KC& k, int j) {
    const float* hdn = (const float*)(k.ws + WS_HDNC);
    const float* w3 = k.hy_f_w3 + (size_t)j * 64 * 4096;
    float* filtc = (float*)(k.ws + WS_FILTC);
    const int tq = TID();
    for (int u = blockIdx.x; u < 256 * 8; u += gridDim.x) {
        const int l = u >> 3, col = (u & 7) * 512 + tq;
        float a = 0.f;
        for (int q0 = 0; q0 < 64; q0 += 16) {
            float wv[16], hv[16];
#pragma unroll
            for (int q = 0; q < 16; ++q) { wv[q] = w3[(size_t)(q0 + q) * 4096 + col]; hv[q] = hdn[l * 64 + q0 + q]; }
            asm volatile("" ::: "memory");
#pragma unroll
            for (int q = 0; q < 16; ++q) a += hv[q] * wv[q];
        }
        const float t = (float)l / 255.0f;
        filtc[(size_t)l * 4096 + col] = a * expf(-t * hy_delta(col & 1023));
    }
}

template <int MODE>
PF void norm_vec(const KC& k, int layer, const float* __restrict__ gain, int mb) {
    const int tid = TID(), lane = tid & 63, wave = tid >> 6;
    float* xs = (float*)(k.ws + WS_XS);
    bf16_t* hbuf = (bf16_t*)(k.ws + AR_HBUF);
    const float* mod = (const float*)(k.ws + WS_MOD);
    const bf16_t* ys = (const bf16_t*)(k.ws + AR_YS);
    const int* tokp = (const int*)(k.ws + WS_TOKP);
    const float* tokw = (const float*)(k.ws + WS_TOKW);
    const int rbeg = (MODE == 3) ? TC : 0, rstr = gridDim.x * 8, c0 = 4 * lane;
    int cur_mr = -1; f32x4 gsv[4], shv[4], g5v[4];
    int r = rbeg + blockIdx.x * 8 + wave;
    if (r >= T) return;
    f32x4 xn[4]; u32x2 yan[4], ybn[4]; float w0n, w1n, w0f, w1f; int p0f, p1f;
    {
        const int p0 = tokp[2 * r], p1 = tokp[2 * r + 1]; w0n = tokw[2 * r]; w1n = tokw[2 * r + 1];
        const int r2 = r + rstr < T ? r + rstr : T - 1;
        p0f = tokp[2 * r2]; p1f = tokp[2 * r2 + 1]; w0f = tokw[2 * r2]; w1f = tokw[2 * r2 + 1];
#pragma unroll
        for (int j = 0; j < 4; ++j) {
            xn[j] = *(const f32x4*)(xs + (size_t)r * 1024 + 256 * j + c0);
            yan[j] = *(const u32x2*)(ys + (size_t)p0 * 1024 + 256 * j + c0); ybn[j] = *(const u32x2*)(ys + (size_t)p1 * 1024 + 256 * j + c0);
        }
    }
    for (; r < T; r += rstr) {
        const int mr = modrow(r);
        f32x4 x[4]; u32x2 ya[4], yb[4];
#pragma unroll
        for (int j = 0; j < 4; ++j) { x[j] = xn[j]; ya[j] = yan[j]; yb[j] = ybn[j]; }
        const float w0 = w0n, w1 = w1n;
        {
            const int rn = r + rstr < T ? r + rstr : T - 1, rf = r + 2 * rstr < T ? r + 2 * rstr : T - 1;
#pragma unroll
            for (int j = 0; j < 4; ++j) {
                xn[j] = *(const f32x4*)(xs + (size_t)rn * 1024 + 256 * j + c0);
                yan[j] = *(const u32x2*)(ys + (size_t)p0f * 1024 + 256 * j + c0); ybn[j] = *(const u32x2*)(ys + (size_t)p1f * 1024 + 256 * j + c0);
            }
            w0n = w0f; w1n = w1f;
            p0f = tokp[2 * rf]; p1f = tokp[2 * rf + 1]; w0f = tokw[2 * rf]; w1f = tokw[2 * rf + 1];
        }
        if (mr != cur_mr) {
            cur_mr = mr;
            const float* shift = mod + ((size_t)(layer * 3 + mr) * 6 + mb) * 1024;
            const float* g5 = mod + ((size_t)((layer - 1) * 3 + mr) * 6 + 5) * 1024;
#pragma unroll
            for (int j = 0; j < 4; ++j) {
                const int col = 256 * j + c0;
                const f32x4 gn = *(const f32x4*)(gain + col);
                if (MODE != 3) { const f32x4 sc = *(const f32x4*)(shift + 1024 + col); shv[j] = *(const f32x4*)(shift + col);
#pragma unroll
                    for (int e = 0; e < 4; ++e) gsv[j][e] = gn[e] * (1.0f + sc[e]); }
                else gsv[j] = gn;
                g5v[j] = *(const f32x4*)(g5 + col);
            }
        }
        float ss = 0.f;
#pragma unroll
        for (int j = 0; j < 4; ++j) {
            const float a0 = __uint_as_float(ya[j][0] << 16), a1 = __uint_as_float(ya[j][0] & 0xffff0000u), a2 = __uint_as_float(ya[j][1] << 16), a3 = __uint_as_float(ya[j][1] & 0xffff0000u);
            const float b0 = __uint_as_float(yb[j][0] << 16), b1 = __uint_as_float(yb[j][0] & 0xffff0000u), b2 = __uint_as_float(yb[j][1] << 16), b3 = __uint_as_float(yb[j][1] & 0xffff0000u);
            x[j][0] += g5v[j][0] * (w0 * a0 + w1 * b0); x[j][1] += g5v[j][1] * (w0 * a1 + w1 * b1);
            x[j][2] += g5v[j][2] * (w0 * a2 + w1 * b2); x[j][3] += g5v[j][3] * (w0 * a3 + w1 * b3);
            if (MODE != 3) *(f32x4*)(xs + (size_t)r * 1024 + 256 * j + c0) = x[j];
            ss += x[j][0] * x[j][0] + x[j][1] * x[j][1] + x[j][2] * x[j][2] + x[j][3] * x[j][3];
        }
        ss = wsum(ss, lane);
        const float rstd = rsqrtf(ss * (1.0f / 1024.0f) + EPS);
#pragma unroll
        for (int j = 0; j < 4; ++j) {
            if (MODE == 3) {
                f32x4 o;
#pragma unroll
                for (int e = 0; e < 4; ++e) o[e] = x[j][e] * rstd * gsv[j][e];
                *(f32x4*)(k.out + (size_t)(r - TC) * 1024 + 256 * j + c0) = o;
            } else {
                u32x2 o;
                o[0] = pk2(x[j][0] * rstd * gsv[j][0] + shv[j][0], x[j][1] * rstd * gsv[j][1] + shv[j][1]);
                o[1] = pk2(x[j][2] * rstd * gsv[j][2] + shv[j][2], x[j][3] * rstd * gsv[j][3] + shv[j][3]);
                *(u32x2*)(hbuf + (size_t)r * 1024 + 256 * j + c0) = o;
            }
        }
    }
}

template <int MODE>
PF void norm_phase(const KC& k, int layer, bool first, bool combine, const float* __restrict__ gain, int mb, const float* __restrict__ Wsk, int ldw,
                   const float* __restrict__ aux0, const float* __restrict__ aux1, bool last, LAS float* lds, bool flush = true) {
    const int tid = TID(), lane = tid & 63, wave = tid >> 6;
    float* xs = (float*)(k.ws + WS_XS);
    bf16_t* hbuf = (bf16_t*)(k.ws + AR_HBUF);
    const float* mod = (const float*)(k.ws + WS_MOD);
    const bf16_t* ys = (const bf16_t*)(k.ws + AR_YS);
    const int* tokp = (const int*)(k.ws + WS_TOKP);
    const float* tokw = (const float*)(k.ws + WS_TOKW);
    LAS int* lcnt = (LAS int*)(lds + 32768);
    if (MODE == 1 && tid < 32) lcnt[tid] = 0;
    if (MODE == 1 || MODE == 2) {
        for (int idx = tid; idx < 1024 * 32; idx += NTHR) {
            const int kk = idx >> 5, n = idx & 31;
            lds[kk * 32 + (((n >> 2) ^ ((kk >> 1) & 7)) << 2) + (n & 3)] = Wsk[(size_t)kk * ldw + n];
        }
        __syncthreads();
    }
    const int rbeg = (MODE == 3) ? TC : 0, rstr = gridDim.x * 8;
    int cur_mr = -1; float gsv[16], shv[16], g5v[16];
    float xn[16];
    int r = rbeg + blockIdx.x * 8 + wave;
    if (r < T) {
        const float* src = first ? (r < TC ? k.ctx + (size_t)r * 1024 : k.x + (size_t)(r - TC) * 1024) : xs + (size_t)r * 1024;
#pragma unroll
        for (int m = 0; m < 16; ++m) xn[m] = src[lane + 64 * m];
    }
    for (; r < T; r += rstr) {
        const int mr = modrow(r);
        float x[16];
#pragma unroll
        for (int m = 0; m < 16; ++m) x[m] = xn[m];
        int p0 = 0, p1 = 0; float w0 = 0.f, w1 = 0.f;
        if (combine) { p0 = tokp[2 * r]; p1 = tokp[2 * r + 1]; w0 = tokw[2 * r]; w1 = tokw[2 * r + 1]; }
        {
            const int rn = r + rstr;
            if (rn < T) {
                const float* srcn = first ? (rn < TC ? k.ctx + (size_t)rn * 1024 : k.x + (size_t)(rn - TC) * 1024) : xs + (size_t)rn * 1024;
#pragma unroll
                for (int m = 0; m < 16; ++m) xn[m] = srcn[lane + 64 * m];
            }
        }
        if (mr != cur_mr) {
            cur_mr = mr;
            if (MODE != 3) {
                const float* shift = mod + ((size_t)(layer * 3 + mr) * 6 + mb) * 1024;
#pragma unroll
                for (int m = 0; m < 16; ++m) { const int col = lane + 64 * m; gsv[m] = gain[col] * (1.0f + shift[1024 + col]); shv[m] = shift[col]; }
            } else {
#pragma unroll
                for (int m = 0; m < 16; ++m) gsv[m] = gain[lane + 64 * m];
            }
            if (combine) {
                const float* g5 = mod + ((size_t)((layer - 1) * 3 + mr) * 6 + 5) * 1024;
#pragma unroll
                for (int m = 0; m < 16; ++m) g5v[m] = g5[lane + 64 * m];
            }
        }
        if (combine) {
            bf16_t ya[16], yb[16];
#pragma unroll
            for (int m = 0; m < 16; ++m) { const int col = lane + 64 * m; ya[m] = ys[(size_t)p0 * 1024 + col]; yb[m] = ys[(size_t)p1 * 1024 + col]; }
            asm volatile("" ::: "memory");
#pragma unroll
            for (int m = 0; m < 16; ++m) x[m] += g5v[m] * (w0 * bf2f(ya[m]) + w1 * bf2f(yb[m]));
        }
        if (first || combine) {
#pragma unroll
            for (int m = 0; m < 16; ++m) xs[(size_t)r * 1024 + lane + 64 * m] = x[m];
        }
        float ss = 0.f;
#pragma unroll
        for (int m = 0; m < 16; ++m) ss += x[m] * x[m];
        ss = wsum(ss, lane);
        const float rstd = rsqrtf(ss * (1.0f / 1024.0f) + EPS);
        if (MODE == 3) {
#pragma unroll
            for (int m = 0; m < 16; ++m) { const int col = lane + 64 * m; k.out[(size_t)(r - TC) * 1024 + col] = x[m] * rstd * gsv[m]; }
            continue;
        }
        float y[16];
#pragma unroll
        for (int m = 0; m < 16; ++m) {
            const int col = lane + 64 * m;
            y[m] = x[m] * rstd * gsv[m] + shv[m];
            hbuf[(size_t)r * 1024 + col] = f2bf(y[m]);
        }
        if (MODE == 1 || MODE == 2) {
            float acc[32];
#pragma unroll
            for (int n = 0; n < 32; ++n) acc[n] = 0.f;
#pragma unroll
            for (int m = 0; m < 16; ++m) {
                f32x4 wa[8];
                const int c = lane + 64 * m; const LAS float* wr = lds + c * 32; const int sw = (c >> 1) & 7;
#pragma unroll
                for (int q = 0; q < 8; ++q) wa[q] = *(const LAS f32x4*)(wr + ((q ^ sw) << 2));
                asm volatile("" ::: "memory");
#pragma unroll
                for (int q = 0; q < 8; ++q) { acc[4 * q + 0] += y[m] * wa[q][0]; acc[4 * q + 1] += y[m] * wa[q][1]; acc[4 * q + 2] += y[m] * wa[q][2]; acc[4 * q + 3] += y[m] * wa[q][3]; }
            }
            float val;
            {
                float a16[16], a8[8], a4[4], a2[2];
                const bool b5 = (lane & 32) != 0, b4 = (lane & 16) != 0, b3 = (lane & 8) != 0, b2 = (lane & 4) != 0, b1 = (lane & 2) != 0;
#pragma unroll
                for (int i = 0; i < 16; ++i) { const float send = b5 ? acc[i] : acc[i + 16], keep = b5 ? acc[i + 16] : acc[i]; a16[i] = keep + shx(send, 32, lane); }
#pragma unroll
                for (int i = 0; i < 8; ++i) { const float send = b4 ? a16[i] : a16[i + 8], keep = b4 ? a16[i + 8] : a16[i]; a8[i] = keep + shx(send, 16, lane); }
#pragma unroll
                for (int i = 0; i < 4; ++i) { const float send = b3 ? a8[i] : a8[i + 4], keep = b3 ? a8[i + 4] : a8[i]; a4[i] = keep + shx(send, 8, lane); }
#pragma unroll
                for (int i = 0; i < 2; ++i) { const float send = b2 ? a4[i] : a4[i + 2], keep = b2 ? a4[i + 2] : a4[i]; a2[i] = keep + shx(send, 4, lane); }
                { const float send = b1 ? a2[0] : a2[1], keep = b1 ? a2[1] : a2[0]; val = keep + shx(send, 2, lane); }
                val += shx(val, 1, lane);
            }
            const int n = lane >> 1;
            if (MODE == 1) {
                int* toke = (int*)(k.ws + WS_TOKE); float* tokwW = (float*)(k.ws + WS_TOKW);
                if (last && r < TC) { if (lane == 0) { int neg = -1; asm volatile("" : "+v"(neg)); toke[2 * r] = neg; toke[2 * r + 1] = neg; } continue; }
                const float sc = 1.0f / (1.0f + expf(-val)), ch = sc + aux0[n];
                const int gl = lane & ~7;
                const float ca = shi(ch, gl), cb = shi(ch, gl + 2), cc = shi(ch, gl + 4), cd = shi(ch, gl + 6);
                const float hi1 = fmaxf(ca, cb), lo1 = fminf(ca, cb), hi2 = fmaxf(cc, cd), lo2 = fminf(cc, cd);
                float gs = fmaxf(hi1, hi2) + fmaxf(fminf(hi1, hi2), fmaxf(lo1, lo2));
                int gi = lane >> 3;
#pragma unroll
                for (int m = 8; m <= 32; m <<= 1) {
                    const float og = shx(gs, m, lane); const int oi = shii(gi, lane ^ m);
                    if (og > gs || (og == gs && oi < gi)) { gs = og; gi = oi; }
                }
                float c4[4], s4[4];
#pragma unroll
                for (int i = 0; i < 4; ++i) { c4[i] = shi(ch, gi * 8 + 2 * i); s4[i] = shi(sc, gi * 8 + 2 * i); }
                int i1 = 0; float b1v = c4[0];
#pragma unroll
                for (int i = 1; i < 4; ++i) if (c4[i] > b1v) { b1v = c4[i]; i1 = i; }
                int i2 = -1; float b2v = -1e30f;
#pragma unroll
                for (int i = 0; i < 4; ++i) if (i != i1 && c4[i] > b2v) { b2v = c4[i]; i2 = i; }
                float w1v = 0.f, w2v = 0.f;
#pragma unroll
                for (int i = 0; i < 4; ++i) { if (i == i1) w1v = s4[i]; if (i == i2) w2v = s4[i]; }
                const float inv = 1.0f / (w1v + w2v);
                if (lane == 0) {
                    const int e1 = gi * 4 + i1, e2 = gi * 4 + i2;
                    toke[2 * r] = e1; toke[2 * r + 1] = e2; tokwW[2 * r] = w1v * inv; tokwW[2 * r + 1] = w2v * inv;
                    __hip_atomic_fetch_add(lcnt + e1, 1, __ATOMIC_RELAXED, __HIP_MEMORY_SCOPE_WORKGROUP);
                    __hip_atomic_fetch_add(lcnt + e2, 1, __ATOMIC_RELAXED, __HIP_MEMORY_SCOPE_WORKGROUP);
                }
            } else {
                float* gb = (float*)(k.ws + WS_GB);
                if ((lane & 1) == 0) {
                    if (n < 16) {
                        const float z = val + aux1[n];
                        const float ez = __expf(z); const float sp = z > 15.f ? z : (ez < 1e-4f ? ez - 0.5f * ez * ez : __logf(1.0f + ez));
                        gb[(size_t)r * 32 + n] = -expf(aux0[n]) * sp;
                    } else {
                        gb[(size_t)r * 32 + n] = 1.0f / (1.0f + expf(-val));
                    }
                }
            }
        }
    }
    if (MODE == 1) {
        __syncthreads();
        int* cnt = (int*)(k.ws + WS_CTL + CTL_CNT) + layer * 32;
        if (flush && tid < 32 && lcnt[tid] > 0) atomicAdd(&cnt[tid], lcnt[tid]);
    }
}

constexpr int NM_WLD = 1032;
template <int MODE>
PF void norm_mfma(const KC& k, int layer, bool first, bool combine, const float* __restrict__ gain, int mb, const float* __restrict__ Wsk, int ldw,
                  const float* __restrict__ aux0, const float* __restrict__ aux1, bool last, LAS unsigned char* lds, bool flush = true) {
    const int tid = TID(), lane = tid & 63, wave = __builtin_amdgcn_readfirstlane(tid >> 6), row = lane & 15, q = lane >> 4;
    LAS bf16_t* WtH = (LAS bf16_t*)lds; LAS bf16_t* WtL = WtH + 32 * NM_WLD;
    LAS float* red = (LAS float*)(WtL + 32 * NM_WLD);
    LAS float* lg = red + 128;
    LAS int* lcnt = (LAS int*)(lg + 8 * 16 * 32);
    float* xs = (float*)(k.ws + WS_XS);
    bf16_t* hbuf = (bf16_t*)(k.ws + AR_HBUF);
    const float* mod = (const float*)(k.ws + WS_MOD);
    const bf16_t* ys = (const bf16_t*)(k.ws + AR_YS);
    const int* tokp = (const int*)(k.ws + WS_TOKP); const float* tokw = (const float*)(k.ws + WS_TOKW);
    if (MODE == 1 && tid < 32) lcnt[tid] = 0;
    for (int idx = tid; idx < 1024 * 32; idx += NTHR) {
        const int kk = idx >> 5, n = idx & 31;
        const float w = Wsk[(size_t)kk * ldw + n]; const bf16_t hi = f2bf(w);
        WtH[n * NM_WLD + kk] = hi; WtL[n * NM_WLD + kk] = f2bf(w - bf2f(hi));
    }
    __syncthreads();
    const int cbase = 128 * wave + 8 * q;
    f32x4 xn[8];
    int bt = blockIdx.x;
    if (bt < T / 16) {
        const float* sb = first ? (16 * bt < TC ? k.ctx : k.x - (size_t)TC * 1024) : xs;
        const unsigned off = (unsigned)(16 * bt + row) * 1024u + (unsigned)cbase;
#pragma unroll
        for (int kk = 0; kk < 4; ++kk) { xn[2 * kk] = *(const f32x4*)(sb + off + 32 * kk); xn[2 * kk + 1] = *(const f32x4*)(sb + off + 32 * kk + 4); }
    }
    const float tail0 = (MODE == 1) ? aux0[tid & 31] : -expf(aux0[tid & 15]), tail1 = (MODE == 1) ? 0.f : aux1[tid & 15];
    int cur_mr = -1; float gsv[32], shv[32];
    for (; bt < T / 16; bt += gridDim.x) {
        const int r = 16 * bt + row, mr = modrow(16 * bt);
        const unsigned roff = (unsigned)r * 1024u + (unsigned)cbase;
        if (MODE == 1 && mr != cur_mr) {
            cur_mr = mr;
            const float* shift = mod + ((size_t)(layer * 3 + mr) * 6 + mb) * 1024;
#pragma unroll
            for (int kk = 0; kk < 4; ++kk) {
                const unsigned co = (unsigned)cbase + 32u * kk;
                const f32x4 g0 = *(const f32x4*)(gain + co), g1 = *(const f32x4*)(gain + co + 4), s0 = *(const f32x4*)(shift + 1024 + co), s1 = *(const f32x4*)(shift + 1024 + co + 4),
                            h0 = *(const f32x4*)(shift + co), h1 = *(const f32x4*)(shift + co + 4);
#pragma unroll
                for (int e = 0; e < 4; ++e) { gsv[8 * kk + e] = g0[e] * (1.0f + s0[e]); gsv[8 * kk + 4 + e] = g1[e] * (1.0f + s1[e]); shv[8 * kk + e] = h0[e]; shv[8 * kk + 4 + e] = h1[e]; }
            }
#pragma unroll
            for (int e = 0; e < 32; ++e) asm volatile("" :: "v"(shv[e]));
        }
        float x[32];
#pragma unroll
        for (int i = 0; i < 8; ++i) { x[4 * i] = xn[i][0]; x[4 * i + 1] = xn[i][1]; x[4 * i + 2] = xn[i][2]; x[4 * i + 3] = xn[i][3]; }
        int p0 = 0, p1 = 0; float w0 = 0.f, w1 = 0.f;
        if (combine) { p0 = tokp[2 * r]; p1 = tokp[2 * r + 1]; w0 = tokw[2 * r]; w1 = tokw[2 * r + 1]; }
        {
            const int bn = bt + gridDim.x;
            if (bn < T / 16) {
                const float* sb = first ? (16 * bn < TC ? k.ctx : k.x - (size_t)TC * 1024) : xs;
                const unsigned off = (unsigned)(16 * bn + row) * 1024u + (unsigned)cbase;
#pragma unroll
                for (int kk = 0; kk < 4; ++kk) { xn[2 * kk] = *(const f32x4*)(sb + off + 32 * kk); xn[2 * kk + 1] = *(const f32x4*)(sb + off + 32 * kk + 4); }
            }
        }
        if (combine) {
            const float* g5 = mod + ((size_t)((layer - 1) * 3 + mr) * 6 + 5) * 1024;
            u32x4 ya[4], yb[4]; float g5v[32];
#pragma unroll
            for (int kk = 0; kk < 4; ++kk) { ya[kk] = *(const u32x4*)(ys + (size_t)p0 * 1024 + cbase + 32 * kk); yb[kk] = *(const u32x4*)(ys + (size_t)p1 * 1024 + cbase + 32 * kk);
                const f32x4 ga = *(const f32x4*)(g5 + cbase + 32 * kk), gb2 = *(const f32x4*)(g5 + cbase + 32 * kk + 4);
#pragma unroll
                for (int e = 0; e < 4; ++e) { g5v[8 * kk + e] = ga[e]; g5v[8 * kk + 4 + e] = gb2[e]; } }
            asm volatile("" ::: "memory");
#pragma unroll
            for (int kk = 0; kk < 4; ++kk)
#pragma unroll
                for (int w = 0; w < 4; ++w) {
                    x[8 * kk + 2 * w] += g5v[8 * kk + 2 * w] * (w0 * __uint_as_float(ya[kk][w] << 16) + w1 * __uint_as_float(yb[kk][w] << 16));
                    x[8 * kk + 2 * w + 1] += g5v[8 * kk + 2 * w + 1] * (w0 * __uint_as_float(ya[kk][w] & 0xffff0000u) + w1 * __uint_as_float(yb[kk][w] & 0xffff0000u));
                }
        }
        if (first || combine) {
#pragma unroll
            for (int kk = 0; kk < 4; ++kk) {
                *(f32x4*)(xs + roff + 32 * kk) = (f32x4){x[8 * kk], x[8 * kk + 1], x[8 * kk + 2], x[8 * kk + 3]};
                *(f32x4*)(xs + roff + 32 * kk + 4) = (f32x4){x[8 * kk + 4], x[8 * kk + 5], x[8 * kk + 6], x[8 * kk + 7]};
            }
        }
        float ss = 0.f;
#pragma unroll
        for (int i = 0; i < 32; ++i) ss += x[i] * x[i];
        ss += shx(ss, 16, lane); ss += shx(ss, 32, lane);
        if (q == 0) red[wave * 16 + row] = ss;
        __syncthreads();
        float tot = 0.f;
#pragma unroll
        for (int w = 0; w < 8; ++w) tot += red[w * 16 + row];
        const float rstd = rsqrtf(tot * (1.0f / 1024.0f) + EPS);
        f32x4 acc[2]; acc[0] = (f32x4){0.f, 0.f, 0.f, 0.f}; acc[1] = (f32x4){0.f, 0.f, 0.f, 0.f};
#pragma unroll
        for (int kk = 0; kk < 4; ++kk) {
            float y[8]; u32x4 ah, al;
            if (MODE == 1) {
#pragma unroll
                for (int e = 0; e < 8; ++e) y[e] = x[8 * kk + e] * rstd * gsv[8 * kk + e] + shv[8 * kk + e];
            } else {
                const float* shift = mod + ((size_t)(layer * 3 + mr) * 6 + mb) * 1024;
                const unsigned co = (unsigned)cbase + 32u * kk;
                const f32x4 g0 = *(const f32x4*)(gain + co), g1 = *(const f32x4*)(gain + co + 4), s0 = *(const f32x4*)(shift + 1024 + co), s1 = *(const f32x4*)(shift + 1024 + co + 4),
                            h0 = *(const f32x4*)(shift + co), h1 = *(const f32x4*)(shift + co + 4);
#pragma unroll
                for (int e = 0; e < 4; ++e) { y[e] = x[8 * kk + e] * rstd * g0[e] * (1.0f + s0[e]) + h0[e]; y[4 + e] = x[8 * kk + 4 + e] * rstd * g1[e] * (1.0f + s1[e]) + h1[e]; }
            }
#pragma unroll
            for (int w = 0; w < 4; ++w) {
                ah[w] = pk2(y[2 * w], y[2 * w + 1]);
                al[w] = pk2(y[2 * w] - __uint_as_float(ah[w] << 16), y[2 * w + 1] - __uint_as_float(ah[w] & 0xffff0000u));
            }
            *(u32x4*)(hbuf + roff + 32 * kk) = ah;
            const bf16x8 fah = __builtin_bit_cast(bf16x8, ah), fal = __builtin_bit_cast(bf16x8, al);
            bf16x8 bh[2], bl[2];
#pragma unroll
            for (int nt = 0; nt < 2; ++nt) {
                bh[nt] = *(const LAS bf16x8*)(WtH + (16 * nt + row) * NM_WLD + cbase + 32 * kk);
                bl[nt] = *(const LAS bf16x8*)(WtL + (16 * nt + row) * NM_WLD + cbase + 32 * kk);
            }
            asm volatile("" ::: "memory");
#pragma unroll
            for (int nt = 0; nt < 2; ++nt) {
                acc[nt] = __builtin_amdgcn_mfma_f32_16x16x32_bf16(fah, bh[nt], acc[nt], 0, 0, 0);
                acc[nt] = __builtin_amdgcn_mfma_f32_16x16x32_bf16(fal, bh[nt], acc[nt], 0, 0, 0);
                acc[nt] = __builtin_amdgcn_mfma_f32_16x16x32_bf16(fah, bl[nt], acc[nt], 0, 0, 0);
            }
        }
#pragma unroll
        for (int nt = 0; nt < 2; ++nt)
#pragma unroll
            for (int j = 0; j < 4; ++j) lg[(wave * 16 + 4 * q + j) * 32 + 16 * nt + row] = acc[nt][j];
        __syncthreads();
        {
            const int prow = tid >> 5, n = tid & 31, rr = 16 * bt + prow, hb = lane & 32;
            float val = 0.f;
#pragma unroll
            for (int w = 0; w < 8; ++w) val += lg[(w * 16 + prow) * 32 + n];
            if (MODE == 1) {
                int* toke = (int*)(k.ws + WS_TOKE); float* tokwW = (float*)(k.ws + WS_TOKW);
                const bool unrouted = last && rr < TC;
                const float sc = 1.0f / (1.0f + expf(-val)), ch = sc + tail0;
                const int gl = hb + (n & ~3);
                const float ca = shi(ch, gl), cb = shi(ch, gl + 1), cc = shi(ch, gl + 2), cd = shi(ch, gl + 3);
                const float hi1 = fmaxf(ca, cb), lo1 = fminf(ca, cb), hi2 = fmaxf(cc, cd), lo2 = fminf(cc, cd);
                float gs = fmaxf(hi1, hi2) + fmaxf(fminf(hi1, hi2), fmaxf(lo1, lo2));
                int gi = n >> 2;
#pragma unroll
                for (int m = 4; m <= 16; m <<= 1) {
                    const float og = shx(gs, m, lane); const int oi = shii(gi, lane ^ m);
                    if (og > gs || (og == gs && oi < gi)) { gs = og; gi = oi; }
                }
                float c4[4], s4[4];
#pragma unroll
                for (int i = 0; i < 4; ++i) { c4[i] = shi(ch, hb + gi * 4 + i); s4[i] = shi(sc, hb + gi * 4 + i); }
                int i1 = 0; float b1v = c4[0];
#pragma unroll
                for (int i = 1; i < 4; ++i) if (c4[i] > b1v) { b1v = c4[i]; i1 = i; }
                int i2 = -1; float b2v = -1e30f;
#pragma unroll
                for (int i = 0; i < 4; ++i) if (i != i1 && c4[i] > b2v) { b2v = c4[i]; i2 = i; }
                float w1v = 0.f, w2v = 0.f;
#pragma unroll
                for (int i = 0; i < 4; ++i) { if (i == i1) w1v = s4[i]; if (i == i2) w2v = s4[i]; }
                const float inv = 1.0f / (w1v + w2v);
                if (n == 0) {
                    if (unrouted) { int neg = -1; asm volatile("" : "+v"(neg)); toke[2 * rr] = neg; toke[2 * rr + 1] = neg; }
                    else {
                        const int e1 = gi * 4 + i1, e2 = gi * 4 + i2;
                        toke[2 * rr] = e1; toke[2 * rr + 1] = e2; tokwW[2 * rr] = w1v * inv; tokwW[2 * rr + 1] = w2v * inv;
                        __hip_atomic_fetch_add(lcnt + e1, 1, __ATOMIC_RELAXED, __HIP_MEMORY_SCOPE_WORKGROUP);
                        __hip_atomic_fetch_add(lcnt + e2, 1, __ATOMIC_RELAXED, __HIP_MEMORY_SCOPE_WORKGROUP);
                    }
                }
            } else {
                float* gb = (float*)(k.ws + WS_GB);
                if (n < 16) {
                    const float z = val + tail1;
                    const float ez = __expf(z); const float sp = z > 15.f ? z : (ez < 1e-4f ? ez - 0.5f * ez * ez : __logf(1.0f + ez));
                    gb[(size_t)rr * 32 + n] = tail0 * sp;
                } else {
                    gb[(size_t)rr * 32 + n] = 1.0f / (1.0f + expf(-val));
                }
            }
        }
        __syncthreads();
    }
    if (MODE == 1) {
        __syncthreads();
        int* cnt = (int*)(k.ws + WS_CTL + CTL_CNT) + layer * 32;
        if (flush && tid < 32 && lcnt[tid] > 0) atomicAdd(&cnt[tid], lcnt[tid]);
    }
}

namespace pg8 {
constexpr int BM = 256, BK = 64, HALF = 128, HTB = HALF * BK * 2, STAGE_BYTES = 8 * HTB;
DI int lds_byte(int r, int c) { const int st = (r >> 4) * 2 + (c >> 5), rr = r & 15, cc = c & 31, ob = rr * 64 + cc * 2; return st * 1024 + (ob ^ (((ob >> 9) & 1) << 5)); }
DI void stage_rc(int b, int& R, int& C) { const int st = b / 1024, sb = b % 1024, swz = sb ^ (((sb >> 9) & 1) << 5); R = (st >> 1) * 16 + swz / 64; C = (st & 1) * 32 + (swz % 64) / 2; }
DI int perm32(int rho) { const int n = rho >> 4, i = rho & 15; return 8 * (i >> 2) + 4 * n + (i & 3); }
struct Unit { int m0, mrows, pn; size_t boff; };
template <bool GATHER, class Epi, class Sched>
DI void gemm_phase(LAS unsigned char* lds, const bf16_t* A, const int* rowidx, const bf16_t* Bt, int K, const Sched& S, const Epi& E) {
    const int tid = TID(), wid = __builtin_amdgcn_readfirstlane(tid >> 6), lane = tid & 63, wr = wid >> 2, wc = wid & 3, fr = lane & 15, fq = lane >> 4;
    const int nt = K / BK;
    unsigned voffA[2], voffB[2];
#pragma unroll
    for (int i = 0; i < 2; ++i) { int R, C; stage_rc(tid * 16 + i * 8192, R, C); const int Rb = Epi::PERM ? ((R & ~31) + perm32(R & 31)) : R;
        voffA[i] = (unsigned)(R * K + C) * 2u; voffB[i] = (unsigned)(Rb * K + C) * 2u; }
    const size_t kstep = (size_t)(BK * 2);
    const size_t hstep = (size_t)HALF * K * 2;
    const size_t tstep = 2 * hstep;
    const size_t rstep = (size_t)K * 2;
    const unsigned ldsw = (unsigned)wid * 1024u;
    const int aoff = lds_byte(wr * 64 + fr, fq * 8), boff = lds_byte(wc * 32 + fr, fq * 8);
#define PG8_SA(b, h) (((b) * 2 + (h)) * HTB)
#define PG8_SB(b, h) ((4 + (b) * 2 + (h)) * HTB)
#define PG8_STAGE(bufoff, gbase, voff) do { _Pragma("unroll") for (int _i = 0; _i < 2; ++_i) \
        __builtin_amdgcn_global_load_lds((const unsigned*)((const char*)(gbase) + (voff)[_i]), (LAS unsigned*)(lds + (bufoff) + ldsw + _i * 8192), 16, 0, 0); } while (0)
#define PG8_STAGE_A(bufoff, p, h, vG) do { if (GATHER) PG8_STAGE(bufoff, p, (vG)[h]); else PG8_STAGE(bufoff, (p) + (h) * hstep, voffA); } while (0)
#define PG8_LDA(dst, b, h) do { _Pragma("unroll") for (int m = 0; m < 4; ++m) _Pragma("unroll") for (int k = 0; k < 2; ++k) dst[m][k] = *(const LAS bf16x8*)(lds + PG8_SA(b, h) + aoff + m * 2048 + k * 1024); } while (0)
#define PG8_LDB(dst, b, h) do { _Pragma("unroll") for (int n = 0; n < 2; ++n) _Pragma("unroll") for (int k = 0; k < 2; ++k) dst[n][k] = *(const LAS bf16x8*)(lds + PG8_SB(b, h) + boff + n * 2048 + k * 1024); } while (0)
#define PG8_MMA(ai, bj, At, Bt_) do { __builtin_amdgcn_s_setprio(1); _Pragma("unroll") for (int m = 0; m < 4; ++m) _Pragma("unroll") for (int n = 0; n < 2; ++n) _Pragma("unroll") for (int k = 0; k < 2; ++k) \
        acc[ai][bj][m][n] = __builtin_amdgcn_mfma_f32_16x16x32_bf16(Bt_[n][k], At[m][k], acc[ai][bj][m][n], 0, 0, 0); __builtin_amdgcn_s_setprio(0); } while (0)
#define PG8_WAIT_V(n) asm volatile("s_waitcnt vmcnt(" #n ")" ::: "memory")
#define PG8_WAIT_L(n) asm volatile("s_waitcnt lgkmcnt(" #n ")" ::: "memory")
#define PG8_BAR __builtin_amdgcn_s_barrier()
#define PG8_SCHED __builtin_amdgcn_sched_barrier(0)
#define PG8_AOFF(dst, u) do { _Pragma("unroll") for (int _h = 0; _h < 2; ++_h) _Pragma("unroll") for (int _i = 0; _i < 2; ++_i) { int _R, _C; stage_rc(tid * 16 + _i * 8192, _R, _C); \
        dst[_h][_i] = (unsigned)(rowidx[(u).m0 + _h * HALF + _R] * K + _C) * 2u; } } while (0)
    Unit cur, nxt; int ui = 0;
    if (!S.next(0, cur)) return;
    f32x4 acc[2][2][4][2];
#pragma unroll
    for (int a = 0; a < 2; ++a)
#pragma unroll
        for (int b = 0; b < 2; ++b)
#pragma unroll
            for (int m = 0; m < 4; ++m)
#pragma unroll
                for (int n = 0; n < 2; ++n) acc[a][b][m][n] = (f32x4){0.f, 0.f, 0.f, 0.f};
    bf16x8 At[4][2], B0[2][2], B1[2][2];
    unsigned vA[2][2], vN[2][2];
    if (GATHER) PG8_AOFF(vA, cur);
    const char* cA = (const char*)A + (GATHER ? (size_t)0 : (size_t)cur.m0 * rstep);
    const char* cB = (const char*)Bt + cur.boff + (size_t)cur.pn * tstep;
    PG8_STAGE(PG8_SB(0, 0), cB, voffB); PG8_STAGE_A(PG8_SA(0, 0), cA, 0, vA); PG8_STAGE(PG8_SB(0, 1), cB + hstep, voffB); PG8_STAGE_A(PG8_SA(0, 1), cA, 1, vA);
    if (wr == 1) PG8_BAR;
    PG8_WAIT_V(4); PG8_BAR;
    PG8_STAGE(PG8_SB(1, 0), cB + kstep, voffB); PG8_STAGE_A(PG8_SA(1, 0), cA + kstep, 0, vA); PG8_STAGE(PG8_SB(1, 1), cB + hstep + kstep, voffB);
    PG8_WAIT_V(6); PG8_BAR;
    for (;;) {
        const bool has_next = S.next(ui + 1, nxt);
        const char* nA = GATHER ? cA : (has_next ? (const char*)A + (size_t)nxt.m0 * rstep : cA);
        const char* nB = has_next ? (const char*)Bt + nxt.boff + (size_t)nxt.pn * tstep : cB;
        if (GATHER) {
            if (has_next) { PG8_AOFF(vN, nxt); }
            else {
#pragma unroll
                for (int h = 0; h < 2; ++h)
#pragma unroll
                    for (int i = 0; i < 2; ++i) vN[h][i] = vA[h][i];
            }
        }
        for (int t = 0; t < nt; t += 2) {
            const bool last = (t == nt - 2);
            const char* a1 = cA + (size_t)(t + 1) * kstep;
            const char* a2 = last ? nA : cA + (size_t)(t + 2) * kstep; const char* b2 = last ? nB : cB + (size_t)(t + 2) * kstep;
            const char* a3 = a2 + kstep; const char* b3 = b2 + kstep;
            PG8_LDB(B0, 0, 0); PG8_SCHED; PG8_LDA(At, 0, 0); PG8_STAGE_A(PG8_SA(1, 1), a1, 1, vA);
            if (GATHER && last) {
#pragma unroll
                for (int h = 0; h < 2; ++h)
#pragma unroll
                    for (int i = 0; i < 2; ++i) vA[h][i] = vN[h][i];
            }
            PG8_WAIT_L(8); PG8_BAR; PG8_WAIT_L(0); PG8_MMA(0, 0, At, B0); PG8_BAR; PG8_SCHED;
            PG8_LDB(B1, 0, 1); PG8_STAGE(PG8_SB(0, 0), b2, voffB);
            PG8_BAR; PG8_WAIT_L(0); PG8_MMA(0, 1, At, B1); PG8_BAR;
            PG8_LDA(At, 0, 1); PG8_STAGE_A(PG8_SA(0, 0), a2, 0, vA);
            PG8_BAR; PG8_WAIT_L(0); PG8_MMA(1, 0, At, B0); PG8_BAR; PG8_SCHED;
            PG8_STAGE(PG8_SB(0, 1), b2 + hstep, voffB);
            PG8_WAIT_V(6); PG8_BAR; PG8_MMA(1, 1, At, B1); PG8_BAR;
            PG8_LDB(B0, 1, 0); PG8_SCHED; PG8_LDA(At, 1, 0); PG8_STAGE_A(PG8_SA(0, 1), a2, 1, vA);
            PG8_WAIT_L(8); PG8_BAR; PG8_WAIT_L(0); PG8_MMA(0, 0, At, B0); PG8_BAR; PG8_SCHED;
            PG8_LDB(B1, 1, 1); PG8_STAGE(PG8_SB(1, 0), b3, voffB);
            PG8_BAR; PG8_WAIT_L(0); PG8_MMA(0, 1, At, B1); PG8_BAR;
            PG8_LDA(At, 1, 1); PG8_STAGE_A(PG8_SA(1, 0), a3, 0, vA);
            PG8_BAR; PG8_WAIT_L(0); PG8_MMA(1, 0, At, B0); PG8_BAR; PG8_SCHED;
            PG8_STAGE(PG8_SB(1, 1), b3 + hstep, voffB);
            PG8_WAIT_V(6); PG8_BAR; PG8_MMA(1, 1, At, B1); PG8_BAR;
        }
        { const int t2 = TID(), l2 = t2 & 63; E(acc, cur, wr, wc, l2 & 15, l2 >> 4); }
        if (!has_next) break;
#pragma unroll
        for (int a = 0; a < 2; ++a)
#pragma unroll
            for (int b = 0; b < 2; ++b)
#pragma unroll
                for (int m = 0; m < 4; ++m)
#pragma unroll
                    for (int n = 0; n < 2; ++n) acc[a][b][m][n] = (f32x4){0.f, 0.f, 0.f, 0.f};
        cur = nxt; cA = nA; cB = nB; ++ui;
    }
    PG8_WAIT_V(0);
    if (wr == 0) PG8_BAR;
    PG8_BAR;
#undef PG8_SA
#undef PG8_SB
#undef PG8_STAGE
#undef PG8_STAGE_A
#undef PG8_LDA
#undef PG8_LDB
#undef PG8_MMA
#undef PG8_WAIT_V
#undef PG8_WAIT_L
#undef PG8_BAR
#undef PG8_SCHED
#undef PG8_AOFF
}
struct DenseOrder {
    int nM, nN, nwg, G, c;
    DI void init(int M, int N, int G_, int c_) { nM = M / BM; nN = N / BM; nwg = nM * nN; G = G_; c = c_; }
    DI bool next(int i, Unit& u) const {
        const long L = (long)i * G + c; if (L >= nwg) return false;
        int wgid = (int)L; { const int q = nwg / 8, r = nwg % 8, xcd = wgid % 8, off = wgid / 8; wgid = (xcd < r ? xcd * (q + 1) : r * (q + 1) + (xcd - r) * q) + off; }
        const int nig = 8 * nN, gid = wgid / nig, fm = gid * 8, gsz = (nM - fm) < 8 ? (nM - fm) : 8;
        u.m0 = (fm + ((wgid % nig) % gsz)) * BM; u.mrows = BM; u.pn = (wgid % nig) / gsz; u.boff = 0; return true;
    }
};
struct MoeOrder {
    const LAS int* tb; int G, c; size_t estride; int lane;
    DI bool next(int i, Unit& u) const {
        const int L = i * G + c; if (L >= __builtin_amdgcn_readfirstlane(tb[97]) * 4) return false;
        const int tile = L >> 2;
        const int pre = tb[65 + (lane & 31)];
        const unsigned long long m = __ballot(lane < 32 && pre <= tile);
        const int e = __popcll(m) - 1;
        const int lt = tile - __builtin_amdgcn_readfirstlane(tb[65 + e]); int mr = __builtin_amdgcn_readfirstlane(tb[e]) - lt * 256; mr = mr > 256 ? 256 : mr;
        u.m0 = __builtin_amdgcn_readfirstlane(tb[32 + e]) + lt * 256; u.mrows = mr; u.pn = L & 3; u.boff = (size_t)e * estride; return true;
    }
};
}
struct EpiBf16 {
    static constexpr bool PERM = true;
    bf16_t* C; int ldc; int split_col; bf16_t* C2; int ldc2;
    DI void operator()(const f32x4 (&acc)[2][2][4][2], const pg8::Unit& u, int wr, int wc, int fr, int fq) const {
        int colt = u.pn * 256; bf16_t* base = C; int ld = ldc;
        if (colt >= split_col) { base = C2; ld = ldc2; colt -= split_col; }
#pragma unroll
        for (int ai = 0; ai < 2; ++ai)
#pragma unroll
            for (int m = 0; m < 4; ++m) {
                const int rl = ai * 128 + wr * 64 + m * 16 + fr;
                if (rl < u.mrows) {
                    bf16_t* rowp = base + (size_t)(u.m0 + rl) * ld + colt + wc * 32 + 8 * fq;
#pragma unroll
                    for (int bj = 0; bj < 2; ++bj) {
                        const f32x4 v0 = acc[ai][bj][m][0], v1 = acc[ai][bj][m][1];
                        u32x4 o; o[0] = cvt_pk_bf16(v0[0], v0[1]); o[1] = cvt_pk_bf16(v0[2], v0[3]); o[2] = cvt_pk_bf16(v1[0], v1[1]); o[3] = cvt_pk_bf16(v1[2], v1[3]);
                        *(u32x4*)(rowp + bj * 128) = o;
                    }
                }
            }
    }
};
struct EpiBf16T {
    static constexpr bool PERM = false;
    bf16_t* C; int ldc;
    DI void operator()(const f32x4 (&acc)[2][2][4][2], const pg8::Unit& u, int wr, int wc, int fr, int fq) const {
#pragma unroll
        for (int ai = 0; ai < 2; ++ai)
#pragma unroll
            for (int bj = 0; bj < 2; ++bj)
#pragma unroll
                for (int m = 0; m < 4; ++m)
#pragma unroll
                    for (int n = 0; n < 2; ++n) {
                        const int row = u.m0 + ai * 128 + wr * 64 + m * 16 + fr, col = u.pn * 256 + bj * 128 + wc * 32 + n * 16 + 4 * fq;
#pragma unroll
                        for (int e = 0; e < 4; ++e) C[(size_t)(col + e) * ldc + row] = f2bf(acc[ai][bj][m][n][e]);
                    }
    }
};
struct EpiTaps {
    static constexpr bool PERM = false;
    bf16_t* FT;
    DI void operator()(const f32x4 (&acc)[2][2][4][2], const pg8::Unit& u, int wr, int wc, int fr, int fq) const {
#pragma unroll
        for (int ai = 0; ai < 2; ++ai)
#pragma unroll
            for (int m = 0; m < 4; ++m) {
                const int row = u.m0 + ai * 128 + wr * 64 + m * 16 + fr; const float dl = hy_delta(row & 1023) * (1.0f / 16383.0f);
#pragma unroll
                for (int bj = 0; bj < 2; ++bj)
#pragma unroll
                    for (int n = 0; n < 2; ++n) {
                        const int l = u.pn * 256 + bj * 128 + wc * 32 + n * 16 + 4 * fq; float o[4];
#pragma unroll
                        for (int e = 0; e < 4; ++e) o[e] = acc[ai][bj][m][n][e] * __expf(-(float)(l + e) * dl);
                        u32x2 pk; pk[0] = pk2(o[0], o[1]); pk[1] = pk2(o[2], o[3]);
                        *(u32x2*)(FT + (size_t)row * 16384 + l) = pk;
                    }
            }
    }
};
struct EpiResid {
    static constexpr bool PERM = false;
    float* xs; const float* mod; int layer; int chunk;
    DI void operator()(const f32x4 (&acc)[2][2][4][2], const pg8::Unit& u, int wr, int wc, int fr, int fq) const {
        const float* g = mod + ((size_t)(layer * 3 + modrow(u.m0)) * 6 + chunk) * 1024;
#pragma unroll
        for (int bj = 0; bj < 2; ++bj)
#pragma unroll
            for (int n = 0; n < 2; ++n) {
                const int col = u.pn * 256 + bj * 128 + wc * 32 + n * 16 + 4 * fq; const f32x4 gv = *(const f32x4*)(g + col);
                float* p0 = xs + (size_t)(u.m0 + wr * 64 + fr) * 1024 + col;
                f32x4 old[8];
#pragma unroll
                for (int ai = 0; ai < 2; ++ai)
#pragma unroll
                    for (int m = 0; m < 4; ++m) old[ai * 4 + m] = *(const f32x4*)(p0 + (size_t)(ai * 128 + m * 16) * 1024);
                asm volatile("" ::: "memory");
#pragma unroll
                for (int ai = 0; ai < 2; ++ai)
#pragma unroll
                    for (int m = 0; m < 4; ++m) *(f32x4*)(p0 + (size_t)(ai * 128 + m * 16) * 1024) = old[ai * 4 + m] + gv * acc[ai][bj][m][n];
            }
    }
};
struct EpiGateUp {
    static constexpr bool PERM = false;
    bf16_t* hid;
    DI void operator()(const f32x4 (&acc)[2][2][4][2], const pg8::Unit& u, int wr, int wc, int fr, int fq) const {
#pragma unroll
        for (int ai = 0; ai < 2; ++ai)
#pragma unroll
            for (int m = 0; m < 4; ++m) {
                const int rl = ai * 128 + wr * 64 + m * 16 + fr;
                if (rl < u.mrows) {
#pragma unroll
                    for (int bj = 0; bj < 2; ++bj) {
                        const int hc = ((u.pn * 256 + bj * 128 + wc * 32) >> 1) + 4 * fq;
                        const f32x4 g = acc[ai][bj][m][0], up = acc[ai][bj][m][1];
                        u32x2 o; o[0] = cvt_pk_bf16(siluf(g[0]) * up[0], siluf(g[1]) * up[1]); o[1] = cvt_pk_bf16(siluf(g[2]) * up[2], siluf(g[3]) * up[3]);
                        *(u32x2*)(hid + (size_t)(u.m0 + rl) * 512 + hc) = o;
                    }
                }
            }
    }
};
template <class Epi>
PF void gemm_dense(LAS unsigned char* lds, const bf16_t* A, int M, const bf16_t* Bt, int N, int K, const Epi& epi) {
    pg8::DenseOrder S; S.init(M, N, (int)gridDim.x, (int)blockIdx.x);
    pg8::gemm_phase<false>(lds, A, (const int*)nullptr, Bt, K, S, epi);
}
DI void moe_table(const KC& k, int layer, LAS int* tb) {
    const int* cnt = (const int*)(k.ws + WS_CTL + CTL_CNT) + layer * 32;
    __syncthreads();
    const int tq = TID();
    if (tq < 32) tb[tq] = __hip_atomic_load(cnt + tq, __ATOMIC_RELAXED, __HIP_MEMORY_SCOPE_AGENT);
    __syncthreads();
    if (tq == 0) {
        int s = 0, tp = 0;
        for (int e = 0; e < 32; ++e) { tb[32 + e] = s; tb[65 + e] = tp; s += tb[e]; tp += (tb[e] + 255) >> 8; }
        tb[64] = s; tb[97] = tp;
    }
    __syncthreads();
}
template <int WHICH>
PF void moe_gemm(const KC& k, int layer, LAS unsigned char* lds, LAS int* tb) {
    moe_table(k, layer, tb);
    if (WHICH == 0) {
        pg8::MoeOrder S{tb, (int)gridDim.x, (int)blockIdx.x, (size_t)1024 * 1024 * 2, TID() & 63};
        EpiGateUp epi{(bf16_t*)(k.ws + AR_HID)};
        pg8::gemm_phase<true>(lds, (const bf16_t*)(k.ws + AR_HBUF), (const int*)(k.ws + WS_SLOT), (const bf16_t*)(k.ws + AR_WGU), 1024, S, epi);
    } else {
        pg8::MoeOrder S{tb, (int)gridDim.x, (int)blockIdx.x, (size_t)1024 * 512 * 2, TID() & 63};
        EpiBf16 epi{(bf16_t*)(k.ws + AR_YS), 1024, 1 << 30, nullptr, 0};
        pg8::gemm_phase<false>(lds, (const bf16_t*)(k.ws + AR_HID), (const int*)nullptr, (const bf16_t*)(k.ws + AR_WD), 512, S, epi);
    }
}
PF void moe_scatter(const KC& k, int layer, LAS int* tb) {
    moe_table(k, layer, tb);
    const int* toke = (const int*)(k.ws + WS_TOKE);
    int* tokp = (int*)(k.ws + WS_TOKP); int* slot = (int*)(k.ws + WS_SLOT);
    int* cur = (int*)(k.ws + WS_CTL + CTL_CNT) + 128 + layer * 32;
    LAS int* lc = tb + 128; LAS int* lb = tb + 160;
    const int tid = TID();
    if (blockIdx.x == 0 && tid < 256) slot[NA + tid] = 0;
    for (int r0 = blockIdx.x * NTHR; r0 < T; r0 += gridDim.x * NTHR) {
        const int r = r0 + tid;
        __syncthreads();
        if (tid < 32) lc[tid] = 0;
        __syncthreads();
        const int e0 = toke[2 * r], e1 = toke[2 * r + 1];
        int k0 = 0, k1 = 0;
        if (e0 >= 0) { k0 = __hip_atomic_fetch_add(lc + e0, 1, __ATOMIC_RELAXED, __HIP_MEMORY_SCOPE_WORKGROUP); k1 = __hip_atomic_fetch_add(lc + e1, 1, __ATOMIC_RELAXED, __HIP_MEMORY_SCOPE_WORKGROUP); }
        __syncthreads();
        if (tid < 32) lb[tid] = lc[tid] > 0 ? atomicAdd(&cur[tid], lc[tid]) : 0;
        __syncthreads();
        if (e0 >= 0) {
            const int p0 = tb[32 + e0] + lb[e0] + k0, p1 = tb[32 + e1] + lb[e1] + k1;
            slot[p0] = r; slot[p1] = r; tokp[2 * r] = p0; tokp[2 * r + 1] = p1;
        }
    }
}

DI void unpack8(const u32x4 v, float (&f)[8]) {
#pragma unroll
    for (int w = 0; w < 4; ++w) { f[2 * w] = __uint_as_float(v[w] << 16); f[2 * w + 1] = __uint_as_float(v[w] & 0xffff0000u); }
}
PF void sc_mix(const KC& k, int j) {
    const int tid = TID(), lane = tid & 63, wave = tid >> 6;
    const bf16_t* P = (const bf16_t*)(k.ws + AR_PB);
    bf16_t* U = (bf16_t*)(k.ws + AR_UBUF);
    const float* cw = k.sc_conv + (size_t)j * 3 * 1024;
    const int c0 = lane * 16;
    float k0[16], k1[16], k2[16];
#pragma unroll
    for (int e = 0; e < 16; ++e) { k0[e] = cw[c0 + e]; k1[e] = cw[1024 + c0 + e]; k2[e] = cw[2048 + c0 + e]; }
    for (int r = blockIdx.x * 8 + wave; r < T; r += gridDim.x * 8) {
        bool lok, rok;
        if (r < TC) { const int t = r & 255; lok = t != 0; rok = t != 255; } else { const int t = (r - TC) & 63; lok = t != 0; rok = t != 63; }
        const bf16_t* p = P + (size_t)r * 3072 + c0;
        const bf16_t* pl = lok ? p - 3072 : p; const bf16_t* pr = rok ? p + 3072 : p;
        u32x4 vb[2], vc[2], vx[2], vcl[2], vxl[2], vcr[2], vxr[2];
#pragma unroll
        for (int hh = 0; hh < 2; ++hh) {
            vb[hh] = *(const u32x4*)(p + hh * 8); vc[hh] = *(const u32x4*)(p + 1024 + hh * 8); vx[hh] = *(const u32x4*)(p + 2048 + hh * 8);
            vcl[hh] = *(const u32x4*)(pl + 1024 + hh * 8); vxl[hh] = *(const u32x4*)(pl + 2048 + hh * 8);
            vcr[hh] = *(const u32x4*)(pr + 1024 + hh * 8); vxr[hh] = *(const u32x4*)(pr + 2048 + hh * 8);
        }
        asm volatile("" ::: "memory");
        const float fl = lok ? 1.f : 0.f, frr = rok ? 1.f : 0.f;
#pragma unroll
        for (int hh = 0; hh < 2; ++hh) {
            float bg[8], cg[8], xi[8], cl[8], xl[8], cr[8], xr[8];
            unpack8(vb[hh], bg); unpack8(vc[hh], cg); unpack8(vx[hh], xi); unpack8(vcl[hh], cl); unpack8(vxl[hh], xl); unpack8(vcr[hh], cr); unpack8(vxr[hh], xr);
            u32x4 o;
#pragma unroll
            for (int w = 0; w < 4; ++w) {
                float ov[2];
#pragma unroll
                for (int e = 0; e < 2; ++e) { const int i = 2 * w + e, c = hh * 8 + i; ov[e] = bg[i] * (k0[c] * fl * cl[i] * xl[i] + k1[c] * cg[i] * xi[i] + k2[c] * frr * cr[i] * xr[i]); }
                o[w] = pk2(ov[0], ov[1]);
            }
            *(u32x4*)(U + (size_t)r * 1024 + c0 + hh * 8) = o;
        }
    }
}

constexpr int DN_STEPS = 260, DN_UNITS = 32 * DN_STEPS;
DI int dn_rbase(int b, int dir, int s) {
    if (s < 4) return dir == 0 ? b * 256 + s * 64 : b * 256 + 255 - s * 64;
    const int cc = s - 4;
    return dir == 0 ? TC + b * SEQ + cc * 64 : TC + b * SEQ + SEQ - 1 - cc * 64;
}
struct DnRaw { u32x4 c[3][2], l[3][2], r[3][2]; float g, be; };
DI void dn_raw_load(const bf16_t* P, const float* gb, int u, int tid, DnRaw& R) {
    const int chain = u / DN_STEPS, s = u - chain * DN_STEPS, dir = chain & 1, h = (chain >> 1) & 7, b = chain >> 4;
    const int rbase = dn_rbase(b, dir, s), rstep = dir == 0 ? 1 : -1;
    const int i = tid >> 3, sg = tid & 7, r = rbase + rstep * i;
    bool lok, rok;
    if (r < TC) { const int t = r & 255; lok = t != 0; rok = t != 255; } else { const int t = (r - TC) & 63; lok = t != 0; rok = t != 63; }
#pragma unroll
    for (int part = 0; part < 3; ++part) {
        const bf16_t* pc = P + (size_t)r * 3072 + part * 1024 + h * 128 + sg * 16;
#pragma unroll
        for (int hf = 0; hf < 2; ++hf) {
            R.c[part][hf] = *(const u32x4*)(pc + hf * 8);
            R.l[part][hf] = (u32x4){0u, 0u, 0u, 0u}; R.r[part][hf] = (u32x4){0u, 0u, 0u, 0u};
            if (lok) R.l[part][hf] = *(const u32x4*)(pc - 3072 + hf * 8);
            if (rok) R.r[part][hf] = *(const u32x4*)(pc + 3072 + hf * 8);
        }
    }
    if (tid < 64) { const size_t row = (size_t)(rbase + rstep * tid); R.g = gb[row * 32 + dir * 8 + h]; R.be = gb[row * 32 + 16 + dir * 8 + h]; }
}
PF void dn_chunk(const KC& k, int jl, LAS unsigned char* lds) {
    const int tid = TID(), lane = tid & 63, wave = tid >> 6, fr = lane & 15, fq = lane >> 4;
    LAS bf16_t* Kt = (LAS bf16_t*)lds;
    LAS bf16_t* Qt = Kt + 64 * 136;
    LAS bf16_t* Vt = Qt + 64 * 136;
    LAS float* Amat = (LAS float*)(Vt + 64 * 136);
    LAS bf16_t* Tb = (LAS bf16_t*)(Amat + 64 * 64);
    LAS bf16_t* VbT = Tb + 64 * 72;
    LAS bf16_t* KbT = VbT + 128 * 72;
    LAS float* gcs = (LAS float*)(KbT + 128 * 72);
    LAS float* bet = gcs + 64; LAS float* eg = bet + 64; LAS float* egr = eg + 64;
    LAS float* Tm = egr + 64;
    LAS float* Wc = Tm + 64 * 64;
    const bf16_t* P = (const bf16_t*)(k.ws + AR_PB);
    const float* gb = (const float*)(k.ws + WS_GB);
    const float* cw = k.dn_conv + (size_t)jl * 3 * 3072;
    bf16_t* CH = (bf16_t*)(k.ws + AR_CHUNK);
    bf16_t* ATT = (bf16_t*)(k.ws + AR_HBUF);
    float* EGL = (float*)(k.ws + WS_EGL);
    for (int v = blockIdx.x; v < DN_UNITS; v += gridDim.x) {
        const int u = (v & 31) * DN_STEPS + (DN_STEPS - 1 - (v >> 5));
        DnRaw Rn; dn_raw_load(P, gb, u, tid, Rn);
        const int chain = u / DN_STEPS, s = u - chain * DN_STEPS, dir = chain & 1, h = (chain >> 1) & 7, b = chain >> 4;
        const int wti = tid < 288 ? tid : 0, wtap = wti / 96, wrem = wti - wtap * 96;
        const f32x4 wcv = *(const f32x4*)(cw + wtap * 3072 + (wrem >> 5) * 1024 + h * 128 + (wrem & 31) * 4);
        const int rbase = dn_rbase(b, dir, s), rstep = dir == 0 ? 1 : -1;
        bf16_t* cW = CH + (size_t)u * 32768; bf16_t* cQd = cW + 8192; bf16_t* cKd = cQd + 8192; bf16_t* cU = cKd + 8192;
        bf16_t* cAt = ATT + (size_t)u * 4096;
        lds_barrier();
        if (tid < 288) *(LAS f32x4*)(Wc + wtap * 384 + wrem * 4) = wcv;
        lds_barrier();
        const float g_in = Rn.g, be_in = Rn.be;
        {
            const int i = tid >> 3, sg = tid & 7;
#pragma unroll
            for (int part = 0; part < 3; ++part) {
                const int col = part * 1024 + h * 128 + sg * 16;
                float v[16];
#pragma unroll
                for (int hf = 0; hf < 2; ++hf) {
                    const u32x4 c4 = Rn.c[part][hf], l4 = Rn.l[part][hf], r4 = Rn.r[part][hf];
#pragma unroll
                    for (int w2 = 0; w2 < 2; ++w2) {
                        const LAS float* wp = Wc + part * 128 + sg * 16 + hf * 8 + 4 * w2;
                        const f32x4 k0 = *(const LAS f32x4*)wp, k1 = *(const LAS f32x4*)(wp + 384), k2 = *(const LAS f32x4*)(wp + 768);
#pragma unroll
                        for (int e = 0; e < 4; ++e) {
                            const int w = 2 * w2 + (e >> 1);
                            const float lv = __uint_as_float((e & 1) ? (l4[w] & 0xffff0000u) : (l4[w] << 16));
                            const float cv = __uint_as_float((e & 1) ? (c4[w] & 0xffff0000u) : (c4[w] << 16));
                            const float rv = __uint_as_float((e & 1) ? (r4[w] & 0xffff0000u) : (r4[w] << 16));
                            v[hf * 8 + 4 * w2 + e] = siluf(k0[e] * lv + k1[e] * cv + k2[e] * rv);
                        }
                    }
                }
                if (part < 2) {
                    float ss = 0.f;
#pragma unroll
                    for (int e = 0; e < 16; ++e) ss += v[e] * v[e];
                    ss += shx(ss, 1, lane); ss += shx(ss, 2, lane); ss += shx(ss, 4, lane);
                    const float sc = rsqrtf(ss + EPS) * (part == 0 ? 0.08838834764831845f : 1.0f);
#pragma unroll
                    for (int e = 0; e < 16; ++e) v[e] *= sc;
                }
                LAS bf16_t* dst = (part == 0 ? Qt : (part == 1 ? Kt : Vt)) + i * 136 + sg * 16;
                u32x4 o0, o1;
#pragma unroll
                for (int w = 0; w < 4; ++w) { o0[w] = pk2(v[2 * w], v[2 * w + 1]); o1[w] = pk2(v[8 + 2 * w], v[8 + 2 * w + 1]); }
                *(LAS u32x4*)dst = o0; *(LAS u32x4*)(dst + 8) = o1;
            }
        }
        if (wave == 0) {
            float g = g_in;
            const float be = be_in;
#pragma unroll
            for (int d = 1; d < 64; d <<= 1) { const float o = shi(g, (lane - d) & 63); if (lane >= d) g += o; }
            const float glast = shi(g, 63);
            gcs[lane] = g; bet[lane] = be; eg[lane] = expf(g); egr[lane] = expf(glast - g);
            if (lane == 0) EGL[u] = expf(glast);
        }
        lds_barrier();
#pragma unroll 1
        for (int x = 0; x < 4; ++x) {
            const int t = wave + 8 * x, isq = t >> 4, mt = (t >> 2) & 3, nt = t & 3;
            f32x4 acc = (f32x4){0.f, 0.f, 0.f, 0.f};
            const int jc = 16 * nt + fr;
            float gi4[4], bi4[4];
            const float gj = gcs[jc];
#pragma unroll
            for (int jj = 0; jj < 4; ++jj) { gi4[jj] = gcs[16 * mt + 4 * fq + jj]; bi4[jj] = bet[16 * mt + 4 * fq + jj]; }
            if (mt >= nt) {
                const LAS bf16_t* Ar = (isq ? Qt : Kt) + (16 * mt + fr) * 136 + 8 * fq;
                const LAS bf16_t* Br = Kt + (16 * nt + fr) * 136 + 8 * fq;
                bf16x8 fa4[4], fb4[4];
#pragma unroll
                for (int ks = 0; ks < 4; ++ks) { fa4[ks] = *(const LAS bf16x8*)(Ar + 32 * ks); fb4[ks] = *(const LAS bf16x8*)(Br + 32 * ks); }
                asm volatile("" ::: "memory");
#pragma unroll
                for (int ks = 0; ks < 4; ++ks) acc = __builtin_amdgcn_mfma_f32_16x16x32_bf16(fa4[ks], fb4[ks], acc, 0, 0, 0);
            }
#pragma unroll
            for (int jj = 0; jj < 4; ++jj) {
                const int ir = 16 * mt + 4 * fq + jj;
                const float dec = __expf(fminf(gi4[jj] - gj, 0.f));
                if (isq) cAt[((mt * 2 + (nt >> 1)) * 64 + (fr >> 2) * 16 + 4 * fq + jj) * 8 + (nt & 1) * 4 + (fr & 3)] = f2bf(ir >= jc ? acc[jj] * dec : 0.f);
                else Amat[ir * 64 + jc] = ir > jc ? bi4[jj] * acc[jj] * dec : 0.f;
            }
        }
        {
            const int vn = v + (int)gridDim.x < DN_UNITS ? v + (int)gridDim.x : v, un = (vn & 31) * DN_STEPS + (DN_STEPS - 1 - (vn >> 5));
            const int chn = un / DN_STEPS, stn = un - chn * DN_STEPS, dirn = chn & 1, hn = (chn >> 1) & 7, bn = chn >> 4;
            const int rbn = dn_rbase(bn, dirn, stn), rsn = dirn == 0 ? 1 : -1;
            const unsigned char* pa;
            if (tid < 396) { const int seg = tid >> 1, ri = seg / 3, part = seg - 3 * ri; int r = rbn + rsn * (ri - 1); r = r < 0 ? 0 : r > T - 1 ? T - 1 : r;
                             pa = (const unsigned char*)(P + (size_t)r * 3072 + part * 1024 + hn * 128 + (tid & 1) * 64); }
            else { const int j = tid < 460 ? tid - 396 : 0; pa = (const unsigned char*)(gb + (size_t)(rbn + rsn * j) * 32); }
            __builtin_amdgcn_global_load_lds((const unsigned*)pa, (LAS unsigned*)(lds + 143360), 4, 0, 0);
        }
        lds_barrier();
        {
        if (wave < 4) {
            if (lane < 16) {
                const int bo = 16 * wave;
                float tc[16];
#pragma unroll
                for (int i = 0; i < 16; ++i) {
                    f32x4 ar[4];
#pragma unroll
                    for (int q = 0; q < (i + 3) / 4; ++q) ar[q] = *(const LAS f32x4*)(Amat + (bo + i) * 64 + bo + 4 * q);
                    float a0 = (i == lane) ? 1.f : 0.f, a1 = 0.f;
#pragma unroll
                    for (int j = 0; j < i; ++j) { const float av = ar[j >> 2][j & 3]; if (j & 1) a1 -= av * tc[j]; else a0 -= av * tc[j]; }
                    tc[i] = a0 + a1;
                    Tm[(bo + i) * 64 + bo + lane] = tc[i];
                }
            }
        } else {
            for (int it = tid - 256; it < 1024; it += 256) {
                const int c = it & 127, ig = it >> 7;
                float kv[8], vv[8];
                { bf16_t kr[8], vr[8];
#pragma unroll
                  for (int e = 0; e < 8; ++e) { kr[e] = Kt[(8 * ig + e) * 136 + c]; vr[e] = Vt[(8 * ig + e) * 136 + c]; }
                  asm volatile("" ::: "memory");
#pragma unroll
                  for (int e = 0; e < 8; ++e) { kv[e] = bf2f(kr[e]); vv[e] = bf2f(vr[e]); } }
                u32x4 ov, ok, od;
#pragma unroll
                for (int w = 0; w < 4; ++w) {
                    const int i0 = 8 * ig + 2 * w, i1 = i0 + 1;
                    ov[w] = pk2(bet[i0] * vv[2 * w], bet[i1] * vv[2 * w + 1]);
                    ok[w] = pk2(bet[i0] * eg[i0] * kv[2 * w], bet[i1] * eg[i1] * kv[2 * w + 1]);
                    od[w] = pk2(egr[i0] * kv[2 * w], egr[i1] * kv[2 * w + 1]);
                }
                *(LAS u32x4*)(VbT + c * 72 + 8 * ig) = ov;
                *(LAS u32x4*)(KbT + c * 72 + 8 * ig) = ok;
                { bf16_t* kd0 = cKd + (((c >> 4) * 2 + (ig >> 2)) * 64 + (2 * (ig & 1)) * 16 + (c & 15)) * 8 + ((ig & 3) >> 1) * 4;
                  *(u32x2*)kd0 = (u32x2){od[0], od[1]}; *(u32x2*)(kd0 + 128) = (u32x2){od[2], od[3]}; }
            }
            for (int it = tid - 256; it < 1024; it += 256) {
                const int i = it >> 4, c8 = (it & 15) * 8; const float e = eg[i];
                const u32x4 qv = *(const LAS u32x4*)(Qt + i * 136 + c8); u32x4 o;
#pragma unroll
                for (int w = 0; w < 4; ++w) o[w] = pk2(__uint_as_float(qv[w] << 16) * e, __uint_as_float(qv[w] & 0xffff0000u) * e);
                { const int k8 = it & 15; bf16_t* qd0 = cQd + (((i >> 4) * 4 + (k8 >> 2)) * 64 + (2 * (k8 & 1)) * 16 + (i & 15)) * 8 + ((k8 & 3) >> 1) * 4;
                  *(u32x2*)qd0 = (u32x2){o[0], o[1]}; *(u32x2*)(qd0 + 128) = (u32x2){o[2], o[3]}; }
            }
        }
        lds_barrier();
#pragma unroll 1
        for (int d = 1; d < 4; ++d) {
            if (wave < 4 - d) {
                const int bi = wave + d, bj = wave, r = lane >> 2, c0 = 4 * (lane & 3);
                f32x4 m = (f32x4){0.f, 0.f, 0.f, 0.f};
                for (int kb = bj; kb < bi; ++kb) {
                    f32x4 av4[4], tv[16];
#pragma unroll
                    for (int q = 0; q < 4; ++q) av4[q] = *(const LAS f32x4*)(Amat + (16 * bi + r) * 64 + 16 * kb + 4 * q);
#pragma unroll
                    for (int kk = 0; kk < 16; ++kk) tv[kk] = *(const LAS f32x4*)(Tm + (16 * kb + kk) * 64 + 16 * bj + c0);
                    asm volatile("" ::: "memory");
#pragma unroll
                    for (int kk = 0; kk < 16; ++kk) m += tv[kk] * av4[kk >> 2][kk & 3];
                }
                *(LAS f32x4*)(Tm + (16 * bj + r) * 64 + 16 * bi + c0) = m;
                f32x4 t = (f32x4){0.f, 0.f, 0.f, 0.f};
                {
                    f32x4 dv4[4], mv[16];
#pragma unroll
                    for (int q = 0; q < 4; ++q) dv4[q] = *(const LAS f32x4*)(Tm + (16 * bi + r) * 64 + 16 * bi + 4 * q);
#pragma unroll
                    for (int kk = 0; kk < 16; ++kk) mv[kk] = *(const LAS f32x4*)(Tm + (16 * bj + kk) * 64 + 16 * bi + c0);
                    asm volatile("" ::: "memory");
#pragma unroll
                    for (int kk = 0; kk < 16; ++kk) t -= mv[kk] * dv4[kk >> 2][kk & 3];
                }
                *(LAS f32x4*)(Tm + (16 * bi + r) * 64 + 16 * bj + c0) = t;
            }
            lds_barrier();
        }
        for (int it = tid; it < 64 * 8; it += NTHR) {
            const int i = it >> 3, c8 = (it & 7) * 8; u32x4 o;
#pragma unroll
            for (int w = 0; w < 4; ++w) {
                const int c = c8 + 2 * w;
                o[w] = pk2(c <= i ? Tm[i * 64 + c] : 0.f, c + 1 <= i ? Tm[i * 64 + c + 1] : 0.f);
            }
            *(LAS u32x4*)(Tb + i * 72 + c8) = o;
        }
        }
        lds_barrier();
        {
            f32x4 au[4], aw[4];
#pragma unroll
            for (int mt = 0; mt < 4; ++mt) { au[mt] = (f32x4){0.f, 0.f, 0.f, 0.f}; aw[mt] = (f32x4){0.f, 0.f, 0.f, 0.f}; }
            bf16x8 bv[2], bk[2], at[2][4];
#pragma unroll
            for (int ks = 0; ks < 2; ++ks) {
                bv[ks] = *(const LAS bf16x8*)(VbT + (16 * wave + fr) * 72 + 32 * ks + 8 * fq);
                bk[ks] = *(const LAS bf16x8*)(KbT + (16 * wave + fr) * 72 + 32 * ks + 8 * fq);
#pragma unroll
                for (int mt = 0; mt < 4; ++mt) at[ks][mt] = *(const LAS bf16x8*)(Tb + (16 * mt + fr) * 72 + 32 * ks + 8 * fq);
            }
            asm volatile("" ::: "memory");
#pragma unroll
            for (int ks = 0; ks < 2; ++ks)
#pragma unroll
                for (int mt = 0; mt < 4; ++mt) {
                    au[mt] = __builtin_amdgcn_mfma_f32_16x16x32_bf16(at[ks][mt], bv[ks], au[mt], 0, 0, 0);
                    aw[mt] = __builtin_amdgcn_mfma_f32_16x16x32_bf16(at[ks][mt], bk[ks], aw[mt], 0, 0, 0);
                }
#pragma unroll
            for (int mt = 0; mt < 4; ++mt)
#pragma unroll
                for (int jj = 0; jj < 4; ++jj)
                    cW[((mt * 4 + (wave >> 1)) * 64 + (fr >> 2) * 16 + 4 * fq + jj) * 8 + (wave & 1) * 4 + (fr & 3)] = f2bf(aw[mt][jj]);
            {
                u32x4 u0, u1;
                u0[0] = pk2(au[0][0], au[0][1]); u0[1] = pk2(au[0][2], au[0][3]); u0[2] = pk2(au[1][0], au[1][1]); u0[3] = pk2(au[1][2], au[1][3]);
                u1[0] = pk2(au[2][0], au[2][1]); u1[1] = pk2(au[2][2], au[2][3]); u1[2] = pk2(au[3][0], au[3][1]); u1[3] = pk2(au[3][2], au[3][3]);
                bf16_t* ud = cU + (wave * 64 + lane) * 16;
                *(u32x4*)ud = u0; *(u32x4*)(ud + 8) = u1;
            }
        }
    }
}
DI bf16x8 pk8(f32x4 a, f32x4 b) { u32x4 r; r[0] = pk2(a[0], a[1]); r[1] = pk2(a[2], a[3]); r[2] = pk2(b[0], b[1]); r[3] = pk2(b[2], b[3]); return __builtin_bit_cast(bf16x8, r); }
constexpr int SC_PFD = 3;
DI bf16x8 ldfrag(const bf16_t* p) { return __builtin_bit_cast(bf16x8, *(const u32x4*)p); }
PF void dn_scan(const KC& k, LAS unsigned char* lds, int pm) {
    const int tid = TID(), lane = tid & 63, fr = lane & 15, fq = lane >> 4;
    const int wave = __builtin_amdgcn_readfirstlane(tid >> 6);
    const bf16_t* CH = (const bf16_t*)(k.ws + AR_CHUNK);
    const bf16_t* ATT = (const bf16_t*)(k.ws + AR_HBUF);
    const float* EGL = (const float*)(k.ws + WS_EGL);
    bf16_t* O = (bf16_t*)(k.ws + (pm ? AR_UBUF : AR_PB));
    LAS float* eglL = (LAS float*)lds;
    LAS u32x4* sbx = (LAS u32x4*)(eglL + 272);
    LAS u32x4* vbx = sbx + 512;
    volatile LAS int* vflag = (volatile LAS int*)(vbx + 256);
    for (int un0 = blockIdx.x; un0 < 256; un0 += gridDim.x) {
        if ((pm == 2 && ((un0 >> 3) & 1)) || (pm == 3 && (un0 & 1))) continue;
        const int un = (gridDim.x == 256) ? ((un0 & 7) * 32 + (un0 >> 3)) : un0;
        const int sl = un & 7, chain = un >> 3, dir = chain & 1, h = (chain >> 1) & 7, b = chain >> 4;
        const int rstep = dir == 0 ? 1 : -1;
        const bf16_t* U0 = CH + (size_t)(chain * DN_STEPS) * 32768 + lane * 8;
        const bf16_t* A0 = ATT + (size_t)(chain * DN_STEPS) * 4096 + lane * 8;
        lds_barrier();
        if (tid < DN_STEPS) eglL[tid] = EGL[chain * DN_STEPS + tid];
        if (tid == 0) *vflag = 0;
        if (wave == 0) {
            f32x4 S[8];
#pragma unroll
            for (int t = 0; t < 8; ++t) S[t] = (f32x4){0.f, 0.f, 0.f, 0.f};
            bf16x8 fw[16], fk[16]; u32x4 uc[2];
#pragma unroll
            for (int i = 0; i < 16; ++i) { fw[i] = ldfrag(U0 + i * 512); fk[i] = ldfrag(U0 + 16384 + i * 512); }
            { const bf16_t* up = U0 - lane * 8 + 24576 + (sl * 64 + lane) * 16; uc[0] = *(const u32x4*)up; uc[1] = *(const u32x4*)(up + 8); }
#pragma unroll
            for (int ks = 0; ks < 4; ++ks) sbx[ks * 64 + lane] = (u32x4){0u, 0u, 0u, 0u};
#pragma unroll
            for (int i = 0; i < 16; ++i) { asm volatile("" :: "v"(__builtin_bit_cast(u32x4, fw[i]))); asm volatile("" :: "v"(__builtin_bit_cast(u32x4, fk[i]))); }
            asm volatile("" :: "v"(uc[0]), "v"(uc[1]));
            lds_barrier();
#pragma unroll 1
            for (int s = 0; s < DN_STEPS; ++s) {
                const int sn = pm == 1 ? 0 : s + 1 < DN_STEPS ? s + 1 : s;
                const bf16_t* Un = U0 + (size_t)sn * 32768;
                const float egl = eglL[s];
                bf16x8 sb[4];
#pragma unroll
                for (int ks = 0; ks < 4; ++ks) sb[ks] = pk8(S[2 * ks], S[2 * ks + 1]);
                f32x4 p[4];
#pragma unroll
                for (int mt = 0; mt < 4; ++mt) p[mt] = (f32x4){0.f, 0.f, 0.f, 0.f};
#pragma unroll
                for (int ks = 0; ks < 4; ++ks)
#pragma unroll
                    for (int mt = 0; mt < 4; ++mt) {
                        p[mt] = __builtin_amdgcn_mfma_f32_16x16x32_bf16(fw[mt * 4 + ks], sb[ks], p[mt], 0, 0, 0);
                        fw[mt * 4 + ks] = ldfrag(Un + (mt * 4 + ks) * 512);
                    }
#pragma unroll
                for (int mt = 0; mt < 4; ++mt) {
                    const unsigned ua = uc[mt >> 1][(mt & 1) * 2], ub = uc[mt >> 1][(mt & 1) * 2 + 1];
                    p[mt][0] = __uint_as_float(ua << 16) - p[mt][0]; p[mt][1] = __uint_as_float(ua & 0xffff0000u) - p[mt][1];
                    p[mt][2] = __uint_as_float(ub << 16) - p[mt][2]; p[mt][3] = __uint_as_float(ub & 0xffff0000u) - p[mt][3];
                }
                { const bf16_t* up = Un - lane * 8 + 24576 + (sl * 64 + lane) * 16; uc[0] = *(const u32x4*)up; uc[1] = *(const u32x4*)(up + 8); }
                bf16x8 vb[2];
                vb[0] = pk8(p[0], p[1]); vb[1] = pk8(p[2], p[3]);
                vbx[(s & 1) * 64 + lane] = __builtin_bit_cast(u32x4, vb[0]); vbx[(s & 1) * 64 + 128 + lane] = __builtin_bit_cast(u32x4, vb[1]);
                asm volatile("s_waitcnt lgkmcnt(0)" ::: "memory");
                if (lane == 0) *vflag = s + 1;
#pragma unroll
                for (int t = 0; t < 8; ++t) S[t] = S[t] * egl;
#pragma unroll
                for (int kc = 0; kc < 2; ++kc)
#pragma unroll
                    for (int t = 0; t < 8; ++t) {
                        S[t] = __builtin_amdgcn_mfma_f32_16x16x32_bf16(fk[t * 2 + kc], vb[kc], S[t], 0, 0, 0);
                        fk[t * 2 + kc] = ldfrag(Un + 16384 + (t * 2 + kc) * 512);
                    }
#pragma unroll
                for (int ks = 0; ks < 4; ++ks) sbx[((s + 1) & 1) * 256 + ks * 64 + lane] = __builtin_bit_cast(u32x4, pk8(S[2 * ks], S[2 * ks + 1]));
                lds_barrier();
            }
        } else if (wave == 1) {
            bf16x8 fqd[16], fat[8];
#pragma unroll
            for (int i = 0; i < 16; ++i) fqd[i] = ldfrag(U0 + 8192 + i * 512);
#pragma unroll
            for (int i = 0; i < 8; ++i) fat[i] = ldfrag(A0 + i * 512);
#pragma unroll
            for (int i = 0; i < 16; ++i) asm volatile("" :: "v"(__builtin_bit_cast(u32x4, fqd[i])));
#pragma unroll
            for (int i = 0; i < 8; ++i) asm volatile("" :: "v"(__builtin_bit_cast(u32x4, fat[i])));
            f32x4 op[4];
#pragma unroll
            for (int mt = 0; mt < 4; ++mt) op[mt] = (f32x4){0.f, 0.f, 0.f, 0.f};
            lds_barrier();
#pragma unroll 1
            for (int s = 0; s < DN_STEPS; ++s) {
                const int sn = pm == 1 ? 0 : s + 1 < DN_STEPS ? s + 1 : s;
                const bf16_t* Un = U0 + (size_t)sn * 32768; const bf16_t* An = A0 + (size_t)sn * 4096;
                bf16x8 sb[4];
#pragma unroll
                for (int ks = 0; ks < 4; ++ks) sb[ks] = __builtin_bit_cast(bf16x8, sbx[(s & 1) * 256 + ks * 64 + lane]);
                {
                    const int sp = s > 0 ? s - 1 : 0; const int rbase = dn_rbase(b, dir, sp);
#pragma unroll
                    for (int mt = 0; mt < 4; ++mt)
#pragma unroll
                        for (int jj = 0; jj < 4; ++jj) {
                            const int row = rbase + rstep * (16 * mt + 4 * fq + jj);
                            O[((size_t)(pm ? 0 : dir) * T + row) * 1024 + h * 128 + sl * 16 + fr] = f2bf(op[mt][jj]);
                        }
                }
                f32x4 o[4];
#pragma unroll
                for (int mt = 0; mt < 4; ++mt) o[mt] = (f32x4){0.f, 0.f, 0.f, 0.f};
#pragma unroll
                for (int ks = 0; ks < 4; ++ks)
#pragma unroll
                    for (int mt = 0; mt < 4; ++mt) {
                        o[mt] = __builtin_amdgcn_mfma_f32_16x16x32_bf16(fqd[mt * 4 + ks], sb[ks], o[mt], 0, 0, 0);
                        fqd[mt * 4 + ks] = ldfrag(Un + 8192 + (mt * 4 + ks) * 512);
                    }
                while (*vflag < s + 1) __builtin_amdgcn_s_sleep(1);
                asm volatile("" ::: "memory");
                bf16x8 vb[2];
                vb[0] = __builtin_bit_cast(bf16x8, vbx[(s & 1) * 64 + lane]); vb[1] = __builtin_bit_cast(bf16x8, vbx[(s & 1) * 64 + 128 + lane]);
#pragma unroll
                for (int kc = 0; kc < 2; ++kc)
#pragma unroll
                    for (int mt = 0; mt < 4; ++mt) {
                        o[mt] = __builtin_amdgcn_mfma_f32_16x16x32_bf16(fat[mt * 2 + kc], vb[kc], o[mt], 0, 0, 0);
                        fat[mt * 2 + kc] = ldfrag(An + (mt * 2 + kc) * 512);
                    }
#pragma unroll
                for (int mt = 0; mt < 4; ++mt) op[mt] = o[mt];
                lds_barrier();
            }
            {
                const int rbase = dn_rbase(b, dir, DN_STEPS - 1);
#pragma unroll
                for (int mt = 0; mt < 4; ++mt)
#pragma unroll
                    for (int jj = 0; jj < 4; ++jj) {
                        const int row = rbase + rstep * (16 * mt + 4 * fq + jj);
                        O[((size_t)(pm ? 0 : dir) * T + row) * 1024 + h * 128 + sl * 16 + fr] = f2bf(op[mt][jj]);
                    }
            }
        } else if (wave == 2) {
            const unsigned char* P0 = (const unsigned char*)(CH + (size_t)(chain * DN_STEPS) * 32768 + sl * 4096) + lane * 64;
            const unsigned char* Q0 = (const unsigned char*)(ATT + (size_t)(chain * DN_STEPS) * 4096 + sl * 512) + (lane & 15) * 64;
            unsigned d0 = 0u, d1 = 0u, d2 = 0u;
            lds_barrier();
#pragma unroll 1
            for (int s = 0; s < DN_STEPS; ++s) {
                const int sp = pm == 1 ? 0 : s + SC_PFD < DN_STEPS ? s + SC_PFD : DN_STEPS - 1;
                const unsigned char* pa = P0 + (size_t)sp * 65536; const unsigned char* pb = pa + 4096; const unsigned char* qa = Q0 + (size_t)sp * 8192;
                asm volatile("global_load_dword %0, %3, off\n\tglobal_load_dword %1, %4, off\n\tglobal_load_dword %2, %5, off"
                             : "+v"(d0), "+v"(d1), "+v"(d2) : "v"(pa), "v"(pb), "v"(qa) : "memory");
                lds_barrier();
            }
            asm volatile("s_waitcnt vmcnt(0)" : "+v"(d0), "+v"(d1), "+v"(d2) :: "memory");
        } else {
            lds_barrier();
#pragma unroll 1
            for (int s = 0; s < DN_STEPS; ++s) lds_barrier();
        }
    }
}
PF void dn_finish(const KC& k, int j) {
    const int tid = TID(), lane = tid & 63, wave = tid >> 6;
    const bf16_t* O = (const bf16_t*)(k.ws + AR_PB);
    const bf16_t* Z = (const bf16_t*)k.out;
    bf16_t* U = (bf16_t*)(k.ws + AR_UBUF);
    const float* on = k.dn_out_norm + j * 128;
    const int c0 = lane * 16;
    float onv[16];
#pragma unroll
    for (int e = 0; e < 16; ++e) onv[e] = on[(c0 + e) & 127];
    for (int r = blockIdx.x * 8 + wave; r < T; r += gridDim.x * 8) {
        u32x4 vf[2], vb[2], vz[2];
#pragma unroll
        for (int hh = 0; hh < 2; ++hh) {
            vf[hh] = *(const u32x4*)(O + (size_t)r * 1024 + c0 + hh * 8); vb[hh] = *(const u32x4*)(O + ((size_t)T + r) * 1024 + c0 + hh * 8);
            vz[hh] = *(const u32x4*)(Z + (size_t)r * 1024 + c0 + hh * 8);
        }
        asm volatile("" ::: "memory");
        float o[16], z[16];
#pragma unroll
        for (int hh = 0; hh < 2; ++hh) { float a[8], b2[8], zz[8]; unpack8(vf[hh], a); unpack8(vb[hh], b2); unpack8(vz[hh], zz);
#pragma unroll
            for (int i = 0; i < 8; ++i) { o[hh * 8 + i] = a[i] + b2[i]; z[hh * 8 + i] = zz[i]; } }
        float ss = 0.f;
#pragma unroll
        for (int e = 0; e < 16; ++e) ss += o[e] * o[e];
        ss += shx(ss, 1, lane); ss += shx(ss, 2, lane); ss += shx(ss, 4, lane);
        const float rs = rsqrtf(ss * (1.0f / 128.0f) + EPS);
#pragma unroll
        for (int hh = 0; hh < 2; ++hh) { u32x4 ov;
#pragma unroll
            for (int w = 0; w < 4; ++w) { const int e0 = hh * 8 + 2 * w; ov[w] = pk2(o[e0] * rs * onv[e0] * siluf(z[e0]), o[e0 + 1] * rs * onv[e0 + 1] * siluf(z[e0 + 1])); }
            *(u32x4*)(U + (size_t)r * 1024 + c0 + hh * 8) = ov; }
    }
}

DI float conv3g(const bf16_t* p, int j, float w0, float w1, float w2) {
    const int gc = j & 63;
    const float l = gc != 0 ? bf2f(p[j - 1]) : 0.f, c = bf2f(p[j]), r = gc != 63 ? bf2f(p[j + 1]) : 0.f;
    return w0 * l + w1 * c + w2 * r;
}
DI float hy_conv_lane(float c, float w0, float w1, float w2, int lane) {
    const float l = shi(c, (lane + 63) & 63), r = shi(c, (lane + 1) & 63);
    return w0 * (lane > 0 ? l : 0.f) + w1 * c + w2 * (lane < 63 ? r : 0.f);
}
PF void hy_lat(const KC& k, int jl, LAS float* ldsf) {
    const int tid = TID();
    LAS cf* X = (LAS cf*)ldsf;
    LAS cf* tw = X + 17408;
    LAS cf* tA = tw + 1024; LAS cf* tB = tA + 128;
    const bf16_t* FT = (const bf16_t*)(k.ws + AR_FT);
    const bf16_t* PT = (const bf16_t*)(k.ws + AR_PB);
    bf16_t* ZT = (bf16_t*)(k.ws + AR_ZT);
    unsigned* scr = (unsigned*)(k.ws + AR_FFTS) + (size_t)blockIdx.x * 4 * 16384;
    unsigned* sKe = scr; unsigned* sKo = scr + 16384; unsigned* zp = scr + 2 * 16384; unsigned* ye = scr + 3 * 16384;
#define CPK(v) pk2((v).x, (v).y)
#define CUP(u_) ((cf){__uint_as_float((u_) << 16), __uint_as_float((u_) & 0xffff0000u)})
    const float* cw = k.hy_conv + (size_t)jl * 3 * 3072;
    for (int m = 0; m < 2; ++m) { const int p = tid + 512 * m; float sn, cs; sincospif(-(float)p / 8192.0f, &sn, &cs); cf w; w.x = cs; w.y = sn; tw[p] = w; }
    if (tid < 256) { const int a = tid & 127; float sn, cs; sincospif(-(float)(tid < 128 ? 128 * a : a) / 16384.0f, &sn, &cs); cf w; w.x = cs; w.y = sn; (tid < 128 ? tA : tB)[a] = w; }
    __syncthreads();
    const int lane = tid & 63;
#define HY_SPLIT() asm volatile("" ::: "memory")
#define HY_CONV(c, w0, w1, w2) hy_conv_lane((c), (w0), (w1), (w2), lane)
    for (int ch = blockIdx.x; ch < 1024; ch += gridDim.x) {
        {
            const bf16_t* pv = PT + (size_t)ch * T + TC;
            const float w0 = cw[ch], w1 = cw[3072 + ch], w2 = cw[6144 + ch];
            for (int m0 = 0; m0 < 32; m0 += 8) {
                bf16_t a0[8], a1[8];
#pragma unroll
                for (int q = 0; q < 8; ++q) { const int j = tid + 512 * (m0 + q); a0[q] = pv[j]; a1[q] = pv[SEQ + j]; }
                HY_SPLIT();
#pragma unroll
                for (int q = 0; q < 8; ++q) { const int j = tid + 512 * (m0 + q); const float c0 = bf2f(a0[q]), c1 = bf2f(a1[q]); cf z; z.x = HY_CONV(c0, w0, w1, w2); z.y = HY_CONV(c1, w0, w1, w2); zp[j] = CPK(z); }
            }
        }
        for (int n = 0; n < 2; ++n) {
            __syncthreads();
            const bf16_t* ftf = FT + (size_t)(n * 2048 + ch) * 16384; const bf16_t* ftb = FT + (size_t)(n * 2048 + 1024 + ch) * 16384;
            for (int m0 = 0; m0 < 32; m0 += 8) {
                bf16_t hfv[8], hbv[8];
#pragma unroll
                for (int q = 0; q < 8; ++q) { const int j = tid + 512 * (m0 + q); hfv[q] = ftf[j]; hbv[q] = ftb[j > 0 ? SEQ - j : 0]; }
                HY_SPLIT();
#pragma unroll
                for (int q = 0; q < 8; ++q) {
                    const int j = tid + 512 * (m0 + q);
                    const float hf = bf2f(hfv[q]), hb = j > 0 ? bf2f(hbv[q]) : 0.f;
                    const cf w = cmul(tA[j >> 7], tB[j & 127]);
                    cf a; a.x = hf + hb; a.y = 0.f; X[PIDX(j)] = a;
                    const float kd = hf - hb; cf o; o.x = kd * w.x; o.y = kd * w.y; sKo[j] = CPK(o);
                }
            }
            __syncthreads();
            fft16k_fwd(X, tw);
            unsigned Ker[32];
#pragma unroll
            for (int m = 0; m < 32; ++m) { const cf t_ = X[PIDX(tid + 512 * m)]; Ker[m] = CPK(t_); }
            __syncthreads();
            for (int m0 = 0; m0 < 32; m0 += 8) { unsigned t[8];
#pragma unroll
                for (int q = 0; q < 8; ++q) t[q] = sKo[tid + 512 * (m0 + q)];
                HY_SPLIT();
#pragma unroll
                for (int q = 0; q < 8; ++q) X[PIDX(tid + 512 * (m0 + q))] = CUP(t[q]); }
            __syncthreads();
            fft16k_fwd(X, tw);
            _Pragma("unroll 8") for (int m = 0; m < 32; ++m) { const int j = tid + 512 * m; const cf t_ = X[PIDX(j)]; sKo[j] = CPK(t_); }
            __syncthreads();
            for (int m0 = 0; m0 < 32; m0 += 8) { unsigned t[8];
#pragma unroll
                for (int q = 0; q < 8; ++q) t[q] = zp[tid + 512 * (m0 + q)];
                HY_SPLIT();
#pragma unroll
                for (int q = 0; q < 8; ++q) X[PIDX(tid + 512 * (m0 + q))] = CUP(t[q]); }
            __syncthreads();
            fft16k_fwd(X, tw);
#pragma unroll
            for (int m = 0; m < 32; ++m) { const int j = tid + 512 * m; X[PIDX(j)] = cmul(X[PIDX(j)], CUP(Ker[m])); }
            __syncthreads();
            fft16k_inv(X, tw);
            _Pragma("unroll 8") for (int m = 0; m < 32; ++m) { const int j = tid + 512 * m; const cf t_ = X[PIDX(j)]; ye[j] = CPK(t_); }
            __syncthreads();
            for (int m0 = 0; m0 < 32; m0 += 8) { unsigned t[8];
#pragma unroll
                for (int q = 0; q < 8; ++q) t[q] = zp[tid + 512 * (m0 + q)];
                HY_SPLIT();
#pragma unroll
                for (int q = 0; q < 8; ++q) { const int j = tid + 512 * (m0 + q); const cf w = cmul(tA[j >> 7], tB[j & 127]); X[PIDX(j)] = cmul(CUP(t[q]), w); } }
            __syncthreads();
            fft16k_fwd(X, tw);
            for (int m0 = 0; m0 < 32; m0 += 8) { unsigned t[8];
#pragma unroll
                for (int q = 0; q < 8; ++q) t[q] = sKo[tid + 512 * (m0 + q)];
                HY_SPLIT();
#pragma unroll
                for (int q = 0; q < 8; ++q) { const int j = tid + 512 * (m0 + q); X[PIDX(j)] = cmul(X[PIDX(j)], CUP(t[q])); } }
            __syncthreads();
            fft16k_inv(X, tw);
            {
                const bf16_t* pg = PT + (size_t)((n + 1) * 1024 + ch) * T + TC;
                const int gcol = (n + 1) * 1024 + ch;
                const float w0 = cw[gcol], w1 = cw[3072 + gcol], w2 = cw[6144 + gcol];
                const float bias = k.hy_bias[(size_t)jl * 2 * 1024 + n * 1024 + ch];
                for (int m0 = 0; m0 < 32; m0 += 8) {
                    unsigned te_[8], tz_[8]; bf16_t g0[8], g1[8];
#pragma unroll
                    for (int q = 0; q < 8; ++q) { const int j = tid + 512 * (m0 + q); te_[q] = ye[j]; tz_[q] = zp[j]; g0[q] = pg[j]; g1[q] = pg[SEQ + j]; }
                    HY_SPLIT();
#pragma unroll
                    for (int q = 0; q < 8; ++q) {
                        const int j = tid + 512 * (m0 + q);
                        cf w = cmul(tA[j >> 7], tB[j & 127]); w.y = -w.y;
                        const cf yo = cmul(X[PIDX(j)], w);
                        const cf te = CUP(te_[q]), tz = CUP(tz_[q]);
                        const float y0 = (0.5f / 16384.0f) * (te.x + yo.x), y1 = (0.5f / 16384.0f) * (te.y + yo.y);
                        const float c0 = bf2f(g0[q]), c1 = bf2f(g1[q]);
                        cf zn; zn.x = HY_CONV(c0, w0, w1, w2) * (y0 + bias * tz.x); zn.y = HY_CONV(c1, w0, w1, w2) * (y1 + bias * tz.y);
                        zp[j] = CPK(zn);
                    }
                }
            }
        }
        for (int m0 = 0; m0 < 32; m0 += 8) { unsigned t[8];
#pragma unroll
            for (int q = 0; q < 8; ++q) t[q] = zp[tid + 512 * (m0 + q)];
            HY_SPLIT();
#pragma unroll
            for (int q = 0; q < 8; ++q) { const int j = tid + 512 * (m0 + q); ZT[(size_t)ch * T + TC + j] = (bf16_t)(t[q] & 0xffffu); ZT[(size_t)ch * T + TC + SEQ + j] = (bf16_t)(t[q] >> 16); } }
        __syncthreads();
    }
#undef CPK
#undef CUP
#undef HY_SPLIT
#undef HY_CONV
}
PF void hy_ctx(const KC& k, int jl, LAS float* lds) {
    const int tid = TID(), t = tid & 255, hsel = tid >> 8;
    LAS float* z = lds + hsel * 1024; LAS float* G = z + 256;
    const bf16_t* PT = (const bf16_t*)(k.ws + AR_PB);
    bf16_t* U = (bf16_t*)(k.ws + AR_UBUF);
    const float* filtc = (const float*)(k.ws + WS_FILTC);
    const float* cw = k.hy_conv + (size_t)jl * 3 * 3072;
    const int tl = t != 0 ? t - 1 : t, tr = t != 255 ? t + 1 : t;
    for (int u = blockIdx.x; u < 1024; u += gridDim.x) {
        const int pr = u * 2 + hsel, b = pr >> 10, ch = pr & 1023;
        bf16_t v3[3][3]; float fv[2][2], cwv[3][3], bias[2];
#pragma unroll
        for (int m = 0; m < 3; ++m) {
            const bf16_t* pm = PT + (size_t)(m * 1024 + ch) * T + b * 256;
            v3[m][0] = pm[tl]; v3[m][1] = pm[t]; v3[m][2] = pm[tr];
#pragma unroll
            for (int tap = 0; tap < 3; ++tap) cwv[m][tap] = cw[tap * 3072 + m * 1024 + ch];
        }
#pragma unroll
        for (int n = 0; n < 2; ++n) {
            fv[n][0] = filtc[(size_t)t * 4096 + n * 2048 + ch]; fv[n][1] = filtc[(size_t)t * 4096 + n * 2048 + 1024 + ch];
            bias[n] = k.hy_bias[(size_t)jl * 2048 + n * 1024 + ch];
        }
        asm volatile("" ::: "memory");
        float c3[3];
#pragma unroll
        for (int m = 0; m < 3; ++m)
            c3[m] = cwv[m][0] * (t != 0 ? bf2f(v3[m][0]) : 0.f) + cwv[m][1] * bf2f(v3[m][1]) + cwv[m][2] * (t != 255 ? bf2f(v3[m][2]) : 0.f);
        float zc = c3[0];
#pragma unroll
        for (int n = 0; n < 2; ++n) {
            __syncthreads();
            z[t] = zc; G[255 + t] = fv[n][0]; if (t > 0) G[255 - t] = fv[n][1];
            __syncthreads();
            float y0 = 0.f, y1 = 0.f;
            const LAS float* gp = G + 255 + t;
#pragma unroll 2
            for (int s0 = 0; s0 < 256; s0 += 8) {
                const f32x4 za = *(const LAS f32x4*)(z + s0), zb = *(const LAS f32x4*)(z + s0 + 4);
                float gg[8];
#pragma unroll
                for (int e = 0; e < 8; ++e) gg[e] = gp[-(s0 + e)];
                y0 += gg[0] * za[0] + gg[2] * za[2] + gg[4] * zb[0] + gg[6] * zb[2];
                y1 += gg[1] * za[1] + gg[3] * za[3] + gg[5] * zb[1] + gg[7] * zb[3];
            }
            zc = c3[n + 1] * ((y0 + y1) + bias[n] * zc);
        }
        U[(size_t)(b * 256 + t) * 1024 + ch] = f2bf(zc);
        __syncthreads();
    }
}
PF void hy_transpose(const KC& k, LAS bf16_t* lds) {
    const int tid = TID();
    const bf16_t* ZT = (const bf16_t*)(k.ws + AR_ZT);
    bf16_t* U = (bf16_t*)(k.ws + AR_UBUF);
    for (int u = blockIdx.x; u < 16 * (TL / 64); u += gridDim.x) {
        const int c0 = (u & 15) * 64, r0 = TC + (u >> 4) * 64;
        { const int c = tid >> 3, sg = (tid & 7) * 8;
          const u32x4 v = *(const u32x4*)(ZT + (size_t)(c0 + c) * T + r0 + sg);
#pragma unroll
          for (int w = 0; w < 4; ++w) { lds[(sg + 2 * w) * 66 + c] = (bf16_t)(v[w] & 0xffff); lds[(sg + 2 * w + 1) * 66 + c] = (bf16_t)(v[w] >> 16); } }
        __syncthreads();
        { const int r = tid >> 3, sg = (tid & 7) * 8; u32x4 o;
#pragma unroll
          for (int w = 0; w < 4; ++w) o[w] = (unsigned)lds[r * 66 + sg + 2 * w] | ((unsigned)lds[r * 66 + sg + 2 * w + 1] << 16);
          *(u32x4*)(U + (size_t)(r0 + r) * 1024 + c0 + sg) = o; }
        __syncthreads();
    }
}

__global__ void __launch_bounds__(NTHR, 2) fwd_kernel(Params prm) {
    extern __shared__ __attribute__((aligned(16))) unsigned char lds_raw[];
    LAS unsigned char* lds = (LAS unsigned char*)lds_raw;
    LAS float* ldsf = (LAS float*)lds;
    LAS bf16_t* ldsh = (LAS bf16_t*)lds;
    LAS int* tb = (LAS int*)(lds + 150 * 1024);
    volatile LAS unsigned* xbw = (volatile LAS unsigned*)(lds + 151 * 1024 + 512);
    KC k;
    k.x = (const float*)(GAS const float*)prm.in[0]; k.c = (const float*)(GAS const float*)prm.in[1]; k.ctx = (const float*)(GAS const float*)prm.in[2]; k.c_ctx = (const float*)(GAS const float*)prm.in[3]; k.ada_w = (const float*)(GAS const float*)prm.in[4]; k.ada_b = (const float*)(GAS const float*)prm.in[5];
    k.norm_mix = (const float*)(GAS const float*)prm.in[6]; k.norm_ffn = (const float*)(GAS const float*)prm.in[7]; k.norm_final = (const float*)(GAS const float*)prm.in[8];
    k.dn_w_in = (const float*)(GAS const float*)prm.in[9]; k.dn_conv = (const float*)(GAS const float*)prm.in[10]; k.dn_a_log = (const float*)(GAS const float*)prm.in[11]; k.dn_dt_bias = (const float*)(GAS const float*)prm.in[12]; k.dn_out_norm = (const float*)(GAS const float*)prm.in[13]; k.dn_w_out = (const float*)(GAS const float*)prm.in[14];
    k.hy_w_in = (const float*)(GAS const float*)prm.in[15]; k.hy_conv = (const float*)(GAS const float*)prm.in[16]; k.hy_f_w1 = (const float*)(GAS const float*)prm.in[17]; k.hy_f_b1 = (const float*)(GAS const float*)prm.in[18]; k.hy_f_freq = (const float*)(GAS const float*)prm.in[19]; k.hy_f_w2 = (const float*)(GAS const float*)prm.in[20];
    k.hy_f_b2 = (const float*)(GAS const float*)prm.in[21]; k.hy_f_w3 = (const float*)(GAS const float*)prm.in[22]; k.hy_bias = (const float*)(GAS const float*)prm.in[23]; k.hy_w_out = (const float*)(GAS const float*)prm.in[24];
    k.sc_w_in = (const float*)(GAS const float*)prm.in[25]; k.sc_conv = (const float*)(GAS const float*)prm.in[26]; k.sc_w_out = (const float*)(GAS const float*)prm.in[27]; k.w_router = (const float*)(GAS const float*)prm.in[28]; k.router_bias = (const float*)(GAS const float*)prm.in[29];
    k.moe_w_gate = (const float*)(GAS const float*)prm.in[30]; k.moe_w_up = (const float*)(GAS const float*)prm.in[31]; k.moe_w_down = (const float*)(GAS const float*)prm.in[32];
    k.out = (float*)(GAS float*)prm.out; k.ws = (unsigned char*)(GAS unsigned char*)prm.ws;
    const int lo = prm.ph_lo, hi = prm.ph_hi;
    XcdBarrier bar; bar.bar = (unsigned*)(k.ws + WS_CTL); bar.x = 0; bar.st = xbw;
    if (hi - lo > 1) {
        if (threadIdx.x == 0) { xbw[0] = 0u; xbw[1] = 0u; }
        __syncthreads();
        bar = xcd_barrier_post((unsigned*)(k.ws + WS_CTL), xbw);
    }
    int ph = 0;
#define PROBE_OK(id) ((id) != 1 || i == 0)
    int i = 0;
#define PH_BEGIN(id) if (ph >= lo && ph < hi) { const int nrep_ = (((id) == PROBE_REP) && PROBE_OK(id)) ? 2 : 1; for (int rep_ = 0; rep_ < nrep_; ++rep_) { { GAS unsigned char* w_ = (GAS unsigned char*)k.ws; asm volatile("" : "+s"(w_)); k.ws = (unsigned char*)w_; }
#define PH_END   if (ph + 1 < hi) xcd_barrier(bar); } } ++ph;

    float* xs = (float*)(k.ws + WS_XS);
    const float* mod = (const float*)(k.ws + WS_MOD);

    PH_BEGIN(0)
        job_mod(k, ldsf);
        job_cvt_small(k, ldsf);
        job_hdn(k, ldsf);
        job_w3s(k);
    PH_END

    for (i = 0; i < DEPTH; ++i) {
        const int kind = i % 3, j = i / 3;
        const bool last = (i == DEPTH - 1);
        PH_BEGIN(1)
            if (kind == 0) norm_mfma<2>(k, i, i == 0, i > 0, k.norm_mix + i * 1024, 0, k.dn_w_in + (size_t)j * 1024 * DN_IN + 4096, DN_IN,
                                        k.dn_a_log + j * 16, k.dn_dt_bias + j * 16, last, lds);
            else norm_vec<0>(k, i, k.norm_mix + i * 1024, 0);
            if (kind == 1) job_filtc(k, j);
        PH_END
        PH_BEGIN(2)
            if (kind == 0) { EpiBf16 e{(bf16_t*)(k.ws + AR_PB), 3072, 3072, (bf16_t*)k.out, 1024}; gemm_dense(lds, (const bf16_t*)(k.ws + AR_HBUF), T, (const bf16_t*)(k.ws + WS_DNWIN) + (size_t)j * 4096 * 1024, 4096, 1024, e); }
            else if (kind == 1) { EpiBf16T e{(bf16_t*)(k.ws + AR_PB), T}; gemm_dense(lds, (const bf16_t*)(k.ws + AR_HBUF), T, (const bf16_t*)(k.ws + WS_HYWIN), 3072, 1024, e);
                                  EpiTaps et{(bf16_t*)(k.ws + AR_FT)}; gemm_dense(lds, (const bf16_t*)(k.ws + WS_W3S), 4096, (const bf16_t*)(k.ws + WS_HS), 16384, 256, et); }
            else { EpiBf16 e{(bf16_t*)(k.ws + AR_PB), 3072, 1 << 30, nullptr, 0}; gemm_dense(lds, (const bf16_t*)(k.ws + AR_HBUF), T, (const bf16_t*)(k.ws + WS_SCWIN), 3072, 1024, e); }
        PH_END
        if (kind == 0) {
            PH_BEGIN(3) dn_chunk(k, j, lds); PH_END
            PH_BEGIN(4) dn_scan(k, lds, rep_ ? PROBE_MODE : 0); PH_END
            PH_BEGIN(5) dn_finish(k, j); PH_END
        } else if (kind == 1) {
            PH_BEGIN(6) hy_lat(k, j, ldsf); hy_ctx(k, j, ldsf); PH_END
            PH_BEGIN(7) hy_transpose(k, ldsh); PH_END
        } else {
            PH_BEGIN(8) sc_mix(k, j); PH_END
        }
        PH_BEGIN(9)
            const bf16_t* Wt = kind == 0 ? (const bf16_t*)(k.ws + WS_DNWOUT) + (size_t)j * 1024 * 1024 : (kind == 1 ? (const bf16_t*)(k.ws + WS_HYWOUT) : (const bf16_t*)(k.ws + WS_SCWOUT));
            EpiResid e{xs, mod, i, 2};
            gemm_dense(lds, (const bf16_t*)(k.ws + AR_UBUF), T, Wt, 1024, 1024, e);
            if (gridDim.x == 256) job_cvt_moe(k, i, ldsf, (int)blockIdx.x - 8, 248); else job_cvt_moe(k, i, ldsf, (int)blockIdx.x, (int)gridDim.x);
        PH_END
        PH_BEGIN(10)
            norm_mfma<1>(k, i, false, false, k.norm_ffn + i * 1024, 3, k.w_router, 32, k.router_bias, nullptr, last, lds, rep_ == nrep_ - 1);
        PH_END
        PH_BEGIN(11)
            moe_scatter(k, i, tb);
        PH_END
        PH_BEGIN(12) moe_gemm<0>(k, i, lds, tb); PH_END
        PH_BEGIN(13) moe_gemm<1>(k, i, lds, tb); PH_END
    }
    PH_BEGIN(14)
        norm_vec<3>(k, DEPTH, k.norm_final, 0);
    PH_END
#undef PH_BEGIN
#undef PH_END
}
constexpr int N_PHASES = 1 + (10 + 9 + 8 + 10) + 1;

extern "C" void kernel_launch(void* const* d_in, const int* in_sizes, int n_in, void* d_out, int out_size, void* d_ws, size_t ws_size, hipStream_t stream) {
    static int grid = 0;
    if (grid == 0) {
        if (n_in != 33 || out_size != TL * D || ws_size < WS_END) { fprintf(stderr, "kernel_launch: unexpected shapes: n_in %d out %d ws %zu (need %zu)\n", n_in, out_size, ws_size, (size_t)WS_END); grid = -1; return; }
        int dev = 0, cus = 0, per_cu = 0;
        if (hipGetDevice(&dev) != hipSuccess || hipDeviceGetAttribute(&cus, hipDeviceAttributeMultiprocessorCount, dev) != hipSuccess) { grid = -1; return; }
        if (hipFuncSetAttribute((const void*)fwd_kernel, hipFuncAttributeMaxDynamicSharedMemorySize, LDS_BYTES) != hipSuccess) { fprintf(stderr, "kernel_launch: hipFuncSetAttribute failed\n"); grid = -1; return; }
        if (hipOccupancyMaxActiveBlocksPerMultiprocessor(&per_cu, (const void*)fwd_kernel, NTHR, LDS_BYTES) != hipSuccess || per_cu < 1) fprintf(stderr, "kernel_launch: occupancy query reports %d\n", per_cu);
        (void)hipGetLastError();
        grid = cus;
    }
    if (grid < 0) return;
    (void)hipMemsetAsync((char*)d_ws + WS_CTL, 0, CTL_BYTES, stream);
    Params p{};
    for (int i = 0; i < 33; ++i) p.in[i] = (const float*)d_in[i];
    p.out = (float*)d_out; p.ws = (unsigned char*)d_ws;
#if MK_MULTI
    for (int ph = 0; ph < N_PHASES; ++ph) { p.ph_lo = ph; p.ph_hi = ph + 1; hipLaunchKernelGGL(fwd_kernel, dim3(grid), dim3(NTHR), LDS_BYTES, stream, p); }
#else
    p.ph_lo = 0; p.ph_hi = N_PHASES;
    hipLaunchKernelGGL(fwd_kernel, dim3(grid), dim3(NTHR), LDS_BYTES, stream, p);
#endif
}
```
